# Optimizing an MI355X kernel written in HIP

```python
import jax, jax.numpy as jnp
from jax import lax
import numpy as np

D_MODEL = 1024
BATCH = 8
SEQ = 4096
DEPTH = 1

CHUNK = 64
Q_BLOCK = 128
SB_WIDTH = D_MODEL // 2
SB_HEAD_DIM = 64
SB_HEADS = SB_WIDTH // SB_HEAD_DIM
ML_WIDTH = D_MODEL - SB_WIDTH
ML_HEADS = 4
ML_HEAD_DIM = ML_WIDTH // ML_HEADS
MIX_WIDTH = SB_WIDTH + ML_WIDTH
CONV_WIDTH = 4
IN_SIZES = (SB_WIDTH, SB_WIDTH, SB_WIDTH, 2 * ML_WIDTH, ML_WIDTH, ML_WIDTH, ML_HEADS, ML_HEADS)
IN_WIDTH = 3 * SB_WIDTH + 4 * ML_WIDTH + 2 * ML_HEADS
PEER_HEADS = 8
PEER_NKEYS = 128
PEER_EXPERTS = PEER_NKEYS * PEER_NKEYS
PEER_TOPK = 16
PEER_QDIM = 256
PEER_HALF = PEER_QDIM // 2
PEER_TOKEN_BLOCK = 128
N_MOD = 6
EPS = 1e-6

kernel_name = "hybrid_stickbreak_mlstm_peer_adaln"


def rms_norm(x, g):
    x32 = x.astype(jnp.float32)
    y = x32 * lax.rsqrt(jnp.mean(x32 * x32, axis=-1, keepdims=True) + EPS)
    return (y * g.astype(jnp.float32)).astype(x.dtype)


def causal_depthwise_conv(x, w):
    return lax.conv_general_dilated(
        x, w[:, None, :].astype(x.dtype), window_strides=(1,),
        padding=[(CONV_WIDTH - 1, 0)], dimension_numbers=('NWC', 'WIO', 'NWC'),
        feature_group_count=x.shape[-1])


def stick_breaking(q, k, v):
    s_len, d = q.shape[2], q.shape[-1]
    scale = d ** -0.5
    outs = []
    for t0 in range(0, s_len, Q_BLOCK):
        t1 = t0 + Q_BLOCK
        z = jnp.einsum('bhtd,bhsd->bhts', q[:, :, t0:t1], k[:, :, :t1]).astype(jnp.float32) * scale
        visible = jnp.arange(t1)[None, :] < jnp.arange(t0, t1)[:, None]
        log_keep = jnp.where(visible, jax.nn.log_sigmoid(-z), 0.0)
        log_between = lax.cumsum(log_keep, axis=3, reverse=True) - log_keep
        w = jnp.where(visible, jnp.exp(jax.nn.log_sigmoid(z) + log_between), 0.0)
        outs.append(jnp.einsum('bhts,bhsd->bhtd', w, v[:, :, :t1].astype(jnp.float32)))
    return jnp.concatenate(outs, axis=2).astype(v.dtype)


def mlstm(q, k, v, i_pre, f_pre):
    b, nh, s_len, d = q.shape
    nc = s_len // CHUNK
    f32 = jnp.float32

    def to_chunks(t):
        t = t.reshape((b, nh, nc, CHUNK) + t.shape[3:])
        return jnp.moveaxis(t, 2, 0)

    qc = to_chunks(q.astype(f32))
    kc = to_chunks(k.astype(f32) * (d ** -0.5))
    vc = to_chunks(v.astype(f32))
    a = jnp.cumsum(to_chunks(jax.nn.log_sigmoid(f_pre.astype(f32))), axis=-1)
    li = to_chunks(i_pre.astype(f32))
    causal = jnp.tril(jnp.ones((CHUNK, CHUNK), dtype=bool))

    def step(carry, inp):
        c_state, n_state, m_state = carry
        q_c, k_c, v_c, a_c, i_c = inp
        log_d = jnp.where(causal, a_c[..., :, None] - a_c[..., None, :] + i_c[..., None, :], -jnp.inf)
        log_inter = a_c + m_state[..., None]
        m_row = jnp.maximum(jnp.max(log_d, axis=-1), log_inter)
        w_intra = jnp.exp(log_d - m_row[..., None])
        w_inter = jnp.exp(log_inter - m_row)
        s_qk = jnp.einsum('bhtk,bhsk->bhts', q_c, k_c) * w_intra
        num = (jnp.einsum('bhts,bhsv->bhtv', s_qk, v_c)
               + w_inter[..., None] * jnp.einsum('bhvk,bhtk->bhtv', c_state, q_c))
        den = jnp.sum(s_qk, axis=-1) + w_inter * jnp.einsum('bhk,bhtk->bht', n_state, q_c)
        h = num / jnp.maximum(jnp.abs(den), jnp.exp(-m_row))[..., None]
        a_end = a_c[..., -1]
        log_w = a_end[..., None] - a_c + i_c
        m_new = jnp.maximum(a_end + m_state, jnp.max(log_w, axis=-1))
        w_s = jnp.exp(log_w - m_new[..., None])
        decay = jnp.exp(a_end + m_state - m_new)
        c_new = decay[..., None, None] * c_state + jnp.einsum('bhs,bhsv,bhsk->bhvk', w_s, v_c, k_c)
        n_new = decay[..., None] * n_state + jnp.einsum('bhs,bhsk->bhk', w_s, k_c)
        return (c_new, n_new, m_new), h

    init = (jnp.zeros((b, nh, d, d), f32), jnp.zeros((b, nh, d), f32), jnp.zeros((b, nh), f32))
    _, h = lax.scan(step, init, (qc, kc, vc, a, li))
    h = jnp.moveaxis(h, 0, 2).reshape(b, nh, s_len, d)
    return h.astype(v.dtype)


def peer(h, w_q, sub_keys, expert_u, expert_v):
    b, s_len, d = h.shape
    q = jnp.einsum('bsd,dq->bsq', h, w_q).reshape(b, s_len, PEER_HEADS, 2, PEER_HALF)
    scores = jnp.einsum('bshpc,hpnc->bshpn', q, sub_keys).astype(jnp.float32)
    top_s, top_i = lax.top_k(scores, PEER_TOPK)
    cand_s = (top_s[..., 0, :, None] + top_s[..., 1, None, :]).reshape(b, s_len, PEER_HEADS, PEER_TOPK * PEER_TOPK)
    cand_i = (top_i[..., 0, :, None] * PEER_NKEYS + top_i[..., 1, None, :]).reshape(b, s_len, PEER_HEADS, PEER_TOPK * PEER_TOPK)
    best_s, best_pos = lax.top_k(cand_s, PEER_TOPK)
    best_i = jnp.take_along_axis(cand_i, best_pos, axis=-1)
    gate = jax.nn.softmax(best_s, axis=-1)
    n_sel = PEER_HEADS * PEER_TOPK
    nb = (b * s_len) // PEER_TOKEN_BLOCK
    xs = h.reshape(nb, PEER_TOKEN_BLOCK, d)
    idx = best_i.reshape(nb, PEER_TOKEN_BLOCK, n_sel)
    gs = gate.reshape(nb, PEER_TOKEN_BLOCK, n_sel)

    def token_block(args):
        xb, ib, gb = args
        u = jnp.take(expert_u, ib, axis=0)
        act = jax.nn.gelu(jnp.einsum('td,tkd->tk', xb, u).astype(jnp.float32), approximate=False)
        vv = jnp.take(expert_v, ib, axis=0)
        return jnp.einsum('tk,tkd->td', (gb * act).astype(h.dtype), vv)

    y = lax.map(token_block, (xs, idx, gs))
    return y.reshape(b, s_len, d)


def setup_inputs(seed: int = 0) -> dict:
    key = jax.random.key(seed)
    ks = jax.random.split(key, 20)
    nrm = jax.random.normal
    D = D_MODEL
    return {
        "x": nrm(ks[0], (BATCH, SEQ, D), jnp.float32),
        "c": nrm(ks[1], (BATCH, D), jnp.float32),
        "w_ada": nrm(ks[2], (DEPTH, D, N_MOD * D), jnp.float32) * (0.5 * D ** -0.5),
        "b_ada": nrm(ks[3], (DEPTH, N_MOD * D), jnp.float32) * 0.02,
        "g_norm1": 1.0 + 0.02 * nrm(ks[4], (DEPTH, D), jnp.float32),
        "w_in": nrm(ks[5], (DEPTH, D, IN_WIDTH), jnp.float32) * D ** -0.5,
        "b_igate": 0.1 * nrm(ks[6], (DEPTH, ML_HEADS), jnp.float32),
        "b_fgate": 3.0 + 3.0 * jax.random.uniform(ks[7], (DEPTH, ML_HEADS), jnp.float32),
        "conv_w": nrm(ks[8], (DEPTH, CONV_WIDTH, 2 * ML_WIDTH), jnp.float32) * CONV_WIDTH ** -0.5,
        "g_q_sb": 1.0 + 0.02 * nrm(ks[9], (DEPTH, SB_HEAD_DIM), jnp.float32),
        "g_k_sb": 1.0 + 0.02 * nrm(ks[10], (DEPTH, SB_HEAD_DIM), jnp.float32),
        "g_out_sb": 1.0 + 0.02 * nrm(ks[11], (DEPTH, SB_HEADS, SB_HEAD_DIM), jnp.float32),
        "g_out_ml": 1.0 + 0.02 * nrm(ks[12], (DEPTH, ML_HEADS, ML_HEAD_DIM), jnp.float32),
        "w_out": nrm(ks[13], (DEPTH, MIX_WIDTH, D), jnp.float32) * MIX_WIDTH ** -0.5,
        "g_norm2": 1.0 + 0.02 * nrm(ks[14], (DEPTH, D), jnp.float32),
        "w_q_peer": nrm(ks[15], (DEPTH, D, PEER_HEADS * PEER_QDIM), jnp.float32) * D ** -0.5,
        "sub_keys": nrm(ks[16], (DEPTH, PEER_HEADS, 2, PEER_NKEYS, PEER_HALF), jnp.float32) * PEER_HALF ** -0.5,
        "expert_u": nrm(ks[17], (DEPTH, PEER_EXPERTS, D), jnp.float32) * D ** -0.5,
        "expert_v": nrm(ks[18], (DEPTH, PEER_EXPERTS, D), jnp.float32),
    }


def reference(x, c, w_ada, b_ada, g_norm1, w_in, b_igate, b_fgate, conv_w, g_q_sb, g_k_sb,
              g_out_sb, g_out_ml, w_out, g_norm2, w_q_peer, sub_keys, expert_u, expert_v):
    b, s_len, _ = x.shape
    cuts = []
    acc = 0
    for size in IN_SIZES[:-1]:
        acc += size
        cuts.append(acc)

    def to_heads(t, n):
        return t.reshape(b, s_len, n, -1).transpose(0, 2, 1, 3)

    for l in range(DEPTH):
        mod = jnp.einsum('bd,dm->bm', jax.nn.silu(c), w_ada[l]) + b_ada[l]
        shift1, scale1, gate1, shift2, scale2, gate2 = jnp.split(mod[:, None, :], N_MOD, axis=-1)

        h = rms_norm(x, g_norm1[l]) * (1 + scale1) + shift1
        proj = jnp.einsum('bsd,dn->bsn', h, w_in[l])
        q_sb, k_sb, v_sb, qk_ml, v_ml, o_ml, i_ml, f_ml = jnp.split(proj, cuts, axis=-1)

        q_sb = rms_norm(to_heads(q_sb, SB_HEADS), g_q_sb[l])
        k_sb = rms_norm(to_heads(k_sb, SB_HEADS), g_k_sb[l])
        y_sb = stick_breaking(q_sb, k_sb, to_heads(v_sb, SB_HEADS)).transpose(0, 2, 1, 3)
        y_sb = rms_norm(y_sb, g_out_sb[l])

        qk_ml = jax.nn.silu(causal_depthwise_conv(qk_ml, conv_w[l]))
        q_ml, k_ml = jnp.split(qk_ml, 2, axis=-1)
        i_pre = (i_ml + b_igate[l]).transpose(0, 2, 1)
        f_pre = (f_ml + b_fgate[l]).transpose(0, 2, 1)
        y_ml = mlstm(to_heads(q_ml, ML_HEADS), to_heads(k_ml, ML_HEADS), to_heads(v_ml, ML_HEADS), i_pre, f_pre)
        y_ml = rms_norm(y_ml.transpose(0, 2, 1, 3), g_out_ml[l]) * jax.nn.sigmoid(o_ml).reshape(b, s_len, ML_HEADS, ML_HEAD_DIM)

        mixed = jnp.concatenate([y_sb.reshape(b, s_len, SB_WIDTH), y_ml.reshape(b, s_len, ML_WIDTH)], axis=-1)
        x = x + gate1 * jnp.einsum('bsm,md->bsd', mixed, w_out[l])

        h2 = rms_norm(x, g_norm2[l]) * (1 + scale2) + shift2
        x = x + gate2 * peer(h2, w_q_peer[l], sub_keys[l], expert_u[l], expert_v[l])
    return x
```

```cpp
#define MK_PER_PHASE 1
#include <cmath>
#include <hip/hip_runtime.h>
#include <cstdio>
#include <cstdint>
namespace pg8 {
#define PG8_LAS __attribute__((address_space(3)))
typedef unsigned short bf16_t;
typedef short bf16x8 __attribute__((ext_vector_type(8)));
typedef float f32x4 __attribute__((ext_vector_type(4)));
typedef unsigned u32x4 __attribute__((ext_vector_type(4)));
constexpr int BM = 256, BK = 64, HALF = 128, HTB = HALF * BK * 2  , STAGE_BYTES = 8 * HTB, NXCD = 8, WGM = 8;

__host__ __device__ __forceinline__ int lds_byte(int r, int c) { const int st = (r >> 4) * 2 + (c >> 5), rr = r & 15, cc = c & 31, ob = rr * 64 + cc * 2; return st * 1024 + (ob ^ (((ob >> 9) & 1) << 5)); }
__host__ __device__ __forceinline__ void stage_rc(int b, int& R, int& C) { const int st = b / 1024, sb = b % 1024, swz = sb ^ (((sb >> 9) & 1) << 5); R = (st >> 1) * 16 + swz / 64; C = (st & 1) * 32 + (swz % 64) / 2; }
__host__ __device__ __forceinline__ int perm32(int rho) { const int n = rho >> 4, i = rho & 15; return 8 * (i >> 2) + 4 * n + (i & 3); }

struct Unit { int pm, pn; };
struct Gemm { const bf16_t* A; const bf16_t* Bt; int M, N, K; };

struct StaticOrder {
    int nM, nN, nwg, G, c;
    __host__ __device__ void init(int M, int N, int G_, int c_) { nM = M / BM; nN = N / BM; nwg = nM * nN; G = G_; c = c_; }
    __host__ __device__ bool next(int i, Unit& u) const {
        const long L = (long)i * G + c; if (L >= nwg) return false;
        int wgid = (int)L; { const int q = nwg / NXCD, r = nwg % NXCD, xcd = wgid % NXCD, off = wgid / NXCD; wgid = (xcd < r ? xcd * (q + 1) : r * (q + 1) + (xcd - r) * q) + off; }
        const int nig = WGM * nN, gid = wgid / nig, fm = gid * WGM, gsz = (nM - fm) < WGM ? (nM - fm) : WGM;
        u.pm = fm + ((wgid % nig) % gsz); u.pn = (wgid % nig) / gsz; return true;
    }
    __device__ __forceinline__ void a_ready(const Unit&) const {}
    __device__ __forceinline__ void done(const Unit&) const {}
};

__device__ __forceinline__ unsigned cvt_pk_bf16(float lo, float hi) { unsigned r; asm volatile("v_cvt_pk_bf16_f32 %0, %1, %2" : "=v"(r) : "v"(lo), "v"(hi)); return r; }
typedef float f32x2 __attribute__((ext_vector_type(2)));
__device__ __forceinline__ f32x2 gelu_pk(f32x2 v) {
    const f32x2 av = __builtin_elementwise_abs(v), d = av * 0.2316418882f + 1.0f;
    f32x2 t; t.x = __builtin_amdgcn_rcpf(d.x); t.y = __builtin_amdgcn_rcpf(d.y);
    f32x2 q = t * 0.5307027145f + (-0.7265760135f); q = q * t + 0.7107068705f; q = q * t + (-0.142248368f); q = q * t + 0.127414796f; q = q * t;
    const f32x2 s = (v * v) * (-0.72134752044f);
    f32x2 e; e.x = __builtin_amdgcn_exp2f(s.x); e.y = __builtin_amdgcn_exp2f(s.y);
    const f32x2 m = v * (q * e), r = v - m;
    f32x2 o; o.x = v.x < 0.f ? m.x : r.x; o.y = v.y < 0.f ? m.y : r.y; return o;
}

template <int ACT  > struct EpiBf16 {
    static constexpr bool PERM = true, AFTER_DRAIN = false; static_assert(ACT == 0 || ACT == 1, "EpiBf16: ACT is 0 (none) or 1 (gelu_pk)");
    bf16_t* O; int ldc; const float* bias; int split_cols; size_t split_stride; float scale0;
    __device__ __forceinline__ void operator()(const f32x4 (&acc)[2][2][4][2], const Unit& u, int wr, int wc, int fr, int fq) const {
        const int row0 = u.pm * BM + wr * 64 + fr; int colt = u.pn * BM; bf16_t* base = O;
        float sc = 1.f; if (split_cols) { const int t = colt / split_cols; base += (size_t)t * split_stride; colt -= t * split_cols; if (t == 0) sc = scale0; }
        const int col0 = colt + wc * 32 + 8 * fq, bcol0 = u.pn * BM + wc * 32 + 8 * fq;
        f32x4 bv[2][2];
#pragma unroll
        for (int bj = 0; bj < 2; ++bj)
#pragma unroll
            for (int n = 0; n < 2; ++n) bv[bj][n] = bias ? *(const f32x4*)(bias + bcol0 + bj * HALF + 4 * n) : (f32x4){0.f, 0.f, 0.f, 0.f};
#pragma unroll
        for (int ai = 0; ai < 2; ++ai)
#pragma unroll
            for (int m = 0; m < 4; ++m) { bf16_t* rowp = base + (size_t)(row0 + ai * HALF + m * 16) * ldc + col0;
#pragma unroll
                for (int bj = 0; bj < 2; ++bj) { f32x4 v0 = acc[ai][bj][m][0] + bv[bj][0], v1 = acc[ai][bj][m][1] + bv[bj][1];
                    if (ACT == 1) { f32x2 a = gelu_pk((f32x2){v0[0], v0[1]}), b = gelu_pk((f32x2){v0[2], v0[3]}), c = gelu_pk((f32x2){v1[0], v1[1]}), d = gelu_pk((f32x2){v1[2], v1[3]});
                        v0 = (f32x4){a.x, a.y, b.x, b.y}; v1 = (f32x4){c.x, c.y, d.x, d.y}; }
                    v0 = v0 * sc; v1 = v1 * sc; u32x4 w; w.x = cvt_pk_bf16(v0[0], v0[1]); w.y = cvt_pk_bf16(v0[2], v0[3]); w.z = cvt_pk_bf16(v1[0], v1[1]); w.w = cvt_pk_bf16(v1[2], v1[3]);
                    *(u32x4*)(rowp + bj * HALF) = w; } }
    }
};
template <class Epi, class Sched, bool ALIGN_EPI = false, bool SP2 = false>
__device__ __forceinline__ void gemm_phase(PG8_LAS unsigned char* lds, const Gemm g, const Sched& S, const Epi& E) {
    const int tid = threadIdx.x, wid = __builtin_amdgcn_readfirstlane(tid >> 6), lane = tid & 63, wr = wid >> 2, wc = wid & 3, fr = lane & 15, fq = lane >> 4;
    const int K = g.K, nt = K / BK;
    unsigned voffA[2], voffB[2];
#pragma unroll
    for (int i = 0; i < 2; ++i) { int R, C; stage_rc(tid * 16 + i * 8192, R, C); const int Rb = Epi::PERM ? ((R & ~31) + perm32(R & 31)) : R;
        voffA[i] = (unsigned)(R * K + C) * 2u; voffB[i] = (unsigned)(Rb * K + C) * 2u; }
    const size_t kstep = (size_t)(BK * 2);
    const size_t hstep = (size_t)HALF * K * 2;
    const size_t tstep = 2 * hstep;
    const unsigned ldsw = (unsigned)wid * 1024u;
    const int aoff = lds_byte(wr * 64 + fr, fq * 8), boff = lds_byte(wc * 32 + fr, fq * 8);
#define PG8_SA(b, h) (((b) * 2 + (h)) * HTB)
#define PG8_SB(b, h) ((4 + (b) * 2 + (h)) * HTB)
#define PG8_STAGE(bufoff, gbase, voff) do { _Pragma("unroll") for (int _i = 0; _i < 2; ++_i) \
        __builtin_amdgcn_global_load_lds((const unsigned*)((const char*)(gbase) + (voff)[_i]), (PG8_LAS unsigned*)(lds + (bufoff) + ldsw + _i * 8192), 16, 0, 0); } while (0)
#define PG8_LDA(dst, b, h) do { _Pragma("unroll") for (int m = 0; m < 4; ++m) _Pragma("unroll") for (int k = 0; k < 2; ++k) dst[m][k] = *(const PG8_LAS bf16x8*)(lds + PG8_SA(b, h) + aoff + m * 2048 + k * 1024); } while (0)
#define PG8_LDB(dst, b, h) do { _Pragma("unroll") for (int n = 0; n < 2; ++n) _Pragma("unroll") for (int k = 0; k < 2; ++k) dst[n][k] = *(const PG8_LAS bf16x8*)(lds + PG8_SB(b, h) + boff + n * 2048 + k * 1024); } while (0)
#define PG8_MMA(ai, bj, At, Bt) do { __builtin_amdgcn_s_setprio(1); _Pragma("unroll") for (int m = 0; m < 4; ++m) _Pragma("unroll") for (int n = 0; n < 2; ++n) _Pragma("unroll") for (int k = 0; k < 2; ++k) \
        acc[ai][bj][m][n] = __builtin_amdgcn_mfma_f32_16x16x32_bf16(Bt[n][k], At[m][k], acc[ai][bj][m][n], 0, 0, 0); __builtin_amdgcn_s_setprio(0); } while (0)
#define PG8_WAIT_V(n) asm volatile("s_waitcnt vmcnt(" #n ")" ::: "memory")
#define PG8_WAIT_L(n) asm volatile("s_waitcnt lgkmcnt(" #n ")" ::: "memory")
#define PG8_BAR __builtin_amdgcn_s_barrier()
#define PG8_SCHED __builtin_amdgcn_sched_barrier(0)
    Unit cur, nxt; int ui = 0;
    if (!S.next(0, cur)) return;
    f32x4 acc[2][2][4][2];
#pragma unroll
    for (int a = 0; a < 2; ++a)
#pragma unroll
        for (int b = 0; b < 2; ++b)
#pragma unroll
            for (int m = 0; m < 4; ++m)
#pragma unroll
                for (int n = 0; n < 2; ++n) acc[a][b][m][n] = (f32x4){0.f, 0.f, 0.f, 0.f};
    bf16x8 At[4][2], B0[2][2], B1[2][2];
    const char* cA = (const char*)g.A + (size_t)cur.pm * tstep; const char* cB = (const char*)g.Bt + (size_t)cur.pn * tstep;
    S.a_ready(cur);
    if constexpr (SP2) {
        PG8_STAGE(PG8_SB(0, 0), cB, voffB); PG8_STAGE(PG8_SB(0, 1), cB + hstep, voffB); PG8_STAGE(PG8_SA(0, 0), cA, voffA); PG8_STAGE(PG8_SA(0, 1), cA + hstep, voffA);
        if (wr == 1) PG8_BAR;
        PG8_WAIT_V(2); PG8_BAR;
        PG8_STAGE(PG8_SB(1, 0), cB + kstep, voffB); PG8_STAGE(PG8_SA(1, 0), cA + kstep, voffA); PG8_STAGE(PG8_SB(1, 1), cB + hstep + kstep, voffB);
        PG8_WAIT_V(6); PG8_BAR;
    } else {
        PG8_STAGE(PG8_SB(0, 0), cB, voffB); PG8_STAGE(PG8_SA(0, 0), cA, voffA); PG8_STAGE(PG8_SB(0, 1), cB + hstep, voffB); PG8_STAGE(PG8_SA(0, 1), cA + hstep, voffA);
        if (wr == 1) PG8_BAR;
        PG8_WAIT_V(4); PG8_BAR;
        PG8_STAGE(PG8_SB(1, 0), cB + kstep, voffB); PG8_STAGE(PG8_SA(1, 0), cA + kstep, voffA); PG8_STAGE(PG8_SB(1, 1), cB + hstep + kstep, voffB);
        PG8_WAIT_V(6); PG8_BAR;
    }
    for (;;) {
        const bool has_next = S.next(ui + 1, nxt);
        const char* nA = has_next ? (const char*)g.A + (size_t)nxt.pm * tstep : cA; const char* nB = has_next ? (const char*)g.Bt + (size_t)nxt.pn * tstep : cB;
        for (int t = 0; t < nt; t += 2) {
            const bool last = (t == nt - 2);
            const char* a1 = cA + (size_t)(t + 1) * kstep;
            const char* a2 = last ? nA : cA + (size_t)(t + 2) * kstep; const char* b2 = last ? nB : cB + (size_t)(t + 2) * kstep;
            const char* a3 = a2 + kstep; const char* b3 = b2 + kstep;
            if (last && has_next) S.a_ready(nxt);
            if constexpr (SP2) {
            PG8_LDB(B0, 0, 0); PG8_LDB(B1, 0, 1); PG8_SCHED; PG8_LDA(At, 0, 0); PG8_STAGE(PG8_SA(1, 1), a1 + hstep, voffA);
            PG8_WAIT_V(8); PG8_WAIT_L(0); PG8_BAR; PG8_MMA(0, 0, At, B0); PG8_MMA(0, 1, At, B1); PG8_BAR; PG8_SCHED;
            PG8_LDA(At, 0, 1); PG8_STAGE(PG8_SB(0, 0), b2, voffB); PG8_STAGE(PG8_SB(0, 1), b2 + hstep, voffB); PG8_STAGE(PG8_SA(0, 0), a2, voffA);
            PG8_WAIT_V(8); PG8_WAIT_L(0); PG8_BAR; PG8_MMA(1, 0, At, B0); PG8_MMA(1, 1, At, B1); PG8_BAR; PG8_SCHED;
            PG8_LDB(B0, 1, 0); PG8_LDB(B1, 1, 1); PG8_SCHED; PG8_LDA(At, 1, 0); PG8_STAGE(PG8_SA(0, 1), a2 + hstep, voffA);
            PG8_WAIT_V(8); PG8_WAIT_L(0); PG8_BAR; PG8_MMA(0, 0, At, B0); PG8_MMA(0, 1, At, B1); PG8_BAR; PG8_SCHED;
            PG8_LDA(At, 1, 1); PG8_STAGE(PG8_SB(1, 0), b3, voffB); PG8_STAGE(PG8_SB(1, 1), b3 + hstep, voffB); PG8_STAGE(PG8_SA(1, 0), a3, voffA);
            PG8_WAIT_V(8); PG8_WAIT_L(0); PG8_BAR; PG8_MMA(1, 0, At, B0); PG8_MMA(1, 1, At, B1); PG8_BAR; PG8_SCHED;
            } else {
            PG8_LDB(B0, 0, 0); PG8_SCHED; PG8_LDA(At, 0, 0); PG8_STAGE(PG8_SA(1, 1), a1 + hstep, voffA);
            PG8_WAIT_L(8); PG8_BAR; PG8_WAIT_L(0); PG8_MMA(0, 0, At, B0); PG8_BAR; PG8_SCHED;
            PG8_LDB(B1, 0, 1); PG8_STAGE(PG8_SB(0, 0), b2, voffB);
            PG8_BAR; PG8_WAIT_L(0); PG8_MMA(0, 1, At, B1); PG8_BAR;
            PG8_LDA(At, 0, 1); PG8_STAGE(PG8_SA(0, 0), a2, voffA);
            PG8_BAR; PG8_WAIT_L(0); PG8_MMA(1, 0, At, B0); PG8_BAR; PG8_SCHED;
            PG8_STAGE(PG8_SB(0, 1), b2 + hstep, voffB);
            PG8_WAIT_V(6); PG8_BAR; PG8_MMA(1, 1, At, B1); PG8_BAR;
            PG8_LDB(B0, 1, 0); PG8_SCHED; PG8_LDA(At, 1, 0); PG8_STAGE(PG8_SA(0, 1), a2 + hstep, voffA);
            PG8_WAIT_L(8); PG8_BAR; PG8_WAIT_L(0); PG8_MMA(0, 0, At, B0); PG8_BAR; PG8_SCHED;
            PG8_LDB(B1, 1, 1); PG8_STAGE(PG8_SB(1, 0), b3, voffB);
            PG8_BAR; PG8_WAIT_L(0); PG8_MMA(0, 1, At, B1); PG8_BAR;
            PG8_LDA(At, 1, 1); PG8_STAGE(PG8_SA(1, 0), a3, voffA);
            PG8_BAR; PG8_WAIT_L(0); PG8_MMA(1, 0, At, B0); PG8_BAR; PG8_SCHED;
            PG8_STAGE(PG8_SB(1, 1), b3 + hstep, voffB);
            PG8_WAIT_V(6); PG8_BAR; PG8_MMA(1, 1, At, B1); PG8_BAR;
            }
        }
        if constexpr (ALIGN_EPI) { if (wr == 0) PG8_BAR; }
        if constexpr (!Epi::AFTER_DRAIN) { E(acc, cur, wr, wc, fr, fq); S.done(cur); }
        if (!has_next) break;
#pragma unroll
        for (int a = 0; a < 2; ++a)
#pragma unroll
            for (int b = 0; b < 2; ++b)
#pragma unroll
                for (int m = 0; m < 4; ++m)
#pragma unroll
                    for (int n = 0; n < 2; ++n) acc[a][b][m][n] = (f32x4){0.f, 0.f, 0.f, 0.f};
        cur = nxt; cA = nA; cB = nB; ++ui;
        if constexpr (ALIGN_EPI) { if (wr == 1) PG8_BAR; }
    }
    PG8_WAIT_V(0);
    if constexpr (!ALIGN_EPI) { if (wr == 0) PG8_BAR; }
    PG8_BAR;
    if constexpr (Epi::AFTER_DRAIN) { E.fused(acc, cur, wr, wc, fr, fq, lds, wid, lane); S.done(cur); }
#undef PG8_SA
#undef PG8_SB
#undef PG8_STAGE
#undef PG8_LDA
#undef PG8_LDB
#undef PG8_MMA
#undef PG8_WAIT_V
#undef PG8_WAIT_L
#undef PG8_BAR
#undef PG8_SCHED
}
}

#ifndef PG8_SP2
#define PG8_SP2 true
#endif
#ifndef PG8_ALIGN
#define PG8_ALIGN true
#endif

namespace pg8 {
struct EpiResGate {
    static constexpr bool PERM = false, AFTER_DRAIN = false;
    const float* base; float* out; const float* gate; int gate_ld; int rows_per_batch; int ldc;
    __device__ __forceinline__ void operator()(const f32x4 (&acc)[2][2][4][2], const Unit& u, int wr, int wc, int fr, int fq) const {
        const int row0 = u.pm * BM + wr * 64 + fr, col0 = u.pn * BM + wc * 32 + 4 * fq;
        const float* gp = gate + (size_t)((u.pm * BM) / rows_per_batch) * gate_ld + col0;
        f32x4 gv[2][2];
#pragma unroll
        for (int bj = 0; bj < 2; ++bj)
#pragma unroll
            for (int n = 0; n < 2; ++n) gv[bj][n] = *(const f32x4*)(gp + bj * HALF + n * 16);
#pragma unroll
        for (int ai = 0; ai < 2; ++ai)
#pragma unroll
            for (int m = 0; m < 4; ++m) { const size_t off = (size_t)(row0 + ai * HALF + m * 16) * ldc + col0;
#pragma unroll
                for (int bj = 0; bj < 2; ++bj)
#pragma unroll
                    for (int n = 0; n < 2; ++n) { const f32x4 bs = *(const f32x4*)(base + off + bj * HALF + n * 16);
                        *(f32x4*)(out + off + bj * HALF + n * 16) = bs + gv[bj][n] * acc[ai][bj][m][n]; } }
    }
};
struct EpiF32 {
    static constexpr bool PERM = false, AFTER_DRAIN = false;
    float* O; int ldc;
    __device__ __forceinline__ void operator()(const f32x4 (&acc)[2][2][4][2], const Unit& u, int wr, int wc, int fr, int fq) const {
        const int row0 = u.pm * BM + wr * 64 + fr, col0 = u.pn * BM + wc * 32 + 4 * fq;
#pragma unroll
        for (int ai = 0; ai < 2; ++ai)
#pragma unroll
            for (int m = 0; m < 4; ++m) { const size_t off = (size_t)(row0 + ai * HALF + m * 16) * ldc + col0;
#pragma unroll
                for (int bj = 0; bj < 2; ++bj)
#pragma unroll
                    for (int n = 0; n < 2; ++n) *(f32x4*)(O + off + bj * HALF + n * 16) = acc[ai][bj][m][n]; }
    }
};
}
#define GAS __attribute__((address_space(1)))
#define LAS __attribute__((address_space(3)))
typedef unsigned short bf16;
typedef unsigned v4u __attribute__((ext_vector_type(4)));
typedef float f32x4 __attribute__((ext_vector_type(4)));
typedef short bf16x8 __attribute__((ext_vector_type(8)));
typedef GAS unsigned gu32;
typedef GAS unsigned long long gu64;
#define RLX_AGENT __ATOMIC_RELAXED, __HIP_MEMORY_SCOPE_AGENT
#define LDS_WAIT() asm volatile("s_waitcnt lgkmcnt(0)" ::: "memory")
#define VM_WAIT() asm volatile("s_waitcnt vmcnt(0)" ::: "memory")
__device__ __forceinline__ unsigned long long rt() { return __builtin_amdgcn_s_memrealtime(); }
__device__ __forceinline__ unsigned f2bf(float f) { unsigned u = __builtin_bit_cast(unsigned, f); return (u + 0x7fffu + ((u >> 16) & 1u)) >> 16; }
__device__ __forceinline__ unsigned pk2(float lo, float hi) { return f2bf(lo) | (f2bf(hi) << 16); }

#define XB_TMO      128
#define XB_XCNT(j)  (256  + 64 * (j))
#define XB_XSUB(j)  (1280 + 64 * (j))
#define XB_XGEN(j)  (2304 + 64 * (j))
#define XB_TOP      3328
#define XB_TOPGEN   3392
#define XCD_BAR_WORDS 3456
#define XB_SPIN_CAP (1u << 24)

__device__ __forceinline__ unsigned xb_ld(unsigned* p)              { return __hip_atomic_load(p, __ATOMIC_RELAXED, __HIP_MEMORY_SCOPE_AGENT); }
__device__ __forceinline__ unsigned xb_add(unsigned* p, unsigned v) { return __hip_atomic_fetch_add(p, v, __ATOMIC_RELAXED, __HIP_MEMORY_SCOPE_AGENT); }
__device__ __forceinline__ unsigned xb_xcc_id() { return (unsigned)__builtin_amdgcn_s_getreg((3 << 11) | 20) & 0xFu; }
#define XB_SPIN(cond, bar) do { unsigned _sp = 0; while (cond) { __builtin_amdgcn_s_sleep(1); \
    if ((++_sp & 255u) == 0u) { if (xb_ld(&(bar)[XB_TMO])) break; if (_sp > XB_SPIN_CAP) { atomicAdd(&(bar)[XB_TMO], 1u); break; } } } } while (0)

struct XcdBarrier {
    unsigned* bar; unsigned x;
    volatile LAS unsigned* st;
};

__device__ __forceinline__ XcdBarrier xcd_barrier_post(unsigned* bar, volatile LAS unsigned* st) {
    XcdBarrier b; b.bar = bar; b.x = xb_xcc_id(); b.st = st;
    if (threadIdx.x == 0) (void)xb_add(&bar[XB_XCNT(b.x)], 1u);
    return b;
}
__device__ __forceinline__ void xcd_barrier_complete(unsigned* bar, unsigned x, unsigned& nloc, unsigned& nx) {
    const unsigned G = gridDim.x * gridDim.y * gridDim.z;
    unsigned sum, cnt, mine, sp = 0u;
    for (;;) {
        sum = 0u; cnt = 0u; mine = 0u;
#pragma unroll
        for (unsigned j = 0; j < 16; ++j) { const unsigned c = xb_ld(&bar[XB_XCNT(j)]); sum += c; cnt += (c > 0u) ? 1u : 0u; mine = (j == x) ? c : mine; }
        if (sum == G) break;
        __builtin_amdgcn_s_sleep(1);
        if ((++sp & 255u) == 0u) { if (xb_ld(&bar[XB_TMO])) break; if (sp > XB_SPIN_CAP) { atomicAdd(&bar[XB_TMO], 1u); break; } }
    }
    nloc = mine > 0u ? mine : 1u; nx = cnt > 0u ? cnt : 1u;
}

__device__ __forceinline__ void xcd_barrier(const XcdBarrier& b) {
    asm volatile("s_waitcnt vmcnt(0)" ::: "memory");
    __syncthreads();
    if (threadIdx.x == 0) {
        unsigned* bar = b.bar;
        __builtin_amdgcn_s_waitcnt(0);
        unsigned nloc = b.st[0], nx = b.st[1];
        if (nloc == 0u) { xcd_barrier_complete(bar, b.x, nloc, nx); b.st[0] = nloc; b.st[1] = nx; }
        const unsigned old = xb_add(&bar[XB_XSUB(b.x)], 1u);
        const unsigned gen = old / nloc;
        if (old + 1u == (gen + 1u) * nloc) {
            __builtin_amdgcn_fence(__ATOMIC_RELEASE, "agent");
            asm volatile("s_waitcnt vmcnt(0)" ::: "memory");
            const unsigned og = xb_add(&bar[XB_TOP], 1u);
            const unsigned tg = og / nx;
            if (og + 1u == (tg + 1u) * nx) xb_add(&bar[XB_TOPGEN], 1u);
            else XB_SPIN(xb_ld(&bar[XB_TOPGEN]) == tg, bar);
            __builtin_amdgcn_fence(__ATOMIC_ACQUIRE, "agent");
            xb_add(&bar[XB_XGEN(b.x)], 1u);
            asm volatile("s_waitcnt vmcnt(0)" ::: "memory");
        } else {
            XB_SPIN(xb_ld(&bar[XB_XGEN(b.x)]) == gen, bar);
            __builtin_amdgcn_fence(__ATOMIC_ACQUIRE, "agent");
            asm volatile("s_waitcnt vmcnt(0)" ::: "memory");
        }
    }
    __syncthreads();
}

constexpr int NWAVES = 8, NTHR = 512;
constexpr int NB = 8, SEQ = 4096, T = NB * SEQ, D = 1024, NPROJ = 3584, NIN = 3592, NMOD = 6144, NSC = 2048;
constexpr int C_QSB = 0, C_KSB = 512, C_VSB = 1024, C_QML = 1536, C_KML = 2048, C_VML = 2560, C_OML = 3072;
constexpr float EPS = 1e-6f, LOG2E = 1.4426950408889634f;
constexpr size_t MiB = 1u << 20;
constexpr size_t WS_CTL = 0, CTL_ZERO_BYTES = 1 * MiB;
constexpr size_t WS_MOD = 256 * 1024;
constexpr size_t WS_WIN = 2 * MiB, WS_WOUT = 10 * MiB, WS_WEFF = 12 * MiB;
constexpr size_t WS_XN = 16 * MiB;
constexpr size_t WS_PROJ = 80 * MiB;
constexpr size_t WS_MIX = 304 * MiB;
constexpr size_t WS_EXPU = 368 * MiB, WS_EXPV = 400 * MiB;
constexpr size_t WS_CST = 432 * MiB;
constexpr size_t WS_NST = 496 * MiB;
constexpr size_t WS_MST = 497 * MiB;
constexpr size_t WS_GATES = 498 * MiB;
constexpr size_t WS_SCORES = 80 * MiB;
constexpr size_t WS_IDX = 336 * MiB, WS_GATE = 352 * MiB;
constexpr size_t WS_END = 500 * MiB;
constexpr int CW_Q3 = 64;
constexpr int CW_BAR = 4096;
constexpr int LDS_BYTES = 147456, LDSCTL_OFF = 143360;

typedef float f32x16 __attribute__((ext_vector_type(16)));
typedef float f32x2_t __attribute__((ext_vector_type(2)));
typedef __bf16 bf16x2_t __attribute__((ext_vector_type(2)));
typedef _Float16 f16x8 __attribute__((ext_vector_type(8)));
typedef short s16x4 __attribute__((ext_vector_type(4)));
typedef unsigned u32x2 __attribute__((ext_vector_type(2)));
#define DI __device__ __forceinline__
DI unsigned cvtpk(float lo, float hi) { f32x2_t v = {lo, hi}; bf16x2_t b = __builtin_convertvector(v, bf16x2_t); return __builtin_bit_cast(unsigned, b); }
DI float bflo(unsigned u) { return __uint_as_float(u << 16); }
DI float bfhi(unsigned u) { return __uint_as_float(u & 0xffff0000u); }
DI int crow(int i, int hi) { return (i & 3) + 8 * (i >> 2) + 4 * hi; }
DI int krow(int s, int hi, int j) { return 16 * s + 8 * (j >> 2) + 4 * hi + (j & 3); }
DI float swap_add(float v) { auto rr = __builtin_amdgcn_permlane32_swap(__float_as_uint(v), __float_as_uint(v), false, false); return __uint_as_float(rr[0]) + __uint_as_float(rr[1]); }
DI float swap_max(float v) { auto rr = __builtin_amdgcn_permlane32_swap(__float_as_uint(v), __float_as_uint(v), false, false); return fmaxf(__uint_as_float(rr[0]), __uint_as_float(rr[1])); }
DI float ex2(float x) { return __builtin_amdgcn_exp2f(x); }
DI float lg2(float x) { return __builtin_amdgcn_logf(x); }
DI float fexp(float x) { return __builtin_amdgcn_exp2f(x * LOG2E); }
DI float wave_sum(float v) {
#pragma unroll
    for (int o = 1; o < 64; o <<= 1) v += __shfl_xor(v, o);
    return v;
}
DI float wave_max(float v) {
#pragma unroll
    for (int o = 1; o < 64; o <<= 1) v = fmaxf(v, __shfl_xor(v, o));
    return v;
}
typedef short v4i16_t __attribute__((ext_vector_type(4)));
DI s16x4 trrd(LAS unsigned char* p) { return __builtin_bit_cast(s16x4, __builtin_amdgcn_ds_read_tr16_b64_v4i16((LAS v4i16_t*)p)); }
DI bf16x8 cat8(s16x4 a, s16x4 b) { return (bf16x8){a[0], a[1], a[2], a[3], b[0], b[1], b[2], b[3]}; }
#define MFMA_BF16(a, b, c) __builtin_amdgcn_mfma_f32_32x32x16_bf16((a), (b), (c), 0, 0, 0)
#define MFMA_F16(a, b, c) __builtin_amdgcn_mfma_f32_32x32x16_f16((a), (b), (c), 0, 0, 0)
DI unsigned pkh(float a, float b) { return __builtin_bit_cast(unsigned, __builtin_amdgcn_cvt_pkrtz(a, b)); }
DI bf16x8 packbf(const f32x16& x, int s) { v4u p; p.x = cvtpk(x[8 * s], x[8 * s + 1]); p.y = cvtpk(x[8 * s + 2], x[8 * s + 3]); p.z = cvtpk(x[8 * s + 4], x[8 * s + 5]); p.w = cvtpk(x[8 * s + 6], x[8 * s + 7]); return __builtin_bit_cast(bf16x8, p); }
DI f16x8 packh(const f32x16& x, int s) { v4u p; p.x = pkh(x[8 * s], x[8 * s + 1]); p.y = pkh(x[8 * s + 2], x[8 * s + 3]); p.z = pkh(x[8 * s + 4], x[8 * s + 5]); p.w = pkh(x[8 * s + 6], x[8 * s + 7]); return __builtin_bit_cast(f16x8, p); }

struct Frame {
    LAS unsigned char* lds;
    volatile LAS unsigned* MISC;
    gu32* ctl;
    unsigned char* ws;
    int tid, lane, wave, vcu, G;
};
DI const float* inp(int i) { const __attribute__((address_space(4))) unsigned long long* kp = (const __attribute__((address_space(4))) unsigned long long*)__builtin_amdgcn_kernarg_segment_ptr(); return (const float*)(*(volatile const __attribute__((address_space(4))) unsigned long long*)(kp + i)); }
enum { I_X = 0, I_C, I_WADA, I_BADA, I_GN1, I_WIN, I_BIG, I_BFG, I_CONVW, I_GQ, I_GK, I_GOSB, I_GOML, I_WOUT, I_GN2, I_WQ, I_SK, I_EU, I_EV, I_OUT };
#define WSP(type, off) ((type*)(F.ws + (off)))

DI void p0_transpose_item(const float* W, int K, int N, int ld, bf16* WT, LAS float* scr, int item, int lane) {
    const int nblk = N / 32, kb = item / nblk, nb = item % nblk, k0 = 64 * kb, n0 = 32 * nb;
#pragma unroll 8
    for (int i = 0; i < 32; ++i) { const int kk = 2 * i + (lane >> 5); scr[kk * 33 + (lane & 31)] = W[(size_t)(k0 + kk) * ld + n0 + (lane & 31)]; }
    LDS_WAIT(); asm volatile("" ::: "memory");
    const int c = lane & 7;
#pragma unroll
    for (int j = 0; j < 4; ++j) { const int n = (lane >> 3) + 8 * j; const LAS float* s = scr + (8 * c) * 33 + n;
        v4u o; o.x = pk2(s[0 * 33], s[1 * 33]); o.y = pk2(s[2 * 33], s[3 * 33]); o.z = pk2(s[4 * 33], s[5 * 33]); o.w = pk2(s[6 * 33], s[7 * 33]);
        *(GAS v4u*)(WT + (size_t)(n0 + n) * K + k0 + 8 * c) = o; }
    LDS_WAIT(); asm volatile("" ::: "memory");
}
DI void p0_mod_block(const Frame& F, int item) {
    const float* const c_ = inp(I_C); const float* const w_ada_ = inp(I_WADA); const float* const b_ada_ = inp(I_BADA); float* const mod_ = WSP(float, WS_MOD);
    LAS float* scr = (LAS float*)(F.lds + F.wave * 16384);
    const int j = item * 64 + F.lane, d0 = F.wave * 128;
#pragma unroll
    for (int b = 0; b < 8; ++b)
#pragma unroll
        for (int q = 0; q < 2; ++q) { const float cv = c_[b * D + d0 + 64 * q + F.lane]; scr[b * 128 + 64 * q + F.lane] = cv / (1.f + fexp(-cv)); }
    LDS_WAIT(); asm volatile("" ::: "memory");
    float acc[8];
#pragma unroll
    for (int b = 0; b < 8; ++b) acc[b] = 0.f;
#pragma unroll 8
    for (int dd = 0; dd < 128; ++dd) { const float w = w_ada_[(size_t)(d0 + dd) * NMOD + j];
#pragma unroll
        for (int b = 0; b < 8; ++b) acc[b] += scr[b * 128 + dd] * w; }
#pragma unroll
    for (int b = 0; b < 8; ++b) scr[1024 + b * 64 + F.lane] = acc[b];
    __syncthreads();
    float tot = b_ada_[j];
#pragma unroll
    for (int w = 0; w < 8; ++w) tot += ((LAS float*)(F.lds + w * 16384))[1024 + F.wave * 64 + F.lane];
    mod_[F.wave * NMOD + j] = tot;
    __syncthreads();
}
DI void p0_weff_item(const Frame& F, int item) {
    const float* const sub_keys_ = inp(I_SK); const float* const w_q_peer_ = inp(I_WQ); bf16* const Weff_t_ = WSP(bf16, WS_WEFF);
    const int hp = item >> 4, dblk = item & 15;
    LAS float* sk = (LAS float*)F.lds;
    LAS float* rb = (LAS float*)(F.lds + 67584) + F.wave * 1024;
    for (int i = 0; i < 32; ++i) { const int idx = F.tid + 512 * i; sk[(idx >> 7) * 129 + (idx & 127)] = sub_keys_[(size_t)hp * 16384 + idx]; }
    const int d0 = 64 * dblk + 8 * F.wave;
#pragma unroll
    for (int r = 0; r < 8; ++r) { rb[r * 128 + F.lane] = w_q_peer_[(size_t)(d0 + r) * NSC + hp * 128 + F.lane]; rb[r * 128 + 64 + F.lane] = w_q_peer_[(size_t)(d0 + r) * NSC + hp * 128 + 64 + F.lane]; }
    __syncthreads();
    float a0[8], a1[8];
#pragma unroll
    for (int r = 0; r < 8; ++r) { a0[r] = 0.f; a1[r] = 0.f; }
#pragma unroll 4
    for (int c = 0; c < 128; ++c) { const float s0 = sk[F.lane * 129 + c], s1 = sk[(F.lane + 64) * 129 + c];
#pragma unroll
        for (int r = 0; r < 8; ++r) { const float a = rb[r * 128 + c]; a0[r] += a * s0; a1[r] += a * s1; } }
    v4u o0, o1; o0.x = pk2(a0[0], a0[1]); o0.y = pk2(a0[2], a0[3]); o0.z = pk2(a0[4], a0[5]); o0.w = pk2(a0[6], a0[7]);
    o1.x = pk2(a1[0], a1[1]); o1.y = pk2(a1[2], a1[3]); o1.z = pk2(a1[4], a1[5]); o1.w = pk2(a1[6], a1[7]);
    *(GAS v4u*)(Weff_t_ + (size_t)(hp * 128 + F.lane) * D + d0) = o0;
    *(GAS v4u*)(Weff_t_ + (size_t)(hp * 128 + 64 + F.lane) * D + d0) = o1;
    __syncthreads();
}
DI void p0_phase(const Frame& F) {
    const float* const w_in_ = inp(I_WIN); bf16* const Win_t_ = WSP(bf16, WS_WIN); const float* const w_out_ = inp(I_WOUT); bf16* const Wout_t_ = WSP(bf16, WS_WOUT); const float* const expert_v_ = inp(I_EV); const float* const expert_u_ = inp(I_EU); bf16* const EXPV_ = WSP(bf16, WS_EXPV); bf16* const EXPU_ = WSP(bf16, WS_EXPU);
    LAS float* scr = (LAS float*)(F.lds + F.wave * 16384);
    const int gw = F.vcu * NWAVES + F.wave, NGW = F.G * NWAVES;
    for (int it = F.vcu; it < 96; it += F.G) p0_mod_block(F, it);
    constexpr int I_WIN = 16 * 112, I_WOUT = 16 * 32, NITEMS = I_WIN + I_WOUT;
    for (int it = gw; it < NITEMS; it += NGW) {
        int r = it;
        if (r < I_WIN) { p0_transpose_item(w_in_, D, NPROJ, NIN, Win_t_, scr, r, F.lane); continue; } r -= I_WIN;
        p0_transpose_item(w_out_, D, D, D, Wout_t_, scr, r, F.lane);
    }
    {
        const size_t nvec = (size_t)16384 * 1024 / 8; const size_t gt = (size_t)F.vcu * NTHR + F.tid, gs = (size_t)F.G * NTHR;
        for (int tb = 0; tb < 2; ++tb) { const float* src = tb ? expert_v_ : expert_u_; bf16* dst = tb ? EXPV_ : EXPU_;
            for (size_t v = gt; v < nvec; v += gs) { const f32x4 a = *(const GAS f32x4*)(src + v * 8), b = *(const GAS f32x4*)(src + v * 8 + 4);
                v4u o; o.x = pk2(a.x, a.y); o.y = pk2(a.z, a.w); o.z = pk2(b.x, b.y); o.w = pk2(b.z, b.w); *(GAS v4u*)(dst + v * 8) = o; } }
    }
    __syncthreads();
    for (int it = F.vcu; it < 256; it += F.G) p0_weff_item(F, it);
}

template <bool DOGATES>
DI void norm_phase(const Frame& F, const float* src, const float* g, int shift_off, int scale_off) {
    const float* const w_in_ = inp(I_WIN); float* const mod_ = WSP(float, WS_MOD); bf16* const XN_ = WSP(bf16, WS_XN); float* const GATES_ = WSP(float, WS_GATES); const float* const b_igate_ = inp(I_BIG); const float* const b_fgate_ = inp(I_BFG);
    LAS float* W8 = (LAS float*)F.lds;
    if (DOGATES) {
        for (int i = 0; i < 16; ++i) { const int idx = F.tid + 512 * i; W8[idx] = w_in_[(size_t)(idx & 1023) * NIN + NPROJ + (idx >> 10)]; }
        __syncthreads();
    }
    const int gw = F.vcu * NWAVES + F.wave, NGW = F.G * NWAVES;
    for (int ch = gw; ch < T / 16; ch += NGW) {
        const int r0 = ch * 16, b = r0 / SEQ;
        f32x4 A[4], Bv[4];
#pragma unroll
        for (int j = 0; j < 4; ++j) { const int col = 4 * F.lane + 256 * j; const f32x4 gg = *(const f32x4*)(g + col), sc = *(const f32x4*)(mod_ + b * NMOD + scale_off + col);
            A[j] = gg * (sc + 1.0f); Bv[j] = *(const f32x4*)(mod_ + b * NMOD + shift_off + col); }
        for (int rr = 0; rr < 16; ++rr) {
            const int row = r0 + rr;
            const GAS f32x4* xr = (const GAS f32x4*)(src + (size_t)row * D) + F.lane;
            f32x4 v[4]; float s = 0.f;
#pragma unroll
            for (int j = 0; j < 4; ++j) { v[j] = xr[64 * j]; s += (v[j].x * v[j].x + v[j].y * v[j].y) + (v[j].z * v[j].z + v[j].w * v[j].w); }
            const float rstd = 1.f / sqrtf(wave_sum(s) * (1.f / D) + EPS);
#pragma unroll
            for (int j = 0; j < 4; ++j) v[j] = v[j] * rstd * A[j] + Bv[j];
            GAS unsigned long long* o8 = (GAS unsigned long long*)(XN_ + (size_t)row * D) + F.lane;
#pragma unroll
            for (int j = 0; j < 4; ++j) o8[64 * j] = (unsigned long long)pk2(v[j].x, v[j].y) | ((unsigned long long)pk2(v[j].z, v[j].w) << 32);
            if (DOGATES) {
                float res = 0.f;
#pragma unroll
                for (int hh = 0; hh < 8; ++hh) { float p = 0.f;
#pragma unroll
                    for (int j = 0; j < 4; ++j) { const f32x4 w = *(const LAS f32x4*)(W8 + hh * 1024 + 4 * F.lane + 256 * j); p += (v[j].x * w.x + v[j].y * w.y) + (v[j].z * w.z + v[j].w * w.w); }
                    p = wave_sum(p); if (F.lane == hh) res = p; }
                if (F.lane < 8) GATES_[(size_t)row * 8 + F.lane] = res + (F.lane < 4 ? b_igate_[F.lane] : b_fgate_[F.lane - 4]);
            }
        }
    }
}

DI void sb_unit(const Frame& F, int b, int h, int qb) {
    bf16* const PROJ_ = WSP(bf16, WS_PROJ); const float* const g_q_sb_ = inp(I_GQ); const float* const g_k_sb_ = inp(I_GK); bf16* const MIX_ = WSP(bf16, WS_MIX); const float* const g_out_sb_ = inp(I_GOSB);
    LAS unsigned char* L = F.lds;
    volatile LAS unsigned* flags = (volatile LAS unsigned*)(L + 32768);
    const int tid = F.tid, lane = F.lane, w = F.wave, r = lane & 31, hi = lane >> 5;
    const int i16 = lane & 15, qq = i16 >> 2, pp = i16 & 3, blk = (lane >> 4) & 1;
    const size_t rowbase = (size_t)b * SEQ; const int q0 = qb * 256, qw0 = q0 + 32 * w, tq = qw0 + r;
    const bf16* P = PROJ_;
    bf16x8 qf[4];
    {
        const bf16* Qp = P + (rowbase + tq) * NPROJ + C_QSB + h * 64 + 8 * hi;
        v4u qraw[4]; float ss = 0.f;
#pragma unroll
        for (int kk = 0; kk < 4; ++kk) { qraw[kk] = *(const GAS v4u*)(Qp + 16 * kk);
#pragma unroll
            for (int e = 0; e < 4; ++e) { const float a = bflo(qraw[kk][e]), c = bfhi(qraw[kk][e]); ss += a * a + c * c; } }
        ss = swap_add(ss);
        const float rq = (1.f / sqrtf(ss * (1.f / 64.f) + EPS)) * (0.125f * LOG2E);
#pragma unroll
        for (int kk = 0; kk < 4; ++kk) { const f32x4 g0 = *(const f32x4*)(g_q_sb_ + 16 * kk + 8 * hi), g1 = *(const f32x4*)(g_q_sb_ + 16 * kk + 8 * hi + 4);
            v4u o; o.x = cvtpk(bflo(qraw[kk].x) * rq * g0.x, bfhi(qraw[kk].x) * rq * g0.y); o.y = cvtpk(bflo(qraw[kk].y) * rq * g0.z, bfhi(qraw[kk].y) * rq * g0.w);
            o.z = cvtpk(bflo(qraw[kk].z) * rq * g1.x, bfhi(qraw[kk].z) * rq * g1.y); o.w = cvtpk(bflo(qraw[kk].w) * rq * g1.z, bfhi(qraw[kk].w) * rq * g1.w);
            qf[kk] = __builtin_bit_cast(bf16x8, o); }
    }
    f16x8 U0, U1, ONES;
#pragma unroll
    for (int j = 0; j < 8; ++j) { U0[j] = (krow(0, hi, j) > r) ? (_Float16)1.0f : (_Float16)0.0f; U1[j] = (krow(1, hi, j) > r) ? (_Float16)1.0f : (_Float16)0.0f; ONES[j] = (_Float16)1.0f; }
    f32x16 o0, o1;
#pragma unroll
    for (int i = 0; i < 16; ++i) { o0[i] = 0.f; o1[i] = 0.f; }
    float R = 0.f; bool done = false;
    const int srow = tid >> 3, sch = tid & 7;
    const bf16* Kg = P + (rowbase + srow) * NPROJ + C_KSB + h * 64 + sch * 8;
    const bf16* Vg = P + (rowbase + srow) * NPROJ + C_VSB + h * 64 + sch * 8;
    const f32x4 gk0 = *(const f32x4*)(g_k_sb_ + sch * 8), gk1 = *(const f32x4*)(g_k_sb_ + sch * 8 + 4);
    const int kbyte = srow * 128 + ((sch ^ ((srow >> 1) & 7)) * 16), vbyte = (sch >> 2) * 4096 + srow * 64 + (sch & 3) * 16;
    const int jmax = qb * 4 + 3;
    v4u kreg = *(const GAS v4u*)(Kg + (size_t)jmax * 64 * NPROJ), vreg = *(const GAS v4u*)(Vg + (size_t)jmax * 64 * NPROJ);
    if (tid < 16) flags[tid] = 0u;
    for (int j = jmax;; --j) {
        const int buf = j & 1;
        LAS unsigned char* Kb = L + buf * 8192; LAS unsigned char* Vb = L + 16384 + buf * 8192;
        {
            float kv[8]; kv[0] = bflo(kreg.x); kv[1] = bfhi(kreg.x); kv[2] = bflo(kreg.y); kv[3] = bfhi(kreg.y); kv[4] = bflo(kreg.z); kv[5] = bfhi(kreg.z); kv[6] = bflo(kreg.w); kv[7] = bfhi(kreg.w);
            float ss = 0.f;
#pragma unroll
            for (int e = 0; e < 8; ++e) ss += kv[e] * kv[e];
            ss += __shfl_xor(ss, 1); ss += __shfl_xor(ss, 2); ss += __shfl_xor(ss, 4);
            const float rk = 1.f / sqrtf(ss * (1.f / 64.f) + EPS);
            v4u o; o.x = cvtpk(kv[0] * rk * gk0.x, kv[1] * rk * gk0.y); o.y = cvtpk(kv[2] * rk * gk0.z, kv[3] * rk * gk0.w); o.z = cvtpk(kv[4] * rk * gk1.x, kv[5] * rk * gk1.y); o.w = cvtpk(kv[6] * rk * gk1.z, kv[7] * rk * gk1.w);
            *(LAS v4u*)(Kb + kbyte) = o; *(LAS v4u*)(Vb + vbyte) = vreg;
        }
        if (j > 0) { kreg = *(const GAS v4u*)(Kg + (size_t)(j - 1) * 64 * NPROJ); vreg = *(const GAS v4u*)(Vg + (size_t)(j - 1) * 64 * NPROJ); }
        __syncthreads();
        if (j != jmax) { const int pb = ((j + 1) & 1) * 8; unsigned all = 1u;
#pragma unroll
            for (int ww = 0; ww < 8; ++ww) all &= flags[pb + ww];
            if (all) break; }
        const bool relevant = !done && (64 * j <= qw0 + 30);
        if (relevant) {
            f32x16 s0, s1;
#pragma unroll
            for (int i = 0; i < 16; ++i) { s0[i] = 0.f; s1[i] = 0.f; }
#pragma unroll
            for (int kk = 0; kk < 4; ++kk) { const int ch = 2 * kk + hi;
                const bf16x8 a0 = *(const LAS bf16x8*)(Kb + r * 128 + ((ch ^ ((r >> 1) & 7)) * 16));
                const bf16x8 a1 = *(const LAS bf16x8*)(Kb + (32 + r) * 128 + ((ch ^ (((32 + r) >> 1) & 7)) * 16));
                s0 = MFMA_BF16(a0, qf[kk], s0); s1 = MFMA_BF16(a1, qf[kk], s1); }
            const bool full = (64 * j + 63 < qw0);
            const int kq = full ? 1000 : tq - 64 * j;
            unsigned lp0[8], lp1[8]; float tsum = 0.f;
#pragma unroll
            for (int i = 0; i < 16; i += 2) {
                float a0_ = -lg2(1.f + ex2(s0[i])), a1_ = -lg2(1.f + ex2(s0[i + 1])), c0_ = -lg2(1.f + ex2(s1[i])), c1_ = -lg2(1.f + ex2(s1[i + 1]));
                const bool ma0 = crow(i, hi) >= kq, ma1 = crow(i + 1, hi) >= kq, mc0 = 32 + crow(i, hi) >= kq, mc1 = 32 + crow(i + 1, hi) >= kq;
                a0_ = ma0 ? 0.f : a0_; a1_ = ma1 ? 0.f : a1_; c0_ = mc0 ? 0.f : c0_; c1_ = mc1 ? 0.f : c1_;
                tsum += (a0_ + a1_) + (c0_ + c1_);
                s0[i] = ma0 ? -INFINITY : s0[i] + a0_; s0[i + 1] = ma1 ? -INFINITY : s0[i + 1] + a1_;
                s1[i] = mc0 ? -INFINITY : s1[i] + c0_; s1[i + 1] = mc1 ? -INFINITY : s1[i + 1] + c1_;
                lp0[i >> 1] = pkh(a0_, a1_); lp1[i >> 1] = pkh(c0_, c1_); }
            const f16x8 L00 = __builtin_bit_cast(f16x8, (v4u){lp0[0], lp0[1], lp0[2], lp0[3]}), L01 = __builtin_bit_cast(f16x8, (v4u){lp0[4], lp0[5], lp0[6], lp0[7]});
            const f16x8 L10 = __builtin_bit_cast(f16x8, (v4u){lp1[0], lp1[1], lp1[2], lp1[3]}), L11 = __builtin_bit_cast(f16x8, (v4u){lp1[4], lp1[5], lp1[6], lp1[7]});
            f32x16 c0, c1;
#pragma unroll
            for (int i = 0; i < 16; ++i) { c0[i] = R; c1[i] = R; }
            c0 = MFMA_F16(U0, L00, c0); c0 = MFMA_F16(U1, L01, c0); c0 = MFMA_F16(ONES, L10, c0); c0 = MFMA_F16(ONES, L11, c0);
            c1 = MFMA_F16(U0, L10, c1); c1 = MFMA_F16(U1, L11, c1);
#pragma unroll
            for (int i = 0; i < 16; ++i) { s0[i] = ex2(s0[i] + c0[i]); s1[i] = ex2(s1[i] + c1[i]); }
            const bf16x8 W00 = packbf(s0, 0), W01 = packbf(s0, 1), W10 = packbf(s1, 0), W11 = packbf(s1, 1);
#pragma unroll
            for (int db = 0; db < 2; ++db) {
                LAS unsigned char* vb_ = Vb + db * 4096 + (4 * hi + qq) * 64 + 32 * blk + 8 * pp;
                const bf16x8 A00 = cat8(trrd(vb_), trrd(vb_ + 8 * 64)), A01 = cat8(trrd(vb_ + 16 * 64), trrd(vb_ + 24 * 64));
                const bf16x8 A10 = cat8(trrd(vb_ + 32 * 64), trrd(vb_ + 40 * 64)), A11 = cat8(trrd(vb_ + 48 * 64), trrd(vb_ + 56 * 64));
                if (db == 0) { o0 = MFMA_BF16(A00, W00, o0); o0 = MFMA_BF16(A01, W01, o0); o0 = MFMA_BF16(A10, W10, o0); o0 = MFMA_BF16(A11, W11, o0); }
                else         { o1 = MFMA_BF16(A00, W00, o1); o1 = MFMA_BF16(A01, W01, o1); o1 = MFMA_BF16(A10, W10, o1); o1 = MFMA_BF16(A11, W11, o1); }
            }
            R += swap_add(tsum);
            done = __all(R < -150.f) != 0;
        }
        if (lane == 0) flags[buf * 8 + w] = done ? 1u : 0u;
        if (j == 0) break;
    }
    {
        float ss = 0.f;
#pragma unroll
        for (int i = 0; i < 16; ++i) ss += o0[i] * o0[i] + o1[i] * o1[i];
        ss = swap_add(ss);
        const float ro = 1.f / sqrtf(ss * (1.f / 64.f) + EPS);
        bf16* Op = MIX_ + (rowbase + tq) * D + h * 64;
        const float* go = g_out_sb_ + h * 64;
#pragma unroll
        for (int g = 0; g < 4; ++g) { const int d0 = 8 * g + 4 * hi; const f32x4 ga = *(const f32x4*)(go + d0), gb = *(const f32x4*)(go + 32 + d0);
            u32x2 wa, wb; wa.x = cvtpk(o0[4 * g] * ro * ga.x, o0[4 * g + 1] * ro * ga.y); wa.y = cvtpk(o0[4 * g + 2] * ro * ga.z, o0[4 * g + 3] * ro * ga.w);
            wb.x = cvtpk(o1[4 * g] * ro * gb.x, o1[4 * g + 1] * ro * gb.y); wb.y = cvtpk(o1[4 * g + 2] * ro * gb.z, o1[4 * g + 3] * ro * gb.w);
            *(GAS u32x2*)(Op + d0) = wa; *(GAS u32x2*)(Op + 32 + d0) = wb; }
    }
    __syncthreads();
}

DI void conv_silu8(const v4u (&xr)[4], const float (&cw)[4][8], float scale, float (&y)[8]) {
#pragma unroll
    for (int e = 0; e < 8; ++e) y[e] = 0.f;
#pragma unroll
    for (int j = 0; j < 4; ++j) {
        y[0] += cw[j][0] * bflo(xr[j].x); y[1] += cw[j][1] * bfhi(xr[j].x); y[2] += cw[j][2] * bflo(xr[j].y); y[3] += cw[j][3] * bfhi(xr[j].y);
        y[4] += cw[j][4] * bflo(xr[j].z); y[5] += cw[j][5] * bfhi(xr[j].z); y[6] += cw[j][6] * bflo(xr[j].w); y[7] += cw[j][7] * bfhi(xr[j].w); }
#pragma unroll
    for (int e = 0; e < 8; ++e) y[e] = scale * y[e] / (1.f + fexp(-y[e]));
}
DI float log_sigmoid(float x) { return fminf(x, 0.f) - __logf(1.f + fexp(-fabsf(x))); }
DI float wave_scan_incl(float a, int lane) {
#pragma unroll
    for (int o = 1; o < 64; o <<= 1) { const float t = __shfl_up(a, o); if (lane >= o) a += t; }
    return a;
}

DI void ml_state_item(const Frame& F, int chain, int dvh) {
    bf16* const PROJ_ = WSP(bf16, WS_PROJ); const float* const conv_w_ = inp(I_CONVW); float* const GATES_ = WSP(float, WS_GATES); bf16* const CST_ = WSP(bf16, WS_CST); float* const NST_ = WSP(float, WS_NST); float* const MST_ = WSP(float, WS_MST);
    LAS unsigned char* L = F.lds;
    const int tid = F.tid, lane = F.lane, w = F.wave, r = lane & 31, hi = lane >> 5;
    const int i16 = lane & 15, qq = i16 >> 2, pp = i16 & 3, blk = (lane >> 4) & 1;
    const int b = chain >> 2, hh = chain & 3; const size_t rowbase = (size_t)b * SEQ;
    const int kbk = w & 3, vbk = w >> 2;
    const bf16* P = PROJ_;
    const int kc = tid & 15, kr0 = tid >> 4;
    float cw[4][8];
#pragma unroll
    for (int j = 0; j < 4; ++j)
#pragma unroll
        for (int e = 0; e < 8; ++e) cw[j][e] = conv_w_[j * 1024 + 512 + hh * 128 + kc * 8 + e];
    const bf16* Kg = P + rowbase * NPROJ + C_KML + hh * 128 + kc * 8;
    const int vrow = tid >> 3, vch = tid & 7;
    const bf16* Vg = P + (rowbase + vrow) * NPROJ + C_VML + hh * 128 + dvh * 64 + vch * 8;
    const float* Gg = GATES_ + (rowbase + lane) * 8;
    f32x16 acc;
#pragma unroll
    for (int i = 0; i < 16; ++i) acc[i] = 0.f;
    float mprev = 0.f, nst = 0.f;
    v4u kraw[2][4], vraw; float gi, gf;
#define ML_LOADK(dst, t0) do { _Pragma("unroll") for (int i_ = 0; i_ < 2; ++i_) _Pragma("unroll") for (int j_ = 0; j_ < 4; ++j_) { const int tt_ = (t0) + kr0 + 32 * i_ - 3 + j_; \
        dst[i_][j_] = (tt_ >= 0) ? *(const GAS v4u*)(Kg + (size_t)tt_ * NPROJ) : (v4u){0u, 0u, 0u, 0u}; } } while (0)
    ML_LOADK(kraw, 0); vraw = *(const GAS v4u*)(Vg); gi = Gg[hh]; gf = Gg[4 + hh];
    for (int c = 0; c < 64; ++c) {
        LAS unsigned char* Lb = L + (c & 1) * 28672;
        LAS float* Lws = (LAS float*)(Lb + 24576);
        const float lf = log_sigmoid(gf);
        const float a = wave_scan_incl(lf, lane);
        const float a_end = __shfl(a, 63);
        const float lw = a_end - a + gi;
        const float m_new = fmaxf(a_end + mprev, wave_max(lw));
        const float ws = fexp(lw - m_new), decay = fexp(a_end + mprev - m_new);
        if (w == 0) Lws[lane] = ws;
#pragma unroll
        for (int i = 0; i < 2; ++i) { float y[8]; conv_silu8(kraw[i], cw, 0.08838834764831845f, y);
            v4u o; o.x = cvtpk(y[0], y[1]); o.y = cvtpk(y[2], y[3]); o.z = cvtpk(y[4], y[5]); o.w = cvtpk(y[6], y[7]);
            *(LAS v4u*)(Lb + (kc >> 2) * 4096 + (kr0 + 32 * i) * 64 + (kc & 3) * 16) = o; }
        { const float wsr = __shfl(ws, vrow & 63);
            v4u o; o.x = cvtpk(bflo(vraw.x) * wsr, bfhi(vraw.x) * wsr); o.y = cvtpk(bflo(vraw.y) * wsr, bfhi(vraw.y) * wsr); o.z = cvtpk(bflo(vraw.z) * wsr, bfhi(vraw.z) * wsr); o.w = cvtpk(bflo(vraw.w) * wsr, bfhi(vraw.w) * wsr);
            *(LAS v4u*)(Lb + 16384 + (vch >> 2) * 4096 + vrow * 64 + (vch & 3) * 16) = o; }
        if (c < 63) { const int t1 = (c + 1) * 64; ML_LOADK(kraw, t1); vraw = *(const GAS v4u*)(Vg + (size_t)t1 * NPROJ); gi = Gg[(size_t)t1 * 8 + hh]; gf = Gg[(size_t)t1 * 8 + 4 + hh]; }
        __syncthreads();
#pragma unroll
        for (int i = 0; i < 16; ++i) acc[i] *= decay;
#pragma unroll
        for (int kk = 0; kk < 4; ++kk) { const int rows = 16 * kk + 8 * hi + qq;
            LAS unsigned char* ka = Lb + kbk * 4096 + rows * 64 + 32 * blk + 8 * pp; LAS unsigned char* va = Lb + 16384 + vbk * 4096 + rows * 64 + 32 * blk + 8 * pp;
            acc = MFMA_BF16(cat8(trrd(ka), trrd(ka + 4 * 64)), cat8(trrd(va), trrd(va + 4 * 64)), acc); }
        if (c < 63) {
            bf16* Cp = CST_ + ((size_t)(chain * 64 + c) * 128 + dvh * 64 + vbk * 32 + r) * 128 + kbk * 32 + 4 * hi;
#pragma unroll
            for (int g = 0; g < 4; ++g) { u32x2 o; o.x = cvtpk(acc[4 * g], acc[4 * g + 1]); o.y = cvtpk(acc[4 * g + 2], acc[4 * g + 3]); *(GAS u32x2*)(Cp + 8 * g) = o; }
        }
        if (dvh == 0) {
            const int k = 16 * w + (lane & 15), sq = lane >> 4; float part = 0.f;
            const LAS unsigned short* kcol = (const LAS unsigned short*)(Lb + (k >> 5) * 4096 + (k & 31) * 2);
#pragma unroll
            for (int e = 0; e < 16; ++e) part += Lws[16 * sq + e] * __uint_as_float((unsigned)kcol[(16 * sq + e) * 32] << 16);
            part += __shfl_xor(part, 16); part += __shfl_xor(part, 32);
            nst = decay * nst + part;
            if (c < 63 && lane < 16) NST_[(size_t)(chain * 64 + c) * 128 + k] = nst;
            if (c < 63 && tid == 0) MST_[chain * 64 + c] = m_new;
        }
        mprev = m_new;
    }
#undef ML_LOADK
    __syncthreads();
}

DI void ml_out_unit(const Frame& F, int chain, int c) {
    bf16* const PROJ_ = WSP(bf16, WS_PROJ); const float* const conv_w_ = inp(I_CONVW); float* const GATES_ = WSP(float, WS_GATES); float* const MST_ = WSP(float, WS_MST); bf16* const CST_ = WSP(bf16, WS_CST); float* const NST_ = WSP(float, WS_NST); bf16* const MIX_ = WSP(bf16, WS_MIX); const float* const g_out_ml_ = inp(I_GOML);
    LAS unsigned char* L = F.lds;
    LAS float* Lbs = (LAS float*)(L + 49152); LAS float* Lav = (LAS float*)(L + 49408); LAS float* Lex = (LAS float*)(L + 49664);
    const int tid = F.tid, lane = F.lane, w = F.wave, r = lane & 31, hi = lane >> 5;
    const int i16 = lane & 15, qq = i16 >> 2, pp = i16 & 3, blk = (lane >> 4) & 1;
    const int b = chain >> 2, hh = chain & 3; const size_t rowbase = (size_t)b * SEQ; const int t0 = c * 64;
    const int tb = w >> 2, vb = w & 3;
    const bf16* P = PROJ_;
    {
        const int kc = tid & 15, kr0 = tid >> 4;
#pragma unroll
        for (int which = 0; which < 2; ++which) {
            const int colbase = (which ? 512 : 0) + hh * 128 + kc * 8;
            float cw[4][8];
#pragma unroll
            for (int j = 0; j < 4; ++j)
#pragma unroll
                for (int e = 0; e < 8; ++e) cw[j][e] = conv_w_[j * 1024 + colbase + e];
            const bf16* Xg = P + rowbase * NPROJ + C_QML + colbase;
#pragma unroll
            for (int i = 0; i < 2; ++i) { const int row = kr0 + 32 * i; v4u xr[4];
#pragma unroll
                for (int j = 0; j < 4; ++j) { const int tt = t0 + row - 3 + j; xr[j] = (tt >= 0) ? *(const GAS v4u*)(Xg + (size_t)tt * NPROJ) : (v4u){0u, 0u, 0u, 0u}; }
                float y[8]; conv_silu8(xr, cw, which ? 0.08838834764831845f : 1.0f, y);
                v4u o; o.x = cvtpk(y[0], y[1]); o.y = cvtpk(y[2], y[3]); o.z = cvtpk(y[4], y[5]); o.w = cvtpk(y[6], y[7]);
                *(LAS v4u*)(L + which * 16384 + row * 256 + ((kc ^ (row & 15)) * 16)) = o; }
        }
#pragma unroll
        for (int i = 0; i < 2; ++i) { const int row = kr0 + 32 * i;
            const v4u v = *(const GAS v4u*)(P + (rowbase + t0 + row) * NPROJ + C_VML + hh * 128 + kc * 8);
            *(LAS v4u*)(L + 32768 + (kc >> 2) * 4096 + row * 64 + (kc & 3) * 16) = v; }
        if (w == 0) { const float* Gg = GATES_ + (rowbase + t0 + lane) * 8; const float a = wave_scan_incl(log_sigmoid(Gg[4 + hh]), lane); Lav[lane] = a; Lbs[lane] = Gg[hh] - a; }
    }
    const float mprev = (c > 0) ? MST_[chain * 64 + c - 1] : 0.f;
    bf16x8 cf[8], nf[8];
    if (c > 0) {
        const bf16* Cp = CST_ + ((size_t)(chain * 64 + c - 1) * 128 + vb * 32 + r) * 128 + 8 * hi;
        const float* Np = NST_ + (size_t)(chain * 64 + c - 1) * 128 + 8 * hi;
        const bool nrow = (r == 0) || (r == 4);
#pragma unroll
        for (int kk = 0; kk < 8; ++kk) { cf[kk] = *(const GAS bf16x8*)(Cp + 16 * kk);
            const f32x4 n0 = *(const f32x4*)(Np + 16 * kk), n1 = *(const f32x4*)(Np + 16 * kk + 4);
            v4u o; o.x = cvtpk(n0.x, n0.y); o.y = cvtpk(n0.z, n0.w); o.z = cvtpk(n1.x, n1.y); o.w = cvtpk(n1.z, n1.w);
            if (!nrow) o = (v4u){0u, 0u, 0u, 0u};
            nf[kk] = __builtin_bit_cast(bf16x8, o); }
    }
    __syncthreads();
    bf16x8 qf[8];
    f32x16 s0, s1;
#pragma unroll
    for (int i = 0; i < 16; ++i) { s0[i] = 0.f; s1[i] = 0.f; }
#pragma unroll
    for (int kk = 0; kk < 8; ++kk) { const int ch = 2 * kk + hi; const int rq_ = 32 * tb + r;
        qf[kk] = *(const LAS bf16x8*)(L + rq_ * 256 + ((ch ^ (rq_ & 15)) * 16));
        const bf16x8 a0 = *(const LAS bf16x8*)(L + 16384 + r * 256 + ((ch ^ (r & 15)) * 16));
        const bf16x8 a1 = *(const LAS bf16x8*)(L + 16384 + (32 + r) * 256 + ((ch ^ ((32 + r) & 15)) * 16));
        s0 = MFMA_BF16(a0, qf[kk], s0); s1 = MFMA_BF16(a1, qf[kk], s1); }
    const int tl = 32 * tb + r; const float a_t = Lav[tl];
    f32x16 d0, d1; float mrow = -INFINITY;
#pragma unroll
    for (int g = 0; g < 4; ++g) { const f32x4 b0 = *(const LAS f32x4*)(Lbs + 8 * g + 4 * hi), b1 = *(const LAS f32x4*)(Lbs + 32 + 8 * g + 4 * hi);
#pragma unroll
        for (int e = 0; e < 4; ++e) { const int sl = 8 * g + 4 * hi + e;
            d0[4 * g + e] = (sl <= tl) ? a_t + b0[e] : -INFINITY; d1[4 * g + e] = (32 + sl <= tl) ? a_t + b1[e] : -INFINITY;
            mrow = fmaxf(mrow, fmaxf(d0[4 * g + e], d1[4 * g + e])); } }
    mrow = fmaxf(swap_max(mrow), a_t + mprev);
    float psum = 0.f;
#pragma unroll
    for (int i = 0; i < 16; ++i) { s0[i] *= fexp(d0[i] - mrow); s1[i] *= fexp(d1[i] - mrow); psum += s0[i] + s1[i]; }
    const float w_inter = fexp(a_t + mprev - mrow);
    float den = swap_add(psum);
    const bf16x8 P00 = packbf(s0, 0), P01 = packbf(s0, 1), P10 = packbf(s1, 0), P11 = packbf(s1, 1);
    f32x16 num;
#pragma unroll
    for (int i = 0; i < 16; ++i) num[i] = 0.f;
    {
        LAS unsigned char* vb_ = L + 32768 + vb * 4096 + (4 * hi + qq) * 64 + 32 * blk + 8 * pp;
        num = MFMA_BF16(cat8(trrd(vb_), trrd(vb_ + 8 * 64)), P00, num); num = MFMA_BF16(cat8(trrd(vb_ + 16 * 64), trrd(vb_ + 24 * 64)), P01, num);
        num = MFMA_BF16(cat8(trrd(vb_ + 32 * 64), trrd(vb_ + 40 * 64)), P10, num); num = MFMA_BF16(cat8(trrd(vb_ + 48 * 64), trrd(vb_ + 56 * 64)), P11, num);
    }
    if (c > 0) {
        f32x16 it, dn;
#pragma unroll
        for (int i = 0; i < 16; ++i) { it[i] = 0.f; dn[i] = 0.f; }
#pragma unroll
        for (int kk = 0; kk < 8; ++kk) { it = MFMA_BF16(cf[kk], qf[kk], it); dn = MFMA_BF16(nf[kk], qf[kk], dn); }
#pragma unroll
        for (int i = 0; i < 16; ++i) num[i] += w_inter * it[i];
        den += w_inter * dn[0];
    }
    const float inv = 1.f / fmaxf(fabsf(den), fexp(-mrow));
    float ss = 0.f;
#pragma unroll
    for (int i = 0; i < 16; ++i) { num[i] *= inv; ss += num[i] * num[i]; }
    ss = swap_add(ss);
    if (lane < 32) Lex[(tb * 4 + vb) * 32 + r] = ss;
    __syncthreads();
    const float tot = (Lex[(tb * 4 + 0) * 32 + r] + Lex[(tb * 4 + 1) * 32 + r]) + (Lex[(tb * 4 + 2) * 32 + r] + Lex[(tb * 4 + 3) * 32 + r]);
    const float rstd = 1.f / sqrtf(tot * (1.f / 128.f) + EPS);
    {
        const size_t trow = rowbase + t0 + tl;
        const bf16* Og = P + trow * NPROJ + C_OML + hh * 128 + vb * 32 + 4 * hi;
        bf16* Mp = MIX_ + trow * D + 512 + hh * 128 + vb * 32 + 4 * hi;
        const float* go = g_out_ml_ + hh * 128 + vb * 32 + 4 * hi;
#pragma unroll
        for (int g = 0; g < 4; ++g) { const u32x2 og = *(const GAS u32x2*)(Og + 8 * g); const f32x4 gg = *(const f32x4*)(go + 8 * g);
            const float o0 = bflo(og.x), o1 = bfhi(og.x), o2 = bflo(og.y), o3 = bfhi(og.y);
            u32x2 o; o.x = cvtpk(num[4 * g] * rstd * gg.x / (1.f + fexp(-o0)), num[4 * g + 1] * rstd * gg.y / (1.f + fexp(-o1)));
            o.y = cvtpk(num[4 * g + 2] * rstd * gg.z / (1.f + fexp(-o2)), num[4 * g + 3] * rstd * gg.w / (1.f + fexp(-o3)));
            *(GAS u32x2*)(Mp + 8 * g) = o; }
    }
    __syncthreads();
}

#define TK_INSERT(arr, xin) do { float x_ = (xin); _Pragma("unroll") for (int q_ = 0; q_ < 16; ++q_) { const float hi_ = fmaxf(arr[q_], x_); x_ = fminf(arr[q_], x_); arr[q_] = hi_; } } while (0)
DI void topk_item(const Frame& F, int item) {
    float* const SCORES_ = WSP(float, WS_SCORES); int* const IDX_ = WSP(int, WS_IDX); float* const GATEW_ = WSP(float, WS_GATE);
    LAS float* Tl = (LAS float*)F.lds;
    LAS float* Ls = (LAS float*)F.lds;
    const int tid = F.tid, tblk = item >> 2, hp2 = item & 3, t0 = tblk * 64;
    for (int i = 0; i < 16; ++i) { const int idx = tid + 512 * i, row = idx >> 7, c4 = idx & 127;
        const f32x4 v = *(const GAS f32x4*)(SCORES_ + (size_t)(t0 + row) * NSC + 512 * hp2 + 4 * c4);
        LAS float* d = Tl + row * 513 + 4 * c4; d[0] = v.x; d[1] = v.y; d[2] = v.z; d[3] = v.w; }
    __syncthreads();
    float k[16];
    const int tl = tid & 63, li = tid >> 6;
    if (tid < 256) {
#pragma unroll
        for (int q = 0; q < 16; ++q) k[q] = -INFINITY;
        const LAS float* src = Tl + tl * 513 + li * 128;
#pragma unroll 4
        for (int n = 0; n < 128; ++n) { const float x = __uint_as_float((__float_as_uint(src[n]) & ~0x7Fu) | (unsigned)n); TK_INSERT(k, x); }
    }
    __syncthreads();
    if (tid < 256) {
#pragma unroll
        for (int q = 0; q < 16; ++q) Ls[(tl * 4 + li) * 17 + q] = k[q];
    }
    __syncthreads();
    if (tid < 128) {
        const int hl = tid >> 6; const LAS float* la = Ls + (tl * 4 + hl * 2) * 17; const LAS float* lb = la + 17;
        float a[16], bb[16], cnd[16];
#pragma unroll
        for (int q = 0; q < 16; ++q) { a[q] = la[q]; bb[q] = lb[q]; cnd[q] = -INFINITY; }
#pragma unroll
        for (int i = 0; i < 16; ++i)
#pragma unroll
            for (int j = 0; j < 16; ++j) if ((i + 1) * (j + 1) <= 16) { const float s = a[i] + bb[j]; const float x = __uint_as_float((__float_as_uint(s) & ~0xFFu) | (unsigned)(i * 16 + j)); TK_INSERT(cnd, x); }
        float sv[16]; int ei[16]; float mx = -INFINITY;
#pragma unroll
        for (int q = 0; q < 16; ++q) { const unsigned code = __float_as_uint(cnd[q]) & 0xFFu; const float va = la[code >> 4], vb = lb[code & 15u];
            ei[q] = (int)((__float_as_uint(va) & 0x7Fu) * 128u + (__float_as_uint(vb) & 0x7Fu)); sv[q] = va + vb; mx = fmaxf(mx, sv[q]); }
        float sum = 0.f;
#pragma unroll
        for (int q = 0; q < 16; ++q) { sv[q] = fexp(sv[q] - mx); sum += sv[q]; }
        const float inv = 1.f / sum;
        const size_t o = (size_t)(t0 + tl) * 128 + (2 * hp2 + hl) * 16;
#pragma unroll
        for (int q = 0; q < 16; q += 4) { *(GAS v4u*)(IDX_ + o + q) = (v4u){(unsigned)ei[q], (unsigned)ei[q + 1], (unsigned)ei[q + 2], (unsigned)ei[q + 3]};
            *(GAS f32x4*)(GATEW_ + o + q) = (f32x4){sv[q] * inv, sv[q + 1] * inv, sv[q + 2] * inv, sv[q + 3] * inv}; }
    }
    __syncthreads();
}

DI float dot2bf(unsigned a, unsigned b, float acc) { return __builtin_amdgcn_fdot2_f32_bf16(__builtin_bit_cast(bf16x2_t, a), __builtin_bit_cast(bf16x2_t, b), acc, false); }
DI float gelu_erf(float x) { return 0.5f * x * (1.f + erff(x * 0.7071067811865476f)); }
DI void peer_phase(const Frame& F) {
    bf16* const XN_ = WSP(bf16, WS_XN); int* const IDX_ = WSP(int, WS_IDX); float* const GATEW_ = WSP(float, WS_GATE); bf16* const EXPU_ = WSP(bf16, WS_EXPU); bf16* const EXPV_ = WSP(bf16, WS_EXPV); float* const mod_ = WSP(float, WS_MOD); float* const out_ = (float*)inp(I_OUT);
    const int gw = F.vcu * NWAVES + F.wave, NGW = F.G * NWAVES, lane = F.lane;
    for (int t = gw; t < T; t += NGW) {
        const int b = t / SEQ;
        const v4u xa = *(const GAS v4u*)(XN_ + (size_t)t * D + 8 * lane), xb = *(const GAS v4u*)(XN_ + (size_t)t * D + 512 + 8 * lane);
        const int id0 = IDX_[(size_t)t * 128 + lane], id1 = IDX_[(size_t)t * 128 + 64 + lane];
        const float gt0 = GATEW_[(size_t)t * 128 + lane], gt1 = GATEW_[(size_t)t * 128 + 64 + lane];
        float y[16];
#pragma unroll
        for (int i = 0; i < 16; ++i) y[i] = 0.f;
        for (int k = 0; k < 128; k += 4) {
            v4u ua[4], ub[4], va[4], vb[4]; float gk[4];
#pragma unroll
            for (int u = 0; u < 4; ++u) { const int kk = k + u;
                const int e = (kk < 64) ? __builtin_amdgcn_readlane(id0, kk & 63) : __builtin_amdgcn_readlane(id1, kk & 63);
                gk[u] = (kk < 64) ? __uint_as_float(__builtin_amdgcn_readlane(__float_as_uint(gt0), kk & 63)) : __uint_as_float(__builtin_amdgcn_readlane(__float_as_uint(gt1), kk & 63));
                const bf16* up = EXPU_ + (size_t)e * D + 8 * lane; const bf16* vp = EXPV_ + (size_t)e * D + 8 * lane;
                ua[u] = *(const GAS v4u*)up; ub[u] = *(const GAS v4u*)(up + 512); va[u] = *(const GAS v4u*)vp; vb[u] = *(const GAS v4u*)(vp + 512); }
#pragma unroll
            for (int u = 0; u < 4; ++u) {
                float d = 0.f;
                d = dot2bf(ua[u].x, xa.x, d); d = dot2bf(ua[u].y, xa.y, d); d = dot2bf(ua[u].z, xa.z, d); d = dot2bf(ua[u].w, xa.w, d);
                d = dot2bf(ub[u].x, xb.x, d); d = dot2bf(ub[u].y, xb.y, d); d = dot2bf(ub[u].z, xb.z, d); d = dot2bf(ub[u].w, xb.w, d);
                d = wave_sum(d);
                const float cf = gk[u] * gelu_erf(d);
                y[0] += cf * bflo(va[u].x); y[1] += cf * bfhi(va[u].x); y[2] += cf * bflo(va[u].y); y[3] += cf * bfhi(va[u].y);
                y[4] += cf * bflo(va[u].z); y[5] += cf * bfhi(va[u].z); y[6] += cf * bflo(va[u].w); y[7] += cf * bfhi(va[u].w);
                y[8] += cf * bflo(vb[u].x); y[9] += cf * bfhi(vb[u].x); y[10] += cf * bflo(vb[u].y); y[11] += cf * bfhi(vb[u].y);
                y[12] += cf * bflo(vb[u].z); y[13] += cf * bfhi(vb[u].z); y[14] += cf * bflo(vb[u].w); y[15] += cf * bfhi(vb[u].w);
            }
        }
        const float* g2 = mod_ + b * NMOD + 5120 + 8 * lane;
        float* op = out_ + (size_t)t * D + 8 * lane;
#pragma unroll
        for (int hf = 0; hf < 2; ++hf)
#pragma unroll
            for (int q = 0; q < 2; ++q) { const f32x4 x1 = *(const GAS f32x4*)(op + 512 * hf + 4 * q); const f32x4 gg = *(const f32x4*)(g2 + 512 * hf + 4 * q);
                f32x4 o; o.x = x1.x + gg.x * y[8 * hf + 4 * q]; o.y = x1.y + gg.y * y[8 * hf + 4 * q + 1]; o.z = x1.z + gg.z * y[8 * hf + 4 * q + 2]; o.w = x1.w + gg.w * y[8 * hf + 4 * q + 3];
                *(GAS f32x4*)(op + 512 * hf + 4 * q) = o; }
    }
}

constexpr int N_PHASES = 10;
struct Args { const float* in[19]; float* out; unsigned char* ws; int ph_lo, ph_hi; };
__global__ void __launch_bounds__(NTHR, 2) hybrid_fwd(Args args) {
    extern __shared__ __attribute__((aligned(16))) unsigned char lds_raw[];
    Frame F;
    F.lds = (LAS unsigned char*)lds_raw;
    F.MISC = (volatile LAS unsigned*)(F.lds + LDSCTL_OFF + 320);
    F.tid = threadIdx.x; F.lane = F.tid & 63; F.wave = __builtin_amdgcn_readfirstlane(F.tid >> 6);
    F.G = gridDim.x; { const int bx = blockIdx.x; F.vcu = (F.G % 8 == 0) ? (bx % 8) * (F.G / 8) + bx / 8 : bx; }
    F.ws = args.ws;
    F.ctl = (gu32*)(F.ws + WS_CTL);
    for (int u = F.tid; u < (LDS_BYTES - LDSCTL_OFF) / 4; u += NTHR) ((LAS unsigned*)(F.lds + LDSCTL_OFF))[u] = 0u;
    __syncthreads();
    const int lo = args.ph_lo, hi = args.ph_hi;
    const bool one_launch = (hi - lo) > 1;
    XcdBarrier bar; bar.bar = (unsigned*)(F.ctl + CW_BAR); bar.x = 0; bar.st = nullptr;
    if (one_launch) bar = xcd_barrier_post((unsigned*)(F.ctl + CW_BAR), F.MISC + 8);
#ifndef PHMASK
#define PHMASK 0x3ff
#endif
#define IN(k) (((PHMASK >> (k)) & 1) && lo <= (k) && (k) < hi)
#define SEAM(k) do { if (IN(k) && IN((k) + 1)) xcd_barrier(bar); } while (0)

    if (IN(0)) { p0_phase(F); } SEAM(0);
    if (IN(1)) { norm_phase<true>(F, inp(I_X), inp(I_GN1), 0, 1024); } SEAM(1);
    if (IN(2)) {
        pg8::Gemm g{WSP(bf16, WS_XN), WSP(bf16, WS_WIN), T, NPROJ, D}; pg8::StaticOrder S; S.init(T, NPROJ, F.G, (int)blockIdx.x);
        pg8::EpiBf16<0> E{WSP(bf16, WS_PROJ), NPROJ, nullptr, 0, 0, 1.f};
        pg8::gemm_phase<pg8::EpiBf16<0>, pg8::StaticOrder, PG8_ALIGN, PG8_SP2>(F.lds, g, S, E);
    } SEAM(2);
    if (IN(3)) {
        for (int it = (int)blockIdx.x; it < 64; it += F.G) ml_state_item(F, it >> 1, it & 1);
        volatile LAS int* qi = (volatile LAS int*)(F.lds + LDSCTL_OFF);
        for (;;) {
            if (F.tid == 0) qi[0] = (int)__hip_atomic_fetch_add(F.ctl + CW_Q3, 1u, RLX_AGENT);
            __syncthreads();
            const int u = qi[0];
            __syncthreads();
            if (u >= 1024) break;
            const int qb = 15 - (u >> 6), bh = u & 63; sb_unit(F, bh >> 3, bh & 7, qb);
        }
    } SEAM(3);
    if (IN(4)) { for (int u = F.vcu; u < 2048; u += F.G) ml_out_unit(F, u >> 6, u & 63); } SEAM(4);
    if (IN(5)) {
        pg8::Gemm g{WSP(bf16, WS_MIX), WSP(bf16, WS_WOUT), T, D, D}; pg8::StaticOrder S; S.init(T, D, F.G, (int)blockIdx.x);
        pg8::EpiResGate E{inp(I_X), (float*)inp(I_OUT), WSP(float, WS_MOD) + 2048, NMOD, SEQ, D};
        pg8::gemm_phase<pg8::EpiResGate, pg8::StaticOrder, PG8_ALIGN, PG8_SP2>(F.lds, g, S, E);
    } SEAM(5);
    if (IN(6)) { norm_phase<false>(F, inp(I_OUT), inp(I_GN2), 3072, 4096); } SEAM(6);
    if (IN(7)) {
        pg8::Gemm g{WSP(bf16, WS_XN), WSP(bf16, WS_WEFF), T, NSC, D}; pg8::StaticOrder S; S.init(T, NSC, F.G, (int)blockIdx.x);
        pg8::EpiF32 E{WSP(float, WS_SCORES), NSC};
        pg8::gemm_phase<pg8::EpiF32, pg8::StaticOrder, PG8_ALIGN, PG8_SP2>(F.lds, g, S, E);
    } SEAM(7);
    if (IN(8)) { for (int it = F.vcu; it < 2048; it += F.G) topk_item(F, it); } SEAM(8);
    if (IN(9)) { peer_phase(F); }
#undef IN
#undef SEAM
}

#ifndef MK_PER_PHASE
#define MK_PER_PHASE 0
#endif
extern "C" void kernel_launch(void* const* d_in, const int* in_sizes, int n_in, void* d_out, int out_size, void* d_ws, size_t ws_size, hipStream_t stream) {
    static int grid = 0;
    if (grid == 0) {
        if (n_in != 19 || in_sizes[0] != T * D || out_size != T * D || ws_size < WS_END) { fprintf(stderr, "kernel_launch: unexpected shapes (n_in %d, in0 %d, out %d, ws %zu)\n", n_in, n_in > 0 ? in_sizes[0] : -1, out_size, ws_size); grid = -1; return; }
        int dev = 0, cus = 0, per_cu = 0;
        if (hipGetDevice(&dev) != hipSuccess || hipDeviceGetAttribute(&cus, hipDeviceAttributeMultiprocessorCount, dev) != hipSuccess) { grid = -1; return; }
        if (hipFuncSetAttribute((const void*)hybrid_fwd, hipFuncAttributeMaxDynamicSharedMemorySize, LDS_BYTES) != hipSuccess) { fprintf(stderr, "kernel_launch: hipFuncSetAttribute failed\n"); grid = -1; return; }
        if (hipOccupancyMaxActiveBlocksPerMultiprocessor(&per_cu, (const void*)hybrid_fwd, NTHR, LDS_BYTES) != hipSuccess || per_cu < 1) fprintf(stderr, "kernel_launch: occupancy query says %d\n", per_cu);
        (void)hipGetLastError();
        grid = cus;
    }
    if (grid < 0) return;
    if (hipMemsetAsync((char*)d_ws + WS_CTL, 0, CTL_ZERO_BYTES, stream) != hipSuccess) { fprintf(stderr, "kernel_launch: memset failed\n"); return; }
    Args a{};
    for (int i = 0; i < 19; ++i) a.in[i] = (const float*)d_in[i];
    a.out = (float*)d_out; a.ws = (unsigned char*)d_ws;
#if MK_PER_PHASE
    for (int p = 0; p < N_PHASES; ++p) { a.ph_lo = p; a.ph_hi = p + 1; hipLaunchKernelGGL(hybrid_fwd, dim3(grid), dim3(NTHR), LDS_BYTES, stream, a); }
#else
    a.ph_lo = 0; a.ph_hi = N_PHASES;
    hipLaunchKernelGGL(hybrid_fwd, dim3(grid), dim3(NTHR), LDS_BYTES, stream, a);
#endif
    const hipError_t le = hipPeekAtLastError();
    if (le != hipSuccess) fprintf(stderr, "kernel_launch: launch failed: %s\n", hipGetErrorName(le));
}
```

```cpp
#include <cmath>
#include <hip/hip_runtime.h>
#include <cstdio>
#include <cstdint>
namespace pg8 {
#define PG8_LAS __attribute__((address_space(3)))
typedef unsigned short bf16_t;
typedef short bf16x8 __attribute__((ext_vector_type(8)));
typedef float f32x4 __attribute__((ext_vector_type(4)));
typedef unsigned u32x4 __attribute__((ext_vector_type(4)));
constexpr int BM = 256, BK = 64, HALF = 128, HTB = HALF * BK * 2  , STAGE_BYTES = 8 * HTB, NXCD = 8,
#ifndef PG8_WGM
#define PG8_WGM 4
#endif
WGM = PG8_WGM;

__host__ __device__ __forceinline__ int lds_byte(int r, int c) { const int st = (r >> 4) * 2 + (c >> 5), rr = r & 15, cc = c & 31, ob = rr * 64 + cc * 2; return st * 1024 + (ob ^ (((ob >> 9) & 1) << 5)); }
__host__ __device__ __forceinline__ void stage_rc(int b, int& R, int& C) { const int st = b / 1024, sb = b % 1024, swz = sb ^ (((sb >> 9) & 1) << 5); R = (st >> 1) * 16 + swz / 64; C = (st & 1) * 32 + (swz % 64) / 2; }
__host__ __device__ __forceinline__ int perm32(int rho) { const int n = rho >> 4, i = rho & 15; return 8 * (i >> 2) + 4 * n + (i & 3); }

struct Unit { int pm, pn; };
struct Gemm { const bf16_t* A; const bf16_t* Bt; int M, N, K; };

struct StaticOrder {
    int nM, nN, nwg, G, c;
    __host__ __device__ void init(int M, int N, int G_, int c_) { nM = M / BM; nN = N / BM; nwg = nM * nN; G = G_; c = c_; }
    __host__ __device__ bool next(int i, Unit& u) const {
        const long L = (long)i * G + c; if (L >= nwg) return false;
        int wgid = (int)L; { const int q = nwg / NXCD, r = nwg % NXCD, xcd = wgid % NXCD, off = wgid / NXCD; wgid = (xcd < r ? xcd * (q + 1) : r * (q + 1) + (xcd - r) * q) + off; }
        const int nig = WGM * nN, gid = wgid / nig, fm = gid * WGM, gsz = (nM - fm) < WGM ? (nM - fm) : WGM;
        u.pm = fm + ((wgid % nig) % gsz); u.pn = (wgid % nig) / gsz; return true;
    }
    __device__ __forceinline__ void a_ready(const Unit&) const {}
    __device__ __forceinline__ void done(const Unit&) const {}
};

__device__ __forceinline__ unsigned cvt_pk_bf16(float lo, float hi) { unsigned r; asm volatile("v_cvt_pk_bf16_f32 %0, %1, %2" : "=v"(r) : "v"(lo), "v"(hi)); return r; }
typedef float f32x2 __attribute__((ext_vector_type(2)));
__device__ __forceinline__ f32x2 gelu_pk(f32x2 v) {
    const f32x2 av = __builtin_elementwise_abs(v), d = av * 0.2316418882f + 1.0f;
    f32x2 t; t.x = __builtin_amdgcn_rcpf(d.x); t.y = __builtin_amdgcn_rcpf(d.y);
    f32x2 q = t * 0.5307027145f + (-0.7265760135f); q = q * t + 0.7107068705f; q = q * t + (-0.142248368f); q = q * t + 0.127414796f; q = q * t;
    const f32x2 s = (v * v) * (-0.72134752044f);
    f32x2 e; e.x = __builtin_amdgcn_exp2f(s.x); e.y = __builtin_amdgcn_exp2f(s.y);
    const f32x2 m = v * (q * e), r = v - m;
    f32x2 o; o.x = v.x < 0.f ? m.x : r.x; o.y = v.y < 0.f ? m.y : r.y; return o;
}

template <int ACT  > struct EpiBf16 {
    static constexpr bool PERM = true, AFTER_DRAIN = false; static_assert(ACT == 0 || ACT == 1, "EpiBf16: ACT is 0 (none) or 1 (gelu_pk)");
    bf16_t* O; int ldc; const float* bias; int split_cols; size_t split_stride; float scale0;
    __device__ __forceinline__ void operator()(const f32x4 (&acc)[2][2][4][2], const Unit& u, int wr, int wc, int fr, int fq) const {
        const int row0 = u.pm * BM + wr * 64 + fr; int colt = u.pn * BM; bf16_t* base = O;
        float sc = 1.f; if (split_cols) { const int t = colt / split_cols; base += (size_t)t * split_stride; colt -= t * split_cols; if (t == 0) sc = scale0; }
        const int col0 = colt + wc * 32 + 8 * fq, bcol0 = u.pn * BM + wc * 32 + 8 * fq;
        f32x4 bv[2][2];
#pragma unroll
        for (int bj = 0; bj < 2; ++bj)
#pragma unroll
            for (int n = 0; n < 2; ++n) bv[bj][n] = bias ? *(const f32x4*)(bias + bcol0 + bj * HALF + 4 * n) : (f32x4){0.f, 0.f, 0.f, 0.f};
#pragma unroll
        for (int ai = 0; ai < 2; ++ai)
#pragma unroll
            for (int m = 0; m < 4; ++m) { bf16_t* rowp = base + (size_t)(row0 + ai * HALF + m * 16) * ldc + col0;
#pragma unroll
                for (int bj = 0; bj < 2; ++bj) { f32x4 v0 = acc[ai][bj][m][0] + bv[bj][0], v1 = acc[ai][bj][m][1] + bv[bj][1];
                    if (ACT == 1) { f32x2 a = gelu_pk((f32x2){v0[0], v0[1]}), b = gelu_pk((f32x2){v0[2], v0[3]}), c = gelu_pk((f32x2){v1[0], v1[1]}), d = gelu_pk((f32x2){v1[2], v1[3]});
                        v0 = (f32x4){a.x, a.y, b.x, b.y}; v1 = (f32x4){c.x, c.y, d.x, d.y}; }
                    v0 = v0 * sc; v1 = v1 * sc; u32x4 w; w.x = cvt_pk_bf16(v0[0], v0[1]); w.y = cvt_pk_bf16(v0[2], v0[3]); w.z = cvt_pk_bf16(v1[0], v1[1]); w.w = cvt_pk_bf16(v1[2], v1[3]);
                    *(u32x4*)(rowp + bj * HALF) = w; } }
    }
};
template <class Epi, class Sched, bool ALIGN_EPI = false, bool SP2 = false>
__device__ __forceinline__ void gemm_phase(PG8_LAS unsigned char* lds, const Gemm g, const Sched& S, const Epi& E) {
    const int tid = threadIdx.x, wid = __builtin_amdgcn_readfirstlane(tid >> 6), lane = tid & 63, wr = wid >> 2, wc = wid & 3, fr = lane & 15, fq = lane >> 4;
    const int K = g.K, nt = K / BK;
    unsigned voffA[2], voffB[2];
#pragma unroll
    for (int i = 0; i < 2; ++i) { int R, C; stage_rc(tid * 16 + i * 8192, R, C); const int Rb = Epi::PERM ? ((R & ~31) + perm32(R & 31)) : R;
        voffA[i] = (unsigned)(R * K + C) * 2u; voffB[i] = (unsigned)(Rb * K + C) * 2u; }
    const size_t kstep = (size_t)(BK * 2);
    const size_t hstep = (size_t)HALF * K * 2;
    const size_t tstep = 2 * hstep;
    const unsigned ldsw = (unsigned)wid * 1024u;
    const int aoff = lds_byte(wr * 64 + fr, fq * 8), boff = lds_byte(wc * 32 + fr, fq * 8);
#define PG8_SA(b, h) (((b) * 2 + (h)) * HTB)
#define PG8_SB(b, h) ((4 + (b) * 2 + (h)) * HTB)
#define PG8_STAGE(bufoff, gbase, voff) do { _Pragma("unroll") for (int _i = 0; _i < 2; ++_i) \
        __builtin_amdgcn_global_load_lds((const unsigned*)((const char*)(gbase) + (voff)[_i]), (PG8_LAS unsigned*)(lds + (bufoff) + ldsw + _i * 8192), 16, 0, 0); } while (0)
#define PG8_LDA(dst, b, h) do { _Pragma("unroll") for (int m = 0; m < 4; ++m) _Pragma("unroll") for (int k = 0; k < 2; ++k) dst[m][k] = *(const PG8_LAS bf16x8*)(lds + PG8_SA(b, h) + aoff + m * 2048 + k * 1024); } while (0)
#define PG8_LDB(dst, b, h) do { _Pragma("unroll") for (int n = 0; n < 2; ++n) _Pragma("unroll") for (int k = 0; k < 2; ++k) dst[n][k] = *(const PG8_LAS bf16x8*)(lds + PG8_SB(b, h) + boff + n * 2048 + k * 1024); } while (0)
#define PG8_MMA(ai, bj, At, Bt) do { __builtin_amdgcn_s_setprio(1); _Pragma("unroll") for (int m = 0; m < 4; ++m) _Pragma("unroll") for (int n = 0; n < 2; ++n) _Pragma("unroll") for (int k = 0; k < 2; ++k) \
        acc[ai][bj][m][n] = __builtin_amdgcn_mfma_f32_16x16x32_bf16(Bt[n][k], At[m][k], acc[ai][bj][m][n], 0, 0, 0); __builtin_amdgcn_s_setprio(0); } while (0)
#define PG8_WAIT_V(n) asm volatile("s_waitcnt vmcnt(" #n ")" ::: "memory")
#define PG8_WAIT_L(n) asm volatile("s_waitcnt lgkmcnt(" #n ")" ::: "memory")
#define PG8_BAR __builtin_amdgcn_s_barrier()
#define PG8_SCHED __builtin_amdgcn_sched_barrier(0)
    Unit cur, nxt; int ui = 0;
    if (!S.next(0, cur)) return;
    f32x4 acc[2][2][4][2];
#pragma unroll
    for (int a = 0; a < 2; ++a)
#pragma unroll
        for (int b = 0; b < 2; ++b)
#pragma unroll
            for (int m = 0; m < 4; ++m)
#pragma unroll
                for (int n = 0; n < 2; ++n) acc[a][b][m][n] = (f32x4){0.f, 0.f, 0.f, 0.f};
    bf16x8 At[4][2], B0[2][2], B1[2][2];
    const char* cA = (const char*)g.A + (size_t)cur.pm * tstep; const char* cB = (const char*)g.Bt + (size_t)cur.pn * tstep;
    S.a_ready(cur);
    if constexpr (SP2) {
        PG8_STAGE(PG8_SB(0, 0), cB, voffB); PG8_STAGE(PG8_SB(0, 1), cB + hstep, voffB); PG8_STAGE(PG8_SA(0, 0), cA, voffA); PG8_STAGE(PG8_SA(0, 1), cA + hstep, voffA);
        if (wr == 1) PG8_BAR;
        PG8_WAIT_V(2); PG8_BAR;
        PG8_STAGE(PG8_SB(1, 0), cB + kstep, voffB); PG8_STAGE(PG8_SA(1, 0), cA + kstep, voffA); PG8_STAGE(PG8_SB(1, 1), cB + hstep + kstep, voffB);
        PG8_WAIT_V(6); PG8_BAR;
    } else {
        PG8_STAGE(PG8_SB(0, 0), cB, voffB); PG8_STAGE(PG8_SA(0, 0), cA, voffA); PG8_STAGE(PG8_SB(0, 1), cB + hstep, voffB); PG8_STAGE(PG8_SA(0, 1), cA + hstep, voffA);
        if (wr == 1) PG8_BAR;
        PG8_WAIT_V(4); PG8_BAR;
        PG8_STAGE(PG8_SB(1, 0), cB + kstep, voffB); PG8_STAGE(PG8_SA(1, 0), cA + kstep, voffA); PG8_STAGE(PG8_SB(1, 1), cB + hstep + kstep, voffB);
        PG8_WAIT_V(6); PG8_BAR;
    }
    for (;;) {
        const bool has_next = S.next(ui + 1, nxt);
        const char* nA = has_next ? (const char*)g.A + (size_t)nxt.pm * tstep : cA; const char* nB = has_next ? (const char*)g.Bt + (size_t)nxt.pn * tstep : cB;
        for (int t = 0; t < nt; t += 2) {
            const bool last = (t == nt - 2);
            const char* a1 = cA + (size_t)(t + 1) * kstep;
            const char* a2 = last ? nA : cA + (size_t)(t + 2) * kstep; const char* b2 = last ? nB : cB + (size_t)(t + 2) * kstep;
            const char* a3 = a2 + kstep; const char* b3 = b2 + kstep;
            if (last && has_next) S.a_ready(nxt);
            if constexpr (SP2) {
            PG8_LDB(B0, 0, 0); PG8_LDB(B1, 0, 1); PG8_SCHED; PG8_LDA(At, 0, 0); PG8_STAGE(PG8_SA(1, 1), a1 + hstep, voffA);
            PG8_WAIT_V(8); PG8_WAIT_L(0); PG8_BAR; PG8_MMA(0, 0, At, B0); PG8_MMA(0, 1, At, B1); PG8_BAR; PG8_SCHED;
            PG8_LDA(At, 0, 1); PG8_STAGE(PG8_SB(0, 0), b2, voffB); PG8_STAGE(PG8_SB(0, 1), b2 + hstep, voffB); PG8_STAGE(PG8_SA(0, 0), a2, voffA);
            PG8_WAIT_V(8); PG8_WAIT_L(0); PG8_BAR; PG8_MMA(1, 0, At, B0); PG8_MMA(1, 1, At, B1); PG8_BAR; PG8_SCHED;
            PG8_LDB(B0, 1, 0); PG8_LDB(B1, 1, 1); PG8_SCHED; PG8_LDA(At, 1, 0); PG8_STAGE(PG8_SA(0, 1), a2 + hstep, voffA);
            PG8_WAIT_V(8); PG8_WAIT_L(0); PG8_BAR; PG8_MMA(0, 0, At, B0); PG8_MMA(0, 1, At, B1); PG8_BAR; PG8_SCHED;
            PG8_LDA(At, 1, 1); PG8_STAGE(PG8_SB(1, 0), b3, voffB); PG8_STAGE(PG8_SB(1, 1), b3 + hstep, voffB); PG8_STAGE(PG8_SA(1, 0), a3, voffA);
            PG8_WAIT_V(8); PG8_WAIT_L(0); PG8_BAR; PG8_MMA(1, 0, At, B0); PG8_MMA(1, 1, At, B1); PG8_BAR; PG8_SCHED;
            } else {
            PG8_LDB(B0, 0, 0); PG8_SCHED; PG8_LDA(At, 0, 0); PG8_STAGE(PG8_SA(1, 1), a1 + hstep, voffA);
            PG8_WAIT_L(8); PG8_BAR; PG8_WAIT_L(0); PG8_MMA(0, 0, At, B0); PG8_BAR; PG8_SCHED;
            PG8_LDB(B1, 0, 1); PG8_STAGE(PG8_SB(0, 0), b2, voffB);
            PG8_BAR; PG8_WAIT_L(0); PG8_MMA(0, 1, At, B1); PG8_BAR;
            PG8_LDA(At, 0, 1); PG8_STAGE(PG8_SA(0, 0), a2, voffA);
            PG8_BAR; PG8_WAIT_L(0); PG8_MMA(1, 0, At, B0); PG8_BAR; PG8_SCHED;
            PG8_STAGE(PG8_SB(0, 1), b2 + hstep, voffB);
            PG8_WAIT_V(6); PG8_BAR; PG8_MMA(1, 1, At, B1); PG8_BAR;
            PG8_LDB(B0, 1, 0); PG8_SCHED; PG8_LDA(At, 1, 0); PG8_STAGE(PG8_SA(0, 1), a2 + hstep, voffA);
            PG8_WAIT_L(8); PG8_BAR; PG8_WAIT_L(0); PG8_MMA(0, 0, At, B0); PG8_BAR; PG8_SCHED;
            PG8_LDB(B1, 1, 1); PG8_STAGE(PG8_SB(1, 0), b3, voffB);
            PG8_BAR; PG8_WAIT_L(0); PG8_MMA(0, 1, At, B1); PG8_BAR;
            PG8_LDA(At, 1, 1); PG8_STAGE(PG8_SA(1, 0), a3, voffA);
            PG8_BAR; PG8_WAIT_L(0); PG8_MMA(1, 0, At, B0); PG8_BAR; PG8_SCHED;
            PG8_STAGE(PG8_SB(1, 1), b3 + hstep, voffB);
            PG8_WAIT_V(6); PG8_BAR; PG8_MMA(1, 1, At, B1); PG8_BAR;
            }
        }
        if constexpr (ALIGN_EPI) { if (wr == 0) PG8_BAR; }
        if constexpr (!Epi::AFTER_DRAIN) { E(acc, cur, wr, wc, fr, fq); S.done(cur); }
        if (!has_next) break;
#pragma unroll
        for (int a = 0; a < 2; ++a)
#pragma unroll
            for (int b = 0; b < 2; ++b)
#pragma unroll
                for (int m = 0; m < 4; ++m)
#pragma unroll
                    for (int n = 0; n < 2; ++n) acc[a][b][m][n] = (f32x4){0.f, 0.f, 0.f, 0.f};
        cur = nxt; cA = nA; cB = nB; ++ui;
        if constexpr (ALIGN_EPI) { if (wr == 1) PG8_BAR; }
    }
    PG8_WAIT_V(0);
    if constexpr (!ALIGN_EPI) { if (wr == 0) PG8_BAR; }
    PG8_BAR;
    if constexpr (Epi::AFTER_DRAIN) { E.fused(acc, cur, wr, wc, fr, fq, lds, wid, lane); S.done(cur); }
#undef PG8_SA
#undef PG8_SB
#undef PG8_STAGE
#undef PG8_LDA
#undef PG8_LDB
#undef PG8_MMA
#undef PG8_WAIT_V
#undef PG8_WAIT_L
#undef PG8_BAR
#undef PG8_SCHED
}
}

#ifndef PG8_SP2
#define PG8_SP2 true
#endif
#ifndef PG8_ALIGN
#define PG8_ALIGN true
#endif

namespace pg8 {
struct EpiResGate {
    static constexpr bool PERM = false, AFTER_DRAIN = false;
    const float* base; float* out; const float* gate; int gate_ld; int rows_per_batch; int ldc;
    __device__ __forceinline__ void operator()(const f32x4 (&acc)[2][2][4][2], const Unit& u, int wr, int wc, int fr, int fq) const {
        const int row0 = u.pm * BM + wr * 64 + fr, col0 = u.pn * BM + wc * 32 + 4 * fq;
        const float* gp = gate + (size_t)((u.pm * BM) / rows_per_batch) * gate_ld + col0;
        f32x4 gv[2][2];
#pragma unroll
        for (int bj = 0; bj < 2; ++bj)
#pragma unroll
            for (int n = 0; n < 2; ++n) gv[bj][n] = *(const f32x4*)(gp + bj * HALF + n * 16);
#pragma unroll
        for (int ai = 0; ai < 2; ++ai)
#pragma unroll
            for (int m = 0; m < 4; ++m) { const size_t off = (size_t)(row0 + ai * HALF + m * 16) * ldc + col0;
#pragma unroll
                for (int bj = 0; bj < 2; ++bj)
#pragma unroll
                    for (int n = 0; n < 2; ++n) { const f32x4 bs = *(const f32x4*)(base + off + bj * HALF + n * 16);
                        *(f32x4*)(out + off + bj * HALF + n * 16) = bs + gv[bj][n] * acc[ai][bj][m][n]; } }
    }
};
struct EpiF32 {
    static constexpr bool PERM = false, AFTER_DRAIN = false;
    float* O; int ldc;
    __device__ __forceinline__ void operator()(const f32x4 (&acc)[2][2][4][2], const Unit& u, int wr, int wc, int fr, int fq) const {
        const int row0 = u.pm * BM + wr * 64 + fr, col0 = u.pn * BM + wc * 32 + 4 * fq;
#pragma unroll
        for (int ai = 0; ai < 2; ++ai)
#pragma unroll
            for (int m = 0; m < 4; ++m) { const size_t off = (size_t)(row0 + ai * HALF + m * 16) * ldc + col0;
#pragma unroll
                for (int bj = 0; bj < 2; ++bj)
#pragma unroll
                    for (int n = 0; n < 2; ++n) *(f32x4*)(O + off + bj * HALF + n * 16) = acc[ai][bj][m][n]; }
    }
};
}
#define GAS __attribute__((address_space(1)))
#define LAS __attribute__((address_space(3)))
typedef unsigned short bf16;
typedef unsigned v4u __attribute__((ext_vector_type(4)));
typedef float f32x4 __attribute__((ext_vector_type(4)));
typedef short bf16x8 __attribute__((ext_vector_type(8)));
typedef GAS unsigned gu32;
typedef GAS unsigned long long gu64;
#define RLX_AGENT __ATOMIC_RELAXED, __HIP_MEMORY_SCOPE_AGENT
#define LDS_WAIT() asm volatile("s_waitcnt lgkmcnt(0)" ::: "memory")
#define VM_WAIT() asm volatile("s_waitcnt vmcnt(0)" ::: "memory")
__device__ __forceinline__ unsigned long long rt() { return __builtin_amdgcn_s_memrealtime(); }
__device__ __forceinline__ unsigned f2bf(float f) { unsigned u = __builtin_bit_cast(unsigned, f); return (u + 0x7fffu + ((u >> 16) & 1u)) >> 16; }
__device__ __forceinline__ unsigned pk2(float lo, float hi) { return f2bf(lo) | (f2bf(hi) << 16); }

#define XB_TMO      128
#define XB_XCNT(j)  (256  + 64 * (j))
#define XB_XSUB(j)  (1280 + 64 * (j))
#define XB_XGEN(j)  (2304 + 64 * (j))
#define XB_TOP      3328
#define XB_TOPGEN   3392
#define XCD_BAR_WORDS 3456
#define XB_SPIN_CAP (1u << 24)

__device__ __forceinline__ unsigned xb_ld(unsigned* p)              { return __hip_atomic_load(p, __ATOMIC_RELAXED, __HIP_MEMORY_SCOPE_AGENT); }
__device__ __forceinline__ unsigned xb_add(unsigned* p, unsigned v) { return __hip_atomic_fetch_add(p, v, __ATOMIC_RELAXED, __HIP_MEMORY_SCOPE_AGENT); }
__device__ __forceinline__ unsigned xb_xcc_id() { return (unsigned)__builtin_amdgcn_s_getreg((3 << 11) | 20) & 0xFu; }
#define XB_SPIN(cond, bar) do { unsigned _sp = 0; while (cond) { __builtin_amdgcn_s_sleep(1); \
    if ((++_sp & 255u) == 0u) { if (xb_ld(&(bar)[XB_TMO])) break; if (_sp > XB_SPIN_CAP) { atomicAdd(&(bar)[XB_TMO], 1u); break; } } } } while (0)

struct XcdBarrier {
    unsigned* bar; unsigned x;
    volatile LAS unsigned* st;
};

__device__ __forceinline__ XcdBarrier xcd_barrier_post(unsigned* bar, volatile LAS unsigned* st) {
    XcdBarrier b; b.bar = bar; b.x = xb_xcc_id(); b.st = st;
    if (threadIdx.x == 0) (void)xb_add(&bar[XB_XCNT(b.x)], 1u);
    return b;
}
__device__ __forceinline__ void xcd_barrier_complete(unsigned* bar, unsigned x, unsigned& nloc, unsigned& nx) {
    const unsigned G = gridDim.x * gridDim.y * gridDim.z;
    unsigned sum, cnt, mine, sp = 0u;
    for (;;) {
        sum = 0u; cnt = 0u; mine = 0u;
#pragma unroll
        for (unsigned j = 0; j < 16; ++j) { const unsigned c = xb_ld(&bar[XB_XCNT(j)]); sum += c; cnt += (c > 0u) ? 1u : 0u; mine = (j == x) ? c : mine; }
        if (sum == G) break;
        __builtin_amdgcn_s_sleep(1);
        if ((++sp & 255u) == 0u) { if (xb_ld(&bar[XB_TMO])) break; if (sp > XB_SPIN_CAP) { atomicAdd(&bar[XB_TMO], 1u); break; } }
    }
    nloc = mine > 0u ? mine : 1u; nx = cnt > 0u ? cnt : 1u;
}

__device__ __forceinline__ void xcd_barrier(const XcdBarrier& b) {
    asm volatile("s_waitcnt vmcnt(0)" ::: "memory");
    __syncthreads();
    if (threadIdx.x == 0) {
        unsigned* bar = b.bar;
        __builtin_amdgcn_s_waitcnt(0);
        unsigned nloc = b.st[0], nx = b.st[1];
        if (nloc == 0u) { xcd_barrier_complete(bar, b.x, nloc, nx); b.st[0] = nloc; b.st[1] = nx; }
        const unsigned old = xb_add(&bar[XB_XSUB(b.x)], 1u);
        const unsigned gen = old / nloc;
        if (old + 1u == (gen + 1u) * nloc) {
            __builtin_amdgcn_fence(__ATOMIC_RELEASE, "agent");
            asm volatile("s_waitcnt vmcnt(0)" ::: "memory");
            const unsigned og = xb_add(&bar[XB_TOP], 1u);
            const unsigned tg = og / nx;
            if (og + 1u == (tg + 1u) * nx) xb_add(&bar[XB_TOPGEN], 1u);
            else XB_SPIN(xb_ld(&bar[XB_TOPGEN]) == tg, bar);
            __builtin_amdgcn_fence(__ATOMIC_ACQUIRE, "agent");
            xb_add(&bar[XB_XGEN(b.x)], 1u);
            asm volatile("s_waitcnt vmcnt(0)" ::: "memory");
        } else {
            XB_SPIN(xb_ld(&bar[XB_XGEN(b.x)]) == gen, bar);
            __builtin_amdgcn_fence(__ATOMIC_ACQUIRE, "agent");
            asm volatile("s_waitcnt vmcnt(0)" ::: "memory");
        }
    }
    __syncthreads();
}

constexpr int NWAVES = 8, NTHR = 512;
constexpr int NB = 8, SEQ = 4096, T = NB * SEQ, D = 1024, NPROJ = 3584, NIN = 3592, NMOD = 6144, NSC = 2048;
constexpr int C_QSB = 0, C_KSB = 512, C_VSB = 1024, C_QML = 1536, C_KML = 2048, C_VML = 2560, C_OML = 3072;
constexpr float EPS = 1e-6f, LOG2E = 1.4426950408889634f;
constexpr size_t MiB = 1u << 20;
constexpr size_t WS_CTL = 0, CTL_ZERO_BYTES = 1 * MiB;
constexpr size_t WS_MOD = 256 * 1024;
constexpr size_t WS_WIN = 2 * MiB, WS_WOUT = 10 * MiB, WS_WEFF = 12 * MiB;
constexpr size_t WS_XN = 16 * MiB;
constexpr size_t WS_PROJ = 80 * MiB;
constexpr size_t WS_MIX = 304 * MiB;
constexpr size_t WS_EXPU = 368 * MiB, WS_EXPV = 400 * MiB;
constexpr size_t WS_CST = 432 * MiB;
constexpr size_t WS_NST = 496 * MiB;
constexpr size_t WS_MST = 497 * MiB;
constexpr size_t WS_GATES = 498 * MiB;
constexpr size_t WS_SCORES = 80 * MiB;
constexpr size_t WS_IDX = 336 * MiB, WS_GATE = 352 * MiB;
constexpr size_t WS_SCL = 499 * MiB;
constexpr size_t WS_SUI = 499 * MiB + 65536, WS_SVI = 499 * MiB + 131072;
constexpr size_t WS_END = 500 * MiB;
constexpr int CW_Q3 = 64;
constexpr int CW_BAR = 4096;
constexpr int LDS_BYTES = 147456, LDSCTL_OFF = 143360;

typedef float f32x16 __attribute__((ext_vector_type(16)));
typedef float f32x2_t __attribute__((ext_vector_type(2)));
typedef __bf16 bf16x2_t __attribute__((ext_vector_type(2)));
typedef _Float16 f16x8 __attribute__((ext_vector_type(8)));
typedef short s16x4 __attribute__((ext_vector_type(4)));
typedef unsigned u32x2 __attribute__((ext_vector_type(2)));
#define DI __device__ __forceinline__
DI unsigned cvtpk(float lo, float hi) { f32x2_t v = {lo, hi}; bf16x2_t b = __builtin_convertvector(v, bf16x2_t); return __builtin_bit_cast(unsigned, b); }
DI float bflo(unsigned u) { return __uint_as_float(u << 16); }
DI float bfhi(unsigned u) { return __uint_as_float(u & 0xffff0000u); }
DI int crow(int i, int hi) { return (i & 3) + 8 * (i >> 2) + 4 * hi; }
DI int krow(int s, int hi, int j) { return 16 * s + 8 * (j >> 2) + 4 * hi + (j & 3); }
DI float swap_add(float v) { auto rr = __builtin_amdgcn_permlane32_swap(__float_as_uint(v), __float_as_uint(v), false, false); return __uint_as_float(rr[0]) + __uint_as_float(rr[1]); }
DI float swap_max(float v) { auto rr = __builtin_amdgcn_permlane32_swap(__float_as_uint(v), __float_as_uint(v), false, false); return fmaxf(__uint_as_float(rr[0]), __uint_as_float(rr[1])); }
DI float dot2bf(unsigned a, unsigned b, float acc) { return __builtin_amdgcn_fdot2_f32_bf16(__builtin_bit_cast(bf16x2_t, a), __builtin_bit_cast(bf16x2_t, b), acc, false); }
DI float ex2(float x) { return __builtin_amdgcn_exp2f(x); }
DI float lg2(float x) { return __builtin_amdgcn_logf(x); }
DI float fexp(float x) { return __builtin_amdgcn_exp2f(x * LOG2E); }
DI float wave_sum(float v) {
#pragma unroll
    for (int o = 1; o < 64; o <<= 1) v += __shfl_xor(v, o);
    return v;
}
DI float wave_max(float v) {
#pragma unroll
    for (int o = 1; o < 64; o <<= 1) v = fmaxf(v, __shfl_xor(v, o));
    return v;
}
#define DPP_MAXF(v, ctrl, rmask) fmaxf((v), __builtin_bit_cast(float, __builtin_amdgcn_update_dpp(0, __builtin_bit_cast(int, (v)), (ctrl), (rmask), 0xF, false)))
DI float wave_max_nonneg(float v) {
    v = DPP_MAXF(v, 0xB1, 0xF); v = DPP_MAXF(v, 0x4E, 0xF); v = DPP_MAXF(v, 0x141, 0xF); v = DPP_MAXF(v, 0x140, 0xF); v = DPP_MAXF(v, 0x142, 0xA); v = DPP_MAXF(v, 0x143, 0xC);
    return __builtin_bit_cast(float, __builtin_amdgcn_readlane(__builtin_bit_cast(int, v), 63));
}
#define DPP_ADDF(v, ctrl, rmask) ((v) + __builtin_bit_cast(float, __builtin_amdgcn_update_dpp(0, __builtin_bit_cast(int, (v)), (ctrl), (rmask), 0xF, false)))
DI float wave_sum_u(float v) {
    v = DPP_ADDF(v, 0xB1, 0xF); v = DPP_ADDF(v, 0x4E, 0xF); v = DPP_ADDF(v, 0x141, 0xF); v = DPP_ADDF(v, 0x140, 0xF); v = DPP_ADDF(v, 0x142, 0xA); v = DPP_ADDF(v, 0x143, 0xC);
    return __builtin_bit_cast(float, __builtin_amdgcn_readlane(__builtin_bit_cast(int, v), 63));
}
typedef short v4i16_t __attribute__((ext_vector_type(4)));
DI s16x4 trrd(LAS unsigned char* p) { return __builtin_bit_cast(s16x4, __builtin_amdgcn_ds_read_tr16_b64_v4i16((LAS v4i16_t*)p)); }
DI bf16x8 cat8(s16x4 a, s16x4 b) { return (bf16x8){a[0], a[1], a[2], a[3], b[0], b[1], b[2], b[3]}; }
#define MFMA_BF16(a, b, c) __builtin_amdgcn_mfma_f32_32x32x16_bf16((a), (b), (c), 0, 0, 0)
#define MFMA_F16(a, b, c) __builtin_amdgcn_mfma_f32_32x32x16_f16((a), (b), (c), 0, 0, 0)
DI unsigned pkh(float a, float b) { return __builtin_bit_cast(unsigned, __builtin_amdgcn_cvt_pkrtz(a, b)); }
DI bf16x8 packbf(const f32x16& x, int s) { v4u p; p.x = cvtpk(x[8 * s], x[8 * s + 1]); p.y = cvtpk(x[8 * s + 2], x[8 * s + 3]); p.z = cvtpk(x[8 * s + 4], x[8 * s + 5]); p.w = cvtpk(x[8 * s + 6], x[8 * s + 7]); return __builtin_bit_cast(bf16x8, p); }
DI f16x8 packh(const f32x16& x, int s) { v4u p; p.x = pkh(x[8 * s], x[8 * s + 1]); p.y = pkh(x[8 * s + 2], x[8 * s + 3]); p.z = pkh(x[8 * s + 4], x[8 * s + 5]); p.w = pkh(x[8 * s + 6], x[8 * s + 7]); return __builtin_bit_cast(f16x8, p); }

struct Frame {
    LAS unsigned char* lds;
    volatile LAS unsigned* MISC;
    gu32* ctl;
    unsigned char* ws;
    int tid, lane, wave, vcu, G;
};
DI const float* inp(int i) { const __attribute__((address_space(4))) unsigned long long* kp = (const __attribute__((address_space(4))) unsigned long long*)__builtin_amdgcn_kernarg_segment_ptr(); return (const float*)(const GAS float*)(*(volatile const __attribute__((address_space(4))) unsigned long long*)(kp + i)); }
enum { I_X = 0, I_C, I_WADA, I_BADA, I_GN1, I_WIN, I_BIG, I_BFG, I_CONVW, I_GQ, I_GK, I_GOSB, I_GOML, I_WOUT, I_GN2, I_WQ, I_SK, I_EU, I_EV, I_OUT };
#define WSP(type, off) ((type*)(F.ws + (off)))

DI void p0_transpose_item(const float* W, int K, int N, int ld, bf16* WT, LAS float* scr, int item, int lane) {
    const int nblk = N / 32, kb = item / nblk, nb = item % nblk, k0 = 64 * kb, n0 = 32 * nb;
    float tv[32];
#pragma unroll
    for (int i = 0; i < 32; ++i) tv[i] = W[(size_t)(k0 + 2 * i + (lane >> 5)) * ld + n0 + (lane & 31)];
#pragma unroll
    for (int i = 0; i < 32; ++i) scr[(2 * i + (lane >> 5)) * 33 + (lane & 31)] = tv[i];
    LDS_WAIT(); asm volatile("" ::: "memory");
    const int c = lane & 7;
#pragma unroll
    for (int j = 0; j < 4; ++j) { const int n = (lane >> 3) + 8 * j; const LAS float* s = scr + (8 * c) * 33 + n;
        v4u o; o.x = pk2(s[0 * 33], s[1 * 33]); o.y = pk2(s[2 * 33], s[3 * 33]); o.z = pk2(s[4 * 33], s[5 * 33]); o.w = pk2(s[6 * 33], s[7 * 33]);
        *(GAS v4u*)(WT + (size_t)(n0 + n) * K + k0 + 8 * c) = o; }
    LDS_WAIT(); asm volatile("" ::: "memory");
}
DI void p0_mod_block(const Frame& F, int item) {
    const float* const c_ = inp(I_C); const float* const w_ada_ = inp(I_WADA); const float* const b_ada_ = inp(I_BADA); float* const mod_ = WSP(float, WS_MOD);
    LAS float* scr = (LAS float*)(F.lds + F.wave * 16384);
    const int j = item * 64 + F.lane, d0 = F.wave * 128;
#pragma unroll
    for (int b = 0; b < 8; ++b)
#pragma unroll
        for (int q = 0; q < 2; ++q) { const float cv = c_[b * D + d0 + 64 * q + F.lane]; scr[b * 128 + 64 * q + F.lane] = cv / (1.f + fexp(-cv)); }
    LDS_WAIT(); asm volatile("" ::: "memory");
    float acc[8];
#pragma unroll
    for (int b = 0; b < 8; ++b) acc[b] = 0.f;
#pragma unroll 32
    for (int dd = 0; dd < 128; ++dd) { const float w = w_ada_[(size_t)(d0 + dd) * NMOD + j];
#pragma unroll
        for (int b = 0; b < 8; ++b) acc[b] += scr[b * 128 + dd] * w; }
#pragma unroll
    for (int b = 0; b < 8; ++b) scr[1024 + b * 64 + F.lane] = acc[b];
    __syncthreads();
    float tot = b_ada_[j];
#pragma unroll
    for (int w = 0; w < 8; ++w) tot += ((LAS float*)(F.lds + w * 16384))[1024 + F.wave * 64 + F.lane];
    mod_[F.wave * NMOD + j] = tot;
    __syncthreads();
}
DI void p0_weff_item(const Frame& F, int item) {
    const float* const sub_keys_ = inp(I_SK); const float* const w_q_peer_ = inp(I_WQ); bf16* const Weff_t_ = WSP(bf16, WS_WEFF);
    const int hp = item >> 4, dblk = item & 15;
    LAS float* sk = (LAS float*)F.lds;
    LAS float* rb = (LAS float*)(F.lds + 67584) + F.wave * 1024;
    { float tv[32];
#pragma unroll
      for (int i = 0; i < 32; ++i) tv[i] = sub_keys_[(size_t)hp * 16384 + F.tid + 512 * i];
#pragma unroll
      for (int i = 0; i < 32; ++i) { const int idx = F.tid + 512 * i; sk[(idx >> 7) * 129 + (idx & 127)] = tv[i]; } }
    const int d0 = 64 * dblk + 8 * F.wave;
#pragma unroll
    for (int r = 0; r < 8; ++r) { rb[r * 128 + F.lane] = w_q_peer_[(size_t)(d0 + r) * NSC + hp * 128 + F.lane]; rb[r * 128 + 64 + F.lane] = w_q_peer_[(size_t)(d0 + r) * NSC + hp * 128 + 64 + F.lane]; }
    __syncthreads();
    float a0[8], a1[8];
#pragma unroll
    for (int r = 0; r < 8; ++r) { a0[r] = 0.f; a1[r] = 0.f; }
#pragma unroll 4
    for (int c = 0; c < 128; ++c) { const float s0 = sk[F.lane * 129 + c], s1 = sk[(F.lane + 64) * 129 + c];
#pragma unroll
        for (int r = 0; r < 8; ++r) { const float a = rb[r * 128 + c]; a0[r] += a * s0; a1[r] += a * s1; } }
    v4u o0, o1; o0.x = pk2(a0[0], a0[1]); o0.y = pk2(a0[2], a0[3]); o0.z = pk2(a0[4], a0[5]); o0.w = pk2(a0[6], a0[7]);
    o1.x = pk2(a1[0], a1[1]); o1.y = pk2(a1[2], a1[3]); o1.z = pk2(a1[4], a1[5]); o1.w = pk2(a1[6], a1[7]);
    *(GAS v4u*)(Weff_t_ + (size_t)(hp * 128 + F.lane) * D + d0) = o0;
    *(GAS v4u*)(Weff_t_ + (size_t)(hp * 128 + 64 + F.lane) * D + d0) = o1;
    __syncthreads();
}
struct ExpRows2 { f32x4 v[2][4]; };
DI void exp_load2(const Frame& F, int blk0, ExpRows2& R) {
    const float* const expert_u_ = inp(I_EU); const float* const expert_v_ = inp(I_EV);
#pragma unroll
    for (int bb = 0; bb < 2; ++bb) { const int blk = blk0 + bb; const float* src = (blk < 16384 ? expert_u_ : expert_v_) + (size_t)(blk & 16383) * 1024 + 4 * F.lane;
#pragma unroll
        for (int k = 0; k < 4; ++k) R.v[bb][k] = *(const GAS f32x4*)(src + 256 * k); }
}
DI void exp_conv2(const Frame& F, int blk0, const ExpRows2& R) {
    float* const SUI_ = WSP(float, WS_SUI); float* const SVI_ = WSP(float, WS_SVI);
#pragma unroll
    for (int bb = 0; bb < 2; ++bb) { const int blk = blk0 + bb; const bool isu = blk < 16384; const int e = blk & 16383;
        float mx = 0.f;
#pragma unroll
        for (int k = 0; k < 4; ++k) mx = fmaxf(mx, fmaxf(fmaxf(fabsf(R.v[bb][k].x), fabsf(R.v[bb][k].y)), fmaxf(fabsf(R.v[bb][k].z), fabsf(R.v[bb][k].w))));
        mx = wave_max_nonneg(mx);
        const float top = 127.f, sc = mx > 0.f ? top / mx : 0.f;
        if (F.lane == 0) (isu ? SUI_ : SVI_)[e] = mx > 0.f ? mx / top : 0.f;
        unsigned char* dst = (isu ? WSP(unsigned char, WS_EXPU) : WSP(unsigned char, WS_EXPV)) + (size_t)e * 1024 + 4 * F.lane;
#pragma unroll
        for (int k = 0; k < 4; ++k) { const f32x4 a = R.v[bb][k] * sc;
            const int q0 = (int)rintf(a.x), q1 = (int)rintf(a.y), q2 = (int)rintf(a.z), q3 = (int)rintf(a.w); const unsigned w = (unsigned)(q0 & 0xff) | ((unsigned)(q1 & 0xff) << 8) | ((unsigned)(q2 & 0xff) << 16) | ((unsigned)q3 << 24);
            *(GAS unsigned*)(dst + 256 * k) = w; } }
}
#ifndef P0_PARTS
#define P0_PARTS 15
#endif
DI void p0_phase(const Frame& F, int parts = 15) {
    const float* const w_in_ = inp(I_WIN); bf16* const Win_t_ = WSP(bf16, WS_WIN); const float* const w_out_ = inp(I_WOUT); bf16* const Wout_t_ = WSP(bf16, WS_WOUT); const float* const expert_v_ = inp(I_EV); const float* const expert_u_ = inp(I_EU);
    LAS float* scr = (LAS float*)(F.lds + F.wave * 16384);
    const int gw = F.vcu * NWAVES + F.wave, NGW = F.G * NWAVES;
    if (parts & 1) for (int it = F.vcu; it < 96; it += F.G) p0_mod_block(F, it);
    constexpr int I_WIN = 16 * 112, I_WOUT = 16 * 32, NITEMS = I_WIN + I_WOUT;
    if (parts & 2) for (int it = gw; it < NITEMS; it += NGW) {
        int r = it;
        if (r < I_WIN) { p0_transpose_item(w_in_, D, NPROJ, NIN, Win_t_, scr, r, F.lane); continue; } r -= I_WIN;
        p0_transpose_item(w_out_, D, D, D, Wout_t_, scr, r, F.lane);
    }
    __syncthreads();
    if (parts & 8) for (int it = F.vcu; it < 256; it += F.G) p0_weff_item(F, it);
}

template <bool DOGATES>
DI void norm_phase(const Frame& F, const float* src, const float* g, int shift_off, int scale_off) {
    const float* const w_in_ = inp(I_WIN); float* const mod_ = WSP(float, WS_MOD); bf16* const XN_ = WSP(bf16, WS_XN); float* const GATES_ = WSP(float, WS_GATES); const float* const b_igate_ = inp(I_BIG); const float* const b_fgate_ = inp(I_BFG);
    LAS float* W8 = (LAS float*)F.lds;
    if (DOGATES) {
        for (int i = 0; i < 16; ++i) { const int idx = F.tid + 512 * i; W8[idx] = w_in_[(size_t)(idx & 1023) * NIN + NPROJ + (idx >> 10)]; }
        __syncthreads();
    }
    const int gw = F.vcu * NWAVES + F.wave, NGW = F.G * NWAVES;
    for (int ch = gw; ch < T / 16; ch += NGW) {
        const int r0 = ch * 16, b = r0 / SEQ;
        f32x4 A[4], Bv[4];
#pragma unroll
        for (int j = 0; j < 4; ++j) { const int col = 4 * F.lane + 256 * j; const f32x4 gg = *(const f32x4*)(g + col), sc = *(const f32x4*)(mod_ + b * NMOD + scale_off + col);
            A[j] = gg * (sc + 1.0f); Bv[j] = *(const f32x4*)(mod_ + b * NMOD + shift_off + col); }
        f32x4 nx[4];
        { const GAS f32x4* xr0 = (const GAS f32x4*)(src + (size_t)r0 * D) + F.lane;
#pragma unroll
          for (int j = 0; j < 4; ++j) nx[j] = xr0[64 * j]; }
        for (int rr = 0; rr < 16; ++rr) {
            const int row = r0 + rr;
            f32x4 v[4]; float s = 0.f;
#pragma unroll
            for (int j = 0; j < 4; ++j) { v[j] = nx[j]; s += (v[j].x * v[j].x + v[j].y * v[j].y) + (v[j].z * v[j].z + v[j].w * v[j].w); }
            if (rr + 1 < 16) { const GAS f32x4* xr = (const GAS f32x4*)(src + (size_t)(row + 1) * D) + F.lane;
#pragma unroll
                for (int j = 0; j < 4; ++j) nx[j] = xr[64 * j]; }
            const float rstd = 1.f / sqrtf(wave_sum_u(s) * (1.f / D) + EPS);
#pragma unroll
            for (int j = 0; j < 4; ++j) v[j] = v[j] * rstd * A[j] + Bv[j];
            GAS unsigned long long* o8 = (GAS unsigned long long*)(XN_ + (size_t)row * D) + F.lane;
#pragma unroll
            for (int j = 0; j < 4; ++j) o8[64 * j] = (unsigned long long)pk2(v[j].x, v[j].y) | ((unsigned long long)pk2(v[j].z, v[j].w) << 32);
            if (DOGATES) {
                float res = 0.f;
#pragma unroll
                for (int hh = 0; hh < 8; ++hh) { float p = 0.f;
#pragma unroll
                    for (int j = 0; j < 4; ++j) { const f32x4 w = *(const LAS f32x4*)(W8 + hh * 1024 + 4 * F.lane + 256 * j); p += (v[j].x * w.x + v[j].y * w.y) + (v[j].z * w.z + v[j].w * w.w); }
                    p = wave_sum_u(p); if (F.lane == hh) res = p; }
                if (F.lane < 8) GATES_[(size_t)row * 8 + F.lane] = res + (F.lane < 4 ? b_igate_[F.lane] : b_fgate_[F.lane - 4]);
            }
        }
    }
}

DI void sb_unit(const Frame& F, int b, int h, int qb) {
    bf16* const PROJ_ = WSP(bf16, WS_PROJ); const float* const g_q_sb_ = inp(I_GQ); const float* const g_k_sb_ = inp(I_GK); bf16* const MIX_ = WSP(bf16, WS_MIX); const float* const g_out_sb_ = inp(I_GOSB);
    const int lane = F.lane, w = F.wave, r = lane & 31, hi = lane >> 5;
    const int i16 = lane & 15, qq = i16 >> 2, pp = i16 & 3, blk = (lane >> 4) & 1;
    LAS unsigned char* Wb = F.lds + w * 16384;
    const size_t rowbase = (size_t)b * SEQ; const int q0 = qb * 256, qw0 = q0 + 32 * w, tq = qw0 + r;
    const bf16* P = PROJ_;
    const bf16* kpiece[4]; const bf16* vpiece[4];
#pragma unroll
    for (int i = 0; i < 4; ++i) { const int krow_ = 8 * i + (lane >> 3), kch = (lane & 7) ^ ((krow_ >> 1) & 7); kpiece[i] = P + (rowbase + krow_) * NPROJ + C_KSB + h * 64 + 8 * kch;
        const int vkey = 16 * (i & 1) + (lane >> 2); vpiece[i] = P + (rowbase + vkey) * NPROJ + C_VSB + h * 64 + 32 * (i >> 1) + 8 * (lane & 3); }
#define SB_DMA(T_, BUF_) do { _Pragma("unroll") for (int i_ = 0; i_ < 4; ++i_) { \
        __builtin_amdgcn_global_load_lds((const unsigned*)(kpiece[i_] + (size_t)(32 * (T_)) * NPROJ), (LAS unsigned*)(Wb + 8192 * (BUF_) + 1024 * i_), 16, 0, 0); \
        __builtin_amdgcn_global_load_lds((const unsigned*)(vpiece[i_] + (size_t)(32 * (T_)) * NPROJ), (LAS unsigned*)(Wb + 8192 * (BUF_) + 4096 + 1024 * i_), 16, 0, 0); } } while (0)
    const int tw = (qw0 + 30) >> 5;
    SB_DMA(tw, 0);
    bf16x8 qf[4];
    {
        const bf16* Qp = P + (rowbase + tq) * NPROJ + C_QSB + h * 64 + 8 * hi;
        v4u qraw[4]; float ss = 0.f;
#pragma unroll
        for (int kk = 0; kk < 4; ++kk) { qraw[kk] = *(const GAS v4u*)(Qp + 16 * kk);
#pragma unroll
            for (int e = 0; e < 4; ++e) { const float a = bflo(qraw[kk][e]), c = bfhi(qraw[kk][e]); ss += a * a + c * c; } }
        ss = swap_add(ss);
        const float rq = __builtin_amdgcn_rsqf(ss * (1.f / 64.f) + EPS) * (0.125f * LOG2E);
#pragma unroll
        for (int kk = 0; kk < 4; ++kk) { const int d0 = 16 * kk + 8 * hi;
            const f32x4 g0 = *(const f32x4*)(g_q_sb_ + d0) * *(const f32x4*)(g_k_sb_ + d0), g1 = *(const f32x4*)(g_q_sb_ + d0 + 4) * *(const f32x4*)(g_k_sb_ + d0 + 4);
            v4u o; o.x = cvtpk(bflo(qraw[kk].x) * rq * g0.x, bfhi(qraw[kk].x) * rq * g0.y); o.y = cvtpk(bflo(qraw[kk].y) * rq * g0.z, bfhi(qraw[kk].y) * rq * g0.w);
            o.z = cvtpk(bflo(qraw[kk].z) * rq * g1.x, bfhi(qraw[kk].z) * rq * g1.y); o.w = cvtpk(bflo(qraw[kk].w) * rq * g1.z, bfhi(qraw[kk].w) * rq * g1.w);
            qf[kk] = __builtin_bit_cast(bf16x8, o); }
    }
    f16x8 U0, U1, E0;
#pragma unroll
    for (int j = 0; j < 8; ++j) { U0[j] = (krow(0, hi, j) > r) ? (_Float16)1.0f : (_Float16)0.0f; U1[j] = (krow(1, hi, j) > r) ? (_Float16)1.0f : (_Float16)0.0f;
        E0[j] = (j == 0 && hi == 0) ? (_Float16)1.0f : (_Float16)0.0f; }
    f32x16 o0, o1;
#pragma unroll
    for (int i = 0; i < 16; ++i) { o0[i] = 0.f; o1[i] = 0.f; }
    float R = 0.f;
    const int kfoff = r * 128, kfsw = (r >> 1) & 7;
    for (int t = tw; t >= 0; --t) {
        const int buf = (tw - t) & 1;
        LAS unsigned char* Kb = Wb + 8192 * buf; LAS unsigned char* Vb = Kb + 4096;
        asm volatile("s_waitcnt vmcnt(0)" ::: "memory");
        if (t > 0) SB_DMA(t - 1, buf ^ 1);
        bf16x8 kf[4]; float ssk = 0.f;
#pragma unroll
        for (int kk = 0; kk < 4; ++kk) { const v4u kv = *(const LAS v4u*)(Kb + kfoff + (((2 * kk + hi) ^ kfsw) * 16)); kf[kk] = __builtin_bit_cast(bf16x8, kv);
            ssk = dot2bf(kv.x, kv.x, ssk); ssk = dot2bf(kv.y, kv.y, ssk); ssk = dot2bf(kv.z, kv.z, ssk); ssk = dot2bf(kv.w, kv.w, ssk); }
        ssk = swap_add(ssk);
        const float rk = __builtin_amdgcn_rsqf(ssk * (1.f / 64.f) + EPS);
        f16x8 RKA;
#pragma unroll
        for (int e = 0; e < 8; ++e) RKA[e] = (_Float16)0.0f;
        RKA[0] = (hi == 0) ? (_Float16)rk : (_Float16)0.0f;
        f32x16 s, rkd;
#pragma unroll
        for (int i = 0; i < 16; ++i) { s[i] = 0.f; rkd[i] = 0.f; }
        rkd = MFMA_F16(RKA, E0, rkd);
#pragma unroll
        for (int kk = 0; kk < 4; ++kk) s = MFMA_BF16(kf[kk], qf[kk], s);
        float tsum = 0.f; unsigned lp[8];
        if (32 * t + 31 < qw0) {
#pragma unroll
            for (int i = 0; i < 16; i += 2) {
                const float z0_ = s[i] * rkd[i], z1_ = s[i + 1] * rkd[i + 1];
                const float a0_ = -lg2(1.f + ex2(z0_)), a1_ = -lg2(1.f + ex2(z1_));
                tsum += a0_ + a1_;
                s[i] = z0_ + a0_; s[i + 1] = z1_ + a1_;
                lp[i >> 1] = pkh(a0_, a1_); }
        } else {
            const int kq = tq - 32 * t;
#pragma unroll
            for (int i = 0; i < 16; i += 2) {
                const float z0_ = s[i] * rkd[i], z1_ = s[i + 1] * rkd[i + 1];
                float a0_ = -lg2(1.f + ex2(z0_)), a1_ = -lg2(1.f + ex2(z1_));
                const bool ma0 = crow(i, hi) >= kq, ma1 = crow(i + 1, hi) >= kq;
                a0_ = ma0 ? 0.f : a0_; a1_ = ma1 ? 0.f : a1_;
                tsum += a0_ + a1_;
                s[i] = ma0 ? -INFINITY : z0_ + a0_; s[i + 1] = ma1 ? -INFINITY : z1_ + a1_;
                lp[i >> 1] = pkh(a0_, a1_); }
        }
        f32x16 c;
#pragma unroll
        for (int i = 0; i < 16; ++i) c[i] = R;
        c = MFMA_F16(U0, __builtin_bit_cast(f16x8, (v4u){lp[0], lp[1], lp[2], lp[3]}), c); c = MFMA_F16(U1, __builtin_bit_cast(f16x8, (v4u){lp[4], lp[5], lp[6], lp[7]}), c);
#pragma unroll
        for (int i = 0; i < 16; ++i) s[i] = ex2(s[i] + c[i]);
        const bf16x8 W0 = packbf(s, 0), W1 = packbf(s, 1);
        LAS unsigned char* vb_ = Vb + (4 * hi + qq) * 64 + 32 * blk + 8 * pp;
        o0 = MFMA_BF16(cat8(trrd(vb_), trrd(vb_ + 8 * 64)), W0, o0); o0 = MFMA_BF16(cat8(trrd(vb_ + 16 * 64), trrd(vb_ + 24 * 64)), W1, o0);
        o1 = MFMA_BF16(cat8(trrd(vb_ + 2048), trrd(vb_ + 2048 + 8 * 64)), W0, o1); o1 = MFMA_BF16(cat8(trrd(vb_ + 2048 + 16 * 64), trrd(vb_ + 2048 + 24 * 64)), W1, o1);
        R += swap_add(tsum);
        if (__all(R < -150.f)) break;
    }
    asm volatile("s_waitcnt vmcnt(0)" ::: "memory");
#undef SB_DMA
    {
        float ss = 0.f;
#pragma unroll
        for (int i = 0; i < 16; ++i) ss += o0[i] * o0[i] + o1[i] * o1[i];
        ss = swap_add(ss);
        const float ro = __builtin_amdgcn_rsqf(ss * (1.f / 64.f) + EPS);
        bf16* Op = MIX_ + (rowbase + tq) * D + h * 64;
        const float* go = g_out_sb_ + h * 64;
#pragma unroll
        for (int g = 0; g < 4; ++g) { const int d0 = 8 * g + 4 * hi; const f32x4 ga = *(const f32x4*)(go + d0), gb = *(const f32x4*)(go + 32 + d0);
            u32x2 wa, wb; wa.x = cvtpk(o0[4 * g] * ro * ga.x, o0[4 * g + 1] * ro * ga.y); wa.y = cvtpk(o0[4 * g + 2] * ro * ga.z, o0[4 * g + 3] * ro * ga.w);
            wb.x = cvtpk(o1[4 * g] * ro * gb.x, o1[4 * g + 1] * ro * gb.y); wb.y = cvtpk(o1[4 * g + 2] * ro * gb.z, o1[4 * g + 3] * ro * gb.w);
            *(GAS u32x2*)(Op + d0) = wa; *(GAS u32x2*)(Op + 32 + d0) = wb; }
    }
    __syncthreads();
}

DI void conv_silu8(const v4u (&xr)[4], const float (&cw)[4][8], float scale, float (&y)[8]) {
#pragma unroll
    for (int e = 0; e < 8; ++e) y[e] = 0.f;
#pragma unroll
    for (int j = 0; j < 4; ++j) {
        y[0] += cw[j][0] * bflo(xr[j].x); y[1] += cw[j][1] * bfhi(xr[j].x); y[2] += cw[j][2] * bflo(xr[j].y); y[3] += cw[j][3] * bfhi(xr[j].y);
        y[4] += cw[j][4] * bflo(xr[j].z); y[5] += cw[j][5] * bfhi(xr[j].z); y[6] += cw[j][6] * bflo(xr[j].w); y[7] += cw[j][7] * bfhi(xr[j].w); }
#pragma unroll
    for (int e = 0; e < 8; ++e) y[e] = scale * y[e] * __builtin_amdgcn_rcpf(1.f + fexp(-y[e]));
}
DI float log_sigmoid(float x) { return fminf(x, 0.f) - 0.6931471805599453f * lg2(1.f + fexp(-fabsf(x))); }
DI float wave_scan_incl(float a, int lane) {
#pragma unroll
    for (int o = 1; o < 64; o <<= 1) { const float t = __shfl_up(a, o); if (lane >= o) a += t; }
    return a;
}

constexpr int LDS_CW = 65536;
DI void stage_conv_w(const Frame& F) {
    const float* const conv_w_ = inp(I_CONVW); LAS float* cwl = (LAS float*)(F.lds + LDS_CW);
    for (int i = F.tid; i < 4096; i += NTHR) cwl[i] = conv_w_[i];
    __syncthreads();
}
DI void load_cw8(const Frame& F, int colbase, float (&cw)[4][8]) {
    const LAS float* cwl = (const LAS float*)(F.lds + LDS_CW);
#pragma unroll
    for (int j = 0; j < 4; ++j) { const f32x4 a = *(const LAS f32x4*)(cwl + j * 1024 + colbase), b = *(const LAS f32x4*)(cwl + j * 1024 + colbase + 4);
        cw[j][0] = a.x; cw[j][1] = a.y; cw[j][2] = a.z; cw[j][3] = a.w; cw[j][4] = b.x; cw[j][5] = b.y; cw[j][6] = b.z; cw[j][7] = b.w; }
}
struct MlLocalRegs { v4u kraw[2][4]; v4u vraw[2]; float gi, gf; };
DI void ml_local_load(const Frame& F, int chain, int c, MlLocalRegs& R) {
    bf16* const PROJ_ = WSP(bf16, WS_PROJ); float* const GATES_ = WSP(float, WS_GATES);
    const int tid = F.tid, lane = F.lane;
    const int b = chain >> 2, hh = chain & 3; const size_t rowbase = (size_t)b * SEQ; const int t0 = c * 64;
    const bf16* P = PROJ_;
    const int kc = tid & 15, kr0 = tid >> 4;
    const bf16* Kg = P + rowbase * NPROJ + C_KML + hh * 128 + kc * 8;
#pragma unroll
    for (int i = 0; i < 2; ++i)
#pragma unroll
        for (int j = 0; j < 4; ++j) { const int tt = t0 + kr0 + 32 * i - 3 + j; R.kraw[i][j] = (tt >= 0) ? *(const GAS v4u*)(Kg + (size_t)tt * NPROJ) : (v4u){0u, 0u, 0u, 0u}; }
#pragma unroll
    for (int i = 0; i < 2; ++i) R.vraw[i] = *(const GAS v4u*)(P + (rowbase + t0 + kr0 + 32 * i) * NPROJ + C_VML + hh * 128 + kc * 8);
    const float* Gg = GATES_ + (rowbase + t0 + lane) * 8;
    R.gi = Gg[hh]; R.gf = Gg[4 + hh];
}
DI void ml_local_unit(const Frame& F, int chain, int c, const MlLocalRegs& RG) {
    bf16* const CST_ = WSP(bf16, WS_CST); float* const NST_ = WSP(float, WS_NST); float* const SCL_ = WSP(float, WS_SCL);
    LAS unsigned char* L = F.lds;
    LAS float* Lws = (LAS float*)(L + 32768);
    const int tid = F.tid, lane = F.lane, w = F.wave, r = lane & 31, hi = lane >> 5;
    const int i16 = lane & 15, qq = i16 >> 2, pp = i16 & 3, blk = (lane >> 4) & 1;
    const int hh = chain & 3;
    const int kbk = w & 3, vb0 = 2 * (w >> 2);
    const int kc = tid & 15, kr0 = tid >> 4;
    v4u kraw[2][4], vraw[2];
#pragma unroll
    for (int i = 0; i < 2; ++i) { vraw[i] = RG.vraw[i];
#pragma unroll
        for (int j = 0; j < 4; ++j) kraw[i][j] = RG.kraw[i][j]; }
    const float gi = RG.gi, gf = RG.gf;
    const float a = wave_scan_incl(log_sigmoid(gf), lane);
    const float a_end = __shfl(a, 63);
    const float lw = a_end - a + gi;
    const float m_loc = wave_max(lw);
    const float ws = fexp(lw - m_loc);
    if (w == 0) Lws[lane] = ws;
    {
        float cw[4][8]; load_cw8(F, 512 + hh * 128 + kc * 8, cw);
#pragma unroll
        for (int i = 0; i < 2; ++i) { float y[8]; conv_silu8(kraw[i], cw, 0.08838834764831845f, y);
            v4u o; o.x = cvtpk(y[0], y[1]); o.y = cvtpk(y[2], y[3]); o.z = cvtpk(y[4], y[5]); o.w = cvtpk(y[6], y[7]);
            *(LAS v4u*)(L + (kc >> 2) * 4096 + (kr0 + 32 * i) * 64 + (kc & 3) * 16) = o; }
#pragma unroll
        for (int i = 0; i < 2; ++i) { const int row = kr0 + 32 * i; const float wsr = __shfl(ws, row);
            v4u o; o.x = cvtpk(bflo(vraw[i].x) * wsr, bfhi(vraw[i].x) * wsr); o.y = cvtpk(bflo(vraw[i].y) * wsr, bfhi(vraw[i].y) * wsr); o.z = cvtpk(bflo(vraw[i].z) * wsr, bfhi(vraw[i].z) * wsr); o.w = cvtpk(bflo(vraw[i].w) * wsr, bfhi(vraw[i].w) * wsr);
            *(LAS v4u*)(L + 16384 + (kc >> 2) * 4096 + row * 64 + (kc & 3) * 16) = o; }
    }
    __syncthreads();
    f32x16 acc0, acc1;
#pragma unroll
    for (int i = 0; i < 16; ++i) { acc0[i] = 0.f; acc1[i] = 0.f; }
#pragma unroll
    for (int kk = 0; kk < 4; ++kk) { const int rows = 16 * kk + 8 * hi + qq;
        LAS unsigned char* ka = L + kbk * 4096 + rows * 64 + 32 * blk + 8 * pp; LAS unsigned char* va = L + 16384 + vb0 * 4096 + rows * 64 + 32 * blk + 8 * pp;
        const bf16x8 A = cat8(trrd(ka), trrd(ka + 4 * 64));
        acc0 = MFMA_BF16(A, cat8(trrd(va), trrd(va + 4 * 64)), acc0); acc1 = MFMA_BF16(A, cat8(trrd(va + 4096), trrd(va + 4096 + 4 * 64)), acc1); }
    {
        bf16* Cp = CST_ + ((size_t)(chain * 64 + c) * 128 + vb0 * 32 + r) * 128 + kbk * 32 + 4 * hi;
#pragma unroll
        for (int g = 0; g < 4; ++g) { u32x2 o; o.x = cvtpk(acc0[4 * g], acc0[4 * g + 1]); o.y = cvtpk(acc0[4 * g + 2], acc0[4 * g + 3]); *(GAS u32x2*)(Cp + 8 * g) = o;
            u32x2 o1; o1.x = cvtpk(acc1[4 * g], acc1[4 * g + 1]); o1.y = cvtpk(acc1[4 * g + 2], acc1[4 * g + 3]); *(GAS u32x2*)(Cp + 32 * 128 + 8 * g) = o1; }
    }
    {
        const int k = 16 * w + (lane & 15), sq = lane >> 4; float part = 0.f;
        const LAS unsigned short* kcol = (const LAS unsigned short*)(L + (k >> 5) * 4096 + (k & 31) * 2);
#pragma unroll
        for (int e = 0; e < 16; ++e) part += Lws[16 * sq + e] * __uint_as_float((unsigned)kcol[(16 * sq + e) * 32] << 16);
        part += __shfl_xor(part, 16); part += __shfl_xor(part, 32);
        if (lane < 16) NST_[(size_t)(chain * 64 + c) * 128 + k] = part;
        if (tid == 0) { SCL_[(chain * 64 + c) * 2] = a_end; SCL_[(chain * 64 + c) * 2 + 1] = m_loc; }
    }
    __syncthreads();
}
DI void ml_scan_phase(const Frame& F) {
    bf16* const CST_ = WSP(bf16, WS_CST); float* const NST_ = WSP(float, WS_NST); float* const SCL_ = WSP(float, WS_SCL); float* const MST_ = WSP(float, WS_MST);
    for (int gt = F.vcu * NTHR + F.tid; gt < 32 * 4096; gt += F.G * NTHR) {
        const int chain = gt >> 12, rem = gt & 4095;
        const float ae_l = SCL_[(chain * 64 + F.lane) * 2], ml_l = SCL_[(chain * 64 + F.lane) * 2 + 1];
        u32x2* Cp = (u32x2*)(CST_ + (size_t)chain * 64 * 16384 + (size_t)rem * 4);
        f32x4* Np = (f32x4*)(NST_ + (size_t)chain * 64 * 128 + rem * 4);
        const bool do_n = rem < 32;
        float c0 = 0.f, c1 = 0.f, c2 = 0.f, c3 = 0.f; f32x4 nn = {0.f, 0.f, 0.f, 0.f}; float m = 0.f;
        u32x2 dr[8]; f32x4 nr[8];
#pragma unroll
        for (int i = 0; i < 8; ++i) { dr[i] = Cp[(size_t)i * 4096]; if (do_n) nr[i] = Np[i * 32]; }
        for (int c0_ = 0; c0_ < 64; c0_ += 8) {
#pragma unroll
            for (int i = 0; i < 8; ++i) { const int c = c0_ + i;
                if (c < 63) {
                    const u32x2 dcur = dr[i]; const f32x4 dn = nr[i];
                    if (c + 8 < 63) { dr[i] = Cp[(size_t)(c + 8) * 4096]; if (do_n) nr[i] = Np[(c + 8) * 32]; }
                    const float ae = __builtin_bit_cast(float, __builtin_amdgcn_readlane(__builtin_bit_cast(int, ae_l), c)), ml = __builtin_bit_cast(float, __builtin_amdgcn_readlane(__builtin_bit_cast(int, ml_l), c));
                    const float mn = fmaxf(ae + m, ml), d1 = fexp(ae + m - mn), d2 = fexp(ml - mn);
                    c0 = d1 * c0 + d2 * bflo(dcur.x); c1 = d1 * c1 + d2 * bfhi(dcur.x); c2 = d1 * c2 + d2 * bflo(dcur.y); c3 = d1 * c3 + d2 * bfhi(dcur.y);
                    u32x2 o; o.x = cvtpk(c0, c1); o.y = cvtpk(c2, c3); Cp[(size_t)c * 4096] = o;
                    if (do_n) { nn = nn * d1 + dn * d2; Np[c * 32] = nn; }
                    if (rem == 0) MST_[chain * 64 + c] = mn;
                    m = mn; } }
        }
    }
}
DI void ml_out_unit(const Frame& F, int chain, int c) {
    bf16* const PROJ_ = WSP(bf16, WS_PROJ); float* const GATES_ = WSP(float, WS_GATES); float* const MST_ = WSP(float, WS_MST); bf16* const CST_ = WSP(bf16, WS_CST); float* const NST_ = WSP(float, WS_NST); bf16* const MIX_ = WSP(bf16, WS_MIX); const float* const g_out_ml_ = inp(I_GOML);
    LAS unsigned char* L = F.lds;
    LAS float* Lbs = (LAS float*)(L + 49152); LAS float* Lav = (LAS float*)(L + 49408); LAS float* Lex = (LAS float*)(L + 49664);
    const int tid = F.tid, lane = F.lane, w = F.wave, r = lane & 31, hi = lane >> 5;
    const int i16 = lane & 15, qq = i16 >> 2, pp = i16 & 3, blk = (lane >> 4) & 1;
    const int b = chain >> 2, hh = chain & 3; const size_t rowbase = (size_t)b * SEQ; const int t0 = c * 64;
    const int tb = w >> 2, vb = w & 3;
    const bf16* P = PROJ_;
    {
        const int kc = tid & 15, kr0 = tid >> 4;
#pragma unroll
        for (int which = 0; which < 2; ++which) {
            const int colbase = (which ? 512 : 0) + hh * 128 + kc * 8;
            float cw[4][8]; load_cw8(F, colbase, cw);
            const bf16* Xg = P + rowbase * NPROJ + C_QML + colbase;
#pragma unroll
            for (int i = 0; i < 2; ++i) { const int row = kr0 + 32 * i; v4u xr[4];
#pragma unroll
                for (int j = 0; j < 4; ++j) { const int tt = t0 + row - 3 + j; xr[j] = (tt >= 0) ? *(const GAS v4u*)(Xg + (size_t)tt * NPROJ) : (v4u){0u, 0u, 0u, 0u}; }
                float y[8]; conv_silu8(xr, cw, which ? 0.08838834764831845f : 1.0f, y);
                v4u o; o.x = cvtpk(y[0], y[1]); o.y = cvtpk(y[2], y[3]); o.z = cvtpk(y[4], y[5]); o.w = cvtpk(y[6], y[7]);
                *(LAS v4u*)(L + which * 16384 + row * 256 + ((kc ^ (row & 15)) * 16)) = o; }
        }
#pragma unroll
        for (int i = 0; i < 2; ++i) { const int row = kr0 + 32 * i;
            const v4u v = *(const GAS v4u*)(P + (rowbase + t0 + row) * NPROJ + C_VML + hh * 128 + kc * 8);
            *(LAS v4u*)(L + 32768 + (kc >> 2) * 4096 + row * 64 + (kc & 3) * 16) = v; }
        if (w == 0) { const float* Gg = GATES_ + (rowbase + t0 + lane) * 8; const float a = wave_scan_incl(log_sigmoid(Gg[4 + hh]), lane); Lav[lane] = a; Lbs[lane] = Gg[hh] - a; }
    }
    const float mprev = (c > 0) ? MST_[chain * 64 + c - 1] : 0.f;
    bf16x8 cf[8], nf[8];
    if (c > 0) {
        const bf16* Cp = CST_ + ((size_t)(chain * 64 + c - 1) * 128 + vb * 32 + r) * 128 + 8 * hi;
        const float* Np = NST_ + (size_t)(chain * 64 + c - 1) * 128 + 8 * hi;
        const bool nrow = (r == 0) || (r == 4);
#pragma unroll
        for (int kk = 0; kk < 8; ++kk) { cf[kk] = *(const GAS bf16x8*)(Cp + 16 * kk);
            const f32x4 n0 = *(const f32x4*)(Np + 16 * kk), n1 = *(const f32x4*)(Np + 16 * kk + 4);
            v4u o; o.x = cvtpk(n0.x, n0.y); o.y = cvtpk(n0.z, n0.w); o.z = cvtpk(n1.x, n1.y); o.w = cvtpk(n1.z, n1.w);
            if (!nrow) o = (v4u){0u, 0u, 0u, 0u};
            nf[kk] = __builtin_bit_cast(bf16x8, o); }
    }
    __syncthreads();
    bf16x8 qf[8];
    f32x16 s0, s1;
#pragma unroll
    for (int i = 0; i < 16; ++i) { s0[i] = 0.f; s1[i] = 0.f; }
#pragma unroll
    for (int kk = 0; kk < 8; ++kk) { const int ch = 2 * kk + hi; const int rq_ = 32 * tb + r;
        qf[kk] = *(const LAS bf16x8*)(L + rq_ * 256 + ((ch ^ (rq_ & 15)) * 16));
        const bf16x8 a0 = *(const LAS bf16x8*)(L + 16384 + r * 256 + ((ch ^ (r & 15)) * 16));
        const bf16x8 a1 = *(const LAS bf16x8*)(L + 16384 + (32 + r) * 256 + ((ch ^ ((32 + r) & 15)) * 16));
        s0 = MFMA_BF16(a0, qf[kk], s0); s1 = MFMA_BF16(a1, qf[kk], s1); }
    const int tl = 32 * tb + r; const float a_t = Lav[tl];
    f32x16 d0, d1; float mrow = -INFINITY;
#pragma unroll
    for (int g = 0; g < 4; ++g) { const f32x4 b0 = *(const LAS f32x4*)(Lbs + 8 * g + 4 * hi), b1 = *(const LAS f32x4*)(Lbs + 32 + 8 * g + 4 * hi);
#pragma unroll
        for (int e = 0; e < 4; ++e) { const int sl = 8 * g + 4 * hi + e;
            d0[4 * g + e] = (sl <= tl) ? a_t + b0[e] : -INFINITY; d1[4 * g + e] = (32 + sl <= tl) ? a_t + b1[e] : -INFINITY;
            mrow = fmaxf(mrow, fmaxf(d0[4 * g + e], d1[4 * g + e])); } }
    mrow = fmaxf(swap_max(mrow), a_t + mprev);
    float psum = 0.f;
#pragma unroll
    for (int i = 0; i < 16; ++i) { s0[i] *= fexp(d0[i] - mrow); s1[i] *= fexp(d1[i] - mrow); psum += s0[i] + s1[i]; }
    const float w_inter = fexp(a_t + mprev - mrow);
    float den = swap_add(psum);
    const bf16x8 P00 = packbf(s0, 0), P01 = packbf(s0, 1), P10 = packbf(s1, 0), P11 = packbf(s1, 1);
    f32x16 num;
#pragma unroll
    for (int i = 0; i < 16; ++i) num[i] = 0.f;
    {
        LAS unsigned char* vb_ = L + 32768 + vb * 4096 + (4 * hi + qq) * 64 + 32 * blk + 8 * pp;
        num = MFMA_BF16(cat8(trrd(vb_), trrd(vb_ + 8 * 64)), P00, num); num = MFMA_BF16(cat8(trrd(vb_ + 16 * 64), trrd(vb_ + 24 * 64)), P01, num);
        num = MFMA_BF16(cat8(trrd(vb_ + 32 * 64), trrd(vb_ + 40 * 64)), P10, num); num = MFMA_BF16(cat8(trrd(vb_ + 48 * 64), trrd(vb_ + 56 * 64)), P11, num);
    }
    if (c > 0) {
        f32x16 it, dn;
#pragma unroll
        for (int i = 0; i < 16; ++i) { it[i] = 0.f; dn[i] = 0.f; }
#pragma unroll
        for (int kk = 0; kk < 8; ++kk) { it = MFMA_BF16(cf[kk], qf[kk], it); dn = MFMA_BF16(nf[kk], qf[kk], dn); }
#pragma unroll
        for (int i = 0; i < 16; ++i) num[i] += w_inter * it[i];
        den += w_inter * dn[0];
    }
    const float inv = __builtin_amdgcn_rcpf(fmaxf(fabsf(den), fexp(-mrow)));
    float ss = 0.f;
#pragma unroll
    for (int i = 0; i < 16; ++i) { num[i] *= inv; ss += num[i] * num[i]; }
    ss = swap_add(ss);
    if (lane < 32) Lex[(tb * 4 + vb) * 32 + r] = ss;
    __syncthreads();
    const float tot = (Lex[(tb * 4 + 0) * 32 + r] + Lex[(tb * 4 + 1) * 32 + r]) + (Lex[(tb * 4 + 2) * 32 + r] + Lex[(tb * 4 + 3) * 32 + r]);
    const float rstd = 1.f / sqrtf(tot * (1.f / 128.f) + EPS);
    {
        const size_t trow = rowbase + t0 + tl;
        const bf16* Og = P + trow * NPROJ + C_OML + hh * 128 + vb * 32 + 4 * hi;
        bf16* Mp = MIX_ + trow * D + 512 + hh * 128 + vb * 32 + 4 * hi;
        const float* go = g_out_ml_ + hh * 128 + vb * 32 + 4 * hi;
#pragma unroll
        for (int g = 0; g < 4; ++g) { const u32x2 og = *(const GAS u32x2*)(Og + 8 * g); const f32x4 gg = *(const f32x4*)(go + 8 * g);
            const float o0 = bflo(og.x), o1 = bfhi(og.x), o2 = bflo(og.y), o3 = bfhi(og.y);
            u32x2 o; o.x = cvtpk(num[4 * g] * rstd * gg.x * __builtin_amdgcn_rcpf(1.f + fexp(-o0)), num[4 * g + 1] * rstd * gg.y * __builtin_amdgcn_rcpf(1.f + fexp(-o1)));
            o.y = cvtpk(num[4 * g + 2] * rstd * gg.z * __builtin_amdgcn_rcpf(1.f + fexp(-o2)), num[4 * g + 3] * rstd * gg.w * __builtin_amdgcn_rcpf(1.f + fexp(-o3)));
            *(GAS u32x2*)(Mp + 8 * g) = o; }
    }
    __syncthreads();
}

#define TK_CE(A, B) do { const float hi_ = fmaxf((A), (B)), lo_ = fminf((A), (B)); (A) = hi_; (B) = lo_; } while (0)
DI void tk_sort16(float (&a)[16]) {
#pragma unroll
    for (int k = 2; k <= 16; k <<= 1)
#pragma unroll
        for (int j = k >> 1; j > 0; j >>= 1)
#pragma unroll
            for (int i = 0; i < 16; ++i) { const int l = i ^ j; if (l > i) { if ((i & k) == 0) TK_CE(a[i], a[l]); else TK_CE(a[l], a[i]); } }
}
DI void tk_merge16(float (&a)[16], const float (&b)[16]) {
#pragma unroll
    for (int i = 0; i < 16; ++i) a[i] = fmaxf(a[i], b[15 - i]);
#pragma unroll
    for (int j = 8; j > 0; j >>= 1)
#pragma unroll
        for (int i = 0; i < 16; ++i) { const int l = i ^ j; if (l > i) TK_CE(a[i], a[l]); }
}
DI void tk_stage2(const LAS float* la, const LAS float* lb, int* IDX_, float* GATEW_, size_t o) {
        float a[16], bb[16], cnd[64];
#pragma unroll
        for (int q = 0; q < 16; ++q) { a[q] = la[q]; bb[q] = lb[q]; }
        int cnt = 0;
#pragma unroll
        for (int i = 0; i < 16; ++i)
#pragma unroll
            for (int j = 0; j < 16; ++j) if ((i + 1) * (j + 1) <= 16) { cnd[cnt] = __uint_as_float((__float_as_uint(a[i] + bb[j]) & ~0xFFu) | (unsigned)(i * 16 + j)); ++cnt; }
#pragma unroll
        for (int q = 50; q < 64; ++q) cnd[q] = -INFINITY;
        float top[16];
#pragma unroll
        for (int c = 0; c < 4; ++c) { float ch[16];
#pragma unroll
            for (int q = 0; q < 16; ++q) ch[q] = cnd[16 * c + q];
            tk_sort16(ch);
            if (c == 0) {
#pragma unroll
                for (int q = 0; q < 16; ++q) top[q] = ch[q];
            } else tk_merge16(top, ch); }
        float sv[16]; int ei[16]; float mx = -INFINITY;
#pragma unroll
        for (int q = 0; q < 16; ++q) { const unsigned code = __float_as_uint(top[q]) & 0xFFu; const float va = la[code >> 4], vb = lb[code & 15u];
            ei[q] = (int)((__float_as_uint(va) & 0x7Fu) * 128u + (__float_as_uint(vb) & 0x7Fu)); sv[q] = va + vb; mx = fmaxf(mx, sv[q]); }
        float sum = 0.f;
#pragma unroll
        for (int q = 0; q < 16; ++q) { sv[q] = fexp(sv[q] - mx); sum += sv[q]; }
        const float inv = 1.f / sum;
#pragma unroll
        for (int q = 0; q < 16; q += 4) { *(GAS v4u*)(IDX_ + o + q) = (v4u){(unsigned)ei[q], (unsigned)ei[q + 1], (unsigned)ei[q + 2], (unsigned)ei[q + 3]};
            *(GAS f32x4*)(GATEW_ + o + q) = (f32x4){sv[q] * inv, sv[q + 1] * inv, sv[q + 2] * inv, sv[q + 3] * inv}; }
    }
struct EpiTopK {
    static constexpr bool PERM = false, AFTER_DRAIN = true;
    int* IDX; float* GATEW;
    DI void fused(f32x4 (&acc)[2][2][4][2], const pg8::Unit& u, int wr, int wc, int fr, int fq, LAS unsigned char* lds, int wid, int lane) const {
        LAS float* Tl = (LAS float*)lds;
        LAS float* Lh2 = (LAS float*)lds;
        LAS float* Ls = (LAS float*)(lds + 36864);
        const int tid = wid * 64 + lane, tl = tid & 127, p = (tid >> 7) & 1, half = tid >> 8;
#pragma unroll
        for (int ai = 0; ai < 2; ++ai) {
#pragma unroll
            for (int bj = 0; bj < 2; ++bj)
#pragma unroll
                for (int m = 0; m < 4; ++m)
#pragma unroll
                    for (int n = 0; n < 2; ++n) { LAS float* d = Tl + (wr * 64 + m * 16 + fr) * 257 + bj * 128 + wc * 32 + n * 16 + fq * 4; const f32x4 v = acc[ai][bj][m][n]; d[0] = v.x; d[1] = v.y; d[2] = v.z; d[3] = v.w; }
            __syncthreads();
            float run[16];
            {
                const LAS float* src = Tl + tl * 257 + p * 128 + half * 64;
#pragma unroll
                for (int c = 0; c < 4; ++c) { float ch[16];
#pragma unroll
                    for (int q = 0; q < 16; ++q) ch[q] = __uint_as_float((__float_as_uint(src[16 * c + q]) & ~0x7Fu) | (unsigned)(half * 64 + 16 * c + q));
                    tk_sort16(ch);
                    if (c == 0) {
#pragma unroll
                        for (int q = 0; q < 16; ++q) run[q] = ch[q];
                    } else tk_merge16(run, ch); }
            }
            __syncthreads();
#pragma unroll
            for (int q = 0; q < 16; ++q) Lh2[((tl * 2 + p) * 2 + half) * 17 + q] = run[q];
            __syncthreads();
            if (half == 0) { float oth[16];
#pragma unroll
                for (int q = 0; q < 16; ++q) oth[q] = Lh2[((tl * 2 + p) * 2 + 1) * 17 + q];
                tk_merge16(run, oth);
#pragma unroll
                for (int q = 0; q < 16; ++q) Ls[(tl * 2 + p) * 17 + q] = run[q]; }
            __syncthreads();
            if (tid < 128) tk_stage2(Ls + (tl * 2) * 17, Ls + (tl * 2) * 17 + 17, IDX, GATEW, (size_t)(u.pm * 256 + ai * 128 + tl) * 128 + u.pn * 16);
            __syncthreads();
        }
    }
};
struct OneUnit {
    pg8::Unit u;
    __device__ __forceinline__ bool next(int i, pg8::Unit& o) const { if (i) return false; o = u; return true; }
    __device__ __forceinline__ void a_ready(const pg8::Unit&) const {}
    __device__ __forceinline__ void done(const pg8::Unit&) const {}
};

DI float gelu_erf(float x) { return 0.5f * x * (1.f + erff(x * 0.7071067811865476f)); }
#define DPP_ADD(v, ctrl, rmask) ((v) + __builtin_bit_cast(float, __builtin_amdgcn_update_dpp(0, __builtin_bit_cast(int, (v)), (ctrl), (rmask), 0xF, false)))
#ifndef PEER_EBL
#define PEER_EBL 9
#endif
constexpr int PEER_EB_LOG = PEER_EBL;
#ifndef PEER_PROBE_MASK
#define PEER_PROBE_MASK 0xFFFF
#endif
typedef float f32x2v __attribute__((ext_vector_type(2)));
DI float gelu_cdf(float v) {
    const float av = fabsf(v), t = __builtin_amdgcn_rcpf(av * 0.2316418882f + 1.0f);
    float q = t * 0.5307027145f - 0.7265760135f; q = q * t + 0.7107068705f; q = q * t - 0.142248368f; q = q * t + 0.127414796f; q = q * t;
    const float m = v * (q * ex2(v * v * -0.72134752044f));
    return v < 0.f ? m : v - m;
}
#define DPP_ADDI(v, ctrl, rmask) ((v) + __builtin_amdgcn_update_dpp(0, (v), (ctrl), (rmask), 0xF, false))
DI void peer_phase(const Frame& F, bool scratch_dst) {
    bf16* const XN_ = WSP(bf16, WS_XN); int* const IDX_ = WSP(int, WS_IDX); float* const GATEW_ = WSP(float, WS_GATE); float* const mod_ = WSP(float, WS_MOD); float* const out_ = (float*)inp(I_OUT);
    const unsigned char* const EU8 = WSP(unsigned char, WS_EXPU); const unsigned char* const EV8 = WSP(unsigned char, WS_EXPV); const float* const SUI_ = WSP(float, WS_SUI); const float* const SVI_ = WSP(float, WS_SVI);
    const int gw = F.vcu * NWAVES + F.wave, NGW = F.G * NWAVES, lane = F.lane, g = lane >> 3, j = lane & 7;
    LAS unsigned char* wl = F.lds + F.wave * 16384;
    volatile LAS int* Le = (volatile LAS int*)(wl + g * 512); volatile LAS float* Lg = (volatile LAS float*)(wl + 4096 + g * 512); volatile LAS int* Lp = (volatile LAS int*)(wl + 8192 + g * 512);
    LAS int* Lh = (LAS int*)(wl + 12288 + g * 128);
    for (int grp = gw; grp < T / 8; grp += NGW) {
        const size_t t = (size_t)grp * 8 + g;
        int xi[32]; float sxi;
        {
            float mx = 0.f; v4u xr[8];
#pragma unroll
            for (int hq = 0; hq < 8; ++hq) { const bf16* xp = XN_ + t * D + 128 * hq + 16 * j; const v4u a = *(const GAS v4u*)xp, b = *(const GAS v4u*)(xp + 8);
                xr[hq] = a;
#pragma unroll
                for (int e = 0; e < 4; ++e) mx = fmaxf(mx, fmaxf(fmaxf(fabsf(bflo(a[e])), fabsf(bfhi(a[e]))), fmaxf(fabsf(bflo(b[e])), fabsf(bfhi(b[e]))))); }
            mx = fmaxf(mx, __shfl_xor(mx, 1, 8)); mx = fmaxf(mx, __shfl_xor(mx, 2, 8)); mx = fmaxf(mx, __shfl_xor(mx, 4, 8));
            const float sx = mx > 0.f ? 127.f / mx : 0.f; sxi = mx > 0.f ? mx / 127.f : 0.f;
#pragma unroll
            for (int hq = 0; hq < 8; ++hq) { const bf16* xp = XN_ + t * D + 128 * hq + 16 * j; const v4u a = xr[hq], b = *(const GAS v4u*)(xp + 8);
#pragma unroll
                for (int e = 0; e < 2; ++e) {
                    const int q0 = (int)rintf(bflo(a[2 * e]) * sx), q1 = (int)rintf(bfhi(a[2 * e]) * sx), q2 = (int)rintf(bflo(a[2 * e + 1]) * sx), q3 = (int)rintf(bfhi(a[2 * e + 1]) * sx);
                    xi[4 * hq + e] = (int)((unsigned)(q0 & 0xff) | ((unsigned)(q1 & 0xff) << 8) | ((unsigned)(q2 & 0xff) << 16) | ((unsigned)q3 << 24));
                    const int p0 = (int)rintf(bflo(b[2 * e]) * sx), p1 = (int)rintf(bfhi(b[2 * e]) * sx), p2 = (int)rintf(bflo(b[2 * e + 1]) * sx), p3 = (int)rintf(bfhi(b[2 * e + 1]) * sx);
                    xi[4 * hq + 2 + e] = (int)((unsigned)(p0 & 0xff) | ((unsigned)(p1 & 0xff) << 8) | ((unsigned)(p2 & 0xff) << 16) | ((unsigned)p3 << 24)); } }
        }
        {
            int ide[16]; float gte[16]; int rk[16];
#pragma unroll
            for (int m = 0; m < 16; ++m) { ide[m] = IDX_[t * 128 + j + 8 * m]; gte[m] = GATEW_[t * 128 + j + 8 * m]; }
#pragma unroll
            for (int m = 0; m < 4; ++m) Lh[j + 8 * m] = 0;
#pragma unroll
            for (int m = 0; m < 16; ++m) rk[m] = __hip_atomic_fetch_add(Lh + (ide[m] >> PEER_EB_LOG), 1, __ATOMIC_RELAXED, __HIP_MEMORY_SCOPE_WORKGROUP);
            {
                const int h0 = ((volatile LAS int*)Lh)[4 * j], h1 = ((volatile LAS int*)Lh)[4 * j + 1], h2 = ((volatile LAS int*)Lh)[4 * j + 2], h3 = ((volatile LAS int*)Lh)[4 * j + 3];
                const int tot = (h0 + h1) + (h2 + h3); int inc = tot;
#pragma unroll
                for (int o = 1; o < 8; o <<= 1) { const int tt = __shfl_up(inc, o, 8); if (j >= o) inc += tt; }
                const int ex = inc - tot;
                ((volatile LAS int*)Lh)[4 * j] = ex; ((volatile LAS int*)Lh)[4 * j + 1] = ex + h0; ((volatile LAS int*)Lh)[4 * j + 2] = ex + h0 + h1; ((volatile LAS int*)Lh)[4 * j + 3] = ex + h0 + h1 + h2;
            }
#pragma unroll
            for (int m = 0; m < 16; ++m) { const int pos = ((volatile LAS int*)Lh)[ide[m] >> PEER_EB_LOG] + rk[m]; Le[pos] = ide[m]; Lg[pos] = gte[m]; }
        }
        v4u R0[4], R1[4], R2[4], R3[4];
#define PEER_ROFF(S0, H) ((size_t)(Le[(S0)] & (scratch_dst ? PEER_PROBE_MASK : 0xFFFF)) * 1024 + 512 * (H) + 16 * j)
#define PEER_LOADT(TAB, RR, S0, H) do { const size_t ro_ = PEER_ROFF(S0, H); _Pragma("unroll") for (int q = 0; q < 4; ++q) RR[q] = *(const GAS v4u*)((TAB) + ro_ + 128 * q); } while (0)
#define PEER_DOTI(RR, H, EOUT) do { int d0_ = 0, d1_ = 0, d2_ = 0, d3_ = 0; \
            _Pragma("unroll") for (int w_ = 0; w_ < 4; ++w_) { d0_ = __builtin_amdgcn_sdot4((int)RR[0][w_], xi[16 * (H) + w_], d0_, false); d1_ = __builtin_amdgcn_sdot4((int)RR[1][w_], xi[16 * (H) + 4 + w_], d1_, false); \
                d2_ = __builtin_amdgcn_sdot4((int)RR[2][w_], xi[16 * (H) + 8 + w_], d2_, false); d3_ = __builtin_amdgcn_sdot4((int)RR[3][w_], xi[16 * (H) + 12 + w_], d3_, false); } \
            int e_ = (d0_ + d1_) + (d2_ + d3_); e_ = DPP_ADDI(e_, 0xB1, 0xF); e_ = DPP_ADDI(e_, 0x4E, 0xF); e_ = DPP_ADDI(e_, 0x141, 0xF); EOUT = e_; } while (0)
#define PEER_SB() __builtin_amdgcn_sched_barrier(0)
#define PEER_SWEEP(LOADM, H, BODY0, BODY1, BODY2, BODY3) do { \
            LOADM(0, 0, H); LOADM(1, 1, H); LOADM(2, 2, H); LOADM(3, 3, H); \
            for (int s = 0; s < 128; s += 4) { \
                PEER_SB(); BODY0; PEER_SB(); LOADM(0, (s + 4) & 127, H); \
                PEER_SB(); BODY1; PEER_SB(); LOADM(1, (s + 5) & 127, H); \
                PEER_SB(); BODY2; PEER_SB(); LOADM(2, (s + 6) & 127, H); \
                PEER_SB(); BODY3; PEER_SB(); LOADM(3, (s + 7) & 127, H); } } while (0)
#define PEER_RK(K) ((K) == 0 ? R0 : (K) == 1 ? R1 : (K) == 2 ? R2 : R3)
#define PEER_LOADU_LO(K, S0, H) do { if ((K) == 0) PEER_LOADT(EU8, R0, S0, H); else if ((K) == 1) PEER_LOADT(EU8, R1, S0, H); else if ((K) == 2) PEER_LOADT(EU8, R2, S0, H); else PEER_LOADT(EU8, R3, S0, H); } while (0)
        float su_[4], sv_[4];
#define PEER_LOADU_HI(K, S0, H) do { const int ex__ = Le[(S0)] & 0xFFFF; su_[K] = SUI_[ex__]; sv_[K] = SVI_[ex__]; PEER_LOADU_LO(K, S0, H); } while (0)
        { int e0_;
          PEER_SWEEP(PEER_LOADU_LO, 0, ({ PEER_DOTI(R0, 0, e0_); Lp[s] = e0_; }), ({ PEER_DOTI(R1, 0, e0_); Lp[s + 1] = e0_; }), ({ PEER_DOTI(R2, 0, e0_); Lp[s + 2] = e0_; }), ({ PEER_DOTI(R3, 0, e0_); Lp[s + 3] = e0_; })); }
        float cmax = 0.f;
#define PEER_FIN(RR, K, SS) do { int e1_; PEER_DOTI(RR, 1, e1_); const float cf__ = Lg[(SS)] * sv_[K] * gelu_cdf((float)(e1_ + Lp[(SS)]) * (su_[K] * sxi)); \
            Lg[(SS)] = cf__; cmax = fmaxf(cmax, fabsf(cf__)); } while (0)
        PEER_SWEEP(PEER_LOADU_HI, 1, PEER_FIN(R0, 0, s), PEER_FIN(R1, 1, s + 1), PEER_FIN(R2, 2, s + 2), PEER_FIN(R3, 3, s + 3));
#undef PEER_FIN
        const float cqs = cmax > 0.f ? 127.f / cmax : 0.f, yscale = cmax > 0.f ? cmax / 127.f : 0.f;
        {
            int pk_[4];
#pragma unroll
            for (int m = 0; m < 4; ++m) { const int d_ = 4 * j + m;
                const int q0 = (int)rintf(Lg[4 * d_] * cqs), q1 = (int)rintf(Lg[4 * d_ + 1] * cqs), q2 = (int)rintf(Lg[4 * d_ + 2] * cqs), q3 = (int)rintf(Lg[4 * d_ + 3] * cqs);
                pk_[m] = (int)((unsigned)(q0 & 0xff) | ((unsigned)(q1 & 0xff) << 8) | ((unsigned)(q2 & 0xff) << 16) | ((unsigned)q3 << 24)); }
#pragma unroll
            for (int m = 0; m < 4; ++m) Lp[4 * j + m] = pk_[m];
        }
#pragma unroll
        for (int H = 0; H < 2; ++H) {
            int yi[64];
#pragma unroll
            for (int i = 0; i < 64; ++i) yi[i] = 0;
            PEER_LOADT(EV8, R0, 0, H); PEER_LOADT(EV8, R1, 1, H); PEER_LOADT(EV8, R2, 2, H); PEER_LOADT(EV8, R3, 3, H);
            for (int bt = 0; bt < 32; ++bt) {
                const int cq_ = Lp[bt];
                size_t ro0_ = 0, ro1_ = 0, ro2_ = 0, ro3_ = 0;
                { const int nb_ = (4 * bt + 4) & 127; ro0_ = PEER_ROFF(nb_, H); ro1_ = PEER_ROFF(nb_ + 1, H); ro2_ = PEER_ROFF(nb_ + 2, H); ro3_ = PEER_ROFF(nb_ + 3, H); }
#pragma unroll
                for (int q = 0; q < 4; ++q) {
#pragma unroll
                    for (int w_ = 0; w_ < 4; ++w_) { const unsigned a0 = R0[q][w_], a1 = R1[q][w_], a2 = R2[q][w_], a3 = R3[q][w_];
                        const unsigned p0 = __builtin_amdgcn_perm(a1, a0, 0x05010400u), p1 = __builtin_amdgcn_perm(a1, a0, 0x07030602u), p2 = __builtin_amdgcn_perm(a3, a2, 0x05010400u), p3 = __builtin_amdgcn_perm(a3, a2, 0x07030602u);
                        yi[16 * q + 4 * w_ + 0] = __builtin_amdgcn_sdot4((int)__builtin_amdgcn_perm(p2, p0, 0x05040100u), cq_, yi[16 * q + 4 * w_ + 0], false);
                        yi[16 * q + 4 * w_ + 1] = __builtin_amdgcn_sdot4((int)__builtin_amdgcn_perm(p2, p0, 0x07060302u), cq_, yi[16 * q + 4 * w_ + 1], false);
                        yi[16 * q + 4 * w_ + 2] = __builtin_amdgcn_sdot4((int)__builtin_amdgcn_perm(p3, p1, 0x05040100u), cq_, yi[16 * q + 4 * w_ + 2], false);
                        yi[16 * q + 4 * w_ + 3] = __builtin_amdgcn_sdot4((int)__builtin_amdgcn_perm(p3, p1, 0x07060302u), cq_, yi[16 * q + 4 * w_ + 3], false); }
                    PEER_SB();
                    { R0[q] = *(const GAS v4u*)(EV8 + ro0_ + 128 * q); R1[q] = *(const GAS v4u*)(EV8 + ro1_ + 128 * q); R2[q] = *(const GAS v4u*)(EV8 + ro2_ + 128 * q); R3[q] = *(const GAS v4u*)(EV8 + ro3_ + 128 * q); }
                    PEER_SB();
                }
            }
            const int b = (int)(t / SEQ);
            const float* g2 = mod_ + b * NMOD + 5120 + 512 * H + 16 * j;
            const float* ip = out_ + t * D + 512 * H + 16 * j; float* op = (scratch_dst ? WSP(float, WS_SCORES) : out_) + t * D + 512 * H + 16 * j;
#pragma unroll
            for (int q = 0; q < 4; ++q)
#pragma unroll
                for (int c4 = 0; c4 < 4; ++c4) { const f32x4 x1 = *(const GAS f32x4*)(ip + 128 * q + 4 * c4); const f32x4 gg = *(const f32x4*)(g2 + 128 * q + 4 * c4) * yscale;
                    f32x4 o; o.x = x1.x + gg.x * (float)yi[16 * q + 4 * c4]; o.y = x1.y + gg.y * (float)yi[16 * q + 4 * c4 + 1]; o.z = x1.z + gg.z * (float)yi[16 * q + 4 * c4 + 2]; o.w = x1.w + gg.w * (float)yi[16 * q + 4 * c4 + 3];
                    *(GAS f32x4*)(op + 128 * q + 4 * c4) = o; }
        }
#undef PEER_ROFF
#undef PEER_LOADT
#undef PEER_DOTI
#undef PEER_SWEEP
#undef PEER_SB
#undef PEER_RK
#undef PEER_LOADU_LO
#undef PEER_LOADU_HI
    }
}

DI void ph_inproj(const Frame& F) {
    pg8::Gemm g{WSP(bf16, WS_XN), WSP(bf16, WS_WIN), T, NPROJ, D}; pg8::StaticOrder S; S.init(T, NPROJ, F.G, (int)blockIdx.x);
    pg8::EpiBf16<0> E{WSP(bf16, WS_PROJ), NPROJ, nullptr, 0, 0, 1.f};
    pg8::gemm_phase<pg8::EpiBf16<0>, pg8::StaticOrder, PG8_ALIGN, PG8_SP2>(F.lds, g, S, E);
}
DI void ph_mix(const Frame& F, bool probe_first) {
    stage_conv_w(F);
    {
        int u = F.vcu;
        MlLocalRegs ra;
        if (u < 2048) ml_local_load(F, u >> 6, u & 63, ra);
        const int gwv = F.vcu * NWAVES + F.wave, NGWv = F.G * NWAVES;
        int eb = 2 * gwv;
        while (u < 2048) {
            const int un = u + F.G;
            MlLocalRegs rb;
            if (un < 2048) ml_local_load(F, un >> 6, un & 63, rb);
            ExpRows2 er; const bool ew = eb < 32768;
            if (ew) exp_load2(F, eb, er);
            ml_local_unit(F, u >> 6, u & 63, ra);
            if (ew) exp_conv2(F, eb, er);
            eb += 2 * NGWv;
            ra = rb; u = un;
        }
        for (; eb < 32768; eb += 2 * NGWv) { ExpRows2 er; exp_load2(F, eb, er); exp_conv2(F, eb, er); }
    }
    (void)probe_first;
}
DI void ph_scan_attn(const Frame& F) {
    ml_scan_phase(F);
    __syncthreads();
    for (int u = F.vcu; u < 1024; u += F.G) { const int qb = 15 - (u >> 6), bh = u & 63; sb_unit(F, bh >> 3, bh & 7, qb); }
}
DI void ph_mlout(const Frame& F) { stage_conv_w(F); for (int u = F.vcu; u < 2048; u += F.G) ml_out_unit(F, u >> 6, u & 63); }
#ifndef P5_ALIGN
#define P5_ALIGN PG8_ALIGN
#endif
DI void ph_outproj(const Frame& F) {
    pg8::Gemm g{WSP(bf16, WS_MIX), WSP(bf16, WS_WOUT), T, D, D}; pg8::StaticOrder S; S.init(T, D, F.G, (int)blockIdx.x);
    pg8::EpiResGate E{inp(I_X), (float*)inp(I_OUT), WSP(float, WS_MOD) + 2048, NMOD, SEQ, D};
    pg8::gemm_phase<pg8::EpiResGate, pg8::StaticOrder, P5_ALIGN, PG8_SP2>(F.lds, g, S, E);
}
DI void ph_scores(const Frame& F) {
    pg8::Gemm g{WSP(bf16, WS_XN), WSP(bf16, WS_WEFF), T, NSC, D}; pg8::StaticOrder S; S.init(T, NSC, F.G, (int)blockIdx.x);
    EpiTopK E{WSP(int, WS_IDX), WSP(float, WS_GATE)};
    pg8::Unit un;
    for (int i = 0; S.next(i, un); ++i) { OneUnit S1{un}; pg8::gemm_phase<EpiTopK, OneUnit, false, PG8_SP2>(F.lds, g, S1, E); }
}
constexpr int N_PHASES = 11;
struct Args { const float* in[19]; float* out; unsigned char* ws; int ph_lo, ph_hi; };
__global__ void __launch_bounds__(NTHR, 2) hybrid_fwd(Args args) {
    extern __shared__ __attribute__((aligned(16))) unsigned char lds_raw[];
    Frame F;
    F.lds = (LAS unsigned char*)lds_raw;
    F.MISC = (volatile LAS unsigned*)(F.lds + LDSCTL_OFF + 320);
    F.tid = threadIdx.x; F.lane = F.tid & 63; F.wave = __builtin_amdgcn_readfirstlane(F.tid >> 6);
    F.G = gridDim.x; { const int bx = blockIdx.x; F.vcu = (F.G % 8 == 0) ? (bx % 8) * (F.G / 8) + bx / 8 : bx; }
    F.ws = args.ws;
    F.ctl = (gu32*)(F.ws + WS_CTL);
    for (int u = F.tid; u < (LDS_BYTES - LDSCTL_OFF) / 4; u += NTHR) ((LAS unsigned*)(F.lds + LDSCTL_OFF))[u] = 0u;
    __syncthreads();
    const int lo = args.ph_lo, hi = args.ph_hi;
    const bool one_launch = (hi - lo) > 1;
    XcdBarrier bar; bar.bar = (unsigned*)(F.ctl + CW_BAR); bar.x = 0; bar.st = nullptr;
    if (one_launch) bar = xcd_barrier_post((unsigned*)(F.ctl + CW_BAR), F.MISC + 8);
#ifndef PHMASK
#define PHMASK 0x7ff
#endif
#define IN(k) (((PHMASK >> (k)) & 1) && lo <= (k) && (k) < hi)
#define SEAM(k) do { if (IN(k) && IN((k) + 1)) xcd_barrier(bar); } while (0)
#ifndef REPMASK
#define REPMASK 0
#endif

#define RUN(k, ...) do { if (IN(k)) { if ((REPMASK >> (k)) & 1) { { const bool first = true; (void)first; __VA_ARGS__; } xcd_barrier(bar); } { const bool first = false; (void)first; __VA_ARGS__; } } } while (0)
    RUN(0, p0_phase(F, first ? P0_PARTS : 15)); SEAM(0);
    RUN(1, norm_phase<true>(F, inp(I_X), inp(I_GN1), 0, 1024)); SEAM(1);
    RUN(2, ph_inproj(F)); SEAM(2);
    RUN(3, ph_mix(F, first)); SEAM(3);
    RUN(10, ph_scan_attn(F)); if (IN(10) && IN(4)) xcd_barrier(bar);
    RUN(4, ph_mlout(F)); SEAM(4);
    RUN(5, ph_outproj(F)); SEAM(5);
    RUN(6, norm_phase<false>(F, inp(I_OUT), inp(I_GN2), 3072, 4096)); SEAM(6);
    RUN(7, ph_scores(F)); if (IN(7) && IN(9)) xcd_barrier(bar);
    RUN(9, peer_phase(F, first));
#undef RUN
#undef IN
#undef SEAM
}

#ifndef MK_PER_PHASE
#define MK_PER_PHASE 0
#endif
extern "C" void kernel_launch(void* const* d_in, const int* in_sizes, int n_in, void* d_out, int out_size, void* d_ws, size_t ws_size, hipStream_t stream) {
    static int grid = 0;
    if (grid == 0) {
        if (n_in != 19 || in_sizes[0] != T * D || out_size != T * D || ws_size < WS_END) { fprintf(stderr, "kernel_launch: unexpected shapes (n_in %d, in0 %d, out %d, ws %zu)\n", n_in, n_in > 0 ? in_sizes[0] : -1, out_size, ws_size); grid = -1; return; }
        int dev = 0, cus = 0, per_cu = 0;
        if (hipGetDevice(&dev) != hipSuccess || hipDeviceGetAttribute(&cus, hipDeviceAttributeMultiprocessorCount, dev) != hipSuccess) { grid = -1; return; }
        if (hipFuncSetAttribute((const void*)hybrid_fwd, hipFuncAttributeMaxDynamicSharedMemorySize, LDS_BYTES) != hipSuccess) { fprintf(stderr, "kernel_launch: hipFuncSetAttribute failed\n"); grid = -1; return; }
        if (hipOccupancyMaxActiveBlocksPerMultiprocessor(&per_cu, (const void*)hybrid_fwd, NTHR, LDS_BYTES) != hipSuccess || per_cu < 1) fprintf(stderr, "kernel_launch: occupancy query says %d\n", per_cu);
        (void)hipGetLastError();
        grid = cus;
    }
    if (grid < 0) return;
    if (hipMemsetAsync((char*)d_ws + WS_CTL, 0, CTL_ZERO_BYTES, stream) != hipSuccess) { fprintf(stderr, "kernel_launch: memset failed\n"); return; }
    Args a{};
    for (int i = 0; i < 19; ++i) a.in[i] = (const float*)d_in[i];
    a.out = (float*)d_out; a.ws = (unsigned char*)d_ws;
#if MK_PER_PHASE
    { const int order[N_PHASES] = {0, 1, 2, 3, 10, 4, 5, 6, 7, 8, 9}; for (int i = 0; i < N_PHASES; ++i) { a.ph_lo = order[i]; a.ph_hi = order[i] + 1; hipLaunchKernelGGL(hybrid_fwd, dim3(grid), dim3(NTHR), LDS_BYTES, stream, a); } }
#else
    a.ph_lo = 0; a.ph_hi = N_PHASES;
    hipLaunchKernelGGL(hybrid_fwd, dim3(grid), dim3(NTHR), LDS_BYTES, stream, a);
#endif
    const hipError_t le = hipPeekAtLastError();
    if (le != hipSuccess) fprintf(stderr, "kernel_launch: launch failed: %s\n", hipGetErrorName(le));
}
```

```cpp
#include <cmath>
#include <hip/hip_runtime.h>
#include <cstdio>
#include <cstdint>
namespace pg8 {
#define PG8_LAS __attribute__((address_space(3)))
typedef unsigned short bf16_t;
typedef short bf16x8 __attribute__((ext_vector_type(8)));
typedef float f32x4 __attribute__((ext_vector_type(4)));
typedef unsigned u32x4 __attribute__((ext_vector_type(4)));
constexpr int BM = 256, BK = 64, HALF = 128, HTB = HALF * BK * 2  , STAGE_BYTES = 8 * HTB, NXCD = 8,
#ifndef PG8_WGM
#define PG8_WGM 4
#endif
WGM = PG8_WGM;

__host__ __device__ __forceinline__ int lds_byte(int r, int c) { const int st = (r >> 4) * 2 + (c >> 5), rr = r & 15, cc = c & 31, ob = rr * 64 + cc * 2; return st * 1024 + (ob ^ (((ob >> 9) & 1) << 5)); }
__host__ __device__ __forceinline__ void stage_rc(int b, int& R, int& C) { const int st = b / 1024, sb = b % 1024, swz = sb ^ (((sb >> 9) & 1) << 5); R = (st >> 1) * 16 + swz / 64; C = (st & 1) * 32 + (swz % 64) / 2; }
__host__ __device__ __forceinline__ int perm32(int rho) { const int n = rho >> 4, i = rho & 15; return 8 * (i >> 2) + 4 * n + (i & 3); }

struct Unit { int pm, pn; };
struct Gemm { const bf16_t* A; const bf16_t* Bt; int M, N, K; };

struct StaticOrder {
    int nM, nN, nwg, G, c;
    __host__ __device__ void init(int M, int N, int G_, int c_) { nM = M / BM; nN = N / BM; nwg = nM * nN; G = G_; c = c_; }
    __host__ __device__ bool next(int i, Unit& u) const {
        const long L = (long)i * G + c; if (L >= nwg) return false;
        int wgid = (int)L; { const int q = nwg / NXCD, r = nwg % NXCD, xcd = wgid % NXCD, off = wgid / NXCD; wgid = (xcd < r ? xcd * (q + 1) : r * (q + 1) + (xcd - r) * q) + off; }
        const int nig = WGM * nN, gid = wgid / nig, fm = gid * WGM, gsz = (nM - fm) < WGM ? (nM - fm) : WGM;
        u.pm = fm + ((wgid % nig) % gsz); u.pn = (wgid % nig) / gsz; return true;
    }
    __device__ __forceinline__ void a_ready(const Unit&) const {}
    __device__ __forceinline__ void done(const Unit&) const {}
};

__device__ __forceinline__ unsigned cvt_pk_bf16(float lo, float hi) { unsigned r; asm volatile("v_cvt_pk_bf16_f32 %0, %1, %2" : "=v"(r) : "v"(lo), "v"(hi)); return r; }
typedef float f32x2 __attribute__((ext_vector_type(2)));
__device__ __forceinline__ f32x2 gelu_pk(f32x2 v) {
    const f32x2 av = __builtin_elementwise_abs(v), d = av * 0.2316418882f + 1.0f;
    f32x2 t; t.x = __builtin_amdgcn_rcpf(d.x); t.y = __builtin_amdgcn_rcpf(d.y);
    f32x2 q = t * 0.5307027145f + (-0.7265760135f); q = q * t + 0.7107068705f; q = q * t + (-0.142248368f); q = q * t + 0.127414796f; q = q * t;
    const f32x2 s = (v * v) * (-0.72134752044f);
    f32x2 e; e.x = __builtin_amdgcn_exp2f(s.x); e.y = __builtin_amdgcn_exp2f(s.y);
    const f32x2 m = v * (q * e), r = v - m;
    f32x2 o; o.x = v.x < 0.f ? m.x : r.x; o.y = v.y < 0.f ? m.y : r.y; return o;
}

template <int ACT  > struct EpiBf16 {
    static constexpr bool PERM = true, AFTER_DRAIN = false; static_assert(ACT == 0 || ACT == 1, "EpiBf16: ACT is 0 (none) or 1 (gelu_pk)");
    bf16_t* O; int ldc; const float* bias; int split_cols; size_t split_stride; float scale0;
    __device__ __forceinline__ void operator()(const f32x4 (&acc)[2][2][4][2], const Unit& u, int wr, int wc, int fr, int fq) const {
        const int row0 = u.pm * BM + wr * 64 + fr; int colt = u.pn * BM; bf16_t* base = O;
        float sc = 1.f; if (split_cols) { const int t = colt / split_cols; base += (size_t)t * split_stride; colt -= t * split_cols; if (t == 0) sc = scale0; }
        const int col0 = colt + wc * 32 + 8 * fq, bcol0 = u.pn * BM + wc * 32 + 8 * fq;
        f32x4 bv[2][2];
#pragma unroll
        for (int bj = 0; bj < 2; ++bj)
#pragma unroll
            for (int n = 0; n < 2; ++n) bv[bj][n] = bias ? *(const f32x4*)(bias + bcol0 + bj * HALF + 4 * n) : (f32x4){0.f, 0.f, 0.f, 0.f};
#pragma unroll
        for (int ai = 0; ai < 2; ++ai)
#pragma unroll
            for (int m = 0; m < 4; ++m) { bf16_t* rowp = base + (size_t)(row0 + ai * HALF + m * 16) * ldc + col0;
#pragma unroll
                for (int bj = 0; bj < 2; ++bj) { f32x4 v0 = acc[ai][bj][m][0] + bv[bj][0], v1 = acc[ai][bj][m][1] + bv[bj][1];
                    if (ACT == 1) { f32x2 a = gelu_pk((f32x2){v0[0], v0[1]}), b = gelu_pk((f32x2){v0[2], v0[3]}), c = gelu_pk((f32x2){v1[0], v1[1]}), d = gelu_pk((f32x2){v1[2], v1[3]});
                        v0 = (f32x4){a.x, a.y, b.x, b.y}; v1 = (f32x4){c.x, c.y, d.x, d.y}; }
                    v0 = v0 * sc; v1 = v1 * sc; u32x4 w; w.x = cvt_pk_bf16(v0[0], v0[1]); w.y = cvt_pk_bf16(v0[2], v0[3]); w.z = cvt_pk_bf16(v1[0], v1[1]); w.w = cvt_pk_bf16(v1[2], v1[3]);
                    *(u32x4*)(rowp + bj * HALF) = w; } }
    }
};
template <class Epi, class Sched, bool ALIGN_EPI = false, bool SP2 = false>
__device__ __forceinline__ void gemm_phase(PG8_LAS unsigned char* lds, const Gemm g, const Sched& S, const Epi& E) {
    const int tid = threadIdx.x, wid = __builtin_amdgcn_readfirstlane(tid >> 6), lane = tid & 63, wr = wid >> 2, wc = wid & 3, fr = lane & 15, fq = lane >> 4;
    const int K = g.K, nt = K / BK;
    unsigned voffA[2], voffB[2];
#pragma unroll
    for (int i = 0; i < 2; ++i) { int R, C; stage_rc(tid * 16 + i * 8192, R, C); const int Rb = Epi::PERM ? ((R & ~31) + perm32(R & 31)) : R;
        voffA[i] = (unsigned)(R * K + C) * 2u; voffB[i] = (unsigned)(Rb * K + C) * 2u; }
    const size_t kstep = (size_t)(BK * 2);
    const size_t hstep = (size_t)HALF * K * 2;
    const size_t tstep = 2 * hstep;
    const unsigned ldsw = (unsigned)wid * 1024u;
    const int aoff = lds_byte(wr * 64 + fr, fq * 8), boff = lds_byte(wc * 32 + fr, fq * 8);
#define PG8_SA(b, h) (((b) * 2 + (h)) * HTB)
#define PG8_SB(b, h) ((4 + (b) * 2 + (h)) * HTB)
#define PG8_STAGE(bufoff, gbase, voff) do { _Pragma("unroll") for (int _i = 0; _i < 2; ++_i) \
        __builtin_amdgcn_global_load_lds((const unsigned*)((const char*)(gbase) + (voff)[_i]), (PG8_LAS unsigned*)(lds + (bufoff) + ldsw + _i * 8192), 16, 0, 0); } while (0)
#define PG8_LDA(dst, b, h) do { _Pragma("unroll") for (int m = 0; m < 4; ++m) _Pragma("unroll") for (int k = 0; k < 2; ++k) dst[m][k] = *(const PG8_LAS bf16x8*)(lds + PG8_SA(b, h) + aoff + m * 2048 + k * 1024); } while (0)
#define PG8_LDB(dst, b, h) do { _Pragma("unroll") for (int n = 0; n < 2; ++n) _Pragma("unroll") for (int k = 0; k < 2; ++k) dst[n][k] = *(const PG8_LAS bf16x8*)(lds + PG8_SB(b, h) + boff + n * 2048 + k * 1024); } while (0)
#define PG8_MMA(ai, bj, At, Bt) do { __builtin_amdgcn_s_setprio(1); _Pragma("unroll") for (int m = 0; m < 4; ++m) _Pragma("unroll") for (int n = 0; n < 2; ++n) _Pragma("unroll") for (int k = 0; k < 2; ++k) \
        acc[ai][bj][m][n] = __builtin_amdgcn_mfma_f32_16x16x32_bf16(Bt[n][k], At[m][k], acc[ai][bj][m][n], 0, 0, 0); __builtin_amdgcn_s_setprio(0); } while (0)
#define PG8_WAIT_V(n) asm volatile("s_waitcnt vmcnt(" #n ")" ::: "memory")
#define PG8_WAIT_L(n) asm volatile("s_waitcnt lgkmcnt(" #n ")" ::: "memory")
#define PG8_BAR __builtin_amdgcn_s_barrier()
#define PG8_SCHED __builtin_amdgcn_sched_barrier(0)
    Unit cur, nxt; int ui = 0;
    if (!S.next(0, cur)) return;
    f32x4 acc[2][2][4][2];
#pragma unroll
    for (int a = 0; a < 2; ++a)
#pragma unroll
        for (int b = 0; b < 2; ++b)
#pragma unroll
            for (int m = 0; m < 4; ++m)
#pragma unroll
                for (int n = 0; n < 2; ++n) acc[a][b][m][n] = (f32x4){0.f, 0.f, 0.f, 0.f};
    bf16x8 At[4][2], B0[2][2], B1[2][2];
    const char* cA = (const char*)g.A + (size_t)cur.pm * tstep; const char* cB = (const char*)g.Bt + (size_t)cur.pn * tstep;
    S.a_ready(cur);
    if constexpr (SP2) {
        PG8_STAGE(PG8_SB(0, 0), cB, voffB); PG8_STAGE(PG8_SB(0, 1), cB + hstep, voffB); PG8_STAGE(PG8_SA(0, 0), cA, voffA); PG8_STAGE(PG8_SA(0, 1), cA + hstep, voffA);
        if (wr == 1) PG8_BAR;
        PG8_WAIT_V(2); PG8_BAR;
        PG8_STAGE(PG8_SB(1, 0), cB + kstep, voffB); PG8_STAGE(PG8_SA(1, 0), cA + kstep, voffA); PG8_STAGE(PG8_SB(1, 1), cB + hstep + kstep, voffB);
        PG8_WAIT_V(6); PG8_BAR;
    } else {
        PG8_STAGE(PG8_SB(0, 0), cB, voffB); PG8_STAGE(PG8_SA(0, 0), cA, voffA); PG8_STAGE(PG8_SB(0, 1), cB + hstep, voffB); PG8_STAGE(PG8_SA(0, 1), cA + hstep, voffA);
        if (wr == 1) PG8_BAR;
        PG8_WAIT_V(4); PG8_BAR;
        PG8_STAGE(PG8_SB(1, 0), cB + kstep, voffB); PG8_STAGE(PG8_SA(1, 0), cA + kstep, voffA); PG8_STAGE(PG8_SB(1, 1), cB + hstep + kstep, voffB);
        PG8_WAIT_V(6); PG8_BAR;
    }
    for (;;) {
        const bool has_next = S.next(ui + 1, nxt);
        const char* nA = has_next ? (const char*)g.A + (size_t)nxt.pm * tstep : cA; const char* nB = has_next ? (const char*)g.Bt + (size_t)nxt.pn * tstep : cB;
        for (int t = 0; t < nt; t += 2) {
            const bool last = (t == nt - 2);
            const char* a1 = cA + (size_t)(t + 1) * kstep;
            const char* a2 = last ? nA : cA + (size_t)(t + 2) * kstep; const char* b2 = last ? nB : cB + (size_t)(t + 2) * kstep;
            const char* a3 = a2 + kstep; const char* b3 = b2 + kstep;
            if (last && has_next) S.a_ready(nxt);
            if constexpr (SP2) {
            PG8_LDB(B0, 0, 0); PG8_LDB(B1, 0, 1); PG8_SCHED; PG8_LDA(At, 0, 0); PG8_STAGE(PG8_SA(1, 1), a1 + hstep, voffA);
            PG8_WAIT_V(8); PG8_WAIT_L(0); PG8_BAR; PG8_MMA(0, 0, At, B0); PG8_MMA(0, 1, At, B1); PG8_BAR; PG8_SCHED;
            PG8_LDA(At, 0, 1); PG8_STAGE(PG8_SB(0, 0), b2, voffB); PG8_STAGE(PG8_SB(0, 1), b2 + hstep, voffB); PG8_STAGE(PG8_SA(0, 0), a2, voffA);
            PG8_WAIT_V(8); PG8_WAIT_L(0); PG8_BAR; PG8_MMA(1, 0, At, B0); PG8_MMA(1, 1, At, B1); PG8_BAR; PG8_SCHED;
            PG8_LDB(B0, 1, 0); PG8_LDB(B1, 1, 1); PG8_SCHED; PG8_LDA(At, 1, 0); PG8_STAGE(PG8_SA(0, 1), a2 + hstep, voffA);
            PG8_WAIT_V(8); PG8_WAIT_L(0); PG8_BAR; PG8_MMA(0, 0, At, B0); PG8_MMA(0, 1, At, B1); PG8_BAR; PG8_SCHED;
            PG8_LDA(At, 1, 1); PG8_STAGE(PG8_SB(1, 0), b3, voffB); PG8_STAGE(PG8_SB(1, 1), b3 + hstep, voffB); PG8_STAGE(PG8_SA(1, 0), a3, voffA);
            PG8_WAIT_V(8); PG8_WAIT_L(0); PG8_BAR; PG8_MMA(1, 0, At, B0); PG8_MMA(1, 1, At, B1); PG8_BAR; PG8_SCHED;
            } else {
            PG8_LDB(B0, 0, 0); PG8_SCHED; PG8_LDA(At, 0, 0); PG8_STAGE(PG8_SA(1, 1), a1 + hstep, voffA);
            PG8_WAIT_L(8); PG8_BAR; PG8_WAIT_L(0); PG8_MMA(0, 0, At, B0); PG8_BAR; PG8_SCHED;
            PG8_LDB(B1, 0, 1); PG8_STAGE(PG8_SB(0, 0), b2, voffB);
            PG8_BAR; PG8_WAIT_L(0); PG8_MMA(0, 1, At, B1); PG8_BAR;
            PG8_LDA(At, 0, 1); PG8_STAGE(PG8_SA(0, 0), a2, voffA);
            PG8_BAR; PG8_WAIT_L(0); PG8_MMA(1, 0, At, B0); PG8_BAR; PG8_SCHED;
            PG8_STAGE(PG8_SB(0, 1), b2 + hstep, voffB);
            PG8_WAIT_V(6); PG8_BAR; PG8_MMA(1, 1, At, B1); PG8_BAR;
            PG8_LDB(B0, 1, 0); PG8_SCHED; PG8_LDA(At, 1, 0); PG8_STAGE(PG8_SA(0, 1), a2 + hstep, voffA);
            PG8_WAIT_L(8); PG8_BAR; PG8_WAIT_L(0); PG8_MMA(0, 0, At, B0); PG8_BAR; PG8_SCHED;
            PG8_LDB(B1, 1, 1); PG8_STAGE(PG8_SB(1, 0), b3, voffB);
            PG8_BAR; PG8_WAIT_L(0); PG8_MMA(0, 1, At, B1); PG8_BAR;
            PG8_LDA(At, 1, 1); PG8_STAGE(PG8_SA(1, 0), a3, voffA);
            PG8_BAR; PG8_WAIT_L(0); PG8_MMA(1, 0, At, B0); PG8_BAR; PG8_SCHED;
            PG8_STAGE(PG8_SB(1, 1), b3 + hstep, voffB);
            PG8_WAIT_V(6); PG8_BAR; PG8_MMA(1, 1, At, B1); PG8_BAR;
            }
        }
        if constexpr (ALIGN_EPI) { if (wr == 0) PG8_BAR; }
        if constexpr (!Epi::AFTER_DRAIN) { E(acc, cur, wr, wc, fr, fq); S.done(cur); }
        if (!has_next) break;
#pragma unroll
        for (int a = 0; a < 2; ++a)
#pragma unroll
            for (int b = 0; b < 2; ++b)
#pragma unroll
                for (int m = 0; m < 4; ++m)
#pragma unroll
                    for (int n = 0; n < 2; ++n) acc[a][b][m][n] = (f32x4){0.f, 0.f, 0.f, 0.f};
        cur = nxt; cA = nA; cB = nB; ++ui;
        if constexpr (ALIGN_EPI) { if (wr == 1) PG8_BAR; }
    }
    PG8_WAIT_V(0);
    if constexpr (!ALIGN_EPI) { if (wr == 0) PG8_BAR; }
    PG8_BAR;
    if constexpr (Epi::AFTER_DRAIN) { E.fused(acc, cur, wr, wc, fr, fq, lds, wid, lane); S.done(cur); }
#undef PG8_SA
#undef PG8_SB
#undef PG8_STAGE
#undef PG8_LDA
#undef PG8_LDB
#undef PG8_MMA
#undef PG8_WAIT_V
#undef PG8_WAIT_L
#undef PG8_BAR
#undef PG8_SCHED
}
}

#ifndef PG8_SP2
#define PG8_SP2 true
#endif
#ifndef PG8_ALIGN
#define PG8_ALIGN true
#endif

namespace pg8 {
struct EpiResGate {
    static constexpr bool PERM = false, AFTER_DRAIN = false;
    const float* base; float* out; const float* gate; int gate_ld; int rows_per_batch; int ldc;
    __device__ __forceinline__ void operator()(const f32x4 (&acc)[2][2][4][2], const Unit& u, int wr, int wc, int fr, int fq) const {
        const int row0 = u.pm * BM + wr * 64 + fr, col0 = u.pn * BM + wc * 32 + 4 * fq;
        const float* gp = gate + (size_t)((u.pm * BM) / rows_per_batch) * gate_ld + col0;
        f32x4 gv[2][2];
#pragma unroll
        for (int bj = 0; bj < 2; ++bj)
#pragma unroll
            for (int n = 0; n < 2; ++n) gv[bj][n] = *(const f32x4*)(gp + bj * HALF + n * 16);
#pragma unroll
        for (int ai = 0; ai < 2; ++ai)
#pragma unroll
            for (int m = 0; m < 4; ++m) { const size_t off = (size_t)(row0 + ai * HALF + m * 16) * ldc + col0;
#pragma unroll
                for (int bj = 0; bj < 2; ++bj)
#pragma unroll
                    for (int n = 0; n < 2; ++n) { const f32x4 bs = *(const f32x4*)(base + off + bj * HALF + n * 16);
                        *(f32x4*)(out + off + bj * HALF + n * 16) = bs + gv[bj][n] * acc[ai][bj][m][n]; } }
    }
};
struct EpiF32 {
    static constexpr bool PERM = false, AFTER_DRAIN = false;
    float* O; int ldc;
    __device__ __forceinline__ void operator()(const f32x4 (&acc)[2][2][4][2], const Unit& u, int wr, int wc, int fr, int fq) const {
        const int row0 = u.pm * BM + wr * 64 + fr, col0 = u.pn * BM + wc * 32 + 4 * fq;
#pragma unroll
        for (int ai = 0; ai < 2; ++ai)
#pragma unroll
            for (int m = 0; m < 4; ++m) { const size_t off = (size_t)(row0 + ai * HALF + m * 16) * ldc + col0;
#pragma unroll
                for (int bj = 0; bj < 2; ++bj)
#pragma unroll
                    for (int n = 0; n < 2; ++n) *(f32x4*)(O + off + bj * HALF + n * 16) = acc[ai][bj][m][n]; }
    }
};
}
#define GAS __attribute__((address_space(1)))
#define LAS __attribute__((address_space(3)))
typedef unsigned short bf16;
typedef unsigned v4u __attribute__((ext_vector_type(4)));
typedef float f32x4 __attribute__((ext_vector_type(4)));
typedef short bf16x8 __attribute__((ext_vector_type(8)));
typedef GAS unsigned gu32;
typedef GAS unsigned long long gu64;
#define RLX_AGENT __ATOMIC_RELAXED, __HIP_MEMORY_SCOPE_AGENT
#define LDS_WAIT() asm volatile("s_waitcnt lgkmcnt(0)" ::: "memory")
#define VM_WAIT() asm volatile("s_waitcnt vmcnt(0)" ::: "memory")
__device__ __forceinline__ unsigned long long rt() { return __builtin_amdgcn_s_memrealtime(); }
__device__ __forceinline__ unsigned f2bf(float f) { unsigned u = __builtin_bit_cast(unsigned, f); return (u + 0x7fffu + ((u >> 16) & 1u)) >> 16; }
__device__ __forceinline__ unsigned pk2(float lo, float hi) { return f2bf(lo) | (f2bf(hi) << 16); }

#define XB_TMO      128
#define XB_XCNT(j)  (256  + 64 * (j))
#define XB_XSUB(j)  (1280 + 64 * (j))
#define XB_XGEN(j)  (2304 + 64 * (j))
#define XB_TOP      3328
#define XB_TOPGEN   3392
#define XCD_BAR_WORDS 3456
#define XB_SPIN_CAP (1u << 24)

__device__ __forceinline__ unsigned xb_ld(unsigned* p)              { return __hip_atomic_load(p, __ATOMIC_RELAXED, __HIP_MEMORY_SCOPE_AGENT); }
__device__ __forceinline__ unsigned xb_add(unsigned* p, unsigned v) { return __hip_atomic_fetch_add(p, v, __ATOMIC_RELAXED, __HIP_MEMORY_SCOPE_AGENT); }
__device__ __forceinline__ unsigned xb_xcc_id() { return (unsigned)__builtin_amdgcn_s_getreg((3 << 11) | 20) & 0xFu; }
#define XB_SPIN(cond, bar) do { unsigned _sp = 0; while (cond) { __builtin_amdgcn_s_sleep(1); \
    if ((++_sp & 255u) == 0u) { if (xb_ld(&(bar)[XB_TMO])) break; if (_sp > XB_SPIN_CAP) { atomicAdd(&(bar)[XB_TMO], 1u); break; } } } } while (0)

struct XcdBarrier {
    unsigned* bar; unsigned x;
    volatile LAS unsigned* st;
};

__device__ __forceinline__ XcdBarrier xcd_barrier_post(unsigned* bar, volatile LAS unsigned* st) {
    XcdBarrier b; b.bar = bar; b.x = xb_xcc_id(); b.st = st;
    if (threadIdx.x == 0) (void)xb_add(&bar[XB_XCNT(b.x)], 1u);
    return b;
}
__device__ __forceinline__ void xcd_barrier_complete(unsigned* bar, unsigned x, unsigned& nloc, unsigned& nx) {
    const unsigned G = gridDim.x * gridDim.y * gridDim.z;
    unsigned sum, cnt, mine, sp = 0u;
    for (;;) {
        sum = 0u; cnt = 0u; mine = 0u;
#pragma unroll
        for (unsigned j = 0; j < 16; ++j) { const unsigned c = xb_ld(&bar[XB_XCNT(j)]); sum += c; cnt += (c > 0u) ? 1u : 0u; mine = (j == x) ? c : mine; }
        if (sum == G) break;
        __builtin_amdgcn_s_sleep(1);
        if ((++sp & 255u) == 0u) { if (xb_ld(&bar[XB_TMO])) break; if (sp > XB_SPIN_CAP) { atomicAdd(&bar[XB_TMO], 1u); break; } }
    }
    nloc = mine > 0u ? mine : 1u; nx = cnt > 0u ? cnt : 1u;
}

__device__ __forceinline__ void xcd_barrier(const XcdBarrier& b) {
    asm volatile("s_waitcnt vmcnt(0)" ::: "memory");
    __syncthreads();
    if (threadIdx.x == 0) {
        unsigned* bar = b.bar;
        __builtin_amdgcn_s_waitcnt(0);
        unsigned nloc = b.st[0], nx = b.st[1];
        if (nloc == 0u) { xcd_barrier_complete(bar, b.x, nloc, nx); b.st[0] = nloc; b.st[1] = nx; }
        const unsigned old = xb_add(&bar[XB_XSUB(b.x)], 1u);
        const unsigned gen = old / nloc;
        if (old + 1u == (gen + 1u) * nloc) {
            __builtin_amdgcn_fence(__ATOMIC_RELEASE, "agent");
            asm volatile("s_waitcnt vmcnt(0)" ::: "memory");
            const unsigned og = xb_add(&bar[XB_TOP], 1u);
            const unsigned tg = og / nx;
            if (og + 1u == (tg + 1u) * nx) xb_add(&bar[XB_TOPGEN], 1u);
            else XB_SPIN(xb_ld(&bar[XB_TOPGEN]) == tg, bar);
            __builtin_amdgcn_fence(__ATOMIC_ACQUIRE, "agent");
            xb_add(&bar[XB_XGEN(b.x)], 1u);
            asm volatile("s_waitcnt vmcnt(0)" ::: "memory");
        } else {
            XB_SPIN(xb_ld(&bar[XB_XGEN(b.x)]) == gen, bar);
            __builtin_amdgcn_fence(__ATOMIC_ACQUIRE, "agent");
            asm volatile("s_waitcnt vmcnt(0)" ::: "memory");
        }
    }
    __syncthreads();
}

constexpr int NWAVES = 8, NTHR = 512;
constexpr int NB = 8, SEQ = 4096, T = NB * SEQ, D = 1024, NPROJ = 3584, NIN = 3592, NMOD = 6144, NSC = 2048;
constexpr int C_QSB = 0, C_KSB = 512, C_VSB = 1024, C_QML = 1536, C_KML = 2048, C_VML = 2560, C_OML = 3072;
constexpr float EPS = 1e-6f, LOG2E = 1.4426950408889634f;
constexpr size_t MiB = 1u << 20;
constexpr size_t WS_CTL = 0, CTL_ZERO_BYTES = 1 * MiB;
constexpr size_t WS_MOD = 256 * 1024;
constexpr size_t WS_WIN = 2 * MiB, WS_WOUT = 10 * MiB, WS_WEFF = 12 * MiB;
constexpr size_t WS_XN = 16 * MiB;
constexpr size_t WS_PROJ = 80 * MiB;
constexpr size_t WS_MIX = 304 * MiB;
constexpr size_t WS_EXPU = 368 * MiB, WS_EXPV = 400 * MiB;
constexpr size_t WS_CST = 432 * MiB;
constexpr size_t WS_NST = 496 * MiB;
constexpr size_t WS_MST = 497 * MiB;
constexpr size_t WS_GATES = 498 * MiB;
constexpr size_t WS_SCORES = 80 * MiB;
constexpr size_t WS_IDX = 336 * MiB, WS_GATE = 352 * MiB;
constexpr size_t WS_SCL = 499 * MiB;
constexpr size_t WS_SUI = 499 * MiB + 65536, WS_SVI = 499 * MiB + 131072;
constexpr size_t WS_END = 500 * MiB;
constexpr int CW_Q3 = 64;
constexpr int CW_BAR = 4096;
constexpr int LDS_BYTES = 147456, LDSCTL_OFF = 143360;

typedef float f32x16 __attribute__((ext_vector_type(16)));
typedef float f32x2_t __attribute__((ext_vector_type(2)));
typedef __bf16 bf16x2_t __attribute__((ext_vector_type(2)));
typedef _Float16 f16x8 __attribute__((ext_vector_type(8)));
typedef short s16x4 __attribute__((ext_vector_type(4)));
typedef unsigned u32x2 __attribute__((ext_vector_type(2)));
#define DI __device__ __forceinline__
DI unsigned cvtpk(float lo, float hi) { f32x2_t v = {lo, hi}; bf16x2_t b = __builtin_convertvector(v, bf16x2_t); return __builtin_bit_cast(unsigned, b); }
DI float bflo(unsigned u) { return __uint_as_float(u << 16); }
DI float bfhi(unsigned u) { return __uint_as_float(u & 0xffff0000u); }
DI int crow(int i, int hi) { return (i & 3) + 8 * (i >> 2) + 4 * hi; }
DI int krow(int s, int hi, int j) { return 16 * s + 8 * (j >> 2) + 4 * hi + (j & 3); }
DI float swap_add(float v) { auto rr = __builtin_amdgcn_permlane32_swap(__float_as_uint(v), __float_as_uint(v), false, false); return __uint_as_float(rr[0]) + __uint_as_float(rr[1]); }
DI float swap_max(float v) { auto rr = __builtin_amdgcn_permlane32_swap(__float_as_uint(v), __float_as_uint(v), false, false); return fmaxf(__uint_as_float(rr[0]), __uint_as_float(rr[1])); }
DI float dot2bf(unsigned a, unsigned b, float acc) { return __builtin_amdgcn_fdot2_f32_bf16(__builtin_bit_cast(bf16x2_t, a), __builtin_bit_cast(bf16x2_t, b), acc, false); }
DI float ex2(float x) { return __builtin_amdgcn_exp2f(x); }
DI float lg2(float x) { return __builtin_amdgcn_logf(x); }
DI float fexp(float x) { return __builtin_amdgcn_exp2f(x * LOG2E); }
DI float wave_sum(float v) {
#pragma unroll
    for (int o = 1; o < 64; o <<= 1) v += __shfl_xor(v, o);
    return v;
}
DI float wave_max(float v) {
#pragma unroll
    for (int o = 1; o < 64; o <<= 1) v = fmaxf(v, __shfl_xor(v, o));
    return v;
}
#define DPP_MAXF(v, ctrl, rmask) fmaxf((v), __builtin_bit_cast(float, __builtin_amdgcn_update_dpp(0, __builtin_bit_cast(int, (v)), (ctrl), (rmask), 0xF, false)))
DI float wave_max_nonneg(float v) {
    v = DPP_MAXF(v, 0xB1, 0xF); v = DPP_MAXF(v, 0x4E, 0xF); v = DPP_MAXF(v, 0x141, 0xF); v = DPP_MAXF(v, 0x140, 0xF); v = DPP_MAXF(v, 0x142, 0xA); v = DPP_MAXF(v, 0x143, 0xC);
    return __builtin_bit_cast(float, __builtin_amdgcn_readlane(__builtin_bit_cast(int, v), 63));
}
#define DPP_ADDF(v, ctrl, rmask) ((v) + __builtin_bit_cast(float, __builtin_amdgcn_update_dpp(0, __builtin_bit_cast(int, (v)), (ctrl), (rmask), 0xF, false)))
DI float wave_sum_u(float v) {
    v = DPP_ADDF(v, 0xB1, 0xF); v = DPP_ADDF(v, 0x4E, 0xF); v = DPP_ADDF(v, 0x141, 0xF); v = DPP_ADDF(v, 0x140, 0xF); v = DPP_ADDF(v, 0x142, 0xA); v = DPP_ADDF(v, 0x143, 0xC);
    return __builtin_bit_cast(float, __builtin_amdgcn_readlane(__builtin_bit_cast(int, v), 63));
}
typedef short v4i16_t __attribute__((ext_vector_type(4)));
DI s16x4 trrd(LAS unsigned char* p) { return __builtin_bit_cast(s16x4, __builtin_amdgcn_ds_read_tr16_b64_v4i16((LAS v4i16_t*)p)); }
DI bf16x8 cat8(s16x4 a, s16x4 b) { return (bf16x8){a[0], a[1], a[2], a[3], b[0], b[1], b[2], b[3]}; }
#define MFMA_BF16(a, b, c) __builtin_amdgcn_mfma_f32_32x32x16_bf16((a), (b), (c), 0, 0, 0)
#define MFMA_F16(a, b, c) __builtin_amdgcn_mfma_f32_32x32x16_f16((a), (b), (c), 0, 0, 0)
DI unsigned pkh(float a, float b) { return __builtin_bit_cast(unsigned, __builtin_amdgcn_cvt_pkrtz(a, b)); }
DI bf16x8 packbf(const f32x16& x, int s) { v4u p; p.x = cvtpk(x[8 * s], x[8 * s + 1]); p.y = cvtpk(x[8 * s + 2], x[8 * s + 3]); p.z = cvtpk(x[8 * s + 4], x[8 * s + 5]); p.w = cvtpk(x[8 * s + 6], x[8 * s + 7]); return __builtin_bit_cast(bf16x8, p); }
DI f16x8 packh(const f32x16& x, int s) { v4u p; p.x = pkh(x[8 * s], x[8 * s + 1]); p.y = pkh(x[8 * s + 2], x[8 * s + 3]); p.z = pkh(x[8 * s + 4], x[8 * s + 5]); p.w = pkh(x[8 * s + 6], x[8 * s + 7]); return __builtin_bit_cast(f16x8, p); }

struct Frame {
    LAS unsigned char* lds;
    volatile LAS unsigned* MISC;
    gu32* ctl;
    unsigned char* ws;
    int tid, lane, wave, vcu, G;
};
DI const float* inp(int i) { const __attribute__((address_space(4))) unsigned long long* kp = (const __attribute__((address_space(4))) unsigned long long*)__builtin_amdgcn_kernarg_segment_ptr(); return (const float*)(const GAS float*)(*(volatile const __attribute__((address_space(4))) unsigned long long*)(kp + i)); }
enum { I_X = 0, I_C, I_WADA, I_BADA, I_GN1, I_WIN, I_BIG, I_BFG, I_CONVW, I_GQ, I_GK, I_GOSB, I_GOML, I_WOUT, I_GN2, I_WQ, I_SK, I_EU, I_EV, I_OUT };
#define WSP(type, off) ((type*)(F.ws + (off)))

DI void p0_transpose_item(const float* W, int K, int N, int ld, bf16* WT, LAS float* scr, int item, int lane) {
    const int nblk = N / 32, kb = item / nblk, nb = item % nblk, k0 = 64 * kb, n0 = 32 * nb;
    float tv[32];
#pragma unroll
    for (int i = 0; i < 32; ++i) tv[i] = W[(size_t)(k0 + 2 * i + (lane >> 5)) * ld + n0 + (lane & 31)];
#pragma unroll
    for (int i = 0; i < 32; ++i) scr[(2 * i + (lane >> 5)) * 33 + (lane & 31)] = tv[i];
    LDS_WAIT(); asm volatile("" ::: "memory");
    const int c = lane & 7;
#pragma unroll
    for (int j = 0; j < 4; ++j) { const int n = (lane >> 3) + 8 * j; const LAS float* s = scr + (8 * c) * 33 + n;
        v4u o; o.x = pk2(s[0 * 33], s[1 * 33]); o.y = pk2(s[2 * 33], s[3 * 33]); o.z = pk2(s[4 * 33], s[5 * 33]); o.w = pk2(s[6 * 33], s[7 * 33]);
        *(GAS v4u*)(WT + (size_t)(n0 + n) * K + k0 + 8 * c) = o; }
    LDS_WAIT(); asm volatile("" ::: "memory");
}
DI void p0_mod_block(const Frame& F, int item) {
    const float* const c_ = inp(I_C); const float* const w_ada_ = inp(I_WADA); const float* const b_ada_ = inp(I_BADA); float* const mod_ = WSP(float, WS_MOD);
    LAS float* scr = (LAS float*)(F.lds + F.wave * 16384);
    const int j = item * 64 + F.lane, d0 = F.wave * 128;
#pragma unroll
    for (int b = 0; b < 8; ++b)
#pragma unroll
        for (int q = 0; q < 2; ++q) { const float cv = c_[b * D + d0 + 64 * q + F.lane]; scr[b * 128 + 64 * q + F.lane] = cv / (1.f + fexp(-cv)); }
    LDS_WAIT(); asm volatile("" ::: "memory");
    float acc[8];
#pragma unroll
    for (int b = 0; b < 8; ++b) acc[b] = 0.f;
#pragma unroll 32
    for (int dd = 0; dd < 128; ++dd) { const float w = w_ada_[(size_t)(d0 + dd) * NMOD + j];
#pragma unroll
        for (int b = 0; b < 8; ++b) acc[b] += scr[b * 128 + dd] * w; }
#pragma unroll
    for (int b = 0; b < 8; ++b) scr[1024 + b * 64 + F.lane] = acc[b];
    __syncthreads();
    float tot = b_ada_[j];
#pragma unroll
    for (int w = 0; w < 8; ++w) tot += ((LAS float*)(F.lds + w * 16384))[1024 + F.wave * 64 + F.lane];
    mod_[F.wave * NMOD + j] = tot;
    __syncthreads();
}
DI void p0_weff_item(const Frame& F, int item) {
    const float* const sub_keys_ = inp(I_SK); const float* const w_q_peer_ = inp(I_WQ); bf16* const Weff_t_ = WSP(bf16, WS_WEFF);
    const int hp = item >> 4, dblk = item & 15;
    LAS float* sk = (LAS float*)F.lds;
    LAS float* rb = (LAS float*)(F.lds + 67584) + F.wave * 1024;
    { float tv[32];
#pragma unroll
      for (int i = 0; i < 32; ++i) tv[i] = sub_keys_[(size_t)hp * 16384 + F.tid + 512 * i];
#pragma unroll
      for (int i = 0; i < 32; ++i) { const int idx = F.tid + 512 * i; sk[(idx >> 7) * 129 + (idx & 127)] = tv[i]; } }
    const int d0 = 64 * dblk + 8 * F.wave;
#pragma unroll
    for (int r = 0; r < 8; ++r) { rb[r * 128 + F.lane] = w_q_peer_[(size_t)(d0 + r) * NSC + hp * 128 + F.lane]; rb[r * 128 + 64 + F.lane] = w_q_peer_[(size_t)(d0 + r) * NSC + hp * 128 + 64 + F.lane]; }
    __syncthreads();
    float a0[8], a1[8];
#pragma unroll
    for (int r = 0; r < 8; ++r) { a0[r] = 0.f; a1[r] = 0.f; }
#pragma unroll 4
    for (int c = 0; c < 128; ++c) { const float s0 = sk[F.lane * 129 + c], s1 = sk[(F.lane + 64) * 129 + c];
#pragma unroll
        for (int r = 0; r < 8; ++r) { const float a = rb[r * 128 + c]; a0[r] += a * s0; a1[r] += a * s1; } }
    v4u o0, o1; o0.x = pk2(a0[0], a0[1]); o0.y = pk2(a0[2], a0[3]); o0.z = pk2(a0[4], a0[5]); o0.w = pk2(a0[6], a0[7]);
    o1.x = pk2(a1[0], a1[1]); o1.y = pk2(a1[2], a1[3]); o1.z = pk2(a1[4], a1[5]); o1.w = pk2(a1[6], a1[7]);
    *(GAS v4u*)(Weff_t_ + (size_t)(hp * 128 + F.lane) * D + d0) = o0;
    *(GAS v4u*)(Weff_t_ + (size_t)(hp * 128 + 64 + F.lane) * D + d0) = o1;
    __syncthreads();
}
struct ExpRows2 { f32x4 v[2][4]; };
DI void exp_load2(const Frame& F, int blk0, ExpRows2& R) {
    const float* const expert_u_ = inp(I_EU); const float* const expert_v_ = inp(I_EV);
#pragma unroll
    for (int bb = 0; bb < 2; ++bb) { const int blk = blk0 + bb; const float* src = (blk < 16384 ? expert_u_ : expert_v_) + (size_t)(blk & 16383) * 1024 + 4 * F.lane;
#pragma unroll
        for (int k = 0; k < 4; ++k) R.v[bb][k] = *(const GAS f32x4*)(src + 256 * k); }
}
DI void exp_conv2(const Frame& F, int blk0, const ExpRows2& R) {
    float* const SUI_ = WSP(float, WS_SUI); float* const SVI_ = WSP(float, WS_SVI);
#pragma unroll
    for (int bb = 0; bb < 2; ++bb) { const int blk = blk0 + bb; const bool isu = blk < 16384; const int e = blk & 16383;
        float mx = 0.f;
#pragma unroll
        for (int k = 0; k < 4; ++k) mx = fmaxf(mx, fmaxf(fmaxf(fabsf(R.v[bb][k].x), fabsf(R.v[bb][k].y)), fmaxf(fabsf(R.v[bb][k].z), fabsf(R.v[bb][k].w))));
        mx = wave_max_nonneg(mx);
        const float top = 127.f, sc = mx > 0.f ? top / mx : 0.f;
        if (F.lane == 0) (isu ? SUI_ : SVI_)[e] = mx > 0.f ? mx / top : 0.f;
        unsigned char* dst = (isu ? WSP(unsigned char, WS_EXPU) : WSP(unsigned char, WS_EXPV)) + (size_t)e * 1024 + 4 * F.lane;
#pragma unroll
        for (int k = 0; k < 4; ++k) { const f32x4 a = R.v[bb][k] * sc;
            const int q0 = (int)rintf(a.x), q1 = (int)rintf(a.y), q2 = (int)rintf(a.z), q3 = (int)rintf(a.w); const unsigned w = (unsigned)(q0 & 0xff) | ((unsigned)(q1 & 0xff) << 8) | ((unsigned)(q2 & 0xff) << 16) | ((unsigned)q3 << 24);
            *(GAS unsigned*)(dst + 256 * k) = w; } }
}
#ifndef P0_PARTS
#define P0_PARTS 15
#endif
DI void p0_phase(const Frame& F, int parts = 15) {
    const float* const w_in_ = inp(I_WIN); bf16* const Win_t_ = WSP(bf16, WS_WIN); const float* const w_out_ = inp(I_WOUT); bf16* const Wout_t_ = WSP(bf16, WS_WOUT); const float* const expert_v_ = inp(I_EV); const float* const expert_u_ = inp(I_EU);
    LAS float* scr = (LAS float*)(F.lds + F.wave * 16384);
    const int gw = F.vcu * NWAVES + F.wave, NGW = F.G * NWAVES;
    if (parts & 1) for (int it = F.vcu; it < 96; it += F.G) p0_mod_block(F, it);
    constexpr int I_WIN = 16 * 112, I_WOUT = 16 * 32, NITEMS = I_WIN + I_WOUT;
    if (parts & 2) for (int it = gw; it < NITEMS; it += NGW) {
        int r = it;
        if (r < I_WIN) { p0_transpose_item(w_in_, D, NPROJ, NIN, Win_t_, scr, r, F.lane); continue; } r -= I_WIN;
        p0_transpose_item(w_out_, D, D, D, Wout_t_, scr, r, F.lane);
    }
    __syncthreads();
    if (parts & 8) for (int it = F.vcu; it < 256; it += F.G) p0_weff_item(F, it);
}

template <bool DOGATES>
DI void norm_phase(const Frame& F, const float* src, const float* g, int shift_off, int scale_off) {
    const float* const w_in_ = inp(I_WIN); float* const mod_ = WSP(float, WS_MOD); bf16* const XN_ = WSP(bf16, WS_XN); float* const GATES_ = WSP(float, WS_GATES); const float* const b_igate_ = inp(I_BIG); const float* const b_fgate_ = inp(I_BFG);
    LAS float* W8 = (LAS float*)F.lds;
    if (DOGATES) {
        for (int i = 0; i < 16; ++i) { const int idx = F.tid + 512 * i; W8[idx] = w_in_[(size_t)(idx & 1023) * NIN + NPROJ + (idx >> 10)]; }
        __syncthreads();
    }
    const int gw = F.vcu * NWAVES + F.wave, NGW = F.G * NWAVES;
    for (int ch = gw; ch < T / 16; ch += NGW) {
        const int r0 = ch * 16, b = r0 / SEQ;
        f32x4 A[4], Bv[4];
#pragma unroll
        for (int j = 0; j < 4; ++j) { const int col = 4 * F.lane + 256 * j; const f32x4 gg = *(const f32x4*)(g + col), sc = *(const f32x4*)(mod_ + b * NMOD + scale_off + col);
            A[j] = gg * (sc + 1.0f); Bv[j] = *(const f32x4*)(mod_ + b * NMOD + shift_off + col); }
        f32x4 nx[4];
        { const GAS f32x4* xr0 = (const GAS f32x4*)(src + (size_t)r0 * D) + F.lane;
#pragma unroll
          for (int j = 0; j < 4; ++j) nx[j] = xr0[64 * j]; }
        for (int rr = 0; rr < 16; ++rr) {
            const int row = r0 + rr;
            f32x4 v[4]; float s = 0.f;
#pragma unroll
            for (int j = 0; j < 4; ++j) { v[j] = nx[j]; s += (v[j].x * v[j].x + v[j].y * v[j].y) + (v[j].z * v[j].z + v[j].w * v[j].w); }
            { const GAS f32x4* xr = (const GAS f32x4*)(src + (size_t)(r0 + ((rr + 1) & 15)) * D) + F.lane;
#pragma unroll
                for (int j = 0; j < 4; ++j) nx[j] = xr[64 * j]; }
            const float rstd = 1.f / sqrtf(wave_sum_u(s) * (1.f / D) + EPS);
#pragma unroll
            for (int j = 0; j < 4; ++j) v[j] = v[j] * rstd * A[j] + Bv[j];
            GAS unsigned long long* o8 = (GAS unsigned long long*)(XN_ + (size_t)row * D) + F.lane;
#pragma unroll
            for (int j = 0; j < 4; ++j) o8[64 * j] = (unsigned long long)pk2(v[j].x, v[j].y) | ((unsigned long long)pk2(v[j].z, v[j].w) << 32);
            if (DOGATES) {
                float res = 0.f;
#pragma unroll
                for (int hh = 0; hh < 8; ++hh) { float p = 0.f;
#pragma unroll
                    for (int j = 0; j < 4; ++j) { const f32x4 w = *(const LAS f32x4*)(W8 + hh * 1024 + 4 * F.lane + 256 * j); p += (v[j].x * w.x + v[j].y * w.y) + (v[j].z * w.z + v[j].w * w.w); }
                    p = wave_sum_u(p); if (F.lane == hh) res = p; }
                if (F.lane < 8) GATES_[(size_t)row * 8 + F.lane] = res + (F.lane < 4 ? b_igate_[F.lane] : b_fgate_[F.lane - 4]);
            }
        }
    }
}

DI void sb_unit(const Frame& F, int b, int h, int qb) {
    bf16* const PROJ_ = WSP(bf16, WS_PROJ); const float* const g_q_sb_ = inp(I_GQ); const float* const g_k_sb_ = inp(I_GK); bf16* const MIX_ = WSP(bf16, WS_MIX); const float* const g_out_sb_ = inp(I_GOSB);
    const int lane = F.lane, w = F.wave, r = lane & 31, hi = lane >> 5;
    const int i16 = lane & 15, qq = i16 >> 2, pp = i16 & 3, blk = (lane >> 4) & 1;
    LAS unsigned char* Wb = F.lds + w * 16384;
    const size_t rowbase = (size_t)b * SEQ; const int q0 = qb * 256, qw0 = q0 + 32 * w, tq = qw0 + r;
    const bf16* P = PROJ_;
    const bf16* kpiece[4]; const bf16* vpiece[4];
#pragma unroll
    for (int i = 0; i < 4; ++i) { const int krow_ = 8 * i + (lane >> 3), kch = (lane & 7) ^ ((krow_ >> 1) & 7); kpiece[i] = P + (rowbase + krow_) * NPROJ + C_KSB + h * 64 + 8 * kch;
        const int vkey = 16 * (i & 1) + (lane >> 2); vpiece[i] = P + (rowbase + vkey) * NPROJ + C_VSB + h * 64 + 32 * (i >> 1) + 8 * (lane & 3); }
#define SB_DMA(T_, BUF_) do { _Pragma("unroll") for (int i_ = 0; i_ < 4; ++i_) { \
        __builtin_amdgcn_global_load_lds((const unsigned*)(kpiece[i_] + (size_t)(32 * (T_)) * NPROJ), (LAS unsigned*)(Wb + 8192 * (BUF_) + 1024 * i_), 16, 0, 0); \
        __builtin_amdgcn_global_load_lds((const unsigned*)(vpiece[i_] + (size_t)(32 * (T_)) * NPROJ), (LAS unsigned*)(Wb + 8192 * (BUF_) + 4096 + 1024 * i_), 16, 0, 0); } } while (0)
    const int tw = (qw0 + 30) >> 5;
    SB_DMA(tw, 0);
    bf16x8 qf[4];
    {
        const bf16* Qp = P + (rowbase + tq) * NPROJ + C_QSB + h * 64 + 8 * hi;
        v4u qraw[4]; float ss = 0.f;
#pragma unroll
        for (int kk = 0; kk < 4; ++kk) { qraw[kk] = *(const GAS v4u*)(Qp + 16 * kk);
#pragma unroll
            for (int e = 0; e < 4; ++e) { const float a = bflo(qraw[kk][e]), c = bfhi(qraw[kk][e]); ss += a * a + c * c; } }
        ss = swap_add(ss);
        const float rq = __builtin_amdgcn_rsqf(ss * (1.f / 64.f) + EPS) * (0.125f * LOG2E);
#pragma unroll
        for (int kk = 0; kk < 4; ++kk) { const int d0 = 16 * kk + 8 * hi;
            const f32x4 g0 = *(const f32x4*)(g_q_sb_ + d0) * *(const f32x4*)(g_k_sb_ + d0), g1 = *(const f32x4*)(g_q_sb_ + d0 + 4) * *(const f32x4*)(g_k_sb_ + d0 + 4);
            v4u o; o.x = cvtpk(bflo(qraw[kk].x) * rq * g0.x, bfhi(qraw[kk].x) * rq * g0.y); o.y = cvtpk(bflo(qraw[kk].y) * rq * g0.z, bfhi(qraw[kk].y) * rq * g0.w);
            o.z = cvtpk(bflo(qraw[kk].z) * rq * g1.x, bfhi(qraw[kk].z) * rq * g1.y); o.w = cvtpk(bflo(qraw[kk].w) * rq * g1.z, bfhi(qraw[kk].w) * rq * g1.w);
            qf[kk] = __builtin_bit_cast(bf16x8, o); }
    }
    f16x8 U0, U1, E0;
#pragma unroll
    for (int j = 0; j < 8; ++j) { U0[j] = (krow(0, hi, j) > r) ? (_Float16)1.0f : (_Float16)0.0f; U1[j] = (krow(1, hi, j) > r) ? (_Float16)1.0f : (_Float16)0.0f;
        E0[j] = (j == 0 && hi == 0) ? (_Float16)1.0f : (_Float16)0.0f; }
    f32x16 o0, o1;
#pragma unroll
    for (int i = 0; i < 16; ++i) { o0[i] = 0.f; o1[i] = 0.f; }
    float R = 0.f;
    const int kfoff = r * 128, kfsw = (r >> 1) & 7;
    for (int t = tw; t >= 0; --t) {
        const int buf = (tw - t) & 1;
        LAS unsigned char* Kb = Wb + 8192 * buf; LAS unsigned char* Vb = Kb + 4096;
        asm volatile("s_waitcnt vmcnt(0)" ::: "memory");
        if (t > 0) SB_DMA(t - 1, buf ^ 1);
        bf16x8 kf[4]; float ssk = 0.f;
#pragma unroll
        for (int kk = 0; kk < 4; ++kk) { const v4u kv = *(const LAS v4u*)(Kb + kfoff + (((2 * kk + hi) ^ kfsw) * 16)); kf[kk] = __builtin_bit_cast(bf16x8, kv);
            ssk = dot2bf(kv.x, kv.x, ssk); ssk = dot2bf(kv.y, kv.y, ssk); ssk = dot2bf(kv.z, kv.z, ssk); ssk = dot2bf(kv.w, kv.w, ssk); }
        ssk = swap_add(ssk);
        const float rk = __builtin_amdgcn_rsqf(ssk * (1.f / 64.f) + EPS);
        f16x8 RKA;
#pragma unroll
        for (int e = 0; e < 8; ++e) RKA[e] = (_Float16)0.0f;
        RKA[0] = (hi == 0) ? (_Float16)rk : (_Float16)0.0f;
        f32x16 s, rkd;
#pragma unroll
        for (int i = 0; i < 16; ++i) { s[i] = 0.f; rkd[i] = 0.f; }
        rkd = MFMA_F16(RKA, E0, rkd);
#pragma unroll
        for (int kk = 0; kk < 4; ++kk) s = MFMA_BF16(kf[kk], qf[kk], s);
        float tsum = 0.f; unsigned lp[8];
        if (32 * t + 31 < qw0) {
#pragma unroll
            for (int i = 0; i < 16; i += 2) {
                const float z0_ = s[i] * rkd[i], z1_ = s[i + 1] * rkd[i + 1];
                const float a0_ = -lg2(1.f + ex2(z0_)), a1_ = -lg2(1.f + ex2(z1_));
                tsum += a0_ + a1_;
                s[i] = z0_ + a0_; s[i + 1] = z1_ + a1_;
                lp[i >> 1] = pkh(a0_, a1_); }
        } else {
            const int kq = tq - 32 * t;
#pragma unroll
            for (int i = 0; i < 16; i += 2) {
                const float z0_ = s[i] * rkd[i], z1_ = s[i + 1] * rkd[i + 1];
                float a0_ = -lg2(1.f + ex2(z0_)), a1_ = -lg2(1.f + ex2(z1_));
                const bool ma0 = crow(i, hi) >= kq, ma1 = crow(i + 1, hi) >= kq;
                a0_ = ma0 ? 0.f : a0_; a1_ = ma1 ? 0.f : a1_;
                tsum += a0_ + a1_;
                s[i] = ma0 ? -INFINITY : z0_ + a0_; s[i + 1] = ma1 ? -INFINITY : z1_ + a1_;
                lp[i >> 1] = pkh(a0_, a1_); }
        }
        f32x16 c;
#pragma unroll
        for (int i = 0; i < 16; ++i) c[i] = R;
        c = MFMA_F16(U0, __builtin_bit_cast(f16x8, (v4u){lp[0], lp[1], lp[2], lp[3]}), c); c = MFMA_F16(U1, __builtin_bit_cast(f16x8, (v4u){lp[4], lp[5], lp[6], lp[7]}), c);
#pragma unroll
        for (int i = 0; i < 16; ++i) s[i] = ex2(s[i] + c[i]);
        const bf16x8 W0 = packbf(s, 0), W1 = packbf(s, 1);
        LAS unsigned char* vb_ = Vb + (4 * hi + qq) * 64 + 32 * blk + 8 * pp;
        o0 = MFMA_BF16(cat8(trrd(vb_), trrd(vb_ + 8 * 64)), W0, o0); o0 = MFMA_BF16(cat8(trrd(vb_ + 16 * 64), trrd(vb_ + 24 * 64)), W1, o0);
        o1 = MFMA_BF16(cat8(trrd(vb_ + 2048), trrd(vb_ + 2048 + 8 * 64)), W0, o1); o1 = MFMA_BF16(cat8(trrd(vb_ + 2048 + 16 * 64), trrd(vb_ + 2048 + 24 * 64)), W1, o1);
        R += swap_add(tsum);
        if (__all(R < -150.f)) break;
    }
    asm volatile("s_waitcnt vmcnt(0)" ::: "memory");
#undef SB_DMA
    {
        float ss = 0.f;
#pragma unroll
        for (int i = 0; i < 16; ++i) ss += o0[i] * o0[i] + o1[i] * o1[i];
        ss = swap_add(ss);
        const float ro = __builtin_amdgcn_rsqf(ss * (1.f / 64.f) + EPS);
        bf16* Op = MIX_ + (rowbase + tq) * D + h * 64;
        const float* go = g_out_sb_ + h * 64;
#pragma unroll
        for (int g = 0; g < 4; ++g) { const int d0 = 8 * g + 4 * hi; const f32x4 ga = *(const f32x4*)(go + d0), gb = *(const f32x4*)(go + 32 + d0);
            u32x2 wa, wb; wa.x = cvtpk(o0[4 * g] * ro * ga.x, o0[4 * g + 1] * ro * ga.y); wa.y = cvtpk(o0[4 * g + 2] * ro * ga.z, o0[4 * g + 3] * ro * ga.w);
            wb.x = cvtpk(o1[4 * g] * ro * gb.x, o1[4 * g + 1] * ro * gb.y); wb.y = cvtpk(o1[4 * g + 2] * ro * gb.z, o1[4 * g + 3] * ro * gb.w);
            *(GAS u32x2*)(Op + d0) = wa; *(GAS u32x2*)(Op + 32 + d0) = wb; }
    }
    __syncthreads();
}

DI void conv_silu8(const v4u (&xr)[4], const float (&cw)[4][8], float scale, float (&y)[8]) {
#pragma unroll
    for (int e = 0; e < 8; ++e) y[e] = 0.f;
#pragma unroll
    for (int j = 0; j < 4; ++j) {
        y[0] += cw[j][0] * bflo(xr[j].x); y[1] += cw[j][1] * bfhi(xr[j].x); y[2] += cw[j][2] * bflo(xr[j].y); y[3] += cw[j][3] * bfhi(xr[j].y);
        y[4] += cw[j][4] * bflo(xr[j].z); y[5] += cw[j][5] * bfhi(xr[j].z); y[6] += cw[j][6] * bflo(xr[j].w); y[7] += cw[j][7] * bfhi(xr[j].w); }
#pragma unroll
    for (int e = 0; e < 8; ++e) y[e] = scale * y[e] * __builtin_amdgcn_rcpf(1.f + fexp(-y[e]));
}
DI float log_sigmoid(float x) { return fminf(x, 0.f) - 0.6931471805599453f * lg2(1.f + fexp(-fabsf(x))); }
DI float wave_scan_incl(float a, int lane) {
#pragma unroll
    for (int o = 1; o < 64; o <<= 1) { const float t = __shfl_up(a, o); if (lane >= o) a += t; }
    return a;
}

constexpr int LDS_CW = 65536;
DI void stage_conv_w(const Frame& F) {
    const float* const conv_w_ = inp(I_CONVW); LAS float* cwl = (LAS float*)(F.lds + LDS_CW);
    for (int i = F.tid; i < 4096; i += NTHR) cwl[i] = conv_w_[i];
    __syncthreads();
}
DI void load_cw8(const Frame& F, int colbase, float (&cw)[4][8]) {
    const LAS float* cwl = (const LAS float*)(F.lds + LDS_CW);
#pragma unroll
    for (int j = 0; j < 4; ++j) { const f32x4 a = *(const LAS f32x4*)(cwl + j * 1024 + colbase), b = *(const LAS f32x4*)(cwl + j * 1024 + colbase + 4);
        cw[j][0] = a.x; cw[j][1] = a.y; cw[j][2] = a.z; cw[j][3] = a.w; cw[j][4] = b.x; cw[j][5] = b.y; cw[j][6] = b.z; cw[j][7] = b.w; }
}
struct MlLocalRegs { v4u kraw[2][4]; v4u vraw[2]; float gi, gf; };
DI void ml_local_load(const Frame& F, int chain, int c, MlLocalRegs& R) {
    bf16* const PROJ_ = WSP(bf16, WS_PROJ); float* const GATES_ = WSP(float, WS_GATES);
    const int tid = F.tid, lane = F.lane;
    const int b = chain >> 2, hh = chain & 3; const size_t rowbase = (size_t)b * SEQ; const int t0 = c * 64;
    const bf16* P = PROJ_;
    const int kc = tid & 15, kr0 = tid >> 4;
    const bf16* Kg = P + rowbase * NPROJ + C_KML + hh * 128 + kc * 8;
#pragma unroll
    for (int i = 0; i < 2; ++i)
#pragma unroll
        for (int j = 0; j < 4; ++j) { const int tt = t0 + kr0 + 32 * i - 3 + j; R.kraw[i][j] = (tt >= 0) ? *(const GAS v4u*)(Kg + (size_t)tt * NPROJ) : (v4u){0u, 0u, 0u, 0u}; }
#pragma unroll
    for (int i = 0; i < 2; ++i) R.vraw[i] = *(const GAS v4u*)(P + (rowbase + t0 + kr0 + 32 * i) * NPROJ + C_VML + hh * 128 + kc * 8);
    const float* Gg = GATES_ + (rowbase + t0 + lane) * 8;
    R.gi = Gg[hh]; R.gf = Gg[4 + hh];
}
DI void ml_local_unit(const Frame& F, int chain, int c, const MlLocalRegs& RG) {
    bf16* const CST_ = WSP(bf16, WS_CST); float* const NST_ = WSP(float, WS_NST); float* const SCL_ = WSP(float, WS_SCL);
    LAS unsigned char* L = F.lds;
    LAS float* Lws = (LAS float*)(L + 32768);
    const int tid = F.tid, lane = F.lane, w = F.wave, r = lane & 31, hi = lane >> 5;
    const int i16 = lane & 15, qq = i16 >> 2, pp = i16 & 3, blk = (lane >> 4) & 1;
    const int hh = chain & 3;
    const int kbk = w & 3, vb0 = 2 * (w >> 2);
    const int kc = tid & 15, kr0 = tid >> 4;
    v4u kraw[2][4], vraw[2];
#pragma unroll
    for (int i = 0; i < 2; ++i) { vraw[i] = RG.vraw[i];
#pragma unroll
        for (int j = 0; j < 4; ++j) kraw[i][j] = RG.kraw[i][j]; }
    const float gi = RG.gi, gf = RG.gf;
    const float a = wave_scan_incl(log_sigmoid(gf), lane);
    const float a_end = __shfl(a, 63);
    const float lw = a_end - a + gi;
    const float m_loc = wave_max(lw);
    const float ws = fexp(lw - m_loc);
    if (w == 0) Lws[lane] = ws;
    {
        float cw[4][8]; load_cw8(F, 512 + hh * 128 + kc * 8, cw);
#pragma unroll
        for (int i = 0; i < 2; ++i) { float y[8]; conv_silu8(kraw[i], cw, 0.08838834764831845f, y);
            v4u o; o.x = cvtpk(y[0], y[1]); o.y = cvtpk(y[2], y[3]); o.z = cvtpk(y[4], y[5]); o.w = cvtpk(y[6], y[7]);
            *(LAS v4u*)(L + (kc >> 2) * 4096 + (kr0 + 32 * i) * 64 + (kc & 3) * 16) = o; }
#pragma unroll
        for (int i = 0; i < 2; ++i) { const int row = kr0 + 32 * i; const float wsr = __shfl(ws, row);
            v4u o; o.x = cvtpk(bflo(vraw[i].x) * wsr, bfhi(vraw[i].x) * wsr); o.y = cvtpk(bflo(vraw[i].y) * wsr, bfhi(vraw[i].y) * wsr); o.z = cvtpk(bflo(vraw[i].z) * wsr, bfhi(vraw[i].z) * wsr); o.w = cvtpk(bflo(vraw[i].w) * wsr, bfhi(vraw[i].w) * wsr);
            *(LAS v4u*)(L + 16384 + (kc >> 2) * 4096 + row * 64 + (kc & 3) * 16) = o; }
    }
    __syncthreads();
    f32x16 acc0, acc1;
#pragma unroll
    for (int i = 0; i < 16; ++i) { acc0[i] = 0.f; acc1[i] = 0.f; }
#pragma unroll
    for (int kk = 0; kk < 4; ++kk) { const int rows = 16 * kk + 8 * hi + qq;
        LAS unsigned char* ka = L + kbk * 4096 + rows * 64 + 32 * blk + 8 * pp; LAS unsigned char* va = L + 16384 + vb0 * 4096 + rows * 64 + 32 * blk + 8 * pp;
        const bf16x8 A = cat8(trrd(ka), trrd(ka + 4 * 64));
        acc0 = MFMA_BF16(A, cat8(trrd(va), trrd(va + 4 * 64)), acc0); acc1 = MFMA_BF16(A, cat8(trrd(va + 4096), trrd(va + 4096 + 4 * 64)), acc1); }
    {
        bf16* Cp = CST_ + ((size_t)(chain * 64 + c) * 128 + vb0 * 32 + r) * 128 + kbk * 32 + 4 * hi;
#pragma unroll
        for (int g = 0; g < 4; ++g) { u32x2 o; o.x = cvtpk(acc0[4 * g], acc0[4 * g + 1]); o.y = cvtpk(acc0[4 * g + 2], acc0[4 * g + 3]); *(GAS u32x2*)(Cp + 8 * g) = o;
            u32x2 o1; o1.x = cvtpk(acc1[4 * g], acc1[4 * g + 1]); o1.y = cvtpk(acc1[4 * g + 2], acc1[4 * g + 3]); *(GAS u32x2*)(Cp + 32 * 128 + 8 * g) = o1; }
    }
    {
        const int k = 16 * w + (lane & 15), sq = lane >> 4; float part = 0.f;
        const LAS unsigned short* kcol = (const LAS unsigned short*)(L + (k >> 5) * 4096 + (k & 31) * 2);
#pragma unroll
        for (int e = 0; e < 16; ++e) part += Lws[16 * sq + e] * __uint_as_float((unsigned)kcol[(16 * sq + e) * 32] << 16);
        part += __shfl_xor(part, 16); part += __shfl_xor(part, 32);
        if (lane < 16) NST_[(size_t)(chain * 64 + c) * 128 + k] = part;
        if (tid == 0) { SCL_[(chain * 64 + c) * 2] = a_end; SCL_[(chain * 64 + c) * 2 + 1] = m_loc; }
    }
    __syncthreads();
}
DI void ml_scan_phase(const Frame& F) {
    bf16* const CST_ = WSP(bf16, WS_CST); float* const NST_ = WSP(float, WS_NST); float* const SCL_ = WSP(float, WS_SCL); float* const MST_ = WSP(float, WS_MST);
    for (int gt = F.vcu * NTHR + F.tid; gt < 32 * 4096; gt += F.G * NTHR) {
        const int chain = gt >> 12, rem = gt & 4095;
        const float ae_l = SCL_[(chain * 64 + F.lane) * 2], ml_l = SCL_[(chain * 64 + F.lane) * 2 + 1];
        u32x2* Cp = (u32x2*)(CST_ + (size_t)chain * 64 * 16384 + (size_t)rem * 4);
        f32x4* Np = (f32x4*)(NST_ + (size_t)chain * 64 * 128 + rem * 4);
        const bool do_n = rem < 32;
        float c0 = 0.f, c1 = 0.f, c2 = 0.f, c3 = 0.f; f32x4 nn = {0.f, 0.f, 0.f, 0.f}; float m = 0.f;
        u32x2 dr[8]; f32x4 nr[8];
#pragma unroll
        for (int i = 0; i < 8; ++i) { dr[i] = Cp[(size_t)i * 4096]; if (do_n) nr[i] = Np[i * 32]; }
        for (int c0_ = 0; c0_ < 64; c0_ += 8) {
#pragma unroll
            for (int i = 0; i < 8; ++i) { const int c = c0_ + i;
                if (c < 63) {
                    const u32x2 dcur = dr[i]; const f32x4 dn = nr[i];
                    { const int cn = (c + 8) & 63; dr[i] = Cp[(size_t)cn * 4096]; if (do_n) nr[i] = Np[cn * 32]; }
                    const float ae = __builtin_bit_cast(float, __builtin_amdgcn_readlane(__builtin_bit_cast(int, ae_l), c)), ml = __builtin_bit_cast(float, __builtin_amdgcn_readlane(__builtin_bit_cast(int, ml_l), c));
                    const float mn = fmaxf(ae + m, ml), d1 = fexp(ae + m - mn), d2 = fexp(ml - mn);
                    c0 = d1 * c0 + d2 * bflo(dcur.x); c1 = d1 * c1 + d2 * bfhi(dcur.x); c2 = d1 * c2 + d2 * bflo(dcur.y); c3 = d1 * c3 + d2 * bfhi(dcur.y);
                    u32x2 o; o.x = cvtpk(c0, c1); o.y = cvtpk(c2, c3); Cp[(size_t)c * 4096] = o;
                    if (do_n) { nn = nn * d1 + dn * d2; Np[c * 32] = nn; }
                    if (rem == 0) MST_[chain * 64 + c] = mn;
                    m = mn; } }
        }
    }
}
DI void ml_out_unit(const Frame& F, int chain, int c) {
    bf16* const PROJ_ = WSP(bf16, WS_PROJ); float* const GATES_ = WSP(float, WS_GATES); float* const MST_ = WSP(float, WS_MST); bf16* const CST_ = WSP(bf16, WS_CST); float* const NST_ = WSP(float, WS_NST); bf16* const MIX_ = WSP(bf16, WS_MIX); const float* const g_out_ml_ = inp(I_GOML);
    LAS unsigned char* L = F.lds;
    LAS float* Lbs = (LAS float*)(L + 49152); LAS float* Lav = (LAS float*)(L + 49408); LAS float* Lex = (LAS float*)(L + 49664);
    const int tid = F.tid, lane = F.lane, w = F.wave, r = lane & 31, hi = lane >> 5;
    const int i16 = lane & 15, qq = i16 >> 2, pp = i16 & 3, blk = (lane >> 4) & 1;
    const int b = chain >> 2, hh = chain & 3; const size_t rowbase = (size_t)b * SEQ; const int t0 = c * 64;
    const int tb = w >> 2, vb = w & 3;
    const bf16* P = PROJ_;
    {
        const int kc = tid & 15, kr0 = tid >> 4;
#pragma unroll
        for (int which = 0; which < 2; ++which) {
            const int colbase = (which ? 512 : 0) + hh * 128 + kc * 8;
            float cw[4][8]; load_cw8(F, colbase, cw);
            const bf16* Xg = P + rowbase * NPROJ + C_QML + colbase;
#pragma unroll
            for (int i = 0; i < 2; ++i) { const int row = kr0 + 32 * i; v4u xr[4];
#pragma unroll
                for (int j = 0; j < 4; ++j) { const int tt = t0 + row - 3 + j; xr[j] = (tt >= 0) ? *(const GAS v4u*)(Xg + (size_t)tt * NPROJ) : (v4u){0u, 0u, 0u, 0u}; }
                float y[8]; conv_silu8(xr, cw, which ? 0.08838834764831845f : 1.0f, y);
                v4u o; o.x = cvtpk(y[0], y[1]); o.y = cvtpk(y[2], y[3]); o.z = cvtpk(y[4], y[5]); o.w = cvtpk(y[6], y[7]);
                *(LAS v4u*)(L + which * 16384 + row * 256 + ((kc ^ (row & 15)) * 16)) = o; }
        }
#pragma unroll
        for (int i = 0; i < 2; ++i) { const int row = kr0 + 32 * i;
            const v4u v = *(const GAS v4u*)(P + (rowbase + t0 + row) * NPROJ + C_VML + hh * 128 + kc * 8);
            *(LAS v4u*)(L + 32768 + (kc >> 2) * 4096 + row * 64 + (kc & 3) * 16) = v; }
        if (w == 0) { const float* Gg = GATES_ + (rowbase + t0 + lane) * 8; const float a = wave_scan_incl(log_sigmoid(Gg[4 + hh]), lane); Lav[lane] = a; Lbs[lane] = Gg[hh] - a; }
    }
    const float mprev = (c > 0) ? MST_[chain * 64 + c - 1] : 0.f;
    bf16x8 cf[8], nf[8];
    if (c > 0) {
        const bf16* Cp = CST_ + ((size_t)(chain * 64 + c - 1) * 128 + vb * 32 + r) * 128 + 8 * hi;
        const float* Np = NST_ + (size_t)(chain * 64 + c - 1) * 128 + 8 * hi;
        const bool nrow = (r == 0) || (r == 4);
#pragma unroll
        for (int kk = 0; kk < 8; ++kk) { cf[kk] = *(const GAS bf16x8*)(Cp + 16 * kk);
            const f32x4 n0 = *(const f32x4*)(Np + 16 * kk), n1 = *(const f32x4*)(Np + 16 * kk + 4);
            v4u o; o.x = cvtpk(n0.x, n0.y); o.y = cvtpk(n0.z, n0.w); o.z = cvtpk(n1.x, n1.y); o.w = cvtpk(n1.z, n1.w);
            if (!nrow) o = (v4u){0u, 0u, 0u, 0u};
            nf[kk] = __builtin_bit_cast(bf16x8, o); }
    }
    __syncthreads();
    bf16x8 qf[8];
    f32x16 s0, s1;
#pragma unroll
    for (int i = 0; i < 16; ++i) { s0[i] = 0.f; s1[i] = 0.f; }
#pragma unroll
    for (int kk = 0; kk < 8; ++kk) { const int ch = 2 * kk + hi; const int rq_ = 32 * tb + r;
        qf[kk] = *(const LAS bf16x8*)(L + rq_ * 256 + ((ch ^ (rq_ & 15)) * 16));
        const bf16x8 a0 = *(const LAS bf16x8*)(L + 16384 + r * 256 + ((ch ^ (r & 15)) * 16));
        const bf16x8 a1 = *(const LAS bf16x8*)(L + 16384 + (32 + r) * 256 + ((ch ^ ((32 + r) & 15)) * 16));
        s0 = MFMA_BF16(a0, qf[kk], s0); s1 = MFMA_BF16(a1, qf[kk], s1); }
    const int tl = 32 * tb + r; const float a_t = Lav[tl];
    f32x16 d0, d1; float mrow = -INFINITY;
#pragma unroll
    for (int g = 0; g < 4; ++g) { const f32x4 b0 = *(const LAS f32x4*)(Lbs + 8 * g + 4 * hi), b1 = *(const LAS f32x4*)(Lbs + 32 + 8 * g + 4 * hi);
#pragma unroll
        for (int e = 0; e < 4; ++e) { const int sl = 8 * g + 4 * hi + e;
            d0[4 * g + e] = (sl <= tl) ? a_t + b0[e] : -INFINITY; d1[4 * g + e] = (32 + sl <= tl) ? a_t + b1[e] : -INFINITY;
            mrow = fmaxf(mrow, fmaxf(d0[4 * g + e], d1[4 * g + e])); } }
    mrow = fmaxf(swap_max(mrow), a_t + mprev);
    float psum = 0.f;
#pragma unroll
    for (int i = 0; i < 16; ++i) { s0[i] *= fexp(d0[i] - mrow); s1[i] *= fexp(d1[i] - mrow); psum += s0[i] + s1[i]; }
    const float w_inter = fexp(a_t + mprev - mrow);
    float den = swap_add(psum);
    const bf16x8 P00 = packbf(s0, 0), P01 = packbf(s0, 1), P10 = packbf(s1, 0), P11 = packbf(s1, 1);
    f32x16 num;
#pragma unroll
    for (int i = 0; i < 16; ++i) num[i] = 0.f;
    {
        LAS unsigned char* vb_ = L + 32768 + vb * 4096 + (4 * hi + qq) * 64 + 32 * blk + 8 * pp;
        num = MFMA_BF16(cat8(trrd(vb_), trrd(vb_ + 8 * 64)), P00, num); num = MFMA_BF16(cat8(trrd(vb_ + 16 * 64), trrd(vb_ + 24 * 64)), P01, num);
        num = MFMA_BF16(cat8(trrd(vb_ + 32 * 64), trrd(vb_ + 40 * 64)), P10, num); num = MFMA_BF16(cat8(trrd(vb_ + 48 * 64), trrd(vb_ + 56 * 64)), P11, num);
    }
    if (c > 0) {
        f32x16 it, dn;
#pragma unroll
        for (int i = 0; i < 16; ++i) { it[i] = 0.f; dn[i] = 0.f; }
#pragma unroll
        for (int kk = 0; kk < 8; ++kk) { it = MFMA_BF16(cf[kk], qf[kk], it); dn = MFMA_BF16(nf[kk], qf[kk], dn); }
#pragma unroll
        for (int i = 0; i < 16; ++i) num[i] += w_inter * it[i];
        den += w_inter * dn[0];
    }
    const float inv = __builtin_amdgcn_rcpf(fmaxf(fabsf(den), fexp(-mrow)));
    float ss = 0.f;
#pragma unroll
    for (int i = 0; i < 16; ++i) { num[i] *= inv; ss += num[i] * num[i]; }
    ss = swap_add(ss);
    if (lane < 32) Lex[(tb * 4 + vb) * 32 + r] = ss;
    __syncthreads();
    const float tot = (Lex[(tb * 4 + 0) * 32 + r] + Lex[(tb * 4 + 1) * 32 + r]) + (Lex[(tb * 4 + 2) * 32 + r] + Lex[(tb * 4 + 3) * 32 + r]);
    const float rstd = 1.f / sqrtf(tot * (1.f / 128.f) + EPS);
    {
        const size_t trow = rowbase + t0 + tl;
        const bf16* Og = P + trow * NPROJ + C_OML + hh * 128 + vb * 32 + 4 * hi;
        bf16* Mp = MIX_ + trow * D + 512 + hh * 128 + vb * 32 + 4 * hi;
        const float* go = g_out_ml_ + hh * 128 + vb * 32 + 4 * hi;
#pragma unroll
        for (int g = 0; g < 4; ++g) { const u32x2 og = *(const GAS u32x2*)(Og + 8 * g); const f32x4 gg = *(const f32x4*)(go + 8 * g);
            const float o0 = bflo(og.x), o1 = bfhi(og.x), o2 = bflo(og.y), o3 = bfhi(og.y);
            u32x2 o; o.x = cvtpk(num[4 * g] * rstd * gg.x * __builtin_amdgcn_rcpf(1.f + fexp(-o0)), num[4 * g + 1] * rstd * gg.y * __builtin_amdgcn_rcpf(1.f + fexp(-o1)));
            o.y = cvtpk(num[4 * g + 2] * rstd * gg.z * __builtin_amdgcn_rcpf(1.f + fexp(-o2)), num[4 * g + 3] * rstd * gg.w * __builtin_amdgcn_rcpf(1.f + fexp(-o3)));
            *(GAS u32x2*)(Mp + 8 * g) = o; }
    }
    __syncthreads();
}

#define TK_CE(A, B) do { const float hi_ = fmaxf((A), (B)), lo_ = fminf((A), (B)); (A) = hi_; (B) = lo_; } while (0)
DI void tk_sort16(float (&a)[16]) {
#pragma unroll
    for (int k = 2; k <= 16; k <<= 1)
#pragma unroll
        for (int j = k >> 1; j > 0; j >>= 1)
#pragma unroll
            for (int i = 0; i < 16; ++i) { const int l = i ^ j; if (l > i) { if ((i & k) == 0) TK_CE(a[i], a[l]); else TK_CE(a[l], a[i]); } }
}
DI void tk_merge16(float (&a)[16], const float (&b)[16]) {
#pragma unroll
    for (int i = 0; i < 16; ++i) a[i] = fmaxf(a[i], b[15 - i]);
#pragma unroll
    for (int j = 8; j > 0; j >>= 1)
#pragma unroll
        for (int i = 0; i < 16; ++i) { const int l = i ^ j; if (l > i) TK_CE(a[i], a[l]); }
}
DI void tk_stage2(const LAS float* la, const LAS float* lb, int* IDX_, float* GATEW_, size_t o) {
        float a[16], bb[16], cnd[64];
#pragma unroll
        for (int q = 0; q < 16; ++q) { a[q] = la[q]; bb[q] = lb[q]; }
        int cnt = 0;
#pragma unroll
        for (int i = 0; i < 16; ++i)
#pragma unroll
            for (int j = 0; j < 16; ++j) if ((i + 1) * (j + 1) <= 16) { cnd[cnt] = __uint_as_float((__float_as_uint(a[i] + bb[j]) & ~0xFFu) | (unsigned)(i * 16 + j)); ++cnt; }
#pragma unroll
        for (int q = 50; q < 64; ++q) cnd[q] = -INFINITY;
        float top[16];
#pragma unroll
        for (int c = 0; c < 4; ++c) { float ch[16];
#pragma unroll
            for (int q = 0; q < 16; ++q) ch[q] = cnd[16 * c + q];
            tk_sort16(ch);
            if (c == 0) {
#pragma unroll
                for (int q = 0; q < 16; ++q) top[q] = ch[q];
            } else tk_merge16(top, ch); }
        float sv[16]; int ei[16]; float mx = -INFINITY;
#pragma unroll
        for (int q = 0; q < 16; ++q) { const unsigned code = __float_as_uint(top[q]) & 0xFFu; const float va = la[code >> 4], vb = lb[code & 15u];
            ei[q] = (int)((__float_as_uint(va) & 0x7Fu) * 128u + (__float_as_uint(vb) & 0x7Fu)); sv[q] = va + vb; mx = fmaxf(mx, sv[q]); }
        float sum = 0.f;
#pragma unroll
        for (int q = 0; q < 16; ++q) { sv[q] = fexp(sv[q] - mx); sum += sv[q]; }
        const float inv = 1.f / sum;
#pragma unroll
        for (int q = 0; q < 16; q += 4) { *(GAS v4u*)(IDX_ + o + q) = (v4u){(unsigned)ei[q], (unsigned)ei[q + 1], (unsigned)ei[q + 2], (unsigned)ei[q + 3]};
            *(GAS f32x4*)(GATEW_ + o + q) = (f32x4){sv[q] * inv, sv[q + 1] * inv, sv[q + 2] * inv, sv[q + 3] * inv}; }
    }
struct EpiTopK {
    static constexpr bool PERM = false, AFTER_DRAIN = true;
    int* IDX; float* GATEW;
    DI void fused(f32x4 (&acc)[2][2][4][2], const pg8::Unit& u, int wr, int wc, int fr, int fq, LAS unsigned char* lds, int wid, int lane) const {
        LAS float* Tl = (LAS float*)lds;
        LAS float* Lh2 = (LAS float*)lds;
        LAS float* Ls = (LAS float*)(lds + 36864);
        const int tid = wid * 64 + lane, tl = tid & 127, p = (tid >> 7) & 1, half = tid >> 8;
#pragma unroll
        for (int ai = 0; ai < 2; ++ai) {
#pragma unroll
            for (int bj = 0; bj < 2; ++bj)
#pragma unroll
                for (int m = 0; m < 4; ++m)
#pragma unroll
                    for (int n = 0; n < 2; ++n) { LAS float* d = Tl + (wr * 64 + m * 16 + fr) * 257 + bj * 128 + wc * 32 + n * 16 + fq * 4; const f32x4 v = acc[ai][bj][m][n]; d[0] = v.x; d[1] = v.y; d[2] = v.z; d[3] = v.w; }
            __syncthreads();
            float run[16];
            {
                const LAS float* src = Tl + tl * 257 + p * 128 + half * 64;
#pragma unroll
                for (int c = 0; c < 4; ++c) { float ch[16];
#pragma unroll
                    for (int q = 0; q < 16; ++q) ch[q] = __uint_as_float((__float_as_uint(src[16 * c + q]) & ~0x7Fu) | (unsigned)(half * 64 + 16 * c + q));
                    tk_sort16(ch);
                    if (c == 0) {
#pragma unroll
                        for (int q = 0; q < 16; ++q) run[q] = ch[q];
                    } else tk_merge16(run, ch); }
            }
            __syncthreads();
#pragma unroll
            for (int q = 0; q < 16; ++q) Lh2[((tl * 2 + p) * 2 + half) * 17 + q] = run[q];
            __syncthreads();
            if (half == 0) { float oth[16];
#pragma unroll
                for (int q = 0; q < 16; ++q) oth[q] = Lh2[((tl * 2 + p) * 2 + 1) * 17 + q];
                tk_merge16(run, oth);
#pragma unroll
                for (int q = 0; q < 16; ++q) Ls[(tl * 2 + p) * 17 + q] = run[q]; }
            __syncthreads();
            if (tid < 128) tk_stage2(Ls + (tl * 2) * 17, Ls + (tl * 2) * 17 + 17, IDX, GATEW, (size_t)(u.pm * 256 + ai * 128 + tl) * 128 + u.pn * 16);
            __syncthreads();
        }
    }
};
struct OneUnit {
    pg8::Unit u;
    __device__ __forceinline__ bool next(int i, pg8::Unit& o) const { if (i) return false; o = u; return true; }
    __device__ __forceinline__ void a_ready(const pg8::Unit&) const {}
    __device__ __forceinline__ void done(const pg8::Unit&) const {}
};

DI float gelu_erf(float x) { return 0.5f * x * (1.f + erff(x * 0.7071067811865476f)); }
#define DPP_ADD(v, ctrl, rmask) ((v) + __builtin_bit_cast(float, __builtin_amdgcn_update_dpp(0, __builtin_bit_cast(int, (v)), (ctrl), (rmask), 0xF, false)))
#ifndef PEER_EBL
#define PEER_EBL 9
#endif
constexpr int PEER_EB_LOG = PEER_EBL;
#ifndef PEER_PROBE_MASK
#define PEER_PROBE_MASK 0xFFFF
#endif
typedef float f32x2v __attribute__((ext_vector_type(2)));
DI float gelu_cdf(float v) {
    const float av = fabsf(v), t = __builtin_amdgcn_rcpf(av * 0.2316418882f + 1.0f);
    float q = t * 0.5307027145f - 0.7265760135f; q = q * t + 0.7107068705f; q = q * t - 0.142248368f; q = q * t + 0.127414796f; q = q * t;
    const float m = v * (q * ex2(v * v * -0.72134752044f));
    return v < 0.f ? m : v - m;
}
#define DPP_ADDI(v, ctrl, rmask) ((v) + __builtin_amdgcn_update_dpp(0, (v), (ctrl), (rmask), 0xF, false))
DI void peer_phase(const Frame& F, bool scratch_dst) {
    bf16* const XN_ = WSP(bf16, WS_XN); int* const IDX_ = WSP(int, WS_IDX); float* const GATEW_ = WSP(float, WS_GATE); float* const mod_ = WSP(float, WS_MOD); float* const out_ = (float*)inp(I_OUT);
    const unsigned char* const EU8 = WSP(unsigned char, WS_EXPU); const unsigned char* const EV8 = WSP(unsigned char, WS_EXPV); const float* const SUI_ = WSP(float, WS_SUI); const float* const SVI_ = WSP(float, WS_SVI);
    const int gw = F.vcu * NWAVES + F.wave, NGW = F.G * NWAVES, lane = F.lane, g = lane >> 3, j = lane & 7;
    LAS unsigned char* wl = F.lds + F.wave * 16384;
    volatile LAS int* Le = (volatile LAS int*)(wl + g * 512); volatile LAS float* Lg = (volatile LAS float*)(wl + 4096 + g * 512); volatile LAS int* Lp = (volatile LAS int*)(wl + 8192 + g * 512);
    LAS int* Lh = (LAS int*)(wl + 12288 + g * 128);
    for (int grp = gw; grp < T / 8; grp += NGW) {
        const size_t t = (size_t)grp * 8 + g;
        int xi[32]; float sxi;
        {
            float mx = 0.f; v4u xr[8];
#pragma unroll
            for (int hq = 0; hq < 8; ++hq) { const bf16* xp = XN_ + t * D + 128 * hq + 16 * j; const v4u a = *(const GAS v4u*)xp, b = *(const GAS v4u*)(xp + 8);
                xr[hq] = a;
#pragma unroll
                for (int e = 0; e < 4; ++e) mx = fmaxf(mx, fmaxf(fmaxf(fabsf(bflo(a[e])), fabsf(bfhi(a[e]))), fmaxf(fabsf(bflo(b[e])), fabsf(bfhi(b[e]))))); }
            mx = fmaxf(mx, __shfl_xor(mx, 1, 8)); mx = fmaxf(mx, __shfl_xor(mx, 2, 8)); mx = fmaxf(mx, __shfl_xor(mx, 4, 8));
            const float sx = mx > 0.f ? 127.f / mx : 0.f; sxi = mx > 0.f ? mx / 127.f : 0.f;
#pragma unroll
            for (int hq = 0; hq < 8; ++hq) { const bf16* xp = XN_ + t * D + 128 * hq + 16 * j; const v4u a = xr[hq], b = *(const GAS v4u*)(xp + 8);
#pragma unroll
                for (int e = 0; e < 2; ++e) {
                    const int q0 = (int)rintf(bflo(a[2 * e]) * sx), q1 = (int)rintf(bfhi(a[2 * e]) * sx), q2 = (int)rintf(bflo(a[2 * e + 1]) * sx), q3 = (int)rintf(bfhi(a[2 * e + 1]) * sx);
                    xi[4 * hq + e] = (int)((unsigned)(q0 & 0xff) | ((unsigned)(q1 & 0xff) << 8) | ((unsigned)(q2 & 0xff) << 16) | ((unsigned)q3 << 24));
                    const int p0 = (int)rintf(bflo(b[2 * e]) * sx), p1 = (int)rintf(bfhi(b[2 * e]) * sx), p2 = (int)rintf(bflo(b[2 * e + 1]) * sx), p3 = (int)rintf(bfhi(b[2 * e + 1]) * sx);
                    xi[4 * hq + 2 + e] = (int)((unsigned)(p0 & 0xff) | ((unsigned)(p1 & 0xff) << 8) | ((unsigned)(p2 & 0xff) << 16) | ((unsigned)p3 << 24)); } }
        }
        {
            int ide[16]; float gte[16]; int rk[16];
#pragma unroll
            for (int m = 0; m < 16; ++m) { ide[m] = IDX_[t * 128 + j + 8 * m]; gte[m] = GATEW_[t * 128 + j + 8 * m]; }
#pragma unroll
            for (int m = 0; m < 4; ++m) Lh[j + 8 * m] = 0;
#pragma unroll
            for (int m = 0; m < 16; ++m) rk[m] = __hip_atomic_fetch_add(Lh + (ide[m] >> PEER_EB_LOG), 1, __ATOMIC_RELAXED, __HIP_MEMORY_SCOPE_WORKGROUP);
            {
                const int h0 = ((volatile LAS int*)Lh)[4 * j], h1 = ((volatile LAS int*)Lh)[4 * j + 1], h2 = ((volatile LAS int*)Lh)[4 * j + 2], h3 = ((volatile LAS int*)Lh)[4 * j + 3];
                const int tot = (h0 + h1) + (h2 + h3); int inc = tot;
#pragma unroll
                for (int o = 1; o < 8; o <<= 1) { const int tt = __shfl_up(inc, o, 8); if (j >= o) inc += tt; }
                const int ex = inc - tot;
                ((volatile LAS int*)Lh)[4 * j] = ex; ((volatile LAS int*)Lh)[4 * j + 1] = ex + h0; ((volatile LAS int*)Lh)[4 * j + 2] = ex + h0 + h1; ((volatile LAS int*)Lh)[4 * j + 3] = ex + h0 + h1 + h2;
            }
#pragma unroll
            for (int m = 0; m < 16; ++m) { const int pos = ((volatile LAS int*)Lh)[ide[m] >> PEER_EB_LOG] + rk[m]; Le[pos] = ide[m]; Lg[pos] = gte[m]; }
        }
        v4u R0[4], R1[4], R2[4], R3[4];
#define PEER_ROFF(S0, H) ((size_t)(Le[(S0)] & (scratch_dst ? PEER_PROBE_MASK : 0xFFFF)) * 1024 + 512 * (H) + 16 * j)
#define PEER_LOADT(TAB, RR, S0, H) do { const size_t ro_ = PEER_ROFF(S0, H); _Pragma("unroll") for (int q = 0; q < 4; ++q) RR[q] = *(const GAS v4u*)((TAB) + ro_ + 128 * q); } while (0)
#define PEER_DOTI(RR, H, EOUT) do { int d0_ = 0, d1_ = 0, d2_ = 0, d3_ = 0; \
            _Pragma("unroll") for (int w_ = 0; w_ < 4; ++w_) { d0_ = __builtin_amdgcn_sdot4((int)RR[0][w_], xi[16 * (H) + w_], d0_, false); d1_ = __builtin_amdgcn_sdot4((int)RR[1][w_], xi[16 * (H) + 4 + w_], d1_, false); \
                d2_ = __builtin_amdgcn_sdot4((int)RR[2][w_], xi[16 * (H) + 8 + w_], d2_, false); d3_ = __builtin_amdgcn_sdot4((int)RR[3][w_], xi[16 * (H) + 12 + w_], d3_, false); } \
            int e_ = (d0_ + d1_) + (d2_ + d3_); e_ = DPP_ADDI(e_, 0xB1, 0xF); e_ = DPP_ADDI(e_, 0x4E, 0xF); e_ = DPP_ADDI(e_, 0x141, 0xF); EOUT = e_; } while (0)
#define PEER_SWEEP(TAB, H, BODY0, BODY1, BODY2, BODY3) do { \
            PEER_LOADT(TAB, R0, 0, H); PEER_LOADT(TAB, R1, 1, H); PEER_LOADT(TAB, R2, 2, H); PEER_LOADT(TAB, R3, 3, H); \
            for (int s = 0; s < 128; s += 4) { \
                BODY0; if (s + 4 < 128) PEER_LOADT(TAB, R0, s + 4, H); \
                BODY1; if (s + 4 < 128) PEER_LOADT(TAB, R1, s + 5, H); \
                BODY2; if (s + 4 < 128) PEER_LOADT(TAB, R2, s + 6, H); \
                BODY3; if (s + 4 < 128) PEER_LOADT(TAB, R3, s + 7, H); } } while (0)
        { int e0_;
          PEER_SWEEP(EU8, 0, ({ PEER_DOTI(R0, 0, e0_); Lp[s] = e0_; }), ({ PEER_DOTI(R1, 0, e0_); Lp[s + 1] = e0_; }), ({ PEER_DOTI(R2, 0, e0_); Lp[s + 2] = e0_; }), ({ PEER_DOTI(R3, 0, e0_); Lp[s + 3] = e0_; })); }
        float cmax = 0.f;
#define PEER_FIN(RR, SS) do { int e1_; PEER_DOTI(RR, 1, e1_); const int ex_ = Le[(SS)] & 0xFFFF; const float cf__ = Lg[(SS)] * SVI_[ex_] * gelu_cdf((float)(e1_ + Lp[(SS)]) * (SUI_[ex_] * sxi)); \
            Lg[(SS)] = cf__; cmax = fmaxf(cmax, fabsf(cf__)); } while (0)
        PEER_SWEEP(EU8, 1, PEER_FIN(R0, s), PEER_FIN(R1, s + 1), PEER_FIN(R2, s + 2), PEER_FIN(R3, s + 3));
#undef PEER_FIN
        const float cqs = cmax > 0.f ? 127.f / cmax : 0.f, yscale = cmax > 0.f ? cmax / 127.f : 0.f;
        {
            int pk_[4];
#pragma unroll
            for (int m = 0; m < 4; ++m) { const int d_ = 4 * j + m;
                const int q0 = (int)rintf(Lg[4 * d_] * cqs), q1 = (int)rintf(Lg[4 * d_ + 1] * cqs), q2 = (int)rintf(Lg[4 * d_ + 2] * cqs), q3 = (int)rintf(Lg[4 * d_ + 3] * cqs);
                pk_[m] = (int)((unsigned)(q0 & 0xff) | ((unsigned)(q1 & 0xff) << 8) | ((unsigned)(q2 & 0xff) << 16) | ((unsigned)q3 << 24)); }
#pragma unroll
            for (int m = 0; m < 4; ++m) Lp[4 * j + m] = pk_[m];
        }
#pragma unroll
        for (int H = 0; H < 2; ++H) {
            int yi[64];
#pragma unroll
            for (int i = 0; i < 64; ++i) yi[i] = 0;
            PEER_LOADT(EV8, R0, 0, H); PEER_LOADT(EV8, R1, 1, H); PEER_LOADT(EV8, R2, 2, H); PEER_LOADT(EV8, R3, 3, H);
            for (int bt = 0; bt < 32; ++bt) {
                const int cq_ = Lp[bt];
                size_t ro0_ = 0, ro1_ = 0, ro2_ = 0, ro3_ = 0;
                if (bt + 1 < 32) { ro0_ = PEER_ROFF(4 * bt + 4, H); ro1_ = PEER_ROFF(4 * bt + 5, H); ro2_ = PEER_ROFF(4 * bt + 6, H); ro3_ = PEER_ROFF(4 * bt + 7, H); }
#pragma unroll
                for (int q = 0; q < 4; ++q) {
#pragma unroll
                    for (int w_ = 0; w_ < 4; ++w_) { const unsigned a0 = R0[q][w_], a1 = R1[q][w_], a2 = R2[q][w_], a3 = R3[q][w_];
                        const unsigned p0 = __builtin_amdgcn_perm(a1, a0, 0x05010400u), p1 = __builtin_amdgcn_perm(a1, a0, 0x07030602u), p2 = __builtin_amdgcn_perm(a3, a2, 0x05010400u), p3 = __builtin_amdgcn_perm(a3, a2, 0x07030602u);
                        yi[16 * q + 4 * w_ + 0] = __builtin_amdgcn_sdot4((int)__builtin_amdgcn_perm(p2, p0, 0x05040100u), cq_, yi[16 * q + 4 * w_ + 0], false);
                        yi[16 * q + 4 * w_ + 1] = __builtin_amdgcn_sdot4((int)__builtin_amdgcn_perm(p2, p0, 0x07060302u), cq_, yi[16 * q + 4 * w_ + 1], false);
                        yi[16 * q + 4 * w_ + 2] = __builtin_amdgcn_sdot4((int)__builtin_amdgcn_perm(p3, p1, 0x05040100u), cq_, yi[16 * q + 4 * w_ + 2], false);
                        yi[16 * q + 4 * w_ + 3] = __builtin_amdgcn_sdot4((int)__builtin_amdgcn_perm(p3, p1, 0x07060302u), cq_, yi[16 * q + 4 * w_ + 3], false); }
                    if (bt + 1 < 32) { R0[q] = *(const GAS v4u*)(EV8 + ro0_ + 128 * q); R1[q] = *(const GAS v4u*)(EV8 + ro1_ + 128 * q); R2[q] = *(const GAS v4u*)(EV8 + ro2_ + 128 * q); R3[q] = *(const GAS v4u*)(EV8 + ro3_ + 128 * q); }
                }
            }
            const int b = (int)(t / SEQ);
            const float* g2 = mod_ + b * NMOD + 5120 + 512 * H + 16 * j;
            const float* ip = out_ + t * D + 512 * H + 16 * j; float* op = (scratch_dst ? WSP(float, WS_SCORES) : out_) + t * D + 512 * H + 16 * j;
#pragma unroll
            for (int q = 0; q < 4; ++q)
#pragma unroll
                for (int c4 = 0; c4 < 4; ++c4) { const f32x4 x1 = *(const GAS f32x4*)(ip + 128 * q + 4 * c4); const f32x4 gg = *(const f32x4*)(g2 + 128 * q + 4 * c4) * yscale;
                    f32x4 o; o.x = x1.x + gg.x * (float)yi[16 * q + 4 * c4]; o.y = x1.y + gg.y * (float)yi[16 * q + 4 * c4 + 1]; o.z = x1.z + gg.z * (float)yi[16 * q + 4 * c4 + 2]; o.w = x1.w + gg.w * (float)yi[16 * q + 4 * c4 + 3];
                    *(GAS f32x4*)(op + 128 * q + 4 * c4) = o; }
        }
#undef PEER_ROFF
#undef PEER_LOADT
#undef PEER_DOTI
#undef PEER_SWEEP
    }
}

DI void ph_inproj(const Frame& F) {
    pg8::Gemm g{WSP(bf16, WS_XN), WSP(bf16, WS_WIN), T, NPROJ, D}; pg8::StaticOrder S; S.init(T, NPROJ, F.G, (int)blockIdx.x);
    pg8::EpiBf16<0> E{WSP(bf16, WS_PROJ), NPROJ, nullptr, 0, 0, 1.f};
    pg8::gemm_phase<pg8::EpiBf16<0>, pg8::StaticOrder, PG8_ALIGN, PG8_SP2>(F.lds, g, S, E);
}
DI void ph_mix(const Frame& F, bool probe_first) {
    stage_conv_w(F);
    {
        int u = F.vcu;
        MlLocalRegs ra;
        if (u < 2048) ml_local_load(F, u >> 6, u & 63, ra);
        const int gwv = F.vcu * NWAVES + F.wave, NGWv = F.G * NWAVES;
        int eb = 2 * gwv;
        while (u < 2048) {
            const int un = u + F.G;
            MlLocalRegs rb;
            if (un < 2048) ml_local_load(F, un >> 6, un & 63, rb);
            ExpRows2 er; const bool ew = eb < 32768;
            if (ew) exp_load2(F, eb, er);
            ml_local_unit(F, u >> 6, u & 63, ra);
            if (ew) exp_conv2(F, eb, er);
            eb += 2 * NGWv;
            ra = rb; u = un;
        }
        for (; eb < 32768; eb += 2 * NGWv) { ExpRows2 er; exp_load2(F, eb, er); exp_conv2(F, eb, er); }
    }
    (void)probe_first;
}
DI void ph_scan_attn(const Frame& F) {
    ml_scan_phase(F);
    __syncthreads();
    for (int u = F.vcu; u < 1024; u += F.G) { const int qb = 15 - (u >> 6), bh = u & 63; sb_unit(F, bh >> 3, bh & 7, qb); }
}
DI void ph_mlout(const Frame& F) { stage_conv_w(F); for (int u = F.vcu; u < 2048; u += F.G) ml_out_unit(F, u >> 6, u & 63); }
#ifndef P5_ALIGN
#define P5_ALIGN PG8_ALIGN
#endif
DI void ph_outproj(const Frame& F) {
    pg8::Gemm g{WSP(bf16, WS_MIX), WSP(bf16, WS_WOUT), T, D, D}; pg8::StaticOrder S; S.init(T, D, F.G, (int)blockIdx.x);
    pg8::EpiResGate E{inp(I_X), (float*)inp(I_OUT), WSP(float, WS_MOD) + 2048, NMOD, SEQ, D};
    pg8::gemm_phase<pg8::EpiResGate, pg8::StaticOrder, P5_ALIGN, PG8_SP2>(F.lds, g, S, E);
}
DI void ph_scores(const Frame& F) {
    pg8::Gemm g{WSP(bf16, WS_XN), WSP(bf16, WS_WEFF), T, NSC, D}; pg8::StaticOrder S; S.init(T, NSC, F.G, (int)blockIdx.x);
    EpiTopK E{WSP(int, WS_IDX), WSP(float, WS_GATE)};
    pg8::Unit un;
    for (int i = 0; S.next(i, un); ++i) { OneUnit S1{un}; pg8::gemm_phase<EpiTopK, OneUnit, false, PG8_SP2>(F.lds, g, S1, E); }
}
constexpr int N_PHASES = 11;
struct Args { const float* in[19]; float* out; unsigned char* ws; int ph_lo, ph_hi; };
__global__ void __launch_bounds__(NTHR, 2) hybrid_fwd(Args args) {
    extern __shared__ __attribute__((aligned(16))) unsigned char lds_raw[];
    Frame F;
    F.lds = (LAS unsigned char*)lds_raw;
    F.MISC = (volatile LAS unsigned*)(F.lds + LDSCTL_OFF + 320);
    F.tid = threadIdx.x; F.lane = F.tid & 63; F.wave = __builtin_amdgcn_readfirstlane(F.tid >> 6);
    F.G = gridDim.x; { const int bx = blockIdx.x; F.vcu = (F.G % 8 == 0) ? (bx % 8) * (F.G / 8) + bx / 8 : bx; }
    F.ws = args.ws;
    F.ctl = (gu32*)(F.ws + WS_CTL);
    for (int u = F.tid; u < (LDS_BYTES - LDSCTL_OFF) / 4; u += NTHR) ((LAS unsigned*)(F.lds + LDSCTL_OFF))[u] = 0u;
    __syncthreads();
    const int lo = args.ph_lo, hi = args.ph_hi;
    const bool one_launch = (hi - lo) > 1;
    XcdBarrier bar; bar.bar = (unsigned*)(F.ctl + CW_BAR); bar.x = 0; bar.st = nullptr;
    if (one_launch) bar = xcd_barrier_post((unsigned*)(F.ctl + CW_BAR), F.MISC + 8);
#ifndef PHMASK
#define PHMASK 0x7ff
#endif
#define IN(k) (((PHMASK >> (k)) & 1) && lo <= (k) && (k) < hi)
#define SEAM(k) do { if (IN(k) && IN((k) + 1)) xcd_barrier(bar); } while (0)
#ifndef REPMASK
#define REPMASK 0
#endif

#define RUN(k, ...) do { if (IN(k)) { if ((REPMASK >> (k)) & 1) { { const bool first = true; (void)first; __VA_ARGS__; } xcd_barrier(bar); } { const bool first = false; (void)first; __VA_ARGS__; } } } while (0)
    RUN(0, p0_phase(F, first ? P0_PARTS : 15)); SEAM(0);
    RUN(1, norm_phase<true>(F, inp(I_X), inp(I_GN1), 0, 1024)); SEAM(1);
    RUN(2, ph_inproj(F)); SEAM(2);
    RUN(3, ph_mix(F, first)); SEAM(3);
    RUN(10, ph_scan_attn(F)); if (IN(10) && IN(4)) xcd_barrier(bar);
    RUN(4, ph_mlout(F)); SEAM(4);
    RUN(5, ph_outproj(F)); SEAM(5);
    RUN(6, norm_phase<false>(F, inp(I_OUT), inp(I_GN2), 3072, 4096)); SEAM(6);
    RUN(7, ph_scores(F)); if (IN(7) && IN(9)) xcd_barrier(bar);
    RUN(9, peer_phase(F, first));
#undef RUN
#undef IN
#undef SEAM
}

#ifndef MK_PER_PHASE
#define MK_PER_PHASE 0
#endif
extern "C" void kernel_launch(void* const* d_in, const int* in_sizes, int n_in, void* d_out, int out_size, void* d_ws, size_t ws_size, hipStream_t stream) {
    static int grid = 0;
    if (grid == 0) {
        if (n_in != 19 || in_sizes[0] != T * D || out_size != T * D || ws_size < WS_END) { fprintf(stderr, "kernel_launch: unexpected shapes (n_in %d, in0 %d, out %d, ws %zu)\n", n_in, n_in > 0 ? in_sizes[0] : -1, out_size, ws_size); grid = -1; return; }
        int dev = 0, cus = 0, per_cu = 0;
        if (hipGetDevice(&dev) != hipSuccess || hipDeviceGetAttribute(&cus, hipDeviceAttributeMultiprocessorCount, dev) != hipSuccess) { grid = -1; return; }
        if (hipFuncSetAttribute((const void*)hybrid_fwd, hipFuncAttributeMaxDynamicSharedMemorySize, LDS_BYTES) != hipSuccess) { fprintf(stderr, "kernel_launch: hipFuncSetAttribute failed\n"); grid = -1; return; }
        if (hipOccupancyMaxActiveBlocksPerMultiprocessor(&per_cu, (const void*)hybrid_fwd, NTHR, LDS_BYTES) != hipSuccess || per_cu < 1) fprintf(stderr, "kernel_launch: occupancy query says %d\n", per_cu);
        (void)hipGetLastError();
        grid = cus;
    }
    if (grid < 0) return;
    if (hipMemsetAsync((char*)d_ws + WS_CTL, 0, CTL_ZERO_BYTES, stream) != hipSuccess) { fprintf(stderr, "kernel_launch: memset failed\n"); return; }
    Args a{};
    for (int i = 0; i < 19; ++i) a.in[i] = (const float*)d_in[i];
    a.out = (float*)d_out; a.ws = (unsigned char*)d_ws;
#if MK_PER_PHASE
    { const int order[N_PHASES] = {0, 1, 2, 3, 10, 4, 5, 6, 7, 8, 9}; for (int i = 0; i < N_PHASES; ++i) { a.ph_lo = order[i]; a.ph_hi = order[i] + 1; hipLaunchKernelGGL(hybrid_fwd, dim3(grid), dim3(NTHR), LDS_BYTES, stream, a); } }
#else
    a.ph_lo = 0; a.ph_hi = N_PHASES;
    hipLaunchKernelGGL(hybrid_fwd, dim3(grid), dim3(NTHR), LDS_BYTES, stream, a);
#endif
    const hipError_t le = hipPeekAtLastError();
    if (le != hipSuccess) fprintf(stderr, "kernel_launch: launch failed: %s\n", hipGetErrorName(le));
}
```

```cpp
#include <cmath>
#include <hip/hip_runtime.h>
#include <cstdio>
#include <cstdint>
namespace pg8 {
#define PG8_LAS __attribute__((address_space(3)))
typedef unsigned short bf16_t;
typedef short bf16x8 __attribute__((ext_vector_type(8)));
typedef float f32x4 __attribute__((ext_vector_type(4)));
typedef unsigned u32x4 __attribute__((ext_vector_type(4)));
constexpr int BM = 256, BK = 64, HALF = 128, HTB = HALF * BK * 2  , STAGE_BYTES = 8 * HTB, NXCD = 8,
#ifndef PG8_WGM
#define PG8_WGM 4
#endif
WGM = PG8_WGM;

__host__ __device__ __forceinline__ int lds_byte(int r, int c) { const int st = (r >> 4) * 2 + (c >> 5), rr = r & 15, cc = c & 31, ob = rr * 64 + cc * 2; return st * 1024 + (ob ^ (((ob >> 9) & 1) << 5)); }
__host__ __device__ __forceinline__ void stage_rc(int b, int& R, int& C) { const int st = b / 1024, sb = b % 1024, swz = sb ^ (((sb >> 9) & 1) << 5); R = (st >> 1) * 16 + swz / 64; C = (st & 1) * 32 + (swz % 64) / 2; }
__host__ __device__ __forceinline__ int perm32(int rho) { const int n = rho >> 4, i = rho & 15; return 8 * (i >> 2) + 4 * n + (i & 3); }

struct Unit { int pm, pn; };
struct Gemm { const bf16_t* A; const bf16_t* Bt; int M, N, K; };

struct StaticOrder {
    int nM, nN, nwg, G, c;
    __host__ __device__ void init(int M, int N, int G_, int c_) { nM = M / BM; nN = N / BM; nwg = nM * nN; G = G_; c = c_; }
    __host__ __device__ bool next(int i, Unit& u) const {
        const long L = (long)i * G + c; if (L >= nwg) return false;
        int wgid = (int)L; { const int q = nwg / NXCD, r = nwg % NXCD, xcd = wgid % NXCD, off = wgid / NXCD; wgid = (xcd < r ? xcd * (q + 1) : r * (q + 1) + (xcd - r) * q) + off; }
        const int nig = WGM * nN, gid = wgid / nig, fm = gid * WGM, gsz = (nM - fm) < WGM ? (nM - fm) : WGM;
        u.pm = fm + ((wgid % nig) % gsz); u.pn = (wgid % nig) / gsz; return true;
    }
    __device__ __forceinline__ void a_ready(const Unit&) const {}
    __device__ __forceinline__ void done(const Unit&) const {}
};

__device__ __forceinline__ unsigned cvt_pk_bf16(float lo, float hi) { unsigned r; asm volatile("v_cvt_pk_bf16_f32 %0, %1, %2" : "=v"(r) : "v"(lo), "v"(hi)); return r; }
typedef float f32x2 __attribute__((ext_vector_type(2)));
__device__ __forceinline__ f32x2 gelu_pk(f32x2 v) {
    const f32x2 av = __builtin_elementwise_abs(v), d = av * 0.2316418882f + 1.0f;
    f32x2 t; t.x = __builtin_amdgcn_rcpf(d.x); t.y = __builtin_amdgcn_rcpf(d.y);
    f32x2 q = t * 0.5307027145f + (-0.7265760135f); q = q * t + 0.7107068705f; q = q * t + (-0.142248368f); q = q * t + 0.127414796f; q = q * t;
    const f32x2 s = (v * v) * (-0.72134752044f);
    f32x2 e; e.x = __builtin_amdgcn_exp2f(s.x); e.y = __builtin_amdgcn_exp2f(s.y);
    const f32x2 m = v * (q * e), r = v - m;
    f32x2 o; o.x = v.x < 0.f ? m.x : r.x; o.y = v.y < 0.f ? m.y : r.y; return o;
}

template <int ACT  > struct EpiBf16 {
    static constexpr bool PERM = true, AFTER_DRAIN = false; static_assert(ACT == 0 || ACT == 1, "EpiBf16: ACT is 0 (none) or 1 (gelu_pk)");
    bf16_t* O; int ldc; const float* bias; int split_cols; size_t split_stride; float scale0;
    __device__ __forceinline__ void operator()(const f32x4 (&acc)[2][2][4][2], const Unit& u, int wr, int wc, int fr, int fq) const {
        const int row0 = u.pm * BM + wr * 64 + fr; int colt = u.pn * BM; bf16_t* base = O;
        float sc = 1.f; if (split_cols) { const int t = colt / split_cols; base += (size_t)t * split_stride; colt -= t * split_cols; if (t == 0) sc = scale0; }
        const int col0 = colt + wc * 32 + 8 * fq, bcol0 = u.pn * BM + wc * 32 + 8 * fq;
        f32x4 bv[2][2];
#pragma unroll
        for (int bj = 0; bj < 2; ++bj)
#pragma unroll
            for (int n = 0; n < 2; ++n) bv[bj][n] = bias ? *(const f32x4*)(bias + bcol0 + bj * HALF + 4 * n) : (f32x4){0.f, 0.f, 0.f, 0.f};
#pragma unroll
        for (int ai = 0; ai < 2; ++ai)
#pragma unroll
            for (int m = 0; m < 4; ++m) { bf16_t* rowp = base + (size_t)(row0 + ai * HALF + m * 16) * ldc + col0;
#pragma unroll
                for (int bj = 0; bj < 2; ++bj) { f32x4 v0 = acc[ai][bj][m][0] + bv[bj][0], v1 = acc[ai][bj][m][1] + bv[bj][1];
                    if (ACT == 1) { f32x2 a = gelu_pk((f32x2){v0[0], v0[1]}), b = gelu_pk((f32x2){v0[2], v0[3]}), c = gelu_pk((f32x2){v1[0], v1[1]}), d = gelu_pk((f32x2){v1[2], v1[3]});
                        v0 = (f32x4){a.x, a.y, b.x, b.y}; v1 = (f32x4){c.x, c.y, d.x, d.y}; }
                    v0 = v0 * sc; v1 = v1 * sc; u32x4 w; w.x = cvt_pk_bf16(v0[0], v0[1]); w.y = cvt_pk_bf16(v0[2], v0[3]); w.z = cvt_pk_bf16(v1[0], v1[1]); w.w = cvt_pk_bf16(v1[2], v1[3]);
                    *(u32x4*)(rowp + bj * HALF) = w; } }
    }
};
template <class Epi, class Sched, bool ALIGN_EPI = false, bool SP2 = false>
__device__ __forceinline__ void gemm_phase(PG8_LAS unsigned char* lds, const Gemm g, const Sched& S, const Epi& E) {
    const int tid = threadIdx.x, wid = __builtin_amdgcn_readfirstlane(tid >> 6), lane = tid & 63, wr = wid >> 2, wc = wid & 3, fr = lane & 15, fq = lane >> 4;
    const int K = g.K, nt = K / BK;
    unsigned voffA[2], voffB[2];
#pragma unroll
    for (int i = 0; i < 2; ++i) { int R, C; stage_rc(tid * 16 + i * 8192, R, C); const int Rb = Epi::PERM ? ((R & ~31) + perm32(R & 31)) : R;
        voffA[i] = (unsigned)(R * K + C) * 2u; voffB[i] = (unsigned)(Rb * K + C) * 2u; }
    const size_t kstep = (size_t)(BK * 2);
    const size_t hstep = (size_t)HALF * K * 2;
    const size_t tstep = 2 * hstep;
    const unsigned ldsw = (unsigned)wid * 1024u;
    const int aoff = lds_byte(wr * 64 + fr, fq * 8), boff = lds_byte(wc * 32 + fr, fq * 8);
#define PG8_SA(b, h) (((b) * 2 + (h)) * HTB)
#define PG8_SB(b, h) ((4 + (b) * 2 + (h)) * HTB)
#define PG8_STAGE(bufoff, gbase, voff) do { _Pragma("unroll") for (int _i = 0; _i < 2; ++_i) \
        __builtin_amdgcn_global_load_lds((const unsigned*)((const char*)(gbase) + (voff)[_i]), (PG8_LAS unsigned*)(lds + (bufoff) + ldsw + _i * 8192), 16, 0, 0); } while (0)
#define PG8_LDA(dst, b, h) do { _Pragma("unroll") for (int m = 0; m < 4; ++m) _Pragma("unroll") for (int k = 0; k < 2; ++k) dst[m][k] = *(const PG8_LAS bf16x8*)(lds + PG8_SA(b, h) + aoff + m * 2048 + k * 1024); } while (0)
#define PG8_LDB(dst, b, h) do { _Pragma("unroll") for (int n = 0; n < 2; ++n) _Pragma("unroll") for (int k = 0; k < 2; ++k) dst[n][k] = *(const PG8_LAS bf16x8*)(lds + PG8_SB(b, h) + boff + n * 2048 + k * 1024); } while (0)
#define PG8_MMA(ai, bj, At, Bt) do { __builtin_amdgcn_s_setprio(1); _Pragma("unroll") for (int m = 0; m < 4; ++m) _Pragma("unroll") for (int n = 0; n < 2; ++n) _Pragma("unroll") for (int k = 0; k < 2; ++k) \
        acc[ai][bj][m][n] = __builtin_amdgcn_mfma_f32_16x16x32_bf16(Bt[n][k], At[m][k], acc[ai][bj][m][n], 0, 0, 0); __builtin_amdgcn_s_setprio(0); } while (0)
#define PG8_WAIT_V(n) asm volatile("s_waitcnt vmcnt(" #n ")" ::: "memory")
#define PG8_WAIT_L(n) asm volatile("s_waitcnt lgkmcnt(" #n ")" ::: "memory")
#define PG8_BAR __builtin_amdgcn_s_barrier()
#define PG8_SCHED __builtin_amdgcn_sched_barrier(0)
    Unit cur, nxt; int ui = 0;
    if (!S.next(0, cur)) return;
    f32x4 acc[2][2][4][2];
#pragma unroll
    for (int a = 0; a < 2; ++a)
#pragma unroll
        for (int b = 0; b < 2; ++b)
#pragma unroll
            for (int m = 0; m < 4; ++m)
#pragma unroll
                for (int n = 0; n < 2; ++n) acc[a][b][m][n] = (f32x4){0.f, 0.f, 0.f, 0.f};
    bf16x8 At[4][2], B0[2][2], B1[2][2];
    const char* cA = (const char*)g.A + (size_t)cur.pm * tstep; const char* cB = (const char*)g.Bt + (size_t)cur.pn * tstep;
    S.a_ready(cur);
    if constexpr (SP2) {
        PG8_STAGE(PG8_SB(0, 0), cB, voffB); PG8_STAGE(PG8_SB(0, 1), cB + hstep, voffB); PG8_STAGE(PG8_SA(0, 0), cA, voffA); PG8_STAGE(PG8_SA(0, 1), cA + hstep, voffA);
        if (wr == 1) PG8_BAR;
        PG8_WAIT_V(2); PG8_BAR;
        PG8_STAGE(PG8_SB(1, 0), cB + kstep, voffB); PG8_STAGE(PG8_SA(1, 0), cA + kstep, voffA); PG8_STAGE(PG8_SB(1, 1), cB + hstep + kstep, voffB);
        PG8_WAIT_V(6); PG8_BAR;
    } else {
        PG8_STAGE(PG8_SB(0, 0), cB, voffB); PG8_STAGE(PG8_SA(0, 0), cA, voffA); PG8_STAGE(PG8_SB(0, 1), cB + hstep, voffB); PG8_STAGE(PG8_SA(0, 1), cA + hstep, voffA);
        if (wr == 1) PG8_BAR;
        PG8_WAIT_V(4); PG8_BAR;
        PG8_STAGE(PG8_SB(1, 0), cB + kstep, voffB); PG8_STAGE(PG8_SA(1, 0), cA + kstep, voffA); PG8_STAGE(PG8_SB(1, 1), cB + hstep + kstep, voffB);
        PG8_WAIT_V(6); PG8_BAR;
    }
    for (;;) {
        const bool has_next = S.next(ui + 1, nxt);
        const char* nA = has_next ? (const char*)g.A + (size_t)nxt.pm * tstep : cA; const char* nB = has_next ? (const char*)g.Bt + (size_t)nxt.pn * tstep : cB;
        for (int t = 0; t < nt; t += 2) {
            const bool last = (t == nt - 2);
            const char* a1 = cA + (size_t)(t + 1) * kstep;
            const char* a2 = last ? nA : cA + (size_t)(t + 2) * kstep; const char* b2 = last ? nB : cB + (size_t)(t + 2) * kstep;
            const char* a3 = a2 + kstep; const char* b3 = b2 + kstep;
            if (last && has_next) S.a_ready(nxt);
            if constexpr (SP2) {
            PG8_LDB(B0, 0, 0); PG8_LDB(B1, 0, 1); PG8_SCHED; PG8_LDA(At, 0, 0); PG8_STAGE(PG8_SA(1, 1), a1 + hstep, voffA);
            PG8_WAIT_V(8); PG8_WAIT_L(0); PG8_BAR; PG8_MMA(0, 0, At, B0); PG8_MMA(0, 1, At, B1); PG8_BAR; PG8_SCHED;
            PG8_LDA(At, 0, 1); PG8_STAGE(PG8_SB(0, 0), b2, voffB); PG8_STAGE(PG8_SB(0, 1), b2 + hstep, voffB); PG8_STAGE(PG8_SA(0, 0), a2, voffA);
            PG8_WAIT_V(8); PG8_WAIT_L(0); PG8_BAR; PG8_MMA(1, 0, At, B0); PG8_MMA(1, 1, At, B1); PG8_BAR; PG8_SCHED;
            PG8_LDB(B0, 1, 0); PG8_LDB(B1, 1, 1); PG8_SCHED; PG8_LDA(At, 1, 0); PG8_STAGE(PG8_SA(0, 1), a2 + hstep, voffA);
            PG8_WAIT_V(8); PG8_WAIT_L(0); PG8_BAR; PG8_MMA(0, 0, At, B0); PG8_MMA(0, 1, At, B1); PG8_BAR; PG8_SCHED;
            PG8_LDA(At, 1, 1); PG8_STAGE(PG8_SB(1, 0), b3, voffB); PG8_STAGE(PG8_SB(1, 1), b3 + hstep, voffB); PG8_STAGE(PG8_SA(1, 0), a3, voffA);
            PG8_WAIT_V(8); PG8_WAIT_L(0); PG8_BAR; PG8_MMA(1, 0, At, B0); PG8_MMA(1, 1, At, B1); PG8_BAR; PG8_SCHED;
            } else {
            PG8_LDB(B0, 0, 0); PG8_SCHED; PG8_LDA(At, 0, 0); PG8_STAGE(PG8_SA(1, 1), a1 + hstep, voffA);
            PG8_WAIT_L(8); PG8_BAR; PG8_WAIT_L(0); PG8_MMA(0, 0, At, B0); PG8_BAR; PG8_SCHED;
            PG8_LDB(B1, 0, 1); PG8_STAGE(PG8_SB(0, 0), b2, voffB);
            PG8_BAR; PG8_WAIT_L(0); PG8_MMA(0, 1, At, B1); PG8_BAR;
            PG8_LDA(At, 0, 1); PG8_STAGE(PG8_SA(0, 0), a2, voffA);
            PG8_BAR; PG8_WAIT_L(0); PG8_MMA(1, 0, At, B0); PG8_BAR; PG8_SCHED;
            PG8_STAGE(PG8_SB(0, 1), b2 + hstep, voffB);
            PG8_WAIT_V(6); PG8_BAR; PG8_MMA(1, 1, At, B1); PG8_BAR;
            PG8_LDB(B0, 1, 0); PG8_SCHED; PG8_LDA(At, 1, 0); PG8_STAGE(PG8_SA(0, 1), a2 + hstep, voffA);
            PG8_WAIT_L(8); PG8_BAR; PG8_WAIT_L(0); PG8_MMA(0, 0, At, B0); PG8_BAR; PG8_SCHED;
            PG8_LDB(B1, 1, 1); PG8_STAGE(PG8_SB(1, 0), b3, voffB);
            PG8_BAR; PG8_WAIT_L(0); PG8_MMA(0, 1, At, B1); PG8_BAR;
            PG8_LDA(At, 1, 1); PG8_STAGE(PG8_SA(1, 0), a3, voffA);
            PG8_BAR; PG8_WAIT_L(0); PG8_MMA(1, 0, At, B0); PG8_BAR; PG8_SCHED;
            PG8_STAGE(PG8_SB(1, 1), b3 + hstep, voffB);
            PG8_WAIT_V(6); PG8_BAR; PG8_MMA(1, 1, At, B1); PG8_BAR;
            }
        }
        if constexpr (ALIGN_EPI) { if (wr == 0) PG8_BAR; }
        if constexpr (!Epi::AFTER_DRAIN) { E(acc, cur, wr, wc, fr, fq); S.done(cur); }
        if (!has_next) break;
#pragma unroll
        for (int a = 0; a < 2; ++a)
#pragma unroll
            for (int b = 0; b < 2; ++b)
#pragma unroll
                for (int m = 0; m < 4; ++m)
#pragma unroll
                    for (int n = 0; n < 2; ++n) acc[a][b][m][n] = (f32x4){0.f, 0.f, 0.f, 0.f};
        cur = nxt; cA = nA; cB = nB; ++ui;
        if constexpr (ALIGN_EPI) { if (wr == 1) PG8_BAR; }
    }
    PG8_WAIT_V(0);
    if constexpr (!ALIGN_EPI) { if (wr == 0) PG8_BAR; }
    PG8_BAR;
    if constexpr (Epi::AFTER_DRAIN) { E.fused(acc, cur, wr, wc, fr, fq, lds, wid, lane); S.done(cur); }
#undef PG8_SA
#undef PG8_SB
#undef PG8_STAGE
#undef PG8_LDA
#undef PG8_LDB
#undef PG8_MMA
#undef PG8_WAIT_V
#undef PG8_WAIT_L
#undef PG8_BAR
#undef PG8_SCHED
}
}

#ifndef PG8_SP2
#define PG8_SP2 true
#endif
#ifndef PG8_ALIGN
#define PG8_ALIGN true
#endif

namespace pg8 {
struct EpiResGate {
    static constexpr bool PERM = false, AFTER_DRAIN = false;
    const float* base; float* out; const float* gate; int gate_ld; int rows_per_batch; int ldc;
    __device__ __forceinline__ void operator()(const f32x4 (&acc)[2][2][4][2], const Unit& u, int wr, int wc, int fr, int fq) const {
        const int row0 = u.pm * BM + wr * 64 + fr, col0 = u.pn * BM + wc * 32 + 4 * fq;
        const float* gp = gate + (size_t)((u.pm * BM) / rows_per_batch) * gate_ld + col0;
        f32x4 gv[2][2];
#pragma unroll
        for (int bj = 0; bj < 2; ++bj)
#pragma unroll
            for (int n = 0; n < 2; ++n) gv[bj][n] = *(const f32x4*)(gp + bj * HALF + n * 16);
#pragma unroll
        for (int ai = 0; ai < 2; ++ai)
#pragma unroll
            for (int m = 0; m < 4; ++m) { const size_t off = (size_t)(row0 + ai * HALF + m * 16) * ldc + col0;
#pragma unroll
                for (int bj = 0; bj < 2; ++bj)
#pragma unroll
                    for (int n = 0; n < 2; ++n) { const f32x4 bs = *(const f32x4*)(base + off + bj * HALF + n * 16);
                        *(f32x4*)(out + off + bj * HALF + n * 16) = bs + gv[bj][n] * acc[ai][bj][m][n]; } }
    }
};
struct EpiF32 {
    static constexpr bool PERM = false, AFTER_DRAIN = false;
    float* O; int ldc;
    __device__ __forceinline__ void operator()(const f32x4 (&acc)[2][2][4][2], const Unit& u, int wr, int wc, int fr, int fq) const {
        const int row0 = u.pm * BM + wr * 64 + fr, col0 = u.pn * BM + wc * 32 + 4 * fq;
#pragma unroll
        for (int ai = 0; ai < 2; ++ai)
#pragma unroll
            for (int m = 0; m < 4; ++m) { const size_t off = (size_t)(row0 + ai * HALF + m * 16) * ldc + col0;
#pragma unroll
                for (int bj = 0; bj < 2; ++bj)
#pragma unroll
                    for (int n = 0; n < 2; ++n) *(f32x4*)(O + off + bj * HALF + n * 16) = acc[ai][bj][m][n]; }
    }
};
}
#define GAS __attribute__((address_space(1)))
#define LAS __attribute__((address_space(3)))
typedef unsigned short bf16;
typedef unsigned v4u __attribute__((ext_vector_type(4)));
typedef float f32x4 __attribute__((ext_vector_type(4)));
typedef short bf16x8 __attribute__((ext_vector_type(8)));
typedef GAS unsigned gu32;
typedef GAS unsigned long long gu64;
#define RLX_AGENT __ATOMIC_RELAXED, __HIP_MEMORY_SCOPE_AGENT
#define LDS_WAIT() asm volatile("s_waitcnt lgkmcnt(0)" ::: "memory")
#define VM_WAIT() asm volatile("s_waitcnt vmcnt(0)" ::: "memory")
__device__ __forceinline__ unsigned long long rt() { return __builtin_amdgcn_s_memrealtime(); }
__device__ __forceinline__ unsigned f2bf(float f) { unsigned u = __builtin_bit_cast(unsigned, f); return (u + 0x7fffu + ((u >> 16) & 1u)) >> 16; }
__device__ __forceinline__ unsigned pk2(float lo, float hi) { return f2bf(lo) | (f2bf(hi) << 16); }

#define XB_TMO      128
#define XB_XCNT(j)  (256  + 64 * (j))
#define XB_XSUB(j)  (1280 + 64 * (j))
#define XB_XGEN(j)  (2304 + 64 * (j))
#define XB_TOP      3328
#define XB_TOPGEN   3392
#define XCD_BAR_WORDS 3456
#define XB_SPIN_CAP (1u << 24)

__device__ __forceinline__ unsigned xb_ld(unsigned* p)              { return __hip_atomic_load(p, __ATOMIC_RELAXED, __HIP_MEMORY_SCOPE_AGENT); }
__device__ __forceinline__ unsigned xb_add(unsigned* p, unsigned v) { return __hip_atomic_fetch_add(p, v, __ATOMIC_RELAXED, __HIP_MEMORY_SCOPE_AGENT); }
__device__ __forceinline__ unsigned xb_xcc_id() { return (unsigned)__builtin_amdgcn_s_getreg((3 << 11) | 20) & 0xFu; }
#define XB_SPIN(cond, bar) do { unsigned _sp = 0; while (cond) { __builtin_amdgcn_s_sleep(1); \
    if ((++_sp & 255u) == 0u) { if (xb_ld(&(bar)[XB_TMO])) break; if (_sp > XB_SPIN_CAP) { atomicAdd(&(bar)[XB_TMO], 1u); break; } } } } while (0)

struct XcdBarrier {
    unsigned* bar; unsigned x;
    volatile LAS unsigned* st;
};

__device__ __forceinline__ XcdBarrier xcd_barrier_post(unsigned* bar, volatile LAS unsigned* st) {
    XcdBarrier b; b.bar = bar; b.x = xb_xcc_id(); b.st = st;
    if (threadIdx.x == 0) (void)xb_add(&bar[XB_XCNT(b.x)], 1u);
    return b;
}
__device__ __forceinline__ void xcd_barrier_complete(unsigned* bar, unsigned x, unsigned& nloc, unsigned& nx) {
    const unsigned G = gridDim.x * gridDim.y * gridDim.z;
    unsigned sum, cnt, mine, sp = 0u;
    for (;;) {
        sum = 0u; cnt = 0u; mine = 0u;
#pragma unroll
        for (unsigned j = 0; j < 16; ++j) { const unsigned c = xb_ld(&bar[XB_XCNT(j)]); sum += c; cnt += (c > 0u) ? 1u : 0u; mine = (j == x) ? c : mine; }
        if (sum == G) break;
        __builtin_amdgcn_s_sleep(1);
        if ((++sp & 255u) == 0u) { if (xb_ld(&bar[XB_TMO])) break; if (sp > XB_SPIN_CAP) { atomicAdd(&bar[XB_TMO], 1u); break; } }
    }
    nloc = mine > 0u ? mine : 1u; nx = cnt > 0u ? cnt : 1u;
}

__device__ __forceinline__ void xcd_barrier(const XcdBarrier& b) {
    asm volatile("s_waitcnt vmcnt(0)" ::: "memory");
    __syncthreads();
    if (threadIdx.x == 0) {
        unsigned* bar = b.bar;
        __builtin_amdgcn_s_waitcnt(0);
        unsigned nloc = b.st[0], nx = b.st[1];
        if (nloc == 0u) { xcd_barrier_complete(bar, b.x, nloc, nx); b.st[0] = nloc; b.st[1] = nx; }
        const unsigned old = xb_add(&bar[XB_XSUB(b.x)], 1u);
        const unsigned gen = old / nloc;
        if (old + 1u == (gen + 1u) * nloc) {
            __builtin_amdgcn_fence(__ATOMIC_RELEASE, "agent");
            asm volatile("s_waitcnt vmcnt(0)" ::: "memory");
            const unsigned og = xb_add(&bar[XB_TOP], 1u);
            const unsigned tg = og / nx;
            if (og + 1u == (tg + 1u) * nx) xb_add(&bar[XB_TOPGEN], 1u);
            else XB_SPIN(xb_ld(&bar[XB_TOPGEN]) == tg, bar);
            __builtin_amdgcn_fence(__ATOMIC_ACQUIRE, "agent");
            xb_add(&bar[XB_XGEN(b.x)], 1u);
            asm volatile("s_waitcnt vmcnt(0)" ::: "memory");
        } else {
            XB_SPIN(xb_ld(&bar[XB_XGEN(b.x)]) == gen, bar);
            __builtin_amdgcn_fence(__ATOMIC_ACQUIRE, "agent");
            asm volatile("s_waitcnt vmcnt(0)" ::: "memory");
        }
    }
    __syncthreads();
}

constexpr int NWAVES = 8, NTHR = 512;
constexpr int NB = 8, SEQ = 4096, T = NB * SEQ, D = 1024, NPROJ = 3584, NIN = 3592, NMOD = 6144, NSC = 2048;
constexpr int C_QSB = 0, C_KSB = 512, C_VSB = 1024, C_QML = 1536, C_KML = 2048, C_VML = 2560, C_OML = 3072;
constexpr float EPS = 1e-6f, LOG2E = 1.4426950408889634f;
constexpr size_t MiB = 1u << 20;
constexpr size_t WS_CTL = 0, CTL_ZERO_BYTES = 1 * MiB;
constexpr size_t WS_MOD = 256 * 1024;
constexpr size_t WS_WIN = 2 * MiB, WS_WOUT = 10 * MiB, WS_WEFF = 12 * MiB;
constexpr size_t WS_XN = 16 * MiB;
constexpr size_t WS_PROJ = 80 * MiB;
constexpr size_t WS_MIX = 304 * MiB;
constexpr size_t WS_EXPU = 368 * MiB, WS_EXPV = 400 * MiB;
constexpr size_t WS_CST = 432 * MiB;
constexpr size_t WS_NST = 496 * MiB;
constexpr size_t WS_MST = 497 * MiB;
constexpr size_t WS_GATES = 498 * MiB;
constexpr size_t WS_SCORES = 80 * MiB;
constexpr size_t WS_IDX = 336 * MiB, WS_GATE = 352 * MiB;
constexpr size_t WS_SCL = 499 * MiB;
constexpr size_t WS_SUI = 499 * MiB + 65536, WS_SVI = 499 * MiB + 131072;
constexpr size_t WS_END = 500 * MiB;
constexpr int CW_Q3 = 64;
constexpr int CW_BAR = 4096;
constexpr int LDS_BYTES = 147456, LDSCTL_OFF = 143360;

typedef float f32x16 __attribute__((ext_vector_type(16)));
typedef float f32x2_t __attribute__((ext_vector_type(2)));
typedef __bf16 bf16x2_t __attribute__((ext_vector_type(2)));
typedef _Float16 f16x8 __attribute__((ext_vector_type(8)));
typedef short s16x4 __attribute__((ext_vector_type(4)));
typedef unsigned u32x2 __attribute__((ext_vector_type(2)));
#define DI __device__ __forceinline__
DI unsigned cvtpk(float lo, float hi) { f32x2_t v = {lo, hi}; bf16x2_t b = __builtin_convertvector(v, bf16x2_t); return __builtin_bit_cast(unsigned, b); }
DI float bflo(unsigned u) { return __uint_as_float(u << 16); }
DI float bfhi(unsigned u) { return __uint_as_float(u & 0xffff0000u); }
DI int crow(int i, int hi) { return (i & 3) + 8 * (i >> 2) + 4 * hi; }
DI int krow(int s, int hi, int j) { return 16 * s + 8 * (j >> 2) + 4 * hi + (j & 3); }
DI float swap_add(float v) { auto rr = __builtin_amdgcn_permlane32_swap(__float_as_uint(v), __float_as_uint(v), false, false); return __uint_as_float(rr[0]) + __uint_as_float(rr[1]); }
DI float swap_max(float v) { auto rr = __builtin_amdgcn_permlane32_swap(__float_as_uint(v), __float_as_uint(v), false, false); return fmaxf(__uint_as_float(rr[0]), __uint_as_float(rr[1])); }
DI float dot2bf(unsigned a, unsigned b, float acc) { return __builtin_amdgcn_fdot2_f32_bf16(__builtin_bit_cast(bf16x2_t, a), __builtin_bit_cast(bf16x2_t, b), acc, false); }
DI float ex2(float x) { return __builtin_amdgcn_exp2f(x); }
DI float lg2(float x) { return __builtin_amdgcn_logf(x); }
DI float fexp(float x) { return __builtin_amdgcn_exp2f(x * LOG2E); }
DI float wave_sum(float v) {
#pragma unroll
    for (int o = 1; o < 64; o <<= 1) v += __shfl_xor(v, o);
    return v;
}
DI float wave_max(float v) {
#pragma unroll
    for (int o = 1; o < 64; o <<= 1) v = fmaxf(v, __shfl_xor(v, o));
    return v;
}
#define DPP_MAXF(v, ctrl, rmask) fmaxf((v), __builtin_bit_cast(float, __builtin_amdgcn_update_dpp(0, __builtin_bit_cast(int, (v)), (ctrl), (rmask), 0xF, false)))
DI float wave_max_nonneg(float v) {
    v = DPP_MAXF(v, 0xB1, 0xF); v = DPP_MAXF(v, 0x4E, 0xF); v = DPP_MAXF(v, 0x141, 0xF); v = DPP_MAXF(v, 0x140, 0xF); v = DPP_MAXF(v, 0x142, 0xA); v = DPP_MAXF(v, 0x143, 0xC);
    return __builtin_bit_cast(float, __builtin_amdgcn_readlane(__builtin_bit_cast(int, v), 63));
}
#define DPP_ADDF(v, ctrl, rmask) ((v) + __builtin_bit_cast(float, __builtin_amdgcn_update_dpp(0, __builtin_bit_cast(int, (v)), (ctrl), (rmask), 0xF, false)))
DI float wave_sum_u(float v) {
    v = DPP_ADDF(v, 0xB1, 0xF); v = DPP_ADDF(v, 0x4E, 0xF); v = DPP_ADDF(v, 0x141, 0xF); v = DPP_ADDF(v, 0x140, 0xF); v = DPP_ADDF(v, 0x142, 0xA); v = DPP_ADDF(v, 0x143, 0xC);
    return __builtin_bit_cast(float, __builtin_amdgcn_readlane(__builtin_bit_cast(int, v), 63));
}
typedef short v4i16_t __attribute__((ext_vector_type(4)));
DI s16x4 trrd(LAS unsigned char* p) { return __builtin_bit_cast(s16x4, __builtin_amdgcn_ds_read_tr16_b64_v4i16((LAS v4i16_t*)p)); }
DI bf16x8 cat8(s16x4 a, s16x4 b) { return (bf16x8){a[0], a[1], a[2], a[3], b[0], b[1], b[2], b[3]}; }
#define MFMA_BF16(a, b, c) __builtin_amdgcn_mfma_f32_32x32x16_bf16((a), (b), (c), 0, 0, 0)
#define MFMA_F16(a, b, c) __builtin_amdgcn_mfma_f32_32x32x16_f16((a), (b), (c), 0, 0, 0)
DI unsigned pkh(float a, float b) { return __builtin_bit_cast(unsigned, __builtin_amdgcn_cvt_pkrtz(a, b)); }
DI bf16x8 packbf(const f32x16& x, int s) { v4u p; p.x = cvtpk(x[8 * s], x[8 * s + 1]); p.y = cvtpk(x[8 * s + 2], x[8 * s + 3]); p.z = cvtpk(x[8 * s + 4], x[8 * s + 5]); p.w = cvtpk(x[8 * s + 6], x[8 * s + 7]); return __builtin_bit_cast(bf16x8, p); }
DI f16x8 packh(const f32x16& x, int s) { v4u p; p.x = pkh(x[8 * s], x[8 * s + 1]); p.y = pkh(x[8 * s + 2], x[8 * s + 3]); p.z = pkh(x[8 * s + 4], x[8 * s + 5]); p.w = pkh(x[8 * s + 6], x[8 * s + 7]); return __builtin_bit_cast(f16x8, p); }

struct Frame {
    LAS unsigned char* lds;
    volatile LAS unsigned* MISC;
    gu32* ctl;
    unsigned char* ws;
    int tid, lane, wave, vcu, G;
};
DI const float* inp(int i) { const __attribute__((address_space(4))) unsigned long long* kp = (const __attribute__((address_space(4))) unsigned long long*)__builtin_amdgcn_kernarg_segment_ptr(); return (const float*)(const GAS float*)(*(volatile const __attribute__((address_space(4))) unsigned long long*)(kp + i)); }
enum { I_X = 0, I_C, I_WADA, I_BADA, I_GN1, I_WIN, I_BIG, I_BFG, I_CONVW, I_GQ, I_GK, I_GOSB, I_GOML, I_WOUT, I_GN2, I_WQ, I_SK, I_EU, I_EV, I_OUT };
#define WSP(type, off) ((type*)(F.ws + (off)))

DI void p0_transpose_item(const float* W, int K, int N, int ld, bf16* WT, LAS float* scr, int item, int lane) {
    const int nblk = N / 32, kb = item / nblk, nb = item % nblk, k0 = 64 * kb, n0 = 32 * nb;
    float tv[32];
#pragma unroll
    for (int i = 0; i < 32; ++i) tv[i] = W[(size_t)(k0 + 2 * i + (lane >> 5)) * ld + n0 + (lane & 31)];
#pragma unroll
    for (int i = 0; i < 32; ++i) scr[(2 * i + (lane >> 5)) * 33 + (lane & 31)] = tv[i];
    LDS_WAIT(); asm volatile("" ::: "memory");
    const int c = lane & 7;
#pragma unroll
    for (int j = 0; j < 4; ++j) { const int n = (lane >> 3) + 8 * j; const LAS float* s = scr + (8 * c) * 33 + n;
        v4u o; o.x = pk2(s[0 * 33], s[1 * 33]); o.y = pk2(s[2 * 33], s[3 * 33]); o.z = pk2(s[4 * 33], s[5 * 33]); o.w = pk2(s[6 * 33], s[7 * 33]);
        *(GAS v4u*)(WT + (size_t)(n0 + n) * K + k0 + 8 * c) = o; }
    LDS_WAIT(); asm volatile("" ::: "memory");
}
DI void p0_mod_block(const Frame& F, int item) {
    const float* const c_ = inp(I_C); const float* const w_ada_ = inp(I_WADA); const float* const b_ada_ = inp(I_BADA); float* const mod_ = WSP(float, WS_MOD);
    LAS float* scr = (LAS float*)(F.lds + F.wave * 16384);
    const int j = item * 64 + F.lane, d0 = F.wave * 128;
#pragma unroll
    for (int b = 0; b < 8; ++b)
#pragma unroll
        for (int q = 0; q < 2; ++q) { const float cv = c_[b * D + d0 + 64 * q + F.lane]; scr[b * 128 + 64 * q + F.lane] = cv / (1.f + fexp(-cv)); }
    LDS_WAIT(); asm volatile("" ::: "memory");
    float acc[8];
#pragma unroll
    for (int b = 0; b < 8; ++b) acc[b] = 0.f;
#pragma unroll 32
    for (int dd = 0; dd < 128; ++dd) { const float w = w_ada_[(size_t)(d0 + dd) * NMOD + j];
#pragma unroll
        for (int b = 0; b < 8; ++b) acc[b] += scr[b * 128 + dd] * w; }
#pragma unroll
    for (int b = 0; b < 8; ++b) scr[1024 + b * 64 + F.lane] = acc[b];
    __syncthreads();
    float tot = b_ada_[j];
#pragma unroll
    for (int w = 0; w < 8; ++w) tot += ((LAS float*)(F.lds + w * 16384))[1024 + F.wave * 64 + F.lane];
    mod_[F.wave * NMOD + j] = tot;
    __syncthreads();
}
DI void p0_weff_item(const Frame& F, int item) {
    const float* const sub_keys_ = inp(I_SK); const float* const w_q_peer_ = inp(I_WQ); bf16* const Weff_t_ = WSP(bf16, WS_WEFF);
    const int hp = item >> 4, dblk = item & 15;
    LAS float* sk = (LAS float*)F.lds;
    LAS float* rb = (LAS float*)(F.lds + 67584) + F.wave * 1024;
    { float tv[32];
#pragma unroll
      for (int i = 0; i < 32; ++i) tv[i] = sub_keys_[(size_t)hp * 16384 + F.tid + 512 * i];
#pragma unroll
      for (int i = 0; i < 32; ++i) { const int idx = F.tid + 512 * i; sk[(idx >> 7) * 129 + (idx & 127)] = tv[i]; } }
    const int d0 = 64 * dblk + 8 * F.wave;
#pragma unroll
    for (int r = 0; r < 8; ++r) { rb[r * 128 + F.lane] = w_q_peer_[(size_t)(d0 + r) * NSC + hp * 128 + F.lane]; rb[r * 128 + 64 + F.lane] = w_q_peer_[(size_t)(d0 + r) * NSC + hp * 128 + 64 + F.lane]; }
    __syncthreads();
    float a0[8], a1[8];
#pragma unroll
    for (int r = 0; r < 8; ++r) { a0[r] = 0.f; a1[r] = 0.f; }
#pragma unroll 4
    for (int c = 0; c < 128; ++c) { const float s0 = sk[F.lane * 129 + c], s1 = sk[(F.lane + 64) * 129 + c];
#pragma unroll
        for (int r = 0; r < 8; ++r) { const float a = rb[r * 128 + c]; a0[r] += a * s0; a1[r] += a * s1; } }
    v4u o0, o1; o0.x = pk2(a0[0], a0[1]); o0.y = pk2(a0[2], a0[3]); o0.z = pk2(a0[4], a0[5]); o0.w = pk2(a0[6], a0[7]);
    o1.x = pk2(a1[0], a1[1]); o1.y = pk2(a1[2], a1[3]); o1.z = pk2(a1[4], a1[5]); o1.w = pk2(a1[6], a1[7]);
    *(GAS v4u*)(Weff_t_ + (size_t)(hp * 128 + F.lane) * D + d0) = o0;
    *(GAS v4u*)(Weff_t_ + (size_t)(hp * 128 + 64 + F.lane) * D + d0) = o1;
    __syncthreads();
}
struct ExpRows2 { f32x4 v[2][4]; };
DI void exp_load2(const Frame& F, int blk0, ExpRows2& R) {
    const float* const expert_u_ = inp(I_EU); const float* const expert_v_ = inp(I_EV);
#pragma unroll
    for (int bb = 0; bb < 2; ++bb) { const int blk = blk0 + bb; const float* src = (blk < 16384 ? expert_u_ : expert_v_) + (size_t)(blk & 16383) * 1024 + 4 * F.lane;
#pragma unroll
        for (int k = 0; k < 4; ++k) R.v[bb][k] = *(const GAS f32x4*)(src + 256 * k); }
}
DI void exp_conv2(const Frame& F, int blk0, const ExpRows2& R) {
    float* const SUI_ = WSP(float, WS_SUI); float* const SVI_ = WSP(float, WS_SVI);
#pragma unroll
    for (int bb = 0; bb < 2; ++bb) { const int blk = blk0 + bb; const bool isu = blk < 16384; const int e = blk & 16383;
        float mx = 0.f;
#pragma unroll
        for (int k = 0; k < 4; ++k) mx = fmaxf(mx, fmaxf(fmaxf(fabsf(R.v[bb][k].x), fabsf(R.v[bb][k].y)), fmaxf(fabsf(R.v[bb][k].z), fabsf(R.v[bb][k].w))));
        mx = wave_max_nonneg(mx);
        const float top = 127.f, sc = mx > 0.f ? top / mx : 0.f;
        if (F.lane == 0) (isu ? SUI_ : SVI_)[e] = mx > 0.f ? mx / top : 0.f;
        unsigned char* dst = (isu ? WSP(unsigned char, WS_EXPU) : WSP(unsigned char, WS_EXPV)) + (size_t)e * 1024 + 4 * F.lane;
#pragma unroll
        for (int k = 0; k < 4; ++k) { const f32x4 a = R.v[bb][k] * sc;
            const int q0 = (int)rintf(a.x), q1 = (int)rintf(a.y), q2 = (int)rintf(a.z), q3 = (int)rintf(a.w); const unsigned w = (unsigned)(q0 & 0xff) | ((unsigned)(q1 & 0xff) << 8) | ((unsigned)(q2 & 0xff) << 16) | ((unsigned)q3 << 24);
            *(GAS unsigned*)(dst + 256 * k) = w; } }
}
#ifndef P0_PARTS
#define P0_PARTS 15
#endif
DI void p0_phase(const Frame& F, int parts = 15) {
    const float* const w_in_ = inp(I_WIN); bf16* const Win_t_ = WSP(bf16, WS_WIN); const float* const w_out_ = inp(I_WOUT); bf16* const Wout_t_ = WSP(bf16, WS_WOUT); const float* const expert_v_ = inp(I_EV); const float* const expert_u_ = inp(I_EU);
    LAS float* scr = (LAS float*)(F.lds + F.wave * 16384);
    const int gw = F.vcu * NWAVES + F.wave, NGW = F.G * NWAVES;
    if (parts & 1) for (int it = F.vcu; it < 96; it += F.G) p0_mod_block(F, it);
    constexpr int I_WIN = 16 * 112, I_WOUT = 16 * 32, NITEMS = I_WIN + I_WOUT;
    if (parts & 2) for (int it = gw; it < NITEMS; it += NGW) {
        int r = it;
        if (r < I_WIN) { p0_transpose_item(w_in_, D, NPROJ, NIN, Win_t_, scr, r, F.lane); continue; } r -= I_WIN;
        p0_transpose_item(w_out_, D, D, D, Wout_t_, scr, r, F.lane);
    }
    __syncthreads();
    if (parts & 8) for (int it = F.vcu; it < 256; it += F.G) p0_weff_item(F, it);
}

template <bool DOGATES>
DI void norm_phase(const Frame& F, const float* src, const float* g, int shift_off, int scale_off) {
    const float* const w_in_ = inp(I_WIN); float* const mod_ = WSP(float, WS_MOD); bf16* const XN_ = WSP(bf16, WS_XN); float* const GATES_ = WSP(float, WS_GATES); const float* const b_igate_ = inp(I_BIG); const float* const b_fgate_ = inp(I_BFG);
    LAS float* W8 = (LAS float*)F.lds;
    if (DOGATES) {
        for (int i = 0; i < 16; ++i) { const int idx = F.tid + 512 * i; W8[idx] = w_in_[(size_t)(idx & 1023) * NIN + NPROJ + (idx >> 10)]; }
        __syncthreads();
    }
    const int gw = F.vcu * NWAVES + F.wave, NGW = F.G * NWAVES;
    for (int ch = gw; ch < T / 16; ch += NGW) {
        const int r0 = ch * 16, b = r0 / SEQ;
        f32x4 A[4], Bv[4];
#pragma unroll
        for (int j = 0; j < 4; ++j) { const int col = 4 * F.lane + 256 * j; const f32x4 gg = *(const f32x4*)(g + col), sc = *(const f32x4*)(mod_ + b * NMOD + scale_off + col);
            A[j] = gg * (sc + 1.0f); Bv[j] = *(const f32x4*)(mod_ + b * NMOD + shift_off + col); }
        f32x4 nx[4];
        { const GAS f32x4* xr0 = (const GAS f32x4*)(src + (size_t)r0 * D) + F.lane;
#pragma unroll
          for (int j = 0; j < 4; ++j) nx[j] = xr0[64 * j]; }
        for (int rr = 0; rr < 16; ++rr) {
            const int row = r0 + rr;
            f32x4 v[4]; float s = 0.f;
#pragma unroll
            for (int j = 0; j < 4; ++j) { v[j] = nx[j]; s += (v[j].x * v[j].x + v[j].y * v[j].y) + (v[j].z * v[j].z + v[j].w * v[j].w); }
            if (rr + 1 < 16) { const GAS f32x4* xr = (const GAS f32x4*)(src + (size_t)(row + 1) * D) + F.lane;
#pragma unroll
                for (int j = 0; j < 4; ++j) nx[j] = xr[64 * j]; }
            const float rstd = 1.f / sqrtf(wave_sum_u(s) * (1.f / D) + EPS);
#pragma unroll
            for (int j = 0; j < 4; ++j) v[j] = v[j] * rstd * A[j] + Bv[j];
            GAS unsigned long long* o8 = (GAS unsigned long long*)(XN_ + (size_t)row * D) + F.lane;
#pragma unroll
            for (int j = 0; j < 4; ++j) o8[64 * j] = (unsigned long long)pk2(v[j].x, v[j].y) | ((unsigned long long)pk2(v[j].z, v[j].w) << 32);
            if (DOGATES) {
                float res = 0.f;
#pragma unroll
                for (int hh = 0; hh < 8; ++hh) { float p = 0.f;
#pragma unroll
                    for (int j = 0; j < 4; ++j) { const f32x4 w = *(const LAS f32x4*)(W8 + hh * 1024 + 4 * F.lane + 256 * j); p += (v[j].x * w.x + v[j].y * w.y) + (v[j].z * w.z + v[j].w * w.w); }
                    p = wave_sum_u(p); if (F.lane == hh) res = p; }
                if (F.lane < 8) GATES_[(size_t)row * 8 + F.lane] = res + (F.lane < 4 ? b_igate_[F.lane] : b_fgate_[F.lane - 4]);
            }
        }
    }
}

DI void sb_unit(const Frame& F, int b, int h, int qb) {
    bf16* const PROJ_ = WSP(bf16, WS_PROJ); const float* const g_q_sb_ = inp(I_GQ); const float* const g_k_sb_ = inp(I_GK); bf16* const MIX_ = WSP(bf16, WS_MIX); const float* const g_out_sb_ = inp(I_GOSB);
    const int lane = F.lane, w = F.wave, r = lane & 31, hi = lane >> 5;
    const int i16 = lane & 15, qq = i16 >> 2, pp = i16 & 3, blk = (lane >> 4) & 1;
    LAS unsigned char* Wb = F.lds + w * 16384;
    const size_t rowbase = (size_t)b * SEQ; const int q0 = qb * 256, qw0 = q0 + 32 * w, tq = qw0 + r;
    const bf16* P = PROJ_;
    const bf16* kpiece[4]; const bf16* vpiece[4];
#pragma unroll
    for (int i = 0; i < 4; ++i) { const int krow_ = 8 * i + (lane >> 3), kch = (lane & 7) ^ ((krow_ >> 1) & 7); kpiece[i] = P + (rowbase + krow_) * NPROJ + C_KSB + h * 64 + 8 * kch;
        const int vkey = 16 * (i & 1) + (lane >> 2); vpiece[i] = P + (rowbase + vkey) * NPROJ + C_VSB + h * 64 + 32 * (i >> 1) + 8 * (lane & 3); }
#define SB_DMA(T_, BUF_) do { _Pragma("unroll") for (int i_ = 0; i_ < 4; ++i_) { \
        __builtin_amdgcn_global_load_lds((const unsigned*)(kpiece[i_] + (size_t)(32 * (T_)) * NPROJ), (LAS unsigned*)(Wb + 8192 * (BUF_) + 1024 * i_), 16, 0, 0); \
        __builtin_amdgcn_global_load_lds((const unsigned*)(vpiece[i_] + (size_t)(32 * (T_)) * NPROJ), (LAS unsigned*)(Wb + 8192 * (BUF_) + 4096 + 1024 * i_), 16, 0, 0); } } while (0)
    const int tw = (qw0 + 30) >> 5;
    SB_DMA(tw, 0);
    bf16x8 qf[4];
    {
        const bf16* Qp = P + (rowbase + tq) * NPROJ + C_QSB + h * 64 + 8 * hi;
        v4u qraw[4]; float ss = 0.f;
#pragma unroll
        for (int kk = 0; kk < 4; ++kk) { qraw[kk] = *(const GAS v4u*)(Qp + 16 * kk);
#pragma unroll
            for (int e = 0; e < 4; ++e) { const float a = bflo(qraw[kk][e]), c = bfhi(qraw[kk][e]); ss += a * a + c * c; } }
        ss = swap_add(ss);
        const float rq = __builtin_amdgcn_rsqf(ss * (1.f / 64.f) + EPS) * (0.125f * LOG2E);
#pragma unroll
        for (int kk = 0; kk < 4; ++kk) { const int d0 = 16 * kk + 8 * hi;
            const f32x4 g0 = *(const f32x4*)(g_q_sb_ + d0) * *(const f32x4*)(g_k_sb_ + d0), g1 = *(const f32x4*)(g_q_sb_ + d0 + 4) * *(const f32x4*)(g_k_sb_ + d0 + 4);
            v4u o; o.x = cvtpk(bflo(qraw[kk].x) * rq * g0.x, bfhi(qraw[kk].x) * rq * g0.y); o.y = cvtpk(bflo(qraw[kk].y) * rq * g0.z, bfhi(qraw[kk].y) * rq * g0.w);
            o.z = cvtpk(bflo(qraw[kk].z) * rq * g1.x, bfhi(qraw[kk].z) * rq * g1.y); o.w = cvtpk(bflo(qraw[kk].w) * rq * g1.z, bfhi(qraw[kk].w) * rq * g1.w);
            qf[kk] = __builtin_bit_cast(bf16x8, o); }
    }
    f16x8 U0, U1, E0;
#pragma unroll
    for (int j = 0; j < 8; ++j) { U0[j] = (krow(0, hi, j) > r) ? (_Float16)1.0f : (_Float16)0.0f; U1[j] = (krow(1, hi, j) > r) ? (_Float16)1.0f : (_Float16)0.0f;
        E0[j] = (j == 0 && hi == 0) ? (_Float16)1.0f : (_Float16)0.0f; }
    f32x16 o0, o1;
#pragma unroll
    for (int i = 0; i < 16; ++i) { o0[i] = 0.f; o1[i] = 0.f; }
    float R = 0.f;
    const int kfoff = r * 128, kfsw = (r >> 1) & 7;
    for (int t = tw; t >= 0; --t) {
        const int buf = (tw - t) & 1;
        LAS unsigned char* Kb = Wb + 8192 * buf; LAS unsigned char* Vb = Kb + 4096;
        asm volatile("s_waitcnt vmcnt(0)" ::: "memory");
        if (t > 0) SB_DMA(t - 1, buf ^ 1);
        bf16x8 kf[4]; float ssk = 0.f;
#pragma unroll
        for (int kk = 0; kk < 4; ++kk) { const v4u kv = *(const LAS v4u*)(Kb + kfoff + (((2 * kk + hi) ^ kfsw) * 16)); kf[kk] = __builtin_bit_cast(bf16x8, kv);
            ssk = dot2bf(kv.x, kv.x, ssk); ssk = dot2bf(kv.y, kv.y, ssk); ssk = dot2bf(kv.z, kv.z, ssk); ssk = dot2bf(kv.w, kv.w, ssk); }
        ssk = swap_add(ssk);
        const float rk = __builtin_amdgcn_rsqf(ssk * (1.f / 64.f) + EPS);
        f16x8 RKA;
#pragma unroll
        for (int e = 0; e < 8; ++e) RKA[e] = (_Float16)0.0f;
        RKA[0] = (hi == 0) ? (_Float16)rk : (_Float16)0.0f;
        f32x16 s, rkd;
#pragma unroll
        for (int i = 0; i < 16; ++i) { s[i] = 0.f; rkd[i] = 0.f; }
        rkd = MFMA_F16(RKA, E0, rkd);
#pragma unroll
        for (int kk = 0; kk < 4; ++kk) s = MFMA_BF16(kf[kk], qf[kk], s);
        float tsum = 0.f; unsigned lp[8];
        if (32 * t + 31 < qw0) {
#pragma unroll
            for (int i = 0; i < 16; i += 2) {
                const float z0_ = s[i] * rkd[i], z1_ = s[i + 1] * rkd[i + 1];
                const float a0_ = -lg2(1.f + ex2(z0_)), a1_ = -lg2(1.f + ex2(z1_));
                tsum += a0_ + a1_;
                s[i] = z0_ + a0_; s[i + 1] = z1_ + a1_;
                lp[i >> 1] = pkh(a0_, a1_); }
        } else {
            const int kq = tq - 32 * t;
#pragma unroll
            for (int i = 0; i < 16; i += 2) {
                const float z0_ = s[i] * rkd[i], z1_ = s[i + 1] * rkd[i + 1];
                float a0_ = -lg2(1.f + ex2(z0_)), a1_ = -lg2(1.f + ex2(z1_));
                const bool ma0 = crow(i, hi) >= kq, ma1 = crow(i + 1, hi) >= kq;
                a0_ = ma0 ? 0.f : a0_; a1_ = ma1 ? 0.f : a1_;
                tsum += a0_ + a1_;
                s[i] = ma0 ? -INFINITY : z0_ + a0_; s[i + 1] = ma1 ? -INFINITY : z1_ + a1_;
                lp[i >> 1] = pkh(a0_, a1_); }
        }
        f32x16 c;
#pragma unroll
        for (int i = 0; i < 16; ++i) c[i] = R;
        c = MFMA_F16(U0, __builtin_bit_cast(f16x8, (v4u){lp[0], lp[1], lp[2], lp[3]}), c); c = MFMA_F16(U1, __builtin_bit_cast(f16x8, (v4u){lp[4], lp[5], lp[6], lp[7]}), c);
#pragma unroll
        for (int i = 0; i < 16; ++i) s[i] = ex2(s[i] + c[i]);
        const bf16x8 W0 = packbf(s, 0), W1 = packbf(s, 1);
        LAS unsigned char* vb_ = Vb + (4 * hi + qq) * 64 + 32 * blk + 8 * pp;
        o0 = MFMA_BF16(cat8(trrd(vb_), trrd(vb_ + 8 * 64)), W0, o0); o0 = MFMA_BF16(cat8(trrd(vb_ + 16 * 64), trrd(vb_ + 24 * 64)), W1, o0);
        o1 = MFMA_BF16(cat8(trrd(vb_ + 2048), trrd(vb_ + 2048 + 8 * 64)), W0, o1); o1 = MFMA_BF16(cat8(trrd(vb_ + 2048 + 16 * 64), trrd(vb_ + 2048 + 24 * 64)), W1, o1);
        R += swap_add(tsum);
        if (__all(R < -150.f)) break;
    }
    asm volatile("s_waitcnt vmcnt(0)" ::: "memory");
#undef SB_DMA
    {
        float ss = 0.f;
#pragma unroll
        for (int i = 0; i < 16; ++i) ss += o0[i] * o0[i] + o1[i] * o1[i];
        ss = swap_add(ss);
        const float ro = __builtin_amdgcn_rsqf(ss * (1.f / 64.f) + EPS);
        bf16* Op = MIX_ + (rowbase + tq) * D + h * 64;
        const float* go = g_out_sb_ + h * 64;
#pragma unroll
        for (int g = 0; g < 4; ++g) { const int d0 = 8 * g + 4 * hi; const f32x4 ga = *(const f32x4*)(go + d0), gb = *(const f32x4*)(go + 32 + d0);
            u32x2 wa, wb; wa.x = cvtpk(o0[4 * g] * ro * ga.x, o0[4 * g + 1] * ro * ga.y); wa.y = cvtpk(o0[4 * g + 2] * ro * ga.z, o0[4 * g + 3] * ro * ga.w);
            wb.x = cvtpk(o1[4 * g] * ro * gb.x, o1[4 * g + 1] * ro * gb.y); wb.y = cvtpk(o1[4 * g + 2] * ro * gb.z, o1[4 * g + 3] * ro * gb.w);
            *(GAS u32x2*)(Op + d0) = wa; *(GAS u32x2*)(Op + 32 + d0) = wb; }
    }
    __syncthreads();
}

DI void conv_silu8(const v4u (&xr)[4], const float (&cw)[4][8], float scale, float (&y)[8]) {
#pragma unroll
    for (int e = 0; e < 8; ++e) y[e] = 0.f;
#pragma unroll
    for (int j = 0; j < 4; ++j) {
        y[0] += cw[j][0] * bflo(xr[j].x); y[1] += cw[j][1] * bfhi(xr[j].x); y[2] += cw[j][2] * bflo(xr[j].y); y[3] += cw[j][3] * bfhi(xr[j].y);
        y[4] += cw[j][4] * bflo(xr[j].z); y[5] += cw[j][5] * bfhi(xr[j].z); y[6] += cw[j][6] * bflo(xr[j].w); y[7] += cw[j][7] * bfhi(xr[j].w); }
#pragma unroll
    for (int e = 0; e < 8; ++e) y[e] = scale * y[e] * __builtin_amdgcn_rcpf(1.f + fexp(-y[e]));
}
DI float log_sigmoid(float x) { return fminf(x, 0.f) - 0.6931471805599453f * lg2(1.f + fexp(-fabsf(x))); }
DI float wave_scan_incl(float a, int lane) {
#pragma unroll
    for (int o = 1; o < 64; o <<= 1) { const float t = __shfl_up(a, o); if (lane >= o) a += t; }
    return a;
}

constexpr int LDS_CW = 65536;
DI void stage_conv_w(const Frame& F) {
    const float* const conv_w_ = inp(I_CONVW); LAS float* cwl = (LAS float*)(F.lds + LDS_CW);
    for (int i = F.tid; i < 4096; i += NTHR) cwl[i] = conv_w_[i];
    __syncthreads();
}
DI void load_cw8(const Frame& F, int colbase, float (&cw)[4][8]) {
    const LAS float* cwl = (const LAS float*)(F.lds + LDS_CW);
#pragma unroll
    for (int j = 0; j < 4; ++j) { const f32x4 a = *(const LAS f32x4*)(cwl + j * 1024 + colbase), b = *(const LAS f32x4*)(cwl + j * 1024 + colbase + 4);
        cw[j][0] = a.x; cw[j][1] = a.y; cw[j][2] = a.z; cw[j][3] = a.w; cw[j][4] = b.x; cw[j][5] = b.y; cw[j][6] = b.z; cw[j][7] = b.w; }
}
struct MlLocalRegs { v4u kraw[2][4]; v4u vraw[2]; float gi, gf; };
DI void ml_local_load(const Frame& F, int chain, int c, MlLocalRegs& R) {
    bf16* const PROJ_ = WSP(bf16, WS_PROJ); float* const GATES_ = WSP(float, WS_GATES);
    const int tid = F.tid, lane = F.lane;
    const int b = chain >> 2, hh = chain & 3; const size_t rowbase = (size_t)b * SEQ; const int t0 = c * 64;
    const bf16* P = PROJ_;
    const int kc = tid & 15, kr0 = tid >> 4;
    const bf16* Kg = P + rowbase * NPROJ + C_KML + hh * 128 + kc * 8;
#pragma unroll
    for (int i = 0; i < 2; ++i)
#pragma unroll
        for (int j = 0; j < 4; ++j) { const int tt = t0 + kr0 + 32 * i - 3 + j; R.kraw[i][j] = (tt >= 0) ? *(const GAS v4u*)(Kg + (size_t)tt * NPROJ) : (v4u){0u, 0u, 0u, 0u}; }
#pragma unroll
    for (int i = 0; i < 2; ++i) R.vraw[i] = *(const GAS v4u*)(P + (rowbase + t0 + kr0 + 32 * i) * NPROJ + C_VML + hh * 128 + kc * 8);
    const float* Gg = GATES_ + (rowbase + t0 + lane) * 8;
    R.gi = Gg[hh]; R.gf = Gg[4 + hh];
}
DI void ml_local_unit(const Frame& F, int chain, int c, const MlLocalRegs& RG) {
    bf16* const CST_ = WSP(bf16, WS_CST); float* const NST_ = WSP(float, WS_NST); float* const SCL_ = WSP(float, WS_SCL);
    LAS unsigned char* L = F.lds;
    LAS float* Lws = (LAS float*)(L + 32768);
    const int tid = F.tid, lane = F.lane, w = F.wave, r = lane & 31, hi = lane >> 5;
    const int i16 = lane & 15, qq = i16 >> 2, pp = i16 & 3, blk = (lane >> 4) & 1;
    const int hh = chain & 3;
    const int kbk = w & 3, vb0 = 2 * (w >> 2);
    const int kc = tid & 15, kr0 = tid >> 4;
    v4u kraw[2][4], vraw[2];
#pragma unroll
    for (int i = 0; i < 2; ++i) { vraw[i] = RG.vraw[i];
#pragma unroll
        for (int j = 0; j < 4; ++j) kraw[i][j] = RG.kraw[i][j]; }
    const float gi = RG.gi, gf = RG.gf;
    const float a = wave_scan_incl(log_sigmoid(gf), lane);
    const float a_end = __shfl(a, 63);
    const float lw = a_end - a + gi;
    const float m_loc = wave_max(lw);
    const float ws = fexp(lw - m_loc);
    if (w == 0) Lws[lane] = ws;
    {
        float cw[4][8]; load_cw8(F, 512 + hh * 128 + kc * 8, cw);
#pragma unroll
        for (int i = 0; i < 2; ++i) { float y[8]; conv_silu8(kraw[i], cw, 0.08838834764831845f, y);
            v4u o; o.x = cvtpk(y[0], y[1]); o.y = cvtpk(y[2], y[3]); o.z = cvtpk(y[4], y[5]); o.w = cvtpk(y[6], y[7]);
            *(LAS v4u*)(L + (kc >> 2) * 4096 + (kr0 + 32 * i) * 64 + (kc & 3) * 16) = o; }
#pragma unroll
        for (int i = 0; i < 2; ++i) { const int row = kr0 + 32 * i; const float wsr = __shfl(ws, row);
            v4u o; o.x = cvtpk(bflo(vraw[i].x) * wsr, bfhi(vraw[i].x) * wsr); o.y = cvtpk(bflo(vraw[i].y) * wsr, bfhi(vraw[i].y) * wsr); o.z = cvtpk(bflo(vraw[i].z) * wsr, bfhi(vraw[i].z) * wsr); o.w = cvtpk(bflo(vraw[i].w) * wsr, bfhi(vraw[i].w) * wsr);
            *(LAS v4u*)(L + 16384 + (kc >> 2) * 4096 + row * 64 + (kc & 3) * 16) = o; }
    }
    __syncthreads();
    f32x16 acc0, acc1;
#pragma unroll
    for (int i = 0; i < 16; ++i) { acc0[i] = 0.f; acc1[i] = 0.f; }
#pragma unroll
    for (int kk = 0; kk < 4; ++kk) { const int rows = 16 * kk + 8 * hi + qq;
        LAS unsigned char* ka = L + kbk * 4096 + rows * 64 + 32 * blk + 8 * pp; LAS unsigned char* va = L + 16384 + vb0 * 4096 + rows * 64 + 32 * blk + 8 * pp;
        const bf16x8 A = cat8(trrd(ka), trrd(ka + 4 * 64));
        acc0 = MFMA_BF16(A, cat8(trrd(va), trrd(va + 4 * 64)), acc0); acc1 = MFMA_BF16(A, cat8(trrd(va + 4096), trrd(va + 4096 + 4 * 64)), acc1); }
    {
        bf16* Cp = CST_ + ((size_t)(chain * 64 + c) * 128 + vb0 * 32 + r) * 128 + kbk * 32 + 4 * hi;
#pragma unroll
        for (int g = 0; g < 4; ++g) { u32x2 o; o.x = cvtpk(acc0[4 * g], acc0[4 * g + 1]); o.y = cvtpk(acc0[4 * g + 2], acc0[4 * g + 3]); *(GAS u32x2*)(Cp + 8 * g) = o;
            u32x2 o1; o1.x = cvtpk(acc1[4 * g], acc1[4 * g + 1]); o1.y = cvtpk(acc1[4 * g + 2], acc1[4 * g + 3]); *(GAS u32x2*)(Cp + 32 * 128 + 8 * g) = o1; }
    }
    {
        const int k = 16 * w + (lane & 15), sq = lane >> 4; float part = 0.f;
        const LAS unsigned short* kcol = (const LAS unsigned short*)(L + (k >> 5) * 4096 + (k & 31) * 2);
#pragma unroll
        for (int e = 0; e < 16; ++e) part += Lws[16 * sq + e] * __uint_as_float((unsigned)kcol[(16 * sq + e) * 32] << 16);
        part += __shfl_xor(part, 16); part += __shfl_xor(part, 32);
        if (lane < 16) NST_[(size_t)(chain * 64 + c) * 128 + k] = part;
        if (tid == 0) { SCL_[(chain * 64 + c) * 2] = a_end; SCL_[(chain * 64 + c) * 2 + 1] = m_loc; }
    }
    __syncthreads();
}
DI void ml_scan_phase(const Frame& F) {
    bf16* const CST_ = WSP(bf16, WS_CST); float* const NST_ = WSP(float, WS_NST); float* const SCL_ = WSP(float, WS_SCL); float* const MST_ = WSP(float, WS_MST);
    for (int gt = F.vcu * NTHR + F.tid; gt < 32 * 4096; gt += F.G * NTHR) {
        const int chain = gt >> 12, rem = gt & 4095;
        const float ae_l = SCL_[(chain * 64 + F.lane) * 2], ml_l = SCL_[(chain * 64 + F.lane) * 2 + 1];
        u32x2* Cp = (u32x2*)(CST_ + (size_t)chain * 64 * 16384 + (size_t)rem * 4);
        f32x4* Np = (f32x4*)(NST_ + (size_t)chain * 64 * 128 + rem * 4);
        const bool do_n = rem < 32;
        float c0 = 0.f, c1 = 0.f, c2 = 0.f, c3 = 0.f; f32x4 nn = {0.f, 0.f, 0.f, 0.f}; float m = 0.f;
        u32x2 dr[8]; f32x4 nr[8];
#pragma unroll
        for (int i = 0; i < 8; ++i) { dr[i] = Cp[(size_t)i * 4096]; if (do_n) nr[i] = Np[i * 32]; }
        for (int c0_ = 0; c0_ < 64; c0_ += 8) {
#pragma unroll
            for (int i = 0; i < 8; ++i) { const int c = c0_ + i;
                if (c < 63) {
                    const u32x2 dcur = dr[i]; const f32x4 dn = nr[i];
                    if (c + 8 < 63) { dr[i] = Cp[(size_t)(c + 8) * 4096]; if (do_n) nr[i] = Np[(c + 8) * 32]; }
                    const float ae = __builtin_bit_cast(float, __builtin_amdgcn_readlane(__builtin_bit_cast(int, ae_l), c)), ml = __builtin_bit_cast(float, __builtin_amdgcn_readlane(__builtin_bit_cast(int, ml_l), c));
                    const float mn = fmaxf(ae + m, ml), d1 = fexp(ae + m - mn), d2 = fexp(ml - mn);
                    c0 = d1 * c0 + d2 * bflo(dcur.x); c1 = d1 * c1 + d2 * bfhi(dcur.x); c2 = d1 * c2 + d2 * bflo(dcur.y); c3 = d1 * c3 + d2 * bfhi(dcur.y);
                    u32x2 o; o.x = cvtpk(c0, c1); o.y = cvtpk(c2, c3); Cp[(size_t)c * 4096] = o;
                    if (do_n) { nn = nn * d1 + dn * d2; Np[c * 32] = nn; }
                    if (rem == 0) MST_[chain * 64 + c] = mn;
                    m = mn; } }
        }
    }
}
DI void ml_out_unit(const Frame& F, int chain, int c) {
    bf16* const PROJ_ = WSP(bf16, WS_PROJ); float* const GATES_ = WSP(float, WS_GATES); float* const MST_ = WSP(float, WS_MST); bf16* const CST_ = WSP(bf16, WS_CST); float* const NST_ = WSP(float, WS_NST); bf16* const MIX_ = WSP(bf16, WS_MIX); const float* const g_out_ml_ = inp(I_GOML);
    LAS unsigned char* L = F.lds;
    LAS float* Lbs = (LAS float*)(L + 49152); LAS float* Lav = (LAS float*)(L + 49408); LAS float* Lex = (LAS float*)(L + 49664);
    const int tid = F.tid, lane = F.lane, w = F.wave, r = lane & 31, hi = lane >> 5;
    const int i16 = lane & 15, qq = i16 >> 2, pp = i16 & 3, blk = (lane >> 4) & 1;
    const int b = chain >> 2, hh = chain & 3; const size_t rowbase = (size_t)b * SEQ; const int t0 = c * 64;
    const int tb = w >> 2, vb = w & 3;
    const bf16* P = PROJ_;
    {
        const int kc = tid & 15, kr0 = tid >> 4;
#pragma unroll
        for (int which = 0; which < 2; ++which) {
            const int colbase = (which ? 512 : 0) + hh * 128 + kc * 8;
            float cw[4][8]; load_cw8(F, colbase, cw);
            const bf16* Xg = P + rowbase * NPROJ + C_QML + colbase;
#pragma unroll
            for (int i = 0; i < 2; ++i) { const int row = kr0 + 32 * i; v4u xr[4];
#pragma unroll
                for (int j = 0; j < 4; ++j) { const int tt = t0 + row - 3 + j; xr[j] = (tt >= 0) ? *(const GAS v4u*)(Xg + (size_t)tt * NPROJ) : (v4u){0u, 0u, 0u, 0u}; }
                float y[8]; conv_silu8(xr, cw, which ? 0.08838834764831845f : 1.0f, y);
                v4u o; o.x = cvtpk(y[0], y[1]); o.y = cvtpk(y[2], y[3]); o.z = cvtpk(y[4], y[5]); o.w = cvtpk(y[6], y[7]);
                *(LAS v4u*)(L + which * 16384 + row * 256 + ((kc ^ (row & 15)) * 16)) = o; }
        }
#pragma unroll
        for (int i = 0; i < 2; ++i) { const int row = kr0 + 32 * i;
            const v4u v = *(const GAS v4u*)(P + (rowbase + t0 + row) * NPROJ + C_VML + hh * 128 + kc * 8);
            *(LAS v4u*)(L + 32768 + (kc >> 2) * 4096 + row * 64 + (kc & 3) * 16) = v; }
        if (w == 0) { const float* Gg = GATES_ + (rowbase + t0 + lane) * 8; const float a = wave_scan_incl(log_sigmoid(Gg[4 + hh]), lane); Lav[lane] = a; Lbs[lane] = Gg[hh] - a; }
    }
    const float mprev = (c > 0) ? MST_[chain * 64 + c - 1] : 0.f;
    bf16x8 cf[8], nf[8];
    if (c > 0) {
        const bf16* Cp = CST_ + ((size_t)(chain * 64 + c - 1) * 128 + vb * 32 + r) * 128 + 8 * hi;
        const float* Np = NST_ + (size_t)(chain * 64 + c - 1) * 128 + 8 * hi;
        const bool nrow = (r == 0) || (r == 4);
#pragma unroll
        for (int kk = 0; kk < 8; ++kk) { cf[kk] = *(const GAS bf16x8*)(Cp + 16 * kk);
            const f32x4 n0 = *(const f32x4*)(Np + 16 * kk), n1 = *(const f32x4*)(Np + 16 * kk + 4);
            v4u o; o.x = cvtpk(n0.x, n0.y); o.y = cvtpk(n0.z, n0.w); o.z = cvtpk(n1.x, n1.y); o.w = cvtpk(n1.z, n1.w);
            if (!nrow) o = (v4u){0u, 0u, 0u, 0u};
            nf[kk] = __builtin_bit_cast(bf16x8, o); }
    }
    __syncthreads();
    bf16x8 qf[8];
    f32x16 s0, s1;
#pragma unroll
    for (int i = 0; i < 16; ++i) { s0[i] = 0.f; s1[i] = 0.f; }
#pragma unroll
    for (int kk = 0; kk < 8; ++kk) { const int ch = 2 * kk + hi; const int rq_ = 32 * tb + r;
        qf[kk] = *(const LAS bf16x8*)(L + rq_ * 256 + ((ch ^ (rq_ & 15)) * 16));
        const bf16x8 a0 = *(const LAS bf16x8*)(L + 16384 + r * 256 + ((ch ^ (r & 15)) * 16));
        const bf16x8 a1 = *(const LAS bf16x8*)(L + 16384 + (32 + r) * 256 + ((ch ^ ((32 + r) & 15)) * 16));
        s0 = MFMA_BF16(a0, qf[kk], s0); s1 = MFMA_BF16(a1, qf[kk], s1); }
    const int tl = 32 * tb + r; const float a_t = Lav[tl];
    f32x16 d0, d1; float mrow = -INFINITY;
#pragma unroll
    for (int g = 0; g < 4; ++g) { const f32x4 b0 = *(const LAS f32x4*)(Lbs + 8 * g + 4 * hi), b1 = *(const LAS f32x4*)(Lbs + 32 + 8 * g + 4 * hi);
#pragma unroll
        for (int e = 0; e < 4; ++e) { const int sl = 8 * g + 4 * hi + e;
            d0[4 * g + e] = (sl <= tl) ? a_t + b0[e] : -INFINITY; d1[4 * g + e] = (32 + sl <= tl) ? a_t + b1[e] : -INFINITY;
            mrow = fmaxf(mrow, fmaxf(d0[4 * g + e], d1[4 * g + e])); } }
    mrow = fmaxf(swap_max(mrow), a_t + mprev);
    float psum = 0.f;
#pragma unroll
    for (int i = 0; i < 16; ++i) { s0[i] *= fexp(d0[i] - mrow); s1[i] *= fexp(d1[i] - mrow); psum += s0[i] + s1[i]; }
    const float w_inter = fexp(a_t + mprev - mrow);
    float den = swap_add(psum);
    const bf16x8 P00 = packbf(s0, 0), P01 = packbf(s0, 1), P10 = packbf(s1, 0), P11 = packbf(s1, 1);
    f32x16 num;
#pragma unroll
    for (int i = 0; i < 16; ++i) num[i] = 0.f;
    {
        LAS unsigned char* vb_ = L + 32768 + vb * 4096 + (4 * hi + qq) * 64 + 32 * blk + 8 * pp;
        num = MFMA_BF16(cat8(trrd(vb_), trrd(vb_ + 8 * 64)), P00, num); num = MFMA_BF16(cat8(trrd(vb_ + 16 * 64), trrd(vb_ + 24 * 64)), P01, num);
        num = MFMA_BF16(cat8(trrd(vb_ + 32 * 64), trrd(vb_ + 40 * 64)), P10, num); num = MFMA_BF16(cat8(trrd(vb_ + 48 * 64), trrd(vb_ + 56 * 64)), P11, num);
    }
    if (c > 0) {
        f32x16 it, dn;
#pragma unroll
        for (int i = 0; i < 16; ++i) { it[i] = 0.f; dn[i] = 0.f; }
#pragma unroll
        for (int kk = 0; kk < 8; ++kk) { it = MFMA_BF16(cf[kk], qf[kk], it); dn = MFMA_BF16(nf[kk], qf[kk], dn); }
#pragma unroll
        for (int i = 0; i < 16; ++i) num[i] += w_inter * it[i];
        den += w_inter * dn[0];
    }
    const float inv = __builtin_amdgcn_rcpf(fmaxf(fabsf(den), fexp(-mrow)));
    float ss = 0.f;
#pragma unroll
    for (int i = 0; i < 16; ++i) { num[i] *= inv; ss += num[i] * num[i]; }
    ss = swap_add(ss);
    if (lane < 32) Lex[(tb * 4 + vb) * 32 + r] = ss;
    __syncthreads();
    const float tot = (Lex[(tb * 4 + 0) * 32 + r] + Lex[(tb * 4 + 1) * 32 + r]) + (Lex[(tb * 4 + 2) * 32 + r] + Lex[(tb * 4 + 3) * 32 + r]);
    const float rstd = 1.f / sqrtf(tot * (1.f / 128.f) + EPS);
    {
        const size_t trow = rowbase + t0 + tl;
        const bf16* Og = P + trow * NPROJ + C_OML + hh * 128 + vb * 32 + 4 * hi;
        bf16* Mp = MIX_ + trow * D + 512 + hh * 128 + vb * 32 + 4 * hi;
        const float* go = g_out_ml_ + hh * 128 + vb * 32 + 4 * hi;
#pragma unroll
        for (int g = 0; g < 4; ++g) { const u32x2 og = *(const GAS u32x2*)(Og + 8 * g); const f32x4 gg = *(const f32x4*)(go + 8 * g);
            const float o0 = bflo(og.x), o1 = bfhi(og.x), o2 = bflo(og.y), o3 = bfhi(og.y);
            u32x2 o; o.x = cvtpk(num[4 * g] * rstd * gg.x * __builtin_amdgcn_rcpf(1.f + fexp(-o0)), num[4 * g + 1] * rstd * gg.y * __builtin_amdgcn_rcpf(1.f + fexp(-o1)));
            o.y = cvtpk(num[4 * g + 2] * rstd * gg.z * __builtin_amdgcn_rcpf(1.f + fexp(-o2)), num[4 * g + 3] * rstd * gg.w * __builtin_amdgcn_rcpf(1.f + fexp(-o3)));
            *(GAS u32x2*)(Mp + 8 * g) = o; }
    }
    __syncthreads();
}

#define TK_CE(A, B) do { const float hi_ = fmaxf((A), (B)), lo_ = fminf((A), (B)); (A) = hi_; (B) = lo_; } while (0)
DI void tk_sort16(float (&a)[16]) {
#pragma unroll
    for (int k = 2; k <= 16; k <<= 1)
#pragma unroll
        for (int j = k >> 1; j > 0; j >>= 1)
#pragma unroll
            for (int i = 0; i < 16; ++i) { const int l = i ^ j; if (l > i) { if ((i & k) == 0) TK_CE(a[i], a[l]); else TK_CE(a[l], a[i]); } }
}
DI void tk_merge16(float (&a)[16], const float (&b)[16]) {
#pragma unroll
    for (int i = 0; i < 16; ++i) a[i] = fmaxf(a[i], b[15 - i]);
#pragma unroll
    for (int j = 8; j > 0; j >>= 1)
#pragma unroll
        for (int i = 0; i < 16; ++i) { const int l = i ^ j; if (l > i) TK_CE(a[i], a[l]); }
}
DI void tk_stage2(const LAS float* la, const LAS float* lb, int* IDX_, float* GATEW_, size_t o) {
        float a[16], bb[16], cnd[64];
#pragma unroll
        for (int q = 0; q < 16; ++q) { a[q] = la[q]; bb[q] = lb[q]; }
        int cnt = 0;
#pragma unroll
        for (int i = 0; i < 16; ++i)
#pragma unroll
            for (int j = 0; j < 16; ++j) if ((i + 1) * (j + 1) <= 16) { cnd[cnt] = __uint_as_float((__float_as_uint(a[i] + bb[j]) & ~0xFFu) | (unsigned)(i * 16 + j)); ++cnt; }
#pragma unroll
        for (int q = 50; q < 64; ++q) cnd[q] = -INFINITY;
        float top[16];
#pragma unroll
        for (int c = 0; c < 4; ++c) { float ch[16];
#pragma unroll
            for (int q = 0; q < 16; ++q) ch[q] = cnd[16 * c + q];
            tk_sort16(ch);
            if (c == 0) {
#pragma unroll
                for (int q = 0; q < 16; ++q) top[q] = ch[q];
            } else tk_merge16(top, ch); }
        float sv[16]; int ei[16]; float mx = -INFINITY;
#pragma unroll
        for (int q = 0; q < 16; ++q) { const unsigned code = __float_as_uint(top[q]) & 0xFFu; const float va = la[code >> 4], vb = lb[code & 15u];
            ei[q] = (int)((__float_as_uint(va) & 0x7Fu) * 128u + (__float_as_uint(vb) & 0x7Fu)); sv[q] = va + vb; mx = fmaxf(mx, sv[q]); }
        float sum = 0.f;
#pragma unroll
        for (int q = 0; q < 16; ++q) { sv[q] = fexp(sv[q] - mx); sum += sv[q]; }
        const float inv = 1.f / sum;
#pragma unroll
        for (int q = 0; q < 16; q += 4) { *(GAS v4u*)(IDX_ + o + q) = (v4u){(unsigned)ei[q], (unsigned)ei[q + 1], (unsigned)ei[q + 2], (unsigned)ei[q + 3]};
            *(GAS f32x4*)(GATEW_ + o + q) = (f32x4){sv[q] * inv, sv[q + 1] * inv, sv[q + 2] * inv, sv[q + 3] * inv}; }
    }
struct EpiTopK {
    static constexpr bool PERM = false, AFTER_DRAIN = true;
    int* IDX; float* GATEW;
    DI void fused(f32x4 (&acc)[2][2][4][2], const pg8::Unit& u, int wr, int wc, int fr, int fq, LAS unsigned char* lds, int wid, int lane) const {
        LAS float* Tl = (LAS float*)lds;
        LAS float* Lh2 = (LAS float*)lds;
        LAS float* Ls = (LAS float*)(lds + 36864);
        const int tid = wid * 64 + lane, tl = tid & 127, p = (tid >> 7) & 1, half = tid >> 8;
#pragma unroll
        for (int ai = 0; ai < 2; ++ai) {
#pragma unroll
            for (int bj = 0; bj < 2; ++bj)
#pragma unroll
                for (int m = 0; m < 4; ++m)
#pragma unroll
                    for (int n = 0; n < 2; ++n) { LAS float* d = Tl + (wr * 64 + m * 16 + fr) * 257 + bj * 128 + wc * 32 + n * 16 + fq * 4; const f32x4 v = acc[ai][bj][m][n]; d[0] = v.x; d[1] = v.y; d[2] = v.z; d[3] = v.w; }
            __syncthreads();
            float run[16];
            {
                const LAS float* src = Tl + tl * 257 + p * 128 + half * 64;
#pragma unroll
                for (int c = 0; c < 4; ++c) { float ch[16];
#pragma unroll
                    for (int q = 0; q < 16; ++q) ch[q] = __uint_as_float((__float_as_uint(src[16 * c + q]) & ~0x7Fu) | (unsigned)(half * 64 + 16 * c + q));
                    tk_sort16(ch);
                    if (c == 0) {
#pragma unroll
                        for (int q = 0; q < 16; ++q) run[q] = ch[q];
                    } else tk_merge16(run, ch); }
            }
            __syncthreads();
#pragma unroll
            for (int q = 0; q < 16; ++q) Lh2[((tl * 2 + p) * 2 + half) * 17 + q] = run[q];
            __syncthreads();
            if (half == 0) { float oth[16];
#pragma unroll
                for (int q = 0; q < 16; ++q) oth[q] = Lh2[((tl * 2 + p) * 2 + 1) * 17 + q];
                tk_merge16(run, oth);
#pragma unroll
                for (int q = 0; q < 16; ++q) Ls[(tl * 2 + p) * 17 + q] = run[q]; }
            __syncthreads();
            if (tid < 128) tk_stage2(Ls + (tl * 2) * 17, Ls + (tl * 2) * 17 + 17, IDX, GATEW, (size_t)(u.pm * 256 + ai * 128 + tl) * 128 + u.pn * 16);
            __syncthreads();
        }
    }
};
struct OneUnit {
    pg8::Unit u;
    __device__ __forceinline__ bool next(int i, pg8::Unit& o) const { if (i) return false; o = u; return true; }
    __device__ __forceinline__ void a_ready(const pg8::Unit&) const {}
    __device__ __forceinline__ void done(const pg8::Unit&) const {}
};

DI float gelu_erf(float x) { return 0.5f * x * (1.f + erff(x * 0.7071067811865476f)); }
#define DPP_ADD(v, ctrl, rmask) ((v) + __builtin_bit_cast(float, __builtin_amdgcn_update_dpp(0, __builtin_bit_cast(int, (v)), (ctrl), (rmask), 0xF, false)))
#ifndef PEER_EBL
#define PEER_EBL 9
#endif
constexpr int PEER_EB_LOG = PEER_EBL;
#ifndef PEER_PROBE_MASK
#define PEER_PROBE_MASK 0xFFFF
#endif
typedef float f32x2v __attribute__((ext_vector_type(2)));
DI float gelu_cdf(float v) {
    const float av = fabsf(v), t = __builtin_amdgcn_rcpf(av * 0.2316418882f + 1.0f);
    float q = t * 0.5307027145f - 0.7265760135f; q = q * t + 0.7107068705f; q = q * t - 0.142248368f; q = q * t + 0.127414796f; q = q * t;
    const float m = v * (q * ex2(v * v * -0.72134752044f));
    return v < 0.f ? m : v - m;
}
#define DPP_ADDI(v, ctrl, rmask) ((v) + __builtin_amdgcn_update_dpp(0, (v), (ctrl), (rmask), 0xF, false))
DI void peer_phase(const Frame& F, bool scratch_dst) {
    bf16* const XN_ = WSP(bf16, WS_XN); int* const IDX_ = WSP(int, WS_IDX); float* const GATEW_ = WSP(float, WS_GATE); float* const mod_ = WSP(float, WS_MOD); float* const out_ = (float*)inp(I_OUT);
    const unsigned char* const EU8 = WSP(unsigned char, WS_EXPU); const unsigned char* const EV8 = WSP(unsigned char, WS_EXPV); const float* const SUI_ = WSP(float, WS_SUI); const float* const SVI_ = WSP(float, WS_SVI);
    const int gw = F.vcu * NWAVES + F.wave, NGW = F.G * NWAVES, lane = F.lane, g = lane >> 3, j = lane & 7;
    LAS unsigned char* wl = F.lds + F.wave * 16384;
    volatile LAS int* Le = (volatile LAS int*)(wl + g * 512); volatile LAS float* Lg = (volatile LAS float*)(wl + 4096 + g * 512); volatile LAS int* Lp = (volatile LAS int*)(wl + 8192 + g * 512);
    LAS int* Lh = (LAS int*)(wl + 12288 + g * 128);
    for (int grp = gw; grp < T / 8; grp += NGW) {
        const size_t t = (size_t)grp * 8 + g;
        int xi[32]; float sxi;
        {
            float mx = 0.f; v4u xr[8];
#pragma unroll
            for (int hq = 0; hq < 8; ++hq) { const bf16* xp = XN_ + t * D + 128 * hq + 16 * j; const v4u a = *(const GAS v4u*)xp, b = *(const GAS v4u*)(xp + 8);
                xr[hq] = a;
#pragma unroll
                for (int e = 0; e < 4; ++e) mx = fmaxf(mx, fmaxf(fmaxf(fabsf(bflo(a[e])), fabsf(bfhi(a[e]))), fmaxf(fabsf(bflo(b[e])), fabsf(bfhi(b[e]))))); }
            mx = fmaxf(mx, __shfl_xor(mx, 1, 8)); mx = fmaxf(mx, __shfl_xor(mx, 2, 8)); mx = fmaxf(mx, __shfl_xor(mx, 4, 8));
            const float sx = mx > 0.f ? 127.f / mx : 0.f; sxi = mx > 0.f ? mx / 127.f : 0.f;
#pragma unroll
            for (int hq = 0; hq < 8; ++hq) { const bf16* xp = XN_ + t * D + 128 * hq + 16 * j; const v4u a = xr[hq], b = *(const GAS v4u*)(xp + 8);
#pragma unroll
                for (int e = 0; e < 2; ++e) {
                    const int q0 = (int)rintf(bflo(a[2 * e]) * sx), q1 = (int)rintf(bfhi(a[2 * e]) * sx), q2 = (int)rintf(bflo(a[2 * e + 1]) * sx), q3 = (int)rintf(bfhi(a[2 * e + 1]) * sx);
                    xi[4 * hq + e] = (int)((unsigned)(q0 & 0xff) | ((unsigned)(q1 & 0xff) << 8) | ((unsigned)(q2 & 0xff) << 16) | ((unsigned)q3 << 24));
                    const int p0 = (int)rintf(bflo(b[2 * e]) * sx), p1 = (int)rintf(bfhi(b[2 * e]) * sx), p2 = (int)rintf(bflo(b[2 * e + 1]) * sx), p3 = (int)rintf(bfhi(b[2 * e + 1]) * sx);
                    xi[4 * hq + 2 + e] = (int)((unsigned)(p0 & 0xff) | ((unsigned)(p1 & 0xff) << 8) | ((unsigned)(p2 & 0xff) << 16) | ((unsigned)p3 << 24)); } }
        }
        {
            int ide[16]; float gte[16]; int rk[16];
#pragma unroll
            for (int m = 0; m < 16; ++m) { ide[m] = IDX_[t * 128 + j + 8 * m]; gte[m] = GATEW_[t * 128 + j + 8 * m]; }
#pragma unroll
            for (int m = 0; m < 4; ++m) Lh[j + 8 * m] = 0;
#pragma unroll
            for (int m = 0; m < 16; ++m) rk[m] = __hip_atomic_fetch_add(Lh + (ide[m] >> PEER_EB_LOG), 1, __ATOMIC_RELAXED, __HIP_MEMORY_SCOPE_WORKGROUP);
            {
                const int h0 = ((volatile LAS int*)Lh)[4 * j], h1 = ((volatile LAS int*)Lh)[4 * j + 1], h2 = ((volatile LAS int*)Lh)[4 * j + 2], h3 = ((volatile LAS int*)Lh)[4 * j + 3];
                const int tot = (h0 + h1) + (h2 + h3); int inc = tot;
#pragma unroll
                for (int o = 1; o < 8; o <<= 1) { const int tt = __shfl_up(inc, o, 8); if (j >= o) inc += tt; }
                const int ex = inc - tot;
                ((volatile LAS int*)Lh)[4 * j] = ex; ((volatile LAS int*)Lh)[4 * j + 1] = ex + h0; ((volatile LAS int*)Lh)[4 * j + 2] = ex + h0 + h1; ((volatile LAS int*)Lh)[4 * j + 3] = ex + h0 + h1 + h2;
            }
#pragma unroll
            for (int m = 0; m < 16; ++m) { const int pos = ((volatile LAS int*)Lh)[ide[m] >> PEER_EB_LOG] + rk[m]; Le[pos] = ide[m]; Lg[pos] = gte[m]; }
        }
        v4u R0[4], R1[4], R2[4], R3[4];
#define PEER_ROFF(S0, H) ((unsigned)((Le[(S0)] & (scratch_dst ? PEER_PROBE_MASK : 0xFFFF)) << 10) + 512u * (H) + 16u * j)
#define PEER_LOADT(TAB, RR, S0, H) do { const unsigned ro_ = PEER_ROFF(S0, H); _Pragma("unroll") for (int q = 0; q < 4; ++q) RR[q] = *(const GAS v4u*)((TAB) + ro_ + 128u * q); } while (0)
#define PEER_DOTI(RR, H, EOUT) do { int d0_ = 0, d1_ = 0, d2_ = 0, d3_ = 0; \
            _Pragma("unroll") for (int w_ = 0; w_ < 4; ++w_) { d0_ = __builtin_amdgcn_sdot4((int)RR[0][w_], xi[16 * (H) + w_], d0_, false); d1_ = __builtin_amdgcn_sdot4((int)RR[1][w_], xi[16 * (H) + 4 + w_], d1_, false); \
                d2_ = __builtin_amdgcn_sdot4((int)RR[2][w_], xi[16 * (H) + 8 + w_], d2_, false); d3_ = __builtin_amdgcn_sdot4((int)RR[3][w_], xi[16 * (H) + 12 + w_], d3_, false); } \
            int e_ = (d0_ + d1_) + (d2_ + d3_); e_ = DPP_ADDI(e_, 0xB1, 0xF); e_ = DPP_ADDI(e_, 0x4E, 0xF); e_ = DPP_ADDI(e_, 0x141, 0xF); EOUT = e_; } while (0)
#define PEER_SWEEP(TAB, H, BODY0, BODY1, BODY2, BODY3) do { \
            PEER_LOADT(TAB, R0, 0, H); PEER_LOADT(TAB, R1, 1, H); PEER_LOADT(TAB, R2, 2, H); PEER_LOADT(TAB, R3, 3, H); \
            for (int s = 0; s < 128; s += 4) { \
                BODY0; if (s + 4 < 128) PEER_LOADT(TAB, R0, s + 4, H); \
                BODY1; if (s + 4 < 128) PEER_LOADT(TAB, R1, s + 5, H); \
                BODY2; if (s + 4 < 128) PEER_LOADT(TAB, R2, s + 6, H); \
                BODY3; if (s + 4 < 128) PEER_LOADT(TAB, R3, s + 7, H); } } while (0)
        { int e0_;
          PEER_SWEEP(EU8, 0, ({ PEER_DOTI(R0, 0, e0_); Lp[s] = e0_; }), ({ PEER_DOTI(R1, 0, e0_); Lp[s + 1] = e0_; }), ({ PEER_DOTI(R2, 0, e0_); Lp[s + 2] = e0_; }), ({ PEER_DOTI(R3, 0, e0_); Lp[s + 3] = e0_; })); }
        float cmax = 0.f;
#define PEER_FIN(RR, SS) do { int e1_; PEER_DOTI(RR, 1, e1_); const int ex_ = Le[(SS)] & 0xFFFF; const float cf__ = Lg[(SS)] * SVI_[ex_] * gelu_cdf((float)(e1_ + Lp[(SS)]) * (SUI_[ex_] * sxi)); \
            Lg[(SS)] = cf__; cmax = fmaxf(cmax, fabsf(cf__)); } while (0)
        PEER_SWEEP(EU8, 1, PEER_FIN(R0, s), PEER_FIN(R1, s + 1), PEER_FIN(R2, s + 2), PEER_FIN(R3, s + 3));
#undef PEER_FIN
        const float cqs = cmax > 0.f ? 127.f / cmax : 0.f, yscale = cmax > 0.f ? cmax / 127.f : 0.f;
        {
            int pk_[4];
#pragma unroll
            for (int m = 0; m < 4; ++m) { const int d_ = 4 * j + m;
                const int q0 = (int)rintf(Lg[4 * d_] * cqs), q1 = (int)rintf(Lg[4 * d_ + 1] * cqs), q2 = (int)rintf(Lg[4 * d_ + 2] * cqs), q3 = (int)rintf(Lg[4 * d_ + 3] * cqs);
                pk_[m] = (int)((unsigned)(q0 & 0xff) | ((unsigned)(q1 & 0xff) << 8) | ((unsigned)(q2 & 0xff) << 16) | ((unsigned)q3 << 24)); }
#pragma unroll
            for (int m = 0; m < 4; ++m) Lp[4 * j + m] = pk_[m];
        }
#pragma unroll
        for (int H = 0; H < 2; ++H) {
            int yi[64];
#pragma unroll
            for (int i = 0; i < 64; ++i) yi[i] = 0;
            PEER_LOADT(EV8, R0, 0, H); PEER_LOADT(EV8, R1, 1, H); PEER_LOADT(EV8, R2, 2, H); PEER_LOADT(EV8, R3, 3, H);
            for (int bt = 0; bt < 32; ++bt) {
                const int cq_ = Lp[bt];
                unsigned ro0_ = 0, ro1_ = 0, ro2_ = 0, ro3_ = 0;
                if (bt + 1 < 32) { ro0_ = PEER_ROFF(4 * bt + 4, H); ro1_ = PEER_ROFF(4 * bt + 5, H); ro2_ = PEER_ROFF(4 * bt + 6, H); ro3_ = PEER_ROFF(4 * bt + 7, H); }
#pragma unroll
                for (int q = 0; q < 4; ++q) {
#pragma unroll
                    for (int w_ = 0; w_ < 4; ++w_) { const unsigned a0 = R0[q][w_], a1 = R1[q][w_], a2 = R2[q][w_], a3 = R3[q][w_];
                        const unsigned p0 = __builtin_amdgcn_perm(a1, a0, 0x05010400u), p1 = __builtin_amdgcn_perm(a1, a0, 0x07030602u), p2 = __builtin_amdgcn_perm(a3, a2, 0x05010400u), p3 = __builtin_amdgcn_perm(a3, a2, 0x07030602u);
                        yi[16 * q + 4 * w_ + 0] = __builtin_amdgcn_sdot4((int)__builtin_amdgcn_perm(p2, p0, 0x05040100u), cq_, yi[16 * q + 4 * w_ + 0], false);
                        yi[16 * q + 4 * w_ + 1] = __builtin_amdgcn_sdot4((int)__builtin_amdgcn_perm(p2, p0, 0x07060302u), cq_, yi[16 * q + 4 * w_ + 1], false);
                        yi[16 * q + 4 * w_ + 2] = __builtin_amdgcn_sdot4((int)__builtin_amdgcn_perm(p3, p1, 0x05040100u), cq_, yi[16 * q + 4 * w_ + 2], false);
                        yi[16 * q + 4 * w_ + 3] = __builtin_amdgcn_sdot4((int)__builtin_amdgcn_perm(p3, p1, 0x07060302u), cq_, yi[16 * q + 4 * w_ + 3], false); }
                    if (bt + 1 < 32) { R0[q] = *(const GAS v4u*)(EV8 + ro0_ + 128u * q); R1[q] = *(const GAS v4u*)(EV8 + ro1_ + 128u * q); R2[q] = *(const GAS v4u*)(EV8 + ro2_ + 128u * q); R3[q] = *(const GAS v4u*)(EV8 + ro3_ + 128u * q); }
                }
            }
            const int b = (int)(t / SEQ);
            const float* g2 = mod_ + b * NMOD + 5120 + 512 * H + 16 * j;
            const float* ip = out_ + t * D + 512 * H + 16 * j; float* op = (scratch_dst ? WSP(float, WS_SCORES) : out_) + t * D + 512 * H + 16 * j;
#pragma unroll
            for (int q = 0; q < 4; ++q)
#pragma unroll
                for (int c4 = 0; c4 < 4; ++c4) { const f32x4 x1 = *(const GAS f32x4*)(ip + 128 * q + 4 * c4); const f32x4 gg = *(const f32x4*)(g2 + 128 * q + 4 * c4) * yscale;
                    f32x4 o; o.x = x1.x + gg.x * (float)yi[16 * q + 4 * c4]; o.y = x1.y + gg.y * (float)yi[16 * q + 4 * c4 + 1]; o.z = x1.z + gg.z * (float)yi[16 * q + 4 * c4 + 2]; o.w = x1.w + gg.w * (float)yi[16 * q + 4 * c4 + 3];
                    *(GAS f32x4*)(op + 128 * q + 4 * c4) = o; }
        }
#undef PEER_ROFF
#undef PEER_LOADT
#undef PEER_DOTI
#undef PEER_SWEEP
    }
}

DI void ph_inproj(const Frame& F) {
    pg8::Gemm g{WSP(bf16, WS_XN), WSP(bf16, WS_WIN), T, NPROJ, D}; pg8::StaticOrder S; S.init(T, NPROJ, F.G, (int)blockIdx.x);
    pg8::EpiBf16<0> E{WSP(bf16, WS_PROJ), NPROJ, nullptr, 0, 0, 1.f};
    pg8::gemm_phase<pg8::EpiBf16<0>, pg8::StaticOrder, PG8_ALIGN, PG8_SP2>(F.lds, g, S, E);
}
DI void ph_mix(const Frame& F, bool probe_first) {
    stage_conv_w(F);
    {
        int u = F.vcu;
        MlLocalRegs ra;
        if (u < 2048) ml_local_load(F, u >> 6, u & 63, ra);
        const int gwv = F.vcu * NWAVES + F.wave, NGWv = F.G * NWAVES;
        int eb = 2 * gwv;
        while (u < 2048) {
            const int un = u + F.G;
            MlLocalRegs rb;
            if (un < 2048) ml_local_load(F, un >> 6, un & 63, rb);
            ExpRows2 er; const bool ew = eb < 32768;
            if (ew) exp_load2(F, eb, er);
            ml_local_unit(F, u >> 6, u & 63, ra);
            if (ew) exp_conv2(F, eb, er);
            eb += 2 * NGWv;
            ra = rb; u = un;
        }
        for (; eb < 32768; eb += 2 * NGWv) { ExpRows2 er; exp_load2(F, eb, er); exp_conv2(F, eb, er); }
    }
    (void)probe_first;
}
DI void ph_scan_attn(const Frame& F) {
    ml_scan_phase(F);
    __syncthreads();
    for (int u = F.vcu; u < 1024; u += F.G) { const int qb = 15 - (u >> 6), bh = u & 63; sb_unit(F, bh >> 3, bh & 7, qb); }
}
DI void ph_mlout(const Frame& F) { stage_conv_w(F); for (int u = F.vcu; u < 2048; u += F.G) ml_out_unit(F, u >> 6, u & 63); }
#ifndef P5_ALIGN
#define P5_ALIGN PG8_ALIGN
#endif
DI void ph_outproj(const Frame& F) {
    pg8::Gemm g{WSP(bf16, WS_MIX), WSP(bf16, WS_WOUT), T, D, D}; pg8::StaticOrder S; S.init(T, D, F.G, (int)blockIdx.x);
    pg8::EpiResGate E{inp(I_X), (float*)inp(I_OUT), WSP(float, WS_MOD) + 2048, NMOD, SEQ, D};
    pg8::gemm_phase<pg8::EpiResGate, pg8::StaticOrder, P5_ALIGN, PG8_SP2>(F.lds, g, S, E);
}
DI void ph_scores(const Frame& F) {
    pg8::Gemm g{WSP(bf16, WS_XN), WSP(bf16, WS_WEFF), T, NSC, D}; pg8::StaticOrder S; S.init(T, NSC, F.G, (int)blockIdx.x);
    EpiTopK E{WSP(int, WS_IDX), WSP(float, WS_GATE)};
    pg8::Unit un;
    for (int i = 0; S.next(i, un); ++i) { OneUnit S1{un}; pg8::gemm_phase<EpiTopK, OneUnit, false, PG8_SP2>(F.lds, g, S1, E); }
}
constexpr int N_PHASES = 11;
struct Args { const float* in[19]; float* out; unsigned char* ws; int ph_lo, ph_hi; };
__global__ void __launch_bounds__(NTHR, 2) hybrid_fwd(Args args) {
    extern __shared__ __attribute__((aligned(16))) unsigned char lds_raw[];
    Frame F;
    F.lds = (LAS unsigned char*)lds_raw;
    F.MISC = (volatile LAS unsigned*)(F.lds + LDSCTL_OFF + 320);
    F.tid = threadIdx.x; F.lane = F.tid & 63; F.wave = __builtin_amdgcn_readfirstlane(F.tid >> 6);
    F.G = gridDim.x; { const int bx = blockIdx.x; F.vcu = (F.G % 8 == 0) ? (bx % 8) * (F.G / 8) + bx / 8 : bx; }
    F.ws = args.ws;
    F.ctl = (gu32*)(F.ws + WS_CTL);
    for (int u = F.tid; u < (LDS_BYTES - LDSCTL_OFF) / 4; u += NTHR) ((LAS unsigned*)(F.lds + LDSCTL_OFF))[u] = 0u;
    __syncthreads();
    const int lo = args.ph_lo, hi = args.ph_hi;
    const bool one_launch = (hi - lo) > 1;
    XcdBarrier bar; bar.bar = (unsigned*)(F.ctl + CW_BAR); bar.x = 0; bar.st = nullptr;
    if (one_launch) bar = xcd_barrier_post((unsigned*)(F.ctl + CW_BAR), F.MISC + 8);
#ifndef PHMASK
#define PHMASK 0x7ff
#endif
#define IN(k) (((PHMASK >> (k)) & 1) && lo <= (k) && (k) < hi)
#define SEAM(k) do { if (IN(k) && IN((k) + 1)) xcd_barrier(bar); } while (0)
#ifndef REPMASK
#define REPMASK 0
#endif

#define RUN(k, ...) do { if (IN(k)) { if ((REPMASK >> (k)) & 1) { { const bool first = true; (void)first; __VA_ARGS__; } xcd_barrier(bar); } { const bool first = false; (void)first; __VA_ARGS__; } } } while (0)
    RUN(0, p0_phase(F, first ? P0_PARTS : 15)); SEAM(0);
    RUN(1, norm_phase<true>(F, inp(I_X), inp(I_GN1), 0, 1024)); SEAM(1);
    RUN(2, ph_inproj(F)); SEAM(2);
    RUN(3, ph_mix(F, first)); SEAM(3);
    RUN(10, ph_scan_attn(F)); if (IN(10) && IN(4)) xcd_barrier(bar);
    RUN(4, ph_mlout(F)); SEAM(4);
    RUN(5, ph_outproj(F)); SEAM(5);
    RUN(6, norm_phase<false>(F, inp(I_OUT), inp(I_GN2), 3072, 4096)); SEAM(6);
    RUN(7, ph_scores(F)); if (IN(7) && IN(9)) xcd_barrier(bar);
    RUN(9, peer_phase(F, first));
#undef RUN
#undef IN
#undef SEAM
}

#ifndef MK_PER_PHASE
#define MK_PER_PHASE 0
#endif
extern "C" void kernel_launch(void* const* d_in, const int* in_sizes, int n_in, void* d_out, int out_size, void* d_ws, size_t ws_size, hipStream_t stream) {
    static int grid = 0;
    if (grid == 0) {
        if (n_in != 19 || in_sizes[0] != T * D || out_size != T * D || ws_size < WS_END) { fprintf(stderr, "kernel_launch: unexpected shapes (n_in %d, in0 %d, out %d, ws %zu)\n", n_in, n_in > 0 ? in_sizes[0] : -1, out_size, ws_size); grid = -1; return; }
        int dev = 0, cus = 0, per_cu = 0;
        if (hipGetDevice(&dev) != hipSuccess || hipDeviceGetAttribute(&cus, hipDeviceAttributeMultiprocessorCount, dev) != hipSuccess) { grid = -1; return; }
        if (hipFuncSetAttribute((const void*)hybrid_fwd, hipFuncAttributeMaxDynamicSharedMemorySize, LDS_BYTES) != hipSuccess) { fprintf(stderr, "kernel_launch: hipFuncSetAttribute failed\n"); grid = -1; return; }
        if (hipOccupancyMaxActiveBlocksPerMultiprocessor(&per_cu, (const void*)hybrid_fwd, NTHR, LDS_BYTES) != hipSuccess || per_cu < 1) fprintf(stderr, "kernel_launch: occupancy query says %d\n", per_cu);
        (void)hipGetLastError();
        grid = cus;
    }
    if (grid < 0) return;
    if (hipMemsetAsync((char*)d_ws + WS_CTL, 0, CTL_ZERO_BYTES, stream) != hipSuccess) { fprintf(stderr, "kernel_launch: memset failed\n"); return; }
    Args a{};
    for (int i = 0; i < 19; ++i) a.in[i] = (const float*)d_in[i];
    a.out = (float*)d_out; a.ws = (unsigned char*)d_ws;
#if MK_PER_PHASE
    { const int order[N_PHASES] = {0, 1, 2, 3, 10, 4, 5, 6, 7, 8, 9}; for (int i = 0; i < N_PHASES; ++i) { a.ph_lo = order[i]; a.ph_hi = order[i] + 1; hipLaunchKernelGGL(hybrid_fwd, dim3(grid), dim3(NTHR), LDS_BYTES, stream, a); } }
#else
    a.ph_lo = 0; a.ph_hi = N_PHASES;
    hipLaunchKernelGGL(hybrid_fwd, dim3(grid), dim3(NTHR), LDS_BYTES, stream, a);
#endif
    const hipError_t le = hipPeekAtLastError();
    if (le != hipSuccess) fprintf(stderr, "kernel_launch: launch failed: %s\n", hipGetErrorName(le));
}
```

```cpp
#include <cmath>
#include <hip/hip_runtime.h>
#include <cstdio>
#include <cstdint>
namespace pg8 {
#define PG8_LAS __attribute__((address_space(3)))
typedef unsigned short bf16_t;
typedef short bf16x8 __attribute__((ext_vector_type(8)));
typedef float f32x4 __attribute__((ext_vector_type(4)));
typedef unsigned u32x4 __attribute__((ext_vector_type(4)));
constexpr int BM = 256, BK = 64, HALF = 128, HTB = HALF * BK * 2  , STAGE_BYTES = 8 * HTB, NXCD = 8,
#ifndef PG8_WGM
#define PG8_WGM 4
#endif
WGM = PG8_WGM;

__host__ __device__ __forceinline__ int lds_byte(int r, int c) { const int st = (r >> 4) * 2 + (c >> 5), rr = r & 15, cc = c & 31, ob = rr * 64 + cc * 2; return st * 1024 + (ob ^ (((ob >> 9) & 1) << 5)); }
__host__ __device__ __forceinline__ void stage_rc(int b, int& R, int& C) { const int st = b / 1024, sb = b % 1024, swz = sb ^ (((sb >> 9) & 1) << 5); R = (st >> 1) * 16 + swz / 64; C = (st & 1) * 32 + (swz % 64) / 2; }
__host__ __device__ __forceinline__ int perm32(int rho) { const int n = rho >> 4, i = rho & 15; return 8 * (i >> 2) + 4 * n + (i & 3); }

struct Unit { int pm, pn; };
struct Gemm { const bf16_t* A; const bf16_t* Bt; int M, N, K; };

struct StaticOrder {
    int nM, nN, nwg, G, c;
    __host__ __device__ void init(int M, int N, int G_, int c_) { nM = M / BM; nN = N / BM; nwg = nM * nN; G = G_; c = c_; }
    __host__ __device__ bool next(int i, Unit& u) const {
        const long L = (long)i * G + c; if (L >= nwg) return false;
        int wgid = (int)L; { const int q = nwg / NXCD, r = nwg % NXCD, xcd = wgid % NXCD, off = wgid / NXCD; wgid = (xcd < r ? xcd * (q + 1) : r * (q + 1) + (xcd - r) * q) + off; }
        const int nig = WGM * nN, gid = wgid / nig, fm = gid * WGM, gsz = (nM - fm) < WGM ? (nM - fm) : WGM;
        u.pm = fm + ((wgid % nig) % gsz); u.pn = (wgid % nig) / gsz; return true;
    }
    __device__ __forceinline__ void a_ready(const Unit&) const {}
    __device__ __forceinline__ void done(const Unit&) const {}
};

__device__ __forceinline__ unsigned cvt_pk_bf16(float lo, float hi) { unsigned r; asm volatile("v_cvt_pk_bf16_f32 %0, %1, %2" : "=v"(r) : "v"(lo), "v"(hi)); return r; }
typedef float f32x2 __attribute__((ext_vector_type(2)));
__device__ __forceinline__ f32x2 gelu_pk(f32x2 v) {
    const f32x2 av = __builtin_elementwise_abs(v), d = av * 0.2316418882f + 1.0f;
    f32x2 t; t.x = __builtin_amdgcn_rcpf(d.x); t.y = __builtin_amdgcn_rcpf(d.y);
    f32x2 q = t * 0.5307027145f + (-0.7265760135f); q = q * t + 0.7107068705f; q = q * t + (-0.142248368f); q = q * t + 0.127414796f; q = q * t;
    const f32x2 s = (v * v) * (-0.72134752044f);
    f32x2 e; e.x = __builtin_amdgcn_exp2f(s.x); e.y = __builtin_amdgcn_exp2f(s.y);
    const f32x2 m = v * (q * e), r = v - m;
    f32x2 o; o.x = v.x < 0.f ? m.x : r.x; o.y = v.y < 0.f ? m.y : r.y; return o;
}

template <int ACT  > struct EpiBf16 {
    static constexpr bool PERM = true, AFTER_DRAIN = false; static_assert(ACT == 0 || ACT == 1, "EpiBf16: ACT is 0 (none) or 1 (gelu_pk)");
    bf16_t* O; int ldc; const float* bias; int split_cols; size_t split_stride; float scale0;
    __device__ __forceinline__ void operator()(const f32x4 (&acc)[2][2][4][2], const Unit& u, int wr, int wc, int fr, int fq) const {
        const int row0 = u.pm * BM + wr * 64 + fr; int colt = u.pn * BM; bf16_t* base = O;
        float sc = 1.f; if (split_cols) { const int t = colt / split_cols; base += (size_t)t * split_stride; colt -= t * split_cols; if (t == 0) sc = scale0; }
        const int col0 = colt + wc * 32 + 8 * fq, bcol0 = u.pn * BM + wc * 32 + 8 * fq;
        f32x4 bv[2][2];
#pragma unroll
        for (int bj = 0; bj < 2; ++bj)
#pragma unroll
            for (int n = 0; n < 2; ++n) bv[bj][n] = bias ? *(const f32x4*)(bias + bcol0 + bj * HALF + 4 * n) : (f32x4){0.f, 0.f, 0.f, 0.f};
#pragma unroll
        for (int ai = 0; ai < 2; ++ai)
#pragma unroll
            for (int m = 0; m < 4; ++m) { bf16_t* rowp = base + (size_t)(row0 + ai * HALF + m * 16) * ldc + col0;
#pragma unroll
                for (int bj = 0; bj < 2; ++bj) { f32x4 v0 = acc[ai][bj][m][0] + bv[bj][0], v1 = acc[ai][bj][m][1] + bv[bj][1];
                    if (ACT == 1) { f32x2 a = gelu_pk((f32x2){v0[0], v0[1]}), b = gelu_pk((f32x2){v0[2], v0[3]}), c = gelu_pk((f32x2){v1[0], v1[1]}), d = gelu_pk((f32x2){v1[2], v1[3]});
                        v0 = (f32x4){a.x, a.y, b.x, b.y}; v1 = (f32x4){c.x, c.y, d.x, d.y}; }
                    v0 = v0 * sc; v1 = v1 * sc; u32x4 w; w.x = cvt_pk_bf16(v0[0], v0[1]); w.y = cvt_pk_bf16(v0[2], v0[3]); w.z = cvt_pk_bf16(v1[0], v1[1]); w.w = cvt_pk_bf16(v1[2], v1[3]);
                    *(u32x4*)(rowp + bj * HALF) = w; } }
    }
};
template <class Epi, class Sched, bool ALIGN_EPI = false, bool SP2 = false>
__device__ __forceinline__ void gemm_phase(PG8_LAS unsigned char* lds, const Gemm g, const Sched& S, const Epi& E) {
    const int tid = threadIdx.x, wid = __builtin_amdgcn_readfirstlane(tid >> 6), lane = tid & 63, wr = wid >> 2, wc = wid & 3, fr = lane & 15, fq = lane >> 4;
    const int K = g.K, nt = K / BK;
    unsigned voffA[2], voffB[2];
#pragma unroll
    for (int i = 0; i < 2; ++i) { int R, C; stage_rc(tid * 16 + i * 8192, R, C); const int Rb = Epi::PERM ? ((R & ~31) + perm32(R & 31)) : R;
        voffA[i] = (unsigned)(R * K + C) * 2u; voffB[i] = (unsigned)(Rb * K + C) * 2u; }
    const size_t kstep = (size_t)(BK * 2);
    const size_t hstep = (size_t)HALF * K * 2;
    const size_t tstep = 2 * hstep;
    const unsigned ldsw = (unsigned)wid * 1024u;
    const int aoff = lds_byte(wr * 64 + fr, fq * 8), boff = lds_byte(wc * 32 + fr, fq * 8);
#define PG8_SA(b, h) (((b) * 2 + (h)) * HTB)
#define PG8_SB(b, h) ((4 + (b) * 2 + (h)) * HTB)
#define PG8_STAGE(bufoff, gbase, voff) do { _Pragma("unroll") for (int _i = 0; _i < 2; ++_i) \
        __builtin_amdgcn_global_load_lds((const unsigned*)((const char*)(gbase) + (voff)[_i]), (PG8_LAS unsigned*)(lds + (bufoff) + ldsw + _i * 8192), 16, 0, 0); } while (0)
#define PG8_LDA(dst, b, h) do { _Pragma("unroll") for (int m = 0; m < 4; ++m) _Pragma("unroll") for (int k = 0; k < 2; ++k) dst[m][k] = *(const PG8_LAS bf16x8*)(lds + PG8_SA(b, h) + aoff + m * 2048 + k * 1024); } while (0)
#define PG8_LDB(dst, b, h) do { _Pragma("unroll") for (int n = 0; n < 2; ++n) _Pragma("unroll") for (int k = 0; k < 2; ++k) dst[n][k] = *(const PG8_LAS bf16x8*)(lds + PG8_SB(b, h) + boff + n * 2048 + k * 1024); } while (0)
#define PG8_MMA(ai, bj, At, Bt) do { __builtin_amdgcn_s_setprio(1); _Pragma("unroll") for (int m = 0; m < 4; ++m) _Pragma("unroll") for (int n = 0; n < 2; ++n) _Pragma("unroll") for (int k = 0; k < 2; ++k) \
        acc[ai][bj][m][n] = __builtin_amdgcn_mfma_f32_16x16x32_bf16(Bt[n][k], At[m][k], acc[ai][bj][m][n], 0, 0, 0); __builtin_amdgcn_s_setprio(0); } while (0)
#define PG8_WAIT_V(n) asm volatile("s_waitcnt vmcnt(" #n ")" ::: "memory")
#define PG8_WAIT_L(n) asm volatile("s_waitcnt lgkmcnt(" #n ")" ::: "memory")
#define PG8_BAR __builtin_amdgcn_s_barrier()
#define PG8_SCHED __builtin_amdgcn_sched_barrier(0)
    Unit cur, nxt; int ui = 0;
    if (!S.next(0, cur)) return;
    f32x4 acc[2][2][4][2];
#pragma unroll
    for (int a = 0; a < 2; ++a)
#pragma unroll
        for (int b = 0; b < 2; ++b)
#pragma unroll
            for (int m = 0; m < 4; ++m)
#pragma unroll
                for (int n = 0; n < 2; ++n) acc[a][b][m][n] = (f32x4){0.f, 0.f, 0.f, 0.f};
    bf16x8 At[4][2], B0[2][2], B1[2][2];
    const char* cA = (const char*)g.A + (size_t)cur.pm * tstep; const char* cB = (const char*)g.Bt + (size_t)cur.pn * tstep;
    S.a_ready(cur);
    if constexpr (SP2) {
        PG8_STAGE(PG8_SB(0, 0), cB, voffB); PG8_STAGE(PG8_SB(0, 1), cB + hstep, voffB); PG8_STAGE(PG8_SA(0, 0), cA, voffA); PG8_STAGE(PG8_SA(0, 1), cA + hstep, voffA);
        if (wr == 1) PG8_BAR;
        PG8_WAIT_V(2); PG8_BAR;
        PG8_STAGE(PG8_SB(1, 0), cB + kstep, voffB); PG8_STAGE(PG8_SA(1, 0), cA + kstep, voffA); PG8_STAGE(PG8_SB(1, 1), cB + hstep + kstep, voffB);
        PG8_WAIT_V(6); PG8_BAR;
    } else {
        PG8_STAGE(PG8_SB(0, 0), cB, voffB); PG8_STAGE(PG8_SA(0, 0), cA, voffA); PG8_STAGE(PG8_SB(0, 1), cB + hstep, voffB); PG8_STAGE(PG8_SA(0, 1), cA + hstep, voffA);
        if (wr == 1) PG8_BAR;
        PG8_WAIT_V(4); PG8_BAR;
        PG8_STAGE(PG8_SB(1, 0), cB + kstep, voffB); PG8_STAGE(PG8_SA(1, 0), cA + kstep, voffA); PG8_STAGE(PG8_SB(1, 1), cB + hstep + kstep, voffB);
        PG8_WAIT_V(6); PG8_BAR;
    }
    for (;;) {
        const bool has_next = S.next(ui + 1, nxt);
        const char* nA = has_next ? (const char*)g.A + (size_t)nxt.pm * tstep : cA; const char* nB = has_next ? (const char*)g.Bt + (size_t)nxt.pn * tstep : cB;
        for (int t = 0; t < nt; t += 2) {
            const bool last = (t == nt - 2);
            const char* a1 = cA + (size_t)(t + 1) * kstep;
            const char* a2 = last ? nA : cA + (size_t)(t + 2) * kstep; const char* b2 = last ? nB : cB + (size_t)(t + 2) * kstep;
            const char* a3 = a2 + kstep; const char* b3 = b2 + kstep;
            if (last && has_next) S.a_ready(nxt);
            if constexpr (SP2) {
            PG8_LDB(B0, 0, 0); PG8_LDB(B1, 0, 1); PG8_SCHED; PG8_LDA(At, 0, 0); PG8_STAGE(PG8_SA(1, 1), a1 + hstep, voffA);
            PG8_WAIT_V(8); PG8_WAIT_L(0); PG8_BAR; PG8_MMA(0, 0, At, B0); PG8_MMA(0, 1, At, B1); PG8_BAR; PG8_SCHED;
            PG8_LDA(At, 0, 1); PG8_STAGE(PG8_SB(0, 0), b2, voffB); PG8_STAGE(PG8_SB(0, 1), b2 + hstep, voffB); PG8_STAGE(PG8_SA(0, 0), a2, voffA);
            PG8_WAIT_V(8); PG8_WAIT_L(0); PG8_BAR; PG8_MMA(1, 0, At, B0); PG8_MMA(1, 1, At, B1); PG8_BAR; PG8_SCHED;
            PG8_LDB(B0, 1, 0); PG8_LDB(B1, 1, 1); PG8_SCHED; PG8_LDA(At, 1, 0); PG8_STAGE(PG8_SA(0, 1), a2 + hstep, voffA);
            PG8_WAIT_V(8); PG8_WAIT_L(0); PG8_BAR; PG8_MMA(0, 0, At, B0); PG8_MMA(0, 1, At, B1); PG8_BAR; PG8_SCHED;
            PG8_LDA(At, 1, 1); PG8_STAGE(PG8_SB(1, 0), b3, voffB); PG8_STAGE(PG8_SB(1, 1), b3 + hstep, voffB); PG8_STAGE(PG8_SA(1, 0), a3, voffA);
            PG8_WAIT_V(8); PG8_WAIT_L(0); PG8_BAR; PG8_MMA(1, 0, At, B0); PG8_MMA(1, 1, At, B1); PG8_BAR; PG8_SCHED;
            } else {
            PG8_LDB(B0, 0, 0); PG8_SCHED; PG8_LDA(At, 0, 0); PG8_STAGE(PG8_SA(1, 1), a1 + hstep, voffA);
            PG8_WAIT_L(8); PG8_BAR; PG8_WAIT_L(0); PG8_MMA(0, 0, At, B0); PG8_BAR; PG8_SCHED;
            PG8_LDB(B1, 0, 1); PG8_STAGE(PG8_SB(0, 0), b2, voffB);
            PG8_BAR; PG8_WAIT_L(0); PG8_MMA(0, 1, At, B1); PG8_BAR;
            PG8_LDA(At, 0, 1); PG8_STAGE(PG8_SA(0, 0), a2, voffA);
            PG8_BAR; PG8_WAIT_L(0); PG8_MMA(1, 0, At, B0); PG8_BAR; PG8_SCHED;
            PG8_STAGE(PG8_SB(0, 1), b2 + hstep, voffB);
            PG8_WAIT_V(6); PG8_BAR; PG8_MMA(1, 1, At, B1); PG8_BAR;
            PG8_LDB(B0, 1, 0); PG8_SCHED; PG8_LDA(At, 1, 0); PG8_STAGE(PG8_SA(0, 1), a2 + hstep, voffA);
            PG8_WAIT_L(8); PG8_BAR; PG8_WAIT_L(0); PG8_MMA(0, 0, At, B0); PG8_BAR; PG8_SCHED;
            PG8_LDB(B1, 1, 1); PG8_STAGE(PG8_SB(1, 0), b3, voffB);
            PG8_BAR; PG8_WAIT_L(0); PG8_MMA(0, 1, At, B1); PG8_BAR;
            PG8_LDA(At, 1, 1); PG8_STAGE(PG8_SA(1, 0), a3, voffA);
            PG8_BAR; PG8_WAIT_L(0); PG8_MMA(1, 0, At, B0); PG8_BAR; PG8_SCHED;
            PG8_STAGE(PG8_SB(1, 1), b3 + hstep, voffB);
            PG8_WAIT_V(6); PG8_BAR; PG8_MMA(1, 1, At, B1); PG8_BAR;
            }
        }
        if constexpr (ALIGN_EPI) { if (wr == 0) PG8_BAR; }
        if constexpr (!Epi::AFTER_DRAIN) { E(acc, cur, wr, wc, fr, fq); S.done(cur); }
        if (!has_next) break;
#pragma unroll
        for (int a = 0; a < 2; ++a)
#pragma unroll
            for (int b = 0; b < 2; ++b)
#pragma unroll
                for (int m = 0; m < 4; ++m)
#pragma unroll
                    for (int n = 0; n < 2; ++n) acc[a][b][m][n] = (f32x4){0.f, 0.f, 0.f, 0.f};
        cur = nxt; cA = nA; cB = nB; ++ui;
        if constexpr (ALIGN_EPI) { if (wr == 1) PG8_BAR; }
    }
    PG8_WAIT_V(0);
    if constexpr (!ALIGN_EPI) { if (wr == 0) PG8_BAR; }
    PG8_BAR;
    if constexpr (Epi::AFTER_DRAIN) { E.fused(acc, cur, wr, wc, fr, fq, lds, wid, lane); S.done(cur); }
#undef PG8_SA
#undef PG8_SB
#undef PG8_STAGE
#undef PG8_LDA
#undef PG8_LDB
#undef PG8_MMA
#undef PG8_WAIT_V
#undef PG8_WAIT_L
#undef PG8_BAR
#undef PG8_SCHED
}
}

#ifndef PG8_SP2
#define PG8_SP2 true
#endif
#ifndef PG8_ALIGN
#define PG8_ALIGN true
#endif

namespace pg8 {
struct EpiResGate {
    static constexpr bool PERM = false, AFTER_DRAIN = false;
    const float* base; float* out; const float* gate; int gate_ld; int rows_per_batch; int ldc;
    __device__ __forceinline__ void operator()(const f32x4 (&acc)[2][2][4][2], const Unit& u, int wr, int wc, int fr, int fq) const {
        const int row0 = u.pm * BM + wr * 64 + fr, col0 = u.pn * BM + wc * 32 + 4 * fq;
        const float* gp = gate + (size_t)((u.pm * BM) / rows_per_batch) * gate_ld + col0;
        f32x4 gv[2][2];
#pragma unroll
        for (int bj = 0; bj < 2; ++bj)
#pragma unroll
            for (int n = 0; n < 2; ++n) gv[bj][n] = *(const f32x4*)(gp + bj * HALF + n * 16);
#pragma unroll
        for (int ai = 0; ai < 2; ++ai)
#pragma unroll
            for (int m = 0; m < 4; ++m) { const size_t off = (size_t)(row0 + ai * HALF + m * 16) * ldc + col0;
#pragma unroll
                for (int bj = 0; bj < 2; ++bj)
#pragma unroll
                    for (int n = 0; n < 2; ++n) { const f32x4 bs = *(const f32x4*)(base + off + bj * HALF + n * 16);
                        *(f32x4*)(out + off + bj * HALF + n * 16) = bs + gv[bj][n] * acc[ai][bj][m][n]; } }
    }
};
struct EpiF32 {
    static constexpr bool PERM = false, AFTER_DRAIN = false;
    float* O; int ldc;
    __device__ __forceinline__ void operator()(const f32x4 (&acc)[2][2][4][2], const Unit& u, int wr, int wc, int fr, int fq) const {
        const int row0 = u.pm * BM + wr * 64 + fr, col0 = u.pn * BM + wc * 32 + 4 * fq;
#pragma unroll
        for (int ai = 0; ai < 2; ++ai)
#pragma unroll
            for (int m = 0; m < 4; ++m) { const size_t off = (size_t)(row0 + ai * HALF + m * 16) * ldc + col0;
#pragma unroll
                for (int bj = 0; bj < 2; ++bj)
#pragma unroll
                    for (int n = 0; n < 2; ++n) *(f32x4*)(O + off + bj * HALF + n * 16) = acc[ai][bj][m][n]; }
    }
};
}
#define GAS __attribute__((address_space(1)))
#define LAS __attribute__((address_space(3)))
typedef unsigned short bf16;
typedef unsigned v4u __attribute__((ext_vector_type(4)));
typedef float f32x4 __attribute__((ext_vector_type(4)));
typedef short bf16x8 __attribute__((ext_vector_type(8)));
typedef GAS unsigned gu32;
typedef GAS unsigned long long gu64;
#define RLX_AGENT __ATOMIC_RELAXED, __HIP_MEMORY_SCOPE_AGENT
#define LDS_WAIT() asm volatile("s_waitcnt lgkmcnt(0)" ::: "memory")
#define VM_WAIT() asm volatile("s_waitcnt vmcnt(0)" ::: "memory")
__device__ __forceinline__ unsigned long long rt() { return __builtin_amdgcn_s_memrealtime(); }
__device__ __forceinline__ unsigned f2bf(float f) { unsigned u = __builtin_bit_cast(unsigned, f); return (u + 0x7fffu + ((u >> 16) & 1u)) >> 16; }
__device__ __forceinline__ unsigned pk2(float lo, float hi) { return f2bf(lo) | (f2bf(hi) << 16); }

#define XB_TMO      128
#define XB_XCNT(j)  (256  + 64 * (j))
#define XB_XSUB(j)  (1280 + 64 * (j))
#define XB_XGEN(j)  (2304 + 64 * (j))
#define XB_TOP      3328
#define XB_TOPGEN   3392
#define XCD_BAR_WORDS 3456
#define XB_SPIN_CAP (1u << 24)

__device__ __forceinline__ unsigned xb_ld(unsigned* p)              { return __hip_atomic_load(p, __ATOMIC_RELAXED, __HIP_MEMORY_SCOPE_AGENT); }
__device__ __forceinline__ unsigned xb_add(unsigned* p, unsigned v) { return __hip_atomic_fetch_add(p, v, __ATOMIC_RELAXED, __HIP_MEMORY_SCOPE_AGENT); }
__device__ __forceinline__ unsigned xb_xcc_id() { return (unsigned)__builtin_amdgcn_s_getreg((3 << 11) | 20) & 0xFu; }
#define XB_SPIN(cond, bar) do { unsigned _sp = 0; while (cond) { __builtin_amdgcn_s_sleep(1); \
    if ((++_sp & 255u) == 0u) { if (xb_ld(&(bar)[XB_TMO])) break; if (_sp > XB_SPIN_CAP) { atomicAdd(&(bar)[XB_TMO], 1u); break; } } } } while (0)

struct XcdBarrier {
    unsigned* bar; unsigned x;
    volatile LAS unsigned* st;
};

__device__ __forceinline__ XcdBarrier xcd_barrier_post(unsigned* bar, volatile LAS unsigned* st) {
    XcdBarrier b; b.bar = bar; b.x = xb_xcc_id(); b.st = st;
    if (threadIdx.x == 0) (void)xb_add(&bar[XB_XCNT(b.x)], 1u);
    return b;
}
__device__ __forceinline__ void xcd_barrier_complete(unsigned* bar, unsigned x, unsigned& nloc, unsigned& nx) {
    const unsigned G = gridDim.x * gridDim.y * gridDim.z;
    unsigned sum, cnt, mine, sp = 0u;
    for (;;) {
        sum = 0u; cnt = 0u; mine = 0u;
#pragma unroll
        for (unsigned j = 0; j < 16; ++j) { const unsigned c = xb_ld(&bar[XB_XCNT(j)]); sum += c; cnt += (c > 0u) ? 1u : 0u; mine = (j == x) ? c : mine; }
        if (sum == G) break;
        __builtin_amdgcn_s_sleep(1);
        if ((++sp & 255u) == 0u) { if (xb_ld(&bar[XB_TMO])) break; if (sp > XB_SPIN_CAP) { atomicAdd(&bar[XB_TMO], 1u); break; } }
    }
    nloc = mine > 0u ? mine : 1u; nx = cnt > 0u ? cnt : 1u;
}

__device__ __forceinline__ void xcd_barrier(const XcdBarrier& b) {
    asm volatile("s_waitcnt vmcnt(0)" ::: "memory");
    __syncthreads();
    if (threadIdx.x == 0) {
        unsigned* bar = b.bar;
        __builtin_amdgcn_s_waitcnt(0);
        unsigned nloc = b.st[0], nx = b.st[1];
        if (nloc == 0u) { xcd_barrier_complete(bar, b.x, nloc, nx); b.st[0] = nloc; b.st[1] = nx; }
        const unsigned old = xb_add(&bar[XB_XSUB(b.x)], 1u);
        const unsigned gen = old / nloc;
        if (old + 1u == (gen + 1u) * nloc) {
            __builtin_amdgcn_fence(__ATOMIC_RELEASE, "agent");
            asm volatile("s_waitcnt vmcnt(0)" ::: "memory");
            const unsigned og = xb_add(&bar[XB_TOP], 1u);
            const unsigned tg = og / nx;
            if (og + 1u == (tg + 1u) * nx) xb_add(&bar[XB_TOPGEN], 1u);
            else XB_SPIN(xb_ld(&bar[XB_TOPGEN]) == tg, bar);
            __builtin_amdgcn_fence(__ATOMIC_ACQUIRE, "agent");
            xb_add(&bar[XB_XGEN(b.x)], 1u);
            asm volatile("s_waitcnt vmcnt(0)" ::: "memory");
        } else {
            XB_SPIN(xb_ld(&bar[XB_XGEN(b.x)]) == gen, bar);
            __builtin_amdgcn_fence(__ATOMIC_ACQUIRE, "agent");
            asm volatile("s_waitcnt vmcnt(0)" ::: "memory");
        }
    }
    __syncthreads();
}

constexpr int NWAVES = 8, NTHR = 512;
constexpr int NB = 8, SEQ = 4096, T = NB * SEQ, D = 1024, NPROJ = 3584, NIN = 3592, NMOD = 6144, NSC = 2048;
constexpr int C_QSB = 0, C_KSB = 512, C_VSB = 1024, C_QML = 1536, C_KML = 2048, C_VML = 2560, C_OML = 3072;
constexpr float EPS = 1e-6f, LOG2E = 1.4426950408889634f;
constexpr size_t MiB = 1u << 20;
constexpr size_t WS_CTL = 0, CTL_ZERO_BYTES = 1 * MiB;
constexpr size_t WS_MOD = 256 * 1024;
constexpr size_t WS_WIN = 2 * MiB, WS_WOUT = 10 * MiB, WS_WEFF = 12 * MiB;
constexpr size_t WS_XN = 16 * MiB;
constexpr size_t WS_PROJ = 80 * MiB;
constexpr size_t WS_MIX = 304 * MiB;
constexpr size_t WS_EXPU = 368 * MiB, WS_EXPV = 400 * MiB;
constexpr size_t WS_CST = 432 * MiB;
constexpr size_t WS_NST = 496 * MiB;
constexpr size_t WS_MST = 497 * MiB;
constexpr size_t WS_GATES = 498 * MiB;
constexpr size_t WS_SCORES = 80 * MiB;
constexpr size_t WS_IDX = 336 * MiB, WS_GATE = 352 * MiB;
constexpr size_t WS_SCL = 499 * MiB;
constexpr size_t WS_SUI = 499 * MiB + 65536, WS_SVI = 499 * MiB + 131072;
constexpr size_t WS_END = 500 * MiB;
constexpr int CW_Q3 = 64;
constexpr int CW_BAR = 4096;
constexpr int LDS_BYTES = 147456, LDSCTL_OFF = 143360;

typedef float f32x16 __attribute__((ext_vector_type(16)));
typedef float f32x2_t __attribute__((ext_vector_type(2)));
typedef __bf16 bf16x2_t __attribute__((ext_vector_type(2)));
typedef _Float16 f16x8 __attribute__((ext_vector_type(8)));
typedef short s16x4 __attribute__((ext_vector_type(4)));
typedef unsigned u32x2 __attribute__((ext_vector_type(2)));
#define DI __device__ __forceinline__
DI unsigned cvtpk(float lo, float hi) { f32x2_t v = {lo, hi}; bf16x2_t b = __builtin_convertvector(v, bf16x2_t); return __builtin_bit_cast(unsigned, b); }
DI float bflo(unsigned u) { return __uint_as_float(u << 16); }
DI float bfhi(unsigned u) { return __uint_as_float(u & 0xffff0000u); }
DI int crow(int i, int hi) { return (i & 3) + 8 * (i >> 2) + 4 * hi; }
DI int krow(int s, int hi, int j) { return 16 * s + 8 * (j >> 2) + 4 * hi + (j & 3); }
DI float swap_add(float v) { auto rr = __builtin_amdgcn_permlane32_swap(__float_as_uint(v), __float_as_uint(v), false, false); return __uint_as_float(rr[0]) + __uint_as_float(rr[1]); }
DI float swap_max(float v) { auto rr = __builtin_amdgcn_permlane32_swap(__float_as_uint(v), __float_as_uint(v), false, false); return fmaxf(__uint_as_float(rr[0]), __uint_as_float(rr[1])); }
DI float dot2bf(unsigned a, unsigned b, float acc) { return __builtin_amdgcn_fdot2_f32_bf16(__builtin_bit_cast(bf16x2_t, a), __builtin_bit_cast(bf16x2_t, b), acc, false); }
DI float ex2(float x) { return __builtin_amdgcn_exp2f(x); }
DI float lg2(float x) { return __builtin_amdgcn_logf(x); }
DI float fexp(float x) { return __builtin_amdgcn_exp2f(x * LOG2E); }
DI float wave_sum(float v) {
#pragma unroll
    for (int o = 1; o < 64; o <<= 1) v += __shfl_xor(v, o);
    return v;
}
DI float wave_max(float v) {
#pragma unroll
    for (int o = 1; o < 64; o <<= 1) v = fmaxf(v, __shfl_xor(v, o));
    return v;
}
#define DPP_MAXF(v, ctrl, rmask) fmaxf((v), __builtin_bit_cast(float, __builtin_amdgcn_update_dpp(0, __builtin_bit_cast(int, (v)), (ctrl), (rmask), 0xF, false)))
DI float wave_max_nonneg(float v) {
    v = DPP_MAXF(v, 0xB1, 0xF); v = DPP_MAXF(v, 0x4E, 0xF); v = DPP_MAXF(v, 0x141, 0xF); v = DPP_MAXF(v, 0x140, 0xF); v = DPP_MAXF(v, 0x142, 0xA); v = DPP_MAXF(v, 0x143, 0xC);
    return __builtin_bit_cast(float, __builtin_amdgcn_readlane(__builtin_bit_cast(int, v), 63));
}
#define DPP_ADDF(v, ctrl, rmask) ((v) + __builtin_bit_cast(float, __builtin_amdgcn_update_dpp(0, __builtin_bit_cast(int, (v)), (ctrl), (rmask), 0xF, false)))
DI float wave_sum_u(float v) {
    v = DPP_ADDF(v, 0xB1, 0xF); v = DPP_ADDF(v, 0x4E, 0xF); v = DPP_ADDF(v, 0x141, 0xF); v = DPP_ADDF(v, 0x140, 0xF); v = DPP_ADDF(v, 0x142, 0xA); v = DPP_ADDF(v, 0x143, 0xC);
    return __builtin_bit_cast(float, __builtin_amdgcn_readlane(__builtin_bit_cast(int, v), 63));
}
typedef short v4i16_t __attribute__((ext_vector_type(4)));
DI s16x4 trrd(LAS unsigned char* p) { return __builtin_bit_cast(s16x4, __builtin_amdgcn_ds_read_tr16_b64_v4i16((LAS v4i16_t*)p)); }
DI bf16x8 cat8(s16x4 a, s16x4 b) { return (bf16x8){a[0], a[1], a[2], a[3], b[0], b[1], b[2], b[3]}; }
#define MFMA_BF16(a, b, c) __builtin_amdgcn_mfma_f32_32x32x16_bf16((a), (b), (c), 0, 0, 0)
#define MFMA_F16(a, b, c) __builtin_amdgcn_mfma_f32_32x32x16_f16((a), (b), (c), 0, 0, 0)
DI unsigned pkh(float a, float b) { return __builtin_bit_cast(unsigned, __builtin_amdgcn_cvt_pkrtz(a, b)); }
DI bf16x8 packbf(const f32x16& x, int s) { v4u p; p.x = cvtpk(x[8 * s], x[8 * s + 1]); p.y = cvtpk(x[8 * s + 2], x[8 * s + 3]); p.z = cvtpk(x[8 * s + 4], x[8 * s + 5]); p.w = cvtpk(x[8 * s + 6], x[8 * s + 7]); return __builtin_bit_cast(bf16x8, p); }
DI f16x8 packh(const f32x16& x, int s) { v4u p; p.x = pkh(x[8 * s], x[8 * s + 1]); p.y = pkh(x[8 * s + 2], x[8 * s + 3]); p.z = pkh(x[8 * s + 4], x[8 * s + 5]); p.w = pkh(x[8 * s + 6], x[8 * s + 7]); return __builtin_bit_cast(f16x8, p); }

struct Frame {
    LAS unsigned char* lds;
    volatile LAS unsigned* MISC;
    gu32* ctl;
    unsigned char* ws;
    int tid, lane, wave, vcu, G;
};
DI const float* inp(int i) { const __attribute__((address_space(4))) unsigned long long* kp = (const __attribute__((address_space(4))) unsigned long long*)__builtin_amdgcn_kernarg_segment_ptr(); return (const float*)(const GAS float*)(*(volatile const __attribute__((address_space(4))) unsigned long long*)(kp + i)); }
enum { I_X = 0, I_C, I_WADA, I_BADA, I_GN1, I_WIN, I_BIG, I_BFG, I_CONVW, I_GQ, I_GK, I_GOSB, I_GOML, I_WOUT, I_GN2, I_WQ, I_SK, I_EU, I_EV, I_OUT };
#define WSP(type, off) ((type*)(F.ws + (off)))

DI void p0_transpose_item(const float* W, int K, int N, int ld, bf16* WT, LAS float* scr, int item, int lane) {
    const int nblk = N / 32, kb = item / nblk, nb = item % nblk, k0 = 64 * kb, n0 = 32 * nb;
    float tv[32];
#pragma unroll
    for (int i = 0; i < 32; ++i) tv[i] = W[(size_t)(k0 + 2 * i + (lane >> 5)) * ld + n0 + (lane & 31)];
#pragma unroll
    for (int i = 0; i < 32; ++i) scr[(2 * i + (lane >> 5)) * 33 + (lane & 31)] = tv[i];
    LDS_WAIT(); asm volatile("" ::: "memory");
    const int c = lane & 7;
#pragma unroll
    for (int j = 0; j < 4; ++j) { const int n = (lane >> 3) + 8 * j; const LAS float* s = scr + (8 * c) * 33 + n;
        v4u o; o.x = pk2(s[0 * 33], s[1 * 33]); o.y = pk2(s[2 * 33], s[3 * 33]); o.z = pk2(s[4 * 33], s[5 * 33]); o.w = pk2(s[6 * 33], s[7 * 33]);
        *(GAS v4u*)(WT + (size_t)(n0 + n) * K + k0 + 8 * c) = o; }
    LDS_WAIT(); asm volatile("" ::: "memory");
}
DI void p0_mod_block(const Frame& F, int item) {
    const float* const c_ = inp(I_C); const float* const w_ada_ = inp(I_WADA); const float* const b_ada_ = inp(I_BADA); float* const mod_ = WSP(float, WS_MOD);
    LAS float* scr = (LAS float*)(F.lds + F.wave * 16384);
    const int j = item * 64 + F.lane, d0 = F.wave * 128;
#pragma unroll
    for (int b = 0; b < 8; ++b)
#pragma unroll
        for (int q = 0; q < 2; ++q) { const float cv = c_[b * D + d0 + 64 * q + F.lane]; scr[b * 128 + 64 * q + F.lane] = cv / (1.f + fexp(-cv)); }
    LDS_WAIT(); asm volatile("" ::: "memory");
    float acc[8];
#pragma unroll
    for (int b = 0; b < 8; ++b) acc[b] = 0.f;
#pragma unroll 32
    for (int dd = 0; dd < 128; ++dd) { const float w = w_ada_[(size_t)(d0 + dd) * NMOD + j];
#pragma unroll
        for (int b = 0; b < 8; ++b) acc[b] += scr[b * 128 + dd] * w; }
#pragma unroll
    for (int b = 0; b < 8; ++b) scr[1024 + b * 64 + F.lane] = acc[b];
    __syncthreads();
    float tot = b_ada_[j];
#pragma unroll
    for (int w = 0; w < 8; ++w) tot += ((LAS float*)(F.lds + w * 16384))[1024 + F.wave * 64 + F.lane];
    mod_[F.wave * NMOD + j] = tot;
    __syncthreads();
}
DI void p0_weff_item(const Frame& F, int item) {
    const float* const sub_keys_ = inp(I_SK); const float* const w_q_peer_ = inp(I_WQ); bf16* const Weff_t_ = WSP(bf16, WS_WEFF);
    const int hp = item >> 4, dblk = item & 15;
    LAS float* sk = (LAS float*)F.lds;
    LAS float* rb = (LAS float*)(F.lds + 67584) + F.wave * 1024;
    { float tv[32];
#pragma unroll
      for (int i = 0; i < 32; ++i) tv[i] = sub_keys_[(size_t)hp * 16384 + F.tid + 512 * i];
#pragma unroll
      for (int i = 0; i < 32; ++i) { const int idx = F.tid + 512 * i; sk[(idx >> 7) * 129 + (idx & 127)] = tv[i]; } }
    const int d0 = 64 * dblk + 8 * F.wave;
#pragma unroll
    for (int r = 0; r < 8; ++r) { rb[r * 128 + F.lane] = w_q_peer_[(size_t)(d0 + r) * NSC + hp * 128 + F.lane]; rb[r * 128 + 64 + F.lane] = w_q_peer_[(size_t)(d0 + r) * NSC + hp * 128 + 64 + F.lane]; }
    __syncthreads();
    float a0[8], a1[8];
#pragma unroll
    for (int r = 0; r < 8; ++r) { a0[r] = 0.f; a1[r] = 0.f; }
#pragma unroll 4
    for (int c = 0; c < 128; ++c) { const float s0 = sk[F.lane * 129 + c], s1 = sk[(F.lane + 64) * 129 + c];
#pragma unroll
        for (int r = 0; r < 8; ++r) { const float a = rb[r * 128 + c]; a0[r] += a * s0; a1[r] += a * s1; } }
    v4u o0, o1; o0.x = pk2(a0[0], a0[1]); o0.y = pk2(a0[2], a0[3]); o0.z = pk2(a0[4], a0[5]); o0.w = pk2(a0[6], a0[7]);
    o1.x = pk2(a1[0], a1[1]); o1.y = pk2(a1[2], a1[3]); o1.z = pk2(a1[4], a1[5]); o1.w = pk2(a1[6], a1[7]);
    *(GAS v4u*)(Weff_t_ + (size_t)(hp * 128 + F.lane) * D + d0) = o0;
    *(GAS v4u*)(Weff_t_ + (size_t)(hp * 128 + 64 + F.lane) * D + d0) = o1;
    __syncthreads();
}
struct ExpRows2 { f32x4 v[2][4]; };
DI void exp_load2(const Frame& F, int blk0, ExpRows2& R) {
    const float* const expert_u_ = inp(I_EU); const float* const expert_v_ = inp(I_EV);
#pragma unroll
    for (int bb = 0; bb < 2; ++bb) { const int blk = blk0 + bb; const float* src = (blk < 16384 ? expert_u_ : expert_v_) + (size_t)(blk & 16383) * 1024 + 4 * F.lane;
#pragma unroll
        for (int k = 0; k < 4; ++k) R.v[bb][k] = __builtin_nontemporal_load((const GAS f32x4*)(src + 256 * k)); }
}
DI void exp_conv2(const Frame& F, int blk0, const ExpRows2& R) {
    float* const SUI_ = WSP(float, WS_SUI); float* const SVI_ = WSP(float, WS_SVI);
#pragma unroll
    for (int bb = 0; bb < 2; ++bb) { const int blk = blk0 + bb; const bool isu = blk < 16384; const int e = blk & 16383;
        float mx = 0.f;
#pragma unroll
        for (int k = 0; k < 4; ++k) mx = fmaxf(mx, fmaxf(fmaxf(fabsf(R.v[bb][k].x), fabsf(R.v[bb][k].y)), fmaxf(fabsf(R.v[bb][k].z), fabsf(R.v[bb][k].w))));
        mx = wave_max_nonneg(mx);
        const float top = 127.f, sc = mx > 0.f ? top / mx : 0.f;
        if (F.lane == 0) (isu ? SUI_ : SVI_)[e] = mx > 0.f ? mx / top : 0.f;
        unsigned char* dst = (isu ? WSP(unsigned char, WS_EXPU) : WSP(unsigned char, WS_EXPV)) + (size_t)e * 1024 + 4 * F.lane;
#pragma unroll
        for (int k = 0; k < 4; ++k) { const f32x4 a = R.v[bb][k] * sc;
            const int q0 = (int)rintf(a.x), q1 = (int)rintf(a.y), q2 = (int)rintf(a.z), q3 = (int)rintf(a.w); const unsigned w = (unsigned)(q0 & 0xff) | ((unsigned)(q1 & 0xff) << 8) | ((unsigned)(q2 & 0xff) << 16) | ((unsigned)q3 << 24);
            *(GAS unsigned*)(dst + 256 * k) = w; } }
}
#ifndef P0_PARTS
#define P0_PARTS 15
#endif
DI void p0_phase(const Frame& F, int parts = 15) {
    const float* const w_in_ = inp(I_WIN); bf16* const Win_t_ = WSP(bf16, WS_WIN); const float* const w_out_ = inp(I_WOUT); bf16* const Wout_t_ = WSP(bf16, WS_WOUT); const float* const expert_v_ = inp(I_EV); const float* const expert_u_ = inp(I_EU);
    LAS float* scr = (LAS float*)(F.lds + F.wave * 16384);
    const int gw = F.vcu * NWAVES + F.wave, NGW = F.G * NWAVES;
    if (parts & 1) for (int it = F.vcu; it < 96; it += F.G) p0_mod_block(F, it);
    constexpr int I_WIN = 16 * 112, I_WOUT = 16 * 32, NITEMS = I_WIN + I_WOUT;
    if (parts & 2) for (int it = gw; it < NITEMS; it += NGW) {
        int r = it;
        if (r < I_WIN) { p0_transpose_item(w_in_, D, NPROJ, NIN, Win_t_, scr, r, F.lane); continue; } r -= I_WIN;
        p0_transpose_item(w_out_, D, D, D, Wout_t_, scr, r, F.lane);
    }
    __syncthreads();
    if (parts & 8) for (int it = F.vcu; it < 256; it += F.G) p0_weff_item(F, it);
}

template <bool DOGATES>
DI void norm_phase(const Frame& F, const float* src, const float* g, int shift_off, int scale_off) {
    const float* const w_in_ = inp(I_WIN); float* const mod_ = WSP(float, WS_MOD); bf16* const XN_ = WSP(bf16, WS_XN); float* const GATES_ = WSP(float, WS_GATES); const float* const b_igate_ = inp(I_BIG); const float* const b_fgate_ = inp(I_BFG);
    LAS float* W8 = (LAS float*)F.lds;
    if (DOGATES) {
        for (int i = 0; i < 16; ++i) { const int idx = F.tid + 512 * i; W8[idx] = w_in_[(size_t)(idx & 1023) * NIN + NPROJ + (idx >> 10)]; }
        __syncthreads();
    }
    const int gw = F.vcu * NWAVES + F.wave, NGW = F.G * NWAVES;
    for (int ch = gw; ch < T / 16; ch += NGW) {
        const int r0 = ch * 16, b = r0 / SEQ;
        f32x4 A[4], Bv[4];
#pragma unroll
        for (int j = 0; j < 4; ++j) { const int col = 4 * F.lane + 256 * j; const f32x4 gg = *(const f32x4*)(g + col), sc = *(const f32x4*)(mod_ + b * NMOD + scale_off + col);
            A[j] = gg * (sc + 1.0f); Bv[j] = *(const f32x4*)(mod_ + b * NMOD + shift_off + col); }
        f32x4 nx[4];
        { const GAS f32x4* xr0 = (const GAS f32x4*)(src + (size_t)r0 * D) + F.lane;
#pragma unroll
          for (int j = 0; j < 4; ++j) nx[j] = __builtin_nontemporal_load(xr0 + 64 * j); }
        for (int rr = 0; rr < 16; ++rr) {
            const int row = r0 + rr;
            f32x4 v[4]; float s = 0.f;
#pragma unroll
            for (int j = 0; j < 4; ++j) { v[j] = nx[j]; s += (v[j].x * v[j].x + v[j].y * v[j].y) + (v[j].z * v[j].z + v[j].w * v[j].w); }
            if (rr + 1 < 16) { const GAS f32x4* xr = (const GAS f32x4*)(src + (size_t)(row + 1) * D) + F.lane;
#pragma unroll
                for (int j = 0; j < 4; ++j) nx[j] = __builtin_nontemporal_load(xr + 64 * j); }
            const float rstd = 1.f / sqrtf(wave_sum_u(s) * (1.f / D) + EPS);
#pragma unroll
            for (int j = 0; j < 4; ++j) v[j] = v[j] * rstd * A[j] + Bv[j];
            GAS unsigned long long* o8 = (GAS unsigned long long*)(XN_ + (size_t)row * D) + F.lane;
#pragma unroll
            for (int j = 0; j < 4; ++j) o8[64 * j] = (unsigned long long)pk2(v[j].x, v[j].y) | ((unsigned long long)pk2(v[j].z, v[j].w) << 32);
            if (DOGATES) {
                float res = 0.f;
#pragma unroll
                for (int hh = 0; hh < 8; ++hh) { float p = 0.f;
#pragma unroll
                    for (int j = 0; j < 4; ++j) { const f32x4 w = *(const LAS f32x4*)(W8 + hh * 1024 + 4 * F.lane + 256 * j); p += (v[j].x * w.x + v[j].y * w.y) + (v[j].z * w.z + v[j].w * w.w); }
                    p = wave_sum_u(p); if (F.lane == hh) res = p; }
                if (F.lane < 8) GATES_[(size_t)row * 8 + F.lane] = res + (F.lane < 4 ? b_igate_[F.lane] : b_fgate_[F.lane - 4]);
            }
        }
    }
}

DI void sb_unit(const Frame& F, int b, int h, int qb) {
    bf16* const PROJ_ = WSP(bf16, WS_PROJ); const float* const g_q_sb_ = inp(I_GQ); const float* const g_k_sb_ = inp(I_GK); bf16* const MIX_ = WSP(bf16, WS_MIX); const float* const g_out_sb_ = inp(I_GOSB);
    const int lane = F.lane, w = F.wave, r = lane & 31, hi = lane >> 5;
    const int i16 = lane & 15, qq = i16 >> 2, pp = i16 & 3, blk = (lane >> 4) & 1;
    LAS unsigned char* Wb = F.lds + w * 16384;
    const size_t rowbase = (size_t)b * SEQ; const int q0 = qb * 256, qw0 = q0 + 32 * w, tq = qw0 + r;
    const bf16* P = PROJ_;
    const bf16* kpiece[4]; const bf16* vpiece[4];
#pragma unroll
    for (int i = 0; i < 4; ++i) { const int krow_ = 8 * i + (lane >> 3), kch = (lane & 7) ^ ((krow_ >> 1) & 7); kpiece[i] = P + (rowbase + krow_) * NPROJ + C_KSB + h * 64 + 8 * kch;
        const int vkey = 16 * (i & 1) + (lane >> 2); vpiece[i] = P + (rowbase + vkey) * NPROJ + C_VSB + h * 64 + 32 * (i >> 1) + 8 * (lane & 3); }
#define SB_DMA(T_, BUF_) do { _Pragma("unroll") for (int i_ = 0; i_ < 4; ++i_) { \
        __builtin_amdgcn_global_load_lds((const unsigned*)(kpiece[i_] + (size_t)(32 * (T_)) * NPROJ), (LAS unsigned*)(Wb + 8192 * (BUF_) + 1024 * i_), 16, 0, 0); \
        __builtin_amdgcn_global_load_lds((const unsigned*)(vpiece[i_] + (size_t)(32 * (T_)) * NPROJ), (LAS unsigned*)(Wb + 8192 * (BUF_) + 4096 + 1024 * i_), 16, 0, 0); } } while (0)
    const int tw = (qw0 + 30) >> 5;
    SB_DMA(tw, 0);
    bf16x8 qf[4];
    {
        const bf16* Qp = P + (rowbase + tq) * NPROJ + C_QSB + h * 64 + 8 * hi;
        v4u qraw[4]; float ss = 0.f;
#pragma unroll
        for (int kk = 0; kk < 4; ++kk) { qraw[kk] = *(const GAS v4u*)(Qp + 16 * kk);
#pragma unroll
            for (int e = 0; e < 4; ++e) { const float a = bflo(qraw[kk][e]), c = bfhi(qraw[kk][e]); ss += a * a + c * c; } }
        ss = swap_add(ss);
        const float rq = __builtin_amdgcn_rsqf(ss * (1.f / 64.f) + EPS) * (0.125f * LOG2E);
#pragma unroll
        for (int kk = 0; kk < 4; ++kk) { const int d0 = 16 * kk + 8 * hi;
            const f32x4 g0 = *(const f32x4*)(g_q_sb_ + d0) * *(const f32x4*)(g_k_sb_ + d0), g1 = *(const f32x4*)(g_q_sb_ + d0 + 4) * *(const f32x4*)(g_k_sb_ + d0 + 4);
            v4u o; o.x = cvtpk(bflo(qraw[kk].x) * rq * g0.x, bfhi(qraw[kk].x) * rq * g0.y); o.y = cvtpk(bflo(qraw[kk].y) * rq * g0.z, bfhi(qraw[kk].y) * rq * g0.w);
            o.z = cvtpk(bflo(qraw[kk].z) * rq * g1.x, bfhi(qraw[kk].z) * rq * g1.y); o.w = cvtpk(bflo(qraw[kk].w) * rq * g1.z, bfhi(qraw[kk].w) * rq * g1.w);
            qf[kk] = __builtin_bit_cast(bf16x8, o); }
    }
    f16x8 U0, U1, E0;
#pragma unroll
    for (int j = 0; j < 8; ++j) { U0[j] = (krow(0, hi, j) > r) ? (_Float16)1.0f : (_Float16)0.0f; U1[j] = (krow(1, hi, j) > r) ? (_Float16)1.0f : (_Float16)0.0f;
        E0[j] = (j == 0 && hi == 0) ? (_Float16)1.0f : (_Float16)0.0f; }
    f32x16 o0, o1;
#pragma unroll
    for (int i = 0; i < 16; ++i) { o0[i] = 0.f; o1[i] = 0.f; }
    float R = 0.f;
    const int kfoff = r * 128, kfsw = (r >> 1) & 7;
    for (int t = tw; t >= 0; --t) {
        const int buf = (tw - t) & 1;
        LAS unsigned char* Kb = Wb + 8192 * buf; LAS unsigned char* Vb = Kb + 4096;
        asm volatile("s_waitcnt vmcnt(0)" ::: "memory");
        if (t > 0) SB_DMA(t - 1, buf ^ 1);
        bf16x8 kf[4]; float ssk = 0.f;
#pragma unroll
        for (int kk = 0; kk < 4; ++kk) { const v4u kv = *(const LAS v4u*)(Kb + kfoff + (((2 * kk + hi) ^ kfsw) * 16)); kf[kk] = __builtin_bit_cast(bf16x8, kv);
            ssk = dot2bf(kv.x, kv.x, ssk); ssk = dot2bf(kv.y, kv.y, ssk); ssk = dot2bf(kv.z, kv.z, ssk); ssk = dot2bf(kv.w, kv.w, ssk); }
        ssk = swap_add(ssk);
        const float rk = __builtin_amdgcn_rsqf(ssk * (1.f / 64.f) + EPS);
        f16x8 RKA;
#pragma unroll
        for (int e = 0; e < 8; ++e) RKA[e] = (_Float16)0.0f;
        RKA[0] = (hi == 0) ? (_Float16)rk : (_Float16)0.0f;
        f32x16 s, rkd;
#pragma unroll
        for (int i = 0; i < 16; ++i) { s[i] = 0.f; rkd[i] = 0.f; }
        rkd = MFMA_F16(RKA, E0, rkd);
#pragma unroll
        for (int kk = 0; kk < 4; ++kk) s = MFMA_BF16(kf[kk], qf[kk], s);
        float tsum = 0.f; unsigned lp[8];
        if (32 * t + 31 < qw0) {
#pragma unroll
            for (int i = 0; i < 16; i += 2) {
                const float z0_ = s[i] * rkd[i], z1_ = s[i + 1] * rkd[i + 1];
                const float a0_ = -lg2(1.f + ex2(z0_)), a1_ = -lg2(1.f + ex2(z1_));
                tsum += a0_ + a1_;
                s[i] = z0_ + a0_; s[i + 1] = z1_ + a1_;
                lp[i >> 1] = pkh(a0_, a1_); }
        } else {
            const int kq = tq - 32 * t;
#pragma unroll
            for (int i = 0; i < 16; i += 2) {
                const float z0_ = s[i] * rkd[i], z1_ = s[i + 1] * rkd[i + 1];
                float a0_ = -lg2(1.f + ex2(z0_)), a1_ = -lg2(1.f + ex2(z1_));
                const bool ma0 = crow(i, hi) >= kq, ma1 = crow(i + 1, hi) >= kq;
                a0_ = ma0 ? 0.f : a0_; a1_ = ma1 ? 0.f : a1_;
                tsum += a0_ + a1_;
                s[i] = ma0 ? -INFINITY : z0_ + a0_; s[i + 1] = ma1 ? -INFINITY : z1_ + a1_;
                lp[i >> 1] = pkh(a0_, a1_); }
        }
        f32x16 c;
#pragma unroll
        for (int i = 0; i < 16; ++i) c[i] = R;
        c = MFMA_F16(U0, __builtin_bit_cast(f16x8, (v4u){lp[0], lp[1], lp[2], lp[3]}), c); c = MFMA_F16(U1, __builtin_bit_cast(f16x8, (v4u){lp[4], lp[5], lp[6], lp[7]}), c);
#pragma unroll
        for (int i = 0; i < 16; ++i) s[i] = ex2(s[i] + c[i]);
        const bf16x8 W0 = packbf(s, 0), W1 = packbf(s, 1);
        LAS unsigned char* vb_ = Vb + (4 * hi + qq) * 64 + 32 * blk + 8 * pp;
        o0 = MFMA_BF16(cat8(trrd(vb_), trrd(vb_ + 8 * 64)), W0, o0); o0 = MFMA_BF16(cat8(trrd(vb_ + 16 * 64), trrd(vb_ + 24 * 64)), W1, o0);
        o1 = MFMA_BF16(cat8(trrd(vb_ + 2048), trrd(vb_ + 2048 + 8 * 64)), W0, o1); o1 = MFMA_BF16(cat8(trrd(vb_ + 2048 + 16 * 64), trrd(vb_ + 2048 + 24 * 64)), W1, o1);
        R += swap_add(tsum);
        if (__all(R < -150.f)) break;
    }
    asm volatile("s_waitcnt vmcnt(0)" ::: "memory");
#undef SB_DMA
    {
        float ss = 0.f;
#pragma unroll
        for (int i = 0; i < 16; ++i) ss += o0[i] * o0[i] + o1[i] * o1[i];
        ss = swap_add(ss);
        const float ro = __builtin_amdgcn_rsqf(ss * (1.f / 64.f) + EPS);
        bf16* Op = MIX_ + (rowbase + tq) * D + h * 64;
        const float* go = g_out_sb_ + h * 64;
#pragma unroll
        for (int g = 0; g < 4; ++g) { const int d0 = 8 * g + 4 * hi; const f32x4 ga = *(const f32x4*)(go + d0), gb = *(const f32x4*)(go + 32 + d0);
            u32x2 wa, wb; wa.x = cvtpk(o0[4 * g] * ro * ga.x, o0[4 * g + 1] * ro * ga.y); wa.y = cvtpk(o0[4 * g + 2] * ro * ga.z, o0[4 * g + 3] * ro * ga.w);
            wb.x = cvtpk(o1[4 * g] * ro * gb.x, o1[4 * g + 1] * ro * gb.y); wb.y = cvtpk(o1[4 * g + 2] * ro * gb.z, o1[4 * g + 3] * ro * gb.w);
            *(GAS u32x2*)(Op + d0) = wa; *(GAS u32x2*)(Op + 32 + d0) = wb; }
    }
    __syncthreads();
}

DI void conv_silu8(const v4u (&xr)[4], const float (&cw)[4][8], float scale, float (&y)[8]) {
#pragma unroll
    for (int e = 0; e < 8; ++e) y[e] = 0.f;
#pragma unroll
    for (int j = 0; j < 4; ++j) {
        y[0] += cw[j][0] * bflo(xr[j].x); y[1] += cw[j][1] * bfhi(xr[j].x); y[2] += cw[j][2] * bflo(xr[j].y); y[3] += cw[j][3] * bfhi(xr[j].y);
        y[4] += cw[j][4] * bflo(xr[j].z); y[5] += cw[j][5] * bfhi(xr[j].z); y[6] += cw[j][6] * bflo(xr[j].w); y[7] += cw[j][7] * bfhi(xr[j].w); }
#pragma unroll
    for (int e = 0; e < 8; ++e) y[e] = scale * y[e] * __builtin_amdgcn_rcpf(1.f + fexp(-y[e]));
}
DI float log_sigmoid(float x) { return fminf(x, 0.f) - 0.6931471805599453f * lg2(1.f + fexp(-fabsf(x))); }
DI float wave_scan_incl(float a, int lane) {
#pragma unroll
    for (int o = 1; o < 64; o <<= 1) { const float t = __shfl_up(a, o); if (lane >= o) a += t; }
    return a;
}

constexpr int LDS_CW = 65536;
DI void stage_conv_w(const Frame& F) {
    const float* const conv_w_ = inp(I_CONVW); LAS float* cwl = (LAS float*)(F.lds + LDS_CW);
    for (int i = F.tid; i < 4096; i += NTHR) cwl[i] = conv_w_[i];
    __syncthreads();
}
DI void load_cw8(const Frame& F, int colbase, float (&cw)[4][8]) {
    const LAS float* cwl = (const LAS float*)(F.lds + LDS_CW);
#pragma unroll
    for (int j = 0; j < 4; ++j) { const f32x4 a = *(const LAS f32x4*)(cwl + j * 1024 + colbase), b = *(const LAS f32x4*)(cwl + j * 1024 + colbase + 4);
        cw[j][0] = a.x; cw[j][1] = a.y; cw[j][2] = a.z; cw[j][3] = a.w; cw[j][4] = b.x; cw[j][5] = b.y; cw[j][6] = b.z; cw[j][7] = b.w; }
}
struct MlLocalRegs { v4u kraw[2][4]; v4u vraw[2]; float gi, gf; };
DI void ml_local_load(const Frame& F, int chain, int c, MlLocalRegs& R) {
    bf16* const PROJ_ = WSP(bf16, WS_PROJ); float* const GATES_ = WSP(float, WS_GATES);
    const int tid = F.tid, lane = F.lane;
    const int b = chain >> 2, hh = chain & 3; const size_t rowbase = (size_t)b * SEQ; const int t0 = c * 64;
    const bf16* P = PROJ_;
    const int kc = tid & 15, kr0 = tid >> 4;
    const bf16* Kg = P + rowbase * NPROJ + C_KML + hh * 128 + kc * 8;
#pragma unroll
    for (int i = 0; i < 2; ++i)
#pragma unroll
        for (int j = 0; j < 4; ++j) { const int tt = t0 + kr0 + 32 * i - 3 + j; R.kraw[i][j] = (tt >= 0) ? *(const GAS v4u*)(Kg + (size_t)tt * NPROJ) : (v4u){0u, 0u, 0u, 0u}; }
#pragma unroll
    for (int i = 0; i < 2; ++i) R.vraw[i] = *(const GAS v4u*)(P + (rowbase + t0 + kr0 + 32 * i) * NPROJ + C_VML + hh * 128 + kc * 8);
    const float* Gg = GATES_ + (rowbase + t0 + lane) * 8;
    R.gi = Gg[hh]; R.gf = Gg[4 + hh];
}
DI void ml_local_unit(const Frame& F, int chain, int c, const MlLocalRegs& RG) {
    bf16* const CST_ = WSP(bf16, WS_CST); float* const NST_ = WSP(float, WS_NST); float* const SCL_ = WSP(float, WS_SCL);
    LAS unsigned char* L = F.lds;
    LAS float* Lws = (LAS float*)(L + 32768);
    const int tid = F.tid, lane = F.lane, w = F.wave, r = lane & 31, hi = lane >> 5;
    const int i16 = lane & 15, qq = i16 >> 2, pp = i16 & 3, blk = (lane >> 4) & 1;
    const int hh = chain & 3;
    const int kbk = w & 3, vb0 = 2 * (w >> 2);
    const int kc = tid & 15, kr0 = tid >> 4;
    v4u kraw[2][4], vraw[2];
#pragma unroll
    for (int i = 0; i < 2; ++i) { vraw[i] = RG.vraw[i];
#pragma unroll
        for (int j = 0; j < 4; ++j) kraw[i][j] = RG.kraw[i][j]; }
    const float gi = RG.gi, gf = RG.gf;
    const float a = wave_scan_incl(log_sigmoid(gf), lane);
    const float a_end = __shfl(a, 63);
    const float lw = a_end - a + gi;
    const float m_loc = wave_max(lw);
    const float ws = fexp(lw - m_loc);
    if (w == 0) Lws[lane] = ws;
    {
        float cw[4][8]; load_cw8(F, 512 + hh * 128 + kc * 8, cw);
#pragma unroll
        for (int i = 0; i < 2; ++i) { float y[8]; conv_silu8(kraw[i], cw, 0.08838834764831845f, y);
            v4u o; o.x = cvtpk(y[0], y[1]); o.y = cvtpk(y[2], y[3]); o.z = cvtpk(y[4], y[5]); o.w = cvtpk(y[6], y[7]);
            *(LAS v4u*)(L + (kc >> 2) * 4096 + (kr0 + 32 * i) * 64 + (kc & 3) * 16) = o; }
#pragma unroll
        for (int i = 0; i < 2; ++i) { const int row = kr0 + 32 * i; const float wsr = __shfl(ws, row);
            v4u o; o.x = cvtpk(bflo(vraw[i].x) * wsr, bfhi(vraw[i].x) * wsr); o.y = cvtpk(bflo(vraw[i].y) * wsr, bfhi(vraw[i].y) * wsr); o.z = cvtpk(bflo(vraw[i].z) * wsr, bfhi(vraw[i].z) * wsr); o.w = cvtpk(bflo(vraw[i].w) * wsr, bfhi(vraw[i].w) * wsr);
            *(LAS v4u*)(L + 16384 + (kc >> 2) * 4096 + row * 64 + (kc & 3) * 16) = o; }
    }
    __syncthreads();
    f32x16 acc0, acc1;
#pragma unroll
    for (int i = 0; i < 16; ++i) { acc0[i] = 0.f; acc1[i] = 0.f; }
#pragma unroll
    for (int kk = 0; kk < 4; ++kk) { const int rows = 16 * kk + 8 * hi + qq;
        LAS unsigned char* ka = L + kbk * 4096 + rows * 64 + 32 * blk + 8 * pp; LAS unsigned char* va = L + 16384 + vb0 * 4096 + rows * 64 + 32 * blk + 8 * pp;
        const bf16x8 A = cat8(trrd(ka), trrd(ka + 4 * 64));
        acc0 = MFMA_BF16(A, cat8(trrd(va), trrd(va + 4 * 64)), acc0); acc1 = MFMA_BF16(A, cat8(trrd(va + 4096), trrd(va + 4096 + 4 * 64)), acc1); }
    {
        bf16* Cp = CST_ + ((size_t)(chain * 64 + c) * 128 + vb0 * 32 + r) * 128 + kbk * 32 + 4 * hi;
#pragma unroll
        for (int g = 0; g < 4; ++g) { u32x2 o; o.x = cvtpk(acc0[4 * g], acc0[4 * g + 1]); o.y = cvtpk(acc0[4 * g + 2], acc0[4 * g + 3]); *(GAS u32x2*)(Cp + 8 * g) = o;
            u32x2 o1; o1.x = cvtpk(acc1[4 * g], acc1[4 * g + 1]); o1.y = cvtpk(acc1[4 * g + 2], acc1[4 * g + 3]); *(GAS u32x2*)(Cp + 32 * 128 + 8 * g) = o1; }
    }
    {
        const int k = 16 * w + (lane & 15), sq = lane >> 4; float part = 0.f;
        const LAS unsigned short* kcol = (const LAS unsigned short*)(L + (k >> 5) * 4096 + (k & 31) * 2);
#pragma unroll
        for (int e = 0; e < 16; ++e) part += Lws[16 * sq + e] * __uint_as_float((unsigned)kcol[(16 * sq + e) * 32] << 16);
        part += __shfl_xor(part, 16); part += __shfl_xor(part, 32);
        if (lane < 16) NST_[(size_t)(chain * 64 + c) * 128 + k] = part;
        if (tid == 0) { SCL_[(chain * 64 + c) * 2] = a_end; SCL_[(chain * 64 + c) * 2 + 1] = m_loc; }
    }
    __syncthreads();
}
DI void ml_scan_phase(const Frame& F) {
    bf16* const CST_ = WSP(bf16, WS_CST); float* const NST_ = WSP(float, WS_NST); float* const SCL_ = WSP(float, WS_SCL); float* const MST_ = WSP(float, WS_MST);
    for (int gt = F.vcu * NTHR + F.tid; gt < 32 * 4096; gt += F.G * NTHR) {
        const int chain = gt >> 12, rem = gt & 4095;
        const float ae_l = SCL_[(chain * 64 + F.lane) * 2], ml_l = SCL_[(chain * 64 + F.lane) * 2 + 1];
        u32x2* Cp = (u32x2*)(CST_ + (size_t)chain * 64 * 16384 + (size_t)rem * 4);
        f32x4* Np = (f32x4*)(NST_ + (size_t)chain * 64 * 128 + rem * 4);
        const bool do_n = rem < 32;
        float c0 = 0.f, c1 = 0.f, c2 = 0.f, c3 = 0.f; f32x4 nn = {0.f, 0.f, 0.f, 0.f}; float m = 0.f;
        u32x2 dr[8]; f32x4 nr[8];
#pragma unroll
        for (int i = 0; i < 8; ++i) { dr[i] = Cp[(size_t)i * 4096]; if (do_n) nr[i] = Np[i * 32]; }
        for (int c0_ = 0; c0_ < 64; c0_ += 8) {
#pragma unroll
            for (int i = 0; i < 8; ++i) { const int c = c0_ + i;
                if (c < 63) {
                    const u32x2 dcur = dr[i]; const f32x4 dn = nr[i];
                    if (c + 8 < 63) { dr[i] = Cp[(size_t)(c + 8) * 4096]; if (do_n) nr[i] = Np[(c + 8) * 32]; }
                    const float ae = __builtin_bit_cast(float, __builtin_amdgcn_readlane(__builtin_bit_cast(int, ae_l), c)), ml = __builtin_bit_cast(float, __builtin_amdgcn_readlane(__builtin_bit_cast(int, ml_l), c));
                    const float mn = fmaxf(ae + m, ml), d1 = fexp(ae + m - mn), d2 = fexp(ml - mn);
                    c0 = d1 * c0 + d2 * bflo(dcur.x); c1 = d1 * c1 + d2 * bfhi(dcur.x); c2 = d1 * c2 + d2 * bflo(dcur.y); c3 = d1 * c3 + d2 * bfhi(dcur.y);
                    u32x2 o; o.x = cvtpk(c0, c1); o.y = cvtpk(c2, c3); Cp[(size_t)c * 4096] = o;
                    if (do_n) { nn = nn * d1 + dn * d2; Np[c * 32] = nn; }
                    if (rem == 0) MST_[chain * 64 + c] = mn;
                    m = mn; } }
        }
    }
}
DI void ml_out_unit(const Frame& F, int chain, int c) {
    bf16* const PROJ_ = WSP(bf16, WS_PROJ); float* const GATES_ = WSP(float, WS_GATES); float* const MST_ = WSP(float, WS_MST); bf16* const CST_ = WSP(bf16, WS_CST); float* const NST_ = WSP(float, WS_NST); bf16* const MIX_ = WSP(bf16, WS_MIX); const float* const g_out_ml_ = inp(I_GOML);
    LAS unsigned char* L = F.lds;
    LAS float* Lbs = (LAS float*)(L + 49152); LAS float* Lav = (LAS float*)(L + 49408); LAS float* Lex = (LAS float*)(L + 49664);
    const int tid = F.tid, lane = F.lane, w = F.wave, r = lane & 31, hi = lane >> 5;
    const int i16 = lane & 15, qq = i16 >> 2, pp = i16 & 3, blk = (lane >> 4) & 1;
    const int b = chain >> 2, hh = chain & 3; const size_t rowbase = (size_t)b * SEQ; const int t0 = c * 64;
    const int tb = w >> 2, vb = w & 3;
    const bf16* P = PROJ_;
    {
        const int kc = tid & 15, kr0 = tid >> 4;
#pragma unroll
        for (int which = 0; which < 2; ++which) {
            const int colbase = (which ? 512 : 0) + hh * 128 + kc * 8;
            float cw[4][8]; load_cw8(F, colbase, cw);
            const bf16* Xg = P + rowbase * NPROJ + C_QML + colbase;
#pragma unroll
            for (int i = 0; i < 2; ++i) { const int row = kr0 + 32 * i; v4u xr[4];
#pragma unroll
                for (int j = 0; j < 4; ++j) { const int tt = t0 + row - 3 + j; xr[j] = (tt >= 0) ? *(const GAS v4u*)(Xg + (size_t)tt * NPROJ) : (v4u){0u, 0u, 0u, 0u}; }
                float y[8]; conv_silu8(xr, cw, which ? 0.08838834764831845f : 1.0f, y);
                v4u o; o.x = cvtpk(y[0], y[1]); o.y = cvtpk(y[2], y[3]); o.z = cvtpk(y[4], y[5]); o.w = cvtpk(y[6], y[7]);
                *(LAS v4u*)(L + which * 16384 + row * 256 + ((kc ^ (row & 15)) * 16)) = o; }
        }
#pragma unroll
        for (int i = 0; i < 2; ++i) { const int row = kr0 + 32 * i;
            const v4u v = *(const GAS v4u*)(P + (rowbase + t0 + row) * NPROJ + C_VML + hh * 128 + kc * 8);
            *(LAS v4u*)(L + 32768 + (kc >> 2) * 4096 + row * 64 + (kc & 3) * 16) = v; }
        if (w == 0) { const float* Gg = GATES_ + (rowbase + t0 + lane) * 8; const float a = wave_scan_incl(log_sigmoid(Gg[4 + hh]), lane); Lav[lane] = a; Lbs[lane] = Gg[hh] - a; }
    }
    const float mprev = (c > 0) ? MST_[chain * 64 + c - 1] : 0.f;
    bf16x8 cf[8], nf[8];
    if (c > 0) {
        const bf16* Cp = CST_ + ((size_t)(chain * 64 + c - 1) * 128 + vb * 32 + r) * 128 + 8 * hi;
        const float* Np = NST_ + (size_t)(chain * 64 + c - 1) * 128 + 8 * hi;
        const bool nrow = (r == 0) || (r == 4);
#pragma unroll
        for (int kk = 0; kk < 8; ++kk) { cf[kk] = *(const GAS bf16x8*)(Cp + 16 * kk);
            const f32x4 n0 = *(const f32x4*)(Np + 16 * kk), n1 = *(const f32x4*)(Np + 16 * kk + 4);
            v4u o; o.x = cvtpk(n0.x, n0.y); o.y = cvtpk(n0.z, n0.w); o.z = cvtpk(n1.x, n1.y); o.w = cvtpk(n1.z, n1.w);
            if (!nrow) o = (v4u){0u, 0u, 0u, 0u};
            nf[kk] = __builtin_bit_cast(bf16x8, o); }
    }
    __syncthreads();
    bf16x8 qf[8];
    f32x16 s0, s1;
#pragma unroll
    for (int i = 0; i < 16; ++i) { s0[i] = 0.f; s1[i] = 0.f; }
#pragma unroll
    for (int kk = 0; kk < 8; ++kk) { const int ch = 2 * kk + hi; const int rq_ = 32 * tb + r;
        qf[kk] = *(const LAS bf16x8*)(L + rq_ * 256 + ((ch ^ (rq_ & 15)) * 16));
        const bf16x8 a0 = *(const LAS bf16x8*)(L + 16384 + r * 256 + ((ch ^ (r & 15)) * 16));
        const bf16x8 a1 = *(const LAS bf16x8*)(L + 16384 + (32 + r) * 256 + ((ch ^ ((32 + r) & 15)) * 16));
        s0 = MFMA_BF16(a0, qf[kk], s0); s1 = MFMA_BF16(a1, qf[kk], s1); }
    const int tl = 32 * tb + r; const float a_t = Lav[tl];
    f32x16 d0, d1; float mrow = -INFINITY;
#pragma unroll
    for (int g = 0; g < 4; ++g) { const f32x4 b0 = *(const LAS f32x4*)(Lbs + 8 * g + 4 * hi), b1 = *(const LAS f32x4*)(Lbs + 32 + 8 * g + 4 * hi);
#pragma unroll
        for (int e = 0; e < 4; ++e) { const int sl = 8 * g + 4 * hi + e;
            d0[4 * g + e] = (sl <= tl) ? a_t + b0[e] : -INFINITY; d1[4 * g + e] = (32 + sl <= tl) ? a_t + b1[e] : -INFINITY;
            mrow = fmaxf(mrow, fmaxf(d0[4 * g + e], d1[4 * g + e])); } }
    mrow = fmaxf(swap_max(mrow), a_t + mprev);
    float psum = 0.f;
#pragma unroll
    for (int i = 0; i < 16; ++i) { s0[i] *= fexp(d0[i] - mrow); s1[i] *= fexp(d1[i] - mrow); psum += s0[i] + s1[i]; }
    const float w_inter = fexp(a_t + mprev - mrow);
    float den = swap_add(psum);
    const bf16x8 P00 = packbf(s0, 0), P01 = packbf(s0, 1), P10 = packbf(s1, 0), P11 = packbf(s1, 1);
    f32x16 num;
#pragma unroll
    for (int i = 0; i < 16; ++i) num[i] = 0.f;
    {
        LAS unsigned char* vb_ = L + 32768 + vb * 4096 + (4 * hi + qq) * 64 + 32 * blk + 8 * pp;
        num = MFMA_BF16(cat8(trrd(vb_), trrd(vb_ + 8 * 64)), P00, num); num = MFMA_BF16(cat8(trrd(vb_ + 16 * 64), trrd(vb_ + 24 * 64)), P01, num);
        num = MFMA_BF16(cat8(trrd(vb_ + 32 * 64), trrd(vb_ + 40 * 64)), P10, num); num = MFMA_BF16(cat8(trrd(vb_ + 48 * 64), trrd(vb_ + 56 * 64)), P11, num);
    }
    if (c > 0) {
        f32x16 it, dn;
#pragma unroll
        for (int i = 0; i < 16; ++i) { it[i] = 0.f; dn[i] = 0.f; }
#pragma unroll
        for (int kk = 0; kk < 8; ++kk) { it = MFMA_BF16(cf[kk], qf[kk], it); dn = MFMA_BF16(nf[kk], qf[kk], dn); }
#pragma unroll
        for (int i = 0; i < 16; ++i) num[i] += w_inter * it[i];
        den += w_inter * dn[0];
    }
    const float inv = __builtin_amdgcn_rcpf(fmaxf(fabsf(den), fexp(-mrow)));
    float ss = 0.f;
#pragma unroll
    for (int i = 0; i < 16; ++i) { num[i] *= inv; ss += num[i] * num[i]; }
    ss = swap_add(ss);
    if (lane < 32) Lex[(tb * 4 + vb) * 32 + r] = ss;
    __syncthreads();
    const float tot = (Lex[(tb * 4 + 0) * 32 + r] + Lex[(tb * 4 + 1) * 32 + r]) + (Lex[(tb * 4 + 2) * 32 + r] + Lex[(tb * 4 + 3) * 32 + r]);
    const float rstd = 1.f / sqrtf(tot * (1.f / 128.f) + EPS);
    {
        const size_t trow = rowbase + t0 + tl;
        const bf16* Og = P + trow * NPROJ + C_OML + hh * 128 + vb * 32 + 4 * hi;
        bf16* Mp = MIX_ + trow * D + 512 + hh * 128 + vb * 32 + 4 * hi;
        const float* go = g_out_ml_ + hh * 128 + vb * 32 + 4 * hi;
#pragma unroll
        for (int g = 0; g < 4; ++g) { const u32x2 og = *(const GAS u32x2*)(Og + 8 * g); const f32x4 gg = *(const f32x4*)(go + 8 * g);
            const float o0 = bflo(og.x), o1 = bfhi(og.x), o2 = bflo(og.y), o3 = bfhi(og.y);
            u32x2 o; o.x = cvtpk(num[4 * g] * rstd * gg.x * __builtin_amdgcn_rcpf(1.f + fexp(-o0)), num[4 * g + 1] * rstd * gg.y * __builtin_amdgcn_rcpf(1.f + fexp(-o1)));
            o.y = cvtpk(num[4 * g + 2] * rstd * gg.z * __builtin_amdgcn_rcpf(1.f + fexp(-o2)), num[4 * g + 3] * rstd * gg.w * __builtin_amdgcn_rcpf(1.f + fexp(-o3)));
            *(GAS u32x2*)(Mp + 8 * g) = o; }
    }
    __syncthreads();
}

#define TK_CE(A, B) do { const float hi_ = fmaxf((A), (B)), lo_ = fminf((A), (B)); (A) = hi_; (B) = lo_; } while (0)
DI void tk_sort16(float (&a)[16]) {
#pragma unroll
    for (int k = 2; k <= 16; k <<= 1)
#pragma unroll
        for (int j = k >> 1; j > 0; j >>= 1)
#pragma unroll
            for (int i = 0; i < 16; ++i) { const int l = i ^ j; if (l > i) { if ((i & k) == 0) TK_CE(a[i], a[l]); else TK_CE(a[l], a[i]); } }
}
DI void tk_merge16(float (&a)[16], const float (&b)[16]) {
#pragma unroll
    for (int i = 0; i < 16; ++i) a[i] = fmaxf(a[i], b[15 - i]);
#pragma unroll
    for (int j = 8; j > 0; j >>= 1)
#pragma unroll
        for (int i = 0; i < 16; ++i) { const int l = i ^ j; if (l > i) TK_CE(a[i], a[l]); }
}
DI void tk_stage2(const LAS float* la, const LAS float* lb, int* IDX_, float* GATEW_, size_t o) {
        float a[16], bb[16], cnd[64];
#pragma unroll
        for (int q = 0; q < 16; ++q) { a[q] = la[q]; bb[q] = lb[q]; }
        int cnt = 0;
#pragma unroll
        for (int i = 0; i < 16; ++i)
#pragma unroll
            for (int j = 0; j < 16; ++j) if ((i + 1) * (j + 1) <= 16) { cnd[cnt] = __uint_as_float((__float_as_uint(a[i] + bb[j]) & ~0xFFu) | (unsigned)(i * 16 + j)); ++cnt; }
#pragma unroll
        for (int q = 50; q < 64; ++q) cnd[q] = -INFINITY;
        float top[16];
#pragma unroll
        for (int c = 0; c < 4; ++c) { float ch[16];
#pragma unroll
            for (int q = 0; q < 16; ++q) ch[q] = cnd[16 * c + q];
            tk_sort16(ch);
            if (c == 0) {
#pragma unroll
                for (int q = 0; q < 16; ++q) top[q] = ch[q];
            } else tk_merge16(top, ch); }
        float sv[16]; int ei[16]; float mx = -INFINITY;
#pragma unroll
        for (int q = 0; q < 16; ++q) { const unsigned code = __float_as_uint(top[q]) & 0xFFu; const float va = la[code >> 4], vb = lb[code & 15u];
            ei[q] = (int)((__float_as_uint(va) & 0x7Fu) * 128u + (__float_as_uint(vb) & 0x7Fu)); sv[q] = va + vb; mx = fmaxf(mx, sv[q]); }
        float sum = 0.f;
#pragma unroll
        for (int q = 0; q < 16; ++q) { sv[q] = fexp(sv[q] - mx); sum += sv[q]; }
        const float inv = 1.f / sum;
#pragma unroll
        for (int q = 0; q < 16; q += 4) { *(GAS v4u*)(IDX_ + o + q) = (v4u){(unsigned)ei[q], (unsigned)ei[q + 1], (unsigned)ei[q + 2], (unsigned)ei[q + 3]};
            *(GAS f32x4*)(GATEW_ + o + q) = (f32x4){sv[q] * inv, sv[q + 1] * inv, sv[q + 2] * inv, sv[q + 3] * inv}; }
    }
struct EpiTopK {
    static constexpr bool PERM = false, AFTER_DRAIN = true;
    int* IDX; float* GATEW;
    DI void fused(f32x4 (&acc)[2][2][4][2], const pg8::Unit& u, int wr, int wc, int fr, int fq, LAS unsigned char* lds, int wid, int lane) const {
        LAS float* Tl = (LAS float*)lds;
        LAS float* Lh2 = (LAS float*)lds;
        LAS float* Ls = (LAS float*)(lds + 36864);
        const int tid = wid * 64 + lane, tl = tid & 127, p = (tid >> 7) & 1, half = tid >> 8;
#pragma unroll
        for (int ai = 0; ai < 2; ++ai) {
#pragma unroll
            for (int bj = 0; bj < 2; ++bj)
#pragma unroll
                for (int m = 0; m < 4; ++m)
#pragma unroll
                    for (int n = 0; n < 2; ++n) { LAS float* d = Tl + (wr * 64 + m * 16 + fr) * 257 + bj * 128 + wc * 32 + n * 16 + fq * 4; const f32x4 v = acc[ai][bj][m][n]; d[0] = v.x; d[1] = v.y; d[2] = v.z; d[3] = v.w; }
            __syncthreads();
            float run[16];
            {
                const LAS float* src = Tl + tl * 257 + p * 128 + half * 64;
#pragma unroll
                for (int c = 0; c < 4; ++c) { float ch[16];
#pragma unroll
                    for (int q = 0; q < 16; ++q) ch[q] = __uint_as_float((__float_as_uint(src[16 * c + q]) & ~0x7Fu) | (unsigned)(half * 64 + 16 * c + q));
                    tk_sort16(ch);
                    if (c == 0) {
#pragma unroll
                        for (int q = 0; q < 16; ++q) run[q] = ch[q];
                    } else tk_merge16(run, ch); }
            }
            __syncthreads();
#pragma unroll
            for (int q = 0; q < 16; ++q) Lh2[((tl * 2 + p) * 2 + half) * 17 + q] = run[q];
            __syncthreads();
            if (half == 0) { float oth[16];
#pragma unroll
                for (int q = 0; q < 16; ++q) oth[q] = Lh2[((tl * 2 + p) * 2 + 1) * 17 + q];
                tk_merge16(run, oth);
#pragma unroll
                for (int q = 0; q < 16; ++q) Ls[(tl * 2 + p) * 17 + q] = run[q]; }
            __syncthreads();
            if (tid < 128) tk_stage2(Ls + (tl * 2) * 17, Ls + (tl * 2) * 17 + 17, IDX, GATEW, (size_t)(u.pm * 256 + ai * 128 + tl) * 128 + u.pn * 16);
            __syncthreads();
        }
    }
};
struct OneUnit {
    pg8::Unit u;
    __device__ __forceinline__ bool next(int i, pg8::Unit& o) const { if (i) return false; o = u; return true; }
    __device__ __forceinline__ void a_ready(const pg8::Unit&) const {}
    __device__ __forceinline__ void done(const pg8::Unit&) const {}
};

DI float gelu_erf(float x) { return 0.5f * x * (1.f + erff(x * 0.7071067811865476f)); }
#define DPP_ADD(v, ctrl, rmask) ((v) + __builtin_bit_cast(float, __builtin_amdgcn_update_dpp(0, __builtin_bit_cast(int, (v)), (ctrl), (rmask), 0xF, false)))
#ifndef PEER_EBL
#define PEER_EBL 9
#endif
constexpr int PEER_EB_LOG = PEER_EBL;
#ifndef PEER_PROBE_MASK
#define PEER_PROBE_MASK 0xFFFF
#endif
typedef float f32x2v __attribute__((ext_vector_type(2)));
DI float gelu_cdf(float v) {
    const float av = fabsf(v), t = __builtin_amdgcn_rcpf(av * 0.2316418882f + 1.0f);
    float q = t * 0.5307027145f - 0.7265760135f; q = q * t + 0.7107068705f; q = q * t - 0.142248368f; q = q * t + 0.127414796f; q = q * t;
    const float m = v * (q * ex2(v * v * -0.72134752044f));
    return v < 0.f ? m : v - m;
}
#define DPP_ADDI(v, ctrl, rmask) ((v) + __builtin_amdgcn_update_dpp(0, (v), (ctrl), (rmask), 0xF, false))
DI void peer_phase(const Frame& F, bool scratch_dst) {
    bf16* const XN_ = WSP(bf16, WS_XN); int* const IDX_ = WSP(int, WS_IDX); float* const GATEW_ = WSP(float, WS_GATE); float* const mod_ = WSP(float, WS_MOD); float* const out_ = (float*)inp(I_OUT);
    const unsigned char* const EU8 = WSP(unsigned char, WS_EXPU); const unsigned char* const EV8 = WSP(unsigned char, WS_EXPV); const float* const SUI_ = WSP(float, WS_SUI); const float* const SVI_ = WSP(float, WS_SVI);
    const int gw = F.vcu * NWAVES + F.wave, NGW = F.G * NWAVES, lane = F.lane, g = lane >> 3, j = lane & 7;
    LAS unsigned char* wl = F.lds + F.wave * 16384;
    volatile LAS int* Le = (volatile LAS int*)(wl + g * 512); volatile LAS float* Lg = (volatile LAS float*)(wl + 4096 + g * 512); volatile LAS int* Lp = (volatile LAS int*)(wl + 8192 + g * 512);
    LAS int* Lh = (LAS int*)(wl + 12288 + g * 128);
    for (int grp = gw; grp < T / 8; grp += NGW) {
        const size_t t = (size_t)grp * 8 + g;
        int xi[32]; float sxi;
        {
            float mx = 0.f; v4u xr[8];
#pragma unroll
            for (int hq = 0; hq < 8; ++hq) { const bf16* xp = XN_ + t * D + 128 * hq + 16 * j; const v4u a = *(const GAS v4u*)xp, b = *(const GAS v4u*)(xp + 8);
                xr[hq] = a;
#pragma unroll
                for (int e = 0; e < 4; ++e) mx = fmaxf(mx, fmaxf(fmaxf(fabsf(bflo(a[e])), fabsf(bfhi(a[e]))), fmaxf(fabsf(bflo(b[e])), fabsf(bfhi(b[e]))))); }
            mx = fmaxf(mx, __shfl_xor(mx, 1, 8)); mx = fmaxf(mx, __shfl_xor(mx, 2, 8)); mx = fmaxf(mx, __shfl_xor(mx, 4, 8));
            const float sx = mx > 0.f ? 127.f / mx : 0.f; sxi = mx > 0.f ? mx / 127.f : 0.f;
#pragma unroll
            for (int hq = 0; hq < 8; ++hq) { const bf16* xp = XN_ + t * D + 128 * hq + 16 * j; const v4u a = xr[hq], b = *(const GAS v4u*)(xp + 8);
#pragma unroll
                for (int e = 0; e < 2; ++e) {
                    const int q0 = (int)rintf(bflo(a[2 * e]) * sx), q1 = (int)rintf(bfhi(a[2 * e]) * sx), q2 = (int)rintf(bflo(a[2 * e + 1]) * sx), q3 = (int)rintf(bfhi(a[2 * e + 1]) * sx);
                    xi[4 * hq + e] = (int)((unsigned)(q0 & 0xff) | ((unsigned)(q1 & 0xff) << 8) | ((unsigned)(q2 & 0xff) << 16) | ((unsigned)q3 << 24));
                    const int p0 = (int)rintf(bflo(b[2 * e]) * sx), p1 = (int)rintf(bfhi(b[2 * e]) * sx), p2 = (int)rintf(bflo(b[2 * e + 1]) * sx), p3 = (int)rintf(bfhi(b[2 * e + 1]) * sx);
                    xi[4 * hq + 2 + e] = (int)((unsigned)(p0 & 0xff) | ((unsigned)(p1 & 0xff) << 8) | ((unsigned)(p2 & 0xff) << 16) | ((unsigned)p3 << 24)); } }
        }
        {
            int ide[16]; float gte[16]; int rk[16];
#pragma unroll
            for (int m = 0; m < 16; ++m) { ide[m] = IDX_[t * 128 + j + 8 * m]; gte[m] = GATEW_[t * 128 + j + 8 * m]; }
#pragma unroll
            for (int m = 0; m < 4; ++m) Lh[j + 8 * m] = 0;
#pragma unroll
            for (int m = 0; m < 16; ++m) rk[m] = __hip_atomic_fetch_add(Lh + (ide[m] >> PEER_EB_LOG), 1, __ATOMIC_RELAXED, __HIP_MEMORY_SCOPE_WORKGROUP);
            {
                const int h0 = ((volatile LAS int*)Lh)[4 * j], h1 = ((volatile LAS int*)Lh)[4 * j + 1], h2 = ((volatile LAS int*)Lh)[4 * j + 2], h3 = ((volatile LAS int*)Lh)[4 * j + 3];
                const int tot = (h0 + h1) + (h2 + h3); int inc = tot;
#pragma unroll
                for (int o = 1; o < 8; o <<= 1) { const int tt = __shfl_up(inc, o, 8); if (j >= o) inc += tt; }
                const int ex = inc - tot;
                ((volatile LAS int*)Lh)[4 * j] = ex; ((volatile LAS int*)Lh)[4 * j + 1] = ex + h0; ((volatile LAS int*)Lh)[4 * j + 2] = ex + h0 + h1; ((volatile LAS int*)Lh)[4 * j + 3] = ex + h0 + h1 + h2;
            }
#pragma unroll
            for (int m = 0; m < 16; ++m) { const int pos = ((volatile LAS int*)Lh)[ide[m] >> PEER_EB_LOG] + rk[m]; Le[pos] = ide[m]; Lg[pos] = gte[m]; }
        }
        v4u R0[4], R1[4], R2[4], R3[4];
#define PEER_ROFF(S0, H) ((size_t)(Le[(S0)] & (scratch_dst ? PEER_PROBE_MASK : 0xFFFF)) * 1024 + 512 * (H) + 16 * j)
#define PEER_LOADT(TAB, RR, S0, H) do { const size_t ro_ = PEER_ROFF(S0, H); _Pragma("unroll") for (int q = 0; q < 4; ++q) RR[q] = *(const GAS v4u*)((TAB) + ro_ + 128 * q); } while (0)
#define PEER_DOTI(RR, H, EOUT) do { int d0_ = 0, d1_ = 0, d2_ = 0, d3_ = 0; \
            _Pragma("unroll") for (int w_ = 0; w_ < 4; ++w_) { d0_ = __builtin_amdgcn_sdot4((int)RR[0][w_], xi[16 * (H) + w_], d0_, false); d1_ = __builtin_amdgcn_sdot4((int)RR[1][w_], xi[16 * (H) + 4 + w_], d1_, false); \
                d2_ = __builtin_amdgcn_sdot4((int)RR[2][w_], xi[16 * (H) + 8 + w_], d2_, false); d3_ = __builtin_amdgcn_sdot4((int)RR[3][w_], xi[16 * (H) + 12 + w_], d3_, false); } \
            int e_ = (d0_ + d1_) + (d2_ + d3_); e_ = DPP_ADDI(e_, 0xB1, 0xF); e_ = DPP_ADDI(e_, 0x4E, 0xF); e_ = DPP_ADDI(e_, 0x141, 0xF); EOUT = e_; } while (0)
#define PEER_SWEEP(TAB, H, BODY0, BODY1, BODY2, BODY3) do { \
            PEER_LOADT(TAB, R0, 0, H); PEER_LOADT(TAB, R1, 1, H); PEER_LOADT(TAB, R2, 2, H); PEER_LOADT(TAB, R3, 3, H); \
            for (int s = 0; s < 128; s += 4) { \
                BODY0; if (s + 4 < 128) PEER_LOADT(TAB, R0, s + 4, H); \
                BODY1; if (s + 4 < 128) PEER_LOADT(TAB, R1, s + 5, H); \
                BODY2; if (s + 4 < 128) PEER_LOADT(TAB, R2, s + 6, H); \
                BODY3; if (s + 4 < 128) PEER_LOADT(TAB, R3, s + 7, H); } } while (0)
        { int e0_;
          PEER_SWEEP(EU8, 0, ({ PEER_DOTI(R0, 0, e0_); Lp[s] = e0_; }), ({ PEER_DOTI(R1, 0, e0_); Lp[s + 1] = e0_; }), ({ PEER_DOTI(R2, 0, e0_); Lp[s + 2] = e0_; }), ({ PEER_DOTI(R3, 0, e0_); Lp[s + 3] = e0_; })); }
        float cmax = 0.f;
#define PEER_FIN(RR, SS) do { int e1_; PEER_DOTI(RR, 1, e1_); const int ex_ = Le[(SS)] & 0xFFFF; const float cf__ = Lg[(SS)] * SVI_[ex_] * gelu_cdf((float)(e1_ + Lp[(SS)]) * (SUI_[ex_] * sxi)); \
            Lg[(SS)] = cf__; cmax = fmaxf(cmax, fabsf(cf__)); } while (0)
        PEER_SWEEP(EU8, 1, PEER_FIN(R0, s), PEER_FIN(R1, s + 1), PEER_FIN(R2, s + 2), PEER_FIN(R3, s + 3));
#undef PEER_FIN
        const float cqs = cmax > 0.f ? 127.f / cmax : 0.f, yscale = cmax > 0.f ? cmax / 127.f : 0.f;
        {
            int pk_[4];
#pragma unroll
            for (int m = 0; m < 4; ++m) { const int d_ = 4 * j + m;
                const int q0 = (int)rintf(Lg[4 * d_] * cqs), q1 = (int)rintf(Lg[4 * d_ + 1] * cqs), q2 = (int)rintf(Lg[4 * d_ + 2] * cqs), q3 = (int)rintf(Lg[4 * d_ + 3] * cqs);
                pk_[m] = (int)((unsigned)(q0 & 0xff) | ((unsigned)(q1 & 0xff) << 8) | ((unsigned)(q2 & 0xff) << 16) | ((unsigned)q3 << 24)); }
#pragma unroll
            for (int m = 0; m < 4; ++m) Lp[4 * j + m] = pk_[m];
        }
#pragma unroll
        for (int H = 0; H < 2; ++H) {
            int yi[64];
#pragma unroll
            for (int i = 0; i < 64; ++i) yi[i] = 0;
            PEER_LOADT(EV8, R0, 0, H); PEER_LOADT(EV8, R1, 1, H); PEER_LOADT(EV8, R2, 2, H); PEER_LOADT(EV8, R3, 3, H);
            for (int bt = 0; bt < 32; ++bt) {
                const int cq_ = Lp[bt];
                size_t ro0_ = 0, ro1_ = 0, ro2_ = 0, ro3_ = 0;
                if (bt + 1 < 32) { ro0_ = PEER_ROFF(4 * bt + 4, H); ro1_ = PEER_ROFF(4 * bt + 5, H); ro2_ = PEER_ROFF(4 * bt + 6, H); ro3_ = PEER_ROFF(4 * bt + 7, H); }
#pragma unroll
                for (int q = 0; q < 4; ++q) {
#pragma unroll
                    for (int w_ = 0; w_ < 4; ++w_) { const unsigned a0 = R0[q][w_], a1 = R1[q][w_], a2 = R2[q][w_], a3 = R3[q][w_];
                        const unsigned p0 = __builtin_amdgcn_perm(a1, a0, 0x05010400u), p1 = __builtin_amdgcn_perm(a1, a0, 0x07030602u), p2 = __builtin_amdgcn_perm(a3, a2, 0x05010400u), p3 = __builtin_amdgcn_perm(a3, a2, 0x07030602u);
                        yi[16 * q + 4 * w_ + 0] = __builtin_amdgcn_sdot4((int)__builtin_amdgcn_perm(p2, p0, 0x05040100u), cq_, yi[16 * q + 4 * w_ + 0], false);
                        yi[16 * q + 4 * w_ + 1] = __builtin_amdgcn_sdot4((int)__builtin_amdgcn_perm(p2, p0, 0x07060302u), cq_, yi[16 * q + 4 * w_ + 1], false);
                        yi[16 * q + 4 * w_ + 2] = __builtin_amdgcn_sdot4((int)__builtin_amdgcn_perm(p3, p1, 0x05040100u), cq_, yi[16 * q + 4 * w_ + 2], false);
                        yi[16 * q + 4 * w_ + 3] = __builtin_amdgcn_sdot4((int)__builtin_amdgcn_perm(p3, p1, 0x07060302u), cq_, yi[16 * q + 4 * w_ + 3], false); }
                    if (bt + 1 < 32) { R0[q] = *(const GAS v4u*)(EV8 + ro0_ + 128 * q); R1[q] = *(const GAS v4u*)(EV8 + ro1_ + 128 * q); R2[q] = *(const GAS v4u*)(EV8 + ro2_ + 128 * q); R3[q] = *(const GAS v4u*)(EV8 + ro3_ + 128 * q); }
                }
            }
            const int b = (int)(t / SEQ);
            const float* g2 = mod_ + b * NMOD + 5120 + 512 * H + 16 * j;
            const float* ip = out_ + t * D + 512 * H + 16 * j; float* op = (scratch_dst ? WSP(float, WS_SCORES) : out_) + t * D + 512 * H + 16 * j;
#pragma unroll
            for (int q = 0; q < 4; ++q)
#pragma unroll
                for (int c4 = 0; c4 < 4; ++c4) { const f32x4 x1 = *(const GAS f32x4*)(ip + 128 * q + 4 * c4); const f32x4 gg = *(const f32x4*)(g2 + 128 * q + 4 * c4) * yscale;
                    f32x4 o; o.x = x1.x + gg.x * (float)yi[16 * q + 4 * c4]; o.y = x1.y + gg.y * (float)yi[16 * q + 4 * c4 + 1]; o.z = x1.z + gg.z * (float)yi[16 * q + 4 * c4 + 2]; o.w = x1.w + gg.w * (float)yi[16 * q + 4 * c4 + 3];
                    *(GAS f32x4*)(op + 128 * q + 4 * c4) = o; }
        }
#undef PEER_ROFF
#undef PEER_LOADT
#undef PEER_DOTI
#undef PEER_SWEEP
    }
}

DI void ph_inproj(const Frame& F) {
    pg8::Gemm g{WSP(bf16, WS_XN), WSP(bf16, WS_WIN), T, NPROJ, D}; pg8::StaticOrder S; S.init(T, NPROJ, F.G, (int)blockIdx.x);
    pg8::EpiBf16<0> E{WSP(bf16, WS_PROJ), NPROJ, nullptr, 0, 0, 1.f};
    pg8::gemm_phase<pg8::EpiBf16<0>, pg8::StaticOrder, PG8_ALIGN, PG8_SP2>(F.lds, g, S, E);
}
DI void ph_mix(const Frame& F, bool probe_first) {
    stage_conv_w(F);
    {
        int u = F.vcu;
        MlLocalRegs ra;
        if (u < 2048) ml_local_load(F, u >> 6, u & 63, ra);
        const int gwv = F.vcu * NWAVES + F.wave, NGWv = F.G * NWAVES;
        int eb = 2 * gwv;
        while (u < 2048) {
            const int un = u + F.G;
            MlLocalRegs rb;
            if (un < 2048) ml_local_load(F, un >> 6, un & 63, rb);
            ExpRows2 er; const bool ew = eb < 32768;
            if (ew) exp_load2(F, eb, er);
            ml_local_unit(F, u >> 6, u & 63, ra);
            if (ew) exp_conv2(F, eb, er);
            eb += 2 * NGWv;
            ra = rb; u = un;
        }
        for (; eb < 32768; eb += 2 * NGWv) { ExpRows2 er; exp_load2(F, eb, er); exp_conv2(F, eb, er); }
    }
    (void)probe_first;
}
DI void ph_scan_attn(const Frame& F) {
    ml_scan_phase(F);
    __syncthreads();
    for (int u = F.vcu; u < 1024; u += F.G) { const int qb = 15 - (u >> 6), bh = u & 63; sb_unit(F, bh >> 3, bh & 7, qb); }
}
DI void ph_mlout(const Frame& F) { stage_conv_w(F); for (int u = F.vcu; u < 2048; u += F.G) ml_out_unit(F, u >> 6, u & 63); }
#ifndef P5_ALIGN
#define P5_ALIGN PG8_ALIGN
#endif
DI void ph_outproj(const Frame& F) {
    pg8::Gemm g{WSP(bf16, WS_MIX), WSP(bf16, WS_WOUT), T, D, D}; pg8::StaticOrder S; S.init(T, D, F.G, (int)blockIdx.x);
    pg8::EpiResGate E{inp(I_X), (float*)inp(I_OUT), WSP(float, WS_MOD) + 2048, NMOD, SEQ, D};
    pg8::gemm_phase<pg8::EpiResGate, pg8::StaticOrder, P5_ALIGN, PG8_SP2>(F.lds, g, S, E);
}
DI void ph_scores(const Frame& F) {
    pg8::Gemm g{WSP(bf16, WS_XN), WSP(bf16, WS_WEFF), T, NSC, D}; pg8::StaticOrder S; S.init(T, NSC, F.G, (int)blockIdx.x);
    EpiTopK E{WSP(int, WS_IDX), WSP(float, WS_GATE)};
    pg8::Unit un;
    for (int i = 0; S.next(i, un); ++i) { OneUnit S1{un}; pg8::gemm_phase<EpiTopK, OneUnit, false, PG8_SP2>(F.lds, g, S1, E); }
}
constexpr int N_PHASES = 11;
struct Args { const float* in[19]; float* out; unsigned char* ws; int ph_lo, ph_hi; };
__global__ void __launch_bounds__(NTHR, 2) hybrid_fwd(Args args) {
    extern __shared__ __attribute__((aligned(16))) unsigned char lds_raw[];
    Frame F;
    F.lds = (LAS unsigned char*)lds_raw;
    F.MISC = (volatile LAS unsigned*)(F.lds + LDSCTL_OFF + 320);
    F.tid = threadIdx.x; F.lane = F.tid & 63; F.wave = __builtin_amdgcn_readfirstlane(F.tid >> 6);
    F.G = gridDim.x; { const int bx = blockIdx.x; F.vcu = (F.G % 8 == 0) ? (bx % 8) * (F.G / 8) + bx / 8 : bx; }
    F.ws = args.ws;
    F.ctl = (gu32*)(F.ws + WS_CTL);
    for (int u = F.tid; u < (LDS_BYTES - LDSCTL_OFF) / 4; u += NTHR) ((LAS unsigned*)(F.lds + LDSCTL_OFF))[u] = 0u;
    __syncthreads();
    const int lo = args.ph_lo, hi = args.ph_hi;
    const bool one_launch = (hi - lo) > 1;
    XcdBarrier bar; bar.bar = (unsigned*)(F.ctl + CW_BAR); bar.x = 0; bar.st = nullptr;
    if (one_launch) bar = xcd_barrier_post((unsigned*)(F.ctl + CW_BAR), F.MISC + 8);
#ifndef PHMASK
#define PHMASK 0x7ff
#endif
#define IN(k) (((PHMASK >> (k)) & 1) && lo <= (k) && (k) < hi)
#define SEAM(k) do { if (IN(k) && IN((k) + 1)) xcd_barrier(bar); } while (0)
#ifndef REPMASK
#define REPMASK 0
#endif

#define RUN(k, ...) do { if (IN(k)) { if ((REPMASK >> (k)) & 1) { { const bool first = true; (void)first; __VA_ARGS__; } xcd_barrier(bar); } { const bool first = false; (void)first; __VA_ARGS__; } } } while (0)
    RUN(0, p0_phase(F, first ? P0_PARTS : 15)); SEAM(0);
    RUN(1, norm_phase<true>(F, inp(I_X), inp(I_GN1), 0, 1024)); SEAM(1);
    RUN(2, ph_inproj(F)); SEAM(2);
    RUN(3, ph_mix(F, first)); SEAM(3);
    RUN(10, ph_scan_attn(F)); if (IN(10) && IN(4)) xcd_barrier(bar);
    RUN(4, ph_mlout(F)); SEAM(4);
    RUN(5, ph_outproj(F)); SEAM(5);
    RUN(6, norm_phase<false>(F, inp(I_OUT), inp(I_GN2), 3072, 4096)); SEAM(6);
    RUN(7, ph_scores(F)); if (IN(7) && IN(9)) xcd_barrier(bar);
    RUN(9, peer_phase(F, first));
#undef RUN
#undef IN
#undef SEAM
}

#ifndef MK_PER_PHASE
#define MK_PER_PHASE 0
#endif
extern "C" void kernel_launch(void* const* d_in, const int* in_sizes, int n_in, void* d_out, int out_size, void* d_ws, size_t ws_size, hipStream_t stream) {
    static int grid = 0;
    if (grid == 0) {
        if (n_in != 19 || in_sizes[0] != T * D || out_size != T * D || ws_size < WS_END) { fprintf(stderr, "kernel_launch: unexpected shapes (n_in %d, in0 %d, out %d, ws %zu)\n", n_in, n_in > 0 ? in_sizes[0] : -1, out_size, ws_size); grid = -1; return; }
        int dev = 0, cus = 0, per_cu = 0;
        if (hipGetDevice(&dev) != hipSuccess || hipDeviceGetAttribute(&cus, hipDeviceAttributeMultiprocessorCount, dev) != hipSuccess) { grid = -1; return; }
        if (hipFuncSetAttribute((const void*)hybrid_fwd, hipFuncAttributeMaxDynamicSharedMemorySize, LDS_BYTES) != hipSuccess) { fprintf(stderr, "kernel_launch: hipFuncSetAttribute failed\n"); grid = -1; return; }
        if (hipOccupancyMaxActiveBlocksPerMultiprocessor(&per_cu, (const void*)hybrid_fwd, NTHR, LDS_BYTES) != hipSuccess || per_cu < 1) fprintf(stderr, "kernel_launch: occupancy query says %d\n", per_cu);
        (void)hipGetLastError();
        grid = cus;
    }
    if (grid < 0) return;
    if (hipMemsetAsync((char*)d_ws + WS_CTL, 0, CTL_ZERO_BYTES, stream) != hipSuccess) { fprintf(stderr, "kernel_launch: memset failed\n"); return; }
    Args a{};
    for (int i = 0; i < 19; ++i) a.in[i] = (const float*)d_in[i];
    a.out = (float*)d_out; a.ws = (unsigned char*)d_ws;
#if MK_PER_PHASE
    { const int order[N_PHASES] = {0, 1, 2, 3, 10, 4, 5, 6, 7, 8, 9}; for (int i = 0; i < N_PHASES; ++i) { a.ph_lo = order[i]; a.ph_hi = order[i] + 1; hipLaunchKernelGGL(hybrid_fwd, dim3(grid), dim3(NTHR), LDS_BYTES, stream, a); } }
#else
    a.ph_lo = 0; a.ph_hi = N_PHASES;
    hipLaunchKernelGGL(hybrid_fwd, dim3(grid), dim3(NTHR), LDS_BYTES, stream, a);
#endif
    const hipError_t le = hipPeekAtLastError();
    if (le != hipSuccess) fprintf(stderr, "kernel_launch: launch failed: %s\n", hipGetErrorName(le));
}
```

```cpp
#include <cmath>
#include <hip/hip_runtime.h>
#include <cstdio>
#include <cstdint>
namespace pg8 {
#define PG8_LAS __attribute__((address_space(3)))
typedef unsigned short bf16_t;
typedef short bf16x8 __attribute__((ext_vector_type(8)));
typedef float f32x4 __attribute__((ext_vector_type(4)));
typedef unsigned u32x4 __attribute__((ext_vector_type(4)));
constexpr int BM = 256, BK = 64, HALF = 128, HTB = HALF * BK * 2  , STAGE_BYTES = 8 * HTB, NXCD = 8,
#ifndef PG8_WGM
#define PG8_WGM 4
#endif
WGM = PG8_WGM;

__host__ __device__ __forceinline__ int lds_byte(int r, int c) { const int st = (r >> 4) * 2 + (c >> 5), rr = r & 15, cc = c & 31, ob = rr * 64 + cc * 2; return st * 1024 + (ob ^ (((ob >> 9) & 1) << 5)); }
__host__ __device__ __forceinline__ void stage_rc(int b, int& R, int& C) { const int st = b / 1024, sb = b % 1024, swz = sb ^ (((sb >> 9) & 1) << 5); R = (st >> 1) * 16 + swz / 64; C = (st & 1) * 32 + (swz % 64) / 2; }
__host__ __device__ __forceinline__ int perm32(int rho) { const int n = rho >> 4, i = rho & 15; return 8 * (i >> 2) + 4 * n + (i & 3); }

struct Unit { int pm, pn; };
struct Gemm { const bf16_t* A; const bf16_t* Bt; int M, N, K; };

struct StaticOrder {
    int nM, nN, nwg, G, c;
    __host__ __device__ void init(int M, int N, int G_, int c_) { nM = M / BM; nN = N / BM; nwg = nM * nN; G = G_; c = c_; }
    __host__ __device__ bool next(int i, Unit& u) const {
        const long L = (long)i * G + c; if (L >= nwg) return false;
        int wgid = (int)L; { const int q = nwg / NXCD, r = nwg % NXCD, xcd = wgid % NXCD, off = wgid / NXCD; wgid = (xcd < r ? xcd * (q + 1) : r * (q + 1) + (xcd - r) * q) + off; }
        const int nig = WGM * nN, gid = wgid / nig, fm = gid * WGM, gsz = (nM - fm) < WGM ? (nM - fm) : WGM;
        u.pm = fm + ((wgid % nig) % gsz); u.pn = (wgid % nig) / gsz; return true;
    }
    __device__ __forceinline__ void a_ready(const Unit&) const {}
    __device__ __forceinline__ void done(const Unit&) const {}
};

__device__ __forceinline__ unsigned cvt_pk_bf16(float lo, float hi) { unsigned r; asm volatile("v_cvt_pk_bf16_f32 %0, %1, %2" : "=v"(r) : "v"(lo), "v"(hi)); return r; }
typedef float f32x2 __attribute__((ext_vector_type(2)));
__device__ __forceinline__ f32x2 gelu_pk(f32x2 v) {
    const f32x2 av = __builtin_elementwise_abs(v), d = av * 0.2316418882f + 1.0f;
    f32x2 t; t.x = __builtin_amdgcn_rcpf(d.x); t.y = __builtin_amdgcn_rcpf(d.y);
    f32x2 q = t * 0.5307027145f + (-0.7265760135f); q = q * t + 0.7107068705f; q = q * t + (-0.142248368f); q = q * t + 0.127414796f; q = q * t;
    const f32x2 s = (v * v) * (-0.72134752044f);
    f32x2 e; e.x = __builtin_amdgcn_exp2f(s.x); e.y = __builtin_amdgcn_exp2f(s.y);
    const f32x2 m = v * (q * e), r = v - m;
    f32x2 o; o.x = v.x < 0.f ? m.x : r.x; o.y = v.y < 0.f ? m.y : r.y; return o;
}

template <int ACT  > struct EpiBf16 {
    static constexpr bool PERM = true, AFTER_DRAIN = false; static_assert(ACT == 0 || ACT == 1, "EpiBf16: ACT is 0 (none) or 1 (gelu_pk)");
    bf16_t* O; int ldc; const float* bias; int split_cols; size_t split_stride; float scale0;
    __device__ __forceinline__ void operator()(const f32x4 (&acc)[2][2][4][2], const Unit& u, int wr, int wc, int fr, int fq) const {
        const int row0 = u.pm * BM + wr * 64 + fr; int colt = u.pn * BM; bf16_t* base = O;
        float sc = 1.f; if (split_cols) { const int t = colt / split_cols; base += (size_t)t * split_stride; colt -= t * split_cols; if (t == 0) sc = scale0; }
        const int col0 = colt + wc * 32 + 8 * fq, bcol0 = u.pn * BM + wc * 32 + 8 * fq;
        f32x4 bv[2][2];
#pragma unroll
        for (int bj = 0; bj < 2; ++bj)
#pragma unroll
            for (int n = 0; n < 2; ++n) bv[bj][n] = bias ? *(const f32x4*)(bias + bcol0 + bj * HALF + 4 * n) : (f32x4){0.f, 0.f, 0.f, 0.f};
#pragma unroll
        for (int ai = 0; ai < 2; ++ai)
#pragma unroll
            for (int m = 0; m < 4; ++m) { bf16_t* rowp = base + (size_t)(row0 + ai * HALF + m * 16) * ldc + col0;
#pragma unroll
                for (int bj = 0; bj < 2; ++bj) { f32x4 v0 = acc[ai][bj][m][0] + bv[bj][0], v1 = acc[ai][bj][m][1] + bv[bj][1];
                    if (ACT == 1) { f32x2 a = gelu_pk((f32x2){v0[0], v0[1]}), b = gelu_pk((f32x2){v0[2], v0[3]}), c = gelu_pk((f32x2){v1[0], v1[1]}), d = gelu_pk((f32x2){v1[2], v1[3]});
                        v0 = (f32x4){a.x, a.y, b.x, b.y}; v1 = (f32x4){c.x, c.y, d.x, d.y}; }
                    v0 = v0 * sc; v1 = v1 * sc; u32x4 w; w.x = cvt_pk_bf16(v0[0], v0[1]); w.y = cvt_pk_bf16(v0[2], v0[3]); w.z = cvt_pk_bf16(v1[0], v1[1]); w.w = cvt_pk_bf16(v1[2], v1[3]);
                    *(u32x4*)(rowp + bj * HALF) = w; } }
    }
};
template <class Epi, class Sched, bool ALIGN_EPI = false, bool SP2 = false>
__device__ __forceinline__ void gemm_phase(PG8_LAS unsigned char* lds, const Gemm g, const Sched& S, const Epi& E) {
    const int tid = threadIdx.x, wid = __builtin_amdgcn_readfirstlane(tid >> 6), lane = tid & 63, wr = wid >> 2, wc = wid & 3, fr = lane & 15, fq = lane >> 4;
    const int K = g.K, nt = K / BK;
    unsigned voffA[2], voffB[2];
#pragma unroll
    for (int i = 0; i < 2; ++i) { int R, C; stage_rc(tid * 16 + i * 8192, R, C); const int Rb = Epi::PERM ? ((R & ~31) + perm32(R & 31)) : R;
        voffA[i] = (unsigned)(R * K + C) * 2u; voffB[i] = (unsigned)(Rb * K + C) * 2u; }
    const size_t kstep = (size_t)(BK * 2);
    const size_t hstep = (size_t)HALF * K * 2;
    const size_t tstep = 2 * hstep;
    const unsigned ldsw = (unsigned)wid * 1024u;
    const int aoff = lds_byte(wr * 64 + fr, fq * 8), boff = lds_byte(wc * 32 + fr, fq * 8);
#define PG8_SA(b, h) (((b) * 2 + (h)) * HTB)
#define PG8_SB(b, h) ((4 + (b) * 2 + (h)) * HTB)
#define PG8_STAGE(bufoff, gbase, voff) do { _Pragma("unroll") for (int _i = 0; _i < 2; ++_i) \
        __builtin_amdgcn_global_load_lds((const unsigned*)((const char*)(gbase) + (voff)[_i]), (PG8_LAS unsigned*)(lds + (bufoff) + ldsw + _i * 8192), 16, 0, 0); } while (0)
#define PG8_LDA(dst, b, h) do { _Pragma("unroll") for (int m = 0; m < 4; ++m) _Pragma("unroll") for (int k = 0; k < 2; ++k) dst[m][k] = *(const PG8_LAS bf16x8*)(lds + PG8_SA(b, h) + aoff + m * 2048 + k * 1024); } while (0)
#define PG8_LDB(dst, b, h) do { _Pragma("unroll") for (int n = 0; n < 2; ++n) _Pragma("unroll") for (int k = 0; k < 2; ++k) dst[n][k] = *(const PG8_LAS bf16x8*)(lds + PG8_SB(b, h) + boff + n * 2048 + k * 1024); } while (0)
#define PG8_MMA(ai, bj, At, Bt) do { __builtin_amdgcn_s_setprio(1); _Pragma("unroll") for (int m = 0; m < 4; ++m) _Pragma("unroll") for (int n = 0; n < 2; ++n) _Pragma("unroll") for (int k = 0; k < 2; ++k) \
        acc[ai][bj][m][n] = __builtin_amdgcn_mfma_f32_16x16x32_bf16(Bt[n][k], At[m][k], acc[ai][bj][m][n], 0, 0, 0); __builtin_amdgcn_s_setprio(0); } while (0)
#define PG8_WAIT_V(n) asm volatile("s_waitcnt vmcnt(" #n ")" ::: "memory")
#define PG8_WAIT_L(n) asm volatile("s_waitcnt lgkmcnt(" #n ")" ::: "memory")
#define PG8_BAR __builtin_amdgcn_s_barrier()
#define PG8_SCHED __builtin_amdgcn_sched_barrier(0)
    Unit cur, nxt; int ui = 0;
    if (!S.next(0, cur)) return;
    f32x4 acc[2][2][4][2];
#pragma unroll
    for (int a = 0; a < 2; ++a)
#pragma unroll
        for (int b = 0; b < 2; ++b)
#pragma unroll
            for (int m = 0; m < 4; ++m)
#pragma unroll
                for (int n = 0; n < 2; ++n) acc[a][b][m][n] = (f32x4){0.f, 0.f, 0.f, 0.f};
    bf16x8 At[4][2], B0[2][2], B1[2][2];
    const char* cA = (const char*)g.A + (size_t)cur.pm * tstep; const char* cB = (const char*)g.Bt + (size_t)cur.pn * tstep;
    S.a_ready(cur);
    if constexpr (SP2) {
        PG8_STAGE(PG8_SB(0, 0), cB, voffB); PG8_STAGE(PG8_SB(0, 1), cB + hstep, voffB); PG8_STAGE(PG8_SA(0, 0), cA, voffA); PG8_STAGE(PG8_SA(0, 1), cA + hstep, voffA);
        if (wr == 1) PG8_BAR;
        PG8_WAIT_V(2); PG8_BAR;
        PG8_STAGE(PG8_SB(1, 0), cB + kstep, voffB); PG8_STAGE(PG8_SA(1, 0), cA + kstep, voffA); PG8_STAGE(PG8_SB(1, 1), cB + hstep + kstep, voffB);
        PG8_WAIT_V(6); PG8_BAR;
    } else {
        PG8_STAGE(PG8_SB(0, 0), cB, voffB); PG8_STAGE(PG8_SA(0, 0), cA, voffA); PG8_STAGE(PG8_SB(0, 1), cB + hstep, voffB); PG8_STAGE(PG8_SA(0, 1), cA + hstep, voffA);
        if (wr == 1) PG8_BAR;
        PG8_WAIT_V(4); PG8_BAR;
        PG8_STAGE(PG8_SB(1, 0), cB + kstep, voffB); PG8_STAGE(PG8_SA(1, 0), cA + kstep, voffA); PG8_STAGE(PG8_SB(1, 1), cB + hstep + kstep, voffB);
        PG8_WAIT_V(6); PG8_BAR;
    }
    for (;;) {
        const bool has_next = S.next(ui + 1, nxt);
        const char* nA = has_next ? (const char*)g.A + (size_t)nxt.pm * tstep : cA; const char* nB = has_next ? (const char*)g.Bt + (size_t)nxt.pn * tstep : cB;
        for (int t = 0; t < nt; t += 2) {
            const bool last = (t == nt - 2);
            const char* a1 = cA + (size_t)(t + 1) * kstep;
            const char* a2 = last ? nA : cA + (size_t)(t + 2) * kstep; const char* b2 = last ? nB : cB + (size_t)(t + 2) * kstep;
            const char* a3 = a2 + kstep; const char* b3 = b2 + kstep;
            if (last && has_next) S.a_ready(nxt);
            if constexpr (SP2) {
            PG8_LDB(B0, 0, 0); PG8_LDB(B1, 0, 1); PG8_SCHED; PG8_LDA(At, 0, 0); PG8_STAGE(PG8_SA(1, 1), a1 + hstep, voffA);
            PG8_WAIT_V(8); PG8_WAIT_L(0); PG8_BAR; PG8_MMA(0, 0, At, B0); PG8_MMA(0, 1, At, B1); PG8_BAR; PG8_SCHED;
            PG8_LDA(At, 0, 1); PG8_STAGE(PG8_SB(0, 0), b2, voffB); PG8_STAGE(PG8_SB(0, 1), b2 + hstep, voffB); PG8_STAGE(PG8_SA(0, 0), a2, voffA);
            PG8_WAIT_V(8); PG8_WAIT_L(0); PG8_BAR; PG8_MMA(1, 0, At, B0); PG8_MMA(1, 1, At, B1); PG8_BAR; PG8_SCHED;
            PG8_LDB(B0, 1, 0); PG8_LDB(B1, 1, 1); PG8_SCHED; PG8_LDA(At, 1, 0); PG8_STAGE(PG8_SA(0, 1), a2 + hstep, voffA);
            PG8_WAIT_V(8); PG8_WAIT_L(0); PG8_BAR; PG8_MMA(0, 0, At, B0); PG8_MMA(0, 1, At, B1); PG8_BAR; PG8_SCHED;
            PG8_LDA(At, 1, 1); PG8_STAGE(PG8_SB(1, 0), b3, voffB); PG8_STAGE(PG8_SB(1, 1), b3 + hstep, voffB); PG8_STAGE(PG8_SA(1, 0), a3, voffA);
            PG8_WAIT_V(8); PG8_WAIT_L(0); PG8_BAR; PG8_MMA(1, 0, At, B0); PG8_MMA(1, 1, At, B1); PG8_BAR; PG8_SCHED;
            } else {
            PG8_LDB(B0, 0, 0); PG8_SCHED; PG8_LDA(At, 0, 0); PG8_STAGE(PG8_SA(1, 1), a1 + hstep, voffA);
            PG8_WAIT_L(8); PG8_BAR; PG8_WAIT_L(0); PG8_MMA(0, 0, At, B0); PG8_BAR; PG8_SCHED;
            PG8_LDB(B1, 0, 1); PG8_STAGE(PG8_SB(0, 0), b2, voffB);
            PG8_BAR; PG8_WAIT_L(0); PG8_MMA(0, 1, At, B1); PG8_BAR;
            PG8_LDA(At, 0, 1); PG8_STAGE(PG8_SA(0, 0), a2, voffA);
            PG8_BAR; PG8_WAIT_L(0); PG8_MMA(1, 0, At, B0); PG8_BAR; PG8_SCHED;
            PG8_STAGE(PG8_SB(0, 1), b2 + hstep, voffB);
            PG8_WAIT_V(6); PG8_BAR; PG8_MMA(1, 1, At, B1); PG8_BAR;
            PG8_LDB(B0, 1, 0); PG8_SCHED; PG8_LDA(At, 1, 0); PG8_STAGE(PG8_SA(0, 1), a2 + hstep, voffA);
            PG8_WAIT_L(8); PG8_BAR; PG8_WAIT_L(0); PG8_MMA(0, 0, At, B0); PG8_BAR; PG8_SCHED;
            PG8_LDB(B1, 1, 1); PG8_STAGE(PG8_SB(1, 0), b3, voffB);
            PG8_BAR; PG8_WAIT_L(0); PG8_MMA(0, 1, At, B1); PG8_BAR;
            PG8_LDA(At, 1, 1); PG8_STAGE(PG8_SA(1, 0), a3, voffA);
            PG8_BAR; PG8_WAIT_L(0); PG8_MMA(1, 0, At, B0); PG8_BAR; PG8_SCHED;
            PG8_STAGE(PG8_SB(1, 1), b3 + hstep, voffB);
            PG8_WAIT_V(6); PG8_BAR; PG8_MMA(1, 1, At, B1); PG8_BAR;
            }
        }
        if constexpr (ALIGN_EPI) { if (wr == 0) PG8_BAR; }
        if constexpr (!Epi::AFTER_DRAIN) { E(acc, cur, wr, wc, fr, fq); S.done(cur); }
        if (!has_next) break;
#pragma unroll
        for (int a = 0; a < 2; ++a)
#pragma unroll
            for (int b = 0; b < 2; ++b)
#pragma unroll
                for (int m = 0; m < 4; ++m)
#pragma unroll
                    for (int n = 0; n < 2; ++n) acc[a][b][m][n] = (f32x4){0.f, 0.f, 0.f, 0.f};
        cur = nxt; cA = nA; cB = nB; ++ui;
        if constexpr (ALIGN_EPI) { if (wr == 1) PG8_BAR; }
    }
    PG8_WAIT_V(0);
    if constexpr (!ALIGN_EPI) { if (wr == 0) PG8_BAR; }
    PG8_BAR;
    if constexpr (Epi::AFTER_DRAIN) { E.fused(acc, cur, wr, wc, fr, fq, lds, wid, lane); S.done(cur); }
#undef PG8_SA
#undef PG8_SB
#undef PG8_STAGE
#undef PG8_LDA
#undef PG8_LDB
#undef PG8_MMA
#undef PG8_WAIT_V
#undef PG8_WAIT_L
#undef PG8_BAR
#undef PG8_SCHED
}
}

#ifndef PG8_SP2
#define PG8_SP2 true
#endif
#ifndef PG8_ALIGN
#define PG8_ALIGN true
#endif

namespace pg8 {
struct EpiResGate {
    static constexpr bool PERM = false, AFTER_DRAIN = false;
    const float* base; float* out; const float* gate; int gate_ld; int rows_per_batch; int ldc;
    __device__ __forceinline__ void operator()(const f32x4 (&acc)[2][2][4][2], const Unit& u, int wr, int wc, int fr, int fq) const {
        const int row0 = u.pm * BM + wr * 64 + fr, col0 = u.pn * BM + wc * 32 + 4 * fq;
        const float* gp = gate + (size_t)((u.pm * BM) / rows_per_batch) * gate_ld + col0;
        f32x4 gv[2][2];
#pragma unroll
        for (int bj = 0; bj < 2; ++bj)
#pragma unroll
            for (int n = 0; n < 2; ++n) gv[bj][n] = *(const f32x4*)(gp + bj * HALF + n * 16);
#pragma unroll
        for (int ai = 0; ai < 2; ++ai)
#pragma unroll
            for (int m = 0; m < 4; ++m) { const size_t off = (size_t)(row0 + ai * HALF + m * 16) * ldc + col0;
#pragma unroll
                for (int bj = 0; bj < 2; ++bj)
#pragma unroll
                    for (int n = 0; n < 2; ++n) { const f32x4 bs = *(const f32x4*)(base + off + bj * HALF + n * 16);
                        *(f32x4*)(out + off + bj * HALF + n * 16) = bs + gv[bj][n] * acc[ai][bj][m][n]; } }
    }
};
struct EpiF32 {
    static constexpr bool PERM = false, AFTER_DRAIN = false;
    float* O; int ldc;
    __device__ __forceinline__ void operator()(const f32x4 (&acc)[2][2][4][2], const Unit& u, int wr, int wc, int fr, int fq) const {
        const int row0 = u.pm * BM + wr * 64 + fr, col0 = u.pn * BM + wc * 32 + 4 * fq;
#pragma unroll
        for (int ai = 0; ai < 2; ++ai)
#pragma unroll
            for (int m = 0; m < 4; ++m) { const size_t off = (size_t)(row0 + ai * HALF + m * 16) * ldc + col0;
#pragma unroll
                for (int bj = 0; bj < 2; ++bj)
#pragma unroll
                    for (int n = 0; n < 2; ++n) *(f32x4*)(O + off + bj * HALF + n * 16) = acc[ai][bj][m][n]; }
    }
};
}
#define GAS __attribute__((address_space(1)))
#define LAS __attribute__((address_space(3)))
typedef unsigned short bf16;
typedef unsigned v4u __attribute__((ext_vector_type(4)));
typedef float f32x4 __attribute__((ext_vector_type(4)));
typedef short bf16x8 __attribute__((ext_vector_type(8)));
typedef GAS unsigned gu32;
typedef GAS unsigned long long gu64;
#define RLX_AGENT __ATOMIC_RELAXED, __HIP_MEMORY_SCOPE_AGENT
#define LDS_WAIT() asm volatile("s_waitcnt lgkmcnt(0)" ::: "memory")
#define VM_WAIT() asm volatile("s_waitcnt vmcnt(0)" ::: "memory")
__device__ __forceinline__ unsigned long long rt() { return __builtin_amdgcn_s_memrealtime(); }
__device__ __forceinline__ unsigned f2bf(float f) { unsigned u = __builtin_bit_cast(unsigned, f); return (u + 0x7fffu + ((u >> 16) & 1u)) >> 16; }
__device__ __forceinline__ unsigned pk2(float lo, float hi) { return f2bf(lo) | (f2bf(hi) << 16); }

#define XB_TMO      128
#define XB_XCNT(j)  (256  + 64 * (j))
#define XB_XSUB(j)  (1280 + 64 * (j))
#define XB_XGEN(j)  (2304 + 64 * (j))
#define XB_TOP      3328
#define XB_TOPGEN   3392
#define XCD_BAR_WORDS 3456
#define XB_SPIN_CAP (1u << 24)

__device__ __forceinline__ unsigned xb_ld(unsigned* p)              { return __hip_atomic_load(p, __ATOMIC_RELAXED, __HIP_MEMORY_SCOPE_AGENT); }
__device__ __forceinline__ unsigned xb_add(unsigned* p, unsigned v) { return __hip_atomic_fetch_add(p, v, __ATOMIC_RELAXED, __HIP_MEMORY_SCOPE_AGENT); }
__device__ __forceinline__ unsigned xb_xcc_id() { return (unsigned)__builtin_amdgcn_s_getreg((3 << 11) | 20) & 0xFu; }
#define XB_SPIN(cond, bar) do { unsigned _sp = 0; while (cond) { __builtin_amdgcn_s_sleep(1); \
    if ((++_sp & 255u) == 0u) { if (xb_ld(&(bar)[XB_TMO])) break; if (_sp > XB_SPIN_CAP) { atomicAdd(&(bar)[XB_TMO], 1u); break; } } } } while (0)

struct XcdBarrier {
    unsigned* bar; unsigned x;
    volatile LAS unsigned* st;
};

__device__ __forceinline__ XcdBarrier xcd_barrier_post(unsigned* bar, volatile LAS unsigned* st) {
    XcdBarrier b; b.bar = bar; b.x = xb_xcc_id(); b.st = st;
    if (threadIdx.x == 0) (void)xb_add(&bar[XB_XCNT(b.x)], 1u);
    return b;
}
__device__ __forceinline__ void xcd_barrier_complete(unsigned* bar, unsigned x, unsigned& nloc, unsigned& nx) {
    const unsigned G = gridDim.x * gridDim.y * gridDim.z;
    unsigned sum, cnt, mine, sp = 0u;
    for (;;) {
        sum = 0u; cnt = 0u; mine = 0u;
#pragma unroll
        for (unsigned j = 0; j < 16; ++j) { const unsigned c = xb_ld(&bar[XB_XCNT(j)]); sum += c; cnt += (c > 0u) ? 1u : 0u; mine = (j == x) ? c : mine; }
        if (sum == G) break;
        __builtin_amdgcn_s_sleep(1);
        if ((++sp & 255u) == 0u) { if (xb_ld(&bar[XB_TMO])) break; if (sp > XB_SPIN_CAP) { atomicAdd(&bar[XB_TMO], 1u); break; } }
    }
    nloc = mine > 0u ? mine : 1u; nx = cnt > 0u ? cnt : 1u;
}

__device__ __forceinline__ void xcd_barrier(const XcdBarrier& b) {
    asm volatile("s_waitcnt vmcnt(0)" ::: "memory");
    __syncthreads();
    if (threadIdx.x == 0) {
        unsigned* bar = b.bar;
        __builtin_amdgcn_s_waitcnt(0);
        unsigned nloc = b.st[0], nx = b.st[1];
        if (nloc == 0u) { xcd_barrier_complete(bar, b.x, nloc, nx); b.st[0] = nloc; b.st[1] = nx; }
        const unsigned old = xb_add(&bar[XB_XSUB(b.x)], 1u);
        const unsigned gen = old / nloc;
        if (old + 1u == (gen + 1u) * nloc) {
            __builtin_amdgcn_fence(__ATOMIC_RELEASE, "agent");
            asm volatile("s_waitcnt vmcnt(0)" ::: "memory");
            const unsigned og = xb_add(&bar[XB_TOP], 1u);
            const unsigned tg = og / nx;
            if (og + 1u == (tg + 1u) * nx) xb_add(&bar[XB_TOPGEN], 1u);
            else XB_SPIN(xb_ld(&bar[XB_TOPGEN]) == tg, bar);
            __builtin_amdgcn_fence(__ATOMIC_ACQUIRE, "agent");
            xb_add(&bar[XB_XGEN(b.x)], 1u);
            asm volatile("s_waitcnt vmcnt(0)" ::: "memory");
        } else {
            XB_SPIN(xb_ld(&bar[XB_XGEN(b.x)]) == gen, bar);
            __builtin_amdgcn_fence(__ATOMIC_ACQUIRE, "agent");
            asm volatile("s_waitcnt vmcnt(0)" ::: "memory");
        }
    }
    __syncthreads();
}

constexpr int NWAVES = 8, NTHR = 512;
constexpr int NB = 8, SEQ = 4096, T = NB * SEQ, D = 1024, NPROJ = 3584, NIN = 3592, NMOD = 6144, NSC = 2048;
constexpr int C_QSB = 0, C_KSB = 512, C_VSB = 1024, C_QML = 1536, C_KML = 2048, C_VML = 2560, C_OML = 3072;
constexpr float EPS = 1e-6f, LOG2E = 1.4426950408889634f;
constexpr size_t MiB = 1u << 20;
constexpr size_t WS_CTL = 0, CTL_ZERO_BYTES = 1 * MiB;
constexpr size_t WS_MOD = 256 * 1024;
constexpr size_t WS_WIN = 2 * MiB, WS_WOUT = 10 * MiB, WS_WEFF = 12 * MiB;
constexpr size_t WS_XN = 16 * MiB;
constexpr size_t WS_PROJ = 80 * MiB;
constexpr size_t WS_MIX = 304 * MiB;
constexpr size_t WS_EXPU = 368 * MiB, WS_EXPV = 400 * MiB;
constexpr size_t WS_CST = 432 * MiB;
constexpr size_t WS_NST = 496 * MiB;
constexpr size_t WS_MST = 497 * MiB;
constexpr size_t WS_GATES = 498 * MiB;
constexpr size_t WS_SCORES = 80 * MiB;
constexpr size_t WS_IDX = 336 * MiB, WS_GATE = 352 * MiB;
constexpr size_t WS_SCL = 499 * MiB;
constexpr size_t WS_SUI = 499 * MiB + 65536, WS_SVI = 499 * MiB + 131072;
constexpr size_t WS_END = 500 * MiB;
constexpr int CW_Q3 = 64;
constexpr int CW_BAR = 4096;
constexpr int LDS_BYTES = 147456, LDSCTL_OFF = 143360;

typedef float f32x16 __attribute__((ext_vector_type(16)));
typedef float f32x2_t __attribute__((ext_vector_type(2)));
typedef __bf16 bf16x2_t __attribute__((ext_vector_type(2)));
typedef _Float16 f16x8 __attribute__((ext_vector_type(8)));
typedef short s16x4 __attribute__((ext_vector_type(4)));
typedef unsigned u32x2 __attribute__((ext_vector_type(2)));
#define DI __device__ __forceinline__
DI unsigned cvtpk(float lo, float hi) { f32x2_t v = {lo, hi}; bf16x2_t b = __builtin_convertvector(v, bf16x2_t); return __builtin_bit_cast(unsigned, b); }
DI float bflo(unsigned u) { return __uint_as_float(u << 16); }
DI float bfhi(unsigned u) { return __uint_as_float(u & 0xffff0000u); }
DI int crow(int i, int hi) { return (i & 3) + 8 * (i >> 2) + 4 * hi; }
DI int krow(int s, int hi, int j) { return 16 * s + 8 * (j >> 2) + 4 * hi + (j & 3); }
DI float swap_add(float v) { auto rr = __builtin_amdgcn_permlane32_swap(__float_as_uint(v), __float_as_uint(v), false, false); return __uint_as_float(rr[0]) + __uint_as_float(rr[1]); }
DI float swap_max(float v) { auto rr = __builtin_amdgcn_permlane32_swap(__float_as_uint(v), __float_as_uint(v), false, false); return fmaxf(__uint_as_float(rr[0]), __uint_as_float(rr[1])); }
DI float dot2bf(unsigned a, unsigned b, float acc) { return __builtin_amdgcn_fdot2_f32_bf16(__builtin_bit_cast(bf16x2_t, a), __builtin_bit_cast(bf16x2_t, b), acc, false); }
DI float ex2(float x) { return __builtin_amdgcn_exp2f(x); }
DI float lg2(float x) { return __builtin_amdgcn_logf(x); }
DI float fexp(float x) { return __builtin_amdgcn_exp2f(x * LOG2E); }
DI float wave_sum(float v) {
#pragma unroll
    for (int o = 1; o < 64; o <<= 1) v += __shfl_xor(v, o);
    return v;
}
DI float wave_max(float v) {
#pragma unroll
    for (int o = 1; o < 64; o <<= 1) v = fmaxf(v, __shfl_xor(v, o));
    return v;
}
#define DPP_MAXF(v, ctrl, rmask) fmaxf((v), __builtin_bit_cast(float, __builtin_amdgcn_update_dpp(0, __builtin_bit_cast(int, (v)), (ctrl), (rmask), 0xF, false)))
DI float wave_max_nonneg(float v) {
    v = DPP_MAXF(v, 0xB1, 0xF); v = DPP_MAXF(v, 0x4E, 0xF); v = DPP_MAXF(v, 0x141, 0xF); v = DPP_MAXF(v, 0x140, 0xF); v = DPP_MAXF(v, 0x142, 0xA); v = DPP_MAXF(v, 0x143, 0xC);
    return __builtin_bit_cast(float, __builtin_amdgcn_readlane(__builtin_bit_cast(int, v), 63));
}
#define DPP_ADDF(v, ctrl, rmask) ((v) + __builtin_bit_cast(float, __builtin_amdgcn_update_dpp(0, __builtin_bit_cast(int, (v)), (ctrl), (rmask), 0xF, false)))
DI float wave_sum_u(float v) {
    v = DPP_ADDF(v, 0xB1, 0xF); v = DPP_ADDF(v, 0x4E, 0xF); v = DPP_ADDF(v, 0x141, 0xF); v = DPP_ADDF(v, 0x140, 0xF); v = DPP_ADDF(v, 0x142, 0xA); v = DPP_ADDF(v, 0x143, 0xC);
    return __builtin_bit_cast(float, __builtin_amdgcn_readlane(__builtin_bit_cast(int, v), 63));
}
typedef short v4i16_t __attribute__((ext_vector_type(4)));
DI s16x4 trrd(LAS unsigned char* p) { return __builtin_bit_cast(s16x4, __builtin_amdgcn_ds_read_tr16_b64_v4i16((LAS v4i16_t*)p)); }
DI bf16x8 cat8(s16x4 a, s16x4 b) { return (bf16x8){a[0], a[1], a[2], a[3], b[0], b[1], b[2], b[3]}; }
#define MFMA_BF16(a, b, c) __builtin_amdgcn_mfma_f32_32x32x16_bf16((a), (b), (c), 0, 0, 0)
#define MFMA_F16(a, b, c) __builtin_amdgcn_mfma_f32_32x32x16_f16((a), (b), (c), 0, 0, 0)
DI unsigned pkh(float a, float b) { return __builtin_bit_cast(unsigned, __builtin_amdgcn_cvt_pkrtz(a, b)); }
DI bf16x8 packbf(const f32x16& x, int s) { v4u p; p.x = cvtpk(x[8 * s], x[8 * s + 1]); p.y = cvtpk(x[8 * s + 2], x[8 * s + 3]); p.z = cvtpk(x[8 * s + 4], x[8 * s + 5]); p.w = cvtpk(x[8 * s + 6], x[8 * s + 7]); return __builtin_bit_cast(bf16x8, p); }
DI f16x8 packh(const f32x16& x, int s) { v4u p; p.x = pkh(x[8 * s], x[8 * s + 1]); p.y = pkh(x[8 * s + 2], x[8 * s + 3]); p.z = pkh(x[8 * s + 4], x[8 * s + 5]); p.w = pkh(x[8 * s + 6], x[8 * s + 7]); return __builtin_bit_cast(f16x8, p); }

struct Frame {
    LAS unsigned char* lds;
    volatile LAS unsigned* MISC;
    gu32* ctl;
    unsigned char* ws;
    int tid, lane, wave, vcu, G;
};
DI const float* inp(int i) { const __attribute__((address_space(4))) unsigned long long* kp = (const __attribute__((address_space(4))) unsigned long long*)__builtin_amdgcn_kernarg_segment_ptr(); return (const float*)(const GAS float*)(*(volatile const __attribute__((address_space(4))) unsigned long long*)(kp + i)); }
enum { I_X = 0, I_C, I_WADA, I_BADA, I_GN1, I_WIN, I_BIG, I_BFG, I_CONVW, I_GQ, I_GK, I_GOSB, I_GOML, I_WOUT, I_GN2, I_WQ, I_SK, I_EU, I_EV, I_OUT };
#define WSP(type, off) ((type*)(F.ws + (off)))

DI void p0_transpose_item(const float* W, int K, int N, int ld, bf16* WT, LAS float* scr, int item, int lane) {
    const int nblk = N / 32, kb = item / nblk, nb = item % nblk, k0 = 64 * kb, n0 = 32 * nb;
    float tv[32];
#pragma unroll
    for (int i = 0; i < 32; ++i) tv[i] = W[(size_t)(k0 + 2 * i + (lane >> 5)) * ld + n0 + (lane & 31)];
#pragma unroll
    for (int i = 0; i < 32; ++i) scr[(2 * i + (lane >> 5)) * 33 + (lane & 31)] = tv[i];
    LDS_WAIT(); asm volatile("" ::: "memory");
    const int c = lane & 7;
#pragma unroll
    for (int j = 0; j < 4; ++j) { const int n = (lane >> 3) + 8 * j; const LAS float* s = scr + (8 * c) * 33 + n;
        v4u o; o.x = pk2(s[0 * 33], s[1 * 33]); o.y = pk2(s[2 * 33], s[3 * 33]); o.z = pk2(s[4 * 33], s[5 * 33]); o.w = pk2(s[6 * 33], s[7 * 33]);
        *(GAS v4u*)(WT + (size_t)(n0 + n) * K + k0 + 8 * c) = o; }
    LDS_WAIT(); asm volatile("" ::: "memory");
}
DI void p0_mod_block(const Frame& F, int item) {
    const float* const c_ = inp(I_C); const float* const w_ada_ = inp(I_WADA); const float* const b_ada_ = inp(I_BADA); float* const mod_ = WSP(float, WS_MOD);
    LAS float* scr = (LAS float*)(F.lds + F.wave * 16384);
    const int j = item * 64 + F.lane, d0 = F.wave * 128;
#pragma unroll
    for (int b = 0; b < 8; ++b)
#pragma unroll
        for (int q = 0; q < 2; ++q) { const float cv = c_[b * D + d0 + 64 * q + F.lane]; scr[b * 128 + 64 * q + F.lane] = cv / (1.f + fexp(-cv)); }
    LDS_WAIT(); asm volatile("" ::: "memory");
    float acc[8];
#pragma unroll
    for (int b = 0; b < 8; ++b) acc[b] = 0.f;
#pragma unroll 32
    for (int dd = 0; dd < 128; ++dd) { const float w = w_ada_[(size_t)(d0 + dd) * NMOD + j];
#pragma unroll
        for (int b = 0; b < 8; ++b) acc[b] += scr[b * 128 + dd] * w; }
#pragma unroll
    for (int b = 0; b < 8; ++b) scr[1024 + b * 64 + F.lane] = acc[b];
    __syncthreads();
    float tot = b_ada_[j];
#pragma unroll
    for (int w = 0; w < 8; ++w) tot += ((LAS float*)(F.lds + w * 16384))[1024 + F.wave * 64 + F.lane];
    mod_[F.wave * NMOD + j] = tot;
    __syncthreads();
}
DI void p0_weff_item(const Frame& F, int item) {
    const float* const sub_keys_ = inp(I_SK); const float* const w_q_peer_ = inp(I_WQ); bf16* const Weff_t_ = WSP(bf16, WS_WEFF);
    const int hp = item >> 4, dblk = item & 15;
    LAS float* sk = (LAS float*)F.lds;
    LAS float* rb = (LAS float*)(F.lds + 67584) + F.wave * 1024;
    { float tv[32];
#pragma unroll
      for (int i = 0; i < 32; ++i) tv[i] = sub_keys_[(size_t)hp * 16384 + F.tid + 512 * i];
#pragma unroll
      for (int i = 0; i < 32; ++i) { const int idx = F.tid + 512 * i; sk[(idx >> 7) * 129 + (idx & 127)] = tv[i]; } }
    const int d0 = 64 * dblk + 8 * F.wave;
#pragma unroll
    for (int r = 0; r < 8; ++r) { rb[r * 128 + F.lane] = w_q_peer_[(size_t)(d0 + r) * NSC + hp * 128 + F.lane]; rb[r * 128 + 64 + F.lane] = w_q_peer_[(size_t)(d0 + r) * NSC + hp * 128 + 64 + F.lane]; }
    __syncthreads();
    float a0[8], a1[8];
#pragma unroll
    for (int r = 0; r < 8; ++r) { a0[r] = 0.f; a1[r] = 0.f; }
#pragma unroll 4
    for (int c = 0; c < 128; ++c) { const float s0 = sk[F.lane * 129 + c], s1 = sk[(F.lane + 64) * 129 + c];
#pragma unroll
        for (int r = 0; r < 8; ++r) { const float a = rb[r * 128 + c]; a0[r] += a * s0; a1[r] += a * s1; } }
    v4u o0, o1; o0.x = pk2(a0[0], a0[1]); o0.y = pk2(a0[2], a0[3]); o0.z = pk2(a0[4], a0[5]); o0.w = pk2(a0[6], a0[7]);
    o1.x = pk2(a1[0], a1[1]); o1.y = pk2(a1[2], a1[3]); o1.z = pk2(a1[4], a1[5]); o1.w = pk2(a1[6], a1[7]);
    *(GAS v4u*)(Weff_t_ + (size_t)(hp * 128 + F.lane) * D + d0) = o0;
    *(GAS v4u*)(Weff_t_ + (size_t)(hp * 128 + 64 + F.lane) * D + d0) = o1;
    __syncthreads();
}
struct ExpRows2 { f32x4 v[2][4]; };
DI void exp_load2(const Frame& F, int blk0, ExpRows2& R) {
    const float* const expert_u_ = inp(I_EU); const float* const expert_v_ = inp(I_EV);
#pragma unroll
    for (int bb = 0; bb < 2; ++bb) { const int blk = blk0 + bb; const float* src = (blk < 16384 ? expert_u_ : expert_v_) + (size_t)(blk & 16383) * 1024 + 4 * F.lane;
#pragma unroll
        for (int k = 0; k < 4; ++k) R.v[bb][k] = __builtin_nontemporal_load((const GAS f32x4*)(src + 256 * k)); }
}
DI void exp_conv2(const Frame& F, int blk0, const ExpRows2& R) {
    float* const SUI_ = WSP(float, WS_SUI); float* const SVI_ = WSP(float, WS_SVI);
#pragma unroll
    for (int bb = 0; bb < 2; ++bb) { const int blk = blk0 + bb; const bool isu = blk < 16384; const int e = blk & 16383;
        float mx = 0.f;
#pragma unroll
        for (int k = 0; k < 4; ++k) mx = fmaxf(mx, fmaxf(fmaxf(fabsf(R.v[bb][k].x), fabsf(R.v[bb][k].y)), fmaxf(fabsf(R.v[bb][k].z), fabsf(R.v[bb][k].w))));
        mx = wave_max_nonneg(mx);
        if (isu) {
            float best = 3.0e38f, bs = 0.f;
#define EXP_TRY(FAC) do { const float s_ = mx * ((FAC) / 7.f), inv_ = s_ > 0.f ? 1.f / s_ : 0.f; float er_ = 0.f; \
                _Pragma("unroll") for (int k = 0; k < 4; ++k) _Pragma("unroll") for (int c = 0; c < 4; ++c) { const float v_ = R.v[bb][k][c]; const float d_ = v_ - s_ * fminf(fmaxf(rintf(v_ * inv_), -7.f), 7.f); er_ += d_ * d_; } \
                er_ = wave_sum_u(er_); if (er_ < best) { best = er_; bs = s_; } } while (0)
            EXP_TRY(1.f); EXP_TRY(0.86f); EXP_TRY(0.74f); EXP_TRY(0.63f);
#undef EXP_TRY
            const float inv = bs > 0.f ? 1.f / bs : 0.f;
            unsigned w01[2] = {0u, 0u};
#pragma unroll
            for (int k = 0; k < 4; ++k)
#pragma unroll
                for (int c = 0; c < 4; ++c) { const int q = (int)fminf(fmaxf(rintf(R.v[bb][k][c] * inv), -7.f), 7.f); w01[k >> 1] |= (unsigned)(q & 15) << (4 * (4 * (k & 1) + c)); }
            if (F.lane == 0) SUI_[e] = bs;
            typedef unsigned v2u_ __attribute__((ext_vector_type(2)));
            v2u_ wv; wv.x = w01[0]; wv.y = w01[1];
            *(GAS v2u_*)(WSP(unsigned char, WS_EXPU) + (size_t)e * 512 + 8 * F.lane) = wv;
        } else {
            const float top = 127.f, sc = mx > 0.f ? top / mx : 0.f;
            if (F.lane == 0) SVI_[e] = mx > 0.f ? mx / top : 0.f;
            unsigned char* dst = WSP(unsigned char, WS_EXPV) + (size_t)e * 1024 + 4 * F.lane;
#pragma unroll
            for (int k = 0; k < 4; ++k) { const f32x4 a = R.v[bb][k] * sc;
                const int q0 = (int)rintf(a.x), q1 = (int)rintf(a.y), q2 = (int)rintf(a.z), q3 = (int)rintf(a.w); const unsigned w = (unsigned)(q0 & 0xff) | ((unsigned)(q1 & 0xff) << 8) | ((unsigned)(q2 & 0xff) << 16) | ((unsigned)q3 << 24);
                *(GAS unsigned*)(dst + 256 * k) = w; }
        } }
}
#ifndef P0_PARTS
#define P0_PARTS 15
#endif
DI void p0_phase(const Frame& F, int parts = 15) {
    const float* const w_in_ = inp(I_WIN); bf16* const Win_t_ = WSP(bf16, WS_WIN); const float* const w_out_ = inp(I_WOUT); bf16* const Wout_t_ = WSP(bf16, WS_WOUT); const float* const expert_v_ = inp(I_EV); const float* const expert_u_ = inp(I_EU);
    LAS float* scr = (LAS float*)(F.lds + F.wave * 16384);
    const int gw = F.vcu * NWAVES + F.wave, NGW = F.G * NWAVES;
    if (parts & 1) for (int it = F.vcu; it < 96; it += F.G) p0_mod_block(F, it);
    constexpr int I_WIN = 16 * 112, I_WOUT = 16 * 32, NITEMS = I_WIN + I_WOUT;
    if (parts & 2) for (int it = gw; it < NITEMS; it += NGW) {
        int r = it;
        if (r < I_WIN) { p0_transpose_item(w_in_, D, NPROJ, NIN, Win_t_, scr, r, F.lane); continue; } r -= I_WIN;
        p0_transpose_item(w_out_, D, D, D, Wout_t_, scr, r, F.lane);
    }
    __syncthreads();
    if (parts & 8) for (int it = F.vcu; it < 256; it += F.G) p0_weff_item(F, it);
}

template <bool DOGATES>
DI void norm_phase(const Frame& F, const float* src, const float* g, int shift_off, int scale_off) {
    const float* const w_in_ = inp(I_WIN); float* const mod_ = WSP(float, WS_MOD); bf16* const XN_ = WSP(bf16, WS_XN); float* const GATES_ = WSP(float, WS_GATES); const float* const b_igate_ = inp(I_BIG); const float* const b_fgate_ = inp(I_BFG);
    LAS float* W8 = (LAS float*)F.lds;
    if (DOGATES) {
        for (int i = 0; i < 16; ++i) { const int idx = F.tid + 512 * i; W8[idx] = w_in_[(size_t)(idx & 1023) * NIN + NPROJ + (idx >> 10)]; }
        __syncthreads();
    }
    const int gw = F.vcu * NWAVES + F.wave, NGW = F.G * NWAVES;
    for (int ch = gw; ch < T / 16; ch += NGW) {
        const int r0 = ch * 16, b = r0 / SEQ;
        f32x4 A[4], Bv[4];
#pragma unroll
        for (int j = 0; j < 4; ++j) { const int col = 4 * F.lane + 256 * j; const f32x4 gg = *(const f32x4*)(g + col), sc = *(const f32x4*)(mod_ + b * NMOD + scale_off + col);
            A[j] = gg * (sc + 1.0f); Bv[j] = *(const f32x4*)(mod_ + b * NMOD + shift_off + col); }
        f32x4 nx[4];
        { const GAS f32x4* xr0 = (const GAS f32x4*)(src + (size_t)r0 * D) + F.lane;
#pragma unroll
          for (int j = 0; j < 4; ++j) nx[j] = __builtin_nontemporal_load(xr0 + 64 * j); }
        for (int rr = 0; rr < 16; ++rr) {
            const int row = r0 + rr;
            f32x4 v[4]; float s = 0.f;
#pragma unroll
            for (int j = 0; j < 4; ++j) { v[j] = nx[j]; s += (v[j].x * v[j].x + v[j].y * v[j].y) + (v[j].z * v[j].z + v[j].w * v[j].w); }
            if (rr + 1 < 16) { const GAS f32x4* xr = (const GAS f32x4*)(src + (size_t)(row + 1) * D) + F.lane;
#pragma unroll
                for (int j = 0; j < 4; ++j) nx[j] = __builtin_nontemporal_load(xr + 64 * j); }
            const float rstd = 1.f / sqrtf(wave_sum_u(s) * (1.f / D) + EPS);
#pragma unroll
            for (int j = 0; j < 4; ++j) v[j] = v[j] * rstd * A[j] + Bv[j];
            GAS unsigned long long* o8 = (GAS unsigned long long*)(XN_ + (size_t)row * D) + F.lane;
#pragma unroll
            for (int j = 0; j < 4; ++j) o8[64 * j] = (unsigned long long)pk2(v[j].x, v[j].y) | ((unsigned long long)pk2(v[j].z, v[j].w) << 32);
            if (DOGATES) {
                float res = 0.f;
#pragma unroll
                for (int hh = 0; hh < 8; ++hh) { float p = 0.f;
#pragma unroll
                    for (int j = 0; j < 4; ++j) { const f32x4 w = *(const LAS f32x4*)(W8 + hh * 1024 + 4 * F.lane + 256 * j); p += (v[j].x * w.x + v[j].y * w.y) + (v[j].z * w.z + v[j].w * w.w); }
                    p = wave_sum_u(p); if (F.lane == hh) res = p; }
                if (F.lane < 8) GATES_[(size_t)row * 8 + F.lane] = res + (F.lane < 4 ? b_igate_[F.lane] : b_fgate_[F.lane - 4]);
            }
        }
    }
}

DI void sb_unit(const Frame& F, int b, int h, int qb) {
    bf16* const PROJ_ = WSP(bf16, WS_PROJ); const float* const g_q_sb_ = inp(I_GQ); const float* const g_k_sb_ = inp(I_GK); bf16* const MIX_ = WSP(bf16, WS_MIX); const float* const g_out_sb_ = inp(I_GOSB);
    const int lane = F.lane, w = F.wave, r = lane & 31, hi = lane >> 5;
    const int i16 = lane & 15, qq = i16 >> 2, pp = i16 & 3, blk = (lane >> 4) & 1;
    LAS unsigned char* Wb = F.lds + w * 16384;
    const size_t rowbase = (size_t)b * SEQ; const int q0 = qb * 256, qw0 = q0 + 32 * w, tq = qw0 + r;
    const bf16* P = PROJ_;
    const bf16* kpiece[4]; const bf16* vpiece[4];
#pragma unroll
    for (int i = 0; i < 4; ++i) { const int krow_ = 8 * i + (lane >> 3), kch = (lane & 7) ^ ((krow_ >> 1) & 7); kpiece[i] = P + (rowbase + krow_) * NPROJ + C_KSB + h * 64 + 8 * kch;
        const int vkey = 16 * (i & 1) + (lane >> 2); vpiece[i] = P + (rowbase + vkey) * NPROJ + C_VSB + h * 64 + 32 * (i >> 1) + 8 * (lane & 3); }
#define SB_DMA(T_, BUF_) do { _Pragma("unroll") for (int i_ = 0; i_ < 4; ++i_) { \
        __builtin_amdgcn_global_load_lds((const unsigned*)(kpiece[i_] + (size_t)(32 * (T_)) * NPROJ), (LAS unsigned*)(Wb + 8192 * (BUF_) + 1024 * i_), 16, 0, 0); \
        __builtin_amdgcn_global_load_lds((const unsigned*)(vpiece[i_] + (size_t)(32 * (T_)) * NPROJ), (LAS unsigned*)(Wb + 8192 * (BUF_) + 4096 + 1024 * i_), 16, 0, 0); } } while (0)
    const int tw = (qw0 + 30) >> 5;
    SB_DMA(tw, 0);
    bf16x8 qf[4];
    {
        const bf16* Qp = P + (rowbase + tq) * NPROJ + C_QSB + h * 64 + 8 * hi;
        v4u qraw[4]; float ss = 0.f;
#pragma unroll
        for (int kk = 0; kk < 4; ++kk) { qraw[kk] = *(const GAS v4u*)(Qp + 16 * kk);
#pragma unroll
            for (int e = 0; e < 4; ++e) { const float a = bflo(qraw[kk][e]), c = bfhi(qraw[kk][e]); ss += a * a + c * c; } }
        ss = swap_add(ss);
        const float rq = __builtin_amdgcn_rsqf(ss * (1.f / 64.f) + EPS) * (0.125f * LOG2E);
#pragma unroll
        for (int kk = 0; kk < 4; ++kk) { const int d0 = 16 * kk + 8 * hi;
            const f32x4 g0 = *(const f32x4*)(g_q_sb_ + d0) * *(const f32x4*)(g_k_sb_ + d0), g1 = *(const f32x4*)(g_q_sb_ + d0 + 4) * *(const f32x4*)(g_k_sb_ + d0 + 4);
            v4u o; o.x = cvtpk(bflo(qraw[kk].x) * rq * g0.x, bfhi(qraw[kk].x) * rq * g0.y); o.y = cvtpk(bflo(qraw[kk].y) * rq * g0.z, bfhi(qraw[kk].y) * rq * g0.w);
            o.z = cvtpk(bflo(qraw[kk].z) * rq * g1.x, bfhi(qraw[kk].z) * rq * g1.y); o.w = cvtpk(bflo(qraw[kk].w) * rq * g1.z, bfhi(qraw[kk].w) * rq * g1.w);
            qf[kk] = __builtin_bit_cast(bf16x8, o); }
    }
    f16x8 U0, U1, E0;
#pragma unroll
    for (int j = 0; j < 8; ++j) { U0[j] = (krow(0, hi, j) > r) ? (_Float16)1.0f : (_Float16)0.0f; U1[j] = (krow(1, hi, j) > r) ? (_Float16)1.0f : (_Float16)0.0f;
        E0[j] = (j == 0 && hi == 0) ? (_Float16)1.0f : (_Float16)0.0f; }
    f32x16 o0, o1;
#pragma unroll
    for (int i = 0; i < 16; ++i) { o0[i] = 0.f; o1[i] = 0.f; }
    float R = 0.f;
    const int kfoff = r * 128, kfsw = (r >> 1) & 7;
    for (int t = tw; t >= 0; --t) {
        const int buf = (tw - t) & 1;
        LAS unsigned char* Kb = Wb + 8192 * buf; LAS unsigned char* Vb = Kb + 4096;
        asm volatile("s_waitcnt vmcnt(0)" ::: "memory");
        if (t > 0) SB_DMA(t - 1, buf ^ 1);
        bf16x8 kf[4]; float ssk = 0.f;
#pragma unroll
        for (int kk = 0; kk < 4; ++kk) { const v4u kv = *(const LAS v4u*)(Kb + kfoff + (((2 * kk + hi) ^ kfsw) * 16)); kf[kk] = __builtin_bit_cast(bf16x8, kv);
            ssk = dot2bf(kv.x, kv.x, ssk); ssk = dot2bf(kv.y, kv.y, ssk); ssk = dot2bf(kv.z, kv.z, ssk); ssk = dot2bf(kv.w, kv.w, ssk); }
        ssk = swap_add(ssk);
        const float rk = __builtin_amdgcn_rsqf(ssk * (1.f / 64.f) + EPS);
        f16x8 RKA;
#pragma unroll
        for (int e = 0; e < 8; ++e) RKA[e] = (_Float16)0.0f;
        RKA[0] = (hi == 0) ? (_Float16)rk : (_Float16)0.0f;
        f32x16 s, rkd;
#pragma unroll
        for (int i = 0; i < 16; ++i) { s[i] = 0.f; rkd[i] = 0.f; }
        rkd = MFMA_F16(RKA, E0, rkd);
#pragma unroll
        for (int kk = 0; kk < 4; ++kk) s = MFMA_BF16(kf[kk], qf[kk], s);
        float tsum = 0.f; unsigned lp[8];
        if (32 * t + 31 < qw0) {
#pragma unroll
            for (int i = 0; i < 16; i += 2) {
                const float z0_ = s[i] * rkd[i], z1_ = s[i + 1] * rkd[i + 1];
                const float a0_ = -lg2(1.f + ex2(z0_)), a1_ = -lg2(1.f + ex2(z1_));
                tsum += a0_ + a1_;
                s[i] = z0_ + a0_; s[i + 1] = z1_ + a1_;
                lp[i >> 1] = pkh(a0_, a1_); }
        } else {
            const int kq = tq - 32 * t;
#pragma unroll
            for (int i = 0; i < 16; i += 2) {
                const float z0_ = s[i] * rkd[i], z1_ = s[i + 1] * rkd[i + 1];
                float a0_ = -lg2(1.f + ex2(z0_)), a1_ = -lg2(1.f + ex2(z1_));
                const bool ma0 = crow(i, hi) >= kq, ma1 = crow(i + 1, hi) >= kq;
                a0_ = ma0 ? 0.f : a0_; a1_ = ma1 ? 0.f : a1_;
                tsum += a0_ + a1_;
                s[i] = ma0 ? -INFINITY : z0_ + a0_; s[i + 1] = ma1 ? -INFINITY : z1_ + a1_;
                lp[i >> 1] = pkh(a0_, a1_); }
        }
        f32x16 c;
#pragma unroll
        for (int i = 0; i < 16; ++i) c[i] = R;
        c = MFMA_F16(U0, __builtin_bit_cast(f16x8, (v4u){lp[0], lp[1], lp[2], lp[3]}), c); c = MFMA_F16(U1, __builtin_bit_cast(f16x8, (v4u){lp[4], lp[5], lp[6], lp[7]}), c);
#pragma unroll
        for (int i = 0; i < 16; ++i) s[i] = ex2(s[i] + c[i]);
        const bf16x8 W0 = packbf(s, 0), W1 = packbf(s, 1);
        LAS unsigned char* vb_ = Vb + (4 * hi + qq) * 64 + 32 * blk + 8 * pp;
        o0 = MFMA_BF16(cat8(trrd(vb_), trrd(vb_ + 8 * 64)), W0, o0); o0 = MFMA_BF16(cat8(trrd(vb_ + 16 * 64), trrd(vb_ + 24 * 64)), W1, o0);
        o1 = MFMA_BF16(cat8(trrd(vb_ + 2048), trrd(vb_ + 2048 + 8 * 64)), W0, o1); o1 = MFMA_BF16(cat8(trrd(vb_ + 2048 + 16 * 64), trrd(vb_ + 2048 + 24 * 64)), W1, o1);
        R += swap_add(tsum);
        if (__all(R < -150.f)) break;
    }
    asm volatile("s_waitcnt vmcnt(0)" ::: "memory");
#undef SB_DMA
    {
        float ss = 0.f;
#pragma unroll
        for (int i = 0; i < 16; ++i) ss += o0[i] * o0[i] + o1[i] * o1[i];
        ss = swap_add(ss);
        const float ro = __builtin_amdgcn_rsqf(ss * (1.f / 64.f) + EPS);
        bf16* Op = MIX_ + (rowbase + tq) * D + h * 64;
        const float* go = g_out_sb_ + h * 64;
#pragma unroll
        for (int g = 0; g < 4; ++g) { const int d0 = 8 * g + 4 * hi; const f32x4 ga = *(const f32x4*)(go + d0), gb = *(const f32x4*)(go + 32 + d0);
            u32x2 wa, wb; wa.x = cvtpk(o0[4 * g] * ro * ga.x, o0[4 * g + 1] * ro * ga.y); wa.y = cvtpk(o0[4 * g + 2] * ro * ga.z, o0[4 * g + 3] * ro * ga.w);
            wb.x = cvtpk(o1[4 * g] * ro * gb.x, o1[4 * g + 1] * ro * gb.y); wb.y = cvtpk(o1[4 * g + 2] * ro * gb.z, o1[4 * g + 3] * ro * gb.w);
            *(GAS u32x2*)(Op + d0) = wa; *(GAS u32x2*)(Op + 32 + d0) = wb; }
    }
    __syncthreads();
}

DI void conv_silu8(const v4u (&xr)[4], const float (&cw)[4][8], float scale, float (&y)[8]) {
#pragma unroll
    for (int e = 0; e < 8; ++e) y[e] = 0.f;
#pragma unroll
    for (int j = 0; j < 4; ++j) {
        y[0] += cw[j][0] * bflo(xr[j].x); y[1] += cw[j][1] * bfhi(xr[j].x); y[2] += cw[j][2] * bflo(xr[j].y); y[3] += cw[j][3] * bfhi(xr[j].y);
        y[4] += cw[j][4] * bflo(xr[j].z); y[5] += cw[j][5] * bfhi(xr[j].z); y[6] += cw[j][6] * bflo(xr[j].w); y[7] += cw[j][7] * bfhi(xr[j].w); }
#pragma unroll
    for (int e = 0; e < 8; ++e) y[e] = scale * y[e] * __builtin_amdgcn_rcpf(1.f + fexp(-y[e]));
}
DI float log_sigmoid(float x) { return fminf(x, 0.f) - 0.6931471805599453f * lg2(1.f + fexp(-fabsf(x))); }
DI float wave_scan_incl(float a, int lane) {
#pragma unroll
    for (int o = 1; o < 64; o <<= 1) { const float t = __shfl_up(a, o); if (lane >= o) a += t; }
    return a;
}

constexpr int LDS_CW = 65536;
DI void stage_conv_w(const Frame& F) {
    const float* const conv_w_ = inp(I_CONVW); LAS float* cwl = (LAS float*)(F.lds + LDS_CW);
    for (int i = F.tid; i < 4096; i += NTHR) cwl[i] = conv_w_[i];
    __syncthreads();
}
DI void load_cw8(const Frame& F, int colbase, float (&cw)[4][8]) {
    const LAS float* cwl = (const LAS float*)(F.lds + LDS_CW);
#pragma unroll
    for (int j = 0; j < 4; ++j) { const f32x4 a = *(const LAS f32x4*)(cwl + j * 1024 + colbase), b = *(const LAS f32x4*)(cwl + j * 1024 + colbase + 4);
        cw[j][0] = a.x; cw[j][1] = a.y; cw[j][2] = a.z; cw[j][3] = a.w; cw[j][4] = b.x; cw[j][5] = b.y; cw[j][6] = b.z; cw[j][7] = b.w; }
}
struct MlLocalRegs { v4u kraw[2][4]; v4u vraw[2]; float gi, gf; };
DI void ml_local_load(const Frame& F, int chain, int c, MlLocalRegs& R) {
    bf16* const PROJ_ = WSP(bf16, WS_PROJ); float* const GATES_ = WSP(float, WS_GATES);
    const int tid = F.tid, lane = F.lane;
    const int b = chain >> 2, hh = chain & 3; const size_t rowbase = (size_t)b * SEQ; const int t0 = c * 64;
    const bf16* P = PROJ_;
    const int kc = tid & 15, kr0 = tid >> 4;
    const bf16* Kg = P + rowbase * NPROJ + C_KML + hh * 128 + kc * 8;
#pragma unroll
    for (int i = 0; i < 2; ++i)
#pragma unroll
        for (int j = 0; j < 4; ++j) { const int tt = t0 + kr0 + 32 * i - 3 + j; R.kraw[i][j] = (tt >= 0) ? *(const GAS v4u*)(Kg + (size_t)tt * NPROJ) : (v4u){0u, 0u, 0u, 0u}; }
#pragma unroll
    for (int i = 0; i < 2; ++i) R.vraw[i] = *(const GAS v4u*)(P + (rowbase + t0 + kr0 + 32 * i) * NPROJ + C_VML + hh * 128 + kc * 8);
    const float* Gg = GATES_ + (rowbase + t0 + lane) * 8;
    R.gi = Gg[hh]; R.gf = Gg[4 + hh];
}
DI void ml_local_unit(const Frame& F, int chain, int c, const MlLocalRegs& RG) {
    bf16* const CST_ = WSP(bf16, WS_CST); float* const NST_ = WSP(float, WS_NST); float* const SCL_ = WSP(float, WS_SCL);
    LAS unsigned char* L = F.lds;
    LAS float* Lws = (LAS float*)(L + 32768);
    const int tid = F.tid, lane = F.lane, w = F.wave, r = lane & 31, hi = lane >> 5;
    const int i16 = lane & 15, qq = i16 >> 2, pp = i16 & 3, blk = (lane >> 4) & 1;
    const int hh = chain & 3;
    const int kbk = w & 3, vb0 = 2 * (w >> 2);
    const int kc = tid & 15, kr0 = tid >> 4;
    v4u kraw[2][4], vraw[2];
#pragma unroll
    for (int i = 0; i < 2; ++i) { vraw[i] = RG.vraw[i];
#pragma unroll
        for (int j = 0; j < 4; ++j) kraw[i][j] = RG.kraw[i][j]; }
    const float gi = RG.gi, gf = RG.gf;
    const float a = wave_scan_incl(log_sigmoid(gf), lane);
    const float a_end = __shfl(a, 63);
    const float lw = a_end - a + gi;
    const float m_loc = wave_max(lw);
    const float ws = fexp(lw - m_loc);
    if (w == 0) Lws[lane] = ws;
    {
        float cw[4][8]; load_cw8(F, 512 + hh * 128 + kc * 8, cw);
#pragma unroll
        for (int i = 0; i < 2; ++i) { float y[8]; conv_silu8(kraw[i], cw, 0.08838834764831845f, y);
            v4u o; o.x = cvtpk(y[0], y[1]); o.y = cvtpk(y[2], y[3]); o.z = cvtpk(y[4], y[5]); o.w = cvtpk(y[6], y[7]);
            *(LAS v4u*)(L + (kc >> 2) * 4096 + (kr0 + 32 * i) * 64 + (kc & 3) * 16) = o; }
#pragma unroll
        for (int i = 0; i < 2; ++i) { const int row = kr0 + 32 * i; const float wsr = __shfl(ws, row);
            v4u o; o.x = cvtpk(bflo(vraw[i].x) * wsr, bfhi(vraw[i].x) * wsr); o.y = cvtpk(bflo(vraw[i].y) * wsr, bfhi(vraw[i].y) * wsr); o.z = cvtpk(bflo(vraw[i].z) * wsr, bfhi(vraw[i].z) * wsr); o.w = cvtpk(bflo(vraw[i].w) * wsr, bfhi(vraw[i].w) * wsr);
            *(LAS v4u*)(L + 16384 + (kc >> 2) * 4096 + row * 64 + (kc & 3) * 16) = o; }
    }
    __syncthreads();
    f32x16 acc0, acc1;
#pragma unroll
    for (int i = 0; i < 16; ++i) { acc0[i] = 0.f; acc1[i] = 0.f; }
#pragma unroll
    for (int kk = 0; kk < 4; ++kk) { const int rows = 16 * kk + 8 * hi + qq;
        LAS unsigned char* ka = L + kbk * 4096 + rows * 64 + 32 * blk + 8 * pp; LAS unsigned char* va = L + 16384 + vb0 * 4096 + rows * 64 + 32 * blk + 8 * pp;
        const bf16x8 A = cat8(trrd(ka), trrd(ka + 4 * 64));
        acc0 = MFMA_BF16(A, cat8(trrd(va), trrd(va + 4 * 64)), acc0); acc1 = MFMA_BF16(A, cat8(trrd(va + 4096), trrd(va + 4096 + 4 * 64)), acc1); }
    {
        bf16* Cp = CST_ + ((size_t)(chain * 64 + c) * 128 + vb0 * 32 + r) * 128 + kbk * 32 + 4 * hi;
#pragma unroll
        for (int g = 0; g < 4; ++g) { u32x2 o; o.x = cvtpk(acc0[4 * g], acc0[4 * g + 1]); o.y = cvtpk(acc0[4 * g + 2], acc0[4 * g + 3]); *(GAS u32x2*)(Cp + 8 * g) = o;
            u32x2 o1; o1.x = cvtpk(acc1[4 * g], acc1[4 * g + 1]); o1.y = cvtpk(acc1[4 * g + 2], acc1[4 * g + 3]); *(GAS u32x2*)(Cp + 32 * 128 + 8 * g) = o1; }
    }
    {
        const int k = 16 * w + (lane & 15), sq = lane >> 4; float part = 0.f;
        const LAS unsigned short* kcol = (const LAS unsigned short*)(L + (k >> 5) * 4096 + (k & 31) * 2);
#pragma unroll
        for (int e = 0; e < 16; ++e) part += Lws[16 * sq + e] * __uint_as_float((unsigned)kcol[(16 * sq + e) * 32] << 16);
        part += __shfl_xor(part, 16); part += __shfl_xor(part, 32);
        if (lane < 16) NST_[(size_t)(chain * 64 + c) * 128 + k] = part;
        if (tid == 0) { SCL_[(chain * 64 + c) * 2] = a_end; SCL_[(chain * 64 + c) * 2 + 1] = m_loc; }
    }
    __syncthreads();
}
DI void ml_scan_phase(const Frame& F) {
    bf16* const CST_ = WSP(bf16, WS_CST); float* const NST_ = WSP(float, WS_NST); float* const SCL_ = WSP(float, WS_SCL); float* const MST_ = WSP(float, WS_MST);
    for (int gt = F.vcu * NTHR + F.tid; gt < 32 * 4096; gt += F.G * NTHR) {
        const int chain = gt >> 12, rem = gt & 4095;
        const float ae_l = SCL_[(chain * 64 + F.lane) * 2], ml_l = SCL_[(chain * 64 + F.lane) * 2 + 1];
        u32x2* Cp = (u32x2*)(CST_ + (size_t)chain * 64 * 16384 + (size_t)rem * 4);
        f32x4* Np = (f32x4*)(NST_ + (size_t)chain * 64 * 128 + rem * 4);
        const bool do_n = rem < 32;
        float c0 = 0.f, c1 = 0.f, c2 = 0.f, c3 = 0.f; f32x4 nn = {0.f, 0.f, 0.f, 0.f}; float m = 0.f;
        u32x2 dr[8]; f32x4 nr[8];
#pragma unroll
        for (int i = 0; i < 8; ++i) { dr[i] = Cp[(size_t)i * 4096]; if (do_n) nr[i] = Np[i * 32]; }
        for (int c0_ = 0; c0_ < 64; c0_ += 8) {
#pragma unroll
            for (int i = 0; i < 8; ++i) { const int c = c0_ + i;
                if (c < 63) {
                    const u32x2 dcur = dr[i]; const f32x4 dn = nr[i];
                    if (c + 8 < 63) { dr[i] = Cp[(size_t)(c + 8) * 4096]; if (do_n) nr[i] = Np[(c + 8) * 32]; }
                    const float ae = __builtin_bit_cast(float, __builtin_amdgcn_readlane(__builtin_bit_cast(int, ae_l), c)), ml = __builtin_bit_cast(float, __builtin_amdgcn_readlane(__builtin_bit_cast(int, ml_l), c));
                    const float mn = fmaxf(ae + m, ml), d1 = fexp(ae + m - mn), d2 = fexp(ml - mn);
                    c0 = d1 * c0 + d2 * bflo(dcur.x); c1 = d1 * c1 + d2 * bfhi(dcur.x); c2 = d1 * c2 + d2 * bflo(dcur.y); c3 = d1 * c3 + d2 * bfhi(dcur.y);
                    u32x2 o; o.x = cvtpk(c0, c1); o.y = cvtpk(c2, c3); Cp[(size_t)c * 4096] = o;
                    if (do_n) { nn = nn * d1 + dn * d2; Np[c * 32] = nn; }
                    if (rem == 0) MST_[chain * 64 + c] = mn;
                    m = mn; } }
        }
    }
}
DI void ml_out_unit(const Frame& F, int chain, int c) {
    bf16* const PROJ_ = WSP(bf16, WS_PROJ); float* const GATES_ = WSP(float, WS_GATES); float* const MST_ = WSP(float, WS_MST); bf16* const CST_ = WSP(bf16, WS_CST); float* const NST_ = WSP(float, WS_NST); bf16* const MIX_ = WSP(bf16, WS_MIX); const float* const g_out_ml_ = inp(I_GOML);
    LAS unsigned char* L = F.lds;
    LAS float* Lbs = (LAS float*)(L + 49152); LAS float* Lav = (LAS float*)(L + 49408); LAS float* Lex = (LAS float*)(L + 49664);
    const int tid = F.tid, lane = F.lane, w = F.wave, r = lane & 31, hi = lane >> 5;
    const int i16 = lane & 15, qq = i16 >> 2, pp = i16 & 3, blk = (lane >> 4) & 1;
    const int b = chain >> 2, hh = chain & 3; const size_t rowbase = (size_t)b * SEQ; const int t0 = c * 64;
    const int tb = w >> 2, vb = w & 3;
    const bf16* P = PROJ_;
    {
        const int kc = tid & 15, kr0 = tid >> 4;
#pragma unroll
        for (int which = 0; which < 2; ++which) {
            const int colbase = (which ? 512 : 0) + hh * 128 + kc * 8;
            float cw[4][8]; load_cw8(F, colbase, cw);
            const bf16* Xg = P + rowbase * NPROJ + C_QML + colbase;
#pragma unroll
            for (int i = 0; i < 2; ++i) { const int row = kr0 + 32 * i; v4u xr[4];
#pragma unroll
                for (int j = 0; j < 4; ++j) { const int tt = t0 + row - 3 + j; xr[j] = (tt >= 0) ? *(const GAS v4u*)(Xg + (size_t)tt * NPROJ) : (v4u){0u, 0u, 0u, 0u}; }
                float y[8]; conv_silu8(xr, cw, which ? 0.08838834764831845f : 1.0f, y);
                v4u o; o.x = cvtpk(y[0], y[1]); o.y = cvtpk(y[2], y[3]); o.z = cvtpk(y[4], y[5]); o.w = cvtpk(y[6], y[7]);
                *(LAS v4u*)(L + which * 16384 + row * 256 + ((kc ^ (row & 15)) * 16)) = o; }
        }
#pragma unroll
        for (int i = 0; i < 2; ++i) { const int row = kr0 + 32 * i;
            const v4u v = *(const GAS v4u*)(P + (rowbase + t0 + row) * NPROJ + C_VML + hh * 128 + kc * 8);
            *(LAS v4u*)(L + 32768 + (kc >> 2) * 4096 + row * 64 + (kc & 3) * 16) = v; }
        if (w == 0) { const float* Gg = GATES_ + (rowbase + t0 + lane) * 8; const float a = wave_scan_incl(log_sigmoid(Gg[4 + hh]), lane); Lav[lane] = a; Lbs[lane] = Gg[hh] - a; }
    }
    const float mprev = (c > 0) ? MST_[chain * 64 + c - 1] : 0.f;
    bf16x8 cf[8], nf[8];
    if (c > 0) {
        const bf16* Cp = CST_ + ((size_t)(chain * 64 + c - 1) * 128 + vb * 32 + r) * 128 + 8 * hi;
        const float* Np = NST_ + (size_t)(chain * 64 + c - 1) * 128 + 8 * hi;
        const bool nrow = (r == 0) || (r == 4);
#pragma unroll
        for (int kk = 0; kk < 8; ++kk) { cf[kk] = *(const GAS bf16x8*)(Cp + 16 * kk);
            const f32x4 n0 = *(const f32x4*)(Np + 16 * kk), n1 = *(const f32x4*)(Np + 16 * kk + 4);
            v4u o; o.x = cvtpk(n0.x, n0.y); o.y = cvtpk(n0.z, n0.w); o.z = cvtpk(n1.x, n1.y); o.w = cvtpk(n1.z, n1.w);
            if (!nrow) o = (v4u){0u, 0u, 0u, 0u};
            nf[kk] = __builtin_bit_cast(bf16x8, o); }
    }
    __syncthreads();
    bf16x8 qf[8];
    f32x16 s0, s1;
#pragma unroll
    for (int i = 0; i < 16; ++i) { s0[i] = 0.f; s1[i] = 0.f; }
#pragma unroll
    for (int kk = 0; kk < 8; ++kk) { const int ch = 2 * kk + hi; const int rq_ = 32 * tb + r;
        qf[kk] = *(const LAS bf16x8*)(L + rq_ * 256 + ((ch ^ (rq_ & 15)) * 16));
        const bf16x8 a0 = *(const LAS bf16x8*)(L + 16384 + r * 256 + ((ch ^ (r & 15)) * 16));
        const bf16x8 a1 = *(const LAS bf16x8*)(L + 16384 + (32 + r) * 256 + ((ch ^ ((32 + r) & 15)) * 16));
        s0 = MFMA_BF16(a0, qf[kk], s0); s1 = MFMA_BF16(a1, qf[kk], s1); }
    const int tl = 32 * tb + r; const float a_t = Lav[tl];
    f32x16 d0, d1; float mrow = -INFINITY;
#pragma unroll
    for (int g = 0; g < 4; ++g) { const f32x4 b0 = *(const LAS f32x4*)(Lbs + 8 * g + 4 * hi), b1 = *(const LAS f32x4*)(Lbs + 32 + 8 * g + 4 * hi);
#pragma unroll
        for (int e = 0; e < 4; ++e) { const int sl = 8 * g + 4 * hi + e;
            d0[4 * g + e] = (sl <= tl) ? a_t + b0[e] : -INFINITY; d1[4 * g + e] = (32 + sl <= tl) ? a_t + b1[e] : -INFINITY;
            mrow = fmaxf(mrow, fmaxf(d0[4 * g + e], d1[4 * g + e])); } }
    mrow = fmaxf(swap_max(mrow), a_t + mprev);
    float psum = 0.f;
#pragma unroll
    for (int i = 0; i < 16; ++i) { s0[i] *= fexp(d0[i] - mrow); s1[i] *= fexp(d1[i] - mrow); psum += s0[i] + s1[i]; }
    const float w_inter = fexp(a_t + mprev - mrow);
    float den = swap_add(psum);
    const bf16x8 P00 = packbf(s0, 0), P01 = packbf(s0, 1), P10 = packbf(s1, 0), P11 = packbf(s1, 1);
    f32x16 num;
#pragma unroll
    for (int i = 0; i < 16; ++i) num[i] = 0.f;
    {
        LAS unsigned char* vb_ = L + 32768 + vb * 4096 + (4 * hi + qq) * 64 + 32 * blk + 8 * pp;
        num = MFMA_BF16(cat8(trrd(vb_), trrd(vb_ + 8 * 64)), P00, num); num = MFMA_BF16(cat8(trrd(vb_ + 16 * 64), trrd(vb_ + 24 * 64)), P01, num);
        num = MFMA_BF16(cat8(trrd(vb_ + 32 * 64), trrd(vb_ + 40 * 64)), P10, num); num = MFMA_BF16(cat8(trrd(vb_ + 48 * 64), trrd(vb_ + 56 * 64)), P11, num);
    }
    if (c > 0) {
        f32x16 it, dn;
#pragma unroll
        for (int i = 0; i < 16; ++i) { it[i] = 0.f; dn[i] = 0.f; }
#pragma unroll
        for (int kk = 0; kk < 8; ++kk) { it = MFMA_BF16(cf[kk], qf[kk], it); dn = MFMA_BF16(nf[kk], qf[kk], dn); }
#pragma unroll
        for (int i = 0; i < 16; ++i) num[i] += w_inter * it[i];
        den += w_inter * dn[0];
    }
    const float inv = __builtin_amdgcn_rcpf(fmaxf(fabsf(den), fexp(-mrow)));
    float ss = 0.f;
#pragma unroll
    for (int i = 0; i < 16; ++i) { num[i] *= inv; ss += num[i] * num[i]; }
    ss = swap_add(ss);
    if (lane < 32) Lex[(tb * 4 + vb) * 32 + r] = ss;
    __syncthreads();
    const float tot = (Lex[(tb * 4 + 0) * 32 + r] + Lex[(tb * 4 + 1) * 32 + r]) + (Lex[(tb * 4 + 2) * 32 + r] + Lex[(tb * 4 + 3) * 32 + r]);
    const float rstd = 1.f / sqrtf(tot * (1.f / 128.f) + EPS);
    {
        const size_t trow = rowbase + t0 + tl;
        const bf16* Og = P + trow * NPROJ + C_OML + hh * 128 + vb * 32 + 4 * hi;
        bf16* Mp = MIX_ + trow * D + 512 + hh * 128 + vb * 32 + 4 * hi;
        const float* go = g_out_ml_ + hh * 128 + vb * 32 + 4 * hi;
#pragma unroll
        for (int g = 0; g < 4; ++g) { const u32x2 og = *(const GAS u32x2*)(Og + 8 * g); const f32x4 gg = *(const f32x4*)(go + 8 * g);
            const float o0 = bflo(og.x), o1 = bfhi(og.x), o2 = bflo(og.y), o3 = bfhi(og.y);
            u32x2 o; o.x = cvtpk(num[4 * g] * rstd * gg.x * __builtin_amdgcn_rcpf(1.f + fexp(-o0)), num[4 * g + 1] * rstd * gg.y * __builtin_amdgcn_rcpf(1.f + fexp(-o1)));
            o.y = cvtpk(num[4 * g + 2] * rstd * gg.z * __builtin_amdgcn_rcpf(1.f + fexp(-o2)), num[4 * g + 3] * rstd * gg.w * __builtin_amdgcn_rcpf(1.f + fexp(-o3)));
            *(GAS u32x2*)(Mp + 8 * g) = o; }
    }
    __syncthreads();
}

#define TK_CE(A, B) do { const float hi_ = fmaxf((A), (B)), lo_ = fminf((A), (B)); (A) = hi_; (B) = lo_; } while (0)
DI void tk_sort16(float (&a)[16]) {
#pragma unroll
    for (int k = 2; k <= 16; k <<= 1)
#pragma unroll
        for (int j = k >> 1; j > 0; j >>= 1)
#pragma unroll
            for (int i = 0; i < 16; ++i) { const int l = i ^ j; if (l > i) { if ((i & k) == 0) TK_CE(a[i], a[l]); else TK_CE(a[l], a[i]); } }
}
DI void tk_merge16(float (&a)[16], const float (&b)[16]) {
#pragma unroll
    for (int i = 0; i < 16; ++i) a[i] = fmaxf(a[i], b[15 - i]);
#pragma unroll
    for (int j = 8; j > 0; j >>= 1)
#pragma unroll
        for (int i = 0; i < 16; ++i) { const int l = i ^ j; if (l > i) TK_CE(a[i], a[l]); }
}
DI void tk_stage2(const LAS float* la, const LAS float* lb, int* IDX_, float* GATEW_, size_t o) {
        float a[16], bb[16], cnd[64];
#pragma unroll
        for (int q = 0; q < 16; ++q) { a[q] = la[q]; bb[q] = lb[q]; }
        int cnt = 0;
#pragma unroll
        for (int i = 0; i < 16; ++i)
#pragma unroll
            for (int j = 0; j < 16; ++j) if ((i + 1) * (j + 1) <= 16) { cnd[cnt] = __uint_as_float((__float_as_uint(a[i] + bb[j]) & ~0xFFu) | (unsigned)(i * 16 + j)); ++cnt; }
#pragma unroll
        for (int q = 50; q < 64; ++q) cnd[q] = -INFINITY;
        float top[16];
#pragma unroll
        for (int c = 0; c < 4; ++c) { float ch[16];
#pragma unroll
            for (int q = 0; q < 16; ++q) ch[q] = cnd[16 * c + q];
            tk_sort16(ch);
            if (c == 0) {
#pragma unroll
                for (int q = 0; q < 16; ++q) top[q] = ch[q];
            } else tk_merge16(top, ch); }
        float sv[16]; int ei[16]; float mx = -INFINITY;
#pragma unroll
        for (int q = 0; q < 16; ++q) { const unsigned code = __float_as_uint(top[q]) & 0xFFu; const float va = la[code >> 4], vb = lb[code & 15u];
            ei[q] = (int)((__float_as_uint(va) & 0x7Fu) * 128u + (__float_as_uint(vb) & 0x7Fu)); sv[q] = va + vb; mx = fmaxf(mx, sv[q]); }
        float sum = 0.f;
#pragma unroll
        for (int q = 0; q < 16; ++q) { sv[q] = fexp(sv[q] - mx); sum += sv[q]; }
        const float inv = 1.f / sum;
#pragma unroll
        for (int q = 0; q < 16; q += 4) { *(GAS v4u*)(IDX_ + o + q) = (v4u){(unsigned)ei[q], (unsigned)ei[q + 1], (unsigned)ei[q + 2], (unsigned)ei[q + 3]};
            *(GAS f32x4*)(GATEW_ + o + q) = (f32x4){sv[q] * inv, sv[q + 1] * inv, sv[q + 2] * inv, sv[q + 3] * inv}; }
    }
struct EpiTopK {
    static constexpr bool PERM = false, AFTER_DRAIN = true;
    int* IDX; float* GATEW;
    DI void fused(f32x4 (&acc)[2][2][4][2], const pg8::Unit& u, int wr, int wc, int fr, int fq, LAS unsigned char* lds, int wid, int lane) const {
        LAS float* Tl = (LAS float*)lds;
        LAS float* Lh2 = (LAS float*)lds;
        LAS float* Ls = (LAS float*)(lds + 36864);
        const int tid = wid * 64 + lane, tl = tid & 127, p = (tid >> 7) & 1, half = tid >> 8;
#pragma unroll
        for (int ai = 0; ai < 2; ++ai) {
#pragma unroll
            for (int bj = 0; bj < 2; ++bj)
#pragma unroll
                for (int m = 0; m < 4; ++m)
#pragma unroll
                    for (int n = 0; n < 2; ++n) { LAS float* d = Tl + (wr * 64 + m * 16 + fr) * 257 + bj * 128 + wc * 32 + n * 16 + fq * 4; const f32x4 v = acc[ai][bj][m][n]; d[0] = v.x; d[1] = v.y; d[2] = v.z; d[3] = v.w; }
            __syncthreads();
            float run[16];
            {
                const LAS float* src = Tl + tl * 257 + p * 128 + half * 64;
#pragma unroll
                for (int c = 0; c < 4; ++c) { float ch[16];
#pragma unroll
                    for (int q = 0; q < 16; ++q) ch[q] = __uint_as_float((__float_as_uint(src[16 * c + q]) & ~0x7Fu) | (unsigned)(half * 64 + 16 * c + q));
                    tk_sort16(ch);
                    if (c == 0) {
#pragma unroll
                        for (int q = 0; q < 16; ++q) run[q] = ch[q];
                    } else tk_merge16(run, ch); }
            }
            __syncthreads();
#pragma unroll
            for (int q = 0; q < 16; ++q) Lh2[((tl * 2 + p) * 2 + half) * 17 + q] = run[q];
            __syncthreads();
            if (half == 0) { float oth[16];
#pragma unroll
                for (int q = 0; q < 16; ++q) oth[q] = Lh2[((tl * 2 + p) * 2 + 1) * 17 + q];
                tk_merge16(run, oth);
#pragma unroll
                for (int q = 0; q < 16; ++q) Ls[(tl * 2 + p) * 17 + q] = run[q]; }
            __syncthreads();
            if (tid < 128) tk_stage2(Ls + (tl * 2) * 17, Ls + (tl * 2) * 17 + 17, IDX, GATEW, (size_t)(u.pm * 256 + ai * 128 + tl) * 128 + u.pn * 16);
            __syncthreads();
        }
    }
};
struct OneUnit {
    pg8::Unit u;
    __device__ __forceinline__ bool next(int i, pg8::Unit& o) const { if (i) return false; o = u; return true; }
    __device__ __forceinline__ void a_ready(const pg8::Unit&) const {}
    __device__ __forceinline__ void done(const pg8::Unit&) const {}
};

DI float gelu_erf(float x) { return 0.5f * x * (1.f + erff(x * 0.7071067811865476f)); }
#define DPP_ADD(v, ctrl, rmask) ((v) + __builtin_bit_cast(float, __builtin_amdgcn_update_dpp(0, __builtin_bit_cast(int, (v)), (ctrl), (rmask), 0xF, false)))
#ifndef PEER_EBL
#define PEER_EBL 9
#endif
constexpr int PEER_EB_LOG = PEER_EBL;
#ifndef PEER_PROBE_MASK
#define PEER_PROBE_MASK 0xFFFF
#endif
typedef float f32x2v __attribute__((ext_vector_type(2)));
DI float gelu_cdf(float v) {
    const float av = fabsf(v), t = __builtin_amdgcn_rcpf(av * 0.2316418882f + 1.0f);
    float q = t * 0.5307027145f - 0.7265760135f; q = q * t + 0.7107068705f; q = q * t - 0.142248368f; q = q * t + 0.127414796f; q = q * t;
    const float m = v * (q * ex2(v * v * -0.72134752044f));
    return v < 0.f ? m : v - m;
}
#define DPP_ADDI(v, ctrl, rmask) ((v) + __builtin_amdgcn_update_dpp(0, (v), (ctrl), (rmask), 0xF, false))
DI void peer_phase(const Frame& F, bool scratch_dst) {
    bf16* const XN_ = WSP(bf16, WS_XN); int* const IDX_ = WSP(int, WS_IDX); float* const GATEW_ = WSP(float, WS_GATE); float* const mod_ = WSP(float, WS_MOD); float* const out_ = (float*)inp(I_OUT);
    const unsigned char* const EU4 = WSP(unsigned char, WS_EXPU); const unsigned char* const EV8 = WSP(unsigned char, WS_EXPV); const float* const SUI_ = WSP(float, WS_SUI); const float* const SVI_ = WSP(float, WS_SVI);
    const int gw = F.vcu * NWAVES + F.wave, NGW = F.G * NWAVES, lane = F.lane, g = lane >> 3, j = lane & 7;
    LAS unsigned char* wl = F.lds + F.wave * 16384;
    volatile LAS int* Le = (volatile LAS int*)(wl + g * 512); volatile LAS float* Lg = (volatile LAS float*)(wl + 4096 + g * 512); volatile LAS int* Lp = (volatile LAS int*)(wl + 8192 + g * 512);
    LAS int* Lh = (LAS int*)(wl + 12288 + g * 128);
    for (int grp = gw; grp < T / 8; grp += NGW) {
        const size_t t = (size_t)grp * 8 + g;
        int xh[16], xl[16]; float sxi;
        {
            float mx = 0.f;
            const bf16* xrow = XN_ + t * D + 8 * j;
#pragma unroll
            for (int kq = 0; kq < 16; ++kq) { const v4u a = *(const GAS v4u*)(xrow + 64 * kq);
#pragma unroll
                for (int e = 0; e < 4; ++e) mx = fmaxf(mx, fmaxf(fabsf(bflo(a[e])), fabsf(bfhi(a[e])))); }
            mx = fmaxf(mx, __shfl_xor(mx, 1, 8)); mx = fmaxf(mx, __shfl_xor(mx, 2, 8)); mx = fmaxf(mx, __shfl_xor(mx, 4, 8));
            const float sx = mx > 0.f ? 119.f / mx : 0.f; sxi = mx > 0.f ? mx / 119.f : 0.f;
#pragma unroll
            for (int q = 0; q < 4; ++q)
#pragma unroll
                for (int kp = 0; kp < 2; ++kp) { const v4u a = *(const GAS v4u*)(xrow + 64 * (8 * kp + q)), b = *(const GAS v4u*)(xrow + 64 * (8 * kp + 4 + q));
#pragma unroll
                    for (int wh = 0; wh < 2; ++wh) {
                        const int t0 = (int)rintf(bflo(a[2 * wh]) * sx) + 8, t1 = (int)rintf(bfhi(a[2 * wh]) * sx) + 8, t2 = (int)rintf(bflo(a[2 * wh + 1]) * sx) + 8, t3 = (int)rintf(bfhi(a[2 * wh + 1]) * sx) + 8;
                        const int t4 = (int)rintf(bflo(b[2 * wh]) * sx) + 8, t5 = (int)rintf(bfhi(b[2 * wh]) * sx) + 8, t6 = (int)rintf(bflo(b[2 * wh + 1]) * sx) + 8, t7 = (int)rintf(bfhi(b[2 * wh + 1]) * sx) + 8;
                        const unsigned lo_ = (unsigned)(t0 & 15) | ((unsigned)(t1 & 15) << 4) | ((unsigned)(t2 & 15) << 8) | ((unsigned)(t3 & 15) << 12) | ((unsigned)(t4 & 15) << 16) | ((unsigned)(t5 & 15) << 20) | ((unsigned)(t6 & 15) << 24) | ((unsigned)(t7 & 15) << 28);
                        const unsigned hi_ = (unsigned)((t0 >> 4) & 15) | ((unsigned)((t1 >> 4) & 15) << 4) | ((unsigned)((t2 >> 4) & 15) << 8) | ((unsigned)((t3 >> 4) & 15) << 12) | ((unsigned)((t4 >> 4) & 15) << 16) | ((unsigned)((t5 >> 4) & 15) << 20) | ((unsigned)((t6 >> 4) & 15) << 24) | ((unsigned)((t7 >> 4) & 15) << 28);
                        xl[4 * q + kp + 2 * wh] = (int)(lo_ ^ 0x88888888u); xh[4 * q + kp + 2 * wh] = (int)hi_; } }
        }
        {
            int ide[16]; float gte[16]; int rk[16];
#pragma unroll
            for (int m = 0; m < 16; ++m) { ide[m] = IDX_[t * 128 + j + 8 * m]; gte[m] = GATEW_[t * 128 + j + 8 * m]; }
#pragma unroll
            for (int m = 0; m < 4; ++m) Lh[j + 8 * m] = 0;
#pragma unroll
            for (int m = 0; m < 16; ++m) rk[m] = __hip_atomic_fetch_add(Lh + (ide[m] >> PEER_EB_LOG), 1, __ATOMIC_RELAXED, __HIP_MEMORY_SCOPE_WORKGROUP);
            {
                const int h0 = ((volatile LAS int*)Lh)[4 * j], h1 = ((volatile LAS int*)Lh)[4 * j + 1], h2 = ((volatile LAS int*)Lh)[4 * j + 2], h3 = ((volatile LAS int*)Lh)[4 * j + 3];
                const int tot = (h0 + h1) + (h2 + h3); int inc = tot;
#pragma unroll
                for (int o = 1; o < 8; o <<= 1) { const int tt = __shfl_up(inc, o, 8); if (j >= o) inc += tt; }
                const int ex = inc - tot;
                ((volatile LAS int*)Lh)[4 * j] = ex; ((volatile LAS int*)Lh)[4 * j + 1] = ex + h0; ((volatile LAS int*)Lh)[4 * j + 2] = ex + h0 + h1; ((volatile LAS int*)Lh)[4 * j + 3] = ex + h0 + h1 + h2;
            }
#pragma unroll
            for (int m = 0; m < 16; ++m) { const int pos = ((volatile LAS int*)Lh)[ide[m] >> PEER_EB_LOG] + rk[m]; Le[pos] = ide[m]; Lg[pos] = gte[m]; }
        }
        v4u R0[4], R1[4], R2[4], R3[4];
#define PEER_ROFF(S0, H) ((size_t)(Le[(S0)] & (scratch_dst ? PEER_PROBE_MASK : 0xFFFF)) * 1024 + 512 * (H) + 16 * j)
#define PEER_LOADT(TAB, RR, S0, H) do { const size_t ro_ = PEER_ROFF(S0, H); _Pragma("unroll") for (int q = 0; q < 4; ++q) RR[q] = *(const GAS v4u*)((TAB) + ro_ + 128 * q); } while (0)
#define PEER_LOADU(RR, S0) do { const size_t ro_ = (size_t)(Le[(S0)] & (scratch_dst ? PEER_PROBE_MASK : 0xFFFF)) * 512 + 16 * j; _Pragma("unroll") for (int q = 0; q < 4; ++q) RR[q] = *(const GAS v4u*)(EU4 + ro_ + 128 * q); } while (0)
#define PEER_DOTU(RR, EOUT) do { int h0_ = 0, h1_ = 0, l0_ = 0, l1_ = 0; \
            _Pragma("unroll") for (int q = 0; q < 4; q += 2) _Pragma("unroll") for (int w_ = 0; w_ < 4; ++w_) { \
                h0_ = __builtin_amdgcn_sdot8((int)RR[q][w_], xh[4 * q + w_], h0_, false); l0_ = __builtin_amdgcn_sdot8((int)RR[q][w_], xl[4 * q + w_], l0_, false); \
                h1_ = __builtin_amdgcn_sdot8((int)RR[q + 1][w_], xh[4 * q + 4 + w_], h1_, false); l1_ = __builtin_amdgcn_sdot8((int)RR[q + 1][w_], xl[4 * q + 4 + w_], l1_, false); } \
            int e_ = ((h0_ + h1_) << 4) + (l0_ + l1_); e_ = DPP_ADDI(e_, 0xB1, 0xF); e_ = DPP_ADDI(e_, 0x4E, 0xF); e_ = DPP_ADDI(e_, 0x141, 0xF); EOUT = e_; } while (0)
#define PEER_SWEEPU(BODY0, BODY1, BODY2, BODY3) do { \
            PEER_LOADU(R0, 0); PEER_LOADU(R1, 1); PEER_LOADU(R2, 2); PEER_LOADU(R3, 3); \
            for (int s = 0; s < 128; s += 4) { \
                BODY0; if (s + 4 < 128) PEER_LOADU(R0, s + 4); \
                BODY1; if (s + 4 < 128) PEER_LOADU(R1, s + 5); \
                BODY2; if (s + 4 < 128) PEER_LOADU(R2, s + 6); \
                BODY3; if (s + 4 < 128) PEER_LOADU(R3, s + 7); } } while (0)
        float cmax = 0.f;
#define PEER_FIN(RR, SS) do { int e1_; PEER_DOTU(RR, e1_); const int ex_ = Le[(SS)] & 0xFFFF; const float cf__ = Lg[(SS)] * SVI_[ex_] * gelu_cdf((float)e1_ * (SUI_[ex_] * sxi)); \
            Lg[(SS)] = cf__; cmax = fmaxf(cmax, fabsf(cf__)); } while (0)
        PEER_SWEEPU(PEER_FIN(R0, s), PEER_FIN(R1, s + 1), PEER_FIN(R2, s + 2), PEER_FIN(R3, s + 3));
#undef PEER_FIN
        const float cqs = cmax > 0.f ? 127.f / cmax : 0.f, yscale = cmax > 0.f ? cmax / 127.f : 0.f;
        {
            int pk_[4];
#pragma unroll
            for (int m = 0; m < 4; ++m) { const int d_ = 4 * j + m;
                const int q0 = (int)rintf(Lg[4 * d_] * cqs), q1 = (int)rintf(Lg[4 * d_ + 1] * cqs), q2 = (int)rintf(Lg[4 * d_ + 2] * cqs), q3 = (int)rintf(Lg[4 * d_ + 3] * cqs);
                pk_[m] = (int)((unsigned)(q0 & 0xff) | ((unsigned)(q1 & 0xff) << 8) | ((unsigned)(q2 & 0xff) << 16) | ((unsigned)q3 << 24)); }
#pragma unroll
            for (int m = 0; m < 4; ++m) Lp[4 * j + m] = pk_[m];
        }
#pragma unroll
        for (int H = 0; H < 2; ++H) {
            int yi[64];
#pragma unroll
            for (int i = 0; i < 64; ++i) yi[i] = 0;
            PEER_LOADT(EV8, R0, 0, H); PEER_LOADT(EV8, R1, 1, H); PEER_LOADT(EV8, R2, 2, H); PEER_LOADT(EV8, R3, 3, H);
            for (int bt = 0; bt < 32; ++bt) {
                const int cq_ = Lp[bt];
                size_t ro0_ = 0, ro1_ = 0, ro2_ = 0, ro3_ = 0;
                if (bt + 1 < 32) { ro0_ = PEER_ROFF(4 * bt + 4, H); ro1_ = PEER_ROFF(4 * bt + 5, H); ro2_ = PEER_ROFF(4 * bt + 6, H); ro3_ = PEER_ROFF(4 * bt + 7, H); }
#pragma unroll
                for (int q = 0; q < 4; ++q) {
#pragma unroll
                    for (int w_ = 0; w_ < 4; ++w_) { const unsigned a0 = R0[q][w_], a1 = R1[q][w_], a2 = R2[q][w_], a3 = R3[q][w_];
                        const unsigned p0 = __builtin_amdgcn_perm(a1, a0, 0x05010400u), p1 = __builtin_amdgcn_perm(a1, a0, 0x07030602u), p2 = __builtin_amdgcn_perm(a3, a2, 0x05010400u), p3 = __builtin_amdgcn_perm(a3, a2, 0x07030602u);
                        yi[16 * q + 4 * w_ + 0] = __builtin_amdgcn_sdot4((int)__builtin_amdgcn_perm(p2, p0, 0x05040100u), cq_, yi[16 * q + 4 * w_ + 0], false);
                        yi[16 * q + 4 * w_ + 1] = __builtin_amdgcn_sdot4((int)__builtin_amdgcn_perm(p2, p0, 0x07060302u), cq_, yi[16 * q + 4 * w_ + 1], false);
                        yi[16 * q + 4 * w_ + 2] = __builtin_amdgcn_sdot4((int)__builtin_amdgcn_perm(p3, p1, 0x05040100u), cq_, yi[16 * q + 4 * w_ + 2], false);
                        yi[16 * q + 4 * w_ + 3] = __builtin_amdgcn_sdot4((int)__builtin_amdgcn_perm(p3, p1, 0x07060302u), cq_, yi[16 * q + 4 * w_ + 3], false); }
                    if (bt + 1 < 32) { R0[q] = *(const GAS v4u*)(EV8 + ro0_ + 128 * q); R1[q] = *(const GAS v4u*)(EV8 + ro1_ + 128 * q); R2[q] = *(const GAS v4u*)(EV8 + ro2_ + 128 * q); R3[q] = *(const GAS v4u*)(EV8 + ro3_ + 128 * q); }
                }
            }
            const int b = (int)(t / SEQ);
            const float* g2 = mod_ + b * NMOD + 5120 + 512 * H + 16 * j;
            const float* ip = out_ + t * D + 512 * H + 16 * j; float* op = (scratch_dst ? WSP(float, WS_SCORES) : out_) + t * D + 512 * H + 16 * j;
#pragma unroll
            for (int q = 0; q < 4; ++q)
#pragma unroll
                for (int c4 = 0; c4 < 4; ++c4) { const f32x4 x1 = *(const GAS f32x4*)(ip + 128 * q + 4 * c4); const f32x4 gg = *(const f32x4*)(g2 + 128 * q + 4 * c4) * yscale;
                    f32x4 o; o.x = x1.x + gg.x * (float)yi[16 * q + 4 * c4]; o.y = x1.y + gg.y * (float)yi[16 * q + 4 * c4 + 1]; o.z = x1.z + gg.z * (float)yi[16 * q + 4 * c4 + 2]; o.w = x1.w + gg.w * (float)yi[16 * q + 4 * c4 + 3];
                    *(GAS f32x4*)(op + 128 * q + 4 * c4) = o; }
        }
#undef PEER_ROFF
#undef PEER_LOADT
#undef PEER_LOADU
#undef PEER_DOTU
#undef PEER_SWEEPU
    }
}

DI void ph_inproj(const Frame& F) {
    pg8::Gemm g{WSP(bf16, WS_XN), WSP(bf16, WS_WIN), T, NPROJ, D}; pg8::StaticOrder S; S.init(T, NPROJ, F.G, (int)blockIdx.x);
    pg8::EpiBf16<0> E{WSP(bf16, WS_PROJ), NPROJ, nullptr, 0, 0, 1.f};
    pg8::gemm_phase<pg8::EpiBf16<0>, pg8::StaticOrder, PG8_ALIGN, PG8_SP2>(F.lds, g, S, E);
}
DI void ph_mix(const Frame& F, bool probe_first) {
    stage_conv_w(F);
    {
        int u = F.vcu;
        MlLocalRegs ra;
        if (u < 2048) ml_local_load(F, u >> 6, u & 63, ra);
        const int gwv = F.vcu * NWAVES + F.wave, NGWv = F.G * NWAVES;
        int eb = 2 * gwv;
        while (u < 2048) {
            const int un = u + F.G;
            MlLocalRegs rb;
            if (un < 2048) ml_local_load(F, un >> 6, un & 63, rb);
            ExpRows2 er; const bool ew = eb < 32768;
            if (ew) exp_load2(F, eb, er);
            ml_local_unit(F, u >> 6, u & 63, ra);
            if (ew) exp_conv2(F, eb, er);
            eb += 2 * NGWv;
            ra = rb; u = un;
        }
        for (; eb < 32768; eb += 2 * NGWv) { ExpRows2 er; exp_load2(F, eb, er); exp_conv2(F, eb, er); }
    }
    (void)probe_first;
}
DI void ph_scan_attn(const Frame& F) {
    ml_scan_phase(F);
    __syncthreads();
    for (int u = F.vcu; u < 1024; u += F.G) { const int qb = 15 - (u >> 6), bh = u & 63; sb_unit(F, bh >> 3, bh & 7, qb); }
}
DI void ph_mlout(const Frame& F) { stage_conv_w(F); for (int u = F.vcu; u < 2048; u += F.G) ml_out_unit(F, u >> 6, u & 63); }
#ifndef P5_ALIGN
#define P5_ALIGN PG8_ALIGN
#endif
DI void ph_outproj(const Frame& F) {
    pg8::Gemm g{WSP(bf16, WS_MIX), WSP(bf16, WS_WOUT), T, D, D}; pg8::StaticOrder S; S.init(T, D, F.G, (int)blockIdx.x);
    pg8::EpiResGate E{inp(I_X), (float*)inp(I_OUT), WSP(float, WS_MOD) + 2048, NMOD, SEQ, D};
    pg8::gemm_phase<pg8::EpiResGate, pg8::StaticOrder, P5_ALIGN, PG8_SP2>(F.lds, g, S, E);
}
DI void ph_scores(const Frame& F) {
    pg8::Gemm g{WSP(bf16, WS_XN), WSP(bf16, WS_WEFF), T, NSC, D}; pg8::StaticOrder S; S.init(T, NSC, F.G, (int)blockIdx.x);
    EpiTopK E{WSP(int, WS_IDX), WSP(float, WS_GATE)};
    pg8::Unit un;
    for (int i = 0; S.next(i, un); ++i) { OneUnit S1{un}; pg8::gemm_phase<EpiTopK, OneUnit, false, PG8_SP2>(F.lds, g, S1, E); }
}
constexpr int N_PHASES = 11;
struct Args { const float* in[19]; float* out; unsigned char* ws; int ph_lo, ph_hi; };
__global__ void __launch_bounds__(NTHR, 2) hybrid_fwd(Args args) {
    extern __shared__ __attribute__((aligned(16))) unsigned char lds_raw[];
    Frame F;
    F.lds = (LAS unsigned char*)lds_raw;
    F.MISC = (volatile LAS unsigned*)(F.lds + LDSCTL_OFF + 320);
    F.tid = threadIdx.x; F.lane = F.tid & 63; F.wave = __builtin_amdgcn_readfirstlane(F.tid >> 6);
    F.G = gridDim.x; { const int bx = blockIdx.x; F.vcu = (F.G % 8 == 0) ? (bx % 8) * (F.G / 8) + bx / 8 : bx; }
    F.ws = args.ws;
    F.ctl = (gu32*)(F.ws + WS_CTL);
    for (int u = F.tid; u < (LDS_BYTES - LDSCTL_OFF) / 4; u += NTHR) ((LAS unsigned*)(F.lds + LDSCTL_OFF))[u] = 0u;
    __syncthreads();
    const int lo = args.ph_lo, hi = args.ph_hi;
    const bool one_launch = (hi - lo) > 1;
    XcdBarrier bar; bar.bar = (unsigned*)(F.ctl + CW_BAR); bar.x = 0; bar.st = nullptr;
    if (one_launch) bar = xcd_barrier_post((unsigned*)(F.ctl + CW_BAR), F.MISC + 8);
#ifndef PHMASK
#define PHMASK 0x7ff
#endif
#define IN(k) (((PHMASK >> (k)) & 1) && lo <= (k) && (k) < hi)
#define SEAM(k) do { if (IN(k) && IN((k) + 1)) xcd_barrier(bar); } while (0)
#ifndef REPMASK
#define REPMASK 0
#endif

#define RUN(k, ...) do { if (IN(k)) { if ((REPMASK >> (k)) & 1) { { const bool first = true; (void)first; __VA_ARGS__; } xcd_barrier(bar); } { const bool first = false; (void)first; __VA_ARGS__; } } } while (0)
    RUN(0, p0_phase(F, first ? P0_PARTS : 15)); SEAM(0);
    RUN(1, norm_phase<true>(F, inp(I_X), inp(I_GN1), 0, 1024)); SEAM(1);
    RUN(2, ph_inproj(F)); SEAM(2);
    RUN(3, ph_mix(F, first)); SEAM(3);
    RUN(10, ph_scan_attn(F)); if (IN(10) && IN(4)) xcd_barrier(bar);
    RUN(4, ph_mlout(F)); SEAM(4);
    RUN(5, ph_outproj(F)); SEAM(5);
    RUN(6, norm_phase<false>(F, inp(I_OUT), inp(I_GN2), 3072, 4096)); SEAM(6);
    RUN(7, ph_scores(F)); if (IN(7) && IN(9)) xcd_barrier(bar);
    RUN(9, peer_phase(F, first));
#undef RUN
#undef IN
#undef SEAM
}

#ifndef MK_PER_PHASE
#define MK_PER_PHASE 0
#endif
extern "C" void kernel_launch(void* const* d_in, const int* in_sizes, int n_in, void* d_out, int out_size, void* d_ws, size_t ws_size, hipStream_t stream) {
    static int grid = 0;
    if (grid == 0) {
        if (n_in != 19 || in_sizes[0] != T * D || out_size != T * D || ws_size < WS_END) { fprintf(stderr, "kernel_launch: unexpected shapes (n_in %d, in0 %d, out %d, ws %zu)\n", n_in, n_in > 0 ? in_sizes[0] : -1, out_size, ws_size); grid = -1; return; }
        int dev = 0, cus = 0, per_cu = 0;
        if (hipGetDevice(&dev) != hipSuccess || hipDeviceGetAttribute(&cus, hipDeviceAttributeMultiprocessorCount, dev) != hipSuccess) { grid = -1; return; }
        if (hipFuncSetAttribute((const void*)hybrid_fwd, hipFuncAttributeMaxDynamicSharedMemorySize, LDS_BYTES) != hipSuccess) { fprintf(stderr, "kernel_launch: hipFuncSetAttribute failed\n"); grid = -1; return; }
        if (hipOccupancyMaxActiveBlocksPerMultiprocessor(&per_cu, (const void*)hybrid_fwd, NTHR, LDS_BYTES) != hipSuccess || per_cu < 1) fprintf(stderr, "kernel_launch: occupancy query says %d\n", per_cu);
        (void)hipGetLastError();
        grid = cus;
    }
    if (grid < 0) return;
    if (hipMemsetAsync((char*)d_ws + WS_CTL, 0, CTL_ZERO_BYTES, stream) != hipSuccess) { fprintf(stderr, "kernel_launch: memset failed\n"); return; }
    Args a{};
    for (int i = 0; i < 19; ++i) a.in[i] = (const float*)d_in[i];
    a.out = (float*)d_out; a.ws = (unsigned char*)d_ws;
#if MK_PER_PHASE
    { const int order[N_PHASES] = {0, 1, 2, 3, 10, 4, 5, 6, 7, 8, 9}; for (int i = 0; i < N_PHASES; ++i) { a.ph_lo = order[i]; a.ph_hi = order[i] + 1; hipLaunchKernelGGL(hybrid_fwd, dim3(grid), dim3(NTHR), LDS_BYTES, stream, a); } }
#else
    a.ph_lo = 0; a.ph_hi = N_PHASES;
    hipLaunchKernelGGL(hybrid_fwd, dim3(grid), dim3(NTHR), LDS_BYTES, stream, a);
#endif
    const hipError_t le = hipPeekAtLastError();
    if (le != hipSuccess) fprintf(stderr, "kernel_launch: launch failed: %s\n", hipGetErrorName(le));
}
```

```cpp
#include <cmath>
#include <hip/hip_runtime.h>
#include <cstdio>
#include <cstdint>
namespace pg8 {
#define PG8_LAS __attribute__((address_space(3)))
typedef unsigned short bf16_t;
typedef short bf16x8 __attribute__((ext_vector_type(8)));
typedef float f32x4 __attribute__((ext_vector_type(4)));
typedef unsigned u32x4 __attribute__((ext_vector_type(4)));
constexpr int BM = 256, BK = 64, HALF = 128, HTB = HALF * BK * 2  , STAGE_BYTES = 8 * HTB, NXCD = 8,
#ifndef PG8_WGM
#define PG8_WGM 4
#endif
WGM = PG8_WGM;

__host__ __device__ __forceinline__ int lds_byte(int r, int c) { const int st = (r >> 4) * 2 + (c >> 5), rr = r & 15, cc = c & 31, ob = rr * 64 + cc * 2; return st * 1024 + (ob ^ (((ob >> 9) & 1) << 5)); }
__host__ __device__ __forceinline__ void stage_rc(int b, int& R, int& C) { const int st = b / 1024, sb = b % 1024, swz = sb ^ (((sb >> 9) & 1) << 5); R = (st >> 1) * 16 + swz / 64; C = (st & 1) * 32 + (swz % 64) / 2; }
__host__ __device__ __forceinline__ int perm32(int rho) { const int n = rho >> 4, i = rho & 15; return 8 * (i >> 2) + 4 * n + (i & 3); }

struct Unit { int pm, pn; };
struct Gemm { const bf16_t* A; const bf16_t* Bt; int M, N, K; };

struct StaticOrder {
    int nM, nN, nwg, G, c;
    __host__ __device__ void init(int M, int N, int G_, int c_) { nM = M / BM; nN = N / BM; nwg = nM * nN; G = G_; c = c_; }
    __host__ __device__ bool next(int i, Unit& u) const {
        const long L = (long)i * G + c; if (L >= nwg) return false;
        int wgid = (int)L; { const int q = nwg / NXCD, r = nwg % NXCD, xcd = wgid % NXCD, off = wgid / NXCD; wgid = (xcd < r ? xcd * (q + 1) : r * (q + 1) + (xcd - r) * q) + off; }
        const int nig = WGM * nN, gid = wgid / nig, fm = gid * WGM, gsz = (nM - fm) < WGM ? (nM - fm) : WGM;
        u.pm = fm + ((wgid % nig) % gsz); u.pn = (wgid % nig) / gsz; return true;
    }
    __device__ __forceinline__ void a_ready(const Unit&) const {}
    __device__ __forceinline__ void done(const Unit&) const {}
};

__device__ __forceinline__ unsigned cvt_pk_bf16(float lo, float hi) { unsigned r; asm volatile("v_cvt_pk_bf16_f32 %0, %1, %2" : "=v"(r) : "v"(lo), "v"(hi)); return r; }
typedef float f32x2 __attribute__((ext_vector_type(2)));
__device__ __forceinline__ f32x2 gelu_pk(f32x2 v) {
    const f32x2 av = __builtin_elementwise_abs(v), d = av * 0.2316418882f + 1.0f;
    f32x2 t; t.x = __builtin_amdgcn_rcpf(d.x); t.y = __builtin_amdgcn_rcpf(d.y);
    f32x2 q = t * 0.5307027145f + (-0.7265760135f); q = q * t + 0.7107068705f; q = q * t + (-0.142248368f); q = q * t + 0.127414796f; q = q * t;
    const f32x2 s = (v * v) * (-0.72134752044f);
    f32x2 e; e.x = __builtin_amdgcn_exp2f(s.x); e.y = __builtin_amdgcn_exp2f(s.y);
    const f32x2 m = v * (q * e), r = v - m;
    f32x2 o; o.x = v.x < 0.f ? m.x : r.x; o.y = v.y < 0.f ? m.y : r.y; return o;
}

template <int ACT  > struct EpiBf16 {
    static constexpr bool PERM = true, AFTER_DRAIN = false; static_assert(ACT == 0 || ACT == 1, "EpiBf16: ACT is 0 (none) or 1 (gelu_pk)");
    bf16_t* O; int ldc; const float* bias; int split_cols; size_t split_stride; float scale0;
    __device__ __forceinline__ void operator()(const f32x4 (&acc)[2][2][4][2], const Unit& u, int wr, int wc, int fr, int fq) const {
        const int row0 = u.pm * BM + wr * 64 + fr; int colt = u.pn * BM; bf16_t* base = O;
        float sc = 1.f; if (split_cols) { const int t = colt / split_cols; base += (size_t)t * split_stride; colt -= t * split_cols; if (t == 0) sc = scale0; }
        const int col0 = colt + wc * 32 + 8 * fq, bcol0 = u.pn * BM + wc * 32 + 8 * fq;
        f32x4 bv[2][2];
#pragma unroll
        for (int bj = 0; bj < 2; ++bj)
#pragma unroll
            for (int n = 0; n < 2; ++n) bv[bj][n] = bias ? *(const f32x4*)(bias + bcol0 + bj * HALF + 4 * n) : (f32x4){0.f, 0.f, 0.f, 0.f};
#pragma unroll
        for (int ai = 0; ai < 2; ++ai)
#pragma unroll
            for (int m = 0; m < 4; ++m) { bf16_t* rowp = base + (size_t)(row0 + ai * HALF + m * 16) * ldc + col0;
#pragma unroll
                for (int bj = 0; bj < 2; ++bj) { f32x4 v0 = acc[ai][bj][m][0] + bv[bj][0], v1 = acc[ai][bj][m][1] + bv[bj][1];
                    if (ACT == 1) { f32x2 a = gelu_pk((f32x2){v0[0], v0[1]}), b = gelu_pk((f32x2){v0[2], v0[3]}), c = gelu_pk((f32x2){v1[0], v1[1]}), d = gelu_pk((f32x2){v1[2], v1[3]});
                        v0 = (f32x4){a.x, a.y, b.x, b.y}; v1 = (f32x4){c.x, c.y, d.x, d.y}; }
                    v0 = v0 * sc; v1 = v1 * sc; u32x4 w; w.x = cvt_pk_bf16(v0[0], v0[1]); w.y = cvt_pk_bf16(v0[2], v0[3]); w.z = cvt_pk_bf16(v1[0], v1[1]); w.w = cvt_pk_bf16(v1[2], v1[3]);
                    *(u32x4*)(rowp + bj * HALF) = w; } }
    }
};
template <class Epi, class Sched, bool ALIGN_EPI = false, bool SP2 = false>
__device__ __forceinline__ void gemm_phase(PG8_LAS unsigned char* lds, const Gemm g, const Sched& S, const Epi& E) {
    const int tid = threadIdx.x, wid = __builtin_amdgcn_readfirstlane(tid >> 6), lane = tid & 63, wr = wid >> 2, wc = wid & 3, fr = lane & 15, fq = lane >> 4;
    const int K = g.K, nt = K / BK;
    unsigned voffA[2], voffB[2];
#pragma unroll
    for (int i = 0; i < 2; ++i) { int R, C; stage_rc(tid * 16 + i * 8192, R, C); const int Rb = Epi::PERM ? ((R & ~31) + perm32(R & 31)) : R;
        voffA[i] = (unsigned)(R * K + C) * 2u; voffB[i] = (unsigned)(Rb * K + C) * 2u; }
    const size_t kstep = (size_t)(BK * 2);
    const size_t hstep = (size_t)HALF * K * 2;
    const size_t tstep = 2 * hstep;
    const unsigned ldsw = (unsigned)wid * 1024u;
    const int aoff = lds_byte(wr * 64 + fr, fq * 8), boff = lds_byte(wc * 32 + fr, fq * 8);
#define PG8_SA(b, h) (((b) * 2 + (h)) * HTB)
#define PG8_SB(b, h) ((4 + (b) * 2 + (h)) * HTB)
#define PG8_STAGE(bufoff, gbase, voff) do { _Pragma("unroll") for (int _i = 0; _i < 2; ++_i) \
        __builtin_amdgcn_global_load_lds((const unsigned*)((const char*)(gbase) + (voff)[_i]), (PG8_LAS unsigned*)(lds + (bufoff) + ldsw + _i * 8192), 16, 0, 0); } while (0)
#define PG8_LDA(dst, b, h) do { _Pragma("unroll") for (int m = 0; m < 4; ++m) _Pragma("unroll") for (int k = 0; k < 2; ++k) dst[m][k] = *(const PG8_LAS bf16x8*)(lds + PG8_SA(b, h) + aoff + m * 2048 + k * 1024); } while (0)
#define PG8_LDB(dst, b, h) do { _Pragma("unroll") for (int n = 0; n < 2; ++n) _Pragma("unroll") for (int k = 0; k < 2; ++k) dst[n][k] = *(const PG8_LAS bf16x8*)(lds + PG8_SB(b, h) + boff + n * 2048 + k * 1024); } while (0)
#define PG8_MMA(ai, bj, At, Bt) do { __builtin_amdgcn_s_setprio(1); _Pragma("unroll") for (int m = 0; m < 4; ++m) _Pragma("unroll") for (int n = 0; n < 2; ++n) _Pragma("unroll") for (int k = 0; k < 2; ++k) \
        acc[ai][bj][m][n] = __builtin_amdgcn_mfma_f32_16x16x32_bf16(Bt[n][k], At[m][k], acc[ai][bj][m][n], 0, 0, 0); __builtin_amdgcn_s_setprio(0); } while (0)
#define PG8_WAIT_V(n) asm volatile("s_waitcnt vmcnt(" #n ")" ::: "memory")
#define PG8_WAIT_L(n) asm volatile("s_waitcnt lgkmcnt(" #n ")" ::: "memory")
#define PG8_BAR __builtin_amdgcn_s_barrier()
#define PG8_SCHED __builtin_amdgcn_sched_barrier(0)
    Unit cur, nxt; int ui = 0;
    if (!S.next(0, cur)) return;
    f32x4 acc[2][2][4][2];
#pragma unroll
    for (int a = 0; a < 2; ++a)
#pragma unroll
        for (int b = 0; b < 2; ++b)
#pragma unroll
            for (int m = 0; m < 4; ++m)
#pragma unroll
                for (int n = 0; n < 2; ++n) acc[a][b][m][n] = (f32x4){0.f, 0.f, 0.f, 0.f};
    bf16x8 At[4][2], B0[2][2], B1[2][2];
    const char* cA = (const char*)g.A + (size_t)cur.pm * tstep; const char* cB = (const char*)g.Bt + (size_t)cur.pn * tstep;
    S.a_ready(cur);
    if constexpr (SP2) {
        PG8_STAGE(PG8_SB(0, 0), cB, voffB); PG8_STAGE(PG8_SB(0, 1), cB + hstep, voffB); PG8_STAGE(PG8_SA(0, 0), cA, voffA); PG8_STAGE(PG8_SA(0, 1), cA + hstep, voffA);
        if (wr == 1) PG8_BAR;
        PG8_WAIT_V(2); PG8_BAR;
        PG8_STAGE(PG8_SB(1, 0), cB + kstep, voffB); PG8_STAGE(PG8_SA(1, 0), cA + kstep, voffA); PG8_STAGE(PG8_SB(1, 1), cB + hstep + kstep, voffB);
        PG8_WAIT_V(6); PG8_BAR;
    } else {
        PG8_STAGE(PG8_SB(0, 0), cB, voffB); PG8_STAGE(PG8_SA(0, 0), cA, voffA); PG8_STAGE(PG8_SB(0, 1), cB + hstep, voffB); PG8_STAGE(PG8_SA(0, 1), cA + hstep, voffA);
        if (wr == 1) PG8_BAR;
        PG8_WAIT_V(4); PG8_BAR;
        PG8_STAGE(PG8_SB(1, 0), cB + kstep, voffB); PG8_STAGE(PG8_SA(1, 0), cA + kstep, voffA); PG8_STAGE(PG8_SB(1, 1), cB + hstep + kstep, voffB);
        PG8_WAIT_V(6); PG8_BAR;
    }
    for (;;) {
        const bool has_next = S.next(ui + 1, nxt);
        const char* nA = has_next ? (const char*)g.A + (size_t)nxt.pm * tstep : cA; const char* nB = has_next ? (const char*)g.Bt + (size_t)nxt.pn * tstep : cB;
        for (int t = 0; t < nt; t += 2) {
            const bool last = (t == nt - 2);
            const char* a1 = cA + (size_t)(t + 1) * kstep;
            const char* a2 = last ? nA : cA + (size_t)(t + 2) * kstep; const char* b2 = last ? nB : cB + (size_t)(t + 2) * kstep;
            const char* a3 = a2 + kstep; const char* b3 = b2 + kstep;
            if (last && has_next) S.a_ready(nxt);
            if constexpr (SP2) {
            PG8_LDB(B0, 0, 0); PG8_LDB(B1, 0, 1); PG8_SCHED; PG8_LDA(At, 0, 0); PG8_STAGE(PG8_SA(1, 1), a1 + hstep, voffA);
            PG8_WAIT_V(8); PG8_WAIT_L(0); PG8_BAR; PG8_MMA(0, 0, At, B0); PG8_MMA(0, 1, At, B1); PG8_BAR; PG8_SCHED;
            PG8_LDA(At, 0, 1); PG8_STAGE(PG8_SB(0, 0), b2, voffB); PG8_STAGE(PG8_SB(0, 1), b2 + hstep, voffB); PG8_STAGE(PG8_SA(0, 0), a2, voffA);
            PG8_WAIT_V(8); PG8_WAIT_L(0); PG8_BAR; PG8_MMA(1, 0, At, B0); PG8_MMA(1, 1, At, B1); PG8_BAR; PG8_SCHED;
            PG8_LDB(B0, 1, 0); PG8_LDB(B1, 1, 1); PG8_SCHED; PG8_LDA(At, 1, 0); PG8_STAGE(PG8_SA(0, 1), a2 + hstep, voffA);
            PG8_WAIT_V(8); PG8_WAIT_L(0); PG8_BAR; PG8_MMA(0, 0, At, B0); PG8_MMA(0, 1, At, B1); PG8_BAR; PG8_SCHED;
            PG8_LDA(At, 1, 1); PG8_STAGE(PG8_SB(1, 0), b3, voffB); PG8_STAGE(PG8_SB(1, 1), b3 + hstep, voffB); PG8_STAGE(PG8_SA(1, 0), a3, voffA);
            PG8_WAIT_V(8); PG8_WAIT_L(0); PG8_BAR; PG8_MMA(1, 0, At, B0); PG8_MMA(1, 1, At, B1); PG8_BAR; PG8_SCHED;
            } else {
            PG8_LDB(B0, 0, 0); PG8_SCHED; PG8_LDA(At, 0, 0); PG8_STAGE(PG8_SA(1, 1), a1 + hstep, voffA);
            PG8_WAIT_L(8); PG8_BAR; PG8_WAIT_L(0); PG8_MMA(0, 0, At, B0); PG8_BAR; PG8_SCHED;
            PG8_LDB(B1, 0, 1); PG8_STAGE(PG8_SB(0, 0), b2, voffB);
            PG8_BAR; PG8_WAIT_L(0); PG8_MMA(0, 1, At, B1); PG8_BAR;
            PG8_LDA(At, 0, 1); PG8_STAGE(PG8_SA(0, 0), a2, voffA);
            PG8_BAR; PG8_WAIT_L(0); PG8_MMA(1, 0, At, B0); PG8_BAR; PG8_SCHED;
            PG8_STAGE(PG8_SB(0, 1), b2 + hstep, voffB);
            PG8_WAIT_V(6); PG8_BAR; PG8_MMA(1, 1, At, B1); PG8_BAR;
            PG8_LDB(B0, 1, 0); PG8_SCHED; PG8_LDA(At, 1, 0); PG8_STAGE(PG8_SA(0, 1), a2 + hstep, voffA);
            PG8_WAIT_L(8); PG8_BAR; PG8_WAIT_L(0); PG8_MMA(0, 0, At, B0); PG8_BAR; PG8_SCHED;
            PG8_LDB(B1, 1, 1); PG8_STAGE(PG8_SB(1, 0), b3, voffB);
            PG8_BAR; PG8_WAIT_L(0); PG8_MMA(0, 1, At, B1); PG8_BAR;
            PG8_LDA(At, 1, 1); PG8_STAGE(PG8_SA(1, 0), a3, voffA);
            PG8_BAR; PG8_WAIT_L(0); PG8_MMA(1, 0, At, B0); PG8_BAR; PG8_SCHED;
            PG8_STAGE(PG8_SB(1, 1), b3 + hstep, voffB);
            PG8_WAIT_V(6); PG8_BAR; PG8_MMA(1, 1, At, B1); PG8_BAR;
            }
        }
        if constexpr (ALIGN_EPI) { if (wr == 0) PG8_BAR; }
        if constexpr (!Epi::AFTER_DRAIN) { E(acc, cur, wr, wc, fr, fq); S.done(cur); }
        if (!has_next) break;
#pragma unroll
        for (int a = 0; a < 2; ++a)
#pragma unroll
            for (int b = 0; b < 2; ++b)
#pragma unroll
                for (int m = 0; m < 4; ++m)
#pragma unroll
                    for (int n = 0; n < 2; ++n) acc[a][b][m][n] = (f32x4){0.f, 0.f, 0.f, 0.f};
        cur = nxt; cA = nA; cB = nB; ++ui;
        if constexpr (ALIGN_EPI) { if (wr == 1) PG8_BAR; }
    }
    PG8_WAIT_V(0);
    if constexpr (!ALIGN_EPI) { if (wr == 0) PG8_BAR; }
    PG8_BAR;
    if constexpr (Epi::AFTER_DRAIN) { E.fused(acc, cur, wr, wc, fr, fq, lds, wid, lane); S.done(cur); }
#undef PG8_SA
#undef PG8_SB
#undef PG8_STAGE
#undef PG8_LDA
#undef PG8_LDB
#undef PG8_MMA
#undef PG8_WAIT_V
#undef PG8_WAIT_L
#undef PG8_BAR
#undef PG8_SCHED
}
}

#ifndef PG8_SP2
#define PG8_SP2 true
#endif
#ifndef PG8_ALIGN
#define PG8_ALIGN true
#endif

namespace pg8 {
struct EpiResGate {
    static constexpr bool PERM = false, AFTER_DRAIN = false;
    const float* base; float* out; const float* gate; int gate_ld; int rows_per_batch; int ldc;
    __device__ __forceinline__ void operator()(const f32x4 (&acc)[2][2][4][2], const Unit& u, int wr, int wc, int fr, int fq) const {
        const int row0 = u.pm * BM + wr * 64 + fr, col0 = u.pn * BM + wc * 32 + 4 * fq;
        const float* gp = gate + (size_t)((u.pm * BM) / rows_per_batch) * gate_ld + col0;
        f32x4 gv[2][2];
#pragma unroll
        for (int bj = 0; bj < 2; ++bj)
#pragma unroll
            for (int n = 0; n < 2; ++n) gv[bj][n] = *(const f32x4*)(gp + bj * HALF + n * 16);
#pragma unroll
        for (int ai = 0; ai < 2; ++ai)
#pragma unroll
            for (int m = 0; m < 4; ++m) { const size_t off = (size_t)(row0 + ai * HALF + m * 16) * ldc + col0;
#pragma unroll
                for (int bj = 0; bj < 2; ++bj)
#pragma unroll
                    for (int n = 0; n < 2; ++n) { const f32x4 bs = *(const f32x4*)(base + off + bj * HALF + n * 16);
                        *(f32x4*)(out + off + bj * HALF + n * 16) = bs + gv[bj][n] * acc[ai][bj][m][n]; } }
    }
};
struct EpiF32 {
    static constexpr bool PERM = false, AFTER_DRAIN = false;
    float* O; int ldc;
    __device__ __forceinline__ void operator()(const f32x4 (&acc)[2][2][4][2], const Unit& u, int wr, int wc, int fr, int fq) const {
        const int row0 = u.pm * BM + wr * 64 + fr, col0 = u.pn * BM + wc * 32 + 4 * fq;
#pragma unroll
        for (int ai = 0; ai < 2; ++ai)
#pragma unroll
            for (int m = 0; m < 4; ++m) { const size_t off = (size_t)(row0 + ai * HALF + m * 16) * ldc + col0;
#pragma unroll
                for (int bj = 0; bj < 2; ++bj)
#pragma unroll
                    for (int n = 0; n < 2; ++n) *(f32x4*)(O + off + bj * HALF + n * 16) = acc[ai][bj][m][n]; }
    }
};
}
#define GAS __attribute__((address_space(1)))
#define LAS __attribute__((address_space(3)))
typedef unsigned short bf16;
typedef unsigned v4u __attribute__((ext_vector_type(4)));
typedef float f32x4 __attribute__((ext_vector_type(4)));
typedef short bf16x8 __attribute__((ext_vector_type(8)));
typedef GAS unsigned gu32;
typedef GAS unsigned long long gu64;
#define RLX_AGENT __ATOMIC_RELAXED, __HIP_MEMORY_SCOPE_AGENT
#define LDS_WAIT() asm volatile("s_waitcnt lgkmcnt(0)" ::: "memory")
#define VM_WAIT() asm volatile("s_waitcnt vmcnt(0)" ::: "memory")
__device__ __forceinline__ unsigned long long rt() { return __builtin_amdgcn_s_memrealtime(); }
__device__ __forceinline__ unsigned f2bf(float f) { unsigned u = __builtin_bit_cast(unsigned, f); return (u + 0x7fffu + ((u >> 16) & 1u)) >> 16; }
__device__ __forceinline__ unsigned pk2(float lo, float hi) { return f2bf(lo) | (f2bf(hi) << 16); }

#define XB_TMO      128
#define XB_XCNT(j)  (256  + 64 * (j))
#define XB_XSUB(j)  (1280 + 64 * (j))
#define XB_XGEN(j)  (2304 + 64 * (j))
#define XB_TOP      3328
#define XB_TOPGEN   3392
#define XCD_BAR_WORDS 3456
#define XB_SPIN_CAP (1u << 24)

__device__ __forceinline__ unsigned xb_ld(unsigned* p)              { return __hip_atomic_load(p, __ATOMIC_RELAXED, __HIP_MEMORY_SCOPE_AGENT); }
__device__ __forceinline__ unsigned xb_add(unsigned* p, unsigned v) { return __hip_atomic_fetch_add(p, v, __ATOMIC_RELAXED, __HIP_MEMORY_SCOPE_AGENT); }
__device__ __forceinline__ unsigned xb_xcc_id() { return (unsigned)__builtin_amdgcn_s_getreg((3 << 11) | 20) & 0xFu; }
#define XB_SPIN(cond, bar) do { unsigned _sp = 0; while (cond) { __builtin_amdgcn_s_sleep(1); \
    if ((++_sp & 255u) == 0u) { if (xb_ld(&(bar)[XB_TMO])) break; if (_sp > XB_SPIN_CAP) { atomicAdd(&(bar)[XB_TMO], 1u); break; } } } } while (0)

struct XcdBarrier {
    unsigned* bar; unsigned x;
    volatile LAS unsigned* st;
};

__device__ __forceinline__ XcdBarrier xcd_barrier_post(unsigned* bar, volatile LAS unsigned* st) {
    XcdBarrier b; b.bar = bar; b.x = xb_xcc_id(); b.st = st;
    if (threadIdx.x == 0) (void)xb_add(&bar[XB_XCNT(b.x)], 1u);
    return b;
}
__device__ __forceinline__ void xcd_barrier_complete(unsigned* bar, unsigned x, unsigned& nloc, unsigned& nx) {
    const unsigned G = gridDim.x * gridDim.y * gridDim.z;
    unsigned sum, cnt, mine, sp = 0u;
    for (;;) {
        sum = 0u; cnt = 0u; mine = 0u;
#pragma unroll
        for (unsigned j = 0; j < 16; ++j) { const unsigned c = xb_ld(&bar[XB_XCNT(j)]); sum += c; cnt += (c > 0u) ? 1u : 0u; mine = (j == x) ? c : mine; }
        if (sum == G) break;
        __builtin_amdgcn_s_sleep(1);
        if ((++sp & 255u) == 0u) { if (xb_ld(&bar[XB_TMO])) break; if (sp > XB_SPIN_CAP) { atomicAdd(&bar[XB_TMO], 1u); break; } }
    }
    nloc = mine > 0u ? mine : 1u; nx = cnt > 0u ? cnt : 1u;
}

__device__ __forceinline__ void xcd_barrier(const XcdBarrier& b) {
    asm volatile("s_waitcnt vmcnt(0)" ::: "memory");
    __syncthreads();
    if (threadIdx.x == 0) {
        unsigned* bar = b.bar;
        __builtin_amdgcn_s_waitcnt(0);
        unsigned nloc = b.st[0], nx = b.st[1];
        if (nloc == 0u) { xcd_barrier_complete(bar, b.x, nloc, nx); b.st[0] = nloc; b.st[1] = nx; }
        const unsigned old = xb_add(&bar[XB_XSUB(b.x)], 1u);
        const unsigned gen = old / nloc;
        if (old + 1u == (gen + 1u) * nloc) {
            __builtin_amdgcn_fence(__ATOMIC_RELEASE, "agent");
            asm volatile("s_waitcnt vmcnt(0)" ::: "memory");
            const unsigned og = xb_add(&bar[XB_TOP], 1u);
            const unsigned tg = og / nx;
            if (og + 1u == (tg + 1u) * nx) xb_add(&bar[XB_TOPGEN], 1u);
            else XB_SPIN(xb_ld(&bar[XB_TOPGEN]) == tg, bar);
            __builtin_amdgcn_fence(__ATOMIC_ACQUIRE, "agent");
            xb_add(&bar[XB_XGEN(b.x)], 1u);
            asm volatile("s_waitcnt vmcnt(0)" ::: "memory");
        } else {
            XB_SPIN(xb_ld(&bar[XB_XGEN(b.x)]) == gen, bar);
            __builtin_amdgcn_fence(__ATOMIC_ACQUIRE, "agent");
            asm volatile("s_waitcnt vmcnt(0)" ::: "memory");
        }
    }
    __syncthreads();
}

constexpr int NWAVES = 8, NTHR = 512;
constexpr int NB = 8, SEQ = 4096, T = NB * SEQ, D = 1024, NPROJ = 3584, NIN = 3592, NMOD = 6144, NSC = 2048;
constexpr int C_QSB = 0, C_KSB = 512, C_VSB = 1024, C_QML = 1536, C_KML = 2048, C_VML = 2560, C_OML = 3072;
constexpr float EPS = 1e-6f, LOG2E = 1.4426950408889634f;
constexpr size_t MiB = 1u << 20;
constexpr size_t WS_CTL = 0, CTL_ZERO_BYTES = 1 * MiB;
constexpr size_t WS_MOD = 256 * 1024;
constexpr size_t WS_WIN = 2 * MiB, WS_WOUT = 10 * MiB, WS_WEFF = 12 * MiB;
constexpr size_t WS_XN = 16 * MiB;
constexpr size_t WS_PROJ = 80 * MiB;
constexpr size_t WS_MIX = 304 * MiB;
constexpr size_t WS_EXPU = 368 * MiB, WS_EXPV = 400 * MiB;
constexpr size_t WS_CST = 432 * MiB;
constexpr size_t WS_NST = 496 * MiB;
constexpr size_t WS_MST = 497 * MiB;
constexpr size_t WS_GATES = 498 * MiB;
constexpr size_t WS_SCORES = 80 * MiB;
constexpr size_t WS_IDX = 336 * MiB, WS_GATE = 352 * MiB;
constexpr size_t WS_SCL = 499 * MiB;
constexpr size_t WS_SUI = 499 * MiB + 65536, WS_SVI = 499 * MiB + 131072;
constexpr size_t WS_END = 500 * MiB;
constexpr int CW_Q3 = 64;
constexpr int CW_BAR = 4096;
constexpr int LDS_BYTES = 147456, LDSCTL_OFF = 143360;

typedef float f32x16 __attribute__((ext_vector_type(16)));
typedef float f32x2_t __attribute__((ext_vector_type(2)));
typedef __bf16 bf16x2_t __attribute__((ext_vector_type(2)));
typedef _Float16 f16x8 __attribute__((ext_vector_type(8)));
typedef short s16x4 __attribute__((ext_vector_type(4)));
typedef unsigned u32x2 __attribute__((ext_vector_type(2)));
#define DI __device__ __forceinline__
DI unsigned cvtpk(float lo, float hi) { f32x2_t v = {lo, hi}; bf16x2_t b = __builtin_convertvector(v, bf16x2_t); return __builtin_bit_cast(unsigned, b); }
DI float bflo(unsigned u) { return __uint_as_float(u << 16); }
DI float bfhi(unsigned u) { return __uint_as_float(u & 0xffff0000u); }
DI int crow(int i, int hi) { return (i & 3) + 8 * (i >> 2) + 4 * hi; }
DI int krow(int s, int hi, int j) { return 16 * s + 8 * (j >> 2) + 4 * hi + (j & 3); }
DI float swap_add(float v) { auto rr = __builtin_amdgcn_permlane32_swap(__float_as_uint(v), __float_as_uint(v), false, false); return __uint_as_float(rr[0]) + __uint_as_float(rr[1]); }
DI float swap_max(float v) { auto rr = __builtin_amdgcn_permlane32_swap(__float_as_uint(v), __float_as_uint(v), false, false); return fmaxf(__uint_as_float(rr[0]), __uint_as_float(rr[1])); }
DI float dot2bf(unsigned a, unsigned b, float acc) { return __builtin_amdgcn_fdot2_f32_bf16(__builtin_bit_cast(bf16x2_t, a), __builtin_bit_cast(bf16x2_t, b), acc, false); }
DI float ex2(float x) { return __builtin_amdgcn_exp2f(x); }
DI float lg2(float x) { return __builtin_amdgcn_logf(x); }
DI float fexp(float x) { return __builtin_amdgcn_exp2f(x * LOG2E); }
DI float wave_sum(float v) {
#pragma unroll
    for (int o = 1; o < 64; o <<= 1) v += __shfl_xor(v, o);
    return v;
}
DI float wave_max(float v) {
#pragma unroll
    for (int o = 1; o < 64; o <<= 1) v = fmaxf(v, __shfl_xor(v, o));
    return v;
}
#define DPP_MAXF(v, ctrl, rmask) fmaxf((v), __builtin_bit_cast(float, __builtin_amdgcn_update_dpp(0, __builtin_bit_cast(int, (v)), (ctrl), (rmask), 0xF, false)))
DI float wave_max_nonneg(float v) {
    v = DPP_MAXF(v, 0xB1, 0xF); v = DPP_MAXF(v, 0x4E, 0xF); v = DPP_MAXF(v, 0x141, 0xF); v = DPP_MAXF(v, 0x140, 0xF); v = DPP_MAXF(v, 0x142, 0xA); v = DPP_MAXF(v, 0x143, 0xC);
    return __builtin_bit_cast(float, __builtin_amdgcn_readlane(__builtin_bit_cast(int, v), 63));
}
#define DPP_ADDF(v, ctrl, rmask) ((v) + __builtin_bit_cast(float, __builtin_amdgcn_update_dpp(0, __builtin_bit_cast(int, (v)), (ctrl), (rmask), 0xF, false)))
DI float wave_sum_u(float v) {
    v = DPP_ADDF(v, 0xB1, 0xF); v = DPP_ADDF(v, 0x4E, 0xF); v = DPP_ADDF(v, 0x141, 0xF); v = DPP_ADDF(v, 0x140, 0xF); v = DPP_ADDF(v, 0x142, 0xA); v = DPP_ADDF(v, 0x143, 0xC);
    return __builtin_bit_cast(float, __builtin_amdgcn_readlane(__builtin_bit_cast(int, v), 63));
}
typedef short v4i16_t __attribute__((ext_vector_type(4)));
DI s16x4 trrd(LAS unsigned char* p) { return __builtin_bit_cast(s16x4, __builtin_amdgcn_ds_read_tr16_b64_v4i16((LAS v4i16_t*)p)); }
DI bf16x8 cat8(s16x4 a, s16x4 b) { return (bf16x8){a[0], a[1], a[2], a[3], b[0], b[1], b[2], b[3]}; }
#define MFMA_BF16(a, b, c) __builtin_amdgcn_mfma_f32_32x32x16_bf16((a), (b), (c), 0, 0, 0)
#define MFMA_F16(a, b, c) __builtin_amdgcn_mfma_f32_32x32x16_f16((a), (b), (c), 0, 0, 0)
DI unsigned pkh(float a, float b) { return __builtin_bit_cast(unsigned, __builtin_amdgcn_cvt_pkrtz(a, b)); }
DI bf16x8 packbf(const f32x16& x, int s) { v4u p; p.x = cvtpk(x[8 * s], x[8 * s + 1]); p.y = cvtpk(x[8 * s + 2], x[8 * s + 3]); p.z = cvtpk(x[8 * s + 4], x[8 * s + 5]); p.w = cvtpk(x[8 * s + 6], x[8 * s + 7]); return __builtin_bit_cast(bf16x8, p); }
DI f16x8 packh(const f32x16& x, int s) { v4u p; p.x = pkh(x[8 * s], x[8 * s + 1]); p.y = pkh(x[8 * s + 2], x[8 * s + 3]); p.z = pkh(x[8 * s + 4], x[8 * s + 5]); p.w = pkh(x[8 * s + 6], x[8 * s + 7]); return __builtin_bit_cast(f16x8, p); }

struct Frame {
    LAS unsigned char* lds;
    volatile LAS unsigned* MISC;
    gu32* ctl;
    unsigned char* ws;
    int tid, lane, wave, vcu, G;
};
DI const float* inp(int i) { const __attribute__((address_space(4))) unsigned long long* kp = (const __attribute__((address_space(4))) unsigned long long*)__builtin_amdgcn_kernarg_segment_ptr(); return (const float*)(const GAS float*)(*(volatile const __attribute__((address_space(4))) unsigned long long*)(kp + i)); }
enum { I_X = 0, I_C, I_WADA, I_BADA, I_GN1, I_WIN, I_BIG, I_BFG, I_CONVW, I_GQ, I_GK, I_GOSB, I_GOML, I_WOUT, I_GN2, I_WQ, I_SK, I_EU, I_EV, I_OUT };
#define WSP(type, off) ((type*)(F.ws + (off)))

DI void p0_transpose_item(const float* W, int K, int N, int ld, bf16* WT, LAS float* scr, int item, int lane) {
    const int nblk = N / 32, kb = item / nblk, nb = item % nblk, k0 = 64 * kb, n0 = 32 * nb;
    float tv[32];
#pragma unroll
    for (int i = 0; i < 32; ++i) tv[i] = W[(size_t)(k0 + 2 * i + (lane >> 5)) * ld + n0 + (lane & 31)];
#pragma unroll
    for (int i = 0; i < 32; ++i) scr[(2 * i + (lane >> 5)) * 33 + (lane & 31)] = tv[i];
    LDS_WAIT(); asm volatile("" ::: "memory");
    const int c = lane & 7;
#pragma unroll
    for (int j = 0; j < 4; ++j) { const int n = (lane >> 3) + 8 * j; const LAS float* s = scr + (8 * c) * 33 + n;
        v4u o; o.x = pk2(s[0 * 33], s[1 * 33]); o.y = pk2(s[2 * 33], s[3 * 33]); o.z = pk2(s[4 * 33], s[5 * 33]); o.w = pk2(s[6 * 33], s[7 * 33]);
        *(GAS v4u*)(WT + (size_t)(n0 + n) * K + k0 + 8 * c) = o; }
    LDS_WAIT(); asm volatile("" ::: "memory");
}
DI void p0_mod_block(const Frame& F, int item) {
    const float* const c_ = inp(I_C); const float* const w_ada_ = inp(I_WADA); const float* const b_ada_ = inp(I_BADA); float* const mod_ = WSP(float, WS_MOD);
    LAS float* scr = (LAS float*)(F.lds + F.wave * 16384);
    const int j = item * 64 + F.lane, d0 = F.wave * 128;
#pragma unroll
    for (int b = 0; b < 8; ++b)
#pragma unroll
        for (int q = 0; q < 2; ++q) { const float cv = c_[b * D + d0 + 64 * q + F.lane]; scr[b * 128 + 64 * q + F.lane] = cv / (1.f + fexp(-cv)); }
    LDS_WAIT(); asm volatile("" ::: "memory");
    float acc[8];
#pragma unroll
    for (int b = 0; b < 8; ++b) acc[b] = 0.f;
#pragma unroll 32
    for (int dd = 0; dd < 128; ++dd) { const float w = w_ada_[(size_t)(d0 + dd) * NMOD + j];
#pragma unroll
        for (int b = 0; b < 8; ++b) acc[b] += scr[b * 128 + dd] * w; }
#pragma unroll
    for (int b = 0; b < 8; ++b) scr[1024 + b * 64 + F.lane] = acc[b];
    __syncthreads();
    float tot = b_ada_[j];
#pragma unroll
    for (int w = 0; w < 8; ++w) tot += ((LAS float*)(F.lds + w * 16384))[1024 + F.wave * 64 + F.lane];
    mod_[F.wave * NMOD + j] = tot;
    __syncthreads();
}
DI void p0_weff_item(const Frame& F, int item) {
    const float* const sub_keys_ = inp(I_SK); const float* const w_q_peer_ = inp(I_WQ); bf16* const Weff_t_ = WSP(bf16, WS_WEFF);
    const int hp = item >> 4, dblk = item & 15;
    LAS float* sk = (LAS float*)F.lds;
    LAS float* rb = (LAS float*)(F.lds + 67584) + F.wave * 1024;
    { float tv[32];
#pragma unroll
      for (int i = 0; i < 32; ++i) tv[i] = sub_keys_[(size_t)hp * 16384 + F.tid + 512 * i];
#pragma unroll
      for (int i = 0; i < 32; ++i) { const int idx = F.tid + 512 * i; sk[(idx >> 7) * 129 + (idx & 127)] = tv[i]; } }
    const int d0 = 64 * dblk + 8 * F.wave;
#pragma unroll
    for (int r = 0; r < 8; ++r) { rb[r * 128 + F.lane] = w_q_peer_[(size_t)(d0 + r) * NSC + hp * 128 + F.lane]; rb[r * 128 + 64 + F.lane] = w_q_peer_[(size_t)(d0 + r) * NSC + hp * 128 + 64 + F.lane]; }
    __syncthreads();
    float a0[8], a1[8];
#pragma unroll
    for (int r = 0; r < 8; ++r) { a0[r] = 0.f; a1[r] = 0.f; }
#pragma unroll 4
    for (int c = 0; c < 128; ++c) { const float s0 = sk[F.lane * 129 + c], s1 = sk[(F.lane + 64) * 129 + c];
#pragma unroll
        for (int r = 0; r < 8; ++r) { const float a = rb[r * 128 + c]; a0[r] += a * s0; a1[r] += a * s1; } }
    v4u o0, o1; o0.x = pk2(a0[0], a0[1]); o0.y = pk2(a0[2], a0[3]); o0.z = pk2(a0[4], a0[5]); o0.w = pk2(a0[6], a0[7]);
    o1.x = pk2(a1[0], a1[1]); o1.y = pk2(a1[2], a1[3]); o1.z = pk2(a1[4], a1[5]); o1.w = pk2(a1[6], a1[7]);
    *(GAS v4u*)(Weff_t_ + (size_t)(hp * 128 + F.lane) * D + d0) = o0;
    *(GAS v4u*)(Weff_t_ + (size_t)(hp * 128 + 64 + F.lane) * D + d0) = o1;
    __syncthreads();
}
struct ExpRows2 { f32x4 v[2][4]; };
DI void exp_load2(const Frame& F, int blk0, ExpRows2& R) {
    const float* const expert_u_ = inp(I_EU); const float* const expert_v_ = inp(I_EV);
#pragma unroll
    for (int bb = 0; bb < 2; ++bb) { const int blk = blk0 + bb; const float* src = (blk < 16384 ? expert_u_ : expert_v_) + (size_t)(blk & 16383) * 1024 + 4 * F.lane;
#pragma unroll
        for (int k = 0; k < 4; ++k) R.v[bb][k] = __builtin_nontemporal_load((const GAS f32x4*)(src + 256 * k)); }
}
DI void exp_conv2(const Frame& F, int blk0, const ExpRows2& R) {
    float* const SUI_ = WSP(float, WS_SUI); float* const SVI_ = WSP(float, WS_SVI);
#pragma unroll
    for (int bb = 0; bb < 2; ++bb) { const int blk = blk0 + bb; const bool isu = blk < 16384; const int e = blk & 16383;
        float mx = 0.f;
#pragma unroll
        for (int k = 0; k < 4; ++k) mx = fmaxf(mx, fmaxf(fmaxf(fabsf(R.v[bb][k].x), fabsf(R.v[bb][k].y)), fmaxf(fabsf(R.v[bb][k].z), fabsf(R.v[bb][k].w))));
        mx = wave_max_nonneg(mx);
        if (isu) {
            float best = 3.0e38f, bs = 0.f;
#define EXP_TRY(FAC) do { const float s_ = mx * ((FAC) / 7.f), inv_ = s_ > 0.f ? 1.f / s_ : 0.f; float er_ = 0.f; \
                _Pragma("unroll") for (int k = 0; k < 4; ++k) _Pragma("unroll") for (int c = 0; c < 4; ++c) { const float v_ = R.v[bb][k][c]; const float d_ = v_ - s_ * fminf(fmaxf(rintf(v_ * inv_), -7.f), 7.f); er_ += d_ * d_; } \
                er_ = wave_sum_u(er_); if (er_ < best) { best = er_; bs = s_; } } while (0)
            EXP_TRY(1.f); EXP_TRY(0.86f); EXP_TRY(0.74f); EXP_TRY(0.63f);
#undef EXP_TRY
            const float inv = bs > 0.f ? 1.f / bs : 0.f;
            unsigned w01[2] = {0u, 0u};
#pragma unroll
            for (int k = 0; k < 4; ++k)
#pragma unroll
                for (int c = 0; c < 4; ++c) { const int q = (int)fminf(fmaxf(rintf(R.v[bb][k][c] * inv), -7.f), 7.f); w01[k >> 1] |= (unsigned)(q & 15) << (4 * (4 * (k & 1) + c)); }
            if (F.lane == 0) SUI_[e] = bs;
            typedef unsigned v2u_ __attribute__((ext_vector_type(2)));
            v2u_ wv; wv.x = w01[0]; wv.y = w01[1];
            *(GAS v2u_*)(WSP(unsigned char, WS_EXPU) + (size_t)e * 512 + 8 * F.lane) = wv;
        } else {
            const float top = 127.f, sc = mx > 0.f ? top / mx : 0.f;
            if (F.lane == 0) SVI_[e] = mx > 0.f ? mx / top : 0.f;
            unsigned char* dst = WSP(unsigned char, WS_EXPV) + (size_t)e * 1024 + 4 * F.lane;
#pragma unroll
            for (int k = 0; k < 4; ++k) { const f32x4 a = R.v[bb][k] * sc;
                const int q0 = (int)rintf(a.x), q1 = (int)rintf(a.y), q2 = (int)rintf(a.z), q3 = (int)rintf(a.w); const unsigned w = (unsigned)(q0 & 0xff) | ((unsigned)(q1 & 0xff) << 8) | ((unsigned)(q2 & 0xff) << 16) | ((unsigned)q3 << 24);
                *(GAS unsigned*)(dst + 256 * k) = w; }
        } }
}
#ifndef P0_PARTS
#define P0_PARTS 15
#endif
DI void p0_phase(const Frame& F, int parts = 15) {
    const float* const w_in_ = inp(I_WIN); bf16* const Win_t_ = WSP(bf16, WS_WIN); const float* const w_out_ = inp(I_WOUT); bf16* const Wout_t_ = WSP(bf16, WS_WOUT); const float* const expert_v_ = inp(I_EV); const float* const expert_u_ = inp(I_EU);
    LAS float* scr = (LAS float*)(F.lds + F.wave * 16384);
    const int gw = F.vcu * NWAVES + F.wave, NGW = F.G * NWAVES;
    if (parts & 1) for (int it = F.vcu; it < 96; it += F.G) p0_mod_block(F, it);
    constexpr int I_WIN = 16 * 112, I_WOUT = 16 * 32, NITEMS = I_WIN + I_WOUT;
    if (parts & 2) for (int it = gw; it < NITEMS; it += NGW) {
        int r = it;
        if (r < I_WIN) { p0_transpose_item(w_in_, D, NPROJ, NIN, Win_t_, scr, r, F.lane); continue; } r -= I_WIN;
        p0_transpose_item(w_out_, D, D, D, Wout_t_, scr, r, F.lane);
    }
    __syncthreads();
    if (parts & 8) for (int it = F.vcu; it < 256; it += F.G) p0_weff_item(F, it);
}

template <bool DOGATES>
DI void norm_phase(const Frame& F, const float* src, const float* g, int shift_off, int scale_off) {
    const float* const w_in_ = inp(I_WIN); float* const mod_ = WSP(float, WS_MOD); bf16* const XN_ = WSP(bf16, WS_XN); float* const GATES_ = WSP(float, WS_GATES); const float* const b_igate_ = inp(I_BIG); const float* const b_fgate_ = inp(I_BFG);
    LAS float* W8 = (LAS float*)F.lds;
    if (DOGATES) {
        for (int i = 0; i < 16; ++i) { const int idx = F.tid + 512 * i; W8[idx] = w_in_[(size_t)(idx & 1023) * NIN + NPROJ + (idx >> 10)]; }
        __syncthreads();
    }
    const int gw = F.vcu * NWAVES + F.wave, NGW = F.G * NWAVES;
    for (int ch = gw; ch < T / 16; ch += NGW) {
        const int r0 = ch * 16, b = r0 / SEQ;
        f32x4 A[4], Bv[4];
#pragma unroll
        for (int j = 0; j < 4; ++j) { const int col = 4 * F.lane + 256 * j; const f32x4 gg = *(const f32x4*)(g + col), sc = *(const f32x4*)(mod_ + b * NMOD + scale_off + col);
            A[j] = gg * (sc + 1.0f); Bv[j] = *(const f32x4*)(mod_ + b * NMOD + shift_off + col); }
        f32x4 nx[4];
        { const GAS f32x4* xr0 = (const GAS f32x4*)(src + (size_t)r0 * D) + F.lane;
#pragma unroll
          for (int j = 0; j < 4; ++j) nx[j] = __builtin_nontemporal_load(xr0 + 64 * j); }
        for (int rr = 0; rr < 16; ++rr) {
            const int row = r0 + rr;
            f32x4 v[4]; float s = 0.f;
#pragma unroll
            for (int j = 0; j < 4; ++j) { v[j] = nx[j]; s += (v[j].x * v[j].x + v[j].y * v[j].y) + (v[j].z * v[j].z + v[j].w * v[j].w); }
            if (rr + 1 < 16) { const GAS f32x4* xr = (const GAS f32x4*)(src + (size_t)(row + 1) * D) + F.lane;
#pragma unroll
                for (int j = 0; j < 4; ++j) nx[j] = __builtin_nontemporal_load(xr + 64 * j); }
            const float rstd = 1.f / sqrtf(wave_sum_u(s) * (1.f / D) + EPS);
#pragma unroll
            for (int j = 0; j < 4; ++j) v[j] = v[j] * rstd * A[j] + Bv[j];
            GAS unsigned long long* o8 = (GAS unsigned long long*)(XN_ + (size_t)row * D) + F.lane;
#pragma unroll
            for (int j = 0; j < 4; ++j) o8[64 * j] = (unsigned long long)pk2(v[j].x, v[j].y) | ((unsigned long long)pk2(v[j].z, v[j].w) << 32);
            if (DOGATES) {
                float res = 0.f;
#pragma unroll
                for (int hh = 0; hh < 8; ++hh) { float p = 0.f;
#pragma unroll
                    for (int j = 0; j < 4; ++j) { const f32x4 w = *(const LAS f32x4*)(W8 + hh * 1024 + 4 * F.lane + 256 * j); p += (v[j].x * w.x + v[j].y * w.y) + (v[j].z * w.z + v[j].w * w.w); }
                    p = wave_sum_u(p); if (F.lane == hh) res = p; }
                if (F.lane < 8) GATES_[(size_t)row * 8 + F.lane] = res + (F.lane < 4 ? b_igate_[F.lane] : b_fgate_[F.lane - 4]);
            }
        }
    }
}

DI void sb_unit(const Frame& F, int b, int h, int qb) {
    bf16* const PROJ_ = WSP(bf16, WS_PROJ); const float* const g_q_sb_ = inp(I_GQ); const float* const g_k_sb_ = inp(I_GK); bf16* const MIX_ = WSP(bf16, WS_MIX); const float* const g_out_sb_ = inp(I_GOSB);
    const int lane = F.lane, w = F.wave, r = lane & 31, hi = lane >> 5;
    const int i16 = lane & 15, qq = i16 >> 2, pp = i16 & 3, blk = (lane >> 4) & 1;
    LAS unsigned char* Wb = F.lds + w * 16384;
    const size_t rowbase = (size_t)b * SEQ; const int q0 = qb * 256, qw0 = q0 + 32 * w, tq = qw0 + r;
    const bf16* P = PROJ_;
    const bf16* kpiece[4]; const bf16* vpiece[4];
#pragma unroll
    for (int i = 0; i < 4; ++i) { const int krow_ = 8 * i + (lane >> 3), kch = (lane & 7) ^ ((krow_ >> 1) & 7); kpiece[i] = P + (rowbase + krow_) * NPROJ + C_KSB + h * 64 + 8 * kch;
        const int vkey = 16 * (i & 1) + (lane >> 2); vpiece[i] = P + (rowbase + vkey) * NPROJ + C_VSB + h * 64 + 32 * (i >> 1) + 8 * (lane & 3); }
#define SB_DMA(T_, BUF_) do { _Pragma("unroll") for (int i_ = 0; i_ < 4; ++i_) { \
        __builtin_amdgcn_global_load_lds((const unsigned*)(kpiece[i_] + (size_t)(32 * (T_)) * NPROJ), (LAS unsigned*)(Wb + 8192 * (BUF_) + 1024 * i_), 16, 0, 0); \
        __builtin_amdgcn_global_load_lds((const unsigned*)(vpiece[i_] + (size_t)(32 * (T_)) * NPROJ), (LAS unsigned*)(Wb + 8192 * (BUF_) + 4096 + 1024 * i_), 16, 0, 0); } } while (0)
    const int tw = (qw0 + 30) >> 5;
    SB_DMA(tw, 0);
    bf16x8 qf[4];
    {
        const bf16* Qp = P + (rowbase + tq) * NPROJ + C_QSB + h * 64 + 8 * hi;
        v4u qraw[4]; float ss = 0.f;
#pragma unroll
        for (int kk = 0; kk < 4; ++kk) { qraw[kk] = *(const GAS v4u*)(Qp + 16 * kk);
#pragma unroll
            for (int e = 0; e < 4; ++e) { const float a = bflo(qraw[kk][e]), c = bfhi(qraw[kk][e]); ss += a * a + c * c; } }
        ss = swap_add(ss);
        const float rq = __builtin_amdgcn_rsqf(ss * (1.f / 64.f) + EPS) * (0.125f * LOG2E);
#pragma unroll
        for (int kk = 0; kk < 4; ++kk) { const int d0 = 16 * kk + 8 * hi;
            const f32x4 g0 = *(const f32x4*)(g_q_sb_ + d0) * *(const f32x4*)(g_k_sb_ + d0), g1 = *(const f32x4*)(g_q_sb_ + d0 + 4) * *(const f32x4*)(g_k_sb_ + d0 + 4);
            v4u o; o.x = cvtpk(bflo(qraw[kk].x) * rq * g0.x, bfhi(qraw[kk].x) * rq * g0.y); o.y = cvtpk(bflo(qraw[kk].y) * rq * g0.z, bfhi(qraw[kk].y) * rq * g0.w);
            o.z = cvtpk(bflo(qraw[kk].z) * rq * g1.x, bfhi(qraw[kk].z) * rq * g1.y); o.w = cvtpk(bflo(qraw[kk].w) * rq * g1.z, bfhi(qraw[kk].w) * rq * g1.w);
            qf[kk] = __builtin_bit_cast(bf16x8, o); }
    }
    f16x8 U0, U1, E0;
#pragma unroll
    for (int j = 0; j < 8; ++j) { U0[j] = (krow(0, hi, j) > r) ? (_Float16)1.0f : (_Float16)0.0f; U1[j] = (krow(1, hi, j) > r) ? (_Float16)1.0f : (_Float16)0.0f;
        E0[j] = (j == 0 && hi == 0) ? (_Float16)1.0f : (_Float16)0.0f; }
    f32x16 o0, o1;
#pragma unroll
    for (int i = 0; i < 16; ++i) { o0[i] = 0.f; o1[i] = 0.f; }
    float R = 0.f;
    const int kfoff = r * 128, kfsw = (r >> 1) & 7;
    for (int t = tw; t >= 0; --t) {
        const int buf = (tw - t) & 1;
        LAS unsigned char* Kb = Wb + 8192 * buf; LAS unsigned char* Vb = Kb + 4096;
        asm volatile("s_waitcnt vmcnt(0)" ::: "memory");
        if (t > 0) SB_DMA(t - 1, buf ^ 1);
        bf16x8 kf[4]; float ssk = 0.f;
#pragma unroll
        for (int kk = 0; kk < 4; ++kk) { const v4u kv = *(const LAS v4u*)(Kb + kfoff + (((2 * kk + hi) ^ kfsw) * 16)); kf[kk] = __builtin_bit_cast(bf16x8, kv);
            ssk = dot2bf(kv.x, kv.x, ssk); ssk = dot2bf(kv.y, kv.y, ssk); ssk = dot2bf(kv.z, kv.z, ssk); ssk = dot2bf(kv.w, kv.w, ssk); }
        ssk = swap_add(ssk);
        const float rk = __builtin_amdgcn_rsqf(ssk * (1.f / 64.f) + EPS);
        f16x8 RKA;
#pragma unroll
        for (int e = 0; e < 8; ++e) RKA[e] = (_Float16)0.0f;
        RKA[0] = (hi == 0) ? (_Float16)rk : (_Float16)0.0f;
        f32x16 s, rkd;
#pragma unroll
        for (int i = 0; i < 16; ++i) { s[i] = 0.f; rkd[i] = 0.f; }
        rkd = MFMA_F16(RKA, E0, rkd);
#pragma unroll
        for (int kk = 0; kk < 4; ++kk) s = MFMA_BF16(kf[kk], qf[kk], s);
        float tsum = 0.f; unsigned lp[8];
        if (32 * t + 31 < qw0) {
#pragma unroll
            for (int i = 0; i < 16; i += 2) {
                const float z0_ = s[i] * rkd[i], z1_ = s[i + 1] * rkd[i + 1];
                const float a0_ = -lg2(1.f + ex2(z0_)), a1_ = -lg2(1.f + ex2(z1_));
                tsum += a0_ + a1_;
                s[i] = z0_ + a0_; s[i + 1] = z1_ + a1_;
                lp[i >> 1] = pkh(a0_, a1_); }
        } else {
            const int kq = tq - 32 * t;
#pragma unroll
            for (int i = 0; i < 16; i += 2) {
                const float z0_ = s[i] * rkd[i], z1_ = s[i + 1] * rkd[i + 1];
                float a0_ = -lg2(1.f + ex2(z0_)), a1_ = -lg2(1.f + ex2(z1_));
                const bool ma0 = crow(i, hi) >= kq, ma1 = crow(i + 1, hi) >= kq;
                a0_ = ma0 ? 0.f : a0_; a1_ = ma1 ? 0.f : a1_;
                tsum += a0_ + a1_;
                s[i] = ma0 ? -INFINITY : z0_ + a0_; s[i + 1] = ma1 ? -INFINITY : z1_ + a1_;
                lp[i >> 1] = pkh(a0_, a1_); }
        }
        f32x16 c;
#pragma unroll
        for (int i = 0; i < 16; ++i) c[i] = R;
        c = MFMA_F16(U0, __builtin_bit_cast(f16x8, (v4u){lp[0], lp[1], lp[2], lp[3]}), c); c = MFMA_F16(U1, __builtin_bit_cast(f16x8, (v4u){lp[4], lp[5], lp[6], lp[7]}), c);
#pragma unroll
        for (int i = 0; i < 16; ++i) s[i] = ex2(s[i] + c[i]);
        const bf16x8 W0 = packbf(s, 0), W1 = packbf(s, 1);
        LAS unsigned char* vb_ = Vb + (4 * hi + qq) * 64 + 32 * blk + 8 * pp;
        o0 = MFMA_BF16(cat8(trrd(vb_), trrd(vb_ + 8 * 64)), W0, o0); o0 = MFMA_BF16(cat8(trrd(vb_ + 16 * 64), trrd(vb_ + 24 * 64)), W1, o0);
        o1 = MFMA_BF16(cat8(trrd(vb_ + 2048), trrd(vb_ + 2048 + 8 * 64)), W0, o1); o1 = MFMA_BF16(cat8(trrd(vb_ + 2048 + 16 * 64), trrd(vb_ + 2048 + 24 * 64)), W1, o1);
        R += swap_add(tsum);
        if (__all(R < -150.f)) break;
    }
    asm volatile("s_waitcnt vmcnt(0)" ::: "memory");
#undef SB_DMA
    {
        float ss = 0.f;
#pragma unroll
        for (int i = 0; i < 16; ++i) ss += o0[i] * o0[i] + o1[i] * o1[i];
        ss = swap_add(ss);
        const float ro = __builtin_amdgcn_rsqf(ss * (1.f / 64.f) + EPS);
        bf16* Op = MIX_ + (rowbase + tq) * D + h * 64;
        const float* go = g_out_sb_ + h * 64;
#pragma unroll
        for (int g = 0; g < 4; ++g) { const int d0 = 8 * g + 4 * hi; const f32x4 ga = *(const f32x4*)(go + d0), gb = *(const f32x4*)(go + 32 + d0);
            u32x2 wa, wb; wa.x = cvtpk(o0[4 * g] * ro * ga.x, o0[4 * g + 1] * ro * ga.y); wa.y = cvtpk(o0[4 * g + 2] * ro * ga.z, o0[4 * g + 3] * ro * ga.w);
            wb.x = cvtpk(o1[4 * g] * ro * gb.x, o1[4 * g + 1] * ro * gb.y); wb.y = cvtpk(o1[4 * g + 2] * ro * gb.z, o1[4 * g + 3] * ro * gb.w);
            *(GAS u32x2*)(Op + d0) = wa; *(GAS u32x2*)(Op + 32 + d0) = wb; }
    }
    __syncthreads();
}

DI void conv_silu8(const v4u (&xr)[4], const float (&cw)[4][8], float scale, float (&y)[8]) {
#pragma unroll
    for (int e = 0; e < 8; ++e) y[e] = 0.f;
#pragma unroll
    for (int j = 0; j < 4; ++j) {
        y[0] += cw[j][0] * bflo(xr[j].x); y[1] += cw[j][1] * bfhi(xr[j].x); y[2] += cw[j][2] * bflo(xr[j].y); y[3] += cw[j][3] * bfhi(xr[j].y);
        y[4] += cw[j][4] * bflo(xr[j].z); y[5] += cw[j][5] * bfhi(xr[j].z); y[6] += cw[j][6] * bflo(xr[j].w); y[7] += cw[j][7] * bfhi(xr[j].w); }
#pragma unroll
    for (int e = 0; e < 8; ++e) y[e] = scale * y[e] * __builtin_amdgcn_rcpf(1.f + fexp(-y[e]));
}
DI float log_sigmoid(float x) { return fminf(x, 0.f) - 0.6931471805599453f * lg2(1.f + fexp(-fabsf(x))); }
DI float wave_scan_incl(float a, int lane) {
#pragma unroll
    for (int o = 1; o < 64; o <<= 1) { const float t = __shfl_up(a, o); if (lane >= o) a += t; }
    return a;
}

constexpr int LDS_CW = 65536;
DI void stage_conv_w(const Frame& F) {
    const float* const conv_w_ = inp(I_CONVW); LAS float* cwl = (LAS float*)(F.lds + LDS_CW);
    for (int i = F.tid; i < 4096; i += NTHR) cwl[i] = conv_w_[i];
    __syncthreads();
}
DI void load_cw8(const Frame& F, int colbase, float (&cw)[4][8]) {
    const LAS float* cwl = (const LAS float*)(F.lds + LDS_CW);
#pragma unroll
    for (int j = 0; j < 4; ++j) { const f32x4 a = *(const LAS f32x4*)(cwl + j * 1024 + colbase), b = *(const LAS f32x4*)(cwl + j * 1024 + colbase + 4);
        cw[j][0] = a.x; cw[j][1] = a.y; cw[j][2] = a.z; cw[j][3] = a.w; cw[j][4] = b.x; cw[j][5] = b.y; cw[j][6] = b.z; cw[j][7] = b.w; }
}
struct MlLocalRegs { v4u kraw[2][4]; v4u vraw[2]; float gi, gf; };
DI void ml_local_load(const Frame& F, int chain, int c, MlLocalRegs& R) {
    bf16* const PROJ_ = WSP(bf16, WS_PROJ); float* const GATES_ = WSP(float, WS_GATES);
    const int tid = F.tid, lane = F.lane;
    const int b = chain >> 2, hh = chain & 3; const size_t rowbase = (size_t)b * SEQ; const int t0 = c * 64;
    const bf16* P = PROJ_;
    const int kc = tid & 15, kr0 = tid >> 4;
    const bf16* Kg = P + rowbase * NPROJ + C_KML + hh * 128 + kc * 8;
#pragma unroll
    for (int i = 0; i < 2; ++i)
#pragma unroll
        for (int j = 0; j < 4; ++j) { const int tt = t0 + kr0 + 32 * i - 3 + j; R.kraw[i][j] = (tt >= 0) ? *(const GAS v4u*)(Kg + (size_t)tt * NPROJ) : (v4u){0u, 0u, 0u, 0u}; }
#pragma unroll
    for (int i = 0; i < 2; ++i) R.vraw[i] = *(const GAS v4u*)(P + (rowbase + t0 + kr0 + 32 * i) * NPROJ + C_VML + hh * 128 + kc * 8);
    const float* Gg = GATES_ + (rowbase + t0 + lane) * 8;
    R.gi = Gg[hh]; R.gf = Gg[4 + hh];
}
DI void ml_local_unit(const Frame& F, int chain, int c, const MlLocalRegs& RG) {
    bf16* const CST_ = WSP(bf16, WS_CST); float* const NST_ = WSP(float, WS_NST); float* const SCL_ = WSP(float, WS_SCL);
    LAS unsigned char* L = F.lds;
    LAS float* Lws = (LAS float*)(L + 32768);
    const int tid = F.tid, lane = F.lane, w = F.wave, r = lane & 31, hi = lane >> 5;
    const int i16 = lane & 15, qq = i16 >> 2, pp = i16 & 3, blk = (lane >> 4) & 1;
    const int hh = chain & 3;
    const int kbk = w & 3, vb0 = 2 * (w >> 2);
    const int kc = tid & 15, kr0 = tid >> 4;
    v4u kraw[2][4], vraw[2];
#pragma unroll
    for (int i = 0; i < 2; ++i) { vraw[i] = RG.vraw[i];
#pragma unroll
        for (int j = 0; j < 4; ++j) kraw[i][j] = RG.kraw[i][j]; }
    const float gi = RG.gi, gf = RG.gf;
    const float a = wave_scan_incl(log_sigmoid(gf), lane);
    const float a_end = __shfl(a, 63);
    const float lw = a_end - a + gi;
    const float m_loc = wave_max(lw);
    const float ws = fexp(lw - m_loc);
    if (w == 0) Lws[lane] = ws;
    {
        float cw[4][8]; load_cw8(F, 512 + hh * 128 + kc * 8, cw);
#pragma unroll
        for (int i = 0; i < 2; ++i) { float y[8]; conv_silu8(kraw[i], cw, 0.08838834764831845f, y);
            v4u o; o.x = cvtpk(y[0], y[1]); o.y = cvtpk(y[2], y[3]); o.z = cvtpk(y[4], y[5]); o.w = cvtpk(y[6], y[7]);
            *(LAS v4u*)(L + (kc >> 2) * 4096 + (kr0 + 32 * i) * 64 + (kc & 3) * 16) = o; }
#pragma unroll
        for (int i = 0; i < 2; ++i) { const int row = kr0 + 32 * i; const float wsr = __shfl(ws, row);
            v4u o; o.x = cvtpk(bflo(vraw[i].x) * wsr, bfhi(vraw[i].x) * wsr); o.y = cvtpk(bflo(vraw[i].y) * wsr, bfhi(vraw[i].y) * wsr); o.z = cvtpk(bflo(vraw[i].z) * wsr, bfhi(vraw[i].z) * wsr); o.w = cvtpk(bflo(vraw[i].w) * wsr, bfhi(vraw[i].w) * wsr);
            *(LAS v4u*)(L + 16384 + (kc >> 2) * 4096 + row * 64 + (kc & 3) * 16) = o; }
    }
    __syncthreads();
    f32x16 acc0, acc1;
#pragma unroll
    for (int i = 0; i < 16; ++i) { acc0[i] = 0.f; acc1[i] = 0.f; }
#pragma unroll
    for (int kk = 0; kk < 4; ++kk) { const int rows = 16 * kk + 8 * hi + qq;
        LAS unsigned char* ka = L + kbk * 4096 + rows * 64 + 32 * blk + 8 * pp; LAS unsigned char* va = L + 16384 + vb0 * 4096 + rows * 64 + 32 * blk + 8 * pp;
        const bf16x8 A = cat8(trrd(ka), trrd(ka + 4 * 64));
        acc0 = MFMA_BF16(A, cat8(trrd(va), trrd(va + 4 * 64)), acc0); acc1 = MFMA_BF16(A, cat8(trrd(va + 4096), trrd(va + 4096 + 4 * 64)), acc1); }
    {
        bf16* Cp = CST_ + ((size_t)(chain * 64 + c) * 128 + vb0 * 32 + r) * 128 + kbk * 32 + 4 * hi;
#pragma unroll
        for (int g = 0; g < 4; ++g) { u32x2 o; o.x = cvtpk(acc0[4 * g], acc0[4 * g + 1]); o.y = cvtpk(acc0[4 * g + 2], acc0[4 * g + 3]); *(GAS u32x2*)(Cp + 8 * g) = o;
            u32x2 o1; o1.x = cvtpk(acc1[4 * g], acc1[4 * g + 1]); o1.y = cvtpk(acc1[4 * g + 2], acc1[4 * g + 3]); *(GAS u32x2*)(Cp + 32 * 128 + 8 * g) = o1; }
    }
    {
        const int k = 16 * w + (lane & 15), sq = lane >> 4; float part = 0.f;
        const LAS unsigned short* kcol = (const LAS unsigned short*)(L + (k >> 5) * 4096 + (k & 31) * 2);
#pragma unroll
        for (int e = 0; e < 16; ++e) part += Lws[16 * sq + e] * __uint_as_float((unsigned)kcol[(16 * sq + e) * 32] << 16);
        part += __shfl_xor(part, 16); part += __shfl_xor(part, 32);
        if (lane < 16) NST_[(size_t)(chain * 64 + c) * 128 + k] = part;
        if (tid == 0) { SCL_[(chain * 64 + c) * 2] = a_end; SCL_[(chain * 64 + c) * 2 + 1] = m_loc; }
    }
    __syncthreads();
}
DI void ml_scan_phase(const Frame& F) {
    bf16* const CST_ = WSP(bf16, WS_CST); float* const NST_ = WSP(float, WS_NST); float* const SCL_ = WSP(float, WS_SCL); float* const MST_ = WSP(float, WS_MST);
    for (int gt = F.vcu * NTHR + F.tid; gt < 32 * 4096; gt += F.G * NTHR) {
        const int chain = gt >> 12, rem = gt & 4095;
        const float ae_l = SCL_[(chain * 64 + F.lane) * 2], ml_l = SCL_[(chain * 64 + F.lane) * 2 + 1];
        u32x2* Cp = (u32x2*)(CST_ + (size_t)chain * 64 * 16384 + (size_t)rem * 4);
        f32x4* Np = (f32x4*)(NST_ + (size_t)chain * 64 * 128 + rem * 4);
        const bool do_n = rem < 32;
        float c0 = 0.f, c1 = 0.f, c2 = 0.f, c3 = 0.f; f32x4 nn = {0.f, 0.f, 0.f, 0.f}; float m = 0.f;
        u32x2 dr[8]; f32x4 nr[8];
#pragma unroll
        for (int i = 0; i < 8; ++i) { dr[i] = Cp[(size_t)i * 4096]; if (do_n) nr[i] = Np[i * 32]; }
        for (int c0_ = 0; c0_ < 64; c0_ += 8) {
#pragma unroll
            for (int i = 0; i < 8; ++i) { const int c = c0_ + i;
                if (c < 63) {
                    const u32x2 dcur = dr[i]; const f32x4 dn = nr[i];
                    if (c + 8 < 63) { dr[i] = Cp[(size_t)(c + 8) * 4096]; if (do_n) nr[i] = Np[(c + 8) * 32]; }
                    const float ae = __builtin_bit_cast(float, __builtin_amdgcn_readlane(__builtin_bit_cast(int, ae_l), c)), ml = __builtin_bit_cast(float, __builtin_amdgcn_readlane(__builtin_bit_cast(int, ml_l), c));
                    const float mn = fmaxf(ae + m, ml), d1 = fexp(ae + m - mn), d2 = fexp(ml - mn);
                    c0 = d1 * c0 + d2 * bflo(dcur.x); c1 = d1 * c1 + d2 * bfhi(dcur.x); c2 = d1 * c2 + d2 * bflo(dcur.y); c3 = d1 * c3 + d2 * bfhi(dcur.y);
                    u32x2 o; o.x = cvtpk(c0, c1); o.y = cvtpk(c2, c3); Cp[(size_t)c * 4096] = o;
                    if (do_n) { nn = nn * d1 + dn * d2; Np[c * 32] = nn; }
                    if (rem == 0) MST_[chain * 64 + c] = mn;
                    m = mn; } }
        }
    }
}
DI void ml_out_unit(const Frame& F, int chain, int c) {
    bf16* const PROJ_ = WSP(bf16, WS_PROJ); float* const GATES_ = WSP(float, WS_GATES); float* const MST_ = WSP(float, WS_MST); bf16* const CST_ = WSP(bf16, WS_CST); float* const NST_ = WSP(float, WS_NST); bf16* const MIX_ = WSP(bf16, WS_MIX); const float* const g_out_ml_ = inp(I_GOML);
    LAS unsigned char* L = F.lds;
    LAS float* Lbs = (LAS float*)(L + 49152); LAS float* Lav = (LAS float*)(L + 49408); LAS float* Lex = (LAS float*)(L + 49664);
    const int tid = F.tid, lane = F.lane, w = F.wave, r = lane & 31, hi = lane >> 5;
    const int i16 = lane & 15, qq = i16 >> 2, pp = i16 & 3, blk = (lane >> 4) & 1;
    const int b = chain >> 2, hh = chain & 3; const size_t rowbase = (size_t)b * SEQ; const int t0 = c * 64;
    const int tb = w >> 2, vb = w & 3;
    const bf16* P = PROJ_;
    {
        const int kc = tid & 15, kr0 = tid >> 4;
#pragma unroll
        for (int which = 0; which < 2; ++which) {
            const int colbase = (which ? 512 : 0) + hh * 128 + kc * 8;
            float cw[4][8]; load_cw8(F, colbase, cw);
            const bf16* Xg = P + rowbase * NPROJ + C_QML + colbase;
#pragma unroll
            for (int i = 0; i < 2; ++i) { const int row = kr0 + 32 * i; v4u xr[4];
#pragma unroll
                for (int j = 0; j < 4; ++j) { const int tt = t0 + row - 3 + j; xr[j] = (tt >= 0) ? *(const GAS v4u*)(Xg + (size_t)tt * NPROJ) : (v4u){0u, 0u, 0u, 0u}; }
                float y[8]; conv_silu8(xr, cw, which ? 0.08838834764831845f : 1.0f, y);
                v4u o; o.x = cvtpk(y[0], y[1]); o.y = cvtpk(y[2], y[3]); o.z = cvtpk(y[4], y[5]); o.w = cvtpk(y[6], y[7]);
                *(LAS v4u*)(L + which * 16384 + row * 256 + ((kc ^ (row & 15)) * 16)) = o; }
        }
#pragma unroll
        for (int i = 0; i < 2; ++i) { const int row = kr0 + 32 * i;
            const v4u v = *(const GAS v4u*)(P + (rowbase + t0 + row) * NPROJ + C_VML + hh * 128 + kc * 8);
            *(LAS v4u*)(L + 32768 + (kc >> 2) * 4096 + row * 64 + (kc & 3) * 16) = v; }
        if (w == 0) { const float* Gg = GATES_ + (rowbase + t0 + lane) * 8; const float a = wave_scan_incl(log_sigmoid(Gg[4 + hh]), lane); Lav[lane] = a; Lbs[lane] = Gg[hh] - a; }
    }
    const float mprev = (c > 0) ? MST_[chain * 64 + c - 1] : 0.f;
    bf16x8 cf[8], nf[8];
    if (c > 0) {
        const bf16* Cp = CST_ + ((size_t)(chain * 64 + c - 1) * 128 + vb * 32 + r) * 128 + 8 * hi;
        const float* Np = NST_ + (size_t)(chain * 64 + c - 1) * 128 + 8 * hi;
        const bool nrow = (r == 0) || (r == 4);
#pragma unroll
        for (int kk = 0; kk < 8; ++kk) { cf[kk] = *(const GAS bf16x8*)(Cp + 16 * kk);
            const f32x4 n0 = *(const f32x4*)(Np + 16 * kk), n1 = *(const f32x4*)(Np + 16 * kk + 4);
            v4u o; o.x = cvtpk(n0.x, n0.y); o.y = cvtpk(n0.z, n0.w); o.z = cvtpk(n1.x, n1.y); o.w = cvtpk(n1.z, n1.w);
            if (!nrow) o = (v4u){0u, 0u, 0u, 0u};
            nf[kk] = __builtin_bit_cast(bf16x8, o); }
    }
    __syncthreads();
    bf16x8 qf[8];
    f32x16 s0, s1;
#pragma unroll
    for (int i = 0; i < 16; ++i) { s0[i] = 0.f; s1[i] = 0.f; }
#pragma unroll
    for (int kk = 0; kk < 8; ++kk) { const int ch = 2 * kk + hi; const int rq_ = 32 * tb + r;
        qf[kk] = *(const LAS bf16x8*)(L + rq_ * 256 + ((ch ^ (rq_ & 15)) * 16));
        const bf16x8 a0 = *(const LAS bf16x8*)(L + 16384 + r * 256 + ((ch ^ (r & 15)) * 16));
        const bf16x8 a1 = *(const LAS bf16x8*)(L + 16384 + (32 + r) * 256 + ((ch ^ ((32 + r) & 15)) * 16));
        s0 = MFMA_BF16(a0, qf[kk], s0); s1 = MFMA_BF16(a1, qf[kk], s1); }
    const int tl = 32 * tb + r; const float a_t = Lav[tl];
    f32x16 d0, d1; float mrow = -INFINITY;
#pragma unroll
    for (int g = 0; g < 4; ++g) { const f32x4 b0 = *(const LAS f32x4*)(Lbs + 8 * g + 4 * hi), b1 = *(const LAS f32x4*)(Lbs + 32 + 8 * g + 4 * hi);
#pragma unroll
        for (int e = 0; e < 4; ++e) { const int sl = 8 * g + 4 * hi + e;
            d0[4 * g + e] = (sl <= tl) ? a_t + b0[e] : -INFINITY; d1[4 * g + e] = (32 + sl <= tl) ? a_t + b1[e] : -INFINITY;
            mrow = fmaxf(mrow, fmaxf(d0[4 * g + e], d1[4 * g + e])); } }
    mrow = fmaxf(swap_max(mrow), a_t + mprev);
    float psum = 0.f;
#pragma unroll
    for (int i = 0; i < 16; ++i) { s0[i] *= fexp(d0[i] - mrow); s1[i] *= fexp(d1[i] - mrow); psum += s0[i] + s1[i]; }
    const float w_inter = fexp(a_t + mprev - mrow);
    float den = swap_add(psum);
    const bf16x8 P00 = packbf(s0, 0), P01 = packbf(s0, 1), P10 = packbf(s1, 0), P11 = packbf(s1, 1);
    f32x16 num;
#pragma unroll
    for (int i = 0; i < 16; ++i) num[i] = 0.f;
    {
        LAS unsigned char* vb_ = L + 32768 + vb * 4096 + (4 * hi + qq) * 64 + 32 * blk + 8 * pp;
        num = MFMA_BF16(cat8(trrd(vb_), trrd(vb_ + 8 * 64)), P00, num); num = MFMA_BF16(cat8(trrd(vb_ + 16 * 64), trrd(vb_ + 24 * 64)), P01, num);
        num = MFMA_BF16(cat8(trrd(vb_ + 32 * 64), trrd(vb_ + 40 * 64)), P10, num); num = MFMA_BF16(cat8(trrd(vb_ + 48 * 64), trrd(vb_ + 56 * 64)), P11, num);
    }
    if (c > 0) {
        f32x16 it, dn;
#pragma unroll
        for (int i = 0; i < 16; ++i) { it[i] = 0.f; dn[i] = 0.f; }
#pragma unroll
        for (int kk = 0; kk < 8; ++kk) { it = MFMA_BF16(cf[kk], qf[kk], it); dn = MFMA_BF16(nf[kk], qf[kk], dn); }
#pragma unroll
        for (int i = 0; i < 16; ++i) num[i] += w_inter * it[i];
        den += w_inter * dn[0];
    }
    const float inv = __builtin_amdgcn_rcpf(fmaxf(fabsf(den), fexp(-mrow)));
    float ss = 0.f;
#pragma unroll
    for (int i = 0; i < 16; ++i) { num[i] *= inv; ss += num[i] * num[i]; }
    ss = swap_add(ss);
    if (lane < 32) Lex[(tb * 4 + vb) * 32 + r] = ss;
    __syncthreads();
    const float tot = (Lex[(tb * 4 + 0) * 32 + r] + Lex[(tb * 4 + 1) * 32 + r]) + (Lex[(tb * 4 + 2) * 32 + r] + Lex[(tb * 4 + 3) * 32 + r]);
    const float rstd = 1.f / sqrtf(tot * (1.f / 128.f) + EPS);
    {
        const size_t trow = rowbase + t0 + tl;
        const bf16* Og = P + trow * NPROJ + C_OML + hh * 128 + vb * 32 + 4 * hi;
        bf16* Mp = MIX_ + trow * D + 512 + hh * 128 + vb * 32 + 4 * hi;
        const float* go = g_out_ml_ + hh * 128 + vb * 32 + 4 * hi;
#pragma unroll
        for (int g = 0; g < 4; ++g) { const u32x2 og = *(const GAS u32x2*)(Og + 8 * g); const f32x4 gg = *(const f32x4*)(go + 8 * g);
            const float o0 = bflo(og.x), o1 = bfhi(og.x), o2 = bflo(og.y), o3 = bfhi(og.y);
            u32x2 o; o.x = cvtpk(num[4 * g] * rstd * gg.x * __builtin_amdgcn_rcpf(1.f + fexp(-o0)), num[4 * g + 1] * rstd * gg.y * __builtin_amdgcn_rcpf(1.f + fexp(-o1)));
            o.y = cvtpk(num[4 * g + 2] * rstd * gg.z * __builtin_amdgcn_rcpf(1.f + fexp(-o2)), num[4 * g + 3] * rstd * gg.w * __builtin_amdgcn_rcpf(1.f + fexp(-o3)));
            *(GAS u32x2*)(Mp + 8 * g) = o; }
    }
    __syncthreads();
}

#define TK_CE(A, B) do { const float hi_ = fmaxf((A), (B)), lo_ = fminf((A), (B)); (A) = hi_; (B) = lo_; } while (0)
DI void tk_sort16(float (&a)[16]) {
#pragma unroll
    for (int k = 2; k <= 16; k <<= 1)
#pragma unroll
        for (int j = k >> 1; j > 0; j >>= 1)
#pragma unroll
            for (int i = 0; i < 16; ++i) { const int l = i ^ j; if (l > i) { if ((i & k) == 0) TK_CE(a[i], a[l]); else TK_CE(a[l], a[i]); } }
}
DI void tk_merge16(float (&a)[16], const float (&b)[16]) {
#pragma unroll
    for (int i = 0; i < 16; ++i) a[i] = fmaxf(a[i], b[15 - i]);
#pragma unroll
    for (int j = 8; j > 0; j >>= 1)
#pragma unroll
        for (int i = 0; i < 16; ++i) { const int l = i ^ j; if (l > i) TK_CE(a[i], a[l]); }
}
DI void tk_stage2(const LAS float* la, const LAS float* lb, int* IDX_, float* GATEW_, size_t o) {
        float a[16], bb[16], cnd[64];
#pragma unroll
        for (int q = 0; q < 16; ++q) { a[q] = la[q]; bb[q] = lb[q]; }
        int cnt = 0;
#pragma unroll
        for (int i = 0; i < 16; ++i)
#pragma unroll
            for (int j = 0; j < 16; ++j) if ((i + 1) * (j + 1) <= 16) { cnd[cnt] = __uint_as_float((__float_as_uint(a[i] + bb[j]) & ~0xFFu) | (unsigned)(i * 16 + j)); ++cnt; }
#pragma unroll
        for (int q = 50; q < 64; ++q) cnd[q] = -INFINITY;
        float top[16];
#pragma unroll
        for (int c = 0; c < 4; ++c) { float ch[16];
#pragma unroll
            for (int q = 0; q < 16; ++q) ch[q] = cnd[16 * c + q];
            tk_sort16(ch);
            if (c == 0) {
#pragma unroll
                for (int q = 0; q < 16; ++q) top[q] = ch[q];
            } else tk_merge16(top, ch); }
        float sv[16]; int ei[16]; float mx = -INFINITY;
#pragma unroll
        for (int q = 0; q < 16; ++q) { const unsigned code = __float_as_uint(top[q]) & 0xFFu; const float va = la[code >> 4], vb = lb[code & 15u];
            ei[q] = (int)((__float_as_uint(va) & 0x7Fu) * 128u + (__float_as_uint(vb) & 0x7Fu)); sv[q] = va + vb; mx = fmaxf(mx, sv[q]); }
        float sum = 0.f;
#pragma unroll
        for (int q = 0; q < 16; ++q) { sv[q] = fexp(sv[q] - mx); sum += sv[q]; }
        const float inv = 1.f / sum;
#pragma unroll
        for (int q = 0; q < 16; q += 4) { *(GAS v4u*)(IDX_ + o + q) = (v4u){(unsigned)ei[q], (unsigned)ei[q + 1], (unsigned)ei[q + 2], (unsigned)ei[q + 3]};
            *(GAS f32x4*)(GATEW_ + o + q) = (f32x4){sv[q] * inv, sv[q + 1] * inv, sv[q + 2] * inv, sv[q + 3] * inv}; }
    }
struct EpiTopK {
    static constexpr bool PERM = false, AFTER_DRAIN = true;
    int* IDX; float* GATEW;
    DI void fused(f32x4 (&acc)[2][2][4][2], const pg8::Unit& u, int wr, int wc, int fr, int fq, LAS unsigned char* lds, int wid, int lane) const {
        LAS float* Tl = (LAS float*)lds;
        LAS float* Lh2 = (LAS float*)lds;
        LAS float* Ls = (LAS float*)(lds + 36864);
        const int tid = wid * 64 + lane, tl = tid & 127, p = (tid >> 7) & 1, half = tid >> 8;
#pragma unroll
        for (int ai = 0; ai < 2; ++ai) {
#pragma unroll
            for (int bj = 0; bj < 2; ++bj)
#pragma unroll
                for (int m = 0; m < 4; ++m)
#pragma unroll
                    for (int n = 0; n < 2; ++n) { LAS float* d = Tl + (wr * 64 + m * 16 + fr) * 257 + bj * 128 + wc * 32 + n * 16 + fq * 4; const f32x4 v = acc[ai][bj][m][n]; d[0] = v.x; d[1] = v.y; d[2] = v.z; d[3] = v.w; }
            __syncthreads();
            float run[16];
            {
                const LAS float* src = Tl + tl * 257 + p * 128 + half * 64;
#pragma unroll
                for (int c = 0; c < 4; ++c) { float ch[16];
#pragma unroll
                    for (int q = 0; q < 16; ++q) ch[q] = __uint_as_float((__float_as_uint(src[16 * c + q]) & ~0x7Fu) | (unsigned)(half * 64 + 16 * c + q));
                    tk_sort16(ch);
                    if (c == 0) {
#pragma unroll
                        for (int q = 0; q < 16; ++q) run[q] = ch[q];
                    } else tk_merge16(run, ch); }
            }
            __syncthreads();
#pragma unroll
            for (int q = 0; q < 16; ++q) Lh2[((tl * 2 + p) * 2 + half) * 17 + q] = run[q];
            __syncthreads();
            if (half == 0) { float oth[16];
#pragma unroll
                for (int q = 0; q < 16; ++q) oth[q] = Lh2[((tl * 2 + p) * 2 + 1) * 17 + q];
                tk_merge16(run, oth);
#pragma unroll
                for (int q = 0; q < 16; ++q) Ls[(tl * 2 + p) * 17 + q] = run[q]; }
            __syncthreads();
            if (tid < 128) tk_stage2(Ls + (tl * 2) * 17, Ls + (tl * 2) * 17 + 17, IDX, GATEW, (size_t)(u.pm * 256 + ai * 128 + tl) * 128 + u.pn * 16);
            __syncthreads();
        }
    }
};
struct OneUnit {
    pg8::Unit u;
    __device__ __forceinline__ bool next(int i, pg8::Unit& o) const { if (i) return false; o = u; return true; }
    __device__ __forceinline__ void a_ready(const pg8::Unit&) const {}
    __device__ __forceinline__ void done(const pg8::Unit&) const {}
};

DI float gelu_erf(float x) { return 0.5f * x * (1.f + erff(x * 0.7071067811865476f)); }
#define DPP_ADD(v, ctrl, rmask) ((v) + __builtin_bit_cast(float, __builtin_amdgcn_update_dpp(0, __builtin_bit_cast(int, (v)), (ctrl), (rmask), 0xF, false)))
#ifndef PEER_EBL
#define PEER_EBL 9
#endif
constexpr int PEER_EB_LOG = PEER_EBL;
#ifndef PEER_PROBE_MASK
#define PEER_PROBE_MASK 0xFFFF
#endif
typedef float f32x2v __attribute__((ext_vector_type(2)));
DI float gelu_cdf(float v) {
    const float av = fabsf(v), t = __builtin_amdgcn_rcpf(av * 0.2316418882f + 1.0f);
    float q = t * 0.5307027145f - 0.7265760135f; q = q * t + 0.7107068705f; q = q * t - 0.142248368f; q = q * t + 0.127414796f; q = q * t;
    const float m = v * (q * ex2(v * v * -0.72134752044f));
    return v < 0.f ? m : v - m;
}
#define DPP_ADDI(v, ctrl, rmask) ((v) + __builtin_amdgcn_update_dpp(0, (v), (ctrl), (rmask), 0xF, false))
DI void peer_phase(const Frame& F, bool scratch_dst) {
    bf16* const XN_ = WSP(bf16, WS_XN); int* const IDX_ = WSP(int, WS_IDX); float* const GATEW_ = WSP(float, WS_GATE); float* const mod_ = WSP(float, WS_MOD); float* const out_ = (float*)inp(I_OUT);
    const unsigned char* const EU4 = WSP(unsigned char, WS_EXPU); const unsigned char* const EV8 = WSP(unsigned char, WS_EXPV); const float* const SUI_ = WSP(float, WS_SUI); const float* const SVI_ = WSP(float, WS_SVI);
    const int gw = F.vcu * NWAVES + F.wave, NGW = F.G * NWAVES, lane = F.lane, g = lane >> 3, j = lane & 7;
    LAS unsigned char* wl = F.lds + F.wave * 16384;
    volatile LAS int* Le = (volatile LAS int*)(wl + g * 512); volatile LAS float* Lg = (volatile LAS float*)(wl + 4096 + g * 512); volatile LAS int* Lp = (volatile LAS int*)(wl + 8192 + g * 512);
    LAS int* Lh = (LAS int*)(wl + 12288 + g * 128);
    for (int grp = gw; grp < T / 8; grp += NGW) {
        const size_t t = (size_t)grp * 8 + g;
        int xh[16], xl[16]; float sxi;
        {
            float mx = 0.f;
            const bf16* xrow = XN_ + t * D + 8 * j;
#pragma unroll
            for (int kq = 0; kq < 16; ++kq) { const v4u a = *(const GAS v4u*)(xrow + 64 * kq);
#pragma unroll
                for (int e = 0; e < 4; ++e) mx = fmaxf(mx, fmaxf(fabsf(bflo(a[e])), fabsf(bfhi(a[e])))); }
            mx = fmaxf(mx, __shfl_xor(mx, 1, 8)); mx = fmaxf(mx, __shfl_xor(mx, 2, 8)); mx = fmaxf(mx, __shfl_xor(mx, 4, 8));
            const float sx = mx > 0.f ? 119.f / mx : 0.f; sxi = mx > 0.f ? mx / 119.f : 0.f;
#pragma unroll
            for (int q = 0; q < 4; ++q)
#pragma unroll
                for (int kp = 0; kp < 2; ++kp) { const v4u a = *(const GAS v4u*)(xrow + 64 * (8 * kp + q)), b = *(const GAS v4u*)(xrow + 64 * (8 * kp + 4 + q));
#pragma unroll
                    for (int wh = 0; wh < 2; ++wh) {
                        const int t0 = (int)rintf(bflo(a[2 * wh]) * sx) + 8, t1 = (int)rintf(bfhi(a[2 * wh]) * sx) + 8, t2 = (int)rintf(bflo(a[2 * wh + 1]) * sx) + 8, t3 = (int)rintf(bfhi(a[2 * wh + 1]) * sx) + 8;
                        const int t4 = (int)rintf(bflo(b[2 * wh]) * sx) + 8, t5 = (int)rintf(bfhi(b[2 * wh]) * sx) + 8, t6 = (int)rintf(bflo(b[2 * wh + 1]) * sx) + 8, t7 = (int)rintf(bfhi(b[2 * wh + 1]) * sx) + 8;
                        const unsigned lo_ = (unsigned)(t0 & 15) | ((unsigned)(t1 & 15) << 4) | ((unsigned)(t2 & 15) << 8) | ((unsigned)(t3 & 15) << 12) | ((unsigned)(t4 & 15) << 16) | ((unsigned)(t5 & 15) << 20) | ((unsigned)(t6 & 15) << 24) | ((unsigned)(t7 & 15) << 28);
                        const unsigned hi_ = (unsigned)((t0 >> 4) & 15) | ((unsigned)((t1 >> 4) & 15) << 4) | ((unsigned)((t2 >> 4) & 15) << 8) | ((unsigned)((t3 >> 4) & 15) << 12) | ((unsigned)((t4 >> 4) & 15) << 16) | ((unsigned)((t5 >> 4) & 15) << 20) | ((unsigned)((t6 >> 4) & 15) << 24) | ((unsigned)((t7 >> 4) & 15) << 28);
                        xl[4 * q + kp + 2 * wh] = (int)(lo_ ^ 0x88888888u); xh[4 * q + kp + 2 * wh] = (int)hi_; } }
        }
        {
            int ide[16]; float gte[16]; int rk[16];
#pragma unroll
            for (int m = 0; m < 16; ++m) { ide[m] = IDX_[t * 128 + j + 8 * m]; gte[m] = GATEW_[t * 128 + j + 8 * m]; }
#pragma unroll
            for (int m = 0; m < 4; ++m) Lh[j + 8 * m] = 0;
#pragma unroll
            for (int m = 0; m < 16; ++m) rk[m] = __hip_atomic_fetch_add(Lh + (ide[m] >> PEER_EB_LOG), 1, __ATOMIC_RELAXED, __HIP_MEMORY_SCOPE_WORKGROUP);
            {
                const int h0 = ((volatile LAS int*)Lh)[4 * j], h1 = ((volatile LAS int*)Lh)[4 * j + 1], h2 = ((volatile LAS int*)Lh)[4 * j + 2], h3 = ((volatile LAS int*)Lh)[4 * j + 3];
                const int tot = (h0 + h1) + (h2 + h3); int inc = tot;
#pragma unroll
                for (int o = 1; o < 8; o <<= 1) { const int tt = __shfl_up(inc, o, 8); if (j >= o) inc += tt; }
                const int ex = inc - tot;
                ((volatile LAS int*)Lh)[4 * j] = ex; ((volatile LAS int*)Lh)[4 * j + 1] = ex + h0; ((volatile LAS int*)Lh)[4 * j + 2] = ex + h0 + h1; ((volatile LAS int*)Lh)[4 * j + 3] = ex + h0 + h1 + h2;
            }
#pragma unroll
            for (int m = 0; m < 16; ++m) { const int pos = ((volatile LAS int*)Lh)[ide[m] >> PEER_EB_LOG] + rk[m]; Le[pos] = ide[m]; Lg[pos] = gte[m] * SVI_[ide[m]]; Lp[pos] = __builtin_bit_cast(int, SUI_[ide[m]] * sxi); }
        }
        v4u R0[4], R1[4], R2[4], R3[4];
#define PEER_ROFF(S0, H) ((size_t)(Le[(S0)] & (scratch_dst ? PEER_PROBE_MASK : 0xFFFF)) * 1024 + 512 * (H) + 16 * j)
#define PEER_LOADT(TAB, RR, S0, H) do { const size_t ro_ = PEER_ROFF(S0, H); _Pragma("unroll") for (int q = 0; q < 4; ++q) RR[q] = *(const GAS v4u*)((TAB) + ro_ + 128 * q); } while (0)
#define PEER_LOADU(RR, S0) do { const size_t ro_ = (size_t)(Le[(S0)] & (scratch_dst ? PEER_PROBE_MASK : 0xFFFF)) * 512 + 16 * j; _Pragma("unroll") for (int q = 0; q < 4; ++q) RR[q] = *(const GAS v4u*)(EU4 + ro_ + 128 * q); } while (0)
#define PEER_DOTU(RR, EOUT) do { int h0_ = 0, h1_ = 0, l0_ = 0, l1_ = 0; \
            _Pragma("unroll") for (int q = 0; q < 4; q += 2) _Pragma("unroll") for (int w_ = 0; w_ < 4; ++w_) { \
                h0_ = __builtin_amdgcn_sdot8((int)RR[q][w_], xh[4 * q + w_], h0_, false); l0_ = __builtin_amdgcn_sdot8((int)RR[q][w_], xl[4 * q + w_], l0_, false); \
                h1_ = __builtin_amdgcn_sdot8((int)RR[q + 1][w_], xh[4 * q + 4 + w_], h1_, false); l1_ = __builtin_amdgcn_sdot8((int)RR[q + 1][w_], xl[4 * q + 4 + w_], l1_, false); } \
            int e_ = ((h0_ + h1_) << 4) + (l0_ + l1_); e_ = DPP_ADDI(e_, 0xB1, 0xF); e_ = DPP_ADDI(e_, 0x4E, 0xF); e_ = DPP_ADDI(e_, 0x141, 0xF); EOUT = e_; } while (0)
#define PEER_SWEEPU(BODY0, BODY1, BODY2, BODY3) do { \
            PEER_LOADU(R0, 0); PEER_LOADU(R1, 1); PEER_LOADU(R2, 2); PEER_LOADU(R3, 3); \
            for (int s = 0; s < 128; s += 4) { \
                BODY0; if (s + 4 < 128) PEER_LOADU(R0, s + 4); \
                BODY1; if (s + 4 < 128) PEER_LOADU(R1, s + 5); \
                BODY2; if (s + 4 < 128) PEER_LOADU(R2, s + 6); \
                BODY3; if (s + 4 < 128) PEER_LOADU(R3, s + 7); } } while (0)
        float cmax = 0.f;
#define PEER_FIN(RR, SS) do { int e1_; PEER_DOTU(RR, e1_); const float cf__ = Lg[(SS)] * gelu_cdf((float)e1_ * __builtin_bit_cast(float, Lp[(SS)])); \
            Lg[(SS)] = cf__; cmax = fmaxf(cmax, fabsf(cf__)); } while (0)
        PEER_SWEEPU(PEER_FIN(R0, s), PEER_FIN(R1, s + 1), PEER_FIN(R2, s + 2), PEER_FIN(R3, s + 3));
#undef PEER_FIN
        const float cqs = cmax > 0.f ? 127.f / cmax : 0.f, yscale = cmax > 0.f ? cmax / 127.f : 0.f;
        {
            int pk_[4];
#pragma unroll
            for (int m = 0; m < 4; ++m) { const int d_ = 4 * j + m;
                const int q0 = (int)rintf(Lg[4 * d_] * cqs), q1 = (int)rintf(Lg[4 * d_ + 1] * cqs), q2 = (int)rintf(Lg[4 * d_ + 2] * cqs), q3 = (int)rintf(Lg[4 * d_ + 3] * cqs);
                pk_[m] = (int)((unsigned)(q0 & 0xff) | ((unsigned)(q1 & 0xff) << 8) | ((unsigned)(q2 & 0xff) << 16) | ((unsigned)q3 << 24)); }
#pragma unroll
            for (int m = 0; m < 4; ++m) Lp[4 * j + m] = pk_[m];
        }
#pragma unroll
        for (int H = 0; H < 2; ++H) {
            int yi[64];
#pragma unroll
            for (int i = 0; i < 64; ++i) yi[i] = 0;
            PEER_LOADT(EV8, R0, 0, H); PEER_LOADT(EV8, R1, 1, H); PEER_LOADT(EV8, R2, 2, H); PEER_LOADT(EV8, R3, 3, H);
            for (int bt = 0; bt < 32; ++bt) {
                const int cq_ = Lp[bt];
                size_t ro0_ = 0, ro1_ = 0, ro2_ = 0, ro3_ = 0;
                if (bt + 1 < 32) { ro0_ = PEER_ROFF(4 * bt + 4, H); ro1_ = PEER_ROFF(4 * bt + 5, H); ro2_ = PEER_ROFF(4 * bt + 6, H); ro3_ = PEER_ROFF(4 * bt + 7, H); }
#pragma unroll
                for (int q = 0; q < 4; ++q) {
#pragma unroll
                    for (int w_ = 0; w_ < 4; ++w_) { const unsigned a0 = R0[q][w_], a1 = R1[q][w_], a2 = R2[q][w_], a3 = R3[q][w_];
                        const unsigned p0 = __builtin_amdgcn_perm(a1, a0, 0x05010400u), p1 = __builtin_amdgcn_perm(a1, a0, 0x07030602u), p2 = __builtin_amdgcn_perm(a3, a2, 0x05010400u), p3 = __builtin_amdgcn_perm(a3, a2, 0x07030602u);
                        yi[16 * q + 4 * w_ + 0] = __builtin_amdgcn_sdot4((int)__builtin_amdgcn_perm(p2, p0, 0x05040100u), cq_, yi[16 * q + 4 * w_ + 0], false);
                        yi[16 * q + 4 * w_ + 1] = __builtin_amdgcn_sdot4((int)__builtin_amdgcn_perm(p2, p0, 0x07060302u), cq_, yi[16 * q + 4 * w_ + 1], false);
                        yi[16 * q + 4 * w_ + 2] = __builtin_amdgcn_sdot4((int)__builtin_amdgcn_perm(p3, p1, 0x05040100u), cq_, yi[16 * q + 4 * w_ + 2], false);
                        yi[16 * q + 4 * w_ + 3] = __builtin_amdgcn_sdot4((int)__builtin_amdgcn_perm(p3, p1, 0x07060302u), cq_, yi[16 * q + 4 * w_ + 3], false); }
                    if (bt + 1 < 32) { R0[q] = *(const GAS v4u*)(EV8 + ro0_ + 128 * q); R1[q] = *(const GAS v4u*)(EV8 + ro1_ + 128 * q); R2[q] = *(const GAS v4u*)(EV8 + ro2_ + 128 * q); R3[q] = *(const GAS v4u*)(EV8 + ro3_ + 128 * q); }
                }
            }
            const int b = (int)(t / SEQ);
            const float* g2 = mod_ + b * NMOD + 5120 + 512 * H + 16 * j;
            const float* ip = out_ + t * D + 512 * H + 16 * j; float* op = (scratch_dst ? WSP(float, WS_SCORES) : out_) + t * D + 512 * H + 16 * j;
#pragma unroll
            for (int q = 0; q < 4; ++q)
#pragma unroll
                for (int c4 = 0; c4 < 4; ++c4) { const f32x4 x1 = *(const GAS f32x4*)(ip + 128 * q + 4 * c4); const f32x4 gg = *(const f32x4*)(g2 + 128 * q + 4 * c4) * yscale;
                    f32x4 o; o.x = x1.x + gg.x * (float)yi[16 * q + 4 * c4]; o.y = x1.y + gg.y * (float)yi[16 * q + 4 * c4 + 1]; o.z = x1.z + gg.z * (float)yi[16 * q + 4 * c4 + 2]; o.w = x1.w + gg.w * (float)yi[16 * q + 4 * c4 + 3];
                    *(GAS f32x4*)(op + 128 * q + 4 * c4) = o; }
        }
#undef PEER_ROFF
#undef PEER_LOADT
#undef PEER_LOADU
#undef PEER_DOTU
#undef PEER_SWEEPU
    }
}

DI void ph_inproj(const Frame& F) {
    pg8::Gemm g{WSP(bf16, WS_XN), WSP(bf16, WS_WIN), T, NPROJ, D}; pg8::StaticOrder S; S.init(T, NPROJ, F.G, (int)blockIdx.x);
    pg8::EpiBf16<0> E{WSP(bf16, WS_PROJ), NPROJ, nullptr, 0, 0, 1.f};
    pg8::gemm_phase<pg8::EpiBf16<0>, pg8::StaticOrder, PG8_ALIGN, PG8_SP2>(F.lds, g, S, E);
}
DI void ph_mix(const Frame& F, bool probe_first) {
    stage_conv_w(F);
    {
        int u = F.vcu;
        MlLocalRegs ra;
        if (u < 2048) ml_local_load(F, u >> 6, u & 63, ra);
        const int gwv = F.vcu * NWAVES + F.wave, NGWv = F.G * NWAVES;
        int eb = 2 * gwv;
        while (u < 2048) {
            const int un = u + F.G;
            MlLocalRegs rb;
            if (un < 2048) ml_local_load(F, un >> 6, un & 63, rb);
            ExpRows2 er; const bool ew = eb < 32768;
            if (ew) exp_load2(F, eb, er);
            ml_local_unit(F, u >> 6, u & 63, ra);
            if (ew) exp_conv2(F, eb, er);
            eb += 2 * NGWv;
            ra = rb; u = un;
        }
        for (; eb < 32768; eb += 2 * NGWv) { ExpRows2 er; exp_load2(F, eb, er); exp_conv2(F, eb, er); }
    }
    (void)probe_first;
}
DI void ph_scan_attn(const Frame& F) {
    ml_scan_phase(F);
    __syncthreads();
    for (int u = F.vcu; u < 1024; u += F.G) { const int qb = 15 - (u >> 6), bh = u & 63; sb_unit(F, bh >> 3, bh & 7, qb); }
}
DI void ph_mlout(const Frame& F) { stage_conv_w(F); for (int u = F.vcu; u < 2048; u += F.G) ml_out_unit(F, u >> 6, u & 63); }
#ifndef P5_ALIGN
#define P5_ALIGN PG8_ALIGN
#endif
DI void ph_outproj(const Frame& F) {
    pg8::Gemm g{WSP(bf16, WS_MIX), WSP(bf16, WS_WOUT), T, D, D}; pg8::StaticOrder S; S.init(T, D, F.G, (int)blockIdx.x);
    pg8::EpiResGate E{inp(I_X), (float*)inp(I_OUT), WSP(float, WS_MOD) + 2048, NMOD, SEQ, D};
    pg8::gemm_phase<pg8::EpiResGate, pg8::StaticOrder, P5_ALIGN, PG8_SP2>(F.lds, g, S, E);
}
DI void ph_scores(const Frame& F) {
    pg8::Gemm g{WSP(bf16, WS_XN), WSP(bf16, WS_WEFF), T, NSC, D}; pg8::StaticOrder S; S.init(T, NSC, F.G, (int)blockIdx.x);
    EpiTopK E{WSP(int, WS_IDX), WSP(float, WS_GATE)};
    pg8::Unit un;
    for (int i = 0; S.next(i, un); ++i) { OneUnit S1{un}; pg8::gemm_phase<EpiTopK, OneUnit, false, PG8_SP2>(F.lds, g, S1, E); }
}
constexpr int N_PHASES = 11;
struct Args { const float* in[19]; float* out; unsigned char* ws; int ph_lo, ph_hi; };
__global__ void __launch_bounds__(NTHR, 2) hybrid_fwd(Args args) {
    extern __shared__ __attribute__((aligned(16))) unsigned char lds_raw[];
    Frame F;
    F.lds = (LAS unsigned char*)lds_raw;
    F.MISC = (volatile LAS unsigned*)(F.lds + LDSCTL_OFF + 320);
    F.tid = threadIdx.x; F.lane = F.tid & 63; F.wave = __builtin_amdgcn_readfirstlane(F.tid >> 6);
    F.G = gridDim.x; { const int bx = blockIdx.x; F.vcu = (F.G % 8 == 0) ? (bx % 8) * (F.G / 8) + bx / 8 : bx; }
    F.ws = args.ws;
    F.ctl = (gu32*)(F.ws + WS_CTL);
    for (int u = F.tid; u < (LDS_BYTES - LDSCTL_OFF) / 4; u += NTHR) ((LAS unsigned*)(F.lds + LDSCTL_OFF))[u] = 0u;
    __syncthreads();
    const int lo = args.ph_lo, hi = args.ph_hi;
    const bool one_launch = (hi - lo) > 1;
    XcdBarrier bar; bar.bar = (unsigned*)(F.ctl + CW_BAR); bar.x = 0; bar.st = nullptr;
    if (one_launch) bar = xcd_barrier_post((unsigned*)(F.ctl + CW_BAR), F.MISC + 8);
#ifndef PHMASK
#define PHMASK 0x7ff
#endif
#define IN(k) (((PHMASK >> (k)) & 1) && lo <= (k) && (k) < hi)
#define SEAM(k) do { if (IN(k) && IN((k) + 1)) xcd_barrier(bar); } while (0)
#ifndef REPMASK
#define REPMASK 0
#endif

#define RUN(k, ...) do { if (IN(k)) { if ((REPMASK >> (k)) & 1) { { const bool first = true; (void)first; __VA_ARGS__; } xcd_barrier(bar); } { const bool first = false; (void)first; __VA_ARGS__; } } } while (0)
    RUN(0, p0_phase(F, first ? P0_PARTS : 15)); SEAM(0);
    RUN(1, norm_phase<true>(F, inp(I_X), inp(I_GN1), 0, 1024)); SEAM(1);
    RUN(2, ph_inproj(F)); SEAM(2);
    RUN(3, ph_mix(F, first)); SEAM(3);
    RUN(10, ph_scan_attn(F)); if (IN(10) && IN(4)) xcd_barrier(bar);
    RUN(4, ph_mlout(F)); SEAM(4);
    RUN(5, ph_outproj(F)); SEAM(5);
    RUN(6, norm_phase<false>(F, inp(I_OUT), inp(I_GN2), 3072, 4096)); SEAM(6);
    RUN(7, ph_scores(F)); if (IN(7) && IN(9)) xcd_barrier(bar);
    RUN(9, peer_phase(F, first));
#undef RUN
#undef IN
#undef SEAM
}

#ifndef MK_PER_PHASE
#define MK_PER_PHASE 0
#endif
extern "C" void kernel_launch(void* const* d_in, const int* in_sizes, int n_in, void* d_out, int out_size, void* d_ws, size_t ws_size, hipStream_t stream) {
    static int grid = 0;
    if (grid == 0) {
        if (n_in != 19 || in_sizes[0] != T * D || out_size != T * D || ws_size < WS_END) { fprintf(stderr, "kernel_launch: unexpected shapes (n_in %d, in0 %d, out %d, ws %zu)\n", n_in, n_in > 0 ? in_sizes[0] : -1, out_size, ws_size); grid = -1; return; }
        int dev = 0, cus = 0, per_cu = 0;
        if (hipGetDevice(&dev) != hipSuccess || hipDeviceGetAttribute(&cus, hipDeviceAttributeMultiprocessorCount, dev) != hipSuccess) { grid = -1; return; }
        if (hipFuncSetAttribute((const void*)hybrid_fwd, hipFuncAttributeMaxDynamicSharedMemorySize, LDS_BYTES) != hipSuccess) { fprintf(stderr, "kernel_launch: hipFuncSetAttribute failed\n"); grid = -1; return; }
        if (hipOccupancyMaxActiveBlocksPerMultiprocessor(&per_cu, (const void*)hybrid_fwd, NTHR, LDS_BYTES) != hipSuccess || per_cu < 1) fprintf(stderr, "kernel_launch: occupancy query says %d\n", per_cu);
        (void)hipGetLastError();
        grid = cus;
    }
    if (grid < 0) return;
    if (hipMemsetAsync((char*)d_ws + WS_CTL, 0, CTL_ZERO_BYTES, stream) != hipSuccess) { fprintf(stderr, "kernel_launch: memset failed\n"); return; }
    Args a{};
    for (int i = 0; i < 19; ++i) a.in[i] = (const float*)d_in[i];
    a.out = (float*)d_out; a.ws = (unsigned char*)d_ws;
#if MK_PER_PHASE
    { const int order[N_PHASES] = {0, 1, 2, 3, 10, 4, 5, 6, 7, 8, 9}; for (int i = 0; i < N_PHASES; ++i) { a.ph_lo = order[i]; a.ph_hi = order[i] + 1; hipLaunchKernelGGL(hybrid_fwd, dim3(grid), dim3(NTHR), LDS_BYTES, stream, a); } }
#else
    a.ph_lo = 0; a.ph_hi = N_PHASES;
    hipLaunchKernelGGL(hybrid_fwd, dim3(grid), dim3(NTHR), LDS_BYTES, stream, a);
#endif
    const hipError_t le = hipPeekAtLastError();
    if (le != hipSuccess) fprintf(stderr, "kernel_launch: launch failed: %s\n", hipGetErrorName(le));
}
```

```cpp
#include <cmath>
#include <hip/hip_runtime.h>
#include <cstdio>
#include <cstdint>
namespace pg8 {
#define PG8_LAS __attribute__((address_space(3)))
typedef unsigned short bf16_t;
typedef short bf16x8 __attribute__((ext_vector_type(8)));
typedef float f32x4 __attribute__((ext_vector_type(4)));
typedef unsigned u32x4 __attribute__((ext_vector_type(4)));
constexpr int BM = 256, BK = 64, HALF = 128, HTB = HALF * BK * 2  , STAGE_BYTES = 8 * HTB, NXCD = 8,
#ifndef PG8_WGM
#define PG8_WGM 4
#endif
WGM = PG8_WGM;

__host__ __device__ __forceinline__ int lds_byte(int r, int c) { const int st = (r >> 4) * 2 + (c >> 5), rr = r & 15, cc = c & 31, ob = rr * 64 + cc * 2; return st * 1024 + (ob ^ (((ob >> 9) & 1) << 5)); }
__host__ __device__ __forceinline__ void stage_rc(int b, int& R, int& C) { const int st = b / 1024, sb = b % 1024, swz = sb ^ (((sb >> 9) & 1) << 5); R = (st >> 1) * 16 + swz / 64; C = (st & 1) * 32 + (swz % 64) / 2; }
__host__ __device__ __forceinline__ int perm32(int rho) { const int n = rho >> 4, i = rho & 15; return 8 * (i >> 2) + 4 * n + (i & 3); }

struct Unit { int pm, pn; };
struct Gemm { const bf16_t* A; const bf16_t* Bt; int M, N, K; };

struct StaticOrder {
    int nM, nN, nwg, G, c;
    __host__ __device__ void init(int M, int N, int G_, int c_) { nM = M / BM; nN = N / BM; nwg = nM * nN; G = G_; c = c_; }
    __host__ __device__ bool next(int i, Unit& u) const {
        const long L = (long)i * G + c; if (L >= nwg) return false;
        int wgid = (int)L; { const int q = nwg / NXCD, r = nwg % NXCD, xcd = wgid % NXCD, off = wgid / NXCD; wgid = (xcd < r ? xcd * (q + 1) : r * (q + 1) + (xcd - r) * q) + off; }
        const int nig = WGM * nN, gid = wgid / nig, fm = gid * WGM, gsz = (nM - fm) < WGM ? (nM - fm) : WGM;
        u.pm = fm + ((wgid % nig) % gsz); u.pn = (wgid % nig) / gsz; return true;
    }
    __device__ __forceinline__ void a_ready(const Unit&) const {}
    __device__ __forceinline__ void done(const Unit&) const {}
};

__device__ __forceinline__ unsigned cvt_pk_bf16(float lo, float hi) { unsigned r; asm volatile("v_cvt_pk_bf16_f32 %0, %1, %2" : "=v"(r) : "v"(lo), "v"(hi)); return r; }
typedef float f32x2 __attribute__((ext_vector_type(2)));
__device__ __forceinline__ f32x2 gelu_pk(f32x2 v) {
    const f32x2 av = __builtin_elementwise_abs(v), d = av * 0.2316418882f + 1.0f;
    f32x2 t; t.x = __builtin_amdgcn_rcpf(d.x); t.y = __builtin_amdgcn_rcpf(d.y);
    f32x2 q = t * 0.5307027145f + (-0.7265760135f); q = q * t + 0.7107068705f; q = q * t + (-0.142248368f); q = q * t + 0.127414796f; q = q * t;
    const f32x2 s = (v * v) * (-0.72134752044f);
    f32x2 e; e.x = __builtin_amdgcn_exp2f(s.x); e.y = __builtin_amdgcn_exp2f(s.y);
    const f32x2 m = v * (q * e), r = v - m;
    f32x2 o; o.x = v.x < 0.f ? m.x : r.x; o.y = v.y < 0.f ? m.y : r.y; return o;
}

template <int ACT  > struct EpiBf16 {
    static constexpr bool PERM = true, AFTER_DRAIN = false; static_assert(ACT == 0 || ACT == 1, "EpiBf16: ACT is 0 (none) or 1 (gelu_pk)");
    bf16_t* O; int ldc; const float* bias; int split_cols; size_t split_stride; float scale0;
    __device__ __forceinline__ void operator()(const f32x4 (&acc)[2][2][4][2], const Unit& u, int wr, int wc, int fr, int fq) const {
        const int row0 = u.pm * BM + wr * 64 + fr; int colt = u.pn * BM; bf16_t* base = O;
        float sc = 1.f; if (split_cols) { const int t = colt / split_cols; base += (size_t)t * split_stride; colt -= t * split_cols; if (t == 0) sc = scale0; }
        const int col0 = colt + wc * 32 + 8 * fq, bcol0 = u.pn * BM + wc * 32 + 8 * fq;
        f32x4 bv[2][2];
#pragma unroll
        for (int bj = 0; bj < 2; ++bj)
#pragma unroll
            for (int n = 0; n < 2; ++n) bv[bj][n] = bias ? *(const f32x4*)(bias + bcol0 + bj * HALF + 4 * n) : (f32x4){0.f, 0.f, 0.f, 0.f};
#pragma unroll
        for (int ai = 0; ai < 2; ++ai)
#pragma unroll
            for (int m = 0; m < 4; ++m) { bf16_t* rowp = base + (size_t)(row0 + ai * HALF + m * 16) * ldc + col0;
#pragma unroll
                for (int bj = 0; bj < 2; ++bj) { f32x4 v0 = acc[ai][bj][m][0] + bv[bj][0], v1 = acc[ai][bj][m][1] + bv[bj][1];
                    if (ACT == 1) { f32x2 a = gelu_pk((f32x2){v0[0], v0[1]}), b = gelu_pk((f32x2){v0[2], v0[3]}), c = gelu_pk((f32x2){v1[0], v1[1]}), d = gelu_pk((f32x2){v1[2], v1[3]});
                        v0 = (f32x4){a.x, a.y, b.x, b.y}; v1 = (f32x4){c.x, c.y, d.x, d.y}; }
                    v0 = v0 * sc; v1 = v1 * sc; u32x4 w; w.x = cvt_pk_bf16(v0[0], v0[1]); w.y = cvt_pk_bf16(v0[2], v0[3]); w.z = cvt_pk_bf16(v1[0], v1[1]); w.w = cvt_pk_bf16(v1[2], v1[3]);
                    *(u32x4*)(rowp + bj * HALF) = w; } }
    }
};
template <class Epi, class Sched, bool ALIGN_EPI = false, bool SP2 = false>
__device__ __forceinline__ void gemm_phase(PG8_LAS unsigned char* lds, const Gemm g, const Sched& S, const Epi& E) {
    const int tid = threadIdx.x, wid = __builtin_amdgcn_readfirstlane(tid >> 6), lane = tid & 63, wr = wid >> 2, wc = wid & 3, fr = lane & 15, fq = lane >> 4;
    const int K = g.K, nt = K / BK;
    unsigned voffA[2], voffB[2];
#pragma unroll
    for (int i = 0; i < 2; ++i) { int R, C; stage_rc(tid * 16 + i * 8192, R, C); const int Rb = Epi::PERM ? ((R & ~31) + perm32(R & 31)) : R;
        voffA[i] = (unsigned)(R * K + C) * 2u; voffB[i] = (unsigned)(Rb * K + C) * 2u; }
    const size_t kstep = (size_t)(BK * 2);
    const size_t hstep = (size_t)HALF * K * 2;
    const size_t tstep = 2 * hstep;
    const unsigned ldsw = (unsigned)wid * 1024u;
    const int aoff = lds_byte(wr * 64 + fr, fq * 8), boff = lds_byte(wc * 32 + fr, fq * 8);
#define PG8_SA(b, h) (((b) * 2 + (h)) * HTB)
#define PG8_SB(b, h) ((4 + (b) * 2 + (h)) * HTB)
#define PG8_STAGE(bufoff, gbase, voff) do { _Pragma("unroll") for (int _i = 0; _i < 2; ++_i) \
        __builtin_amdgcn_global_load_lds((const unsigned*)((const char*)(gbase) + (voff)[_i]), (PG8_LAS unsigned*)(lds + (bufoff) + ldsw + _i * 8192), 16, 0, 0); } while (0)
#define PG8_LDA(dst, b, h) do { _Pragma("unroll") for (int m = 0; m < 4; ++m) _Pragma("unroll") for (int k = 0; k < 2; ++k) dst[m][k] = *(const PG8_LAS bf16x8*)(lds + PG8_SA(b, h) + aoff + m * 2048 + k * 1024); } while (0)
#define PG8_LDB(dst, b, h) do { _Pragma("unroll") for (int n = 0; n < 2; ++n) _Pragma("unroll") for (int k = 0; k < 2; ++k) dst[n][k] = *(const PG8_LAS bf16x8*)(lds + PG8_SB(b, h) + boff + n * 2048 + k * 1024); } while (0)
#define PG8_MMA(ai, bj, At, Bt) do { __builtin_amdgcn_s_setprio(1); _Pragma("unroll") for (int m = 0; m < 4; ++m) _Pragma("unroll") for (int n = 0; n < 2; ++n) _Pragma("unroll") for (int k = 0; k < 2; ++k) \
        acc[ai][bj][m][n] = __builtin_amdgcn_mfma_f32_16x16x32_bf16(Bt[n][k], At[m][k], acc[ai][bj][m][n], 0, 0, 0); __builtin_amdgcn_s_setprio(0); } while (0)
#define PG8_WAIT_V(n) asm volatile("s_waitcnt vmcnt(" #n ")" ::: "memory")
#define PG8_WAIT_L(n) asm volatile("s_waitcnt lgkmcnt(" #n ")" ::: "memory")
#define PG8_BAR __builtin_amdgcn_s_barrier()
#define PG8_SCHED __builtin_amdgcn_sched_barrier(0)
    Unit cur, nxt; int ui = 0;
    if (!S.next(0, cur)) return;
    f32x4 acc[2][2][4][2];
#pragma unroll
    for (int a = 0; a < 2; ++a)
#pragma unroll
        for (int b = 0; b < 2; ++b)
#pragma unroll
            for (int m = 0; m < 4; ++m)
#pragma unroll
                for (int n = 0; n < 2; ++n) acc[a][b][m][n] = (f32x4){0.f, 0.f, 0.f, 0.f};
    bf16x8 At[4][2], B0[2][2], B1[2][2];
    const char* cA = (const char*)g.A + (size_t)cur.pm * tstep; const char* cB = (const char*)g.Bt + (size_t)cur.pn * tstep;
    S.a_ready(cur);
    if constexpr (SP2) {
        PG8_STAGE(PG8_SB(0, 0), cB, voffB); PG8_STAGE(PG8_SB(0, 1), cB + hstep, voffB); PG8_STAGE(PG8_SA(0, 0), cA, voffA); PG8_STAGE(PG8_SA(0, 1), cA + hstep, voffA);
        if (wr == 1) PG8_BAR;
        PG8_WAIT_V(2); PG8_BAR;
        PG8_STAGE(PG8_SB(1, 0), cB + kstep, voffB); PG8_STAGE(PG8_SA(1, 0), cA + kstep, voffA); PG8_STAGE(PG8_SB(1, 1), cB + hstep + kstep, voffB);
        PG8_WAIT_V(6); PG8_BAR;
    } else {
        PG8_STAGE(PG8_SB(0, 0), cB, voffB); PG8_STAGE(PG8_SA(0, 0), cA, voffA); PG8_STAGE(PG8_SB(0, 1), cB + hstep, voffB); PG8_STAGE(PG8_SA(0, 1), cA + hstep, voffA);
        if (wr == 1) PG8_BAR;
        PG8_WAIT_V(4); PG8_BAR;
        PG8_STAGE(PG8_SB(1, 0), cB + kstep, voffB); PG8_STAGE(PG8_SA(1, 0), cA + kstep, voffA); PG8_STAGE(PG8_SB(1, 1), cB + hstep + kstep, voffB);
        PG8_WAIT_V(6); PG8_BAR;
    }
    for (;;) {
        const bool has_next = S.next(ui + 1, nxt);
        const char* nA = has_next ? (const char*)g.A + (size_t)nxt.pm * tstep : cA; const char* nB = has_next ? (const char*)g.Bt + (size_t)nxt.pn * tstep : cB;
        for (int t = 0; t < nt; t += 2) {
            const bool last = (t == nt - 2);
            const char* a1 = cA + (size_t)(t + 1) * kstep;
            const char* a2 = last ? nA : cA + (size_t)(t + 2) * kstep; const char* b2 = last ? nB : cB + (size_t)(t + 2) * kstep;
            const char* a3 = a2 + kstep; const char* b3 = b2 + kstep;
            if (last && has_next) S.a_ready(nxt);
            if constexpr (SP2) {
            PG8_LDB(B0, 0, 0); PG8_LDB(B1, 0, 1); PG8_SCHED; PG8_LDA(At, 0, 0); PG8_STAGE(PG8_SA(1, 1), a1 + hstep, voffA);
            PG8_WAIT_V(8); PG8_WAIT_L(0); PG8_BAR; PG8_MMA(0, 0, At, B0); PG8_MMA(0, 1, At, B1); PG8_BAR; PG8_SCHED;
            PG8_LDA(At, 0, 1); PG8_STAGE(PG8_SB(0, 0), b2, voffB); PG8_STAGE(PG8_SB(0, 1), b2 + hstep, voffB); PG8_STAGE(PG8_SA(0, 0), a2, voffA);
            PG8_WAIT_V(8); PG8_WAIT_L(0); PG8_BAR; PG8_MMA(1, 0, At, B0); PG8_MMA(1, 1, At, B1); PG8_BAR; PG8_SCHED;
            PG8_LDB(B0, 1, 0); PG8_LDB(B1, 1, 1); PG8_SCHED; PG8_LDA(At, 1, 0); PG8_STAGE(PG8_SA(0, 1), a2 + hstep, voffA);
            PG8_WAIT_V(8); PG8_WAIT_L(0); PG8_BAR; PG8_MMA(0, 0, At, B0); PG8_MMA(0, 1, At, B1); PG8_BAR; PG8_SCHED;
            PG8_LDA(At, 1, 1); PG8_STAGE(PG8_SB(1, 0), b3, voffB); PG8_STAGE(PG8_SB(1, 1), b3 + hstep, voffB); PG8_STAGE(PG8_SA(1, 0), a3, voffA);
            PG8_WAIT_V(8); PG8_WAIT_L(0); PG8_BAR; PG8_MMA(1, 0, At, B0); PG8_MMA(1, 1, At, B1); PG8_BAR; PG8_SCHED;
            } else {
            PG8_LDB(B0, 0, 0); PG8_SCHED; PG8_LDA(At, 0, 0); PG8_STAGE(PG8_SA(1, 1), a1 + hstep, voffA);
            PG8_WAIT_L(8); PG8_BAR; PG8_WAIT_L(0); PG8_MMA(0, 0, At, B0); PG8_BAR; PG8_SCHED;
            PG8_LDB(B1, 0, 1); PG8_STAGE(PG8_SB(0, 0), b2, voffB);
            PG8_BAR; PG8_WAIT_L(0); PG8_MMA(0, 1, At, B1); PG8_BAR;
            PG8_LDA(At, 0, 1); PG8_STAGE(PG8_SA(0, 0), a2, voffA);
            PG8_BAR; PG8_WAIT_L(0); PG8_MMA(1, 0, At, B0); PG8_BAR; PG8_SCHED;
            PG8_STAGE(PG8_SB(0, 1), b2 + hstep, voffB);
            PG8_WAIT_V(6); PG8_BAR; PG8_MMA(1, 1, At, B1); PG8_BAR;
            PG8_LDB(B0, 1, 0); PG8_SCHED; PG8_LDA(At, 1, 0); PG8_STAGE(PG8_SA(0, 1), a2 + hstep, voffA);
            PG8_WAIT_L(8); PG8_BAR; PG8_WAIT_L(0); PG8_MMA(0, 0, At, B0); PG8_BAR; PG8_SCHED;
            PG8_LDB(B1, 1, 1); PG8_STAGE(PG8_SB(1, 0), b3, voffB);
            PG8_BAR; PG8_WAIT_L(0); PG8_MMA(0, 1, At, B1); PG8_BAR;
            PG8_LDA(At, 1, 1); PG8_STAGE(PG8_SA(1, 0), a3, voffA);
            PG8_BAR; PG8_WAIT_L(0); PG8_MMA(1, 0, At, B0); PG8_BAR; PG8_SCHED;
            PG8_STAGE(PG8_SB(1, 1), b3 + hstep, voffB);
            PG8_WAIT_V(6); PG8_BAR; PG8_MMA(1, 1, At, B1); PG8_BAR;
            }
        }
        if constexpr (ALIGN_EPI) { if (wr == 0) PG8_BAR; }
        if constexpr (!Epi::AFTER_DRAIN) { E(acc, cur, wr, wc, fr, fq); S.done(cur); }
        if (!has_next) break;
#pragma unroll
        for (int a = 0; a < 2; ++a)
#pragma unroll
            for (int b = 0; b < 2; ++b)
#pragma unroll
                for (int m = 0; m < 4; ++m)
#pragma unroll
                    for (int n = 0; n < 2; ++n) acc[a][b][m][n] = (f32x4){0.f, 0.f, 0.f, 0.f};
        cur = nxt; cA = nA; cB = nB; ++ui;
        if constexpr (ALIGN_EPI) { if (wr == 1) PG8_BAR; }
    }
    PG8_WAIT_V(0);
    if constexpr (!ALIGN_EPI) { if (wr == 0) PG8_BAR; }
    PG8_BAR;
    if constexpr (Epi::AFTER_DRAIN) { E.fused(acc, cur, wr, wc, fr, fq, lds, wid, lane); S.done(cur); }
#undef PG8_SA
#undef PG8_SB
#undef PG8_STAGE
#undef PG8_LDA
#undef PG8_LDB
#undef PG8_MMA
#undef PG8_WAIT_V
#undef PG8_WAIT_L
#undef PG8_BAR
#undef PG8_SCHED
}
}

#ifndef PG8_SP2
#define PG8_SP2 true
#endif
#ifndef PG8_ALIGN
#define PG8_ALIGN true
#endif

namespace pg8 {
struct EpiResGate {
    static constexpr bool PERM = false, AFTER_DRAIN = false;
    const float* base; float* out; const float* gate; int gate_ld; int rows_per_batch; int ldc;
    __device__ __forceinline__ void operator()(const f32x4 (&acc)[2][2][4][2], const Unit& u, int wr, int wc, int fr, int fq) const {
        const int row0 = u.pm * BM + wr * 64 + fr, col0 = u.pn * BM + wc * 32 + 4 * fq;
        const float* gp = gate + (size_t)((u.pm * BM) / rows_per_batch) * gate_ld + col0;
        f32x4 gv[2][2];
#pragma unroll
        for (int bj = 0; bj < 2; ++bj)
#pragma unroll
            for (int n = 0; n < 2; ++n) gv[bj][n] = *(const f32x4*)(gp + bj * HALF + n * 16);
#pragma unroll
        for (int ai = 0; ai < 2; ++ai)
#pragma unroll
            for (int m = 0; m < 4; ++m) { const size_t off = (size_t)(row0 + ai * HALF + m * 16) * ldc + col0;
#pragma unroll
                for (int bj = 0; bj < 2; ++bj)
#pragma unroll
                    for (int n = 0; n < 2; ++n) { const f32x4 bs = *(const f32x4*)(base + off + bj * HALF + n * 16);
                        *(f32x4*)(out + off + bj * HALF + n * 16) = bs + gv[bj][n] * acc[ai][bj][m][n]; } }
    }
};
struct EpiF32 {
    static constexpr bool PERM = false, AFTER_DRAIN = false;
    float* O; int ldc;
    __device__ __forceinline__ void operator()(const f32x4 (&acc)[2][2][4][2], const Unit& u, int wr, int wc, int fr, int fq) const {
        const int row0 = u.pm * BM + wr * 64 + fr, col0 = u.pn * BM + wc * 32 + 4 * fq;
#pragma unroll
        for (int ai = 0; ai < 2; ++ai)
#pragma unroll
            for (int m = 0; m < 4; ++m) { const size_t off = (size_t)(row0 + ai * HALF + m * 16) * ldc + col0;
#pragma unroll
                for (int bj = 0; bj < 2; ++bj)
#pragma unroll
                    for (int n = 0; n < 2; ++n) *(f32x4*)(O + off + bj * HALF + n * 16) = acc[ai][bj][m][n]; }
    }
};
}
#define GAS __attribute__((address_space(1)))
#define LAS __attribute__((address_space(3)))
typedef unsigned short bf16;
typedef unsigned v4u __attribute__((ext_vector_type(4)));
typedef float f32x4 __attribute__((ext_vector_type(4)));
typedef short bf16x8 __attribute__((ext_vector_type(8)));
typedef GAS unsigned gu32;
typedef GAS unsigned long long gu64;
#define RLX_AGENT __ATOMIC_RELAXED, __HIP_MEMORY_SCOPE_AGENT
#define LDS_WAIT() asm volatile("s_waitcnt lgkmcnt(0)" ::: "memory")
#define VM_WAIT() asm volatile("s_waitcnt vmcnt(0)" ::: "memory")
__device__ __forceinline__ unsigned long long rt() { return __builtin_amdgcn_s_memrealtime(); }
__device__ __forceinline__ unsigned f2bf(float f) { unsigned u = __builtin_bit_cast(unsigned, f); return (u + 0x7fffu + ((u >> 16) & 1u)) >> 16; }
__device__ __forceinline__ unsigned pk2(float lo, float hi) { return f2bf(lo) | (f2bf(hi) << 16); }

#define XB_TMO      128
#define XB_XCNT(j)  (256  + 64 * (j))
#define XB_XSUB(j)  (1280 + 64 * (j))
#define XB_XGEN(j)  (2304 + 64 * (j))
#define XB_TOP      3328
#define XB_TOPGEN   3392
#define XCD_BAR_WORDS 3456
#define XB_SPIN_CAP (1u << 24)

__device__ __forceinline__ unsigned xb_ld(unsigned* p)              { return __hip_atomic_load(p, __ATOMIC_RELAXED, __HIP_MEMORY_SCOPE_AGENT); }
__device__ __forceinline__ unsigned xb_add(unsigned* p, unsigned v) { return __hip_atomic_fetch_add(p, v, __ATOMIC_RELAXED, __HIP_MEMORY_SCOPE_AGENT); }
__device__ __forceinline__ unsigned xb_xcc_id() { return (unsigned)__builtin_amdgcn_s_getreg((3 << 11) | 20) & 0xFu; }
#define XB_SPIN(cond, bar) do { unsigned _sp = 0; while (cond) { __builtin_amdgcn_s_sleep(1); \
    if ((++_sp & 255u) == 0u) { if (xb_ld(&(bar)[XB_TMO])) break; if (_sp > XB_SPIN_CAP) { atomicAdd(&(bar)[XB_TMO], 1u); break; } } } } while (0)

struct XcdBarrier {
    unsigned* bar; unsigned x;
    volatile LAS unsigned* st;
};

__device__ __forceinline__ XcdBarrier xcd_barrier_post(unsigned* bar, volatile LAS unsigned* st) {
    XcdBarrier b; b.bar = bar; b.x = xb_xcc_id(); b.st = st;
    if (threadIdx.x == 0) (void)xb_add(&bar[XB_XCNT(b.x)], 1u);
    return b;
}
__device__ __forceinline__ void xcd_barrier_complete(unsigned* bar, unsigned x, unsigned& nloc, unsigned& nx) {
    const unsigned G = gridDim.x * gridDim.y * gridDim.z;
    unsigned sum, cnt, mine, sp = 0u;
    for (;;) {
        sum = 0u; cnt = 0u; mine = 0u;
#pragma unroll
        for (unsigned j = 0; j < 16; ++j) { const unsigned c = xb_ld(&bar[XB_XCNT(j)]); sum += c; cnt += (c > 0u) ? 1u : 0u; mine = (j == x) ? c : mine; }
        if (sum == G) break;
        __builtin_amdgcn_s_sleep(1);
        if ((++sp & 255u) == 0u) { if (xb_ld(&bar[XB_TMO])) break; if (sp > XB_SPIN_CAP) { atomicAdd(&bar[XB_TMO], 1u); break; } }
    }
    nloc = mine > 0u ? mine : 1u; nx = cnt > 0u ? cnt : 1u;
}

__device__ __forceinline__ void xcd_barrier(const XcdBarrier& b) {
    asm volatile("s_waitcnt vmcnt(0)" ::: "memory");
    __syncthreads();
    if (threadIdx.x == 0) {
        unsigned* bar = b.bar;
        __builtin_amdgcn_s_waitcnt(0);
        unsigned nloc = b.st[0], nx = b.st[1];
        if (nloc == 0u) { xcd_barrier_complete(bar, b.x, nloc, nx); b.st[0] = nloc; b.st[1] = nx; }
        const unsigned old = xb_add(&bar[XB_XSUB(b.x)], 1u);
        const unsigned gen = old / nloc;
        if (old + 1u == (gen + 1u) * nloc) {
            __builtin_amdgcn_fence(__ATOMIC_RELEASE, "agent");
            asm volatile("s_waitcnt vmcnt(0)" ::: "memory");
            const unsigned og = xb_add(&bar[XB_TOP], 1u);
            const unsigned tg = og / nx;
            if (og + 1u == (tg + 1u) * nx) xb_add(&bar[XB_TOPGEN], 1u);
            else XB_SPIN(xb_ld(&bar[XB_TOPGEN]) == tg, bar);
            __builtin_amdgcn_fence(__ATOMIC_ACQUIRE, "agent");
            xb_add(&bar[XB_XGEN(b.x)], 1u);
            asm volatile("s_waitcnt vmcnt(0)" ::: "memory");
        } else {
            XB_SPIN(xb_ld(&bar[XB_XGEN(b.x)]) == gen, bar);
            __builtin_amdgcn_fence(__ATOMIC_ACQUIRE, "agent");
            asm volatile("s_waitcnt vmcnt(0)" ::: "memory");
        }
    }
    __syncthreads();
}

constexpr int NWAVES = 8, NTHR = 512;
constexpr int NB = 8, SEQ = 4096, T = NB * SEQ, D = 1024, NPROJ = 3584, NIN = 3592, NMOD = 6144, NSC = 2048;
constexpr int C_QSB = 0, C_KSB = 512, C_VSB = 1024, C_QML = 1536, C_KML = 2048, C_VML = 2560, C_OML = 3072;
constexpr float EPS = 1e-6f, LOG2E = 1.4426950408889634f;
constexpr size_t MiB = 1u << 20;
constexpr size_t WS_CTL = 0, CTL_ZERO_BYTES = 1 * MiB;
constexpr size_t WS_MOD = 256 * 1024;
constexpr size_t WS_WIN = 2 * MiB, WS_WOUT = 10 * MiB, WS_WEFF = 12 * MiB;
constexpr size_t WS_XN = 16 * MiB;
constexpr size_t WS_PROJ = 80 * MiB;
constexpr size_t WS_MIX = 304 * MiB;
constexpr size_t WS_EXPU = 368 * MiB, WS_EXPV = 400 * MiB;
constexpr size_t WS_CST = 432 * MiB;
constexpr size_t WS_NST = 496 * MiB;
constexpr size_t WS_MST = 497 * MiB;
constexpr size_t WS_GATES = 498 * MiB;
constexpr size_t WS_SCORES = 80 * MiB;
constexpr size_t WS_IDX = 336 * MiB, WS_GATE = 352 * MiB;
constexpr size_t WS_SCL = 499 * MiB;
constexpr size_t WS_SUI = 499 * MiB + 65536, WS_SVI = 499 * MiB + 131072;
constexpr size_t WS_END = 500 * MiB;
constexpr int CW_Q3 = 64;
constexpr int CW_BAR = 4096;
constexpr int LDS_BYTES = 147456, LDSCTL_OFF = 143360;

typedef float f32x16 __attribute__((ext_vector_type(16)));
typedef float f32x2_t __attribute__((ext_vector_type(2)));
typedef __bf16 bf16x2_t __attribute__((ext_vector_type(2)));
typedef _Float16 f16x8 __attribute__((ext_vector_type(8)));
typedef short s16x4 __attribute__((ext_vector_type(4)));
typedef unsigned u32x2 __attribute__((ext_vector_type(2)));
#define DI __device__ __forceinline__
DI unsigned cvtpk(float lo, float hi) { f32x2_t v = {lo, hi}; bf16x2_t b = __builtin_convertvector(v, bf16x2_t); return __builtin_bit_cast(unsigned, b); }
DI float bflo(unsigned u) { return __uint_as_float(u << 16); }
DI float bfhi(unsigned u) { return __uint_as_float(u & 0xffff0000u); }
DI int crow(int i, int hi) { return (i & 3) + 8 * (i >> 2) + 4 * hi; }
DI int krow(int s, int hi, int j) { return 16 * s + 8 * (j >> 2) + 4 * hi + (j & 3); }
DI float swap_add(float v) { auto rr = __builtin_amdgcn_permlane32_swap(__float_as_uint(v), __float_as_uint(v), false, false); return __uint_as_float(rr[0]) + __uint_as_float(rr[1]); }
DI float swap_max(float v) { auto rr = __builtin_amdgcn_permlane32_swap(__float_as_uint(v), __float_as_uint(v), false, false); return fmaxf(__uint_as_float(rr[0]), __uint_as_float(rr[1])); }
DI float dot2bf(unsigned a, unsigned b, float acc) { return __builtin_amdgcn_fdot2_f32_bf16(__builtin_bit_cast(bf16x2_t, a), __builtin_bit_cast(bf16x2_t, b), acc, false); }
DI float ex2(float x) { return __builtin_amdgcn_exp2f(x); }
DI float lg2(float x) { return __builtin_amdgcn_logf(x); }
DI float fexp(float x) { return __builtin_amdgcn_exp2f(x * LOG2E); }
DI float wave_sum(float v) {
#pragma unroll
    for (int o = 1; o < 64; o <<= 1) v += __shfl_xor(v, o);
    return v;
}
DI float wave_max(float v) {
#pragma unroll
    for (int o = 1; o < 64; o <<= 1) v = fmaxf(v, __shfl_xor(v, o));
    return v;
}
#define DPP_MAXF(v, ctrl, rmask) fmaxf((v), __builtin_bit_cast(float, __builtin_amdgcn_update_dpp(0, __builtin_bit_cast(int, (v)), (ctrl), (rmask), 0xF, false)))
DI float wave_max_nonneg(float v) {
    v = DPP_MAXF(v, 0xB1, 0xF); v = DPP_MAXF(v, 0x4E, 0xF); v = DPP_MAXF(v, 0x141, 0xF); v = DPP_MAXF(v, 0x140, 0xF); v = DPP_MAXF(v, 0x142, 0xA); v = DPP_MAXF(v, 0x143, 0xC);
    return __builtin_bit_cast(float, __builtin_amdgcn_readlane(__builtin_bit_cast(int, v), 63));
}
#define DPP_ADDF(v, ctrl, rmask) ((v) + __builtin_bit_cast(float, __builtin_amdgcn_update_dpp(0, __builtin_bit_cast(int, (v)), (ctrl), (rmask), 0xF, false)))
DI float wave_sum_u(float v) {
    v = DPP_ADDF(v, 0xB1, 0xF); v = DPP_ADDF(v, 0x4E, 0xF); v = DPP_ADDF(v, 0x141, 0xF); v = DPP_ADDF(v, 0x140, 0xF); v = DPP_ADDF(v, 0x142, 0xA); v = DPP_ADDF(v, 0x143, 0xC);
    return __builtin_bit_cast(float, __builtin_amdgcn_readlane(__builtin_bit_cast(int, v), 63));
}
typedef short v4i16_t __attribute__((ext_vector_type(4)));
DI s16x4 trrd(LAS unsigned char* p) { return __builtin_bit_cast(s16x4, __builtin_amdgcn_ds_read_tr16_b64_v4i16((LAS v4i16_t*)p)); }
DI bf16x8 cat8(s16x4 a, s16x4 b) { return (bf16x8){a[0], a[1], a[2], a[3], b[0], b[1], b[2], b[3]}; }
#define MFMA_BF16(a, b, c) __builtin_amdgcn_mfma_f32_32x32x16_bf16((a), (b), (c), 0, 0, 0)
#define MFMA_F16(a, b, c) __builtin_amdgcn_mfma_f32_32x32x16_f16((a), (b), (c), 0, 0, 0)
DI unsigned pkh(float a, float b) { return __builtin_bit_cast(unsigned, __builtin_amdgcn_cvt_pkrtz(a, b)); }
DI bf16x8 packbf(const f32x16& x, int s) { v4u p; p.x = cvtpk(x[8 * s], x[8 * s + 1]); p.y = cvtpk(x[8 * s + 2], x[8 * s + 3]); p.z = cvtpk(x[8 * s + 4], x[8 * s + 5]); p.w = cvtpk(x[8 * s + 6], x[8 * s + 7]); return __builtin_bit_cast(bf16x8, p); }
DI f16x8 packh(const f32x16& x, int s) { v4u p; p.x = pkh(x[8 * s], x[8 * s + 1]); p.y = pkh(x[8 * s + 2], x[8 * s + 3]); p.z = pkh(x[8 * s + 4], x[8 * s + 5]); p.w = pkh(x[8 * s + 6], x[8 * s + 7]); return __builtin_bit_cast(f16x8, p); }

struct Frame {
    LAS unsigned char* lds;
    volatile LAS unsigned* MISC;
    gu32* ctl;
    unsigned char* ws;
    int tid, lane, wave, vcu, G;
};
DI const float* inp(int i) { const __attribute__((address_space(4))) unsigned long long* kp = (const __attribute__((address_space(4))) unsigned long long*)__builtin_amdgcn_kernarg_segment_ptr(); return (const float*)(const GAS float*)(*(volatile const __attribute__((address_space(4))) unsigned long long*)(kp + i)); }
enum { I_X = 0, I_C, I_WADA, I_BADA, I_GN1, I_WIN, I_BIG, I_BFG, I_CONVW, I_GQ, I_GK, I_GOSB, I_GOML, I_WOUT, I_GN2, I_WQ, I_SK, I_EU, I_EV, I_OUT };
#define WSP(type, off) ((type*)(F.ws + (off)))

DI void p0_transpose_item(const float* W, int K, int N, int ld, bf16* WT, LAS float* scr, int item, int lane) {
    const int nblk = N / 32, kb = item / nblk, nb = item % nblk, k0 = 64 * kb, n0 = 32 * nb;
    float tv[32];
#pragma unroll
    for (int i = 0; i < 32; ++i) tv[i] = W[(size_t)(k0 + 2 * i + (lane >> 5)) * ld + n0 + (lane & 31)];
#pragma unroll
    for (int i = 0; i < 32; ++i) scr[(2 * i + (lane >> 5)) * 33 + (lane & 31)] = tv[i];
    LDS_WAIT(); asm volatile("" ::: "memory");
    const int c = lane & 7;
#pragma unroll
    for (int j = 0; j < 4; ++j) { const int n = (lane >> 3) + 8 * j; const LAS float* s = scr + (8 * c) * 33 + n;
        v4u o; o.x = pk2(s[0 * 33], s[1 * 33]); o.y = pk2(s[2 * 33], s[3 * 33]); o.z = pk2(s[4 * 33], s[5 * 33]); o.w = pk2(s[6 * 33], s[7 * 33]);
        *(GAS v4u*)(WT + (size_t)(n0 + n) * K + k0 + 8 * c) = o; }
    LDS_WAIT(); asm volatile("" ::: "memory");
}
DI void p0_mod_block(const Frame& F, int item) {
    const float* const c_ = inp(I_C); const float* const w_ada_ = inp(I_WADA); const float* const b_ada_ = inp(I_BADA); float* const mod_ = WSP(float, WS_MOD);
    LAS float* scr = (LAS float*)(F.lds + F.wave * 16384);
    const int j = item * 64 + F.lane, d0 = F.wave * 128;
#pragma unroll
    for (int b = 0; b < 8; ++b)
#pragma unroll
        for (int q = 0; q < 2; ++q) { const float cv = c_[b * D + d0 + 64 * q + F.lane]; scr[b * 128 + 64 * q + F.lane] = cv / (1.f + fexp(-cv)); }
    LDS_WAIT(); asm volatile("" ::: "memory");
    float acc[8];
#pragma unroll
    for (int b = 0; b < 8; ++b) acc[b] = 0.f;
#pragma unroll 32
    for (int dd = 0; dd < 128; ++dd) { const float w = w_ada_[(size_t)(d0 + dd) * NMOD + j];
#pragma unroll
        for (int b = 0; b < 8; ++b) acc[b] += scr[b * 128 + dd] * w; }
#pragma unroll
    for (int b = 0; b < 8; ++b) scr[1024 + b * 64 + F.lane] = acc[b];
    __syncthreads();
    float tot = b_ada_[j];
#pragma unroll
    for (int w = 0; w < 8; ++w) tot += ((LAS float*)(F.lds + w * 16384))[1024 + F.wave * 64 + F.lane];
    mod_[F.wave * NMOD + j] = tot;
    __syncthreads();
}
DI void p0_weff_item(const Frame& F, int item) {
    const float* const sub_keys_ = inp(I_SK); const float* const w_q_peer_ = inp(I_WQ); bf16* const Weff_t_ = WSP(bf16, WS_WEFF);
    const int hp = item >> 4, dblk = item & 15;
    LAS float* sk = (LAS float*)F.lds;
    LAS float* rb = (LAS float*)(F.lds + 67584) + F.wave * 1024;
    { float tv[32];
#pragma unroll
      for (int i = 0; i < 32; ++i) tv[i] = sub_keys_[(size_t)hp * 16384 + F.tid + 512 * i];
#pragma unroll
      for (int i = 0; i < 32; ++i) { const int idx = F.tid + 512 * i; sk[(idx >> 7) * 129 + (idx & 127)] = tv[i]; } }
    const int d0 = 64 * dblk + 8 * F.wave;
#pragma unroll
    for (int r = 0; r < 8; ++r) { rb[r * 128 + F.lane] = w_q_peer_[(size_t)(d0 + r) * NSC + hp * 128 + F.lane]; rb[r * 128 + 64 + F.lane] = w_q_peer_[(size_t)(d0 + r) * NSC + hp * 128 + 64 + F.lane]; }
    __syncthreads();
    float a0[8], a1[8];
#pragma unroll
    for (int r = 0; r < 8; ++r) { a0[r] = 0.f; a1[r] = 0.f; }
#pragma unroll 4
    for (int c = 0; c < 128; ++c) { const float s0 = sk[F.lane * 129 + c], s1 = sk[(F.lane + 64) * 129 + c];
#pragma unroll
        for (int r = 0; r < 8; ++r) { const float a = rb[r * 128 + c]; a0[r] += a * s0; a1[r] += a * s1; } }
    v4u o0, o1; o0.x = pk2(a0[0], a0[1]); o0.y = pk2(a0[2], a0[3]); o0.z = pk2(a0[4], a0[5]); o0.w = pk2(a0[6], a0[7]);
    o1.x = pk2(a1[0], a1[1]); o1.y = pk2(a1[2], a1[3]); o1.z = pk2(a1[4], a1[5]); o1.w = pk2(a1[6], a1[7]);
    *(GAS v4u*)(Weff_t_ + (size_t)(hp * 128 + F.lane) * D + d0) = o0;
    *(GAS v4u*)(Weff_t_ + (size_t)(hp * 128 + 64 + F.lane) * D + d0) = o1;
    __syncthreads();
}
struct ExpRows2 { f32x4 v[2][4]; };
DI void exp_load2(const Frame& F, int blk0, ExpRows2& R) {
    const float* const expert_u_ = inp(I_EU); const float* const expert_v_ = inp(I_EV);
#pragma unroll
    for (int bb = 0; bb < 2; ++bb) { const int blk = blk0 + bb; const float* src = (blk < 16384 ? expert_u_ : expert_v_) + (size_t)(blk & 16383) * 1024 + 4 * F.lane;
#pragma unroll
        for (int k = 0; k < 4; ++k) R.v[bb][k] = __builtin_nontemporal_load((const GAS f32x4*)(src + 256 * k)); }
}
DI void exp_conv2(const Frame& F, int blk0, const ExpRows2& R) {
    float* const SUI_ = WSP(float, WS_SUI); float* const SVI_ = WSP(float, WS_SVI);
#pragma unroll
    for (int bb = 0; bb < 2; ++bb) { const int blk = blk0 + bb; const bool isu = blk < 16384; const int e = blk & 16383;
        float mx = 0.f;
#pragma unroll
        for (int k = 0; k < 4; ++k) mx = fmaxf(mx, fmaxf(fmaxf(fabsf(R.v[bb][k].x), fabsf(R.v[bb][k].y)), fmaxf(fabsf(R.v[bb][k].z), fabsf(R.v[bb][k].w))));
        mx = wave_max_nonneg(mx);
        {
            float best = 3.0e38f, bs = 0.f;
#define EXP_TRY(FAC) do { const float s_ = mx * ((FAC) / 7.f), inv_ = s_ > 0.f ? 1.f / s_ : 0.f; float er_ = 0.f; \
                _Pragma("unroll") for (int k = 0; k < 4; ++k) _Pragma("unroll") for (int c = 0; c < 4; ++c) { const float v_ = R.v[bb][k][c]; const float d_ = v_ - s_ * fminf(fmaxf(rintf(v_ * inv_), -7.f), 7.f); er_ += d_ * d_; } \
                er_ = wave_sum_u(er_); if (er_ < best) { best = er_; bs = s_; } } while (0)
            EXP_TRY(1.f); EXP_TRY(0.86f); EXP_TRY(0.74f); EXP_TRY(0.63f);
#undef EXP_TRY
            const float inv = bs > 0.f ? 1.f / bs : 0.f;
            unsigned w01[2] = {0u, 0u};
#pragma unroll
            for (int k = 0; k < 4; ++k)
#pragma unroll
                for (int c = 0; c < 4; ++c) { const int q = (int)fminf(fmaxf(rintf(R.v[bb][k][c] * inv), -7.f), 7.f); w01[k >> 1] |= (unsigned)(q & 15) << (4 * (4 * (k & 1) + c)); }
            if (F.lane == 0) (isu ? SUI_ : SVI_)[e] = bs;
            typedef unsigned v2u_ __attribute__((ext_vector_type(2)));
            v2u_ wv; wv.x = w01[0]; wv.y = w01[1];
            *(GAS v2u_*)((isu ? WSP(unsigned char, WS_EXPU) : WSP(unsigned char, WS_EXPV)) + (size_t)e * 512 + 8 * F.lane) = wv;
        } }
}
#ifndef P0_PARTS
#define P0_PARTS 15
#endif
DI void p0_phase(const Frame& F, int parts = 15) {
    const float* const w_in_ = inp(I_WIN); bf16* const Win_t_ = WSP(bf16, WS_WIN); const float* const w_out_ = inp(I_WOUT); bf16* const Wout_t_ = WSP(bf16, WS_WOUT); const float* const expert_v_ = inp(I_EV); const float* const expert_u_ = inp(I_EU);
    LAS float* scr = (LAS float*)(F.lds + F.wave * 16384);
    const int gw = F.vcu * NWAVES + F.wave, NGW = F.G * NWAVES;
    if (parts & 1) for (int it = F.vcu; it < 96; it += F.G) p0_mod_block(F, it);
    constexpr int I_WIN = 16 * 112, I_WOUT = 16 * 32, NITEMS = I_WIN + I_WOUT;
    if (parts & 2) for (int it = gw; it < NITEMS; it += NGW) {
        int r = it;
        if (r < I_WIN) { p0_transpose_item(w_in_, D, NPROJ, NIN, Win_t_, scr, r, F.lane); continue; } r -= I_WIN;
        p0_transpose_item(w_out_, D, D, D, Wout_t_, scr, r, F.lane);
    }
    __syncthreads();
    if (parts & 8) for (int it = F.vcu; it < 256; it += F.G) p0_weff_item(F, it);
}

template <bool DOGATES>
DI void norm_phase(const Frame& F, const float* src, const float* g, int shift_off, int scale_off) {
    const float* const w_in_ = inp(I_WIN); float* const mod_ = WSP(float, WS_MOD); bf16* const XN_ = WSP(bf16, WS_XN); float* const GATES_ = WSP(float, WS_GATES); const float* const b_igate_ = inp(I_BIG); const float* const b_fgate_ = inp(I_BFG);
    LAS float* W8 = (LAS float*)F.lds;
    if (DOGATES) {
        for (int i = 0; i < 16; ++i) { const int idx = F.tid + 512 * i; W8[idx] = w_in_[(size_t)(idx & 1023) * NIN + NPROJ + (idx >> 10)]; }
        __syncthreads();
    }
    const int gw = F.vcu * NWAVES + F.wave, NGW = F.G * NWAVES;
    for (int ch = gw; ch < T / 16; ch += NGW) {
        const int r0 = ch * 16, b = r0 / SEQ;
        f32x4 A[4], Bv[4];
#pragma unroll
        for (int j = 0; j < 4; ++j) { const int col = 4 * F.lane + 256 * j; const f32x4 gg = *(const f32x4*)(g + col), sc = *(const f32x4*)(mod_ + b * NMOD + scale_off + col);
            A[j] = gg * (sc + 1.0f); Bv[j] = *(const f32x4*)(mod_ + b * NMOD + shift_off + col); }
        f32x4 nx[4];
        { const GAS f32x4* xr0 = (const GAS f32x4*)(src + (size_t)r0 * D) + F.lane;
#pragma unroll
          for (int j = 0; j < 4; ++j) nx[j] = __builtin_nontemporal_load(xr0 + 64 * j); }
        for (int rr = 0; rr < 16; ++rr) {
            const int row = r0 + rr;
            f32x4 v[4]; float s = 0.f;
#pragma unroll
            for (int j = 0; j < 4; ++j) { v[j] = nx[j]; s += (v[j].x * v[j].x + v[j].y * v[j].y) + (v[j].z * v[j].z + v[j].w * v[j].w); }
            if (rr + 1 < 16) { const GAS f32x4* xr = (const GAS f32x4*)(src + (size_t)(row + 1) * D) + F.lane;
#pragma unroll
                for (int j = 0; j < 4; ++j) nx[j] = __builtin_nontemporal_load(xr + 64 * j); }
            const float rstd = 1.f / sqrtf(wave_sum_u(s) * (1.f / D) + EPS);
#pragma unroll
            for (int j = 0; j < 4; ++j) v[j] = v[j] * rstd * A[j] + Bv[j];
            GAS unsigned long long* o8 = (GAS unsigned long long*)(XN_ + (size_t)row * D) + F.lane;
#pragma unroll
            for (int j = 0; j < 4; ++j) o8[64 * j] = (unsigned long long)pk2(v[j].x, v[j].y) | ((unsigned long long)pk2(v[j].z, v[j].w) << 32);
            if (DOGATES) {
                float res = 0.f;
#pragma unroll
                for (int hh = 0; hh < 8; ++hh) { float p = 0.f;
#pragma unroll
                    for (int j = 0; j < 4; ++j) { const f32x4 w = *(const LAS f32x4*)(W8 + hh * 1024 + 4 * F.lane + 256 * j); p += (v[j].x * w.x + v[j].y * w.y) + (v[j].z * w.z + v[j].w * w.w); }
                    p = wave_sum_u(p); if (F.lane == hh) res = p; }
                if (F.lane < 8) GATES_[(size_t)row * 8 + F.lane] = res + (F.lane < 4 ? b_igate_[F.lane] : b_fgate_[F.lane - 4]);
            }
        }
    }
}

DI void sb_unit(const Frame& F, int b, int h, int qb) {
    bf16* const PROJ_ = WSP(bf16, WS_PROJ); const float* const g_q_sb_ = inp(I_GQ); const float* const g_k_sb_ = inp(I_GK); bf16* const MIX_ = WSP(bf16, WS_MIX); const float* const g_out_sb_ = inp(I_GOSB);
    const int lane = F.lane, w = F.wave, r = lane & 31, hi = lane >> 5;
    const int i16 = lane & 15, qq = i16 >> 2, pp = i16 & 3, blk = (lane >> 4) & 1;
    LAS unsigned char* Wb = F.lds + w * 16384;
    const size_t rowbase = (size_t)b * SEQ; const int q0 = qb * 256, qw0 = q0 + 32 * w, tq = qw0 + r;
    const bf16* P = PROJ_;
    const bf16* kpiece[4]; const bf16* vpiece[4];
#pragma unroll
    for (int i = 0; i < 4; ++i) { const int krow_ = 8 * i + (lane >> 3), kch = (lane & 7) ^ ((krow_ >> 1) & 7); kpiece[i] = P + (rowbase + krow_) * NPROJ + C_KSB + h * 64 + 8 * kch;
        const int vkey = 16 * (i & 1) + (lane >> 2); vpiece[i] = P + (rowbase + vkey) * NPROJ + C_VSB + h * 64 + 32 * (i >> 1) + 8 * (lane & 3); }
#define SB_DMA(T_, BUF_) do { _Pragma("unroll") for (int i_ = 0; i_ < 4; ++i_) { \
        __builtin_amdgcn_global_load_lds((const unsigned*)(kpiece[i_] + (size_t)(32 * (T_)) * NPROJ), (LAS unsigned*)(Wb + 8192 * (BUF_) + 1024 * i_), 16, 0, 0); \
        __builtin_amdgcn_global_load_lds((const unsigned*)(vpiece[i_] + (size_t)(32 * (T_)) * NPROJ), (LAS unsigned*)(Wb + 8192 * (BUF_) + 4096 + 1024 * i_), 16, 0, 0); } } while (0)
    const int tw = (qw0 + 30) >> 5;
    SB_DMA(tw, 0);
    bf16x8 qf[4];
    {
        const bf16* Qp = P + (rowbase + tq) * NPROJ + C_QSB + h * 64 + 8 * hi;
        v4u qraw[4]; float ss = 0.f;
#pragma unroll
        for (int kk = 0; kk < 4; ++kk) { qraw[kk] = *(const GAS v4u*)(Qp + 16 * kk);
#pragma unroll
            for (int e = 0; e < 4; ++e) { const float a = bflo(qraw[kk][e]), c = bfhi(qraw[kk][e]); ss += a * a + c * c; } }
        ss = swap_add(ss);
        const float rq = __builtin_amdgcn_rsqf(ss * (1.f / 64.f) + EPS) * (0.125f * LOG2E);
#pragma unroll
        for (int kk = 0; kk < 4; ++kk) { const int d0 = 16 * kk + 8 * hi;
            const f32x4 g0 = *(const f32x4*)(g_q_sb_ + d0) * *(const f32x4*)(g_k_sb_ + d0), g1 = *(const f32x4*)(g_q_sb_ + d0 + 4) * *(const f32x4*)(g_k_sb_ + d0 + 4);
            v4u o; o.x = cvtpk(bflo(qraw[kk].x) * rq * g0.x, bfhi(qraw[kk].x) * rq * g0.y); o.y = cvtpk(bflo(qraw[kk].y) * rq * g0.z, bfhi(qraw[kk].y) * rq * g0.w);
            o.z = cvtpk(bflo(qraw[kk].z) * rq * g1.x, bfhi(qraw[kk].z) * rq * g1.y); o.w = cvtpk(bflo(qraw[kk].w) * rq * g1.z, bfhi(qraw[kk].w) * rq * g1.w);
            qf[kk] = __builtin_bit_cast(bf16x8, o); }
    }
    f16x8 U0, U1, E0;
#pragma unroll
    for (int j = 0; j < 8; ++j) { U0[j] = (krow(0, hi, j) > r) ? (_Float16)1.0f : (_Float16)0.0f; U1[j] = (krow(1, hi, j) > r) ? (_Float16)1.0f : (_Float16)0.0f;
        E0[j] = (j == 0 && hi == 0) ? (_Float16)1.0f : (_Float16)0.0f; }
    f32x16 o0, o1;
#pragma unroll
    for (int i = 0; i < 16; ++i) { o0[i] = 0.f; o1[i] = 0.f; }
    float R = 0.f;
    const int kfoff = r * 128, kfsw = (r >> 1) & 7;
    for (int t = tw; t >= 0; --t) {
        const int buf = (tw - t) & 1;
        LAS unsigned char* Kb = Wb + 8192 * buf; LAS unsigned char* Vb = Kb + 4096;
        asm volatile("s_waitcnt vmcnt(0)" ::: "memory");
        if (t > 0) SB_DMA(t - 1, buf ^ 1);
        bf16x8 kf[4]; float ssk = 0.f;
#pragma unroll
        for (int kk = 0; kk < 4; ++kk) { const v4u kv = *(const LAS v4u*)(Kb + kfoff + (((2 * kk + hi) ^ kfsw) * 16)); kf[kk] = __builtin_bit_cast(bf16x8, kv);
            ssk = dot2bf(kv.x, kv.x, ssk); ssk = dot2bf(kv.y, kv.y, ssk); ssk = dot2bf(kv.z, kv.z, ssk); ssk = dot2bf(kv.w, kv.w, ssk); }
        ssk = swap_add(ssk);
        const float rk = __builtin_amdgcn_rsqf(ssk * (1.f / 64.f) + EPS);
        f16x8 RKA;
#pragma unroll
        for (int e = 0; e < 8; ++e) RKA[e] = (_Float16)0.0f;
        RKA[0] = (hi == 0) ? (_Float16)rk : (_Float16)0.0f;
        f32x16 s, rkd;
#pragma unroll
        for (int i = 0; i < 16; ++i) { s[i] = 0.f; rkd[i] = 0.f; }
        rkd = MFMA_F16(RKA, E0, rkd);
#pragma unroll
        for (int kk = 0; kk < 4; ++kk) s = MFMA_BF16(kf[kk], qf[kk], s);
        float tsum = 0.f; unsigned lp[8];
        if (32 * t + 31 < qw0) {
#pragma unroll
            for (int i = 0; i < 16; i += 2) {
                const float z0_ = s[i] * rkd[i], z1_ = s[i + 1] * rkd[i + 1];
                const float a0_ = -lg2(1.f + ex2(z0_)), a1_ = -lg2(1.f + ex2(z1_));
                tsum += a0_ + a1_;
                s[i] = z0_ + a0_; s[i + 1] = z1_ + a1_;
                lp[i >> 1] = pkh(a0_, a1_); }
        } else {
            const int kq = tq - 32 * t;
#pragma unroll
            for (int i = 0; i < 16; i += 2) {
                const float z0_ = s[i] * rkd[i], z1_ = s[i + 1] * rkd[i + 1];
                float a0_ = -lg2(1.f + ex2(z0_)), a1_ = -lg2(1.f + ex2(z1_));
                const bool ma0 = crow(i, hi) >= kq, ma1 = crow(i + 1, hi) >= kq;
                a0_ = ma0 ? 0.f : a0_; a1_ = ma1 ? 0.f : a1_;
                tsum += a0_ + a1_;
                s[i] = ma0 ? -INFINITY : z0_ + a0_; s[i + 1] = ma1 ? -INFINITY : z1_ + a1_;
                lp[i >> 1] = pkh(a0_, a1_); }
        }
        f32x16 c;
#pragma unroll
        for (int i = 0; i < 16; ++i) c[i] = R;
        c = MFMA_F16(U0, __builtin_bit_cast(f16x8, (v4u){lp[0], lp[1], lp[2], lp[3]}), c); c = MFMA_F16(U1, __builtin_bit_cast(f16x8, (v4u){lp[4], lp[5], lp[6], lp[7]}), c);
#pragma unroll
        for (int i = 0; i < 16; ++i) s[i] = ex2(s[i] + c[i]);
        const bf16x8 W0 = packbf(s, 0), W1 = packbf(s, 1);
        LAS unsigned char* vb_ = Vb + (4 * hi + qq) * 64 + 32 * blk + 8 * pp;
        o0 = MFMA_BF16(cat8(trrd(vb_), trrd(vb_ + 8 * 64)), W0, o0); o0 = MFMA_BF16(cat8(trrd(vb_ + 16 * 64), trrd(vb_ + 24 * 64)), W1, o0);
        o1 = MFMA_BF16(cat8(trrd(vb_ + 2048), trrd(vb_ + 2048 + 8 * 64)), W0, o1); o1 = MFMA_BF16(cat8(trrd(vb_ + 2048 + 16 * 64), trrd(vb_ + 2048 + 24 * 64)), W1, o1);
        R += swap_add(tsum);
        if (__all(R < -150.f)) break;
    }
    asm volatile("s_waitcnt vmcnt(0)" ::: "memory");
#undef SB_DMA
    {
        float ss = 0.f;
#pragma unroll
        for (int i = 0; i < 16; ++i) ss += o0[i] * o0[i] + o1[i] * o1[i];
        ss = swap_add(ss);
        const float ro = __builtin_amdgcn_rsqf(ss * (1.f / 64.f) + EPS);
        bf16* Op = MIX_ + (rowbase + tq) * D + h * 64;
        const float* go = g_out_sb_ + h * 64;
#pragma unroll
        for (int g = 0; g < 4; ++g) { const int d0 = 8 * g + 4 * hi; const f32x4 ga = *(const f32x4*)(go + d0), gb = *(const f32x4*)(go + 32 + d0);
            u32x2 wa, wb; wa.x = cvtpk(o0[4 * g] * ro * ga.x, o0[4 * g + 1] * ro * ga.y); wa.y = cvtpk(o0[4 * g + 2] * ro * ga.z, o0[4 * g + 3] * ro * ga.w);
            wb.x = cvtpk(o1[4 * g] * ro * gb.x, o1[4 * g + 1] * ro * gb.y); wb.y = cvtpk(o1[4 * g + 2] * ro * gb.z, o1[4 * g + 3] * ro * gb.w);
            *(GAS u32x2*)(Op + d0) = wa; *(GAS u32x2*)(Op + 32 + d0) = wb; }
    }
    __syncthreads();
}

DI void conv_silu8(const v4u (&xr)[4], const float (&cw)[4][8], float scale, float (&y)[8]) {
#pragma unroll
    for (int e = 0; e < 8; ++e) y[e] = 0.f;
#pragma unroll
    for (int j = 0; j < 4; ++j) {
        y[0] += cw[j][0] * bflo(xr[j].x); y[1] += cw[j][1] * bfhi(xr[j].x); y[2] += cw[j][2] * bflo(xr[j].y); y[3] += cw[j][3] * bfhi(xr[j].y);
        y[4] += cw[j][4] * bflo(xr[j].z); y[5] += cw[j][5] * bfhi(xr[j].z); y[6] += cw[j][6] * bflo(xr[j].w); y[7] += cw[j][7] * bfhi(xr[j].w); }
#pragma unroll
    for (int e = 0; e < 8; ++e) y[e] = scale * y[e] * __builtin_amdgcn_rcpf(1.f + fexp(-y[e]));
}
DI float log_sigmoid(float x) { return fminf(x, 0.f) - 0.6931471805599453f * lg2(1.f + fexp(-fabsf(x))); }
DI float wave_scan_incl(float a, int lane) {
#pragma unroll
    for (int o = 1; o < 64; o <<= 1) { const float t = __shfl_up(a, o); if (lane >= o) a += t; }
    return a;
}

constexpr int LDS_CW = 65536;
DI void stage_conv_w(const Frame& F) {
    const float* const conv_w_ = inp(I_CONVW); LAS float* cwl = (LAS float*)(F.lds + LDS_CW);
    for (int i = F.tid; i < 4096; i += NTHR) cwl[i] = conv_w_[i];
    __syncthreads();
}
DI void load_cw8(const Frame& F, int colbase, float (&cw)[4][8]) {
    const LAS float* cwl = (const LAS float*)(F.lds + LDS_CW);
#pragma unroll
    for (int j = 0; j < 4; ++j) { const f32x4 a = *(const LAS f32x4*)(cwl + j * 1024 + colbase), b = *(const LAS f32x4*)(cwl + j * 1024 + colbase + 4);
        cw[j][0] = a.x; cw[j][1] = a.y; cw[j][2] = a.z; cw[j][3] = a.w; cw[j][4] = b.x; cw[j][5] = b.y; cw[j][6] = b.z; cw[j][7] = b.w; }
}
struct MlLocalRegs { v4u kraw[2][4]; v4u vraw[2]; float gi, gf; };
DI void ml_local_load(const Frame& F, int chain, int c, MlLocalRegs& R) {
    bf16* const PROJ_ = WSP(bf16, WS_PROJ); float* const GATES_ = WSP(float, WS_GATES);
    const int tid = F.tid, lane = F.lane;
    const int b = chain >> 2, hh = chain & 3; const size_t rowbase = (size_t)b * SEQ; const int t0 = c * 64;
    const bf16* P = PROJ_;
    const int kc = tid & 15, kr0 = tid >> 4;
    const bf16* Kg = P + rowbase * NPROJ + C_KML + hh * 128 + kc * 8;
#pragma unroll
    for (int i = 0; i < 2; ++i)
#pragma unroll
        for (int j = 0; j < 4; ++j) { const int tt = t0 + kr0 + 32 * i - 3 + j; R.kraw[i][j] = (tt >= 0) ? *(const GAS v4u*)(Kg + (size_t)tt * NPROJ) : (v4u){0u, 0u, 0u, 0u}; }
#pragma unroll
    for (int i = 0; i < 2; ++i) R.vraw[i] = *(const GAS v4u*)(P + (rowbase + t0 + kr0 + 32 * i) * NPROJ + C_VML + hh * 128 + kc * 8);
    const float* Gg = GATES_ + (rowbase + t0 + lane) * 8;
    R.gi = Gg[hh]; R.gf = Gg[4 + hh];
}
DI void ml_local_unit(const Frame& F, int chain, int c, const MlLocalRegs& RG) {
    bf16* const CST_ = WSP(bf16, WS_CST); float* const NST_ = WSP(float, WS_NST); float* const SCL_ = WSP(float, WS_SCL);
    LAS unsigned char* L = F.lds;
    LAS float* Lws = (LAS float*)(L + 32768);
    const int tid = F.tid, lane = F.lane, w = F.wave, r = lane & 31, hi = lane >> 5;
    const int i16 = lane & 15, qq = i16 >> 2, pp = i16 & 3, blk = (lane >> 4) & 1;
    const int hh = chain & 3;
    const int kbk = w & 3, vb0 = 2 * (w >> 2);
    const int kc = tid & 15, kr0 = tid >> 4;
    v4u kraw[2][4], vraw[2];
#pragma unroll
    for (int i = 0; i < 2; ++i) { vraw[i] = RG.vraw[i];
#pragma unroll
        for (int j = 0; j < 4; ++j) kraw[i][j] = RG.kraw[i][j]; }
    const float gi = RG.gi, gf = RG.gf;
    const float a = wave_scan_incl(log_sigmoid(gf), lane);
    const float a_end = __shfl(a, 63);
    const float lw = a_end - a + gi;
    const float m_loc = wave_max(lw);
    const float ws = fexp(lw - m_loc);
    if (w == 0) Lws[lane] = ws;
    {
        float cw[4][8]; load_cw8(F, 512 + hh * 128 + kc * 8, cw);
#pragma unroll
        for (int i = 0; i < 2; ++i) { float y[8]; conv_silu8(kraw[i], cw, 0.08838834764831845f, y);
            v4u o; o.x = cvtpk(y[0], y[1]); o.y = cvtpk(y[2], y[3]); o.z = cvtpk(y[4], y[5]); o.w = cvtpk(y[6], y[7]);
            *(LAS v4u*)(L + (kc >> 2) * 4096 + (kr0 + 32 * i) * 64 + (kc & 3) * 16) = o; }
#pragma unroll
        for (int i = 0; i < 2; ++i) { const int row = kr0 + 32 * i; const float wsr = __shfl(ws, row);
            v4u o; o.x = cvtpk(bflo(vraw[i].x) * wsr, bfhi(vraw[i].x) * wsr); o.y = cvtpk(bflo(vraw[i].y) * wsr, bfhi(vraw[i].y) * wsr); o.z = cvtpk(bflo(vraw[i].z) * wsr, bfhi(vraw[i].z) * wsr); o.w = cvtpk(bflo(vraw[i].w) * wsr, bfhi(vraw[i].w) * wsr);
            *(LAS v4u*)(L + 16384 + (kc >> 2) * 4096 + row * 64 + (kc & 3) * 16) = o; }
    }
    __syncthreads();
    f32x16 acc0, acc1;
#pragma unroll
    for (int i = 0; i < 16; ++i) { acc0[i] = 0.f; acc1[i] = 0.f; }
#pragma unroll
    for (int kk = 0; kk < 4; ++kk) { const int rows = 16 * kk + 8 * hi + qq;
        LAS unsigned char* ka = L + kbk * 4096 + rows * 64 + 32 * blk + 8 * pp; LAS unsigned char* va = L + 16384 + vb0 * 4096 + rows * 64 + 32 * blk + 8 * pp;
        const bf16x8 A = cat8(trrd(ka), trrd(ka + 4 * 64));
        acc0 = MFMA_BF16(A, cat8(trrd(va), trrd(va + 4 * 64)), acc0); acc1 = MFMA_BF16(A, cat8(trrd(va + 4096), trrd(va + 4096 + 4 * 64)), acc1); }
    {
        bf16* Cp = CST_ + ((size_t)(chain * 64 + c) * 128 + vb0 * 32 + r) * 128 + kbk * 32 + 4 * hi;
#pragma unroll
        for (int g = 0; g < 4; ++g) { u32x2 o; o.x = cvtpk(acc0[4 * g], acc0[4 * g + 1]); o.y = cvtpk(acc0[4 * g + 2], acc0[4 * g + 3]); *(GAS u32x2*)(Cp + 8 * g) = o;
            u32x2 o1; o1.x = cvtpk(acc1[4 * g], acc1[4 * g + 1]); o1.y = cvtpk(acc1[4 * g + 2], acc1[4 * g + 3]); *(GAS u32x2*)(Cp + 32 * 128 + 8 * g) = o1; }
    }
    {
        const int k = 16 * w + (lane & 15), sq = lane >> 4; float part = 0.f;
        const LAS unsigned short* kcol = (const LAS unsigned short*)(L + (k >> 5) * 4096 + (k & 31) * 2);
#pragma unroll
        for (int e = 0; e < 16; ++e) part += Lws[16 * sq + e] * __uint_as_float((unsigned)kcol[(16 * sq + e) * 32] << 16);
        part += __shfl_xor(part, 16); part += __shfl_xor(part, 32);
        if (lane < 16) NST_[(size_t)(chain * 64 + c) * 128 + k] = part;
        if (tid == 0) { SCL_[(chain * 64 + c) * 2] = a_end; SCL_[(chain * 64 + c) * 2 + 1] = m_loc; }
    }
    __syncthreads();
}
DI void ml_scan_phase(const Frame& F) {
    bf16* const CST_ = WSP(bf16, WS_CST); float* const NST_ = WSP(float, WS_NST); float* const SCL_ = WSP(float, WS_SCL); float* const MST_ = WSP(float, WS_MST);
    for (int gt = F.vcu * NTHR + F.tid; gt < 32 * 4096; gt += F.G * NTHR) {
        const int chain = gt >> 12, rem = gt & 4095;
        const float ae_l = SCL_[(chain * 64 + F.lane) * 2], ml_l = SCL_[(chain * 64 + F.lane) * 2 + 1];
        u32x2* Cp = (u32x2*)(CST_ + (size_t)chain * 64 * 16384 + (size_t)rem * 4);
        f32x4* Np = (f32x4*)(NST_ + (size_t)chain * 64 * 128 + rem * 4);
        const bool do_n = rem < 32;
        float c0 = 0.f, c1 = 0.f, c2 = 0.f, c3 = 0.f; f32x4 nn = {0.f, 0.f, 0.f, 0.f}; float m = 0.f;
        u32x2 dr[8]; f32x4 nr[8];
#pragma unroll
        for (int i = 0; i < 8; ++i) { dr[i] = Cp[(size_t)i * 4096]; if (do_n) nr[i] = Np[i * 32]; }
        for (int c0_ = 0; c0_ < 64; c0_ += 8) {
#pragma unroll
            for (int i = 0; i < 8; ++i) { const int c = c0_ + i;
                if (c < 63) {
                    const u32x2 dcur = dr[i]; const f32x4 dn = nr[i];
                    if (c + 8 < 63) { dr[i] = Cp[(size_t)(c + 8) * 4096]; if (do_n) nr[i] = Np[(c + 8) * 32]; }
                    const float ae = __builtin_bit_cast(float, __builtin_amdgcn_readlane(__builtin_bit_cast(int, ae_l), c)), ml = __builtin_bit_cast(float, __builtin_amdgcn_readlane(__builtin_bit_cast(int, ml_l), c));
                    const float mn = fmaxf(ae + m, ml), d1 = fexp(ae + m - mn), d2 = fexp(ml - mn);
                    c0 = d1 * c0 + d2 * bflo(dcur.x); c1 = d1 * c1 + d2 * bfhi(dcur.x); c2 = d1 * c2 + d2 * bflo(dcur.y); c3 = d1 * c3 + d2 * bfhi(dcur.y);
                    u32x2 o; o.x = cvtpk(c0, c1); o.y = cvtpk(c2, c3); Cp[(size_t)c * 4096] = o;
                    if (do_n) { nn = nn * d1 + dn * d2; Np[c * 32] = nn; }
                    if (rem == 0) MST_[chain * 64 + c] = mn;
                    m = mn; } }
        }
    }
}
DI void ml_out_unit(const Frame& F, int chain, int c) {
    bf16* const PROJ_ = WSP(bf16, WS_PROJ); float* const GATES_ = WSP(float, WS_GATES); float* const MST_ = WSP(float, WS_MST); bf16* const CST_ = WSP(bf16, WS_CST); float* const NST_ = WSP(float, WS_NST); bf16* const MIX_ = WSP(bf16, WS_MIX); const float* const g_out_ml_ = inp(I_GOML);
    LAS unsigned char* L = F.lds;
    LAS float* Lbs = (LAS float*)(L + 49152); LAS float* Lav = (LAS float*)(L + 49408); LAS float* Lex = (LAS float*)(L + 49664);
    const int tid = F.tid, lane = F.lane, w = F.wave, r = lane & 31, hi = lane >> 5;
    const int i16 = lane & 15, qq = i16 >> 2, pp = i16 & 3, blk = (lane >> 4) & 1;
    const int b = chain >> 2, hh = chain & 3; const size_t rowbase = (size_t)b * SEQ; const int t0 = c * 64;
    const int tb = w >> 2, vb = w & 3;
    const bf16* P = PROJ_;
    {
        const int kc = tid & 15, kr0 = tid >> 4;
#pragma unroll
        for (int which = 0; which < 2; ++which) {
            const int colbase = (which ? 512 : 0) + hh * 128 + kc * 8;
            float cw[4][8]; load_cw8(F, colbase, cw);
            const bf16* Xg = P + rowbase * NPROJ + C_QML + colbase;
#pragma unroll
            for (int i = 0; i < 2; ++i) { const int row = kr0 + 32 * i; v4u xr[4];
#pragma unroll
                for (int j = 0; j < 4; ++j) { const int tt = t0 + row - 3 + j; xr[j] = (tt >= 0) ? *(const GAS v4u*)(Xg + (size_t)tt * NPROJ) : (v4u){0u, 0u, 0u, 0u}; }
                float y[8]; conv_silu8(xr, cw, which ? 0.08838834764831845f : 1.0f, y);
                v4u o; o.x = cvtpk(y[0], y[1]); o.y = cvtpk(y[2], y[3]); o.z = cvtpk(y[4], y[5]); o.w = cvtpk(y[6], y[7]);
                *(LAS v4u*)(L + which * 16384 + row * 256 + ((kc ^ (row & 15)) * 16)) = o; }
        }
#pragma unroll
        for (int i = 0; i < 2; ++i) { const int row = kr0 + 32 * i;
            const v4u v = *(const GAS v4u*)(P + (rowbase + t0 + row) * NPROJ + C_VML + hh * 128 + kc * 8);
            *(LAS v4u*)(L + 32768 + (kc >> 2) * 4096 + row * 64 + (kc & 3) * 16) = v; }
        if (w == 0) { const float* Gg = GATES_ + (rowbase + t0 + lane) * 8; const float a = wave_scan_incl(log_sigmoid(Gg[4 + hh]), lane); Lav[lane] = a; Lbs[lane] = Gg[hh] - a; }
    }
    const float mprev = (c > 0) ? MST_[chain * 64 + c - 1] : 0.f;
    bf16x8 cf[8], nf[8];
    if (c > 0) {
        const bf16* Cp = CST_ + ((size_t)(chain * 64 + c - 1) * 128 + vb * 32 + r) * 128 + 8 * hi;
        const float* Np = NST_ + (size_t)(chain * 64 + c - 1) * 128 + 8 * hi;
        const bool nrow = (r == 0) || (r == 4);
#pragma unroll
        for (int kk = 0; kk < 8; ++kk) { cf[kk] = *(const GAS bf16x8*)(Cp + 16 * kk);
            const f32x4 n0 = *(const f32x4*)(Np + 16 * kk), n1 = *(const f32x4*)(Np + 16 * kk + 4);
            v4u o; o.x = cvtpk(n0.x, n0.y); o.y = cvtpk(n0.z, n0.w); o.z = cvtpk(n1.x, n1.y); o.w = cvtpk(n1.z, n1.w);
            if (!nrow) o = (v4u){0u, 0u, 0u, 0u};
            nf[kk] = __builtin_bit_cast(bf16x8, o); }
    }
    __syncthreads();
    bf16x8 qf[8];
    f32x16 s0, s1;
#pragma unroll
    for (int i = 0; i < 16; ++i) { s0[i] = 0.f; s1[i] = 0.f; }
#pragma unroll
    for (int kk = 0; kk < 8; ++kk) { const int ch = 2 * kk + hi; const int rq_ = 32 * tb + r;
        qf[kk] = *(const LAS bf16x8*)(L + rq_ * 256 + ((ch ^ (rq_ & 15)) * 16));
        const bf16x8 a0 = *(const LAS bf16x8*)(L + 16384 + r * 256 + ((ch ^ (r & 15)) * 16));
        const bf16x8 a1 = *(const LAS bf16x8*)(L + 16384 + (32 + r) * 256 + ((ch ^ ((32 + r) & 15)) * 16));
        s0 = MFMA_BF16(a0, qf[kk], s0); s1 = MFMA_BF16(a1, qf[kk], s1); }
    const int tl = 32 * tb + r; const float a_t = Lav[tl];
    f32x16 d0, d1; float mrow = -INFINITY;
#pragma unroll
    for (int g = 0; g < 4; ++g) { const f32x4 b0 = *(const LAS f32x4*)(Lbs + 8 * g + 4 * hi), b1 = *(const LAS f32x4*)(Lbs + 32 + 8 * g + 4 * hi);
#pragma unroll
        for (int e = 0; e < 4; ++e) { const int sl = 8 * g + 4 * hi + e;
            d0[4 * g + e] = (sl <= tl) ? a_t + b0[e] : -INFINITY; d1[4 * g + e] = (32 + sl <= tl) ? a_t + b1[e] : -INFINITY;
            mrow = fmaxf(mrow, fmaxf(d0[4 * g + e], d1[4 * g + e])); } }
    mrow = fmaxf(swap_max(mrow), a_t + mprev);
    float psum = 0.f;
#pragma unroll
    for (int i = 0; i < 16; ++i) { s0[i] *= fexp(d0[i] - mrow); s1[i] *= fexp(d1[i] - mrow); psum += s0[i] + s1[i]; }
    const float w_inter = fexp(a_t + mprev - mrow);
    float den = swap_add(psum);
    const bf16x8 P00 = packbf(s0, 0), P01 = packbf(s0, 1), P10 = packbf(s1, 0), P11 = packbf(s1, 1);
    f32x16 num;
#pragma unroll
    for (int i = 0; i < 16; ++i) num[i] = 0.f;
    {
        LAS unsigned char* vb_ = L + 32768 + vb * 4096 + (4 * hi + qq) * 64 + 32 * blk + 8 * pp;
        num = MFMA_BF16(cat8(trrd(vb_), trrd(vb_ + 8 * 64)), P00, num); num = MFMA_BF16(cat8(trrd(vb_ + 16 * 64), trrd(vb_ + 24 * 64)), P01, num);
        num = MFMA_BF16(cat8(trrd(vb_ + 32 * 64), trrd(vb_ + 40 * 64)), P10, num); num = MFMA_BF16(cat8(trrd(vb_ + 48 * 64), trrd(vb_ + 56 * 64)), P11, num);
    }
    if (c > 0) {
        f32x16 it, dn;
#pragma unroll
        for (int i = 0; i < 16; ++i) { it[i] = 0.f; dn[i] = 0.f; }
#pragma unroll
        for (int kk = 0; kk < 8; ++kk) { it = MFMA_BF16(cf[kk], qf[kk], it); dn = MFMA_BF16(nf[kk], qf[kk], dn); }
#pragma unroll
        for (int i = 0; i < 16; ++i) num[i] += w_inter * it[i];
        den += w_inter * dn[0];
    }
    const float inv = __builtin_amdgcn_rcpf(fmaxf(fabsf(den), fexp(-mrow)));
    float ss = 0.f;
#pragma unroll
    for (int i = 0; i < 16; ++i) { num[i] *= inv; ss += num[i] * num[i]; }
    ss = swap_add(ss);
    if (lane < 32) Lex[(tb * 4 + vb) * 32 + r] = ss;
    __syncthreads();
    const float tot = (Lex[(tb * 4 + 0) * 32 + r] + Lex[(tb * 4 + 1) * 32 + r]) + (Lex[(tb * 4 + 2) * 32 + r] + Lex[(tb * 4 + 3) * 32 + r]);
    const float rstd = 1.f / sqrtf(tot * (1.f / 128.f) + EPS);
    {
        const size_t trow = rowbase + t0 + tl;
        const bf16* Og = P + trow * NPROJ + C_OML + hh * 128 + vb * 32 + 4 * hi;
        bf16* Mp = MIX_ + trow * D + 512 + hh * 128 + vb * 32 + 4 * hi;
        const float* go = g_out_ml_ + hh * 128 + vb * 32 + 4 * hi;
#pragma unroll
        for (int g = 0; g < 4; ++g) { const u32x2 og = *(const GAS u32x2*)(Og + 8 * g); const f32x4 gg = *(const f32x4*)(go + 8 * g);
            const float o0 = bflo(og.x), o1 = bfhi(og.x), o2 = bflo(og.y), o3 = bfhi(og.y);
            u32x2 o; o.x = cvtpk(num[4 * g] * rstd * gg.x * __builtin_amdgcn_rcpf(1.f + fexp(-o0)), num[4 * g + 1] * rstd * gg.y * __builtin_amdgcn_rcpf(1.f + fexp(-o1)));
            o.y = cvtpk(num[4 * g + 2] * rstd * gg.z * __builtin_amdgcn_rcpf(1.f + fexp(-o2)), num[4 * g + 3] * rstd * gg.w * __builtin_amdgcn_rcpf(1.f + fexp(-o3)));
            *(GAS u32x2*)(Mp + 8 * g) = o; }
    }
    __syncthreads();
}

#define TK_CE(A, B) do { const float hi_ = fmaxf((A), (B)), lo_ = fminf((A), (B)); (A) = hi_; (B) = lo_; } while (0)
DI void tk_sort16(float (&a)[16]) {
#pragma unroll
    for (int k = 2; k <= 16; k <<= 1)
#pragma unroll
        for (int j = k >> 1; j > 0; j >>= 1)
#pragma unroll
            for (int i = 0; i < 16; ++i) { const int l = i ^ j; if (l > i) { if ((i & k) == 0) TK_CE(a[i], a[l]); else TK_CE(a[l], a[i]); } }
}
DI void tk_merge16(float (&a)[16], const float (&b)[16]) {
#pragma unroll
    for (int i = 0; i < 16; ++i) a[i] = fmaxf(a[i], b[15 - i]);
#pragma unroll
    for (int j = 8; j > 0; j >>= 1)
#pragma unroll
        for (int i = 0; i < 16; ++i) { const int l = i ^ j; if (l > i) TK_CE(a[i], a[l]); }
}
DI void tk_stage2(const LAS float* la, const LAS float* lb, int* IDX_, float* GATEW_, size_t o) {
        float a[16], bb[16], cnd[64];
#pragma unroll
        for (int q = 0; q < 16; ++q) { a[q] = la[q]; bb[q] = lb[q]; }
        int cnt = 0;
#pragma unroll
        for (int i = 0; i < 16; ++i)
#pragma unroll
            for (int j = 0; j < 16; ++j) if ((i + 1) * (j + 1) <= 16) { cnd[cnt] = __uint_as_float((__float_as_uint(a[i] + bb[j]) & ~0xFFu) | (unsigned)(i * 16 + j)); ++cnt; }
#pragma unroll
        for (int q = 50; q < 64; ++q) cnd[q] = -INFINITY;
        float top[16];
#pragma unroll
        for (int c = 0; c < 4; ++c) { float ch[16];
#pragma unroll
            for (int q = 0; q < 16; ++q) ch[q] = cnd[16 * c + q];
            tk_sort16(ch);
            if (c == 0) {
#pragma unroll
                for (int q = 0; q < 16; ++q) top[q] = ch[q];
            } else tk_merge16(top, ch); }
        float sv[16]; int ei[16]; float mx = -INFINITY;
#pragma unroll
        for (int q = 0; q < 16; ++q) { const unsigned code = __float_as_uint(top[q]) & 0xFFu; const float va = la[code >> 4], vb = lb[code & 15u];
            ei[q] = (int)((__float_as_uint(va) & 0x7Fu) * 128u + (__float_as_uint(vb) & 0x7Fu)); sv[q] = va + vb; mx = fmaxf(mx, sv[q]); }
        float sum = 0.f;
#pragma unroll
        for (int q = 0; q < 16; ++q) { sv[q] = fexp(sv[q] - mx); sum += sv[q]; }
        const float inv = 1.f / sum;
#pragma unroll
        for (int q = 0; q < 16; q += 4) { *(GAS v4u*)(IDX_ + o + q) = (v4u){(unsigned)ei[q], (unsigned)ei[q + 1], (unsigned)ei[q + 2], (unsigned)ei[q + 3]};
            *(GAS f32x4*)(GATEW_ + o + q) = (f32x4){sv[q] * inv, sv[q + 1] * inv, sv[q + 2] * inv, sv[q + 3] * inv}; }
    }
struct EpiTopK {
    static constexpr bool PERM = false, AFTER_DRAIN = true;
    int* IDX; float* GATEW;
    DI void fused(f32x4 (&acc)[2][2][4][2], const pg8::Unit& u, int wr, int wc, int fr, int fq, LAS unsigned char* lds, int wid, int lane) const {
        LAS float* Tl = (LAS float*)lds;
        LAS float* Lh2 = (LAS float*)lds;
        LAS float* Ls = (LAS float*)(lds + 36864);
        const int tid = wid * 64 + lane, tl = tid & 127, p = (tid >> 7) & 1, half = tid >> 8;
#pragma unroll
        for (int ai = 0; ai < 2; ++ai) {
#pragma unroll
            for (int bj = 0; bj < 2; ++bj)
#pragma unroll
                for (int m = 0; m < 4; ++m)
#pragma unroll
                    for (int n = 0; n < 2; ++n) { LAS float* d = Tl + (wr * 64 + m * 16 + fr) * 257 + bj * 128 + wc * 32 + n * 16 + fq * 4; const f32x4 v = acc[ai][bj][m][n]; d[0] = v.x; d[1] = v.y; d[2] = v.z; d[3] = v.w; }
            __syncthreads();
            float run[16];
            {
                const LAS float* src = Tl + tl * 257 + p * 128 + half * 64;
#pragma unroll
                for (int c = 0; c < 4; ++c) { float ch[16];
#pragma unroll
                    for (int q = 0; q < 16; ++q) ch[q] = __uint_as_float((__float_as_uint(src[16 * c + q]) & ~0x7Fu) | (unsigned)(half * 64 + 16 * c + q));
                    tk_sort16(ch);
                    if (c == 0) {
#pragma unroll
                        for (int q = 0; q < 16; ++q) run[q] = ch[q];
                    } else tk_merge16(run, ch); }
            }
            __syncthreads();
#pragma unroll
            for (int q = 0; q < 16; ++q) Lh2[((tl * 2 + p) * 2 + half) * 17 + q] = run[q];
            __syncthreads();
            if (half == 0) { float oth[16];
#pragma unroll
                for (int q = 0; q < 16; ++q) oth[q] = Lh2[((tl * 2 + p) * 2 + 1) * 17 + q];
                tk_merge16(run, oth);
#pragma unroll
                for (int q = 0; q < 16; ++q) Ls[(tl * 2 + p) * 17 + q] = run[q]; }
            __syncthreads();
            if (tid < 128) tk_stage2(Ls + (tl * 2) * 17, Ls + (tl * 2) * 17 + 17, IDX, GATEW, (size_t)(u.pm * 256 + ai * 128 + tl) * 128 + u.pn * 16);
            __syncthreads();
        }
    }
};
struct OneUnit {
    pg8::Unit u;
    __device__ __forceinline__ bool next(int i, pg8::Unit& o) const { if (i) return false; o = u; return true; }
    __device__ __forceinline__ void a_ready(const pg8::Unit&) const {}
    __device__ __forceinline__ void done(const pg8::Unit&) const {}
};

DI float gelu_erf(float x) { return 0.5f * x * (1.f + erff(x * 0.7071067811865476f)); }
#define DPP_ADD(v, ctrl, rmask) ((v) + __builtin_bit_cast(float, __builtin_amdgcn_update_dpp(0, __builtin_bit_cast(int, (v)), (ctrl), (rmask), 0xF, false)))
#ifndef PEER_EBL
#define PEER_EBL 9
#endif
constexpr int PEER_EB_LOG = PEER_EBL;
#ifndef PEER_PROBE_MASK
#define PEER_PROBE_MASK 0xFFFF
#endif
typedef float f32x2v __attribute__((ext_vector_type(2)));
DI float gelu_cdf(float v) {
    const float av = fabsf(v), t = __builtin_amdgcn_rcpf(av * 0.2316418882f + 1.0f);
    float q = t * 0.5307027145f - 0.7265760135f; q = q * t + 0.7107068705f; q = q * t - 0.142248368f; q = q * t + 0.127414796f; q = q * t;
    const float m = v * (q * ex2(v * v * -0.72134752044f));
    return v < 0.f ? m : v - m;
}
#define DPP_ADDI(v, ctrl, rmask) ((v) + __builtin_amdgcn_update_dpp(0, (v), (ctrl), (rmask), 0xF, false))
DI void peer_phase(const Frame& F, bool scratch_dst) {
    bf16* const XN_ = WSP(bf16, WS_XN); int* const IDX_ = WSP(int, WS_IDX); float* const GATEW_ = WSP(float, WS_GATE); float* const mod_ = WSP(float, WS_MOD); float* const out_ = (float*)inp(I_OUT);
    const unsigned char* const EU4 = WSP(unsigned char, WS_EXPU); const unsigned char* const EV4 = WSP(unsigned char, WS_EXPV); const float* const SUI_ = WSP(float, WS_SUI); const float* const SVI_ = WSP(float, WS_SVI);
    const int gw = F.vcu * NWAVES + F.wave, NGW = F.G * NWAVES, lane = F.lane, g = lane >> 3, j = lane & 7;
    LAS unsigned char* wl = F.lds + F.wave * 16384;
    volatile LAS int* Le = (volatile LAS int*)(wl + g * 512); volatile LAS float* Lg = (volatile LAS float*)(wl + 4096 + g * 512); volatile LAS int* Lp = (volatile LAS int*)(wl + 8192 + g * 512);
    LAS int* Lh = (LAS int*)(wl + 12288 + g * 128);
    for (int grp = gw; grp < T / 8; grp += NGW) {
        const size_t t = (size_t)grp * 8 + g;
        int xh[16], xl[16]; float sxi;
        {
            float mx = 0.f;
            const bf16* xrow = XN_ + t * D + 8 * j;
#pragma unroll
            for (int kq = 0; kq < 16; ++kq) { const v4u a = *(const GAS v4u*)(xrow + 64 * kq);
#pragma unroll
                for (int e = 0; e < 4; ++e) mx = fmaxf(mx, fmaxf(fabsf(bflo(a[e])), fabsf(bfhi(a[e])))); }
            mx = fmaxf(mx, __shfl_xor(mx, 1, 8)); mx = fmaxf(mx, __shfl_xor(mx, 2, 8)); mx = fmaxf(mx, __shfl_xor(mx, 4, 8));
            const float sx = mx > 0.f ? 119.f / mx : 0.f; sxi = mx > 0.f ? mx / 119.f : 0.f;
#pragma unroll
            for (int q = 0; q < 4; ++q)
#pragma unroll
                for (int kp = 0; kp < 2; ++kp) { const v4u a = *(const GAS v4u*)(xrow + 64 * (8 * kp + q)), b = *(const GAS v4u*)(xrow + 64 * (8 * kp + 4 + q));
#pragma unroll
                    for (int wh = 0; wh < 2; ++wh) {
                        const int t0 = (int)rintf(bflo(a[2 * wh]) * sx) + 8, t1 = (int)rintf(bfhi(a[2 * wh]) * sx) + 8, t2 = (int)rintf(bflo(a[2 * wh + 1]) * sx) + 8, t3 = (int)rintf(bfhi(a[2 * wh + 1]) * sx) + 8;
                        const int t4 = (int)rintf(bflo(b[2 * wh]) * sx) + 8, t5 = (int)rintf(bfhi(b[2 * wh]) * sx) + 8, t6 = (int)rintf(bflo(b[2 * wh + 1]) * sx) + 8, t7 = (int)rintf(bfhi(b[2 * wh + 1]) * sx) + 8;
                        const unsigned lo_ = (unsigned)(t0 & 15) | ((unsigned)(t1 & 15) << 4) | ((unsigned)(t2 & 15) << 8) | ((unsigned)(t3 & 15) << 12) | ((unsigned)(t4 & 15) << 16) | ((unsigned)(t5 & 15) << 20) | ((unsigned)(t6 & 15) << 24) | ((unsigned)(t7 & 15) << 28);
                        const unsigned hi_ = (unsigned)((t0 >> 4) & 15) | ((unsigned)((t1 >> 4) & 15) << 4) | ((unsigned)((t2 >> 4) & 15) << 8) | ((unsigned)((t3 >> 4) & 15) << 12) | ((unsigned)((t4 >> 4) & 15) << 16) | ((unsigned)((t5 >> 4) & 15) << 20) | ((unsigned)((t6 >> 4) & 15) << 24) | ((unsigned)((t7 >> 4) & 15) << 28);
                        xl[4 * q + kp + 2 * wh] = (int)(lo_ ^ 0x88888888u); xh[4 * q + kp + 2 * wh] = (int)hi_; } }
        }
        {
            int ide[16]; float gte[16]; int rk[16];
#pragma unroll
            for (int m = 0; m < 16; ++m) { ide[m] = IDX_[t * 128 + j + 8 * m]; gte[m] = GATEW_[t * 128 + j + 8 * m]; }
#pragma unroll
            for (int m = 0; m < 4; ++m) Lh[j + 8 * m] = 0;
#pragma unroll
            for (int m = 0; m < 16; ++m) rk[m] = __hip_atomic_fetch_add(Lh + (ide[m] >> PEER_EB_LOG), 1, __ATOMIC_RELAXED, __HIP_MEMORY_SCOPE_WORKGROUP);
            {
                const int h0 = ((volatile LAS int*)Lh)[4 * j], h1 = ((volatile LAS int*)Lh)[4 * j + 1], h2 = ((volatile LAS int*)Lh)[4 * j + 2], h3 = ((volatile LAS int*)Lh)[4 * j + 3];
                const int tot = (h0 + h1) + (h2 + h3); int inc = tot;
#pragma unroll
                for (int o = 1; o < 8; o <<= 1) { const int tt = __shfl_up(inc, o, 8); if (j >= o) inc += tt; }
                const int ex = inc - tot;
                ((volatile LAS int*)Lh)[4 * j] = ex; ((volatile LAS int*)Lh)[4 * j + 1] = ex + h0; ((volatile LAS int*)Lh)[4 * j + 2] = ex + h0 + h1; ((volatile LAS int*)Lh)[4 * j + 3] = ex + h0 + h1 + h2;
            }
#pragma unroll
            for (int m = 0; m < 16; ++m) { const int pos = ((volatile LAS int*)Lh)[ide[m] >> PEER_EB_LOG] + rk[m]; Le[pos] = ide[m]; Lg[pos] = gte[m] * SVI_[ide[m]]; Lp[pos] = __builtin_bit_cast(int, SUI_[ide[m]] * sxi); }
        }
        v4u R0[4], R1[4], R2[4], R3[4];
#define PEER_LOADU(RR, S0) do { const size_t ro_ = (size_t)(Le[(S0)] & (scratch_dst ? PEER_PROBE_MASK : 0xFFFF)) * 512 + 16 * j; _Pragma("unroll") for (int q = 0; q < 4; ++q) RR[q] = *(const GAS v4u*)(EU4 + ro_ + 128 * q); } while (0)
#define PEER_DOTU(RR, EOUT) do { int h0_ = 0, h1_ = 0, l0_ = 0, l1_ = 0; \
            _Pragma("unroll") for (int q = 0; q < 4; q += 2) _Pragma("unroll") for (int w_ = 0; w_ < 4; ++w_) { \
                h0_ = __builtin_amdgcn_sdot8((int)RR[q][w_], xh[4 * q + w_], h0_, false); l0_ = __builtin_amdgcn_sdot8((int)RR[q][w_], xl[4 * q + w_], l0_, false); \
                h1_ = __builtin_amdgcn_sdot8((int)RR[q + 1][w_], xh[4 * q + 4 + w_], h1_, false); l1_ = __builtin_amdgcn_sdot8((int)RR[q + 1][w_], xl[4 * q + 4 + w_], l1_, false); } \
            int e_ = ((h0_ + h1_) << 4) + (l0_ + l1_); e_ = DPP_ADDI(e_, 0xB1, 0xF); e_ = DPP_ADDI(e_, 0x4E, 0xF); e_ = DPP_ADDI(e_, 0x141, 0xF); EOUT = e_; } while (0)
#define PEER_SWEEPU(BODY0, BODY1, BODY2, BODY3) do { \
            PEER_LOADU(R0, 0); PEER_LOADU(R1, 1); PEER_LOADU(R2, 2); PEER_LOADU(R3, 3); \
            for (int s = 0; s < 128; s += 4) { \
                BODY0; if (s + 4 < 128) PEER_LOADU(R0, s + 4); \
                BODY1; if (s + 4 < 128) PEER_LOADU(R1, s + 5); \
                BODY2; if (s + 4 < 128) PEER_LOADU(R2, s + 6); \
                BODY3; if (s + 4 < 128) PEER_LOADU(R3, s + 7); } } while (0)
        float cmax = 0.f;
#define PEER_FIN(RR, SS) do { int e1_; PEER_DOTU(RR, e1_); const float cf__ = Lg[(SS)] * gelu_cdf((float)e1_ * __builtin_bit_cast(float, Lp[(SS)])); \
            Lg[(SS)] = cf__; cmax = fmaxf(cmax, fabsf(cf__)); } while (0)
        PEER_SWEEPU(PEER_FIN(R0, s), PEER_FIN(R1, s + 1), PEER_FIN(R2, s + 2), PEER_FIN(R3, s + 3));
#undef PEER_FIN
        const float cqs = cmax > 0.f ? 119.f / cmax : 0.f, yscale = cmax > 0.f ? cmax / 119.f : 0.f;
        {
            int pk_[4];
#pragma unroll
            for (int m = 0; m < 2; ++m) { const int bt_ = 2 * j + m; unsigned lo_ = 0u, hi_ = 0u;
#pragma unroll
                for (int n = 0; n < 8; ++n) { const int t_ = (int)rintf(Lg[8 * bt_ + n] * cqs) + 8; lo_ |= (unsigned)(t_ & 15) << (4 * n); hi_ |= (unsigned)((t_ >> 4) & 15) << (4 * n); }
                pk_[2 * m] = (int)(lo_ ^ 0x88888888u); pk_[2 * m + 1] = (int)hi_; }
#pragma unroll
            for (int m = 0; m < 4; ++m) Lp[4 * j + m] = pk_[m];
        }
#pragma unroll
        for (int H = 0; H < 2; ++H) {
            int yi[64];
#pragma unroll
            for (int i = 0; i < 64; ++i) yi[i] = 0;
            v4u RV[8][2];
#define PEER_ROFFV(S0) ((size_t)(Le[(S0)] & (scratch_dst ? PEER_PROBE_MASK : 0xFFFF)) * 512 + 256 * H + 16 * j)
#pragma unroll
            for (int r = 0; r < 8; ++r) { const size_t ro_ = PEER_ROFFV(r); RV[r][0] = *(const GAS v4u*)(EV4 + ro_); RV[r][1] = *(const GAS v4u*)(EV4 + ro_ + 128); }
            for (int bt = 0; bt < 16; ++bt) {
                const int cl_ = Lp[2 * bt], ch_ = Lp[2 * bt + 1];
                size_t ron[8];
#pragma unroll
                for (int r = 0; r < 8; ++r) ron[r] = (bt + 1 < 16) ? PEER_ROFFV(8 * bt + 8 + r) : 0;
#pragma unroll
                for (int q = 0; q < 2; ++q) {
#pragma unroll
                    for (int w_ = 0; w_ < 4; ++w_) {
                        unsigned E[4], O[4];
#pragma unroll
                        for (int p_ = 0; p_ < 4; ++p_) { const unsigned x_ = RV[2 * p_][q][w_], y_ = RV[2 * p_ + 1][q][w_];
                            E[p_] = (x_ & 0x0F0F0F0Fu) | ((y_ << 4) & 0xF0F0F0F0u); O[p_] = ((x_ >> 4) & 0x0F0F0F0Fu) | (y_ & 0xF0F0F0F0u); }
                        unsigned C[8];
                        { const unsigned p0 = __builtin_amdgcn_perm(E[1], E[0], 0x05010400u), p1 = __builtin_amdgcn_perm(E[1], E[0], 0x07030602u), p2 = __builtin_amdgcn_perm(E[3], E[2], 0x05010400u), p3 = __builtin_amdgcn_perm(E[3], E[2], 0x07030602u);
                          C[0] = __builtin_amdgcn_perm(p2, p0, 0x05040100u); C[2] = __builtin_amdgcn_perm(p2, p0, 0x07060302u); C[4] = __builtin_amdgcn_perm(p3, p1, 0x05040100u); C[6] = __builtin_amdgcn_perm(p3, p1, 0x07060302u); }
                        { const unsigned p0 = __builtin_amdgcn_perm(O[1], O[0], 0x05010400u), p1 = __builtin_amdgcn_perm(O[1], O[0], 0x07030602u), p2 = __builtin_amdgcn_perm(O[3], O[2], 0x05010400u), p3 = __builtin_amdgcn_perm(O[3], O[2], 0x07030602u);
                          C[1] = __builtin_amdgcn_perm(p2, p0, 0x05040100u); C[3] = __builtin_amdgcn_perm(p2, p0, 0x07060302u); C[5] = __builtin_amdgcn_perm(p3, p1, 0x05040100u); C[7] = __builtin_amdgcn_perm(p3, p1, 0x07060302u); }
#pragma unroll
                        for (int n = 0; n < 8; ++n) { const int th_ = __builtin_amdgcn_sdot8((int)C[n], ch_, 0, false);
                            yi[32 * q + 8 * w_ + n] = __builtin_amdgcn_sdot8((int)C[n], cl_, yi[32 * q + 8 * w_ + n], false) + (th_ << 4); }
                    }
                    if (bt + 1 < 16) {
#pragma unroll
                        for (int r = 0; r < 8; ++r) RV[r][q] = *(const GAS v4u*)(EV4 + ron[r] + 128 * q); }
                }
            }
#undef PEER_ROFFV
            const int b = (int)(t / SEQ);
            const float* g2 = mod_ + b * NMOD + 5120 + 128 * H + 8 * j;
            const float* ip = out_ + t * D + 128 * H + 8 * j; float* op = (scratch_dst ? WSP(float, WS_SCORES) : out_) + t * D + 128 * H + 8 * j;
#pragma unroll
            for (int q = 0; q < 2; ++q)
#pragma unroll
                for (int w_ = 0; w_ < 4; ++w_)
#pragma unroll
                    for (int nh = 0; nh < 2; ++nh) { const int co = 256 * (2 * (w_ & 1) + nh) + 64 * q + 4 * (w_ >> 1); const int yb = 32 * q + 8 * w_ + 4 * nh;
                        const f32x4 x1 = *(const GAS f32x4*)(ip + co); const f32x4 gg = *(const f32x4*)(g2 + co) * yscale;
                        f32x4 o; o.x = x1.x + gg.x * (float)yi[yb]; o.y = x1.y + gg.y * (float)yi[yb + 1]; o.z = x1.z + gg.z * (float)yi[yb + 2]; o.w = x1.w + gg.w * (float)yi[yb + 3];
                        *(GAS f32x4*)(op + co) = o; }
        }
#undef PEER_LOADU
#undef PEER_DOTU
#undef PEER_SWEEPU
    }
}

DI void ph_inproj(const Frame& F) {
    pg8::Gemm g{WSP(bf16, WS_XN), WSP(bf16, WS_WIN), T, NPROJ, D}; pg8::StaticOrder S; S.init(T, NPROJ, F.G, (int)blockIdx.x);
    pg8::EpiBf16<0> E{WSP(bf16, WS_PROJ), NPROJ, nullptr, 0, 0, 1.f};
    pg8::gemm_phase<pg8::EpiBf16<0>, pg8::StaticOrder, PG8_ALIGN, PG8_SP2>(F.lds, g, S, E);
}
DI void ph_mix(const Frame& F, bool probe_first) {
    stage_conv_w(F);
    {
        int u = F.vcu;
        MlLocalRegs ra;
        if (u < 2048) ml_local_load(F, u >> 6, u & 63, ra);
        const int gwv = F.vcu * NWAVES + F.wave, NGWv = F.G * NWAVES;
        int eb = 2 * gwv;
        while (u < 2048) {
            const int un = u + F.G;
            MlLocalRegs rb;
            if (un < 2048) ml_local_load(F, un >> 6, un & 63, rb);
            ExpRows2 er; const bool ew = eb < 32768;
            if (ew) exp_load2(F, eb, er);
            ml_local_unit(F, u >> 6, u & 63, ra);
            if (ew) exp_conv2(F, eb, er);
            eb += 2 * NGWv;
            ra = rb; u = un;
        }
        for (; eb < 32768; eb += 2 * NGWv) { ExpRows2 er; exp_load2(F, eb, er); exp_conv2(F, eb, er); }
    }
    (void)probe_first;
}
DI void ph_scan_attn(const Frame& F) {
    ml_scan_phase(F);
    __syncthreads();
    for (int u = F.vcu; u < 1024; u += F.G) { const int qb = 15 - (u >> 6), bh = u & 63; sb_unit(F, bh >> 3, bh & 7, qb); }
}
DI void ph_mlout(const Frame& F) { stage_conv_w(F); for (int u = F.vcu; u < 2048; u += F.G) ml_out_unit(F, u >> 6, u & 63); }
#ifndef P5_ALIGN
#define P5_ALIGN PG8_ALIGN
#endif
DI void ph_outproj(const Frame& F) {
    pg8::Gemm g{WSP(bf16, WS_MIX), WSP(bf16, WS_WOUT), T, D, D}; pg8::StaticOrder S; S.init(T, D, F.G, (int)blockIdx.x);
    pg8::EpiResGate E{inp(I_X), (float*)inp(I_OUT), WSP(float, WS_MOD) + 2048, NMOD, SEQ, D};
    pg8::gemm_phase<pg8::EpiResGate, pg8::StaticOrder, P5_ALIGN, PG8_SP2>(F.lds, g, S, E);
}
DI void ph_scores(const Frame& F) {
    pg8::Gemm g{WSP(bf16, WS_XN), WSP(bf16, WS_WEFF), T, NSC, D}; pg8::StaticOrder S; S.init(T, NSC, F.G, (int)blockIdx.x);
    EpiTopK E{WSP(int, WS_IDX), WSP(float, WS_GATE)};
    pg8::Unit un;
    for (int i = 0; S.next(i, un); ++i) { OneUnit S1{un}; pg8::gemm_phase<EpiTopK, OneUnit, false, PG8_SP2>(F.lds, g, S1, E); }
}
constexpr int N_PHASES = 11;
struct Args { const float* in[19]; float* out; unsigned char* ws; int ph_lo, ph_hi; };
__global__ void __launch_bounds__(NTHR, 2) hybrid_fwd(Args args) {
    extern __shared__ __attribute__((aligned(16))) unsigned char lds_raw[];
    Frame F;
    F.lds = (LAS unsigned char*)lds_raw;
    F.MISC = (volatile LAS unsigned*)(F.lds + LDSCTL_OFF + 320);
    F.tid = threadIdx.x; F.lane = F.tid & 63; F.wave = __builtin_amdgcn_readfirstlane(F.tid >> 6);
    F.G = gridDim.x; { const int bx = blockIdx.x; F.vcu = (F.G % 8 == 0) ? (bx % 8) * (F.G / 8) + bx / 8 : bx; }
    F.ws = args.ws;
    F.ctl = (gu32*)(F.ws + WS_CTL);
    for (int u = F.tid; u < (LDS_BYTES - LDSCTL_OFF) / 4; u += NTHR) ((LAS unsigned*)(F.lds + LDSCTL_OFF))[u] = 0u;
    __syncthreads();
    const int lo = args.ph_lo, hi = args.ph_hi;
    const bool one_launch = (hi - lo) > 1;
    XcdBarrier bar; bar.bar = (unsigned*)(F.ctl + CW_BAR); bar.x = 0; bar.st = nullptr;
    if (one_launch) bar = xcd_barrier_post((unsigned*)(F.ctl + CW_BAR), F.MISC + 8);
#ifndef PHMASK
#define PHMASK 0x7ff
#endif
#define IN(k) (((PHMASK >> (k)) & 1) && lo <= (k) && (k) < hi)
#define SEAM(k) do { if (IN(k) && IN((k) + 1)) xcd_barrier(bar); } while (0)
#ifndef REPMASK
#define REPMASK 0
#endif

#define RUN(k, ...) do { if (IN(k)) { if ((REPMASK >> (k)) & 1) { { const bool first = true; (void)first; __VA_ARGS__; } xcd_barrier(bar); } { const bool first = false; (void)first; __VA_ARGS__; } } } while (0)
    RUN(0, p0_phase(F, first ? P0_PARTS : 15)); SEAM(0);
    RUN(1, norm_phase<true>(F, inp(I_X), inp(I_GN1), 0, 1024)); SEAM(1);
    RUN(2, ph_inproj(F)); SEAM(2);
    RUN(3, ph_mix(F, first)); SEAM(3);
    RUN(10, ph_scan_attn(F)); if (IN(10) && IN(4)) xcd_barrier(bar);
    RUN(4, ph_mlout(F)); SEAM(4);
    RUN(5, ph_outproj(F)); SEAM(5);
    RUN(6, norm_phase<false>(F, inp(I_OUT), inp(I_GN2), 3072, 4096)); SEAM(6);
    RUN(7, ph_scores(F)); if (IN(7) && IN(9)) xcd_barrier(bar);
    RUN(9, peer_phase(F, first));
#undef RUN
#undef IN
#undef SEAM
}

#ifndef MK_PER_PHASE
#define MK_PER_PHASE 0
#endif
extern "C" void kernel_launch(void* const* d_in, const int* in_sizes, int n_in, void* d_out, int out_size, void* d_ws, size_t ws_size, hipStream_t stream) {
    static int grid = 0;
    if (grid == 0) {
        if (n_in != 19 || in_sizes[0] != T * D || out_size != T * D || ws_size < WS_END) { fprintf(stderr, "kernel_launch: unexpected shapes (n_in %d, in0 %d, out %d, ws %zu)\n", n_in, n_in > 0 ? in_sizes[0] : -1, out_size, ws_size); grid = -1; return; }
        int dev = 0, cus = 0, per_cu = 0;
        if (hipGetDevice(&dev) != hipSuccess || hipDeviceGetAttribute(&cus, hipDeviceAttributeMultiprocessorCount, dev) != hipSuccess) { grid = -1; return; }
        if (hipFuncSetAttribute((const void*)hybrid_fwd, hipFuncAttributeMaxDynamicSharedMemorySize, LDS_BYTES) != hipSuccess) { fprintf(stderr, "kernel_launch: hipFuncSetAttribute failed\n"); grid = -1; return; }
        if (hipOccupancyMaxActiveBlocksPerMultiprocessor(&per_cu, (const void*)hybrid_fwd, NTHR, LDS_BYTES) != hipSuccess || per_cu < 1) fprintf(stderr, "kernel_launch: occupancy query says %d\n", per_cu);
        (void)hipGetLastError();
        grid = cus;
    }
    if (grid < 0) return;
    if (hipMemsetAsync((char*)d_ws + WS_CTL, 0, CTL_ZERO_BYTES, stream) != hipSuccess) { fprintf(stderr, "kernel_launch: memset failed\n"); return; }
    Args a{};
    for (int i = 0; i < 19; ++i) a.in[i] = (const float*)d_in[i];
    a.out = (float*)d_out; a.ws = (unsigned char*)d_ws;
#if MK_PER_PHASE
    { const int order[N_PHASES] = {0, 1, 2, 3, 10, 4, 5, 6, 7, 8, 9}; for (int i = 0; i < N_PHASES; ++i) { a.ph_lo = order[i]; a.ph_hi = order[i] + 1; hipLaunchKernelGGL(hybrid_fwd, dim3(grid), dim3(NTHR), LDS_BYTES, stream, a); } }
#else
    a.ph_lo = 0; a.ph_hi = N_PHASES;
    hipLaunchKernelGGL(hybrid_fwd, dim3(grid), dim3(NTHR), LDS_BYTES, stream, a);
#endif
    const hipError_t le = hipPeekAtLastError();
    if (le != hipSuccess) fprintf(stderr, "kernel_launch: launch failed: %s\n", hipGetErrorName(le));
}
```

```cpp
#include <cmath>
#include <hip/hip_runtime.h>
#include <cstdio>
#include <cstdint>
namespace pg8 {
#define PG8_LAS __attribute__((address_space(3)))
typedef unsigned short bf16_t;
typedef short bf16x8 __attribute__((ext_vector_type(8)));
typedef float f32x4 __attribute__((ext_vector_type(4)));
typedef unsigned u32x4 __attribute__((ext_vector_type(4)));
constexpr int BM = 256, BK = 64, HALF = 128, HTB = HALF * BK * 2  , STAGE_BYTES = 8 * HTB, NXCD = 8,
#ifndef PG8_WGM
#define PG8_WGM 4
#endif
WGM = PG8_WGM;

__host__ __device__ __forceinline__ int lds_byte(int r, int c) { const int st = (r >> 4) * 2 + (c >> 5), rr = r & 15, cc = c & 31, ob = rr * 64 + cc * 2; return st * 1024 + (ob ^ (((ob >> 9) & 1) << 5)); }
__host__ __device__ __forceinline__ void stage_rc(int b, int& R, int& C) { const int st = b / 1024, sb = b % 1024, swz = sb ^ (((sb >> 9) & 1) << 5); R = (st >> 1) * 16 + swz / 64; C = (st & 1) * 32 + (swz % 64) / 2; }
__host__ __device__ __forceinline__ int perm32(int rho) { const int n = rho >> 4, i = rho & 15; return 8 * (i >> 2) + 4 * n + (i & 3); }

struct Unit { int pm, pn; };
struct Gemm { const bf16_t* A; const bf16_t* Bt; int M, N, K; };

struct StaticOrder {
    int nM, nN, nwg, G, c;
    __host__ __device__ void init(int M, int N, int G_, int c_) { nM = M / BM; nN = N / BM; nwg = nM * nN; G = G_; c = c_; }
    __host__ __device__ bool next(int i, Unit& u) const {
        const long L = (long)i * G + c; if (L >= nwg) return false;
        int wgid = (int)L; { const int q = nwg / NXCD, r = nwg % NXCD, xcd = wgid % NXCD, off = wgid / NXCD; wgid = (xcd < r ? xcd * (q + 1) : r * (q + 1) + (xcd - r) * q) + off; }
        const int nig = WGM * nN, gid = wgid / nig, fm = gid * WGM, gsz = (nM - fm) < WGM ? (nM - fm) : WGM;
        u.pm = fm + ((wgid % nig) % gsz); u.pn = (wgid % nig) / gsz; return true;
    }
    __device__ __forceinline__ void a_ready(const Unit&) const {}
    __device__ __forceinline__ void done(const Unit&) const {}
};

__device__ __forceinline__ unsigned cvt_pk_bf16(float lo, float hi) { unsigned r; asm volatile("v_cvt_pk_bf16_f32 %0, %1, %2" : "=v"(r) : "v"(lo), "v"(hi)); return r; }
typedef float f32x2 __attribute__((ext_vector_type(2)));
__device__ __forceinline__ f32x2 gelu_pk(f32x2 v) {
    const f32x2 av = __builtin_elementwise_abs(v), d = av * 0.2316418882f + 1.0f;
    f32x2 t; t.x = __builtin_amdgcn_rcpf(d.x); t.y = __builtin_amdgcn_rcpf(d.y);
    f32x2 q = t * 0.5307027145f + (-0.7265760135f); q = q * t + 0.7107068705f; q = q * t + (-0.142248368f); q = q * t + 0.127414796f; q = q * t;
    const f32x2 s = (v * v) * (-0.72134752044f);
    f32x2 e; e.x = __builtin_amdgcn_exp2f(s.x); e.y = __builtin_amdgcn_exp2f(s.y);
    const f32x2 m = v * (q * e), r = v - m;
    f32x2 o; o.x = v.x < 0.f ? m.x : r.x; o.y = v.y < 0.f ? m.y : r.y; return o;
}

template <int ACT  > struct EpiBf16 {
    static constexpr bool PERM = true, AFTER_DRAIN = false; static_assert(ACT == 0 || ACT == 1, "EpiBf16: ACT is 0 (none) or 1 (gelu_pk)");
    bf16_t* O; int ldc; const float* bias; int split_cols; size_t split_stride; float scale0;
    __device__ __forceinline__ void operator()(const f32x4 (&acc)[2][2][4][2], const Unit& u, int wr, int wc, int fr, int fq) const {
        const int row0 = u.pm * BM + wr * 64 + fr; int colt = u.pn * BM; bf16_t* base = O;
        float sc = 1.f; if (split_cols) { const int t = colt / split_cols; base += (size_t)t * split_stride; colt -= t * split_cols; if (t == 0) sc = scale0; }
        const int col0 = colt + wc * 32 + 8 * fq, bcol0 = u.pn * BM + wc * 32 + 8 * fq;
        f32x4 bv[2][2];
#pragma unroll
        for (int bj = 0; bj < 2; ++bj)
#pragma unroll
            for (int n = 0; n < 2; ++n) bv[bj][n] = bias ? *(const f32x4*)(bias + bcol0 + bj * HALF + 4 * n) : (f32x4){0.f, 0.f, 0.f, 0.f};
#pragma unroll
        for (int ai = 0; ai < 2; ++ai)
#pragma unroll
            for (int m = 0; m < 4; ++m) { bf16_t* rowp = base + (size_t)(row0 + ai * HALF + m * 16) * ldc + col0;
#pragma unroll
                for (int bj = 0; bj < 2; ++bj) { f32x4 v0 = acc[ai][bj][m][0] + bv[bj][0], v1 = acc[ai][bj][m][1] + bv[bj][1];
                    if (ACT == 1) { f32x2 a = gelu_pk((f32x2){v0[0], v0[1]}), b = gelu_pk((f32x2){v0[2], v0[3]}), c = gelu_pk((f32x2){v1[0], v1[1]}), d = gelu_pk((f32x2){v1[2], v1[3]});
                        v0 = (f32x4){a.x, a.y, b.x, b.y}; v1 = (f32x4){c.x, c.y, d.x, d.y}; }
                    v0 = v0 * sc; v1 = v1 * sc; u32x4 w; w.x = cvt_pk_bf16(v0[0], v0[1]); w.y = cvt_pk_bf16(v0[2], v0[3]); w.z = cvt_pk_bf16(v1[0], v1[1]); w.w = cvt_pk_bf16(v1[2], v1[3]);
                    *(u32x4*)(rowp + bj * HALF) = w; } }
    }
};
template <class Epi, class Sched, bool ALIGN_EPI = false, bool SP2 = false>
__device__ __forceinline__ void gemm_phase(PG8_LAS unsigned char* lds, const Gemm g, const Sched& S, const Epi& E) {
    const int tid = threadIdx.x, wid = __builtin_amdgcn_readfirstlane(tid >> 6), lane = tid & 63, wr = wid >> 2, wc = wid & 3, fr = lane & 15, fq = lane >> 4;
    const int K = g.K, nt = K / BK;
    unsigned voffA[2], voffB[2];
#pragma unroll
    for (int i = 0; i < 2; ++i) { int R, C; stage_rc(tid * 16 + i * 8192, R, C); const int Rb = Epi::PERM ? ((R & ~31) + perm32(R & 31)) : R;
        voffA[i] = (unsigned)(R * K + C) * 2u; voffB[i] = (unsigned)(Rb * K + C) * 2u; }
    const size_t kstep = (size_t)(BK * 2);
    const size_t hstep = (size_t)HALF * K * 2;
    const size_t tstep = 2 * hstep;
    const unsigned ldsw = (unsigned)wid * 1024u;
    const int aoff = lds_byte(wr * 64 + fr, fq * 8), boff = lds_byte(wc * 32 + fr, fq * 8);
#define PG8_SA(b, h) (((b) * 2 + (h)) * HTB)
#define PG8_SB(b, h) ((4 + (b) * 2 + (h)) * HTB)
#define PG8_STAGE(bufoff, gbase, voff) do { _Pragma("unroll") for (int _i = 0; _i < 2; ++_i) \
        __builtin_amdgcn_global_load_lds((const unsigned*)((const char*)(gbase) + (voff)[_i]), (PG8_LAS unsigned*)(lds + (bufoff) + ldsw + _i * 8192), 16, 0, 0); } while (0)
#define PG8_LDA(dst, b, h) do { _Pragma("unroll") for (int m = 0; m < 4; ++m) _Pragma("unroll") for (int k = 0; k < 2; ++k) dst[m][k] = *(const PG8_LAS bf16x8*)(lds + PG8_SA(b, h) + aoff + m * 2048 + k * 1024); } while (0)
#define PG8_LDB(dst, b, h) do { _Pragma("unroll") for (int n = 0; n < 2; ++n) _Pragma("unroll") for (int k = 0; k < 2; ++k) dst[n][k] = *(const PG8_LAS bf16x8*)(lds + PG8_SB(b, h) + boff + n * 2048 + k * 1024); } while (0)
#define PG8_MMA(ai, bj, At, Bt) do { __builtin_amdgcn_s_setprio(1); _Pragma("unroll") for (int m = 0; m < 4; ++m) _Pragma("unroll") for (int n = 0; n < 2; ++n) _Pragma("unroll") for (int k = 0; k < 2; ++k) \
        acc[ai][bj][m][n] = __builtin_amdgcn_mfma_f32_16x16x32_bf16(Bt[n][k], At[m][k], acc[ai][bj][m][n], 0, 0, 0); __builtin_amdgcn_s_setprio(0); } while (0)
#define PG8_WAIT_V(n) asm volatile("s_waitcnt vmcnt(" #n ")" ::: "memory")
#define PG8_WAIT_L(n) asm volatile("s_waitcnt lgkmcnt(" #n ")" ::: "memory")
#define PG8_BAR __builtin_amdgcn_s_barrier()
#define PG8_SCHED __builtin_amdgcn_sched_barrier(0)
    Unit cur, nxt; int ui = 0;
    if (!S.next(0, cur)) return;
    f32x4 acc[2][2][4][2];
#pragma unroll
    for (int a = 0; a < 2; ++a)
#pragma unroll
        for (int b = 0; b < 2; ++b)
#pragma unroll
            for (int m = 0; m < 4; ++m)
#pragma unroll
                for (int n = 0; n < 2; ++n) acc[a][b][m][n] = (f32x4){0.f, 0.f, 0.f, 0.f};
    bf16x8 At[4][2], B0[2][2], B1[2][2];
    const char* cA = (const char*)g.A + (size_t)cur.pm * tstep; const char* cB = (const char*)g.Bt + (size_t)cur.pn * tstep;
    S.a_ready(cur);
    if constexpr (SP2) {
        PG8_STAGE(PG8_SB(0, 0), cB, voffB); PG8_STAGE(PG8_SB(0, 1), cB + hstep, voffB); PG8_STAGE(PG8_SA(0, 0), cA, voffA); PG8_STAGE(PG8_SA(0, 1), cA + hstep, voffA);
        if (wr == 1) PG8_BAR;
        PG8_WAIT_V(2); PG8_BAR;
        PG8_STAGE(PG8_SB(1, 0), cB + kstep, voffB); PG8_STAGE(PG8_SA(1, 0), cA + kstep, voffA); PG8_STAGE(PG8_SB(1, 1), cB + hstep + kstep, voffB);
        PG8_WAIT_V(6); PG8_BAR;
    } else {
        PG8_STAGE(PG8_SB(0, 0), cB, voffB); PG8_STAGE(PG8_SA(0, 0), cA, voffA); PG8_STAGE(PG8_SB(0, 1), cB + hstep, voffB); PG8_STAGE(PG8_SA(0, 1), cA + hstep, voffA);
        if (wr == 1) PG8_BAR;
        PG8_WAIT_V(4); PG8_BAR;
        PG8_STAGE(PG8_SB(1, 0), cB + kstep, voffB); PG8_STAGE(PG8_SA(1, 0), cA + kstep, voffA); PG8_STAGE(PG8_SB(1, 1), cB + hstep + kstep, voffB);
        PG8_WAIT_V(6); PG8_BAR;
    }
    for (;;) {
        const bool has_next = S.next(ui + 1, nxt);
        const char* nA = has_next ? (const char*)g.A + (size_t)nxt.pm * tstep : cA; const char* nB = has_next ? (const char*)g.Bt + (size_t)nxt.pn * tstep : cB;
        for (int t = 0; t < nt; t += 2) {
            const bool last = (t == nt - 2);
            const char* a1 = cA + (size_t)(t + 1) * kstep;
            const char* a2 = last ? nA : cA + (size_t)(t + 2) * kstep; const char* b2 = last ? nB : cB + (size_t)(t + 2) * kstep;
            const char* a3 = a2 + kstep; const char* b3 = b2 + kstep;
            if (last && has_next) S.a_ready(nxt);
            if constexpr (SP2) {
            PG8_LDB(B0, 0, 0); PG8_LDB(B1, 0, 1); PG8_SCHED; PG8_LDA(At, 0, 0); PG8_STAGE(PG8_SA(1, 1), a1 + hstep, voffA);
            PG8_WAIT_V(8); PG8_WAIT_L(0); PG8_BAR; PG8_MMA(0, 0, At, B0); PG8_MMA(0, 1, At, B1); PG8_BAR; PG8_SCHED;
            PG8_LDA(At, 0, 1); PG8_STAGE(PG8_SB(0, 0), b2, voffB); PG8_STAGE(PG8_SB(0, 1), b2 + hstep, voffB); PG8_STAGE(PG8_SA(0, 0), a2, voffA);
            PG8_WAIT_V(8); PG8_WAIT_L(0); PG8_BAR; PG8_MMA(1, 0, At, B0); PG8_MMA(1, 1, At, B1); PG8_BAR; PG8_SCHED;
            PG8_LDB(B0, 1, 0); PG8_LDB(B1, 1, 1); PG8_SCHED; PG8_LDA(At, 1, 0); PG8_STAGE(PG8_SA(0, 1), a2 + hstep, voffA);
            PG8_WAIT_V(8); PG8_WAIT_L(0); PG8_BAR; PG8_MMA(0, 0, At, B0); PG8_MMA(0, 1, At, B1); PG8_BAR; PG8_SCHED;
            PG8_LDA(At, 1, 1); PG8_STAGE(PG8_SB(1, 0), b3, voffB); PG8_STAGE(PG8_SB(1, 1), b3 + hstep, voffB); PG8_STAGE(PG8_SA(1, 0), a3, voffA);
            PG8_WAIT_V(8); PG8_WAIT_L(0); PG8_BAR; PG8_MMA(1, 0, At, B0); PG8_MMA(1, 1, At, B1); PG8_BAR; PG8_SCHED;
            } else {
            PG8_LDB(B0, 0, 0); PG8_SCHED; PG8_LDA(At, 0, 0); PG8_STAGE(PG8_SA(1, 1), a1 + hstep, voffA);
            PG8_WAIT_L(8); PG8_BAR; PG8_WAIT_L(0); PG8_MMA(0, 0, At, B0); PG8_BAR; PG8_SCHED;
            PG8_LDB(B1, 0, 1); PG8_STAGE(PG8_SB(0, 0), b2, voffB);
            PG8_BAR; PG8_WAIT_L(0); PG8_MMA(0, 1, At, B1); PG8_BAR;
            PG8_LDA(At, 0, 1); PG8_STAGE(PG8_SA(0, 0), a2, voffA);
            PG8_BAR; PG8_WAIT_L(0); PG8_MMA(1, 0, At, B0); PG8_BAR; PG8_SCHED;
            PG8_STAGE(PG8_SB(0, 1), b2 + hstep, voffB);
            PG8_WAIT_V(6); PG8_BAR; PG8_MMA(1, 1, At, B1); PG8_BAR;
            PG8_LDB(B0, 1, 0); PG8_SCHED; PG8_LDA(At, 1, 0); PG8_STAGE(PG8_SA(0, 1), a2 + hstep, voffA);
            PG8_WAIT_L(8); PG8_BAR; PG8_WAIT_L(0); PG8_MMA(0, 0, At, B0); PG8_BAR; PG8_SCHED;
            PG8_LDB(B1, 1, 1); PG8_STAGE(PG8_SB(1, 0), b3, voffB);
            PG8_BAR; PG8_WAIT_L(0); PG8_MMA(0, 1, At, B1); PG8_BAR;
            PG8_LDA(At, 1, 1); PG8_STAGE(PG8_SA(1, 0), a3, voffA);
            PG8_BAR; PG8_WAIT_L(0); PG8_MMA(1, 0, At, B0); PG8_BAR; PG8_SCHED;
            PG8_STAGE(PG8_SB(1, 1), b3 + hstep, voffB);
            PG8_WAIT_V(6); PG8_BAR; PG8_MMA(1, 1, At, B1); PG8_BAR;
            }
        }
        if constexpr (ALIGN_EPI) { if (wr == 0) PG8_BAR; }
        if constexpr (!Epi::AFTER_DRAIN) { E(acc, cur, wr, wc, fr, fq); S.done(cur); }
        if (!has_next) break;
#pragma unroll
        for (int a = 0; a < 2; ++a)
#pragma unroll
            for (int b = 0; b < 2; ++b)
#pragma unroll
                for (int m = 0; m < 4; ++m)
#pragma unroll
                    for (int n = 0; n < 2; ++n) acc[a][b][m][n] = (f32x4){0.f, 0.f, 0.f, 0.f};
        cur = nxt; cA = nA; cB = nB; ++ui;
        if constexpr (ALIGN_EPI) { if (wr == 1) PG8_BAR; }
    }
    PG8_WAIT_V(0);
    if constexpr (!ALIGN_EPI) { if (wr == 0) PG8_BAR; }
    PG8_BAR;
    if constexpr (Epi::AFTER_DRAIN) { E.fused(acc, cur, wr, wc, fr, fq, lds, wid, lane); S.done(cur); }
#undef PG8_SA
#undef PG8_SB
#undef PG8_STAGE
#undef PG8_LDA
#undef PG8_LDB
#undef PG8_MMA
#undef PG8_WAIT_V
#undef PG8_WAIT_L
#undef PG8_BAR
#undef PG8_SCHED
}
}

#ifndef PG8_SP2
#define PG8_SP2 true
#endif
#ifndef PG8_ALIGN
#define PG8_ALIGN true
#endif

namespace pg8 {
struct EpiResGate {
    static constexpr bool PERM = false, AFTER_DRAIN = false;
    const float* base; float* out; const float* gate; int gate_ld; int rows_per_batch; int ldc;
    __device__ __forceinline__ void operator()(const f32x4 (&acc)[2][2][4][2], const Unit& u, int wr, int wc, int fr, int fq) const {
        const int row0 = u.pm * BM + wr * 64 + fr, col0 = u.pn * BM + wc * 32 + 4 * fq;
        const float* gp = gate + (size_t)((u.pm * BM) / rows_per_batch) * gate_ld + col0;
        f32x4 gv[2][2];
#pragma unroll
        for (int bj = 0; bj < 2; ++bj)
#pragma unroll
            for (int n = 0; n < 2; ++n) gv[bj][n] = *(const f32x4*)(gp + bj * HALF + n * 16);
#pragma unroll
        for (int ai = 0; ai < 2; ++ai)
#pragma unroll
            for (int m = 0; m < 4; ++m) { const size_t off = (size_t)(row0 + ai * HALF + m * 16) * ldc + col0;
#pragma unroll
                for (int bj = 0; bj < 2; ++bj)
#pragma unroll
                    for (int n = 0; n < 2; ++n) { const f32x4 bs = *(const f32x4*)(base + off + bj * HALF + n * 16);
                        *(f32x4*)(out + off + bj * HALF + n * 16) = bs + gv[bj][n] * acc[ai][bj][m][n]; } }
    }
};
struct EpiF32 {
    static constexpr bool PERM = false, AFTER_DRAIN = false;
    float* O; int ldc;
    __device__ __forceinline__ void operator()(const f32x4 (&acc)[2][2][4][2], const Unit& u, int wr, int wc, int fr, int fq) const {
        const int row0 = u.pm * BM + wr * 64 + fr, col0 = u.pn * BM + wc * 32 + 4 * fq;
#pragma unroll
        for (int ai = 0; ai < 2; ++ai)
#pragma unroll
            for (int m = 0; m < 4; ++m) { const size_t off = (size_t)(row0 + ai * HALF + m * 16) * ldc + col0;
#pragma unroll
                for (int bj = 0; bj < 2; ++bj)
#pragma unroll
                    for (int n = 0; n < 2; ++n) *(f32x4*)(O + off + bj * HALF + n * 16) = acc[ai][bj][m][n]; }
    }
};
}
#define GAS __attribute__((address_space(1)))
#define LAS __attribute__((address_space(3)))
typedef unsigned short bf16;
typedef unsigned v4u __attribute__((ext_vector_type(4)));
typedef float f32x4 __attribute__((ext_vector_type(4)));
typedef short bf16x8 __attribute__((ext_vector_type(8)));
typedef GAS unsigned gu32;
typedef GAS unsigned long long gu64;
#define RLX_AGENT __ATOMIC_RELAXED, __HIP_MEMORY_SCOPE_AGENT
#define LDS_WAIT() asm volatile("s_waitcnt lgkmcnt(0)" ::: "memory")
#define VM_WAIT() asm volatile("s_waitcnt vmcnt(0)" ::: "memory")
__device__ __forceinline__ unsigned long long rt() { return __builtin_amdgcn_s_memrealtime(); }
__device__ __forceinline__ unsigned f2bf(float f) { unsigned u = __builtin_bit_cast(unsigned, f); return (u + 0x7fffu + ((u >> 16) & 1u)) >> 16; }
__device__ __forceinline__ unsigned pk2(float lo, float hi) { return f2bf(lo) | (f2bf(hi) << 16); }

#define XB_TMO      128
#define XB_XCNT(j)  (256  + 64 * (j))
#define XB_XSUB(j)  (1280 + 64 * (j))
#define XB_XGEN(j)  (2304 + 64 * (j))
#define XB_TOP      3328
#define XB_TOPGEN   3392
#define XCD_BAR_WORDS 3456
#define XB_SPIN_CAP (1u << 24)

__device__ __forceinline__ unsigned xb_ld(unsigned* p)              { return __hip_atomic_load(p, __ATOMIC_RELAXED, __HIP_MEMORY_SCOPE_AGENT); }
__device__ __forceinline__ unsigned xb_add(unsigned* p, unsigned v) { return __hip_atomic_fetch_add(p, v, __ATOMIC_RELAXED, __HIP_MEMORY_SCOPE_AGENT); }
__device__ __forceinline__ unsigned xb_xcc_id() { return (unsigned)__builtin_amdgcn_s_getreg((3 << 11) | 20) & 0xFu; }
#define XB_SPIN(cond, bar) do { unsigned _sp = 0; while (cond) { __builtin_amdgcn_s_sleep(1); \
    if ((++_sp & 255u) == 0u) { if (xb_ld(&(bar)[XB_TMO])) break; if (_sp > XB_SPIN_CAP) { atomicAdd(&(bar)[XB_TMO], 1u); break; } } } } while (0)

struct XcdBarrier {
    unsigned* bar; unsigned x;
    volatile LAS unsigned* st;
};

__device__ __forceinline__ XcdBarrier xcd_barrier_post(unsigned* bar, volatile LAS unsigned* st) {
    XcdBarrier b; b.bar = bar; b.x = xb_xcc_id(); b.st = st;
    if (threadIdx.x == 0) (void)xb_add(&bar[XB_XCNT(b.x)], 1u);
    return b;
}
__device__ __forceinline__ void xcd_barrier_complete(unsigned* bar, unsigned x, unsigned& nloc, unsigned& nx) {
    const unsigned G = gridDim.x * gridDim.y * gridDim.z;
    unsigned sum, cnt, mine, sp = 0u;
    for (;;) {
        sum = 0u; cnt = 0u; mine = 0u;
#pragma unroll
        for (unsigned j = 0; j < 16; ++j) { const unsigned c = xb_ld(&bar[XB_XCNT(j)]); sum += c; cnt += (c > 0u) ? 1u : 0u; mine = (j == x) ? c : mine; }
        if (sum == G) break;
        __builtin_amdgcn_s_sleep(1);
        if ((++sp & 255u) == 0u) { if (xb_ld(&bar[XB_TMO])) break; if (sp > XB_SPIN_CAP) { atomicAdd(&bar[XB_TMO], 1u); break; } }
    }
    nloc = mine > 0u ? mine : 1u; nx = cnt > 0u ? cnt : 1u;
}

__device__ __forceinline__ void xcd_barrier(const XcdBarrier& b) {
    asm volatile("s_waitcnt vmcnt(0)" ::: "memory");
    __syncthreads();
    if (threadIdx.x == 0) {
        unsigned* bar = b.bar;
        __builtin_amdgcn_s_waitcnt(0);
        unsigned nloc = b.st[0], nx = b.st[1];
        if (nloc == 0u) { xcd_barrier_complete(bar, b.x, nloc, nx); b.st[0] = nloc; b.st[1] = nx; }
        const unsigned old = xb_add(&bar[XB_XSUB(b.x)], 1u);
        const unsigned gen = old / nloc;
        if (old + 1u == (gen + 1u) * nloc) {
            __builtin_amdgcn_fence(__ATOMIC_RELEASE, "agent");
            asm volatile("s_waitcnt vmcnt(0)" ::: "memory");
            const unsigned og = xb_add(&bar[XB_TOP], 1u);
            const unsigned tg = og / nx;
            if (og + 1u == (tg + 1u) * nx) xb_add(&bar[XB_TOPGEN], 1u);
            else XB_SPIN(xb_ld(&bar[XB_TOPGEN]) == tg, bar);
            __builtin_amdgcn_fence(__ATOMIC_ACQUIRE, "agent");
            xb_add(&bar[XB_XGEN(b.x)], 1u);
            asm volatile("s_waitcnt vmcnt(0)" ::: "memory");
        } else {
            XB_SPIN(xb_ld(&bar[XB_XGEN(b.x)]) == gen, bar);
            __builtin_amdgcn_fence(__ATOMIC_ACQUIRE, "agent");
            asm volatile("s_waitcnt vmcnt(0)" ::: "memory");
        }
    }
    __syncthreads();
}

constexpr int NWAVES = 8, NTHR = 512;
constexpr int NB = 8, SEQ = 4096, T = NB * SEQ, D = 1024, NPROJ = 3584, NIN = 3592, NMOD = 6144, NSC = 2048;
constexpr int C_QSB = 0, C_KSB = 512, C_VSB = 1024, C_QML = 1536, C_KML = 2048, C_VML = 2560, C_OML = 3072;
constexpr float EPS = 1e-6f, LOG2E = 1.4426950408889634f;
constexpr size_t MiB = 1u << 20;
constexpr size_t WS_CTL = 0, CTL_ZERO_BYTES = 1 * MiB;
constexpr size_t WS_MOD = 256 * 1024;
constexpr size_t WS_WIN = 2 * MiB, WS_WOUT = 10 * MiB, WS_WEFF = 12 * MiB;
constexpr size_t WS_XN = 16 * MiB;
constexpr size_t WS_PROJ = 80 * MiB;
constexpr size_t WS_MIX = 304 * MiB;
constexpr size_t WS_EXPU = 368 * MiB, WS_EXPV = 400 * MiB;
constexpr size_t WS_CST = 432 * MiB;
constexpr size_t WS_NST = 496 * MiB;
constexpr size_t WS_MST = 497 * MiB;
constexpr size_t WS_GATES = 498 * MiB;
constexpr size_t WS_SCORES = 80 * MiB;
constexpr size_t WS_IDX = 336 * MiB, WS_GATE = 352 * MiB;
constexpr size_t WS_SCL = 499 * MiB;
constexpr size_t WS_SUI = 499 * MiB + 65536, WS_SVI = 499 * MiB + 131072;
constexpr size_t WS_END = 500 * MiB;
constexpr int CW_Q3 = 64;
constexpr int CW_BAR = 4096;
constexpr int LDS_BYTES = 147456, LDSCTL_OFF = 143360;

typedef float f32x16 __attribute__((ext_vector_type(16)));
typedef float f32x2_t __attribute__((ext_vector_type(2)));
typedef __bf16 bf16x2_t __attribute__((ext_vector_type(2)));
typedef _Float16 f16x8 __attribute__((ext_vector_type(8)));
typedef short s16x4 __attribute__((ext_vector_type(4)));
typedef unsigned u32x2 __attribute__((ext_vector_type(2)));
#define DI __device__ __forceinline__
DI unsigned cvtpk(float lo, float hi) { f32x2_t v = {lo, hi}; bf16x2_t b = __builtin_convertvector(v, bf16x2_t); return __builtin_bit_cast(unsigned, b); }
DI float bflo(unsigned u) { return __uint_as_float(u << 16); }
DI float bfhi(unsigned u) { return __uint_as_float(u & 0xffff0000u); }
DI int crow(int i, int hi) { return (i & 3) + 8 * (i >> 2) + 4 * hi; }
DI int krow(int s, int hi, int j) { return 16 * s + 8 * (j >> 2) + 4 * hi + (j & 3); }
DI float swap_add(float v) { auto rr = __builtin_amdgcn_permlane32_swap(__float_as_uint(v), __float_as_uint(v), false, false); return __uint_as_float(rr[0]) + __uint_as_float(rr[1]); }
DI float swap_max(float v) { auto rr = __builtin_amdgcn_permlane32_swap(__float_as_uint(v), __float_as_uint(v), false, false); return fmaxf(__uint_as_float(rr[0]), __uint_as_float(rr[1])); }
DI float dot2bf(unsigned a, unsigned b, float acc) { return __builtin_amdgcn_fdot2_f32_bf16(__builtin_bit_cast(bf16x2_t, a), __builtin_bit_cast(bf16x2_t, b), acc, false); }
DI float ex2(float x) { return __builtin_amdgcn_exp2f(x); }
DI float lg2(float x) { return __builtin_amdgcn_logf(x); }
DI float fexp(float x) { return __builtin_amdgcn_exp2f(x * LOG2E); }
DI float wave_sum(float v) {
#pragma unroll
    for (int o = 1; o < 64; o <<= 1) v += __shfl_xor(v, o);
    return v;
}
DI float wave_max(float v) {
#pragma unroll
    for (int o = 1; o < 64; o <<= 1) v = fmaxf(v, __shfl_xor(v, o));
    return v;
}
#define DPP_MAXF(v, ctrl, rmask) fmaxf((v), __builtin_bit_cast(float, __builtin_amdgcn_update_dpp(0, __builtin_bit_cast(int, (v)), (ctrl), (rmask), 0xF, false)))
DI float wave_max_nonneg(float v) {
    v = DPP_MAXF(v, 0xB1, 0xF); v = DPP_MAXF(v, 0x4E, 0xF); v = DPP_MAXF(v, 0x141, 0xF); v = DPP_MAXF(v, 0x140, 0xF); v = DPP_MAXF(v, 0x142, 0xA); v = DPP_MAXF(v, 0x143, 0xC);
    return __builtin_bit_cast(float, __builtin_amdgcn_readlane(__builtin_bit_cast(int, v), 63));
}
#define DPP_ADDF(v, ctrl, rmask) ((v) + __builtin_bit_cast(float, __builtin_amdgcn_update_dpp(0, __builtin_bit_cast(int, (v)), (ctrl), (rmask), 0xF, false)))
DI float wave_sum_u(float v) {
    v = DPP_ADDF(v, 0xB1, 0xF); v = DPP_ADDF(v, 0x4E, 0xF); v = DPP_ADDF(v, 0x141, 0xF); v = DPP_ADDF(v, 0x140, 0xF); v = DPP_ADDF(v, 0x142, 0xA); v = DPP_ADDF(v, 0x143, 0xC);
    return __builtin_bit_cast(float, __builtin_amdgcn_readlane(__builtin_bit_cast(int, v), 63));
}
typedef short v4i16_t __attribute__((ext_vector_type(4)));
DI s16x4 trrd(LAS unsigned char* p) { return __builtin_bit_cast(s16x4, __builtin_amdgcn_ds_read_tr16_b64_v4i16((LAS v4i16_t*)p)); }
DI bf16x8 cat8(s16x4 a, s16x4 b) { return (bf16x8){a[0], a[1], a[2], a[3], b[0], b[1], b[2], b[3]}; }
#define MFMA_BF16(a, b, c) __builtin_amdgcn_mfma_f32_32x32x16_bf16((a), (b), (c), 0, 0, 0)
#define MFMA_F16(a, b, c) __builtin_amdgcn_mfma_f32_32x32x16_f16((a), (b), (c), 0, 0, 0)
DI unsigned pkh(float a, float b) { return __builtin_bit_cast(unsigned, __builtin_amdgcn_cvt_pkrtz(a, b)); }
DI bf16x8 packbf(const f32x16& x, int s) { v4u p; p.x = cvtpk(x[8 * s], x[8 * s + 1]); p.y = cvtpk(x[8 * s + 2], x[8 * s + 3]); p.z = cvtpk(x[8 * s + 4], x[8 * s + 5]); p.w = cvtpk(x[8 * s + 6], x[8 * s + 7]); return __builtin_bit_cast(bf16x8, p); }
DI f16x8 packh(const f32x16& x, int s) { v4u p; p.x = pkh(x[8 * s], x[8 * s + 1]); p.y = pkh(x[8 * s + 2], x[8 * s + 3]); p.z = pkh(x[8 * s + 4], x[8 * s + 5]); p.w = pkh(x[8 * s + 6], x[8 * s + 7]); return __builtin_bit_cast(f16x8, p); }

struct Frame {
    LAS unsigned char* lds;
    volatile LAS unsigned* MISC;
    gu32* ctl;
    unsigned char* ws;
    int tid, lane, wave, vcu, G;
};
DI const float* inp(int i) { const __attribute__((address_space(4))) unsigned long long* kp = (const __attribute__((address_space(4))) unsigned long long*)__builtin_amdgcn_kernarg_segment_ptr(); return (const float*)(const GAS float*)(*(volatile const __attribute__((address_space(4))) unsigned long long*)(kp + i)); }
enum { I_X = 0, I_C, I_WADA, I_BADA, I_GN1, I_WIN, I_BIG, I_BFG, I_CONVW, I_GQ, I_GK, I_GOSB, I_GOML, I_WOUT, I_GN2, I_WQ, I_SK, I_EU, I_EV, I_OUT };
#define WSP(type, off) ((type*)(F.ws + (off)))

DI void p0_transpose_item(const float* W, int K, int N, int ld, bf16* WT, LAS float* scr, int item, int lane) {
    const int nblk = N / 32, kb = item / nblk, nb = item % nblk, k0 = 64 * kb, n0 = 32 * nb;
    float tv[32];
#pragma unroll
    for (int i = 0; i < 32; ++i) tv[i] = W[(size_t)(k0 + 2 * i + (lane >> 5)) * ld + n0 + (lane & 31)];
#pragma unroll
    for (int i = 0; i < 32; ++i) scr[(2 * i + (lane >> 5)) * 33 + (lane & 31)] = tv[i];
    LDS_WAIT(); asm volatile("" ::: "memory");
    const int c = lane & 7;
#pragma unroll
    for (int j = 0; j < 4; ++j) { const int n = (lane >> 3) + 8 * j; const LAS float* s = scr + (8 * c) * 33 + n;
        v4u o; o.x = pk2(s[0 * 33], s[1 * 33]); o.y = pk2(s[2 * 33], s[3 * 33]); o.z = pk2(s[4 * 33], s[5 * 33]); o.w = pk2(s[6 * 33], s[7 * 33]);
        *(GAS v4u*)(WT + (size_t)(n0 + n) * K + k0 + 8 * c) = o; }
    LDS_WAIT(); asm volatile("" ::: "memory");
}
DI void p0_mod_block(const Frame& F, int item) {
    const float* const c_ = inp(I_C); const float* const w_ada_ = inp(I_WADA); const float* const b_ada_ = inp(I_BADA); float* const mod_ = WSP(float, WS_MOD);
    LAS float* scr = (LAS float*)(F.lds + F.wave * 16384);
    const int j = item * 64 + F.lane, d0 = F.wave * 128;
#pragma unroll
    for (int b = 0; b < 8; ++b)
#pragma unroll
        for (int q = 0; q < 2; ++q) { const float cv = c_[b * D + d0 + 64 * q + F.lane]; scr[b * 128 + 64 * q + F.lane] = cv / (1.f + fexp(-cv)); }
    LDS_WAIT(); asm volatile("" ::: "memory");
    float acc[8];
#pragma unroll
    for (int b = 0; b < 8; ++b) acc[b] = 0.f;
#pragma unroll 32
    for (int dd = 0; dd < 128; ++dd) { const float w = w_ada_[(size_t)(d0 + dd) * NMOD + j];
#pragma unroll
        for (int b = 0; b < 8; ++b) acc[b] += scr[b * 128 + dd] * w; }
#pragma unroll
    for (int b = 0; b < 8; ++b) scr[1024 + b * 64 + F.lane] = acc[b];
    __syncthreads();
    float tot = b_ada_[j];
#pragma unroll
    for (int w = 0; w < 8; ++w) tot += ((LAS float*)(F.lds + w * 16384))[1024 + F.wave * 64 + F.lane];
    mod_[F.wave * NMOD + j] = tot;
    __syncthreads();
}
DI void p0_weff_item(const Frame& F, int item) {
    const float* const sub_keys_ = inp(I_SK); const float* const w_q_peer_ = inp(I_WQ); bf16* const Weff_t_ = WSP(bf16, WS_WEFF);
    const int hp = item >> 4, dblk = item & 15;
    LAS float* sk = (LAS float*)F.lds;
    LAS float* rb = (LAS float*)(F.lds + 67584) + F.wave * 1024;
    { float tv[32];
#pragma unroll
      for (int i = 0; i < 32; ++i) tv[i] = sub_keys_[(size_t)hp * 16384 + F.tid + 512 * i];
#pragma unroll
      for (int i = 0; i < 32; ++i) { const int idx = F.tid + 512 * i; sk[(idx >> 7) * 129 + (idx & 127)] = tv[i]; } }
    const int d0 = 64 * dblk + 8 * F.wave;
#pragma unroll
    for (int r = 0; r < 8; ++r) { rb[r * 128 + F.lane] = w_q_peer_[(size_t)(d0 + r) * NSC + hp * 128 + F.lane]; rb[r * 128 + 64 + F.lane] = w_q_peer_[(size_t)(d0 + r) * NSC + hp * 128 + 64 + F.lane]; }
    __syncthreads();
    float a0[8], a1[8];
#pragma unroll
    for (int r = 0; r < 8; ++r) { a0[r] = 0.f; a1[r] = 0.f; }
#pragma unroll 4
    for (int c = 0; c < 128; ++c) { const float s0 = sk[F.lane * 129 + c], s1 = sk[(F.lane + 64) * 129 + c];
#pragma unroll
        for (int r = 0; r < 8; ++r) { const float a = rb[r * 128 + c]; a0[r] += a * s0; a1[r] += a * s1; } }
    v4u o0, o1; o0.x = pk2(a0[0], a0[1]); o0.y = pk2(a0[2], a0[3]); o0.z = pk2(a0[4], a0[5]); o0.w = pk2(a0[6], a0[7]);
    o1.x = pk2(a1[0], a1[1]); o1.y = pk2(a1[2], a1[3]); o1.z = pk2(a1[4], a1[5]); o1.w = pk2(a1[6], a1[7]);
    *(GAS v4u*)(Weff_t_ + (size_t)(hp * 128 + F.lane) * D + d0) = o0;
    *(GAS v4u*)(Weff_t_ + (size_t)(hp * 128 + 64 + F.lane) * D + d0) = o1;
    __syncthreads();
}
struct ExpRows2 { f32x4 v[2][4]; };
DI void exp_load2(const Frame& F, int blk0, ExpRows2& R) {
    const float* const expert_u_ = inp(I_EU); const float* const expert_v_ = inp(I_EV);
#pragma unroll
    for (int bb = 0; bb < 2; ++bb) { const int blk = blk0 + bb; const float* src = (blk < 16384 ? expert_u_ : expert_v_) + (size_t)(blk & 16383) * 1024 + 4 * F.lane;
#pragma unroll
        for (int k = 0; k < 4; ++k) R.v[bb][k] = __builtin_nontemporal_load((const GAS f32x4*)(src + 256 * k)); }
}
DI void exp_conv2(const Frame& F, int blk0, const ExpRows2& R) {
    float* const SUI_ = WSP(float, WS_SUI); float* const SVI_ = WSP(float, WS_SVI);
#pragma unroll
    for (int bb = 0; bb < 2; ++bb) { const int blk = blk0 + bb; const bool isu = blk < 16384; const int e = blk & 16383;
        float mx = 0.f;
#pragma unroll
        for (int k = 0; k < 4; ++k) mx = fmaxf(mx, fmaxf(fmaxf(fabsf(R.v[bb][k].x), fabsf(R.v[bb][k].y)), fmaxf(fabsf(R.v[bb][k].z), fabsf(R.v[bb][k].w))));
        mx = wave_max_nonneg(mx);
        {
            float best = 3.0e38f, bs = 0.f;
#define EXP_TRY(FAC) do { const float s_ = mx * ((FAC) / 7.f), inv_ = s_ > 0.f ? 1.f / s_ : 0.f; float er_ = 0.f; \
                _Pragma("unroll") for (int k = 0; k < 4; ++k) _Pragma("unroll") for (int c = 0; c < 4; ++c) { const float v_ = R.v[bb][k][c]; const float d_ = v_ - s_ * fminf(fmaxf(rintf(v_ * inv_), -7.f), 7.f); er_ += d_ * d_; } \
                er_ = wave_sum_u(er_); if (er_ < best) { best = er_; bs = s_; } } while (0)
            EXP_TRY(1.f); EXP_TRY(0.86f); EXP_TRY(0.74f); EXP_TRY(0.63f);
#undef EXP_TRY
            const float inv = bs > 0.f ? 1.f / bs : 0.f;
            unsigned w01[2] = {0u, 0u};
#pragma unroll
            for (int k = 0; k < 4; ++k)
#pragma unroll
                for (int c = 0; c < 4; ++c) { const int q = (int)fminf(fmaxf(rintf(R.v[bb][k][c] * inv), -7.f), 7.f); w01[k >> 1] |= (unsigned)(q & 15) << (4 * (4 * (k & 1) + c)); }
            if (F.lane == 0) (isu ? SUI_ : SVI_)[e] = bs;
            typedef unsigned v2u_ __attribute__((ext_vector_type(2)));
            v2u_ wv; wv.x = w01[0]; wv.y = w01[1];
            *(GAS v2u_*)((isu ? WSP(unsigned char, WS_EXPU) : WSP(unsigned char, WS_EXPV)) + (size_t)e * 512 + 8 * F.lane) = wv;
        } }
}
#ifndef P0_PARTS
#define P0_PARTS 15
#endif
DI void p0_phase(const Frame& F, int parts = 15) {
    const float* const w_in_ = inp(I_WIN); bf16* const Win_t_ = WSP(bf16, WS_WIN); const float* const w_out_ = inp(I_WOUT); bf16* const Wout_t_ = WSP(bf16, WS_WOUT); const float* const expert_v_ = inp(I_EV); const float* const expert_u_ = inp(I_EU);
    LAS float* scr = (LAS float*)(F.lds + F.wave * 16384);
    const int gw = F.vcu * NWAVES + F.wave, NGW = F.G * NWAVES;
    if (parts & 1) for (int it = F.vcu; it < 96; it += F.G) p0_mod_block(F, it);
    constexpr int I_WIN = 16 * 112, I_WOUT = 16 * 32, NITEMS = I_WIN + I_WOUT;
    if (parts & 2) for (int it = gw; it < NITEMS; it += NGW) {
        int r = it;
        if (r < I_WIN) { p0_transpose_item(w_in_, D, NPROJ, NIN, Win_t_, scr, r, F.lane); continue; } r -= I_WIN;
        p0_transpose_item(w_out_, D, D, D, Wout_t_, scr, r, F.lane);
    }
    __syncthreads();
    if (parts & 8) for (int it = F.vcu; it < 256; it += F.G) p0_weff_item(F, it);
}

template <bool DOGATES>
DI void norm_phase(const Frame& F, const float* src, const float* g, int shift_off, int scale_off) {
    const float* const w_in_ = inp(I_WIN); float* const mod_ = WSP(float, WS_MOD); bf16* const XN_ = WSP(bf16, WS_XN); float* const GATES_ = WSP(float, WS_GATES); const float* const b_igate_ = inp(I_BIG); const float* const b_fgate_ = inp(I_BFG);
    LAS float* W8 = (LAS float*)F.lds;
    if (DOGATES) {
        for (int i = 0; i < 16; ++i) { const int idx = F.tid + 512 * i; W8[idx] = w_in_[(size_t)(idx & 1023) * NIN + NPROJ + (idx >> 10)]; }
        __syncthreads();
    }
    const int gw = F.vcu * NWAVES + F.wave, NGW = F.G * NWAVES;
    for (int ch = gw; ch < T / 16; ch += NGW) {
        const int r0 = ch * 16, b = r0 / SEQ;
        f32x4 A[4], Bv[4];
#pragma unroll
        for (int j = 0; j < 4; ++j) { const int col = 4 * F.lane + 256 * j; const f32x4 gg = *(const f32x4*)(g + col), sc = *(const f32x4*)(mod_ + b * NMOD + scale_off + col);
            A[j] = gg * (sc + 1.0f); Bv[j] = *(const f32x4*)(mod_ + b * NMOD + shift_off + col); }
        f32x4 nx[4];
        { const GAS f32x4* xr0 = (const GAS f32x4*)(src + (size_t)r0 * D) + F.lane;
#pragma unroll
          for (int j = 0; j < 4; ++j) nx[j] = __builtin_nontemporal_load(xr0 + 64 * j); }
        for (int rr = 0; rr < 16; ++rr) {
            const int row = r0 + rr;
            f32x4 v[4]; float s = 0.f;
#pragma unroll
            for (int j = 0; j < 4; ++j) { v[j] = nx[j]; s += (v[j].x * v[j].x + v[j].y * v[j].y) + (v[j].z * v[j].z + v[j].w * v[j].w); }
            if (rr + 1 < 16) { const GAS f32x4* xr = (const GAS f32x4*)(src + (size_t)(row + 1) * D) + F.lane;
#pragma unroll
                for (int j = 0; j < 4; ++j) nx[j] = __builtin_nontemporal_load(xr + 64 * j); }
            const float rstd = 1.f / sqrtf(wave_sum_u(s) * (1.f / D) + EPS);
#pragma unroll
            for (int j = 0; j < 4; ++j) v[j] = v[j] * rstd * A[j] + Bv[j];
            GAS unsigned long long* o8 = (GAS unsigned long long*)(XN_ + (size_t)row * D) + F.lane;
#pragma unroll
            for (int j = 0; j < 4; ++j) o8[64 * j] = (unsigned long long)pk2(v[j].x, v[j].y) | ((unsigned long long)pk2(v[j].z, v[j].w) << 32);
            if (DOGATES) {
                float res = 0.f;
#pragma unroll
                for (int hh = 0; hh < 8; ++hh) { float p = 0.f;
#pragma unroll
                    for (int j = 0; j < 4; ++j) { const f32x4 w = *(const LAS f32x4*)(W8 + hh * 1024 + 4 * F.lane + 256 * j); p += (v[j].x * w.x + v[j].y * w.y) + (v[j].z * w.z + v[j].w * w.w); }
                    p = wave_sum_u(p); if (F.lane == hh) res = p; }
                if (F.lane < 8) GATES_[(size_t)row * 8 + F.lane] = res + (F.lane < 4 ? b_igate_[F.lane] : b_fgate_[F.lane - 4]);
            }
        }
    }
}

DI void sb_unit(const Frame& F, int b, int h, int qb) {
    bf16* const PROJ_ = WSP(bf16, WS_PROJ); const float* const g_q_sb_ = inp(I_GQ); const float* const g_k_sb_ = inp(I_GK); bf16* const MIX_ = WSP(bf16, WS_MIX); const float* const g_out_sb_ = inp(I_GOSB);
    const int lane = F.lane, w = F.wave, r = lane & 31, hi = lane >> 5;
    const int i16 = lane & 15, qq = i16 >> 2, pp = i16 & 3, blk = (lane >> 4) & 1;
    LAS unsigned char* Wb = F.lds + w * 16384;
    const size_t rowbase = (size_t)b * SEQ; const int q0 = qb * 256, qw0 = q0 + 32 * w, tq = qw0 + r;
    const bf16* P = PROJ_;
    const bf16* kpiece[4]; const bf16* vpiece[4];
#pragma unroll
    for (int i = 0; i < 4; ++i) { const int krow_ = 8 * i + (lane >> 3), kch = (lane & 7) ^ ((krow_ >> 1) & 7); kpiece[i] = P + (rowbase + krow_) * NPROJ + C_KSB + h * 64 + 8 * kch;
        const int vkey = 16 * (i & 1) + (lane >> 2); vpiece[i] = P + (rowbase + vkey) * NPROJ + C_VSB + h * 64 + 32 * (i >> 1) + 8 * (lane & 3); }
#define SB_DMA(T_, BUF_) do { _Pragma("unroll") for (int i_ = 0; i_ < 4; ++i_) { \
        __builtin_amdgcn_global_load_lds((const unsigned*)(kpiece[i_] + (size_t)(32 * (T_)) * NPROJ), (LAS unsigned*)(Wb + 8192 * (BUF_) + 1024 * i_), 16, 0, 0); \
        __builtin_amdgcn_global_load_lds((const unsigned*)(vpiece[i_] + (size_t)(32 * (T_)) * NPROJ), (LAS unsigned*)(Wb + 8192 * (BUF_) + 4096 + 1024 * i_), 16, 0, 0); } } while (0)
    const int tw = (qw0 + 30) >> 5;
    SB_DMA(tw, 0);
    bf16x8 qf[4];
    {
        const bf16* Qp = P + (rowbase + tq) * NPROJ + C_QSB + h * 64 + 8 * hi;
        v4u qraw[4]; float ss = 0.f;
#pragma unroll
        for (int kk = 0; kk < 4; ++kk) { qraw[kk] = *(const GAS v4u*)(Qp + 16 * kk);
#pragma unroll
            for (int e = 0; e < 4; ++e) { const float a = bflo(qraw[kk][e]), c = bfhi(qraw[kk][e]); ss += a * a + c * c; } }
        ss = swap_add(ss);
        const float rq = __builtin_amdgcn_rsqf(ss * (1.f / 64.f) + EPS) * (0.125f * LOG2E);
#pragma unroll
        for (int kk = 0; kk < 4; ++kk) { const int d0 = 16 * kk + 8 * hi;
            const f32x4 g0 = *(const f32x4*)(g_q_sb_ + d0) * *(const f32x4*)(g_k_sb_ + d0), g1 = *(const f32x4*)(g_q_sb_ + d0 + 4) * *(const f32x4*)(g_k_sb_ + d0 + 4);
            v4u o; o.x = cvtpk(bflo(qraw[kk].x) * rq * g0.x, bfhi(qraw[kk].x) * rq * g0.y); o.y = cvtpk(bflo(qraw[kk].y) * rq * g0.z, bfhi(qraw[kk].y) * rq * g0.w);
            o.z = cvtpk(bflo(qraw[kk].z) * rq * g1.x, bfhi(qraw[kk].z) * rq * g1.y); o.w = cvtpk(bflo(qraw[kk].w) * rq * g1.z, bfhi(qraw[kk].w) * rq * g1.w);
            qf[kk] = __builtin_bit_cast(bf16x8, o); }
    }
    f16x8 U0, U1, E0;
#pragma unroll
    for (int j = 0; j < 8; ++j) { U0[j] = (krow(0, hi, j) > r) ? (_Float16)1.0f : (_Float16)0.0f; U1[j] = (krow(1, hi, j) > r) ? (_Float16)1.0f : (_Float16)0.0f;
        E0[j] = (j == 0 && hi == 0) ? (_Float16)1.0f : (_Float16)0.0f; }
    f32x16 o0, o1;
#pragma unroll
    for (int i = 0; i < 16; ++i) { o0[i] = 0.f; o1[i] = 0.f; }
    float R = 0.f;
    const int kfoff = r * 128, kfsw = (r >> 1) & 7;
    for (int t = tw; t >= 0; --t) {
        const int buf = (tw - t) & 1;
        LAS unsigned char* Kb = Wb + 8192 * buf; LAS unsigned char* Vb = Kb + 4096;
        asm volatile("s_waitcnt vmcnt(0)" ::: "memory");
        if (t > 0) SB_DMA(t - 1, buf ^ 1);
        bf16x8 kf[4]; float ssk = 0.f;
#pragma unroll
        for (int kk = 0; kk < 4; ++kk) { const v4u kv = *(const LAS v4u*)(Kb + kfoff + (((2 * kk + hi) ^ kfsw) * 16)); kf[kk] = __builtin_bit_cast(bf16x8, kv);
            ssk = dot2bf(kv.x, kv.x, ssk); ssk = dot2bf(kv.y, kv.y, ssk); ssk = dot2bf(kv.z, kv.z, ssk); ssk = dot2bf(kv.w, kv.w, ssk); }
        ssk = swap_add(ssk);
        const float rk = __builtin_amdgcn_rsqf(ssk * (1.f / 64.f) + EPS);
        f16x8 RKA;
#pragma unroll
        for (int e = 0; e < 8; ++e) RKA[e] = (_Float16)0.0f;
        RKA[0] = (hi == 0) ? (_Float16)rk : (_Float16)0.0f;
        f32x16 s, rkd;
#pragma unroll
        for (int i = 0; i < 16; ++i) { s[i] = 0.f; rkd[i] = 0.f; }
        rkd = MFMA_F16(RKA, E0, rkd);
#pragma unroll
        for (int kk = 0; kk < 4; ++kk) s = MFMA_BF16(kf[kk], qf[kk], s);
        float tsum = 0.f; unsigned lp[8];
        if (32 * t + 31 < qw0) {
#pragma unroll
            for (int i = 0; i < 16; i += 2) {
                const float z0_ = s[i] * rkd[i], z1_ = s[i + 1] * rkd[i + 1];
                const float a0_ = -lg2(1.f + ex2(z0_)), a1_ = -lg2(1.f + ex2(z1_));
                tsum += a0_ + a1_;
                s[i] = z0_ + a0_; s[i + 1] = z1_ + a1_;
                lp[i >> 1] = pkh(a0_, a1_); }
        } else {
            const int kq = tq - 32 * t;
#pragma unroll
            for (int i = 0; i < 16; i += 2) {
                const float z0_ = s[i] * rkd[i], z1_ = s[i + 1] * rkd[i + 1];
                float a0_ = -lg2(1.f + ex2(z0_)), a1_ = -lg2(1.f + ex2(z1_));
                const bool ma0 = crow(i, hi) >= kq, ma1 = crow(i + 1, hi) >= kq;
                a0_ = ma0 ? 0.f : a0_; a1_ = ma1 ? 0.f : a1_;
                tsum += a0_ + a1_;
                s[i] = ma0 ? -INFINITY : z0_ + a0_; s[i + 1] = ma1 ? -INFINITY : z1_ + a1_;
                lp[i >> 1] = pkh(a0_, a1_); }
        }
        f32x16 c;
#pragma unroll
        for (int i = 0; i < 16; ++i) c[i] = R;
        c = MFMA_F16(U0, __builtin_bit_cast(f16x8, (v4u){lp[0], lp[1], lp[2], lp[3]}), c); c = MFMA_F16(U1, __builtin_bit_cast(f16x8, (v4u){lp[4], lp[5], lp[6], lp[7]}), c);
#pragma unroll
        for (int i = 0; i < 16; ++i) s[i] = ex2(s[i] + c[i]);
        const bf16x8 W0 = packbf(s, 0), W1 = packbf(s, 1);
        LAS unsigned char* vb_ = Vb + (4 * hi + qq) * 64 + 32 * blk + 8 * pp;
        o0 = MFMA_BF16(cat8(trrd(vb_), trrd(vb_ + 8 * 64)), W0, o0); o0 = MFMA_BF16(cat8(trrd(vb_ + 16 * 64), trrd(vb_ + 24 * 64)), W1, o0);
        o1 = MFMA_BF16(cat8(trrd(vb_ + 2048), trrd(vb_ + 2048 + 8 * 64)), W0, o1); o1 = MFMA_BF16(cat8(trrd(vb_ + 2048 + 16 * 64), trrd(vb_ + 2048 + 24 * 64)), W1, o1);
        R += swap_add(tsum);
        if (__all(R < -150.f)) break;
    }
    asm volatile("s_waitcnt vmcnt(0)" ::: "memory");
#undef SB_DMA
    {
        float ss = 0.f;
#pragma unroll
        for (int i = 0; i < 16; ++i) ss += o0[i] * o0[i] + o1[i] * o1[i];
        ss = swap_add(ss);
        const float ro = __builtin_amdgcn_rsqf(ss * (1.f / 64.f) + EPS);
        bf16* Op = MIX_ + (rowbase + tq) * D + h * 64;
        const float* go = g_out_sb_ + h * 64;
#pragma unroll
        for (int g = 0; g < 4; ++g) { const int d0 = 8 * g + 4 * hi; const f32x4 ga = *(const f32x4*)(go + d0), gb = *(const f32x4*)(go + 32 + d0);
            u32x2 wa, wb; wa.x = cvtpk(o0[4 * g] * ro * ga.x, o0[4 * g + 1] * ro * ga.y); wa.y = cvtpk(o0[4 * g + 2] * ro * ga.z, o0[4 * g + 3] * ro * ga.w);
            wb.x = cvtpk(o1[4 * g] * ro * gb.x, o1[4 * g + 1] * ro * gb.y); wb.y = cvtpk(o1[4 * g + 2] * ro * gb.z, o1[4 * g + 3] * ro * gb.w);
            *(GAS u32x2*)(Op + d0) = wa; *(GAS u32x2*)(Op + 32 + d0) = wb; }
    }
    __syncthreads();
}

DI void conv_silu8(const v4u (&xr)[4], const float (&cw)[4][8], float scale, float (&y)[8]) {
#pragma unroll
    for (int e = 0; e < 8; ++e) y[e] = 0.f;
#pragma unroll
    for (int j = 0; j < 4; ++j) {
        y[0] += cw[j][0] * bflo(xr[j].x); y[1] += cw[j][1] * bfhi(xr[j].x); y[2] += cw[j][2] * bflo(xr[j].y); y[3] += cw[j][3] * bfhi(xr[j].y);
        y[4] += cw[j][4] * bflo(xr[j].z); y[5] += cw[j][5] * bfhi(xr[j].z); y[6] += cw[j][6] * bflo(xr[j].w); y[7] += cw[j][7] * bfhi(xr[j].w); }
#pragma unroll
    for (int e = 0; e < 8; ++e) y[e] = scale * y[e] * __builtin_amdgcn_rcpf(1.f + fexp(-y[e]));
}
DI float log_sigmoid(float x) { return fminf(x, 0.f) - 0.6931471805599453f * lg2(1.f + fexp(-fabsf(x))); }
DI float wave_scan_incl(float a, int lane) {
#pragma unroll
    for (int o = 1; o < 64; o <<= 1) { const float t = __shfl_up(a, o); if (lane >= o) a += t; }
    return a;
}

constexpr int LDS_CW = 65536;
DI void stage_conv_w(const Frame& F) {
    const float* const conv_w_ = inp(I_CONVW); LAS float* cwl = (LAS float*)(F.lds + LDS_CW);
    for (int i = F.tid; i < 4096; i += NTHR) cwl[i] = conv_w_[i];
    __syncthreads();
}
DI void load_cw8(const Frame& F, int colbase, float (&cw)[4][8]) {
    const LAS float* cwl = (const LAS float*)(F.lds + LDS_CW);
#pragma unroll
    for (int j = 0; j < 4; ++j) { const f32x4 a = *(const LAS f32x4*)(cwl + j * 1024 + colbase), b = *(const LAS f32x4*)(cwl + j * 1024 + colbase + 4);
        cw[j][0] = a.x; cw[j][1] = a.y; cw[j][2] = a.z; cw[j][3] = a.w; cw[j][4] = b.x; cw[j][5] = b.y; cw[j][6] = b.z; cw[j][7] = b.w; }
}
struct MlLocalRegs { v4u kraw[2][4]; v4u vraw[2]; float gi, gf; };
DI void ml_local_load(const Frame& F, int chain, int c, MlLocalRegs& R) {
    bf16* const PROJ_ = WSP(bf16, WS_PROJ); float* const GATES_ = WSP(float, WS_GATES);
    const int tid = F.tid, lane = F.lane;
    const int b = chain >> 2, hh = chain & 3; const size_t rowbase = (size_t)b * SEQ; const int t0 = c * 64;
    const bf16* P = PROJ_;
    const int kc = tid & 15, kr0 = tid >> 4;
    const bf16* Kg = P + rowbase * NPROJ + C_KML + hh * 128 + kc * 8;
#pragma unroll
    for (int i = 0; i < 2; ++i)
#pragma unroll
        for (int j = 0; j < 4; ++j) { const int tt = t0 + kr0 + 32 * i - 3 + j; R.kraw[i][j] = (tt >= 0) ? *(const GAS v4u*)(Kg + (size_t)tt * NPROJ) : (v4u){0u, 0u, 0u, 0u}; }
#pragma unroll
    for (int i = 0; i < 2; ++i) R.vraw[i] = *(const GAS v4u*)(P + (rowbase + t0 + kr0 + 32 * i) * NPROJ + C_VML + hh * 128 + kc * 8);
    const float* Gg = GATES_ + (rowbase + t0 + lane) * 8;
    R.gi = Gg[hh]; R.gf = Gg[4 + hh];
}
DI void ml_local_unit(const Frame& F, int chain, int c, const MlLocalRegs& RG) {
    bf16* const CST_ = WSP(bf16, WS_CST); float* const NST_ = WSP(float, WS_NST); float* const SCL_ = WSP(float, WS_SCL);
    LAS unsigned char* L = F.lds;
    LAS float* Lws = (LAS float*)(L + 32768);
    const int tid = F.tid, lane = F.lane, w = F.wave, r = lane & 31, hi = lane >> 5;
    const int i16 = lane & 15, qq = i16 >> 2, pp = i16 & 3, blk = (lane >> 4) & 1;
    const int hh = chain & 3;
    const int kbk = w & 3, vb0 = 2 * (w >> 2);
    const int kc = tid & 15, kr0 = tid >> 4;
    v4u kraw[2][4], vraw[2];
#pragma unroll
    for (int i = 0; i < 2; ++i) { vraw[i] = RG.vraw[i];
#pragma unroll
        for (int j = 0; j < 4; ++j) kraw[i][j] = RG.kraw[i][j]; }
    const float gi = RG.gi, gf = RG.gf;
    const float a = wave_scan_incl(log_sigmoid(gf), lane);
    const float a_end = __shfl(a, 63);
    const float lw = a_end - a + gi;
    const float m_loc = wave_max(lw);
    const float ws = fexp(lw - m_loc);
    if (w == 0) Lws[lane] = ws;
    {
        float cw[4][8]; load_cw8(F, 512 + hh * 128 + kc * 8, cw);
#pragma unroll
        for (int i = 0; i < 2; ++i) { float y[8]; conv_silu8(kraw[i], cw, 0.08838834764831845f, y);
            v4u o; o.x = cvtpk(y[0], y[1]); o.y = cvtpk(y[2], y[3]); o.z = cvtpk(y[4], y[5]); o.w = cvtpk(y[6], y[7]);
            *(LAS v4u*)(L + (kc >> 2) * 4096 + (kr0 + 32 * i) * 64 + (kc & 3) * 16) = o; }
#pragma unroll
        for (int i = 0; i < 2; ++i) { const int row = kr0 + 32 * i; const float wsr = __shfl(ws, row);
            v4u o; o.x = cvtpk(bflo(vraw[i].x) * wsr, bfhi(vraw[i].x) * wsr); o.y = cvtpk(bflo(vraw[i].y) * wsr, bfhi(vraw[i].y) * wsr); o.z = cvtpk(bflo(vraw[i].z) * wsr, bfhi(vraw[i].z) * wsr); o.w = cvtpk(bflo(vraw[i].w) * wsr, bfhi(vraw[i].w) * wsr);
            *(LAS v4u*)(L + 16384 + (kc >> 2) * 4096 + row * 64 + (kc & 3) * 16) = o; }
    }
    __syncthreads();
    f32x16 acc0, acc1;
#pragma unroll
    for (int i = 0; i < 16; ++i) { acc0[i] = 0.f; acc1[i] = 0.f; }
#pragma unroll
    for (int kk = 0; kk < 4; ++kk) { const int rows = 16 * kk + 8 * hi + qq;
        LAS unsigned char* ka = L + kbk * 4096 + rows * 64 + 32 * blk + 8 * pp; LAS unsigned char* va = L + 16384 + vb0 * 4096 + rows * 64 + 32 * blk + 8 * pp;
        const bf16x8 A = cat8(trrd(ka), trrd(ka + 4 * 64));
        acc0 = MFMA_BF16(A, cat8(trrd(va), trrd(va + 4 * 64)), acc0); acc1 = MFMA_BF16(A, cat8(trrd(va + 4096), trrd(va + 4096 + 4 * 64)), acc1); }
    {
        bf16* Cp = CST_ + ((size_t)(chain * 64 + c) * 128 + vb0 * 32 + r) * 128 + kbk * 32 + 4 * hi;
#pragma unroll
        for (int g = 0; g < 4; ++g) { u32x2 o; o.x = cvtpk(acc0[4 * g], acc0[4 * g + 1]); o.y = cvtpk(acc0[4 * g + 2], acc0[4 * g + 3]); *(GAS u32x2*)(Cp + 8 * g) = o;
            u32x2 o1; o1.x = cvtpk(acc1[4 * g], acc1[4 * g + 1]); o1.y = cvtpk(acc1[4 * g + 2], acc1[4 * g + 3]); *(GAS u32x2*)(Cp + 32 * 128 + 8 * g) = o1; }
    }
    {
        const int k = 16 * w + (lane & 15), sq = lane >> 4; float part = 0.f;
        const LAS unsigned short* kcol = (const LAS unsigned short*)(L + (k >> 5) * 4096 + (k & 31) * 2);
#pragma unroll
        for (int e = 0; e < 16; ++e) part += Lws[16 * sq + e] * __uint_as_float((unsigned)kcol[(16 * sq + e) * 32] << 16);
        part += __shfl_xor(part, 16); part += __shfl_xor(part, 32);
        if (lane < 16) NST_[(size_t)(chain * 64 + c) * 128 + k] = part;
        if (tid == 0) { SCL_[(chain * 64 + c) * 2] = a_end; SCL_[(chain * 64 + c) * 2 + 1] = m_loc; }
    }
    __syncthreads();
}
DI void ml_scan_phase(const Frame& F) {
    bf16* const CST_ = WSP(bf16, WS_CST); float* const NST_ = WSP(float, WS_NST); float* const SCL_ = WSP(float, WS_SCL); float* const MST_ = WSP(float, WS_MST);
    for (int gt = F.vcu * NTHR + F.tid; gt < 32 * 4096; gt += F.G * NTHR) {
        const int chain = gt >> 12, rem = gt & 4095;
        const float ae_l = SCL_[(chain * 64 + F.lane) * 2], ml_l = SCL_[(chain * 64 + F.lane) * 2 + 1];
        u32x2* Cp = (u32x2*)(CST_ + (size_t)chain * 64 * 16384 + (size_t)rem * 4);
        f32x4* Np = (f32x4*)(NST_ + (size_t)chain * 64 * 128 + rem * 4);
        const bool do_n = rem < 32;
        float c0 = 0.f, c1 = 0.f, c2 = 0.f, c3 = 0.f; f32x4 nn = {0.f, 0.f, 0.f, 0.f}; float m = 0.f;
        u32x2 dr[8]; f32x4 nr[8];
#pragma unroll
        for (int i = 0; i < 8; ++i) { dr[i] = Cp[(size_t)i * 4096]; if (do_n) nr[i] = Np[i * 32]; }
        for (int c0_ = 0; c0_ < 64; c0_ += 8) {
#pragma unroll
            for (int i = 0; i < 8; ++i) { const int c = c0_ + i;
                if (c < 63) {
                    const u32x2 dcur = dr[i]; const f32x4 dn = nr[i];
                    if (c + 8 < 63) { dr[i] = Cp[(size_t)(c + 8) * 4096]; if (do_n) nr[i] = Np[(c + 8) * 32]; }
                    const float ae = __builtin_bit_cast(float, __builtin_amdgcn_readlane(__builtin_bit_cast(int, ae_l), c)), ml = __builtin_bit_cast(float, __builtin_amdgcn_readlane(__builtin_bit_cast(int, ml_l), c));
                    const float mn = fmaxf(ae + m, ml), d1 = fexp(ae + m - mn), d2 = fexp(ml - mn);
                    c0 = d1 * c0 + d2 * bflo(dcur.x); c1 = d1 * c1 + d2 * bfhi(dcur.x); c2 = d1 * c2 + d2 * bflo(dcur.y); c3 = d1 * c3 + d2 * bfhi(dcur.y);
                    u32x2 o; o.x = cvtpk(c0, c1); o.y = cvtpk(c2, c3); Cp[(size_t)c * 4096] = o;
                    if (do_n) { nn = nn * d1 + dn * d2; Np[c * 32] = nn; }
                    if (rem == 0) MST_[chain * 64 + c] = mn;
                    m = mn; } }
        }
    }
}
DI void ml_out_unit(const Frame& F, int chain, int c) {
    bf16* const PROJ_ = WSP(bf16, WS_PROJ); float* const GATES_ = WSP(float, WS_GATES); float* const MST_ = WSP(float, WS_MST); bf16* const CST_ = WSP(bf16, WS_CST); float* const NST_ = WSP(float, WS_NST); bf16* const MIX_ = WSP(bf16, WS_MIX); const float* const g_out_ml_ = inp(I_GOML);
    LAS unsigned char* L = F.lds;
    LAS float* Lbs = (LAS float*)(L + 49152); LAS float* Lav = (LAS float*)(L + 49408); LAS float* Lex = (LAS float*)(L + 49664);
    const int tid = F.tid, lane = F.lane, w = F.wave, r = lane & 31, hi = lane >> 5;
    const int i16 = lane & 15, qq = i16 >> 2, pp = i16 & 3, blk = (lane >> 4) & 1;
    const int b = chain >> 2, hh = chain & 3; const size_t rowbase = (size_t)b * SEQ; const int t0 = c * 64;
    const int tb = w >> 2, vb = w & 3;
    const bf16* P = PROJ_;
    {
        const int kc = tid & 15, kr0 = tid >> 4;
#pragma unroll
        for (int which = 0; which < 2; ++which) {
            const int colbase = (which ? 512 : 0) + hh * 128 + kc * 8;
            float cw[4][8]; load_cw8(F, colbase, cw);
            const bf16* Xg = P + rowbase * NPROJ + C_QML + colbase;
#pragma unroll
            for (int i = 0; i < 2; ++i) { const int row = kr0 + 32 * i; v4u xr[4];
#pragma unroll
                for (int j = 0; j < 4; ++j) { const int tt = t0 + row - 3 + j; xr[j] = (tt >= 0) ? *(const GAS v4u*)(Xg + (size_t)tt * NPROJ) : (v4u){0u, 0u, 0u, 0u}; }
                float y[8]; conv_silu8(xr, cw, which ? 0.08838834764831845f : 1.0f, y);
                v4u o; o.x = cvtpk(y[0], y[1]); o.y = cvtpk(y[2], y[3]); o.z = cvtpk(y[4], y[5]); o.w = cvtpk(y[6], y[7]);
                *(LAS v4u*)(L + which * 16384 + row * 256 + ((kc ^ (row & 15)) * 16)) = o; }
        }
#pragma unroll
        for (int i = 0; i < 2; ++i) { const int row = kr0 + 32 * i;
            const v4u v = *(const GAS v4u*)(P + (rowbase + t0 + row) * NPROJ + C_VML + hh * 128 + kc * 8);
            *(LAS v4u*)(L + 32768 + (kc >> 2) * 4096 + row * 64 + (kc & 3) * 16) = v; }
        if (w == 0) { const float* Gg = GATES_ + (rowbase + t0 + lane) * 8; const float a = wave_scan_incl(log_sigmoid(Gg[4 + hh]), lane); Lav[lane] = a; Lbs[lane] = Gg[hh] - a; }
    }
    const float mprev = (c > 0) ? MST_[chain * 64 + c - 1] : 0.f;
    bf16x8 cf[8], nf[8];
    if (c > 0) {
        const bf16* Cp = CST_ + ((size_t)(chain * 64 + c - 1) * 128 + vb * 32 + r) * 128 + 8 * hi;
        const float* Np = NST_ + (size_t)(chain * 64 + c - 1) * 128 + 8 * hi;
        const bool nrow = (r == 0) || (r == 4);
#pragma unroll
        for (int kk = 0; kk < 8; ++kk) { cf[kk] = *(const GAS bf16x8*)(Cp + 16 * kk);
            const f32x4 n0 = *(const f32x4*)(Np + 16 * kk), n1 = *(const f32x4*)(Np + 16 * kk + 4);
            v4u o; o.x = cvtpk(n0.x, n0.y); o.y = cvtpk(n0.z, n0.w); o.z = cvtpk(n1.x, n1.y); o.w = cvtpk(n1.z, n1.w);
            if (!nrow) o = (v4u){0u, 0u, 0u, 0u};
            nf[kk] = __builtin_bit_cast(bf16x8, o); }
    }
    __syncthreads();
    bf16x8 qf[8];
    f32x16 s0, s1;
#pragma unroll
    for (int i = 0; i < 16; ++i) { s0[i] = 0.f; s1[i] = 0.f; }
#pragma unroll
    for (int kk = 0; kk < 8; ++kk) { const int ch = 2 * kk + hi; const int rq_ = 32 * tb + r;
        qf[kk] = *(const LAS bf16x8*)(L + rq_ * 256 + ((ch ^ (rq_ & 15)) * 16));
        const bf16x8 a0 = *(const LAS bf16x8*)(L + 16384 + r * 256 + ((ch ^ (r & 15)) * 16));
        const bf16x8 a1 = *(const LAS bf16x8*)(L + 16384 + (32 + r) * 256 + ((ch ^ ((32 + r) & 15)) * 16));
        s0 = MFMA_BF16(a0, qf[kk], s0); s1 = MFMA_BF16(a1, qf[kk], s1); }
    const int tl = 32 * tb + r; const float a_t = Lav[tl];
    f32x16 d0, d1; float mrow = -INFINITY;
#pragma unroll
    for (int g = 0; g < 4; ++g) { const f32x4 b0 = *(const LAS f32x4*)(Lbs + 8 * g + 4 * hi), b1 = *(const LAS f32x4*)(Lbs + 32 + 8 * g + 4 * hi);
#pragma unroll
        for (int e = 0; e < 4; ++e) { const int sl = 8 * g + 4 * hi + e;
            d0[4 * g + e] = (sl <= tl) ? a_t + b0[e] : -INFINITY; d1[4 * g + e] = (32 + sl <= tl) ? a_t + b1[e] : -INFINITY;
            mrow = fmaxf(mrow, fmaxf(d0[4 * g + e], d1[4 * g + e])); } }
    mrow = fmaxf(swap_max(mrow), a_t + mprev);
    float psum = 0.f;
#pragma unroll
    for (int i = 0; i < 16; ++i) { s0[i] *= fexp(d0[i] - mrow); s1[i] *= fexp(d1[i] - mrow); psum += s0[i] + s1[i]; }
    const float w_inter = fexp(a_t + mprev - mrow);
    float den = swap_add(psum);
    const bf16x8 P00 = packbf(s0, 0), P01 = packbf(s0, 1), P10 = packbf(s1, 0), P11 = packbf(s1, 1);
    f32x16 num;
#pragma unroll
    for (int i = 0; i < 16; ++i) num[i] = 0.f;
    {
        LAS unsigned char* vb_ = L + 32768 + vb * 4096 + (4 * hi + qq) * 64 + 32 * blk + 8 * pp;
        num = MFMA_BF16(cat8(trrd(vb_), trrd(vb_ + 8 * 64)), P00, num); num = MFMA_BF16(cat8(trrd(vb_ + 16 * 64), trrd(vb_ + 24 * 64)), P01, num);
        num = MFMA_BF16(cat8(trrd(vb_ + 32 * 64), trrd(vb_ + 40 * 64)), P10, num); num = MFMA_BF16(cat8(trrd(vb_ + 48 * 64), trrd(vb_ + 56 * 64)), P11, num);
    }
    if (c > 0) {
        f32x16 it, dn;
#pragma unroll
        for (int i = 0; i < 16; ++i) { it[i] = 0.f; dn[i] = 0.f; }
#pragma unroll
        for (int kk = 0; kk < 8; ++kk) { it = MFMA_BF16(cf[kk], qf[kk], it); dn = MFMA_BF16(nf[kk], qf[kk], dn); }
#pragma unroll
        for (int i = 0; i < 16; ++i) num[i] += w_inter * it[i];
        den += w_inter * dn[0];
    }
    const float inv = __builtin_amdgcn_rcpf(fmaxf(fabsf(den), fexp(-mrow)));
    float ss = 0.f;
#pragma unroll
    for (int i = 0; i < 16; ++i) { num[i] *= inv; ss += num[i] * num[i]; }
    ss = swap_add(ss);
    if (lane < 32) Lex[(tb * 4 + vb) * 32 + r] = ss;
    __syncthreads();
    const float tot = (Lex[(tb * 4 + 0) * 32 + r] + Lex[(tb * 4 + 1) * 32 + r]) + (Lex[(tb * 4 + 2) * 32 + r] + Lex[(tb * 4 + 3) * 32 + r]);
    const float rstd = 1.f / sqrtf(tot * (1.f / 128.f) + EPS);
    {
        const size_t trow = rowbase + t0 + tl;
        const bf16* Og = P + trow * NPROJ + C_OML + hh * 128 + vb * 32 + 4 * hi;
        bf16* Mp = MIX_ + trow * D + 512 + hh * 128 + vb * 32 + 4 * hi;
        const float* go = g_out_ml_ + hh * 128 + vb * 32 + 4 * hi;
#pragma unroll
        for (int g = 0; g < 4; ++g) { const u32x2 og = *(const GAS u32x2*)(Og + 8 * g); const f32x4 gg = *(const f32x4*)(go + 8 * g);
            const float o0 = bflo(og.x), o1 = bfhi(og.x), o2 = bflo(og.y), o3 = bfhi(og.y);
            u32x2 o; o.x = cvtpk(num[4 * g] * rstd * gg.x * __builtin_amdgcn_rcpf(1.f + fexp(-o0)), num[4 * g + 1] * rstd * gg.y * __builtin_amdgcn_rcpf(1.f + fexp(-o1)));
            o.y = cvtpk(num[4 * g + 2] * rstd * gg.z * __builtin_amdgcn_rcpf(1.f + fexp(-o2)), num[4 * g + 3] * rstd * gg.w * __builtin_amdgcn_rcpf(1.f + fexp(-o3)));
            *(GAS u32x2*)(Mp + 8 * g) = o; }
    }
    __syncthreads();
}

#define TK_CE(A, B) do { const float hi_ = fmaxf((A), (B)), lo_ = fminf((A), (B)); (A) = hi_; (B) = lo_; } while (0)
DI void tk_sort16(float (&a)[16]) {
#pragma unroll
    for (int k = 2; k <= 16; k <<= 1)
#pragma unroll
        for (int j = k >> 1; j > 0; j >>= 1)
#pragma unroll
            for (int i = 0; i < 16; ++i) { const int l = i ^ j; if (l > i) { if ((i & k) == 0) TK_CE(a[i], a[l]); else TK_CE(a[l], a[i]); } }
}
DI void tk_merge16(float (&a)[16], const float (&b)[16]) {
#pragma unroll
    for (int i = 0; i < 16; ++i) a[i] = fmaxf(a[i], b[15 - i]);
#pragma unroll
    for (int j = 8; j > 0; j >>= 1)
#pragma unroll
        for (int i = 0; i < 16; ++i) { const int l = i ^ j; if (l > i) TK_CE(a[i], a[l]); }
}
DI void tk_stage2(const LAS float* la, const LAS float* lb, int* IDX_, float* GATEW_, size_t o) {
        float a[16], bb[16], cnd[64];
#pragma unroll
        for (int q = 0; q < 16; ++q) { a[q] = la[q]; bb[q] = lb[q]; }
        int cnt = 0;
#pragma unroll
        for (int i = 0; i < 16; ++i)
#pragma unroll
            for (int j = 0; j < 16; ++j) if ((i + 1) * (j + 1) <= 16) { cnd[cnt] = __uint_as_float((__float_as_uint(a[i] + bb[j]) & ~0xFFu) | (unsigned)(i * 16 + j)); ++cnt; }
#pragma unroll
        for (int q = 50; q < 64; ++q) cnd[q] = -INFINITY;
        float top[16];
#pragma unroll
        for (int c = 0; c < 4; ++c) { float ch[16];
#pragma unroll
            for (int q = 0; q < 16; ++q) ch[q] = cnd[16 * c + q];
            tk_sort16(ch);
            if (c == 0) {
#pragma unroll
                for (int q = 0; q < 16; ++q) top[q] = ch[q];
            } else tk_merge16(top, ch); }
        float sv[16]; int ei[16]; float mx = -INFINITY;
#pragma unroll
        for (int q = 0; q < 16; ++q) { const unsigned code = __float_as_uint(top[q]) & 0xFFu; const float va = la[code >> 4], vb = lb[code & 15u];
            ei[q] = (int)((__float_as_uint(va) & 0x7Fu) * 128u + (__float_as_uint(vb) & 0x7Fu)); sv[q] = va + vb; mx = fmaxf(mx, sv[q]); }
        float sum = 0.f;
#pragma unroll
        for (int q = 0; q < 16; ++q) { sv[q] = fexp(sv[q] - mx); sum += sv[q]; }
        const float inv = 1.f / sum;
#pragma unroll
        for (int q = 0; q < 16; q += 4) { *(GAS v4u*)(IDX_ + o + q) = (v4u){(unsigned)ei[q], (unsigned)ei[q + 1], (unsigned)ei[q + 2], (unsigned)ei[q + 3]};
            *(GAS f32x4*)(GATEW_ + o + q) = (f32x4){sv[q] * inv, sv[q + 1] * inv, sv[q + 2] * inv, sv[q + 3] * inv}; }
    }
struct EpiTopK {
    static constexpr bool PERM = false, AFTER_DRAIN = true;
    int* IDX; float* GATEW;
    DI void fused(f32x4 (&acc)[2][2][4][2], const pg8::Unit& u, int wr, int wc, int fr, int fq, LAS unsigned char* lds, int wid, int lane) const {
        LAS float* Tl = (LAS float*)lds;
        LAS float* Lh2 = (LAS float*)lds;
        LAS float* Ls = (LAS float*)(lds + 36864);
        const int tid = wid * 64 + lane, tl = tid & 127, p = (tid >> 7) & 1, half = tid >> 8;
#pragma unroll
        for (int ai = 0; ai < 2; ++ai) {
#pragma unroll
            for (int bj = 0; bj < 2; ++bj)
#pragma unroll
                for (int m = 0; m < 4; ++m)
#pragma unroll
                    for (int n = 0; n < 2; ++n) { LAS float* d = Tl + (wr * 64 + m * 16 + fr) * 257 + bj * 128 + wc * 32 + n * 16 + fq * 4; const f32x4 v = acc[ai][bj][m][n]; d[0] = v.x; d[1] = v.y; d[2] = v.z; d[3] = v.w; }
            __syncthreads();
            float run[16];
            {
                const LAS float* src = Tl + tl * 257 + p * 128 + half * 64;
#pragma unroll
                for (int c = 0; c < 4; ++c) { float ch[16];
#pragma unroll
                    for (int q = 0; q < 16; ++q) ch[q] = __uint_as_float((__float_as_uint(src[16 * c + q]) & ~0x7Fu) | (unsigned)(half * 64 + 16 * c + q));
                    tk_sort16(ch);
                    if (c == 0) {
#pragma unroll
                        for (int q = 0; q < 16; ++q) run[q] = ch[q];
                    } else tk_merge16(run, ch); }
            }
            __syncthreads();
#pragma unroll
            for (int q = 0; q < 16; ++q) Lh2[((tl * 2 + p) * 2 + half) * 17 + q] = run[q];
            __syncthreads();
            if (half == 0) { float oth[16];
#pragma unroll
                for (int q = 0; q < 16; ++q) oth[q] = Lh2[((tl * 2 + p) * 2 + 1) * 17 + q];
                tk_merge16(run, oth);
#pragma unroll
                for (int q = 0; q < 16; ++q) Ls[(tl * 2 + p) * 17 + q] = run[q]; }
            __syncthreads();
            if (tid < 128) tk_stage2(Ls + (tl * 2) * 17, Ls + (tl * 2) * 17 + 17, IDX, GATEW, (size_t)(u.pm * 256 + ai * 128 + tl) * 128 + u.pn * 16);
            __syncthreads();
        }
    }
};
struct OneUnit {
    pg8::Unit u;
    __device__ __forceinline__ bool next(int i, pg8::Unit& o) const { if (i) return false; o = u; return true; }
    __device__ __forceinline__ void a_ready(const pg8::Unit&) const {}
    __device__ __forceinline__ void done(const pg8::Unit&) const {}
};

DI float gelu_erf(float x) { return 0.5f * x * (1.f + erff(x * 0.7071067811865476f)); }
#define DPP_ADD(v, ctrl, rmask) ((v) + __builtin_bit_cast(float, __builtin_amdgcn_update_dpp(0, __builtin_bit_cast(int, (v)), (ctrl), (rmask), 0xF, false)))
#ifndef PEER_EBL
#define PEER_EBL 9
#endif
constexpr int PEER_EB_LOG = PEER_EBL;
#ifndef PEER_PROBE_MASK
#define PEER_PROBE_MASK 0xFFFF
#endif
typedef float f32x2v __attribute__((ext_vector_type(2)));
DI float gelu_cdf(float v) {
    const float av = fabsf(v), t = __builtin_amdgcn_rcpf(av * 0.2316418882f + 1.0f);
    float q = t * 0.5307027145f - 0.7265760135f; q = q * t + 0.7107068705f; q = q * t - 0.142248368f; q = q * t + 0.127414796f; q = q * t;
    const float m = v * (q * ex2(v * v * -0.72134752044f));
    return v < 0.f ? m : v - m;
}
#define DPP_ADDI(v, ctrl, rmask) ((v) + __builtin_amdgcn_update_dpp(0, (v), (ctrl), (rmask), 0xF, false))
DI void peer_phase(const Frame& F, bool scratch_dst) {
    bf16* const XN_ = WSP(bf16, WS_XN); int* const IDX_ = WSP(int, WS_IDX); float* const GATEW_ = WSP(float, WS_GATE); float* const mod_ = WSP(float, WS_MOD); float* const out_ = (float*)inp(I_OUT);
    const unsigned char* const EU4 = WSP(unsigned char, WS_EXPU); const unsigned char* const EV4 = WSP(unsigned char, WS_EXPV); const float* const SUI_ = WSP(float, WS_SUI); const float* const SVI_ = WSP(float, WS_SVI);
    const int gw = F.vcu * NWAVES + F.wave, NGW = F.G * NWAVES, lane = F.lane, g = lane >> 3, j = lane & 7;
    LAS unsigned char* wl = F.lds + F.wave * 17408;
    volatile LAS int* Le = (volatile LAS int*)(wl + g * 512); volatile LAS float* Lg = (volatile LAS float*)(wl + 4096 + g * 512); volatile LAS int* Lp = (volatile LAS int*)(wl + 8192 + g * 512);
    volatile LAS int* Lx = (volatile LAS int*)(wl + 12288 + g * 512); LAS int* Lh = (LAS int*)(wl + 16384 + g * 128);
    for (int grp = gw; grp < T / 8; grp += NGW) {
        const size_t t = (size_t)grp * 8 + g;
        int xh[16], xl[16]; float sxi;
        {
            float mx = 0.f;
            const bf16* xrow = XN_ + t * D + 8 * j;
#pragma unroll
            for (int kq = 0; kq < 16; ++kq) { const v4u a = *(const GAS v4u*)(xrow + 64 * kq);
#pragma unroll
                for (int e = 0; e < 4; ++e) mx = fmaxf(mx, fmaxf(fabsf(bflo(a[e])), fabsf(bfhi(a[e])))); }
            mx = fmaxf(mx, __shfl_xor(mx, 1, 8)); mx = fmaxf(mx, __shfl_xor(mx, 2, 8)); mx = fmaxf(mx, __shfl_xor(mx, 4, 8));
            const float sx = mx > 0.f ? 119.f / mx : 0.f; sxi = mx > 0.f ? mx / 119.f : 0.f;
#pragma unroll
            for (int q = 0; q < 4; ++q)
#pragma unroll
                for (int kp = 0; kp < 2; ++kp) { const v4u a = *(const GAS v4u*)(xrow + 64 * (8 * kp + q)), b = *(const GAS v4u*)(xrow + 64 * (8 * kp + 4 + q));
#pragma unroll
                    for (int wh = 0; wh < 2; ++wh) {
                        const int t0 = (int)rintf(bflo(a[2 * wh]) * sx) + 8, t1 = (int)rintf(bfhi(a[2 * wh]) * sx) + 8, t2 = (int)rintf(bflo(a[2 * wh + 1]) * sx) + 8, t3 = (int)rintf(bfhi(a[2 * wh + 1]) * sx) + 8;
                        const int t4 = (int)rintf(bflo(b[2 * wh]) * sx) + 8, t5 = (int)rintf(bfhi(b[2 * wh]) * sx) + 8, t6 = (int)rintf(bflo(b[2 * wh + 1]) * sx) + 8, t7 = (int)rintf(bfhi(b[2 * wh + 1]) * sx) + 8;
                        const unsigned lo_ = (unsigned)(t0 & 15) | ((unsigned)(t1 & 15) << 4) | ((unsigned)(t2 & 15) << 8) | ((unsigned)(t3 & 15) << 12) | ((unsigned)(t4 & 15) << 16) | ((unsigned)(t5 & 15) << 20) | ((unsigned)(t6 & 15) << 24) | ((unsigned)(t7 & 15) << 28);
                        const unsigned hi_ = (unsigned)((t0 >> 4) & 15) | ((unsigned)((t1 >> 4) & 15) << 4) | ((unsigned)((t2 >> 4) & 15) << 8) | ((unsigned)((t3 >> 4) & 15) << 12) | ((unsigned)((t4 >> 4) & 15) << 16) | ((unsigned)((t5 >> 4) & 15) << 20) | ((unsigned)((t6 >> 4) & 15) << 24) | ((unsigned)((t7 >> 4) & 15) << 28);
                        xl[4 * q + kp + 2 * wh] = (int)(lo_ ^ 0x88888888u); xh[4 * q + kp + 2 * wh] = (int)hi_; } }
        }
        {
            int ide[16]; float gte[16]; int rk[16];
#pragma unroll
            for (int m = 0; m < 16; ++m) { ide[m] = IDX_[t * 128 + j + 8 * m]; gte[m] = GATEW_[t * 128 + j + 8 * m]; }
#pragma unroll
            for (int m = 0; m < 4; ++m) Lh[j + 8 * m] = 0;
#pragma unroll
            for (int m = 0; m < 16; ++m) rk[m] = __hip_atomic_fetch_add(Lh + (ide[m] >> PEER_EB_LOG), 1, __ATOMIC_RELAXED, __HIP_MEMORY_SCOPE_WORKGROUP);
            {
                const int h0 = ((volatile LAS int*)Lh)[4 * j], h1 = ((volatile LAS int*)Lh)[4 * j + 1], h2 = ((volatile LAS int*)Lh)[4 * j + 2], h3 = ((volatile LAS int*)Lh)[4 * j + 3];
                const int tot = (h0 + h1) + (h2 + h3); int inc = tot;
#pragma unroll
                for (int o = 1; o < 8; o <<= 1) { const int tt = __shfl_up(inc, o, 8); if (j >= o) inc += tt; }
                const int ex = inc - tot;
                ((volatile LAS int*)Lh)[4 * j] = ex; ((volatile LAS int*)Lh)[4 * j + 1] = ex + h0; ((volatile LAS int*)Lh)[4 * j + 2] = ex + h0 + h1; ((volatile LAS int*)Lh)[4 * j + 3] = ex + h0 + h1 + h2;
            }
#pragma unroll
            for (int m = 0; m < 16; ++m) { const int pos = ((volatile LAS int*)Lh)[ide[m] >> PEER_EB_LOG] + rk[m]; Le[pos] = ide[m]; Lg[pos] = gte[m] * SVI_[ide[m]]; Lp[pos] = __builtin_bit_cast(int, SUI_[ide[m]] * sxi); }
        }
        v4u R0[4], R1[4], R2[4], R3[4];
#define PEER_LOADU(RR, S0) do { const size_t ro_ = (size_t)(Le[(S0)] & (scratch_dst ? PEER_PROBE_MASK : 0xFFFF)) * 512 + 16 * j; _Pragma("unroll") for (int q = 0; q < 4; ++q) RR[q] = *(const GAS v4u*)(EU4 + ro_ + 128 * q); } while (0)
#define PEER_DOTU(RR, EOUT) do { int h0_ = 0, h1_ = 0, l0_ = 0, l1_ = 0; \
            _Pragma("unroll") for (int q = 0; q < 4; q += 2) _Pragma("unroll") for (int w_ = 0; w_ < 4; ++w_) { \
                h0_ = __builtin_amdgcn_sdot8((int)RR[q][w_], xh[4 * q + w_], h0_, false); l0_ = __builtin_amdgcn_sdot8((int)RR[q][w_], xl[4 * q + w_], l0_, false); \
                h1_ = __builtin_amdgcn_sdot8((int)RR[q + 1][w_], xh[4 * q + 4 + w_], h1_, false); l1_ = __builtin_amdgcn_sdot8((int)RR[q + 1][w_], xl[4 * q + 4 + w_], l1_, false); } \
            int e_ = ((h0_ + h1_) << 4) + (l0_ + l1_); e_ = DPP_ADDI(e_, 0xB1, 0xF); e_ = DPP_ADDI(e_, 0x4E, 0xF); e_ = DPP_ADDI(e_, 0x141, 0xF); EOUT = e_; } while (0)
#define PEER_SWEEPU(BODY0, BODY1, BODY2, BODY3) do { \
            PEER_LOADU(R0, 0); PEER_LOADU(R1, 1); PEER_LOADU(R2, 2); PEER_LOADU(R3, 3); \
            for (int s = 0; s < 128; s += 4) { \
                BODY0; if (s + 4 < 128) PEER_LOADU(R0, s + 4); \
                BODY1; if (s + 4 < 128) PEER_LOADU(R1, s + 5); \
                BODY2; if (s + 4 < 128) PEER_LOADU(R2, s + 6); \
                BODY3; if (s + 4 < 128) PEER_LOADU(R3, s + 7); } } while (0)
#define PEER_FIN(RR, SS) do { int e1_; PEER_DOTU(RR, e1_); Lx[(SS)] = e1_; } while (0)
        PEER_SWEEPU(PEER_FIN(R0, s), PEER_FIN(R1, s + 1), PEER_FIN(R2, s + 2), PEER_FIN(R3, s + 3));
#undef PEER_FIN
        float yscale;
        {
            float cf_[16]; float cmax = 0.f;
#pragma unroll
            for (int i = 0; i < 16; ++i) { const int ix = 16 * j + i; cf_[i] = Lg[ix] * gelu_cdf((float)Lx[ix] * __builtin_bit_cast(float, Lp[ix])); cmax = fmaxf(cmax, fabsf(cf_[i])); }
            cmax = fmaxf(cmax, __shfl_xor(cmax, 1, 8)); cmax = fmaxf(cmax, __shfl_xor(cmax, 2, 8)); cmax = fmaxf(cmax, __shfl_xor(cmax, 4, 8));
            const float cqs = cmax > 0.f ? 119.f / cmax : 0.f; yscale = cmax > 0.f ? cmax / 119.f : 0.f;
            int pk_[4];
#pragma unroll
            for (int m = 0; m < 2; ++m) { unsigned lo_ = 0u, hi_ = 0u;
#pragma unroll
                for (int n = 0; n < 8; ++n) { const int t_ = (int)rintf(cf_[8 * m + n] * cqs) + 8; lo_ |= (unsigned)(t_ & 15) << (4 * n); hi_ |= (unsigned)((t_ >> 4) & 15) << (4 * n); }
                pk_[2 * m] = (int)(lo_ ^ 0x88888888u); pk_[2 * m + 1] = (int)hi_; }
#pragma unroll
            for (int m = 0; m < 4; ++m) Lp[4 * j + m] = pk_[m];
        }
#pragma unroll
        for (int H = 0; H < 2; ++H) {
            int yi[64];
#pragma unroll
            for (int i = 0; i < 64; ++i) yi[i] = 0;
            v4u RV[8][2];
#define PEER_ROFFV(S0) ((size_t)(Le[(S0)] & (scratch_dst ? PEER_PROBE_MASK : 0xFFFF)) * 512 + 256 * H + 16 * j)
#pragma unroll
            for (int r = 0; r < 8; ++r) { const size_t ro_ = PEER_ROFFV(r); RV[r][0] = *(const GAS v4u*)(EV4 + ro_); RV[r][1] = *(const GAS v4u*)(EV4 + ro_ + 128); }
            for (int bt = 0; bt < 16; ++bt) {
                const int cl_ = Lp[2 * bt], ch_ = Lp[2 * bt + 1];
                size_t ron[8];
#pragma unroll
                for (int r = 0; r < 8; ++r) ron[r] = (bt + 1 < 16) ? PEER_ROFFV(8 * bt + 8 + r) : 0;
#pragma unroll
                for (int q = 0; q < 2; ++q) {
#pragma unroll
                    for (int w_ = 0; w_ < 4; ++w_) {
                        unsigned E[4], O[4];
#pragma unroll
                        for (int p_ = 0; p_ < 4; ++p_) { const unsigned x_ = RV[2 * p_][q][w_], y_ = RV[2 * p_ + 1][q][w_];
                            E[p_] = (x_ & 0x0F0F0F0Fu) | ((y_ << 4) & 0xF0F0F0F0u); O[p_] = ((x_ >> 4) & 0x0F0F0F0Fu) | (y_ & 0xF0F0F0F0u); }
                        unsigned C[8];
                        { const unsigned p0 = __builtin_amdgcn_perm(E[1], E[0], 0x05010400u), p1 = __builtin_amdgcn_perm(E[1], E[0], 0x07030602u), p2 = __builtin_amdgcn_perm(E[3], E[2], 0x05010400u), p3 = __builtin_amdgcn_perm(E[3], E[2], 0x07030602u);
                          C[0] = __builtin_amdgcn_perm(p2, p0, 0x05040100u); C[2] = __builtin_amdgcn_perm(p2, p0, 0x07060302u); C[4] = __builtin_amdgcn_perm(p3, p1, 0x05040100u); C[6] = __builtin_amdgcn_perm(p3, p1, 0x07060302u); }
                        { const unsigned p0 = __builtin_amdgcn_perm(O[1], O[0], 0x05010400u), p1 = __builtin_amdgcn_perm(O[1], O[0], 0x07030602u), p2 = __builtin_amdgcn_perm(O[3], O[2], 0x05010400u), p3 = __builtin_amdgcn_perm(O[3], O[2], 0x07030602u);
                          C[1] = __builtin_amdgcn_perm(p2, p0, 0x05040100u); C[3] = __builtin_amdgcn_perm(p2, p0, 0x07060302u); C[5] = __builtin_amdgcn_perm(p3, p1, 0x05040100u); C[7] = __builtin_amdgcn_perm(p3, p1, 0x07060302u); }
#pragma unroll
                        for (int n = 0; n < 8; ++n) { const int th_ = __builtin_amdgcn_sdot8((int)C[n], ch_, 0, false);
                            yi[32 * q + 8 * w_ + n] = __builtin_amdgcn_sdot8((int)C[n], cl_, yi[32 * q + 8 * w_ + n], false) + (th_ << 4); }
                    }
                    if (bt + 1 < 16) {
#pragma unroll
                        for (int r = 0; r < 8; ++r) RV[r][q] = *(const GAS v4u*)(EV4 + ron[r] + 128 * q); }
                }
            }
#undef PEER_ROFFV
            const int b = (int)(t / SEQ);
            const float* g2 = mod_ + b * NMOD + 5120 + 128 * H + 8 * j;
            const float* ip = out_ + t * D + 128 * H + 8 * j; float* op = (scratch_dst ? WSP(float, WS_SCORES) : out_) + t * D + 128 * H + 8 * j;
#pragma unroll
            for (int q = 0; q < 2; ++q)
#pragma unroll
                for (int w_ = 0; w_ < 4; ++w_)
#pragma unroll
                    for (int nh = 0; nh < 2; ++nh) { const int co = 256 * (2 * (w_ & 1) + nh) + 64 * q + 4 * (w_ >> 1); const int yb = 32 * q + 8 * w_ + 4 * nh;
                        const f32x4 x1 = *(const GAS f32x4*)(ip + co); const f32x4 gg = *(const f32x4*)(g2 + co) * yscale;
                        f32x4 o; o.x = x1.x + gg.x * (float)yi[yb]; o.y = x1.y + gg.y * (float)yi[yb + 1]; o.z = x1.z + gg.z * (float)yi[yb + 2]; o.w = x1.w + gg.w * (float)yi[yb + 3];
                        *(GAS f32x4*)(op + co) = o; }
        }
#undef PEER_LOADU
#undef PEER_DOTU
#undef PEER_SWEEPU
    }
}

DI void ph_inproj(const Frame& F) {
    pg8::Gemm g{WSP(bf16, WS_XN), WSP(bf16, WS_WIN), T, NPROJ, D}; pg8::StaticOrder S; S.init(T, NPROJ, F.G, (int)blockIdx.x);
    pg8::EpiBf16<0> E{WSP(bf16, WS_PROJ), NPROJ, nullptr, 0, 0, 1.f};
    pg8::gemm_phase<pg8::EpiBf16<0>, pg8::StaticOrder, PG8_ALIGN, PG8_SP2>(F.lds, g, S, E);
}
DI void ph_mix(const Frame& F, bool probe_first) {
    stage_conv_w(F);
    {
        int u = F.vcu;
        MlLocalRegs ra;
        if (u < 2048) ml_local_load(F, u >> 6, u & 63, ra);
        const int gwv = F.vcu * NWAVES + F.wave, NGWv = F.G * NWAVES;
        int eb = 2 * gwv;
        while (u < 2048) {
            const int un = u + F.G;
            MlLocalRegs rb;
            if (un < 2048) ml_local_load(F, un >> 6, un & 63, rb);
            ExpRows2 er; const bool ew = eb < 32768;
            if (ew) exp_load2(F, eb, er);
            ml_local_unit(F, u >> 6, u & 63, ra);
            if (ew) exp_conv2(F, eb, er);
            eb += 2 * NGWv;
            ra = rb; u = un;
        }
        for (; eb < 32768; eb += 2 * NGWv) { ExpRows2 er; exp_load2(F, eb, er); exp_conv2(F, eb, er); }
    }
    (void)probe_first;
}
DI void ph_scan_attn(const Frame& F) {
    ml_scan_phase(F);
    __syncthreads();
    for (int u = F.vcu; u < 1024; u += F.G) { const int qb = 15 - (u >> 6), bh = u & 63; sb_unit(F, bh >> 3, bh & 7, qb); }
}
DI void ph_mlout(const Frame& F) { stage_conv_w(F); for (int u = F.vcu; u < 2048; u += F.G) ml_out_unit(F, u >> 6, u & 63); }
#ifndef P5_ALIGN
#define P5_ALIGN PG8_ALIGN
#endif
DI void ph_outproj(const Frame& F) {
    pg8::Gemm g{WSP(bf16, WS_MIX), WSP(bf16, WS_WOUT), T, D, D}; pg8::StaticOrder S; S.init(T, D, F.G, (int)blockIdx.x);
    pg8::EpiResGate E{inp(I_X), (float*)inp(I_OUT), WSP(float, WS_MOD) + 2048, NMOD, SEQ, D};
    pg8::gemm_phase<pg8::EpiResGate, pg8::StaticOrder, P5_ALIGN, PG8_SP2>(F.lds, g, S, E);
}
DI void ph_scores(const Frame& F) {
    pg8::Gemm g{WSP(bf16, WS_XN), WSP(bf16, WS_WEFF), T, NSC, D}; pg8::StaticOrder S; S.init(T, NSC, F.G, (int)blockIdx.x);
    EpiTopK E{WSP(int, WS_IDX), WSP(float, WS_GATE)};
    pg8::Unit un;
    for (int i = 0; S.next(i, un); ++i) { OneUnit S1{un}; pg8::gemm_phase<EpiTopK, OneUnit, false, PG8_SP2>(F.lds, g, S1, E); }
}
constexpr int N_PHASES = 11;
struct Args { const float* in[19]; float* out; unsigned char* ws; int ph_lo, ph_hi; };
__global__ void __launch_bounds__(NTHR, 2) hybrid_fwd(Args args) {
    extern __shared__ __attribute__((aligned(16))) unsigned char lds_raw[];
    Frame F;
    F.lds = (LAS unsigned char*)lds_raw;
    F.MISC = (volatile LAS unsigned*)(F.lds + LDSCTL_OFF + 320);
    F.tid = threadIdx.x; F.lane = F.tid & 63; F.wave = __builtin_amdgcn_readfirstlane(F.tid >> 6);
    F.G = gridDim.x; { const int bx = blockIdx.x; F.vcu = (F.G % 8 == 0) ? (bx % 8) * (F.G / 8) + bx / 8 : bx; }
    F.ws = args.ws;
    F.ctl = (gu32*)(F.ws + WS_CTL);
    for (int u = F.tid; u < (LDS_BYTES - LDSCTL_OFF) / 4; u += NTHR) ((LAS unsigned*)(F.lds + LDSCTL_OFF))[u] = 0u;
    __syncthreads();
    const int lo = args.ph_lo, hi = args.ph_hi;
    const bool one_launch = (hi - lo) > 1;
    XcdBarrier bar; bar.bar = (unsigned*)(F.ctl + CW_BAR); bar.x = 0; bar.st = nullptr;
    if (one_launch) bar = xcd_barrier_post((unsigned*)(F.ctl + CW_BAR), F.MISC + 8);
#ifndef PHMASK
#define PHMASK 0x7ff
#endif
#define IN(k) (((PHMASK >> (k)) & 1) && lo <= (k) && (k) < hi)
#define SEAM(k) do { if (IN(k) && IN((k) + 1)) xcd_barrier(bar); } while (0)
#ifndef REPMASK
#define REPMASK 0
#endif

#define RUN(k, ...) do { if (IN(k)) { if ((REPMASK >> (k)) & 1) { { const bool first = true; (void)first; __VA_ARGS__; } xcd_barrier(bar); } { const bool first = false; (void)first; __VA_ARGS__; } } } while (0)
    RUN(0, p0_phase(F, first ? P0_PARTS : 15)); SEAM(0);
    RUN(1, norm_phase<true>(F, inp(I_X), inp(I_GN1), 0, 1024)); SEAM(1);
    RUN(2, ph_inproj(F)); SEAM(2);
    RUN(3, ph_mix(F, first)); SEAM(3);
    RUN(10, ph_scan_attn(F)); if (IN(10) && IN(4)) xcd_barrier(bar);
    RUN(4, ph_mlout(F)); SEAM(4);
    RUN(5, ph_outproj(F)); SEAM(5);
    RUN(6, norm_phase<false>(F, inp(I_OUT), inp(I_GN2), 3072, 4096)); SEAM(6);
    RUN(7, ph_scores(F)); if (IN(7) && IN(9)) xcd_barrier(bar);
    RUN(9, peer_phase(F, first));
#undef RUN
#undef IN
#undef SEAM
}

#ifndef MK_PER_PHASE
#define MK_PER_PHASE 0
#endif
extern "C" void kernel_launch(void* const* d_in, const int* in_sizes, int n_in, void* d_out, int out_size, void* d_ws, size_t ws_size, hipStream_t stream) {
    static int grid = 0;
    if (grid == 0) {
        if (n_in != 19 || in_sizes[0] != T * D || out_size != T * D || ws_size < WS_END) { fprintf(stderr, "kernel_launch: unexpected shapes (n_in %d, in0 %d, out %d, ws %zu)\n", n_in, n_in > 0 ? in_sizes[0] : -1, out_size, ws_size); grid = -1; return; }
        int dev = 0, cus = 0, per_cu = 0;
        if (hipGetDevice(&dev) != hipSuccess || hipDeviceGetAttribute(&cus, hipDeviceAttributeMultiprocessorCount, dev) != hipSuccess) { grid = -1; return; }
        if (hipFuncSetAttribute((const void*)hybrid_fwd, hipFuncAttributeMaxDynamicSharedMemorySize, LDS_BYTES) != hipSuccess) { fprintf(stderr, "kernel_launch: hipFuncSetAttribute failed\n"); grid = -1; return; }
        if (hipOccupancyMaxActiveBlocksPerMultiprocessor(&per_cu, (const void*)hybrid_fwd, NTHR, LDS_BYTES) != hipSuccess || per_cu < 1) fprintf(stderr, "kernel_launch: occupancy query says %d\n", per_cu);
        (void)hipGetLastError();
        grid = cus;
    }
    if (grid < 0) return;
    if (hipMemsetAsync((char*)d_ws + WS_CTL, 0, CTL_ZERO_BYTES, stream) != hipSuccess) { fprintf(stderr, "kernel_launch: memset failed\n"); return; }
    Args a{};
    for (int i = 0; i < 19; ++i) a.in[i] = (const float*)d_in[i];
    a.out = (float*)d_out; a.ws = (unsigned char*)d_ws;
#if MK_PER_PHASE
    { const int order[N_PHASES] = {0, 1, 2, 3, 10, 4, 5, 6, 7, 8, 9}; for (int i = 0; i < N_PHASES; ++i) { a.ph_lo = order[i]; a.ph_hi = order[i] + 1; hipLaunchKernelGGL(hybrid_fwd, dim3(grid), dim3(NTHR), LDS_BYTES, stream, a); } }
#else
    a.ph_lo = 0; a.ph_hi = N_PHASES;
    hipLaunchKernelGGL(hybrid_fwd, dim3(grid), dim3(NTHR), LDS_BYTES, stream, a);
#endif
    const hipError_t le = hipPeekAtLastError();
    if (le != hipSuccess) fprintf(stderr, "kernel_launch: launch failed: %s\n", hipGetErrorName(le));
}
```

```cpp
#include <cmath>
#include <hip/hip_runtime.h>
#include <cstdio>
#include <cstdint>
namespace pg8 {
#define PG8_LAS __attribute__((address_space(3)))
typedef unsigned short bf16_t;
typedef short bf16x8 __attribute__((ext_vector_type(8)));
typedef float f32x4 __attribute__((ext_vector_type(4)));
typedef unsigned u32x4 __attribute__((ext_vector_type(4)));
constexpr int BM = 256, BK = 64, HALF = 128, HTB = HALF * BK * 2  , STAGE_BYTES = 8 * HTB, NXCD = 8,
#ifndef PG8_WGM
#define PG8_WGM 4
#endif
WGM = PG8_WGM;

__host__ __device__ __forceinline__ int lds_byte(int r, int c) { const int st = (r >> 4) * 2 + (c >> 5), rr = r & 15, cc = c & 31, ob = rr * 64 + cc * 2; return st * 1024 + (ob ^ (((ob >> 9) & 1) << 5)); }
__host__ __device__ __forceinline__ void stage_rc(int b, int& R, int& C) { const int st = b / 1024, sb = b % 1024, swz = sb ^ (((sb >> 9) & 1) << 5); R = (st >> 1) * 16 + swz / 64; C = (st & 1) * 32 + (swz % 64) / 2; }
__host__ __device__ __forceinline__ int perm32(int rho) { const int n = rho >> 4, i = rho & 15; return 8 * (i >> 2) + 4 * n + (i & 3); }

struct Unit { int pm, pn; };
struct Gemm { const bf16_t* A; const bf16_t* Bt; int M, N, K; };

struct StaticOrder {
    int nM, nN, nwg, G, c;
    __host__ __device__ void init(int M, int N, int G_, int c_) { nM = M / BM; nN = N / BM; nwg = nM * nN; G = G_; c = c_; }
    __host__ __device__ bool next(int i, Unit& u) const {
        const long L = (long)i * G + c; if (L >= nwg) return false;
        int wgid = (int)L; { const int q = nwg / NXCD, r = nwg % NXCD, xcd = wgid % NXCD, off = wgid / NXCD; wgid = (xcd < r ? xcd * (q + 1) : r * (q + 1) + (xcd - r) * q) + off; }
        const int nig = WGM * nN, gid = wgid / nig, fm = gid * WGM, gsz = (nM - fm) < WGM ? (nM - fm) : WGM;
        u.pm = fm + ((wgid % nig) % gsz); u.pn = (wgid % nig) / gsz; return true;
    }
    __device__ __forceinline__ void a_ready(const Unit&) const {}
    __device__ __forceinline__ void done(const Unit&) const {}
};

__device__ __forceinline__ unsigned cvt_pk_bf16(float lo, float hi) { unsigned r; asm volatile("v_cvt_pk_bf16_f32 %0, %1, %2" : "=v"(r) : "v"(lo), "v"(hi)); return r; }
typedef float f32x2 __attribute__((ext_vector_type(2)));
__device__ __forceinline__ f32x2 gelu_pk(f32x2 v) {
    const f32x2 av = __builtin_elementwise_abs(v), d = av * 0.2316418882f + 1.0f;
    f32x2 t; t.x = __builtin_amdgcn_rcpf(d.x); t.y = __builtin_amdgcn_rcpf(d.y);
    f32x2 q = t * 0.5307027145f + (-0.7265760135f); q = q * t + 0.7107068705f; q = q * t + (-0.142248368f); q = q * t + 0.127414796f; q = q * t;
    const f32x2 s = (v * v) * (-0.72134752044f);
    f32x2 e; e.x = __builtin_amdgcn_exp2f(s.x); e.y = __builtin_amdgcn_exp2f(s.y);
    const f32x2 m = v * (q * e), r = v - m;
    f32x2 o; o.x = v.x < 0.f ? m.x : r.x; o.y = v.y < 0.f ? m.y : r.y; return o;
}

template <int ACT  > struct EpiBf16 {
    static constexpr bool PERM = true, AFTER_DRAIN = false; static_assert(ACT == 0 || ACT == 1, "EpiBf16: ACT is 0 (none) or 1 (gelu_pk)");
    bf16_t* O; int ldc; const float* bias; int split_cols; size_t split_stride; float scale0;
    __device__ __forceinline__ void operator()(const f32x4 (&acc)[2][2][4][2], const Unit& u, int wr, int wc, int fr, int fq) const {
        const int row0 = u.pm * BM + wr * 64 + fr; int colt = u.pn * BM; bf16_t* base = O;
        float sc = 1.f; if (split_cols) { const int t = colt / split_cols; base += (size_t)t * split_stride; colt -= t * split_cols; if (t == 0) sc = scale0; }
        const int col0 = colt + wc * 32 + 8 * fq, bcol0 = u.pn * BM + wc * 32 + 8 * fq;
        f32x4 bv[2][2];
#pragma unroll
        for (int bj = 0; bj < 2; ++bj)
#pragma unroll
            for (int n = 0; n < 2; ++n) bv[bj][n] = bias ? *(const f32x4*)(bias + bcol0 + bj * HALF + 4 * n) : (f32x4){0.f, 0.f, 0.f, 0.f};
#pragma unroll
        for (int ai = 0; ai < 2; ++ai)
#pragma unroll
            for (int m = 0; m < 4; ++m) { bf16_t* rowp = base + (size_t)(row0 + ai * HALF + m * 16) * ldc + col0;
#pragma unroll
                for (int bj = 0; bj < 2; ++bj) { f32x4 v0 = acc[ai][bj][m][0] + bv[bj][0], v1 = acc[ai][bj][m][1] + bv[bj][1];
                    if (ACT == 1) { f32x2 a = gelu_pk((f32x2){v0[0], v0[1]}), b = gelu_pk((f32x2){v0[2], v0[3]}), c = gelu_pk((f32x2){v1[0], v1[1]}), d = gelu_pk((f32x2){v1[2], v1[3]});
                        v0 = (f32x4){a.x, a.y, b.x, b.y}; v1 = (f32x4){c.x, c.y, d.x, d.y}; }
                    v0 = v0 * sc; v1 = v1 * sc; u32x4 w; w.x = cvt_pk_bf16(v0[0], v0[1]); w.y = cvt_pk_bf16(v0[2], v0[3]); w.z = cvt_pk_bf16(v1[0], v1[1]); w.w = cvt_pk_bf16(v1[2], v1[3]);
                    *(u32x4*)(rowp + bj * HALF) = w; } }
    }
};
template <class Epi, class Sched, bool ALIGN_EPI = false, bool SP2 = false>
__device__ __forceinline__ void gemm_phase(PG8_LAS unsigned char* lds, const Gemm g, const Sched& S, const Epi& E) {
    const int tid = threadIdx.x, wid = __builtin_amdgcn_readfirstlane(tid >> 6), lane = tid & 63, wr = wid >> 2, wc = wid & 3, fr = lane & 15, fq = lane >> 4;
    const int K = g.K, nt = K / BK;
    unsigned voffA[2], voffB[2];
#pragma unroll
    for (int i = 0; i < 2; ++i) { int R, C; stage_rc(tid * 16 + i * 8192, R, C); const int Rb = Epi::PERM ? ((R & ~31) + perm32(R & 31)) : R;
        voffA[i] = (unsigned)(R * K + C) * 2u; voffB[i] = (unsigned)(Rb * K + C) * 2u; }
    const size_t kstep = (size_t)(BK * 2);
    const size_t hstep = (size_t)HALF * K * 2;
    const size_t tstep = 2 * hstep;
    const unsigned ldsw = (unsigned)wid * 1024u;
    const int aoff = lds_byte(wr * 64 + fr, fq * 8), boff = lds_byte(wc * 32 + fr, fq * 8);
#define PG8_SA(b, h) (((b) * 2 + (h)) * HTB)
#define PG8_SB(b, h) ((4 + (b) * 2 + (h)) * HTB)
#define PG8_STAGE(bufoff, gbase, voff) do { _Pragma("unroll") for (int _i = 0; _i < 2; ++_i) \
        __builtin_amdgcn_global_load_lds((const unsigned*)((const char*)(gbase) + (voff)[_i]), (PG8_LAS unsigned*)(lds + (bufoff) + ldsw + _i * 8192), 16, 0, 0); } while (0)
#define PG8_LDA(dst, b, h) do { _Pragma("unroll") for (int m = 0; m < 4; ++m) _Pragma("unroll") for (int k = 0; k < 2; ++k) dst[m][k] = *(const PG8_LAS bf16x8*)(lds + PG8_SA(b, h) + aoff + m * 2048 + k * 1024); } while (0)
#define PG8_LDB(dst, b, h) do { _Pragma("unroll") for (int n = 0; n < 2; ++n) _Pragma("unroll") for (int k = 0; k < 2; ++k) dst[n][k] = *(const PG8_LAS bf16x8*)(lds + PG8_SB(b, h) + boff + n * 2048 + k * 1024); } while (0)
#define PG8_MMA(ai, bj, At, Bt) do { __builtin_amdgcn_s_setprio(1); _Pragma("unroll") for (int m = 0; m < 4; ++m) _Pragma("unroll") for (int n = 0; n < 2; ++n) _Pragma("unroll") for (int k = 0; k < 2; ++k) \
        acc[ai][bj][m][n] = __builtin_amdgcn_mfma_f32_16x16x32_bf16(Bt[n][k], At[m][k], acc[ai][bj][m][n], 0, 0, 0); __builtin_amdgcn_s_setprio(0); } while (0)
#define PG8_WAIT_V(n) asm volatile("s_waitcnt vmcnt(" #n ")" ::: "memory")
#define PG8_WAIT_L(n) asm volatile("s_waitcnt lgkmcnt(" #n ")" ::: "memory")
#define PG8_BAR __builtin_amdgcn_s_barrier()
#define PG8_SCHED __builtin_amdgcn_sched_barrier(0)
    Unit cur, nxt; int ui = 0;
    if (!S.next(0, cur)) return;
    f32x4 acc[2][2][4][2];
#pragma unroll
    for (int a = 0; a < 2; ++a)
#pragma unroll
        for (int b = 0; b < 2; ++b)
#pragma unroll
            for (int m = 0; m < 4; ++m)
#pragma unroll
                for (int n = 0; n < 2; ++n) acc[a][b][m][n] = (f32x4){0.f, 0.f, 0.f, 0.f};
    bf16x8 At[4][2], B0[2][2], B1[2][2];
    const char* cA = (const char*)g.A + (size_t)cur.pm * tstep; const char* cB = (const char*)g.Bt + (size_t)cur.pn * tstep;
    S.a_ready(cur);
    if constexpr (SP2) {
        PG8_STAGE(PG8_SB(0, 0), cB, voffB); PG8_STAGE(PG8_SB(0, 1), cB + hstep, voffB); PG8_STAGE(PG8_SA(0, 0), cA, voffA); PG8_STAGE(PG8_SA(0, 1), cA + hstep, voffA);
        if (wr == 1) PG8_BAR;
        PG8_WAIT_V(2); PG8_BAR;
        PG8_STAGE(PG8_SB(1, 0), cB + kstep, voffB); PG8_STAGE(PG8_SA(1, 0), cA + kstep, voffA); PG8_STAGE(PG8_SB(1, 1), cB + hstep + kstep, voffB);
        PG8_WAIT_V(6); PG8_BAR;
    } else {
        PG8_STAGE(PG8_SB(0, 0), cB, voffB); PG8_STAGE(PG8_SA(0, 0), cA, voffA); PG8_STAGE(PG8_SB(0, 1), cB + hstep, voffB); PG8_STAGE(PG8_SA(0, 1), cA + hstep, voffA);
        if (wr == 1) PG8_BAR;
        PG8_WAIT_V(4); PG8_BAR;
        PG8_STAGE(PG8_SB(1, 0), cB + kstep, voffB); PG8_STAGE(PG8_SA(1, 0), cA + kstep, voffA); PG8_STAGE(PG8_SB(1, 1), cB + hstep + kstep, voffB);
        PG8_WAIT_V(6); PG8_BAR;
    }
    for (;;) {
        const bool has_next = S.next(ui + 1, nxt);
        const char* nA = has_next ? (const char*)g.A + (size_t)nxt.pm * tstep : cA; const char* nB = has_next ? (const char*)g.Bt + (size_t)nxt.pn * tstep : cB;
        for (int t = 0; t < nt; t += 2) {
            const bool last = (t == nt - 2);
            const char* a1 = cA + (size_t)(t + 1) * kstep;
            const char* a2 = last ? nA : cA + (size_t)(t + 2) * kstep; const char* b2 = last ? nB : cB + (size_t)(t + 2) * kstep;
            const char* a3 = a2 + kstep; const char* b3 = b2 + kstep;
            if (last && has_next) S.a_ready(nxt);
            if constexpr (SP2) {
            PG8_LDB(B0, 0, 0); PG8_LDB(B1, 0, 1); PG8_SCHED; PG8_LDA(At, 0, 0); PG8_STAGE(PG8_SA(1, 1), a1 + hstep, voffA);
            PG8_WAIT_V(8); PG8_WAIT_L(0); PG8_BAR; PG8_MMA(0, 0, At, B0); PG8_MMA(0, 1, At, B1); PG8_BAR; PG8_SCHED;
            PG8_LDA(At, 0, 1); PG8_STAGE(PG8_SB(0, 0), b2, voffB); PG8_STAGE(PG8_SB(0, 1), b2 + hstep, voffB); PG8_STAGE(PG8_SA(0, 0), a2, voffA);
            PG8_WAIT_V(8); PG8_WAIT_L(0); PG8_BAR; PG8_MMA(1, 0, At, B0); PG8_MMA(1, 1, At, B1); PG8_BAR; PG8_SCHED;
            PG8_LDB(B0, 1, 0); PG8_LDB(B1, 1, 1); PG8_SCHED; PG8_LDA(At, 1, 0); PG8_STAGE(PG8_SA(0, 1), a2 + hstep, voffA);
            PG8_WAIT_V(8); PG8_WAIT_L(0); PG8_BAR; PG8_MMA(0, 0, At, B0); PG8_MMA(0, 1, At, B1); PG8_BAR; PG8_SCHED;
            PG8_LDA(At, 1, 1); PG8_STAGE(PG8_SB(1, 0), b3, voffB); PG8_STAGE(PG8_SB(1, 1), b3 + hstep, voffB); PG8_STAGE(PG8_SA(1, 0), a3, voffA);
            PG8_WAIT_V(8); PG8_WAIT_L(0); PG8_BAR; PG8_MMA(1, 0, At, B0); PG8_MMA(1, 1, At, B1); PG8_BAR; PG8_SCHED;
            } else {
            PG8_LDB(B0, 0, 0); PG8_SCHED; PG8_LDA(At, 0, 0); PG8_STAGE(PG8_SA(1, 1), a1 + hstep, voffA);
            PG8_WAIT_L(8); PG8_BAR; PG8_WAIT_L(0); PG8_MMA(0, 0, At, B0); PG8_BAR; PG8_SCHED;
            PG8_LDB(B1, 0, 1); PG8_STAGE(PG8_SB(0, 0), b2, voffB);
            PG8_BAR; PG8_WAIT_L(0); PG8_MMA(0, 1, At, B1); PG8_BAR;
            PG8_LDA(At, 0, 1); PG8_STAGE(PG8_SA(0, 0), a2, voffA);
            PG8_BAR; PG8_WAIT_L(0); PG8_MMA(1, 0, At, B0); PG8_BAR; PG8_SCHED;
            PG8_STAGE(PG8_SB(0, 1), b2 + hstep, voffB);
            PG8_WAIT_V(6); PG8_BAR; PG8_MMA(1, 1, At, B1); PG8_BAR;
            PG8_LDB(B0, 1, 0); PG8_SCHED; PG8_LDA(At, 1, 0); PG8_STAGE(PG8_SA(0, 1), a2 + hstep, voffA);
            PG8_WAIT_L(8); PG8_BAR; PG8_WAIT_L(0); PG8_MMA(0, 0, At, B0); PG8_BAR; PG8_SCHED;
            PG8_LDB(B1, 1, 1); PG8_STAGE(PG8_SB(1, 0), b3, voffB);
            PG8_BAR; PG8_WAIT_L(0); PG8_MMA(0, 1, At, B1); PG8_BAR;
            PG8_LDA(At, 1, 1); PG8_STAGE(PG8_SA(1, 0), a3, voffA);
            PG8_BAR; PG8_WAIT_L(0); PG8_MMA(1, 0, At, B0); PG8_BAR; PG8_SCHED;
            PG8_STAGE(PG8_SB(1, 1), b3 + hstep, voffB);
            PG8_WAIT_V(6); PG8_BAR; PG8_MMA(1, 1, At, B1); PG8_BAR;
            }
        }
        if constexpr (ALIGN_EPI) { if (wr == 0) PG8_BAR; }
        if constexpr (!Epi::AFTER_DRAIN) { E(acc, cur, wr, wc, fr, fq); S.done(cur); }
        if (!has_next) break;
#pragma unroll
        for (int a = 0; a < 2; ++a)
#pragma unroll
            for (int b = 0; b < 2; ++b)
#pragma unroll
                for (int m = 0; m < 4; ++m)
#pragma unroll
                    for (int n = 0; n < 2; ++n) acc[a][b][m][n] = (f32x4){0.f, 0.f, 0.f, 0.f};
        cur = nxt; cA = nA; cB = nB; ++ui;
        if constexpr (ALIGN_EPI) { if (wr == 1) PG8_BAR; }
    }
    PG8_WAIT_V(0);
    if constexpr (!ALIGN_EPI) { if (wr == 0) PG8_BAR; }
    PG8_BAR;
    if constexpr (Epi::AFTER_DRAIN) { E.fused(acc, cur, wr, wc, fr, fq, lds, wid, lane); S.done(cur); }
#undef PG8_SA
#undef PG8_SB
#undef PG8_STAGE
#undef PG8_LDA
#undef PG8_LDB
#undef PG8_MMA
#undef PG8_WAIT_V
#undef PG8_WAIT_L
#undef PG8_BAR
#undef PG8_SCHED
}
}

#ifndef PG8_SP2
#define PG8_SP2 true
#endif
#ifndef PG8_ALIGN
#define PG8_ALIGN true
#endif

namespace pg8 {
struct EpiResGate {
    static constexpr bool PERM = false, AFTER_DRAIN = false;
    const float* base; float* out; const float* gate; int gate_ld; int rows_per_batch; int ldc;
    __device__ __forceinline__ void operator()(const f32x4 (&acc)[2][2][4][2], const Unit& u, int wr, int wc, int fr, int fq) const {
        const int row0 = u.pm * BM + wr * 64 + fr, col0 = u.pn * BM + wc * 32 + 4 * fq;
        const float* gp = gate + (size_t)((u.pm * BM) / rows_per_batch) * gate_ld + col0;
        f32x4 gv[2][2];
#pragma unroll
        for (int bj = 0; bj < 2; ++bj)
#pragma unroll
            for (int n = 0; n < 2; ++n) gv[bj][n] = *(const f32x4*)(gp + bj * HALF + n * 16);
#pragma unroll
        for (int ai = 0; ai < 2; ++ai)
#pragma unroll
            for (int m = 0; m < 4; ++m) { const size_t off = (size_t)(row0 + ai * HALF + m * 16) * ldc + col0;
#pragma unroll
                for (int bj = 0; bj < 2; ++bj)
#pragma unroll
                    for (int n = 0; n < 2; ++n) { const f32x4 bs = *(const f32x4*)(base + off + bj * HALF + n * 16);
                        *(f32x4*)(out + off + bj * HALF + n * 16) = bs + gv[bj][n] * acc[ai][bj][m][n]; } }
    }
};
struct EpiF32 {
    static constexpr bool PERM = false, AFTER_DRAIN = false;
    float* O; int ldc;
    __device__ __forceinline__ void operator()(const f32x4 (&acc)[2][2][4][2], const Unit& u, int wr, int wc, int fr, int fq) const {
        const int row0 = u.pm * BM + wr * 64 + fr, col0 = u.pn * BM + wc * 32 + 4 * fq;
#pragma unroll
        for (int ai = 0; ai < 2; ++ai)
#pragma unroll
            for (int m = 0; m < 4; ++m) { const size_t off = (size_t)(row0 + ai * HALF + m * 16) * ldc + col0;
#pragma unroll
                for (int bj = 0; bj < 2; ++bj)
#pragma unroll
                    for (int n = 0; n < 2; ++n) *(f32x4*)(O + off + bj * HALF + n * 16) = acc[ai][bj][m][n]; }
    }
};
}
#define GAS __attribute__((address_space(1)))
#define LAS __attribute__((address_space(3)))
typedef unsigned short bf16;
typedef unsigned v4u __attribute__((ext_vector_type(4)));
typedef float f32x4 __attribute__((ext_vector_type(4)));
typedef short bf16x8 __attribute__((ext_vector_type(8)));
typedef GAS unsigned gu32;
typedef GAS unsigned long long gu64;
#define RLX_AGENT __ATOMIC_RELAXED, __HIP_MEMORY_SCOPE_AGENT
#define LDS_WAIT() asm volatile("s_waitcnt lgkmcnt(0)" ::: "memory")
#define VM_WAIT() asm volatile("s_waitcnt vmcnt(0)" ::: "memory")
__device__ __forceinline__ unsigned long long rt() { return __builtin_amdgcn_s_memrealtime(); }
__device__ __forceinline__ unsigned f2bf(float f) { unsigned u = __builtin_bit_cast(unsigned, f); return (u + 0x7fffu + ((u >> 16) & 1u)) >> 16; }
__device__ __forceinline__ unsigned pk2(float lo, float hi) { return f2bf(lo) | (f2bf(hi) << 16); }

#define XB_TMO      128
#define XB_XCNT(j)  (256  + 64 * (j))
#define XB_XSUB(j)  (1280 + 64 * (j))
#define XB_XGEN(j)  (2304 + 64 * (j))
#define XB_TOP      3328
#define XB_TOPGEN   3392
#define XCD_BAR_WORDS 3456
#define XB_SPIN_CAP (1u << 24)

__device__ __forceinline__ unsigned xb_ld(unsigned* p)              { return __hip_atomic_load(p, __ATOMIC_RELAXED, __HIP_MEMORY_SCOPE_AGENT); }
__device__ __forceinline__ unsigned xb_add(unsigned* p, unsigned v) { return __hip_atomic_fetch_add(p, v, __ATOMIC_RELAXED, __HIP_MEMORY_SCOPE_AGENT); }
__device__ __forceinline__ unsigned xb_xcc_id() { return (unsigned)__builtin_amdgcn_s_getreg((3 << 11) | 20) & 0xFu; }
#define XB_SPIN(cond, bar) do { unsigned _sp = 0; while (cond) { __builtin_amdgcn_s_sleep(1); \
    if ((++_sp & 255u) == 0u) { if (xb_ld(&(bar)[XB_TMO])) break; if (_sp > XB_SPIN_CAP) { atomicAdd(&(bar)[XB_TMO], 1u); break; } } } } while (0)

struct XcdBarrier {
    unsigned* bar; unsigned x;
    volatile LAS unsigned* st;
};

__device__ __forceinline__ XcdBarrier xcd_barrier_post(unsigned* bar, volatile LAS unsigned* st) {
    XcdBarrier b; b.bar = bar; b.x = xb_xcc_id(); b.st = st;
    if (threadIdx.x == 0) (void)xb_add(&bar[XB_XCNT(b.x)], 1u);
    return b;
}
__device__ __forceinline__ void xcd_barrier_complete(unsigned* bar, unsigned x, unsigned& nloc, unsigned& nx) {
    const unsigned G = gridDim.x * gridDim.y * gridDim.z;
    unsigned sum, cnt, mine, sp = 0u;
    for (;;) {
        sum = 0u; cnt = 0u; mine = 0u;
#pragma unroll
        for (unsigned j = 0; j < 16; ++j) { const unsigned c = xb_ld(&bar[XB_XCNT(j)]); sum += c; cnt += (c > 0u) ? 1u : 0u; mine = (j == x) ? c : mine; }
        if (sum == G) break;
        __builtin_amdgcn_s_sleep(1);
        if ((++sp & 255u) == 0u) { if (xb_ld(&bar[XB_TMO])) break; if (sp > XB_SPIN_CAP) { atomicAdd(&bar[XB_TMO], 1u); break; } }
    }
    nloc = mine > 0u ? mine : 1u; nx = cnt > 0u ? cnt : 1u;
}

__device__ __forceinline__ void xcd_barrier(const XcdBarrier& b) {
    asm volatile("s_waitcnt vmcnt(0)" ::: "memory");
    __syncthreads();
    if (threadIdx.x == 0) {
        unsigned* bar = b.bar;
        __builtin_amdgcn_s_waitcnt(0);
        unsigned nloc = b.st[0], nx = b.st[1];
        if (nloc == 0u) { xcd_barrier_complete(bar, b.x, nloc, nx); b.st[0] = nloc; b.st[1] = nx; }
        const unsigned old = xb_add(&bar[XB_XSUB(b.x)], 1u);
        const unsigned gen = old / nloc;
        if (old + 1u == (gen + 1u) * nloc) {
            __builtin_amdgcn_fence(__ATOMIC_RELEASE, "agent");
            asm volatile("s_waitcnt vmcnt(0)" ::: "memory");
            const unsigned og = xb_add(&bar[XB_TOP], 1u);
            const unsigned tg = og / nx;
            if (og + 1u == (tg + 1u) * nx) xb_add(&bar[XB_TOPGEN], 1u);
            else XB_SPIN(xb_ld(&bar[XB_TOPGEN]) == tg, bar);
            __builtin_amdgcn_fence(__ATOMIC_ACQUIRE, "agent");
            xb_add(&bar[XB_XGEN(b.x)], 1u);
            asm volatile("s_waitcnt vmcnt(0)" ::: "memory");
        } else {
            XB_SPIN(xb_ld(&bar[XB_XGEN(b.x)]) == gen, bar);
            __builtin_amdgcn_fence(__ATOMIC_ACQUIRE, "agent");
            asm volatile("s_waitcnt vmcnt(0)" ::: "memory");
        }
    }
    __syncthreads();
}

constexpr int NWAVES = 8, NTHR = 512;
constexpr int NB = 8, SEQ = 4096, T = NB * SEQ, D = 1024, NPROJ = 3584, NIN = 3592, NMOD = 6144, NSC = 2048;
constexpr int C_QSB = 0, C_KSB = 512, C_VSB = 1024, C_QML = 1536, C_KML = 2048, C_VML = 2560, C_OML = 3072;
constexpr float EPS = 1e-6f, LOG2E = 1.4426950408889634f;
constexpr size_t MiB = 1u << 20;
constexpr size_t WS_CTL = 0, CTL_ZERO_BYTES = 1 * MiB;
constexpr size_t WS_MOD = 256 * 1024;
constexpr size_t WS_WIN = 2 * MiB, WS_WOUT = 10 * MiB, WS_WEFF = 12 * MiB;
constexpr size_t WS_XN = 16 * MiB;
constexpr size_t WS_PROJ = 80 * MiB;
constexpr size_t WS_MIX = 304 * MiB;
constexpr size_t WS_EXPU = 368 * MiB, WS_EXPV = 400 * MiB;
constexpr size_t WS_CST = 432 * MiB;
constexpr size_t WS_NST = 496 * MiB;
constexpr size_t WS_MST = 497 * MiB;
constexpr size_t WS_GATES = 498 * MiB;
constexpr size_t WS_SCORES = 80 * MiB;
constexpr size_t WS_IDX = 336 * MiB, WS_GATE = 352 * MiB;
constexpr size_t WS_SCL = 499 * MiB;
constexpr size_t WS_SUI = 499 * MiB + 65536, WS_SVI = 499 * MiB + 131072;
constexpr size_t WS_END = 500 * MiB;
constexpr int CW_Q3 = 64;
constexpr int CW_BAR = 4096;
constexpr int LDS_BYTES = 147456, LDSCTL_OFF = 143360;

typedef float f32x16 __attribute__((ext_vector_type(16)));
typedef float f32x2_t __attribute__((ext_vector_type(2)));
typedef __bf16 bf16x2_t __attribute__((ext_vector_type(2)));
typedef _Float16 f16x8 __attribute__((ext_vector_type(8)));
typedef short s16x4 __attribute__((ext_vector_type(4)));
typedef unsigned u32x2 __attribute__((ext_vector_type(2)));
#define DI __device__ __forceinline__
DI unsigned cvtpk(float lo, float hi) { f32x2_t v = {lo, hi}; bf16x2_t b = __builtin_convertvector(v, bf16x2_t); return __builtin_bit_cast(unsigned, b); }
DI float bflo(unsigned u) { return __uint_as_float(u << 16); }
DI float bfhi(unsigned u) { return __uint_as_float(u & 0xffff0000u); }
DI int crow(int i, int hi) { return (i & 3) + 8 * (i >> 2) + 4 * hi; }
DI int krow(int s, int hi, int j) { return 16 * s + 8 * (j >> 2) + 4 * hi + (j & 3); }
DI float swap_add(float v) { auto rr = __builtin_amdgcn_permlane32_swap(__float_as_uint(v), __float_as_uint(v), false, false); return __uint_as_float(rr[0]) + __uint_as_float(rr[1]); }
DI float swap_max(float v) { auto rr = __builtin_amdgcn_permlane32_swap(__float_as_uint(v), __float_as_uint(v), false, false); return fmaxf(__uint_as_float(rr[0]), __uint_as_float(rr[1])); }
DI float dot2bf(unsigned a, unsigned b, float acc) { return __builtin_amdgcn_fdot2_f32_bf16(__builtin_bit_cast(bf16x2_t, a), __builtin_bit_cast(bf16x2_t, b), acc, false); }
DI float ex2(float x) { return __builtin_amdgcn_exp2f(x); }
DI float lg2(float x) { return __builtin_amdgcn_logf(x); }
DI float fexp(float x) { return __builtin_amdgcn_exp2f(x * LOG2E); }
DI float wave_sum(float v) {
#pragma unroll
    for (int o = 1; o < 64; o <<= 1) v += __shfl_xor(v, o);
    return v;
}
DI float wave_max(float v) {
#pragma unroll
    for (int o = 1; o < 64; o <<= 1) v = fmaxf(v, __shfl_xor(v, o));
    return v;
}
#define DPP_MAXF(v, ctrl, rmask) fmaxf((v), __builtin_bit_cast(float, __builtin_amdgcn_update_dpp(0, __builtin_bit_cast(int, (v)), (ctrl), (rmask), 0xF, false)))
DI float wave_max_nonneg(float v) {
    v = DPP_MAXF(v, 0xB1, 0xF); v = DPP_MAXF(v, 0x4E, 0xF); v = DPP_MAXF(v, 0x141, 0xF); v = DPP_MAXF(v, 0x140, 0xF); v = DPP_MAXF(v, 0x142, 0xA); v = DPP_MAXF(v, 0x143, 0xC);
    return __builtin_bit_cast(float, __builtin_amdgcn_readlane(__builtin_bit_cast(int, v), 63));
}
#define DPP_ADDF(v, ctrl, rmask) ((v) + __builtin_bit_cast(float, __builtin_amdgcn_update_dpp(0, __builtin_bit_cast(int, (v)), (ctrl), (rmask), 0xF, false)))
DI float wave_sum_u(float v) {
    v = DPP_ADDF(v, 0xB1, 0xF); v = DPP_ADDF(v, 0x4E, 0xF); v = DPP_ADDF(v, 0x141, 0xF); v = DPP_ADDF(v, 0x140, 0xF); v = DPP_ADDF(v, 0x142, 0xA); v = DPP_ADDF(v, 0x143, 0xC);
    return __builtin_bit_cast(float, __builtin_amdgcn_readlane(__builtin_bit_cast(int, v), 63));
}
typedef short v4i16_t __attribute__((ext_vector_type(4)));
DI s16x4 trrd(LAS unsigned char* p) { return __builtin_bit_cast(s16x4, __builtin_amdgcn_ds_read_tr16_b64_v4i16((LAS v4i16_t*)p)); }
DI bf16x8 cat8(s16x4 a, s16x4 b) { return (bf16x8){a[0], a[1], a[2], a[3], b[0], b[1], b[2], b[3]}; }
#define MFMA_BF16(a, b, c) __builtin_amdgcn_mfma_f32_32x32x16_bf16((a), (b), (c), 0, 0, 0)
#define MFMA_F16(a, b, c) __builtin_amdgcn_mfma_f32_32x32x16_f16((a), (b), (c), 0, 0, 0)
DI unsigned pkh(float a, float b) { return __builtin_bit_cast(unsigned, __builtin_amdgcn_cvt_pkrtz(a, b)); }
DI bf16x8 packbf(const f32x16& x, int s) { v4u p; p.x = cvtpk(x[8 * s], x[8 * s + 1]); p.y = cvtpk(x[8 * s + 2], x[8 * s + 3]); p.z = cvtpk(x[8 * s + 4], x[8 * s + 5]); p.w = cvtpk(x[8 * s + 6], x[8 * s + 7]); return __builtin_bit_cast(bf16x8, p); }
DI f16x8 packh(const f32x16& x, int s) { v4u p; p.x = pkh(x[8 * s], x[8 * s + 1]); p.y = pkh(x[8 * s + 2], x[8 * s + 3]); p.z = pkh(x[8 * s + 4], x[8 * s + 5]); p.w = pkh(x[8 * s + 6], x[8 * s + 7]); return __builtin_bit_cast(f16x8, p); }

struct Frame {
    LAS unsigned char* lds;
    volatile LAS unsigned* MISC;
    gu32* ctl;
    unsigned char* ws;
    int tid, lane, wave, vcu, G;
};
DI const float* inp(int i) { const __attribute__((address_space(4))) unsigned long long* kp = (const __attribute__((address_space(4))) unsigned long long*)__builtin_amdgcn_kernarg_segment_ptr(); return (const float*)(const GAS float*)(*(volatile const __attribute__((address_space(4))) unsigned long long*)(kp + i)); }
enum { I_X = 0, I_C, I_WADA, I_BADA, I_GN1, I_WIN, I_BIG, I_BFG, I_CONVW, I_GQ, I_GK, I_GOSB, I_GOML, I_WOUT, I_GN2, I_WQ, I_SK, I_EU, I_EV, I_OUT };
#define WSP(type, off) ((type*)(F.ws + (off)))

DI void p0_transpose_item(const float* W, int K, int N, int ld, bf16* WT, LAS float* scr, int item, int lane) {
    const int nblk = N / 32, kb = item / nblk, nb = item % nblk, k0 = 64 * kb, n0 = 32 * nb;
    float tv[32];
#pragma unroll
    for (int i = 0; i < 32; ++i) tv[i] = W[(size_t)(k0 + 2 * i + (lane >> 5)) * ld + n0 + (lane & 31)];
#pragma unroll
    for (int i = 0; i < 32; ++i) scr[(2 * i + (lane >> 5)) * 33 + (lane & 31)] = tv[i];
    LDS_WAIT(); asm volatile("" ::: "memory");
    const int c = lane & 7;
#pragma unroll
    for (int j = 0; j < 4; ++j) { const int n = (lane >> 3) + 8 * j; const LAS float* s = scr + (8 * c) * 33 + n;
        v4u o; o.x = pk2(s[0 * 33], s[1 * 33]); o.y = pk2(s[2 * 33], s[3 * 33]); o.z = pk2(s[4 * 33], s[5 * 33]); o.w = pk2(s[6 * 33], s[7 * 33]);
        *(GAS v4u*)(WT + (size_t)(n0 + n) * K + k0 + 8 * c) = o; }
    LDS_WAIT(); asm volatile("" ::: "memory");
}
DI void p0_mod_block(const Frame& F, int item) {
    const float* const c_ = inp(I_C); const float* const w_ada_ = inp(I_WADA); const float* const b_ada_ = inp(I_BADA); float* const mod_ = WSP(float, WS_MOD);
    LAS float* scr = (LAS float*)(F.lds + F.wave * 16384);
    const int j = item * 64 + F.lane, d0 = F.wave * 128;
#pragma unroll
    for (int b = 0; b < 8; ++b)
#pragma unroll
        for (int q = 0; q < 2; ++q) { const float cv = c_[b * D + d0 + 64 * q + F.lane]; scr[b * 128 + 64 * q + F.lane] = cv / (1.f + fexp(-cv)); }
    LDS_WAIT(); asm volatile("" ::: "memory");
    float acc[8];
#pragma unroll
    for (int b = 0; b < 8; ++b) acc[b] = 0.f;
#pragma unroll 32
    for (int dd = 0; dd < 128; ++dd) { const float w = w_ada_[(size_t)(d0 + dd) * NMOD + j];
#pragma unroll
        for (int b = 0; b < 8; ++b) acc[b] += scr[b * 128 + dd] * w; }
#pragma unroll
    for (int b = 0; b < 8; ++b) scr[1024 + b * 64 + F.lane] = acc[b];
    __syncthreads();
    float tot = b_ada_[j];
#pragma unroll
    for (int w = 0; w < 8; ++w) tot += ((LAS float*)(F.lds + w * 16384))[1024 + F.wave * 64 + F.lane];
    mod_[F.wave * NMOD + j] = tot;
    __syncthreads();
}
DI void p0_weff_item(const Frame& F, int item) {
    const float* const sub_keys_ = inp(I_SK); const float* const w_q_peer_ = inp(I_WQ); bf16* const Weff_t_ = WSP(bf16, WS_WEFF);
    const int hp = item >> 4, dblk = item & 15;
    LAS float* sk = (LAS float*)F.lds;
    LAS float* rb = (LAS float*)(F.lds + 67584) + F.wave * 1024;
    { float tv[32];
#pragma unroll
      for (int i = 0; i < 32; ++i) tv[i] = sub_keys_[(size_t)hp * 16384 + F.tid + 512 * i];
#pragma unroll
      for (int i = 0; i < 32; ++i) { const int idx = F.tid + 512 * i; sk[(idx >> 7) * 129 + (idx & 127)] = tv[i]; } }
    const int d0 = 64 * dblk + 8 * F.wave;
#pragma unroll
    for (int r = 0; r < 8; ++r) { rb[r * 128 + F.lane] = w_q_peer_[(size_t)(d0 + r) * NSC + hp * 128 + F.lane]; rb[r * 128 + 64 + F.lane] = w_q_peer_[(size_t)(d0 + r) * NSC + hp * 128 + 64 + F.lane]; }
    __syncthreads();
    float a0[8], a1[8];
#pragma unroll
    for (int r = 0; r < 8; ++r) { a0[r] = 0.f; a1[r] = 0.f; }
#pragma unroll 4
    for (int c = 0; c < 128; ++c) { const float s0 = sk[F.lane * 129 + c], s1 = sk[(F.lane + 64) * 129 + c];
#pragma unroll
        for (int r = 0; r < 8; ++r) { const float a = rb[r * 128 + c]; a0[r] += a * s0; a1[r] += a * s1; } }
    v4u o0, o1; o0.x = pk2(a0[0], a0[1]); o0.y = pk2(a0[2], a0[3]); o0.z = pk2(a0[4], a0[5]); o0.w = pk2(a0[6], a0[7]);
    o1.x = pk2(a1[0], a1[1]); o1.y = pk2(a1[2], a1[3]); o1.z = pk2(a1[4], a1[5]); o1.w = pk2(a1[6], a1[7]);
    *(GAS v4u*)(Weff_t_ + (size_t)(hp * 128 + F.lane) * D + d0) = o0;
    *(GAS v4u*)(Weff_t_ + (size_t)(hp * 128 + 64 + F.lane) * D + d0) = o1;
    __syncthreads();
}
struct ExpRows2 { f32x4 v[2][4]; };
DI void exp_load2(const Frame& F, int blk0, ExpRows2& R) {
    const float* const expert_u_ = inp(I_EU); const float* const expert_v_ = inp(I_EV);
#pragma unroll
    for (int bb = 0; bb < 2; ++bb) { const int blk = blk0 + bb; const float* src = (blk < 16384 ? expert_u_ : expert_v_) + (size_t)(blk & 16383) * 1024 + 4 * F.lane;
#pragma unroll
        for (int k = 0; k < 4; ++k) R.v[bb][k] = __builtin_nontemporal_load((const GAS f32x4*)(src + 256 * k)); }
}
DI void exp_conv2(const Frame& F, int blk0, const ExpRows2& R) {
    float* const SUI_ = WSP(float, WS_SUI); float* const SVI_ = WSP(float, WS_SVI);
#pragma unroll
    for (int bb = 0; bb < 2; ++bb) { const int blk = blk0 + bb; const bool isu = blk < 16384; const int e = blk & 16383;
        float mx = 0.f;
#pragma unroll
        for (int k = 0; k < 4; ++k) mx = fmaxf(mx, fmaxf(fmaxf(fabsf(R.v[bb][k].x), fabsf(R.v[bb][k].y)), fmaxf(fabsf(R.v[bb][k].z), fabsf(R.v[bb][k].w))));
        mx = wave_max_nonneg(mx);
        {
            float best = 3.0e38f, bs = 0.f;
#define EXP_TRY(FAC) do { const float s_ = mx * ((FAC) / 7.f), inv_ = s_ > 0.f ? 1.f / s_ : 0.f; float er_ = 0.f; \
                _Pragma("unroll") for (int k = 0; k < 4; ++k) _Pragma("unroll") for (int c = 0; c < 4; ++c) { const float v_ = R.v[bb][k][c]; const float d_ = v_ - s_ * fminf(fmaxf(rintf(v_ * inv_), -7.f), 7.f); er_ += d_ * d_; } \
                er_ = wave_sum_u(er_); if (er_ < best) { best = er_; bs = s_; } } while (0)
            EXP_TRY(1.f); EXP_TRY(0.86f); EXP_TRY(0.74f); EXP_TRY(0.63f);
#undef EXP_TRY
            const float inv = bs > 0.f ? 1.f / bs : 0.f;
            unsigned w01[2] = {0u, 0u};
#pragma unroll
            for (int k = 0; k < 4; ++k)
#pragma unroll
                for (int c = 0; c < 4; ++c) { const int q = (int)fminf(fmaxf(rintf(R.v[bb][k][c] * inv), -7.f), 7.f); w01[k >> 1] |= (unsigned)(q & 15) << (4 * (4 * (k & 1) + c)); }
            if (F.lane == 0) (isu ? SUI_ : SVI_)[e] = bs;
            typedef unsigned v2u_ __attribute__((ext_vector_type(2)));
            v2u_ wv; wv.x = w01[0]; wv.y = w01[1];
            *(GAS v2u_*)((isu ? WSP(unsigned char, WS_EXPU) : WSP(unsigned char, WS_EXPV)) + (size_t)e * 512 + 8 * F.lane) = wv;
        } }
}
#ifndef P0_PARTS
#define P0_PARTS 15
#endif
DI void p0_phase(const Frame& F, int parts = 15) {
    const float* const w_in_ = inp(I_WIN); bf16* const Win_t_ = WSP(bf16, WS_WIN); const float* const w_out_ = inp(I_WOUT); bf16* const Wout_t_ = WSP(bf16, WS_WOUT); const float* const expert_v_ = inp(I_EV); const float* const expert_u_ = inp(I_EU);
    LAS float* scr = (LAS float*)(F.lds + F.wave * 16384);
    const int gw = F.vcu * NWAVES + F.wave, NGW = F.G * NWAVES;
    if (parts & 1) for (int it = F.vcu; it < 96; it += F.G) p0_mod_block(F, it);
    constexpr int I_WIN = 16 * 112, I_WOUT = 16 * 32, NITEMS = I_WIN + I_WOUT;
    if (parts & 2) for (int it = gw; it < NITEMS; it += NGW) {
        int r = it;
        if (r < I_WIN) { p0_transpose_item(w_in_, D, NPROJ, NIN, Win_t_, scr, r, F.lane); continue; } r -= I_WIN;
        p0_transpose_item(w_out_, D, D, D, Wout_t_, scr, r, F.lane);
    }
    __syncthreads();
    if (parts & 8) for (int it = F.vcu; it < 256; it += F.G) p0_weff_item(F, it);
}

template <bool DOGATES>
DI void norm_phase(const Frame& F, const float* src, const float* g, int shift_off, int scale_off) {
    const float* const w_in_ = inp(I_WIN); float* const mod_ = WSP(float, WS_MOD); bf16* const XN_ = WSP(bf16, WS_XN); float* const GATES_ = WSP(float, WS_GATES); const float* const b_igate_ = inp(I_BIG); const float* const b_fgate_ = inp(I_BFG);
    LAS float* W8 = (LAS float*)F.lds;
    if (DOGATES) {
        for (int i = 0; i < 16; ++i) { const int idx = F.tid + 512 * i; W8[idx] = w_in_[(size_t)(idx & 1023) * NIN + NPROJ + (idx >> 10)]; }
        __syncthreads();
    }
    const int gw = F.vcu * NWAVES + F.wave, NGW = F.G * NWAVES;
    for (int ch = gw; ch < T / 16; ch += NGW) {
        const int r0 = ch * 16, b = r0 / SEQ;
        f32x4 A[4], Bv[4];
#pragma unroll
        for (int j = 0; j < 4; ++j) { const int col = 4 * F.lane + 256 * j; const f32x4 gg = *(const f32x4*)(g + col), sc = *(const f32x4*)(mod_ + b * NMOD + scale_off + col);
            A[j] = gg * (sc + 1.0f); Bv[j] = *(const f32x4*)(mod_ + b * NMOD + shift_off + col); }
        f32x4 nx[4];
        { const GAS f32x4* xr0 = (const GAS f32x4*)(src + (size_t)r0 * D) + F.lane;
#pragma unroll
          for (int j = 0; j < 4; ++j) nx[j] = __builtin_nontemporal_load(xr0 + 64 * j); }
        for (int rr = 0; rr < 16; ++rr) {
            const int row = r0 + rr;
            f32x4 v[4]; float s = 0.f;
#pragma unroll
            for (int j = 0; j < 4; ++j) { v[j] = nx[j]; s += (v[j].x * v[j].x + v[j].y * v[j].y) + (v[j].z * v[j].z + v[j].w * v[j].w); }
            if (rr + 1 < 16) { const GAS f32x4* xr = (const GAS f32x4*)(src + (size_t)(row + 1) * D) + F.lane;
#pragma unroll
                for (int j = 0; j < 4; ++j) nx[j] = __builtin_nontemporal_load(xr + 64 * j); }
            const float rstd = 1.f / sqrtf(wave_sum_u(s) * (1.f / D) + EPS);
#pragma unroll
            for (int j = 0; j < 4; ++j) v[j] = v[j] * rstd * A[j] + Bv[j];
            GAS unsigned long long* o8 = (GAS unsigned long long*)(XN_ + (size_t)row * D) + F.lane;
#pragma unroll
            for (int j = 0; j < 4; ++j) o8[64 * j] = (unsigned long long)pk2(v[j].x, v[j].y) | ((unsigned long long)pk2(v[j].z, v[j].w) << 32);
            if (DOGATES) {
                float res = 0.f;
#pragma unroll
                for (int hh = 0; hh < 8; ++hh) { float p = 0.f;
#pragma unroll
                    for (int j = 0; j < 4; ++j) { const f32x4 w = *(const LAS f32x4*)(W8 + hh * 1024 + 4 * F.lane + 256 * j); p += (v[j].x * w.x + v[j].y * w.y) + (v[j].z * w.z + v[j].w * w.w); }
                    p = wave_sum_u(p); if (F.lane == hh) res = p; }
                if (F.lane < 8) GATES_[(size_t)row * 8 + F.lane] = res + (F.lane < 4 ? b_igate_[F.lane] : b_fgate_[F.lane - 4]);
            }
        }
    }
}

DI void sb_unit(const Frame& F, int b, int h, int qb) {
    bf16* const PROJ_ = WSP(bf16, WS_PROJ); const float* const g_q_sb_ = inp(I_GQ); const float* const g_k_sb_ = inp(I_GK); bf16* const MIX_ = WSP(bf16, WS_MIX); const float* const g_out_sb_ = inp(I_GOSB);
    const int lane = F.lane, w = F.wave, r = lane & 31, hi = lane >> 5;
    const int i16 = lane & 15, qq = i16 >> 2, pp = i16 & 3, blk = (lane >> 4) & 1;
    LAS unsigned char* Wb = F.lds + w * 16384;
    const size_t rowbase = (size_t)b * SEQ; const int q0 = qb * 256, qw0 = q0 + 32 * w, tq = qw0 + r;
    const bf16* P = PROJ_;
    const bf16* kpiece[4]; const bf16* vpiece[4];
#pragma unroll
    for (int i = 0; i < 4; ++i) { const int krow_ = 8 * i + (lane >> 3), kch = (lane & 7) ^ ((krow_ >> 1) & 7); kpiece[i] = P + (rowbase + krow_) * NPROJ + C_KSB + h * 64 + 8 * kch;
        const int vkey = 16 * (i & 1) + (lane >> 2); vpiece[i] = P + (rowbase + vkey) * NPROJ + C_VSB + h * 64 + 32 * (i >> 1) + 8 * (lane & 3); }
#define SB_DMA(T_, BUF_) do { _Pragma("unroll") for (int i_ = 0; i_ < 4; ++i_) { \
        __builtin_amdgcn_global_load_lds((const unsigned*)(kpiece[i_] + (size_t)(32 * (T_)) * NPROJ), (LAS unsigned*)(Wb + 8192 * (BUF_) + 1024 * i_), 16, 0, 0); \
        __builtin_amdgcn_global_load_lds((const unsigned*)(vpiece[i_] + (size_t)(32 * (T_)) * NPROJ), (LAS unsigned*)(Wb + 8192 * (BUF_) + 4096 + 1024 * i_), 16, 0, 0); } } while (0)
    const int tw = (qw0 + 30) >> 5;
    SB_DMA(tw, 0);
    bf16x8 qf[4];
    {
        const bf16* Qp = P + (rowbase + tq) * NPROJ + C_QSB + h * 64 + 8 * hi;
        v4u qraw[4]; float ss = 0.f;
#pragma unroll
        for (int kk = 0; kk < 4; ++kk) { qraw[kk] = *(const GAS v4u*)(Qp + 16 * kk);
#pragma unroll
            for (int e = 0; e < 4; ++e) { const float a = bflo(qraw[kk][e]), c = bfhi(qraw[kk][e]); ss += a * a + c * c; } }
        ss = swap_add(ss);
        const float rq = __builtin_amdgcn_rsqf(ss * (1.f / 64.f) + EPS) * (0.125f * LOG2E);
#pragma unroll
        for (int kk = 0; kk < 4; ++kk) { const int d0 = 16 * kk + 8 * hi;
            const f32x4 g0 = *(const f32x4*)(g_q_sb_ + d0) * *(const f32x4*)(g_k_sb_ + d0), g1 = *(const f32x4*)(g_q_sb_ + d0 + 4) * *(const f32x4*)(g_k_sb_ + d0 + 4);
            v4u o; o.x = cvtpk(bflo(qraw[kk].x) * rq * g0.x, bfhi(qraw[kk].x) * rq * g0.y); o.y = cvtpk(bflo(qraw[kk].y) * rq * g0.z, bfhi(qraw[kk].y) * rq * g0.w);
            o.z = cvtpk(bflo(qraw[kk].z) * rq * g1.x, bfhi(qraw[kk].z) * rq * g1.y); o.w = cvtpk(bflo(qraw[kk].w) * rq * g1.z, bfhi(qraw[kk].w) * rq * g1.w);
            qf[kk] = __builtin_bit_cast(bf16x8, o); }
    }
    f16x8 U0, U1, E0;
#pragma unroll
    for (int j = 0; j < 8; ++j) { U0[j] = (krow(0, hi, j) > r) ? (_Float16)1.0f : (_Float16)0.0f; U1[j] = (krow(1, hi, j) > r) ? (_Float16)1.0f : (_Float16)0.0f;
        E0[j] = (j == 0 && hi == 0) ? (_Float16)1.0f : (_Float16)0.0f; }
    f32x16 o0, o1;
#pragma unroll
    for (int i = 0; i < 16; ++i) { o0[i] = 0.f; o1[i] = 0.f; }
    float R = 0.f;
    const int kfoff = r * 128, kfsw = (r >> 1) & 7;
    for (int t = tw; t >= 0; --t) {
        const int buf = (tw - t) & 1;
        LAS unsigned char* Kb = Wb + 8192 * buf; LAS unsigned char* Vb = Kb + 4096;
        asm volatile("s_waitcnt vmcnt(0)" ::: "memory");
        if (t > 0) SB_DMA(t - 1, buf ^ 1);
        bf16x8 kf[4]; float ssk = 0.f;
#pragma unroll
        for (int kk = 0; kk < 4; ++kk) { const v4u kv = *(const LAS v4u*)(Kb + kfoff + (((2 * kk + hi) ^ kfsw) * 16)); kf[kk] = __builtin_bit_cast(bf16x8, kv);
            ssk = dot2bf(kv.x, kv.x, ssk); ssk = dot2bf(kv.y, kv.y, ssk); ssk = dot2bf(kv.z, kv.z, ssk); ssk = dot2bf(kv.w, kv.w, ssk); }
        ssk = swap_add(ssk);
        const float rk = __builtin_amdgcn_rsqf(ssk * (1.f / 64.f) + EPS);
        f16x8 RKA;
#pragma unroll
        for (int e = 0; e < 8; ++e) RKA[e] = (_Float16)0.0f;
        RKA[0] = (hi == 0) ? (_Float16)rk : (_Float16)0.0f;
        f32x16 s, rkd;
#pragma unroll
        for (int i = 0; i < 16; ++i) { s[i] = 0.f; rkd[i] = 0.f; }
        rkd = MFMA_F16(RKA, E0, rkd);
#pragma unroll
        for (int kk = 0; kk < 4; ++kk) s = MFMA_BF16(kf[kk], qf[kk], s);
        float tsum = 0.f; unsigned lp[8];
        if (32 * t + 31 < qw0) {
#pragma unroll
            for (int i = 0; i < 16; i += 2) {
                const float z0_ = s[i] * rkd[i], z1_ = s[i + 1] * rkd[i + 1];
                const float a0_ = -lg2(1.f + ex2(z0_)), a1_ = -lg2(1.f + ex2(z1_));
                tsum += a0_ + a1_;
                s[i] = z0_ + a0_; s[i + 1] = z1_ + a1_;
                lp[i >> 1] = pkh(a0_, a1_); }
        } else {
            const int kq = tq - 32 * t;
#pragma unroll
            for (int i = 0; i < 16; i += 2) {
                const float z0_ = s[i] * rkd[i], z1_ = s[i + 1] * rkd[i + 1];
                float a0_ = -lg2(1.f + ex2(z0_)), a1_ = -lg2(1.f + ex2(z1_));
                const bool ma0 = crow(i, hi) >= kq, ma1 = crow(i + 1, hi) >= kq;
                a0_ = ma0 ? 0.f : a0_; a1_ = ma1 ? 0.f : a1_;
                tsum += a0_ + a1_;
                s[i] = ma0 ? -INFINITY : z0_ + a0_; s[i + 1] = ma1 ? -INFINITY : z1_ + a1_;
                lp[i >> 1] = pkh(a0_, a1_); }
        }
        f32x16 c;
#pragma unroll
        for (int i = 0; i < 16; ++i) c[i] = R;
        c = MFMA_F16(U0, __builtin_bit_cast(f16x8, (v4u){lp[0], lp[1], lp[2], lp[3]}), c); c = MFMA_F16(U1, __builtin_bit_cast(f16x8, (v4u){lp[4], lp[5], lp[6], lp[7]}), c);
#pragma unroll
        for (int i = 0; i < 16; ++i) s[i] = ex2(s[i] + c[i]);
        const bf16x8 W0 = packbf(s, 0), W1 = packbf(s, 1);
        LAS unsigned char* vb_ = Vb + (4 * hi + qq) * 64 + 32 * blk + 8 * pp;
        o0 = MFMA_BF16(cat8(trrd(vb_), trrd(vb_ + 8 * 64)), W0, o0); o0 = MFMA_BF16(cat8(trrd(vb_ + 16 * 64), trrd(vb_ + 24 * 64)), W1, o0);
        o1 = MFMA_BF16(cat8(trrd(vb_ + 2048), trrd(vb_ + 2048 + 8 * 64)), W0, o1); o1 = MFMA_BF16(cat8(trrd(vb_ + 2048 + 16 * 64), trrd(vb_ + 2048 + 24 * 64)), W1, o1);
        R += swap_add(tsum);
        if (__all(R < -150.f)) break;
    }
    asm volatile("s_waitcnt vmcnt(0)" ::: "memory");
#undef SB_DMA
    {
        float ss = 0.f;
#pragma unroll
        for (int i = 0; i < 16; ++i) ss += o0[i] * o0[i] + o1[i] * o1[i];
        ss = swap_add(ss);
        const float ro = __builtin_amdgcn_rsqf(ss * (1.f / 64.f) + EPS);
        bf16* Op = MIX_ + (rowbase + tq) * D + h * 64;
        const float* go = g_out_sb_ + h * 64;
#pragma unroll
        for (int g = 0; g < 4; ++g) { const int d0 = 8 * g + 4 * hi; const f32x4 ga = *(const f32x4*)(go + d0), gb = *(const f32x4*)(go + 32 + d0);
            u32x2 wa, wb; wa.x = cvtpk(o0[4 * g] * ro * ga.x, o0[4 * g + 1] * ro * ga.y); wa.y = cvtpk(o0[4 * g + 2] * ro * ga.z, o0[4 * g + 3] * ro * ga.w);
            wb.x = cvtpk(o1[4 * g] * ro * gb.x, o1[4 * g + 1] * ro * gb.y); wb.y = cvtpk(o1[4 * g + 2] * ro * gb.z, o1[4 * g + 3] * ro * gb.w);
            *(GAS u32x2*)(Op + d0) = wa; *(GAS u32x2*)(Op + 32 + d0) = wb; }
    }
    __syncthreads();
}

DI void conv_silu8(const v4u (&xr)[4], const float (&cw)[4][8], float scale, float (&y)[8]) {
#pragma unroll
    for (int e = 0; e < 8; ++e) y[e] = 0.f;
#pragma unroll
    for (int j = 0; j < 4; ++j) {
        y[0] += cw[j][0] * bflo(xr[j].x); y[1] += cw[j][1] * bfhi(xr[j].x); y[2] += cw[j][2] * bflo(xr[j].y); y[3] += cw[j][3] * bfhi(xr[j].y);
        y[4] += cw[j][4] * bflo(xr[j].z); y[5] += cw[j][5] * bfhi(xr[j].z); y[6] += cw[j][6] * bflo(xr[j].w); y[7] += cw[j][7] * bfhi(xr[j].w); }
#pragma unroll
    for (int e = 0; e < 8; ++e) y[e] = scale * y[e] * __builtin_amdgcn_rcpf(1.f + fexp(-y[e]));
}
DI float log_sigmoid(float x) { return fminf(x, 0.f) - 0.6931471805599453f * lg2(1.f + fexp(-fabsf(x))); }
DI float wave_scan_incl(float a, int lane) {
#pragma unroll
    for (int o = 1; o < 64; o <<= 1) { const float t = __shfl_up(a, o); if (lane >= o) a += t; }
    return a;
}

constexpr int LDS_CW = 65536;
DI void stage_conv_w(const Frame& F) {
    const float* const conv_w_ = inp(I_CONVW); LAS float* cwl = (LAS float*)(F.lds + LDS_CW);
    for (int i = F.tid; i < 4096; i += NTHR) cwl[i] = conv_w_[i];
    __syncthreads();
}
DI void load_cw8(const Frame& F, int colbase, float (&cw)[4][8]) {
    const LAS float* cwl = (const LAS float*)(F.lds + LDS_CW);
#pragma unroll
    for (int j = 0; j < 4; ++j) { const f32x4 a = *(const LAS f32x4*)(cwl + j * 1024 + colbase), b = *(const LAS f32x4*)(cwl + j * 1024 + colbase + 4);
        cw[j][0] = a.x; cw[j][1] = a.y; cw[j][2] = a.z; cw[j][3] = a.w; cw[j][4] = b.x; cw[j][5] = b.y; cw[j][6] = b.z; cw[j][7] = b.w; }
}
struct MlLocalRegs { v4u kraw[2][4]; v4u vraw[2]; float gi, gf; };
DI void ml_local_load(const Frame& F, int chain, int c, MlLocalRegs& R) {
    bf16* const PROJ_ = WSP(bf16, WS_PROJ); float* const GATES_ = WSP(float, WS_GATES);
    const int tid = F.tid, lane = F.lane;
    const int b = chain >> 2, hh = chain & 3; const size_t rowbase = (size_t)b * SEQ; const int t0 = c * 64;
    const bf16* P = PROJ_;
    const int kc = tid & 15, kr0 = tid >> 4;
    const bf16* Kg = P + rowbase * NPROJ + C_KML + hh * 128 + kc * 8;
#pragma unroll
    for (int i = 0; i < 2; ++i)
#pragma unroll
        for (int j = 0; j < 4; ++j) { const int tt = t0 + kr0 + 32 * i - 3 + j; R.kraw[i][j] = (tt >= 0) ? *(const GAS v4u*)(Kg + (size_t)tt * NPROJ) : (v4u){0u, 0u, 0u, 0u}; }
#pragma unroll
    for (int i = 0; i < 2; ++i) R.vraw[i] = *(const GAS v4u*)(P + (rowbase + t0 + kr0 + 32 * i) * NPROJ + C_VML + hh * 128 + kc * 8);
    const float* Gg = GATES_ + (rowbase + t0 + lane) * 8;
    R.gi = Gg[hh]; R.gf = Gg[4 + hh];
}
DI void ml_local_unit(const Frame& F, int chain, int c, const MlLocalRegs& RG) {
    bf16* const CST_ = WSP(bf16, WS_CST); float* const NST_ = WSP(float, WS_NST); float* const SCL_ = WSP(float, WS_SCL);
    LAS unsigned char* L = F.lds;
    LAS float* Lws = (LAS float*)(L + 32768);
    const int tid = F.tid, lane = F.lane, w = F.wave, r = lane & 31, hi = lane >> 5;
    const int i16 = lane & 15, qq = i16 >> 2, pp = i16 & 3, blk = (lane >> 4) & 1;
    const int hh = chain & 3;
    const int kbk = w & 3, vb0 = 2 * (w >> 2);
    const int kc = tid & 15, kr0 = tid >> 4;
    v4u kraw[2][4], vraw[2];
#pragma unroll
    for (int i = 0; i < 2; ++i) { vraw[i] = RG.vraw[i];
#pragma unroll
        for (int j = 0; j < 4; ++j) kraw[i][j] = RG.kraw[i][j]; }
    const float gi = RG.gi, gf = RG.gf;
    const float a = wave_scan_incl(log_sigmoid(gf), lane);
    const float a_end = __shfl(a, 63);
    const float lw = a_end - a + gi;
    const float m_loc = wave_max(lw);
    const float ws = fexp(lw - m_loc);
    if (w == 0) Lws[lane] = ws;
    {
        float cw[4][8]; load_cw8(F, 512 + hh * 128 + kc * 8, cw);
#pragma unroll
        for (int i = 0; i < 2; ++i) { float y[8]; conv_silu8(kraw[i], cw, 0.08838834764831845f, y);
            v4u o; o.x = cvtpk(y[0], y[1]); o.y = cvtpk(y[2], y[3]); o.z = cvtpk(y[4], y[5]); o.w = cvtpk(y[6], y[7]);
            *(LAS v4u*)(L + (kc >> 2) * 4096 + (kr0 + 32 * i) * 64 + (kc & 3) * 16) = o; }
#pragma unroll
        for (int i = 0; i < 2; ++i) { const int row = kr0 + 32 * i; const float wsr = __shfl(ws, row);
            v4u o; o.x = cvtpk(bflo(vraw[i].x) * wsr, bfhi(vraw[i].x) * wsr); o.y = cvtpk(bflo(vraw[i].y) * wsr, bfhi(vraw[i].y) * wsr); o.z = cvtpk(bflo(vraw[i].z) * wsr, bfhi(vraw[i].z) * wsr); o.w = cvtpk(bflo(vraw[i].w) * wsr, bfhi(vraw[i].w) * wsr);
            *(LAS v4u*)(L + 16384 + (kc >> 2) * 4096 + row * 64 + (kc & 3) * 16) = o; }
    }
    __syncthreads();
    f32x16 acc0, acc1;
#pragma unroll
    for (int i = 0; i < 16; ++i) { acc0[i] = 0.f; acc1[i] = 0.f; }
#pragma unroll
    for (int kk = 0; kk < 4; ++kk) { const int rows = 16 * kk + 8 * hi + qq;
        LAS unsigned char* ka = L + kbk * 4096 + rows * 64 + 32 * blk + 8 * pp; LAS unsigned char* va = L + 16384 + vb0 * 4096 + rows * 64 + 32 * blk + 8 * pp;
        const bf16x8 A = cat8(trrd(ka), trrd(ka + 4 * 64));
        acc0 = MFMA_BF16(A, cat8(trrd(va), trrd(va + 4 * 64)), acc0); acc1 = MFMA_BF16(A, cat8(trrd(va + 4096), trrd(va + 4096 + 4 * 64)), acc1); }
    {
        bf16* Cp = CST_ + ((size_t)(chain * 64 + c) * 128 + vb0 * 32 + r) * 128 + kbk * 32 + 4 * hi;
#pragma unroll
        for (int g = 0; g < 4; ++g) { u32x2 o; o.x = cvtpk(acc0[4 * g], acc0[4 * g + 1]); o.y = cvtpk(acc0[4 * g + 2], acc0[4 * g + 3]); *(GAS u32x2*)(Cp + 8 * g) = o;
            u32x2 o1; o1.x = cvtpk(acc1[4 * g], acc1[4 * g + 1]); o1.y = cvtpk(acc1[4 * g + 2], acc1[4 * g + 3]); *(GAS u32x2*)(Cp + 32 * 128 + 8 * g) = o1; }
    }
    {
        const int k = 16 * w + (lane & 15), sq = lane >> 4; float part = 0.f;
        const LAS unsigned short* kcol = (const LAS unsigned short*)(L + (k >> 5) * 4096 + (k & 31) * 2);
#pragma unroll
        for (int e = 0; e < 16; ++e) part += Lws[16 * sq + e] * __uint_as_float((unsigned)kcol[(16 * sq + e) * 32] << 16);
        part += __shfl_xor(part, 16); part += __shfl_xor(part, 32);
        if (lane < 16) NST_[(size_t)(chain * 64 + c) * 128 + k] = part;
        if (tid == 0) { SCL_[(chain * 64 + c) * 2] = a_end; SCL_[(chain * 64 + c) * 2 + 1] = m_loc; }
    }
    __syncthreads();
}
DI void ml_scan_phase(const Frame& F) {
    bf16* const CST_ = WSP(bf16, WS_CST); float* const NST_ = WSP(float, WS_NST); float* const SCL_ = WSP(float, WS_SCL); float* const MST_ = WSP(float, WS_MST);
    for (int gt = F.vcu * NTHR + F.tid; gt < 32 * 4096; gt += F.G * NTHR) {
        const int chain = gt >> 12, rem = gt & 4095;
        const float ae_l = SCL_[(chain * 64 + F.lane) * 2], ml_l = SCL_[(chain * 64 + F.lane) * 2 + 1];
        u32x2* Cp = (u32x2*)(CST_ + (size_t)chain * 64 * 16384 + (size_t)rem * 4);
        f32x4* Np = (f32x4*)(NST_ + (size_t)chain * 64 * 128 + rem * 4);
        const bool do_n = rem < 32;
        float c0 = 0.f, c1 = 0.f, c2 = 0.f, c3 = 0.f; f32x4 nn = {0.f, 0.f, 0.f, 0.f}; float m = 0.f;
        u32x2 dr[8]; f32x4 nr[8];
#pragma unroll
        for (int i = 0; i < 8; ++i) { dr[i] = Cp[(size_t)i * 4096]; if (do_n) nr[i] = Np[i * 32]; }
        for (int c0_ = 0; c0_ < 64; c0_ += 8) {
#pragma unroll
            for (int i = 0; i < 8; ++i) { const int c = c0_ + i;
                if (c < 63) {
                    const u32x2 dcur = dr[i]; const f32x4 dn = nr[i];
                    if (c + 8 < 63) { dr[i] = Cp[(size_t)(c + 8) * 4096]; if (do_n) nr[i] = Np[(c + 8) * 32]; }
                    const float ae = __builtin_bit_cast(float, __builtin_amdgcn_readlane(__builtin_bit_cast(int, ae_l), c)), ml = __builtin_bit_cast(float, __builtin_amdgcn_readlane(__builtin_bit_cast(int, ml_l), c));
                    const float mn = fmaxf(ae + m, ml), d1 = fexp(ae + m - mn), d2 = fexp(ml - mn);
                    c0 = d1 * c0 + d2 * bflo(dcur.x); c1 = d1 * c1 + d2 * bfhi(dcur.x); c2 = d1 * c2 + d2 * bflo(dcur.y); c3 = d1 * c3 + d2 * bfhi(dcur.y);
                    u32x2 o; o.x = cvtpk(c0, c1); o.y = cvtpk(c2, c3); Cp[(size_t)c * 4096] = o;
                    if (do_n) { nn = nn * d1 + dn * d2; Np[c * 32] = nn; }
                    if (rem == 0) MST_[chain * 64 + c] = mn;
                    m = mn; } }
        }
    }
}
DI void ml_out_unit(const Frame& F, int chain, int c) {
    bf16* const PROJ_ = WSP(bf16, WS_PROJ); float* const GATES_ = WSP(float, WS_GATES); float* const MST_ = WSP(float, WS_MST); bf16* const CST_ = WSP(bf16, WS_CST); float* const NST_ = WSP(float, WS_NST); bf16* const MIX_ = WSP(bf16, WS_MIX); const float* const g_out_ml_ = inp(I_GOML);
    LAS unsigned char* L = F.lds;
    LAS float* Lbs = (LAS float*)(L + 49152); LAS float* Lav = (LAS float*)(L + 49408); LAS float* Lex = (LAS float*)(L + 49664);
    const int tid = F.tid, lane = F.lane, w = F.wave, r = lane & 31, hi = lane >> 5;
    const int i16 = lane & 15, qq = i16 >> 2, pp = i16 & 3, blk = (lane >> 4) & 1;
    const int b = chain >> 2, hh = chain & 3; const size_t rowbase = (size_t)b * SEQ; const int t0 = c * 64;
    const int tb = w >> 2, vb = w & 3;
    const bf16* P = PROJ_;
    {
        const int kc = tid & 15, kr0 = tid >> 4;
#pragma unroll
        for (int which = 0; which < 2; ++which) {
            const int colbase = (which ? 512 : 0) + hh * 128 + kc * 8;
            float cw[4][8]; load_cw8(F, colbase, cw);
            const bf16* Xg = P + rowbase * NPROJ + C_QML + colbase;
#pragma unroll
            for (int i = 0; i < 2; ++i) { const int row = kr0 + 32 * i; v4u xr[4];
#pragma unroll
                for (int j = 0; j < 4; ++j) { const int tt = t0 + row - 3 + j; xr[j] = (tt >= 0) ? *(const GAS v4u*)(Xg + (size_t)tt * NPROJ) : (v4u){0u, 0u, 0u, 0u}; }
                float y[8]; conv_silu8(xr, cw, which ? 0.08838834764831845f : 1.0f, y);
                v4u o; o.x = cvtpk(y[0], y[1]); o.y = cvtpk(y[2], y[3]); o.z = cvtpk(y[4], y[5]); o.w = cvtpk(y[6], y[7]);
                *(LAS v4u*)(L + which * 16384 + row * 256 + ((kc ^ (row & 15)) * 16)) = o; }
        }
#pragma unroll
        for (int i = 0; i < 2; ++i) { const int row = kr0 + 32 * i;
            const v4u v = *(const GAS v4u*)(P + (rowbase + t0 + row) * NPROJ + C_VML + hh * 128 + kc * 8);
            *(LAS v4u*)(L + 32768 + (kc >> 2) * 4096 + row * 64 + (kc & 3) * 16) = v; }
        if (w == 0) { const float* Gg = GATES_ + (rowbase + t0 + lane) * 8; const float a = wave_scan_incl(log_sigmoid(Gg[4 + hh]), lane); Lav[lane] = a; Lbs[lane] = Gg[hh] - a; }
    }
    const float mprev = (c > 0) ? MST_[chain * 64 + c - 1] : 0.f;
    bf16x8 cf[8], nf[8];
    if (c > 0) {
        const bf16* Cp = CST_ + ((size_t)(chain * 64 + c - 1) * 128 + vb * 32 + r) * 128 + 8 * hi;
        const float* Np = NST_ + (size_t)(chain * 64 + c - 1) * 128 + 8 * hi;
        const bool nrow = (r == 0) || (r == 4);
#pragma unroll
        for (int kk = 0; kk < 8; ++kk) { cf[kk] = *(const GAS bf16x8*)(Cp + 16 * kk);
            const f32x4 n0 = *(const f32x4*)(Np + 16 * kk), n1 = *(const f32x4*)(Np + 16 * kk + 4);
            v4u o; o.x = cvtpk(n0.x, n0.y); o.y = cvtpk(n0.z, n0.w); o.z = cvtpk(n1.x, n1.y); o.w = cvtpk(n1.z, n1.w);
            if (!nrow) o = (v4u){0u, 0u, 0u, 0u};
            nf[kk] = __builtin_bit_cast(bf16x8, o); }
    }
    __syncthreads();
    bf16x8 qf[8];
    f32x16 s0, s1;
#pragma unroll
    for (int i = 0; i < 16; ++i) { s0[i] = 0.f; s1[i] = 0.f; }
#pragma unroll
    for (int kk = 0; kk < 8; ++kk) { const int ch = 2 * kk + hi; const int rq_ = 32 * tb + r;
        qf[kk] = *(const LAS bf16x8*)(L + rq_ * 256 + ((ch ^ (rq_ & 15)) * 16));
        const bf16x8 a0 = *(const LAS bf16x8*)(L + 16384 + r * 256 + ((ch ^ (r & 15)) * 16));
        const bf16x8 a1 = *(const LAS bf16x8*)(L + 16384 + (32 + r) * 256 + ((ch ^ ((32 + r) & 15)) * 16));
        s0 = MFMA_BF16(a0, qf[kk], s0); s1 = MFMA_BF16(a1, qf[kk], s1); }
    const int tl = 32 * tb + r; const float a_t = Lav[tl];
    f32x16 d0, d1; float mrow = -INFINITY;
#pragma unroll
    for (int g = 0; g < 4; ++g) { const f32x4 b0 = *(const LAS f32x4*)(Lbs + 8 * g + 4 * hi), b1 = *(const LAS f32x4*)(Lbs + 32 + 8 * g + 4 * hi);
#pragma unroll
        for (int e = 0; e < 4; ++e) { const int sl = 8 * g + 4 * hi + e;
            d0[4 * g + e] = (sl <= tl) ? a_t + b0[e] : -INFINITY; d1[4 * g + e] = (32 + sl <= tl) ? a_t + b1[e] : -INFINITY;
            mrow = fmaxf(mrow, fmaxf(d0[4 * g + e], d1[4 * g + e])); } }
    mrow = fmaxf(swap_max(mrow), a_t + mprev);
    float psum = 0.f;
#pragma unroll
    for (int i = 0; i < 16; ++i) { s0[i] *= fexp(d0[i] - mrow); s1[i] *= fexp(d1[i] - mrow); psum += s0[i] + s1[i]; }
    const float w_inter = fexp(a_t + mprev - mrow);
    float den = swap_add(psum);
    const bf16x8 P00 = packbf(s0, 0), P01 = packbf(s0, 1), P10 = packbf(s1, 0), P11 = packbf(s1, 1);
    f32x16 num;
#pragma unroll
    for (int i = 0; i < 16; ++i) num[i] = 0.f;
    {
        LAS unsigned char* vb_ = L + 32768 + vb * 4096 + (4 * hi + qq) * 64 + 32 * blk + 8 * pp;
        num = MFMA_BF16(cat8(trrd(vb_), trrd(vb_ + 8 * 64)), P00, num); num = MFMA_BF16(cat8(trrd(vb_ + 16 * 64), trrd(vb_ + 24 * 64)), P01, num);
        num = MFMA_BF16(cat8(trrd(vb_ + 32 * 64), trrd(vb_ + 40 * 64)), P10, num); num = MFMA_BF16(cat8(trrd(vb_ + 48 * 64), trrd(vb_ + 56 * 64)), P11, num);
    }
    if (c > 0) {
        f32x16 it, dn;
#pragma unroll
        for (int i = 0; i < 16; ++i) { it[i] = 0.f; dn[i] = 0.f; }
#pragma unroll
        for (int kk = 0; kk < 8; ++kk) { it = MFMA_BF16(cf[kk], qf[kk], it); dn = MFMA_BF16(nf[kk], qf[kk], dn); }
#pragma unroll
        for (int i = 0; i < 16; ++i) num[i] += w_inter * it[i];
        den += w_inter * dn[0];
    }
    const float inv = __builtin_amdgcn_rcpf(fmaxf(fabsf(den), fexp(-mrow)));
    float ss = 0.f;
#pragma unroll
    for (int i = 0; i < 16; ++i) { num[i] *= inv; ss += num[i] * num[i]; }
    ss = swap_add(ss);
    if (lane < 32) Lex[(tb * 4 + vb) * 32 + r] = ss;
    __syncthreads();
    const float tot = (Lex[(tb * 4 + 0) * 32 + r] + Lex[(tb * 4 + 1) * 32 + r]) + (Lex[(tb * 4 + 2) * 32 + r] + Lex[(tb * 4 + 3) * 32 + r]);
    const float rstd = 1.f / sqrtf(tot * (1.f / 128.f) + EPS);
    {
        const size_t trow = rowbase + t0 + tl;
        const bf16* Og = P + trow * NPROJ + C_OML + hh * 128 + vb * 32 + 4 * hi;
        bf16* Mp = MIX_ + trow * D + 512 + hh * 128 + vb * 32 + 4 * hi;
        const float* go = g_out_ml_ + hh * 128 + vb * 32 + 4 * hi;
#pragma unroll
        for (int g = 0; g < 4; ++g) { const u32x2 og = *(const GAS u32x2*)(Og + 8 * g); const f32x4 gg = *(const f32x4*)(go + 8 * g);
            const float o0 = bflo(og.x), o1 = bfhi(og.x), o2 = bflo(og.y), o3 = bfhi(og.y);
            u32x2 o; o.x = cvtpk(num[4 * g] * rstd * gg.x * __builtin_amdgcn_rcpf(1.f + fexp(-o0)), num[4 * g + 1] * rstd * gg.y * __builtin_amdgcn_rcpf(1.f + fexp(-o1)));
            o.y = cvtpk(num[4 * g + 2] * rstd * gg.z * __builtin_amdgcn_rcpf(1.f + fexp(-o2)), num[4 * g + 3] * rstd * gg.w * __builtin_amdgcn_rcpf(1.f + fexp(-o3)));
            *(GAS u32x2*)(Mp + 8 * g) = o; }
    }
    __syncthreads();
}

#define TK_CE(A, B) do { const float hi_ = fmaxf((A), (B)), lo_ = fminf((A), (B)); (A) = hi_; (B) = lo_; } while (0)
DI void tk_sort16(float (&a)[16]) {
#pragma unroll
    for (int k = 2; k <= 16; k <<= 1)
#pragma unroll
        for (int j = k >> 1; j > 0; j >>= 1)
#pragma unroll
            for (int i = 0; i < 16; ++i) { const int l = i ^ j; if (l > i) { if ((i & k) == 0) TK_CE(a[i], a[l]); else TK_CE(a[l], a[i]); } }
}
DI void tk_merge16(float (&a)[16], const float (&b)[16]) {
#pragma unroll
    for (int i = 0; i < 16; ++i) a[i] = fmaxf(a[i], b[15 - i]);
#pragma unroll
    for (int j = 8; j > 0; j >>= 1)
#pragma unroll
        for (int i = 0; i < 16; ++i) { const int l = i ^ j; if (l > i) TK_CE(a[i], a[l]); }
}
DI void tk_stage2(const LAS float* la, const LAS float* lb, int* IDX_, float* GATEW_, size_t o) {
        float a[16], bb[16], cnd[64];
#pragma unroll
        for (int q = 0; q < 16; ++q) { a[q] = la[q]; bb[q] = lb[q]; }
        int cnt = 0;
#pragma unroll
        for (int i = 0; i < 16; ++i)
#pragma unroll
            for (int j = 0; j < 16; ++j) if ((i + 1) * (j + 1) <= 16) { cnd[cnt] = __uint_as_float((__float_as_uint(a[i] + bb[j]) & ~0xFFu) | (unsigned)(i * 16 + j)); ++cnt; }
#pragma unroll
        for (int q = 50; q < 64; ++q) cnd[q] = -INFINITY;
        float top[16];
#pragma unroll
        for (int c = 0; c < 4; ++c) { float ch[16];
#pragma unroll
            for (int q = 0; q < 16; ++q) ch[q] = cnd[16 * c + q];
            tk_sort16(ch);
            if (c == 0) {
#pragma unroll
                for (int q = 0; q < 16; ++q) top[q] = ch[q];
            } else tk_merge16(top, ch); }
        float sv[16]; int ei[16]; float mx = -INFINITY;
#pragma unroll
        for (int q = 0; q < 16; ++q) { const unsigned code = __float_as_uint(top[q]) & 0xFFu; const float va = la[code >> 4], vb = lb[code & 15u];
            ei[q] = (int)((__float_as_uint(va) & 0x7Fu) * 128u + (__float_as_uint(vb) & 0x7Fu)); sv[q] = va + vb; mx = fmaxf(mx, sv[q]); }
        float sum = 0.f;
#pragma unroll
        for (int q = 0; q < 16; ++q) { sv[q] = fexp(sv[q] - mx); sum += sv[q]; }
        const float inv = 1.f / sum;
#pragma unroll
        for (int q = 0; q < 16; q += 4) { *(GAS v4u*)(IDX_ + o + q) = (v4u){(unsigned)ei[q], (unsigned)ei[q + 1], (unsigned)ei[q + 2], (unsigned)ei[q + 3]};
            *(GAS f32x4*)(GATEW_ + o + q) = (f32x4){sv[q] * inv, sv[q + 1] * inv, sv[q + 2] * inv, sv[q + 3] * inv}; }
    }
struct EpiTopK {
    static constexpr bool PERM = false, AFTER_DRAIN = true;
    int* IDX; float* GATEW;
    DI void fused(f32x4 (&acc)[2][2][4][2], const pg8::Unit& u, int wr, int wc, int fr, int fq, LAS unsigned char* lds, int wid, int lane) const {
        LAS float* Tl = (LAS float*)lds;
        LAS float* Lh2 = (LAS float*)lds;
        LAS float* Ls = (LAS float*)(lds + 36864);
        const int tid = wid * 64 + lane, tl = tid & 127, p = (tid >> 7) & 1, half = tid >> 8;
#pragma unroll
        for (int ai = 0; ai < 2; ++ai) {
#pragma unroll
            for (int bj = 0; bj < 2; ++bj)
#pragma unroll
                for (int m = 0; m < 4; ++m)
#pragma unroll
                    for (int n = 0; n < 2; ++n) { LAS float* d = Tl + (wr * 64 + m * 16 + fr) * 257 + bj * 128 + wc * 32 + n * 16 + fq * 4; const f32x4 v = acc[ai][bj][m][n]; d[0] = v.x; d[1] = v.y; d[2] = v.z; d[3] = v.w; }
            __syncthreads();
            float run[16];
            {
                const LAS float* src = Tl + tl * 257 + p * 128 + half * 64;
#pragma unroll
                for (int c = 0; c < 4; ++c) { float ch[16];
#pragma unroll
                    for (int q = 0; q < 16; ++q) ch[q] = __uint_as_float((__float_as_uint(src[16 * c + q]) & ~0x7Fu) | (unsigned)(half * 64 + 16 * c + q));
                    tk_sort16(ch);
                    if (c == 0) {
#pragma unroll
                        for (int q = 0; q < 16; ++q) run[q] = ch[q];
                    } else tk_merge16(run, ch); }
            }
            __syncthreads();
#pragma unroll
            for (int q = 0; q < 16; ++q) Lh2[((tl * 2 + p) * 2 + half) * 17 + q] = run[q];
            __syncthreads();
            if (half == 0) { float oth[16];
#pragma unroll
                for (int q = 0; q < 16; ++q) oth[q] = Lh2[((tl * 2 + p) * 2 + 1) * 17 + q];
                tk_merge16(run, oth);
#pragma unroll
                for (int q = 0; q < 16; ++q) Ls[(tl * 2 + p) * 17 + q] = run[q]; }
            __syncthreads();
            if (tid < 128) tk_stage2(Ls + (tl * 2) * 17, Ls + (tl * 2) * 17 + 17, IDX, GATEW, (size_t)(u.pm * 256 + ai * 128 + tl) * 128 + u.pn * 16);
            __syncthreads();
        }
    }
};
struct OneUnit {
    pg8::Unit u;
    __device__ __forceinline__ bool next(int i, pg8::Unit& o) const { if (i) return false; o = u; return true; }
    __device__ __forceinline__ void a_ready(const pg8::Unit&) const {}
    __device__ __forceinline__ void done(const pg8::Unit&) const {}
};

DI float gelu_erf(float x) { return 0.5f * x * (1.f + erff(x * 0.7071067811865476f)); }
#define DPP_ADD(v, ctrl, rmask) ((v) + __builtin_bit_cast(float, __builtin_amdgcn_update_dpp(0, __builtin_bit_cast(int, (v)), (ctrl), (rmask), 0xF, false)))
#ifndef PEER_EBL
#define PEER_EBL 9
#endif
constexpr int PEER_EB_LOG = PEER_EBL;
#ifndef PEER_PROBE_MASK
#define PEER_PROBE_MASK 0xFFFF
#endif
typedef float f32x2v __attribute__((ext_vector_type(2)));
DI float gelu_cdf(float v) {
    const float av = fabsf(v), t = __builtin_amdgcn_rcpf(av * 0.2316418882f + 1.0f);
    float q = t * 0.5307027145f - 0.7265760135f; q = q * t + 0.7107068705f; q = q * t - 0.142248368f; q = q * t + 0.127414796f; q = q * t;
    const float m = v * (q * ex2(v * v * -0.72134752044f));
    return v < 0.f ? m : v - m;
}
#define DPP_ADDI(v, ctrl, rmask) ((v) + __builtin_amdgcn_update_dpp(0, (v), (ctrl), (rmask), 0xF, false))
DI void peer_phase(const Frame& F, bool scratch_dst) {
    bf16* const XN_ = WSP(bf16, WS_XN); int* const IDX_ = WSP(int, WS_IDX); float* const GATEW_ = WSP(float, WS_GATE); float* const mod_ = WSP(float, WS_MOD); float* const out_ = (float*)inp(I_OUT);
    const unsigned char* const EU4 = WSP(unsigned char, WS_EXPU); const unsigned char* const EV4 = WSP(unsigned char, WS_EXPV); const float* const SUI_ = WSP(float, WS_SUI); const float* const SVI_ = WSP(float, WS_SVI);
    const int gw = F.vcu * NWAVES + F.wave, NGW = F.G * NWAVES, lane = F.lane, g = lane >> 3, j = lane & 7;
    LAS unsigned char* wl = F.lds + F.wave * 17408;
    volatile LAS int* Le = (volatile LAS int*)(wl + g * 512); volatile LAS float* Lg = (volatile LAS float*)(wl + 4096 + g * 512); volatile LAS int* Lp = (volatile LAS int*)(wl + 8192 + g * 512);
    volatile LAS int* Lx = (volatile LAS int*)(wl + 12288 + g * 512); LAS int* Lh = (LAS int*)(wl + 16384 + g * 128);
    for (int grp = gw; grp < T / 8; grp += NGW) {
        const size_t t = (size_t)grp * 8 + g;
        int xh[16], xl[16]; float sxi;
#ifdef PEER_DUP_S
        auto qs_ = [&]() __attribute__((always_inline)) {
#endif
        {
            float mx = 0.f;
            const bf16* xrow = XN_ + t * D + 8 * j;
#pragma unroll
            for (int kq = 0; kq < 16; ++kq) { const v4u a = *(const GAS v4u*)(xrow + 64 * kq);
#pragma unroll
                for (int e = 0; e < 4; ++e) mx = fmaxf(mx, fmaxf(fabsf(bflo(a[e])), fabsf(bfhi(a[e])))); }
            mx = fmaxf(mx, __shfl_xor(mx, 1, 8)); mx = fmaxf(mx, __shfl_xor(mx, 2, 8)); mx = fmaxf(mx, __shfl_xor(mx, 4, 8));
            const float sx = mx > 0.f ? 119.f / mx : 0.f; sxi = mx > 0.f ? mx / 119.f : 0.f;
#pragma unroll
            for (int q = 0; q < 4; ++q)
#pragma unroll
                for (int kp = 0; kp < 2; ++kp) { const v4u a = *(const GAS v4u*)(xrow + 64 * (8 * kp + q)), b = *(const GAS v4u*)(xrow + 64 * (8 * kp + 4 + q));
#pragma unroll
                    for (int wh = 0; wh < 2; ++wh) {
                        const int t0 = (int)rintf(bflo(a[2 * wh]) * sx) + 8, t1 = (int)rintf(bfhi(a[2 * wh]) * sx) + 8, t2 = (int)rintf(bflo(a[2 * wh + 1]) * sx) + 8, t3 = (int)rintf(bfhi(a[2 * wh + 1]) * sx) + 8;
                        const int t4 = (int)rintf(bflo(b[2 * wh]) * sx) + 8, t5 = (int)rintf(bfhi(b[2 * wh]) * sx) + 8, t6 = (int)rintf(bflo(b[2 * wh + 1]) * sx) + 8, t7 = (int)rintf(bfhi(b[2 * wh + 1]) * sx) + 8;
                        const unsigned lo_ = (unsigned)(t0 & 15) | ((unsigned)(t1 & 15) << 4) | ((unsigned)(t2 & 15) << 8) | ((unsigned)(t3 & 15) << 12) | ((unsigned)(t4 & 15) << 16) | ((unsigned)(t5 & 15) << 20) | ((unsigned)(t6 & 15) << 24) | ((unsigned)(t7 & 15) << 28);
                        const unsigned hi_ = (unsigned)((t0 >> 4) & 15) | ((unsigned)((t1 >> 4) & 15) << 4) | ((unsigned)((t2 >> 4) & 15) << 8) | ((unsigned)((t3 >> 4) & 15) << 12) | ((unsigned)((t4 >> 4) & 15) << 16) | ((unsigned)((t5 >> 4) & 15) << 20) | ((unsigned)((t6 >> 4) & 15) << 24) | ((unsigned)((t7 >> 4) & 15) << 28);
                        xl[4 * q + kp + 2 * wh] = (int)(lo_ ^ 0x88888888u); xh[4 * q + kp + 2 * wh] = (int)hi_; } }
        }
        {
            int ide[16]; float gte[16]; int rk[16];
#pragma unroll
            for (int m = 0; m < 16; ++m) { ide[m] = IDX_[t * 128 + j + 8 * m]; gte[m] = GATEW_[t * 128 + j + 8 * m]; }
#pragma unroll
            for (int m = 0; m < 4; ++m) Lh[j + 8 * m] = 0;
#pragma unroll
            for (int m = 0; m < 16; ++m) rk[m] = __hip_atomic_fetch_add(Lh + (ide[m] >> PEER_EB_LOG), 1, __ATOMIC_RELAXED, __HIP_MEMORY_SCOPE_WORKGROUP);
            {
                const int h0 = ((volatile LAS int*)Lh)[4 * j], h1 = ((volatile LAS int*)Lh)[4 * j + 1], h2 = ((volatile LAS int*)Lh)[4 * j + 2], h3 = ((volatile LAS int*)Lh)[4 * j + 3];
                const int tot = (h0 + h1) + (h2 + h3); int inc = tot;
#pragma unroll
                for (int o = 1; o < 8; o <<= 1) { const int tt = __shfl_up(inc, o, 8); if (j >= o) inc += tt; }
                const int ex = inc - tot;
                ((volatile LAS int*)Lh)[4 * j] = ex; ((volatile LAS int*)Lh)[4 * j + 1] = ex + h0; ((volatile LAS int*)Lh)[4 * j + 2] = ex + h0 + h1; ((volatile LAS int*)Lh)[4 * j + 3] = ex + h0 + h1 + h2;
            }
#pragma unroll
            for (int m = 0; m < 16; ++m) { const int pos = ((volatile LAS int*)Lh)[ide[m] >> PEER_EB_LOG] + rk[m]; Le[pos] = ide[m]; Lg[pos] = gte[m] * SVI_[ide[m]]; Lp[pos] = __builtin_bit_cast(int, SUI_[ide[m]] * sxi); }
        }
#ifdef PEER_DUP_S
        }; qs_(); __builtin_amdgcn_sched_barrier(0); qs_();
#endif
        v4u R0[4], R1[4], R2[4], R3[4];
#define PEER_LOADU(RR, S0) do { const size_t ro_ = (size_t)(Le[(S0)] & (scratch_dst ? PEER_PROBE_MASK : 0xFFFF)) * 512 + 16 * j; _Pragma("unroll") for (int q = 0; q < 4; ++q) RR[q] = *(const GAS v4u*)(EU4 + ro_ + 128 * q); } while (0)
#define PEER_DOTU(RR, EOUT) do { int h0_ = 0, h1_ = 0, l0_ = 0, l1_ = 0; \
            _Pragma("unroll") for (int q = 0; q < 4; q += 2) _Pragma("unroll") for (int w_ = 0; w_ < 4; ++w_) { \
                h0_ = __builtin_amdgcn_sdot8((int)RR[q][w_], xh[4 * q + w_], h0_, false); l0_ = __builtin_amdgcn_sdot8((int)RR[q][w_], xl[4 * q + w_], l0_, false); \
                h1_ = __builtin_amdgcn_sdot8((int)RR[q + 1][w_], xh[4 * q + 4 + w_], h1_, false); l1_ = __builtin_amdgcn_sdot8((int)RR[q + 1][w_], xl[4 * q + 4 + w_], l1_, false); } \
            int e_ = ((h0_ + h1_) << 4) + (l0_ + l1_); e_ = DPP_ADDI(e_, 0xB1, 0xF); e_ = DPP_ADDI(e_, 0x4E, 0xF); e_ = DPP_ADDI(e_, 0x141, 0xF); EOUT = e_; } while (0)
#define PEER_SWEEPU(BODY0, BODY1, BODY2, BODY3) do { \
            PEER_LOADU(R0, 0); PEER_LOADU(R1, 1); PEER_LOADU(R2, 2); PEER_LOADU(R3, 3); \
            for (int s = 0; s < 128; s += 4) { \
                BODY0; if (s + 4 < 128) PEER_LOADU(R0, s + 4); \
                BODY1; if (s + 4 < 128) PEER_LOADU(R1, s + 5); \
                BODY2; if (s + 4 < 128) PEER_LOADU(R2, s + 6); \
                BODY3; if (s + 4 < 128) PEER_LOADU(R3, s + 7); } } while (0)
#define PEER_FIN(RR, SS) do { int e1_; PEER_DOTU(RR, e1_); Lx[(SS)] = e1_; } while (0)
        PEER_SWEEPU(PEER_FIN(R0, s), PEER_FIN(R1, s + 1), PEER_FIN(R2, s + 2), PEER_FIN(R3, s + 3));
#ifdef PEER_DUP_U
        PEER_SWEEPU(PEER_FIN(R0, s), PEER_FIN(R1, s + 1), PEER_FIN(R2, s + 2), PEER_FIN(R3, s + 3));
#endif
#undef PEER_FIN
        float yscale;
        {
            float cf_[16]; float cmax = 0.f;
#pragma unroll
            for (int i = 0; i < 16; ++i) { const int ix = 16 * j + i; cf_[i] = Lg[ix] * gelu_cdf((float)Lx[ix] * __builtin_bit_cast(float, Lp[ix])); cmax = fmaxf(cmax, fabsf(cf_[i])); }
            cmax = fmaxf(cmax, __shfl_xor(cmax, 1, 8)); cmax = fmaxf(cmax, __shfl_xor(cmax, 2, 8)); cmax = fmaxf(cmax, __shfl_xor(cmax, 4, 8));
            const float cqs = cmax > 0.f ? 119.f / cmax : 0.f; yscale = cmax > 0.f ? cmax / 119.f : 0.f;
            int pk_[4];
#pragma unroll
            for (int m = 0; m < 2; ++m) { unsigned lo_ = 0u, hi_ = 0u;
#pragma unroll
                for (int n = 0; n < 8; ++n) { const int t_ = (int)rintf(cf_[8 * m + n] * cqs) + 8; lo_ |= (unsigned)(t_ & 15) << (4 * n); hi_ |= (unsigned)((t_ >> 4) & 15) << (4 * n); }
                pk_[2 * m] = (int)(lo_ ^ 0x88888888u); pk_[2 * m + 1] = (int)hi_; }
#pragma unroll
            for (int m = 0; m < 4; ++m) Lp[4 * j + m] = pk_[m];
        }
#ifndef PEER_DUP_V
#define PEER_DUP_V 1
#endif
#pragma unroll
        for (int HH = 0; HH < 2 * PEER_DUP_V; ++HH) { const int H = HH & 1;
            int yi[64], yh[64];
#pragma unroll
            for (int i = 0; i < 64; ++i) { yi[i] = 0; yh[i] = 0; }
            v4u RV[8][2];
#define PEER_ROFFV(S0) ((size_t)(Le[(S0)] & (scratch_dst ? PEER_PROBE_MASK : 0xFFFF)) * 512 + 256 * H + 16 * j)
#pragma unroll
            for (int r = 0; r < 8; ++r) { const size_t ro_ = PEER_ROFFV(r); RV[r][0] = *(const GAS v4u*)(EV4 + ro_); RV[r][1] = *(const GAS v4u*)(EV4 + ro_ + 128); }
            for (int bt = 0; bt < 16; ++bt) {
                const int cl_ = Lp[2 * bt], ch_ = Lp[2 * bt + 1];
                size_t ron[8];
#pragma unroll
                for (int r = 0; r < 8; ++r) ron[r] = (bt + 1 < 16) ? PEER_ROFFV(8 * bt + 8 + r) : 0;
#pragma unroll
                for (int q = 0; q < 2; ++q) {
#pragma unroll
                    for (int w_ = 0; w_ < 4; ++w_) {
                        unsigned E[4], O[4];
#pragma unroll
                        for (int p_ = 0; p_ < 4; ++p_) { const unsigned x_ = RV[2 * p_][q][w_], y_ = RV[2 * p_ + 1][q][w_];
                            E[p_] = (x_ & 0x0F0F0F0Fu) | ((y_ << 4) & 0xF0F0F0F0u); O[p_] = ((x_ >> 4) & 0x0F0F0F0Fu) | (y_ & 0xF0F0F0F0u); }
                        unsigned C[8];
                        { const unsigned p0 = __builtin_amdgcn_perm(E[1], E[0], 0x05010400u), p1 = __builtin_amdgcn_perm(E[1], E[0], 0x07030602u), p2 = __builtin_amdgcn_perm(E[3], E[2], 0x05010400u), p3 = __builtin_amdgcn_perm(E[3], E[2], 0x07030602u);
                          C[0] = __builtin_amdgcn_perm(p2, p0, 0x05040100u); C[2] = __builtin_amdgcn_perm(p2, p0, 0x07060302u); C[4] = __builtin_amdgcn_perm(p3, p1, 0x05040100u); C[6] = __builtin_amdgcn_perm(p3, p1, 0x07060302u); }
                        { const unsigned p0 = __builtin_amdgcn_perm(O[1], O[0], 0x05010400u), p1 = __builtin_amdgcn_perm(O[1], O[0], 0x07030602u), p2 = __builtin_amdgcn_perm(O[3], O[2], 0x05010400u), p3 = __builtin_amdgcn_perm(O[3], O[2], 0x07030602u);
                          C[1] = __builtin_amdgcn_perm(p2, p0, 0x05040100u); C[3] = __builtin_amdgcn_perm(p2, p0, 0x07060302u); C[5] = __builtin_amdgcn_perm(p3, p1, 0x05040100u); C[7] = __builtin_amdgcn_perm(p3, p1, 0x07060302u); }
#pragma unroll
                        for (int n = 0; n < 8; ++n) { yh[32 * q + 8 * w_ + n] = __builtin_amdgcn_sdot8((int)C[n], ch_, yh[32 * q + 8 * w_ + n], false);
                            yi[32 * q + 8 * w_ + n] = __builtin_amdgcn_sdot8((int)C[n], cl_, yi[32 * q + 8 * w_ + n], false); }
                    }
                    if (bt + 1 < 16) {
#pragma unroll
                        for (int r = 0; r < 8; ++r) RV[r][q] = *(const GAS v4u*)(EV4 + ron[r] + 128 * q); }
                }
            }
#undef PEER_ROFFV
#pragma unroll
            for (int i = 0; i < 64; ++i) yi[i] += yh[i] << 4;
            const int b = (int)(t / SEQ);
            const float* g2 = mod_ + b * NMOD + 5120 + 128 * H + 8 * j;
            const float* ip = out_ + t * D + 128 * H + 8 * j; float* op = ((scratch_dst || HH + 2 < 2 * PEER_DUP_V) ? WSP(float, WS_SCORES) : out_) + t * D + 128 * H + 8 * j;
#pragma unroll
            for (int q = 0; q < 2; ++q)
#pragma unroll
                for (int w_ = 0; w_ < 4; ++w_)
#pragma unroll
                    for (int nh = 0; nh < 2; ++nh) { const int co = 256 * (2 * (w_ & 1) + nh) + 64 * q + 4 * (w_ >> 1); const int yb = 32 * q + 8 * w_ + 4 * nh;
                        const f32x4 x1 = *(const GAS f32x4*)(ip + co); const f32x4 gg = *(const f32x4*)(g2 + co) * yscale;
                        f32x4 o; o.x = x1.x + gg.x * (float)yi[yb]; o.y = x1.y + gg.y * (float)yi[yb + 1]; o.z = x1.z + gg.z * (float)yi[yb + 2]; o.w = x1.w + gg.w * (float)yi[yb + 3];
                        *(GAS f32x4*)(op + co) = o; }
        }
#undef PEER_LOADU
#undef PEER_DOTU
#undef PEER_SWEEPU
    }
}

DI void ph_inproj(const Frame& F) {
    pg8::Gemm g{WSP(bf16, WS_XN), WSP(bf16, WS_WIN), T, NPROJ, D}; pg8::StaticOrder S; S.init(T, NPROJ, F.G, (int)blockIdx.x);
    pg8::EpiBf16<0> E{WSP(bf16, WS_PROJ), NPROJ, nullptr, 0, 0, 1.f};
    pg8::gemm_phase<pg8::EpiBf16<0>, pg8::StaticOrder, PG8_ALIGN, PG8_SP2>(F.lds, g, S, E);
}
DI void ph_mix(const Frame& F, bool probe_first) {
    stage_conv_w(F);
    {
        int u = F.vcu;
        MlLocalRegs ra;
        if (u < 2048) ml_local_load(F, u >> 6, u & 63, ra);
        const int gwv = F.vcu * NWAVES + F.wave, NGWv = F.G * NWAVES;
        int eb = 2 * gwv;
        while (u < 2048) {
            const int un = u + F.G;
            MlLocalRegs rb;
            if (un < 2048) ml_local_load(F, un >> 6, un & 63, rb);
            ExpRows2 er; const bool ew = eb < 32768;
            if (ew) exp_load2(F, eb, er);
            ml_local_unit(F, u >> 6, u & 63, ra);
            if (ew) exp_conv2(F, eb, er);
            eb += 2 * NGWv;
            ra = rb; u = un;
        }
        for (; eb < 32768; eb += 2 * NGWv) { ExpRows2 er; exp_load2(F, eb, er); exp_conv2(F, eb, er); }
    }
    (void)probe_first;
}
DI void ph_scan_attn(const Frame& F) {
    ml_scan_phase(F);
    __syncthreads();
    for (int u = F.vcu; u < 1024; u += F.G) { const int qb = 15 - (u >> 6), bh = u & 63; sb_unit(F, bh >> 3, bh & 7, qb); }
}
DI void ph_mlout(const Frame& F) { stage_conv_w(F); for (int u = F.vcu; u < 2048; u += F.G) ml_out_unit(F, u >> 6, u & 63); }
#ifndef P5_ALIGN
#define P5_ALIGN PG8_ALIGN
#endif
DI void ph_outproj(const Frame& F) {
    pg8::Gemm g{WSP(bf16, WS_MIX), WSP(bf16, WS_WOUT), T, D, D}; pg8::StaticOrder S; S.init(T, D, F.G, (int)blockIdx.x);
    pg8::EpiResGate E{inp(I_X), (float*)inp(I_OUT), WSP(float, WS_MOD) + 2048, NMOD, SEQ, D};
    pg8::gemm_phase<pg8::EpiResGate, pg8::StaticOrder, P5_ALIGN, PG8_SP2>(F.lds, g, S, E);
}
DI void ph_scores(const Frame& F) {
    pg8::Gemm g{WSP(bf16, WS_XN), WSP(bf16, WS_WEFF), T, NSC, D}; pg8::StaticOrder S; S.init(T, NSC, F.G, (int)blockIdx.x);
    EpiTopK E{WSP(int, WS_IDX), WSP(float, WS_GATE)};
    pg8::Unit un;
    for (int i = 0; S.next(i, un); ++i) { OneUnit S1{un}; pg8::gemm_phase<EpiTopK, OneUnit, false, PG8_SP2>(F.lds, g, S1, E); }
}
constexpr int N_PHASES = 11;
struct Args { const float* in[19]; float* out; unsigned char* ws; int ph_lo, ph_hi; };
__global__ void __launch_bounds__(NTHR, 2) hybrid_fwd(Args args) {
    extern __shared__ __attribute__((aligned(16))) unsigned char lds_raw[];
    Frame F;
    F.lds = (LAS unsigned char*)lds_raw;
    F.MISC = (volatile LAS unsigned*)(F.lds + LDSCTL_OFF + 320);
    F.tid = threadIdx.x; F.lane = F.tid & 63; F.wave = __builtin_amdgcn_readfirstlane(F.tid >> 6);
    F.G = gridDim.x; { const int bx = blockIdx.x; F.vcu = (F.G % 8 == 0) ? (bx % 8) * (F.G / 8) + bx / 8 : bx; }
    F.ws = args.ws;
    F.ctl = (gu32*)(F.ws + WS_CTL);
    for (int u = F.tid; u < (LDS_BYTES - LDSCTL_OFF) / 4; u += NTHR) ((LAS unsigned*)(F.lds + LDSCTL_OFF))[u] = 0u;
    __syncthreads();
    const int lo = args.ph_lo, hi = args.ph_hi;
    const bool one_launch = (hi - lo) > 1;
    XcdBarrier bar; bar.bar = (unsigned*)(F.ctl + CW_BAR); bar.x = 0; bar.st = nullptr;
    if (one_launch) bar = xcd_barrier_post((unsigned*)(F.ctl + CW_BAR), F.MISC + 8);
#ifndef PHMASK
#define PHMASK 0x7ff
#endif
#define IN(k) (((PHMASK >> (k)) & 1) && lo <= (k) && (k) < hi)
#define SEAM(k) do { if (IN(k) && IN((k) + 1)) xcd_barrier(bar); } while (0)
#ifndef REPMASK
#define REPMASK 0
#endif

#define RUN(k, ...) do { if (IN(k)) { if ((REPMASK >> (k)) & 1) { { const bool first = true; (void)first; __VA_ARGS__; } xcd_barrier(bar); } { const bool first = false; (void)first; __VA_ARGS__; } } } while (0)
    RUN(0, p0_phase(F, first ? P0_PARTS : 15)); SEAM(0);
    RUN(1, norm_phase<true>(F, inp(I_X), inp(I_GN1), 0, 1024)); SEAM(1);
    RUN(2, ph_inproj(F)); SEAM(2);
    RUN(3, ph_mix(F, first)); SEAM(3);
    RUN(10, ph_scan_attn(F)); if (IN(10) && IN(4)) xcd_barrier(bar);
    RUN(4, ph_mlout(F)); SEAM(4);
    RUN(5, ph_outproj(F)); SEAM(5);
    RUN(6, norm_phase<false>(F, inp(I_OUT), inp(I_GN2), 3072, 4096)); SEAM(6);
    RUN(7, ph_scores(F)); if (IN(7) && IN(9)) xcd_barrier(bar);
    RUN(9, peer_phase(F, first));
#undef RUN
#undef IN
#undef SEAM
}

#ifndef MK_PER_PHASE
#define MK_PER_PHASE 0
#endif
extern "C" void kernel_launch(void* const* d_in, const int* in_sizes, int n_in, void* d_out, int out_size, void* d_ws, size_t ws_size, hipStream_t stream) {
    static int grid = 0;
    if (grid == 0) {
        if (n_in != 19 || in_sizes[0] != T * D || out_size != T * D || ws_size < WS_END) { fprintf(stderr, "kernel_launch: unexpected shapes (n_in %d, in0 %d, out %d, ws %zu)\n", n_in, n_in > 0 ? in_sizes[0] : -1, out_size, ws_size); grid = -1; return; }
        int dev = 0, cus = 0, per_cu = 0;
        if (hipGetDevice(&dev) != hipSuccess || hipDeviceGetAttribute(&cus, hipDeviceAttributeMultiprocessorCount, dev) != hipSuccess) { grid = -1; return; }
        if (hipFuncSetAttribute((const void*)hybrid_fwd, hipFuncAttributeMaxDynamicSharedMemorySize, LDS_BYTES) != hipSuccess) { fprintf(stderr, "kernel_launch: hipFuncSetAttribute failed\n"); grid = -1; return; }
        if (hipOccupancyMaxActiveBlocksPerMultiprocessor(&per_cu, (const void*)hybrid_fwd, NTHR, LDS_BYTES) != hipSuccess || per_cu < 1) fprintf(stderr, "kernel_launch: occupancy query says %d\n", per_cu);
        (void)hipGetLastError();
        grid = cus;
    }
    if (grid < 0) return;
    if (hipMemsetAsync((char*)d_ws + WS_CTL, 0, CTL_ZERO_BYTES, stream) != hipSuccess) { fprintf(stderr, "kernel_launch: memset failed\n"); return; }
    Args a{};
    for (int i = 0; i < 19; ++i) a.in[i] = (const float*)d_in[i];
    a.out = (float*)d_out; a.ws = (unsigned char*)d_ws;
#if MK_PER_PHASE
    { const int order[N_PHASES] = {0, 1, 2, 3, 10, 4, 5, 6, 7, 8, 9}; for (int i = 0; i < N_PHASES; ++i) { a.ph_lo = order[i]; a.ph_hi = order[i] + 1; hipLaunchKernelGGL(hybrid_fwd, dim3(grid), dim3(NTHR), LDS_BYTES, stream, a); } }
#else
    a.ph_lo = 0; a.ph_hi = N_PHASES;
    hipLaunchKernelGGL(hybrid_fwd, dim3(grid), dim3(NTHR), LDS_BYTES, stream, a);
#endif
    const hipError_t le = hipPeekAtLastError();
    if (le != hipSuccess) fprintf(stderr, "kernel_launch: launch failed: %s\n", hipGetErrorName(le));
}
```

```cpp
#include <cmath>
#include <hip/hip_runtime.h>
#include <cstdio>
#include <cstdint>
namespace pg8 {
#define PG8_LAS __attribute__((address_space(3)))
typedef unsigned short bf16_t;
typedef short bf16x8 __attribute__((ext_vector_type(8)));
typedef float f32x4 __attribute__((ext_vector_type(4)));
typedef unsigned u32x4 __attribute__((ext_vector_type(4)));
constexpr int BM = 256, BK = 64, HALF = 128, HTB = HALF * BK * 2  , STAGE_BYTES = 8 * HTB, NXCD = 8,
#ifndef PG8_WGM
#define PG8_WGM 4
#endif
WGM = PG8_WGM;

__host__ __device__ __forceinline__ int lds_byte(int r, int c) { const int st = (r >> 4) * 2 + (c >> 5), rr = r & 15, cc = c & 31, ob = rr * 64 + cc * 2; return st * 1024 + (ob ^ (((ob >> 9) & 1) << 5)); }
__host__ __device__ __forceinline__ void stage_rc(int b, int& R, int& C) { const int st = b / 1024, sb = b % 1024, swz = sb ^ (((sb >> 9) & 1) << 5); R = (st >> 1) * 16 + swz / 64; C = (st & 1) * 32 + (swz % 64) / 2; }
__host__ __device__ __forceinline__ int perm32(int rho) { const int n = rho >> 4, i = rho & 15; return 8 * (i >> 2) + 4 * n + (i & 3); }

struct Unit { int pm, pn; };
struct Gemm { const bf16_t* A; const bf16_t* Bt; int M, N, K; };

struct StaticOrder {
    int nM, nN, nwg, G, c;
    __host__ __device__ void init(int M, int N, int G_, int c_) { nM = M / BM; nN = N / BM; nwg = nM * nN; G = G_; c = c_; }
    __host__ __device__ bool next(int i, Unit& u) const {
        const long L = (long)i * G + c; if (L >= nwg) return false;
        int wgid = (int)L; { const int q = nwg / NXCD, r = nwg % NXCD, xcd = wgid % NXCD, off = wgid / NXCD; wgid = (xcd < r ? xcd * (q + 1) : r * (q + 1) + (xcd - r) * q) + off; }
        const int nig = WGM * nN, gid = wgid / nig, fm = gid * WGM, gsz = (nM - fm) < WGM ? (nM - fm) : WGM;
        u.pm = fm + ((wgid % nig) % gsz); u.pn = (wgid % nig) / gsz; return true;
    }
    __device__ __forceinline__ void a_ready(const Unit&) const {}
    __device__ __forceinline__ void done(const Unit&) const {}
};

__device__ __forceinline__ unsigned cvt_pk_bf16(float lo, float hi) { unsigned r; asm volatile("v_cvt_pk_bf16_f32 %0, %1, %2" : "=v"(r) : "v"(lo), "v"(hi)); return r; }
typedef float f32x2 __attribute__((ext_vector_type(2)));
__device__ __forceinline__ f32x2 gelu_pk(f32x2 v) {
    const f32x2 av = __builtin_elementwise_abs(v), d = av * 0.2316418882f + 1.0f;
    f32x2 t; t.x = __builtin_amdgcn_rcpf(d.x); t.y = __builtin_amdgcn_rcpf(d.y);
    f32x2 q = t * 0.5307027145f + (-0.7265760135f); q = q * t + 0.7107068705f; q = q * t + (-0.142248368f); q = q * t + 0.127414796f; q = q * t;
    const f32x2 s = (v * v) * (-0.72134752044f);
    f32x2 e; e.x = __builtin_amdgcn_exp2f(s.x); e.y = __builtin_amdgcn_exp2f(s.y);
    const f32x2 m = v * (q * e), r = v - m;
    f32x2 o; o.x = v.x < 0.f ? m.x : r.x; o.y = v.y < 0.f ? m.y : r.y; return o;
}

template <int ACT  > struct EpiBf16 {
    static constexpr bool PERM = true, AFTER_DRAIN = false; static_assert(ACT == 0 || ACT == 1, "EpiBf16: ACT is 0 (none) or 1 (gelu_pk)");
    bf16_t* O; int ldc; const float* bias; int split_cols; size_t split_stride; float scale0;
    __device__ __forceinline__ void operator()(const f32x4 (&acc)[2][2][4][2], const Unit& u, int wr, int wc, int fr, int fq) const {
        const int row0 = u.pm * BM + wr * 64 + fr; int colt = u.pn * BM; bf16_t* base = O;
        float sc = 1.f; if (split_cols) { const int t = colt / split_cols; base += (size_t)t * split_stride; colt -= t * split_cols; if (t == 0) sc = scale0; }
        const int col0 = colt + wc * 32 + 8 * fq, bcol0 = u.pn * BM + wc * 32 + 8 * fq;
        f32x4 bv[2][2];
#pragma unroll
        for (int bj = 0; bj < 2; ++bj)
#pragma unroll
            for (int n = 0; n < 2; ++n) bv[bj][n] = bias ? *(const f32x4*)(bias + bcol0 + bj * HALF + 4 * n) : (f32x4){0.f, 0.f, 0.f, 0.f};
#pragma unroll
        for (int ai = 0; ai < 2; ++ai)
#pragma unroll
            for (int m = 0; m < 4; ++m) { bf16_t* rowp = base + (size_t)(row0 + ai * HALF + m * 16) * ldc + col0;
#pragma unroll
                for (int bj = 0; bj < 2; ++bj) { f32x4 v0 = acc[ai][bj][m][0] + bv[bj][0], v1 = acc[ai][bj][m][1] + bv[bj][1];
                    if (ACT == 1) { f32x2 a = gelu_pk((f32x2){v0[0], v0[1]}), b = gelu_pk((f32x2){v0[2], v0[3]}), c = gelu_pk((f32x2){v1[0], v1[1]}), d = gelu_pk((f32x2){v1[2], v1[3]});
                        v0 = (f32x4){a.x, a.y, b.x, b.y}; v1 = (f32x4){c.x, c.y, d.x, d.y}; }
                    v0 = v0 * sc; v1 = v1 * sc; u32x4 w; w.x = cvt_pk_bf16(v0[0], v0[1]); w.y = cvt_pk_bf16(v0[2], v0[3]); w.z = cvt_pk_bf16(v1[0], v1[1]); w.w = cvt_pk_bf16(v1[2], v1[3]);
                    *(u32x4*)(rowp + bj * HALF) = w; } }
    }
};
template <class Epi, class Sched, bool ALIGN_EPI = false, bool SP2 = false>
__device__ __forceinline__ void gemm_phase(PG8_LAS unsigned char* lds, const Gemm g, const Sched& S, const Epi& E) {
    const int tid = threadIdx.x, wid = __builtin_amdgcn_readfirstlane(tid >> 6), lane = tid & 63, wr = wid >> 2, wc = wid & 3, fr = lane & 15, fq = lane >> 4;
    const int K = g.K, nt = K / BK;
    unsigned voffA[2], voffB[2];
#pragma unroll
    for (int i = 0; i < 2; ++i) { int R, C; stage_rc(tid * 16 + i * 8192, R, C); const int Rb = Epi::PERM ? ((R & ~31) + perm32(R & 31)) : R;
        voffA[i] = (unsigned)(R * K + C) * 2u; voffB[i] = (unsigned)(Rb * K + C) * 2u; }
    const size_t kstep = (size_t)(BK * 2);
    const size_t hstep = (size_t)HALF * K * 2;
    const size_t tstep = 2 * hstep;
    const unsigned ldsw = (unsigned)wid * 1024u;
    const int aoff = lds_byte(wr * 64 + fr, fq * 8), boff = lds_byte(wc * 32 + fr, fq * 8);
#define PG8_SA(b, h) (((b) * 2 + (h)) * HTB)
#define PG8_SB(b, h) ((4 + (b) * 2 + (h)) * HTB)
#define PG8_STAGE(bufoff, gbase, voff) do { _Pragma("unroll") for (int _i = 0; _i < 2; ++_i) \
        __builtin_amdgcn_global_load_lds((const unsigned*)((const char*)(gbase) + (voff)[_i]), (PG8_LAS unsigned*)(lds + (bufoff) + ldsw + _i * 8192), 16, 0, 0); } while (0)
#define PG8_LDA(dst, b, h) do { _Pragma("unroll") for (int m = 0; m < 4; ++m) _Pragma("unroll") for (int k = 0; k < 2; ++k) dst[m][k] = *(const PG8_LAS bf16x8*)(lds + PG8_SA(b, h) + aoff + m * 2048 + k * 1024); } while (0)
#define PG8_LDB(dst, b, h) do { _Pragma("unroll") for (int n = 0; n < 2; ++n) _Pragma("unroll") for (int k = 0; k < 2; ++k) dst[n][k] = *(const PG8_LAS bf16x8*)(lds + PG8_SB(b, h) + boff + n * 2048 + k * 1024); } while (0)
#define PG8_MMA(ai, bj, At, Bt) do { __builtin_amdgcn_s_setprio(1); _Pragma("unroll") for (int m = 0; m < 4; ++m) _Pragma("unroll") for (int n = 0; n < 2; ++n) _Pragma("unroll") for (int k = 0; k < 2; ++k) \
        acc[ai][bj][m][n] = __builtin_amdgcn_mfma_f32_16x16x32_bf16(Bt[n][k], At[m][k], acc[ai][bj][m][n], 0, 0, 0); __builtin_amdgcn_s_setprio(0); } while (0)
#define PG8_WAIT_V(n) asm volatile("s_waitcnt vmcnt(" #n ")" ::: "memory")
#define PG8_WAIT_L(n) asm volatile("s_waitcnt lgkmcnt(" #n ")" ::: "memory")
#define PG8_BAR __builtin_amdgcn_s_barrier()
#define PG8_SCHED __builtin_amdgcn_sched_barrier(0)
    Unit cur, nxt; int ui = 0;
    if (!S.next(0, cur)) return;
    f32x4 acc[2][2][4][2];
#pragma unroll
    for (int a = 0; a < 2; ++a)
#pragma unroll
        for (int b = 0; b < 2; ++b)
#pragma unroll
            for (int m = 0; m < 4; ++m)
#pragma unroll
                for (int n = 0; n < 2; ++n) acc[a][b][m][n] = (f32x4){0.f, 0.f, 0.f, 0.f};
    bf16x8 At[4][2], B0[2][2], B1[2][2];
    const char* cA = (const char*)g.A + (size_t)cur.pm * tstep; const char* cB = (const char*)g.Bt + (size_t)cur.pn * tstep;
    S.a_ready(cur);
    if constexpr (SP2) {
        PG8_STAGE(PG8_SB(0, 0), cB, voffB); PG8_STAGE(PG8_SB(0, 1), cB + hstep, voffB); PG8_STAGE(PG8_SA(0, 0), cA, voffA); PG8_STAGE(PG8_SA(0, 1), cA + hstep, voffA);
        if (wr == 1) PG8_BAR;
        PG8_WAIT_V(2); PG8_BAR;
        PG8_STAGE(PG8_SB(1, 0), cB + kstep, voffB); PG8_STAGE(PG8_SA(1, 0), cA + kstep, voffA); PG8_STAGE(PG8_SB(1, 1), cB + hstep + kstep, voffB);
        PG8_WAIT_V(6); PG8_BAR;
    } else {
        PG8_STAGE(PG8_SB(0, 0), cB, voffB); PG8_STAGE(PG8_SA(0, 0), cA, voffA); PG8_STAGE(PG8_SB(0, 1), cB + hstep, voffB); PG8_STAGE(PG8_SA(0, 1), cA + hstep, voffA);
        if (wr == 1) PG8_BAR;
        PG8_WAIT_V(4); PG8_BAR;
        PG8_STAGE(PG8_SB(1, 0), cB + kstep, voffB); PG8_STAGE(PG8_SA(1, 0), cA + kstep, voffA); PG8_STAGE(PG8_SB(1, 1), cB + hstep + kstep, voffB);
        PG8_WAIT_V(6); PG8_BAR;
    }
    for (;;) {
        const bool has_next = S.next(ui + 1, nxt);
        const char* nA = has_next ? (const char*)g.A + (size_t)nxt.pm * tstep : cA; const char* nB = has_next ? (const char*)g.Bt + (size_t)nxt.pn * tstep : cB;
        for (int t = 0; t < nt; t += 2) {
            const bool last = (t == nt - 2);
            const char* a1 = cA + (size_t)(t + 1) * kstep;
            const char* a2 = last ? nA : cA + (size_t)(t + 2) * kstep; const char* b2 = last ? nB : cB + (size_t)(t + 2) * kstep;
            const char* a3 = a2 + kstep; const char* b3 = b2 + kstep;
            if (last && has_next) S.a_ready(nxt);
            if constexpr (SP2) {
            PG8_LDB(B0, 0, 0); PG8_LDB(B1, 0, 1); PG8_SCHED; PG8_LDA(At, 0, 0); PG8_STAGE(PG8_SA(1, 1), a1 + hstep, voffA);
            PG8_WAIT_V(8); PG8_WAIT_L(0); PG8_BAR; PG8_MMA(0, 0, At, B0); PG8_MMA(0, 1, At, B1); PG8_BAR; PG8_SCHED;
            PG8_LDA(At, 0, 1); PG8_STAGE(PG8_SB(0, 0), b2, voffB); PG8_STAGE(PG8_SB(0, 1), b2 + hstep, voffB); PG8_STAGE(PG8_SA(0, 0), a2, voffA);
            PG8_WAIT_V(8); PG8_WAIT_L(0); PG8_BAR; PG8_MMA(1, 0, At, B0); PG8_MMA(1, 1, At, B1); PG8_BAR; PG8_SCHED;
            PG8_LDB(B0, 1, 0); PG8_LDB(B1, 1, 1); PG8_SCHED; PG8_LDA(At, 1, 0); PG8_STAGE(PG8_SA(0, 1), a2 + hstep, voffA);
            PG8_WAIT_V(8); PG8_WAIT_L(0); PG8_BAR; PG8_MMA(0, 0, At, B0); PG8_MMA(0, 1, At, B1); PG8_BAR; PG8_SCHED;
            PG8_LDA(At, 1, 1); PG8_STAGE(PG8_SB(1, 0), b3, voffB); PG8_STAGE(PG8_SB(1, 1), b3 + hstep, voffB); PG8_STAGE(PG8_SA(1, 0), a3, voffA);
            PG8_WAIT_V(8); PG8_WAIT_L(0); PG8_BAR; PG8_MMA(1, 0, At, B0); PG8_MMA(1, 1, At, B1); PG8_BAR; PG8_SCHED;
            } else {
            PG8_LDB(B0, 0, 0); PG8_SCHED; PG8_LDA(At, 0, 0); PG8_STAGE(PG8_SA(1, 1), a1 + hstep, voffA);
            PG8_WAIT_L(8); PG8_BAR; PG8_WAIT_L(0); PG8_MMA(0, 0, At, B0); PG8_BAR; PG8_SCHED;
            PG8_LDB(B1, 0, 1); PG8_STAGE(PG8_SB(0, 0), b2, voffB);
            PG8_BAR; PG8_WAIT_L(0); PG8_MMA(0, 1, At, B1); PG8_BAR;
            PG8_LDA(At, 0, 1); PG8_STAGE(PG8_SA(0, 0), a2, voffA);
            PG8_BAR; PG8_WAIT_L(0); PG8_MMA(1, 0, At, B0); PG8_BAR; PG8_SCHED;
            PG8_STAGE(PG8_SB(0, 1), b2 + hstep, voffB);
            PG8_WAIT_V(6); PG8_BAR; PG8_MMA(1, 1, At, B1); PG8_BAR;
            PG8_LDB(B0, 1, 0); PG8_SCHED; PG8_LDA(At, 1, 0); PG8_STAGE(PG8_SA(0, 1), a2 + hstep, voffA);
            PG8_WAIT_L(8); PG8_BAR; PG8_WAIT_L(0); PG8_MMA(0, 0, At, B0); PG8_BAR; PG8_SCHED;
            PG8_LDB(B1, 1, 1); PG8_STAGE(PG8_SB(1, 0), b3, voffB);
            PG8_BAR; PG8_WAIT_L(0); PG8_MMA(0, 1, At, B1); PG8_BAR;
            PG8_LDA(At, 1, 1); PG8_STAGE(PG8_SA(1, 0), a3, voffA);
            PG8_BAR; PG8_WAIT_L(0); PG8_MMA(1, 0, At, B0); PG8_BAR; PG8_SCHED;
            PG8_STAGE(PG8_SB(1, 1), b3 + hstep, voffB);
            PG8_WAIT_V(6); PG8_BAR; PG8_MMA(1, 1, At, B1); PG8_BAR;
            }
        }
        if constexpr (ALIGN_EPI) { if (wr == 0) PG8_BAR; }
        if constexpr (!Epi::AFTER_DRAIN) { E(acc, cur, wr, wc, fr, fq); S.done(cur); }
        if (!has_next) break;
#pragma unroll
        for (int a = 0; a < 2; ++a)
#pragma unroll
            for (int b = 0; b < 2; ++b)
#pragma unroll
                for (int m = 0; m < 4; ++m)
#pragma unroll
                    for (int n = 0; n < 2; ++n) acc[a][b][m][n] = (f32x4){0.f, 0.f, 0.f, 0.f};
        cur = nxt; cA = nA; cB = nB; ++ui;
        if constexpr (ALIGN_EPI) { if (wr == 1) PG8_BAR; }
    }
    PG8_WAIT_V(0);
    if constexpr (!ALIGN_EPI) { if (wr == 0) PG8_BAR; }
    PG8_BAR;
    if constexpr (Epi::AFTER_DRAIN) { E.fused(acc, cur, wr, wc, fr, fq, lds, wid, lane); S.done(cur); }
#undef PG8_SA
#undef PG8_SB
#undef PG8_STAGE
#undef PG8_LDA
#undef PG8_LDB
#undef PG8_MMA
#undef PG8_WAIT_V
#undef PG8_WAIT_L
#undef PG8_BAR
#undef PG8_SCHED
}
}

#ifndef PG8_SP2
#define PG8_SP2 true
#endif
#ifndef PG8_ALIGN
#define PG8_ALIGN true
#endif

namespace pg8 {
struct EpiResGate {
    static constexpr bool PERM = false, AFTER_DRAIN = false;
    const float* base; float* out; const float* gate; int gate_ld; int rows_per_batch; int ldc;
    __device__ __forceinline__ void operator()(const f32x4 (&acc)[2][2][4][2], const Unit& u, int wr, int wc, int fr, int fq) const {
        const int row0 = u.pm * BM + wr * 64 + fr, col0 = u.pn * BM + wc * 32 + 4 * fq;
        const float* gp = gate + (size_t)((u.pm * BM) / rows_per_batch) * gate_ld + col0;
        f32x4 gv[2][2];
#pragma unroll
        for (int bj = 0; bj < 2; ++bj)
#pragma unroll
            for (int n = 0; n < 2; ++n) gv[bj][n] = *(const f32x4*)(gp + bj * HALF + n * 16);
#pragma unroll
        for (int ai = 0; ai < 2; ++ai)
#pragma unroll
            for (int m = 0; m < 4; ++m) { const size_t off = (size_t)(row0 + ai * HALF + m * 16) * ldc + col0;
#pragma unroll
                for (int bj = 0; bj < 2; ++bj)
#pragma unroll
                    for (int n = 0; n < 2; ++n) { const f32x4 bs = *(const f32x4*)(base + off + bj * HALF + n * 16);
                        *(f32x4*)(out + off + bj * HALF + n * 16) = bs + gv[bj][n] * acc[ai][bj][m][n]; } }
    }
};
struct EpiF32 {
    static constexpr bool PERM = false, AFTER_DRAIN = false;
    float* O; int ldc;
    __device__ __forceinline__ void operator()(const f32x4 (&acc)[2][2][4][2], const Unit& u, int wr, int wc, int fr, int fq) const {
        const int row0 = u.pm * BM + wr * 64 + fr, col0 = u.pn * BM + wc * 32 + 4 * fq;
#pragma unroll
        for (int ai = 0; ai < 2; ++ai)
#pragma unroll
            for (int m = 0; m < 4; ++m) { const size_t off = (size_t)(row0 + ai * HALF + m * 16) * ldc + col0;
#pragma unroll
                for (int bj = 0; bj < 2; ++bj)
#pragma unroll
                    for (int n = 0; n < 2; ++n) *(f32x4*)(O + off + bj * HALF + n * 16) = acc[ai][bj][m][n]; }
    }
};
}
#define GAS __attribute__((address_space(1)))
#define LAS __attribute__((address_space(3)))
typedef unsigned short bf16;
typedef unsigned v4u __attribute__((ext_vector_type(4)));
typedef float f32x4 __attribute__((ext_vector_type(4)));
typedef short bf16x8 __attribute__((ext_vector_type(8)));
typedef GAS unsigned gu32;
typedef GAS unsigned long long gu64;
#define RLX_AGENT __ATOMIC_RELAXED, __HIP_MEMORY_SCOPE_AGENT
#define LDS_WAIT() asm volatile("s_waitcnt lgkmcnt(0)" ::: "memory")
#define VM_WAIT() asm volatile("s_waitcnt vmcnt(0)" ::: "memory")
__device__ __forceinline__ unsigned long long rt() { return __builtin_amdgcn_s_memrealtime(); }
__device__ __forceinline__ unsigned f2bf(float f) { unsigned u = __builtin_bit_cast(unsigned, f); return (u + 0x7fffu + ((u >> 16) & 1u)) >> 16; }
__device__ __forceinline__ unsigned pk2(float lo, float hi) { return f2bf(lo) | (f2bf(hi) << 16); }

#define XB_TMO      128
#define XB_XCNT(j)  (256  + 64 * (j))
#define XB_XSUB(j)  (1280 + 64 * (j))
#define XB_XGEN(j)  (2304 + 64 * (j))
#define XB_TOP      3328
#define XB_TOPGEN   3392
#define XCD_BAR_WORDS 3456
#define XB_SPIN_CAP (1u << 24)

__device__ __forceinline__ unsigned xb_ld(unsigned* p)              { return __hip_atomic_load(p, __ATOMIC_RELAXED, __HIP_MEMORY_SCOPE_AGENT); }
__device__ __forceinline__ unsigned xb_add(unsigned* p, unsigned v) { return __hip_atomic_fetch_add(p, v, __ATOMIC_RELAXED, __HIP_MEMORY_SCOPE_AGENT); }
__device__ __forceinline__ unsigned xb_xcc_id() { return (unsigned)__builtin_amdgcn_s_getreg((3 << 11) | 20) & 0xFu; }
#define XB_SPIN(cond, bar) do { unsigned _sp = 0; while (cond) { __builtin_amdgcn_s_sleep(1); \
    if ((++_sp & 255u) == 0u) { if (xb_ld(&(bar)[XB_TMO])) break; if (_sp > XB_SPIN_CAP) { atomicAdd(&(bar)[XB_TMO], 1u); break; } } } } while (0)

struct XcdBarrier {
    unsigned* bar; unsigned x;
    volatile LAS unsigned* st;
};

__device__ __forceinline__ XcdBarrier xcd_barrier_post(unsigned* bar, volatile LAS unsigned* st) {
    XcdBarrier b; b.bar = bar; b.x = xb_xcc_id(); b.st = st;
    if (threadIdx.x == 0) (void)xb_add(&bar[XB_XCNT(b.x)], 1u);
    return b;
}
__device__ __forceinline__ void xcd_barrier_complete(unsigned* bar, unsigned x, unsigned& nloc, unsigned& nx) {
    const unsigned G = gridDim.x * gridDim.y * gridDim.z;
    unsigned sum, cnt, mine, sp = 0u;
    for (;;) {
        sum = 0u; cnt = 0u; mine = 0u;
#pragma unroll
        for (unsigned j = 0; j < 16; ++j) { const unsigned c = xb_ld(&bar[XB_XCNT(j)]); sum += c; cnt += (c > 0u) ? 1u : 0u; mine = (j == x) ? c : mine; }
        if (sum == G) break;
        __builtin_amdgcn_s_sleep(1);
        if ((++sp & 255u) == 0u) { if (xb_ld(&bar[XB_TMO])) break; if (sp > XB_SPIN_CAP) { atomicAdd(&bar[XB_TMO], 1u); break; } }
    }
    nloc = mine > 0u ? mine : 1u; nx = cnt > 0u ? cnt : 1u;
}

__device__ __forceinline__ void xcd_barrier(const XcdBarrier& b) {
    asm volatile("s_waitcnt vmcnt(0)" ::: "memory");
    __syncthreads();
    if (threadIdx.x == 0) {
        unsigned* bar = b.bar;
        __builtin_amdgcn_s_waitcnt(0);
        unsigned nloc = b.st[0], nx = b.st[1];
        if (nloc == 0u) { xcd_barrier_complete(bar, b.x, nloc, nx); b.st[0] = nloc; b.st[1] = nx; }
        const unsigned old = xb_add(&bar[XB_XSUB(b.x)], 1u);
        const unsigned gen = old / nloc;
        if (old + 1u == (gen + 1u) * nloc) {
            __builtin_amdgcn_fence(__ATOMIC_RELEASE, "agent");
            asm volatile("s_waitcnt vmcnt(0)" ::: "memory");
            const unsigned og = xb_add(&bar[XB_TOP], 1u);
            const unsigned tg = og / nx;
            if (og + 1u == (tg + 1u) * nx) xb_add(&bar[XB_TOPGEN], 1u);
            else XB_SPIN(xb_ld(&bar[XB_TOPGEN]) == tg, bar);
            __builtin_amdgcn_fence(__ATOMIC_ACQUIRE, "agent");
            xb_add(&bar[XB_XGEN(b.x)], 1u);
            asm volatile("s_waitcnt vmcnt(0)" ::: "memory");
        } else {
            XB_SPIN(xb_ld(&bar[XB_XGEN(b.x)]) == gen, bar);
            __builtin_amdgcn_fence(__ATOMIC_ACQUIRE, "agent");
            asm volatile("s_waitcnt vmcnt(0)" ::: "memory");
        }
    }
    __syncthreads();
}

constexpr int NWAVES = 8, NTHR = 512;
constexpr int NB = 8, SEQ = 4096, T = NB * SEQ, D = 1024, NPROJ = 3584, NIN = 3592, NMOD = 6144, NSC = 2048;
constexpr int C_QSB = 0, C_KSB = 512, C_VSB = 1024, C_QML = 1536, C_KML = 2048, C_VML = 2560, C_OML = 3072;
constexpr float EPS = 1e-6f, LOG2E = 1.4426950408889634f;
constexpr size_t MiB = 1u << 20;
constexpr size_t WS_CTL = 0, CTL_ZERO_BYTES = 1 * MiB;
constexpr size_t WS_MOD = 256 * 1024;
constexpr size_t WS_WIN = 2 * MiB, WS_WOUT = 10 * MiB, WS_WEFF = 12 * MiB;
constexpr size_t WS_XN = 16 * MiB;
constexpr size_t WS_PROJ = 80 * MiB;
constexpr size_t WS_MIX = 304 * MiB;
constexpr size_t WS_EXPU = 368 * MiB, WS_EXPV = 400 * MiB;
constexpr size_t WS_CST = 432 * MiB;
constexpr size_t WS_NST = 496 * MiB;
constexpr size_t WS_MST = 497 * MiB;
constexpr size_t WS_GATES = 498 * MiB;
constexpr size_t WS_SCORES = 80 * MiB;
constexpr size_t WS_IDX = 336 * MiB, WS_GATE = 352 * MiB;
constexpr size_t WS_SCL = 499 * MiB;
constexpr size_t WS_SUI = 499 * MiB + 65536, WS_SVI = 499 * MiB + 131072;
constexpr size_t WS_END = 500 * MiB;
constexpr int CW_Q3 = 64;
constexpr int CW_BAR = 4096;
constexpr int LDS_BYTES = 147456, LDSCTL_OFF = 143360;

typedef float f32x16 __attribute__((ext_vector_type(16)));
typedef float f32x2_t __attribute__((ext_vector_type(2)));
typedef __bf16 bf16x2_t __attribute__((ext_vector_type(2)));
typedef _Float16 f16x8 __attribute__((ext_vector_type(8)));
typedef short s16x4 __attribute__((ext_vector_type(4)));
typedef unsigned u32x2 __attribute__((ext_vector_type(2)));
#define DI __device__ __forceinline__
DI unsigned cvtpk(float lo, float hi) { f32x2_t v = {lo, hi}; bf16x2_t b = __builtin_convertvector(v, bf16x2_t); return __builtin_bit_cast(unsigned, b); }
DI float bflo(unsigned u) { return __uint_as_float(u << 16); }
DI float bfhi(unsigned u) { return __uint_as_float(u & 0xffff0000u); }
DI int crow(int i, int hi) { return (i & 3) + 8 * (i >> 2) + 4 * hi; }
DI int krow(int s, int hi, int j) { return 16 * s + 8 * (j >> 2) + 4 * hi + (j & 3); }
DI float swap_add(float v) { auto rr = __builtin_amdgcn_permlane32_swap(__float_as_uint(v), __float_as_uint(v), false, false); return __uint_as_float(rr[0]) + __uint_as_float(rr[1]); }
DI float swap_max(float v) { auto rr = __builtin_amdgcn_permlane32_swap(__float_as_uint(v), __float_as_uint(v), false, false); return fmaxf(__uint_as_float(rr[0]), __uint_as_float(rr[1])); }
DI float dot2bf(unsigned a, unsigned b, float acc) { return __builtin_amdgcn_fdot2_f32_bf16(__builtin_bit_cast(bf16x2_t, a), __builtin_bit_cast(bf16x2_t, b), acc, false); }
DI float ex2(float x) { return __builtin_amdgcn_exp2f(x); }
DI float lg2(float x) { return __builtin_amdgcn_logf(x); }
DI float fexp(float x) { return __builtin_amdgcn_exp2f(x * LOG2E); }
DI float wave_sum(float v) {
#pragma unroll
    for (int o = 1; o < 64; o <<= 1) v += __shfl_xor(v, o);
    return v;
}
DI float wave_max(float v) {
#pragma unroll
    for (int o = 1; o < 64; o <<= 1) v = fmaxf(v, __shfl_xor(v, o));
    return v;
}
#define DPP_MAXF(v, ctrl, rmask) fmaxf((v), __builtin_bit_cast(float, __builtin_amdgcn_update_dpp(0, __builtin_bit_cast(int, (v)), (ctrl), (rmask), 0xF, false)))
DI float wave_max_nonneg(float v) {
    v = DPP_MAXF(v, 0xB1, 0xF); v = DPP_MAXF(v, 0x4E, 0xF); v = DPP_MAXF(v, 0x141, 0xF); v = DPP_MAXF(v, 0x140, 0xF); v = DPP_MAXF(v, 0x142, 0xA); v = DPP_MAXF(v, 0x143, 0xC);
    return __builtin_bit_cast(float, __builtin_amdgcn_readlane(__builtin_bit_cast(int, v), 63));
}
#define DPP_ADDF(v, ctrl, rmask) ((v) + __builtin_bit_cast(float, __builtin_amdgcn_update_dpp(0, __builtin_bit_cast(int, (v)), (ctrl), (rmask), 0xF, false)))
DI float wave_sum_u(float v) {
    v = DPP_ADDF(v, 0xB1, 0xF); v = DPP_ADDF(v, 0x4E, 0xF); v = DPP_ADDF(v, 0x141, 0xF); v = DPP_ADDF(v, 0x140, 0xF); v = DPP_ADDF(v, 0x142, 0xA); v = DPP_ADDF(v, 0x143, 0xC);
    return __builtin_bit_cast(float, __builtin_amdgcn_readlane(__builtin_bit_cast(int, v), 63));
}
typedef short v4i16_t __attribute__((ext_vector_type(4)));
DI s16x4 trrd(LAS unsigned char* p) { return __builtin_bit_cast(s16x4, __builtin_amdgcn_ds_read_tr16_b64_v4i16((LAS v4i16_t*)p)); }
DI bf16x8 cat8(s16x4 a, s16x4 b) { return (bf16x8){a[0], a[1], a[2], a[3], b[0], b[1], b[2], b[3]}; }
#define MFMA_BF16(a, b, c) __builtin_amdgcn_mfma_f32_32x32x16_bf16((a), (b), (c), 0, 0, 0)
#define MFMA_F16(a, b, c) __builtin_amdgcn_mfma_f32_32x32x16_f16((a), (b), (c), 0, 0, 0)
DI unsigned pkh(float a, float b) { return __builtin_bit_cast(unsigned, __builtin_amdgcn_cvt_pkrtz(a, b)); }
DI bf16x8 packbf(const f32x16& x, int s) { v4u p; p.x = cvtpk(x[8 * s], x[8 * s + 1]); p.y = cvtpk(x[8 * s + 2], x[8 * s + 3]); p.z = cvtpk(x[8 * s + 4], x[8 * s + 5]); p.w = cvtpk(x[8 * s + 6], x[8 * s + 7]); return __builtin_bit_cast(bf16x8, p); }
DI f16x8 packh(const f32x16& x, int s) { v4u p; p.x = pkh(x[8 * s], x[8 * s + 1]); p.y = pkh(x[8 * s + 2], x[8 * s + 3]); p.z = pkh(x[8 * s + 4], x[8 * s + 5]); p.w = pkh(x[8 * s + 6], x[8 * s + 7]); return __builtin_bit_cast(f16x8, p); }

struct Frame {
    LAS unsigned char* lds;
    volatile LAS unsigned* MISC;
    gu32* ctl;
    unsigned char* ws;
    int tid, lane, wave, vcu, G;
};
DI const float* inp(int i) { const __attribute__((address_space(4))) unsigned long long* kp = (const __attribute__((address_space(4))) unsigned long long*)__builtin_amdgcn_kernarg_segment_ptr(); return (const float*)(const GAS float*)(*(volatile const __attribute__((address_space(4))) unsigned long long*)(kp + i)); }
enum { I_X = 0, I_C, I_WADA, I_BADA, I_GN1, I_WIN, I_BIG, I_BFG, I_CONVW, I_GQ, I_GK, I_GOSB, I_GOML, I_WOUT, I_GN2, I_WQ, I_SK, I_EU, I_EV, I_OUT };
#define WSP(type, off) ((type*)(F.ws + (off)))

DI void p0_transpose_item(const float* W, int K, int N, int ld, bf16* WT, LAS float* scr, int item, int lane) {
    const int nblk = N / 32, kb = item / nblk, nb = item % nblk, k0 = 64 * kb, n0 = 32 * nb;
    float tv[32];
#pragma unroll
    for (int i = 0; i < 32; ++i) tv[i] = W[(size_t)(k0 + 2 * i + (lane >> 5)) * ld + n0 + (lane & 31)];
#pragma unroll
    for (int i = 0; i < 32; ++i) scr[(2 * i + (lane >> 5)) * 33 + (lane & 31)] = tv[i];
    LDS_WAIT(); asm volatile("" ::: "memory");
    const int c = lane & 7;
#pragma unroll
    for (int j = 0; j < 4; ++j) { const int n = (lane >> 3) + 8 * j; const LAS float* s = scr + (8 * c) * 33 + n;
        v4u o; o.x = pk2(s[0 * 33], s[1 * 33]); o.y = pk2(s[2 * 33], s[3 * 33]); o.z = pk2(s[4 * 33], s[5 * 33]); o.w = pk2(s[6 * 33], s[7 * 33]);
        *(GAS v4u*)(WT + (size_t)(n0 + n) * K + k0 + 8 * c) = o; }
    LDS_WAIT(); asm volatile("" ::: "memory");
}
DI void p0_mod_block(const Frame& F, int item) {
    const float* const c_ = inp(I_C); const float* const w_ada_ = inp(I_WADA); const float* const b_ada_ = inp(I_BADA); float* const mod_ = WSP(float, WS_MOD);
    LAS float* scr = (LAS float*)(F.lds + F.wave * 16384);
    const int j = item * 64 + F.lane, d0 = F.wave * 128;
#pragma unroll
    for (int b = 0; b < 8; ++b)
#pragma unroll
        for (int q = 0; q < 2; ++q) { const float cv = c_[b * D + d0 + 64 * q + F.lane]; scr[b * 128 + 64 * q + F.lane] = cv / (1.f + fexp(-cv)); }
    LDS_WAIT(); asm volatile("" ::: "memory");
    float acc[8];
#pragma unroll
    for (int b = 0; b < 8; ++b) acc[b] = 0.f;
#pragma unroll 32
    for (int dd = 0; dd < 128; ++dd) { const float w = w_ada_[(size_t)(d0 + dd) * NMOD + j];
#pragma unroll
        for (int b = 0; b < 8; ++b) acc[b] += scr[b * 128 + dd] * w; }
#pragma unroll
    for (int b = 0; b < 8; ++b) scr[1024 + b * 64 + F.lane] = acc[b];
    __syncthreads();
    float tot = b_ada_[j];
#pragma unroll
    for (int w = 0; w < 8; ++w) tot += ((LAS float*)(F.lds + w * 16384))[1024 + F.wave * 64 + F.lane];
    mod_[F.wave * NMOD + j] = tot;
    __syncthreads();
}
DI void p0_weff_item(const Frame& F, int item) {
    const float* const sub_keys_ = inp(I_SK); const float* const w_q_peer_ = inp(I_WQ); bf16* const Weff_t_ = WSP(bf16, WS_WEFF);
    const int hp = item >> 4, dblk = item & 15;
    LAS float* sk = (LAS float*)F.lds;
    LAS float* rb = (LAS float*)(F.lds + 67584) + F.wave * 1024;
    { float tv[32];
#pragma unroll
      for (int i = 0; i < 32; ++i) tv[i] = sub_keys_[(size_t)hp * 16384 + F.tid + 512 * i];
#pragma unroll
      for (int i = 0; i < 32; ++i) { const int idx = F.tid + 512 * i; sk[(idx >> 7) * 129 + (idx & 127)] = tv[i]; } }
    const int d0 = 64 * dblk + 8 * F.wave;
#pragma unroll
    for (int r = 0; r < 8; ++r) { rb[r * 128 + F.lane] = w_q_peer_[(size_t)(d0 + r) * NSC + hp * 128 + F.lane]; rb[r * 128 + 64 + F.lane] = w_q_peer_[(size_t)(d0 + r) * NSC + hp * 128 + 64 + F.lane]; }
    __syncthreads();
    float a0[8], a1[8];
#pragma unroll
    for (int r = 0; r < 8; ++r) { a0[r] = 0.f; a1[r] = 0.f; }
#pragma unroll 4
    for (int c = 0; c < 128; ++c) { const float s0 = sk[F.lane * 129 + c], s1 = sk[(F.lane + 64) * 129 + c];
#pragma unroll
        for (int r = 0; r < 8; ++r) { const float a = rb[r * 128 + c]; a0[r] += a * s0; a1[r] += a * s1; } }
    v4u o0, o1; o0.x = pk2(a0[0], a0[1]); o0.y = pk2(a0[2], a0[3]); o0.z = pk2(a0[4], a0[5]); o0.w = pk2(a0[6], a0[7]);
    o1.x = pk2(a1[0], a1[1]); o1.y = pk2(a1[2], a1[3]); o1.z = pk2(a1[4], a1[5]); o1.w = pk2(a1[6], a1[7]);
    *(GAS v4u*)(Weff_t_ + (size_t)(hp * 128 + F.lane) * D + d0) = o0;
    *(GAS v4u*)(Weff_t_ + (size_t)(hp * 128 + 64 + F.lane) * D + d0) = o1;
    __syncthreads();
}
struct ExpRows2 { f32x4 v[2][4]; };
DI void exp_load2(const Frame& F, int blk0, ExpRows2& R) {
    const float* const expert_u_ = inp(I_EU); const float* const expert_v_ = inp(I_EV);
#pragma unroll
    for (int bb = 0; bb < 2; ++bb) { const int blk = blk0 + bb; const float* src = (blk < 16384 ? expert_u_ : expert_v_) + (size_t)(blk & 16383) * 1024 + 4 * F.lane;
#pragma unroll
        for (int k = 0; k < 4; ++k) R.v[bb][k] = __builtin_nontemporal_load((const GAS f32x4*)(src + 256 * k)); }
}
DI void exp_conv2(const Frame& F, int blk0, const ExpRows2& R) {
    float* const SUI_ = WSP(float, WS_SUI); float* const SVI_ = WSP(float, WS_SVI);
#pragma unroll
    for (int bb = 0; bb < 2; ++bb) { const int blk = blk0 + bb; const bool isu = blk < 16384; const int e = blk & 16383;
        float mx = 0.f;
#pragma unroll
        for (int k = 0; k < 4; ++k) mx = fmaxf(mx, fmaxf(fmaxf(fabsf(R.v[bb][k].x), fabsf(R.v[bb][k].y)), fmaxf(fabsf(R.v[bb][k].z), fabsf(R.v[bb][k].w))));
        mx = wave_max_nonneg(mx);
        {
            float best = 3.0e38f, bs = 0.f;
#define EXP_TRY(FAC) do { const float s_ = mx * ((FAC) / 7.f), inv_ = s_ > 0.f ? 1.f / s_ : 0.f; float er_ = 0.f; \
                _Pragma("unroll") for (int k = 0; k < 4; ++k) _Pragma("unroll") for (int c = 0; c < 4; ++c) { const float v_ = R.v[bb][k][c]; const float d_ = v_ - s_ * fminf(fmaxf(rintf(v_ * inv_), -7.f), 7.f); er_ += d_ * d_; } \
                er_ = wave_sum_u(er_); if (er_ < best) { best = er_; bs = s_; } } while (0)
            EXP_TRY(1.f); EXP_TRY(0.86f); EXP_TRY(0.74f); EXP_TRY(0.63f);
#undef EXP_TRY
            const float inv = bs > 0.f ? 1.f / bs : 0.f;
            unsigned w01[2] = {0u, 0u};
#pragma unroll
            for (int k = 0; k < 4; ++k)
#pragma unroll
                for (int c = 0; c < 4; ++c) { const int q = (int)fminf(fmaxf(rintf(R.v[bb][k][c] * inv), -7.f), 7.f); w01[k >> 1] |= (unsigned)((isu || (c & 1)) ? (q & 15) : (q + 8)) << (4 * (4 * (k & 1) + c)); }
            if (F.lane == 0) (isu ? SUI_ : SVI_)[e] = bs;
            typedef unsigned v2u_ __attribute__((ext_vector_type(2)));
            v2u_ wv; wv.x = w01[0]; wv.y = w01[1];
            *(GAS v2u_*)((isu ? WSP(unsigned char, WS_EXPU) : WSP(unsigned char, WS_EXPV)) + (size_t)e * 512 + 8 * F.lane) = wv;
        } }
}
#ifndef P0_PARTS
#define P0_PARTS 15
#endif
DI void p0_phase(const Frame& F, int parts = 15) {
    const float* const w_in_ = inp(I_WIN); bf16* const Win_t_ = WSP(bf16, WS_WIN); const float* const w_out_ = inp(I_WOUT); bf16* const Wout_t_ = WSP(bf16, WS_WOUT); const float* const expert_v_ = inp(I_EV); const float* const expert_u_ = inp(I_EU);
    LAS float* scr = (LAS float*)(F.lds + F.wave * 16384);
    const int gw = F.vcu * NWAVES + F.wave, NGW = F.G * NWAVES;
    if (parts & 1) for (int it = F.vcu; it < 96; it += F.G) p0_mod_block(F, it);
    constexpr int I_WIN = 16 * 112, I_WOUT = 16 * 32, NITEMS = I_WIN + I_WOUT;
    if (parts & 2) for (int it = gw; it < NITEMS; it += NGW) {
        int r = it;
        if (r < I_WIN) { p0_transpose_item(w_in_, D, NPROJ, NIN, Win_t_, scr, r, F.lane); continue; } r -= I_WIN;
        p0_transpose_item(w_out_, D, D, D, Wout_t_, scr, r, F.lane);
    }
    __syncthreads();
    if (parts & 8) for (int it = F.vcu; it < 256; it += F.G) p0_weff_item(F, it);
}

template <bool DOGATES>
DI void norm_phase(const Frame& F, const float* src, const float* g, int shift_off, int scale_off) {
    const float* const w_in_ = inp(I_WIN); float* const mod_ = WSP(float, WS_MOD); bf16* const XN_ = WSP(bf16, WS_XN); float* const GATES_ = WSP(float, WS_GATES); const float* const b_igate_ = inp(I_BIG); const float* const b_fgate_ = inp(I_BFG);
    LAS float* W8 = (LAS float*)F.lds;
    if (DOGATES) {
        for (int i = 0; i < 16; ++i) { const int idx = F.tid + 512 * i; W8[idx] = w_in_[(size_t)(idx & 1023) * NIN + NPROJ + (idx >> 10)]; }
        __syncthreads();
    }
    const int gw = F.vcu * NWAVES + F.wave, NGW = F.G * NWAVES;
    for (int ch = gw; ch < T / 16; ch += NGW) {
        const int r0 = ch * 16, b = r0 / SEQ;
        f32x4 A[4], Bv[4];
#pragma unroll
        for (int j = 0; j < 4; ++j) { const int col = 4 * F.lane + 256 * j; const f32x4 gg = *(const f32x4*)(g + col), sc = *(const f32x4*)(mod_ + b * NMOD + scale_off + col);
            A[j] = gg * (sc + 1.0f); Bv[j] = *(const f32x4*)(mod_ + b * NMOD + shift_off + col); }
        f32x4 nx[4];
        { const GAS f32x4* xr0 = (const GAS f32x4*)(src + (size_t)r0 * D) + F.lane;
#pragma unroll
          for (int j = 0; j < 4; ++j) nx[j] = __builtin_nontemporal_load(xr0 + 64 * j); }
        for (int rr = 0; rr < 16; ++rr) {
            const int row = r0 + rr;
            f32x4 v[4]; float s = 0.f;
#pragma unroll
            for (int j = 0; j < 4; ++j) { v[j] = nx[j]; s += (v[j].x * v[j].x + v[j].y * v[j].y) + (v[j].z * v[j].z + v[j].w * v[j].w); }
            if (rr + 1 < 16) { const GAS f32x4* xr = (const GAS f32x4*)(src + (size_t)(row + 1) * D) + F.lane;
#pragma unroll
                for (int j = 0; j < 4; ++j) nx[j] = __builtin_nontemporal_load(xr + 64 * j); }
            const float rstd = 1.f / sqrtf(wave_sum_u(s) * (1.f / D) + EPS);
#pragma unroll
            for (int j = 0; j < 4; ++j) v[j] = v[j] * rstd * A[j] + Bv[j];
            GAS unsigned long long* o8 = (GAS unsigned long long*)(XN_ + (size_t)row * D) + F.lane;
#pragma unroll
            for (int j = 0; j < 4; ++j) o8[64 * j] = (unsigned long long)pk2(v[j].x, v[j].y) | ((unsigned long long)pk2(v[j].z, v[j].w) << 32);
            if (DOGATES) {
                float res = 0.f;
#pragma unroll
                for (int hh = 0; hh < 8; ++hh) { float p = 0.f;
#pragma unroll
                    for (int j = 0; j < 4; ++j) { const f32x4 w = *(const LAS f32x4*)(W8 + hh * 1024 + 4 * F.lane + 256 * j); p += (v[j].x * w.x + v[j].y * w.y) + (v[j].z * w.z + v[j].w * w.w); }
                    p = wave_sum_u(p); if (F.lane == hh) res = p; }
                if (F.lane < 8) GATES_[(size_t)row * 8 + F.lane] = res + (F.lane < 4 ? b_igate_[F.lane] : b_fgate_[F.lane - 4]);
            }
        }
    }
}

DI void sb_unit(const Frame& F, int b, int h, int qb) {
    bf16* const PROJ_ = WSP(bf16, WS_PROJ); const float* const g_q_sb_ = inp(I_GQ); const float* const g_k_sb_ = inp(I_GK); bf16* const MIX_ = WSP(bf16, WS_MIX); const float* const g_out_sb_ = inp(I_GOSB);
    const int lane = F.lane, w = F.wave, r = lane & 31, hi = lane >> 5;
    const int i16 = lane & 15, qq = i16 >> 2, pp = i16 & 3, blk = (lane >> 4) & 1;
    LAS unsigned char* Wb = F.lds + w * 16384;
    const size_t rowbase = (size_t)b * SEQ; const int q0 = qb * 256, qw0 = q0 + 32 * w, tq = qw0 + r;
    const bf16* P = PROJ_;
    const bf16* kpiece[4]; const bf16* vpiece[4];
#pragma unroll
    for (int i = 0; i < 4; ++i) { const int krow_ = 8 * i + (lane >> 3), kch = (lane & 7) ^ ((krow_ >> 1) & 7); kpiece[i] = P + (rowbase + krow_) * NPROJ + C_KSB + h * 64 + 8 * kch;
        const int vkey = 16 * (i & 1) + (lane >> 2); vpiece[i] = P + (rowbase + vkey) * NPROJ + C_VSB + h * 64 + 32 * (i >> 1) + 8 * (lane & 3); }
#define SB_DMA(T_, BUF_) do { _Pragma("unroll") for (int i_ = 0; i_ < 4; ++i_) { \
        __builtin_amdgcn_global_load_lds((const unsigned*)(kpiece[i_] + (size_t)(32 * (T_)) * NPROJ), (LAS unsigned*)(Wb + 8192 * (BUF_) + 1024 * i_), 16, 0, 0); \
        __builtin_amdgcn_global_load_lds((const unsigned*)(vpiece[i_] + (size_t)(32 * (T_)) * NPROJ), (LAS unsigned*)(Wb + 8192 * (BUF_) + 4096 + 1024 * i_), 16, 0, 0); } } while (0)
    const int tw = (qw0 + 30) >> 5;
    SB_DMA(tw, 0);
    bf16x8 qf[4];
    {
        const bf16* Qp = P + (rowbase + tq) * NPROJ + C_QSB + h * 64 + 8 * hi;
        v4u qraw[4]; float ss = 0.f;
#pragma unroll
        for (int kk = 0; kk < 4; ++kk) { qraw[kk] = *(const GAS v4u*)(Qp + 16 * kk);
#pragma unroll
            for (int e = 0; e < 4; ++e) { const float a = bflo(qraw[kk][e]), c = bfhi(qraw[kk][e]); ss += a * a + c * c; } }
        ss = swap_add(ss);
        const float rq = __builtin_amdgcn_rsqf(ss * (1.f / 64.f) + EPS) * (0.125f * LOG2E);
#pragma unroll
        for (int kk = 0; kk < 4; ++kk) { const int d0 = 16 * kk + 8 * hi;
            const f32x4 g0 = *(const f32x4*)(g_q_sb_ + d0) * *(const f32x4*)(g_k_sb_ + d0), g1 = *(const f32x4*)(g_q_sb_ + d0 + 4) * *(const f32x4*)(g_k_sb_ + d0 + 4);
            v4u o; o.x = cvtpk(bflo(qraw[kk].x) * rq * g0.x, bfhi(qraw[kk].x) * rq * g0.y); o.y = cvtpk(bflo(qraw[kk].y) * rq * g0.z, bfhi(qraw[kk].y) * rq * g0.w);
            o.z = cvtpk(bflo(qraw[kk].z) * rq * g1.x, bfhi(qraw[kk].z) * rq * g1.y); o.w = cvtpk(bflo(qraw[kk].w) * rq * g1.z, bfhi(qraw[kk].w) * rq * g1.w);
            qf[kk] = __builtin_bit_cast(bf16x8, o); }
    }
    f16x8 U0, U1, E0;
#pragma unroll
    for (int j = 0; j < 8; ++j) { U0[j] = (krow(0, hi, j) > r) ? (_Float16)1.0f : (_Float16)0.0f; U1[j] = (krow(1, hi, j) > r) ? (_Float16)1.0f : (_Float16)0.0f;
        E0[j] = (j == 0 && hi == 0) ? (_Float16)1.0f : (_Float16)0.0f; }
    f32x16 o0, o1;
#pragma unroll
    for (int i = 0; i < 16; ++i) { o0[i] = 0.f; o1[i] = 0.f; }
    float R = 0.f;
    const int kfoff = r * 128, kfsw = (r >> 1) & 7;
    for (int t = tw; t >= 0; --t) {
        const int buf = (tw - t) & 1;
        LAS unsigned char* Kb = Wb + 8192 * buf; LAS unsigned char* Vb = Kb + 4096;
        asm volatile("s_waitcnt vmcnt(0)" ::: "memory");
        if (t > 0) SB_DMA(t - 1, buf ^ 1);
        bf16x8 kf[4]; float ssk = 0.f;
#pragma unroll
        for (int kk = 0; kk < 4; ++kk) { const v4u kv = *(const LAS v4u*)(Kb + kfoff + (((2 * kk + hi) ^ kfsw) * 16)); kf[kk] = __builtin_bit_cast(bf16x8, kv);
            ssk = dot2bf(kv.x, kv.x, ssk); ssk = dot2bf(kv.y, kv.y, ssk); ssk = dot2bf(kv.z, kv.z, ssk); ssk = dot2bf(kv.w, kv.w, ssk); }
        ssk = swap_add(ssk);
        const float rk = __builtin_amdgcn_rsqf(ssk * (1.f / 64.f) + EPS);
        f16x8 RKA;
#pragma unroll
        for (int e = 0; e < 8; ++e) RKA[e] = (_Float16)0.0f;
        RKA[0] = (hi == 0) ? (_Float16)rk : (_Float16)0.0f;
        f32x16 s, rkd;
#pragma unroll
        for (int i = 0; i < 16; ++i) { s[i] = 0.f; rkd[i] = 0.f; }
        rkd = MFMA_F16(RKA, E0, rkd);
#pragma unroll
        for (int kk = 0; kk < 4; ++kk) s = MFMA_BF16(kf[kk], qf[kk], s);
        float tsum = 0.f; unsigned lp[8];
        if (32 * t + 31 < qw0) {
#pragma unroll
            for (int i = 0; i < 16; i += 2) {
                const float z0_ = s[i] * rkd[i], z1_ = s[i + 1] * rkd[i + 1];
                const float a0_ = -lg2(1.f + ex2(z0_)), a1_ = -lg2(1.f + ex2(z1_));
                tsum += a0_ + a1_;
                s[i] = z0_ + a0_; s[i + 1] = z1_ + a1_;
                lp[i >> 1] = pkh(a0_, a1_); }
        } else {
            const int kq = tq - 32 * t;
#pragma unroll
            for (int i = 0; i < 16; i += 2) {
                const float z0_ = s[i] * rkd[i], z1_ = s[i + 1] * rkd[i + 1];
                float a0_ = -lg2(1.f + ex2(z0_)), a1_ = -lg2(1.f + ex2(z1_));
                const bool ma0 = crow(i, hi) >= kq, ma1 = crow(i + 1, hi) >= kq;
                a0_ = ma0 ? 0.f : a0_; a1_ = ma1 ? 0.f : a1_;
                tsum += a0_ + a1_;
                s[i] = ma0 ? -INFINITY : z0_ + a0_; s[i + 1] = ma1 ? -INFINITY : z1_ + a1_;
                lp[i >> 1] = pkh(a0_, a1_); }
        }
        f32x16 c;
#pragma unroll
        for (int i = 0; i < 16; ++i) c[i] = R;
        c = MFMA_F16(U0, __builtin_bit_cast(f16x8, (v4u){lp[0], lp[1], lp[2], lp[3]}), c); c = MFMA_F16(U1, __builtin_bit_cast(f16x8, (v4u){lp[4], lp[5], lp[6], lp[7]}), c);
#pragma unroll
        for (int i = 0; i < 16; ++i) s[i] = ex2(s[i] + c[i]);
        const bf16x8 W0 = packbf(s, 0), W1 = packbf(s, 1);
        LAS unsigned char* vb_ = Vb + (4 * hi + qq) * 64 + 32 * blk + 8 * pp;
        o0 = MFMA_BF16(cat8(trrd(vb_), trrd(vb_ + 8 * 64)), W0, o0); o0 = MFMA_BF16(cat8(trrd(vb_ + 16 * 64), trrd(vb_ + 24 * 64)), W1, o0);
        o1 = MFMA_BF16(cat8(trrd(vb_ + 2048), trrd(vb_ + 2048 + 8 * 64)), W0, o1); o1 = MFMA_BF16(cat8(trrd(vb_ + 2048 + 16 * 64), trrd(vb_ + 2048 + 24 * 64)), W1, o1);
        R += swap_add(tsum);
        if (__all(R < -150.f)) break;
    }
    asm volatile("s_waitcnt vmcnt(0)" ::: "memory");
#undef SB_DMA
    {
        float ss = 0.f;
#pragma unroll
        for (int i = 0; i < 16; ++i) ss += o0[i] * o0[i] + o1[i] * o1[i];
        ss = swap_add(ss);
        const float ro = __builtin_amdgcn_rsqf(ss * (1.f / 64.f) + EPS);
        bf16* Op = MIX_ + (rowbase + tq) * D + h * 64;
        const float* go = g_out_sb_ + h * 64;
#pragma unroll
        for (int g = 0; g < 4; ++g) { const int d0 = 8 * g + 4 * hi; const f32x4 ga = *(const f32x4*)(go + d0), gb = *(const f32x4*)(go + 32 + d0);
            u32x2 wa, wb; wa.x = cvtpk(o0[4 * g] * ro * ga.x, o0[4 * g + 1] * ro * ga.y); wa.y = cvtpk(o0[4 * g + 2] * ro * ga.z, o0[4 * g + 3] * ro * ga.w);
            wb.x = cvtpk(o1[4 * g] * ro * gb.x, o1[4 * g + 1] * ro * gb.y); wb.y = cvtpk(o1[4 * g + 2] * ro * gb.z, o1[4 * g + 3] * ro * gb.w);
            *(GAS u32x2*)(Op + d0) = wa; *(GAS u32x2*)(Op + 32 + d0) = wb; }
    }
    __syncthreads();
}

DI void conv_silu8(const v4u (&xr)[4], const float (&cw)[4][8], float scale, float (&y)[8]) {
#pragma unroll
    for (int e = 0; e < 8; ++e) y[e] = 0.f;
#pragma unroll
    for (int j = 0; j < 4; ++j) {
        y[0] += cw[j][0] * bflo(xr[j].x); y[1] += cw[j][1] * bfhi(xr[j].x); y[2] += cw[j][2] * bflo(xr[j].y); y[3] += cw[j][3] * bfhi(xr[j].y);
        y[4] += cw[j][4] * bflo(xr[j].z); y[5] += cw[j][5] * bfhi(xr[j].z); y[6] += cw[j][6] * bflo(xr[j].w); y[7] += cw[j][7] * bfhi(xr[j].w); }
#pragma unroll
    for (int e = 0; e < 8; ++e) y[e] = scale * y[e] * __builtin_amdgcn_rcpf(1.f + fexp(-y[e]));
}
DI float log_sigmoid(float x) { return fminf(x, 0.f) - 0.6931471805599453f * lg2(1.f + fexp(-fabsf(x))); }
DI float wave_scan_incl(float a, int lane) {
#pragma unroll
    for (int o = 1; o < 64; o <<= 1) { const float t = __shfl_up(a, o); if (lane >= o) a += t; }
    return a;
}

constexpr int LDS_CW = 65536;
DI void stage_conv_w(const Frame& F) {
    const float* const conv_w_ = inp(I_CONVW); LAS float* cwl = (LAS float*)(F.lds + LDS_CW);
    for (int i = F.tid; i < 4096; i += NTHR) cwl[i] = conv_w_[i];
    __syncthreads();
}
DI void load_cw8(const Frame& F, int colbase, float (&cw)[4][8]) {
    const LAS float* cwl = (const LAS float*)(F.lds + LDS_CW);
#pragma unroll
    for (int j = 0; j < 4; ++j) { const f32x4 a = *(const LAS f32x4*)(cwl + j * 1024 + colbase), b = *(const LAS f32x4*)(cwl + j * 1024 + colbase + 4);
        cw[j][0] = a.x; cw[j][1] = a.y; cw[j][2] = a.z; cw[j][3] = a.w; cw[j][4] = b.x; cw[j][5] = b.y; cw[j][6] = b.z; cw[j][7] = b.w; }
}
struct MlLocalRegs { v4u kraw[2][4]; v4u vraw[2]; float gi, gf; };
DI void ml_local_load(const Frame& F, int chain, int c, MlLocalRegs& R) {
    bf16* const PROJ_ = WSP(bf16, WS_PROJ); float* const GATES_ = WSP(float, WS_GATES);
    const int tid = F.tid, lane = F.lane;
    const int b = chain >> 2, hh = chain & 3; const size_t rowbase = (size_t)b * SEQ; const int t0 = c * 64;
    const bf16* P = PROJ_;
    const int kc = tid & 15, kr0 = tid >> 4;
    const bf16* Kg = P + rowbase * NPROJ + C_KML + hh * 128 + kc * 8;
#pragma unroll
    for (int i = 0; i < 2; ++i)
#pragma unroll
        for (int j = 0; j < 4; ++j) { const int tt = t0 + kr0 + 32 * i - 3 + j; R.kraw[i][j] = (tt >= 0) ? *(const GAS v4u*)(Kg + (size_t)tt * NPROJ) : (v4u){0u, 0u, 0u, 0u}; }
#pragma unroll
    for (int i = 0; i < 2; ++i) R.vraw[i] = *(const GAS v4u*)(P + (rowbase + t0 + kr0 + 32 * i) * NPROJ + C_VML + hh * 128 + kc * 8);
    const float* Gg = GATES_ + (rowbase + t0 + lane) * 8;
    R.gi = Gg[hh]; R.gf = Gg[4 + hh];
}
DI void ml_local_unit(const Frame& F, int chain, int c, const MlLocalRegs& RG) {
    bf16* const CST_ = WSP(bf16, WS_CST); float* const NST_ = WSP(float, WS_NST); float* const SCL_ = WSP(float, WS_SCL);
    LAS unsigned char* L = F.lds;
    LAS float* Lws = (LAS float*)(L + 32768);
    const int tid = F.tid, lane = F.lane, w = F.wave, r = lane & 31, hi = lane >> 5;
    const int i16 = lane & 15, qq = i16 >> 2, pp = i16 & 3, blk = (lane >> 4) & 1;
    const int hh = chain & 3;
    const int kbk = w & 3, vb0 = 2 * (w >> 2);
    const int kc = tid & 15, kr0 = tid >> 4;
    v4u kraw[2][4], vraw[2];
#pragma unroll
    for (int i = 0; i < 2; ++i) { vraw[i] = RG.vraw[i];
#pragma unroll
        for (int j = 0; j < 4; ++j) kraw[i][j] = RG.kraw[i][j]; }
    const float gi = RG.gi, gf = RG.gf;
    const float a = wave_scan_incl(log_sigmoid(gf), lane);
    const float a_end = __shfl(a, 63);
    const float lw = a_end - a + gi;
    const float m_loc = wave_max(lw);
    const float ws = fexp(lw - m_loc);
    if (w == 0) Lws[lane] = ws;
    {
        float cw[4][8]; load_cw8(F, 512 + hh * 128 + kc * 8, cw);
#pragma unroll
        for (int i = 0; i < 2; ++i) { float y[8]; conv_silu8(kraw[i], cw, 0.08838834764831845f, y);
            v4u o; o.x = cvtpk(y[0], y[1]); o.y = cvtpk(y[2], y[3]); o.z = cvtpk(y[4], y[5]); o.w = cvtpk(y[6], y[7]);
            *(LAS v4u*)(L + (kc >> 2) * 4096 + (kr0 + 32 * i) * 64 + (kc & 3) * 16) = o; }
#pragma unroll
        for (int i = 0; i < 2; ++i) { const int row = kr0 + 32 * i; const float wsr = __shfl(ws, row);
            v4u o; o.x = cvtpk(bflo(vraw[i].x) * wsr, bfhi(vraw[i].x) * wsr); o.y = cvtpk(bflo(vraw[i].y) * wsr, bfhi(vraw[i].y) * wsr); o.z = cvtpk(bflo(vraw[i].z) * wsr, bfhi(vraw[i].z) * wsr); o.w = cvtpk(bflo(vraw[i].w) * wsr, bfhi(vraw[i].w) * wsr);
            *(LAS v4u*)(L + 16384 + (kc >> 2) * 4096 + row * 64 + (kc & 3) * 16) = o; }
    }
    __syncthreads();
    f32x16 acc0, acc1;
#pragma unroll
    for (int i = 0; i < 16; ++i) { acc0[i] = 0.f; acc1[i] = 0.f; }
#pragma unroll
    for (int kk = 0; kk < 4; ++kk) { const int rows = 16 * kk + 8 * hi + qq;
        LAS unsigned char* ka = L + kbk * 4096 + rows * 64 + 32 * blk + 8 * pp; LAS unsigned char* va = L + 16384 + vb0 * 4096 + rows * 64 + 32 * blk + 8 * pp;
        const bf16x8 A = cat8(trrd(ka), trrd(ka + 4 * 64));
        acc0 = MFMA_BF16(A, cat8(trrd(va), trrd(va + 4 * 64)), acc0); acc1 = MFMA_BF16(A, cat8(trrd(va + 4096), trrd(va + 4096 + 4 * 64)), acc1); }
    {
        bf16* Cp = CST_ + ((size_t)(chain * 64 + c) * 128 + vb0 * 32 + r) * 128 + kbk * 32 + 4 * hi;
#pragma unroll
        for (int g = 0; g < 4; ++g) { u32x2 o; o.x = cvtpk(acc0[4 * g], acc0[4 * g + 1]); o.y = cvtpk(acc0[4 * g + 2], acc0[4 * g + 3]); *(GAS u32x2*)(Cp + 8 * g) = o;
            u32x2 o1; o1.x = cvtpk(acc1[4 * g], acc1[4 * g + 1]); o1.y = cvtpk(acc1[4 * g + 2], acc1[4 * g + 3]); *(GAS u32x2*)(Cp + 32 * 128 + 8 * g) = o1; }
    }
    {
        const int k = 16 * w + (lane & 15), sq = lane >> 4; float part = 0.f;
        const LAS unsigned short* kcol = (const LAS unsigned short*)(L + (k >> 5) * 4096 + (k & 31) * 2);
#pragma unroll
        for (int e = 0; e < 16; ++e) part += Lws[16 * sq + e] * __uint_as_float((unsigned)kcol[(16 * sq + e) * 32] << 16);
        part += __shfl_xor(part, 16); part += __shfl_xor(part, 32);
        if (lane < 16) NST_[(size_t)(chain * 64 + c) * 128 + k] = part;
        if (tid == 0) { SCL_[(chain * 64 + c) * 2] = a_end; SCL_[(chain * 64 + c) * 2 + 1] = m_loc; }
    }
    __syncthreads();
}
DI void ml_scan_phase(const Frame& F) {
    bf16* const CST_ = WSP(bf16, WS_CST); float* const NST_ = WSP(float, WS_NST); float* const SCL_ = WSP(float, WS_SCL); float* const MST_ = WSP(float, WS_MST);
    for (int gt = F.vcu * NTHR + F.tid; gt < 32 * 4096; gt += F.G * NTHR) {
        const int chain = gt >> 12, rem = gt & 4095;
        const float ae_l = SCL_[(chain * 64 + F.lane) * 2], ml_l = SCL_[(chain * 64 + F.lane) * 2 + 1];
        u32x2* Cp = (u32x2*)(CST_ + (size_t)chain * 64 * 16384 + (size_t)rem * 4);
        f32x4* Np = (f32x4*)(NST_ + (size_t)chain * 64 * 128 + rem * 4);
        const bool do_n = rem < 32;
        float c0 = 0.f, c1 = 0.f, c2 = 0.f, c3 = 0.f; f32x4 nn = {0.f, 0.f, 0.f, 0.f}; float m = 0.f;
        u32x2 dr[8]; f32x4 nr[8];
#pragma unroll
        for (int i = 0; i < 8; ++i) { dr[i] = Cp[(size_t)i * 4096]; if (do_n) nr[i] = Np[i * 32]; }
        for (int c0_ = 0; c0_ < 64; c0_ += 8) {
#pragma unroll
            for (int i = 0; i < 8; ++i) { const int c = c0_ + i;
                if (c < 63) {
                    const u32x2 dcur = dr[i]; const f32x4 dn = nr[i];
                    if (c + 8 < 63) { dr[i] = Cp[(size_t)(c + 8) * 4096]; if (do_n) nr[i] = Np[(c + 8) * 32]; }
                    const float ae = __builtin_bit_cast(float, __builtin_amdgcn_readlane(__builtin_bit_cast(int, ae_l), c)), ml = __builtin_bit_cast(float, __builtin_amdgcn_readlane(__builtin_bit_cast(int, ml_l), c));
                    const float mn = fmaxf(ae + m, ml), d1 = fexp(ae + m - mn), d2 = fexp(ml - mn);
                    c0 = d1 * c0 + d2 * bflo(dcur.x); c1 = d1 * c1 + d2 * bfhi(dcur.x); c2 = d1 * c2 + d2 * bflo(dcur.y); c3 = d1 * c3 + d2 * bfhi(dcur.y);
                    u32x2 o; o.x = cvtpk(c0, c1); o.y = cvtpk(c2, c3); Cp[(size_t)c * 4096] = o;
                    if (do_n) { nn = nn * d1 + dn * d2; Np[c * 32] = nn; }
                    if (rem == 0) MST_[chain * 64 + c] = mn;
                    m = mn; } }
        }
    }
}
DI void ml_out_unit(const Frame& F, int chain, int c) {
    bf16* const PROJ_ = WSP(bf16, WS_PROJ); float* const GATES_ = WSP(float, WS_GATES); float* const MST_ = WSP(float, WS_MST); bf16* const CST_ = WSP(bf16, WS_CST); float* const NST_ = WSP(float, WS_NST); bf16* const MIX_ = WSP(bf16, WS_MIX); const float* const g_out_ml_ = inp(I_GOML);
    LAS unsigned char* L = F.lds;
    LAS float* Lbs = (LAS float*)(L + 49152); LAS float* Lav = (LAS float*)(L + 49408); LAS float* Lex = (LAS float*)(L + 49664);
    const int tid = F.tid, lane = F.lane, w = F.wave, r = lane & 31, hi = lane >> 5;
    const int i16 = lane & 15, qq = i16 >> 2, pp = i16 & 3, blk = (lane >> 4) & 1;
    const int b = chain >> 2, hh = chain & 3; const size_t rowbase = (size_t)b * SEQ; const int t0 = c * 64;
    const int tb = w >> 2, vb = w & 3;
    const bf16* P = PROJ_;
    {
        const int kc = tid & 15, kr0 = tid >> 4;
#pragma unroll
        for (int which = 0; which < 2; ++which) {
            const int colbase = (which ? 512 : 0) + hh * 128 + kc * 8;
            float cw[4][8]; load_cw8(F, colbase, cw);
            const bf16* Xg = P + rowbase * NPROJ + C_QML + colbase;
#pragma unroll
            for (int i = 0; i < 2; ++i) { const int row = kr0 + 32 * i; v4u xr[4];
#pragma unroll
                for (int j = 0; j < 4; ++j) { const int tt = t0 + row - 3 + j; xr[j] = (tt >= 0) ? *(const GAS v4u*)(Xg + (size_t)tt * NPROJ) : (v4u){0u, 0u, 0u, 0u}; }
                float y[8]; conv_silu8(xr, cw, which ? 0.08838834764831845f : 1.0f, y);
                v4u o; o.x = cvtpk(y[0], y[1]); o.y = cvtpk(y[2], y[3]); o.z = cvtpk(y[4], y[5]); o.w = cvtpk(y[6], y[7]);
                *(LAS v4u*)(L + which * 16384 + row * 256 + ((kc ^ (row & 15)) * 16)) = o; }
        }
#pragma unroll
        for (int i = 0; i < 2; ++i) { const int row = kr0 + 32 * i;
            const v4u v = *(const GAS v4u*)(P + (rowbase + t0 + row) * NPROJ + C_VML + hh * 128 + kc * 8);
            *(LAS v4u*)(L + 32768 + (kc >> 2) * 4096 + row * 64 + (kc & 3) * 16) = v; }
        if (w == 0) { const float* Gg = GATES_ + (rowbase + t0 + lane) * 8; const float a = wave_scan_incl(log_sigmoid(Gg[4 + hh]), lane); Lav[lane] = a; Lbs[lane] = Gg[hh] - a; }
    }
    const float mprev = (c > 0) ? MST_[chain * 64 + c - 1] : 0.f;
    bf16x8 cf[8], nf[8];
    if (c > 0) {
        const bf16* Cp = CST_ + ((size_t)(chain * 64 + c - 1) * 128 + vb * 32 + r) * 128 + 8 * hi;
        const float* Np = NST_ + (size_t)(chain * 64 + c - 1) * 128 + 8 * hi;
        const bool nrow = (r == 0) || (r == 4);
#pragma unroll
        for (int kk = 0; kk < 8; ++kk) { cf[kk] = *(const GAS bf16x8*)(Cp + 16 * kk);
            const f32x4 n0 = *(const f32x4*)(Np + 16 * kk), n1 = *(const f32x4*)(Np + 16 * kk + 4);
            v4u o; o.x = cvtpk(n0.x, n0.y); o.y = cvtpk(n0.z, n0.w); o.z = cvtpk(n1.x, n1.y); o.w = cvtpk(n1.z, n1.w);
            if (!nrow) o = (v4u){0u, 0u, 0u, 0u};
            nf[kk] = __builtin_bit_cast(bf16x8, o); }
    }
    __syncthreads();
    bf16x8 qf[8];
    f32x16 s0, s1;
#pragma unroll
    for (int i = 0; i < 16; ++i) { s0[i] = 0.f; s1[i] = 0.f; }
#pragma unroll
    for (int kk = 0; kk < 8; ++kk) { const int ch = 2 * kk + hi; const int rq_ = 32 * tb + r;
        qf[kk] = *(const LAS bf16x8*)(L + rq_ * 256 + ((ch ^ (rq_ & 15)) * 16));
        const bf16x8 a0 = *(const LAS bf16x8*)(L + 16384 + r * 256 + ((ch ^ (r & 15)) * 16));
        const bf16x8 a1 = *(const LAS bf16x8*)(L + 16384 + (32 + r) * 256 + ((ch ^ ((32 + r) & 15)) * 16));
        s0 = MFMA_BF16(a0, qf[kk], s0); s1 = MFMA_BF16(a1, qf[kk], s1); }
    const int tl = 32 * tb + r; const float a_t = Lav[tl];
    f32x16 d0, d1; float mrow = -INFINITY;
#pragma unroll
    for (int g = 0; g < 4; ++g) { const f32x4 b0 = *(const LAS f32x4*)(Lbs + 8 * g + 4 * hi), b1 = *(const LAS f32x4*)(Lbs + 32 + 8 * g + 4 * hi);
#pragma unroll
        for (int e = 0; e < 4; ++e) { const int sl = 8 * g + 4 * hi + e;
            d0[4 * g + e] = (sl <= tl) ? a_t + b0[e] : -INFINITY; d1[4 * g + e] = (32 + sl <= tl) ? a_t + b1[e] : -INFINITY;
            mrow = fmaxf(mrow, fmaxf(d0[4 * g + e], d1[4 * g + e])); } }
    mrow = fmaxf(swap_max(mrow), a_t + mprev);
    float psum = 0.f;
#pragma unroll
    for (int i = 0; i < 16; ++i) { s0[i] *= fexp(d0[i] - mrow); s1[i] *= fexp(d1[i] - mrow); psum += s0[i] + s1[i]; }
    const float w_inter = fexp(a_t + mprev - mrow);
    float den = swap_add(psum);
    const bf16x8 P00 = packbf(s0, 0), P01 = packbf(s0, 1), P10 = packbf(s1, 0), P11 = packbf(s1, 1);
    f32x16 num;
#pragma unroll
    for (int i = 0; i < 16; ++i) num[i] = 0.f;
    {
        LAS unsigned char* vb_ = L + 32768 + vb * 4096 + (4 * hi + qq) * 64 + 32 * blk + 8 * pp;
        num = MFMA_BF16(cat8(trrd(vb_), trrd(vb_ + 8 * 64)), P00, num); num = MFMA_BF16(cat8(trrd(vb_ + 16 * 64), trrd(vb_ + 24 * 64)), P01, num);
        num = MFMA_BF16(cat8(trrd(vb_ + 32 * 64), trrd(vb_ + 40 * 64)), P10, num); num = MFMA_BF16(cat8(trrd(vb_ + 48 * 64), trrd(vb_ + 56 * 64)), P11, num);
    }
    if (c > 0) {
        f32x16 it, dn;
#pragma unroll
        for (int i = 0; i < 16; ++i) { it[i] = 0.f; dn[i] = 0.f; }
#pragma unroll
        for (int kk = 0; kk < 8; ++kk) { it = MFMA_BF16(cf[kk], qf[kk], it); dn = MFMA_BF16(nf[kk], qf[kk], dn); }
#pragma unroll
        for (int i = 0; i < 16; ++i) num[i] += w_inter * it[i];
        den += w_inter * dn[0];
    }
    const float inv = __builtin_amdgcn_rcpf(fmaxf(fabsf(den), fexp(-mrow)));
    float ss = 0.f;
#pragma unroll
    for (int i = 0; i < 16; ++i) { num[i] *= inv; ss += num[i] * num[i]; }
    ss = swap_add(ss);
    if (lane < 32) Lex[(tb * 4 + vb) * 32 + r] = ss;
    __syncthreads();
    const float tot = (Lex[(tb * 4 + 0) * 32 + r] + Lex[(tb * 4 + 1) * 32 + r]) + (Lex[(tb * 4 + 2) * 32 + r] + Lex[(tb * 4 + 3) * 32 + r]);
    const float rstd = 1.f / sqrtf(tot * (1.f / 128.f) + EPS);
    {
        const size_t trow = rowbase + t0 + tl;
        const bf16* Og = P + trow * NPROJ + C_OML + hh * 128 + vb * 32 + 4 * hi;
        bf16* Mp = MIX_ + trow * D + 512 + hh * 128 + vb * 32 + 4 * hi;
        const float* go = g_out_ml_ + hh * 128 + vb * 32 + 4 * hi;
#pragma unroll
        for (int g = 0; g < 4; ++g) { const u32x2 og = *(const GAS u32x2*)(Og + 8 * g); const f32x4 gg = *(const f32x4*)(go + 8 * g);
            const float o0 = bflo(og.x), o1 = bfhi(og.x), o2 = bflo(og.y), o3 = bfhi(og.y);
            u32x2 o; o.x = cvtpk(num[4 * g] * rstd * gg.x * __builtin_amdgcn_rcpf(1.f + fexp(-o0)), num[4 * g + 1] * rstd * gg.y * __builtin_amdgcn_rcpf(1.f + fexp(-o1)));
            o.y = cvtpk(num[4 * g + 2] * rstd * gg.z * __builtin_amdgcn_rcpf(1.f + fexp(-o2)), num[4 * g + 3] * rstd * gg.w * __builtin_amdgcn_rcpf(1.f + fexp(-o3)));
            *(GAS u32x2*)(Mp + 8 * g) = o; }
    }
    __syncthreads();
}

#define TK_CE(A, B) do { const float hi_ = fmaxf((A), (B)), lo_ = fminf((A), (B)); (A) = hi_; (B) = lo_; } while (0)
DI void tk_sort16(float (&a)[16]) {
#pragma unroll
    for (int k = 2; k <= 16; k <<= 1)
#pragma unroll
        for (int j = k >> 1; j > 0; j >>= 1)
#pragma unroll
            for (int i = 0; i < 16; ++i) { const int l = i ^ j; if (l > i) { if ((i & k) == 0) TK_CE(a[i], a[l]); else TK_CE(a[l], a[i]); } }
}
DI void tk_merge16(float (&a)[16], const float (&b)[16]) {
#pragma unroll
    for (int i = 0; i < 16; ++i) a[i] = fmaxf(a[i], b[15 - i]);
#pragma unroll
    for (int j = 8; j > 0; j >>= 1)
#pragma unroll
        for (int i = 0; i < 16; ++i) { const int l = i ^ j; if (l > i) TK_CE(a[i], a[l]); }
}
DI void tk_stage2(const LAS float* la, const LAS float* lb, int* IDX_, float* GATEW_, size_t o) {
        float a[16], bb[16], cnd[64];
#pragma unroll
        for (int q = 0; q < 16; ++q) { a[q] = la[q]; bb[q] = lb[q]; }
        int cnt = 0;
#pragma unroll
        for (int i = 0; i < 16; ++i)
#pragma unroll
            for (int j = 0; j < 16; ++j) if ((i + 1) * (j + 1) <= 16) { cnd[cnt] = __uint_as_float((__float_as_uint(a[i] + bb[j]) & ~0xFFu) | (unsigned)(i * 16 + j)); ++cnt; }
#pragma unroll
        for (int q = 50; q < 64; ++q) cnd[q] = -INFINITY;
        float top[16];
#pragma unroll
        for (int c = 0; c < 4; ++c) { float ch[16];
#pragma unroll
            for (int q = 0; q < 16; ++q) ch[q] = cnd[16 * c + q];
            tk_sort16(ch);
            if (c == 0) {
#pragma unroll
                for (int q = 0; q < 16; ++q) top[q] = ch[q];
            } else tk_merge16(top, ch); }
        float sv[16]; int ei[16]; float mx = -INFINITY;
#pragma unroll
        for (int q = 0; q < 16; ++q) { const unsigned code = __float_as_uint(top[q]) & 0xFFu; const float va = la[code >> 4], vb = lb[code & 15u];
            ei[q] = (int)((__float_as_uint(va) & 0x7Fu) * 128u + (__float_as_uint(vb) & 0x7Fu)); sv[q] = va + vb; mx = fmaxf(mx, sv[q]); }
        float sum = 0.f;
#pragma unroll
        for (int q = 0; q < 16; ++q) { sv[q] = fexp(sv[q] - mx); sum += sv[q]; }
        const float inv = 1.f / sum;
#pragma unroll
        for (int q = 0; q < 16; q += 4) { *(GAS v4u*)(IDX_ + o + q) = (v4u){(unsigned)ei[q], (unsigned)ei[q + 1], (unsigned)ei[q + 2], (unsigned)ei[q + 3]};
            *(GAS f32x4*)(GATEW_ + o + q) = (f32x4){sv[q] * inv, sv[q + 1] * inv, sv[q + 2] * inv, sv[q + 3] * inv}; }
    }
struct EpiTopK {
    static constexpr bool PERM = false, AFTER_DRAIN = true;
    int* IDX; float* GATEW;
    DI void fused(f32x4 (&acc)[2][2][4][2], const pg8::Unit& u, int wr, int wc, int fr, int fq, LAS unsigned char* lds, int wid, int lane) const {
        LAS float* Tl = (LAS float*)lds;
        LAS float* Lh2 = (LAS float*)lds;
        LAS float* Ls = (LAS float*)(lds + 36864);
        const int tid = wid * 64 + lane, tl = tid & 127, p = (tid >> 7) & 1, half = tid >> 8;
#pragma unroll
        for (int ai = 0; ai < 2; ++ai) {
#pragma unroll
            for (int bj = 0; bj < 2; ++bj)
#pragma unroll
                for (int m = 0; m < 4; ++m)
#pragma unroll
                    for (int n = 0; n < 2; ++n) { LAS float* d = Tl + (wr * 64 + m * 16 + fr) * 257 + bj * 128 + wc * 32 + n * 16 + fq * 4; const f32x4 v = acc[ai][bj][m][n]; d[0] = v.x; d[1] = v.y; d[2] = v.z; d[3] = v.w; }
            __syncthreads();
            float run[16];
            {
                const LAS float* src = Tl + tl * 257 + p * 128 + half * 64;
#pragma unroll
                for (int c = 0; c < 4; ++c) { float ch[16];
#pragma unroll
                    for (int q = 0; q < 16; ++q) ch[q] = __uint_as_float((__float_as_uint(src[16 * c + q]) & ~0x7Fu) | (unsigned)(half * 64 + 16 * c + q));
                    tk_sort16(ch);
                    if (c == 0) {
#pragma unroll
                        for (int q = 0; q < 16; ++q) run[q] = ch[q];
                    } else tk_merge16(run, ch); }
            }
            __syncthreads();
#pragma unroll
            for (int q = 0; q < 16; ++q) Lh2[((tl * 2 + p) * 2 + half) * 17 + q] = run[q];
            __syncthreads();
            if (half == 0) { float oth[16];
#pragma unroll
                for (int q = 0; q < 16; ++q) oth[q] = Lh2[((tl * 2 + p) * 2 + 1) * 17 + q];
                tk_merge16(run, oth);
#pragma unroll
                for (int q = 0; q < 16; ++q) Ls[(tl * 2 + p) * 17 + q] = run[q]; }
            __syncthreads();
            if (tid < 128) tk_stage2(Ls + (tl * 2) * 17, Ls + (tl * 2) * 17 + 17, IDX, GATEW, (size_t)(u.pm * 256 + ai * 128 + tl) * 128 + u.pn * 16);
            __syncthreads();
        }
    }
};
struct OneUnit {
    pg8::Unit u;
    __device__ __forceinline__ bool next(int i, pg8::Unit& o) const { if (i) return false; o = u; return true; }
    __device__ __forceinline__ void a_ready(const pg8::Unit&) const {}
    __device__ __forceinline__ void done(const pg8::Unit&) const {}
};

DI float gelu_erf(float x) { return 0.5f * x * (1.f + erff(x * 0.7071067811865476f)); }
#define DPP_ADD(v, ctrl, rmask) ((v) + __builtin_bit_cast(float, __builtin_amdgcn_update_dpp(0, __builtin_bit_cast(int, (v)), (ctrl), (rmask), 0xF, false)))
#ifndef PEER_EBL
#define PEER_EBL 9
#endif
constexpr int PEER_EB_LOG = PEER_EBL;
#ifndef PEER_PROBE_MASK
#define PEER_PROBE_MASK 0xFFFF
#endif
typedef float f32x2v __attribute__((ext_vector_type(2)));
DI float gelu_cdf(float v) {
    const float av = fabsf(v), t = __builtin_amdgcn_rcpf(av * 0.2316418882f + 1.0f);
    float q = t * 0.5307027145f - 0.7265760135f; q = q * t + 0.7107068705f; q = q * t - 0.142248368f; q = q * t + 0.127414796f; q = q * t;
    const float m = v * (q * ex2(v * v * -0.72134752044f));
    return v < 0.f ? m : v - m;
}
#define DPP_ADDI(v, ctrl, rmask) ((v) + __builtin_amdgcn_update_dpp(0, (v), (ctrl), (rmask), 0xF, false))
DI void peer_phase(const Frame& F, bool scratch_dst) {
    bf16* const XN_ = WSP(bf16, WS_XN); int* const IDX_ = WSP(int, WS_IDX); float* const GATEW_ = WSP(float, WS_GATE); float* const mod_ = WSP(float, WS_MOD); float* const out_ = (float*)inp(I_OUT);
    const unsigned char* const EU4 = WSP(unsigned char, WS_EXPU); const unsigned char* const EV4 = WSP(unsigned char, WS_EXPV); const float* const SUI_ = WSP(float, WS_SUI); const float* const SVI_ = WSP(float, WS_SVI);
    const int gw = F.vcu * NWAVES + F.wave, NGW = F.G * NWAVES, lane = F.lane, g = lane >> 3, j = lane & 7;
    LAS unsigned char* wl = F.lds + F.wave * 17408;
    volatile LAS int* Le = (volatile LAS int*)(wl + g * 512); volatile LAS float* Lg = (volatile LAS float*)(wl + 4096 + g * 512); volatile LAS int* Lp = (volatile LAS int*)(wl + 8192 + g * 512);
    volatile LAS int* Lx = (volatile LAS int*)(wl + 12288 + g * 512); LAS int* Lh = (LAS int*)(wl + 16384 + g * 128);
    for (int grp = gw; grp < T / 8; grp += NGW) {
        const size_t t = (size_t)grp * 8 + g;
        int xh[16], xl[16]; float sxi;
#ifdef PEER_DUP_S
        auto qs_ = [&]() __attribute__((always_inline)) {
#endif
        {
            float mx = 0.f;
            const bf16* xrow = XN_ + t * D + 8 * j;
#pragma unroll
            for (int kq = 0; kq < 16; ++kq) { const v4u a = *(const GAS v4u*)(xrow + 64 * kq);
#pragma unroll
                for (int e = 0; e < 4; ++e) mx = fmaxf(mx, fmaxf(fabsf(bflo(a[e])), fabsf(bfhi(a[e])))); }
            mx = fmaxf(mx, __shfl_xor(mx, 1, 8)); mx = fmaxf(mx, __shfl_xor(mx, 2, 8)); mx = fmaxf(mx, __shfl_xor(mx, 4, 8));
            const float sx = mx > 0.f ? 119.f / mx : 0.f; sxi = mx > 0.f ? mx / 119.f : 0.f;
#pragma unroll
            for (int q = 0; q < 4; ++q)
#pragma unroll
                for (int kp = 0; kp < 2; ++kp) { const v4u a = *(const GAS v4u*)(xrow + 64 * (8 * kp + q)), b = *(const GAS v4u*)(xrow + 64 * (8 * kp + 4 + q));
#pragma unroll
                    for (int wh = 0; wh < 2; ++wh) {
                        const int t0 = (int)rintf(bflo(a[2 * wh]) * sx) + 8, t1 = (int)rintf(bfhi(a[2 * wh]) * sx) + 8, t2 = (int)rintf(bflo(a[2 * wh + 1]) * sx) + 8, t3 = (int)rintf(bfhi(a[2 * wh + 1]) * sx) + 8;
                        const int t4 = (int)rintf(bflo(b[2 * wh]) * sx) + 8, t5 = (int)rintf(bfhi(b[2 * wh]) * sx) + 8, t6 = (int)rintf(bflo(b[2 * wh + 1]) * sx) + 8, t7 = (int)rintf(bfhi(b[2 * wh + 1]) * sx) + 8;
                        const unsigned lo_ = (unsigned)(t0 & 15) | ((unsigned)(t1 & 15) << 4) | ((unsigned)(t2 & 15) << 8) | ((unsigned)(t3 & 15) << 12) | ((unsigned)(t4 & 15) << 16) | ((unsigned)(t5 & 15) << 20) | ((unsigned)(t6 & 15) << 24) | ((unsigned)(t7 & 15) << 28);
                        const unsigned hi_ = (unsigned)((t0 >> 4) & 15) | ((unsigned)((t1 >> 4) & 15) << 4) | ((unsigned)((t2 >> 4) & 15) << 8) | ((unsigned)((t3 >> 4) & 15) << 12) | ((unsigned)((t4 >> 4) & 15) << 16) | ((unsigned)((t5 >> 4) & 15) << 20) | ((unsigned)((t6 >> 4) & 15) << 24) | ((unsigned)((t7 >> 4) & 15) << 28);
                        xl[4 * q + kp + 2 * wh] = (int)(lo_ ^ 0x88888888u); xh[4 * q + kp + 2 * wh] = (int)hi_; } }
        }
        {
            int ide[16]; float gte[16]; int rk[16];
#pragma unroll
            for (int m = 0; m < 16; ++m) { ide[m] = IDX_[t * 128 + j + 8 * m]; gte[m] = GATEW_[t * 128 + j + 8 * m]; }
#pragma unroll
            for (int m = 0; m < 4; ++m) Lh[j + 8 * m] = 0;
#pragma unroll
            for (int m = 0; m < 16; ++m) rk[m] = __hip_atomic_fetch_add(Lh + (ide[m] >> PEER_EB_LOG), 1, __ATOMIC_RELAXED, __HIP_MEMORY_SCOPE_WORKGROUP);
            {
                const int h0 = ((volatile LAS int*)Lh)[4 * j], h1 = ((volatile LAS int*)Lh)[4 * j + 1], h2 = ((volatile LAS int*)Lh)[4 * j + 2], h3 = ((volatile LAS int*)Lh)[4 * j + 3];
                const int tot = (h0 + h1) + (h2 + h3); int inc = tot;
#pragma unroll
                for (int o = 1; o < 8; o <<= 1) { const int tt = __shfl_up(inc, o, 8); if (j >= o) inc += tt; }
                const int ex = inc - tot;
                ((volatile LAS int*)Lh)[4 * j] = ex; ((volatile LAS int*)Lh)[4 * j + 1] = ex + h0; ((volatile LAS int*)Lh)[4 * j + 2] = ex + h0 + h1; ((volatile LAS int*)Lh)[4 * j + 3] = ex + h0 + h1 + h2;
            }
#pragma unroll
            for (int m = 0; m < 16; ++m) { const int pos = ((volatile LAS int*)Lh)[ide[m] >> PEER_EB_LOG] + rk[m]; Le[pos] = ide[m]; Lg[pos] = gte[m] * SVI_[ide[m]]; Lp[pos] = __builtin_bit_cast(int, SUI_[ide[m]] * sxi); }
        }
#ifdef PEER_DUP_S
        }; qs_(); __builtin_amdgcn_sched_barrier(0); qs_();
#endif
        v4u R0[4], R1[4], R2[4], R3[4];
#define PEER_LOADU(RR, S0) do { const size_t ro_ = (size_t)(Le[(S0)] & (scratch_dst ? PEER_PROBE_MASK : 0xFFFF)) * 512 + 16 * j; _Pragma("unroll") for (int q = 0; q < 4; ++q) RR[q] = *(const GAS v4u*)(EU4 + ro_ + 128 * q); } while (0)
#define PEER_DOTU(RR, EOUT) do { int h0_ = 0, h1_ = 0, l0_ = 0, l1_ = 0; \
            _Pragma("unroll") for (int q = 0; q < 4; q += 2) _Pragma("unroll") for (int w_ = 0; w_ < 4; ++w_) { \
                h0_ = __builtin_amdgcn_sdot8((int)RR[q][w_], xh[4 * q + w_], h0_, false); l0_ = __builtin_amdgcn_sdot8((int)RR[q][w_], xl[4 * q + w_], l0_, false); \
                h1_ = __builtin_amdgcn_sdot8((int)RR[q + 1][w_], xh[4 * q + 4 + w_], h1_, false); l1_ = __builtin_amdgcn_sdot8((int)RR[q + 1][w_], xl[4 * q + 4 + w_], l1_, false); } \
            int e_ = ((h0_ + h1_) << 4) + (l0_ + l1_); e_ = DPP_ADDI(e_, 0xB1, 0xF); e_ = DPP_ADDI(e_, 0x4E, 0xF); e_ = DPP_ADDI(e_, 0x141, 0xF); EOUT = e_; } while (0)
#define PEER_SWEEPU(BODY0, BODY1, BODY2, BODY3) do { \
            PEER_LOADU(R0, 0); PEER_LOADU(R1, 1); PEER_LOADU(R2, 2); PEER_LOADU(R3, 3); \
            for (int s = 0; s < 128; s += 4) { \
                BODY0; if (s + 4 < 128) PEER_LOADU(R0, s + 4); \
                BODY1; if (s + 4 < 128) PEER_LOADU(R1, s + 5); \
                BODY2; if (s + 4 < 128) PEER_LOADU(R2, s + 6); \
                BODY3; if (s + 4 < 128) PEER_LOADU(R3, s + 7); } } while (0)
#define PEER_FIN(RR, SS) do { int e1_; PEER_DOTU(RR, e1_); Lx[(SS)] = e1_; } while (0)
        PEER_SWEEPU(PEER_FIN(R0, s), PEER_FIN(R1, s + 1), PEER_FIN(R2, s + 2), PEER_FIN(R3, s + 3));
#ifdef PEER_DUP_U
        PEER_SWEEPU(PEER_FIN(R0, s), PEER_FIN(R1, s + 1), PEER_FIN(R2, s + 2), PEER_FIN(R3, s + 3));
#endif
#undef PEER_FIN
        float yscale; int csum8;
        {
            float cf_[16]; float cmax = 0.f;
#pragma unroll
            for (int i = 0; i < 16; ++i) { const int ix = 16 * j + i; cf_[i] = Lg[ix] * gelu_cdf((float)Lx[ix] * __builtin_bit_cast(float, Lp[ix])); cmax = fmaxf(cmax, fabsf(cf_[i])); }
            cmax = fmaxf(cmax, __shfl_xor(cmax, 1, 8)); cmax = fmaxf(cmax, __shfl_xor(cmax, 2, 8)); cmax = fmaxf(cmax, __shfl_xor(cmax, 4, 8));
            const float cqs = cmax > 0.f ? 127.f / cmax : 0.f; yscale = cmax > 0.f ? cmax / 127.f : 0.f;
            int pk_[4]; int cs_ = 0;
#pragma unroll
            for (int m = 0; m < 4; ++m) { const int q0 = (int)rintf(cf_[4 * m] * cqs), q1 = (int)rintf(cf_[4 * m + 1] * cqs), q2 = (int)rintf(cf_[4 * m + 2] * cqs), q3 = (int)rintf(cf_[4 * m + 3] * cqs);
                cs_ += (q0 + q1) + (q2 + q3);
                pk_[m] = (int)((unsigned)(q0 & 0xff) | ((unsigned)(q1 & 0xff) << 8) | ((unsigned)(q2 & 0xff) << 16) | ((unsigned)q3 << 24)); }
            cs_ += __shfl_xor(cs_, 1, 8); cs_ += __shfl_xor(cs_, 2, 8); cs_ += __shfl_xor(cs_, 4, 8); csum8 = 8 * cs_;
#pragma unroll
            for (int m = 0; m < 4; ++m) Lp[4 * j + m] = pk_[m];
        }
#ifndef PEER_DUP_V
#define PEER_DUP_V 1
#endif
#pragma unroll
        for (int HH = 0; HH < 2 * PEER_DUP_V; ++HH) { const int H = HH & 1;
            int ya[32], yl[32];
#pragma unroll
            for (int i = 0; i < 32; ++i) { ya[i] = 0; yl[i] = 0; }
            v4u RV[8][2];
#define PEER_ROFFV(S0) ((size_t)(Le[(S0)] & (scratch_dst ? PEER_PROBE_MASK : 0xFFFF)) * 512 + 256 * H + 16 * j)
#pragma unroll
            for (int r = 0; r < 8; ++r) { const size_t ro_ = PEER_ROFFV(r); RV[r][0] = *(const GAS v4u*)(EV4 + ro_); RV[r][1] = *(const GAS v4u*)(EV4 + ro_ + 128); }
            for (int bt = 0; bt < 16; ++bt) {
                const int c0_ = Lp[2 * bt], c1_ = Lp[2 * bt + 1];
                size_t ron[8];
#pragma unroll
                for (int r = 0; r < 8; ++r) ron[r] = (bt + 1 < 16) ? PEER_ROFFV(8 * bt + 8 + r) : 0;
#pragma unroll
                for (int q = 0; q < 2; ++q) {
#pragma unroll
                    for (int hb = 0; hb < 2; ++hb) { const int cq_ = hb ? c1_ : c0_;
#pragma unroll
                        for (int w_ = 0; w_ < 4; ++w_) { const unsigned a0 = RV[4 * hb][q][w_], a1 = RV[4 * hb + 1][q][w_], a2 = RV[4 * hb + 2][q][w_], a3 = RV[4 * hb + 3][q][w_];
                            const unsigned p0 = __builtin_amdgcn_perm(a1, a0, 0x05010400u), p1 = __builtin_amdgcn_perm(a1, a0, 0x07030602u), p2 = __builtin_amdgcn_perm(a3, a2, 0x05010400u), p3 = __builtin_amdgcn_perm(a3, a2, 0x07030602u);
                            unsigned Tb[4]; Tb[0] = __builtin_amdgcn_perm(p2, p0, 0x05040100u); Tb[1] = __builtin_amdgcn_perm(p2, p0, 0x07060302u); Tb[2] = __builtin_amdgcn_perm(p3, p1, 0x05040100u); Tb[3] = __builtin_amdgcn_perm(p3, p1, 0x07060302u);
#pragma unroll
                            for (int b_ = 0; b_ < 4; ++b_) { ya[16 * q + 4 * w_ + b_] = __builtin_amdgcn_sdot4((int)Tb[b_], cq_, ya[16 * q + 4 * w_ + b_], false);
                                yl[16 * q + 4 * w_ + b_] = __builtin_amdgcn_sdot4((int)(Tb[b_] & 0x0F0F0F0Fu), cq_, yl[16 * q + 4 * w_ + b_], false); } } }
                    if (bt + 1 < 16) {
#pragma unroll
                        for (int r = 0; r < 8; ++r) RV[r][q] = *(const GAS v4u*)(EV4 + ron[r] + 128 * q); }
                }
            }
#undef PEER_ROFFV
            const int b = (int)(t / SEQ);
            const float* g2 = mod_ + b * NMOD + 5120 + 128 * H + 8 * j;
            const float* ip = out_ + t * D + 128 * H + 8 * j; float* op = ((scratch_dst || HH + 2 < 2 * PEER_DUP_V) ? WSP(float, WS_SCORES) : out_) + t * D + 128 * H + 8 * j;
#pragma unroll
            for (int q = 0; q < 2; ++q)
#pragma unroll
                for (int w_ = 0; w_ < 4; ++w_)
#pragma unroll
                    for (int nh = 0; nh < 2; ++nh) { const int co = 256 * (2 * (w_ & 1) + nh) + 64 * q + 4 * (w_ >> 1); const int yb = 16 * q + 4 * w_ + 2 * nh;
                        const f32x4 x1 = *(const GAS f32x4*)(ip + co); const f32x4 gg = *(const f32x4*)(g2 + co) * yscale;
                        f32x4 o; o.x = x1.x + gg.x * (float)(yl[yb] - csum8); o.y = x1.y + gg.y * (float)((ya[yb] - yl[yb]) >> 4); o.z = x1.z + gg.z * (float)(yl[yb + 1] - csum8); o.w = x1.w + gg.w * (float)((ya[yb + 1] - yl[yb + 1]) >> 4);
                        *(GAS f32x4*)(op + co) = o; }
        }
#undef PEER_LOADU
#undef PEER_DOTU
#undef PEER_SWEEPU
    }
}

DI void ph_inproj(const Frame& F) {
    pg8::Gemm g{WSP(bf16, WS_XN), WSP(bf16, WS_WIN), T, NPROJ, D}; pg8::StaticOrder S; S.init(T, NPROJ, F.G, (int)blockIdx.x);
    pg8::EpiBf16<0> E{WSP(bf16, WS_PROJ), NPROJ, nullptr, 0, 0, 1.f};
    pg8::gemm_phase<pg8::EpiBf16<0>, pg8::StaticOrder, PG8_ALIGN, PG8_SP2>(F.lds, g, S, E);
}
DI void ph_mix(const Frame& F, bool probe_first) {
    stage_conv_w(F);
    {
        int u = F.vcu;
        MlLocalRegs ra;
        if (u < 2048) ml_local_load(F, u >> 6, u & 63, ra);
        const int gwv = F.vcu * NWAVES + F.wave, NGWv = F.G * NWAVES;
        int eb = 2 * gwv;
        while (u < 2048) {
            const int un = u + F.G;
            MlLocalRegs rb;
            if (un < 2048) ml_local_load(F, un >> 6, un & 63, rb);
            ExpRows2 er; const bool ew = eb < 32768;
            if (ew) exp_load2(F, eb, er);
            ml_local_unit(F, u >> 6, u & 63, ra);
            if (ew) exp_conv2(F, eb, er);
            eb += 2 * NGWv;
            ra = rb; u = un;
        }
        for (; eb < 32768; eb += 2 * NGWv) { ExpRows2 er; exp_load2(F, eb, er); exp_conv2(F, eb, er); }
    }
    (void)probe_first;
}
DI void ph_scan_attn(const Frame& F) {
    ml_scan_phase(F);
    __syncthreads();
    for (int u = F.vcu; u < 1024; u += F.G) { const int qb = 15 - (u >> 6), bh = u & 63; sb_unit(F, bh >> 3, bh & 7, qb); }
}
DI void ph_mlout(const Frame& F) { stage_conv_w(F); for (int u = F.vcu; u < 2048; u += F.G) ml_out_unit(F, u >> 6, u & 63); }
#ifndef P5_ALIGN
#define P5_ALIGN PG8_ALIGN
#endif
DI void ph_outproj(const Frame& F) {
    pg8::Gemm g{WSP(bf16, WS_MIX), WSP(bf16, WS_WOUT), T, D, D}; pg8::StaticOrder S; S.init(T, D, F.G, (int)blockIdx.x);
    pg8::EpiResGate E{inp(I_X), (float*)inp(I_OUT), WSP(float, WS_MOD) + 2048, NMOD, SEQ, D};
    pg8::gemm_phase<pg8::EpiResGate, pg8::StaticOrder, P5_ALIGN, PG8_SP2>(F.lds, g, S, E);
}
DI void ph_scores(const Frame& F) {
    pg8::Gemm g{WSP(bf16, WS_XN), WSP(bf16, WS_WEFF), T, NSC, D}; pg8::StaticOrder S; S.init(T, NSC, F.G, (int)blockIdx.x);
    EpiTopK E{WSP(int, WS_IDX), WSP(float, WS_GATE)};
    pg8::Unit un;
    for (int i = 0; S.next(i, un); ++i) { OneUnit S1{un}; pg8::gemm_phase<EpiTopK, OneUnit, false, PG8_SP2>(F.lds, g, S1, E); }
}
constexpr int N_PHASES = 11;
struct Args { const float* in[19]; float* out; unsigned char* ws; int ph_lo, ph_hi; };
__global__ void __launch_bounds__(NTHR, 2) hybrid_fwd(Args args) {
    extern __shared__ __attribute__((aligned(16))) unsigned char lds_raw[];
    Frame F;
    F.lds = (LAS unsigned char*)lds_raw;
    F.MISC = (volatile LAS unsigned*)(F.lds + LDSCTL_OFF + 320);
    F.tid = threadIdx.x; F.lane = F.tid & 63; F.wave = __builtin_amdgcn_readfirstlane(F.tid >> 6);
    F.G = gridDim.x; { const int bx = blockIdx.x; F.vcu = (F.G % 8 == 0) ? (bx % 8) * (F.G / 8) + bx / 8 : bx; }
    F.ws = args.ws;
    F.ctl = (gu32*)(F.ws + WS_CTL);
    for (int u = F.tid; u < (LDS_BYTES - LDSCTL_OFF) / 4; u += NTHR) ((LAS unsigned*)(F.lds + LDSCTL_OFF))[u] = 0u;
    __syncthreads();
    const int lo = args.ph_lo, hi = args.ph_hi;
    const bool one_launch = (hi - lo) > 1;
    XcdBarrier bar; bar.bar = (unsigned*)(F.ctl + CW_BAR); bar.x = 0; bar.st = nullptr;
    if (one_launch) bar = xcd_barrier_post((unsigned*)(F.ctl + CW_BAR), F.MISC + 8);
#ifndef PHMASK
#define PHMASK 0x7ff
#endif
#define IN(k) (((PHMASK >> (k)) & 1) && lo <= (k) && (k) < hi)
#define SEAM(k) do { if (IN(k) && IN((k) + 1)) xcd_barrier(bar); } while (0)
#ifndef REPMASK
#define REPMASK 0
#endif

#define RUN(k, ...) do { if (IN(k)) { if ((REPMASK >> (k)) & 1) { { const bool first = true; (void)first; __VA_ARGS__; } xcd_barrier(bar); } { const bool first = false; (void)first; __VA_ARGS__; } } } while (0)
    RUN(0, p0_phase(F, first ? P0_PARTS : 15)); SEAM(0);
    RUN(1, norm_phase<true>(F, inp(I_X), inp(I_GN1), 0, 1024)); SEAM(1);
    RUN(2, ph_inproj(F)); SEAM(2);
    RUN(3, ph_mix(F, first)); SEAM(3);
    RUN(10, ph_scan_attn(F)); if (IN(10) && IN(4)) xcd_barrier(bar);
    RUN(4, ph_mlout(F)); SEAM(4);
    RUN(5, ph_outproj(F)); SEAM(5);
    RUN(6, norm_phase<false>(F, inp(I_OUT), inp(I_GN2), 3072, 4096)); SEAM(6);
    RUN(7, ph_scores(F)); if (IN(7) && IN(9)) xcd_barrier(bar);
    RUN(9, peer_phase(F, first));
#undef RUN
#undef IN
#undef SEAM
}

#ifndef MK_PER_PHASE
#define MK_PER_PHASE 0
#endif
extern "C" void kernel_launch(void* const* d_in, const int* in_sizes, int n_in, void* d_out, int out_size, void* d_ws, size_t ws_size, hipStream_t stream) {
    static int grid = 0;
    if (grid == 0) {
        if (n_in != 19 || in_sizes[0] != T * D || out_size != T * D || ws_size < WS_END) { fprintf(stderr, "kernel_launch: unexpected shapes (n_in %d, in0 %d, out %d, ws %zu)\n", n_in, n_in > 0 ? in_sizes[0] : -1, out_size, ws_size); grid = -1; return; }
        int dev = 0, cus = 0, per_cu = 0;
        if (hipGetDevice(&dev) != hipSuccess || hipDeviceGetAttribute(&cus, hipDeviceAttributeMultiprocessorCount, dev) != hipSuccess) { grid = -1; return; }
        if (hipFuncSetAttribute((const void*)hybrid_fwd, hipFuncAttributeMaxDynamicSharedMemorySize, LDS_BYTES) != hipSuccess) { fprintf(stderr, "kernel_launch: hipFuncSetAttribute failed\n"); grid = -1; return; }
        if (hipOccupancyMaxActiveBlocksPerMultiprocessor(&per_cu, (const void*)hybrid_fwd, NTHR, LDS_BYTES) != hipSuccess || per_cu < 1) fprintf(stderr, "kernel_launch: occupancy query says %d\n", per_cu);
        (void)hipGetLastError();
        grid = cus;
    }
    if (grid < 0) return;
    if (hipMemsetAsync((char*)d_ws + WS_CTL, 0, CTL_ZERO_BYTES, stream) != hipSuccess) { fprintf(stderr, "kernel_launch: memset failed\n"); return; }
    Args a{};
    for (int i = 0; i < 19; ++i) a.in[i] = (const float*)d_in[i];
    a.out = (float*)d_out; a.ws = (unsigned char*)d_ws;
#if MK_PER_PHASE
    { const int order[N_PHASES] = {0, 1, 2, 3, 10, 4, 5, 6, 7, 8, 9}; for (int i = 0; i < N_PHASES; ++i) { a.ph_lo = order[i]; a.ph_hi = order[i] + 1; hipLaunchKernelGGL(hybrid_fwd, dim3(grid), dim3(NTHR), LDS_BYTES, stream, a); } }
#else
    a.ph_lo = 0; a.ph_hi = N_PHASES;
    hipLaunchKernelGGL(hybrid_fwd, dim3(grid), dim3(NTHR), LDS_BYTES, stream, a);
#endif
    const hipError_t le = hipPeekAtLastError();
    if (le != hipSuccess) fprintf(stderr, "kernel_launch: launch failed: %s\n", hipGetErrorName(le));
}
```

```cpp
#include <cmath>
#include <hip/hip_runtime.h>
#include <cstdio>
#include <cstdint>
namespace pg8 {
#define PG8_LAS __attribute__((address_space(3)))
typedef unsigned short bf16_t;
typedef short bf16x8 __attribute__((ext_vector_type(8)));
typedef float f32x4 __attribute__((ext_vector_type(4)));
typedef unsigned u32x4 __attribute__((ext_vector_type(4)));
constexpr int BM = 256, BK = 64, HALF = 128, HTB = HALF * BK * 2  , STAGE_BYTES = 8 * HTB, NXCD = 8,
#ifndef PG8_WGM
#define PG8_WGM 4
#endif
WGM = PG8_WGM;

__host__ __device__ __forceinline__ int lds_byte(int r, int c) { const int st = (r >> 4) * 2 + (c >> 5), rr = r & 15, cc = c & 31, ob = rr * 64 + cc * 2; return st * 1024 + (ob ^ (((ob >> 9) & 1) << 5)); }
__host__ __device__ __forceinline__ void stage_rc(int b, int& R, int& C) { const int st = b / 1024, sb = b % 1024, swz = sb ^ (((sb >> 9) & 1) << 5); R = (st >> 1) * 16 + swz / 64; C = (st & 1) * 32 + (swz % 64) / 2; }
__host__ __device__ __forceinline__ int perm32(int rho) { const int n = rho >> 4, i = rho & 15; return 8 * (i >> 2) + 4 * n + (i & 3); }

struct Unit { int pm, pn; };
struct Gemm { const bf16_t* A; const bf16_t* Bt; int M, N, K; };

struct StaticOrder {
    int nM, nN, nwg, G, c;
    __host__ __device__ void init(int M, int N, int G_, int c_) { nM = M / BM; nN = N / BM; nwg = nM * nN; G = G_; c = c_; }
    __host__ __device__ bool next(int i, Unit& u) const {
        const long L = (long)i * G + c; if (L >= nwg) return false;
        int wgid = (int)L; { const int q = nwg / NXCD, r = nwg % NXCD, xcd = wgid % NXCD, off = wgid / NXCD; wgid = (xcd < r ? xcd * (q + 1) : r * (q + 1) + (xcd - r) * q) + off; }
        const int nig = WGM * nN, gid = wgid / nig, fm = gid * WGM, gsz = (nM - fm) < WGM ? (nM - fm) : WGM;
        u.pm = fm + ((wgid % nig) % gsz); u.pn = (wgid % nig) / gsz; return true;
    }
    __device__ __forceinline__ void a_ready(const Unit&) const {}
    __device__ __forceinline__ void done(const Unit&) const {}
};

__device__ __forceinline__ unsigned cvt_pk_bf16(float lo, float hi) { unsigned r; asm volatile("v_cvt_pk_bf16_f32 %0, %1, %2" : "=v"(r) : "v"(lo), "v"(hi)); return r; }
typedef float f32x2 __attribute__((ext_vector_type(2)));
__device__ __forceinline__ f32x2 gelu_pk(f32x2 v) {
    const f32x2 av = __builtin_elementwise_abs(v), d = av * 0.2316418882f + 1.0f;
    f32x2 t; t.x = __builtin_amdgcn_rcpf(d.x); t.y = __builtin_amdgcn_rcpf(d.y);
    f32x2 q = t * 0.5307027145f + (-0.7265760135f); q = q * t + 0.7107068705f; q = q * t + (-0.142248368f); q = q * t + 0.127414796f; q = q * t;
    const f32x2 s = (v * v) * (-0.72134752044f);
    f32x2 e; e.x = __builtin_amdgcn_exp2f(s.x); e.y = __builtin_amdgcn_exp2f(s.y);
    const f32x2 m = v * (q * e), r = v - m;
    f32x2 o; o.x = v.x < 0.f ? m.x : r.x; o.y = v.y < 0.f ? m.y : r.y; return o;
}

template <int ACT  > struct EpiBf16 {
    static constexpr bool PERM = true, AFTER_DRAIN = false; static_assert(ACT == 0 || ACT == 1, "EpiBf16: ACT is 0 (none) or 1 (gelu_pk)");
    bf16_t* O; int ldc; const float* bias; int split_cols; size_t split_stride; float scale0;
    __device__ __forceinline__ void operator()(const f32x4 (&acc)[2][2][4][2], const Unit& u, int wr, int wc, int fr, int fq) const {
        const int row0 = u.pm * BM + wr * 64 + fr; int colt = u.pn * BM; bf16_t* base = O;
        float sc = 1.f; if (split_cols) { const int t = colt / split_cols; base += (size_t)t * split_stride; colt -= t * split_cols; if (t == 0) sc = scale0; }
        const int col0 = colt + wc * 32 + 8 * fq, bcol0 = u.pn * BM + wc * 32 + 8 * fq;
        f32x4 bv[2][2];
#pragma unroll
        for (int bj = 0; bj < 2; ++bj)
#pragma unroll
            for (int n = 0; n < 2; ++n) bv[bj][n] = bias ? *(const f32x4*)(bias + bcol0 + bj * HALF + 4 * n) : (f32x4){0.f, 0.f, 0.f, 0.f};
#pragma unroll
        for (int ai = 0; ai < 2; ++ai)
#pragma unroll
            for (int m = 0; m < 4; ++m) { bf16_t* rowp = base + (size_t)(row0 + ai * HALF + m * 16) * ldc + col0;
#pragma unroll
                for (int bj = 0; bj < 2; ++bj) { f32x4 v0 = acc[ai][bj][m][0] + bv[bj][0], v1 = acc[ai][bj][m][1] + bv[bj][1];
                    if (ACT == 1) { f32x2 a = gelu_pk((f32x2){v0[0], v0[1]}), b = gelu_pk((f32x2){v0[2], v0[3]}), c = gelu_pk((f32x2){v1[0], v1[1]}), d = gelu_pk((f32x2){v1[2], v1[3]});
                        v0 = (f32x4){a.x, a.y, b.x, b.y}; v1 = (f32x4){c.x, c.y, d.x, d.y}; }
                    v0 = v0 * sc; v1 = v1 * sc; u32x4 w; w.x = cvt_pk_bf16(v0[0], v0[1]); w.y = cvt_pk_bf16(v0[2], v0[3]); w.z = cvt_pk_bf16(v1[0], v1[1]); w.w = cvt_pk_bf16(v1[2], v1[3]);
                    *(u32x4*)(rowp + bj * HALF) = w; } }
    }
};
template <class Epi, class Sched, bool ALIGN_EPI = false, bool SP2 = false>
__device__ __forceinline__ void gemm_phase(PG8_LAS unsigned char* lds, const Gemm g, const Sched& S, const Epi& E) {
    const int tid = threadIdx.x, wid = __builtin_amdgcn_readfirstlane(tid >> 6), lane = tid & 63, wr = wid >> 2, wc = wid & 3, fr = lane & 15, fq = lane >> 4;
    const int K = g.K, nt = K / BK;
    unsigned voffA[2], voffB[2];
#pragma unroll
    for (int i = 0; i < 2; ++i) { int R, C; stage_rc(tid * 16 + i * 8192, R, C); const int Rb = Epi::PERM ? ((R & ~31) + perm32(R & 31)) : R;
        voffA[i] = (unsigned)(R * K + C) * 2u; voffB[i] = (unsigned)(Rb * K + C) * 2u; }
    const size_t kstep = (size_t)(BK * 2);
    const size_t hstep = (size_t)HALF * K * 2;
    const size_t tstep = 2 * hstep;
    const unsigned ldsw = (unsigned)wid * 1024u;
    const int aoff = lds_byte(wr * 64 + fr, fq * 8), boff = lds_byte(wc * 32 + fr, fq * 8);
#define PG8_SA(b, h) (((b) * 2 + (h)) * HTB)
#define PG8_SB(b, h) ((4 + (b) * 2 + (h)) * HTB)
#define PG8_STAGE(bufoff, gbase, voff) do { _Pragma("unroll") for (int _i = 0; _i < 2; ++_i) \
        __builtin_amdgcn_global_load_lds((const unsigned*)((const char*)(gbase) + (voff)[_i]), (PG8_LAS unsigned*)(lds + (bufoff) + ldsw + _i * 8192), 16, 0, 0); } while (0)
#define PG8_LDA(dst, b, h) do { _Pragma("unroll") for (int m = 0; m < 4; ++m) _Pragma("unroll") for (int k = 0; k < 2; ++k) dst[m][k] = *(const PG8_LAS bf16x8*)(lds + PG8_SA(b, h) + aoff + m * 2048 + k * 1024); } while (0)
#define PG8_LDB(dst, b, h) do { _Pragma("unroll") for (int n = 0; n < 2; ++n) _Pragma("unroll") for (int k = 0; k < 2; ++k) dst[n][k] = *(const PG8_LAS bf16x8*)(lds + PG8_SB(b, h) + boff + n * 2048 + k * 1024); } while (0)
#define PG8_MMA(ai, bj, At, Bt) do { __builtin_amdgcn_s_setprio(1); _Pragma("unroll") for (int m = 0; m < 4; ++m) _Pragma("unroll") for (int n = 0; n < 2; ++n) _Pragma("unroll") for (int k = 0; k < 2; ++k) \
        acc[ai][bj][m][n] = __builtin_amdgcn_mfma_f32_16x16x32_bf16(Bt[n][k], At[m][k], acc[ai][bj][m][n], 0, 0, 0); __builtin_amdgcn_s_setprio(0); } while (0)
#define PG8_WAIT_V(n) asm volatile("s_waitcnt vmcnt(" #n ")" ::: "memory")
#define PG8_WAIT_L(n) asm volatile("s_waitcnt lgkmcnt(" #n ")" ::: "memory")
#define PG8_BAR __builtin_amdgcn_s_barrier()
#define PG8_SCHED __builtin_amdgcn_sched_barrier(0)
    Unit cur, nxt; int ui = 0;
    if (!S.next(0, cur)) return;
    f32x4 acc[2][2][4][2];
#pragma unroll
    for (int a = 0; a < 2; ++a)
#pragma unroll
        for (int b = 0; b < 2; ++b)
#pragma unroll
            for (int m = 0; m < 4; ++m)
#pragma unroll
                for (int n = 0; n < 2; ++n) acc[a][b][m][n] = (f32x4){0.f, 0.f, 0.f, 0.f};
    bf16x8 At[4][2], B0[2][2], B1[2][2];
    const char* cA = (const char*)g.A + (size_t)cur.pm * tstep; const char* cB = (const char*)g.Bt + (size_t)cur.pn * tstep;
    S.a_ready(cur);
    if constexpr (SP2) {
        PG8_STAGE(PG8_SB(0, 0), cB, voffB); PG8_STAGE(PG8_SB(0, 1), cB + hstep, voffB); PG8_STAGE(PG8_SA(0, 0), cA, voffA); PG8_STAGE(PG8_SA(0, 1), cA + hstep, voffA);
        if (wr == 1) PG8_BAR;
        PG8_WAIT_V(2); PG8_BAR;
        PG8_STAGE(PG8_SB(1, 0), cB + kstep, voffB); PG8_STAGE(PG8_SA(1, 0), cA + kstep, voffA); PG8_STAGE(PG8_SB(1, 1), cB + hstep + kstep, voffB);
        PG8_WAIT_V(6); PG8_BAR;
    } else {
        PG8_STAGE(PG8_SB(0, 0), cB, voffB); PG8_STAGE(PG8_SA(0, 0), cA, voffA); PG8_STAGE(PG8_SB(0, 1), cB + hstep, voffB); PG8_STAGE(PG8_SA(0, 1), cA + hstep, voffA);
        if (wr == 1) PG8_BAR;
        PG8_WAIT_V(4); PG8_BAR;
        PG8_STAGE(PG8_SB(1, 0), cB + kstep, voffB); PG8_STAGE(PG8_SA(1, 0), cA + kstep, voffA); PG8_STAGE(PG8_SB(1, 1), cB + hstep + kstep, voffB);
        PG8_WAIT_V(6); PG8_BAR;
    }
    for (;;) {
        const bool has_next = S.next(ui + 1, nxt);
        const char* nA = has_next ? (const char*)g.A + (size_t)nxt.pm * tstep : cA; const char* nB = has_next ? (const char*)g.Bt + (size_t)nxt.pn * tstep : cB;
        for (int t = 0; t < nt; t += 2) {
            const bool last = (t == nt - 2);
            const char* a1 = cA + (size_t)(t + 1) * kstep;
            const char* a2 = last ? nA : cA + (size_t)(t + 2) * kstep; const char* b2 = last ? nB : cB + (size_t)(t + 2) * kstep;
            const char* a3 = a2 + kstep; const char* b3 = b2 + kstep;
            if (last && has_next) S.a_ready(nxt);
            if constexpr (SP2) {
            PG8_LDB(B0, 0, 0); PG8_LDB(B1, 0, 1); PG8_SCHED; PG8_LDA(At, 0, 0); PG8_STAGE(PG8_SA(1, 1), a1 + hstep, voffA);
            PG8_WAIT_V(8); PG8_WAIT_L(0); PG8_BAR; PG8_MMA(0, 0, At, B0); PG8_MMA(0, 1, At, B1); PG8_BAR; PG8_SCHED;
            PG8_LDA(At, 0, 1); PG8_STAGE(PG8_SB(0, 0), b2, voffB); PG8_STAGE(PG8_SB(0, 1), b2 + hstep, voffB); PG8_STAGE(PG8_SA(0, 0), a2, voffA);
            PG8_WAIT_V(8); PG8_WAIT_L(0); PG8_BAR; PG8_MMA(1, 0, At, B0); PG8_MMA(1, 1, At, B1); PG8_BAR; PG8_SCHED;
            PG8_LDB(B0, 1, 0); PG8_LDB(B1, 1, 1); PG8_SCHED; PG8_LDA(At, 1, 0); PG8_STAGE(PG8_SA(0, 1), a2 + hstep, voffA);
            PG8_WAIT_V(8); PG8_WAIT_L(0); PG8_BAR; PG8_MMA(0, 0, At, B0); PG8_MMA(0, 1, At, B1); PG8_BAR; PG8_SCHED;
            PG8_LDA(At, 1, 1); PG8_STAGE(PG8_SB(1, 0), b3, voffB); PG8_STAGE(PG8_SB(1, 1), b3 + hstep, voffB); PG8_STAGE(PG8_SA(1, 0), a3, voffA);
            PG8_WAIT_V(8); PG8_WAIT_L(0); PG8_BAR; PG8_MMA(1, 0, At, B0); PG8_MMA(1, 1, At, B1); PG8_BAR; PG8_SCHED;
            } else {
            PG8_LDB(B0, 0, 0); PG8_SCHED; PG8_LDA(At, 0, 0); PG8_STAGE(PG8_SA(1, 1), a1 + hstep, voffA);
            PG8_WAIT_L(8); PG8_BAR; PG8_WAIT_L(0); PG8_MMA(0, 0, At, B0); PG8_BAR; PG8_SCHED;
            PG8_LDB(B1, 0, 1); PG8_STAGE(PG8_SB(0, 0), b2, voffB);
            PG8_BAR; PG8_WAIT_L(0); PG8_MMA(0, 1, At, B1); PG8_BAR;
            PG8_LDA(At, 0, 1); PG8_STAGE(PG8_SA(0, 0), a2, voffA);
            PG8_BAR; PG8_WAIT_L(0); PG8_MMA(1, 0, At, B0); PG8_BAR; PG8_SCHED;
            PG8_STAGE(PG8_SB(0, 1), b2 + hstep, voffB);
            PG8_WAIT_V(6); PG8_BAR; PG8_MMA(1, 1, At, B1); PG8_BAR;
            PG8_LDB(B0, 1, 0); PG8_SCHED; PG8_LDA(At, 1, 0); PG8_STAGE(PG8_SA(0, 1), a2 + hstep, voffA);
            PG8_WAIT_L(8); PG8_BAR; PG8_WAIT_L(0); PG8_MMA(0, 0, At, B0); PG8_BAR; PG8_SCHED;
            PG8_LDB(B1, 1, 1); PG8_STAGE(PG8_SB(1, 0), b3, voffB);
            PG8_BAR; PG8_WAIT_L(0); PG8_MMA(0, 1, At, B1); PG8_BAR;
            PG8_LDA(At, 1, 1); PG8_STAGE(PG8_SA(1, 0), a3, voffA);
            PG8_BAR; PG8_WAIT_L(0); PG8_MMA(1, 0, At, B0); PG8_BAR; PG8_SCHED;
            PG8_STAGE(PG8_SB(1, 1), b3 + hstep, voffB);
            PG8_WAIT_V(6); PG8_BAR; PG8_MMA(1, 1, At, B1); PG8_BAR;
            }
        }
        if constexpr (ALIGN_EPI) { if (wr == 0) PG8_BAR; }
        if constexpr (!Epi::AFTER_DRAIN) { E(acc, cur, wr, wc, fr, fq); S.done(cur); }
        if (!has_next) break;
#pragma unroll
        for (int a = 0; a < 2; ++a)
#pragma unroll
            for (int b = 0; b < 2; ++b)
#pragma unroll
                for (int m = 0; m < 4; ++m)
#pragma unroll
                    for (int n = 0; n < 2; ++n) acc[a][b][m][n] = (f32x4){0.f, 0.f, 0.f, 0.f};
        cur = nxt; cA = nA; cB = nB; ++ui;
        if constexpr (ALIGN_EPI) { if (wr == 1) PG8_BAR; }
    }
    PG8_WAIT_V(0);
    if constexpr (!ALIGN_EPI) { if (wr == 0) PG8_BAR; }
    PG8_BAR;
    if constexpr (Epi::AFTER_DRAIN) { E.fused(acc, cur, wr, wc, fr, fq, lds, wid, lane); S.done(cur); }
#undef PG8_SA
#undef PG8_SB
#undef PG8_STAGE
#undef PG8_LDA
#undef PG8_LDB
#undef PG8_MMA
#undef PG8_WAIT_V
#undef PG8_WAIT_L
#undef PG8_BAR
#undef PG8_SCHED
}
}

#ifndef PG8_SP2
#define PG8_SP2 true
#endif
#ifndef PG8_ALIGN
#define PG8_ALIGN true
#endif

namespace pg8 {
struct EpiResGate {
    static constexpr bool PERM = false, AFTER_DRAIN = false;
    const float* base; float* out; const float* gate; int gate_ld; int rows_per_batch; int ldc;
    __device__ __forceinline__ void operator()(const f32x4 (&acc)[2][2][4][2], const Unit& u, int wr, int wc, int fr, int fq) const {
        const int row0 = u.pm * BM + wr * 64 + fr, col0 = u.pn * BM + wc * 32 + 4 * fq;
        const float* gp = gate + (size_t)((u.pm * BM) / rows_per_batch) * gate_ld + col0;
        f32x4 gv[2][2];
#pragma unroll
        for (int bj = 0; bj < 2; ++bj)
#pragma unroll
            for (int n = 0; n < 2; ++n) gv[bj][n] = *(const f32x4*)(gp + bj * HALF + n * 16);
#pragma unroll
        for (int ai = 0; ai < 2; ++ai)
#pragma unroll
            for (int m = 0; m < 4; ++m) { const size_t off = (size_t)(row0 + ai * HALF + m * 16) * ldc + col0;
#pragma unroll
                for (int bj = 0; bj < 2; ++bj)
#pragma unroll
                    for (int n = 0; n < 2; ++n) { const f32x4 bs = *(const f32x4*)(base + off + bj * HALF + n * 16);
                        *(f32x4*)(out + off + bj * HALF + n * 16) = bs + gv[bj][n] * acc[ai][bj][m][n]; } }
    }
};
struct EpiResGateBf16 {
    static constexpr bool PERM = false, AFTER_DRAIN = false;
    const float* base; bf16_t* out; const float* gate; int gate_ld; int rows_per_batch; int ldc;
    __device__ __forceinline__ void operator()(const f32x4 (&acc)[2][2][4][2], const Unit& u, int wr, int wc, int fr, int fq) const {
        const int row0 = u.pm * BM + wr * 64 + fr, col0 = u.pn * BM + wc * 32 + 4 * fq;
        const float* gp = gate + (size_t)((u.pm * BM) / rows_per_batch) * gate_ld + col0;
        f32x4 gv[2][2];
#pragma unroll
        for (int bj = 0; bj < 2; ++bj)
#pragma unroll
            for (int n = 0; n < 2; ++n) gv[bj][n] = *(const f32x4*)(gp + bj * HALF + n * 16);
#pragma unroll
        for (int ai = 0; ai < 2; ++ai)
#pragma unroll
            for (int m = 0; m < 4; ++m) { const size_t off = (size_t)(row0 + ai * HALF + m * 16) * ldc + col0;
#pragma unroll
                for (int bj = 0; bj < 2; ++bj)
#pragma unroll
                    for (int n = 0; n < 2; ++n) { const f32x4 bs = __builtin_nontemporal_load((const f32x4*)(base + off + bj * HALF + n * 16)); const f32x4 r = bs + gv[bj][n] * acc[ai][bj][m][n];
                        *(unsigned long long*)(out + off + bj * HALF + n * 16) = (unsigned long long)cvt_pk_bf16(r.x, r.y) | ((unsigned long long)cvt_pk_bf16(r.z, r.w) << 32); } }
    }
};
struct EpiF32 {
    static constexpr bool PERM = false, AFTER_DRAIN = false;
    float* O; int ldc;
    __device__ __forceinline__ void operator()(const f32x4 (&acc)[2][2][4][2], const Unit& u, int wr, int wc, int fr, int fq) const {
        const int row0 = u.pm * BM + wr * 64 + fr, col0 = u.pn * BM + wc * 32 + 4 * fq;
#pragma unroll
        for (int ai = 0; ai < 2; ++ai)
#pragma unroll
            for (int m = 0; m < 4; ++m) { const size_t off = (size_t)(row0 + ai * HALF + m * 16) * ldc + col0;
#pragma unroll
                for (int bj = 0; bj < 2; ++bj)
#pragma unroll
                    for (int n = 0; n < 2; ++n) *(f32x4*)(O + off + bj * HALF + n * 16) = acc[ai][bj][m][n]; }
    }
};
}
#define GAS __attribute__((address_space(1)))
#define LAS __attribute__((address_space(3)))
typedef unsigned short bf16;
typedef unsigned v4u __attribute__((ext_vector_type(4)));
typedef float f32x4 __attribute__((ext_vector_type(4)));
typedef short bf16x8 __attribute__((ext_vector_type(8)));
typedef GAS unsigned gu32;
typedef GAS unsigned long long gu64;
#define RLX_AGENT __ATOMIC_RELAXED, __HIP_MEMORY_SCOPE_AGENT
#define LDS_WAIT() asm volatile("s_waitcnt lgkmcnt(0)" ::: "memory")
#define VM_WAIT() asm volatile("s_waitcnt vmcnt(0)" ::: "memory")
__device__ __forceinline__ unsigned long long rt() { return __builtin_amdgcn_s_memrealtime(); }
__device__ __forceinline__ unsigned f2bf(float f) { unsigned u = __builtin_bit_cast(unsigned, f); return (u + 0x7fffu + ((u >> 16) & 1u)) >> 16; }
__device__ __forceinline__ unsigned pk2(float lo, float hi) { return f2bf(lo) | (f2bf(hi) << 16); }

#define XB_TMO      128
#define XB_XCNT(j)  (256  + 64 * (j))
#define XB_XSUB(j)  (1280 + 64 * (j))
#define XB_XGEN(j)  (2304 + 64 * (j))
#define XB_TOP      3328
#define XB_TOPGEN   3392
#define XCD_BAR_WORDS 3456
#define XB_SPIN_CAP (1u << 24)

__device__ __forceinline__ unsigned xb_ld(unsigned* p)              { return __hip_atomic_load(p, __ATOMIC_RELAXED, __HIP_MEMORY_SCOPE_AGENT); }
__device__ __forceinline__ unsigned xb_add(unsigned* p, unsigned v) { return __hip_atomic_fetch_add(p, v, __ATOMIC_RELAXED, __HIP_MEMORY_SCOPE_AGENT); }
__device__ __forceinline__ unsigned xb_xcc_id() { return (unsigned)__builtin_amdgcn_s_getreg((3 << 11) | 20) & 0xFu; }
#define XB_SPIN(cond, bar) do { unsigned _sp = 0; while (cond) { __builtin_amdgcn_s_sleep(1); \
    if ((++_sp & 255u) == 0u) { if (xb_ld(&(bar)[XB_TMO])) break; if (_sp > XB_SPIN_CAP) { atomicAdd(&(bar)[XB_TMO], 1u); break; } } } } while (0)

struct XcdBarrier {
    unsigned* bar; unsigned x;
    volatile LAS unsigned* st;
};

__device__ __forceinline__ XcdBarrier xcd_barrier_post(unsigned* bar, volatile LAS unsigned* st) {
    XcdBarrier b; b.bar = bar; b.x = xb_xcc_id(); b.st = st;
    if (threadIdx.x == 0) (void)xb_add(&bar[XB_XCNT(b.x)], 1u);
    return b;
}
__device__ __forceinline__ void xcd_barrier_complete(unsigned* bar, unsigned x, unsigned& nloc, unsigned& nx) {
    const unsigned G = gridDim.x * gridDim.y * gridDim.z;
    unsigned sum, cnt, mine, sp = 0u;
    for (;;) {
        sum = 0u; cnt = 0u; mine = 0u;
#pragma unroll
        for (unsigned j = 0; j < 16; ++j) { const unsigned c = xb_ld(&bar[XB_XCNT(j)]); sum += c; cnt += (c > 0u) ? 1u : 0u; mine = (j == x) ? c : mine; }
        if (sum == G) break;
        __builtin_amdgcn_s_sleep(1);
        if ((++sp & 255u) == 0u) { if (xb_ld(&bar[XB_TMO])) break; if (sp > XB_SPIN_CAP) { atomicAdd(&bar[XB_TMO], 1u); break; } }
    }
    nloc = mine > 0u ? mine : 1u; nx = cnt > 0u ? cnt : 1u;
}

__device__ __forceinline__ void xcd_barrier(const XcdBarrier& b) {
    asm volatile("s_waitcnt vmcnt(0)" ::: "memory");
    __syncthreads();
    if (threadIdx.x == 0) {
        unsigned* bar = b.bar;
        __builtin_amdgcn_s_waitcnt(0);
        unsigned nloc = b.st[0], nx = b.st[1];
        if (nloc == 0u) { xcd_barrier_complete(bar, b.x, nloc, nx); b.st[0] = nloc; b.st[1] = nx; }
        const unsigned old = xb_add(&bar[XB_XSUB(b.x)], 1u);
        const unsigned gen = old / nloc;
        if (old + 1u == (gen + 1u) * nloc) {
            __builtin_amdgcn_fence(__ATOMIC_RELEASE, "agent");
            asm volatile("s_waitcnt vmcnt(0)" ::: "memory");
            const unsigned og = xb_add(&bar[XB_TOP], 1u);
            const unsigned tg = og / nx;
            if (og + 1u == (tg + 1u) * nx) xb_add(&bar[XB_TOPGEN], 1u);
            else XB_SPIN(xb_ld(&bar[XB_TOPGEN]) == tg, bar);
            __builtin_amdgcn_fence(__ATOMIC_ACQUIRE, "agent");
            xb_add(&bar[XB_XGEN(b.x)], 1u);
            asm volatile("s_waitcnt vmcnt(0)" ::: "memory");
        } else {
            XB_SPIN(xb_ld(&bar[XB_XGEN(b.x)]) == gen, bar);
            __builtin_amdgcn_fence(__ATOMIC_ACQUIRE, "agent");
            asm volatile("s_waitcnt vmcnt(0)" ::: "memory");
        }
    }
    __syncthreads();
}

constexpr int NWAVES = 8, NTHR = 512;
constexpr int NB = 8, SEQ = 4096, T = NB * SEQ, D = 1024, NPROJ = 3584, NIN = 3592, NMOD = 6144, NSC = 2048;
constexpr int C_QSB = 0, C_KSB = 512, C_VSB = 1024, C_QML = 1536, C_KML = 2048, C_VML = 2560, C_OML = 3072;
constexpr float EPS = 1e-6f, LOG2E = 1.4426950408889634f;
constexpr size_t MiB = 1u << 20;
constexpr size_t WS_CTL = 0, CTL_ZERO_BYTES = 1 * MiB;
constexpr size_t WS_MOD = 256 * 1024;
constexpr size_t WS_WIN = 2 * MiB, WS_WOUT = 10 * MiB, WS_WEFF = 12 * MiB;
constexpr size_t WS_XN = 16 * MiB;
constexpr size_t WS_PROJ = 80 * MiB;
constexpr size_t WS_MIX = 304 * MiB;
constexpr size_t WS_EXPU = 368 * MiB, WS_EXPV = 400 * MiB;
constexpr size_t WS_CST = 432 * MiB;
constexpr size_t WS_NST = 496 * MiB;
constexpr size_t WS_MST = 497 * MiB;
constexpr size_t WS_GATES = 498 * MiB;
constexpr size_t WS_XQ = 272 * MiB;
constexpr size_t WS_XS = 499 * MiB + 256 * 1024;
constexpr size_t WS_X1B = 208 * MiB;
constexpr size_t WS_SCORES = 80 * MiB;
constexpr size_t WS_IDX = 336 * MiB, WS_GATE = 352 * MiB;
constexpr size_t WS_SCL = 499 * MiB;
constexpr size_t WS_SUI = 499 * MiB + 65536, WS_SVI = 499 * MiB + 131072;
constexpr size_t WS_END = 500 * MiB;
constexpr int CW_Q3 = 64;
constexpr int CW_BAR = 4096;
constexpr int LDS_BYTES = 147456, LDSCTL_OFF = 143360;

typedef float f32x16 __attribute__((ext_vector_type(16)));
typedef float f32x2_t __attribute__((ext_vector_type(2)));
typedef __bf16 bf16x2_t __attribute__((ext_vector_type(2)));
typedef _Float16 f16x8 __attribute__((ext_vector_type(8)));
typedef short s16x4 __attribute__((ext_vector_type(4)));
typedef unsigned u32x2 __attribute__((ext_vector_type(2)));
#define DI __device__ __forceinline__
DI unsigned cvtpk(float lo, float hi) { f32x2_t v = {lo, hi}; bf16x2_t b = __builtin_convertvector(v, bf16x2_t); return __builtin_bit_cast(unsigned, b); }
DI float bflo(unsigned u) { return __uint_as_float(u << 16); }
DI float bfhi(unsigned u) { return __uint_as_float(u & 0xffff0000u); }
DI int crow(int i, int hi) { return (i & 3) + 8 * (i >> 2) + 4 * hi; }
DI int krow(int s, int hi, int j) { return 16 * s + 8 * (j >> 2) + 4 * hi + (j & 3); }
DI float swap_add(float v) { auto rr = __builtin_amdgcn_permlane32_swap(__float_as_uint(v), __float_as_uint(v), false, false); return __uint_as_float(rr[0]) + __uint_as_float(rr[1]); }
DI float swap_max(float v) { auto rr = __builtin_amdgcn_permlane32_swap(__float_as_uint(v), __float_as_uint(v), false, false); return fmaxf(__uint_as_float(rr[0]), __uint_as_float(rr[1])); }
DI float dot2bf(unsigned a, unsigned b, float acc) { return __builtin_amdgcn_fdot2_f32_bf16(__builtin_bit_cast(bf16x2_t, a), __builtin_bit_cast(bf16x2_t, b), acc, false); }
DI float ex2(float x) { return __builtin_amdgcn_exp2f(x); }
DI float lg2(float x) { return __builtin_amdgcn_logf(x); }
DI float fexp(float x) { return __builtin_amdgcn_exp2f(x * LOG2E); }
DI float wave_sum(float v) {
#pragma unroll
    for (int o = 1; o < 64; o <<= 1) v += __shfl_xor(v, o);
    return v;
}
DI float wave_max(float v) {
#pragma unroll
    for (int o = 1; o < 64; o <<= 1) v = fmaxf(v, __shfl_xor(v, o));
    return v;
}
#define DPP_MAXF(v, ctrl, rmask) fmaxf((v), __builtin_bit_cast(float, __builtin_amdgcn_update_dpp(0, __builtin_bit_cast(int, (v)), (ctrl), (rmask), 0xF, false)))
DI float wave_max_nonneg(float v) {
    v = DPP_MAXF(v, 0xB1, 0xF); v = DPP_MAXF(v, 0x4E, 0xF); v = DPP_MAXF(v, 0x141, 0xF); v = DPP_MAXF(v, 0x140, 0xF); v = DPP_MAXF(v, 0x142, 0xA); v = DPP_MAXF(v, 0x143, 0xC);
    return __builtin_bit_cast(float, __builtin_amdgcn_readlane(__builtin_bit_cast(int, v), 63));
}
#define DPP_ADDF(v, ctrl, rmask) ((v) + __builtin_bit_cast(float, __builtin_amdgcn_update_dpp(0, __builtin_bit_cast(int, (v)), (ctrl), (rmask), 0xF, false)))
DI float wave_sum_u(float v) {
    v = DPP_ADDF(v, 0xB1, 0xF); v = DPP_ADDF(v, 0x4E, 0xF); v = DPP_ADDF(v, 0x141, 0xF); v = DPP_ADDF(v, 0x140, 0xF); v = DPP_ADDF(v, 0x142, 0xA); v = DPP_ADDF(v, 0x143, 0xC);
    return __builtin_bit_cast(float, __builtin_amdgcn_readlane(__builtin_bit_cast(int, v), 63));
}
typedef short v4i16_t __attribute__((ext_vector_type(4)));
DI s16x4 trrd(LAS unsigned char* p) { return __builtin_bit_cast(s16x4, __builtin_amdgcn_ds_read_tr16_b64_v4i16((LAS v4i16_t*)p)); }
DI bf16x8 cat8(s16x4 a, s16x4 b) { return (bf16x8){a[0], a[1], a[2], a[3], b[0], b[1], b[2], b[3]}; }
#define MFMA_BF16(a, b, c) __builtin_amdgcn_mfma_f32_32x32x16_bf16((a), (b), (c), 0, 0, 0)
#define MFMA_F16(a, b, c) __builtin_amdgcn_mfma_f32_32x32x16_f16((a), (b), (c), 0, 0, 0)
DI unsigned pkh(float a, float b) { return __builtin_bit_cast(unsigned, __builtin_amdgcn_cvt_pkrtz(a, b)); }
DI bf16x8 packbf(const f32x16& x, int s) { v4u p; p.x = cvtpk(x[8 * s], x[8 * s + 1]); p.y = cvtpk(x[8 * s + 2], x[8 * s + 3]); p.z = cvtpk(x[8 * s + 4], x[8 * s + 5]); p.w = cvtpk(x[8 * s + 6], x[8 * s + 7]); return __builtin_bit_cast(bf16x8, p); }
DI f16x8 packh(const f32x16& x, int s) { v4u p; p.x = pkh(x[8 * s], x[8 * s + 1]); p.y = pkh(x[8 * s + 2], x[8 * s + 3]); p.z = pkh(x[8 * s + 4], x[8 * s + 5]); p.w = pkh(x[8 * s + 6], x[8 * s + 7]); return __builtin_bit_cast(f16x8, p); }

struct Frame {
    LAS unsigned char* lds;
    volatile LAS unsigned* MISC;
    gu32* ctl;
    unsigned char* ws;
    int tid, lane, wave, vcu, G;
};
DI const float* inp(int i) { const __attribute__((address_space(4))) unsigned long long* kp = (const __attribute__((address_space(4))) unsigned long long*)__builtin_amdgcn_kernarg_segment_ptr(); return (const float*)(const GAS float*)(*(volatile const __attribute__((address_space(4))) unsigned long long*)(kp + i)); }
enum { I_X = 0, I_C, I_WADA, I_BADA, I_GN1, I_WIN, I_BIG, I_BFG, I_CONVW, I_GQ, I_GK, I_GOSB, I_GOML, I_WOUT, I_GN2, I_WQ, I_SK, I_EU, I_EV, I_OUT };
#define WSP(type, off) ((type*)(F.ws + (off)))

DI void p0_transpose_item(const float* W, int K, int N, int ld, bf16* WT, LAS float* scr, int item, int lane) {
    const int nblk = N / 32, kb = item / nblk, nb = item % nblk, k0 = 64 * kb, n0 = 32 * nb;
    float tv[32];
#pragma unroll
    for (int i = 0; i < 32; ++i) tv[i] = W[(size_t)(k0 + 2 * i + (lane >> 5)) * ld + n0 + (lane & 31)];
#pragma unroll
    for (int i = 0; i < 32; ++i) scr[(2 * i + (lane >> 5)) * 33 + (lane & 31)] = tv[i];
    LDS_WAIT(); asm volatile("" ::: "memory");
    const int c = lane & 7;
#pragma unroll
    for (int j = 0; j < 4; ++j) { const int n = (lane >> 3) + 8 * j; const LAS float* s = scr + (8 * c) * 33 + n;
        v4u o; o.x = pk2(s[0 * 33], s[1 * 33]); o.y = pk2(s[2 * 33], s[3 * 33]); o.z = pk2(s[4 * 33], s[5 * 33]); o.w = pk2(s[6 * 33], s[7 * 33]);
        *(GAS v4u*)(WT + (size_t)(n0 + n) * K + k0 + 8 * c) = o; }
    LDS_WAIT(); asm volatile("" ::: "memory");
}
DI void p0_mod_block(const Frame& F, int item) {
    const float* const c_ = inp(I_C); const float* const w_ada_ = inp(I_WADA); const float* const b_ada_ = inp(I_BADA); float* const mod_ = WSP(float, WS_MOD);
    LAS float* scr = (LAS float*)(F.lds + F.wave * 16384);
    const int j = item * 64 + F.lane, d0 = F.wave * 128;
#pragma unroll
    for (int b = 0; b < 8; ++b)
#pragma unroll
        for (int q = 0; q < 2; ++q) { const float cv = c_[b * D + d0 + 64 * q + F.lane]; scr[b * 128 + 64 * q + F.lane] = cv / (1.f + fexp(-cv)); }
    LDS_WAIT(); asm volatile("" ::: "memory");
    float acc[8];
#pragma unroll
    for (int b = 0; b < 8; ++b) acc[b] = 0.f;
#pragma unroll 32
    for (int dd = 0; dd < 128; ++dd) { const float w = w_ada_[(size_t)(d0 + dd) * NMOD + j];
#pragma unroll
        for (int b = 0; b < 8; ++b) acc[b] += scr[b * 128 + dd] * w; }
#pragma unroll
    for (int b = 0; b < 8; ++b) scr[1024 + b * 64 + F.lane] = acc[b];
    __syncthreads();
    float tot = b_ada_[j];
#pragma unroll
    for (int w = 0; w < 8; ++w) tot += ((LAS float*)(F.lds + w * 16384))[1024 + F.wave * 64 + F.lane];
    mod_[F.wave * NMOD + j] = tot;
    __syncthreads();
}
DI void p0_weff_item(const Frame& F, int item) {
    const float* const sub_keys_ = inp(I_SK); const float* const w_q_peer_ = inp(I_WQ); bf16* const Weff_t_ = WSP(bf16, WS_WEFF);
    const int hp = item >> 4, dblk = item & 15;
    LAS float* sk = (LAS float*)F.lds;
    LAS float* rb = (LAS float*)(F.lds + 67584) + F.wave * 1024;
    { float tv[32];
#pragma unroll
      for (int i = 0; i < 32; ++i) tv[i] = sub_keys_[(size_t)hp * 16384 + F.tid + 512 * i];
#pragma unroll
      for (int i = 0; i < 32; ++i) { const int idx = F.tid + 512 * i; sk[(idx >> 7) * 129 + (idx & 127)] = tv[i]; } }
    const int d0 = 64 * dblk + 8 * F.wave;
#pragma unroll
    for (int r = 0; r < 8; ++r) { rb[r * 128 + F.lane] = w_q_peer_[(size_t)(d0 + r) * NSC + hp * 128 + F.lane]; rb[r * 128 + 64 + F.lane] = w_q_peer_[(size_t)(d0 + r) * NSC + hp * 128 + 64 + F.lane]; }
    __syncthreads();
    float a0[8], a1[8];
#pragma unroll
    for (int r = 0; r < 8; ++r) { a0[r] = 0.f; a1[r] = 0.f; }
#pragma unroll 4
    for (int c = 0; c < 128; ++c) { const float s0 = sk[F.lane * 129 + c], s1 = sk[(F.lane + 64) * 129 + c];
#pragma unroll
        for (int r = 0; r < 8; ++r) { const float a = rb[r * 128 + c]; a0[r] += a * s0; a1[r] += a * s1; } }
    v4u o0, o1; o0.x = pk2(a0[0], a0[1]); o0.y = pk2(a0[2], a0[3]); o0.z = pk2(a0[4], a0[5]); o0.w = pk2(a0[6], a0[7]);
    o1.x = pk2(a1[0], a1[1]); o1.y = pk2(a1[2], a1[3]); o1.z = pk2(a1[4], a1[5]); o1.w = pk2(a1[6], a1[7]);
    *(GAS v4u*)(Weff_t_ + (size_t)(hp * 128 + F.lane) * D + d0) = o0;
    *(GAS v4u*)(Weff_t_ + (size_t)(hp * 128 + 64 + F.lane) * D + d0) = o1;
    __syncthreads();
}
struct ExpRows2 { f32x4 v[2][4]; };
DI void exp_load2(const Frame& F, int blk0, ExpRows2& R) {
    const float* const expert_u_ = inp(I_EU); const float* const expert_v_ = inp(I_EV);
#pragma unroll
    for (int bb = 0; bb < 2; ++bb) { const int blk = blk0 + bb; const float* src = (blk < 16384 ? expert_u_ : expert_v_) + (size_t)(blk & 16383) * 1024 + 4 * F.lane;
#pragma unroll
        for (int k = 0; k < 4; ++k) R.v[bb][k] = __builtin_nontemporal_load((const GAS f32x4*)(src + 256 * k)); }
}
DI void exp_conv2(const Frame& F, int blk0, const ExpRows2& R) {
    float* const SUI_ = WSP(float, WS_SUI); float* const SVI_ = WSP(float, WS_SVI);
#pragma unroll
    for (int bb = 0; bb < 2; ++bb) { const int blk = blk0 + bb; const bool isu = blk < 16384; const int e = blk & 16383;
        float mx = 0.f;
#pragma unroll
        for (int k = 0; k < 4; ++k) mx = fmaxf(mx, fmaxf(fmaxf(fabsf(R.v[bb][k].x), fabsf(R.v[bb][k].y)), fmaxf(fabsf(R.v[bb][k].z), fabsf(R.v[bb][k].w))));
        mx = wave_max_nonneg(mx);
        {
            float best = 3.0e38f, bs = 0.f;
#define EXP_TRY(FAC) do { const float s_ = mx * ((FAC) / 7.f), inv_ = s_ > 0.f ? 1.f / s_ : 0.f; float er_ = 0.f; \
                _Pragma("unroll") for (int k = 0; k < 4; ++k) _Pragma("unroll") for (int c = 0; c < 4; ++c) { const float v_ = R.v[bb][k][c]; const float d_ = v_ - s_ * fminf(fmaxf(rintf(v_ * inv_), -7.f), 7.f); er_ += d_ * d_; } \
                er_ = wave_sum_u(er_); if (er_ < best) { best = er_; bs = s_; } } while (0)
            EXP_TRY(1.f); EXP_TRY(0.86f); EXP_TRY(0.74f); EXP_TRY(0.63f);
#undef EXP_TRY
            const float inv = bs > 0.f ? 1.f / bs : 0.f;
            unsigned w01[2] = {0u, 0u};
#pragma unroll
            for (int k = 0; k < 4; ++k)
#pragma unroll
                for (int c = 0; c < 4; ++c) { const int q = (int)fminf(fmaxf(rintf(R.v[bb][k][c] * inv), -7.f), 7.f); w01[k >> 1] |= (unsigned)((isu || (c & 1)) ? (q & 15) : (q + 8)) << (4 * (4 * (k & 1) + c)); }
            if (F.lane == 0) (isu ? SUI_ : SVI_)[e] = bs;
            typedef unsigned v2u_ __attribute__((ext_vector_type(2)));
            v2u_ wv; wv.x = w01[0]; wv.y = w01[1];
            *(GAS v2u_*)((isu ? WSP(unsigned char, WS_EXPU) : WSP(unsigned char, WS_EXPV)) + (size_t)e * 512 + 8 * F.lane) = wv;
        } }
}
#ifndef P0_PARTS
#define P0_PARTS 15
#endif
DI void p0_phase(const Frame& F, int parts = 15) {
    const float* const w_in_ = inp(I_WIN); bf16* const Win_t_ = WSP(bf16, WS_WIN); const float* const w_out_ = inp(I_WOUT); bf16* const Wout_t_ = WSP(bf16, WS_WOUT); const float* const expert_v_ = inp(I_EV); const float* const expert_u_ = inp(I_EU);
    LAS float* scr = (LAS float*)(F.lds + F.wave * 16384);
    const int gw = F.vcu * NWAVES + F.wave, NGW = F.G * NWAVES;
    if (parts & 1) for (int it = F.vcu; it < 96; it += F.G) p0_mod_block(F, it);
    constexpr int I_WIN = 16 * 112, I_WOUT = 16 * 32, NITEMS = I_WIN + I_WOUT;
    if (parts & 2) for (int it = gw; it < NITEMS; it += NGW) {
        int r = it;
        if (r < I_WIN) { p0_transpose_item(w_in_, D, NPROJ, NIN, Win_t_, scr, r, F.lane); continue; } r -= I_WIN;
        p0_transpose_item(w_out_, D, D, D, Wout_t_, scr, r, F.lane);
    }
    __syncthreads();
    if (parts & 8) for (int it = F.vcu; it < 256; it += F.G) p0_weff_item(F, it);
}

template <bool DOGATES, bool SRCB = false>
DI void norm_phase(const Frame& F, const float* src, const float* g, int shift_off, int scale_off) {
    const float* const w_in_ = inp(I_WIN); float* const mod_ = WSP(float, WS_MOD); bf16* const XN_ = WSP(bf16, WS_XN); float* const GATES_ = WSP(float, WS_GATES); const float* const b_igate_ = inp(I_BIG); const float* const b_fgate_ = inp(I_BFG);
    LAS float* W8 = (LAS float*)F.lds;
    if (DOGATES) {
        for (int i = 0; i < 16; ++i) { const int idx = F.tid + 512 * i; W8[idx] = w_in_[(size_t)(idx & 1023) * NIN + NPROJ + (idx >> 10)]; }
        __syncthreads();
    }
    const int gw = F.vcu * NWAVES + F.wave, NGW = F.G * NWAVES;
    for (int ch = gw; ch < T / 16; ch += NGW) {
        const int r0 = ch * 16, b = r0 / SEQ;
        f32x4 A[4], Bv[4];
#pragma unroll
        for (int j = 0; j < 4; ++j) { const int col = 4 * F.lane + 256 * j; const f32x4 gg = *(const f32x4*)(g + col), sc = *(const f32x4*)(mod_ + b * NMOD + scale_off + col);
            A[j] = gg * (sc + 1.0f); Bv[j] = *(const f32x4*)(mod_ + b * NMOD + shift_off + col); }
        f32x4 nx[4];
#define NORM_LOADROW(ROW) do { if (SRCB) { const GAS unsigned long long* xb_ = (const GAS unsigned long long*)((const bf16*)src + (size_t)(ROW) * D) + F.lane; \
              _Pragma("unroll") for (int j = 0; j < 4; ++j) { const unsigned long long w_ = __builtin_nontemporal_load(xb_ + 64 * j); const unsigned lo_ = (unsigned)w_, hi_ = (unsigned)(w_ >> 32); \
                  nx[j] = (f32x4){bflo(lo_), bfhi(lo_), bflo(hi_), bfhi(hi_)}; } } \
          else { const GAS f32x4* xr_ = (const GAS f32x4*)(src + (size_t)(ROW) * D) + F.lane; _Pragma("unroll") for (int j = 0; j < 4; ++j) nx[j] = __builtin_nontemporal_load(xr_ + 64 * j); } } while (0)
        NORM_LOADROW(r0);
        for (int rr = 0; rr < 16; ++rr) {
            const int row = r0 + rr;
            f32x4 v[4]; float s = 0.f;
#pragma unroll
            for (int j = 0; j < 4; ++j) { v[j] = nx[j]; s += (v[j].x * v[j].x + v[j].y * v[j].y) + (v[j].z * v[j].z + v[j].w * v[j].w); }
            if (rr + 1 < 16) NORM_LOADROW(row + 1);
            const float rstd = 1.f / sqrtf(wave_sum_u(s) * (1.f / D) + EPS);
#pragma unroll
            for (int j = 0; j < 4; ++j) v[j] = v[j] * rstd * A[j] + Bv[j];
            GAS unsigned long long* o8 = (GAS unsigned long long*)(XN_ + (size_t)row * D) + F.lane;
#pragma unroll
            for (int j = 0; j < 4; ++j) o8[64 * j] = (unsigned long long)pk2(v[j].x, v[j].y) | ((unsigned long long)pk2(v[j].z, v[j].w) << 32);
            if (SRCB) {
                float mx = 0.f;
#pragma unroll
                for (int j = 0; j < 4; ++j) mx = fmaxf(mx, fmaxf(fmaxf(fabsf(v[j].x), fabsf(v[j].y)), fmaxf(fabsf(v[j].z), fabsf(v[j].w))));
                mx = wave_max_nonneg(mx);
                const float sx = mx > 0.f ? 119.f / mx : 0.f;
                unsigned lo_[2] = {0u, 0u}, hi_[2] = {0u, 0u};
#pragma unroll
                for (int j = 0; j < 4; ++j)
#pragma unroll
                    for (int c = 0; c < 4; ++c) { const int t_ = (int)rintf(v[j][c] * sx) + 8; const int sh_ = 4 * (4 * (j & 1) + c);
                        lo_[j >> 1] |= (unsigned)(t_ & 15) << sh_; hi_[j >> 1] |= (unsigned)((t_ >> 4) & 15) << sh_; }
                typedef unsigned v2u_ __attribute__((ext_vector_type(2)));
                unsigned char* xq = WSP(unsigned char, WS_XQ) + (size_t)row * 1024 + 8 * F.lane;
                v2u_ hv, lv; hv.x = hi_[0]; hv.y = hi_[1]; lv.x = lo_[0] ^ 0x88888888u; lv.y = lo_[1] ^ 0x88888888u;
                *(GAS v2u_*)xq = hv; *(GAS v2u_*)(xq + 512) = lv;
                if (F.lane == 0) WSP(float, WS_XS)[row] = mx > 0.f ? mx / 119.f : 0.f;
            }
            if (DOGATES) {
                float res = 0.f;
#pragma unroll
                for (int hh = 0; hh < 8; ++hh) { float p = 0.f;
#pragma unroll
                    for (int j = 0; j < 4; ++j) { const f32x4 w = *(const LAS f32x4*)(W8 + hh * 1024 + 4 * F.lane + 256 * j); p += (v[j].x * w.x + v[j].y * w.y) + (v[j].z * w.z + v[j].w * w.w); }
                    p = wave_sum_u(p); if (F.lane == hh) res = p; }
                if (F.lane < 8) GATES_[(size_t)row * 8 + F.lane] = res + (F.lane < 4 ? b_igate_[F.lane] : b_fgate_[F.lane - 4]);
            }
        }
    }
}

DI void sb_unit(const Frame& F, int b, int h, int qb) {
    bf16* const PROJ_ = WSP(bf16, WS_PROJ); const float* const g_q_sb_ = inp(I_GQ); const float* const g_k_sb_ = inp(I_GK); bf16* const MIX_ = WSP(bf16, WS_MIX); const float* const g_out_sb_ = inp(I_GOSB);
    const int lane = F.lane, w = F.wave, r = lane & 31, hi = lane >> 5;
    const int i16 = lane & 15, qq = i16 >> 2, pp = i16 & 3, blk = (lane >> 4) & 1;
    LAS unsigned char* Wb = F.lds + w * 16384;
    const size_t rowbase = (size_t)b * SEQ; const int q0 = qb * 256, qw0 = q0 + 32 * w, tq = qw0 + r;
    const bf16* P = PROJ_;
    const bf16* kpiece[4]; const bf16* vpiece[4];
#pragma unroll
    for (int i = 0; i < 4; ++i) { const int krow_ = 8 * i + (lane >> 3), kch = (lane & 7) ^ ((krow_ >> 1) & 7); kpiece[i] = P + (rowbase + krow_) * NPROJ + C_KSB + h * 64 + 8 * kch;
        const int vkey = 16 * (i & 1) + (lane >> 2); vpiece[i] = P + (rowbase + vkey) * NPROJ + C_VSB + h * 64 + 32 * (i >> 1) + 8 * (lane & 3); }
#define SB_DMA(T_, BUF_) do { _Pragma("unroll") for (int i_ = 0; i_ < 4; ++i_) { \
        __builtin_amdgcn_global_load_lds((const unsigned*)(kpiece[i_] + (size_t)(32 * (T_)) * NPROJ), (LAS unsigned*)(Wb + 8192 * (BUF_) + 1024 * i_), 16, 0, 0); \
        __builtin_amdgcn_global_load_lds((const unsigned*)(vpiece[i_] + (size_t)(32 * (T_)) * NPROJ), (LAS unsigned*)(Wb + 8192 * (BUF_) + 4096 + 1024 * i_), 16, 0, 0); } } while (0)
    const int tw = (qw0 + 30) >> 5;
    SB_DMA(tw, 0);
    bf16x8 qf[4];
    {
        const bf16* Qp = P + (rowbase + tq) * NPROJ + C_QSB + h * 64 + 8 * hi;
        v4u qraw[4]; float ss = 0.f;
#pragma unroll
        for (int kk = 0; kk < 4; ++kk) { qraw[kk] = *(const GAS v4u*)(Qp + 16 * kk);
#pragma unroll
            for (int e = 0; e < 4; ++e) { const float a = bflo(qraw[kk][e]), c = bfhi(qraw[kk][e]); ss += a * a + c * c; } }
        ss = swap_add(ss);
        const float rq = __builtin_amdgcn_rsqf(ss * (1.f / 64.f) + EPS) * (0.125f * LOG2E);
#pragma unroll
        for (int kk = 0; kk < 4; ++kk) { const int d0 = 16 * kk + 8 * hi;
            const f32x4 g0 = *(const f32x4*)(g_q_sb_ + d0) * *(const f32x4*)(g_k_sb_ + d0), g1 = *(const f32x4*)(g_q_sb_ + d0 + 4) * *(const f32x4*)(g_k_sb_ + d0 + 4);
            v4u o; o.x = cvtpk(bflo(qraw[kk].x) * rq * g0.x, bfhi(qraw[kk].x) * rq * g0.y); o.y = cvtpk(bflo(qraw[kk].y) * rq * g0.z, bfhi(qraw[kk].y) * rq * g0.w);
            o.z = cvtpk(bflo(qraw[kk].z) * rq * g1.x, bfhi(qraw[kk].z) * rq * g1.y); o.w = cvtpk(bflo(qraw[kk].w) * rq * g1.z, bfhi(qraw[kk].w) * rq * g1.w);
            qf[kk] = __builtin_bit_cast(bf16x8, o); }
    }
    f16x8 U0, U1, E0;
#pragma unroll
    for (int j = 0; j < 8; ++j) { U0[j] = (krow(0, hi, j) > r) ? (_Float16)1.0f : (_Float16)0.0f; U1[j] = (krow(1, hi, j) > r) ? (_Float16)1.0f : (_Float16)0.0f;
        E0[j] = (j == 0 && hi == 0) ? (_Float16)1.0f : (_Float16)0.0f; }
    f32x16 o0, o1;
#pragma unroll
    for (int i = 0; i < 16; ++i) { o0[i] = 0.f; o1[i] = 0.f; }
    float R = 0.f;
    const int kfoff = r * 128, kfsw = (r >> 1) & 7;
    for (int t = tw; t >= 0; --t) {
        const int buf = (tw - t) & 1;
        LAS unsigned char* Kb = Wb + 8192 * buf; LAS unsigned char* Vb = Kb + 4096;
        asm volatile("s_waitcnt vmcnt(0)" ::: "memory");
        if (t > 0) SB_DMA(t - 1, buf ^ 1);
        bf16x8 kf[4]; float ssk = 0.f;
#pragma unroll
        for (int kk = 0; kk < 4; ++kk) { const v4u kv = *(const LAS v4u*)(Kb + kfoff + (((2 * kk + hi) ^ kfsw) * 16)); kf[kk] = __builtin_bit_cast(bf16x8, kv);
            ssk = dot2bf(kv.x, kv.x, ssk); ssk = dot2bf(kv.y, kv.y, ssk); ssk = dot2bf(kv.z, kv.z, ssk); ssk = dot2bf(kv.w, kv.w, ssk); }
        ssk = swap_add(ssk);
        const float rk = __builtin_amdgcn_rsqf(ssk * (1.f / 64.f) + EPS);
        f16x8 RKA;
#pragma unroll
        for (int e = 0; e < 8; ++e) RKA[e] = (_Float16)0.0f;
        RKA[0] = (hi == 0) ? (_Float16)rk : (_Float16)0.0f;
        f32x16 s, rkd;
#pragma unroll
        for (int i = 0; i < 16; ++i) { s[i] = 0.f; rkd[i] = 0.f; }
        rkd = MFMA_F16(RKA, E0, rkd);
#pragma unroll
        for (int kk = 0; kk < 4; ++kk) s = MFMA_BF16(kf[kk], qf[kk], s);
        float tsum = 0.f; unsigned lp[8];
        if (32 * t + 31 < qw0) {
#pragma unroll
            for (int i = 0; i < 16; i += 2) {
                const float z0_ = s[i] * rkd[i], z1_ = s[i + 1] * rkd[i + 1];
                const float a0_ = -lg2(1.f + ex2(z0_)), a1_ = -lg2(1.f + ex2(z1_));
                tsum += a0_ + a1_;
                s[i] = z0_ + a0_; s[i + 1] = z1_ + a1_;
                lp[i >> 1] = pkh(a0_, a1_); }
        } else {
            const int kq = tq - 32 * t;
#pragma unroll
            for (int i = 0; i < 16; i += 2) {
                const float z0_ = s[i] * rkd[i], z1_ = s[i + 1] * rkd[i + 1];
                float a0_ = -lg2(1.f + ex2(z0_)), a1_ = -lg2(1.f + ex2(z1_));
                const bool ma0 = crow(i, hi) >= kq, ma1 = crow(i + 1, hi) >= kq;
                a0_ = ma0 ? 0.f : a0_; a1_ = ma1 ? 0.f : a1_;
                tsum += a0_ + a1_;
                s[i] = ma0 ? -INFINITY : z0_ + a0_; s[i + 1] = ma1 ? -INFINITY : z1_ + a1_;
                lp[i >> 1] = pkh(a0_, a1_); }
        }
        f32x16 c;
#pragma unroll
        for (int i = 0; i < 16; ++i) c[i] = R;
        c = MFMA_F16(U0, __builtin_bit_cast(f16x8, (v4u){lp[0], lp[1], lp[2], lp[3]}), c); c = MFMA_F16(U1, __builtin_bit_cast(f16x8, (v4u){lp[4], lp[5], lp[6], lp[7]}), c);
#pragma unroll
        for (int i = 0; i < 16; ++i) s[i] = ex2(s[i] + c[i]);
        const bf16x8 W0 = packbf(s, 0), W1 = packbf(s, 1);
        LAS unsigned char* vb_ = Vb + (4 * hi + qq) * 64 + 32 * blk + 8 * pp;
        o0 = MFMA_BF16(cat8(trrd(vb_), trrd(vb_ + 8 * 64)), W0, o0); o0 = MFMA_BF16(cat8(trrd(vb_ + 16 * 64), trrd(vb_ + 24 * 64)), W1, o0);
        o1 = MFMA_BF16(cat8(trrd(vb_ + 2048), trrd(vb_ + 2048 + 8 * 64)), W0, o1); o1 = MFMA_BF16(cat8(trrd(vb_ + 2048 + 16 * 64), trrd(vb_ + 2048 + 24 * 64)), W1, o1);
        R += swap_add(tsum);
        if (__all(R < -150.f)) break;
    }
    asm volatile("s_waitcnt vmcnt(0)" ::: "memory");
#undef SB_DMA
    {
        float ss = 0.f;
#pragma unroll
        for (int i = 0; i < 16; ++i) ss += o0[i] * o0[i] + o1[i] * o1[i];
        ss = swap_add(ss);
        const float ro = __builtin_amdgcn_rsqf(ss * (1.f / 64.f) + EPS);
        bf16* Op = MIX_ + (rowbase + tq) * D + h * 64;
        const float* go = g_out_sb_ + h * 64;
#pragma unroll
        for (int g = 0; g < 4; ++g) { const int d0 = 8 * g + 4 * hi; const f32x4 ga = *(const f32x4*)(go + d0), gb = *(const f32x4*)(go + 32 + d0);
            u32x2 wa, wb; wa.x = cvtpk(o0[4 * g] * ro * ga.x, o0[4 * g + 1] * ro * ga.y); wa.y = cvtpk(o0[4 * g + 2] * ro * ga.z, o0[4 * g + 3] * ro * ga.w);
            wb.x = cvtpk(o1[4 * g] * ro * gb.x, o1[4 * g + 1] * ro * gb.y); wb.y = cvtpk(o1[4 * g + 2] * ro * gb.z, o1[4 * g + 3] * ro * gb.w);
            *(GAS u32x2*)(Op + d0) = wa; *(GAS u32x2*)(Op + 32 + d0) = wb; }
    }
    __syncthreads();
}

DI void conv_silu8(const v4u (&xr)[4], const float (&cw)[4][8], float scale, float (&y)[8]) {
#pragma unroll
    for (int e = 0; e < 8; ++e) y[e] = 0.f;
#pragma unroll
    for (int j = 0; j < 4; ++j) {
        y[0] += cw[j][0] * bflo(xr[j].x); y[1] += cw[j][1] * bfhi(xr[j].x); y[2] += cw[j][2] * bflo(xr[j].y); y[3] += cw[j][3] * bfhi(xr[j].y);
        y[4] += cw[j][4] * bflo(xr[j].z); y[5] += cw[j][5] * bfhi(xr[j].z); y[6] += cw[j][6] * bflo(xr[j].w); y[7] += cw[j][7] * bfhi(xr[j].w); }
#pragma unroll
    for (int e = 0; e < 8; ++e) y[e] = scale * y[e] * __builtin_amdgcn_rcpf(1.f + fexp(-y[e]));
}
DI float log_sigmoid(float x) { return fminf(x, 0.f) - 0.6931471805599453f * lg2(1.f + fexp(-fabsf(x))); }
DI float wave_scan_incl(float a, int lane) {
#pragma unroll
    for (int o = 1; o < 64; o <<= 1) { const float t = __shfl_up(a, o); if (lane >= o) a += t; }
    return a;
}

constexpr int LDS_CW = 65536;
DI void stage_conv_w(const Frame& F) {
    const float* const conv_w_ = inp(I_CONVW); LAS float* cwl = (LAS float*)(F.lds + LDS_CW);
    for (int i = F.tid; i < 4096; i += NTHR) cwl[i] = conv_w_[i];
    __syncthreads();
}
DI void load_cw8(const Frame& F, int colbase, float (&cw)[4][8]) {
    const LAS float* cwl = (const LAS float*)(F.lds + LDS_CW);
#pragma unroll
    for (int j = 0; j < 4; ++j) { const f32x4 a = *(const LAS f32x4*)(cwl + j * 1024 + colbase), b = *(const LAS f32x4*)(cwl + j * 1024 + colbase + 4);
        cw[j][0] = a.x; cw[j][1] = a.y; cw[j][2] = a.z; cw[j][3] = a.w; cw[j][4] = b.x; cw[j][5] = b.y; cw[j][6] = b.z; cw[j][7] = b.w; }
}
struct MlLocalRegs { v4u kraw[2][4]; v4u vraw[2]; float gi, gf; };
DI void ml_local_load(const Frame& F, int chain, int c, MlLocalRegs& R) {
    bf16* const PROJ_ = WSP(bf16, WS_PROJ); float* const GATES_ = WSP(float, WS_GATES);
    const int tid = F.tid, lane = F.lane;
    const int b = chain >> 2, hh = chain & 3; const size_t rowbase = (size_t)b * SEQ; const int t0 = c * 64;
    const bf16* P = PROJ_;
    const int kc = tid & 15, kr0 = tid >> 4;
    const bf16* Kg = P + rowbase * NPROJ + C_KML + hh * 128 + kc * 8;
#pragma unroll
    for (int i = 0; i < 2; ++i)
#pragma unroll
        for (int j = 0; j < 4; ++j) { const int tt = t0 + kr0 + 32 * i - 3 + j; R.kraw[i][j] = (tt >= 0) ? *(const GAS v4u*)(Kg + (size_t)tt * NPROJ) : (v4u){0u, 0u, 0u, 0u}; }
#pragma unroll
    for (int i = 0; i < 2; ++i) R.vraw[i] = *(const GAS v4u*)(P + (rowbase + t0 + kr0 + 32 * i) * NPROJ + C_VML + hh * 128 + kc * 8);
    const float* Gg = GATES_ + (rowbase + t0 + lane) * 8;
    R.gi = Gg[hh]; R.gf = Gg[4 + hh];
}
DI void ml_local_unit(const Frame& F, int chain, int c, const MlLocalRegs& RG) {
    bf16* const CST_ = WSP(bf16, WS_CST); float* const NST_ = WSP(float, WS_NST); float* const SCL_ = WSP(float, WS_SCL);
    LAS unsigned char* L = F.lds;
    LAS float* Lws = (LAS float*)(L + 32768);
    const int tid = F.tid, lane = F.lane, w = F.wave, r = lane & 31, hi = lane >> 5;
    const int i16 = lane & 15, qq = i16 >> 2, pp = i16 & 3, blk = (lane >> 4) & 1;
    const int hh = chain & 3;
    const int kbk = w & 3, vb0 = 2 * (w >> 2);
    const int kc = tid & 15, kr0 = tid >> 4;
    v4u kraw[2][4], vraw[2];
#pragma unroll
    for (int i = 0; i < 2; ++i) { vraw[i] = RG.vraw[i];
#pragma unroll
        for (int j = 0; j < 4; ++j) kraw[i][j] = RG.kraw[i][j]; }
    const float gi = RG.gi, gf = RG.gf;
    const float a = wave_scan_incl(log_sigmoid(gf), lane);
    const float a_end = __shfl(a, 63);
    const float lw = a_end - a + gi;
    const float m_loc = wave_max(lw);
    const float ws = fexp(lw - m_loc);
    if (w == 0) Lws[lane] = ws;
    {
        float cw[4][8]; load_cw8(F, 512 + hh * 128 + kc * 8, cw);
#pragma unroll
        for (int i = 0; i < 2; ++i) { float y[8]; conv_silu8(kraw[i], cw, 0.08838834764831845f, y);
            v4u o; o.x = cvtpk(y[0], y[1]); o.y = cvtpk(y[2], y[3]); o.z = cvtpk(y[4], y[5]); o.w = cvtpk(y[6], y[7]);
            *(LAS v4u*)(L + (kc >> 2) * 4096 + (kr0 + 32 * i) * 64 + (kc & 3) * 16) = o; }
#pragma unroll
        for (int i = 0; i < 2; ++i) { const int row = kr0 + 32 * i; const float wsr = __shfl(ws, row);
            v4u o; o.x = cvtpk(bflo(vraw[i].x) * wsr, bfhi(vraw[i].x) * wsr); o.y = cvtpk(bflo(vraw[i].y) * wsr, bfhi(vraw[i].y) * wsr); o.z = cvtpk(bflo(vraw[i].z) * wsr, bfhi(vraw[i].z) * wsr); o.w = cvtpk(bflo(vraw[i].w) * wsr, bfhi(vraw[i].w) * wsr);
            *(LAS v4u*)(L + 16384 + (kc >> 2) * 4096 + row * 64 + (kc & 3) * 16) = o; }
    }
    __syncthreads();
    f32x16 acc0, acc1;
#pragma unroll
    for (int i = 0; i < 16; ++i) { acc0[i] = 0.f; acc1[i] = 0.f; }
#pragma unroll
    for (int kk = 0; kk < 4; ++kk) { const int rows = 16 * kk + 8 * hi + qq;
        LAS unsigned char* ka = L + kbk * 4096 + rows * 64 + 32 * blk + 8 * pp; LAS unsigned char* va = L + 16384 + vb0 * 4096 + rows * 64 + 32 * blk + 8 * pp;
        const bf16x8 A = cat8(trrd(ka), trrd(ka + 4 * 64));
        acc0 = MFMA_BF16(A, cat8(trrd(va), trrd(va + 4 * 64)), acc0); acc1 = MFMA_BF16(A, cat8(trrd(va + 4096), trrd(va + 4096 + 4 * 64)), acc1); }
    {
        bf16* Cp = CST_ + ((size_t)(chain * 64 + c) * 128 + vb0 * 32 + r) * 128 + kbk * 32 + 4 * hi;
#pragma unroll
        for (int g = 0; g < 4; ++g) { u32x2 o; o.x = cvtpk(acc0[4 * g], acc0[4 * g + 1]); o.y = cvtpk(acc0[4 * g + 2], acc0[4 * g + 3]); *(GAS u32x2*)(Cp + 8 * g) = o;
            u32x2 o1; o1.x = cvtpk(acc1[4 * g], acc1[4 * g + 1]); o1.y = cvtpk(acc1[4 * g + 2], acc1[4 * g + 3]); *(GAS u32x2*)(Cp + 32 * 128 + 8 * g) = o1; }
    }
    {
        const int k = 16 * w + (lane & 15), sq = lane >> 4; float part = 0.f;
        const LAS unsigned short* kcol = (const LAS unsigned short*)(L + (k >> 5) * 4096 + (k & 31) * 2);
#pragma unroll
        for (int e = 0; e < 16; ++e) part += Lws[16 * sq + e] * __uint_as_float((unsigned)kcol[(16 * sq + e) * 32] << 16);
        part += __shfl_xor(part, 16); part += __shfl_xor(part, 32);
        if (lane < 16) NST_[(size_t)(chain * 64 + c) * 128 + k] = part;
        if (tid == 0) { SCL_[(chain * 64 + c) * 2] = a_end; SCL_[(chain * 64 + c) * 2 + 1] = m_loc; }
    }
    __syncthreads();
}
DI void ml_scan_phase(const Frame& F) {
    bf16* const CST_ = WSP(bf16, WS_CST); float* const NST_ = WSP(float, WS_NST); float* const SCL_ = WSP(float, WS_SCL); float* const MST_ = WSP(float, WS_MST);
    for (int gt = F.vcu * NTHR + F.tid; gt < 32 * 4096; gt += F.G * NTHR) {
        const int chain = gt >> 12, rem = gt & 4095;
        const float ae_l = SCL_[(chain * 64 + F.lane) * 2], ml_l = SCL_[(chain * 64 + F.lane) * 2 + 1];
        u32x2* Cp = (u32x2*)(CST_ + (size_t)chain * 64 * 16384 + (size_t)rem * 4);
        f32x4* Np = (f32x4*)(NST_ + (size_t)chain * 64 * 128 + rem * 4);
        const bool do_n = rem < 32;
        float c0 = 0.f, c1 = 0.f, c2 = 0.f, c3 = 0.f; f32x4 nn = {0.f, 0.f, 0.f, 0.f}; float m = 0.f;
        u32x2 dr[8]; f32x4 nr[8];
#pragma unroll
        for (int i = 0; i < 8; ++i) { dr[i] = Cp[(size_t)i * 4096]; if (do_n) nr[i] = Np[i * 32]; }
        for (int c0_ = 0; c0_ < 64; c0_ += 8) {
#pragma unroll
            for (int i = 0; i < 8; ++i) { const int c = c0_ + i;
                if (c < 63) {
                    const u32x2 dcur = dr[i]; const f32x4 dn = nr[i];
                    if (c + 8 < 63) { dr[i] = Cp[(size_t)(c + 8) * 4096]; if (do_n) nr[i] = Np[(c + 8) * 32]; }
                    const float ae = __builtin_bit_cast(float, __builtin_amdgcn_readlane(__builtin_bit_cast(int, ae_l), c)), ml = __builtin_bit_cast(float, __builtin_amdgcn_readlane(__builtin_bit_cast(int, ml_l), c));
                    const float mn = fmaxf(ae + m, ml), d1 = fexp(ae + m - mn), d2 = fexp(ml - mn);
                    c0 = d1 * c0 + d2 * bflo(dcur.x); c1 = d1 * c1 + d2 * bfhi(dcur.x); c2 = d1 * c2 + d2 * bflo(dcur.y); c3 = d1 * c3 + d2 * bfhi(dcur.y);
                    u32x2 o; o.x = cvtpk(c0, c1); o.y = cvtpk(c2, c3); Cp[(size_t)c * 4096] = o;
                    if (do_n) { nn = nn * d1 + dn * d2; Np[c * 32] = nn; }
                    if (rem == 0) MST_[chain * 64 + c] = mn;
                    m = mn; } }
        }
    }
}
DI void ml_out_unit(const Frame& F, int chain, int c) {
    bf16* const PROJ_ = WSP(bf16, WS_PROJ); float* const GATES_ = WSP(float, WS_GATES); float* const MST_ = WSP(float, WS_MST); bf16* const CST_ = WSP(bf16, WS_CST); float* const NST_ = WSP(float, WS_NST); bf16* const MIX_ = WSP(bf16, WS_MIX); const float* const g_out_ml_ = inp(I_GOML);
    LAS unsigned char* L = F.lds;
    LAS float* Lbs = (LAS float*)(L + 49152); LAS float* Lav = (LAS float*)(L + 49408); LAS float* Lex = (LAS float*)(L + 49664);
    const int tid = F.tid, lane = F.lane, w = F.wave, r = lane & 31, hi = lane >> 5;
    const int i16 = lane & 15, qq = i16 >> 2, pp = i16 & 3, blk = (lane >> 4) & 1;
    const int b = chain >> 2, hh = chain & 3; const size_t rowbase = (size_t)b * SEQ; const int t0 = c * 64;
    const int tb = w >> 2, vb = w & 3;
    const bf16* P = PROJ_;
    {
        const int kc = tid & 15, kr0 = tid >> 4;
#pragma unroll
        for (int which = 0; which < 2; ++which) {
            const int colbase = (which ? 512 : 0) + hh * 128 + kc * 8;
            float cw[4][8]; load_cw8(F, colbase, cw);
            const bf16* Xg = P + rowbase * NPROJ + C_QML + colbase;
#pragma unroll
            for (int i = 0; i < 2; ++i) { const int row = kr0 + 32 * i; v4u xr[4];
#pragma unroll
                for (int j = 0; j < 4; ++j) { const int tt = t0 + row - 3 + j; xr[j] = (tt >= 0) ? *(const GAS v4u*)(Xg + (size_t)tt * NPROJ) : (v4u){0u, 0u, 0u, 0u}; }
                float y[8]; conv_silu8(xr, cw, which ? 0.08838834764831845f : 1.0f, y);
                v4u o; o.x = cvtpk(y[0], y[1]); o.y = cvtpk(y[2], y[3]); o.z = cvtpk(y[4], y[5]); o.w = cvtpk(y[6], y[7]);
                *(LAS v4u*)(L + which * 16384 + row * 256 + ((kc ^ (row & 15)) * 16)) = o; }
        }
#pragma unroll
        for (int i = 0; i < 2; ++i) { const int row = kr0 + 32 * i;
            const v4u v = *(const GAS v4u*)(P + (rowbase + t0 + row) * NPROJ + C_VML + hh * 128 + kc * 8);
            *(LAS v4u*)(L + 32768 + (kc >> 2) * 4096 + row * 64 + (kc & 3) * 16) = v; }
        if (w == 0) { const float* Gg = GATES_ + (rowbase + t0 + lane) * 8; const float a = wave_scan_incl(log_sigmoid(Gg[4 + hh]), lane); Lav[lane] = a; Lbs[lane] = Gg[hh] - a; }
    }
    const float mprev = (c > 0) ? MST_[chain * 64 + c - 1] : 0.f;
    bf16x8 cf[8], nf[8];
    if (c > 0) {
        const bf16* Cp = CST_ + ((size_t)(chain * 64 + c - 1) * 128 + vb * 32 + r) * 128 + 8 * hi;
        const float* Np = NST_ + (size_t)(chain * 64 + c - 1) * 128 + 8 * hi;
        const bool nrow = (r == 0) || (r == 4);
#pragma unroll
        for (int kk = 0; kk < 8; ++kk) { cf[kk] = *(const GAS bf16x8*)(Cp + 16 * kk);
            const f32x4 n0 = *(const f32x4*)(Np + 16 * kk), n1 = *(const f32x4*)(Np + 16 * kk + 4);
            v4u o; o.x = cvtpk(n0.x, n0.y); o.y = cvtpk(n0.z, n0.w); o.z = cvtpk(n1.x, n1.y); o.w = cvtpk(n1.z, n1.w);
            if (!nrow) o = (v4u){0u, 0u, 0u, 0u};
            nf[kk] = __builtin_bit_cast(bf16x8, o); }
    }
    __syncthreads();
    bf16x8 qf[8];
    f32x16 s0, s1;
#pragma unroll
    for (int i = 0; i < 16; ++i) { s0[i] = 0.f; s1[i] = 0.f; }
#pragma unroll
    for (int kk = 0; kk < 8; ++kk) { const int ch = 2 * kk + hi; const int rq_ = 32 * tb + r;
        qf[kk] = *(const LAS bf16x8*)(L + rq_ * 256 + ((ch ^ (rq_ & 15)) * 16));
        const bf16x8 a0 = *(const LAS bf16x8*)(L + 16384 + r * 256 + ((ch ^ (r & 15)) * 16));
        const bf16x8 a1 = *(const LAS bf16x8*)(L + 16384 + (32 + r) * 256 + ((ch ^ ((32 + r) & 15)) * 16));
        s0 = MFMA_BF16(a0, qf[kk], s0); s1 = MFMA_BF16(a1, qf[kk], s1); }
    const int tl = 32 * tb + r; const float a_t = Lav[tl];
    f32x16 d0, d1; float mrow = -INFINITY;
#pragma unroll
    for (int g = 0; g < 4; ++g) { const f32x4 b0 = *(const LAS f32x4*)(Lbs + 8 * g + 4 * hi), b1 = *(const LAS f32x4*)(Lbs + 32 + 8 * g + 4 * hi);
#pragma unroll
        for (int e = 0; e < 4; ++e) { const int sl = 8 * g + 4 * hi + e;
            d0[4 * g + e] = (sl <= tl) ? a_t + b0[e] : -INFINITY; d1[4 * g + e] = (32 + sl <= tl) ? a_t + b1[e] : -INFINITY;
            mrow = fmaxf(mrow, fmaxf(d0[4 * g + e], d1[4 * g + e])); } }
    mrow = fmaxf(swap_max(mrow), a_t + mprev);
    float psum = 0.f;
#pragma unroll
    for (int i = 0; i < 16; ++i) { s0[i] *= fexp(d0[i] - mrow); s1[i] *= fexp(d1[i] - mrow); psum += s0[i] + s1[i]; }
    const float w_inter = fexp(a_t + mprev - mrow);
    float den = swap_add(psum);
    const bf16x8 P00 = packbf(s0, 0), P01 = packbf(s0, 1), P10 = packbf(s1, 0), P11 = packbf(s1, 1);
    f32x16 num;
#pragma unroll
    for (int i = 0; i < 16; ++i) num[i] = 0.f;
    {
        LAS unsigned char* vb_ = L + 32768 + vb * 4096 + (4 * hi + qq) * 64 + 32 * blk + 8 * pp;
        num = MFMA_BF16(cat8(trrd(vb_), trrd(vb_ + 8 * 64)), P00, num); num = MFMA_BF16(cat8(trrd(vb_ + 16 * 64), trrd(vb_ + 24 * 64)), P01, num);
        num = MFMA_BF16(cat8(trrd(vb_ + 32 * 64), trrd(vb_ + 40 * 64)), P10, num); num = MFMA_BF16(cat8(trrd(vb_ + 48 * 64), trrd(vb_ + 56 * 64)), P11, num);
    }
    if (c > 0) {
        f32x16 it, dn;
#pragma unroll
        for (int i = 0; i < 16; ++i) { it[i] = 0.f; dn[i] = 0.f; }
#pragma unroll
        for (int kk = 0; kk < 8; ++kk) { it = MFMA_BF16(cf[kk], qf[kk], it); dn = MFMA_BF16(nf[kk], qf[kk], dn); }
#pragma unroll
        for (int i = 0; i < 16; ++i) num[i] += w_inter * it[i];
        den += w_inter * dn[0];
    }
    const float inv = __builtin_amdgcn_rcpf(fmaxf(fabsf(den), fexp(-mrow)));
    float ss = 0.f;
#pragma unroll
    for (int i = 0; i < 16; ++i) { num[i] *= inv; ss += num[i] * num[i]; }
    ss = swap_add(ss);
    if (lane < 32) Lex[(tb * 4 + vb) * 32 + r] = ss;
    __syncthreads();
    const float tot = (Lex[(tb * 4 + 0) * 32 + r] + Lex[(tb * 4 + 1) * 32 + r]) + (Lex[(tb * 4 + 2) * 32 + r] + Lex[(tb * 4 + 3) * 32 + r]);
    const float rstd = 1.f / sqrtf(tot * (1.f / 128.f) + EPS);
    {
        const size_t trow = rowbase + t0 + tl;
        const bf16* Og = P + trow * NPROJ + C_OML + hh * 128 + vb * 32 + 4 * hi;
        bf16* Mp = MIX_ + trow * D + 512 + hh * 128 + vb * 32 + 4 * hi;
        const float* go = g_out_ml_ + hh * 128 + vb * 32 + 4 * hi;
#pragma unroll
        for (int g = 0; g < 4; ++g) { const u32x2 og = *(const GAS u32x2*)(Og + 8 * g); const f32x4 gg = *(const f32x4*)(go + 8 * g);
            const float o0 = bflo(og.x), o1 = bfhi(og.x), o2 = bflo(og.y), o3 = bfhi(og.y);
            u32x2 o; o.x = cvtpk(num[4 * g] * rstd * gg.x * __builtin_amdgcn_rcpf(1.f + fexp(-o0)), num[4 * g + 1] * rstd * gg.y * __builtin_amdgcn_rcpf(1.f + fexp(-o1)));
            o.y = cvtpk(num[4 * g + 2] * rstd * gg.z * __builtin_amdgcn_rcpf(1.f + fexp(-o2)), num[4 * g + 3] * rstd * gg.w * __builtin_amdgcn_rcpf(1.f + fexp(-o3)));
            *(GAS u32x2*)(Mp + 8 * g) = o; }
    }
    __syncthreads();
}

#define TK_CE(A, B) do { const float hi_ = fmaxf((A), (B)), lo_ = fminf((A), (B)); (A) = hi_; (B) = lo_; } while (0)
DI void tk_sort16(float (&a)[16]) {
#pragma unroll
    for (int k = 2; k <= 16; k <<= 1)
#pragma unroll
        for (int j = k >> 1; j > 0; j >>= 1)
#pragma unroll
            for (int i = 0; i < 16; ++i) { const int l = i ^ j; if (l > i) { if ((i & k) == 0) TK_CE(a[i], a[l]); else TK_CE(a[l], a[i]); } }
}
DI void tk_merge16(float (&a)[16], const float (&b)[16]) {
#pragma unroll
    for (int i = 0; i < 16; ++i) a[i] = fmaxf(a[i], b[15 - i]);
#pragma unroll
    for (int j = 8; j > 0; j >>= 1)
#pragma unroll
        for (int i = 0; i < 16; ++i) { const int l = i ^ j; if (l > i) TK_CE(a[i], a[l]); }
}
DI void tk_stage2(const LAS float* la, const LAS float* lb, int* IDX_, float* GATEW_, size_t o) {
        float a[16], bb[16], cnd[64];
#pragma unroll
        for (int q = 0; q < 16; ++q) { a[q] = la[q]; bb[q] = lb[q]; }
        int cnt = 0;
#pragma unroll
        for (int i = 0; i < 16; ++i)
#pragma unroll
            for (int j = 0; j < 16; ++j) if ((i + 1) * (j + 1) <= 16) { cnd[cnt] = __uint_as_float((__float_as_uint(a[i] + bb[j]) & ~0xFFu) | (unsigned)(i * 16 + j)); ++cnt; }
#pragma unroll
        for (int q = 50; q < 64; ++q) cnd[q] = -INFINITY;
        float top[16];
#pragma unroll
        for (int c = 0; c < 4; ++c) { float ch[16];
#pragma unroll
            for (int q = 0; q < 16; ++q) ch[q] = cnd[16 * c + q];
            tk_sort16(ch);
            if (c == 0) {
#pragma unroll
                for (int q = 0; q < 16; ++q) top[q] = ch[q];
            } else tk_merge16(top, ch); }
        float sv[16]; int ei[16]; float mx = -INFINITY;
#pragma unroll
        for (int q = 0; q < 16; ++q) { const unsigned code = __float_as_uint(top[q]) & 0xFFu; const float va = la[code >> 4], vb = lb[code & 15u];
            ei[q] = (int)((__float_as_uint(va) & 0x7Fu) * 128u + (__float_as_uint(vb) & 0x7Fu)); sv[q] = va + vb; mx = fmaxf(mx, sv[q]); }
        float sum = 0.f;
#pragma unroll
        for (int q = 0; q < 16; ++q) { sv[q] = fexp(sv[q] - mx); sum += sv[q]; }
        const float inv = 1.f / sum;
#pragma unroll
#define TK_PK(Q) (((__builtin_bit_cast(unsigned, sv[(Q)] * inv) + 0x2000u) & 0xFFFFC000u) | (unsigned)ei[(Q)])
        for (int q = 0; q < 16; q += 4) *(GAS v4u*)(IDX_ + o + q) = (v4u){TK_PK(q), TK_PK(q + 1), TK_PK(q + 2), TK_PK(q + 3)};
#undef TK_PK
        (void)GATEW_;
    }
struct EpiTopK {
    static constexpr bool PERM = false, AFTER_DRAIN = true;
    int* IDX; float* GATEW;
    DI void fused(f32x4 (&acc)[2][2][4][2], const pg8::Unit& u, int wr, int wc, int fr, int fq, LAS unsigned char* lds, int wid, int lane) const {
        LAS float* Tl = (LAS float*)lds;
        LAS float* Lh2 = (LAS float*)lds;
        LAS float* Ls = (LAS float*)(lds + 36864);
        const int tid = wid * 64 + lane, tl = tid & 127, p = (tid >> 7) & 1, half = tid >> 8;
#pragma unroll
        for (int ai = 0; ai < 2; ++ai) {
#pragma unroll
            for (int bj = 0; bj < 2; ++bj)
#pragma unroll
                for (int m = 0; m < 4; ++m)
#pragma unroll
                    for (int n = 0; n < 2; ++n) { LAS float* d = Tl + (wr * 64 + m * 16 + fr) * 257 + bj * 128 + wc * 32 + n * 16 + fq * 4; const f32x4 v = acc[ai][bj][m][n]; d[0] = v.x; d[1] = v.y; d[2] = v.z; d[3] = v.w; }
            __syncthreads();
            float run[16];
            {
                const LAS float* src = Tl + tl * 257 + p * 128 + half * 64;
#pragma unroll
                for (int c = 0; c < 4; ++c) { float ch[16];
#pragma unroll
                    for (int q = 0; q < 16; ++q) ch[q] = __uint_as_float((__float_as_uint(src[16 * c + q]) & ~0x7Fu) | (unsigned)(half * 64 + 16 * c + q));
                    tk_sort16(ch);
                    if (c == 0) {
#pragma unroll
                        for (int q = 0; q < 16; ++q) run[q] = ch[q];
                    } else tk_merge16(run, ch); }
            }
            __syncthreads();
#pragma unroll
            for (int q = 0; q < 16; ++q) Lh2[((tl * 2 + p) * 2 + half) * 17 + q] = run[q];
            __syncthreads();
            if (half == 0) { float oth[16];
#pragma unroll
                for (int q = 0; q < 16; ++q) oth[q] = Lh2[((tl * 2 + p) * 2 + 1) * 17 + q];
                tk_merge16(run, oth);
#pragma unroll
                for (int q = 0; q < 16; ++q) Ls[(tl * 2 + p) * 17 + q] = run[q]; }
            __syncthreads();
            if (tid < 128) tk_stage2(Ls + (tl * 2) * 17, Ls + (tl * 2) * 17 + 17, IDX, GATEW, (size_t)(u.pm * 256 + ai * 128 + tl) * 128 + u.pn * 16);
            __syncthreads();
        }
    }
};
struct OneUnit {
    pg8::Unit u;
    __device__ __forceinline__ bool next(int i, pg8::Unit& o) const { if (i) return false; o = u; return true; }
    __device__ __forceinline__ void a_ready(const pg8::Unit&) const {}
    __device__ __forceinline__ void done(const pg8::Unit&) const {}
};

DI float gelu_erf(float x) { return 0.5f * x * (1.f + erff(x * 0.7071067811865476f)); }
#define DPP_ADD(v, ctrl, rmask) ((v) + __builtin_bit_cast(float, __builtin_amdgcn_update_dpp(0, __builtin_bit_cast(int, (v)), (ctrl), (rmask), 0xF, false)))
#ifndef PEER_EBL
#define PEER_EBL 9
#endif
constexpr int PEER_EB_LOG = PEER_EBL;
#ifndef PEER_PROBE_MASK
#define PEER_PROBE_MASK 0xFFFF
#endif
typedef float f32x2v __attribute__((ext_vector_type(2)));
DI float gelu_cdf(float v) {
    const float av = fabsf(v), t = __builtin_amdgcn_rcpf(av * 0.2316418882f + 1.0f);
    float q = t * 0.5307027145f - 0.7265760135f; q = q * t + 0.7107068705f; q = q * t - 0.142248368f; q = q * t + 0.127414796f; q = q * t;
    const float m = v * (q * ex2(v * v * -0.72134752044f));
    return v < 0.f ? m : v - m;
}
#define DPP_ADDI(v, ctrl, rmask) ((v) + __builtin_amdgcn_update_dpp(0, (v), (ctrl), (rmask), 0xF, false))
DI void peer_phase(const Frame& F, bool scratch_dst) {
    bf16* const XN_ = WSP(bf16, WS_XN); int* const IDX_ = WSP(int, WS_IDX); float* const GATEW_ = WSP(float, WS_GATE); float* const mod_ = WSP(float, WS_MOD); float* const out_ = (float*)inp(I_OUT); const bf16* const X1B_ = WSP(bf16, WS_X1B);
    const unsigned char* const EU4 = WSP(unsigned char, WS_EXPU); const unsigned char* const EV4 = WSP(unsigned char, WS_EXPV); const float* const SUI_ = WSP(float, WS_SUI); const float* const SVI_ = WSP(float, WS_SVI);
    const int gw = F.vcu * NWAVES + F.wave, NGW = F.G * NWAVES, lane = F.lane, g = lane >> 3, j = lane & 7;
    LAS unsigned char* wl = F.lds + F.wave * 17408;
    volatile LAS int* Le = (volatile LAS int*)(wl + g * 512); volatile LAS float* Lg = (volatile LAS float*)(wl + 4096 + g * 512); volatile LAS int* Lp = (volatile LAS int*)(wl + 8192 + g * 512);
    volatile LAS int* Lx = (volatile LAS int*)(wl + 12288 + g * 512); LAS int* Lh = (LAS int*)(wl + 16384 + g * 128);
    for (int grp = gw; grp < T / 8; grp += NGW) {
        const size_t t = (size_t)grp * 8 + g;
        int xh[16], xl[16]; float sxi;
#ifdef PEER_DUP_S
        auto qs_ = [&]() __attribute__((always_inline)) {
#endif
        {
            const unsigned char* xq = WSP(unsigned char, WS_XQ) + t * 1024 + 16 * j;
#pragma unroll
            for (int q = 0; q < 4; ++q) { const v4u a = *(const GAS v4u*)(xq + 128 * q), b = *(const GAS v4u*)(xq + 512 + 128 * q);
#pragma unroll
                for (int w_ = 0; w_ < 4; ++w_) { xh[4 * q + w_] = (int)a[w_]; xl[4 * q + w_] = (int)b[w_]; } }
            sxi = WSP(float, WS_XS)[t];
        }
        {
            int ide[16]; float gte[16]; int rk[16];
#pragma unroll
            for (int m = 0; m < 16; ++m) { const unsigned pk_ = (unsigned)IDX_[t * 128 + j + 8 * m]; ide[m] = (int)(pk_ & 0x3FFFu); gte[m] = __builtin_bit_cast(float, pk_ & 0xFFFFC000u); }
#pragma unroll
            for (int m = 0; m < 4; ++m) Lh[j + 8 * m] = 0;
#pragma unroll
            for (int m = 0; m < 16; ++m) rk[m] = __hip_atomic_fetch_add(Lh + (ide[m] >> PEER_EB_LOG), 1, __ATOMIC_RELAXED, __HIP_MEMORY_SCOPE_WORKGROUP);
            {
                const int h0 = ((volatile LAS int*)Lh)[4 * j], h1 = ((volatile LAS int*)Lh)[4 * j + 1], h2 = ((volatile LAS int*)Lh)[4 * j + 2], h3 = ((volatile LAS int*)Lh)[4 * j + 3];
                const int tot = (h0 + h1) + (h2 + h3); int inc = tot;
#pragma unroll
                for (int o = 1; o < 8; o <<= 1) { const int tt = __shfl_up(inc, o, 8); if (j >= o) inc += tt; }
                const int ex = inc - tot;
                ((volatile LAS int*)Lh)[4 * j] = ex; ((volatile LAS int*)Lh)[4 * j + 1] = ex + h0; ((volatile LAS int*)Lh)[4 * j + 2] = ex + h0 + h1; ((volatile LAS int*)Lh)[4 * j + 3] = ex + h0 + h1 + h2;
            }
#pragma unroll
            for (int m = 0; m < 16; ++m) { const int pos = ((volatile LAS int*)Lh)[ide[m] >> PEER_EB_LOG] + rk[m]; Le[pos] = ide[m]; Lg[pos] = gte[m] * SVI_[ide[m]]; Lp[pos] = __builtin_bit_cast(int, SUI_[ide[m]] * sxi); }
        }
#ifdef PEER_DUP_S
        }; qs_(); __builtin_amdgcn_sched_barrier(0); qs_();
#endif
        v4u R0[4], R1[4], R2[4], R3[4];
#define PEER_LOADU(RR, S0) do { const size_t ro_ = (size_t)(Le[(S0)] & (scratch_dst ? PEER_PROBE_MASK : 0xFFFF)) * 512 + 16 * j; _Pragma("unroll") for (int q = 0; q < 4; ++q) RR[q] = *(const GAS v4u*)(EU4 + ro_ + 128 * q); } while (0)
#define PEER_DOTU(RR, EOUT) do { int h0_ = 0, h1_ = 0, l0_ = 0, l1_ = 0; \
            _Pragma("unroll") for (int q = 0; q < 4; q += 2) _Pragma("unroll") for (int w_ = 0; w_ < 4; ++w_) { \
                h0_ = __builtin_amdgcn_sdot8((int)RR[q][w_], xh[4 * q + w_], h0_, false); l0_ = __builtin_amdgcn_sdot8((int)RR[q][w_], xl[4 * q + w_], l0_, false); \
                h1_ = __builtin_amdgcn_sdot8((int)RR[q + 1][w_], xh[4 * q + 4 + w_], h1_, false); l1_ = __builtin_amdgcn_sdot8((int)RR[q + 1][w_], xl[4 * q + 4 + w_], l1_, false); } \
            int e_ = ((h0_ + h1_) << 4) + (l0_ + l1_); e_ = DPP_ADDI(e_, 0xB1, 0xF); e_ = DPP_ADDI(e_, 0x4E, 0xF); e_ = DPP_ADDI(e_, 0x141, 0xF); EOUT = e_; } while (0)
#define PEER_SWEEPU(BODY0, BODY1, BODY2, BODY3) do { \
            PEER_LOADU(R0, 0); PEER_LOADU(R1, 1); PEER_LOADU(R2, 2); PEER_LOADU(R3, 3); \
            for (int s = 0; s < 128; s += 4) { \
                BODY0; if (s + 4 < 128) PEER_LOADU(R0, s + 4); \
                BODY1; if (s + 4 < 128) PEER_LOADU(R1, s + 5); \
                BODY2; if (s + 4 < 128) PEER_LOADU(R2, s + 6); \
                BODY3; if (s + 4 < 128) PEER_LOADU(R3, s + 7); } } while (0)
#define PEER_FIN(RR, SS) do { int e1_; PEER_DOTU(RR, e1_); Lx[(SS)] = e1_; } while (0)
        PEER_SWEEPU(PEER_FIN(R0, s), PEER_FIN(R1, s + 1), PEER_FIN(R2, s + 2), PEER_FIN(R3, s + 3));
#ifdef PEER_DUP_U
        PEER_SWEEPU(PEER_FIN(R0, s), PEER_FIN(R1, s + 1), PEER_FIN(R2, s + 2), PEER_FIN(R3, s + 3));
#endif
#undef PEER_FIN
        float yscale; int csum8;
        {
            float cf_[16]; float cmax = 0.f;
#pragma unroll
            for (int i = 0; i < 16; ++i) { const int ix = 16 * j + i; cf_[i] = Lg[ix] * gelu_cdf((float)Lx[ix] * __builtin_bit_cast(float, Lp[ix])); cmax = fmaxf(cmax, fabsf(cf_[i])); }
            cmax = fmaxf(cmax, __shfl_xor(cmax, 1, 8)); cmax = fmaxf(cmax, __shfl_xor(cmax, 2, 8)); cmax = fmaxf(cmax, __shfl_xor(cmax, 4, 8));
            const float cqs = cmax > 0.f ? 127.f / cmax : 0.f; yscale = cmax > 0.f ? cmax / 127.f : 0.f;
            int pk_[4]; int cs_ = 0;
#pragma unroll
            for (int m = 0; m < 4; ++m) { const int q0 = (int)rintf(cf_[4 * m] * cqs), q1 = (int)rintf(cf_[4 * m + 1] * cqs), q2 = (int)rintf(cf_[4 * m + 2] * cqs), q3 = (int)rintf(cf_[4 * m + 3] * cqs);
                cs_ += (q0 + q1) + (q2 + q3);
                pk_[m] = (int)((unsigned)(q0 & 0xff) | ((unsigned)(q1 & 0xff) << 8) | ((unsigned)(q2 & 0xff) << 16) | ((unsigned)q3 << 24)); }
            cs_ += __shfl_xor(cs_, 1, 8); cs_ += __shfl_xor(cs_, 2, 8); cs_ += __shfl_xor(cs_, 4, 8); csum8 = 8 * cs_;
#pragma unroll
            for (int m = 0; m < 4; ++m) Lp[4 * j + m] = pk_[m];
        }
#ifndef PEER_DUP_V
#define PEER_DUP_V 1
#endif
#pragma unroll
        for (int HH = 0; HH < 2 * PEER_DUP_V; ++HH) { const int H = HH & 1;
            int ya[32], yl[32];
#pragma unroll
            for (int i = 0; i < 32; ++i) { ya[i] = 0; yl[i] = 0; }
            v4u RV[8][2];
#define PEER_ROFFV(S0) ((size_t)(Le[(S0)] & (scratch_dst ? PEER_PROBE_MASK : 0xFFFF)) * 512 + 256 * H + 16 * j)
#pragma unroll
            for (int r = 0; r < 8; ++r) { const size_t ro_ = PEER_ROFFV(r); RV[r][0] = *(const GAS v4u*)(EV4 + ro_); RV[r][1] = *(const GAS v4u*)(EV4 + ro_ + 128); }
            for (int bt = 0; bt < 16; ++bt) {
                const int c0_ = Lp[2 * bt], c1_ = Lp[2 * bt + 1];
                size_t ron[8];
#pragma unroll
                for (int r = 0; r < 8; ++r) ron[r] = (bt + 1 < 16) ? PEER_ROFFV(8 * bt + 8 + r) : 0;
#pragma unroll
                for (int q = 0; q < 2; ++q) {
#pragma unroll
                    for (int hb = 0; hb < 2; ++hb) { const int cq_ = hb ? c1_ : c0_;
#pragma unroll
                        for (int w_ = 0; w_ < 4; ++w_) { const unsigned a0 = RV[4 * hb][q][w_], a1 = RV[4 * hb + 1][q][w_], a2 = RV[4 * hb + 2][q][w_], a3 = RV[4 * hb + 3][q][w_];
                            const unsigned p0 = __builtin_amdgcn_perm(a1, a0, 0x05010400u), p1 = __builtin_amdgcn_perm(a1, a0, 0x07030602u), p2 = __builtin_amdgcn_perm(a3, a2, 0x05010400u), p3 = __builtin_amdgcn_perm(a3, a2, 0x07030602u);
                            unsigned Tb[4]; Tb[0] = __builtin_amdgcn_perm(p2, p0, 0x05040100u); Tb[1] = __builtin_amdgcn_perm(p2, p0, 0x07060302u); Tb[2] = __builtin_amdgcn_perm(p3, p1, 0x05040100u); Tb[3] = __builtin_amdgcn_perm(p3, p1, 0x07060302u);
#pragma unroll
                            for (int b_ = 0; b_ < 4; ++b_) { ya[16 * q + 4 * w_ + b_] = __builtin_amdgcn_sdot4((int)Tb[b_], cq_, ya[16 * q + 4 * w_ + b_], false);
                                yl[16 * q + 4 * w_ + b_] = __builtin_amdgcn_sdot4((int)(Tb[b_] & 0x0F0F0F0Fu), cq_, yl[16 * q + 4 * w_ + b_], false); } } }
                    if (bt + 1 < 16) {
#pragma unroll
                        for (int r = 0; r < 8; ++r) RV[r][q] = *(const GAS v4u*)(EV4 + ron[r] + 128 * q); }
                }
            }
#undef PEER_ROFFV
            int to_ = grp * 8 + g, jo_ = j; asm volatile("" : "+v"(to_), "+v"(jo_));
            const int b = to_ / SEQ; const unsigned eo_ = (unsigned)to_ * D + 128 * H + 8 * jo_;
            const float* g2 = mod_ + b * NMOD + 5120 + 128 * H + 8 * jo_;
            const bf16* ip = X1B_ + eo_; float* op = ((scratch_dst || HH + 2 < 2 * PEER_DUP_V) ? WSP(float, WS_SCORES) : out_) + eo_;
#pragma unroll
            for (int q = 0; q < 2; ++q) { __builtin_amdgcn_sched_barrier(0);
#pragma unroll
                for (int w_ = 0; w_ < 4; ++w_)
#pragma unroll
                    for (int nh = 0; nh < 2; ++nh) { const int co = 256 * (2 * (w_ & 1) + nh) + 64 * q + 4 * (w_ >> 1); const int yb = 16 * q + 4 * w_ + 2 * nh;
                        const unsigned long long xw_ = *(const GAS unsigned long long*)(ip + co); const unsigned xlo_ = (unsigned)xw_, xhi_ = (unsigned)(xw_ >> 32); const f32x4 x1 = (f32x4){bflo(xlo_), bfhi(xlo_), bflo(xhi_), bfhi(xhi_)}; const f32x4 gg = *(const f32x4*)(g2 + co) * yscale;
                        f32x4 o; o.x = x1.x + gg.x * (float)(yl[yb] - csum8); o.y = x1.y + gg.y * (float)((ya[yb] - yl[yb]) >> 4); o.z = x1.z + gg.z * (float)(yl[yb + 1] - csum8); o.w = x1.w + gg.w * (float)((ya[yb + 1] - yl[yb + 1]) >> 4);
                        *(GAS f32x4*)(op + co) = o; } }
        }
#undef PEER_LOADU
#undef PEER_DOTU
#undef PEER_SWEEPU
    }
}

DI void ph_inproj(const Frame& F) {
    pg8::Gemm g{WSP(bf16, WS_XN), WSP(bf16, WS_WIN), T, NPROJ, D}; pg8::StaticOrder S; S.init(T, NPROJ, F.G, (int)blockIdx.x);
    pg8::EpiBf16<0> E{WSP(bf16, WS_PROJ), NPROJ, nullptr, 0, 0, 1.f};
    pg8::gemm_phase<pg8::EpiBf16<0>, pg8::StaticOrder, PG8_ALIGN, PG8_SP2>(F.lds, g, S, E);
}
DI void ph_mix(const Frame& F, bool probe_first) {
    stage_conv_w(F);
    {
        int u = F.vcu;
        MlLocalRegs ra;
        if (u < 2048) ml_local_load(F, u >> 6, u & 63, ra);
        const int gwv = F.vcu * NWAVES + F.wave, NGWv = F.G * NWAVES;
        int eb = 2 * gwv;
        while (u < 2048) {
            const int un = u + F.G;
            MlLocalRegs rb;
            if (un < 2048) ml_local_load(F, un >> 6, un & 63, rb);
            ExpRows2 er; const bool ew = eb < 32768;
            if (ew) exp_load2(F, eb, er);
            ml_local_unit(F, u >> 6, u & 63, ra);
            if (ew) exp_conv2(F, eb, er);
            eb += 2 * NGWv;
            ra = rb; u = un;
        }
        for (; eb < 32768; eb += 2 * NGWv) { ExpRows2 er; exp_load2(F, eb, er); exp_conv2(F, eb, er); }
    }
    (void)probe_first;
}
DI void ph_scan_attn(const Frame& F) {
    ml_scan_phase(F);
    __syncthreads();
    for (int u = F.vcu; u < 1024; u += F.G) { const int qb = 15 - (u >> 6), bh = u & 63; sb_unit(F, bh >> 3, bh & 7, qb); }
}
DI void ph_mlout(const Frame& F) { stage_conv_w(F); for (int u = F.vcu; u < 2048; u += F.G) ml_out_unit(F, u >> 6, u & 63); }
#ifndef P5_ALIGN
#define P5_ALIGN PG8_ALIGN
#endif
DI void ph_outproj(const Frame& F) {
    pg8::Gemm g{WSP(bf16, WS_MIX), WSP(bf16, WS_WOUT), T, D, D}; pg8::StaticOrder S; S.init(T, D, F.G, (int)blockIdx.x);
    pg8::EpiResGateBf16 E{inp(I_X), WSP(pg8::bf16_t, WS_X1B), WSP(float, WS_MOD) + 2048, NMOD, SEQ, D};
    pg8::gemm_phase<pg8::EpiResGateBf16, pg8::StaticOrder, P5_ALIGN, PG8_SP2>(F.lds, g, S, E);
}
DI void ph_scores(const Frame& F) {
    pg8::Gemm g{WSP(bf16, WS_XN), WSP(bf16, WS_WEFF), T, NSC, D}; pg8::StaticOrder S; S.init(T, NSC, F.G, (int)blockIdx.x);
    EpiTopK E{WSP(int, WS_IDX), WSP(float, WS_GATE)};
    pg8::Unit un;
    for (int i = 0; S.next(i, un); ++i) { OneUnit S1{un}; pg8::gemm_phase<EpiTopK, OneUnit, false, PG8_SP2>(F.lds, g, S1, E); }
}
constexpr int N_PHASES = 11;
struct Args { const float* in[19]; float* out; unsigned char* ws; int ph_lo, ph_hi; };
__global__ void __launch_bounds__(NTHR, 2) hybrid_fwd(Args args) {
    extern __shared__ __attribute__((aligned(16))) unsigned char lds_raw[];
    Frame F;
    F.lds = (LAS unsigned char*)lds_raw;
    F.MISC = (volatile LAS unsigned*)(F.lds + LDSCTL_OFF + 320);
    F.tid = threadIdx.x; F.lane = F.tid & 63; F.wave = __builtin_amdgcn_readfirstlane(F.tid >> 6);
    F.G = gridDim.x; { const int bx = blockIdx.x; F.vcu = (F.G % 8 == 0) ? (bx % 8) * (F.G / 8) + bx / 8 : bx; }
    F.ws = args.ws;
    F.ctl = (gu32*)(F.ws + WS_CTL);
    for (int u = F.tid; u < (LDS_BYTES - LDSCTL_OFF) / 4; u += NTHR) ((LAS unsigned*)(F.lds + LDSCTL_OFF))[u] = 0u;
    __syncthreads();
    const int lo = args.ph_lo, hi = args.ph_hi;
    const bool one_launch = (hi - lo) > 1;
    XcdBarrier bar; bar.bar = (unsigned*)(F.ctl + CW_BAR); bar.x = 0; bar.st = nullptr;
    if (one_launch) bar = xcd_barrier_post((unsigned*)(F.ctl + CW_BAR), F.MISC + 8);
#ifndef PHMASK
#define PHMASK 0x7ff
#endif
#define IN(k) (((PHMASK >> (k)) & 1) && lo <= (k) && (k) < hi)
#define SEAM(k) do { if (IN(k) && IN((k) + 1)) xcd_barrier(bar); } while (0)
#ifndef REPMASK
#define REPMASK 0
#endif

#define RUN(k, ...) do { if (IN(k)) { if ((REPMASK >> (k)) & 1) { { const bool first = true; (void)first; __VA_ARGS__; } xcd_barrier(bar); } { const bool first = false; (void)first; __VA_ARGS__; } } } while (0)
    RUN(0, p0_phase(F, first ? P0_PARTS : 15)); SEAM(0);
    RUN(1, norm_phase<true>(F, inp(I_X), inp(I_GN1), 0, 1024)); SEAM(1);
    RUN(2, ph_inproj(F)); SEAM(2);
    RUN(3, ph_mix(F, first)); SEAM(3);
    RUN(10, ph_scan_attn(F)); if (IN(10) && IN(4)) xcd_barrier(bar);
    RUN(4, ph_mlout(F)); SEAM(4);
    RUN(5, ph_outproj(F)); SEAM(5);
    RUN(6, norm_phase<false, true>(F, (const float*)WSP(bf16, WS_X1B), inp(I_GN2), 3072, 4096)); SEAM(6);
    RUN(7, ph_scores(F)); if (IN(7) && IN(9)) xcd_barrier(bar);
    RUN(9, peer_phase(F, first));
#undef RUN
#undef IN
#undef SEAM
}

#ifndef MK_PER_PHASE
#define MK_PER_PHASE 0
#endif
extern "C" void kernel_launch(void* const* d_in, const int* in_sizes, int n_in, void* d_out, int out_size, void* d_ws, size_t ws_size, hipStream_t stream) {
    static int grid = 0;
    if (grid == 0) {
        if (n_in != 19 || in_sizes[0] != T * D || out_size != T * D || ws_size < WS_END) { fprintf(stderr, "kernel_launch: unexpected shapes (n_in %d, in0 %d, out %d, ws %zu)\n", n_in, n_in > 0 ? in_sizes[0] : -1, out_size, ws_size); grid = -1; return; }
        int dev = 0, cus = 0, per_cu = 0;
        if (hipGetDevice(&dev) != hipSuccess || hipDeviceGetAttribute(&cus, hipDeviceAttributeMultiprocessorCount, dev) != hipSuccess) { grid = -1; return; }
        if (hipFuncSetAttribute((const void*)hybrid_fwd, hipFuncAttributeMaxDynamicSharedMemorySize, LDS_BYTES) != hipSuccess) { fprintf(stderr, "kernel_launch: hipFuncSetAttribute failed\n"); grid = -1; return; }
        if (hipOccupancyMaxActiveBlocksPerMultiprocessor(&per_cu, (const void*)hybrid_fwd, NTHR, LDS_BYTES) != hipSuccess || per_cu < 1) fprintf(stderr, "kernel_launch: occupancy query says %d\n", per_cu);
        (void)hipGetLastError();
        grid = cus;
    }
    if (grid < 0) return;
    if (hipMemsetAsync((char*)d_ws + WS_CTL, 0, CTL_ZERO_BYTES, stream) != hipSuccess) { fprintf(stderr, "kernel_launch: memset failed\n"); return; }
    Args a{};
    for (int i = 0; i < 19; ++i) a.in[i] = (const float*)d_in[i];
    a.out = (float*)d_out; a.ws = (unsigned char*)d_ws;
#if MK_PER_PHASE
    { const int order[N_PHASES] = {0, 1, 2, 3, 10, 4, 5, 6, 7, 8, 9}; for (int i = 0; i < N_PHASES; ++i) { a.ph_lo = order[i]; a.ph_hi = order[i] + 1; hipLaunchKernelGGL(hybrid_fwd, dim3(grid), dim3(NTHR), LDS_BYTES, stream, a); } }
#else
    a.ph_lo = 0; a.ph_hi = N_PHASES;
    hipLaunchKernelGGL(hybrid_fwd, dim3(grid), dim3(NTHR), LDS_BYTES, stream, a);
#endif
    const hipError_t le = hipPeekAtLastError();
    if (le != hipSuccess) fprintf(stderr, "kernel_launch: launch failed: %s\n", hipGetErrorName(le));
}
```

```cpp
#include <cmath>
#include <hip/hip_runtime.h>
#include <cstdio>
#include <cstdint>
namespace pg8 {
#define PG8_LAS __attribute__((address_space(3)))
typedef unsigned short bf16_t;
typedef short bf16x8 __attribute__((ext_vector_type(8)));
typedef float f32x4 __attribute__((ext_vector_type(4)));
typedef unsigned u32x4 __attribute__((ext_vector_type(4)));
constexpr int BM = 256, BK = 64, HALF = 128, HTB = HALF * BK * 2  , STAGE_BYTES = 8 * HTB, NXCD = 8,
#ifndef PG8_WGM
#define PG8_WGM 4
#endif
WGM = PG8_WGM;

__host__ __device__ __forceinline__ int lds_byte(int r, int c) { const int st = (r >> 4) * 2 + (c >> 5), rr = r & 15, cc = c & 31, ob = rr * 64 + cc * 2; return st * 1024 + (ob ^ (((ob >> 9) & 1) << 5)); }
__host__ __device__ __forceinline__ void stage_rc(int b, int& R, int& C) { const int st = b / 1024, sb = b % 1024, swz = sb ^ (((sb >> 9) & 1) << 5); R = (st >> 1) * 16 + swz / 64; C = (st & 1) * 32 + (swz % 64) / 2; }
__host__ __device__ __forceinline__ int perm32(int rho) { const int n = rho >> 4, i = rho & 15; return 8 * (i >> 2) + 4 * n + (i & 3); }

struct Unit { int pm, pn; };
struct Gemm { const bf16_t* A; const bf16_t* Bt; int M, N, K; };

struct StaticOrder {
    int nM, nN, nwg, G, c;
    __host__ __device__ void init(int M, int N, int G_, int c_) { nM = M / BM; nN = N / BM; nwg = nM * nN; G = G_; c = c_; }
    __host__ __device__ bool next(int i, Unit& u) const {
        const long L = (long)i * G + c; if (L >= nwg) return false;
        int wgid = (int)L; { const int q = nwg / NXCD, r = nwg % NXCD, xcd = wgid % NXCD, off = wgid / NXCD; wgid = (xcd < r ? xcd * (q + 1) : r * (q + 1) + (xcd - r) * q) + off; }
        const int nig = WGM * nN, gid = wgid / nig, fm = gid * WGM, gsz = (nM - fm) < WGM ? (nM - fm) : WGM;
        u.pm = fm + ((wgid % nig) % gsz); u.pn = (wgid % nig) / gsz; return true;
    }
    __device__ __forceinline__ void a_ready(const Unit&) const {}
    __device__ __forceinline__ void done(const Unit&) const {}
};

__device__ __forceinline__ unsigned cvt_pk_bf16(float lo, float hi) { unsigned r; asm volatile("v_cvt_pk_bf16_f32 %0, %1, %2" : "=v"(r) : "v"(lo), "v"(hi)); return r; }
typedef float f32x2 __attribute__((ext_vector_type(2)));
__device__ __forceinline__ f32x2 gelu_pk(f32x2 v) {
    const f32x2 av = __builtin_elementwise_abs(v), d = av * 0.2316418882f + 1.0f;
    f32x2 t; t.x = __builtin_amdgcn_rcpf(d.x); t.y = __builtin_amdgcn_rcpf(d.y);
    f32x2 q = t * 0.5307027145f + (-0.7265760135f); q = q * t + 0.7107068705f; q = q * t + (-0.142248368f); q = q * t + 0.127414796f; q = q * t;
    const f32x2 s = (v * v) * (-0.72134752044f);
    f32x2 e; e.x = __builtin_amdgcn_exp2f(s.x); e.y = __builtin_amdgcn_exp2f(s.y);
    const f32x2 m = v * (q * e), r = v - m;
    f32x2 o; o.x = v.x < 0.f ? m.x : r.x; o.y = v.y < 0.f ? m.y : r.y; return o;
}

template <int ACT  > struct EpiBf16 {
    static constexpr bool PERM = true, AFTER_DRAIN = false; static_assert(ACT == 0 || ACT == 1, "EpiBf16: ACT is 0 (none) or 1 (gelu_pk)");
    bf16_t* O; int ldc; const float* bias; int split_cols; size_t split_stride; float scale0;
    __device__ __forceinline__ void operator()(const f32x4 (&acc)[2][2][4][2], const Unit& u, int wr, int wc, int fr, int fq) const {
        const int row0 = u.pm * BM + wr * 64 + fr; int colt = u.pn * BM; bf16_t* base = O;
        float sc = 1.f; if (split_cols) { const int t = colt / split_cols; base += (size_t)t * split_stride; colt -= t * split_cols; if (t == 0) sc = scale0; }
        const int col0 = colt + wc * 32 + 8 * fq, bcol0 = u.pn * BM + wc * 32 + 8 * fq;
        f32x4 bv[2][2];
#pragma unroll
        for (int bj = 0; bj < 2; ++bj)
#pragma unroll
            for (int n = 0; n < 2; ++n) bv[bj][n] = bias ? *(const f32x4*)(bias + bcol0 + bj * HALF + 4 * n) : (f32x4){0.f, 0.f, 0.f, 0.f};
#pragma unroll
        for (int ai = 0; ai < 2; ++ai)
#pragma unroll
            for (int m = 0; m < 4; ++m) { bf16_t* rowp = base + (size_t)(row0 + ai * HALF + m * 16) * ldc + col0;
#pragma unroll
                for (int bj = 0; bj < 2; ++bj) { f32x4 v0 = acc[ai][bj][m][0] + bv[bj][0], v1 = acc[ai][bj][m][1] + bv[bj][1];
                    if (ACT == 1) { f32x2 a = gelu_pk((f32x2){v0[0], v0[1]}), b = gelu_pk((f32x2){v0[2], v0[3]}), c = gelu_pk((f32x2){v1[0], v1[1]}), d = gelu_pk((f32x2){v1[2], v1[3]});
                        v0 = (f32x4){a.x, a.y, b.x, b.y}; v1 = (f32x4){c.x, c.y, d.x, d.y}; }
                    v0 = v0 * sc; v1 = v1 * sc; u32x4 w; w.x = cvt_pk_bf16(v0[0], v0[1]); w.y = cvt_pk_bf16(v0[2], v0[3]); w.z = cvt_pk_bf16(v1[0], v1[1]); w.w = cvt_pk_bf16(v1[2], v1[3]);
                    *(u32x4*)(rowp + bj * HALF) = w; } }
    }
};
template <class Epi, class Sched, bool ALIGN_EPI = false, bool SP2 = false>
__device__ __forceinline__ void gemm_phase(PG8_LAS unsigned char* lds, const Gemm g, const Sched& S, const Epi& E) {
    const int tid = threadIdx.x, wid = __builtin_amdgcn_readfirstlane(tid >> 6), lane = tid & 63, wr = wid >> 2, wc = wid & 3, fr = lane & 15, fq = lane >> 4;
    const int K = g.K, nt = K / BK;
    unsigned voffA[2], voffB[2];
#pragma unroll
    for (int i = 0; i < 2; ++i) { int R, C; stage_rc(tid * 16 + i * 8192, R, C); const int Rb = Epi::PERM ? ((R & ~31) + perm32(R & 31)) : R;
        voffA[i] = (unsigned)(R * K + C) * 2u; voffB[i] = (unsigned)(Rb * K + C) * 2u; }
    const size_t kstep = (size_t)(BK * 2);
    const size_t hstep = (size_t)HALF * K * 2;
    const size_t tstep = 2 * hstep;
    const unsigned ldsw = (unsigned)wid * 1024u;
    const int aoff = lds_byte(wr * 64 + fr, fq * 8), boff = lds_byte(wc * 32 + fr, fq * 8);
#define PG8_SA(b, h) (((b) * 2 + (h)) * HTB)
#define PG8_SB(b, h) ((4 + (b) * 2 + (h)) * HTB)
#define PG8_STAGE(bufoff, gbase, voff) do { _Pragma("unroll") for (int _i = 0; _i < 2; ++_i) \
        __builtin_amdgcn_global_load_lds((const unsigned*)((const char*)(gbase) + (voff)[_i]), (PG8_LAS unsigned*)(lds + (bufoff) + ldsw + _i * 8192), 16, 0, 0); } while (0)
#define PG8_LDA(dst, b, h) do { _Pragma("unroll") for (int m = 0; m < 4; ++m) _Pragma("unroll") for (int k = 0; k < 2; ++k) dst[m][k] = *(const PG8_LAS bf16x8*)(lds + PG8_SA(b, h) + aoff + m * 2048 + k * 1024); } while (0)
#define PG8_LDB(dst, b, h) do { _Pragma("unroll") for (int n = 0; n < 2; ++n) _Pragma("unroll") for (int k = 0; k < 2; ++k) dst[n][k] = *(const PG8_LAS bf16x8*)(lds + PG8_SB(b, h) + boff + n * 2048 + k * 1024); } while (0)
#define PG8_MMA(ai, bj, At, Bt) do { __builtin_amdgcn_s_setprio(1); _Pragma("unroll") for (int m = 0; m < 4; ++m) _Pragma("unroll") for (int n = 0; n < 2; ++n) _Pragma("unroll") for (int k = 0; k < 2; ++k) \
        acc[ai][bj][m][n] = __builtin_amdgcn_mfma_f32_16x16x32_bf16(Bt[n][k], At[m][k], acc[ai][bj][m][n], 0, 0, 0); __builtin_amdgcn_s_setprio(0); } while (0)
#define PG8_WAIT_V(n) asm volatile("s_waitcnt vmcnt(" #n ")" ::: "memory")
#define PG8_WAIT_L(n) asm volatile("s_waitcnt lgkmcnt(" #n ")" ::: "memory")
#define PG8_BAR __builtin_amdgcn_s_barrier()
#define PG8_SCHED __builtin_amdgcn_sched_barrier(0)
    Unit cur, nxt; int ui = 0;
    if (!S.next(0, cur)) return;
    f32x4 acc[2][2][4][2];
#pragma unroll
    for (int a = 0; a < 2; ++a)
#pragma unroll
        for (int b = 0; b < 2; ++b)
#pragma unroll
            for (int m = 0; m < 4; ++m)
#pragma unroll
                for (int n = 0; n < 2; ++n) acc[a][b][m][n] = (f32x4){0.f, 0.f, 0.f, 0.f};
    bf16x8 At[4][2], B0[2][2], B1[2][2];
    const char* cA = (const char*)g.A + (size_t)cur.pm * tstep; const char* cB = (const char*)g.Bt + (size_t)cur.pn * tstep;
    S.a_ready(cur);
    if constexpr (SP2) {
        PG8_STAGE(PG8_SB(0, 0), cB, voffB); PG8_STAGE(PG8_SB(0, 1), cB + hstep, voffB); PG8_STAGE(PG8_SA(0, 0), cA, voffA); PG8_STAGE(PG8_SA(0, 1), cA + hstep, voffA);
        if (wr == 1) PG8_BAR;
        PG8_WAIT_V(2); PG8_BAR;
        PG8_STAGE(PG8_SB(1, 0), cB + kstep, voffB); PG8_STAGE(PG8_SA(1, 0), cA + kstep, voffA); PG8_STAGE(PG8_SB(1, 1), cB + hstep + kstep, voffB);
        PG8_WAIT_V(6); PG8_BAR;
    } else {
        PG8_STAGE(PG8_SB(0, 0), cB, voffB); PG8_STAGE(PG8_SA(0, 0), cA, voffA); PG8_STAGE(PG8_SB(0, 1), cB + hstep, voffB); PG8_STAGE(PG8_SA(0, 1), cA + hstep, voffA);
        if (wr == 1) PG8_BAR;
        PG8_WAIT_V(4); PG8_BAR;
        PG8_STAGE(PG8_SB(1, 0), cB + kstep, voffB); PG8_STAGE(PG8_SA(1, 0), cA + kstep, voffA); PG8_STAGE(PG8_SB(1, 1), cB + hstep + kstep, voffB);
        PG8_WAIT_V(6); PG8_BAR;
    }
    for (;;) {
        const bool has_next = S.next(ui + 1, nxt);
        const char* nA = has_next ? (const char*)g.A + (size_t)nxt.pm * tstep : cA; const char* nB = has_next ? (const char*)g.Bt + (size_t)nxt.pn * tstep : cB;
        for (int t = 0; t < nt; t += 2) {
            const bool last = (t == nt - 2);
            const char* a1 = cA + (size_t)(t + 1) * kstep;
            const char* a2 = last ? nA : cA + (size_t)(t + 2) * kstep; const char* b2 = last ? nB : cB + (size_t)(t + 2) * kstep;
            const char* a3 = a2 + kstep; const char* b3 = b2 + kstep;
            if (last && has_next) S.a_ready(nxt);
            if constexpr (SP2) {
            PG8_LDB(B0, 0, 0); PG8_LDB(B1, 0, 1); PG8_SCHED; PG8_LDA(At, 0, 0); PG8_STAGE(PG8_SA(1, 1), a1 + hstep, voffA);
            PG8_WAIT_V(8); PG8_WAIT_L(0); PG8_BAR; PG8_MMA(0, 0, At, B0); PG8_MMA(0, 1, At, B1); PG8_BAR; PG8_SCHED;
            PG8_LDA(At, 0, 1); PG8_STAGE(PG8_SB(0, 0), b2, voffB); PG8_STAGE(PG8_SB(0, 1), b2 + hstep, voffB); PG8_STAGE(PG8_SA(0, 0), a2, voffA);
            PG8_WAIT_V(8); PG8_WAIT_L(0); PG8_BAR; PG8_MMA(1, 0, At, B0); PG8_MMA(1, 1, At, B1); PG8_BAR; PG8_SCHED;
            PG8_LDB(B0, 1, 0); PG8_LDB(B1, 1, 1); PG8_SCHED; PG8_LDA(At, 1, 0); PG8_STAGE(PG8_SA(0, 1), a2 + hstep, voffA);
            PG8_WAIT_V(8); PG8_WAIT_L(0); PG8_BAR; PG8_MMA(0, 0, At, B0); PG8_MMA(0, 1, At, B1); PG8_BAR; PG8_SCHED;
            PG8_LDA(At, 1, 1); PG8_STAGE(PG8_SB(1, 0), b3, voffB); PG8_STAGE(PG8_SB(1, 1), b3 + hstep, voffB); PG8_STAGE(PG8_SA(1, 0), a3, voffA);
            PG8_WAIT_V(8); PG8_WAIT_L(0); PG8_BAR; PG8_MMA(1, 0, At, B0); PG8_MMA(1, 1, At, B1); PG8_BAR; PG8_SCHED;
            } else {
            PG8_LDB(B0, 0, 0); PG8_SCHED; PG8_LDA(At, 0, 0); PG8_STAGE(PG8_SA(1, 1), a1 + hstep, voffA);
            PG8_WAIT_L(8); PG8_BAR; PG8_WAIT_L(0); PG8_MMA(0, 0, At, B0); PG8_BAR; PG8_SCHED;
            PG8_LDB(B1, 0, 1); PG8_STAGE(PG8_SB(0, 0), b2, voffB);
            PG8_BAR; PG8_WAIT_L(0); PG8_MMA(0, 1, At, B1); PG8_BAR;
            PG8_LDA(At, 0, 1); PG8_STAGE(PG8_SA(0, 0), a2, voffA);
            PG8_BAR; PG8_WAIT_L(0); PG8_MMA(1, 0, At, B0); PG8_BAR; PG8_SCHED;
            PG8_STAGE(PG8_SB(0, 1), b2 + hstep, voffB);
            PG8_WAIT_V(6); PG8_BAR; PG8_MMA(1, 1, At, B1); PG8_BAR;
            PG8_LDB(B0, 1, 0); PG8_SCHED; PG8_LDA(At, 1, 0); PG8_STAGE(PG8_SA(0, 1), a2 + hstep, voffA);
            PG8_WAIT_L(8); PG8_BAR; PG8_WAIT_L(0); PG8_MMA(0, 0, At, B0); PG8_BAR; PG8_SCHED;
            PG8_LDB(B1, 1, 1); PG8_STAGE(PG8_SB(1, 0), b3, voffB);
            PG8_BAR; PG8_WAIT_L(0); PG8_MMA(0, 1, At, B1); PG8_BAR;
            PG8_LDA(At, 1, 1); PG8_STAGE(PG8_SA(1, 0), a3, voffA);
            PG8_BAR; PG8_WAIT_L(0); PG8_MMA(1, 0, At, B0); PG8_BAR; PG8_SCHED;
            PG8_STAGE(PG8_SB(1, 1), b3 + hstep, voffB);
            PG8_WAIT_V(6); PG8_BAR; PG8_MMA(1, 1, At, B1); PG8_BAR;
            }
        }
        if constexpr (ALIGN_EPI) { if (wr == 0) PG8_BAR; }
        if constexpr (!Epi::AFTER_DRAIN) { E(acc, cur, wr, wc, fr, fq); S.done(cur); }
        if (!has_next) break;
#pragma unroll
        for (int a = 0; a < 2; ++a)
#pragma unroll
            for (int b = 0; b < 2; ++b)
#pragma unroll
                for (int m = 0; m < 4; ++m)
#pragma unroll
                    for (int n = 0; n < 2; ++n) acc[a][b][m][n] = (f32x4){0.f, 0.f, 0.f, 0.f};
        cur = nxt; cA = nA; cB = nB; ++ui;
        if constexpr (ALIGN_EPI) { if (wr == 1) PG8_BAR; }
    }
    PG8_WAIT_V(0);
    if constexpr (!ALIGN_EPI) { if (wr == 0) PG8_BAR; }
    PG8_BAR;
    if constexpr (Epi::AFTER_DRAIN) { E.fused(acc, cur, wr, wc, fr, fq, lds, wid, lane); S.done(cur); }
#undef PG8_SA
#undef PG8_SB
#undef PG8_STAGE
#undef PG8_LDA
#undef PG8_LDB
#undef PG8_MMA
#undef PG8_WAIT_V
#undef PG8_WAIT_L
#undef PG8_BAR
#undef PG8_SCHED
}
}

#ifndef PG8_SP2
#define PG8_SP2 true
#endif
#ifndef PG8_ALIGN
#define PG8_ALIGN true
#endif

namespace pg8 {
struct EpiResGate {
    static constexpr bool PERM = false, AFTER_DRAIN = false;
    const float* base; float* out; const float* gate; int gate_ld; int rows_per_batch; int ldc;
    __device__ __forceinline__ void operator()(const f32x4 (&acc)[2][2][4][2], const Unit& u, int wr, int wc, int fr, int fq) const {
        const int row0 = u.pm * BM + wr * 64 + fr, col0 = u.pn * BM + wc * 32 + 4 * fq;
        const float* gp = gate + (size_t)((u.pm * BM) / rows_per_batch) * gate_ld + col0;
        f32x4 gv[2][2];
#pragma unroll
        for (int bj = 0; bj < 2; ++bj)
#pragma unroll
            for (int n = 0; n < 2; ++n) gv[bj][n] = *(const f32x4*)(gp + bj * HALF + n * 16);
#pragma unroll
        for (int ai = 0; ai < 2; ++ai)
#pragma unroll
            for (int m = 0; m < 4; ++m) { const size_t off = (size_t)(row0 + ai * HALF + m * 16) * ldc + col0;
#pragma unroll
                for (int bj = 0; bj < 2; ++bj)
#pragma unroll
                    for (int n = 0; n < 2; ++n) { const f32x4 bs = *(const f32x4*)(base + off + bj * HALF + n * 16);
                        *(f32x4*)(out + off + bj * HALF + n * 16) = bs + gv[bj][n] * acc[ai][bj][m][n]; } }
    }
};
struct EpiResGateBf16 {
    static constexpr bool PERM = false, AFTER_DRAIN = false;
    const float* base; bf16_t* out; const float* gate; int gate_ld; int rows_per_batch; int ldc;
    __device__ __forceinline__ void operator()(const f32x4 (&acc)[2][2][4][2], const Unit& u, int wr, int wc, int fr, int fq) const {
        const int row0 = u.pm * BM + wr * 64 + fr, col0 = u.pn * BM + wc * 32 + 4 * fq;
        const float* gp = gate + (size_t)((u.pm * BM) / rows_per_batch) * gate_ld + col0;
        f32x4 gv[2][2];
#pragma unroll
        for (int bj = 0; bj < 2; ++bj)
#pragma unroll
            for (int n = 0; n < 2; ++n) gv[bj][n] = *(const f32x4*)(gp + bj * HALF + n * 16);
#pragma unroll
        for (int ai = 0; ai < 2; ++ai)
#pragma unroll
            for (int m = 0; m < 4; ++m) { const size_t off = (size_t)(row0 + ai * HALF + m * 16) * ldc + col0;
#pragma unroll
                for (int bj = 0; bj < 2; ++bj)
#pragma unroll
                    for (int n = 0; n < 2; ++n) { const f32x4 bs = __builtin_nontemporal_load((const f32x4*)(base + off + bj * HALF + n * 16)); const f32x4 r = bs + gv[bj][n] * acc[ai][bj][m][n];
                        *(unsigned long long*)(out + off + bj * HALF + n * 16) = (unsigned long long)cvt_pk_bf16(r.x, r.y) | ((unsigned long long)cvt_pk_bf16(r.z, r.w) << 32); } }
    }
};
struct EpiF32 {
    static constexpr bool PERM = false, AFTER_DRAIN = false;
    float* O; int ldc;
    __device__ __forceinline__ void operator()(const f32x4 (&acc)[2][2][4][2], const Unit& u, int wr, int wc, int fr, int fq) const {
        const int row0 = u.pm * BM + wr * 64 + fr, col0 = u.pn * BM + wc * 32 + 4 * fq;
#pragma unroll
        for (int ai = 0; ai < 2; ++ai)
#pragma unroll
            for (int m = 0; m < 4; ++m) { const size_t off = (size_t)(row0 + ai * HALF + m * 16) * ldc + col0;
#pragma unroll
                for (int bj = 0; bj < 2; ++bj)
#pragma unroll
                    for (int n = 0; n < 2; ++n) *(f32x4*)(O + off + bj * HALF + n * 16) = acc[ai][bj][m][n]; }
    }
};
}
#define GAS __attribute__((address_space(1)))
#define LAS __attribute__((address_space(3)))
typedef unsigned short bf16;
typedef unsigned v4u __attribute__((ext_vector_type(4)));
typedef float f32x4 __attribute__((ext_vector_type(4)));
typedef short bf16x8 __attribute__((ext_vector_type(8)));
typedef GAS unsigned gu32;
typedef GAS unsigned long long gu64;
#define RLX_AGENT __ATOMIC_RELAXED, __HIP_MEMORY_SCOPE_AGENT
#define LDS_WAIT() asm volatile("s_waitcnt lgkmcnt(0)" ::: "memory")
#define VM_WAIT() asm volatile("s_waitcnt vmcnt(0)" ::: "memory")
__device__ __forceinline__ unsigned long long rt() { return __builtin_amdgcn_s_memrealtime(); }
__device__ __forceinline__ unsigned f2bf(float f) { unsigned u = __builtin_bit_cast(unsigned, f); return (u + 0x7fffu + ((u >> 16) & 1u)) >> 16; }
__device__ __forceinline__ unsigned pk2(float lo, float hi) { return f2bf(lo) | (f2bf(hi) << 16); }

#define XB_TMO      128
#define XB_XCNT(j)  (256  + 64 * (j))
#define XB_XSUB(j)  (1280 + 64 * (j))
#define XB_XGEN(j)  (2304 + 64 * (j))
#define XB_TOP      3328
#define XB_TOPGEN   3392
#define XCD_BAR_WORDS 3456
#define XB_SPIN_CAP (1u << 24)

__device__ __forceinline__ unsigned xb_ld(unsigned* p)              { return __hip_atomic_load(p, __ATOMIC_RELAXED, __HIP_MEMORY_SCOPE_AGENT); }
__device__ __forceinline__ unsigned xb_add(unsigned* p, unsigned v) { return __hip_atomic_fetch_add(p, v, __ATOMIC_RELAXED, __HIP_MEMORY_SCOPE_AGENT); }
__device__ __forceinline__ unsigned xb_xcc_id() { return (unsigned)__builtin_amdgcn_s_getreg((3 << 11) | 20) & 0xFu; }
#define XB_SPIN(cond, bar) do { unsigned _sp = 0; while (cond) { __builtin_amdgcn_s_sleep(1); \
    if ((++_sp & 255u) == 0u) { if (xb_ld(&(bar)[XB_TMO])) break; if (_sp > XB_SPIN_CAP) { atomicAdd(&(bar)[XB_TMO], 1u); break; } } } } while (0)

struct XcdBarrier {
    unsigned* bar; unsigned x;
    volatile LAS unsigned* st;
};

__device__ __forceinline__ XcdBarrier xcd_barrier_post(unsigned* bar, volatile LAS unsigned* st) {
    XcdBarrier b; b.bar = bar; b.x = xb_xcc_id(); b.st = st;
    if (threadIdx.x == 0) (void)xb_add(&bar[XB_XCNT(b.x)], 1u);
    return b;
}
__device__ __forceinline__ void xcd_barrier_complete(unsigned* bar, unsigned x, unsigned& nloc, unsigned& nx) {
    const unsigned G = gridDim.x * gridDim.y * gridDim.z;
    unsigned sum, cnt, mine, sp = 0u;
    for (;;) {
        sum = 0u; cnt = 0u; mine = 0u;
#pragma unroll
        for (unsigned j = 0; j < 16; ++j) { const unsigned c = xb_ld(&bar[XB_XCNT(j)]); sum += c; cnt += (c > 0u) ? 1u : 0u; mine = (j == x) ? c : mine; }
        if (sum == G) break;
        __builtin_amdgcn_s_sleep(1);
        if ((++sp & 255u) == 0u) { if (xb_ld(&bar[XB_TMO])) break; if (sp > XB_SPIN_CAP) { atomicAdd(&bar[XB_TMO], 1u); break; } }
    }
    nloc = mine > 0u ? mine : 1u; nx = cnt > 0u ? cnt : 1u;
}

__device__ __forceinline__ void xcd_barrier(const XcdBarrier& b) {
    asm volatile("s_waitcnt vmcnt(0)" ::: "memory");
    __syncthreads();
    if (threadIdx.x == 0) {
        unsigned* bar = b.bar;
        __builtin_amdgcn_s_waitcnt(0);
        unsigned nloc = b.st[0], nx = b.st[1];
        if (nloc == 0u) { xcd_barrier_complete(bar, b.x, nloc, nx); b.st[0] = nloc; b.st[1] = nx; }
        const unsigned old = xb_add(&bar[XB_XSUB(b.x)], 1u);
        const unsigned gen = old / nloc;
        if (old + 1u == (gen + 1u) * nloc) {
            __builtin_amdgcn_fence(__ATOMIC_RELEASE, "agent");
            asm volatile("s_waitcnt vmcnt(0)" ::: "memory");
            const unsigned og = xb_add(&bar[XB_TOP], 1u);
            const unsigned tg = og / nx;
            if (og + 1u == (tg + 1u) * nx) xb_add(&bar[XB_TOPGEN], 1u);
            else XB_SPIN(xb_ld(&bar[XB_TOPGEN]) == tg, bar);
            __builtin_amdgcn_fence(__ATOMIC_ACQUIRE, "agent");
            xb_add(&bar[XB_XGEN(b.x)], 1u);
            asm volatile("s_waitcnt vmcnt(0)" ::: "memory");
        } else {
            XB_SPIN(xb_ld(&bar[XB_XGEN(b.x)]) == gen, bar);
            __builtin_amdgcn_fence(__ATOMIC_ACQUIRE, "agent");
            asm volatile("s_waitcnt vmcnt(0)" ::: "memory");
        }
    }
    __syncthreads();
}

constexpr int NWAVES = 8, NTHR = 512;
constexpr int NB = 8, SEQ = 4096, T = NB * SEQ, D = 1024, NPROJ = 3584, NIN = 3592, NMOD = 6144, NSC = 2048;
constexpr int C_QSB = 0, C_KSB = 512, C_VSB = 1024, C_QML = 1536, C_KML = 2048, C_VML = 2560, C_OML = 3072;
constexpr float EPS = 1e-6f, LOG2E = 1.4426950408889634f;
constexpr size_t MiB = 1u << 20;
constexpr size_t WS_CTL = 0, CTL_ZERO_BYTES = 1 * MiB;
constexpr size_t WS_MOD = 256 * 1024;
constexpr size_t WS_WIN = 2 * MiB, WS_WOUT = 10 * MiB, WS_WEFF = 12 * MiB;
constexpr size_t WS_XN = 16 * MiB;
constexpr size_t WS_PROJ = 80 * MiB;
constexpr size_t WS_MIX = 304 * MiB;
constexpr size_t WS_EXPU = 368 * MiB, WS_EXPV = 400 * MiB;
constexpr size_t WS_CST = 432 * MiB;
constexpr size_t WS_NST = 496 * MiB;
constexpr size_t WS_MST = 497 * MiB;
constexpr size_t WS_GATES = 498 * MiB;
constexpr size_t WS_XQ = 272 * MiB;
constexpr size_t WS_XS = 499 * MiB + 256 * 1024;
constexpr size_t WS_X1B = 208 * MiB;
constexpr size_t WS_SCORES = 80 * MiB;
constexpr size_t WS_IDX = 336 * MiB, WS_GATE = 352 * MiB;
constexpr size_t WS_SCL = 499 * MiB;
constexpr size_t WS_SUI = 499 * MiB + 65536, WS_SVI = 499 * MiB + 131072;
constexpr size_t WS_END = 500 * MiB;
constexpr int CW_Q3 = 64;
constexpr int CW_BAR = 4096;
constexpr int LDS_BYTES = 147456, LDSCTL_OFF = 143360;

typedef float f32x16 __attribute__((ext_vector_type(16)));
typedef float f32x2_t __attribute__((ext_vector_type(2)));
typedef __bf16 bf16x2_t __attribute__((ext_vector_type(2)));
typedef _Float16 f16x8 __attribute__((ext_vector_type(8)));
typedef short s16x4 __attribute__((ext_vector_type(4)));
typedef unsigned u32x2 __attribute__((ext_vector_type(2)));
#define DI __device__ __forceinline__
DI unsigned cvtpk(float lo, float hi) { f32x2_t v = {lo, hi}; bf16x2_t b = __builtin_convertvector(v, bf16x2_t); return __builtin_bit_cast(unsigned, b); }
DI float bflo(unsigned u) { return __uint_as_float(u << 16); }
DI float bfhi(unsigned u) { return __uint_as_float(u & 0xffff0000u); }
DI int crow(int i, int hi) { return (i & 3) + 8 * (i >> 2) + 4 * hi; }
DI int krow(int s, int hi, int j) { return 16 * s + 8 * (j >> 2) + 4 * hi + (j & 3); }
DI float swap_add(float v) { auto rr = __builtin_amdgcn_permlane32_swap(__float_as_uint(v), __float_as_uint(v), false, false); return __uint_as_float(rr[0]) + __uint_as_float(rr[1]); }
DI float swap_max(float v) { auto rr = __builtin_amdgcn_permlane32_swap(__float_as_uint(v), __float_as_uint(v), false, false); return fmaxf(__uint_as_float(rr[0]), __uint_as_float(rr[1])); }
DI float dot2bf(unsigned a, unsigned b, float acc) { return __builtin_amdgcn_fdot2_f32_bf16(__builtin_bit_cast(bf16x2_t, a), __builtin_bit_cast(bf16x2_t, b), acc, false); }
DI float ex2(float x) { return __builtin_amdgcn_exp2f(x); }
DI float lg2(float x) { return __builtin_amdgcn_logf(x); }
DI float fexp(float x) { return __builtin_amdgcn_exp2f(x * LOG2E); }
DI float wave_sum(float v) {
#pragma unroll
    for (int o = 1; o < 64; o <<= 1) v += __shfl_xor(v, o);
    return v;
}
DI float wave_max(float v) {
#pragma unroll
    for (int o = 1; o < 64; o <<= 1) v = fmaxf(v, __shfl_xor(v, o));
    return v;
}
#define DPP_MAXF(v, ctrl, rmask) fmaxf((v), __builtin_bit_cast(float, __builtin_amdgcn_update_dpp(0, __builtin_bit_cast(int, (v)), (ctrl), (rmask), 0xF, false)))
DI float wave_max_nonneg(float v) {
    v = DPP_MAXF(v, 0xB1, 0xF); v = DPP_MAXF(v, 0x4E, 0xF); v = DPP_MAXF(v, 0x141, 0xF); v = DPP_MAXF(v, 0x140, 0xF); v = DPP_MAXF(v, 0x142, 0xA); v = DPP_MAXF(v, 0x143, 0xC);
    return __builtin_bit_cast(float, __builtin_amdgcn_readlane(__builtin_bit_cast(int, v), 63));
}
#define DPP_ADDF(v, ctrl, rmask) ((v) + __builtin_bit_cast(float, __builtin_amdgcn_update_dpp(0, __builtin_bit_cast(int, (v)), (ctrl), (rmask), 0xF, false)))
DI float wave_sum_u(float v) {
    v = DPP_ADDF(v, 0xB1, 0xF); v = DPP_ADDF(v, 0x4E, 0xF); v = DPP_ADDF(v, 0x141, 0xF); v = DPP_ADDF(v, 0x140, 0xF); v = DPP_ADDF(v, 0x142, 0xA); v = DPP_ADDF(v, 0x143, 0xC);
    return __builtin_bit_cast(float, __builtin_amdgcn_readlane(__builtin_bit_cast(int, v), 63));
}
typedef short v4i16_t __attribute__((ext_vector_type(4)));
DI s16x4 trrd(LAS unsigned char* p) { return __builtin_bit_cast(s16x4, __builtin_amdgcn_ds_read_tr16_b64_v4i16((LAS v4i16_t*)p)); }
DI bf16x8 cat8(s16x4 a, s16x4 b) { return (bf16x8){a[0], a[1], a[2], a[3], b[0], b[1], b[2], b[3]}; }
#define MFMA_BF16(a, b, c) __builtin_amdgcn_mfma_f32_32x32x16_bf16((a), (b), (c), 0, 0, 0)
#define MFMA_F16(a, b, c) __builtin_amdgcn_mfma_f32_32x32x16_f16((a), (b), (c), 0, 0, 0)
DI unsigned pkh(float a, float b) { return __builtin_bit_cast(unsigned, __builtin_amdgcn_cvt_pkrtz(a, b)); }
DI bf16x8 packbf(const f32x16& x, int s) { v4u p; p.x = cvtpk(x[8 * s], x[8 * s + 1]); p.y = cvtpk(x[8 * s + 2], x[8 * s + 3]); p.z = cvtpk(x[8 * s + 4], x[8 * s + 5]); p.w = cvtpk(x[8 * s + 6], x[8 * s + 7]); return __builtin_bit_cast(bf16x8, p); }
DI f16x8 packh(const f32x16& x, int s) { v4u p; p.x = pkh(x[8 * s], x[8 * s + 1]); p.y = pkh(x[8 * s + 2], x[8 * s + 3]); p.z = pkh(x[8 * s + 4], x[8 * s + 5]); p.w = pkh(x[8 * s + 6], x[8 * s + 7]); return __builtin_bit_cast(f16x8, p); }

struct Frame {
    LAS unsigned char* lds;
    volatile LAS unsigned* MISC;
    gu32* ctl;
    unsigned char* ws;
    int tid, lane, wave, vcu, G;
};
DI const float* inp(int i) { const __attribute__((address_space(4))) unsigned long long* kp = (const __attribute__((address_space(4))) unsigned long long*)__builtin_amdgcn_kernarg_segment_ptr(); return (const float*)(const GAS float*)(*(volatile const __attribute__((address_space(4))) unsigned long long*)(kp + i)); }
enum { I_X = 0, I_C, I_WADA, I_BADA, I_GN1, I_WIN, I_BIG, I_BFG, I_CONVW, I_GQ, I_GK, I_GOSB, I_GOML, I_WOUT, I_GN2, I_WQ, I_SK, I_EU, I_EV, I_OUT };
#define WSP(type, off) ((type*)(F.ws + (off)))

DI void p0_transpose_item(const float* W, int K, int N, int ld, bf16* WT, LAS float* scr, int item, int lane) {
    const int nblk = N / 32, kb = item / nblk, nb = item % nblk, k0 = 64 * kb, n0 = 32 * nb;
    float tv[32];
#pragma unroll
    for (int i = 0; i < 32; ++i) tv[i] = W[(size_t)(k0 + 2 * i + (lane >> 5)) * ld + n0 + (lane & 31)];
#pragma unroll
    for (int i = 0; i < 32; ++i) scr[(2 * i + (lane >> 5)) * 33 + (lane & 31)] = tv[i];
    LDS_WAIT(); asm volatile("" ::: "memory");
    const int c = lane & 7;
#pragma unroll
    for (int j = 0; j < 4; ++j) { const int n = (lane >> 3) + 8 * j; const LAS float* s = scr + (8 * c) * 33 + n;
        v4u o; o.x = pk2(s[0 * 33], s[1 * 33]); o.y = pk2(s[2 * 33], s[3 * 33]); o.z = pk2(s[4 * 33], s[5 * 33]); o.w = pk2(s[6 * 33], s[7 * 33]);
        *(GAS v4u*)(WT + (size_t)(n0 + n) * K + k0 + 8 * c) = o; }
    LDS_WAIT(); asm volatile("" ::: "memory");
}
DI void p0_mod_block(const Frame& F, int item) {
    const float* const c_ = inp(I_C); const float* const w_ada_ = inp(I_WADA); const float* const b_ada_ = inp(I_BADA); float* const mod_ = WSP(float, WS_MOD);
    LAS float* scr = (LAS float*)(F.lds + F.wave * 16384);
    const int j = item * 64 + F.lane, d0 = F.wave * 128;
#pragma unroll
    for (int b = 0; b < 8; ++b)
#pragma unroll
        for (int q = 0; q < 2; ++q) { const float cv = c_[b * D + d0 + 64 * q + F.lane]; scr[b * 128 + 64 * q + F.lane] = cv / (1.f + fexp(-cv)); }
    LDS_WAIT(); asm volatile("" ::: "memory");
    float acc[8];
#pragma unroll
    for (int b = 0; b < 8; ++b) acc[b] = 0.f;
#pragma unroll 32
    for (int dd = 0; dd < 128; ++dd) { const float w = w_ada_[(size_t)(d0 + dd) * NMOD + j];
#pragma unroll
        for (int b = 0; b < 8; ++b) acc[b] += scr[b * 128 + dd] * w; }
#pragma unroll
    for (int b = 0; b < 8; ++b) scr[1024 + b * 64 + F.lane] = acc[b];
    __syncthreads();
    float tot = b_ada_[j];
#pragma unroll
    for (int w = 0; w < 8; ++w) tot += ((LAS float*)(F.lds + w * 16384))[1024 + F.wave * 64 + F.lane];
    mod_[F.wave * NMOD + j] = tot;
    __syncthreads();
}
DI void p0_weff_item(const Frame& F, int item) {
    const float* const sub_keys_ = inp(I_SK); const float* const w_q_peer_ = inp(I_WQ); bf16* const Weff_t_ = WSP(bf16, WS_WEFF);
    const int hp = item >> 4, dblk = item & 15;
    LAS float* sk = (LAS float*)F.lds;
    LAS float* rb = (LAS float*)(F.lds + 67584) + F.wave * 1024;
    { float tv[32];
#pragma unroll
      for (int i = 0; i < 32; ++i) tv[i] = sub_keys_[(size_t)hp * 16384 + F.tid + 512 * i];
#pragma unroll
      for (int i = 0; i < 32; ++i) { const int idx = F.tid + 512 * i; sk[(idx >> 7) * 129 + (idx & 127)] = tv[i]; } }
    const int d0 = 64 * dblk + 8 * F.wave;
#pragma unroll
    for (int r = 0; r < 8; ++r) { rb[r * 128 + F.lane] = w_q_peer_[(size_t)(d0 + r) * NSC + hp * 128 + F.lane]; rb[r * 128 + 64 + F.lane] = w_q_peer_[(size_t)(d0 + r) * NSC + hp * 128 + 64 + F.lane]; }
    __syncthreads();
    float a0[8], a1[8];
#pragma unroll
    for (int r = 0; r < 8; ++r) { a0[r] = 0.f; a1[r] = 0.f; }
#pragma unroll 4
    for (int c = 0; c < 128; ++c) { const float s0 = sk[F.lane * 129 + c], s1 = sk[(F.lane + 64) * 129 + c];
#pragma unroll
        for (int r = 0; r < 8; ++r) { const float a = rb[r * 128 + c]; a0[r] += a * s0; a1[r] += a * s1; } }
    v4u o0, o1; o0.x = pk2(a0[0], a0[1]); o0.y = pk2(a0[2], a0[3]); o0.z = pk2(a0[4], a0[5]); o0.w = pk2(a0[6], a0[7]);
    o1.x = pk2(a1[0], a1[1]); o1.y = pk2(a1[2], a1[3]); o1.z = pk2(a1[4], a1[5]); o1.w = pk2(a1[6], a1[7]);
    *(GAS v4u*)(Weff_t_ + (size_t)(hp * 128 + F.lane) * D + d0) = o0;
    *(GAS v4u*)(Weff_t_ + (size_t)(hp * 128 + 64 + F.lane) * D + d0) = o1;
    __syncthreads();
}
struct ExpRows2 { f32x4 v[2][4]; };
DI void exp_load2(const Frame& F, int blk0, ExpRows2& R) {
    const float* const expert_u_ = inp(I_EU); const float* const expert_v_ = inp(I_EV);
#pragma unroll
    for (int bb = 0; bb < 2; ++bb) { const int blk = blk0 + bb; const float* src = (blk < 16384 ? expert_u_ : expert_v_) + (size_t)(blk & 16383) * 1024 + 4 * F.lane;
#pragma unroll
        for (int k = 0; k < 4; ++k) R.v[bb][k] = __builtin_nontemporal_load((const GAS f32x4*)(src + 256 * k)); }
}
DI void exp_conv2(const Frame& F, int blk0, const ExpRows2& R) {
    float* const SUI_ = WSP(float, WS_SUI); float* const SVI_ = WSP(float, WS_SVI);
#pragma unroll
    for (int bb = 0; bb < 2; ++bb) { const int blk = blk0 + bb; const bool isu = blk < 16384; const int e = blk & 16383;
        float mx = 0.f;
#pragma unroll
        for (int k = 0; k < 4; ++k) mx = fmaxf(mx, fmaxf(fmaxf(fabsf(R.v[bb][k].x), fabsf(R.v[bb][k].y)), fmaxf(fabsf(R.v[bb][k].z), fabsf(R.v[bb][k].w))));
        mx = wave_max_nonneg(mx);
        {
            float best = 3.0e38f, bs = 0.f;
#define EXP_TRY(FAC) do { const float s_ = mx * ((FAC) / 7.f), inv_ = s_ > 0.f ? 1.f / s_ : 0.f; float er_ = 0.f; \
                _Pragma("unroll") for (int k = 0; k < 4; ++k) _Pragma("unroll") for (int c = 0; c < 4; ++c) { const float v_ = R.v[bb][k][c]; const float d_ = v_ - s_ * fminf(fmaxf(rintf(v_ * inv_), -7.f), 7.f); er_ += d_ * d_; } \
                er_ = wave_sum_u(er_); if (er_ < best) { best = er_; bs = s_; } } while (0)
            EXP_TRY(1.f); EXP_TRY(0.86f); EXP_TRY(0.74f); EXP_TRY(0.63f);
#undef EXP_TRY
            const float inv = bs > 0.f ? 1.f / bs : 0.f;
            unsigned w01[2] = {0u, 0u};
#pragma unroll
            for (int k = 0; k < 4; ++k)
#pragma unroll
                for (int c = 0; c < 4; ++c) { const int q = (int)fminf(fmaxf(rintf(R.v[bb][k][c] * inv), -7.f), 7.f); w01[k >> 1] |= (unsigned)((isu || (c & 1)) ? (q & 15) : (q + 8)) << (4 * (4 * (k & 1) + c)); }
            if (F.lane == 0) (isu ? SUI_ : SVI_)[e] = bs;
            typedef unsigned v2u_ __attribute__((ext_vector_type(2)));
            v2u_ wv; wv.x = w01[0]; wv.y = w01[1];
            *(GAS v2u_*)((isu ? WSP(unsigned char, WS_EXPU) : WSP(unsigned char, WS_EXPV)) + (size_t)e * 512 + 8 * F.lane) = wv;
        } }
}
#ifndef P0_PARTS
#define P0_PARTS 15
#endif
DI void p0_phase(const Frame& F, int parts = 15) {
    const float* const w_in_ = inp(I_WIN); bf16* const Win_t_ = WSP(bf16, WS_WIN); const float* const w_out_ = inp(I_WOUT); bf16* const Wout_t_ = WSP(bf16, WS_WOUT); const float* const expert_v_ = inp(I_EV); const float* const expert_u_ = inp(I_EU);
    LAS float* scr = (LAS float*)(F.lds + F.wave * 16384);
    const int gw = F.vcu * NWAVES + F.wave, NGW = F.G * NWAVES;
    if (parts & 1) for (int it = F.vcu; it < 96; it += F.G) p0_mod_block(F, it);
    constexpr int I_WIN = 16 * 112, I_WOUT = 16 * 32, NITEMS = I_WIN + I_WOUT;
    if (parts & 2) for (int it = gw; it < NITEMS; it += NGW) {
        int r = it;
        if (r < I_WIN) { p0_transpose_item(w_in_, D, NPROJ, NIN, Win_t_, scr, r, F.lane); continue; } r -= I_WIN;
        p0_transpose_item(w_out_, D, D, D, Wout_t_, scr, r, F.lane);
    }
    __syncthreads();
    if (parts & 8) for (int it = F.vcu; it < 256; it += F.G) p0_weff_item(F, it);
}

template <bool DOGATES, bool SRCB = false>
DI void norm_phase(const Frame& F, const float* src, const float* g, int shift_off, int scale_off) {
    const float* const w_in_ = inp(I_WIN); float* const mod_ = WSP(float, WS_MOD); bf16* const XN_ = WSP(bf16, WS_XN); float* const GATES_ = WSP(float, WS_GATES); const float* const b_igate_ = inp(I_BIG); const float* const b_fgate_ = inp(I_BFG);
    LAS float* W8 = (LAS float*)F.lds;
    if (DOGATES) {
        for (int i = 0; i < 16; ++i) { const int idx = F.tid + 512 * i; W8[idx] = w_in_[(size_t)(idx & 1023) * NIN + NPROJ + (idx >> 10)]; }
        __syncthreads();
    }
    const int gw = F.vcu * NWAVES + F.wave, NGW = F.G * NWAVES;
    for (int ch = gw; ch < T / 16; ch += NGW) {
        const int r0 = ch * 16, b = r0 / SEQ;
        f32x4 A[4], Bv[4];
#pragma unroll
        for (int j = 0; j < 4; ++j) { const int col = 4 * F.lane + 256 * j; const f32x4 gg = *(const f32x4*)(g + col), sc = *(const f32x4*)(mod_ + b * NMOD + scale_off + col);
            A[j] = gg * (sc + 1.0f); Bv[j] = *(const f32x4*)(mod_ + b * NMOD + shift_off + col); }
        f32x4 nx[4];
#define NORM_LOADROW(ROW) do { if (SRCB) { const GAS unsigned long long* xb_ = (const GAS unsigned long long*)((const bf16*)src + (size_t)(ROW) * D) + F.lane; \
              _Pragma("unroll") for (int j = 0; j < 4; ++j) { const unsigned long long w_ = __builtin_nontemporal_load(xb_ + 64 * j); const unsigned lo_ = (unsigned)w_, hi_ = (unsigned)(w_ >> 32); \
                  nx[j] = (f32x4){bflo(lo_), bfhi(lo_), bflo(hi_), bfhi(hi_)}; } } \
          else { const GAS f32x4* xr_ = (const GAS f32x4*)(src + (size_t)(ROW) * D) + F.lane; _Pragma("unroll") for (int j = 0; j < 4; ++j) nx[j] = __builtin_nontemporal_load(xr_ + 64 * j); } } while (0)
        NORM_LOADROW(r0);
        for (int rr = 0; rr < 16; ++rr) {
            const int row = r0 + rr;
            f32x4 v[4]; float s = 0.f;
#pragma unroll
            for (int j = 0; j < 4; ++j) { v[j] = nx[j]; s += (v[j].x * v[j].x + v[j].y * v[j].y) + (v[j].z * v[j].z + v[j].w * v[j].w); }
            if (rr + 1 < 16) NORM_LOADROW(row + 1);
            const float rstd = 1.f / sqrtf(wave_sum_u(s) * (1.f / D) + EPS);
#pragma unroll
            for (int j = 0; j < 4; ++j) v[j] = v[j] * rstd * A[j] + Bv[j];
            GAS unsigned long long* o8 = (GAS unsigned long long*)(XN_ + (size_t)row * D) + F.lane;
#pragma unroll
            for (int j = 0; j < 4; ++j) o8[64 * j] = (unsigned long long)pk2(v[j].x, v[j].y) | ((unsigned long long)pk2(v[j].z, v[j].w) << 32);
            if (SRCB) {
                float mx = 0.f;
#pragma unroll
                for (int j = 0; j < 4; ++j) mx = fmaxf(mx, fmaxf(fmaxf(fabsf(v[j].x), fabsf(v[j].y)), fmaxf(fabsf(v[j].z), fabsf(v[j].w))));
                mx = wave_max_nonneg(mx);
                const float sx = mx > 0.f ? 119.f / mx : 0.f;
                unsigned lo_[2] = {0u, 0u}, hi_[2] = {0u, 0u};
#pragma unroll
                for (int j = 0; j < 4; ++j)
#pragma unroll
                    for (int c = 0; c < 4; ++c) { const int t_ = (int)rintf(v[j][c] * sx) + 8; const int sh_ = 4 * (4 * (j & 1) + c);
                        lo_[j >> 1] |= (unsigned)(t_ & 15) << sh_; hi_[j >> 1] |= (unsigned)((t_ >> 4) & 15) << sh_; }
                typedef unsigned v2u_ __attribute__((ext_vector_type(2)));
                unsigned char* xq = WSP(unsigned char, WS_XQ) + (size_t)row * 1024 + 8 * F.lane;
                v2u_ hv, lv; hv.x = hi_[0]; hv.y = hi_[1]; lv.x = lo_[0] ^ 0x88888888u; lv.y = lo_[1] ^ 0x88888888u;
                *(GAS v2u_*)xq = hv; *(GAS v2u_*)(xq + 512) = lv;
                if (F.lane == 0) WSP(float, WS_XS)[row] = mx > 0.f ? mx / 119.f : 0.f;
            }
            if (DOGATES) {
                float res = 0.f;
#pragma unroll
                for (int hh = 0; hh < 8; ++hh) { float p = 0.f;
#pragma unroll
                    for (int j = 0; j < 4; ++j) { const f32x4 w = *(const LAS f32x4*)(W8 + hh * 1024 + 4 * F.lane + 256 * j); p += (v[j].x * w.x + v[j].y * w.y) + (v[j].z * w.z + v[j].w * w.w); }
                    p = wave_sum_u(p); if (F.lane == hh) res = p; }
                if (F.lane < 8) GATES_[(size_t)row * 8 + F.lane] = res + (F.lane < 4 ? b_igate_[F.lane] : b_fgate_[F.lane - 4]);
            }
        }
    }
}

DI void sb_unit(const Frame& F, int b, int h, int qb) {
    bf16* const PROJ_ = WSP(bf16, WS_PROJ); const float* const g_q_sb_ = inp(I_GQ); const float* const g_k_sb_ = inp(I_GK); bf16* const MIX_ = WSP(bf16, WS_MIX); const float* const g_out_sb_ = inp(I_GOSB);
    const int lane = F.lane, w = F.wave, r = lane & 31, hi = lane >> 5;
    const int i16 = lane & 15, qq = i16 >> 2, pp = i16 & 3, blk = (lane >> 4) & 1;
    LAS unsigned char* Wb = F.lds + w * 16384;
    const size_t rowbase = (size_t)b * SEQ; const int q0 = qb * 256, qw0 = q0 + 32 * w, tq = qw0 + r;
    const bf16* P = PROJ_;
    const bf16* kpiece[4]; const bf16* vpiece[4];
#pragma unroll
    for (int i = 0; i < 4; ++i) { const int krow_ = 8 * i + (lane >> 3), kch = (lane & 7) ^ ((krow_ >> 1) & 7); kpiece[i] = P + (rowbase + krow_) * NPROJ + C_KSB + h * 64 + 8 * kch;
        const int vkey = 16 * (i & 1) + (lane >> 2); vpiece[i] = P + (rowbase + vkey) * NPROJ + C_VSB + h * 64 + 32 * (i >> 1) + 8 * (lane & 3); }
#define SB_DMA(T_, BUF_) do { _Pragma("unroll") for (int i_ = 0; i_ < 4; ++i_) { \
        __builtin_amdgcn_global_load_lds((const unsigned*)(kpiece[i_] + (size_t)(32 * (T_)) * NPROJ), (LAS unsigned*)(Wb + 8192 * (BUF_) + 1024 * i_), 16, 0, 0); \
        __builtin_amdgcn_global_load_lds((const unsigned*)(vpiece[i_] + (size_t)(32 * (T_)) * NPROJ), (LAS unsigned*)(Wb + 8192 * (BUF_) + 4096 + 1024 * i_), 16, 0, 0); } } while (0)
    const int tw = (qw0 + 30) >> 5;
    SB_DMA(tw, 0);
    bf16x8 qf[4];
    {
        const bf16* Qp = P + (rowbase + tq) * NPROJ + C_QSB + h * 64 + 8 * hi;
        v4u qraw[4]; float ss = 0.f;
#pragma unroll
        for (int kk = 0; kk < 4; ++kk) { qraw[kk] = *(const GAS v4u*)(Qp + 16 * kk);
#pragma unroll
            for (int e = 0; e < 4; ++e) { const float a = bflo(qraw[kk][e]), c = bfhi(qraw[kk][e]); ss += a * a + c * c; } }
        ss = swap_add(ss);
        const float rq = __builtin_amdgcn_rsqf(ss * (1.f / 64.f) + EPS) * (0.125f * LOG2E);
#pragma unroll
        for (int kk = 0; kk < 4; ++kk) { const int d0 = 16 * kk + 8 * hi;
            const f32x4 g0 = *(const f32x4*)(g_q_sb_ + d0) * *(const f32x4*)(g_k_sb_ + d0), g1 = *(const f32x4*)(g_q_sb_ + d0 + 4) * *(const f32x4*)(g_k_sb_ + d0 + 4);
            v4u o; o.x = cvtpk(bflo(qraw[kk].x) * rq * g0.x, bfhi(qraw[kk].x) * rq * g0.y); o.y = cvtpk(bflo(qraw[kk].y) * rq * g0.z, bfhi(qraw[kk].y) * rq * g0.w);
            o.z = cvtpk(bflo(qraw[kk].z) * rq * g1.x, bfhi(qraw[kk].z) * rq * g1.y); o.w = cvtpk(bflo(qraw[kk].w) * rq * g1.z, bfhi(qraw[kk].w) * rq * g1.w);
            qf[kk] = __builtin_bit_cast(bf16x8, o); }
    }
    f16x8 U0, U1, E0;
#pragma unroll
    for (int j = 0; j < 8; ++j) { U0[j] = (krow(0, hi, j) > r) ? (_Float16)1.0f : (_Float16)0.0f; U1[j] = (krow(1, hi, j) > r) ? (_Float16)1.0f : (_Float16)0.0f;
        E0[j] = (j == 0 && hi == 0) ? (_Float16)1.0f : (_Float16)0.0f; }
    f32x16 o0, o1;
#pragma unroll
    for (int i = 0; i < 16; ++i) { o0[i] = 0.f; o1[i] = 0.f; }
    float R = 0.f;
    const int kfoff = r * 128, kfsw = (r >> 1) & 7;
    for (int t = tw; t >= 0; --t) {
        const int buf = (tw - t) & 1;
        LAS unsigned char* Kb = Wb + 8192 * buf; LAS unsigned char* Vb = Kb + 4096;
        asm volatile("s_waitcnt vmcnt(0)" ::: "memory");
        if (t > 0) SB_DMA(t - 1, buf ^ 1);
        bf16x8 kf[4]; float ssk = 0.f;
#pragma unroll
        for (int kk = 0; kk < 4; ++kk) { const v4u kv = *(const LAS v4u*)(Kb + kfoff + (((2 * kk + hi) ^ kfsw) * 16)); kf[kk] = __builtin_bit_cast(bf16x8, kv);
            ssk = dot2bf(kv.x, kv.x, ssk); ssk = dot2bf(kv.y, kv.y, ssk); ssk = dot2bf(kv.z, kv.z, ssk); ssk = dot2bf(kv.w, kv.w, ssk); }
        ssk = swap_add(ssk);
        const float rk = __builtin_amdgcn_rsqf(ssk * (1.f / 64.f) + EPS);
        f16x8 RKA;
#pragma unroll
        for (int e = 0; e < 8; ++e) RKA[e] = (_Float16)0.0f;
        RKA[0] = (hi == 0) ? (_Float16)rk : (_Float16)0.0f;
        f32x16 s, rkd;
#pragma unroll
        for (int i = 0; i < 16; ++i) { s[i] = 0.f; rkd[i] = 0.f; }
        rkd = MFMA_F16(RKA, E0, rkd);
#pragma unroll
        for (int kk = 0; kk < 4; ++kk) s = MFMA_BF16(kf[kk], qf[kk], s);
        float tsum = 0.f; unsigned lp[8];
        if (32 * t + 31 < qw0) {
#pragma unroll
            for (int i = 0; i < 16; i += 2) {
                const float z0_ = s[i] * rkd[i], z1_ = s[i + 1] * rkd[i + 1];
                const float a0_ = -lg2(1.f + ex2(z0_)), a1_ = -lg2(1.f + ex2(z1_));
                tsum += a0_ + a1_;
                s[i] = z0_ + a0_; s[i + 1] = z1_ + a1_;
                lp[i >> 1] = pkh(a0_, a1_); }
        } else {
            const int kq = tq - 32 * t;
#pragma unroll
            for (int i = 0; i < 16; i += 2) {
                const float z0_ = s[i] * rkd[i], z1_ = s[i + 1] * rkd[i + 1];
                float a0_ = -lg2(1.f + ex2(z0_)), a1_ = -lg2(1.f + ex2(z1_));
                const bool ma0 = crow(i, hi) >= kq, ma1 = crow(i + 1, hi) >= kq;
                a0_ = ma0 ? 0.f : a0_; a1_ = ma1 ? 0.f : a1_;
                tsum += a0_ + a1_;
                s[i] = ma0 ? -INFINITY : z0_ + a0_; s[i + 1] = ma1 ? -INFINITY : z1_ + a1_;
                lp[i >> 1] = pkh(a0_, a1_); }
        }
        f32x16 c;
#pragma unroll
        for (int i = 0; i < 16; ++i) c[i] = R;
        c = MFMA_F16(U0, __builtin_bit_cast(f16x8, (v4u){lp[0], lp[1], lp[2], lp[3]}), c); c = MFMA_F16(U1, __builtin_bit_cast(f16x8, (v4u){lp[4], lp[5], lp[6], lp[7]}), c);
#pragma unroll
        for (int i = 0; i < 16; ++i) s[i] = ex2(s[i] + c[i]);
        const bf16x8 W0 = packbf(s, 0), W1 = packbf(s, 1);
        LAS unsigned char* vb_ = Vb + (4 * hi + qq) * 64 + 32 * blk + 8 * pp;
        o0 = MFMA_BF16(cat8(trrd(vb_), trrd(vb_ + 8 * 64)), W0, o0); o0 = MFMA_BF16(cat8(trrd(vb_ + 16 * 64), trrd(vb_ + 24 * 64)), W1, o0);
        o1 = MFMA_BF16(cat8(trrd(vb_ + 2048), trrd(vb_ + 2048 + 8 * 64)), W0, o1); o1 = MFMA_BF16(cat8(trrd(vb_ + 2048 + 16 * 64), trrd(vb_ + 2048 + 24 * 64)), W1, o1);
        R += swap_add(tsum);
        if (__all(R < -150.f)) break;
    }
    asm volatile("s_waitcnt vmcnt(0)" ::: "memory");
#undef SB_DMA
    {
        float ss = 0.f;
#pragma unroll
        for (int i = 0; i < 16; ++i) ss += o0[i] * o0[i] + o1[i] * o1[i];
        ss = swap_add(ss);
        const float ro = __builtin_amdgcn_rsqf(ss * (1.f / 64.f) + EPS);
        bf16* Op = MIX_ + (rowbase + tq) * D + h * 64;
        const float* go = g_out_sb_ + h * 64;
#pragma unroll
        for (int g = 0; g < 4; ++g) { const int d0 = 8 * g + 4 * hi; const f32x4 ga = *(const f32x4*)(go + d0), gb = *(const f32x4*)(go + 32 + d0);
            u32x2 wa, wb; wa.x = cvtpk(o0[4 * g] * ro * ga.x, o0[4 * g + 1] * ro * ga.y); wa.y = cvtpk(o0[4 * g + 2] * ro * ga.z, o0[4 * g + 3] * ro * ga.w);
            wb.x = cvtpk(o1[4 * g] * ro * gb.x, o1[4 * g + 1] * ro * gb.y); wb.y = cvtpk(o1[4 * g + 2] * ro * gb.z, o1[4 * g + 3] * ro * gb.w);
            *(GAS u32x2*)(Op + d0) = wa; *(GAS u32x2*)(Op + 32 + d0) = wb; }
    }
    __syncthreads();
}

DI void conv_silu8(const v4u (&xr)[4], const float (&cw)[4][8], float scale, float (&y)[8]) {
#pragma unroll
    for (int e = 0; e < 8; ++e) y[e] = 0.f;
#pragma unroll
    for (int j = 0; j < 4; ++j) {
        y[0] += cw[j][0] * bflo(xr[j].x); y[1] += cw[j][1] * bfhi(xr[j].x); y[2] += cw[j][2] * bflo(xr[j].y); y[3] += cw[j][3] * bfhi(xr[j].y);
        y[4] += cw[j][4] * bflo(xr[j].z); y[5] += cw[j][5] * bfhi(xr[j].z); y[6] += cw[j][6] * bflo(xr[j].w); y[7] += cw[j][7] * bfhi(xr[j].w); }
#pragma unroll
    for (int e = 0; e < 8; ++e) y[e] = scale * y[e] * __builtin_amdgcn_rcpf(1.f + fexp(-y[e]));
}
DI float log_sigmoid(float x) { return fminf(x, 0.f) - 0.6931471805599453f * lg2(1.f + fexp(-fabsf(x))); }
DI float wave_scan_incl(float a, int lane) {
#pragma unroll
    for (int o = 1; o < 64; o <<= 1) { const float t = __shfl_up(a, o); if (lane >= o) a += t; }
    return a;
}

constexpr int LDS_CW = 65536;
DI void stage_conv_w(const Frame& F) {
    const float* const conv_w_ = inp(I_CONVW); LAS float* cwl = (LAS float*)(F.lds + LDS_CW);
    for (int i = F.tid; i < 4096; i += NTHR) cwl[i] = conv_w_[i];
    __syncthreads();
}
DI void load_cw8(const Frame& F, int colbase, float (&cw)[4][8]) {
    const LAS float* cwl = (const LAS float*)(F.lds + LDS_CW);
#pragma unroll
    for (int j = 0; j < 4; ++j) { const f32x4 a = *(const LAS f32x4*)(cwl + j * 1024 + colbase), b = *(const LAS f32x4*)(cwl + j * 1024 + colbase + 4);
        cw[j][0] = a.x; cw[j][1] = a.y; cw[j][2] = a.z; cw[j][3] = a.w; cw[j][4] = b.x; cw[j][5] = b.y; cw[j][6] = b.z; cw[j][7] = b.w; }
}
struct MlLocalRegs { v4u kraw[2][4]; v4u vraw[2]; float gi, gf; };
DI void ml_local_load(const Frame& F, int chain, int c, MlLocalRegs& R) {
    bf16* const PROJ_ = WSP(bf16, WS_PROJ); float* const GATES_ = WSP(float, WS_GATES);
    const int tid = F.tid, lane = F.lane;
    const int b = chain >> 2, hh = chain & 3; const size_t rowbase = (size_t)b * SEQ; const int t0 = c * 64;
    const bf16* P = PROJ_;
    const int kc = tid & 15, kr0 = tid >> 4;
    const bf16* Kg = P + rowbase * NPROJ + C_KML + hh * 128 + kc * 8;
#pragma unroll
    for (int i = 0; i < 2; ++i)
#pragma unroll
        for (int j = 0; j < 4; ++j) { const int tt = t0 + kr0 + 32 * i - 3 + j; R.kraw[i][j] = (tt >= 0) ? *(const GAS v4u*)(Kg + (size_t)tt * NPROJ) : (v4u){0u, 0u, 0u, 0u}; }
#pragma unroll
    for (int i = 0; i < 2; ++i) R.vraw[i] = *(const GAS v4u*)(P + (rowbase + t0 + kr0 + 32 * i) * NPROJ + C_VML + hh * 128 + kc * 8);
    const float* Gg = GATES_ + (rowbase + t0 + lane) * 8;
    R.gi = Gg[hh]; R.gf = Gg[4 + hh];
}
DI void ml_local_unit(const Frame& F, int chain, int c, const MlLocalRegs& RG) {
    bf16* const CST_ = WSP(bf16, WS_CST); float* const NST_ = WSP(float, WS_NST); float* const SCL_ = WSP(float, WS_SCL);
    LAS unsigned char* L = F.lds;
    LAS float* Lws = (LAS float*)(L + 32768);
    const int tid = F.tid, lane = F.lane, w = F.wave, r = lane & 31, hi = lane >> 5;
    const int i16 = lane & 15, qq = i16 >> 2, pp = i16 & 3, blk = (lane >> 4) & 1;
    const int hh = chain & 3;
    const int kbk = w & 3, vb0 = 2 * (w >> 2);
    const int kc = tid & 15, kr0 = tid >> 4;
    v4u kraw[2][4], vraw[2];
#pragma unroll
    for (int i = 0; i < 2; ++i) { vraw[i] = RG.vraw[i];
#pragma unroll
        for (int j = 0; j < 4; ++j) kraw[i][j] = RG.kraw[i][j]; }
    const float gi = RG.gi, gf = RG.gf;
    const float a = wave_scan_incl(log_sigmoid(gf), lane);
    const float a_end = __shfl(a, 63);
    const float lw = a_end - a + gi;
    const float m_loc = wave_max(lw);
    const float ws = fexp(lw - m_loc);
    if (w == 0) Lws[lane] = ws;
    {
        float cw[4][8]; load_cw8(F, 512 + hh * 128 + kc * 8, cw);
#pragma unroll
        for (int i = 0; i < 2; ++i) { float y[8]; conv_silu8(kraw[i], cw, 0.08838834764831845f, y);
            v4u o; o.x = cvtpk(y[0], y[1]); o.y = cvtpk(y[2], y[3]); o.z = cvtpk(y[4], y[5]); o.w = cvtpk(y[6], y[7]);
            *(LAS v4u*)(L + (kc >> 2) * 4096 + (kr0 + 32 * i) * 64 + (kc & 3) * 16) = o; }
#pragma unroll
        for (int i = 0; i < 2; ++i) { const int row = kr0 + 32 * i; const float wsr = __shfl(ws, row);
            v4u o; o.x = cvtpk(bflo(vraw[i].x) * wsr, bfhi(vraw[i].x) * wsr); o.y = cvtpk(bflo(vraw[i].y) * wsr, bfhi(vraw[i].y) * wsr); o.z = cvtpk(bflo(vraw[i].z) * wsr, bfhi(vraw[i].z) * wsr); o.w = cvtpk(bflo(vraw[i].w) * wsr, bfhi(vraw[i].w) * wsr);
            *(LAS v4u*)(L + 16384 + (kc >> 2) * 4096 + row * 64 + (kc & 3) * 16) = o; }
    }
    __syncthreads();
    f32x16 acc0, acc1;
#pragma unroll
    for (int i = 0; i < 16; ++i) { acc0[i] = 0.f; acc1[i] = 0.f; }
#pragma unroll
    for (int kk = 0; kk < 4; ++kk) { const int rows = 16 * kk + 8 * hi + qq;
        LAS unsigned char* ka = L + kbk * 4096 + rows * 64 + 32 * blk + 8 * pp; LAS unsigned char* va = L + 16384 + vb0 * 4096 + rows * 64 + 32 * blk + 8 * pp;
        const bf16x8 A = cat8(trrd(ka), trrd(ka + 4 * 64));
        acc0 = MFMA_BF16(A, cat8(trrd(va), trrd(va + 4 * 64)), acc0); acc1 = MFMA_BF16(A, cat8(trrd(va + 4096), trrd(va + 4096 + 4 * 64)), acc1); }
    {
        bf16* Cp = CST_ + ((size_t)(chain * 64 + c) * 128 + vb0 * 32 + r) * 128 + kbk * 32 + 4 * hi;
#pragma unroll
        for (int g = 0; g < 4; ++g) { u32x2 o; o.x = cvtpk(acc0[4 * g], acc0[4 * g + 1]); o.y = cvtpk(acc0[4 * g + 2], acc0[4 * g + 3]); *(GAS u32x2*)(Cp + 8 * g) = o;
            u32x2 o1; o1.x = cvtpk(acc1[4 * g], acc1[4 * g + 1]); o1.y = cvtpk(acc1[4 * g + 2], acc1[4 * g + 3]); *(GAS u32x2*)(Cp + 32 * 128 + 8 * g) = o1; }
    }
    {
        const int k = 16 * w + (lane & 15), sq = lane >> 4; float part = 0.f;
        const LAS unsigned short* kcol = (const LAS unsigned short*)(L + (k >> 5) * 4096 + (k & 31) * 2);
#pragma unroll
        for (int e = 0; e < 16; ++e) part += Lws[16 * sq + e] * __uint_as_float((unsigned)kcol[(16 * sq + e) * 32] << 16);
        part += __shfl_xor(part, 16); part += __shfl_xor(part, 32);
        if (lane < 16) NST_[(size_t)(chain * 64 + c) * 128 + k] = part;
        if (tid == 0) { SCL_[(chain * 64 + c) * 2] = a_end; SCL_[(chain * 64 + c) * 2 + 1] = m_loc; }
    }
    __syncthreads();
}
DI void ml_scan_phase(const Frame& F) {
    bf16* const CST_ = WSP(bf16, WS_CST); float* const NST_ = WSP(float, WS_NST); float* const SCL_ = WSP(float, WS_SCL); float* const MST_ = WSP(float, WS_MST);
    for (int gt = F.vcu * NTHR + F.tid; gt < 32 * 4096; gt += F.G * NTHR) {
        const int chain = gt >> 12, rem = gt & 4095;
        const float ae_l = SCL_[(chain * 64 + F.lane) * 2], ml_l = SCL_[(chain * 64 + F.lane) * 2 + 1];
        u32x2* Cp = (u32x2*)(CST_ + (size_t)chain * 64 * 16384 + (size_t)rem * 4);
        f32x4* Np = (f32x4*)(NST_ + (size_t)chain * 64 * 128 + rem * 4);
        const bool do_n = rem < 32;
        float c0 = 0.f, c1 = 0.f, c2 = 0.f, c3 = 0.f; f32x4 nn = {0.f, 0.f, 0.f, 0.f}; float m = 0.f;
        u32x2 dr[8]; f32x4 nr[8];
#pragma unroll
        for (int i = 0; i < 8; ++i) { dr[i] = Cp[(size_t)i * 4096]; if (do_n) nr[i] = Np[i * 32]; }
        for (int c0_ = 0; c0_ < 64; c0_ += 8) {
#pragma unroll
            for (int i = 0; i < 8; ++i) { const int c = c0_ + i;
                if (c < 63) {
                    const u32x2 dcur = dr[i]; const f32x4 dn = nr[i];
                    if (c + 8 < 63) { dr[i] = Cp[(size_t)(c + 8) * 4096]; if (do_n) nr[i] = Np[(c + 8) * 32]; }
                    const float ae = __builtin_bit_cast(float, __builtin_amdgcn_readlane(__builtin_bit_cast(int, ae_l), c)), ml = __builtin_bit_cast(float, __builtin_amdgcn_readlane(__builtin_bit_cast(int, ml_l), c));
                    const float mn = fmaxf(ae + m, ml), d1 = fexp(ae + m - mn), d2 = fexp(ml - mn);
                    c0 = d1 * c0 + d2 * bflo(dcur.x); c1 = d1 * c1 + d2 * bfhi(dcur.x); c2 = d1 * c2 + d2 * bflo(dcur.y); c3 = d1 * c3 + d2 * bfhi(dcur.y);
                    u32x2 o; o.x = cvtpk(c0, c1); o.y = cvtpk(c2, c3); Cp[(size_t)c * 4096] = o;
                    if (do_n) { nn = nn * d1 + dn * d2; Np[c * 32] = nn; }
                    if (rem == 0) MST_[chain * 64 + c] = mn;
                    m = mn; } }
        }
    }
}
DI void ml_out_unit(const Frame& F, int chain, int c, int nchain = -1, int nc = 0) {
    bf16* const PROJ_ = WSP(bf16, WS_PROJ); float* const GATES_ = WSP(float, WS_GATES); float* const MST_ = WSP(float, WS_MST); bf16* const CST_ = WSP(bf16, WS_CST); float* const NST_ = WSP(float, WS_NST); bf16* const MIX_ = WSP(bf16, WS_MIX); const float* const g_out_ml_ = inp(I_GOML);
    LAS unsigned char* L = F.lds;
    LAS float* Lbs = (LAS float*)(L + 49152); LAS float* Lav = (LAS float*)(L + 49408); LAS float* Lex = (LAS float*)(L + 49664);
    const int tid = F.tid, lane = F.lane, w = F.wave, r = lane & 31, hi = lane >> 5;
    const int i16 = lane & 15, qq = i16 >> 2, pp = i16 & 3, blk = (lane >> 4) & 1;
    const int b = chain >> 2, hh = chain & 3; const size_t rowbase = (size_t)b * SEQ; const int t0 = c * 64;
    const int tb = w >> 2, vb = w & 3;
    const bf16* P = PROJ_;
    {
        const int kc = tid & 15, kr0 = tid >> 4;
#pragma unroll
        for (int which = 0; which < 2; ++which) {
            const int colbase = (which ? 512 : 0) + hh * 128 + kc * 8;
            float cw[4][8]; load_cw8(F, colbase, cw);
            const bf16* Xg = P + rowbase * NPROJ + C_QML + colbase;
#pragma unroll
            for (int i = 0; i < 2; ++i) { const int row = kr0 + 32 * i; v4u xr[4];
#pragma unroll
                for (int j = 0; j < 4; ++j) { const int tt = t0 + row - 3 + j; xr[j] = (tt >= 0) ? *(const GAS v4u*)(Xg + (size_t)tt * NPROJ) : (v4u){0u, 0u, 0u, 0u}; }
                float y[8]; conv_silu8(xr, cw, which ? 0.08838834764831845f : 1.0f, y);
                v4u o; o.x = cvtpk(y[0], y[1]); o.y = cvtpk(y[2], y[3]); o.z = cvtpk(y[4], y[5]); o.w = cvtpk(y[6], y[7]);
                *(LAS v4u*)(L + which * 16384 + row * 256 + ((kc ^ (row & 15)) * 16)) = o; }
        }
#pragma unroll
        for (int i = 0; i < 2; ++i) { const int row = kr0 + 32 * i;
            const v4u v = *(const GAS v4u*)(P + (rowbase + t0 + row) * NPROJ + C_VML + hh * 128 + kc * 8);
            *(LAS v4u*)(L + 32768 + (kc >> 2) * 4096 + row * 64 + (kc & 3) * 16) = v; }
        if (w == 0) { const float* Gg = GATES_ + (rowbase + t0 + lane) * 8; const float a = wave_scan_incl(log_sigmoid(Gg[4 + hh]), lane); Lav[lane] = a; Lbs[lane] = Gg[hh] - a; }
    }
    const float mprev = (c > 0) ? MST_[chain * 64 + c - 1] : 0.f;
    bf16x8 cf[8], nf[8];
    if (c > 0) {
        const bf16* Cp = CST_ + ((size_t)(chain * 64 + c - 1) * 128 + vb * 32 + r) * 128 + 8 * hi;
        const float* Np = NST_ + (size_t)(chain * 64 + c - 1) * 128 + 8 * hi;
        const bool nrow = (r == 0) || (r == 4);
#pragma unroll
        for (int kk = 0; kk < 8; ++kk) { cf[kk] = *(const GAS bf16x8*)(Cp + 16 * kk);
            const f32x4 n0 = *(const f32x4*)(Np + 16 * kk), n1 = *(const f32x4*)(Np + 16 * kk + 4);
            v4u o; o.x = cvtpk(n0.x, n0.y); o.y = cvtpk(n0.z, n0.w); o.z = cvtpk(n1.x, n1.y); o.w = cvtpk(n1.z, n1.w);
            if (!nrow) o = (v4u){0u, 0u, 0u, 0u};
            nf[kk] = __builtin_bit_cast(bf16x8, o); }
    }
    unsigned tch0 = 0u, tch1 = 0u;
    if (nchain >= 0) {
        const unsigned nhh = (unsigned)nchain & 3u, nrow0 = (unsigned)(nchain >> 2) * SEQ + (unsigned)nc * 64u, cst = (unsigned)(nchain * 64 + nc - 1);
        const unsigned rr = (unsigned)tid >> 2, part = (unsigned)tid & 3u;
        unsigned o0 = (unsigned)WS_PROJ + ((nrow0 - 3u + rr) * NPROJ + C_QML + (part >> 1) * 512u + nhh * 128u + (part & 1u) * 64u) * 2u; bool v0 = (nc > 0) || (rr >= 3u);
        if (tid >= 268) { o0 = (unsigned)WS_CST + cst * 32768u + (unsigned)(tid - 268) * 128u; v0 = nc > 0; }
        unsigned o1 = (unsigned)WS_PROJ + ((nrow0 + rr) * NPROJ + ((part >> 1) ? C_OML : C_VML) + nhh * 128u + (part & 1u) * 64u) * 2u; bool v1 = true;
        if (tid >= 256) { o1 = (unsigned)WS_CST + cst * 32768u + (unsigned)(244 + tid - 256) * 128u; v1 = nc > 0; }
        if (tid >= 268) { o1 = (unsigned)WS_NST + cst * 512u + (unsigned)(tid - 268) * 128u; }
        if (tid >= 272) { o1 = (unsigned)WS_GATES + nrow0 * 32u + (unsigned)(tid - 272) * 128u; v1 = tid < 288; }
        const GAS unsigned char* wsb = (const GAS unsigned char*)F.ws;
        if (v0) tch0 = *(const GAS unsigned*)(wsb + o0);
        if (v1) tch1 = *(const GAS unsigned*)(wsb + o1);
    }
    __syncthreads();
    bf16x8 qf[8];
    f32x16 s0, s1;
#pragma unroll
    for (int i = 0; i < 16; ++i) { s0[i] = 0.f; s1[i] = 0.f; }
#pragma unroll
    for (int kk = 0; kk < 8; ++kk) { const int ch = 2 * kk + hi; const int rq_ = 32 * tb + r;
        qf[kk] = *(const LAS bf16x8*)(L + rq_ * 256 + ((ch ^ (rq_ & 15)) * 16));
        const bf16x8 a0 = *(const LAS bf16x8*)(L + 16384 + r * 256 + ((ch ^ (r & 15)) * 16));
        const bf16x8 a1 = *(const LAS bf16x8*)(L + 16384 + (32 + r) * 256 + ((ch ^ ((32 + r) & 15)) * 16));
        s0 = MFMA_BF16(a0, qf[kk], s0); s1 = MFMA_BF16(a1, qf[kk], s1); }
    const int tl = 32 * tb + r; const float a_t = Lav[tl];
    f32x16 d0, d1; float mrow = -INFINITY;
#pragma unroll
    for (int g = 0; g < 4; ++g) { const f32x4 b0 = *(const LAS f32x4*)(Lbs + 8 * g + 4 * hi), b1 = *(const LAS f32x4*)(Lbs + 32 + 8 * g + 4 * hi);
#pragma unroll
        for (int e = 0; e < 4; ++e) { const int sl = 8 * g + 4 * hi + e;
            d0[4 * g + e] = (sl <= tl) ? a_t + b0[e] : -INFINITY; d1[4 * g + e] = (32 + sl <= tl) ? a_t + b1[e] : -INFINITY;
            mrow = fmaxf(mrow, fmaxf(d0[4 * g + e], d1[4 * g + e])); } }
    mrow = fmaxf(swap_max(mrow), a_t + mprev);
    float psum = 0.f;
#pragma unroll
    for (int i = 0; i < 16; ++i) { s0[i] *= fexp(d0[i] - mrow); s1[i] *= fexp(d1[i] - mrow); psum += s0[i] + s1[i]; }
    const float w_inter = fexp(a_t + mprev - mrow);
    float den = swap_add(psum);
    const bf16x8 P00 = packbf(s0, 0), P01 = packbf(s0, 1), P10 = packbf(s1, 0), P11 = packbf(s1, 1);
    f32x16 num;
#pragma unroll
    for (int i = 0; i < 16; ++i) num[i] = 0.f;
    {
        LAS unsigned char* vb_ = L + 32768 + vb * 4096 + (4 * hi + qq) * 64 + 32 * blk + 8 * pp;
        num = MFMA_BF16(cat8(trrd(vb_), trrd(vb_ + 8 * 64)), P00, num); num = MFMA_BF16(cat8(trrd(vb_ + 16 * 64), trrd(vb_ + 24 * 64)), P01, num);
        num = MFMA_BF16(cat8(trrd(vb_ + 32 * 64), trrd(vb_ + 40 * 64)), P10, num); num = MFMA_BF16(cat8(trrd(vb_ + 48 * 64), trrd(vb_ + 56 * 64)), P11, num);
    }
    if (c > 0) {
        f32x16 it, dn;
#pragma unroll
        for (int i = 0; i < 16; ++i) { it[i] = 0.f; dn[i] = 0.f; }
#pragma unroll
        for (int kk = 0; kk < 8; ++kk) { it = MFMA_BF16(cf[kk], qf[kk], it); dn = MFMA_BF16(nf[kk], qf[kk], dn); }
#pragma unroll
        for (int i = 0; i < 16; ++i) num[i] += w_inter * it[i];
        den += w_inter * dn[0];
    }
    const float inv = __builtin_amdgcn_rcpf(fmaxf(fabsf(den), fexp(-mrow)));
    float ss = 0.f;
#pragma unroll
    for (int i = 0; i < 16; ++i) { num[i] *= inv; ss += num[i] * num[i]; }
    ss = swap_add(ss);
    if (lane < 32) Lex[(tb * 4 + vb) * 32 + r] = ss;
    __syncthreads();
    const float tot = (Lex[(tb * 4 + 0) * 32 + r] + Lex[(tb * 4 + 1) * 32 + r]) + (Lex[(tb * 4 + 2) * 32 + r] + Lex[(tb * 4 + 3) * 32 + r]);
    const float rstd = 1.f / sqrtf(tot * (1.f / 128.f) + EPS);
    {
        const size_t trow = rowbase + t0 + tl;
        const bf16* Og = P + trow * NPROJ + C_OML + hh * 128 + vb * 32 + 4 * hi;
        bf16* Mp = MIX_ + trow * D + 512 + hh * 128 + vb * 32 + 4 * hi;
        const float* go = g_out_ml_ + hh * 128 + vb * 32 + 4 * hi;
#pragma unroll
        for (int g = 0; g < 4; ++g) { const u32x2 og = *(const GAS u32x2*)(Og + 8 * g); const f32x4 gg = *(const f32x4*)(go + 8 * g);
            const float o0 = bflo(og.x), o1 = bfhi(og.x), o2 = bflo(og.y), o3 = bfhi(og.y);
            u32x2 o; o.x = cvtpk(num[4 * g] * rstd * gg.x * __builtin_amdgcn_rcpf(1.f + fexp(-o0)), num[4 * g + 1] * rstd * gg.y * __builtin_amdgcn_rcpf(1.f + fexp(-o1)));
            o.y = cvtpk(num[4 * g + 2] * rstd * gg.z * __builtin_amdgcn_rcpf(1.f + fexp(-o2)), num[4 * g + 3] * rstd * gg.w * __builtin_amdgcn_rcpf(1.f + fexp(-o3)));
            *(GAS u32x2*)(Mp + 8 * g) = o; }
    }
    asm volatile("" :: "v"(tch0), "v"(tch1));
    __syncthreads();
}

#define TK_CE(A, B) do { const float hi_ = fmaxf((A), (B)), lo_ = fminf((A), (B)); (A) = hi_; (B) = lo_; } while (0)
DI void tk_sort16(float (&a)[16]) {
#pragma unroll
    for (int k = 2; k <= 16; k <<= 1)
#pragma unroll
        for (int j = k >> 1; j > 0; j >>= 1)
#pragma unroll
            for (int i = 0; i < 16; ++i) { const int l = i ^ j; if (l > i) { if ((i & k) == 0) TK_CE(a[i], a[l]); else TK_CE(a[l], a[i]); } }
}
DI void tk_merge16(float (&a)[16], const float (&b)[16]) {
#pragma unroll
    for (int i = 0; i < 16; ++i) a[i] = fmaxf(a[i], b[15 - i]);
#pragma unroll
    for (int j = 8; j > 0; j >>= 1)
#pragma unroll
        for (int i = 0; i < 16; ++i) { const int l = i ^ j; if (l > i) TK_CE(a[i], a[l]); }
}
DI void tk_stage2(const LAS float* la, const LAS float* lb, int* IDX_, float* GATEW_, size_t o) {
        float a[16], bb[16], cnd[64];
#pragma unroll
        for (int q = 0; q < 16; ++q) { a[q] = la[q]; bb[q] = lb[q]; }
        int cnt = 0;
#pragma unroll
        for (int i = 0; i < 16; ++i)
#pragma unroll
            for (int j = 0; j < 16; ++j) if ((i + 1) * (j + 1) <= 16) { cnd[cnt] = __uint_as_float((__float_as_uint(a[i] + bb[j]) & ~0xFFu) | (unsigned)(i * 16 + j)); ++cnt; }
#pragma unroll
        for (int q = 50; q < 64; ++q) cnd[q] = -INFINITY;
        float top[16];
#pragma unroll
        for (int c = 0; c < 4; ++c) { float ch[16];
#pragma unroll
            for (int q = 0; q < 16; ++q) ch[q] = cnd[16 * c + q];
            tk_sort16(ch);
            if (c == 0) {
#pragma unroll
                for (int q = 0; q < 16; ++q) top[q] = ch[q];
            } else tk_merge16(top, ch); }
        float sv[16]; int ei[16]; float mx = -INFINITY;
#pragma unroll
        for (int q = 0; q < 16; ++q) { const unsigned code = __float_as_uint(top[q]) & 0xFFu; const float va = la[code >> 4], vb = lb[code & 15u];
            ei[q] = (int)((__float_as_uint(va) & 0x7Fu) * 128u + (__float_as_uint(vb) & 0x7Fu)); sv[q] = va + vb; mx = fmaxf(mx, sv[q]); }
        float sum = 0.f;
#pragma unroll
        for (int q = 0; q < 16; ++q) { sv[q] = fexp(sv[q] - mx); sum += sv[q]; }
        const float inv = 1.f / sum;
#pragma unroll
#define TK_PK(Q) (((__builtin_bit_cast(unsigned, sv[(Q)] * inv) + 0x2000u) & 0xFFFFC000u) | (unsigned)ei[(Q)])
        for (int q = 0; q < 16; q += 4) *(GAS v4u*)(IDX_ + o + q) = (v4u){TK_PK(q), TK_PK(q + 1), TK_PK(q + 2), TK_PK(q + 3)};
#undef TK_PK
        (void)GATEW_;
    }
struct EpiTopK {
    static constexpr bool PERM = false, AFTER_DRAIN = true;
    int* IDX; float* GATEW;
    DI void fused(f32x4 (&acc)[2][2][4][2], const pg8::Unit& u, int wr, int wc, int fr, int fq, LAS unsigned char* lds, int wid, int lane) const {
        LAS float* Tl = (LAS float*)lds;
        LAS float* Lh2 = (LAS float*)lds;
        LAS float* Ls = (LAS float*)(lds + 36864);
        const int tid = wid * 64 + lane, tl = tid & 127, p = (tid >> 7) & 1, half = tid >> 8;
#pragma unroll
        for (int ai = 0; ai < 2; ++ai) {
#pragma unroll
            for (int bj = 0; bj < 2; ++bj)
#pragma unroll
                for (int m = 0; m < 4; ++m)
#pragma unroll
                    for (int n = 0; n < 2; ++n) { LAS float* d = Tl + (wr * 64 + m * 16 + fr) * 257 + bj * 128 + wc * 32 + n * 16 + fq * 4; const f32x4 v = acc[ai][bj][m][n]; d[0] = v.x; d[1] = v.y; d[2] = v.z; d[3] = v.w; }
            __syncthreads();
            float run[16];
            {
                const LAS float* src = Tl + tl * 257 + p * 128 + half * 64;
#pragma unroll
                for (int c = 0; c < 4; ++c) { float ch[16];
#pragma unroll
                    for (int q = 0; q < 16; ++q) ch[q] = __uint_as_float((__float_as_uint(src[16 * c + q]) & ~0x7Fu) | (unsigned)(half * 64 + 16 * c + q));
                    tk_sort16(ch);
                    if (c == 0) {
#pragma unroll
                        for (int q = 0; q < 16; ++q) run[q] = ch[q];
                    } else tk_merge16(run, ch); }
            }
            __syncthreads();
#pragma unroll
            for (int q = 0; q < 16; ++q) Lh2[((tl * 2 + p) * 2 + half) * 17 + q] = run[q];
            __syncthreads();
            if (half == 0) { float oth[16];
#pragma unroll
                for (int q = 0; q < 16; ++q) oth[q] = Lh2[((tl * 2 + p) * 2 + 1) * 17 + q];
                tk_merge16(run, oth);
#pragma unroll
                for (int q = 0; q < 16; ++q) Ls[(tl * 2 + p) * 17 + q] = run[q]; }
            __syncthreads();
            if (tid < 128) tk_stage2(Ls + (tl * 2) * 17, Ls + (tl * 2) * 17 + 17, IDX, GATEW, (size_t)(u.pm * 256 + ai * 128 + tl) * 128 + u.pn * 16);
            __syncthreads();
        }
    }
};
struct OneUnit {
    pg8::Unit u;
    __device__ __forceinline__ bool next(int i, pg8::Unit& o) const { if (i) return false; o = u; return true; }
    __device__ __forceinline__ void a_ready(const pg8::Unit&) const {}
    __device__ __forceinline__ void done(const pg8::Unit&) const {}
};

DI float gelu_erf(float x) { return 0.5f * x * (1.f + erff(x * 0.7071067811865476f)); }
#define DPP_ADD(v, ctrl, rmask) ((v) + __builtin_bit_cast(float, __builtin_amdgcn_update_dpp(0, __builtin_bit_cast(int, (v)), (ctrl), (rmask), 0xF, false)))
#ifndef PEER_EBL
#define PEER_EBL 9
#endif
constexpr int PEER_EB_LOG = PEER_EBL;
#ifndef PEER_PROBE_MASK
#define PEER_PROBE_MASK 0xFFFF
#endif
typedef float f32x2v __attribute__((ext_vector_type(2)));
DI float gelu_cdf(float v) {
    const float av = fabsf(v), t = __builtin_amdgcn_rcpf(av * 0.2316418882f + 1.0f);
    float q = t * 0.5307027145f - 0.7265760135f; q = q * t + 0.7107068705f; q = q * t - 0.142248368f; q = q * t + 0.127414796f; q = q * t;
    const float m = v * (q * ex2(v * v * -0.72134752044f));
    return v < 0.f ? m : v - m;
}
#define DPP_ADDI(v, ctrl, rmask) ((v) + __builtin_amdgcn_update_dpp(0, (v), (ctrl), (rmask), 0xF, false))
DI void peer_phase(const Frame& F, bool scratch_dst) {
    bf16* const XN_ = WSP(bf16, WS_XN); int* const IDX_ = WSP(int, WS_IDX); float* const GATEW_ = WSP(float, WS_GATE); float* const mod_ = WSP(float, WS_MOD); float* const out_ = (float*)inp(I_OUT); const bf16* const X1B_ = WSP(bf16, WS_X1B);
    const unsigned char* const EU4 = WSP(unsigned char, WS_EXPU); const unsigned char* const EV4 = WSP(unsigned char, WS_EXPV); const float* const SUI_ = WSP(float, WS_SUI); const float* const SVI_ = WSP(float, WS_SVI);
    const int gw = F.vcu * NWAVES + F.wave, NGW = F.G * NWAVES, lane = F.lane, g = lane >> 3, j = lane & 7;
    LAS unsigned char* wl = F.lds + F.wave * 17408;
    volatile LAS int* Le = (volatile LAS int*)(wl + g * 512); volatile LAS float* Lg = (volatile LAS float*)(wl + 4096 + g * 512); volatile LAS int* Lp = (volatile LAS int*)(wl + 8192 + g * 512);
    volatile LAS int* Lx = (volatile LAS int*)(wl + 12288 + g * 512); LAS int* Lh = (LAS int*)(wl + 16384 + g * 128);
    for (int grp = gw; grp < T / 8; grp += NGW) {
        const size_t t = (size_t)grp * 8 + g;
        int xh[16], xl[16]; float sxi;
#ifdef PEER_DUP_S
        auto qs_ = [&]() __attribute__((always_inline)) {
#endif
        {
            const unsigned char* xq = WSP(unsigned char, WS_XQ) + t * 1024 + 16 * j;
#pragma unroll
            for (int q = 0; q < 4; ++q) { const v4u a = *(const GAS v4u*)(xq + 128 * q), b = *(const GAS v4u*)(xq + 512 + 128 * q);
#pragma unroll
                for (int w_ = 0; w_ < 4; ++w_) { xh[4 * q + w_] = (int)a[w_]; xl[4 * q + w_] = (int)b[w_]; } }
            sxi = WSP(float, WS_XS)[t];
        }
        {
            int ide[16]; float gte[16]; int rk[16];
#pragma unroll
            for (int m = 0; m < 16; ++m) { const unsigned pk_ = (unsigned)IDX_[t * 128 + j + 8 * m]; ide[m] = (int)(pk_ & 0x3FFFu); gte[m] = __builtin_bit_cast(float, pk_ & 0xFFFFC000u); }
#pragma unroll
            for (int m = 0; m < 4; ++m) Lh[j + 8 * m] = 0;
#pragma unroll
            for (int m = 0; m < 16; ++m) rk[m] = __hip_atomic_fetch_add(Lh + (ide[m] >> PEER_EB_LOG), 1, __ATOMIC_RELAXED, __HIP_MEMORY_SCOPE_WORKGROUP);
            {
                const int h0 = ((volatile LAS int*)Lh)[4 * j], h1 = ((volatile LAS int*)Lh)[4 * j + 1], h2 = ((volatile LAS int*)Lh)[4 * j + 2], h3 = ((volatile LAS int*)Lh)[4 * j + 3];
                const int tot = (h0 + h1) + (h2 + h3); int inc = tot;
#pragma unroll
                for (int o = 1; o < 8; o <<= 1) { const int tt = __shfl_up(inc, o, 8); if (j >= o) inc += tt; }
                const int ex = inc - tot;
                ((volatile LAS int*)Lh)[4 * j] = ex; ((volatile LAS int*)Lh)[4 * j + 1] = ex + h0; ((volatile LAS int*)Lh)[4 * j + 2] = ex + h0 + h1; ((volatile LAS int*)Lh)[4 * j + 3] = ex + h0 + h1 + h2;
            }
#pragma unroll
            for (int m = 0; m < 16; ++m) { const int pos = ((volatile LAS int*)Lh)[ide[m] >> PEER_EB_LOG] + rk[m]; Le[pos] = ide[m]; Lg[pos] = gte[m] * SVI_[ide[m]]; Lp[pos] = __builtin_bit_cast(int, SUI_[ide[m]] * sxi); }
        }
#ifdef PEER_DUP_S
        }; qs_(); __builtin_amdgcn_sched_barrier(0); qs_();
#endif
        v4u R0[4], R1[4], R2[4], R3[4];
#define PEER_LOADU(RR, S0) do { const size_t ro_ = (size_t)(Le[(S0)] & (scratch_dst ? PEER_PROBE_MASK : 0xFFFF)) * 512 + 16 * j; _Pragma("unroll") for (int q = 0; q < 4; ++q) RR[q] = *(const GAS v4u*)(EU4 + ro_ + 128 * q); } while (0)
#define PEER_DOTU(RR, EOUT) do { int h0_ = 0, h1_ = 0, l0_ = 0, l1_ = 0; \
            _Pragma("unroll") for (int q = 0; q < 4; q += 2) _Pragma("unroll") for (int w_ = 0; w_ < 4; ++w_) { \
                h0_ = __builtin_amdgcn_sdot8((int)RR[q][w_], xh[4 * q + w_], h0_, false); l0_ = __builtin_amdgcn_sdot8((int)RR[q][w_], xl[4 * q + w_], l0_, false); \
                h1_ = __builtin_amdgcn_sdot8((int)RR[q + 1][w_], xh[4 * q + 4 + w_], h1_, false); l1_ = __builtin_amdgcn_sdot8((int)RR[q + 1][w_], xl[4 * q + 4 + w_], l1_, false); } \
            int e_ = ((h0_ + h1_) << 4) + (l0_ + l1_); e_ = DPP_ADDI(e_, 0xB1, 0xF); e_ = DPP_ADDI(e_, 0x4E, 0xF); e_ = DPP_ADDI(e_, 0x141, 0xF); EOUT = e_; } while (0)
#define PEER_SWEEPU(BODY0, BODY1, BODY2, BODY3) do { \
            PEER_LOADU(R0, 0); PEER_LOADU(R1, 1); PEER_LOADU(R2, 2); PEER_LOADU(R3, 3); \
            for (int s = 0; s < 128; s += 4) { \
                BODY0; if (s + 4 < 128) PEER_LOADU(R0, s + 4); \
                BODY1; if (s + 4 < 128) PEER_LOADU(R1, s + 5); \
                BODY2; if (s + 4 < 128) PEER_LOADU(R2, s + 6); \
                BODY3; if (s + 4 < 128) PEER_LOADU(R3, s + 7); } } while (0)
#define PEER_FIN(RR, SS) do { int e1_; PEER_DOTU(RR, e1_); Lx[(SS)] = e1_; } while (0)
        PEER_SWEEPU(PEER_FIN(R0, s), PEER_FIN(R1, s + 1), PEER_FIN(R2, s + 2), PEER_FIN(R3, s + 3));
#ifdef PEER_DUP_U
        PEER_SWEEPU(PEER_FIN(R0, s), PEER_FIN(R1, s + 1), PEER_FIN(R2, s + 2), PEER_FIN(R3, s + 3));
#endif
#undef PEER_FIN
        float yscale; int csum8;
        {
            float cf_[16]; float cmax = 0.f;
#pragma unroll
            for (int i = 0; i < 16; ++i) { const int ix = 16 * j + i; cf_[i] = Lg[ix] * gelu_cdf((float)Lx[ix] * __builtin_bit_cast(float, Lp[ix])); cmax = fmaxf(cmax, fabsf(cf_[i])); }
            cmax = fmaxf(cmax, __shfl_xor(cmax, 1, 8)); cmax = fmaxf(cmax, __shfl_xor(cmax, 2, 8)); cmax = fmaxf(cmax, __shfl_xor(cmax, 4, 8));
            const float cqs = cmax > 0.f ? 127.f / cmax : 0.f; yscale = cmax > 0.f ? cmax / 127.f : 0.f;
            int pk_[4]; int cs_ = 0;
#pragma unroll
            for (int m = 0; m < 4; ++m) { const int q0 = (int)rintf(cf_[4 * m] * cqs), q1 = (int)rintf(cf_[4 * m + 1] * cqs), q2 = (int)rintf(cf_[4 * m + 2] * cqs), q3 = (int)rintf(cf_[4 * m + 3] * cqs);
                cs_ += (q0 + q1) + (q2 + q3);
                pk_[m] = (int)((unsigned)(q0 & 0xff) | ((unsigned)(q1 & 0xff) << 8) | ((unsigned)(q2 & 0xff) << 16) | ((unsigned)q3 << 24)); }
            cs_ += __shfl_xor(cs_, 1, 8); cs_ += __shfl_xor(cs_, 2, 8); cs_ += __shfl_xor(cs_, 4, 8); csum8 = 8 * cs_;
#pragma unroll
            for (int m = 0; m < 4; ++m) Lp[4 * j + m] = pk_[m];
        }
#ifndef PEER_DUP_V
#define PEER_DUP_V 1
#endif
#pragma unroll
        for (int HH = 0; HH < 2 * PEER_DUP_V; ++HH) { const int H = HH & 1;
            int ya[32], yl[32];
#pragma unroll
            for (int i = 0; i < 32; ++i) { ya[i] = 0; yl[i] = 0; }
            v4u RV[8][2];
#define PEER_ROFFV(S0) ((size_t)(Le[(S0)] & (scratch_dst ? PEER_PROBE_MASK : 0xFFFF)) * 512 + 256 * H + 16 * j)
#pragma unroll
            for (int r = 0; r < 8; ++r) { const size_t ro_ = PEER_ROFFV(r); RV[r][0] = *(const GAS v4u*)(EV4 + ro_); RV[r][1] = *(const GAS v4u*)(EV4 + ro_ + 128); }
            for (int bt = 0; bt < 16; ++bt) {
                const int c0_ = Lp[2 * bt], c1_ = Lp[2 * bt + 1];
                size_t ron[8];
#pragma unroll
                for (int r = 0; r < 8; ++r) ron[r] = (bt + 1 < 16) ? PEER_ROFFV(8 * bt + 8 + r) : 0;
#pragma unroll
                for (int q = 0; q < 2; ++q) {
#pragma unroll
                    for (int hb = 0; hb < 2; ++hb) { const int cq_ = hb ? c1_ : c0_;
#pragma unroll
                        for (int w_ = 0; w_ < 4; ++w_) { const unsigned a0 = RV[4 * hb][q][w_], a1 = RV[4 * hb + 1][q][w_], a2 = RV[4 * hb + 2][q][w_], a3 = RV[4 * hb + 3][q][w_];
                            const unsigned p0 = __builtin_amdgcn_perm(a1, a0, 0x05010400u), p1 = __builtin_amdgcn_perm(a1, a0, 0x07030602u), p2 = __builtin_amdgcn_perm(a3, a2, 0x05010400u), p3 = __builtin_amdgcn_perm(a3, a2, 0x07030602u);
                            unsigned Tb[4]; Tb[0] = __builtin_amdgcn_perm(p2, p0, 0x05040100u); Tb[1] = __builtin_amdgcn_perm(p2, p0, 0x07060302u); Tb[2] = __builtin_amdgcn_perm(p3, p1, 0x05040100u); Tb[3] = __builtin_amdgcn_perm(p3, p1, 0x07060302u);
#pragma unroll
                            for (int b_ = 0; b_ < 4; ++b_) { ya[16 * q + 4 * w_ + b_] = __builtin_amdgcn_sdot4((int)Tb[b_], cq_, ya[16 * q + 4 * w_ + b_], false);
                                yl[16 * q + 4 * w_ + b_] = __builtin_amdgcn_sdot4((int)(Tb[b_] & 0x0F0F0F0Fu), cq_, yl[16 * q + 4 * w_ + b_], false); } } }
                    if (bt + 1 < 16) {
#pragma unroll
                        for (int r = 0; r < 8; ++r) RV[r][q] = *(const GAS v4u*)(EV4 + ron[r] + 128 * q); }
                }
            }
#undef PEER_ROFFV
            int to_ = grp * 8 + g, jo_ = j; asm volatile("" : "+v"(to_), "+v"(jo_));
            const int b = to_ / SEQ; const unsigned eo_ = (unsigned)to_ * D + 128 * H + 8 * jo_;
            const float* g2 = mod_ + b * NMOD + 5120 + 128 * H + 8 * jo_;
            const bf16* ip = X1B_ + eo_; float* op = ((scratch_dst || HH + 2 < 2 * PEER_DUP_V) ? WSP(float, WS_SCORES) : out_) + eo_;
#pragma unroll
            for (int q = 0; q < 2; ++q) { __builtin_amdgcn_sched_barrier(0);
#pragma unroll
                for (int w_ = 0; w_ < 4; ++w_)
#pragma unroll
                    for (int nh = 0; nh < 2; ++nh) { const int co = 256 * (2 * (w_ & 1) + nh) + 64 * q + 4 * (w_ >> 1); const int yb = 16 * q + 4 * w_ + 2 * nh;
                        const unsigned long long xw_ = *(const GAS unsigned long long*)(ip + co); const unsigned xlo_ = (unsigned)xw_, xhi_ = (unsigned)(xw_ >> 32); const f32x4 x1 = (f32x4){bflo(xlo_), bfhi(xlo_), bflo(xhi_), bfhi(xhi_)}; const f32x4 gg = *(const f32x4*)(g2 + co) * yscale;
                        f32x4 o; o.x = x1.x + gg.x * (float)(yl[yb] - csum8); o.y = x1.y + gg.y * (float)((ya[yb] - yl[yb]) >> 4); o.z = x1.z + gg.z * (float)(yl[yb + 1] - csum8); o.w = x1.w + gg.w * (float)((ya[yb + 1] - yl[yb + 1]) >> 4);
                        *(GAS f32x4*)(op + co) = o; } }
        }
#undef PEER_LOADU
#undef PEER_DOTU
#undef PEER_SWEEPU
    }
}

DI void ph_inproj(const Frame& F) {
    pg8::Gemm g{WSP(bf16, WS_XN), WSP(bf16, WS_WIN), T, NPROJ, D}; pg8::StaticOrder S; S.init(T, NPROJ, F.G, (int)blockIdx.x);
    pg8::EpiBf16<0> E{WSP(bf16, WS_PROJ), NPROJ, nullptr, 0, 0, 1.f};
    pg8::gemm_phase<pg8::EpiBf16<0>, pg8::StaticOrder, PG8_ALIGN, PG8_SP2>(F.lds, g, S, E);
}
DI void ph_mix(const Frame& F, bool probe_first) {
    stage_conv_w(F);
    {
        int u = F.vcu;
        MlLocalRegs ra;
        if (u < 2048) ml_local_load(F, u >> 6, u & 63, ra);
        const int gwv = F.vcu * NWAVES + F.wave, NGWv = F.G * NWAVES;
        int eb = 2 * gwv;
        while (u < 2048) {
            const int un = u + F.G;
            MlLocalRegs rb;
            if (un < 2048) ml_local_load(F, un >> 6, un & 63, rb);
            ExpRows2 er; const bool ew = eb < 32768;
            if (ew) exp_load2(F, eb, er);
            ml_local_unit(F, u >> 6, u & 63, ra);
            if (ew) exp_conv2(F, eb, er);
            eb += 2 * NGWv;
            ra = rb; u = un;
        }
        for (; eb < 32768; eb += 2 * NGWv) { ExpRows2 er; exp_load2(F, eb, er); exp_conv2(F, eb, er); }
    }
    (void)probe_first;
}
DI void ph_scan_attn(const Frame& F) {
    ml_scan_phase(F);
    __syncthreads();
    for (int u = F.vcu; u < 1024; u += F.G) { const int qb = 15 - (u >> 6), bh = u & 63; sb_unit(F, bh >> 3, bh & 7, qb); }
}
DI void ph_mlout(const Frame& F) { stage_conv_w(F); for (int u = F.vcu; u < 2048; u += F.G) { const int un = u + F.G; ml_out_unit(F, u >> 6, u & 63, un < 2048 ? (un >> 6) : -1, un & 63); } }
#ifndef P5_ALIGN
#define P5_ALIGN PG8_ALIGN
#endif
DI void ph_outproj(const Frame& F) {
    pg8::Gemm g{WSP(bf16, WS_MIX), WSP(bf16, WS_WOUT), T, D, D}; pg8::StaticOrder S; S.init(T, D, F.G, (int)blockIdx.x);
    pg8::EpiResGateBf16 E{inp(I_X), WSP(pg8::bf16_t, WS_X1B), WSP(float, WS_MOD) + 2048, NMOD, SEQ, D};
    pg8::gemm_phase<pg8::EpiResGateBf16, pg8::StaticOrder, P5_ALIGN, PG8_SP2>(F.lds, g, S, E);
}
DI void ph_scores(const Frame& F) {
    pg8::Gemm g{WSP(bf16, WS_XN), WSP(bf16, WS_WEFF), T, NSC, D}; pg8::StaticOrder S; S.init(T, NSC, F.G, (int)blockIdx.x);
    EpiTopK E{WSP(int, WS_IDX), WSP(float, WS_GATE)};
    pg8::Unit un;
    for (int i = 0; S.next(i, un); ++i) { OneUnit S1{un}; pg8::gemm_phase<EpiTopK, OneUnit, false, PG8_SP2>(F.lds, g, S1, E); }
}
constexpr int N_PHASES = 11;
struct Args { const float* in[19]; float* out; unsigned char* ws; int ph_lo, ph_hi; };
__global__ void __launch_bounds__(NTHR, 2) hybrid_fwd(Args args) {
    extern __shared__ __attribute__((aligned(16))) unsigned char lds_raw[];
    Frame F;
    F.lds = (LAS unsigned char*)lds_raw;
    F.MISC = (volatile LAS unsigned*)(F.lds + LDSCTL_OFF + 320);
    F.tid = threadIdx.x; F.lane = F.tid & 63; F.wave = __builtin_amdgcn_readfirstlane(F.tid >> 6);
    F.G = gridDim.x; { const int bx = blockIdx.x; F.vcu = (F.G % 8 == 0) ? (bx % 8) * (F.G / 8) + bx / 8 : bx; }
    F.ws = args.ws;
    F.ctl = (gu32*)(F.ws + WS_CTL);
    for (int u = F.tid; u < (LDS_BYTES - LDSCTL_OFF) / 4; u += NTHR) ((LAS unsigned*)(F.lds + LDSCTL_OFF))[u] = 0u;
    __syncthreads();
    const int lo = args.ph_lo, hi = args.ph_hi;
    const bool one_launch = (hi - lo) > 1;
    XcdBarrier bar; bar.bar = (unsigned*)(F.ctl + CW_BAR); bar.x = 0; bar.st = nullptr;
    if (one_launch) bar = xcd_barrier_post((unsigned*)(F.ctl + CW_BAR), F.MISC + 8);
#ifndef PHMASK
#define PHMASK 0x7ff
#endif
#define IN(k) (((PHMASK >> (k)) & 1) && lo <= (k) && (k) < hi)
#define SEAM(k) do { if (IN(k) && IN((k) + 1)) xcd_barrier(bar); } while (0)
#ifndef REPMASK
#define REPMASK 0
#endif

#define RUN(k, ...) do { if (IN(k)) { if ((REPMASK >> (k)) & 1) { { const bool first = true; (void)first; __VA_ARGS__; } xcd_barrier(bar); } { const bool first = false; (void)first; __VA_ARGS__; } } } while (0)
    RUN(0, p0_phase(F, first ? P0_PARTS : 15)); SEAM(0);
    RUN(1, norm_phase<true>(F, inp(I_X), inp(I_GN1), 0, 1024)); SEAM(1);
    RUN(2, ph_inproj(F)); SEAM(2);
    RUN(3, ph_mix(F, first)); SEAM(3);
    RUN(10, ph_scan_attn(F)); if (IN(10) && IN(4)) xcd_barrier(bar);
    RUN(4, ph_mlout(F)); SEAM(4);
    RUN(5, ph_outproj(F)); SEAM(5);
    RUN(6, norm_phase<false, true>(F, (const float*)WSP(bf16, WS_X1B), inp(I_GN2), 3072, 4096)); SEAM(6);
    RUN(7, ph_scores(F)); if (IN(7) && IN(9)) xcd_barrier(bar);
    RUN(9, peer_phase(F, first));
#undef RUN
#undef IN
#undef SEAM
}

#ifndef MK_PER_PHASE
#define MK_PER_PHASE 0
#endif
extern "C" void kernel_launch(void* const* d_in, const int* in_sizes, int n_in, void* d_out, int out_size, void* d_ws, size_t ws_size, hipStream_t stream) {
    static int grid = 0;
    if (grid == 0) {
        if (n_in != 19 || in_sizes[0] != T * D || out_size != T * D || ws_size < WS_END) { fprintf(stderr, "kernel_launch: unexpected shapes (n_in %d, in0 %d, out %d, ws %zu)\n", n_in, n_in > 0 ? in_sizes[0] : -1, out_size, ws_size); grid = -1; return; }
        int dev = 0, cus = 0, per_cu = 0;
        if (hipGetDevice(&dev) != hipSuccess || hipDeviceGetAttribute(&cus, hipDeviceAttributeMultiprocessorCount, dev) != hipSuccess) { grid = -1; return; }
        if (hipFuncSetAttribute((const void*)hybrid_fwd, hipFuncAttributeMaxDynamicSharedMemorySize, LDS_BYTES) != hipSuccess) { fprintf(stderr, "kernel_launch: hipFuncSetAttribute failed\n"); grid = -1; return; }
        if (hipOccupancyMaxActiveBlocksPerMultiprocessor(&per_cu, (const void*)hybrid_fwd, NTHR, LDS_BYTES) != hipSuccess || per_cu < 1) fprintf(stderr, "kernel_launch: occupancy query says %d\n", per_cu);
        (void)hipGetLastError();
        grid = cus;
    }
    if (grid < 0) return;
    if (hipMemsetAsync((char*)d_ws + WS_CTL, 0, CTL_ZERO_BYTES, stream) != hipSuccess) { fprintf(stderr, "kernel_launch: memset failed\n"); return; }
    Args a{};
    for (int i = 0; i < 19; ++i) a.in[i] = (const float*)d_in[i];
    a.out = (float*)d_out; a.ws = (unsigned char*)d_ws;
#if MK_PER_PHASE
    { const int order[N_PHASES] = {0, 1, 2, 3, 10, 4, 5, 6, 7, 8, 9}; for (int i = 0; i < N_PHASES; ++i) { a.ph_lo = order[i]; a.ph_hi = order[i] + 1; hipLaunchKernelGGL(hybrid_fwd, dim3(grid), dim3(NTHR), LDS_BYTES, stream, a); } }
#else
    a.ph_lo = 0; a.ph_hi = N_PHASES;
    hipLaunchKernelGGL(hybrid_fwd, dim3(grid), dim3(NTHR), LDS_BYTES, stream, a);
#endif
    const hipError_t le = hipPeekAtLastError();
    if (le != hipSuccess) fprintf(stderr, "kernel_launch: launch failed: %s\n", hipGetErrorName(le));
}
```

```cpp
#include <cmath>
#include <hip/hip_runtime.h>
#include <cstdio>
#include <cstdint>
namespace pg8 {
#define PG8_LAS __attribute__((address_space(3)))
typedef unsigned short bf16_t;
typedef short bf16x8 __attribute__((ext_vector_type(8)));
typedef float f32x4 __attribute__((ext_vector_type(4)));
typedef unsigned u32x4 __attribute__((ext_vector_type(4)));
constexpr int BM = 256, BK = 64, HALF = 128, HTB = HALF * BK * 2  , STAGE_BYTES = 8 * HTB, NXCD = 8,
#ifndef PG8_WGM
#define PG8_WGM 4
#endif
WGM = PG8_WGM;

__host__ __device__ __forceinline__ int lds_byte(int r, int c) { const int st = (r >> 4) * 2 + (c >> 5), rr = r & 15, cc = c & 31, ob = rr * 64 + cc * 2; return st * 1024 + (ob ^ (((ob >> 9) & 1) << 5)); }
__host__ __device__ __forceinline__ void stage_rc(int b, int& R, int& C) { const int st = b / 1024, sb = b % 1024, swz = sb ^ (((sb >> 9) & 1) << 5); R = (st >> 1) * 16 + swz / 64; C = (st & 1) * 32 + (swz % 64) / 2; }
__host__ __device__ __forceinline__ int perm32(int rho) { const int n = rho >> 4, i = rho & 15; return 8 * (i >> 2) + 4 * n + (i & 3); }

struct Unit { int pm, pn; };
struct Gemm { const bf16_t* A; const bf16_t* Bt; int M, N, K; };

struct StaticOrder {
    int nM, nN, nwg, G, c;
    __host__ __device__ void init(int M, int N, int G_, int c_) { nM = M / BM; nN = N / BM; nwg = nM * nN; G = G_; c = c_; }
    __host__ __device__ bool next(int i, Unit& u) const {
        const long L = (long)i * G + c; if (L >= nwg) return false;
        int wgid = (int)L; { const int q = nwg / NXCD, r = nwg % NXCD, xcd = wgid % NXCD, off = wgid / NXCD; wgid = (xcd < r ? xcd * (q + 1) : r * (q + 1) + (xcd - r) * q) + off; }
        const int nig = WGM * nN, gid = wgid / nig, fm = gid * WGM, gsz = (nM - fm) < WGM ? (nM - fm) : WGM;
        u.pm = fm + ((wgid % nig) % gsz); u.pn = (wgid % nig) / gsz; return true;
    }
    __device__ __forceinline__ void a_ready(const Unit&) const {}
    __device__ __forceinline__ void done(const Unit&) const {}
};

__device__ __forceinline__ unsigned cvt_pk_bf16(float lo, float hi) { unsigned r; asm volatile("v_cvt_pk_bf16_f32 %0, %1, %2" : "=v"(r) : "v"(lo), "v"(hi)); return r; }
typedef float f32x2 __attribute__((ext_vector_type(2)));
__device__ __forceinline__ f32x2 gelu_pk(f32x2 v) {
    const f32x2 av = __builtin_elementwise_abs(v), d = av * 0.2316418882f + 1.0f;
    f32x2 t; t.x = __builtin_amdgcn_rcpf(d.x); t.y = __builtin_amdgcn_rcpf(d.y);
    f32x2 q = t * 0.5307027145f + (-0.7265760135f); q = q * t + 0.7107068705f; q = q * t + (-0.142248368f); q = q * t + 0.127414796f; q = q * t;
    const f32x2 s = (v * v) * (-0.72134752044f);
    f32x2 e; e.x = __builtin_amdgcn_exp2f(s.x); e.y = __builtin_amdgcn_exp2f(s.y);
    const f32x2 m = v * (q * e), r = v - m;
    f32x2 o; o.x = v.x < 0.f ? m.x : r.x; o.y = v.y < 0.f ? m.y : r.y; return o;
}

template <int ACT  > struct EpiBf16 {
    static constexpr bool PERM = true, AFTER_DRAIN = false; static_assert(ACT == 0 || ACT == 1, "EpiBf16: ACT is 0 (none) or 1 (gelu_pk)");
    bf16_t* O; int ldc; const float* bias; int split_cols; size_t split_stride; float scale0;
    __device__ __forceinline__ void operator()(const f32x4 (&acc)[2][2][4][2], const Unit& u, int wr, int wc, int fr, int fq) const {
        const int row0 = u.pm * BM + wr * 64 + fr; int colt = u.pn * BM; bf16_t* base = O;
        float sc = 1.f; if (split_cols) { const int t = colt / split_cols; base += (size_t)t * split_stride; colt -= t * split_cols; if (t == 0) sc = scale0; }
        const int col0 = colt + wc * 32 + 8 * fq, bcol0 = u.pn * BM + wc * 32 + 8 * fq;
        f32x4 bv[2][2];
#pragma unroll
        for (int bj = 0; bj < 2; ++bj)
#pragma unroll
            for (int n = 0; n < 2; ++n) bv[bj][n] = bias ? *(const f32x4*)(bias + bcol0 + bj * HALF + 4 * n) : (f32x4){0.f, 0.f, 0.f, 0.f};
#pragma unroll
        for (int ai = 0; ai < 2; ++ai)
#pragma unroll
            for (int m = 0; m < 4; ++m) { bf16_t* rowp = base + (size_t)(row0 + ai * HALF + m * 16) * ldc + col0;
#pragma unroll
                for (int bj = 0; bj < 2; ++bj) { f32x4 v0 = acc[ai][bj][m][0] + bv[bj][0], v1 = acc[ai][bj][m][1] + bv[bj][1];
                    if (ACT == 1) { f32x2 a = gelu_pk((f32x2){v0[0], v0[1]}), b = gelu_pk((f32x2){v0[2], v0[3]}), c = gelu_pk((f32x2){v1[0], v1[1]}), d = gelu_pk((f32x2){v1[2], v1[3]});
                        v0 = (f32x4){a.x, a.y, b.x, b.y}; v1 = (f32x4){c.x, c.y, d.x, d.y}; }
                    v0 = v0 * sc; v1 = v1 * sc; u32x4 w; w.x = cvt_pk_bf16(v0[0], v0[1]); w.y = cvt_pk_bf16(v0[2], v0[3]); w.z = cvt_pk_bf16(v1[0], v1[1]); w.w = cvt_pk_bf16(v1[2], v1[3]);
                    *(u32x4*)(rowp + bj * HALF) = w; } }
    }
};
template <class Epi, class Sched, bool ALIGN_EPI = false, bool SP2 = false>
__device__ __forceinline__ void gemm_phase(PG8_LAS unsigned char* lds, const Gemm g, const Sched& S, const Epi& E) {
    const int tid = threadIdx.x, wid = __builtin_amdgcn_readfirstlane(tid >> 6), lane = tid & 63, wr = wid >> 2, wc = wid & 3, fr = lane & 15, fq = lane >> 4;
    const int K = g.K, nt = K / BK;
    unsigned voffA[2], voffB[2];
#pragma unroll
    for (int i = 0; i < 2; ++i) { int R, C; stage_rc(tid * 16 + i * 8192, R, C); const int Rb = Epi::PERM ? ((R & ~31) + perm32(R & 31)) : R;
        voffA[i] = (unsigned)(R * K + C) * 2u; voffB[i] = (unsigned)(Rb * K + C) * 2u; }
    const size_t kstep = (size_t)(BK * 2);
    const size_t hstep = (size_t)HALF * K * 2;
    const size_t tstep = 2 * hstep;
    const unsigned ldsw = (unsigned)wid * 1024u;
    const int aoff = lds_byte(wr * 64 + fr, fq * 8), boff = lds_byte(wc * 32 + fr, fq * 8);
#define PG8_SA(b, h) (((b) * 2 + (h)) * HTB)
#define PG8_SB(b, h) ((4 + (b) * 2 + (h)) * HTB)
#define PG8_STAGE(bufoff, gbase, voff) do { _Pragma("unroll") for (int _i = 0; _i < 2; ++_i) \
        __builtin_amdgcn_global_load_lds((const unsigned*)((const char*)(gbase) + (voff)[_i]), (PG8_LAS unsigned*)(lds + (bufoff) + ldsw + _i * 8192), 16, 0, 0); } while (0)
#define PG8_LDA(dst, b, h) do { _Pragma("unroll") for (int m = 0; m < 4; ++m) _Pragma("unroll") for (int k = 0; k < 2; ++k) dst[m][k] = *(const PG8_LAS bf16x8*)(lds + PG8_SA(b, h) + aoff + m * 2048 + k * 1024); } while (0)
#define PG8_LDB(dst, b, h) do { _Pragma("unroll") for (int n = 0; n < 2; ++n) _Pragma("unroll") for (int k = 0; k < 2; ++k) dst[n][k] = *(const PG8_LAS bf16x8*)(lds + PG8_SB(b, h) + boff + n * 2048 + k * 1024); } while (0)
#define PG8_MMA(ai, bj, At, Bt) do { __builtin_amdgcn_s_setprio(1); _Pragma("unroll") for (int m = 0; m < 4; ++m) _Pragma("unroll") for (int n = 0; n < 2; ++n) _Pragma("unroll") for (int k = 0; k < 2; ++k) \
        acc[ai][bj][m][n] = __builtin_amdgcn_mfma_f32_16x16x32_bf16(Bt[n][k], At[m][k], acc[ai][bj][m][n], 0, 0, 0); __builtin_amdgcn_s_setprio(0); } while (0)
#define PG8_WAIT_V(n) asm volatile("s_waitcnt vmcnt(" #n ")" ::: "memory")
#define PG8_WAIT_L(n) asm volatile("s_waitcnt lgkmcnt(" #n ")" ::: "memory")
#define PG8_BAR __builtin_amdgcn_s_barrier()
#define PG8_SCHED __builtin_amdgcn_sched_barrier(0)
    Unit cur, nxt; int ui = 0;
    if (!S.next(0, cur)) return;
    f32x4 acc[2][2][4][2];
#pragma unroll
    for (int a = 0; a < 2; ++a)
#pragma unroll
        for (int b = 0; b < 2; ++b)
#pragma unroll
            for (int m = 0; m < 4; ++m)
#pragma unroll
                for (int n = 0; n < 2; ++n) acc[a][b][m][n] = (f32x4){0.f, 0.f, 0.f, 0.f};
    bf16x8 At[4][2], B0[2][2], B1[2][2];
    const char* cA = (const char*)g.A + (size_t)cur.pm * tstep; const char* cB = (const char*)g.Bt + (size_t)cur.pn * tstep;
    S.a_ready(cur);
    if constexpr (SP2) {
        PG8_STAGE(PG8_SB(0, 0), cB, voffB); PG8_STAGE(PG8_SB(0, 1), cB + hstep, voffB); PG8_STAGE(PG8_SA(0, 0), cA, voffA); PG8_STAGE(PG8_SA(0, 1), cA + hstep, voffA);
        if (wr == 1) PG8_BAR;
        PG8_WAIT_V(2); PG8_BAR;
        PG8_STAGE(PG8_SB(1, 0), cB + kstep, voffB); PG8_STAGE(PG8_SA(1, 0), cA + kstep, voffA); PG8_STAGE(PG8_SB(1, 1), cB + hstep + kstep, voffB);
        PG8_WAIT_V(6); PG8_BAR;
    } else {
        PG8_STAGE(PG8_SB(0, 0), cB, voffB); PG8_STAGE(PG8_SA(0, 0), cA, voffA); PG8_STAGE(PG8_SB(0, 1), cB + hstep, voffB); PG8_STAGE(PG8_SA(0, 1), cA + hstep, voffA);
        if (wr == 1) PG8_BAR;
        PG8_WAIT_V(4); PG8_BAR;
        PG8_STAGE(PG8_SB(1, 0), cB + kstep, voffB); PG8_STAGE(PG8_SA(1, 0), cA + kstep, voffA); PG8_STAGE(PG8_SB(1, 1), cB + hstep + kstep, voffB);
        PG8_WAIT_V(6); PG8_BAR;
    }
    for (;;) {
        const bool has_next = S.next(ui + 1, nxt);
        const char* nA = has_next ? (const char*)g.A + (size_t)nxt.pm * tstep : cA; const char* nB = has_next ? (const char*)g.Bt + (size_t)nxt.pn * tstep : cB;
        for (int t = 0; t < nt; t += 2) {
            const bool last = (t == nt - 2);
            const char* a1 = cA + (size_t)(t + 1) * kstep;
            const char* a2 = last ? nA : cA + (size_t)(t + 2) * kstep; const char* b2 = last ? nB : cB + (size_t)(t + 2) * kstep;
            const char* a3 = a2 + kstep; const char* b3 = b2 + kstep;
            if (last && has_next) S.a_ready(nxt);
            if constexpr (SP2) {
            PG8_LDB(B0, 0, 0); PG8_LDB(B1, 0, 1); PG8_SCHED; PG8_LDA(At, 0, 0); PG8_STAGE(PG8_SA(1, 1), a1 + hstep, voffA);
            PG8_WAIT_V(8); PG8_WAIT_L(0); PG8_BAR; PG8_MMA(0, 0, At, B0); PG8_MMA(0, 1, At, B1); PG8_BAR; PG8_SCHED;
            PG8_LDA(At, 0, 1); PG8_STAGE(PG8_SB(0, 0), b2, voffB); PG8_STAGE(PG8_SB(0, 1), b2 + hstep, voffB); PG8_STAGE(PG8_SA(0, 0), a2, voffA);
            PG8_WAIT_V(8); PG8_WAIT_L(0); PG8_BAR; PG8_MMA(1, 0, At, B0); PG8_MMA(1, 1, At, B1); PG8_BAR; PG8_SCHED;
            PG8_LDB(B0, 1, 0); PG8_LDB(B1, 1, 1); PG8_SCHED; PG8_LDA(At, 1, 0); PG8_STAGE(PG8_SA(0, 1), a2 + hstep, voffA);
            PG8_WAIT_V(8); PG8_WAIT_L(0); PG8_BAR; PG8_MMA(0, 0, At, B0); PG8_MMA(0, 1, At, B1); PG8_BAR; PG8_SCHED;
            PG8_LDA(At, 1, 1); PG8_STAGE(PG8_SB(1, 0), b3, voffB); PG8_STAGE(PG8_SB(1, 1), b3 + hstep, voffB); PG8_STAGE(PG8_SA(1, 0), a3, voffA);
            PG8_WAIT_V(8); PG8_WAIT_L(0); PG8_BAR; PG8_MMA(1, 0, At, B0); PG8_MMA(1, 1, At, B1); PG8_BAR; PG8_SCHED;
            } else {
            PG8_LDB(B0, 0, 0); PG8_SCHED; PG8_LDA(At, 0, 0); PG8_STAGE(PG8_SA(1, 1), a1 + hstep, voffA);
            PG8_WAIT_L(8); PG8_BAR; PG8_WAIT_L(0); PG8_MMA(0, 0, At, B0); PG8_BAR; PG8_SCHED;
            PG8_LDB(B1, 0, 1); PG8_STAGE(PG8_SB(0, 0), b2, voffB);
            PG8_BAR; PG8_WAIT_L(0); PG8_MMA(0, 1, At, B1); PG8_BAR;
            PG8_LDA(At, 0, 1); PG8_STAGE(PG8_SA(0, 0), a2, voffA);
            PG8_BAR; PG8_WAIT_L(0); PG8_MMA(1, 0, At, B0); PG8_BAR; PG8_SCHED;
            PG8_STAGE(PG8_SB(0, 1), b2 + hstep, voffB);
            PG8_WAIT_V(6); PG8_BAR; PG8_MMA(1, 1, At, B1); PG8_BAR;
            PG8_LDB(B0, 1, 0); PG8_SCHED; PG8_LDA(At, 1, 0); PG8_STAGE(PG8_SA(0, 1), a2 + hstep, voffA);
            PG8_WAIT_L(8); PG8_BAR; PG8_WAIT_L(0); PG8_MMA(0, 0, At, B0); PG8_BAR; PG8_SCHED;
            PG8_LDB(B1, 1, 1); PG8_STAGE(PG8_SB(1, 0), b3, voffB);
            PG8_BAR; PG8_WAIT_L(0); PG8_MMA(0, 1, At, B1); PG8_BAR;
            PG8_LDA(At, 1, 1); PG8_STAGE(PG8_SA(1, 0), a3, voffA);
            PG8_BAR; PG8_WAIT_L(0); PG8_MMA(1, 0, At, B0); PG8_BAR; PG8_SCHED;
            PG8_STAGE(PG8_SB(1, 1), b3 + hstep, voffB);
            PG8_WAIT_V(6); PG8_BAR; PG8_MMA(1, 1, At, B1); PG8_BAR;
            }
        }
        if constexpr (ALIGN_EPI) { if (wr == 0) PG8_BAR; }
        if constexpr (!Epi::AFTER_DRAIN) { E(acc, cur, wr, wc, fr, fq); S.done(cur); }
        if (!has_next) break;
#pragma unroll
        for (int a = 0; a < 2; ++a)
#pragma unroll
            for (int b = 0; b < 2; ++b)
#pragma unroll
                for (int m = 0; m < 4; ++m)
#pragma unroll
                    for (int n = 0; n < 2; ++n) acc[a][b][m][n] = (f32x4){0.f, 0.f, 0.f, 0.f};
        cur = nxt; cA = nA; cB = nB; ++ui;
        if constexpr (ALIGN_EPI) { if (wr == 1) PG8_BAR; }
    }
    PG8_WAIT_V(0);
    if constexpr (!ALIGN_EPI) { if (wr == 0) PG8_BAR; }
    PG8_BAR;
    if constexpr (Epi::AFTER_DRAIN) { E.fused(acc, cur, wr, wc, fr, fq, lds, wid, lane); S.done(cur); }
#undef PG8_SA
#undef PG8_SB
#undef PG8_STAGE
#undef PG8_LDA
#undef PG8_LDB
#undef PG8_MMA
#undef PG8_WAIT_V
#undef PG8_WAIT_L
#undef PG8_BAR
#undef PG8_SCHED
}
}

#ifndef PG8_SP2
#define PG8_SP2 true
#endif
#ifndef PG8_ALIGN
#define PG8_ALIGN true
#endif

namespace pg8 {
struct EpiResGate {
    static constexpr bool PERM = false, AFTER_DRAIN = false;
    const float* base; float* out; const float* gate; int gate_ld; int rows_per_batch; int ldc;
    __device__ __forceinline__ void operator()(const f32x4 (&acc)[2][2][4][2], const Unit& u, int wr, int wc, int fr, int fq) const {
        const int row0 = u.pm * BM + wr * 64 + fr, col0 = u.pn * BM + wc * 32 + 4 * fq;
        const float* gp = gate + (size_t)((u.pm * BM) / rows_per_batch) * gate_ld + col0;
        f32x4 gv[2][2];
#pragma unroll
        for (int bj = 0; bj < 2; ++bj)
#pragma unroll
            for (int n = 0; n < 2; ++n) gv[bj][n] = *(const f32x4*)(gp + bj * HALF + n * 16);
#pragma unroll
        for (int ai = 0; ai < 2; ++ai)
#pragma unroll
            for (int m = 0; m < 4; ++m) { const size_t off = (size_t)(row0 + ai * HALF + m * 16) * ldc + col0;
#pragma unroll
                for (int bj = 0; bj < 2; ++bj)
#pragma unroll
                    for (int n = 0; n < 2; ++n) { const f32x4 bs = *(const f32x4*)(base + off + bj * HALF + n * 16);
                        *(f32x4*)(out + off + bj * HALF + n * 16) = bs + gv[bj][n] * acc[ai][bj][m][n]; } }
    }
};
struct EpiResGateBf16 {
    static constexpr bool PERM = false, AFTER_DRAIN = false;
    const float* base; bf16_t* out; const float* gate; int gate_ld; int rows_per_batch; int ldc;
    __device__ __forceinline__ void operator()(const f32x4 (&acc)[2][2][4][2], const Unit& u, int wr, int wc, int fr, int fq) const {
        const int row0 = u.pm * BM + wr * 64 + fr, col0 = u.pn * BM + wc * 32 + 4 * fq;
        const float* gp = gate + (size_t)((u.pm * BM) / rows_per_batch) * gate_ld + col0;
        f32x4 gv[2][2];
#pragma unroll
        for (int bj = 0; bj < 2; ++bj)
#pragma unroll
            for (int n = 0; n < 2; ++n) gv[bj][n] = *(const f32x4*)(gp + bj * HALF + n * 16);
#pragma unroll
        for (int ai = 0; ai < 2; ++ai)
#pragma unroll
            for (int m = 0; m < 4; ++m) { const size_t off = (size_t)(row0 + ai * HALF + m * 16) * ldc + col0;
#pragma unroll
                for (int bj = 0; bj < 2; ++bj)
#pragma unroll
                    for (int n = 0; n < 2; ++n) { const f32x4 bs = __builtin_nontemporal_load((const f32x4*)(base + off + bj * HALF + n * 16)); const f32x4 r = bs + gv[bj][n] * acc[ai][bj][m][n];
                        *(unsigned long long*)(out + off + bj * HALF + n * 16) = (unsigned long long)cvt_pk_bf16(r.x, r.y) | ((unsigned long long)cvt_pk_bf16(r.z, r.w) << 32); } }
    }
};
struct EpiF32 {
    static constexpr bool PERM = false, AFTER_DRAIN = false;
    float* O; int ldc;
    __device__ __forceinline__ void operator()(const f32x4 (&acc)[2][2][4][2], const Unit& u, int wr, int wc, int fr, int fq) const {
        const int row0 = u.pm * BM + wr * 64 + fr, col0 = u.pn * BM + wc * 32 + 4 * fq;
#pragma unroll
        for (int ai = 0; ai < 2; ++ai)
#pragma unroll
            for (int m = 0; m < 4; ++m) { const size_t off = (size_t)(row0 + ai * HALF + m * 16) * ldc + col0;
#pragma unroll
                for (int bj = 0; bj < 2; ++bj)
#pragma unroll
                    for (int n = 0; n < 2; ++n) *(f32x4*)(O + off + bj * HALF + n * 16) = acc[ai][bj][m][n]; }
    }
};
}
#define GAS __attribute__((address_space(1)))
#define LAS __attribute__((address_space(3)))
typedef unsigned short bf16;
typedef unsigned v4u __attribute__((ext_vector_type(4)));
typedef float f32x4 __attribute__((ext_vector_type(4)));
typedef short bf16x8 __attribute__((ext_vector_type(8)));
typedef GAS unsigned gu32;
typedef GAS unsigned long long gu64;
#define RLX_AGENT __ATOMIC_RELAXED, __HIP_MEMORY_SCOPE_AGENT
#define LDS_WAIT() asm volatile("s_waitcnt lgkmcnt(0)" ::: "memory")
#define VM_WAIT() asm volatile("s_waitcnt vmcnt(0)" ::: "memory")
__device__ __forceinline__ unsigned long long rt() { return __builtin_amdgcn_s_memrealtime(); }
__device__ __forceinline__ unsigned f2bf(float f) { unsigned u = __builtin_bit_cast(unsigned, f); return (u + 0x7fffu + ((u >> 16) & 1u)) >> 16; }
__device__ __forceinline__ unsigned pk2(float lo, float hi) { return f2bf(lo) | (f2bf(hi) << 16); }

#define XB_TMO      128
#define XB_XCNT(j)  (256  + 64 * (j))
#define XB_XSUB(j)  (1280 + 64 * (j))
#define XB_XGEN(j)  (2304 + 64 * (j))
#define XB_TOP      3328
#define XB_TOPGEN   3392
#define XCD_BAR_WORDS 3456
#define XB_SPIN_CAP (1u << 24)

__device__ __forceinline__ unsigned xb_ld(unsigned* p)              { return __hip_atomic_load(p, __ATOMIC_RELAXED, __HIP_MEMORY_SCOPE_AGENT); }
__device__ __forceinline__ unsigned xb_add(unsigned* p, unsigned v) { return __hip_atomic_fetch_add(p, v, __ATOMIC_RELAXED, __HIP_MEMORY_SCOPE_AGENT); }
__device__ __forceinline__ unsigned xb_xcc_id() { return (unsigned)__builtin_amdgcn_s_getreg((3 << 11) | 20) & 0xFu; }
#define XB_SPIN(cond, bar) do { unsigned _sp = 0; while (cond) { __builtin_amdgcn_s_sleep(1); \
    if ((++_sp & 255u) == 0u) { if (xb_ld(&(bar)[XB_TMO])) break; if (_sp > XB_SPIN_CAP) { atomicAdd(&(bar)[XB_TMO], 1u); break; } } } } while (0)

struct XcdBarrier {
    unsigned* bar; unsigned x;
    volatile LAS unsigned* st;
};

__device__ __forceinline__ XcdBarrier xcd_barrier_post(unsigned* bar, volatile LAS unsigned* st) {
    XcdBarrier b; b.bar = bar; b.x = xb_xcc_id(); b.st = st;
    if (threadIdx.x == 0) (void)xb_add(&bar[XB_XCNT(b.x)], 1u);
    return b;
}
__device__ __forceinline__ void xcd_barrier_complete(unsigned* bar, unsigned x, unsigned& nloc, unsigned& nx) {
    const unsigned G = gridDim.x * gridDim.y * gridDim.z;
    unsigned sum, cnt, mine, sp = 0u;
    for (;;) {
        sum = 0u; cnt = 0u; mine = 0u;
#pragma unroll
        for (unsigned j = 0; j < 16; ++j) { const unsigned c = xb_ld(&bar[XB_XCNT(j)]); sum += c; cnt += (c > 0u) ? 1u : 0u; mine = (j == x) ? c : mine; }
        if (sum == G) break;
        __builtin_amdgcn_s_sleep(1);
        if ((++sp & 255u) == 0u) { if (xb_ld(&bar[XB_TMO])) break; if (sp > XB_SPIN_CAP) { atomicAdd(&bar[XB_TMO], 1u); break; } }
    }
    nloc = mine > 0u ? mine : 1u; nx = cnt > 0u ? cnt : 1u;
}

__device__ __forceinline__ void xcd_barrier(const XcdBarrier& b) {
    asm volatile("s_waitcnt vmcnt(0)" ::: "memory");
    __syncthreads();
    if (threadIdx.x == 0) {
        unsigned* bar = b.bar;
        __builtin_amdgcn_s_waitcnt(0);
        unsigned nloc = b.st[0], nx = b.st[1];
        if (nloc == 0u) { xcd_barrier_complete(bar, b.x, nloc, nx); b.st[0] = nloc; b.st[1] = nx; }
        const unsigned old = xb_add(&bar[XB_XSUB(b.x)], 1u);
        const unsigned gen = old / nloc;
        if (old + 1u == (gen + 1u) * nloc) {
            __builtin_amdgcn_fence(__ATOMIC_RELEASE, "agent");
            asm volatile("s_waitcnt vmcnt(0)" ::: "memory");
            const unsigned og = xb_add(&bar[XB_TOP], 1u);
            const unsigned tg = og / nx;
            if (og + 1u == (tg + 1u) * nx) xb_add(&bar[XB_TOPGEN], 1u);
            else XB_SPIN(xb_ld(&bar[XB_TOPGEN]) == tg, bar);
            __builtin_amdgcn_fence(__ATOMIC_ACQUIRE, "agent");
            xb_add(&bar[XB_XGEN(b.x)], 1u);
            asm volatile("s_waitcnt vmcnt(0)" ::: "memory");
        } else {
            XB_SPIN(xb_ld(&bar[XB_XGEN(b.x)]) == gen, bar);
            __builtin_amdgcn_fence(__ATOMIC_ACQUIRE, "agent");
            asm volatile("s_waitcnt vmcnt(0)" ::: "memory");
        }
    }
    __syncthreads();
}

constexpr int NWAVES = 8, NTHR = 512;
constexpr int NB = 8, SEQ = 4096, T = NB * SEQ, D = 1024, NPROJ = 3584, NIN = 3592, NMOD = 6144, NSC = 2048;
constexpr int C_QSB = 0, C_KSB = 512, C_VSB = 1024, C_QML = 1536, C_KML = 2048, C_VML = 2560, C_OML = 3072;
constexpr float EPS = 1e-6f, LOG2E = 1.4426950408889634f;
constexpr size_t MiB = 1u << 20;
constexpr size_t WS_CTL = 0, CTL_ZERO_BYTES = 1 * MiB;
constexpr size_t WS_MOD = 256 * 1024;
constexpr size_t WS_WIN = 2 * MiB, WS_WOUT = 10 * MiB, WS_WEFF = 12 * MiB;
constexpr size_t WS_XN = 16 * MiB;
constexpr size_t WS_PROJ = 80 * MiB;
constexpr size_t WS_MIX = 304 * MiB;
constexpr size_t WS_EXPU = 368 * MiB, WS_EXPV = 400 * MiB;
constexpr size_t WS_CST = 432 * MiB;
constexpr size_t WS_NST = 496 * MiB;
constexpr size_t WS_MST = 497 * MiB;
constexpr size_t WS_GATES = 498 * MiB;
constexpr size_t WS_XQ = 272 * MiB;
constexpr size_t WS_XS = 499 * MiB + 256 * 1024;
constexpr size_t WS_X1B = 208 * MiB;
constexpr size_t WS_SCORES = 80 * MiB;
constexpr size_t WS_IDX = 336 * MiB, WS_GATE = 352 * MiB;
constexpr size_t WS_SCL = 499 * MiB;
constexpr size_t WS_SUI = 499 * MiB + 65536, WS_SVI = 499 * MiB + 131072;
constexpr size_t WS_END = 500 * MiB;
constexpr int CW_Q3 = 64;
constexpr int CW_BAR = 4096;
constexpr int LDS_BYTES = 147456, LDSCTL_OFF = 143360;

typedef float f32x16 __attribute__((ext_vector_type(16)));
typedef float f32x2_t __attribute__((ext_vector_type(2)));
typedef __bf16 bf16x2_t __attribute__((ext_vector_type(2)));
typedef _Float16 f16x8 __attribute__((ext_vector_type(8)));
typedef short s16x4 __attribute__((ext_vector_type(4)));
typedef unsigned u32x2 __attribute__((ext_vector_type(2)));
#define DI __device__ __forceinline__
DI unsigned cvtpk(float lo, float hi) { f32x2_t v = {lo, hi}; bf16x2_t b = __builtin_convertvector(v, bf16x2_t); return __builtin_bit_cast(unsigned, b); }
DI float bflo(unsigned u) { return __uint_as_float(u << 16); }
DI float bfhi(unsigned u) { return __uint_as_float(u & 0xffff0000u); }
DI int crow(int i, int hi) { return (i & 3) + 8 * (i >> 2) + 4 * hi; }
DI int krow(int s, int hi, int j) { return 16 * s + 8 * (j >> 2) + 4 * hi + (j & 3); }
DI float swap_add(float v) { auto rr = __builtin_amdgcn_permlane32_swap(__float_as_uint(v), __float_as_uint(v), false, false); return __uint_as_float(rr[0]) + __uint_as_float(rr[1]); }
DI float swap_max(float v) { auto rr = __builtin_amdgcn_permlane32_swap(__float_as_uint(v), __float_as_uint(v), false, false); return fmaxf(__uint_as_float(rr[0]), __uint_as_float(rr[1])); }
DI float dot2bf(unsigned a, unsigned b, float acc) { return __builtin_amdgcn_fdot2_f32_bf16(__builtin_bit_cast(bf16x2_t, a), __builtin_bit_cast(bf16x2_t, b), acc, false); }
DI float ex2(float x) { return __builtin_amdgcn_exp2f(x); }
DI float lg2(float x) { return __builtin_amdgcn_logf(x); }
DI float fexp(float x) { return __builtin_amdgcn_exp2f(x * LOG2E); }
DI float wave_sum(float v) {
#pragma unroll
    for (int o = 1; o < 64; o <<= 1) v += __shfl_xor(v, o);
    return v;
}
DI float wave_max(float v) {
#pragma unroll
    for (int o = 1; o < 64; o <<= 1) v = fmaxf(v, __shfl_xor(v, o));
    return v;
}
#define DPP_MAXF(v, ctrl, rmask) fmaxf((v), __builtin_bit_cast(float, __builtin_amdgcn_update_dpp(0, __builtin_bit_cast(int, (v)), (ctrl), (rmask), 0xF, false)))
DI float wave_max_nonneg(float v) {
    v = DPP_MAXF(v, 0xB1, 0xF); v = DPP_MAXF(v, 0x4E, 0xF); v = DPP_MAXF(v, 0x141, 0xF); v = DPP_MAXF(v, 0x140, 0xF); v = DPP_MAXF(v, 0x142, 0xA); v = DPP_MAXF(v, 0x143, 0xC);
    return __builtin_bit_cast(float, __builtin_amdgcn_readlane(__builtin_bit_cast(int, v), 63));
}
#define DPP_ADDF(v, ctrl, rmask) ((v) + __builtin_bit_cast(float, __builtin_amdgcn_update_dpp(0, __builtin_bit_cast(int, (v)), (ctrl), (rmask), 0xF, false)))
DI float wave_sum_u(float v) {
    v = DPP_ADDF(v, 0xB1, 0xF); v = DPP_ADDF(v, 0x4E, 0xF); v = DPP_ADDF(v, 0x141, 0xF); v = DPP_ADDF(v, 0x140, 0xF); v = DPP_ADDF(v, 0x142, 0xA); v = DPP_ADDF(v, 0x143, 0xC);
    return __builtin_bit_cast(float, __builtin_amdgcn_readlane(__builtin_bit_cast(int, v), 63));
}
typedef short v4i16_t __attribute__((ext_vector_type(4)));
DI s16x4 trrd(LAS unsigned char* p) { return __builtin_bit_cast(s16x4, __builtin_amdgcn_ds_read_tr16_b64_v4i16((LAS v4i16_t*)p)); }
DI bf16x8 cat8(s16x4 a, s16x4 b) { return (bf16x8){a[0], a[1], a[2], a[3], b[0], b[1], b[2], b[3]}; }
#define MFMA_BF16(a, b, c) __builtin_amdgcn_mfma_f32_32x32x16_bf16((a), (b), (c), 0, 0, 0)
#define MFMA_F16(a, b, c) __builtin_amdgcn_mfma_f32_32x32x16_f16((a), (b), (c), 0, 0, 0)
DI unsigned pkh(float a, float b) { return __builtin_bit_cast(unsigned, __builtin_amdgcn_cvt_pkrtz(a, b)); }
DI bf16x8 packbf(const f32x16& x, int s) { v4u p; p.x = cvtpk(x[8 * s], x[8 * s + 1]); p.y = cvtpk(x[8 * s + 2], x[8 * s + 3]); p.z = cvtpk(x[8 * s + 4], x[8 * s + 5]); p.w = cvtpk(x[8 * s + 6], x[8 * s + 7]); return __builtin_bit_cast(bf16x8, p); }
DI f16x8 packh(const f32x16& x, int s) { v4u p; p.x = pkh(x[8 * s], x[8 * s + 1]); p.y = pkh(x[8 * s + 2], x[8 * s + 3]); p.z = pkh(x[8 * s + 4], x[8 * s + 5]); p.w = pkh(x[8 * s + 6], x[8 * s + 7]); return __builtin_bit_cast(f16x8, p); }

struct Frame {
    LAS unsigned char* lds;
    volatile LAS unsigned* MISC;
    gu32* ctl;
    unsigned char* ws;
    int tid, lane, wave, vcu, G;
};
DI const float* inp(int i) { const __attribute__((address_space(4))) unsigned long long* kp = (const __attribute__((address_space(4))) unsigned long long*)__builtin_amdgcn_kernarg_segment_ptr(); return (const float*)(const GAS float*)(*(volatile const __attribute__((address_space(4))) unsigned long long*)(kp + i)); }
enum { I_X = 0, I_C, I_WADA, I_BADA, I_GN1, I_WIN, I_BIG, I_BFG, I_CONVW, I_GQ, I_GK, I_GOSB, I_GOML, I_WOUT, I_GN2, I_WQ, I_SK, I_EU, I_EV, I_OUT };
#define WSP(type, off) ((type*)(F.ws + (off)))

DI void p0_transpose_item(const float* W, int K, int N, int ld, bf16* WT, LAS float* scr, int item, int lane) {
    const int nblk = N / 32, kb = item / nblk, nb = item % nblk, k0 = 64 * kb, n0 = 32 * nb;
    float tv[32];
#pragma unroll
    for (int i = 0; i < 32; ++i) tv[i] = W[(size_t)(k0 + 2 * i + (lane >> 5)) * ld + n0 + (lane & 31)];
#pragma unroll
    for (int i = 0; i < 32; ++i) scr[(2 * i + (lane >> 5)) * 33 + (lane & 31)] = tv[i];
    LDS_WAIT(); asm volatile("" ::: "memory");
    const int c = lane & 7;
#pragma unroll
    for (int j = 0; j < 4; ++j) { const int n = (lane >> 3) + 8 * j; const LAS float* s = scr + (8 * c) * 33 + n;
        v4u o; o.x = pk2(s[0 * 33], s[1 * 33]); o.y = pk2(s[2 * 33], s[3 * 33]); o.z = pk2(s[4 * 33], s[5 * 33]); o.w = pk2(s[6 * 33], s[7 * 33]);
        *(GAS v4u*)(WT + (size_t)(n0 + n) * K + k0 + 8 * c) = o; }
    LDS_WAIT(); asm volatile("" ::: "memory");
}
DI void p0_mod_block(const Frame& F, int item) {
    const float* const c_ = inp(I_C); const float* const w_ada_ = inp(I_WADA); const float* const b_ada_ = inp(I_BADA); float* const mod_ = WSP(float, WS_MOD);
    LAS float* scr = (LAS float*)(F.lds + F.wave * 16384);
    const int j = item * 64 + F.lane, d0 = F.wave * 128;
    const int rg = F.lane >> 4, cl = F.lane & 15;
    f32x4 wv[32];
    { const float* wp = w_ada_ + (size_t)(d0 + rg) * NMOD + item * 64 + 4 * cl;
#pragma unroll
      for (int i = 0; i < 32; ++i) wv[i] = __builtin_nontemporal_load((const GAS f32x4*)(wp + (size_t)(4 * i) * NMOD)); }
#pragma unroll
    for (int b = 0; b < 8; ++b)
#pragma unroll
        for (int q = 0; q < 2; ++q) { const float cv = c_[b * D + d0 + 64 * q + F.lane]; scr[b * 128 + 64 * q + F.lane] = cv / (1.f + fexp(-cv)); }
    LDS_WAIT(); asm volatile("" ::: "memory");
    f32x4 acc[8];
#pragma unroll
    for (int b = 0; b < 8; ++b) acc[b] = (f32x4){0.f, 0.f, 0.f, 0.f};
#pragma unroll
    for (int i = 0; i < 32; ++i)
#pragma unroll
        for (int b = 0; b < 8; ++b) acc[b] += wv[i] * scr[b * 128 + 4 * i + rg];
#pragma unroll
    for (int b = 0; b < 8; ++b)
#pragma unroll
        for (int c = 0; c < 4; ++c) { float v = acc[b][c]; v += __shfl_xor(v, 16); v += __shfl_xor(v, 32); acc[b][c] = v; }
    if (rg == 0) {
#pragma unroll
        for (int b = 0; b < 8; ++b) *(LAS f32x4*)(scr + 1024 + b * 64 + 4 * cl) = acc[b]; }
    __syncthreads();
    float tot = b_ada_[j];
#pragma unroll
    for (int w = 0; w < 8; ++w) tot += ((LAS float*)(F.lds + w * 16384))[1024 + F.wave * 64 + F.lane];
    mod_[F.wave * NMOD + j] = tot;
    __syncthreads();
}
DI void p0_weff_item(const Frame& F, int item) {
    const float* const sub_keys_ = inp(I_SK); const float* const w_q_peer_ = inp(I_WQ); bf16* const Weff_t_ = WSP(bf16, WS_WEFF);
    const int hp = item >> 4, dblk = item & 15;
    LAS float* sk = (LAS float*)F.lds;
    LAS float* rb = (LAS float*)(F.lds + 67584) + F.wave * 1024;
    { float tv[32];
#pragma unroll
      for (int i = 0; i < 32; ++i) tv[i] = sub_keys_[(size_t)hp * 16384 + F.tid + 512 * i];
#pragma unroll
      for (int i = 0; i < 32; ++i) { const int idx = F.tid + 512 * i; sk[(idx >> 7) * 129 + (idx & 127)] = tv[i]; } }
    const int d0 = 64 * dblk + 8 * F.wave;
#pragma unroll
    for (int r = 0; r < 8; ++r) { rb[r * 128 + F.lane] = w_q_peer_[(size_t)(d0 + r) * NSC + hp * 128 + F.lane]; rb[r * 128 + 64 + F.lane] = w_q_peer_[(size_t)(d0 + r) * NSC + hp * 128 + 64 + F.lane]; }
    __syncthreads();
    float a0[8], a1[8];
#pragma unroll
    for (int r = 0; r < 8; ++r) { a0[r] = 0.f; a1[r] = 0.f; }
#pragma unroll 4
    for (int c = 0; c < 128; ++c) { const float s0 = sk[F.lane * 129 + c], s1 = sk[(F.lane + 64) * 129 + c];
#pragma unroll
        for (int r = 0; r < 8; ++r) { const float a = rb[r * 128 + c]; a0[r] += a * s0; a1[r] += a * s1; } }
    v4u o0, o1; o0.x = pk2(a0[0], a0[1]); o0.y = pk2(a0[2], a0[3]); o0.z = pk2(a0[4], a0[5]); o0.w = pk2(a0[6], a0[7]);
    o1.x = pk2(a1[0], a1[1]); o1.y = pk2(a1[2], a1[3]); o1.z = pk2(a1[4], a1[5]); o1.w = pk2(a1[6], a1[7]);
    *(GAS v4u*)(Weff_t_ + (size_t)(hp * 128 + F.lane) * D + d0) = o0;
    *(GAS v4u*)(Weff_t_ + (size_t)(hp * 128 + 64 + F.lane) * D + d0) = o1;
    __syncthreads();
}
struct ExpRows2 { f32x4 v[2][4]; };
DI void exp_load2(const Frame& F, int blk0, ExpRows2& R) {
    const float* const expert_u_ = inp(I_EU); const float* const expert_v_ = inp(I_EV);
#pragma unroll
    for (int bb = 0; bb < 2; ++bb) { const int blk = blk0 + bb; const float* src = (blk < 16384 ? expert_u_ : expert_v_) + (size_t)(blk & 16383) * 1024 + 4 * F.lane;
#pragma unroll
        for (int k = 0; k < 4; ++k) R.v[bb][k] = __builtin_nontemporal_load((const GAS f32x4*)(src + 256 * k)); }
}
DI void exp_conv2(const Frame& F, int blk0, const ExpRows2& R) {
    float* const SUI_ = WSP(float, WS_SUI); float* const SVI_ = WSP(float, WS_SVI);
#pragma unroll
    for (int bb = 0; bb < 2; ++bb) { const int blk = blk0 + bb; const bool isu = blk < 16384; const int e = blk & 16383;
        float mx = 0.f;
#pragma unroll
        for (int k = 0; k < 4; ++k) mx = fmaxf(mx, fmaxf(fmaxf(fabsf(R.v[bb][k].x), fabsf(R.v[bb][k].y)), fmaxf(fabsf(R.v[bb][k].z), fabsf(R.v[bb][k].w))));
        mx = wave_max_nonneg(mx);
        {
            float best = 3.0e38f, bs = 0.f;
#define EXP_TRY(FAC) do { const float s_ = mx * ((FAC) / 7.f), inv_ = s_ > 0.f ? 1.f / s_ : 0.f; float er_ = 0.f; \
                _Pragma("unroll") for (int k = 0; k < 4; ++k) _Pragma("unroll") for (int c = 0; c < 4; ++c) { const float v_ = R.v[bb][k][c]; const float d_ = v_ - s_ * fminf(fmaxf(rintf(v_ * inv_), -7.f), 7.f); er_ += d_ * d_; } \
                er_ = wave_sum_u(er_); if (er_ < best) { best = er_; bs = s_; } } while (0)
            EXP_TRY(1.f); EXP_TRY(0.86f); EXP_TRY(0.74f); EXP_TRY(0.63f);
#undef EXP_TRY
            const float inv = bs > 0.f ? 1.f / bs : 0.f;
            unsigned w01[2] = {0u, 0u};
#pragma unroll
            for (int k = 0; k < 4; ++k)
#pragma unroll
                for (int c = 0; c < 4; ++c) { const int q = (int)fminf(fmaxf(rintf(R.v[bb][k][c] * inv), -7.f), 7.f); w01[k >> 1] |= (unsigned)((isu || (c & 1)) ? (q & 15) : (q + 8)) << (4 * (4 * (k & 1) + c)); }
            if (F.lane == 0) (isu ? SUI_ : SVI_)[e] = bs;
            typedef unsigned v2u_ __attribute__((ext_vector_type(2)));
            v2u_ wv; wv.x = w01[0]; wv.y = w01[1];
            *(GAS v2u_*)((isu ? WSP(unsigned char, WS_EXPU) : WSP(unsigned char, WS_EXPV)) + (size_t)e * 512 + 8 * F.lane) = wv;
        } }
}
#ifndef P0_PARTS
#define P0_PARTS 15
#endif
DI void p0_phase(const Frame& F, int parts = 15) {
    const float* const w_in_ = inp(I_WIN); bf16* const Win_t_ = WSP(bf16, WS_WIN); const float* const w_out_ = inp(I_WOUT); bf16* const Wout_t_ = WSP(bf16, WS_WOUT); const float* const expert_v_ = inp(I_EV); const float* const expert_u_ = inp(I_EU);
    LAS float* scr = (LAS float*)(F.lds + F.wave * 16384);
    const int gw = F.vcu * NWAVES + F.wave, NGW = F.G * NWAVES;
    if (parts & 1) for (int it = F.vcu; it < 96; it += F.G) p0_mod_block(F, it);
    constexpr int I_WIN = 16 * 112, I_WOUT = 16 * 32, NITEMS = I_WIN + I_WOUT;
    if (parts & 2) for (int it = gw; it < NITEMS; it += NGW) {
        int r = it;
        if (r < I_WIN) { p0_transpose_item(w_in_, D, NPROJ, NIN, Win_t_, scr, r, F.lane); continue; } r -= I_WIN;
        p0_transpose_item(w_out_, D, D, D, Wout_t_, scr, r, F.lane);
    }
    __syncthreads();
    if (parts & 8) for (int it = F.vcu; it < 256; it += F.G) p0_weff_item(F, it);
}

template <bool DOGATES, bool SRCB = false>
DI void norm_phase(const Frame& F, const float* src, const float* g, int shift_off, int scale_off) {
    const float* const w_in_ = inp(I_WIN); float* const mod_ = WSP(float, WS_MOD); bf16* const XN_ = WSP(bf16, WS_XN); float* const GATES_ = WSP(float, WS_GATES); const float* const b_igate_ = inp(I_BIG); const float* const b_fgate_ = inp(I_BFG);
    LAS float* W8 = (LAS float*)F.lds;
    if (DOGATES) {
        for (int i = 0; i < 16; ++i) { const int idx = F.tid + 512 * i; W8[idx] = w_in_[(size_t)(idx & 1023) * NIN + NPROJ + (idx >> 10)]; }
        __syncthreads();
    }
    const int gw = F.vcu * NWAVES + F.wave, NGW = F.G * NWAVES;
    for (int ch = gw; ch < T / 16; ch += NGW) {
        const int r0 = ch * 16, b = r0 / SEQ;
        f32x4 A[4], Bv[4];
#pragma unroll
        for (int j = 0; j < 4; ++j) { const int col = 4 * F.lane + 256 * j; const f32x4 gg = *(const f32x4*)(g + col), sc = *(const f32x4*)(mod_ + b * NMOD + scale_off + col);
            A[j] = gg * (sc + 1.0f); Bv[j] = *(const f32x4*)(mod_ + b * NMOD + shift_off + col); }
        f32x4 nx[4];
#define NORM_LOADROW(ROW) do { if (SRCB) { const GAS unsigned long long* xb_ = (const GAS unsigned long long*)((const bf16*)src + (size_t)(ROW) * D) + F.lane; \
              _Pragma("unroll") for (int j = 0; j < 4; ++j) { const unsigned long long w_ = __builtin_nontemporal_load(xb_ + 64 * j); const unsigned lo_ = (unsigned)w_, hi_ = (unsigned)(w_ >> 32); \
                  nx[j] = (f32x4){bflo(lo_), bfhi(lo_), bflo(hi_), bfhi(hi_)}; } } \
          else { const GAS f32x4* xr_ = (const GAS f32x4*)(src + (size_t)(ROW) * D) + F.lane; _Pragma("unroll") for (int j = 0; j < 4; ++j) nx[j] = __builtin_nontemporal_load(xr_ + 64 * j); } } while (0)
        NORM_LOADROW(r0);
        for (int rr = 0; rr < 16; ++rr) {
            const int row = r0 + rr;
            f32x4 v[4]; float s = 0.f;
#pragma unroll
            for (int j = 0; j < 4; ++j) { v[j] = nx[j]; s += (v[j].x * v[j].x + v[j].y * v[j].y) + (v[j].z * v[j].z + v[j].w * v[j].w); }
            if (rr + 1 < 16) NORM_LOADROW(row + 1);
            const float rstd = 1.f / sqrtf(wave_sum_u(s) * (1.f / D) + EPS);
#pragma unroll
            for (int j = 0; j < 4; ++j) v[j] = v[j] * rstd * A[j] + Bv[j];
            GAS unsigned long long* o8 = (GAS unsigned long long*)(XN_ + (size_t)row * D) + F.lane;
#pragma unroll
            for (int j = 0; j < 4; ++j) o8[64 * j] = (unsigned long long)pk2(v[j].x, v[j].y) | ((unsigned long long)pk2(v[j].z, v[j].w) << 32);
            if (SRCB) {
                float mx = 0.f;
#pragma unroll
                for (int j = 0; j < 4; ++j) mx = fmaxf(mx, fmaxf(fmaxf(fabsf(v[j].x), fabsf(v[j].y)), fmaxf(fabsf(v[j].z), fabsf(v[j].w))));
                mx = wave_max_nonneg(mx);
                const float sx = mx > 0.f ? 119.f / mx : 0.f;
                unsigned lo_[2] = {0u, 0u}, hi_[2] = {0u, 0u};
#pragma unroll
                for (int j = 0; j < 4; ++j)
#pragma unroll
                    for (int c = 0; c < 4; ++c) { const int t_ = (int)rintf(v[j][c] * sx) + 8; const int sh_ = 4 * (4 * (j & 1) + c);
                        lo_[j >> 1] |= (unsigned)(t_ & 15) << sh_; hi_[j >> 1] |= (unsigned)((t_ >> 4) & 15) << sh_; }
                typedef unsigned v2u_ __attribute__((ext_vector_type(2)));
                unsigned char* xq = WSP(unsigned char, WS_XQ) + (size_t)row * 1024 + 8 * F.lane;
                v2u_ hv, lv; hv.x = hi_[0]; hv.y = hi_[1]; lv.x = lo_[0] ^ 0x88888888u; lv.y = lo_[1] ^ 0x88888888u;
                *(GAS v2u_*)xq = hv; *(GAS v2u_*)(xq + 512) = lv;
                if (F.lane == 0) WSP(float, WS_XS)[row] = mx > 0.f ? mx / 119.f : 0.f;
            }
            if (DOGATES) {
                float res = 0.f;
#pragma unroll
                for (int hh = 0; hh < 8; ++hh) { float p = 0.f;
#pragma unroll
                    for (int j = 0; j < 4; ++j) { const f32x4 w = *(const LAS f32x4*)(W8 + hh * 1024 + 4 * F.lane + 256 * j); p += (v[j].x * w.x + v[j].y * w.y) + (v[j].z * w.z + v[j].w * w.w); }
                    p = wave_sum_u(p); if (F.lane == hh) res = p; }
                if (F.lane < 8) GATES_[(size_t)row * 8 + F.lane] = res + (F.lane < 4 ? b_igate_[F.lane] : b_fgate_[F.lane - 4]);
            }
        }
    }
}

DI void sb_unit(const Frame& F, int b, int h, int qb) {
    bf16* const PROJ_ = WSP(bf16, WS_PROJ); const float* const g_q_sb_ = inp(I_GQ); const float* const g_k_sb_ = inp(I_GK); bf16* const MIX_ = WSP(bf16, WS_MIX); const float* const g_out_sb_ = inp(I_GOSB);
    const int lane = F.lane, w = F.wave, r = lane & 31, hi = lane >> 5;
    const int i16 = lane & 15, qq = i16 >> 2, pp = i16 & 3, blk = (lane >> 4) & 1;
    LAS unsigned char* Wb = F.lds + w * 16384;
    const size_t rowbase = (size_t)b * SEQ; const int q0 = qb * 256, qw0 = q0 + 32 * w, tq = qw0 + r;
    const bf16* P = PROJ_;
    const bf16* kpiece[4]; const bf16* vpiece[4];
#pragma unroll
    for (int i = 0; i < 4; ++i) { const int krow_ = 8 * i + (lane >> 3), kch = (lane & 7) ^ ((krow_ >> 1) & 7); kpiece[i] = P + (rowbase + krow_) * NPROJ + C_KSB + h * 64 + 8 * kch;
        const int vkey = 16 * (i & 1) + (lane >> 2); vpiece[i] = P + (rowbase + vkey) * NPROJ + C_VSB + h * 64 + 32 * (i >> 1) + 8 * (lane & 3); }
#define SB_DMA(T_, BUF_) do { _Pragma("unroll") for (int i_ = 0; i_ < 4; ++i_) { \
        __builtin_amdgcn_global_load_lds((const unsigned*)(kpiece[i_] + (size_t)(32 * (T_)) * NPROJ), (LAS unsigned*)(Wb + 8192 * (BUF_) + 1024 * i_), 16, 0, 0); \
        __builtin_amdgcn_global_load_lds((const unsigned*)(vpiece[i_] + (size_t)(32 * (T_)) * NPROJ), (LAS unsigned*)(Wb + 8192 * (BUF_) + 4096 + 1024 * i_), 16, 0, 0); } } while (0)
    const int tw = (qw0 + 30) >> 5;
    SB_DMA(tw, 0);
    bf16x8 qf[4];
    {
        const bf16* Qp = P + (rowbase + tq) * NPROJ + C_QSB + h * 64 + 8 * hi;
        v4u qraw[4]; float ss = 0.f;
#pragma unroll
        for (int kk = 0; kk < 4; ++kk) { qraw[kk] = *(const GAS v4u*)(Qp + 16 * kk);
#pragma unroll
            for (int e = 0; e < 4; ++e) { const float a = bflo(qraw[kk][e]), c = bfhi(qraw[kk][e]); ss += a * a + c * c; } }
        ss = swap_add(ss);
        const float rq = __builtin_amdgcn_rsqf(ss * (1.f / 64.f) + EPS) * (0.125f * LOG2E);
#pragma unroll
        for (int kk = 0; kk < 4; ++kk) { const int d0 = 16 * kk + 8 * hi;
            const f32x4 g0 = *(const f32x4*)(g_q_sb_ + d0) * *(const f32x4*)(g_k_sb_ + d0), g1 = *(const f32x4*)(g_q_sb_ + d0 + 4) * *(const f32x4*)(g_k_sb_ + d0 + 4);
            v4u o; o.x = cvtpk(bflo(qraw[kk].x) * rq * g0.x, bfhi(qraw[kk].x) * rq * g0.y); o.y = cvtpk(bflo(qraw[kk].y) * rq * g0.z, bfhi(qraw[kk].y) * rq * g0.w);
            o.z = cvtpk(bflo(qraw[kk].z) * rq * g1.x, bfhi(qraw[kk].z) * rq * g1.y); o.w = cvtpk(bflo(qraw[kk].w) * rq * g1.z, bfhi(qraw[kk].w) * rq * g1.w);
            qf[kk] = __builtin_bit_cast(bf16x8, o); }
    }
    f16x8 U0, U1, E0;
#pragma unroll
    for (int j = 0; j < 8; ++j) { U0[j] = (krow(0, hi, j) > r) ? (_Float16)1.0f : (_Float16)0.0f; U1[j] = (krow(1, hi, j) > r) ? (_Float16)1.0f : (_Float16)0.0f;
        E0[j] = (j == 0 && hi == 0) ? (_Float16)1.0f : (_Float16)0.0f; }
    f32x16 o0, o1;
#pragma unroll
    for (int i = 0; i < 16; ++i) { o0[i] = 0.f; o1[i] = 0.f; }
    float R = 0.f;
    const int kfoff = r * 128, kfsw = (r >> 1) & 7;
    for (int t = tw; t >= 0; --t) {
        const int buf = (tw - t) & 1;
        LAS unsigned char* Kb = Wb + 8192 * buf; LAS unsigned char* Vb = Kb + 4096;
        asm volatile("s_waitcnt vmcnt(0)" ::: "memory");
        if (t > 0) SB_DMA(t - 1, buf ^ 1);
        bf16x8 kf[4]; float ssk = 0.f;
#pragma unroll
        for (int kk = 0; kk < 4; ++kk) { const v4u kv = *(const LAS v4u*)(Kb + kfoff + (((2 * kk + hi) ^ kfsw) * 16)); kf[kk] = __builtin_bit_cast(bf16x8, kv);
            ssk = dot2bf(kv.x, kv.x, ssk); ssk = dot2bf(kv.y, kv.y, ssk); ssk = dot2bf(kv.z, kv.z, ssk); ssk = dot2bf(kv.w, kv.w, ssk); }
        ssk = swap_add(ssk);
        const float rk = __builtin_amdgcn_rsqf(ssk * (1.f / 64.f) + EPS);
        f16x8 RKA;
#pragma unroll
        for (int e = 0; e < 8; ++e) RKA[e] = (_Float16)0.0f;
        RKA[0] = (hi == 0) ? (_Float16)rk : (_Float16)0.0f;
        f32x16 s, rkd;
#pragma unroll
        for (int i = 0; i < 16; ++i) { s[i] = 0.f; rkd[i] = 0.f; }
        rkd = MFMA_F16(RKA, E0, rkd);
#pragma unroll
        for (int kk = 0; kk < 4; ++kk) s = MFMA_BF16(kf[kk], qf[kk], s);
        float tsum = 0.f; unsigned lp[8];
        if (32 * t + 31 < qw0) {
#pragma unroll
            for (int i = 0; i < 16; i += 2) {
                const float z0_ = s[i] * rkd[i], z1_ = s[i + 1] * rkd[i + 1];
                const float a0_ = -lg2(1.f + ex2(z0_)), a1_ = -lg2(1.f + ex2(z1_));
                tsum += a0_ + a1_;
                s[i] = z0_ + a0_; s[i + 1] = z1_ + a1_;
                lp[i >> 1] = pkh(a0_, a1_); }
        } else {
            const int kq = tq - 32 * t;
#pragma unroll
            for (int i = 0; i < 16; i += 2) {
                const float z0_ = s[i] * rkd[i], z1_ = s[i + 1] * rkd[i + 1];
                float a0_ = -lg2(1.f + ex2(z0_)), a1_ = -lg2(1.f + ex2(z1_));
                const bool ma0 = crow(i, hi) >= kq, ma1 = crow(i + 1, hi) >= kq;
                a0_ = ma0 ? 0.f : a0_; a1_ = ma1 ? 0.f : a1_;
                tsum += a0_ + a1_;
                s[i] = ma0 ? -INFINITY : z0_ + a0_; s[i + 1] = ma1 ? -INFINITY : z1_ + a1_;
                lp[i >> 1] = pkh(a0_, a1_); }
        }
        f32x16 c;
#pragma unroll
        for (int i = 0; i < 16; ++i) c[i] = R;
        c = MFMA_F16(U0, __builtin_bit_cast(f16x8, (v4u){lp[0], lp[1], lp[2], lp[3]}), c); c = MFMA_F16(U1, __builtin_bit_cast(f16x8, (v4u){lp[4], lp[5], lp[6], lp[7]}), c);
#pragma unroll
        for (int i = 0; i < 16; ++i) s[i] = ex2(s[i] + c[i]);
        const bf16x8 W0 = packbf(s, 0), W1 = packbf(s, 1);
        LAS unsigned char* vb_ = Vb + (4 * hi + qq) * 64 + 32 * blk + 8 * pp;
        o0 = MFMA_BF16(cat8(trrd(vb_), trrd(vb_ + 8 * 64)), W0, o0); o0 = MFMA_BF16(cat8(trrd(vb_ + 16 * 64), trrd(vb_ + 24 * 64)), W1, o0);
        o1 = MFMA_BF16(cat8(trrd(vb_ + 2048), trrd(vb_ + 2048 + 8 * 64)), W0, o1); o1 = MFMA_BF16(cat8(trrd(vb_ + 2048 + 16 * 64), trrd(vb_ + 2048 + 24 * 64)), W1, o1);
        R += swap_add(tsum);
        if (__all(R < -150.f)) break;
    }
    asm volatile("s_waitcnt vmcnt(0)" ::: "memory");
#undef SB_DMA
    {
        float ss = 0.f;
#pragma unroll
        for (int i = 0; i < 16; ++i) ss += o0[i] * o0[i] + o1[i] * o1[i];
        ss = swap_add(ss);
        const float ro = __builtin_amdgcn_rsqf(ss * (1.f / 64.f) + EPS);
        bf16* Op = MIX_ + (rowbase + tq) * D + h * 64;
        const float* go = g_out_sb_ + h * 64;
#pragma unroll
        for (int g = 0; g < 4; ++g) { const int d0 = 8 * g + 4 * hi; const f32x4 ga = *(const f32x4*)(go + d0), gb = *(const f32x4*)(go + 32 + d0);
            u32x2 wa, wb; wa.x = cvtpk(o0[4 * g] * ro * ga.x, o0[4 * g + 1] * ro * ga.y); wa.y = cvtpk(o0[4 * g + 2] * ro * ga.z, o0[4 * g + 3] * ro * ga.w);
            wb.x = cvtpk(o1[4 * g] * ro * gb.x, o1[4 * g + 1] * ro * gb.y); wb.y = cvtpk(o1[4 * g + 2] * ro * gb.z, o1[4 * g + 3] * ro * gb.w);
            *(GAS u32x2*)(Op + d0) = wa; *(GAS u32x2*)(Op + 32 + d0) = wb; }
    }
    __syncthreads();
}

DI void conv_silu8(const v4u (&xr)[4], const float (&cw)[4][8], float scale, float (&y)[8]) {
#pragma unroll
    for (int e = 0; e < 8; ++e) y[e] = 0.f;
#pragma unroll
    for (int j = 0; j < 4; ++j) {
        y[0] += cw[j][0] * bflo(xr[j].x); y[1] += cw[j][1] * bfhi(xr[j].x); y[2] += cw[j][2] * bflo(xr[j].y); y[3] += cw[j][3] * bfhi(xr[j].y);
        y[4] += cw[j][4] * bflo(xr[j].z); y[5] += cw[j][5] * bfhi(xr[j].z); y[6] += cw[j][6] * bflo(xr[j].w); y[7] += cw[j][7] * bfhi(xr[j].w); }
#pragma unroll
    for (int e = 0; e < 8; ++e) y[e] = scale * y[e] * __builtin_amdgcn_rcpf(1.f + fexp(-y[e]));
}
DI float log_sigmoid(float x) { return fminf(x, 0.f) - 0.6931471805599453f * lg2(1.f + fexp(-fabsf(x))); }
DI float wave_scan_incl(float a, int lane) {
#pragma unroll
    for (int o = 1; o < 64; o <<= 1) { const float t = __shfl_up(a, o); if (lane >= o) a += t; }
    return a;
}

constexpr int LDS_CW = 65536;
DI void stage_conv_w(const Frame& F) {
    const float* const conv_w_ = inp(I_CONVW); LAS float* cwl = (LAS float*)(F.lds + LDS_CW);
    for (int i = F.tid; i < 4096; i += NTHR) cwl[i] = conv_w_[i];
    __syncthreads();
}
DI void load_cw8(const Frame& F, int colbase, float (&cw)[4][8]) {
    const LAS float* cwl = (const LAS float*)(F.lds + LDS_CW);
#pragma unroll
    for (int j = 0; j < 4; ++j) { const f32x4 a = *(const LAS f32x4*)(cwl + j * 1024 + colbase), b = *(const LAS f32x4*)(cwl + j * 1024 + colbase + 4);
        cw[j][0] = a.x; cw[j][1] = a.y; cw[j][2] = a.z; cw[j][3] = a.w; cw[j][4] = b.x; cw[j][5] = b.y; cw[j][6] = b.z; cw[j][7] = b.w; }
}
struct MlLocalRegs { v4u kraw[2][4]; v4u vraw[2]; float gi, gf; };
DI void ml_local_load(const Frame& F, int chain, int c, MlLocalRegs& R) {
    bf16* const PROJ_ = WSP(bf16, WS_PROJ); float* const GATES_ = WSP(float, WS_GATES);
    const int tid = F.tid, lane = F.lane;
    const int b = chain >> 2, hh = chain & 3; const size_t rowbase = (size_t)b * SEQ; const int t0 = c * 64;
    const bf16* P = PROJ_;
    const int kc = tid & 15, kr0 = tid >> 4;
    const bf16* Kg = P + rowbase * NPROJ + C_KML + hh * 128 + kc * 8;
#pragma unroll
    for (int i = 0; i < 2; ++i)
#pragma unroll
        for (int j = 0; j < 4; ++j) { const int tt = t0 + kr0 + 32 * i - 3 + j; R.kraw[i][j] = (tt >= 0) ? *(const GAS v4u*)(Kg + (size_t)tt * NPROJ) : (v4u){0u, 0u, 0u, 0u}; }
#pragma unroll
    for (int i = 0; i < 2; ++i) R.vraw[i] = *(const GAS v4u*)(P + (rowbase + t0 + kr0 + 32 * i) * NPROJ + C_VML + hh * 128 + kc * 8);
    const float* Gg = GATES_ + (rowbase + t0 + lane) * 8;
    R.gi = Gg[hh]; R.gf = Gg[4 + hh];
}
DI void ml_local_unit(const Frame& F, int chain, int c, const MlLocalRegs& RG) {
    bf16* const CST_ = WSP(bf16, WS_CST); float* const NST_ = WSP(float, WS_NST); float* const SCL_ = WSP(float, WS_SCL);
    LAS unsigned char* L = F.lds;
    LAS float* Lws = (LAS float*)(L + 32768);
    const int tid = F.tid, lane = F.lane, w = F.wave, r = lane & 31, hi = lane >> 5;
    const int i16 = lane & 15, qq = i16 >> 2, pp = i16 & 3, blk = (lane >> 4) & 1;
    const int hh = chain & 3;
    const int kbk = w & 3, vb0 = 2 * (w >> 2);
    const int kc = tid & 15, kr0 = tid >> 4;
    v4u kraw[2][4], vraw[2];
#pragma unroll
    for (int i = 0; i < 2; ++i) { vraw[i] = RG.vraw[i];
#pragma unroll
        for (int j = 0; j < 4; ++j) kraw[i][j] = RG.kraw[i][j]; }
    const float gi = RG.gi, gf = RG.gf;
    const float a = wave_scan_incl(log_sigmoid(gf), lane);
    const float a_end = __shfl(a, 63);
    const float lw = a_end - a + gi;
    const float m_loc = wave_max(lw);
    const float ws = fexp(lw - m_loc);
    if (w == 0) Lws[lane] = ws;
    {
        float cw[4][8]; load_cw8(F, 512 + hh * 128 + kc * 8, cw);
#pragma unroll
        for (int i = 0; i < 2; ++i) { float y[8]; conv_silu8(kraw[i], cw, 0.08838834764831845f, y);
            v4u o; o.x = cvtpk(y[0], y[1]); o.y = cvtpk(y[2], y[3]); o.z = cvtpk(y[4], y[5]); o.w = cvtpk(y[6], y[7]);
            *(LAS v4u*)(L + (kc >> 2) * 4096 + (kr0 + 32 * i) * 64 + (kc & 3) * 16) = o; }
#pragma unroll
        for (int i = 0; i < 2; ++i) { const int row = kr0 + 32 * i; const float wsr = __shfl(ws, row);
            v4u o; o.x = cvtpk(bflo(vraw[i].x) * wsr, bfhi(vraw[i].x) * wsr); o.y = cvtpk(bflo(vraw[i].y) * wsr, bfhi(vraw[i].y) * wsr); o.z = cvtpk(bflo(vraw[i].z) * wsr, bfhi(vraw[i].z) * wsr); o.w = cvtpk(bflo(vraw[i].w) * wsr, bfhi(vraw[i].w) * wsr);
            *(LAS v4u*)(L + 16384 + (kc >> 2) * 4096 + row * 64 + (kc & 3) * 16) = o; }
    }
    __syncthreads();
    f32x16 acc0, acc1;
#pragma unroll
    for (int i = 0; i < 16; ++i) { acc0[i] = 0.f; acc1[i] = 0.f; }
#pragma unroll
    for (int kk = 0; kk < 4; ++kk) { const int rows = 16 * kk + 8 * hi + qq;
        LAS unsigned char* ka = L + kbk * 4096 + rows * 64 + 32 * blk + 8 * pp; LAS unsigned char* va = L + 16384 + vb0 * 4096 + rows * 64 + 32 * blk + 8 * pp;
        const bf16x8 A = cat8(trrd(ka), trrd(ka + 4 * 64));
        acc0 = MFMA_BF16(A, cat8(trrd(va), trrd(va + 4 * 64)), acc0); acc1 = MFMA_BF16(A, cat8(trrd(va + 4096), trrd(va + 4096 + 4 * 64)), acc1); }
    {
        bf16* Cp = CST_ + ((size_t)(chain * 64 + c) * 128 + vb0 * 32 + r) * 128 + kbk * 32 + 4 * hi;
#pragma unroll
        for (int g = 0; g < 4; ++g) { u32x2 o; o.x = cvtpk(acc0[4 * g], acc0[4 * g + 1]); o.y = cvtpk(acc0[4 * g + 2], acc0[4 * g + 3]); *(GAS u32x2*)(Cp + 8 * g) = o;
            u32x2 o1; o1.x = cvtpk(acc1[4 * g], acc1[4 * g + 1]); o1.y = cvtpk(acc1[4 * g + 2], acc1[4 * g + 3]); *(GAS u32x2*)(Cp + 32 * 128 + 8 * g) = o1; }
    }
    {
        const int k = 16 * w + (lane & 15), sq = lane >> 4; float part = 0.f;
        const LAS unsigned short* kcol = (const LAS unsigned short*)(L + (k >> 5) * 4096 + (k & 31) * 2);
#pragma unroll
        for (int e = 0; e < 16; ++e) part += Lws[16 * sq + e] * __uint_as_float((unsigned)kcol[(16 * sq + e) * 32] << 16);
        part += __shfl_xor(part, 16); part += __shfl_xor(part, 32);
        if (lane < 16) NST_[(size_t)(chain * 64 + c) * 128 + k] = part;
        if (tid == 0) { SCL_[(chain * 64 + c) * 2] = a_end; SCL_[(chain * 64 + c) * 2 + 1] = m_loc; }
    }
    __syncthreads();
}
DI void ml_scan_phase(const Frame& F) {
    bf16* const CST_ = WSP(bf16, WS_CST); float* const NST_ = WSP(float, WS_NST); float* const SCL_ = WSP(float, WS_SCL); float* const MST_ = WSP(float, WS_MST);
    for (int gt = F.vcu * NTHR + F.tid; gt < 32 * 4096; gt += F.G * NTHR) {
        const int chain = gt >> 12, rem = gt & 4095;
        const float ae_l = SCL_[(chain * 64 + F.lane) * 2], ml_l = SCL_[(chain * 64 + F.lane) * 2 + 1];
        u32x2* Cp = (u32x2*)(CST_ + (size_t)chain * 64 * 16384 + (size_t)rem * 4);
        f32x4* Np = (f32x4*)(NST_ + (size_t)chain * 64 * 128 + rem * 4);
        const bool do_n = rem < 32;
        float c0 = 0.f, c1 = 0.f, c2 = 0.f, c3 = 0.f; f32x4 nn = {0.f, 0.f, 0.f, 0.f}; float m = 0.f;
        u32x2 dr[8]; f32x4 nr[8];
#pragma unroll
        for (int i = 0; i < 8; ++i) { dr[i] = Cp[(size_t)i * 4096]; if (do_n) nr[i] = Np[i * 32]; }
        for (int c0_ = 0; c0_ < 64; c0_ += 8) {
#pragma unroll
            for (int i = 0; i < 8; ++i) { const int c = c0_ + i;
                if (c < 63) {
                    const u32x2 dcur = dr[i]; const f32x4 dn = nr[i];
                    if (c + 8 < 63) { dr[i] = Cp[(size_t)(c + 8) * 4096]; if (do_n) nr[i] = Np[(c + 8) * 32]; }
                    const float ae = __builtin_bit_cast(float, __builtin_amdgcn_readlane(__builtin_bit_cast(int, ae_l), c)), ml = __builtin_bit_cast(float, __builtin_amdgcn_readlane(__builtin_bit_cast(int, ml_l), c));
                    const float mn = fmaxf(ae + m, ml), d1 = fexp(ae + m - mn), d2 = fexp(ml - mn);
                    c0 = d1 * c0 + d2 * bflo(dcur.x); c1 = d1 * c1 + d2 * bfhi(dcur.x); c2 = d1 * c2 + d2 * bflo(dcur.y); c3 = d1 * c3 + d2 * bfhi(dcur.y);
                    u32x2 o; o.x = cvtpk(c0, c1); o.y = cvtpk(c2, c3); Cp[(size_t)c * 4096] = o;
                    if (do_n) { nn = nn * d1 + dn * d2; Np[c * 32] = nn; }
                    if (rem == 0) MST_[chain * 64 + c] = mn;
                    m = mn; } }
        }
    }
}
DI void ml_out_unit(const Frame& F, int chain, int c, int nchain = -1, int nc = 0) {
    bf16* const PROJ_ = WSP(bf16, WS_PROJ); float* const GATES_ = WSP(float, WS_GATES); float* const MST_ = WSP(float, WS_MST); bf16* const CST_ = WSP(bf16, WS_CST); float* const NST_ = WSP(float, WS_NST); bf16* const MIX_ = WSP(bf16, WS_MIX); const float* const g_out_ml_ = inp(I_GOML);
    LAS unsigned char* L = F.lds;
    LAS float* Lbs = (LAS float*)(L + 49152); LAS float* Lav = (LAS float*)(L + 49408); LAS float* Lex = (LAS float*)(L + 49664);
    const int tid = F.tid, lane = F.lane, w = F.wave, r = lane & 31, hi = lane >> 5;
    const int i16 = lane & 15, qq = i16 >> 2, pp = i16 & 3, blk = (lane >> 4) & 1;
    const int b = chain >> 2, hh = chain & 3; const size_t rowbase = (size_t)b * SEQ; const int t0 = c * 64;
    const int tb = w >> 2, vb = w & 3;
    const bf16* P = PROJ_;
    {
        const int kc = tid & 15, kr0 = tid >> 4;
#pragma unroll
        for (int which = 0; which < 2; ++which) {
            const int colbase = (which ? 512 : 0) + hh * 128 + kc * 8;
            float cw[4][8]; load_cw8(F, colbase, cw);
            const bf16* Xg = P + rowbase * NPROJ + C_QML + colbase;
#pragma unroll
            for (int i = 0; i < 2; ++i) { const int row = kr0 + 32 * i; v4u xr[4];
#pragma unroll
                for (int j = 0; j < 4; ++j) { const int tt = t0 + row - 3 + j; xr[j] = (tt >= 0) ? *(const GAS v4u*)(Xg + (size_t)tt * NPROJ) : (v4u){0u, 0u, 0u, 0u}; }
                float y[8]; conv_silu8(xr, cw, which ? 0.08838834764831845f : 1.0f, y);
                v4u o; o.x = cvtpk(y[0], y[1]); o.y = cvtpk(y[2], y[3]); o.z = cvtpk(y[4], y[5]); o.w = cvtpk(y[6], y[7]);
                *(LAS v4u*)(L + which * 16384 + row * 256 + ((kc ^ (row & 15)) * 16)) = o; }
        }
#pragma unroll
        for (int i = 0; i < 2; ++i) { const int row = kr0 + 32 * i;
            const v4u v = *(const GAS v4u*)(P + (rowbase + t0 + row) * NPROJ + C_VML + hh * 128 + kc * 8);
            *(LAS v4u*)(L + 32768 + (kc >> 2) * 4096 + row * 64 + (kc & 3) * 16) = v; }
        if (w == 0) { const float* Gg = GATES_ + (rowbase + t0 + lane) * 8; const float a = wave_scan_incl(log_sigmoid(Gg[4 + hh]), lane); Lav[lane] = a; Lbs[lane] = Gg[hh] - a; }
    }
    const float mprev = (c > 0) ? MST_[chain * 64 + c - 1] : 0.f;
    bf16x8 cf[8], nf[8];
    if (c > 0) {
        const bf16* Cp = CST_ + ((size_t)(chain * 64 + c - 1) * 128 + vb * 32 + r) * 128 + 8 * hi;
        const float* Np = NST_ + (size_t)(chain * 64 + c - 1) * 128 + 8 * hi;
        const bool nrow = (r == 0) || (r == 4);
#pragma unroll
        for (int kk = 0; kk < 8; ++kk) { cf[kk] = *(const GAS bf16x8*)(Cp + 16 * kk);
            const f32x4 n0 = *(const f32x4*)(Np + 16 * kk), n1 = *(const f32x4*)(Np + 16 * kk + 4);
            v4u o; o.x = cvtpk(n0.x, n0.y); o.y = cvtpk(n0.z, n0.w); o.z = cvtpk(n1.x, n1.y); o.w = cvtpk(n1.z, n1.w);
            if (!nrow) o = (v4u){0u, 0u, 0u, 0u};
            nf[kk] = __builtin_bit_cast(bf16x8, o); }
    }
    unsigned tch0 = 0u, tch1 = 0u;
    if (nchain >= 0) {
        const unsigned nhh = (unsigned)nchain & 3u, nrow0 = (unsigned)(nchain >> 2) * SEQ + (unsigned)nc * 64u, cst = (unsigned)(nchain * 64 + nc - 1);
        const unsigned rr = (unsigned)tid >> 2, part = (unsigned)tid & 3u;
        unsigned o0 = (unsigned)WS_PROJ + ((nrow0 - 3u + rr) * NPROJ + C_QML + (part >> 1) * 512u + nhh * 128u + (part & 1u) * 64u) * 2u; bool v0 = (nc > 0) || (rr >= 3u);
        if (tid >= 268) { o0 = (unsigned)WS_CST + cst * 32768u + (unsigned)(tid - 268) * 128u; v0 = nc > 0; }
        unsigned o1 = (unsigned)WS_PROJ + ((nrow0 + rr) * NPROJ + ((part >> 1) ? C_OML : C_VML) + nhh * 128u + (part & 1u) * 64u) * 2u; bool v1 = true;
        if (tid >= 256) { o1 = (unsigned)WS_CST + cst * 32768u + (unsigned)(244 + tid - 256) * 128u; v1 = nc > 0; }
        if (tid >= 268) { o1 = (unsigned)WS_NST + cst * 512u + (unsigned)(tid - 268) * 128u; }
        if (tid >= 272) { o1 = (unsigned)WS_GATES + nrow0 * 32u + (unsigned)(tid - 272) * 128u; v1 = tid < 288; }
        const GAS unsigned char* wsb = (const GAS unsigned char*)F.ws;
        if (v0) tch0 = *(const GAS unsigned*)(wsb + o0);
        if (v1) tch1 = *(const GAS unsigned*)(wsb + o1);
    }
    __syncthreads();
    bf16x8 qf[8];
    f32x16 s0, s1;
#pragma unroll
    for (int i = 0; i < 16; ++i) { s0[i] = 0.f; s1[i] = 0.f; }
#pragma unroll
    for (int kk = 0; kk < 8; ++kk) { const int ch = 2 * kk + hi; const int rq_ = 32 * tb + r;
        qf[kk] = *(const LAS bf16x8*)(L + rq_ * 256 + ((ch ^ (rq_ & 15)) * 16));
        const bf16x8 a0 = *(const LAS bf16x8*)(L + 16384 + r * 256 + ((ch ^ (r & 15)) * 16));
        const bf16x8 a1 = *(const LAS bf16x8*)(L + 16384 + (32 + r) * 256 + ((ch ^ ((32 + r) & 15)) * 16));
        s0 = MFMA_BF16(a0, qf[kk], s0); s1 = MFMA_BF16(a1, qf[kk], s1); }
    const int tl = 32 * tb + r; const float a_t = Lav[tl];
    f32x16 d0, d1; float mrow = -INFINITY;
#pragma unroll
    for (int g = 0; g < 4; ++g) { const f32x4 b0 = *(const LAS f32x4*)(Lbs + 8 * g + 4 * hi), b1 = *(const LAS f32x4*)(Lbs + 32 + 8 * g + 4 * hi);
#pragma unroll
        for (int e = 0; e < 4; ++e) { const int sl = 8 * g + 4 * hi + e;
            d0[4 * g + e] = (sl <= tl) ? a_t + b0[e] : -INFINITY; d1[4 * g + e] = (32 + sl <= tl) ? a_t + b1[e] : -INFINITY;
            mrow = fmaxf(mrow, fmaxf(d0[4 * g + e], d1[4 * g + e])); } }
    mrow = fmaxf(swap_max(mrow), a_t + mprev);
    float psum = 0.f;
#pragma unroll
    for (int i = 0; i < 16; ++i) { s0[i] *= fexp(d0[i] - mrow); s1[i] *= fexp(d1[i] - mrow); psum += s0[i] + s1[i]; }
    const float w_inter = fexp(a_t + mprev - mrow);
    float den = swap_add(psum);
    const bf16x8 P00 = packbf(s0, 0), P01 = packbf(s0, 1), P10 = packbf(s1, 0), P11 = packbf(s1, 1);
    f32x16 num;
#pragma unroll
    for (int i = 0; i < 16; ++i) num[i] = 0.f;
    {
        LAS unsigned char* vb_ = L + 32768 + vb * 4096 + (4 * hi + qq) * 64 + 32 * blk + 8 * pp;
        num = MFMA_BF16(cat8(trrd(vb_), trrd(vb_ + 8 * 64)), P00, num); num = MFMA_BF16(cat8(trrd(vb_ + 16 * 64), trrd(vb_ + 24 * 64)), P01, num);
        num = MFMA_BF16(cat8(trrd(vb_ + 32 * 64), trrd(vb_ + 40 * 64)), P10, num); num = MFMA_BF16(cat8(trrd(vb_ + 48 * 64), trrd(vb_ + 56 * 64)), P11, num);
    }
    if (c > 0) {
        f32x16 it, dn;
#pragma unroll
        for (int i = 0; i < 16; ++i) { it[i] = 0.f; dn[i] = 0.f; }
#pragma unroll
        for (int kk = 0; kk < 8; ++kk) { it = MFMA_BF16(cf[kk], qf[kk], it); dn = MFMA_BF16(nf[kk], qf[kk], dn); }
#pragma unroll
        for (int i = 0; i < 16; ++i) num[i] += w_inter * it[i];
        den += w_inter * dn[0];
    }
    const float inv = __builtin_amdgcn_rcpf(fmaxf(fabsf(den), fexp(-mrow)));
    float ss = 0.f;
#pragma unroll
    for (int i = 0; i < 16; ++i) { num[i] *= inv; ss += num[i] * num[i]; }
    ss = swap_add(ss);
    if (lane < 32) Lex[(tb * 4 + vb) * 32 + r] = ss;
    __syncthreads();
    const float tot = (Lex[(tb * 4 + 0) * 32 + r] + Lex[(tb * 4 + 1) * 32 + r]) + (Lex[(tb * 4 + 2) * 32 + r] + Lex[(tb * 4 + 3) * 32 + r]);
    const float rstd = 1.f / sqrtf(tot * (1.f / 128.f) + EPS);
    {
        const size_t trow = rowbase + t0 + tl;
        const bf16* Og = P + trow * NPROJ + C_OML + hh * 128 + vb * 32 + 4 * hi;
        bf16* Mp = MIX_ + trow * D + 512 + hh * 128 + vb * 32 + 4 * hi;
        const float* go = g_out_ml_ + hh * 128 + vb * 32 + 4 * hi;
#pragma unroll
        for (int g = 0; g < 4; ++g) { const u32x2 og = *(const GAS u32x2*)(Og + 8 * g); const f32x4 gg = *(const f32x4*)(go + 8 * g);
            const float o0 = bflo(og.x), o1 = bfhi(og.x), o2 = bflo(og.y), o3 = bfhi(og.y);
            u32x2 o; o.x = cvtpk(num[4 * g] * rstd * gg.x * __builtin_amdgcn_rcpf(1.f + fexp(-o0)), num[4 * g + 1] * rstd * gg.y * __builtin_amdgcn_rcpf(1.f + fexp(-o1)));
            o.y = cvtpk(num[4 * g + 2] * rstd * gg.z * __builtin_amdgcn_rcpf(1.f + fexp(-o2)), num[4 * g + 3] * rstd * gg.w * __builtin_amdgcn_rcpf(1.f + fexp(-o3)));
            *(GAS u32x2*)(Mp + 8 * g) = o; }
    }
    asm volatile("" :: "v"(tch0), "v"(tch1));
    __syncthreads();
}

#define TK_CE(A, B) do { const float hi_ = fmaxf((A), (B)), lo_ = fminf((A), (B)); (A) = hi_; (B) = lo_; } while (0)
DI void tk_sort16(float (&a)[16]) {
#pragma unroll
    for (int k = 2; k <= 16; k <<= 1)
#pragma unroll
        for (int j = k >> 1; j > 0; j >>= 1)
#pragma unroll
            for (int i = 0; i < 16; ++i) { const int l = i ^ j; if (l > i) { if ((i & k) == 0) TK_CE(a[i], a[l]); else TK_CE(a[l], a[i]); } }
}
DI void tk_merge16(float (&a)[16], const float (&b)[16]) {
#pragma unroll
    for (int i = 0; i < 16; ++i) a[i] = fmaxf(a[i], b[15 - i]);
#pragma unroll
    for (int j = 8; j > 0; j >>= 1)
#pragma unroll
        for (int i = 0; i < 16; ++i) { const int l = i ^ j; if (l > i) TK_CE(a[i], a[l]); }
}
DI void tk_stage2(const LAS float* la, const LAS float* lb, int* IDX_, float* GATEW_, size_t o) {
        float a[16], bb[16], cnd[64];
#pragma unroll
        for (int q = 0; q < 16; ++q) { a[q] = la[q]; bb[q] = lb[q]; }
        int cnt = 0;
#pragma unroll
        for (int i = 0; i < 16; ++i)
#pragma unroll
            for (int j = 0; j < 16; ++j) if ((i + 1) * (j + 1) <= 16) { cnd[cnt] = __uint_as_float((__float_as_uint(a[i] + bb[j]) & ~0xFFu) | (unsigned)(i * 16 + j)); ++cnt; }
#pragma unroll
        for (int q = 50; q < 64; ++q) cnd[q] = -INFINITY;
        float top[16];
#pragma unroll
        for (int c = 0; c < 4; ++c) { float ch[16];
#pragma unroll
            for (int q = 0; q < 16; ++q) ch[q] = cnd[16 * c + q];
            tk_sort16(ch);
            if (c == 0) {
#pragma unroll
                for (int q = 0; q < 16; ++q) top[q] = ch[q];
            } else tk_merge16(top, ch); }
        float sv[16]; int ei[16]; float mx = -INFINITY;
#pragma unroll
        for (int q = 0; q < 16; ++q) { const unsigned code = __float_as_uint(top[q]) & 0xFFu; const float va = la[code >> 4], vb = lb[code & 15u];
            ei[q] = (int)((__float_as_uint(va) & 0x7Fu) * 128u + (__float_as_uint(vb) & 0x7Fu)); sv[q] = va + vb; mx = fmaxf(mx, sv[q]); }
        float sum = 0.f;
#pragma unroll
        for (int q = 0; q < 16; ++q) { sv[q] = fexp(sv[q] - mx); sum += sv[q]; }
        const float inv = 1.f / sum;
#pragma unroll
#define TK_PK(Q) (((__builtin_bit_cast(unsigned, sv[(Q)] * inv) + 0x2000u) & 0xFFFFC000u) | (unsigned)ei[(Q)])
        for (int q = 0; q < 16; q += 4) *(GAS v4u*)(IDX_ + o + q) = (v4u){TK_PK(q), TK_PK(q + 1), TK_PK(q + 2), TK_PK(q + 3)};
#undef TK_PK
        (void)GATEW_;
    }
struct EpiTopK {
    static constexpr bool PERM = false, AFTER_DRAIN = true;
    int* IDX; float* GATEW;
    DI void fused(f32x4 (&acc)[2][2][4][2], const pg8::Unit& u, int wr, int wc, int fr, int fq, LAS unsigned char* lds, int wid, int lane) const {
        LAS float* Tl = (LAS float*)lds;
        LAS float* Lh2 = (LAS float*)lds;
        LAS float* Ls = (LAS float*)(lds + 36864);
        const int tid = wid * 64 + lane, tl = tid & 127, p = (tid >> 7) & 1, half = tid >> 8;
#pragma unroll
        for (int ai = 0; ai < 2; ++ai) {
#pragma unroll
            for (int bj = 0; bj < 2; ++bj)
#pragma unroll
                for (int m = 0; m < 4; ++m)
#pragma unroll
                    for (int n = 0; n < 2; ++n) { LAS float* d = Tl + (wr * 64 + m * 16 + fr) * 257 + bj * 128 + wc * 32 + n * 16 + fq * 4; const f32x4 v = acc[ai][bj][m][n]; d[0] = v.x; d[1] = v.y; d[2] = v.z; d[3] = v.w; }
            __syncthreads();
            float run[16];
            {
                const LAS float* src = Tl + tl * 257 + p * 128 + half * 64;
#pragma unroll
                for (int c = 0; c < 4; ++c) { float ch[16];
#pragma unroll
                    for (int q = 0; q < 16; ++q) ch[q] = __uint_as_float((__float_as_uint(src[16 * c + q]) & ~0x7Fu) | (unsigned)(half * 64 + 16 * c + q));
                    tk_sort16(ch);
                    if (c == 0) {
#pragma unroll
                        for (int q = 0; q < 16; ++q) run[q] = ch[q];
                    } else tk_merge16(run, ch); }
            }
            __syncthreads();
#pragma unroll
            for (int q = 0; q < 16; ++q) Lh2[((tl * 2 + p) * 2 + half) * 17 + q] = run[q];
            __syncthreads();
            if (half == 0) { float oth[16];
#pragma unroll
                for (int q = 0; q < 16; ++q) oth[q] = Lh2[((tl * 2 + p) * 2 + 1) * 17 + q];
                tk_merge16(run, oth);
#pragma unroll
                for (int q = 0; q < 16; ++q) Ls[(tl * 2 + p) * 17 + q] = run[q]; }
            __syncthreads();
            if (tid < 128) tk_stage2(Ls + (tl * 2) * 17, Ls + (tl * 2) * 17 + 17, IDX, GATEW, (size_t)(u.pm * 256 + ai * 128 + tl) * 128 + u.pn * 16);
            __syncthreads();
        }
    }
};
struct OneUnit {
    pg8::Unit u;
    __device__ __forceinline__ bool next(int i, pg8::Unit& o) const { if (i) return false; o = u; return true; }
    __device__ __forceinline__ void a_ready(const pg8::Unit&) const {}
    __device__ __forceinline__ void done(const pg8::Unit&) const {}
};

DI float gelu_erf(float x) { return 0.5f * x * (1.f + erff(x * 0.7071067811865476f)); }
#define DPP_ADD(v, ctrl, rmask) ((v) + __builtin_bit_cast(float, __builtin_amdgcn_update_dpp(0, __builtin_bit_cast(int, (v)), (ctrl), (rmask), 0xF, false)))
#ifndef PEER_EBL
#define PEER_EBL 9
#endif
constexpr int PEER_EB_LOG = PEER_EBL;
#ifndef PEER_PROBE_MASK
#define PEER_PROBE_MASK 0xFFFF
#endif
typedef float f32x2v __attribute__((ext_vector_type(2)));
DI float gelu_cdf(float v) {
    const float av = fabsf(v), t = __builtin_amdgcn_rcpf(av * 0.2316418882f + 1.0f);
    float q = t * 0.5307027145f - 0.7265760135f; q = q * t + 0.7107068705f; q = q * t - 0.142248368f; q = q * t + 0.127414796f; q = q * t;
    const float m = v * (q * ex2(v * v * -0.72134752044f));
    return v < 0.f ? m : v - m;
}
#define DPP_ADDI(v, ctrl, rmask) ((v) + __builtin_amdgcn_update_dpp(0, (v), (ctrl), (rmask), 0xF, false))
DI void peer_phase(const Frame& F, bool scratch_dst) {
    bf16* const XN_ = WSP(bf16, WS_XN); int* const IDX_ = WSP(int, WS_IDX); float* const GATEW_ = WSP(float, WS_GATE); float* const mod_ = WSP(float, WS_MOD); float* const out_ = (float*)inp(I_OUT); const bf16* const X1B_ = WSP(bf16, WS_X1B);
    const unsigned char* const EU4 = WSP(unsigned char, WS_EXPU); const unsigned char* const EV4 = WSP(unsigned char, WS_EXPV); const float* const SUI_ = WSP(float, WS_SUI); const float* const SVI_ = WSP(float, WS_SVI);
    const int gw = F.vcu * NWAVES + F.wave, NGW = F.G * NWAVES, lane = F.lane, g = lane >> 3, j = lane & 7;
    LAS unsigned char* wl = F.lds + F.wave * 17408;
    volatile LAS int* Le = (volatile LAS int*)(wl + g * 512); volatile LAS float* Lg = (volatile LAS float*)(wl + 4096 + g * 512); volatile LAS int* Lp = (volatile LAS int*)(wl + 8192 + g * 512);
    volatile LAS int* Lx = (volatile LAS int*)(wl + 12288 + g * 512); LAS int* Lh = (LAS int*)(wl + 16384 + g * 128);
    for (int grp = gw; grp < T / 8; grp += NGW) {
        const size_t t = (size_t)grp * 8 + g;
        int xh[16], xl[16]; float sxi;
#ifdef PEER_DUP_S
        auto qs_ = [&]() __attribute__((always_inline)) {
#endif
        {
            const unsigned char* xq = WSP(unsigned char, WS_XQ) + t * 1024 + 16 * j;
#pragma unroll
            for (int q = 0; q < 4; ++q) { const v4u a = *(const GAS v4u*)(xq + 128 * q), b = *(const GAS v4u*)(xq + 512 + 128 * q);
#pragma unroll
                for (int w_ = 0; w_ < 4; ++w_) { xh[4 * q + w_] = (int)a[w_]; xl[4 * q + w_] = (int)b[w_]; } }
            sxi = WSP(float, WS_XS)[t];
        }
        {
            int ide[16]; float gte[16]; int rk[16];
#pragma unroll
            for (int m = 0; m < 16; ++m) { const unsigned pk_ = (unsigned)IDX_[t * 128 + j + 8 * m]; ide[m] = (int)(pk_ & 0x3FFFu); gte[m] = __builtin_bit_cast(float, pk_ & 0xFFFFC000u); }
#pragma unroll
            for (int m = 0; m < 4; ++m) Lh[j + 8 * m] = 0;
#pragma unroll
            for (int m = 0; m < 16; ++m) rk[m] = __hip_atomic_fetch_add(Lh + (ide[m] >> PEER_EB_LOG), 1, __ATOMIC_RELAXED, __HIP_MEMORY_SCOPE_WORKGROUP);
            {
                const int h0 = ((volatile LAS int*)Lh)[4 * j], h1 = ((volatile LAS int*)Lh)[4 * j + 1], h2 = ((volatile LAS int*)Lh)[4 * j + 2], h3 = ((volatile LAS int*)Lh)[4 * j + 3];
                const int tot = (h0 + h1) + (h2 + h3); int inc = tot;
#pragma unroll
                for (int o = 1; o < 8; o <<= 1) { const int tt = __shfl_up(inc, o, 8); if (j >= o) inc += tt; }
                const int ex = inc - tot;
                ((volatile LAS int*)Lh)[4 * j] = ex; ((volatile LAS int*)Lh)[4 * j + 1] = ex + h0; ((volatile LAS int*)Lh)[4 * j + 2] = ex + h0 + h1; ((volatile LAS int*)Lh)[4 * j + 3] = ex + h0 + h1 + h2;
            }
#pragma unroll
            for (int m = 0; m < 16; ++m) { const int pos = ((volatile LAS int*)Lh)[ide[m] >> PEER_EB_LOG] + rk[m]; Le[pos] = ide[m]; Lg[pos] = gte[m] * SVI_[ide[m]]; Lp[pos] = __builtin_bit_cast(int, SUI_[ide[m]] * sxi); }
        }
#ifdef PEER_DUP_S
        }; qs_(); __builtin_amdgcn_sched_barrier(0); qs_();
#endif
        v4u R0[4], R1[4], R2[4], R3[4];
#define PEER_LOADU(RR, S0) do { const size_t ro_ = (size_t)(Le[(S0)] & (scratch_dst ? PEER_PROBE_MASK : 0xFFFF)) * 512 + 16 * j; _Pragma("unroll") for (int q = 0; q < 4; ++q) RR[q] = *(const GAS v4u*)(EU4 + ro_ + 128 * q); } while (0)
#define PEER_DOTU(RR, EOUT) do { int h0_ = 0, h1_ = 0, l0_ = 0, l1_ = 0; \
            _Pragma("unroll") for (int q = 0; q < 4; q += 2) _Pragma("unroll") for (int w_ = 0; w_ < 4; ++w_) { \
                h0_ = __builtin_amdgcn_sdot8((int)RR[q][w_], xh[4 * q + w_], h0_, false); l0_ = __builtin_amdgcn_sdot8((int)RR[q][w_], xl[4 * q + w_], l0_, false); \
                h1_ = __builtin_amdgcn_sdot8((int)RR[q + 1][w_], xh[4 * q + 4 + w_], h1_, false); l1_ = __builtin_amdgcn_sdot8((int)RR[q + 1][w_], xl[4 * q + 4 + w_], l1_, false); } \
            int e_ = ((h0_ + h1_) << 4) + (l0_ + l1_); e_ = DPP_ADDI(e_, 0xB1, 0xF); e_ = DPP_ADDI(e_, 0x4E, 0xF); e_ = DPP_ADDI(e_, 0x141, 0xF); EOUT = e_; } while (0)
#define PEER_SWEEPU(BODY0, BODY1, BODY2, BODY3) do { \
            PEER_LOADU(R0, 0); PEER_LOADU(R1, 1); PEER_LOADU(R2, 2); PEER_LOADU(R3, 3); \
            for (int s = 0; s < 128; s += 4) { \
                BODY0; if (s + 4 < 128) PEER_LOADU(R0, s + 4); \
                BODY1; if (s + 4 < 128) PEER_LOADU(R1, s + 5); \
                BODY2; if (s + 4 < 128) PEER_LOADU(R2, s + 6); \
                BODY3; if (s + 4 < 128) PEER_LOADU(R3, s + 7); } } while (0)
#define PEER_FIN(RR, SS) do { int e1_; PEER_DOTU(RR, e1_); Lx[(SS)] = e1_; } while (0)
        PEER_SWEEPU(PEER_FIN(R0, s), PEER_FIN(R1, s + 1), PEER_FIN(R2, s + 2), PEER_FIN(R3, s + 3));
#ifdef PEER_DUP_U
        PEER_SWEEPU(PEER_FIN(R0, s), PEER_FIN(R1, s + 1), PEER_FIN(R2, s + 2), PEER_FIN(R3, s + 3));
#endif
#undef PEER_FIN
        float yscale; int csum8;
        {
            float cf_[16]; float cmax = 0.f;
#pragma unroll
            for (int i = 0; i < 16; ++i) { const int ix = 16 * j + i; cf_[i] = Lg[ix] * gelu_cdf((float)Lx[ix] * __builtin_bit_cast(float, Lp[ix])); cmax = fmaxf(cmax, fabsf(cf_[i])); }
            cmax = fmaxf(cmax, __shfl_xor(cmax, 1, 8)); cmax = fmaxf(cmax, __shfl_xor(cmax, 2, 8)); cmax = fmaxf(cmax, __shfl_xor(cmax, 4, 8));
            const float cqs = cmax > 0.f ? 127.f / cmax : 0.f; yscale = cmax > 0.f ? cmax / 127.f : 0.f;
            int pk_[4]; int cs_ = 0;
#pragma unroll
            for (int m = 0; m < 4; ++m) { const int q0 = (int)rintf(cf_[4 * m] * cqs), q1 = (int)rintf(cf_[4 * m + 1] * cqs), q2 = (int)rintf(cf_[4 * m + 2] * cqs), q3 = (int)rintf(cf_[4 * m + 3] * cqs);
                cs_ += (q0 + q1) + (q2 + q3);
                pk_[m] = (int)((unsigned)(q0 & 0xff) | ((unsigned)(q1 & 0xff) << 8) | ((unsigned)(q2 & 0xff) << 16) | ((unsigned)q3 << 24)); }
            cs_ += __shfl_xor(cs_, 1, 8); cs_ += __shfl_xor(cs_, 2, 8); cs_ += __shfl_xor(cs_, 4, 8); csum8 = 8 * cs_;
#pragma unroll
            for (int m = 0; m < 4; ++m) Lp[4 * j + m] = pk_[m];
        }
#ifndef PEER_DUP_V
#define PEER_DUP_V 1
#endif
#pragma unroll
        for (int HH = 0; HH < 2 * PEER_DUP_V; ++HH) { const int H = HH & 1;
            int ya[32], yl[32];
#pragma unroll
            for (int i = 0; i < 32; ++i) { ya[i] = 0; yl[i] = 0; }
            v4u RV[8][2];
#define PEER_ROFFV(S0) ((size_t)(Le[(S0)] & (scratch_dst ? PEER_PROBE_MASK : 0xFFFF)) * 512 + 256 * H + 16 * j)
#pragma unroll
            for (int r = 0; r < 8; ++r) { const size_t ro_ = PEER_ROFFV(r); RV[r][0] = *(const GAS v4u*)(EV4 + ro_); RV[r][1] = *(const GAS v4u*)(EV4 + ro_ + 128); }
            for (int bt = 0; bt < 16; ++bt) {
                const int c0_ = Lp[2 * bt], c1_ = Lp[2 * bt + 1];
                size_t ron[8];
#pragma unroll
                for (int r = 0; r < 8; ++r) ron[r] = (bt + 1 < 16) ? PEER_ROFFV(8 * bt + 8 + r) : 0;
#pragma unroll
                for (int q = 0; q < 2; ++q) {
#pragma unroll
                    for (int hb = 0; hb < 2; ++hb) { const int cq_ = hb ? c1_ : c0_;
#pragma unroll
                        for (int w_ = 0; w_ < 4; ++w_) { const unsigned a0 = RV[4 * hb][q][w_], a1 = RV[4 * hb + 1][q][w_], a2 = RV[4 * hb + 2][q][w_], a3 = RV[4 * hb + 3][q][w_];
                            const unsigned p0 = __builtin_amdgcn_perm(a1, a0, 0x05010400u), p1 = __builtin_amdgcn_perm(a1, a0, 0x07030602u), p2 = __builtin_amdgcn_perm(a3, a2, 0x05010400u), p3 = __builtin_amdgcn_perm(a3, a2, 0x07030602u);
                            unsigned Tb[4]; Tb[0] = __builtin_amdgcn_perm(p2, p0, 0x05040100u); Tb[1] = __builtin_amdgcn_perm(p2, p0, 0x07060302u); Tb[2] = __builtin_amdgcn_perm(p3, p1, 0x05040100u); Tb[3] = __builtin_amdgcn_perm(p3, p1, 0x07060302u);
#pragma unroll
                            for (int b_ = 0; b_ < 4; ++b_) { ya[16 * q + 4 * w_ + b_] = __builtin_amdgcn_sdot4((int)Tb[b_], cq_, ya[16 * q + 4 * w_ + b_], false);
                                yl[16 * q + 4 * w_ + b_] = __builtin_amdgcn_sdot4((int)(Tb[b_] & 0x0F0F0F0Fu), cq_, yl[16 * q + 4 * w_ + b_], false); } } }
                    if (bt + 1 < 16) {
#pragma unroll
                        for (int r = 0; r < 8; ++r) RV[r][q] = *(const GAS v4u*)(EV4 + ron[r] + 128 * q); }
                }
            }
#undef PEER_ROFFV
            int to_ = grp * 8 + g, jo_ = j; asm volatile("" : "+v"(to_), "+v"(jo_));
            const int b = to_ / SEQ; const unsigned eo_ = (unsigned)to_ * D + 128 * H + 8 * jo_;
            const float* g2 = mod_ + b * NMOD + 5120 + 128 * H + 8 * jo_;
            const bf16* ip = X1B_ + eo_; float* op = ((scratch_dst || HH + 2 < 2 * PEER_DUP_V) ? WSP(float, WS_SCORES) : out_) + eo_;
#pragma unroll
            for (int q = 0; q < 2; ++q) { __builtin_amdgcn_sched_barrier(0);
#pragma unroll
                for (int w_ = 0; w_ < 4; ++w_)
#pragma unroll
                    for (int nh = 0; nh < 2; ++nh) { const int co = 256 * (2 * (w_ & 1) + nh) + 64 * q + 4 * (w_ >> 1); const int yb = 16 * q + 4 * w_ + 2 * nh;
                        const unsigned long long xw_ = *(const GAS unsigned long long*)(ip + co); const unsigned xlo_ = (unsigned)xw_, xhi_ = (unsigned)(xw_ >> 32); const f32x4 x1 = (f32x4){bflo(xlo_), bfhi(xlo_), bflo(xhi_), bfhi(xhi_)}; const f32x4 gg = *(const f32x4*)(g2 + co) * yscale;
                        f32x4 o; o.x = x1.x + gg.x * (float)(yl[yb] - csum8); o.y = x1.y + gg.y * (float)((ya[yb] - yl[yb]) >> 4); o.z = x1.z + gg.z * (float)(yl[yb + 1] - csum8); o.w = x1.w + gg.w * (float)((ya[yb + 1] - yl[yb + 1]) >> 4);
                        *(GAS f32x4*)(op + co) = o; } }
        }
#undef PEER_LOADU
#undef PEER_DOTU
#undef PEER_SWEEPU
    }
}

DI void ph_inproj(const Frame& F) {
    pg8::Gemm g{WSP(bf16, WS_XN), WSP(bf16, WS_WIN), T, NPROJ, D}; pg8::StaticOrder S; S.init(T, NPROJ, F.G, (int)blockIdx.x);
    pg8::EpiBf16<0> E{WSP(bf16, WS_PROJ), NPROJ, nullptr, 0, 0, 1.f};
    pg8::gemm_phase<pg8::EpiBf16<0>, pg8::StaticOrder, PG8_ALIGN, PG8_SP2>(F.lds, g, S, E);
}
DI void ph_mix(const Frame& F, bool probe_first) {
    stage_conv_w(F);
    {
        int u = F.vcu;
        MlLocalRegs ra;
        if (u < 2048) ml_local_load(F, u >> 6, u & 63, ra);
        const int gwv = F.vcu * NWAVES + F.wave, NGWv = F.G * NWAVES;
        int eb = 2 * gwv;
        while (u < 2048) {
            const int un = u + F.G;
            MlLocalRegs rb;
            if (un < 2048) ml_local_load(F, un >> 6, un & 63, rb);
            ExpRows2 er; const bool ew = eb < 32768;
            if (ew) exp_load2(F, eb, er);
            ml_local_unit(F, u >> 6, u & 63, ra);
            if (ew) exp_conv2(F, eb, er);
            eb += 2 * NGWv;
            ra = rb; u = un;
        }
        for (; eb < 32768; eb += 2 * NGWv) { ExpRows2 er; exp_load2(F, eb, er); exp_conv2(F, eb, er); }
    }
    (void)probe_first;
}
DI void ph_scan_attn(const Frame& F) {
    ml_scan_phase(F);
    __syncthreads();
    for (int u = F.vcu; u < 1024; u += F.G) { const int qb = 15 - (u >> 6), bh = u & 63; sb_unit(F, bh >> 3, bh & 7, qb); }
}
DI void ph_mlout(const Frame& F) { stage_conv_w(F); for (int u = F.vcu; u < 2048; u += F.G) { const int un = u + F.G; ml_out_unit(F, u >> 6, u & 63, un < 2048 ? (un >> 6) : -1, un & 63); } }
#ifndef P5_ALIGN
#define P5_ALIGN PG8_ALIGN
#endif
DI void ph_outproj(const Frame& F) {
    pg8::Gemm g{WSP(bf16, WS_MIX), WSP(bf16, WS_WOUT), T, D, D}; pg8::StaticOrder S; S.init(T, D, F.G, (int)blockIdx.x);
    pg8::EpiResGateBf16 E{inp(I_X), WSP(pg8::bf16_t, WS_X1B), WSP(float, WS_MOD) + 2048, NMOD, SEQ, D};
    pg8::gemm_phase<pg8::EpiResGateBf16, pg8::StaticOrder, P5_ALIGN, PG8_SP2>(F.lds, g, S, E);
}
DI void ph_scores(const Frame& F) {
    pg8::Gemm g{WSP(bf16, WS_XN), WSP(bf16, WS_WEFF), T, NSC, D}; pg8::StaticOrder S; S.init(T, NSC, F.G, (int)blockIdx.x);
    EpiTopK E{WSP(int, WS_IDX), WSP(float, WS_GATE)};
    pg8::Unit un;
    for (int i = 0; S.next(i, un); ++i) { OneUnit S1{un}; pg8::gemm_phase<EpiTopK, OneUnit, false, PG8_SP2>(F.lds, g, S1, E); }
}
constexpr int N_PHASES = 11;
struct Args { const float* in[19]; float* out; unsigned char* ws; int ph_lo, ph_hi; };
__global__ void __launch_bounds__(NTHR, 2) hybrid_fwd(Args args) {
    extern __shared__ __attribute__((aligned(16))) unsigned char lds_raw[];
    Frame F;
    F.lds = (LAS unsigned char*)lds_raw;
    F.MISC = (volatile LAS unsigned*)(F.lds + LDSCTL_OFF + 320);
    F.tid = threadIdx.x; F.lane = F.tid & 63; F.wave = __builtin_amdgcn_readfirstlane(F.tid >> 6);
    F.G = gridDim.x; { const int bx = blockIdx.x; F.vcu = (F.G % 8 == 0) ? (bx % 8) * (F.G / 8) + bx / 8 : bx; }
    F.ws = args.ws;
    F.ctl = (gu32*)(F.ws + WS_CTL);
    for (int u = F.tid; u < (LDS_BYTES - LDSCTL_OFF) / 4; u += NTHR) ((LAS unsigned*)(F.lds + LDSCTL_OFF))[u] = 0u;
    __syncthreads();
    const int lo = args.ph_lo, hi = args.ph_hi;
    const bool one_launch = (hi - lo) > 1;
    XcdBarrier bar; bar.bar = (unsigned*)(F.ctl + CW_BAR); bar.x = 0; bar.st = nullptr;
    if (one_launch) bar = xcd_barrier_post((unsigned*)(F.ctl + CW_BAR), F.MISC + 8);
#ifndef PHMASK
#define PHMASK 0x7ff
#endif
#define IN(k) (((PHMASK >> (k)) & 1) && lo <= (k) && (k) < hi)
#define SEAM(k) do { if (IN(k) && IN((k) + 1)) xcd_barrier(bar); } while (0)
#ifndef REPMASK
#define REPMASK 0
#endif

#define RUN(k, ...) do { if (IN(k)) { if ((REPMASK >> (k)) & 1) { { const bool first = true; (void)first; __VA_ARGS__; } xcd_barrier(bar); } { const bool first = false; (void)first; __VA_ARGS__; } } } while (0)
    RUN(0, p0_phase(F, first ? P0_PARTS : 15)); SEAM(0);
    RUN(1, norm_phase<true>(F, inp(I_X), inp(I_GN1), 0, 1024)); SEAM(1);
    RUN(2, ph_inproj(F)); SEAM(2);
    RUN(3, ph_mix(F, first)); SEAM(3);
    RUN(10, ph_scan_attn(F)); if (IN(10) && IN(4)) xcd_barrier(bar);
    RUN(4, ph_mlout(F)); SEAM(4);
    RUN(5, ph_outproj(F)); SEAM(5);
    RUN(6, norm_phase<false, true>(F, (const float*)WSP(bf16, WS_X1B), inp(I_GN2), 3072, 4096)); SEAM(6);
    RUN(7, ph_scores(F)); if (IN(7) && IN(9)) xcd_barrier(bar);
    RUN(9, peer_phase(F, first));
#undef RUN
#undef IN
#undef SEAM
}

#ifndef MK_PER_PHASE
#define MK_PER_PHASE 0
#endif
extern "C" void kernel_launch(void* const* d_in, const int* in_sizes, int n_in, void* d_out, int out_size, void* d_ws, size_t ws_size, hipStream_t stream) {
    static int grid = 0;
    if (grid == 0) {
        if (n_in != 19 || in_sizes[0] != T * D || out_size != T * D || ws_size < WS_END) { fprintf(stderr, "kernel_launch: unexpected shapes (n_in %d, in0 %d, out %d, ws %zu)\n", n_in, n_in > 0 ? in_sizes[0] : -1, out_size, ws_size); grid = -1; return; }
        int dev = 0, cus = 0, per_cu = 0;
        if (hipGetDevice(&dev) != hipSuccess || hipDeviceGetAttribute(&cus, hipDeviceAttributeMultiprocessorCount, dev) != hipSuccess) { grid = -1; return; }
        if (hipFuncSetAttribute((const void*)hybrid_fwd, hipFuncAttributeMaxDynamicSharedMemorySize, LDS_BYTES) != hipSuccess) { fprintf(stderr, "kernel_launch: hipFuncSetAttribute failed\n"); grid = -1; return; }
        if (hipOccupancyMaxActiveBlocksPerMultiprocessor(&per_cu, (const void*)hybrid_fwd, NTHR, LDS_BYTES) != hipSuccess || per_cu < 1) fprintf(stderr, "kernel_launch: occupancy query says %d\n", per_cu);
        (void)hipGetLastError();
        grid = cus;
    }
    if (grid < 0) return;
    if (hipMemsetAsync((char*)d_ws + WS_CTL, 0, CTL_ZERO_BYTES, stream) != hipSuccess) { fprintf(stderr, "kernel_launch: memset failed\n"); return; }
    Args a{};
    for (int i = 0; i < 19; ++i) a.in[i] = (const float*)d_in[i];
    a.out = (float*)d_out; a.ws = (unsigned char*)d_ws;
#if MK_PER_PHASE
    { const int order[N_PHASES] = {0, 1, 2, 3, 10, 4, 5, 6, 7, 8, 9}; for (int i = 0; i < N_PHASES; ++i) { a.ph_lo = order[i]; a.ph_hi = order[i] + 1; hipLaunchKernelGGL(hybrid_fwd, dim3(grid), dim3(NTHR), LDS_BYTES, stream, a); } }
#else
    a.ph_lo = 0; a.ph_hi = N_PHASES;
    hipLaunchKernelGGL(hybrid_fwd, dim3(grid), dim3(NTHR), LDS_BYTES, stream, a);
#endif
    const hipError_t le = hipPeekAtLastError();
    if (le != hipSuccess) fprintf(stderr, "kernel_launch: launch failed: %s\n", hipGetErrorName(le));
}
```

```cpp
#include <cmath>
#include <hip/hip_runtime.h>
#include <cstdio>
#include <cstdint>
namespace pg8 {
#define PG8_LAS __attribute__((address_space(3)))
typedef unsigned short bf16_t;
typedef short bf16x8 __attribute__((ext_vector_type(8)));
typedef float f32x4 __attribute__((ext_vector_type(4)));
typedef unsigned u32x4 __attribute__((ext_vector_type(4)));
constexpr int BM = 256, BK = 64, HALF = 128, HTB = HALF * BK * 2  , STAGE_BYTES = 8 * HTB, NXCD = 8,
#ifndef PG8_WGM
#define PG8_WGM 4
#endif
WGM = PG8_WGM;

__host__ __device__ __forceinline__ int lds_byte(int r, int c) { const int st = (r >> 4) * 2 + (c >> 5), rr = r & 15, cc = c & 31, ob = rr * 64 + cc * 2; return st * 1024 + (ob ^ (((ob >> 9) & 1) << 5)); }
__host__ __device__ __forceinline__ void stage_rc(int b, int& R, int& C) { const int st = b / 1024, sb = b % 1024, swz = sb ^ (((sb >> 9) & 1) << 5); R = (st >> 1) * 16 + swz / 64; C = (st & 1) * 32 + (swz % 64) / 2; }
__host__ __device__ __forceinline__ int perm32(int rho) { const int n = rho >> 4, i = rho & 15; return 8 * (i >> 2) + 4 * n + (i & 3); }

struct Unit { int pm, pn; };
struct Gemm { const bf16_t* A; const bf16_t* Bt; int M, N, K; };

struct StaticOrder {
    int nM, nN, nwg, G, c;
    __host__ __device__ void init(int M, int N, int G_, int c_) { nM = M / BM; nN = N / BM; nwg = nM * nN; G = G_; c = c_; }
    __host__ __device__ bool next(int i, Unit& u) const {
        const long L = (long)i * G + c; if (L >= nwg) return false;
        int wgid = (int)L; { const int q = nwg / NXCD, r = nwg % NXCD, xcd = wgid % NXCD, off = wgid / NXCD; wgid = (xcd < r ? xcd * (q + 1) : r * (q + 1) + (xcd - r) * q) + off; }
        const int nig = WGM * nN, gid = wgid / nig, fm = gid * WGM, gsz = (nM - fm) < WGM ? (nM - fm) : WGM;
        u.pm = fm + ((wgid % nig) % gsz); u.pn = (wgid % nig) / gsz; return true;
    }
    __device__ __forceinline__ void a_ready(const Unit&) const {}
    __device__ __forceinline__ void done(const Unit&) const {}
};

__device__ __forceinline__ unsigned cvt_pk_bf16(float lo, float hi) { unsigned r; asm volatile("v_cvt_pk_bf16_f32 %0, %1, %2" : "=v"(r) : "v"(lo), "v"(hi)); return r; }
typedef float f32x2 __attribute__((ext_vector_type(2)));
__device__ __forceinline__ f32x2 gelu_pk(f32x2 v) {
    const f32x2 av = __builtin_elementwise_abs(v), d = av * 0.2316418882f + 1.0f;
    f32x2 t; t.x = __builtin_amdgcn_rcpf(d.x); t.y = __builtin_amdgcn_rcpf(d.y);
    f32x2 q = t * 0.5307027145f + (-0.7265760135f); q = q * t + 0.7107068705f; q = q * t + (-0.142248368f); q = q * t + 0.127414796f; q = q * t;
    const f32x2 s = (v * v) * (-0.72134752044f);
    f32x2 e; e.x = __builtin_amdgcn_exp2f(s.x); e.y = __builtin_amdgcn_exp2f(s.y);
    const f32x2 m = v * (q * e), r = v - m;
    f32x2 o; o.x = v.x < 0.f ? m.x : r.x; o.y = v.y < 0.f ? m.y : r.y; return o;
}

template <int ACT  > struct EpiBf16 {
    static constexpr bool PERM = true, AFTER_DRAIN = false; static_assert(ACT == 0 || ACT == 1, "EpiBf16: ACT is 0 (none) or 1 (gelu_pk)");
    bf16_t* O; int ldc; const float* bias; int split_cols; size_t split_stride; float scale0;
    __device__ __forceinline__ void operator()(const f32x4 (&acc)[2][2][4][2], const Unit& u, int wr, int wc, int fr, int fq) const {
        const int row0 = u.pm * BM + wr * 64 + fr; int colt = u.pn * BM; bf16_t* base = O;
        float sc = 1.f; if (split_cols) { const int t = colt / split_cols; base += (size_t)t * split_stride; colt -= t * split_cols; if (t == 0) sc = scale0; }
        const int col0 = colt + wc * 32 + 8 * fq, bcol0 = u.pn * BM + wc * 32 + 8 * fq;
        f32x4 bv[2][2];
#pragma unroll
        for (int bj = 0; bj < 2; ++bj)
#pragma unroll
            for (int n = 0; n < 2; ++n) bv[bj][n] = bias ? *(const f32x4*)(bias + bcol0 + bj * HALF + 4 * n) : (f32x4){0.f, 0.f, 0.f, 0.f};
#pragma unroll
        for (int ai = 0; ai < 2; ++ai)
#pragma unroll
            for (int m = 0; m < 4; ++m) { bf16_t* rowp = base + (size_t)(row0 + ai * HALF + m * 16) * ldc + col0;
#pragma unroll
                for (int bj = 0; bj < 2; ++bj) { f32x4 v0 = acc[ai][bj][m][0] + bv[bj][0], v1 = acc[ai][bj][m][1] + bv[bj][1];
                    if (ACT == 1) { f32x2 a = gelu_pk((f32x2){v0[0], v0[1]}), b = gelu_pk((f32x2){v0[2], v0[3]}), c = gelu_pk((f32x2){v1[0], v1[1]}), d = gelu_pk((f32x2){v1[2], v1[3]});
                        v0 = (f32x4){a.x, a.y, b.x, b.y}; v1 = (f32x4){c.x, c.y, d.x, d.y}; }
                    v0 = v0 * sc; v1 = v1 * sc; u32x4 w; w.x = cvt_pk_bf16(v0[0], v0[1]); w.y = cvt_pk_bf16(v0[2], v0[3]); w.z = cvt_pk_bf16(v1[0], v1[1]); w.w = cvt_pk_bf16(v1[2], v1[3]);
                    *(u32x4*)(rowp + bj * HALF) = w; } }
    }
};
template <class Epi, class Sched, bool ALIGN_EPI = false, bool SP2 = false>
__device__ __forceinline__ void gemm_phase(PG8_LAS unsigned char* lds, const Gemm g, const Sched& S, const Epi& E) {
    const int tid = threadIdx.x, wid = __builtin_amdgcn_readfirstlane(tid >> 6), lane = tid & 63, wr = wid >> 2, wc = wid & 3, fr = lane & 15, fq = lane >> 4;
    const int K = g.K, nt = K / BK;
    unsigned voffA[2], voffB[2];
#pragma unroll
    for (int i = 0; i < 2; ++i) { int R, C; stage_rc(tid * 16 + i * 8192, R, C); const int Rb = Epi::PERM ? ((R & ~31) + perm32(R & 31)) : R;
        voffA[i] = (unsigned)(R * K + C) * 2u; voffB[i] = (unsigned)(Rb * K + C) * 2u; }
    const size_t kstep = (size_t)(BK * 2);
    const size_t hstep = (size_t)HALF * K * 2;
    const size_t tstep = 2 * hstep;
    const unsigned ldsw = (unsigned)wid * 1024u;
    const int aoff = lds_byte(wr * 64 + fr, fq * 8), boff = lds_byte(wc * 32 + fr, fq * 8);
#define PG8_SA(b, h) (((b) * 2 + (h)) * HTB)
#define PG8_SB(b, h) ((4 + (b) * 2 + (h)) * HTB)
#define PG8_STAGE(bufoff, gbase, voff) do { _Pragma("unroll") for (int _i = 0; _i < 2; ++_i) \
        __builtin_amdgcn_global_load_lds((const unsigned*)((const char*)(gbase) + (voff)[_i]), (PG8_LAS unsigned*)(lds + (bufoff) + ldsw + _i * 8192), 16, 0, 0); } while (0)
#define PG8_LDA(dst, b, h) do { _Pragma("unroll") for (int m = 0; m < 4; ++m) _Pragma("unroll") for (int k = 0; k < 2; ++k) dst[m][k] = *(const PG8_LAS bf16x8*)(lds + PG8_SA(b, h) + aoff + m * 2048 + k * 1024); } while (0)
#define PG8_LDB(dst, b, h) do { _Pragma("unroll") for (int n = 0; n < 2; ++n) _Pragma("unroll") for (int k = 0; k < 2; ++k) dst[n][k] = *(const PG8_LAS bf16x8*)(lds + PG8_SB(b, h) + boff + n * 2048 + k * 1024); } while (0)
#define PG8_MMA(ai, bj, At, Bt) do { __builtin_amdgcn_s_setprio(1); _Pragma("unroll") for (int m = 0; m < 4; ++m) _Pragma("unroll") for (int n = 0; n < 2; ++n) _Pragma("unroll") for (int k = 0; k < 2; ++k) \
        acc[ai][bj][m][n] = __builtin_amdgcn_mfma_f32_16x16x32_bf16(Bt[n][k], At[m][k], acc[ai][bj][m][n], 0, 0, 0); __builtin_amdgcn_s_setprio(0); } while (0)
#define PG8_WAIT_V(n) asm volatile("s_waitcnt vmcnt(" #n ")" ::: "memory")
#define PG8_WAIT_L(n) asm volatile("s_waitcnt lgkmcnt(" #n ")" ::: "memory")
#define PG8_BAR __builtin_amdgcn_s_barrier()
#define PG8_SCHED __builtin_amdgcn_sched_barrier(0)
    Unit cur, nxt; int ui = 0;
    if (!S.next(0, cur)) return;
    f32x4 acc[2][2][4][2];
#pragma unroll
    for (int a = 0; a < 2; ++a)
#pragma unroll
        for (int b = 0; b < 2; ++b)
#pragma unroll
            for (int m = 0; m < 4; ++m)
#pragma unroll
                for (int n = 0; n < 2; ++n) acc[a][b][m][n] = (f32x4){0.f, 0.f, 0.f, 0.f};
    bf16x8 At[4][2], B0[2][2], B1[2][2];
    const char* cA = (const char*)g.A + (size_t)cur.pm * tstep; const char* cB = (const char*)g.Bt + (size_t)cur.pn * tstep;
    S.a_ready(cur);
    if constexpr (SP2) {
        PG8_STAGE(PG8_SB(0, 0), cB, voffB); PG8_STAGE(PG8_SB(0, 1), cB + hstep, voffB); PG8_STAGE(PG8_SA(0, 0), cA, voffA); PG8_STAGE(PG8_SA(0, 1), cA + hstep, voffA);
        if (wr == 1) PG8_BAR;
        PG8_WAIT_V(2); PG8_BAR;
        PG8_STAGE(PG8_SB(1, 0), cB + kstep, voffB); PG8_STAGE(PG8_SA(1, 0), cA + kstep, voffA); PG8_STAGE(PG8_SB(1, 1), cB + hstep + kstep, voffB);
        PG8_WAIT_V(6); PG8_BAR;
    } else {
        PG8_STAGE(PG8_SB(0, 0), cB, voffB); PG8_STAGE(PG8_SA(0, 0), cA, voffA); PG8_STAGE(PG8_SB(0, 1), cB + hstep, voffB); PG8_STAGE(PG8_SA(0, 1), cA + hstep, voffA);
        if (wr == 1) PG8_BAR;
        PG8_WAIT_V(4); PG8_BAR;
        PG8_STAGE(PG8_SB(1, 0), cB + kstep, voffB); PG8_STAGE(PG8_SA(1, 0), cA + kstep, voffA); PG8_STAGE(PG8_SB(1, 1), cB + hstep + kstep, voffB);
        PG8_WAIT_V(6); PG8_BAR;
    }
    for (;;) {
        const bool has_next = S.next(ui + 1, nxt);
        const char* nA = has_next ? (const char*)g.A + (size_t)nxt.pm * tstep : cA; const char* nB = has_next ? (const char*)g.Bt + (size_t)nxt.pn * tstep : cB;
        for (int t = 0; t < nt; t += 2) {
            const bool last = (t == nt - 2);
            const char* a1 = cA + (size_t)(t + 1) * kstep;
            const char* a2 = last ? nA : cA + (size_t)(t + 2) * kstep; const char* b2 = last ? nB : cB + (size_t)(t + 2) * kstep;
            const char* a3 = a2 + kstep; const char* b3 = b2 + kstep;
            if (last && has_next) S.a_ready(nxt);
            if constexpr (SP2) {
            PG8_LDB(B0, 0, 0); PG8_LDB(B1, 0, 1); PG8_SCHED; PG8_LDA(At, 0, 0); PG8_STAGE(PG8_SA(1, 1), a1 + hstep, voffA);
            PG8_WAIT_V(8); PG8_WAIT_L(0); PG8_BAR; PG8_MMA(0, 0, At, B0); PG8_MMA(0, 1, At, B1); PG8_BAR; PG8_SCHED;
            PG8_LDA(At, 0, 1); PG8_STAGE(PG8_SB(0, 0), b2, voffB); PG8_STAGE(PG8_SB(0, 1), b2 + hstep, voffB); PG8_STAGE(PG8_SA(0, 0), a2, voffA);
            PG8_WAIT_V(8); PG8_WAIT_L(0); PG8_BAR; PG8_MMA(1, 0, At, B0); PG8_MMA(1, 1, At, B1); PG8_BAR; PG8_SCHED;
            PG8_LDB(B0, 1, 0); PG8_LDB(B1, 1, 1); PG8_SCHED; PG8_LDA(At, 1, 0); PG8_STAGE(PG8_SA(0, 1), a2 + hstep, voffA);
            PG8_WAIT_V(8); PG8_WAIT_L(0); PG8_BAR; PG8_MMA(0, 0, At, B0); PG8_MMA(0, 1, At, B1); PG8_BAR; PG8_SCHED;
            PG8_LDA(At, 1, 1); PG8_STAGE(PG8_SB(1, 0), b3, voffB); PG8_STAGE(PG8_SB(1, 1), b3 + hstep, voffB); PG8_STAGE(PG8_SA(1, 0), a3, voffA);
            PG8_WAIT_V(8); PG8_WAIT_L(0); PG8_BAR; PG8_MMA(1, 0, At, B0); PG8_MMA(1, 1, At, B1); PG8_BAR; PG8_SCHED;
            } else {
            PG8_LDB(B0, 0, 0); PG8_SCHED; PG8_LDA(At, 0, 0); PG8_STAGE(PG8_SA(1, 1), a1 + hstep, voffA);
            PG8_WAIT_L(8); PG8_BAR; PG8_WAIT_L(0); PG8_MMA(0, 0, At, B0); PG8_BAR; PG8_SCHED;
            PG8_LDB(B1, 0, 1); PG8_STAGE(PG8_SB(0, 0), b2, voffB);
            PG8_BAR; PG8_WAIT_L(0); PG8_MMA(0, 1, At, B1); PG8_BAR;
            PG8_LDA(At, 0, 1); PG8_STAGE(PG8_SA(0, 0), a2, voffA);
            PG8_BAR; PG8_WAIT_L(0); PG8_MMA(1, 0, At, B0); PG8_BAR; PG8_SCHED;
            PG8_STAGE(PG8_SB(0, 1), b2 + hstep, voffB);
            PG8_WAIT_V(6); PG8_BAR; PG8_MMA(1, 1, At, B1); PG8_BAR;
            PG8_LDB(B0, 1, 0); PG8_SCHED; PG8_LDA(At, 1, 0); PG8_STAGE(PG8_SA(0, 1), a2 + hstep, voffA);
            PG8_WAIT_L(8); PG8_BAR; PG8_WAIT_L(0); PG8_MMA(0, 0, At, B0); PG8_BAR; PG8_SCHED;
            PG8_LDB(B1, 1, 1); PG8_STAGE(PG8_SB(1, 0), b3, voffB);
            PG8_BAR; PG8_WAIT_L(0); PG8_MMA(0, 1, At, B1); PG8_BAR;
            PG8_LDA(At, 1, 1); PG8_STAGE(PG8_SA(1, 0), a3, voffA);
            PG8_BAR; PG8_WAIT_L(0); PG8_MMA(1, 0, At, B0); PG8_BAR; PG8_SCHED;
            PG8_STAGE(PG8_SB(1, 1), b3 + hstep, voffB);
            PG8_WAIT_V(6); PG8_BAR; PG8_MMA(1, 1, At, B1); PG8_BAR;
            }
        }
        if constexpr (ALIGN_EPI) { if (wr == 0) PG8_BAR; }
        if constexpr (!Epi::AFTER_DRAIN) { E(acc, cur, wr, wc, fr, fq); S.done(cur); }
        if (!has_next) break;
#pragma unroll
        for (int a = 0; a < 2; ++a)
#pragma unroll
            for (int b = 0; b < 2; ++b)
#pragma unroll
                for (int m = 0; m < 4; ++m)
#pragma unroll
                    for (int n = 0; n < 2; ++n) acc[a][b][m][n] = (f32x4){0.f, 0.f, 0.f, 0.f};
        cur = nxt; cA = nA; cB = nB; ++ui;
        if constexpr (ALIGN_EPI) { if (wr == 1) PG8_BAR; }
    }
    PG8_WAIT_V(0);
    if constexpr (!ALIGN_EPI) { if (wr == 0) PG8_BAR; }
    PG8_BAR;
    if constexpr (Epi::AFTER_DRAIN) { E.fused(acc, cur, wr, wc, fr, fq, lds, wid, lane); S.done(cur); }
#undef PG8_SA
#undef PG8_SB
#undef PG8_STAGE
#undef PG8_LDA
#undef PG8_LDB
#undef PG8_MMA
#undef PG8_WAIT_V
#undef PG8_WAIT_L
#undef PG8_BAR
#undef PG8_SCHED
}
}

#ifndef PG8_SP2
#define PG8_SP2 true
#endif
#ifndef PG8_ALIGN
#define PG8_ALIGN true
#endif

namespace pg8 {
struct EpiResGate {
    static constexpr bool PERM = false, AFTER_DRAIN = false;
    const float* base; float* out; const float* gate; int gate_ld; int rows_per_batch; int ldc;
    __device__ __forceinline__ void operator()(const f32x4 (&acc)[2][2][4][2], const Unit& u, int wr, int wc, int fr, int fq) const {
        const int row0 = u.pm * BM + wr * 64 + fr, col0 = u.pn * BM + wc * 32 + 4 * fq;
        const float* gp = gate + (size_t)((u.pm * BM) / rows_per_batch) * gate_ld + col0;
        f32x4 gv[2][2];
#pragma unroll
        for (int bj = 0; bj < 2; ++bj)
#pragma unroll
            for (int n = 0; n < 2; ++n) gv[bj][n] = *(const f32x4*)(gp + bj * HALF + n * 16);
#pragma unroll
        for (int ai = 0; ai < 2; ++ai)
#pragma unroll
            for (int m = 0; m < 4; ++m) { const size_t off = (size_t)(row0 + ai * HALF + m * 16) * ldc + col0;
#pragma unroll
                for (int bj = 0; bj < 2; ++bj)
#pragma unroll
                    for (int n = 0; n < 2; ++n) { const f32x4 bs = *(const f32x4*)(base + off + bj * HALF + n * 16);
                        *(f32x4*)(out + off + bj * HALF + n * 16) = bs + gv[bj][n] * acc[ai][bj][m][n]; } }
    }
};
struct EpiResGateBf16 {
    static constexpr bool PERM = false, AFTER_DRAIN = false;
    const float* base; bf16_t* out; const float* gate; int gate_ld; int rows_per_batch; int ldc;
    __device__ __forceinline__ void operator()(const f32x4 (&acc)[2][2][4][2], const Unit& u, int wr, int wc, int fr, int fq) const {
        const int row0 = u.pm * BM + wr * 64 + fr, col0 = u.pn * BM + wc * 32 + 4 * fq;
        const float* gp = gate + (size_t)((u.pm * BM) / rows_per_batch) * gate_ld + col0;
        f32x4 gv[2][2];
#pragma unroll
        for (int bj = 0; bj < 2; ++bj)
#pragma unroll
            for (int n = 0; n < 2; ++n) gv[bj][n] = *(const f32x4*)(gp + bj * HALF + n * 16);
#pragma unroll
        for (int ai = 0; ai < 2; ++ai)
#pragma unroll
            for (int m = 0; m < 4; ++m) { const size_t off = (size_t)(row0 + ai * HALF + m * 16) * ldc + col0;
#pragma unroll
                for (int bj = 0; bj < 2; ++bj)
#pragma unroll
                    for (int n = 0; n < 2; ++n) { const f32x4 bs = __builtin_nontemporal_load((const f32x4*)(base + off + bj * HALF + n * 16)); const f32x4 r = bs + gv[bj][n] * acc[ai][bj][m][n];
                        *(unsigned long long*)(out + off + bj * HALF + n * 16) = (unsigned long long)cvt_pk_bf16(r.x, r.y) | ((unsigned long long)cvt_pk_bf16(r.z, r.w) << 32); } }
    }
};
struct EpiF32 {
    static constexpr bool PERM = false, AFTER_DRAIN = false;
    float* O; int ldc;
    __device__ __forceinline__ void operator()(const f32x4 (&acc)[2][2][4][2], const Unit& u, int wr, int wc, int fr, int fq) const {
        const int row0 = u.pm * BM + wr * 64 + fr, col0 = u.pn * BM + wc * 32 + 4 * fq;
#pragma unroll
        for (int ai = 0; ai < 2; ++ai)
#pragma unroll
            for (int m = 0; m < 4; ++m) { const size_t off = (size_t)(row0 + ai * HALF + m * 16) * ldc + col0;
#pragma unroll
                for (int bj = 0; bj < 2; ++bj)
#pragma unroll
                    for (int n = 0; n < 2; ++n) *(f32x4*)(O + off + bj * HALF + n * 16) = acc[ai][bj][m][n]; }
    }
};
}
#define GAS __attribute__((address_space(1)))
#define LAS __attribute__((address_space(3)))
typedef unsigned short bf16;
typedef unsigned v4u __attribute__((ext_vector_type(4)));
typedef float f32x4 __attribute__((ext_vector_type(4)));
typedef short bf16x8 __attribute__((ext_vector_type(8)));
typedef GAS unsigned gu32;
typedef GAS unsigned long long gu64;
#define RLX_AGENT __ATOMIC_RELAXED, __HIP_MEMORY_SCOPE_AGENT
#define LDS_WAIT() asm volatile("s_waitcnt lgkmcnt(0)" ::: "memory")
#define VM_WAIT() asm volatile("s_waitcnt vmcnt(0)" ::: "memory")
__device__ __forceinline__ unsigned long long rt() { return __builtin_amdgcn_s_memrealtime(); }
__device__ __forceinline__ unsigned f2bf(float f) { unsigned u = __builtin_bit_cast(unsigned, f); return (u + 0x7fffu + ((u >> 16) & 1u)) >> 16; }
__device__ __forceinline__ unsigned pk2(float lo, float hi) { return f2bf(lo) | (f2bf(hi) << 16); }

#define XB_TMO      128
#define XB_XCNT(j)  (256  + 64 * (j))
#define XB_XSUB(j)  (1280 + 64 * (j))
#define XB_XGEN(j)  (2304 + 64 * (j))
#define XB_TOP      3328
#define XB_TOPGEN   3392
#define XCD_BAR_WORDS 3456
#define XB_SPIN_CAP (1u << 24)

__device__ __forceinline__ unsigned xb_ld(unsigned* p)              { return __hip_atomic_load(p, __ATOMIC_RELAXED, __HIP_MEMORY_SCOPE_AGENT); }
__device__ __forceinline__ unsigned xb_add(unsigned* p, unsigned v) { return __hip_atomic_fetch_add(p, v, __ATOMIC_RELAXED, __HIP_MEMORY_SCOPE_AGENT); }
__device__ __forceinline__ unsigned xb_xcc_id() { return (unsigned)__builtin_amdgcn_s_getreg((3 << 11) | 20) & 0xFu; }
#define XB_SPIN(cond, bar) do { unsigned _sp = 0; while (cond) { __builtin_amdgcn_s_sleep(1); \
    if ((++_sp & 255u) == 0u) { if (xb_ld(&(bar)[XB_TMO])) break; if (_sp > XB_SPIN_CAP) { atomicAdd(&(bar)[XB_TMO], 1u); break; } } } } while (0)

struct XcdBarrier {
    unsigned* bar; unsigned x;
    volatile LAS unsigned* st;
};

__device__ __forceinline__ XcdBarrier xcd_barrier_post(unsigned* bar, volatile LAS unsigned* st) {
    XcdBarrier b; b.bar = bar; b.x = xb_xcc_id(); b.st = st;
    if (threadIdx.x == 0) (void)xb_add(&bar[XB_XCNT(b.x)], 1u);
    return b;
}
__device__ __forceinline__ void xcd_barrier_complete(unsigned* bar, unsigned x, unsigned& nloc, unsigned& nx) {
    const unsigned G = gridDim.x * gridDim.y * gridDim.z;
    unsigned sum, cnt, mine, sp = 0u;
    for (;;) {
        sum = 0u; cnt = 0u; mine = 0u;
#pragma unroll
        for (unsigned j = 0; j < 16; ++j) { const unsigned c = xb_ld(&bar[XB_XCNT(j)]); sum += c; cnt += (c > 0u) ? 1u : 0u; mine = (j == x) ? c : mine; }
        if (sum == G) break;
        __builtin_amdgcn_s_sleep(1);
        if ((++sp & 255u) == 0u) { if (xb_ld(&bar[XB_TMO])) break; if (sp > XB_SPIN_CAP) { atomicAdd(&bar[XB_TMO], 1u); break; } }
    }
    nloc = mine > 0u ? mine : 1u; nx = cnt > 0u ? cnt : 1u;
}

__device__ __forceinline__ void xcd_barrier(const XcdBarrier& b) {
    asm volatile("s_waitcnt vmcnt(0)" ::: "memory");
    __syncthreads();
    if (threadIdx.x == 0) {
        unsigned* bar = b.bar;
        __builtin_amdgcn_s_waitcnt(0);
        unsigned nloc = b.st[0], nx = b.st[1];
        if (nloc == 0u) { xcd_barrier_complete(bar, b.x, nloc, nx); b.st[0] = nloc; b.st[1] = nx; }
        const unsigned old = xb_add(&bar[XB_XSUB(b.x)], 1u);
        const unsigned gen = old / nloc;
        if (old + 1u == (gen + 1u) * nloc) {
            __builtin_amdgcn_fence(__ATOMIC_RELEASE, "agent");
            asm volatile("s_waitcnt vmcnt(0)" ::: "memory");
            const unsigned og = xb_add(&bar[XB_TOP], 1u);
            const unsigned tg = og / nx;
            if (og + 1u == (tg + 1u) * nx) xb_add(&bar[XB_TOPGEN], 1u);
            else XB_SPIN(xb_ld(&bar[XB_TOPGEN]) == tg, bar);
            __builtin_amdgcn_fence(__ATOMIC_ACQUIRE, "agent");
            xb_add(&bar[XB_XGEN(b.x)], 1u);
            asm volatile("s_waitcnt vmcnt(0)" ::: "memory");
        } else {
            XB_SPIN(xb_ld(&bar[XB_XGEN(b.x)]) == gen, bar);
            __builtin_amdgcn_fence(__ATOMIC_ACQUIRE, "agent");
            asm volatile("s_waitcnt vmcnt(0)" ::: "memory");
        }
    }
    __syncthreads();
}

constexpr int NWAVES = 8, NTHR = 512;
constexpr int NB = 8, SEQ = 4096, T = NB * SEQ, D = 1024, NPROJ = 3584, NIN = 3592, NMOD = 6144, NSC = 2048;
constexpr int C_QSB = 0, C_KSB = 512, C_VSB = 1024, C_QML = 1536, C_KML = 2048, C_VML = 2560, C_OML = 3072;
constexpr float EPS = 1e-6f, LOG2E = 1.4426950408889634f;
constexpr size_t MiB = 1u << 20;
constexpr size_t WS_CTL = 0, CTL_ZERO_BYTES = 1 * MiB;
constexpr size_t WS_MOD = 256 * 1024;
constexpr size_t WS_WIN = 2 * MiB, WS_WOUT = 10 * MiB, WS_WEFF = 12 * MiB;
constexpr size_t WS_XN = 16 * MiB;
constexpr size_t WS_PROJ = 80 * MiB;
constexpr size_t WS_MIX = 304 * MiB;
constexpr size_t WS_EXPU = 368 * MiB, WS_EXPV = 400 * MiB;
constexpr size_t WS_CST = 432 * MiB;
constexpr size_t WS_NST = 496 * MiB;
constexpr size_t WS_MST = 497 * MiB;
constexpr size_t WS_GATES = 498 * MiB;
constexpr size_t WS_XQ = 272 * MiB;
constexpr size_t WS_XS = 499 * MiB + 256 * 1024;
constexpr size_t WS_X1B = 208 * MiB;
constexpr size_t WS_SCORES = 80 * MiB;
constexpr size_t WS_IDX = 336 * MiB, WS_GATE = 352 * MiB;
constexpr size_t WS_SCL = 499 * MiB;
constexpr size_t WS_SUI = 499 * MiB + 65536, WS_SVI = 499 * MiB + 131072;
constexpr size_t WS_END = 500 * MiB;
constexpr int CW_Q3 = 64;
constexpr int CW_BAR = 4096;
constexpr int LDS_BYTES = 147456, LDSCTL_OFF = 143360;

typedef float f32x16 __attribute__((ext_vector_type(16)));
typedef float f32x2_t __attribute__((ext_vector_type(2)));
typedef __bf16 bf16x2_t __attribute__((ext_vector_type(2)));
typedef _Float16 f16x8 __attribute__((ext_vector_type(8)));
typedef short s16x4 __attribute__((ext_vector_type(4)));
typedef unsigned u32x2 __attribute__((ext_vector_type(2)));
#define DI __device__ __forceinline__
DI unsigned cvtpk(float lo, float hi) { f32x2_t v = {lo, hi}; bf16x2_t b = __builtin_convertvector(v, bf16x2_t); return __builtin_bit_cast(unsigned, b); }
DI float bflo(unsigned u) { return __uint_as_float(u << 16); }
DI float bfhi(unsigned u) { return __uint_as_float(u & 0xffff0000u); }
DI int crow(int i, int hi) { return (i & 3) + 8 * (i >> 2) + 4 * hi; }
DI int krow(int s, int hi, int j) { return 16 * s + 8 * (j >> 2) + 4 * hi + (j & 3); }
DI float swap_add(float v) { auto rr = __builtin_amdgcn_permlane32_swap(__float_as_uint(v), __float_as_uint(v), false, false); return __uint_as_float(rr[0]) + __uint_as_float(rr[1]); }
DI float swap_max(float v) { auto rr = __builtin_amdgcn_permlane32_swap(__float_as_uint(v), __float_as_uint(v), false, false); return fmaxf(__uint_as_float(rr[0]), __uint_as_float(rr[1])); }
DI float dot2bf(unsigned a, unsigned b, float acc) { return __builtin_amdgcn_fdot2_f32_bf16(__builtin_bit_cast(bf16x2_t, a), __builtin_bit_cast(bf16x2_t, b), acc, false); }
DI float ex2(float x) { return __builtin_amdgcn_exp2f(x); }
DI float lg2(float x) { return __builtin_amdgcn_logf(x); }
DI float fexp(float x) { return __builtin_amdgcn_exp2f(x * LOG2E); }
DI float wave_sum(float v) {
#pragma unroll
    for (int o = 1; o < 64; o <<= 1) v += __shfl_xor(v, o);
    return v;
}
DI float wave_max(float v) {
#pragma unroll
    for (int o = 1; o < 64; o <<= 1) v = fmaxf(v, __shfl_xor(v, o));
    return v;
}
#define DPP_MAXF(v, ctrl, rmask) fmaxf((v), __builtin_bit_cast(float, __builtin_amdgcn_update_dpp(0, __builtin_bit_cast(int, (v)), (ctrl), (rmask), 0xF, false)))
DI float wave_max_nonneg(float v) {
    v = DPP_MAXF(v, 0xB1, 0xF); v = DPP_MAXF(v, 0x4E, 0xF); v = DPP_MAXF(v, 0x141, 0xF); v = DPP_MAXF(v, 0x140, 0xF); v = DPP_MAXF(v, 0x142, 0xA); v = DPP_MAXF(v, 0x143, 0xC);
    return __builtin_bit_cast(float, __builtin_amdgcn_readlane(__builtin_bit_cast(int, v), 63));
}
#define DPP_ADDF(v, ctrl, rmask) ((v) + __builtin_bit_cast(float, __builtin_amdgcn_update_dpp(0, __builtin_bit_cast(int, (v)), (ctrl), (rmask), 0xF, false)))
DI float wave_sum_u(float v) {
    v = DPP_ADDF(v, 0xB1, 0xF); v = DPP_ADDF(v, 0x4E, 0xF); v = DPP_ADDF(v, 0x141, 0xF); v = DPP_ADDF(v, 0x140, 0xF); v = DPP_ADDF(v, 0x142, 0xA); v = DPP_ADDF(v, 0x143, 0xC);
    return __builtin_bit_cast(float, __builtin_amdgcn_readlane(__builtin_bit_cast(int, v), 63));
}
typedef short v4i16_t __attribute__((ext_vector_type(4)));
DI s16x4 trrd(LAS unsigned char* p) { return __builtin_bit_cast(s16x4, __builtin_amdgcn_ds_read_tr16_b64_v4i16((LAS v4i16_t*)p)); }
DI bf16x8 cat8(s16x4 a, s16x4 b) { return (bf16x8){a[0], a[1], a[2], a[3], b[0], b[1], b[2], b[3]}; }
#define MFMA_BF16(a, b, c) __builtin_amdgcn_mfma_f32_32x32x16_bf16((a), (b), (c), 0, 0, 0)
#define MFMA_F16(a, b, c) __builtin_amdgcn_mfma_f32_32x32x16_f16((a), (b), (c), 0, 0, 0)
DI unsigned pkh(float a, float b) { return __builtin_bit_cast(unsigned, __builtin_amdgcn_cvt_pkrtz(a, b)); }
DI bf16x8 packbf(const f32x16& x, int s) { v4u p; p.x = cvtpk(x[8 * s], x[8 * s + 1]); p.y = cvtpk(x[8 * s + 2], x[8 * s + 3]); p.z = cvtpk(x[8 * s + 4], x[8 * s + 5]); p.w = cvtpk(x[8 * s + 6], x[8 * s + 7]); return __builtin_bit_cast(bf16x8, p); }
DI f16x8 packh(const f32x16& x, int s) { v4u p; p.x = pkh(x[8 * s], x[8 * s + 1]); p.y = pkh(x[8 * s + 2], x[8 * s + 3]); p.z = pkh(x[8 * s + 4], x[8 * s + 5]); p.w = pkh(x[8 * s + 6], x[8 * s + 7]); return __builtin_bit_cast(f16x8, p); }

struct Frame {
    LAS unsigned char* lds;
    volatile LAS unsigned* MISC;
    gu32* ctl;
    unsigned char* ws;
    int tid, lane, wave, vcu, G;
};
DI const float* inp(int i) { const __attribute__((address_space(4))) unsigned long long* kp = (const __attribute__((address_space(4))) unsigned long long*)__builtin_amdgcn_kernarg_segment_ptr(); return (const float*)(const GAS float*)(*(volatile const __attribute__((address_space(4))) unsigned long long*)(kp + i)); }
enum { I_X = 0, I_C, I_WADA, I_BADA, I_GN1, I_WIN, I_BIG, I_BFG, I_CONVW, I_GQ, I_GK, I_GOSB, I_GOML, I_WOUT, I_GN2, I_WQ, I_SK, I_EU, I_EV, I_OUT };
#define WSP(type, off) ((type*)(F.ws + (off)))

DI void p0_transpose_item(const float* W, int K, int N, int ld, bf16* WT, LAS float* scr, int item, int lane) {
    const int nblk = N / 32, kb = item / nblk, nb = item % nblk, k0 = 64 * kb, n0 = 32 * nb;
    float tv[32];
#pragma unroll
    for (int i = 0; i < 32; ++i) tv[i] = W[(size_t)(k0 + 2 * i + (lane >> 5)) * ld + n0 + (lane & 31)];
#pragma unroll
    for (int i = 0; i < 32; ++i) scr[(2 * i + (lane >> 5)) * 33 + (lane & 31)] = tv[i];
    LDS_WAIT(); asm volatile("" ::: "memory");
    const int c = lane & 7;
#pragma unroll
    for (int j = 0; j < 4; ++j) { const int n = (lane >> 3) + 8 * j; const LAS float* s = scr + (8 * c) * 33 + n;
        v4u o; o.x = pk2(s[0 * 33], s[1 * 33]); o.y = pk2(s[2 * 33], s[3 * 33]); o.z = pk2(s[4 * 33], s[5 * 33]); o.w = pk2(s[6 * 33], s[7 * 33]);
        *(GAS v4u*)(WT + (size_t)(n0 + n) * K + k0 + 8 * c) = o; }
    LDS_WAIT(); asm volatile("" ::: "memory");
}
DI void p0_mod_block(const Frame& F, int item) {
    const float* const c_ = inp(I_C); const float* const w_ada_ = inp(I_WADA); const float* const b_ada_ = inp(I_BADA); float* const mod_ = WSP(float, WS_MOD);
    LAS float* scr = (LAS float*)(F.lds + F.wave * 16384);
    const int j = item * 64 + F.lane, d0 = F.wave * 128;
    const int rg = F.lane >> 4, cl = F.lane & 15;
    f32x4 wv[32];
    { const float* wp = w_ada_ + (size_t)(d0 + rg) * NMOD + item * 64 + 4 * cl;
#pragma unroll
      for (int i = 0; i < 32; ++i) wv[i] = __builtin_nontemporal_load((const GAS f32x4*)(wp + (size_t)(4 * i) * NMOD)); }
#pragma unroll
    for (int b = 0; b < 8; ++b)
#pragma unroll
        for (int q = 0; q < 2; ++q) { const float cv = c_[b * D + d0 + 64 * q + F.lane]; scr[b * 128 + 64 * q + F.lane] = cv / (1.f + fexp(-cv)); }
    LDS_WAIT(); asm volatile("" ::: "memory");
    f32x4 acc[8];
#pragma unroll
    for (int b = 0; b < 8; ++b) acc[b] = (f32x4){0.f, 0.f, 0.f, 0.f};
#pragma unroll
    for (int i = 0; i < 32; ++i)
#pragma unroll
        for (int b = 0; b < 8; ++b) acc[b] += wv[i] * scr[b * 128 + 4 * i + rg];
#pragma unroll
    for (int b = 0; b < 8; ++b)
#pragma unroll
        for (int c = 0; c < 4; ++c) { float v = acc[b][c]; v += __shfl_xor(v, 16); v += __shfl_xor(v, 32); acc[b][c] = v; }
    if (rg == 0) {
#pragma unroll
        for (int b = 0; b < 8; ++b) *(LAS f32x4*)(scr + 1024 + b * 64 + 4 * cl) = acc[b]; }
    __syncthreads();
    float tot = b_ada_[j];
#pragma unroll
    for (int w = 0; w < 8; ++w) tot += ((LAS float*)(F.lds + w * 16384))[1024 + F.wave * 64 + F.lane];
    mod_[F.wave * NMOD + j] = tot;
    __syncthreads();
}
DI void p0_weff_item(const Frame& F, int item) {
    const float* const sub_keys_ = inp(I_SK); const float* const w_q_peer_ = inp(I_WQ); bf16* const Weff_t_ = WSP(bf16, WS_WEFF);
    const int hp = item >> 4, dblk = item & 15;
    LAS float* sk = (LAS float*)F.lds;
    LAS float* rb = (LAS float*)(F.lds + 67584) + F.wave * 1024;
    { float tv[32];
#pragma unroll
      for (int i = 0; i < 32; ++i) tv[i] = sub_keys_[(size_t)hp * 16384 + F.tid + 512 * i];
#pragma unroll
      for (int i = 0; i < 32; ++i) { const int idx = F.tid + 512 * i; sk[(idx >> 7) * 129 + (idx & 127)] = tv[i]; } }
    const int d0 = 64 * dblk + 8 * F.wave;
#pragma unroll
    for (int r = 0; r < 8; ++r) { rb[r * 128 + F.lane] = w_q_peer_[(size_t)(d0 + r) * NSC + hp * 128 + F.lane]; rb[r * 128 + 64 + F.lane] = w_q_peer_[(size_t)(d0 + r) * NSC + hp * 128 + 64 + F.lane]; }
    __syncthreads();
    float a0[8], a1[8];
#pragma unroll
    for (int r = 0; r < 8; ++r) { a0[r] = 0.f; a1[r] = 0.f; }
#pragma unroll 4
    for (int c = 0; c < 128; ++c) { const float s0 = sk[F.lane * 129 + c], s1 = sk[(F.lane + 64) * 129 + c];
#pragma unroll
        for (int r = 0; r < 8; ++r) { const float a = rb[r * 128 + c]; a0[r] += a * s0; a1[r] += a * s1; } }
    v4u o0, o1; o0.x = pk2(a0[0], a0[1]); o0.y = pk2(a0[2], a0[3]); o0.z = pk2(a0[4], a0[5]); o0.w = pk2(a0[6], a0[7]);
    o1.x = pk2(a1[0], a1[1]); o1.y = pk2(a1[2], a1[3]); o1.z = pk2(a1[4], a1[5]); o1.w = pk2(a1[6], a1[7]);
    *(GAS v4u*)(Weff_t_ + (size_t)(hp * 128 + F.lane) * D + d0) = o0;
    *(GAS v4u*)(Weff_t_ + (size_t)(hp * 128 + 64 + F.lane) * D + d0) = o1;
    __syncthreads();
}
struct ExpRows2 { f32x4 v[2][4]; };
DI void exp_load2(const Frame& F, int blk0, ExpRows2& R) {
    const float* const expert_u_ = inp(I_EU); const float* const expert_v_ = inp(I_EV);
#pragma unroll
    for (int bb = 0; bb < 2; ++bb) { const int blk = blk0 + bb; const float* src = (blk < 16384 ? expert_u_ : expert_v_) + (size_t)(blk & 16383) * 1024 + 4 * F.lane;
#pragma unroll
        for (int k = 0; k < 4; ++k) R.v[bb][k] = __builtin_nontemporal_load((const GAS f32x4*)(src + 256 * k)); }
}
DI void exp_conv2(const Frame& F, int blk0, const ExpRows2& R) {
    float* const SUI_ = WSP(float, WS_SUI); float* const SVI_ = WSP(float, WS_SVI);
#pragma unroll
    for (int bb = 0; bb < 2; ++bb) { const int blk = blk0 + bb; const bool isu = blk < 16384; const int e = blk & 16383;
        float mx = 0.f;
#pragma unroll
        for (int k = 0; k < 4; ++k) mx = fmaxf(mx, fmaxf(fmaxf(fabsf(R.v[bb][k].x), fabsf(R.v[bb][k].y)), fmaxf(fabsf(R.v[bb][k].z), fabsf(R.v[bb][k].w))));
        mx = wave_max_nonneg(mx);
        {
            float best = 3.0e38f, bs = 0.f;
#define EXP_TRY(FAC) do { const float s_ = mx * ((FAC) / 7.f), inv_ = s_ > 0.f ? 1.f / s_ : 0.f; float er_ = 0.f; \
                _Pragma("unroll") for (int k = 0; k < 4; ++k) _Pragma("unroll") for (int c = 0; c < 4; ++c) { const float v_ = R.v[bb][k][c]; const float d_ = v_ - s_ * fminf(fmaxf(rintf(v_ * inv_), -7.f), 7.f); er_ += d_ * d_; } \
                er_ = wave_sum_u(er_); if (er_ < best) { best = er_; bs = s_; } } while (0)
            EXP_TRY(1.f); EXP_TRY(0.86f); EXP_TRY(0.74f); EXP_TRY(0.63f);
#undef EXP_TRY
            const float inv = bs > 0.f ? 1.f / bs : 0.f;
            unsigned w01[2] = {0u, 0u};
#pragma unroll
            for (int k = 0; k < 4; ++k)
#pragma unroll
                for (int c = 0; c < 4; ++c) { const int q = (int)fminf(fmaxf(rintf(R.v[bb][k][c] * inv), -7.f), 7.f); w01[k >> 1] |= (unsigned)((isu || (c & 1)) ? (q & 15) : (q + 8)) << (4 * (4 * (k & 1) + c)); }
            if (F.lane == 0) (isu ? SUI_ : SVI_)[e] = bs;
            typedef unsigned v2u_ __attribute__((ext_vector_type(2)));
            v2u_ wv; wv.x = w01[0]; wv.y = w01[1];
            *(GAS v2u_*)((isu ? WSP(unsigned char, WS_EXPU) : WSP(unsigned char, WS_EXPV)) + (size_t)e * 512 + 8 * F.lane) = wv;
        } }
}
#ifndef P0_PARTS
#define P0_PARTS 15
#endif
DI void p0_phase(const Frame& F, int parts = 15) {
    const float* const w_in_ = inp(I_WIN); bf16* const Win_t_ = WSP(bf16, WS_WIN); const float* const w_out_ = inp(I_WOUT); bf16* const Wout_t_ = WSP(bf16, WS_WOUT); const float* const expert_v_ = inp(I_EV); const float* const expert_u_ = inp(I_EU);
    LAS float* scr = (LAS float*)(F.lds + F.wave * 16384);
    const int gw = F.vcu * NWAVES + F.wave, NGW = F.G * NWAVES;
    if (parts & 1) for (int it = F.vcu; it < 96; it += F.G) p0_mod_block(F, it);
    constexpr int I_WIN = 16 * 112, I_WOUT = 16 * 32, NITEMS = I_WIN + I_WOUT;
    if (parts & 2) for (int it = gw; it < NITEMS; it += NGW) {
        int r = it;
        if (r < I_WIN) { p0_transpose_item(w_in_, D, NPROJ, NIN, Win_t_, scr, r, F.lane); continue; } r -= I_WIN;
        p0_transpose_item(w_out_, D, D, D, Wout_t_, scr, r, F.lane);
    }
    __syncthreads();
    if (parts & 8) for (int it = F.vcu; it < 256; it += F.G) p0_weff_item(F, it);
}

template <bool DOGATES, bool SRCB = false>
DI void norm_phase(const Frame& F, const float* src, const float* g, int shift_off, int scale_off) {
    const float* const w_in_ = inp(I_WIN); float* const mod_ = WSP(float, WS_MOD); bf16* const XN_ = WSP(bf16, WS_XN); float* const GATES_ = WSP(float, WS_GATES); const float* const b_igate_ = inp(I_BIG); const float* const b_fgate_ = inp(I_BFG);
    LAS float* W8 = (LAS float*)F.lds;
    if (DOGATES) {
        for (int i = 0; i < 16; ++i) { const int idx = F.tid + 512 * i; W8[idx] = w_in_[(size_t)(idx & 1023) * NIN + NPROJ + (idx >> 10)]; }
        __syncthreads();
    }
    const int gw = F.vcu * NWAVES + F.wave, NGW = F.G * NWAVES;
    for (int ch = gw; ch < T / 16; ch += NGW) {
        const int r0 = ch * 16, b = r0 / SEQ;
        f32x4 A[4], Bv[4];
#pragma unroll
        for (int j = 0; j < 4; ++j) { const int col = 4 * F.lane + 256 * j; const f32x4 gg = *(const f32x4*)(g + col), sc = *(const f32x4*)(mod_ + b * NMOD + scale_off + col);
            A[j] = gg * (sc + 1.0f); Bv[j] = *(const f32x4*)(mod_ + b * NMOD + shift_off + col); }
        f32x4 nx[4];
#define NORM_LOADROW(ROW) do { if (SRCB) { const GAS unsigned long long* xb_ = (const GAS unsigned long long*)((const bf16*)src + (size_t)(ROW) * D) + F.lane; \
              _Pragma("unroll") for (int j = 0; j < 4; ++j) { const unsigned long long w_ = __builtin_nontemporal_load(xb_ + 64 * j); const unsigned lo_ = (unsigned)w_, hi_ = (unsigned)(w_ >> 32); \
                  nx[j] = (f32x4){bflo(lo_), bfhi(lo_), bflo(hi_), bfhi(hi_)}; } } \
          else { const GAS f32x4* xr_ = (const GAS f32x4*)(src + (size_t)(ROW) * D) + F.lane; _Pragma("unroll") for (int j = 0; j < 4; ++j) nx[j] = __builtin_nontemporal_load(xr_ + 64 * j); } } while (0)
        NORM_LOADROW(r0);
        for (int rr = 0; rr < 16; ++rr) {
            const int row = r0 + rr;
            f32x4 v[4]; float s = 0.f;
#pragma unroll
            for (int j = 0; j < 4; ++j) { v[j] = nx[j]; s += (v[j].x * v[j].x + v[j].y * v[j].y) + (v[j].z * v[j].z + v[j].w * v[j].w); }
            if (rr + 1 < 16) NORM_LOADROW(row + 1);
            const float rstd = 1.f / sqrtf(wave_sum_u(s) * (1.f / D) + EPS);
#pragma unroll
            for (int j = 0; j < 4; ++j) v[j] = v[j] * rstd * A[j] + Bv[j];
            GAS unsigned long long* o8 = (GAS unsigned long long*)(XN_ + (size_t)row * D) + F.lane;
#pragma unroll
            for (int j = 0; j < 4; ++j) o8[64 * j] = (unsigned long long)pk2(v[j].x, v[j].y) | ((unsigned long long)pk2(v[j].z, v[j].w) << 32);
            if (SRCB) {
                float mx = 0.f;
#pragma unroll
                for (int j = 0; j < 4; ++j) mx = fmaxf(mx, fmaxf(fmaxf(fabsf(v[j].x), fabsf(v[j].y)), fmaxf(fabsf(v[j].z), fabsf(v[j].w))));
                mx = wave_max_nonneg(mx);
                const float sx = mx > 0.f ? 119.f / mx : 0.f;
                unsigned lo_[2] = {0u, 0u}, hi_[2] = {0u, 0u};
#pragma unroll
                for (int j = 0; j < 4; ++j)
#pragma unroll
                    for (int c = 0; c < 4; ++c) { const int t_ = (int)rintf(v[j][c] * sx) + 8; const int sh_ = 4 * (4 * (j & 1) + c);
                        lo_[j >> 1] |= (unsigned)(t_ & 15) << sh_; hi_[j >> 1] |= (unsigned)((t_ >> 4) & 15) << sh_; }
                typedef unsigned v2u_ __attribute__((ext_vector_type(2)));
                unsigned char* xq = WSP(unsigned char, WS_XQ) + (size_t)row * 1024 + 8 * F.lane;
                v2u_ hv, lv; hv.x = hi_[0]; hv.y = hi_[1]; lv.x = lo_[0] ^ 0x88888888u; lv.y = lo_[1] ^ 0x88888888u;
                *(GAS v2u_*)xq = hv; *(GAS v2u_*)(xq + 512) = lv;
                if (F.lane == 0) WSP(float, WS_XS)[row] = mx > 0.f ? mx / 119.f : 0.f;
            }
            if (DOGATES) {
                float res = 0.f;
#pragma unroll
                for (int hh = 0; hh < 8; ++hh) { float p = 0.f;
#pragma unroll
                    for (int j = 0; j < 4; ++j) { const f32x4 w = *(const LAS f32x4*)(W8 + hh * 1024 + 4 * F.lane + 256 * j); p += (v[j].x * w.x + v[j].y * w.y) + (v[j].z * w.z + v[j].w * w.w); }
                    p = wave_sum_u(p); if (F.lane == hh) res = p; }
                if (F.lane < 8) GATES_[(size_t)row * 8 + F.lane] = res + (F.lane < 4 ? b_igate_[F.lane] : b_fgate_[F.lane - 4]);
            }
        }
    }
}

DI void sb_unit(const Frame& F, int b, int h, int qb) {
    bf16* const PROJ_ = WSP(bf16, WS_PROJ); const float* const g_q_sb_ = inp(I_GQ); const float* const g_k_sb_ = inp(I_GK); bf16* const MIX_ = WSP(bf16, WS_MIX); const float* const g_out_sb_ = inp(I_GOSB);
    const int lane = F.lane, w = F.wave, r = lane & 31, hi = lane >> 5;
    const int i16 = lane & 15, qq = i16 >> 2, pp = i16 & 3, blk = (lane >> 4) & 1;
    LAS unsigned char* Wb = F.lds + w * 16384;
    const size_t rowbase = (size_t)b * SEQ; const int q0 = qb * 256, qw0 = q0 + 32 * w, tq = qw0 + r;
    const bf16* P = PROJ_;
    const bf16* kpiece[4]; const bf16* vpiece[4];
#pragma unroll
    for (int i = 0; i < 4; ++i) { const int krow_ = 8 * i + (lane >> 3), kch = (lane & 7) ^ ((krow_ >> 1) & 7); kpiece[i] = P + (rowbase + krow_) * NPROJ + C_KSB + h * 64 + 8 * kch;
        const int vkey = 16 * (i & 1) + (lane >> 2); vpiece[i] = P + (rowbase + vkey) * NPROJ + C_VSB + h * 64 + 32 * (i >> 1) + 8 * (lane & 3); }
#define SB_DMA(T_, BUF_) do { _Pragma("unroll") for (int i_ = 0; i_ < 4; ++i_) { \
        __builtin_amdgcn_global_load_lds((const unsigned*)(kpiece[i_] + (size_t)(32 * (T_)) * NPROJ), (LAS unsigned*)(Wb + 8192 * (BUF_) + 1024 * i_), 16, 0, 0); \
        __builtin_amdgcn_global_load_lds((const unsigned*)(vpiece[i_] + (size_t)(32 * (T_)) * NPROJ), (LAS unsigned*)(Wb + 8192 * (BUF_) + 4096 + 1024 * i_), 16, 0, 0); } } while (0)
    const int tw = (qw0 + 30) >> 5;
    SB_DMA(tw, 0);
    bf16x8 qf[4];
    {
        const bf16* Qp = P + (rowbase + tq) * NPROJ + C_QSB + h * 64 + 8 * hi;
        v4u qraw[4]; float ss = 0.f;
#pragma unroll
        for (int kk = 0; kk < 4; ++kk) { qraw[kk] = *(const GAS v4u*)(Qp + 16 * kk);
#pragma unroll
            for (int e = 0; e < 4; ++e) { const float a = bflo(qraw[kk][e]), c = bfhi(qraw[kk][e]); ss += a * a + c * c; } }
        ss = swap_add(ss);
        const float rq = __builtin_amdgcn_rsqf(ss * (1.f / 64.f) + EPS) * (0.125f * LOG2E);
#pragma unroll
        for (int kk = 0; kk < 4; ++kk) { const int d0 = 16 * kk + 8 * hi;
            const f32x4 g0 = *(const f32x4*)(g_q_sb_ + d0) * *(const f32x4*)(g_k_sb_ + d0), g1 = *(const f32x4*)(g_q_sb_ + d0 + 4) * *(const f32x4*)(g_k_sb_ + d0 + 4);
            v4u o; o.x = cvtpk(bflo(qraw[kk].x) * rq * g0.x, bfhi(qraw[kk].x) * rq * g0.y); o.y = cvtpk(bflo(qraw[kk].y) * rq * g0.z, bfhi(qraw[kk].y) * rq * g0.w);
            o.z = cvtpk(bflo(qraw[kk].z) * rq * g1.x, bfhi(qraw[kk].z) * rq * g1.y); o.w = cvtpk(bflo(qraw[kk].w) * rq * g1.z, bfhi(qraw[kk].w) * rq * g1.w);
            qf[kk] = __builtin_bit_cast(bf16x8, o); }
    }
    f16x8 U0, U1, E0;
#pragma unroll
    for (int j = 0; j < 8; ++j) { U0[j] = (krow(0, hi, j) > r) ? (_Float16)1.0f : (_Float16)0.0f; U1[j] = (krow(1, hi, j) > r) ? (_Float16)1.0f : (_Float16)0.0f;
        E0[j] = (j == 0 && hi == 0) ? (_Float16)1.0f : (_Float16)0.0f; }
    f32x16 o0, o1;
#pragma unroll
    for (int i = 0; i < 16; ++i) { o0[i] = 0.f; o1[i] = 0.f; }
    float R = 0.f;
    const int kfoff = r * 128, kfsw = (r >> 1) & 7;
    for (int t = tw; t >= 0; --t) {
        const int buf = (tw - t) & 1;
        LAS unsigned char* Kb = Wb + 8192 * buf; LAS unsigned char* Vb = Kb + 4096;
        asm volatile("s_waitcnt vmcnt(0)" ::: "memory");
        if (t > 0) SB_DMA(t - 1, buf ^ 1);
        bf16x8 kf[4]; float ssk = 0.f;
#pragma unroll
        for (int kk = 0; kk < 4; ++kk) { const v4u kv = *(const LAS v4u*)(Kb + kfoff + (((2 * kk + hi) ^ kfsw) * 16)); kf[kk] = __builtin_bit_cast(bf16x8, kv);
            ssk = dot2bf(kv.x, kv.x, ssk); ssk = dot2bf(kv.y, kv.y, ssk); ssk = dot2bf(kv.z, kv.z, ssk); ssk = dot2bf(kv.w, kv.w, ssk); }
        ssk = swap_add(ssk);
        const float rk = __builtin_amdgcn_rsqf(ssk * (1.f / 64.f) + EPS);
        f16x8 RKA;
#pragma unroll
        for (int e = 0; e < 8; ++e) RKA[e] = (_Float16)0.0f;
        RKA[0] = (hi == 0) ? (_Float16)rk : (_Float16)0.0f;
        f32x16 s, rkd;
#pragma unroll
        for (int i = 0; i < 16; ++i) { s[i] = 0.f; rkd[i] = 0.f; }
        rkd = MFMA_F16(RKA, E0, rkd);
#pragma unroll
        for (int kk = 0; kk < 4; ++kk) s = MFMA_BF16(kf[kk], qf[kk], s);
        float tsum = 0.f; unsigned lp[8];
        if (32 * t + 31 < qw0) {
#pragma unroll
            for (int i = 0; i < 16; i += 2) {
                const float z0_ = s[i] * rkd[i], z1_ = s[i + 1] * rkd[i + 1];
                const float a0_ = -lg2(1.f + ex2(z0_)), a1_ = -lg2(1.f + ex2(z1_));
                tsum += a0_ + a1_;
                s[i] = z0_ + a0_; s[i + 1] = z1_ + a1_;
                lp[i >> 1] = pkh(a0_, a1_); }
        } else {
            const int kq = tq - 32 * t;
#pragma unroll
            for (int i = 0; i < 16; i += 2) {
                const float z0_ = s[i] * rkd[i], z1_ = s[i + 1] * rkd[i + 1];
                float a0_ = -lg2(1.f + ex2(z0_)), a1_ = -lg2(1.f + ex2(z1_));
                const bool ma0 = crow(i, hi) >= kq, ma1 = crow(i + 1, hi) >= kq;
                a0_ = ma0 ? 0.f : a0_; a1_ = ma1 ? 0.f : a1_;
                tsum += a0_ + a1_;
                s[i] = ma0 ? -INFINITY : z0_ + a0_; s[i + 1] = ma1 ? -INFINITY : z1_ + a1_;
                lp[i >> 1] = pkh(a0_, a1_); }
        }
        f32x16 c;
#pragma unroll
        for (int i = 0; i < 16; ++i) c[i] = R;
        c = MFMA_F16(U0, __builtin_bit_cast(f16x8, (v4u){lp[0], lp[1], lp[2], lp[3]}), c); c = MFMA_F16(U1, __builtin_bit_cast(f16x8, (v4u){lp[4], lp[5], lp[6], lp[7]}), c);
#pragma unroll
        for (int i = 0; i < 16; ++i) s[i] = ex2(s[i] + c[i]);
        const bf16x8 W0 = packbf(s, 0), W1 = packbf(s, 1);
        LAS unsigned char* vb_ = Vb + (4 * hi + qq) * 64 + 32 * blk + 8 * pp;
        o0 = MFMA_BF16(cat8(trrd(vb_), trrd(vb_ + 8 * 64)), W0, o0); o0 = MFMA_BF16(cat8(trrd(vb_ + 16 * 64), trrd(vb_ + 24 * 64)), W1, o0);
        o1 = MFMA_BF16(cat8(trrd(vb_ + 2048), trrd(vb_ + 2048 + 8 * 64)), W0, o1); o1 = MFMA_BF16(cat8(trrd(vb_ + 2048 + 16 * 64), trrd(vb_ + 2048 + 24 * 64)), W1, o1);
        R += swap_add(tsum);
        if (__all(R < -150.f)) break;
    }
    asm volatile("s_waitcnt vmcnt(0)" ::: "memory");
#undef SB_DMA
    {
        float ss = 0.f;
#pragma unroll
        for (int i = 0; i < 16; ++i) ss += o0[i] * o0[i] + o1[i] * o1[i];
        ss = swap_add(ss);
        const float ro = __builtin_amdgcn_rsqf(ss * (1.f / 64.f) + EPS);
        bf16* Op = MIX_ + (rowbase + tq) * D + h * 64;
        const float* go = g_out_sb_ + h * 64;
#pragma unroll
        for (int g = 0; g < 4; ++g) { const int d0 = 8 * g + 4 * hi; const f32x4 ga = *(const f32x4*)(go + d0), gb = *(const f32x4*)(go + 32 + d0);
            u32x2 wa, wb; wa.x = cvtpk(o0[4 * g] * ro * ga.x, o0[4 * g + 1] * ro * ga.y); wa.y = cvtpk(o0[4 * g + 2] * ro * ga.z, o0[4 * g + 3] * ro * ga.w);
            wb.x = cvtpk(o1[4 * g] * ro * gb.x, o1[4 * g + 1] * ro * gb.y); wb.y = cvtpk(o1[4 * g + 2] * ro * gb.z, o1[4 * g + 3] * ro * gb.w);
            *(GAS u32x2*)(Op + d0) = wa; *(GAS u32x2*)(Op + 32 + d0) = wb; }
    }
    __syncthreads();
}

DI void conv_silu8(const v4u (&xr)[4], const float (&cw)[4][8], float scale, float (&y)[8]) {
#pragma unroll
    for (int e = 0; e < 8; ++e) y[e] = 0.f;
#pragma unroll
    for (int j = 0; j < 4; ++j) {
        y[0] += cw[j][0] * bflo(xr[j].x); y[1] += cw[j][1] * bfhi(xr[j].x); y[2] += cw[j][2] * bflo(xr[j].y); y[3] += cw[j][3] * bfhi(xr[j].y);
        y[4] += cw[j][4] * bflo(xr[j].z); y[5] += cw[j][5] * bfhi(xr[j].z); y[6] += cw[j][6] * bflo(xr[j].w); y[7] += cw[j][7] * bfhi(xr[j].w); }
#pragma unroll
    for (int e = 0; e < 8; ++e) y[e] = scale * y[e] * __builtin_amdgcn_rcpf(1.f + fexp(-y[e]));
}
DI float log_sigmoid(float x) { return fminf(x, 0.f) - 0.6931471805599453f * lg2(1.f + fexp(-fabsf(x))); }
DI float wave_scan_incl(float a, int lane) {
#pragma unroll
    for (int o = 1; o < 64; o <<= 1) { const float t = __shfl_up(a, o); if (lane >= o) a += t; }
    return a;
}

constexpr int LDS_CW = 65536;
DI void stage_conv_w(const Frame& F) {
    const float* const conv_w_ = inp(I_CONVW); LAS float* cwl = (LAS float*)(F.lds + LDS_CW);
    for (int i = F.tid; i < 4096; i += NTHR) cwl[i] = conv_w_[i];
    __syncthreads();
}
DI void load_cw8(const Frame& F, int colbase, float (&cw)[4][8]) {
    const LAS float* cwl = (const LAS float*)(F.lds + LDS_CW);
#pragma unroll
    for (int j = 0; j < 4; ++j) { const f32x4 a = *(const LAS f32x4*)(cwl + j * 1024 + colbase), b = *(const LAS f32x4*)(cwl + j * 1024 + colbase + 4);
        cw[j][0] = a.x; cw[j][1] = a.y; cw[j][2] = a.z; cw[j][3] = a.w; cw[j][4] = b.x; cw[j][5] = b.y; cw[j][6] = b.z; cw[j][7] = b.w; }
}
struct MlLocalRegs { v4u kraw[2][4]; v4u vraw[2]; float gi, gf; };
DI void ml_local_load(const Frame& F, int chain, int c, MlLocalRegs& R) {
    bf16* const PROJ_ = WSP(bf16, WS_PROJ); float* const GATES_ = WSP(float, WS_GATES);
    const int tid = F.tid, lane = F.lane;
    const int b = chain >> 2, hh = chain & 3; const size_t rowbase = (size_t)b * SEQ; const int t0 = c * 64;
    const bf16* P = PROJ_;
    const int kc = tid & 15, kr0 = tid >> 4;
    const bf16* Kg = P + rowbase * NPROJ + C_KML + hh * 128 + kc * 8;
#pragma unroll
    for (int i = 0; i < 2; ++i)
#pragma unroll
        for (int j = 0; j < 4; ++j) { const int tt = t0 + kr0 + 32 * i - 3 + j; R.kraw[i][j] = (tt >= 0) ? *(const GAS v4u*)(Kg + (size_t)tt * NPROJ) : (v4u){0u, 0u, 0u, 0u}; }
#pragma unroll
    for (int i = 0; i < 2; ++i) R.vraw[i] = *(const GAS v4u*)(P + (rowbase + t0 + kr0 + 32 * i) * NPROJ + C_VML + hh * 128 + kc * 8);
    const float* Gg = GATES_ + (rowbase + t0 + lane) * 8;
    R.gi = Gg[hh]; R.gf = Gg[4 + hh];
}
DI void ml_local_unit(const Frame& F, int chain, int c, const MlLocalRegs& RG) {
    bf16* const CST_ = WSP(bf16, WS_CST); float* const NST_ = WSP(float, WS_NST); float* const SCL_ = WSP(float, WS_SCL);
    LAS unsigned char* L = F.lds;
    LAS float* Lws = (LAS float*)(L + 32768);
    const int tid = F.tid, lane = F.lane, w = F.wave, r = lane & 31, hi = lane >> 5;
    const int i16 = lane & 15, qq = i16 >> 2, pp = i16 & 3, blk = (lane >> 4) & 1;
    const int hh = chain & 3;
    const int kbk = w & 3, vb0 = 2 * (w >> 2);
    const int kc = tid & 15, kr0 = tid >> 4;
    v4u kraw[2][4], vraw[2];
#pragma unroll
    for (int i = 0; i < 2; ++i) { vraw[i] = RG.vraw[i];
#pragma unroll
        for (int j = 0; j < 4; ++j) kraw[i][j] = RG.kraw[i][j]; }
    const float gi = RG.gi, gf = RG.gf;
    const float a = wave_scan_incl(log_sigmoid(gf), lane);
    const float a_end = __shfl(a, 63);
    const float lw = a_end - a + gi;
    const float m_loc = wave_max(lw);
    const float ws = fexp(lw - m_loc);
    if (w == 0) Lws[lane] = ws;
    {
        float cw[4][8]; load_cw8(F, 512 + hh * 128 + kc * 8, cw);
#pragma unroll
        for (int i = 0; i < 2; ++i) { float y[8]; conv_silu8(kraw[i], cw, 0.08838834764831845f, y);
            v4u o; o.x = cvtpk(y[0], y[1]); o.y = cvtpk(y[2], y[3]); o.z = cvtpk(y[4], y[5]); o.w = cvtpk(y[6], y[7]);
            *(LAS v4u*)(L + (kc >> 2) * 4096 + (kr0 + 32 * i) * 64 + (kc & 3) * 16) = o; }
#pragma unroll
        for (int i = 0; i < 2; ++i) { const int row = kr0 + 32 * i; const float wsr = __shfl(ws, row);
            v4u o; o.x = cvtpk(bflo(vraw[i].x) * wsr, bfhi(vraw[i].x) * wsr); o.y = cvtpk(bflo(vraw[i].y) * wsr, bfhi(vraw[i].y) * wsr); o.z = cvtpk(bflo(vraw[i].z) * wsr, bfhi(vraw[i].z) * wsr); o.w = cvtpk(bflo(vraw[i].w) * wsr, bfhi(vraw[i].w) * wsr);
            *(LAS v4u*)(L + 16384 + (kc >> 2) * 4096 + row * 64 + (kc & 3) * 16) = o; }
    }
    __syncthreads();
    f32x16 acc0, acc1;
#pragma unroll
    for (int i = 0; i < 16; ++i) { acc0[i] = 0.f; acc1[i] = 0.f; }
#pragma unroll
    for (int kk = 0; kk < 4; ++kk) { const int rows = 16 * kk + 8 * hi + qq;
        LAS unsigned char* ka = L + kbk * 4096 + rows * 64 + 32 * blk + 8 * pp; LAS unsigned char* va = L + 16384 + vb0 * 4096 + rows * 64 + 32 * blk + 8 * pp;
        const bf16x8 A = cat8(trrd(ka), trrd(ka + 4 * 64));
        acc0 = MFMA_BF16(A, cat8(trrd(va), trrd(va + 4 * 64)), acc0); acc1 = MFMA_BF16(A, cat8(trrd(va + 4096), trrd(va + 4096 + 4 * 64)), acc1); }
    {
        bf16* Cp = CST_ + ((size_t)(chain * 64 + c) * 128 + vb0 * 32 + r) * 128 + kbk * 32 + 4 * hi;
#pragma unroll
        for (int g = 0; g < 4; ++g) { u32x2 o; o.x = cvtpk(acc0[4 * g], acc0[4 * g + 1]); o.y = cvtpk(acc0[4 * g + 2], acc0[4 * g + 3]); *(GAS u32x2*)(Cp + 8 * g) = o;
            u32x2 o1; o1.x = cvtpk(acc1[4 * g], acc1[4 * g + 1]); o1.y = cvtpk(acc1[4 * g + 2], acc1[4 * g + 3]); *(GAS u32x2*)(Cp + 32 * 128 + 8 * g) = o1; }
    }
    {
        const int k = 16 * w + (lane & 15), sq = lane >> 4; float part = 0.f;
        const LAS unsigned short* kcol = (const LAS unsigned short*)(L + (k >> 5) * 4096 + (k & 31) * 2);
#pragma unroll
        for (int e = 0; e < 16; ++e) part += Lws[16 * sq + e] * __uint_as_float((unsigned)kcol[(16 * sq + e) * 32] << 16);
        part += __shfl_xor(part, 16); part += __shfl_xor(part, 32);
        if (lane < 16) NST_[(size_t)(chain * 64 + c) * 128 + k] = part;
        if (tid == 0) { SCL_[(chain * 64 + c) * 2] = a_end; SCL_[(chain * 64 + c) * 2 + 1] = m_loc; }
    }
    __syncthreads();
}
DI void ml_scan_phase(const Frame& F) {
    bf16* const CST_ = WSP(bf16, WS_CST); float* const NST_ = WSP(float, WS_NST); float* const SCL_ = WSP(float, WS_SCL); float* const MST_ = WSP(float, WS_MST);
    for (int gt = F.vcu * NTHR + F.tid; gt < 32 * 4096; gt += F.G * NTHR) {
        const int chain = gt >> 12, rem = gt & 4095;
        const float ae_l = SCL_[(chain * 64 + F.lane) * 2], ml_l = SCL_[(chain * 64 + F.lane) * 2 + 1];
        u32x2* Cp = (u32x2*)(CST_ + (size_t)chain * 64 * 16384 + (size_t)rem * 4);
        f32x4* Np = (f32x4*)(NST_ + (size_t)chain * 64 * 128 + rem * 4);
        const bool do_n = rem < 32;
        float c0 = 0.f, c1 = 0.f, c2 = 0.f, c3 = 0.f; f32x4 nn = {0.f, 0.f, 0.f, 0.f}; float m = 0.f;
        u32x2 dr[8]; f32x4 nr[8];
#pragma unroll
        for (int i = 0; i < 8; ++i) { dr[i] = Cp[(size_t)i * 4096]; if (do_n) nr[i] = Np[i * 32]; }
        for (int c0_ = 0; c0_ < 64; c0_ += 8) {
#pragma unroll
            for (int i = 0; i < 8; ++i) { const int c = c0_ + i;
                if (c < 63) {
                    const u32x2 dcur = dr[i]; const f32x4 dn = nr[i];
                    if (c + 8 < 63) { dr[i] = Cp[(size_t)(c + 8) * 4096]; if (do_n) nr[i] = Np[(c + 8) * 32]; }
                    const float ae = __builtin_bit_cast(float, __builtin_amdgcn_readlane(__builtin_bit_cast(int, ae_l), c)), ml = __builtin_bit_cast(float, __builtin_amdgcn_readlane(__builtin_bit_cast(int, ml_l), c));
                    const float mn = fmaxf(ae + m, ml), d1 = fexp(ae + m - mn), d2 = fexp(ml - mn);
                    c0 = d1 * c0 + d2 * bflo(dcur.x); c1 = d1 * c1 + d2 * bfhi(dcur.x); c2 = d1 * c2 + d2 * bflo(dcur.y); c3 = d1 * c3 + d2 * bfhi(dcur.y);
                    u32x2 o; o.x = cvtpk(c0, c1); o.y = cvtpk(c2, c3); Cp[(size_t)c * 4096] = o;
                    if (do_n) { nn = nn * d1 + dn * d2; Np[c * 32] = nn; }
                    if (rem == 0) MST_[chain * 64 + c] = mn;
                    m = mn; } }
        }
    }
}
DI void ml_out_unit(const Frame& F, int chain, int c, int nchain = -1, int nc = 0) {
    bf16* const PROJ_ = WSP(bf16, WS_PROJ); float* const GATES_ = WSP(float, WS_GATES); float* const MST_ = WSP(float, WS_MST); bf16* const CST_ = WSP(bf16, WS_CST); float* const NST_ = WSP(float, WS_NST); bf16* const MIX_ = WSP(bf16, WS_MIX); const float* const g_out_ml_ = inp(I_GOML);
    LAS unsigned char* L = F.lds;
    LAS float* Lbs = (LAS float*)(L + 49152); LAS float* Lav = (LAS float*)(L + 49408); LAS float* Lex = (LAS float*)(L + 49664);
    const int tid = F.tid, lane = F.lane, w = F.wave, r = lane & 31, hi = lane >> 5;
    const int i16 = lane & 15, qq = i16 >> 2, pp = i16 & 3, blk = (lane >> 4) & 1;
    const int b = chain >> 2, hh = chain & 3; const size_t rowbase = (size_t)b * SEQ; const int t0 = c * 64;
    const int tb = w >> 2, vb = w & 3;
    const bf16* P = PROJ_;
    {
        const int kc = tid & 15, kr0 = tid >> 4;
#pragma unroll
        for (int which = 0; which < 2; ++which) {
            const int colbase = (which ? 512 : 0) + hh * 128 + kc * 8;
            float cw[4][8]; load_cw8(F, colbase, cw);
            const bf16* Xg = P + rowbase * NPROJ + C_QML + colbase;
#pragma unroll
            for (int i = 0; i < 2; ++i) { const int row = kr0 + 32 * i; v4u xr[4];
#pragma unroll
                for (int j = 0; j < 4; ++j) { const int tt = t0 + row - 3 + j; xr[j] = (tt >= 0) ? *(const GAS v4u*)(Xg + (size_t)tt * NPROJ) : (v4u){0u, 0u, 0u, 0u}; }
                float y[8]; conv_silu8(xr, cw, which ? 0.08838834764831845f : 1.0f, y);
                v4u o; o.x = cvtpk(y[0], y[1]); o.y = cvtpk(y[2], y[3]); o.z = cvtpk(y[4], y[5]); o.w = cvtpk(y[6], y[7]);
                *(LAS v4u*)(L + which * 16384 + row * 256 + ((kc ^ (row & 15)) * 16)) = o; }
        }
#pragma unroll
        for (int i = 0; i < 2; ++i) { const int row = kr0 + 32 * i;
            const v4u v = *(const GAS v4u*)(P + (rowbase + t0 + row) * NPROJ + C_VML + hh * 128 + kc * 8);
            *(LAS v4u*)(L + 32768 + (kc >> 2) * 4096 + row * 64 + (kc & 3) * 16) = v; }
        if (w == 0) { const float* Gg = GATES_ + (rowbase + t0 + lane) * 8; const float a = wave_scan_incl(log_sigmoid(Gg[4 + hh]), lane); Lav[lane] = a; Lbs[lane] = Gg[hh] - a; }
    }
    const float mprev = (c > 0) ? MST_[chain * 64 + c - 1] : 0.f;
    bf16x8 cf[8], nf[8];
    if (c > 0) {
        const bf16* Cp = CST_ + ((size_t)(chain * 64 + c - 1) * 128 + vb * 32 + r) * 128 + 8 * hi;
        const float* Np = NST_ + (size_t)(chain * 64 + c - 1) * 128 + 8 * hi;
        const bool nrow = (r == 0) || (r == 4);
#pragma unroll
        for (int kk = 0; kk < 8; ++kk) { cf[kk] = *(const GAS bf16x8*)(Cp + 16 * kk);
            const f32x4 n0 = *(const f32x4*)(Np + 16 * kk), n1 = *(const f32x4*)(Np + 16 * kk + 4);
            v4u o; o.x = cvtpk(n0.x, n0.y); o.y = cvtpk(n0.z, n0.w); o.z = cvtpk(n1.x, n1.y); o.w = cvtpk(n1.z, n1.w);
            if (!nrow) o = (v4u){0u, 0u, 0u, 0u};
            nf[kk] = __builtin_bit_cast(bf16x8, o); }
    }
    unsigned tch0 = 0u, tch1 = 0u;
    if (nchain >= 0) {
        const unsigned nhh = (unsigned)nchain & 3u, nrow0 = (unsigned)(nchain >> 2) * SEQ + (unsigned)nc * 64u, cst = (unsigned)(nchain * 64 + nc - 1);
        const unsigned rr = (unsigned)tid >> 2, part = (unsigned)tid & 3u;
        unsigned o0 = (unsigned)WS_PROJ + ((nrow0 - 3u + rr) * NPROJ + C_QML + (part >> 1) * 512u + nhh * 128u + (part & 1u) * 64u) * 2u; bool v0 = (nc > 0) || (rr >= 3u);
        if (tid >= 268) { o0 = (unsigned)WS_CST + cst * 32768u + (unsigned)(tid - 268) * 128u; v0 = nc > 0; }
        unsigned o1 = (unsigned)WS_PROJ + ((nrow0 + rr) * NPROJ + ((part >> 1) ? C_OML : C_VML) + nhh * 128u + (part & 1u) * 64u) * 2u; bool v1 = true;
        if (tid >= 256) { o1 = (unsigned)WS_CST + cst * 32768u + (unsigned)(244 + tid - 256) * 128u; v1 = nc > 0; }
        if (tid >= 268) { o1 = (unsigned)WS_NST + cst * 512u + (unsigned)(tid - 268) * 128u; }
        if (tid >= 272) { o1 = (unsigned)WS_GATES + nrow0 * 32u + (unsigned)(tid - 272) * 128u; v1 = tid < 288; }
        const GAS unsigned char* wsb = (const GAS unsigned char*)F.ws;
        if (v0) tch0 = *(const GAS unsigned*)(wsb + o0);
        if (v1) tch1 = *(const GAS unsigned*)(wsb + o1);
    }
    __syncthreads();
    bf16x8 qf[8];
    f32x16 s0, s1;
#pragma unroll
    for (int i = 0; i < 16; ++i) { s0[i] = 0.f; s1[i] = 0.f; }
#pragma unroll
    for (int kk = 0; kk < 8; ++kk) { const int ch = 2 * kk + hi; const int rq_ = 32 * tb + r;
        qf[kk] = *(const LAS bf16x8*)(L + rq_ * 256 + ((ch ^ (rq_ & 15)) * 16));
        const bf16x8 a0 = *(const LAS bf16x8*)(L + 16384 + r * 256 + ((ch ^ (r & 15)) * 16));
        const bf16x8 a1 = *(const LAS bf16x8*)(L + 16384 + (32 + r) * 256 + ((ch ^ ((32 + r) & 15)) * 16));
        s0 = MFMA_BF16(a0, qf[kk], s0); s1 = MFMA_BF16(a1, qf[kk], s1); }
    const int tl = 32 * tb + r; const float a_t = Lav[tl];
    f32x16 d0, d1; float mrow = -INFINITY;
#pragma unroll
    for (int g = 0; g < 4; ++g) { const f32x4 b0 = *(const LAS f32x4*)(Lbs + 8 * g + 4 * hi), b1 = *(const LAS f32x4*)(Lbs + 32 + 8 * g + 4 * hi);
#pragma unroll
        for (int e = 0; e < 4; ++e) { const int sl = 8 * g + 4 * hi + e;
            d0[4 * g + e] = (sl <= tl) ? a_t + b0[e] : -INFINITY; d1[4 * g + e] = (32 + sl <= tl) ? a_t + b1[e] : -INFINITY;
            mrow = fmaxf(mrow, fmaxf(d0[4 * g + e], d1[4 * g + e])); } }
    mrow = fmaxf(swap_max(mrow), a_t + mprev);
    float psum = 0.f;
#pragma unroll
    for (int i = 0; i < 16; ++i) { s0[i] *= fexp(d0[i] - mrow); s1[i] *= fexp(d1[i] - mrow); psum += s0[i] + s1[i]; }
    const float w_inter = fexp(a_t + mprev - mrow);
    float den = swap_add(psum);
    const bf16x8 P00 = packbf(s0, 0), P01 = packbf(s0, 1), P10 = packbf(s1, 0), P11 = packbf(s1, 1);
    f32x16 num;
#pragma unroll
    for (int i = 0; i < 16; ++i) num[i] = 0.f;
    {
        LAS unsigned char* vb_ = L + 32768 + vb * 4096 + (4 * hi + qq) * 64 + 32 * blk + 8 * pp;
        num = MFMA_BF16(cat8(trrd(vb_), trrd(vb_ + 8 * 64)), P00, num); num = MFMA_BF16(cat8(trrd(vb_ + 16 * 64), trrd(vb_ + 24 * 64)), P01, num);
        num = MFMA_BF16(cat8(trrd(vb_ + 32 * 64), trrd(vb_ + 40 * 64)), P10, num); num = MFMA_BF16(cat8(trrd(vb_ + 48 * 64), trrd(vb_ + 56 * 64)), P11, num);
    }
    if (c > 0) {
        f32x16 it, dn;
#pragma unroll
        for (int i = 0; i < 16; ++i) { it[i] = 0.f; dn[i] = 0.f; }
#pragma unroll
        for (int kk = 0; kk < 8; ++kk) { it = MFMA_BF16(cf[kk], qf[kk], it); dn = MFMA_BF16(nf[kk], qf[kk], dn); }
#pragma unroll
        for (int i = 0; i < 16; ++i) num[i] += w_inter * it[i];
        den += w_inter * dn[0];
    }
    const float inv = __builtin_amdgcn_rcpf(fmaxf(fabsf(den), fexp(-mrow)));
    float ss = 0.f;
#pragma unroll
    for (int i = 0; i < 16; ++i) { num[i] *= inv; ss += num[i] * num[i]; }
    ss = swap_add(ss);
    if (lane < 32) Lex[(tb * 4 + vb) * 32 + r] = ss;
    __syncthreads();
    const float tot = (Lex[(tb * 4 + 0) * 32 + r] + Lex[(tb * 4 + 1) * 32 + r]) + (Lex[(tb * 4 + 2) * 32 + r] + Lex[(tb * 4 + 3) * 32 + r]);
    const float rstd = 1.f / sqrtf(tot * (1.f / 128.f) + EPS);
    {
        const size_t trow = rowbase + t0 + tl;
        const bf16* Og = P + trow * NPROJ + C_OML + hh * 128 + vb * 32 + 4 * hi;
        bf16* Mp = MIX_ + trow * D + 512 + hh * 128 + vb * 32 + 4 * hi;
        const float* go = g_out_ml_ + hh * 128 + vb * 32 + 4 * hi;
#pragma unroll
        for (int g = 0; g < 4; ++g) { const u32x2 og = *(const GAS u32x2*)(Og + 8 * g); const f32x4 gg = *(const f32x4*)(go + 8 * g);
            const float o0 = bflo(og.x), o1 = bfhi(og.x), o2 = bflo(og.y), o3 = bfhi(og.y);
            u32x2 o; o.x = cvtpk(num[4 * g] * rstd * gg.x * __builtin_amdgcn_rcpf(1.f + fexp(-o0)), num[4 * g + 1] * rstd * gg.y * __builtin_amdgcn_rcpf(1.f + fexp(-o1)));
            o.y = cvtpk(num[4 * g + 2] * rstd * gg.z * __builtin_amdgcn_rcpf(1.f + fexp(-o2)), num[4 * g + 3] * rstd * gg.w * __builtin_amdgcn_rcpf(1.f + fexp(-o3)));
            *(GAS u32x2*)(Mp + 8 * g) = o; }
    }
    asm volatile("" :: "v"(tch0), "v"(tch1));
    __syncthreads();
}

#define TK_CE(A, B) do { const float hi_ = fmaxf((A), (B)), lo_ = fminf((A), (B)); (A) = hi_; (B) = lo_; } while (0)
DI void tk_sort16(float (&a)[16]) {
    TK_CE(a[0], a[1]); TK_CE(a[2], a[3]); TK_CE(a[0], a[2]); TK_CE(a[1], a[3]); TK_CE(a[1], a[2]); TK_CE(a[4], a[5]); TK_CE(a[6], a[7]); TK_CE(a[4], a[6]); TK_CE(a[5], a[7]); TK_CE(a[5], a[6]); TK_CE(a[0], a[4]); TK_CE(a[2], a[6]); TK_CE(a[2], a[4]); TK_CE(a[1], a[5]); TK_CE(a[3], a[7]); TK_CE(a[3], a[5]); TK_CE(a[1], a[2]); TK_CE(a[3], a[4]); TK_CE(a[5], a[6]); TK_CE(a[8], a[9]); TK_CE(a[10], a[11]); TK_CE(a[8], a[10]); TK_CE(a[9], a[11]); TK_CE(a[9], a[10]); TK_CE(a[12], a[13]); TK_CE(a[14], a[15]); TK_CE(a[12], a[14]); TK_CE(a[13], a[15]); TK_CE(a[13], a[14]); TK_CE(a[8], a[12]); TK_CE(a[10], a[14]); TK_CE(a[10], a[12]); TK_CE(a[9], a[13]); TK_CE(a[11], a[15]); TK_CE(a[11], a[13]); TK_CE(a[9], a[10]); TK_CE(a[11], a[12]); TK_CE(a[13], a[14]); TK_CE(a[0], a[8]); TK_CE(a[4], a[12]); TK_CE(a[4], a[8]); TK_CE(a[2], a[10]); TK_CE(a[6], a[14]); TK_CE(a[6], a[10]); TK_CE(a[2], a[4]); TK_CE(a[6], a[8]); TK_CE(a[10], a[12]); TK_CE(a[1], a[9]); TK_CE(a[5], a[13]); TK_CE(a[5], a[9]); TK_CE(a[3], a[11]); TK_CE(a[7], a[15]); TK_CE(a[7], a[11]); TK_CE(a[3], a[5]); TK_CE(a[7], a[9]); TK_CE(a[11], a[13]); TK_CE(a[1], a[2]); TK_CE(a[3], a[4]); TK_CE(a[5], a[6]); TK_CE(a[7], a[8]); TK_CE(a[9], a[10]); TK_CE(a[11], a[12]); TK_CE(a[13], a[14]);
}
DI void tk_merge16(float (&a)[16], const float (&b)[16]) {
#pragma unroll
    for (int i = 0; i < 16; ++i) a[i] = fmaxf(a[i], b[15 - i]);
#pragma unroll
    for (int j = 8; j > 0; j >>= 1)
#pragma unroll
        for (int i = 0; i < 16; ++i) { const int l = i ^ j; if (l > i) TK_CE(a[i], a[l]); }
}
DI void tk_stage2(const LAS float* la, const LAS float* lb, int* IDX_, float* GATEW_, size_t o) {
        float a[16], bb[16], cnd[64];
#pragma unroll
        for (int q = 0; q < 16; ++q) { a[q] = la[q]; bb[q] = lb[q]; }
        int cnt = 0;
#pragma unroll
        for (int i = 0; i < 16; ++i)
#pragma unroll
            for (int j = 0; j < 16; ++j) if ((i + 1) * (j + 1) <= 16) { cnd[cnt] = __uint_as_float((__float_as_uint(a[i] + bb[j]) & ~0xFFu) | (unsigned)(i * 16 + j)); ++cnt; }
#pragma unroll
        for (int q = 50; q < 64; ++q) cnd[q] = -INFINITY;
        float top[16];
#pragma unroll
        for (int c = 0; c < 4; ++c) { float ch[16];
#pragma unroll
            for (int q = 0; q < 16; ++q) ch[q] = cnd[16 * c + q];
            tk_sort16(ch);
            if (c == 0) {
#pragma unroll
                for (int q = 0; q < 16; ++q) top[q] = ch[q];
            } else tk_merge16(top, ch); }
        float sv[16]; int ei[16]; float mx = -INFINITY;
#pragma unroll
        for (int q = 0; q < 16; ++q) { const unsigned code = __float_as_uint(top[q]) & 0xFFu; const float va = la[code >> 4], vb = lb[code & 15u];
            ei[q] = (int)((__float_as_uint(va) & 0x7Fu) * 128u + (__float_as_uint(vb) & 0x7Fu)); sv[q] = va + vb; mx = fmaxf(mx, sv[q]); }
        float sum = 0.f;
#pragma unroll
        for (int q = 0; q < 16; ++q) { sv[q] = fexp(sv[q] - mx); sum += sv[q]; }
        const float inv = 1.f / sum;
#pragma unroll
#define TK_PK(Q) (((__builtin_bit_cast(unsigned, sv[(Q)] * inv) + 0x2000u) & 0xFFFFC000u) | (unsigned)ei[(Q)])
        for (int q = 0; q < 16; q += 4) *(GAS v4u*)(IDX_ + o + q) = (v4u){TK_PK(q), TK_PK(q + 1), TK_PK(q + 2), TK_PK(q + 3)};
#undef TK_PK
        (void)GATEW_;
    }
struct EpiTopK {
    static constexpr bool PERM = false, AFTER_DRAIN = true;
    int* IDX; float* GATEW;
    DI void fused(f32x4 (&acc)[2][2][4][2], const pg8::Unit& u, int wr, int wc, int fr, int fq, LAS unsigned char* lds, int wid, int lane) const {
        LAS float* Tl = (LAS float*)lds;
        LAS float* Lh2 = (LAS float*)lds;
        LAS float* Ls = (LAS float*)(lds + 36864);
        const int tid = wid * 64 + lane, tl = tid & 127, p = (tid >> 7) & 1, half = tid >> 8;
        float keep[16], fin[16];
#pragma unroll
        for (int q = 0; q < 16; ++q) { keep[q] = 0.f; fin[q] = 0.f; }
#pragma unroll
        for (int ai = 0; ai < 2; ++ai) {
#pragma unroll
            for (int bj = 0; bj < 2; ++bj)
#pragma unroll
                for (int m = 0; m < 4; ++m)
#pragma unroll
                    for (int n = 0; n < 2; ++n) { LAS float* d = Tl + (wr * 64 + m * 16 + fr) * 257 + bj * 128 + wc * 32 + n * 16 + fq * 4; const f32x4 v = acc[ai][bj][m][n]; d[0] = v.x; d[1] = v.y; d[2] = v.z; d[3] = v.w; }
            __syncthreads();
            float run[16];
            {
                const LAS float* src = Tl + tl * 257 + p * 128 + half * 64;
#pragma unroll
                for (int c = 0; c < 4; ++c) { float ch[16];
#pragma unroll
                    for (int q = 0; q < 16; ++q) ch[q] = __uint_as_float((__float_as_uint(src[16 * c + q]) & ~0x7Fu) | (unsigned)(half * 64 + 16 * c + q));
                    tk_sort16(ch);
                    if (c == 0) {
#pragma unroll
                        for (int q = 0; q < 16; ++q) run[q] = ch[q];
                    } else tk_merge16(run, ch); }
            }
            __syncthreads();
#pragma unroll
            for (int q = 0; q < 16; ++q) Lh2[((tl * 2 + p) * 2 + half) * 17 + q] = run[q];
            __syncthreads();
            if (half == 0) { float oth[16];
#pragma unroll
                for (int q = 0; q < 16; ++q) oth[q] = Lh2[((tl * 2 + p) * 2 + 1) * 17 + q];
                tk_merge16(run, oth);
                if (ai == 0) {
#pragma unroll
                    for (int q = 0; q < 16; ++q) keep[q] = run[q]; }
                else {
#pragma unroll
                    for (int q = 0; q < 16; ++q) fin[q] = run[q]; } }
            __syncthreads();
        }
        if (half == 0) {
#pragma unroll
            for (int q = 0; q < 16; ++q) { Ls[(tl * 2 + p) * 17 + q] = keep[q]; Ls[(256 + tl * 2 + p) * 17 + q] = fin[q]; } }
        __syncthreads();
        if (tid < 256) tk_stage2(Ls + (tid * 2) * 17, Ls + (tid * 2) * 17 + 17, IDX, GATEW, (size_t)(u.pm * 256 + tid) * 128 + u.pn * 16);
        __syncthreads();
    }
};
struct OneUnit {
    pg8::Unit u;
    __device__ __forceinline__ bool next(int i, pg8::Unit& o) const { if (i) return false; o = u; return true; }
    __device__ __forceinline__ void a_ready(const pg8::Unit&) const {}
    __device__ __forceinline__ void done(const pg8::Unit&) const {}
};

DI float gelu_erf(float x) { return 0.5f * x * (1.f + erff(x * 0.7071067811865476f)); }
#define DPP_ADD(v, ctrl, rmask) ((v) + __builtin_bit_cast(float, __builtin_amdgcn_update_dpp(0, __builtin_bit_cast(int, (v)), (ctrl), (rmask), 0xF, false)))
#ifndef PEER_EBL
#define PEER_EBL 9
#endif
constexpr int PEER_EB_LOG = PEER_EBL;
#ifndef PEER_PROBE_MASK
#define PEER_PROBE_MASK 0xFFFF
#endif
typedef float f32x2v __attribute__((ext_vector_type(2)));
DI float gelu_cdf(float v) {
    const float av = fabsf(v), t = __builtin_amdgcn_rcpf(av * 0.2316418882f + 1.0f);
    float q = t * 0.5307027145f - 0.7265760135f; q = q * t + 0.7107068705f; q = q * t - 0.142248368f; q = q * t + 0.127414796f; q = q * t;
    const float m = v * (q * ex2(v * v * -0.72134752044f));
    return v < 0.f ? m : v - m;
}
#define DPP_ADDI(v, ctrl, rmask) ((v) + __builtin_amdgcn_update_dpp(0, (v), (ctrl), (rmask), 0xF, false))
DI void peer_phase(const Frame& F, bool scratch_dst) {
    bf16* const XN_ = WSP(bf16, WS_XN); int* const IDX_ = WSP(int, WS_IDX); float* const GATEW_ = WSP(float, WS_GATE); float* const mod_ = WSP(float, WS_MOD); float* const out_ = (float*)inp(I_OUT); const bf16* const X1B_ = WSP(bf16, WS_X1B);
    const unsigned char* const EU4 = WSP(unsigned char, WS_EXPU); const unsigned char* const EV4 = WSP(unsigned char, WS_EXPV); const float* const SUI_ = WSP(float, WS_SUI); const float* const SVI_ = WSP(float, WS_SVI);
    const int gw = F.vcu * NWAVES + F.wave, NGW = F.G * NWAVES, lane = F.lane, g = lane >> 3, j = lane & 7;
    LAS unsigned char* wl = F.lds + F.wave * 17408;
    volatile LAS int* Le = (volatile LAS int*)(wl + g * 512); volatile LAS float* Lg = (volatile LAS float*)(wl + 4096 + g * 512); volatile LAS int* Lp = (volatile LAS int*)(wl + 8192 + g * 512);
    volatile LAS int* Lx = (volatile LAS int*)(wl + 12288 + g * 512); LAS int* Lh = (LAS int*)(wl + 16384 + g * 128);
    for (int grp = gw; grp < T / 8; grp += NGW) {
        const size_t t = (size_t)grp * 8 + g;
        int xh[16], xl[16]; float sxi;
#ifdef PEER_DUP_S
        auto qs_ = [&]() __attribute__((always_inline)) {
#endif
        {
            const unsigned char* xq = WSP(unsigned char, WS_XQ) + t * 1024 + 16 * j;
#pragma unroll
            for (int q = 0; q < 4; ++q) { const v4u a = *(const GAS v4u*)(xq + 128 * q), b = *(const GAS v4u*)(xq + 512 + 128 * q);
#pragma unroll
                for (int w_ = 0; w_ < 4; ++w_) { xh[4 * q + w_] = (int)a[w_]; xl[4 * q + w_] = (int)b[w_]; } }
            sxi = WSP(float, WS_XS)[t];
        }
        {
            int ide[16]; float gte[16]; int rk[16];
#pragma unroll
            for (int m = 0; m < 16; ++m) { const unsigned pk_ = (unsigned)IDX_[t * 128 + j + 8 * m]; ide[m] = (int)(pk_ & 0x3FFFu); gte[m] = __builtin_bit_cast(float, pk_ & 0xFFFFC000u); }
#pragma unroll
            for (int m = 0; m < 4; ++m) Lh[j + 8 * m] = 0;
#pragma unroll
            for (int m = 0; m < 16; ++m) rk[m] = __hip_atomic_fetch_add(Lh + (ide[m] >> PEER_EB_LOG), 1, __ATOMIC_RELAXED, __HIP_MEMORY_SCOPE_WORKGROUP);
            {
                const int h0 = ((volatile LAS int*)Lh)[4 * j], h1 = ((volatile LAS int*)Lh)[4 * j + 1], h2 = ((volatile LAS int*)Lh)[4 * j + 2], h3 = ((volatile LAS int*)Lh)[4 * j + 3];
                const int tot = (h0 + h1) + (h2 + h3); int inc = tot;
#pragma unroll
                for (int o = 1; o < 8; o <<= 1) { const int tt = __shfl_up(inc, o, 8); if (j >= o) inc += tt; }
                const int ex = inc - tot;
                ((volatile LAS int*)Lh)[4 * j] = ex; ((volatile LAS int*)Lh)[4 * j + 1] = ex + h0; ((volatile LAS int*)Lh)[4 * j + 2] = ex + h0 + h1; ((volatile LAS int*)Lh)[4 * j + 3] = ex + h0 + h1 + h2;
            }
#pragma unroll
            for (int m = 0; m < 16; ++m) { const int pos = ((volatile LAS int*)Lh)[ide[m] >> PEER_EB_LOG] + rk[m]; Le[pos] = ide[m]; Lg[pos] = gte[m] * SVI_[ide[m]]; Lp[pos] = __builtin_bit_cast(int, SUI_[ide[m]] * sxi); }
        }
#ifdef PEER_DUP_S
        }; qs_(); __builtin_amdgcn_sched_barrier(0); qs_();
#endif
        v4u R0[4], R1[4], R2[4], R3[4];
#define PEER_LOADU(RR, S0) do { const size_t ro_ = (size_t)(Le[(S0)] & (scratch_dst ? PEER_PROBE_MASK : 0xFFFF)) * 512 + 16 * j; _Pragma("unroll") for (int q = 0; q < 4; ++q) RR[q] = *(const GAS v4u*)(EU4 + ro_ + 128 * q); } while (0)
#define PEER_DOTU(RR, EOUT) do { int h0_ = 0, h1_ = 0, l0_ = 0, l1_ = 0; \
            _Pragma("unroll") for (int q = 0; q < 4; q += 2) _Pragma("unroll") for (int w_ = 0; w_ < 4; ++w_) { \
                h0_ = __builtin_amdgcn_sdot8((int)RR[q][w_], xh[4 * q + w_], h0_, false); l0_ = __builtin_amdgcn_sdot8((int)RR[q][w_], xl[4 * q + w_], l0_, false); \
                h1_ = __builtin_amdgcn_sdot8((int)RR[q + 1][w_], xh[4 * q + 4 + w_], h1_, false); l1_ = __builtin_amdgcn_sdot8((int)RR[q + 1][w_], xl[4 * q + 4 + w_], l1_, false); } \
            int e_ = ((h0_ + h1_) << 4) + (l0_ + l1_); e_ = DPP_ADDI(e_, 0xB1, 0xF); e_ = DPP_ADDI(e_, 0x4E, 0xF); e_ = DPP_ADDI(e_, 0x141, 0xF); EOUT = e_; } while (0)
#define PEER_SWEEPU(BODY0, BODY1, BODY2, BODY3) do { \
            PEER_LOADU(R0, 0); PEER_LOADU(R1, 1); PEER_LOADU(R2, 2); PEER_LOADU(R3, 3); \
            for (int s = 0; s < 128; s += 4) { \
                BODY0; if (s + 4 < 128) PEER_LOADU(R0, s + 4); \
                BODY1; if (s + 4 < 128) PEER_LOADU(R1, s + 5); \
                BODY2; if (s + 4 < 128) PEER_LOADU(R2, s + 6); \
                BODY3; if (s + 4 < 128) PEER_LOADU(R3, s + 7); } } while (0)
#define PEER_FIN(RR, SS) do { int e1_; PEER_DOTU(RR, e1_); Lx[(SS)] = e1_; } while (0)
        PEER_SWEEPU(PEER_FIN(R0, s), PEER_FIN(R1, s + 1), PEER_FIN(R2, s + 2), PEER_FIN(R3, s + 3));
#ifdef PEER_DUP_U
        PEER_SWEEPU(PEER_FIN(R0, s), PEER_FIN(R1, s + 1), PEER_FIN(R2, s + 2), PEER_FIN(R3, s + 3));
#endif
#undef PEER_FIN
        float yscale; int csum8;
        {
            float cf_[16]; float cmax = 0.f;
#pragma unroll
            for (int i = 0; i < 16; ++i) { const int ix = 16 * j + i; cf_[i] = Lg[ix] * gelu_cdf((float)Lx[ix] * __builtin_bit_cast(float, Lp[ix])); cmax = fmaxf(cmax, fabsf(cf_[i])); }
            cmax = fmaxf(cmax, __shfl_xor(cmax, 1, 8)); cmax = fmaxf(cmax, __shfl_xor(cmax, 2, 8)); cmax = fmaxf(cmax, __shfl_xor(cmax, 4, 8));
            const float cqs = cmax > 0.f ? 127.f / cmax : 0.f; yscale = cmax > 0.f ? cmax / 127.f : 0.f;
            int pk_[4]; int cs_ = 0;
#pragma unroll
            for (int m = 0; m < 4; ++m) { const int q0 = (int)rintf(cf_[4 * m] * cqs), q1 = (int)rintf(cf_[4 * m + 1] * cqs), q2 = (int)rintf(cf_[4 * m + 2] * cqs), q3 = (int)rintf(cf_[4 * m + 3] * cqs);
                cs_ += (q0 + q1) + (q2 + q3);
                pk_[m] = (int)((unsigned)(q0 & 0xff) | ((unsigned)(q1 & 0xff) << 8) | ((unsigned)(q2 & 0xff) << 16) | ((unsigned)q3 << 24)); }
            cs_ += __shfl_xor(cs_, 1, 8); cs_ += __shfl_xor(cs_, 2, 8); cs_ += __shfl_xor(cs_, 4, 8); csum8 = 8 * cs_;
#pragma unroll
            for (int m = 0; m < 4; ++m) Lp[4 * j + m] = pk_[m];
        }
#ifndef PEER_DUP_V
#define PEER_DUP_V 1
#endif
#pragma unroll
        for (int HH = 0; HH < 2 * PEER_DUP_V; ++HH) { const int H = HH & 1;
            int ya[32], yl[32];
#pragma unroll
            for (int i = 0; i < 32; ++i) { ya[i] = 0; yl[i] = 0; }
            v4u RV[8][2];
#define PEER_ROFFV(S0) ((size_t)(Le[(S0)] & (scratch_dst ? PEER_PROBE_MASK : 0xFFFF)) * 512 + 256 * H + 16 * j)
#pragma unroll
            for (int r = 0; r < 8; ++r) { const size_t ro_ = PEER_ROFFV(r); RV[r][0] = *(const GAS v4u*)(EV4 + ro_); RV[r][1] = *(const GAS v4u*)(EV4 + ro_ + 128); }
            for (int bt = 0; bt < 16; ++bt) {
                const int c0_ = Lp[2 * bt], c1_ = Lp[2 * bt + 1];
                size_t ron[8];
#pragma unroll
                for (int r = 0; r < 8; ++r) ron[r] = (bt + 1 < 16) ? PEER_ROFFV(8 * bt + 8 + r) : 0;
#pragma unroll
                for (int q = 0; q < 2; ++q) {
#pragma unroll
                    for (int hb = 0; hb < 2; ++hb) { const int cq_ = hb ? c1_ : c0_;
#pragma unroll
                        for (int w_ = 0; w_ < 4; ++w_) { const unsigned a0 = RV[4 * hb][q][w_], a1 = RV[4 * hb + 1][q][w_], a2 = RV[4 * hb + 2][q][w_], a3 = RV[4 * hb + 3][q][w_];
                            const unsigned p0 = __builtin_amdgcn_perm(a1, a0, 0x05010400u), p1 = __builtin_amdgcn_perm(a1, a0, 0x07030602u), p2 = __builtin_amdgcn_perm(a3, a2, 0x05010400u), p3 = __builtin_amdgcn_perm(a3, a2, 0x07030602u);
                            unsigned Tb[4]; Tb[0] = __builtin_amdgcn_perm(p2, p0, 0x05040100u); Tb[1] = __builtin_amdgcn_perm(p2, p0, 0x07060302u); Tb[2] = __builtin_amdgcn_perm(p3, p1, 0x05040100u); Tb[3] = __builtin_amdgcn_perm(p3, p1, 0x07060302u);
#pragma unroll
                            for (int b_ = 0; b_ < 4; ++b_) { ya[16 * q + 4 * w_ + b_] = __builtin_amdgcn_sdot4((int)Tb[b_], cq_, ya[16 * q + 4 * w_ + b_], false);
                                yl[16 * q + 4 * w_ + b_] = __builtin_amdgcn_sdot4((int)(Tb[b_] & 0x0F0F0F0Fu), cq_, yl[16 * q + 4 * w_ + b_], false); } } }
                    if (bt + 1 < 16) {
#pragma unroll
                        for (int r = 0; r < 8; ++r) RV[r][q] = *(const GAS v4u*)(EV4 + ron[r] + 128 * q); }
                }
            }
#undef PEER_ROFFV
            int to_ = grp * 8 + g, jo_ = j; asm volatile("" : "+v"(to_), "+v"(jo_));
            const int b = to_ / SEQ; const unsigned eo_ = (unsigned)to_ * D + 128 * H + 8 * jo_;
            const float* g2 = mod_ + b * NMOD + 5120 + 128 * H + 8 * jo_;
            const bf16* ip = X1B_ + eo_; float* op = ((scratch_dst || HH + 2 < 2 * PEER_DUP_V) ? WSP(float, WS_SCORES) : out_) + eo_;
#pragma unroll
            for (int q = 0; q < 2; ++q) { __builtin_amdgcn_sched_barrier(0);
#pragma unroll
                for (int w_ = 0; w_ < 4; ++w_)
#pragma unroll
                    for (int nh = 0; nh < 2; ++nh) { const int co = 256 * (2 * (w_ & 1) + nh) + 64 * q + 4 * (w_ >> 1); const int yb = 16 * q + 4 * w_ + 2 * nh;
                        const unsigned long long xw_ = *(const GAS unsigned long long*)(ip + co); const unsigned xlo_ = (unsigned)xw_, xhi_ = (unsigned)(xw_ >> 32); const f32x4 x1 = (f32x4){bflo(xlo_), bfhi(xlo_), bflo(xhi_), bfhi(xhi_)}; const f32x4 gg = *(const f32x4*)(g2 + co) * yscale;
                        f32x4 o; o.x = x1.x + gg.x * (float)(yl[yb] - csum8); o.y = x1.y + gg.y * (float)((ya[yb] - yl[yb]) >> 4); o.z = x1.z + gg.z * (float)(yl[yb + 1] - csum8); o.w = x1.w + gg.w * (float)((ya[yb + 1] - yl[yb + 1]) >> 4);
                        *(GAS f32x4*)(op + co) = o; } }
        }
#undef PEER_LOADU
#undef PEER_DOTU
#undef PEER_SWEEPU
    }
}

DI void ph_inproj(const Frame& F) {
    pg8::Gemm g{WSP(bf16, WS_XN), WSP(bf16, WS_WIN), T, NPROJ, D}; pg8::StaticOrder S; S.init(T, NPROJ, F.G, (int)blockIdx.x);
    pg8::EpiBf16<0> E{WSP(bf16, WS_PROJ), NPROJ, nullptr, 0, 0, 1.f};
    pg8::gemm_phase<pg8::EpiBf16<0>, pg8::StaticOrder, PG8_ALIGN, PG8_SP2>(F.lds, g, S, E);
}
DI void ph_mix(const Frame& F, bool probe_first) {
    stage_conv_w(F);
    {
        int u = F.vcu;
        MlLocalRegs ra;
        if (u < 2048) ml_local_load(F, u >> 6, u & 63, ra);
        const int gwv = F.vcu * NWAVES + F.wave, NGWv = F.G * NWAVES;
        int eb = 2 * gwv;
        while (u < 2048) {
            const int un = u + F.G;
            MlLocalRegs rb;
            if (un < 2048) ml_local_load(F, un >> 6, un & 63, rb);
            ExpRows2 er; const bool ew = eb < 32768;
            if (ew) exp_load2(F, eb, er);
            ml_local_unit(F, u >> 6, u & 63, ra);
            if (ew) exp_conv2(F, eb, er);
            eb += 2 * NGWv;
            ra = rb; u = un;
        }
        for (; eb < 32768; eb += 2 * NGWv) { ExpRows2 er; exp_load2(F, eb, er); exp_conv2(F, eb, er); }
    }
    (void)probe_first;
}
DI void ph_scan_attn(const Frame& F) {
    ml_scan_phase(F);
    __syncthreads();
    for (int u = F.vcu; u < 1024; u += F.G) { const int qb = 15 - (u >> 6), bh = u & 63; sb_unit(F, bh >> 3, bh & 7, qb); }
}
DI void ph_mlout(const Frame& F) { stage_conv_w(F); for (int u = F.vcu; u < 2048; u += F.G) { const int un = u + F.G; ml_out_unit(F, u >> 6, u & 63, un < 2048 ? (un >> 6) : -1, un & 63); } }
#ifndef P5_ALIGN
#define P5_ALIGN PG8_ALIGN
#endif
DI void ph_outproj(const Frame& F) {
    pg8::Gemm g{WSP(bf16, WS_MIX), WSP(bf16, WS_WOUT), T, D, D}; pg8::StaticOrder S; S.init(T, D, F.G, (int)blockIdx.x);
    pg8::EpiResGateBf16 E{inp(I_X), WSP(pg8::bf16_t, WS_X1B), WSP(float, WS_MOD) + 2048, NMOD, SEQ, D};
    pg8::gemm_phase<pg8::EpiResGateBf16, pg8::StaticOrder, P5_ALIGN, PG8_SP2>(F.lds, g, S, E);
}
DI void ph_scores(const Frame& F) {
    pg8::Gemm g{WSP(bf16, WS_XN), WSP(bf16, WS_WEFF), T, NSC, D}; pg8::StaticOrder S; S.init(T, NSC, F.G, (int)blockIdx.x);
    EpiTopK E{WSP(int, WS_IDX), WSP(float, WS_GATE)};
    pg8::Unit un;
    for (int i = 0; S.next(i, un); ++i) { OneUnit S1{un}; pg8::gemm_phase<EpiTopK, OneUnit, false, PG8_SP2>(F.lds, g, S1, E); }
}
constexpr int N_PHASES = 11;
struct Args { const float* in[19]; float* out; unsigned char* ws; int ph_lo, ph_hi; };
__global__ void __launch_bounds__(NTHR, 2) hybrid_fwd(Args args) {
    extern __shared__ __attribute__((aligned(16))) unsigned char lds_raw[];
    Frame F;
    F.lds = (LAS unsigned char*)lds_raw;
    F.MISC = (volatile LAS unsigned*)(F.lds + LDSCTL_OFF + 320);
    F.tid = threadIdx.x; F.lane = F.tid & 63; F.wave = __builtin_amdgcn_readfirstlane(F.tid >> 6);
    F.G = gridDim.x; { const int bx = blockIdx.x; F.vcu = (F.G % 8 == 0) ? (bx % 8) * (F.G / 8) + bx / 8 : bx; }
    F.ws = args.ws;
    F.ctl = (gu32*)(F.ws + WS_CTL);
    for (int u = F.tid; u < (LDS_BYTES - LDSCTL_OFF) / 4; u += NTHR) ((LAS unsigned*)(F.lds + LDSCTL_OFF))[u] = 0u;
    __syncthreads();
    const int lo = args.ph_lo, hi = args.ph_hi;
    const bool one_launch = (hi - lo) > 1;
    XcdBarrier bar; bar.bar = (unsigned*)(F.ctl + CW_BAR); bar.x = 0; bar.st = nullptr;
    if (one_launch) bar = xcd_barrier_post((unsigned*)(F.ctl + CW_BAR), F.MISC + 8);
#ifndef PHMASK
#define PHMASK 0x7ff
#endif
#define IN(k) (((PHMASK >> (k)) & 1) && lo <= (k) && (k) < hi)
#define SEAM(k) do { if (IN(k) && IN((k) + 1)) xcd_barrier(bar); } while (0)
#ifndef REPMASK
#define REPMASK 0
#endif

#define RUN(k, ...) do { if (IN(k)) { if ((REPMASK >> (k)) & 1) { { const bool first = true; (void)first; __VA_ARGS__; } xcd_barrier(bar); } { const bool first = false; (void)first; __VA_ARGS__; } } } while (0)
    RUN(0, p0_phase(F, first ? P0_PARTS : 15)); SEAM(0);
    RUN(1, norm_phase<true>(F, inp(I_X), inp(I_GN1), 0, 1024)); SEAM(1);
    RUN(2, ph_inproj(F)); SEAM(2);
    RUN(3, ph_mix(F, first)); SEAM(3);
    RUN(10, ph_scan_attn(F)); if (IN(10) && IN(4)) xcd_barrier(bar);
    RUN(4, ph_mlout(F)); SEAM(4);
    RUN(5, ph_outproj(F)); SEAM(5);
    RUN(6, norm_phase<false, true>(F, (const float*)WSP(bf16, WS_X1B), inp(I_GN2), 3072, 4096)); SEAM(6);
    RUN(7, ph_scores(F)); if (IN(7) && IN(9)) xcd_barrier(bar);
    RUN(9, peer_phase(F, first));
#undef RUN
#undef IN
#undef SEAM
}

#ifndef MK_PER_PHASE
#define MK_PER_PHASE 0
#endif
extern "C" void kernel_launch(void* const* d_in, const int* in_sizes, int n_in, void* d_out, int out_size, void* d_ws, size_t ws_size, hipStream_t stream) {
    static int grid = 0;
    if (grid == 0) {
        if (n_in != 19 || in_sizes[0] != T * D || out_size != T * D || ws_size < WS_END) { fprintf(stderr, "kernel_launch: unexpected shapes (n_in %d, in0 %d, out %d, ws %zu)\n", n_in, n_in > 0 ? in_sizes[0] : -1, out_size, ws_size); grid = -1; return; }
        int dev = 0, cus = 0, per_cu = 0;
        if (hipGetDevice(&dev) != hipSuccess || hipDeviceGetAttribute(&cus, hipDeviceAttributeMultiprocessorCount, dev) != hipSuccess) { grid = -1; return; }
        if (hipFuncSetAttribute((const void*)hybrid_fwd, hipFuncAttributeMaxDynamicSharedMemorySize, LDS_BYTES) != hipSuccess) { fprintf(stderr, "kernel_launch: hipFuncSetAttribute failed\n"); grid = -1; return; }
        if (hipOccupancyMaxActiveBlocksPerMultiprocessor(&per_cu, (const void*)hybrid_fwd, NTHR, LDS_BYTES) != hipSuccess || per_cu < 1) fprintf(stderr, "kernel_launch: occupancy query says %d\n", per_cu);
        (void)hipGetLastError();
        grid = cus;
    }
    if (grid < 0) return;
    if (hipMemsetAsync((char*)d_ws + WS_CTL, 0, CTL_ZERO_BYTES, stream) != hipSuccess) { fprintf(stderr, "kernel_launch: memset failed\n"); return; }
    Args a{};
    for (int i = 0; i < 19; ++i) a.in[i] = (const float*)d_in[i];
    a.out = (float*)d_out; a.ws = (unsigned char*)d_ws;
#if MK_PER_PHASE
    { const int order[N_PHASES] = {0, 1, 2, 3, 10, 4, 5, 6, 7, 8, 9}; for (int i = 0; i < N_PHASES; ++i) { a.ph_lo = order[i]; a.ph_hi = order[i] + 1; hipLaunchKernelGGL(hybrid_fwd, dim3(grid), dim3(NTHR), LDS_BYTES, stream, a); } }
#else
    a.ph_lo = 0; a.ph_hi = N_PHASES;
    hipLaunchKernelGGL(hybrid_fwd, dim3(grid), dim3(NTHR), LDS_BYTES, stream, a);
#endif
    const hipError_t le = hipPeekAtLastError();
    if (le != hipSuccess) fprintf(stderr, "kernel_launch: launch failed: %s\n", hipGetErrorName(le));
}
```

```cpp
#include <cmath>
#include <hip/hip_runtime.h>
#include <cstdio>
#include <cstdint>
namespace pg8 {
#define PG8_LAS __attribute__((address_space(3)))
typedef unsigned short bf16_t;
typedef short bf16x8 __attribute__((ext_vector_type(8)));
typedef float f32x4 __attribute__((ext_vector_type(4)));
typedef unsigned u32x4 __attribute__((ext_vector_type(4)));
constexpr int BM = 256, BK = 64, HALF = 128, HTB = HALF * BK * 2  , STAGE_BYTES = 8 * HTB, NXCD = 8,
#ifndef PG8_WGM
#define PG8_WGM 4
#endif
WGM = PG8_WGM;

__host__ __device__ __forceinline__ int lds_byte(int r, int c) { const int st = (r >> 4) * 2 + (c >> 5), rr = r & 15, cc = c & 31, ob = rr * 64 + cc * 2; return st * 1024 + (ob ^ (((ob >> 9) & 1) << 5)); }
__host__ __device__ __forceinline__ void stage_rc(int b, int& R, int& C) { const int st = b / 1024, sb = b % 1024, swz = sb ^ (((sb >> 9) & 1) << 5); R = (st >> 1) * 16 + swz / 64; C = (st & 1) * 32 + (swz % 64) / 2; }
__host__ __device__ __forceinline__ int perm32(int rho) { const int n = rho >> 4, i = rho & 15; return 8 * (i >> 2) + 4 * n + (i & 3); }

struct Unit { int pm, pn; };
struct Gemm { const bf16_t* A; const bf16_t* Bt; int M, N, K; };

struct StaticOrder {
    int nM, nN, nwg, G, c;
    __host__ __device__ void init(int M, int N, int G_, int c_) { nM = M / BM; nN = N / BM; nwg = nM * nN; G = G_; c = c_; }
    __host__ __device__ bool next(int i, Unit& u) const {
        const long L = (long)i * G + c; if (L >= nwg) return false;
        int wgid = (int)L; { const int q = nwg / NXCD, r = nwg % NXCD, xcd = wgid % NXCD, off = wgid / NXCD; wgid = (xcd < r ? xcd * (q + 1) : r * (q + 1) + (xcd - r) * q) + off; }
        const int nig = WGM * nN, gid = wgid / nig, fm = gid * WGM, gsz = (nM - fm) < WGM ? (nM - fm) : WGM;
        u.pm = fm + ((wgid % nig) % gsz); u.pn = (wgid % nig) / gsz; return true;
    }
    __device__ __forceinline__ void a_ready(const Unit&) const {}
    __device__ __forceinline__ void done(const Unit&) const {}
};

__device__ __forceinline__ unsigned cvt_pk_bf16(float lo, float hi) { unsigned r; asm volatile("v_cvt_pk_bf16_f32 %0, %1, %2" : "=v"(r) : "v"(lo), "v"(hi)); return r; }
typedef float f32x2 __attribute__((ext_vector_type(2)));
__device__ __forceinline__ f32x2 gelu_pk(f32x2 v) {
    const f32x2 av = __builtin_elementwise_abs(v), d = av * 0.2316418882f + 1.0f;
    f32x2 t; t.x = __builtin_amdgcn_rcpf(d.x); t.y = __builtin_amdgcn_rcpf(d.y);
    f32x2 q = t * 0.5307027145f + (-0.7265760135f); q = q * t + 0.7107068705f; q = q * t + (-0.142248368f); q = q * t + 0.127414796f; q = q * t;
    const f32x2 s = (v * v) * (-0.72134752044f);
    f32x2 e; e.x = __builtin_amdgcn_exp2f(s.x); e.y = __builtin_amdgcn_exp2f(s.y);
    const f32x2 m = v * (q * e), r = v - m;
    f32x2 o; o.x = v.x < 0.f ? m.x : r.x; o.y = v.y < 0.f ? m.y : r.y; return o;
}

template <int ACT  > struct EpiBf16 {
    static constexpr bool PERM = true, AFTER_DRAIN = false; static_assert(ACT == 0 || ACT == 1, "EpiBf16: ACT is 0 (none) or 1 (gelu_pk)");
    bf16_t* O; int ldc; const float* bias; int split_cols; size_t split_stride; float scale0;
    __device__ __forceinline__ void operator()(const f32x4 (&acc)[2][2][4][2], const Unit& u, int wr, int wc, int fr, int fq) const {
        const int row0 = u.pm * BM + wr * 64 + fr; int colt = u.pn * BM; bf16_t* base = O;
        float sc = 1.f; if (split_cols) { const int t = colt / split_cols; base += (size_t)t * split_stride; colt -= t * split_cols; if (t == 0) sc = scale0; }
        const int col0 = colt + wc * 32 + 8 * fq, bcol0 = u.pn * BM + wc * 32 + 8 * fq;
        f32x4 bv[2][2];
#pragma unroll
        for (int bj = 0; bj < 2; ++bj)
#pragma unroll
            for (int n = 0; n < 2; ++n) bv[bj][n] = bias ? *(const f32x4*)(bias + bcol0 + bj * HALF + 4 * n) : (f32x4){0.f, 0.f, 0.f, 0.f};
#pragma unroll
        for (int ai = 0; ai < 2; ++ai)
#pragma unroll
            for (int m = 0; m < 4; ++m) { bf16_t* rowp = base + (size_t)(row0 + ai * HALF + m * 16) * ldc + col0;
#pragma unroll
                for (int bj = 0; bj < 2; ++bj) { f32x4 v0 = acc[ai][bj][m][0] + bv[bj][0], v1 = acc[ai][bj][m][1] + bv[bj][1];
                    if (ACT == 1) { f32x2 a = gelu_pk((f32x2){v0[0], v0[1]}), b = gelu_pk((f32x2){v0[2], v0[3]}), c = gelu_pk((f32x2){v1[0], v1[1]}), d = gelu_pk((f32x2){v1[2], v1[3]});
                        v0 = (f32x4){a.x, a.y, b.x, b.y}; v1 = (f32x4){c.x, c.y, d.x, d.y}; }
                    v0 = v0 * sc; v1 = v1 * sc; u32x4 w; w.x = cvt_pk_bf16(v0[0], v0[1]); w.y = cvt_pk_bf16(v0[2], v0[3]); w.z = cvt_pk_bf16(v1[0], v1[1]); w.w = cvt_pk_bf16(v1[2], v1[3]);
                    *(u32x4*)(rowp + bj * HALF) = w; } }
    }
};
template <class Epi, class Sched, bool ALIGN_EPI = false, bool SP2 = false>
__device__ __forceinline__ void gemm_phase(PG8_LAS unsigned char* lds, const Gemm g, const Sched& S, const Epi& E) {
    const int tid = threadIdx.x, wid = __builtin_amdgcn_readfirstlane(tid >> 6), lane = tid & 63, wr = wid >> 2, wc = wid & 3, fr = lane & 15, fq = lane >> 4;
    const int K = g.K, nt = K / BK;
    unsigned voffA[2], voffB[2];
#pragma unroll
    for (int i = 0; i < 2; ++i) { int R, C; stage_rc(tid * 16 + i * 8192, R, C); const int Rb = Epi::PERM ? ((R & ~31) + perm32(R & 31)) : R;
        voffA[i] = (unsigned)(R * K + C) * 2u; voffB[i] = (unsigned)(Rb * K + C) * 2u; }
    const size_t kstep = (size_t)(BK * 2);
    const size_t hstep = (size_t)HALF * K * 2;
    const size_t tstep = 2 * hstep;
    const unsigned ldsw = (unsigned)wid * 1024u;
    const int aoff = lds_byte(wr * 64 + fr, fq * 8), boff = lds_byte(wc * 32 + fr, fq * 8);
#define PG8_SA(b, h) (((b) * 2 + (h)) * HTB)
#define PG8_SB(b, h) ((4 + (b) * 2 + (h)) * HTB)
#define PG8_STAGE(bufoff, gbase, voff) do { _Pragma("unroll") for (int _i = 0; _i < 2; ++_i) \
        __builtin_amdgcn_global_load_lds((const unsigned*)((const char*)(gbase) + (voff)[_i]), (PG8_LAS unsigned*)(lds + (bufoff) + ldsw + _i * 8192), 16, 0, 0); } while (0)
#define PG8_LDA(dst, b, h) do { _Pragma("unroll") for (int m = 0; m < 4; ++m) _Pragma("unroll") for (int k = 0; k < 2; ++k) dst[m][k] = *(const PG8_LAS bf16x8*)(lds + PG8_SA(b, h) + aoff + m * 2048 + k * 1024); } while (0)
#define PG8_LDB(dst, b, h) do { _Pragma("unroll") for (int n = 0; n < 2; ++n) _Pragma("unroll") for (int k = 0; k < 2; ++k) dst[n][k] = *(const PG8_LAS bf16x8*)(lds + PG8_SB(b, h) + boff + n * 2048 + k * 1024); } while (0)
#define PG8_MMA(ai, bj, At, Bt) do { __builtin_amdgcn_s_setprio(1); _Pragma("unroll") for (int m = 0; m < 4; ++m) _Pragma("unroll") for (int n = 0; n < 2; ++n) _Pragma("unroll") for (int k = 0; k < 2; ++k) \
        acc[ai][bj][m][n] = __builtin_amdgcn_mfma_f32_16x16x32_bf16(Bt[n][k], At[m][k], acc[ai][bj][m][n], 0, 0, 0); __builtin_amdgcn_s_setprio(0); } while (0)
#define PG8_WAIT_V(n) asm volatile("s_waitcnt vmcnt(" #n ")" ::: "memory")
#define PG8_WAIT_L(n) asm volatile("s_waitcnt lgkmcnt(" #n ")" ::: "memory")
#define PG8_BAR __builtin_amdgcn_s_barrier()
#define PG8_SCHED __builtin_amdgcn_sched_barrier(0)
    Unit cur, nxt; int ui = 0;
    if (!S.next(0, cur)) return;
    f32x4 acc[2][2][4][2];
#pragma unroll
    for (int a = 0; a < 2; ++a)
#pragma unroll
        for (int b = 0; b < 2; ++b)
#pragma unroll
            for (int m = 0; m < 4; ++m)
#pragma unroll
                for (int n = 0; n < 2; ++n) acc[a][b][m][n] = (f32x4){0.f, 0.f, 0.f, 0.f};
    bf16x8 At[4][2], B0[2][2], B1[2][2];
    const char* cA = (const char*)g.A + (size_t)cur.pm * tstep; const char* cB = (const char*)g.Bt + (size_t)cur.pn * tstep;
    S.a_ready(cur);
    if constexpr (SP2) {
        PG8_STAGE(PG8_SB(0, 0), cB, voffB); PG8_STAGE(PG8_SB(0, 1), cB + hstep, voffB); PG8_STAGE(PG8_SA(0, 0), cA, voffA); PG8_STAGE(PG8_SA(0, 1), cA + hstep, voffA);
        if (wr == 1) PG8_BAR;
        PG8_WAIT_V(2); PG8_BAR;
        PG8_STAGE(PG8_SB(1, 0), cB + kstep, voffB); PG8_STAGE(PG8_SA(1, 0), cA + kstep, voffA); PG8_STAGE(PG8_SB(1, 1), cB + hstep + kstep, voffB);
        PG8_WAIT_V(6); PG8_BAR;
    } else {
        PG8_STAGE(PG8_SB(0, 0), cB, voffB); PG8_STAGE(PG8_SA(0, 0), cA, voffA); PG8_STAGE(PG8_SB(0, 1), cB + hstep, voffB); PG8_STAGE(PG8_SA(0, 1), cA + hstep, voffA);
        if (wr == 1) PG8_BAR;
        PG8_WAIT_V(4); PG8_BAR;
        PG8_STAGE(PG8_SB(1, 0), cB + kstep, voffB); PG8_STAGE(PG8_SA(1, 0), cA + kstep, voffA); PG8_STAGE(PG8_SB(1, 1), cB + hstep + kstep, voffB);
        PG8_WAIT_V(6); PG8_BAR;
    }
    for (;;) {
        const bool has_next = S.next(ui + 1, nxt);
        const char* nA = has_next ? (const char*)g.A + (size_t)nxt.pm * tstep : cA; const char* nB = has_next ? (const char*)g.Bt + (size_t)nxt.pn * tstep : cB;
        for (int t = 0; t < nt; t += 2) {
            const bool last = (t == nt - 2);
            const char* a1 = cA + (size_t)(t + 1) * kstep;
            const char* a2 = last ? nA : cA + (size_t)(t + 2) * kstep; const char* b2 = last ? nB : cB + (size_t)(t + 2) * kstep;
            const char* a3 = a2 + kstep; const char* b3 = b2 + kstep;
            if (last && has_next) S.a_ready(nxt);
            if constexpr (SP2) {
            PG8_LDB(B0, 0, 0); PG8_LDB(B1, 0, 1); PG8_SCHED; PG8_LDA(At, 0, 0); PG8_STAGE(PG8_SA(1, 1), a1 + hstep, voffA);
            PG8_WAIT_V(8); PG8_WAIT_L(0); PG8_BAR; PG8_MMA(0, 0, At, B0); PG8_MMA(0, 1, At, B1); PG8_BAR; PG8_SCHED;
            PG8_LDA(At, 0, 1); PG8_STAGE(PG8_SB(0, 0), b2, voffB); PG8_STAGE(PG8_SB(0, 1), b2 + hstep, voffB); PG8_STAGE(PG8_SA(0, 0), a2, voffA);
            PG8_WAIT_V(8); PG8_WAIT_L(0); PG8_BAR; PG8_MMA(1, 0, At, B0); PG8_MMA(1, 1, At, B1); PG8_BAR; PG8_SCHED;
            PG8_LDB(B0, 1, 0); PG8_LDB(B1, 1, 1); PG8_SCHED; PG8_LDA(At, 1, 0); PG8_STAGE(PG8_SA(0, 1), a2 + hstep, voffA);
            PG8_WAIT_V(8); PG8_WAIT_L(0); PG8_BAR; PG8_MMA(0, 0, At, B0); PG8_MMA(0, 1, At, B1); PG8_BAR; PG8_SCHED;
            PG8_LDA(At, 1, 1); PG8_STAGE(PG8_SB(1, 0), b3, voffB); PG8_STAGE(PG8_SB(1, 1), b3 + hstep, voffB); PG8_STAGE(PG8_SA(1, 0), a3, voffA);
            PG8_WAIT_V(8); PG8_WAIT_L(0); PG8_BAR; PG8_MMA(1, 0, At, B0); PG8_MMA(1, 1, At, B1); PG8_BAR; PG8_SCHED;
            } else {
            PG8_LDB(B0, 0, 0); PG8_SCHED; PG8_LDA(At, 0, 0); PG8_STAGE(PG8_SA(1, 1), a1 + hstep, voffA);
            PG8_WAIT_L(8); PG8_BAR; PG8_WAIT_L(0); PG8_MMA(0, 0, At, B0); PG8_BAR; PG8_SCHED;
            PG8_LDB(B1, 0, 1); PG8_STAGE(PG8_SB(0, 0), b2, voffB);
            PG8_BAR; PG8_WAIT_L(0); PG8_MMA(0, 1, At, B1); PG8_BAR;
            PG8_LDA(At, 0, 1); PG8_STAGE(PG8_SA(0, 0), a2, voffA);
            PG8_BAR; PG8_WAIT_L(0); PG8_MMA(1, 0, At, B0); PG8_BAR; PG8_SCHED;
            PG8_STAGE(PG8_SB(0, 1), b2 + hstep, voffB);
            PG8_WAIT_V(6); PG8_BAR; PG8_MMA(1, 1, At, B1); PG8_BAR;
            PG8_LDB(B0, 1, 0); PG8_SCHED; PG8_LDA(At, 1, 0); PG8_STAGE(PG8_SA(0, 1), a2 + hstep, voffA);
            PG8_WAIT_L(8); PG8_BAR; PG8_WAIT_L(0); PG8_MMA(0, 0, At, B0); PG8_BAR; PG8_SCHED;
            PG8_LDB(B1, 1, 1); PG8_STAGE(PG8_SB(1, 0), b3, voffB);
            PG8_BAR; PG8_WAIT_L(0); PG8_MMA(0, 1, At, B1); PG8_BAR;
            PG8_LDA(At, 1, 1); PG8_STAGE(PG8_SA(1, 0), a3, voffA);
            PG8_BAR; PG8_WAIT_L(0); PG8_MMA(1, 0, At, B0); PG8_BAR; PG8_SCHED;
            PG8_STAGE(PG8_SB(1, 1), b3 + hstep, voffB);
            PG8_WAIT_V(6); PG8_BAR; PG8_MMA(1, 1, At, B1); PG8_BAR;
            }
        }
        if constexpr (ALIGN_EPI) { if (wr == 0) PG8_BAR; }
        if constexpr (!Epi::AFTER_DRAIN) { E(acc, cur, wr, wc, fr, fq); S.done(cur); }
        if (!has_next) break;
#pragma unroll
        for (int a = 0; a < 2; ++a)
#pragma unroll
            for (int b = 0; b < 2; ++b)
#pragma unroll
                for (int m = 0; m < 4; ++m)
#pragma unroll
                    for (int n = 0; n < 2; ++n) acc[a][b][m][n] = (f32x4){0.f, 0.f, 0.f, 0.f};
        cur = nxt; cA = nA; cB = nB; ++ui;
        if constexpr (ALIGN_EPI) { if (wr == 1) PG8_BAR; }
    }
    PG8_WAIT_V(0);
    if constexpr (!ALIGN_EPI) { if (wr == 0) PG8_BAR; }
    PG8_BAR;
    if constexpr (Epi::AFTER_DRAIN) { E.fused(acc, cur, wr, wc, fr, fq, lds, wid, lane); S.done(cur); }
#undef PG8_SA
#undef PG8_SB
#undef PG8_STAGE
#undef PG8_LDA
#undef PG8_LDB
#undef PG8_MMA
#undef PG8_WAIT_V
#undef PG8_WAIT_L
#undef PG8_BAR
#undef PG8_SCHED
}
}

#ifndef PG8_SP2
#define PG8_SP2 true
#endif
#ifndef PG8_ALIGN
#define PG8_ALIGN true
#endif

namespace pg8 {
struct EpiResGate {
    static constexpr bool PERM = false, AFTER_DRAIN = false;
    const float* base; float* out; const float* gate; int gate_ld; int rows_per_batch; int ldc;
    __device__ __forceinline__ void operator()(const f32x4 (&acc)[2][2][4][2], const Unit& u, int wr, int wc, int fr, int fq) const {
        const int row0 = u.pm * BM + wr * 64 + fr, col0 = u.pn * BM + wc * 32 + 4 * fq;
        const float* gp = gate + (size_t)((u.pm * BM) / rows_per_batch) * gate_ld + col0;
        f32x4 gv[2][2];
#pragma unroll
        for (int bj = 0; bj < 2; ++bj)
#pragma unroll
            for (int n = 0; n < 2; ++n) gv[bj][n] = *(const f32x4*)(gp + bj * HALF + n * 16);
#pragma unroll
        for (int ai = 0; ai < 2; ++ai)
#pragma unroll
            for (int m = 0; m < 4; ++m) { const size_t off = (size_t)(row0 + ai * HALF + m * 16) * ldc + col0;
#pragma unroll
                for (int bj = 0; bj < 2; ++bj)
#pragma unroll
                    for (int n = 0; n < 2; ++n) { const f32x4 bs = *(const f32x4*)(base + off + bj * HALF + n * 16);
                        *(f32x4*)(out + off + bj * HALF + n * 16) = bs + gv[bj][n] * acc[ai][bj][m][n]; } }
    }
};
struct EpiResGateBf16 {
    static constexpr bool PERM = false, AFTER_DRAIN = false;
    const float* base; bf16_t* out; const float* gate; int gate_ld; int rows_per_batch; int ldc;
    __device__ __forceinline__ void operator()(const f32x4 (&acc)[2][2][4][2], const Unit& u, int wr, int wc, int fr, int fq) const {
        const int row0 = u.pm * BM + wr * 64 + fr, col0 = u.pn * BM + wc * 32 + 4 * fq;
        const float* gp = gate + (size_t)((u.pm * BM) / rows_per_batch) * gate_ld + col0;
        f32x4 gv[2][2];
#pragma unroll
        for (int bj = 0; bj < 2; ++bj)
#pragma unroll
            for (int n = 0; n < 2; ++n) gv[bj][n] = *(const f32x4*)(gp + bj * HALF + n * 16);
#pragma unroll
        for (int ai = 0; ai < 2; ++ai)
#pragma unroll
            for (int m = 0; m < 4; ++m) { const size_t off = (size_t)(row0 + ai * HALF + m * 16) * ldc + col0;
#pragma unroll
                for (int bj = 0; bj < 2; ++bj)
#pragma unroll
                    for (int n = 0; n < 2; ++n) { const f32x4 bs = __builtin_nontemporal_load((const f32x4*)(base + off + bj * HALF + n * 16)); const f32x4 r = bs + gv[bj][n] * acc[ai][bj][m][n];
                        *(unsigned long long*)(out + off + bj * HALF + n * 16) = (unsigned long long)cvt_pk_bf16(r.x, r.y) | ((unsigned long long)cvt_pk_bf16(r.z, r.w) << 32); } }
    }
};
struct EpiF32 {
    static constexpr bool PERM = false, AFTER_DRAIN = false;
    float* O; int ldc;
    __device__ __forceinline__ void operator()(const f32x4 (&acc)[2][2][4][2], const Unit& u, int wr, int wc, int fr, int fq) const {
        const int row0 = u.pm * BM + wr * 64 + fr, col0 = u.pn * BM + wc * 32 + 4 * fq;
#pragma unroll
        for (int ai = 0; ai < 2; ++ai)
#pragma unroll
            for (int m = 0; m < 4; ++m) { const size_t off = (size_t)(row0 + ai * HALF + m * 16) * ldc + col0;
#pragma unroll
                for (int bj = 0; bj < 2; ++bj)
#pragma unroll
                    for (int n = 0; n < 2; ++n) *(f32x4*)(O + off + bj * HALF + n * 16) = acc[ai][bj][m][n]; }
    }
};
}
#define GAS __attribute__((address_space(1)))
#define LAS __attribute__((address_space(3)))
typedef unsigned short bf16;
typedef unsigned v4u __attribute__((ext_vector_type(4)));
typedef float f32x4 __attribute__((ext_vector_type(4)));
typedef short bf16x8 __attribute__((ext_vector_type(8)));
typedef GAS unsigned gu32;
typedef GAS unsigned long long gu64;
#define RLX_AGENT __ATOMIC_RELAXED, __HIP_MEMORY_SCOPE_AGENT
#define LDS_WAIT() asm volatile("s_waitcnt lgkmcnt(0)" ::: "memory")
#define VM_WAIT() asm volatile("s_waitcnt vmcnt(0)" ::: "memory")
__device__ __forceinline__ unsigned long long rt() { return __builtin_amdgcn_s_memrealtime(); }
__device__ __forceinline__ unsigned f2bf(float f) { unsigned u = __builtin_bit_cast(unsigned, f); return (u + 0x7fffu + ((u >> 16) & 1u)) >> 16; }
__device__ __forceinline__ unsigned pk2(float lo, float hi) { return f2bf(lo) | (f2bf(hi) << 16); }

#define XB_TMO      128
#define XB_XCNT(j)  (256  + 64 * (j))
#define XB_XSUB(j)  (1280 + 64 * (j))
#define XB_XGEN(j)  (2304 + 64 * (j))
#define XB_TOP      3328
#define XB_TOPGEN   3392
#define XCD_BAR_WORDS 3456
#define XB_SPIN_CAP (1u << 24)

__device__ __forceinline__ unsigned xb_ld(unsigned* p)              { return __hip_atomic_load(p, __ATOMIC_RELAXED, __HIP_MEMORY_SCOPE_AGENT); }
__device__ __forceinline__ unsigned xb_add(unsigned* p, unsigned v) { return __hip_atomic_fetch_add(p, v, __ATOMIC_RELAXED, __HIP_MEMORY_SCOPE_AGENT); }
__device__ __forceinline__ unsigned xb_xcc_id() { return (unsigned)__builtin_amdgcn_s_getreg((3 << 11) | 20) & 0xFu; }
#define XB_SPIN(cond, bar) do { unsigned _sp = 0; while (cond) { __builtin_amdgcn_s_sleep(1); \
    if ((++_sp & 255u) == 0u) { if (xb_ld(&(bar)[XB_TMO])) break; if (_sp > XB_SPIN_CAP) { atomicAdd(&(bar)[XB_TMO], 1u); break; } } } } while (0)

struct XcdBarrier {
    unsigned* bar; unsigned x;
    volatile LAS unsigned* st;
};

__device__ __forceinline__ XcdBarrier xcd_barrier_post(unsigned* bar, volatile LAS unsigned* st) {
    XcdBarrier b; b.bar = bar; b.x = xb_xcc_id(); b.st = st;
    if (threadIdx.x == 0) (void)xb_add(&bar[XB_XCNT(b.x)], 1u);
    return b;
}
__device__ __forceinline__ void xcd_barrier_complete(unsigned* bar, unsigned x, unsigned& nloc, unsigned& nx) {
    const unsigned G = gridDim.x * gridDim.y * gridDim.z;
    unsigned sum, cnt, mine, sp = 0u;
    for (;;) {
        sum = 0u; cnt = 0u; mine = 0u;
#pragma unroll
        for (unsigned j = 0; j < 16; ++j) { const unsigned c = xb_ld(&bar[XB_XCNT(j)]); sum += c; cnt += (c > 0u) ? 1u : 0u; mine = (j == x) ? c : mine; }
        if (sum == G) break;
        __builtin_amdgcn_s_sleep(1);
        if ((++sp & 255u) == 0u) { if (xb_ld(&bar[XB_TMO])) break; if (sp > XB_SPIN_CAP) { atomicAdd(&bar[XB_TMO], 1u); break; } }
    }
    nloc = mine > 0u ? mine : 1u; nx = cnt > 0u ? cnt : 1u;
}

__device__ __forceinline__ void xcd_barrier(const XcdBarrier& b) {
    asm volatile("s_waitcnt vmcnt(0)" ::: "memory");
    __syncthreads();
    if (threadIdx.x == 0) {
        unsigned* bar = b.bar;
        __builtin_amdgcn_s_waitcnt(0);
        unsigned nloc = b.st[0], nx = b.st[1];
        if (nloc == 0u) { xcd_barrier_complete(bar, b.x, nloc, nx); b.st[0] = nloc; b.st[1] = nx; }
        const unsigned old = xb_add(&bar[XB_XSUB(b.x)], 1u);
        const unsigned gen = old / nloc;
        if (old + 1u == (gen + 1u) * nloc) {
            __builtin_amdgcn_fence(__ATOMIC_RELEASE, "agent");
            asm volatile("s_waitcnt vmcnt(0)" ::: "memory");
            const unsigned og = xb_add(&bar[XB_TOP], 1u);
            const unsigned tg = og / nx;
            if (og + 1u == (tg + 1u) * nx) xb_add(&bar[XB_TOPGEN], 1u);
            else XB_SPIN(xb_ld(&bar[XB_TOPGEN]) == tg, bar);
            __builtin_amdgcn_fence(__ATOMIC_ACQUIRE, "agent");
            xb_add(&bar[XB_XGEN(b.x)], 1u);
            asm volatile("s_waitcnt vmcnt(0)" ::: "memory");
        } else {
            XB_SPIN(xb_ld(&bar[XB_XGEN(b.x)]) == gen, bar);
            __builtin_amdgcn_fence(__ATOMIC_ACQUIRE, "agent");
            asm volatile("s_waitcnt vmcnt(0)" ::: "memory");
        }
    }
    __syncthreads();
}

constexpr int NWAVES = 8, NTHR = 512;
constexpr int NB = 8, SEQ = 4096, T = NB * SEQ, D = 1024, NPROJ = 3584, NIN = 3592, NMOD = 6144, NSC = 2048;
constexpr int C_QSB = 0, C_KSB = 512, C_VSB = 1024, C_QML = 1536, C_KML = 2048, C_VML = 2560, C_OML = 3072;
constexpr float EPS = 1e-6f, LOG2E = 1.4426950408889634f;
constexpr size_t MiB = 1u << 20;
constexpr size_t WS_CTL = 0, CTL_ZERO_BYTES = 1 * MiB;
constexpr size_t WS_MOD = 256 * 1024;
constexpr size_t WS_WIN = 2 * MiB, WS_WOUT = 10 * MiB, WS_WEFF = 12 * MiB;
constexpr size_t WS_XN = 16 * MiB;
constexpr size_t WS_PROJ = 80 * MiB;
constexpr size_t WS_MIX = 304 * MiB;
constexpr size_t WS_EXPU = 368 * MiB, WS_EXPV = 400 * MiB;
constexpr size_t WS_CST = 432 * MiB;
constexpr size_t WS_NST = 496 * MiB;
constexpr size_t WS_MST = 497 * MiB;
constexpr size_t WS_GATES = 498 * MiB;
constexpr size_t WS_XQ = 272 * MiB;
constexpr size_t WS_XS = 499 * MiB + 256 * 1024;
constexpr size_t WS_X1B = 208 * MiB;
constexpr size_t WS_SCORES = 80 * MiB;
constexpr size_t WS_IDX = 336 * MiB, WS_GATE = 352 * MiB;
constexpr size_t WS_SCL = 499 * MiB;
constexpr size_t WS_SUI = 499 * MiB + 65536, WS_SVI = 499 * MiB + 131072;
constexpr size_t WS_END = 500 * MiB;
constexpr int CW_Q3 = 64;
constexpr int CW_BAR = 4096;
constexpr int LDS_BYTES = 147456, LDSCTL_OFF = 143360;

typedef float f32x16 __attribute__((ext_vector_type(16)));
typedef float f32x2_t __attribute__((ext_vector_type(2)));
typedef __bf16 bf16x2_t __attribute__((ext_vector_type(2)));
typedef _Float16 f16x8 __attribute__((ext_vector_type(8)));
typedef short s16x4 __attribute__((ext_vector_type(4)));
typedef unsigned u32x2 __attribute__((ext_vector_type(2)));
#define DI __device__ __forceinline__
DI unsigned cvtpk(float lo, float hi) { f32x2_t v = {lo, hi}; bf16x2_t b = __builtin_convertvector(v, bf16x2_t); return __builtin_bit_cast(unsigned, b); }
DI float bflo(unsigned u) { return __uint_as_float(u << 16); }
DI float bfhi(unsigned u) { return __uint_as_float(u & 0xffff0000u); }
DI int crow(int i, int hi) { return (i & 3) + 8 * (i >> 2) + 4 * hi; }
DI int krow(int s, int hi, int j) { return 16 * s + 8 * (j >> 2) + 4 * hi + (j & 3); }
DI float swap_add(float v) { auto rr = __builtin_amdgcn_permlane32_swap(__float_as_uint(v), __float_as_uint(v), false, false); return __uint_as_float(rr[0]) + __uint_as_float(rr[1]); }
DI float swap_max(float v) { auto rr = __builtin_amdgcn_permlane32_swap(__float_as_uint(v), __float_as_uint(v), false, false); return fmaxf(__uint_as_float(rr[0]), __uint_as_float(rr[1])); }
DI float dot2bf(unsigned a, unsigned b, float acc) { return __builtin_amdgcn_fdot2_f32_bf16(__builtin_bit_cast(bf16x2_t, a), __builtin_bit_cast(bf16x2_t, b), acc, false); }
DI float ex2(float x) { return __builtin_amdgcn_exp2f(x); }
DI float lg2(float x) { return __builtin_amdgcn_logf(x); }
DI float fexp(float x) { return __builtin_amdgcn_exp2f(x * LOG2E); }
DI float wave_sum(float v) {
#pragma unroll
    for (int o = 1; o < 64; o <<= 1) v += __shfl_xor(v, o);
    return v;
}
DI float wave_max(float v) {
#pragma unroll
    for (int o = 1; o < 64; o <<= 1) v = fmaxf(v, __shfl_xor(v, o));
    return v;
}
#define DPP_MAXF(v, ctrl, rmask) fmaxf((v), __builtin_bit_cast(float, __builtin_amdgcn_update_dpp(0, __builtin_bit_cast(int, (v)), (ctrl), (rmask), 0xF, false)))
DI float wave_max_nonneg(float v) {
    v = DPP_MAXF(v, 0xB1, 0xF); v = DPP_MAXF(v, 0x4E, 0xF); v = DPP_MAXF(v, 0x141, 0xF); v = DPP_MAXF(v, 0x140, 0xF); v = DPP_MAXF(v, 0x142, 0xA); v = DPP_MAXF(v, 0x143, 0xC);
    return __builtin_bit_cast(float, __builtin_amdgcn_readlane(__builtin_bit_cast(int, v), 63));
}
#define DPP_ADDF(v, ctrl, rmask) ((v) + __builtin_bit_cast(float, __builtin_amdgcn_update_dpp(0, __builtin_bit_cast(int, (v)), (ctrl), (rmask), 0xF, false)))
DI float wave_sum_u(float v) {
    v = DPP_ADDF(v, 0xB1, 0xF); v = DPP_ADDF(v, 0x4E, 0xF); v = DPP_ADDF(v, 0x141, 0xF); v = DPP_ADDF(v, 0x140, 0xF); v = DPP_ADDF(v, 0x142, 0xA); v = DPP_ADDF(v, 0x143, 0xC);
    return __builtin_bit_cast(float, __builtin_amdgcn_readlane(__builtin_bit_cast(int, v), 63));
}
typedef short v4i16_t __attribute__((ext_vector_type(4)));
DI s16x4 trrd(LAS unsigned char* p) { return __builtin_bit_cast(s16x4, __builtin_amdgcn_ds_read_tr16_b64_v4i16((LAS v4i16_t*)p)); }
DI bf16x8 cat8(s16x4 a, s16x4 b) { return (bf16x8){a[0], a[1], a[2], a[3], b[0], b[1], b[2], b[3]}; }
#define MFMA_BF16(a, b, c) __builtin_amdgcn_mfma_f32_32x32x16_bf16((a), (b), (c), 0, 0, 0)
#define MFMA_F16(a, b, c) __builtin_amdgcn_mfma_f32_32x32x16_f16((a), (b), (c), 0, 0, 0)
DI unsigned pkh(float a, float b) { return __builtin_bit_cast(unsigned, __builtin_amdgcn_cvt_pkrtz(a, b)); }
DI bf16x8 packbf(const f32x16& x, int s) { v4u p; p.x = cvtpk(x[8 * s], x[8 * s + 1]); p.y = cvtpk(x[8 * s + 2], x[8 * s + 3]); p.z = cvtpk(x[8 * s + 4], x[8 * s + 5]); p.w = cvtpk(x[8 * s + 6], x[8 * s + 7]); return __builtin_bit_cast(bf16x8, p); }
DI f16x8 packh(const f32x16& x, int s) { v4u p; p.x = pkh(x[8 * s], x[8 * s + 1]); p.y = pkh(x[8 * s + 2], x[8 * s + 3]); p.z = pkh(x[8 * s + 4], x[8 * s + 5]); p.w = pkh(x[8 * s + 6], x[8 * s + 7]); return __builtin_bit_cast(f16x8, p); }

struct Frame {
    LAS unsigned char* lds;
    volatile LAS unsigned* MISC;
    gu32* ctl;
    unsigned char* ws;
    int tid, lane, wave, vcu, G;
};
DI const float* inp(int i) { const __attribute__((address_space(4))) unsigned long long* kp = (const __attribute__((address_space(4))) unsigned long long*)__builtin_amdgcn_kernarg_segment_ptr(); return (const float*)(const GAS float*)(*(volatile const __attribute__((address_space(4))) unsigned long long*)(kp + i)); }
enum { I_X = 0, I_C, I_WADA, I_BADA, I_GN1, I_WIN, I_BIG, I_BFG, I_CONVW, I_GQ, I_GK, I_GOSB, I_GOML, I_WOUT, I_GN2, I_WQ, I_SK, I_EU, I_EV, I_OUT };
#define WSP(type, off) ((type*)(F.ws + (off)))

DI void p0_transpose_item(const float* W, int K, int N, int ld, bf16* WT, LAS float* scr, int item, int lane) {
    const int nblk = N / 32, kb = item / nblk, nb = item % nblk, k0 = 64 * kb, n0 = 32 * nb;
    float tv[32];
#pragma unroll
    for (int i = 0; i < 32; ++i) tv[i] = W[(size_t)(k0 + 2 * i + (lane >> 5)) * ld + n0 + (lane & 31)];
#pragma unroll
    for (int i = 0; i < 32; ++i) scr[(2 * i + (lane >> 5)) * 33 + (lane & 31)] = tv[i];
    LDS_WAIT(); asm volatile("" ::: "memory");
    const int c = lane & 7;
#pragma unroll
    for (int j = 0; j < 4; ++j) { const int n = (lane >> 3) + 8 * j; const LAS float* s = scr + (8 * c) * 33 + n;
        v4u o; o.x = pk2(s[0 * 33], s[1 * 33]); o.y = pk2(s[2 * 33], s[3 * 33]); o.z = pk2(s[4 * 33], s[5 * 33]); o.w = pk2(s[6 * 33], s[7 * 33]);
        *(GAS v4u*)(WT + (size_t)(n0 + n) * K + k0 + 8 * c) = o; }
    LDS_WAIT(); asm volatile("" ::: "memory");
}
DI void p0_mod_block(const Frame& F, int item) {
    const float* const c_ = inp(I_C); const float* const w_ada_ = inp(I_WADA); const float* const b_ada_ = inp(I_BADA); float* const mod_ = WSP(float, WS_MOD);
    LAS float* scr = (LAS float*)(F.lds + F.wave * 16384);
    const int j = item * 64 + F.lane, d0 = F.wave * 128;
    const int rg = F.lane >> 4, cl = F.lane & 15;
    f32x4 wv[32];
    { const float* wp = w_ada_ + (size_t)(d0 + rg) * NMOD + item * 64 + 4 * cl;
#pragma unroll
      for (int i = 0; i < 32; ++i) wv[i] = __builtin_nontemporal_load((const GAS f32x4*)(wp + (size_t)(4 * i) * NMOD)); }
#pragma unroll
    for (int b = 0; b < 8; ++b)
#pragma unroll
        for (int q = 0; q < 2; ++q) { const float cv = c_[b * D + d0 + 64 * q + F.lane]; scr[b * 128 + 64 * q + F.lane] = cv / (1.f + fexp(-cv)); }
    LDS_WAIT(); asm volatile("" ::: "memory");
    f32x4 acc[8];
#pragma unroll
    for (int b = 0; b < 8; ++b) acc[b] = (f32x4){0.f, 0.f, 0.f, 0.f};
#pragma unroll
    for (int i = 0; i < 32; ++i)
#pragma unroll
        for (int b = 0; b < 8; ++b) acc[b] += wv[i] * scr[b * 128 + 4 * i + rg];
#pragma unroll
    for (int b = 0; b < 8; ++b)
#pragma unroll
        for (int c = 0; c < 4; ++c) { float v = acc[b][c]; v += __shfl_xor(v, 16); v += __shfl_xor(v, 32); acc[b][c] = v; }
    if (rg == 0) {
#pragma unroll
        for (int b = 0; b < 8; ++b) *(LAS f32x4*)(scr + 1024 + b * 64 + 4 * cl) = acc[b]; }
    __syncthreads();
    float tot = b_ada_[j];
#pragma unroll
    for (int w = 0; w < 8; ++w) tot += ((LAS float*)(F.lds + w * 16384))[1024 + F.wave * 64 + F.lane];
    mod_[F.wave * NMOD + j] = tot;
    __syncthreads();
}
DI void p0_weff_item(const Frame& F, int item) {
    const float* const sub_keys_ = inp(I_SK); const float* const w_q_peer_ = inp(I_WQ); bf16* const Weff_t_ = WSP(bf16, WS_WEFF);
    const int hp = item >> 4, dblk = item & 15, dt = F.wave >> 2, nt = F.wave & 3, r = F.lane & 31, hi = F.lane >> 5;
    const float* ap = w_q_peer_ + (size_t)(64 * dblk + 32 * dt + r) * NSC + hp * 128 + 8 * hi;
    const float* bp = sub_keys_ + (size_t)hp * 16384 + (size_t)(32 * nt + r) * 128 + 8 * hi;
    f32x4 av[16], bv[16];
#pragma unroll
    for (int kk = 0; kk < 8; ++kk) { av[2 * kk] = *(const GAS f32x4*)(ap + 16 * kk); av[2 * kk + 1] = *(const GAS f32x4*)(ap + 16 * kk + 4); bv[2 * kk] = *(const GAS f32x4*)(bp + 16 * kk); bv[2 * kk + 1] = *(const GAS f32x4*)(bp + 16 * kk + 4); }
    f32x16 acc;
#pragma unroll
    for (int i = 0; i < 16; ++i) acc[i] = 0.f;
#define WEFF_SPLIT(V0, V1, HI, LO) do { v4u h_, l_; \
        h_.x = cvtpk(V0.x, V0.y); h_.y = cvtpk(V0.z, V0.w); h_.z = cvtpk(V1.x, V1.y); h_.w = cvtpk(V1.z, V1.w); \
        l_.x = cvtpk(V0.x - bflo(h_.x), V0.y - bfhi(h_.x)); l_.y = cvtpk(V0.z - bflo(h_.y), V0.w - bfhi(h_.y)); l_.z = cvtpk(V1.x - bflo(h_.z), V1.y - bfhi(h_.z)); l_.w = cvtpk(V1.z - bflo(h_.w), V1.w - bfhi(h_.w)); \
        HI = __builtin_bit_cast(bf16x8, h_); LO = __builtin_bit_cast(bf16x8, l_); } while (0)
#pragma unroll
    for (int kk = 0; kk < 8; ++kk) { bf16x8 ah, al, bh, bl; WEFF_SPLIT(av[2 * kk], av[2 * kk + 1], ah, al); WEFF_SPLIT(bv[2 * kk], bv[2 * kk + 1], bh, bl);
        acc = MFMA_BF16(al, bh, acc); acc = MFMA_BF16(ah, bl, acc); acc = MFMA_BF16(ah, bh, acc); __builtin_amdgcn_sched_barrier(0); }
#undef WEFF_SPLIT
    bf16* op = Weff_t_ + (size_t)(hp * 128 + 32 * nt + r) * D + 64 * dblk + 32 * dt + 4 * hi;
#pragma unroll
    for (int g = 0; g < 4; ++g) *(GAS unsigned long long*)(op + 8 * g) = (unsigned long long)pk2(acc[4 * g], acc[4 * g + 1]) | ((unsigned long long)pk2(acc[4 * g + 2], acc[4 * g + 3]) << 32);
}
struct ExpRows2 { f32x4 v[2][4]; };
DI void exp_load2(const Frame& F, int blk0, ExpRows2& R) {
    const float* const expert_u_ = inp(I_EU); const float* const expert_v_ = inp(I_EV);
#pragma unroll
    for (int bb = 0; bb < 2; ++bb) { const int blk = blk0 + bb; const float* src = (blk < 16384 ? expert_u_ : expert_v_) + (size_t)(blk & 16383) * 1024 + 4 * F.lane;
#pragma unroll
        for (int k = 0; k < 4; ++k) R.v[bb][k] = __builtin_nontemporal_load((const GAS f32x4*)(src + 256 * k)); }
}
DI void exp_conv2(const Frame& F, int blk0, const ExpRows2& R) {
    float* const SUI_ = WSP(float, WS_SUI); float* const SVI_ = WSP(float, WS_SVI);
#pragma unroll
    for (int bb = 0; bb < 2; ++bb) { const int blk = blk0 + bb; const bool isu = blk < 16384; const int e = blk & 16383;
        float mx = 0.f;
#pragma unroll
        for (int k = 0; k < 4; ++k) mx = fmaxf(mx, fmaxf(fmaxf(fabsf(R.v[bb][k].x), fabsf(R.v[bb][k].y)), fmaxf(fabsf(R.v[bb][k].z), fabsf(R.v[bb][k].w))));
        mx = wave_max_nonneg(mx);
        {
            float best = 3.0e38f, bs = 0.f;
#define EXP_TRY(FAC) do { const float s_ = mx * ((FAC) / 7.f), inv_ = s_ > 0.f ? 1.f / s_ : 0.f; float er_ = 0.f; \
                _Pragma("unroll") for (int k = 0; k < 4; ++k) _Pragma("unroll") for (int c = 0; c < 4; ++c) { const float v_ = R.v[bb][k][c]; const float d_ = v_ - s_ * fminf(fmaxf(rintf(v_ * inv_), -7.f), 7.f); er_ += d_ * d_; } \
                er_ = wave_sum_u(er_); if (er_ < best) { best = er_; bs = s_; } } while (0)
            EXP_TRY(1.f); EXP_TRY(0.74f);
#undef EXP_TRY
            const float inv = bs > 0.f ? 1.f / bs : 0.f;
            unsigned w01[2] = {0u, 0u};
#pragma unroll
            for (int k = 0; k < 4; ++k)
#pragma unroll
                for (int c = 0; c < 4; ++c) { const int q = (int)fminf(fmaxf(rintf(R.v[bb][k][c] * inv), -7.f), 7.f); w01[k >> 1] |= (unsigned)((isu || (c & 1)) ? (q & 15) : (q + 8)) << (4 * (4 * (k & 1) + c)); }
            if (F.lane == 0) (isu ? SUI_ : SVI_)[e] = bs;
            typedef unsigned v2u_ __attribute__((ext_vector_type(2)));
            v2u_ wv; wv.x = w01[0]; wv.y = w01[1];
            *(GAS v2u_*)((isu ? WSP(unsigned char, WS_EXPU) : WSP(unsigned char, WS_EXPV)) + (size_t)e * 512 + 8 * F.lane) = wv;
        } }
}
#ifndef P0_PARTS
#define P0_PARTS 15
#endif
DI void p0_phase(const Frame& F, int parts = 15) {
    const float* const w_in_ = inp(I_WIN); bf16* const Win_t_ = WSP(bf16, WS_WIN); const float* const w_out_ = inp(I_WOUT); bf16* const Wout_t_ = WSP(bf16, WS_WOUT); const float* const expert_v_ = inp(I_EV); const float* const expert_u_ = inp(I_EU);
    LAS float* scr = (LAS float*)(F.lds + F.wave * 16384);
    const int gw = F.vcu * NWAVES + F.wave, NGW = F.G * NWAVES;
    if (parts & 1) for (int it = F.vcu; it < 96; it += F.G) p0_mod_block(F, it);
    constexpr int I_WIN = 16 * 112, I_WOUT = 16 * 32, NITEMS = I_WIN + I_WOUT;
    if (parts & 2) for (int it = gw; it < NITEMS; it += NGW) {
        int r = it;
        if (r < I_WIN) { p0_transpose_item(w_in_, D, NPROJ, NIN, Win_t_, scr, r, F.lane); continue; } r -= I_WIN;
        p0_transpose_item(w_out_, D, D, D, Wout_t_, scr, r, F.lane);
    }
    __syncthreads();
    if (parts & 8) for (int it = F.vcu; it < 256; it += F.G) p0_weff_item(F, it);
}

template <bool DOGATES, bool SRCB = false>
DI void norm_phase(const Frame& F, const float* src, const float* g, int shift_off, int scale_off) {
    const float* const w_in_ = inp(I_WIN); float* const mod_ = WSP(float, WS_MOD); bf16* const XN_ = WSP(bf16, WS_XN); float* const GATES_ = WSP(float, WS_GATES); const float* const b_igate_ = inp(I_BIG); const float* const b_fgate_ = inp(I_BFG);
    LAS float* W8 = (LAS float*)F.lds;
    if (DOGATES) {
        for (int i = 0; i < 16; ++i) { const int idx = F.tid + 512 * i; W8[idx] = w_in_[(size_t)(idx & 1023) * NIN + NPROJ + (idx >> 10)]; }
        __syncthreads();
    }
    const int gw = F.vcu * NWAVES + F.wave, NGW = F.G * NWAVES;
    for (int ch = gw; ch < T / 16; ch += NGW) {
        const int r0 = ch * 16, b = r0 / SEQ;
        f32x4 A[4], Bv[4];
#pragma unroll
        for (int j = 0; j < 4; ++j) { const int col = 4 * F.lane + 256 * j; const f32x4 gg = *(const f32x4*)(g + col), sc = *(const f32x4*)(mod_ + b * NMOD + scale_off + col);
            A[j] = gg * (sc + 1.0f); Bv[j] = *(const f32x4*)(mod_ + b * NMOD + shift_off + col); }
        f32x4 nx[4];
#define NORM_LOADROW(ROW) do { if (SRCB) { const GAS unsigned long long* xb_ = (const GAS unsigned long long*)((const bf16*)src + (size_t)(ROW) * D) + F.lane; \
              _Pragma("unroll") for (int j = 0; j < 4; ++j) { const unsigned long long w_ = __builtin_nontemporal_load(xb_ + 64 * j); const unsigned lo_ = (unsigned)w_, hi_ = (unsigned)(w_ >> 32); \
                  nx[j] = (f32x4){bflo(lo_), bfhi(lo_), bflo(hi_), bfhi(hi_)}; } } \
          else { const GAS f32x4* xr_ = (const GAS f32x4*)(src + (size_t)(ROW) * D) + F.lane; _Pragma("unroll") for (int j = 0; j < 4; ++j) nx[j] = __builtin_nontemporal_load(xr_ + 64 * j); } } while (0)
        NORM_LOADROW(r0);
        for (int rr = 0; rr < 16; ++rr) {
            const int row = r0 + rr;
            f32x4 v[4]; float s = 0.f;
#pragma unroll
            for (int j = 0; j < 4; ++j) { v[j] = nx[j]; s += (v[j].x * v[j].x + v[j].y * v[j].y) + (v[j].z * v[j].z + v[j].w * v[j].w); }
            if (rr + 1 < 16) NORM_LOADROW(row + 1);
            const float rstd = 1.f / sqrtf(wave_sum_u(s) * (1.f / D) + EPS);
#pragma unroll
            for (int j = 0; j < 4; ++j) v[j] = v[j] * rstd * A[j] + Bv[j];
            GAS unsigned long long* o8 = (GAS unsigned long long*)(XN_ + (size_t)row * D) + F.lane;
#pragma unroll
            for (int j = 0; j < 4; ++j) o8[64 * j] = (unsigned long long)pk2(v[j].x, v[j].y) | ((unsigned long long)pk2(v[j].z, v[j].w) << 32);
            if (SRCB) {
                float mx = 0.f;
#pragma unroll
                for (int j = 0; j < 4; ++j) mx = fmaxf(mx, fmaxf(fmaxf(fabsf(v[j].x), fabsf(v[j].y)), fmaxf(fabsf(v[j].z), fabsf(v[j].w))));
                mx = wave_max_nonneg(mx);
                const float sx = mx > 0.f ? 119.f / mx : 0.f;
                unsigned lo_[2] = {0u, 0u}, hi_[2] = {0u, 0u};
#pragma unroll
                for (int j = 0; j < 4; ++j)
#pragma unroll
                    for (int c = 0; c < 4; ++c) { const int t_ = (int)rintf(v[j][c] * sx) + 8; const int sh_ = 4 * (4 * (j & 1) + c);
                        lo_[j >> 1] |= (unsigned)(t_ & 15) << sh_; hi_[j >> 1] |= (unsigned)((t_ >> 4) & 15) << sh_; }
                typedef unsigned v2u_ __attribute__((ext_vector_type(2)));
                unsigned char* xq = WSP(unsigned char, WS_XQ) + (size_t)row * 1024 + 8 * F.lane;
                v2u_ hv, lv; hv.x = hi_[0]; hv.y = hi_[1]; lv.x = lo_[0] ^ 0x88888888u; lv.y = lo_[1] ^ 0x88888888u;
                *(GAS v2u_*)xq = hv; *(GAS v2u_*)(xq + 512) = lv;
                if (F.lane == 0) WSP(float, WS_XS)[row] = mx > 0.f ? mx / 119.f : 0.f;
            }
            if (DOGATES) {
                float res = 0.f;
#pragma unroll
                for (int hh = 0; hh < 8; ++hh) { float p = 0.f;
#pragma unroll
                    for (int j = 0; j < 4; ++j) { const f32x4 w = *(const LAS f32x4*)(W8 + hh * 1024 + 4 * F.lane + 256 * j); p += (v[j].x * w.x + v[j].y * w.y) + (v[j].z * w.z + v[j].w * w.w); }
                    p = wave_sum_u(p); if (F.lane == hh) res = p; }
                if (F.lane < 8) GATES_[(size_t)row * 8 + F.lane] = res + (F.lane < 4 ? b_igate_[F.lane] : b_fgate_[F.lane - 4]);
            }
        }
    }
}

DI void sb_unit(const Frame& F, int b, int h, int qb) {
    bf16* const PROJ_ = WSP(bf16, WS_PROJ); const float* const g_q_sb_ = inp(I_GQ); const float* const g_k_sb_ = inp(I_GK); bf16* const MIX_ = WSP(bf16, WS_MIX); const float* const g_out_sb_ = inp(I_GOSB);
    const int lane = F.lane, w = F.wave, r = lane & 31, hi = lane >> 5;
    const int i16 = lane & 15, qq = i16 >> 2, pp = i16 & 3, blk = (lane >> 4) & 1;
    LAS unsigned char* Wb = F.lds + w * 16384;
    const size_t rowbase = (size_t)b * SEQ; const int q0 = qb * 256, qw0 = q0 + 32 * w, tq = qw0 + r;
    const bf16* P = PROJ_;
    const bf16* kpiece[4]; const bf16* vpiece[4];
#pragma unroll
    for (int i = 0; i < 4; ++i) { const int krow_ = 8 * i + (lane >> 3), kch = (lane & 7) ^ ((krow_ >> 1) & 7); kpiece[i] = P + (rowbase + krow_) * NPROJ + C_KSB + h * 64 + 8 * kch;
        const int vkey = 16 * (i & 1) + (lane >> 2); vpiece[i] = P + (rowbase + vkey) * NPROJ + C_VSB + h * 64 + 32 * (i >> 1) + 8 * (lane & 3); }
#define SB_DMA(T_, BUF_) do { _Pragma("unroll") for (int i_ = 0; i_ < 4; ++i_) { \
        __builtin_amdgcn_global_load_lds((const unsigned*)(kpiece[i_] + (size_t)(32 * (T_)) * NPROJ), (LAS unsigned*)(Wb + 8192 * (BUF_) + 1024 * i_), 16, 0, 0); \
        __builtin_amdgcn_global_load_lds((const unsigned*)(vpiece[i_] + (size_t)(32 * (T_)) * NPROJ), (LAS unsigned*)(Wb + 8192 * (BUF_) + 4096 + 1024 * i_), 16, 0, 0); } } while (0)
    const int tw = (qw0 + 30) >> 5;
    SB_DMA(tw, 0);
    bf16x8 qf[4];
    {
        const bf16* Qp = P + (rowbase + tq) * NPROJ + C_QSB + h * 64 + 8 * hi;
        v4u qraw[4]; float ss = 0.f;
#pragma unroll
        for (int kk = 0; kk < 4; ++kk) { qraw[kk] = *(const GAS v4u*)(Qp + 16 * kk);
#pragma unroll
            for (int e = 0; e < 4; ++e) { const float a = bflo(qraw[kk][e]), c = bfhi(qraw[kk][e]); ss += a * a + c * c; } }
        ss = swap_add(ss);
        const float rq = __builtin_amdgcn_rsqf(ss * (1.f / 64.f) + EPS) * (0.125f * LOG2E);
#pragma unroll
        for (int kk = 0; kk < 4; ++kk) { const int d0 = 16 * kk + 8 * hi;
            const f32x4 g0 = *(const f32x4*)(g_q_sb_ + d0) * *(const f32x4*)(g_k_sb_ + d0), g1 = *(const f32x4*)(g_q_sb_ + d0 + 4) * *(const f32x4*)(g_k_sb_ + d0 + 4);
            v4u o; o.x = cvtpk(bflo(qraw[kk].x) * rq * g0.x, bfhi(qraw[kk].x) * rq * g0.y); o.y = cvtpk(bflo(qraw[kk].y) * rq * g0.z, bfhi(qraw[kk].y) * rq * g0.w);
            o.z = cvtpk(bflo(qraw[kk].z) * rq * g1.x, bfhi(qraw[kk].z) * rq * g1.y); o.w = cvtpk(bflo(qraw[kk].w) * rq * g1.z, bfhi(qraw[kk].w) * rq * g1.w);
            qf[kk] = __builtin_bit_cast(bf16x8, o); }
    }
    f16x8 U0, U1, E0;
#pragma unroll
    for (int j = 0; j < 8; ++j) { U0[j] = (krow(0, hi, j) > r) ? (_Float16)1.0f : (_Float16)0.0f; U1[j] = (krow(1, hi, j) > r) ? (_Float16)1.0f : (_Float16)0.0f;
        E0[j] = (j == 0 && hi == 0) ? (_Float16)1.0f : (_Float16)0.0f; }
    f32x16 o0, o1;
#pragma unroll
    for (int i = 0; i < 16; ++i) { o0[i] = 0.f; o1[i] = 0.f; }
    float R = 0.f;
    const int kfoff = r * 128, kfsw = (r >> 1) & 7;
    for (int t = tw; t >= 0; --t) {
        const int buf = (tw - t) & 1;
        LAS unsigned char* Kb = Wb + 8192 * buf; LAS unsigned char* Vb = Kb + 4096;
        asm volatile("s_waitcnt vmcnt(0)" ::: "memory");
        if (t > 0) SB_DMA(t - 1, buf ^ 1);
        bf16x8 kf[4]; float ssk = 0.f;
#pragma unroll
        for (int kk = 0; kk < 4; ++kk) { const v4u kv = *(const LAS v4u*)(Kb + kfoff + (((2 * kk + hi) ^ kfsw) * 16)); kf[kk] = __builtin_bit_cast(bf16x8, kv);
            ssk = dot2bf(kv.x, kv.x, ssk); ssk = dot2bf(kv.y, kv.y, ssk); ssk = dot2bf(kv.z, kv.z, ssk); ssk = dot2bf(kv.w, kv.w, ssk); }
        ssk = swap_add(ssk);
        const float rk = __builtin_amdgcn_rsqf(ssk * (1.f / 64.f) + EPS);
        f16x8 RKA;
#pragma unroll
        for (int e = 0; e < 8; ++e) RKA[e] = (_Float16)0.0f;
        RKA[0] = (hi == 0) ? (_Float16)rk : (_Float16)0.0f;
        f32x16 s, rkd;
#pragma unroll
        for (int i = 0; i < 16; ++i) { s[i] = 0.f; rkd[i] = 0.f; }
        rkd = MFMA_F16(RKA, E0, rkd);
#pragma unroll
        for (int kk = 0; kk < 4; ++kk) s = MFMA_BF16(kf[kk], qf[kk], s);
        float tsum = 0.f; unsigned lp[8];
        if (32 * t + 31 < qw0) {
#pragma unroll
            for (int i = 0; i < 16; i += 2) {
                const float z0_ = s[i] * rkd[i], z1_ = s[i + 1] * rkd[i + 1];
                const float a0_ = -lg2(1.f + ex2(z0_)), a1_ = -lg2(1.f + ex2(z1_));
                tsum += a0_ + a1_;
                s[i] = z0_ + a0_; s[i + 1] = z1_ + a1_;
                lp[i >> 1] = pkh(a0_, a1_); }
        } else {
            const int kq = tq - 32 * t;
#pragma unroll
            for (int i = 0; i < 16; i += 2) {
                const float z0_ = s[i] * rkd[i], z1_ = s[i + 1] * rkd[i + 1];
                float a0_ = -lg2(1.f + ex2(z0_)), a1_ = -lg2(1.f + ex2(z1_));
                const bool ma0 = crow(i, hi) >= kq, ma1 = crow(i + 1, hi) >= kq;
                a0_ = ma0 ? 0.f : a0_; a1_ = ma1 ? 0.f : a1_;
                tsum += a0_ + a1_;
                s[i] = ma0 ? -INFINITY : z0_ + a0_; s[i + 1] = ma1 ? -INFINITY : z1_ + a1_;
                lp[i >> 1] = pkh(a0_, a1_); }
        }
        f32x16 c;
#pragma unroll
        for (int i = 0; i < 16; ++i) c[i] = R;
        c = MFMA_F16(U0, __builtin_bit_cast(f16x8, (v4u){lp[0], lp[1], lp[2], lp[3]}), c); c = MFMA_F16(U1, __builtin_bit_cast(f16x8, (v4u){lp[4], lp[5], lp[6], lp[7]}), c);
#pragma unroll
        for (int i = 0; i < 16; ++i) s[i] = ex2(s[i] + c[i]);
        const bf16x8 W0 = packbf(s, 0), W1 = packbf(s, 1);
        LAS unsigned char* vb_ = Vb + (4 * hi + qq) * 64 + 32 * blk + 8 * pp;
        o0 = MFMA_BF16(cat8(trrd(vb_), trrd(vb_ + 8 * 64)), W0, o0); o0 = MFMA_BF16(cat8(trrd(vb_ + 16 * 64), trrd(vb_ + 24 * 64)), W1, o0);
        o1 = MFMA_BF16(cat8(trrd(vb_ + 2048), trrd(vb_ + 2048 + 8 * 64)), W0, o1); o1 = MFMA_BF16(cat8(trrd(vb_ + 2048 + 16 * 64), trrd(vb_ + 2048 + 24 * 64)), W1, o1);
        R += swap_add(tsum);
        if (__all(R < -150.f)) break;
    }
    asm volatile("s_waitcnt vmcnt(0)" ::: "memory");
#undef SB_DMA
    {
        float ss = 0.f;
#pragma unroll
        for (int i = 0; i < 16; ++i) ss += o0[i] * o0[i] + o1[i] * o1[i];
        ss = swap_add(ss);
        const float ro = __builtin_amdgcn_rsqf(ss * (1.f / 64.f) + EPS);
        bf16* Op = MIX_ + (rowbase + tq) * D + h * 64;
        const float* go = g_out_sb_ + h * 64;
#pragma unroll
        for (int g = 0; g < 4; ++g) { const int d0 = 8 * g + 4 * hi; const f32x4 ga = *(const f32x4*)(go + d0), gb = *(const f32x4*)(go + 32 + d0);
            u32x2 wa, wb; wa.x = cvtpk(o0[4 * g] * ro * ga.x, o0[4 * g + 1] * ro * ga.y); wa.y = cvtpk(o0[4 * g + 2] * ro * ga.z, o0[4 * g + 3] * ro * ga.w);
            wb.x = cvtpk(o1[4 * g] * ro * gb.x, o1[4 * g + 1] * ro * gb.y); wb.y = cvtpk(o1[4 * g + 2] * ro * gb.z, o1[4 * g + 3] * ro * gb.w);
            *(GAS u32x2*)(Op + d0) = wa; *(GAS u32x2*)(Op + 32 + d0) = wb; }
    }
    __syncthreads();
}

DI void conv_silu8(const v4u (&xr)[4], const float (&cw)[4][8], float scale, float (&y)[8]) {
#pragma unroll
    for (int e = 0; e < 8; ++e) y[e] = 0.f;
#pragma unroll
    for (int j = 0; j < 4; ++j) {
        y[0] += cw[j][0] * bflo(xr[j].x); y[1] += cw[j][1] * bfhi(xr[j].x); y[2] += cw[j][2] * bflo(xr[j].y); y[3] += cw[j][3] * bfhi(xr[j].y);
        y[4] += cw[j][4] * bflo(xr[j].z); y[5] += cw[j][5] * bfhi(xr[j].z); y[6] += cw[j][6] * bflo(xr[j].w); y[7] += cw[j][7] * bfhi(xr[j].w); }
#pragma unroll
    for (int e = 0; e < 8; ++e) y[e] = scale * y[e] * __builtin_amdgcn_rcpf(1.f + fexp(-y[e]));
}
DI float log_sigmoid(float x) { return fminf(x, 0.f) - 0.6931471805599453f * lg2(1.f + fexp(-fabsf(x))); }
DI float wave_scan_incl(float a, int lane) {
#pragma unroll
    for (int o = 1; o < 64; o <<= 1) { const float t = __shfl_up(a, o); if (lane >= o) a += t; }
    return a;
}

constexpr int LDS_CW = 65536;
DI void stage_conv_w(const Frame& F) {
    const float* const conv_w_ = inp(I_CONVW); LAS float* cwl = (LAS float*)(F.lds + LDS_CW);
    for (int i = F.tid; i < 4096; i += NTHR) cwl[i] = conv_w_[i];
    __syncthreads();
}
DI void load_cw8(const Frame& F, int colbase, float (&cw)[4][8]) {
    const LAS float* cwl = (const LAS float*)(F.lds + LDS_CW);
#pragma unroll
    for (int j = 0; j < 4; ++j) { const f32x4 a = *(const LAS f32x4*)(cwl + j * 1024 + colbase), b = *(const LAS f32x4*)(cwl + j * 1024 + colbase + 4);
        cw[j][0] = a.x; cw[j][1] = a.y; cw[j][2] = a.z; cw[j][3] = a.w; cw[j][4] = b.x; cw[j][5] = b.y; cw[j][6] = b.z; cw[j][7] = b.w; }
}
struct MlLocalRegs { v4u kraw[2][4]; v4u vraw[2]; float gi, gf; };
DI void ml_local_load(const Frame& F, int chain, int c, MlLocalRegs& R) {
    bf16* const PROJ_ = WSP(bf16, WS_PROJ); float* const GATES_ = WSP(float, WS_GATES);
    const int tid = F.tid, lane = F.lane;
    const int b = chain >> 2, hh = chain & 3; const size_t rowbase = (size_t)b * SEQ; const int t0 = c * 64;
    const bf16* P = PROJ_;
    const int kc = tid & 15, kr0 = tid >> 4;
    const bf16* Kg = P + rowbase * NPROJ + C_KML + hh * 128 + kc * 8;
#pragma unroll
    for (int i = 0; i < 2; ++i)
#pragma unroll
        for (int j = 0; j < 4; ++j) { const int tt = t0 + kr0 + 32 * i - 3 + j; R.kraw[i][j] = (tt >= 0) ? *(const GAS v4u*)(Kg + (size_t)tt * NPROJ) : (v4u){0u, 0u, 0u, 0u}; }
#pragma unroll
    for (int i = 0; i < 2; ++i) R.vraw[i] = *(const GAS v4u*)(P + (rowbase + t0 + kr0 + 32 * i) * NPROJ + C_VML + hh * 128 + kc * 8);
    const float* Gg = GATES_ + (rowbase + t0 + lane) * 8;
    R.gi = Gg[hh]; R.gf = Gg[4 + hh];
}
DI void ml_local_unit(const Frame& F, int chain, int c, const MlLocalRegs& RG) {
    bf16* const CST_ = WSP(bf16, WS_CST); float* const NST_ = WSP(float, WS_NST); float* const SCL_ = WSP(float, WS_SCL);
    LAS unsigned char* L = F.lds;
    LAS float* Lws = (LAS float*)(L + 32768);
    const int tid = F.tid, lane = F.lane, w = F.wave, r = lane & 31, hi = lane >> 5;
    const int i16 = lane & 15, qq = i16 >> 2, pp = i16 & 3, blk = (lane >> 4) & 1;
    const int hh = chain & 3;
    const int kbk = w & 3, vb0 = 2 * (w >> 2);
    const int kc = tid & 15, kr0 = tid >> 4;
    v4u kraw[2][4], vraw[2];
#pragma unroll
    for (int i = 0; i < 2; ++i) { vraw[i] = RG.vraw[i];
#pragma unroll
        for (int j = 0; j < 4; ++j) kraw[i][j] = RG.kraw[i][j]; }
    const float gi = RG.gi, gf = RG.gf;
    const float a = wave_scan_incl(log_sigmoid(gf), lane);
    const float a_end = __shfl(a, 63);
    const float lw = a_end - a + gi;
    const float m_loc = wave_max(lw);
    const float ws = fexp(lw - m_loc);
    if (w == 0) Lws[lane] = ws;
    {
        float cw[4][8]; load_cw8(F, 512 + hh * 128 + kc * 8, cw);
#pragma unroll
        for (int i = 0; i < 2; ++i) { float y[8]; conv_silu8(kraw[i], cw, 0.08838834764831845f, y);
            v4u o; o.x = cvtpk(y[0], y[1]); o.y = cvtpk(y[2], y[3]); o.z = cvtpk(y[4], y[5]); o.w = cvtpk(y[6], y[7]);
            *(LAS v4u*)(L + (kc >> 2) * 4096 + (kr0 + 32 * i) * 64 + (kc & 3) * 16) = o; }
#pragma unroll
        for (int i = 0; i < 2; ++i) { const int row = kr0 + 32 * i; const float wsr = __shfl(ws, row);
            v4u o; o.x = cvtpk(bflo(vraw[i].x) * wsr, bfhi(vraw[i].x) * wsr); o.y = cvtpk(bflo(vraw[i].y) * wsr, bfhi(vraw[i].y) * wsr); o.z = cvtpk(bflo(vraw[i].z) * wsr, bfhi(vraw[i].z) * wsr); o.w = cvtpk(bflo(vraw[i].w) * wsr, bfhi(vraw[i].w) * wsr);
            *(LAS v4u*)(L + 16384 + (kc >> 2) * 4096 + row * 64 + (kc & 3) * 16) = o; }
    }
    __syncthreads();
    f32x16 acc0, acc1;
#pragma unroll
    for (int i = 0; i < 16; ++i) { acc0[i] = 0.f; acc1[i] = 0.f; }
#pragma unroll
    for (int kk = 0; kk < 4; ++kk) { const int rows = 16 * kk + 8 * hi + qq;
        LAS unsigned char* ka = L + kbk * 4096 + rows * 64 + 32 * blk + 8 * pp; LAS unsigned char* va = L + 16384 + vb0 * 4096 + rows * 64 + 32 * blk + 8 * pp;
        const bf16x8 A = cat8(trrd(ka), trrd(ka + 4 * 64));
        acc0 = MFMA_BF16(A, cat8(trrd(va), trrd(va + 4 * 64)), acc0); acc1 = MFMA_BF16(A, cat8(trrd(va + 4096), trrd(va + 4096 + 4 * 64)), acc1); }
    {
        bf16* Cp = CST_ + ((size_t)(chain * 64 + c) * 128 + vb0 * 32 + r) * 128 + kbk * 32 + 4 * hi;
#pragma unroll
        for (int g = 0; g < 4; ++g) { u32x2 o; o.x = cvtpk(acc0[4 * g], acc0[4 * g + 1]); o.y = cvtpk(acc0[4 * g + 2], acc0[4 * g + 3]); *(GAS u32x2*)(Cp + 8 * g) = o;
            u32x2 o1; o1.x = cvtpk(acc1[4 * g], acc1[4 * g + 1]); o1.y = cvtpk(acc1[4 * g + 2], acc1[4 * g + 3]); *(GAS u32x2*)(Cp + 32 * 128 + 8 * g) = o1; }
    }
    {
        const int k = 16 * w + (lane & 15), sq = lane >> 4; float part = 0.f;
        const LAS unsigned short* kcol = (const LAS unsigned short*)(L + (k >> 5) * 4096 + (k & 31) * 2);
#pragma unroll
        for (int e = 0; e < 16; ++e) part += Lws[16 * sq + e] * __uint_as_float((unsigned)kcol[(16 * sq + e) * 32] << 16);
        part += __shfl_xor(part, 16); part += __shfl_xor(part, 32);
        if (lane < 16) NST_[(size_t)(chain * 64 + c) * 128 + k] = part;
        if (tid == 0) { SCL_[(chain * 64 + c) * 2] = a_end; SCL_[(chain * 64 + c) * 2 + 1] = m_loc; }
    }
    __syncthreads();
}
DI void ml_scan_phase(const Frame& F) {
    bf16* const CST_ = WSP(bf16, WS_CST); float* const NST_ = WSP(float, WS_NST); float* const SCL_ = WSP(float, WS_SCL); float* const MST_ = WSP(float, WS_MST);
    for (int gt = F.vcu * NTHR + F.tid; gt < 32 * 4096; gt += F.G * NTHR) {
        const int chain = gt >> 12, rem = gt & 4095;
        const float ae_l = SCL_[(chain * 64 + F.lane) * 2], ml_l = SCL_[(chain * 64 + F.lane) * 2 + 1];
        u32x2* Cp = (u32x2*)(CST_ + (size_t)chain * 64 * 16384 + (size_t)rem * 4);
        f32x4* Np = (f32x4*)(NST_ + (size_t)chain * 64 * 128 + rem * 4);
        const bool do_n = rem < 32;
        float c0 = 0.f, c1 = 0.f, c2 = 0.f, c3 = 0.f; f32x4 nn = {0.f, 0.f, 0.f, 0.f}; float m = 0.f;
        u32x2 dr[8]; f32x4 nr[8];
#pragma unroll
        for (int i = 0; i < 8; ++i) { dr[i] = Cp[(size_t)i * 4096]; if (do_n) nr[i] = Np[i * 32]; }
        for (int c0_ = 0; c0_ < 64; c0_ += 8) {
#pragma unroll
            for (int i = 0; i < 8; ++i) { const int c = c0_ + i;
                if (c < 63) {
                    const u32x2 dcur = dr[i]; const f32x4 dn = nr[i];
                    if (c + 8 < 63) { dr[i] = Cp[(size_t)(c + 8) * 4096]; if (do_n) nr[i] = Np[(c + 8) * 32]; }
                    const float ae = __builtin_bit_cast(float, __builtin_amdgcn_readlane(__builtin_bit_cast(int, ae_l), c)), ml = __builtin_bit_cast(float, __builtin_amdgcn_readlane(__builtin_bit_cast(int, ml_l), c));
                    const float mn = fmaxf(ae + m, ml), d1 = fexp(ae + m - mn), d2 = fexp(ml - mn);
                    c0 = d1 * c0 + d2 * bflo(dcur.x); c1 = d1 * c1 + d2 * bfhi(dcur.x); c2 = d1 * c2 + d2 * bflo(dcur.y); c3 = d1 * c3 + d2 * bfhi(dcur.y);
                    u32x2 o; o.x = cvtpk(c0, c1); o.y = cvtpk(c2, c3); Cp[(size_t)c * 4096] = o;
                    if (do_n) { nn = nn * d1 + dn * d2; Np[c * 32] = nn; }
                    if (rem == 0) MST_[chain * 64 + c] = mn;
                    m = mn; } }
        }
    }
}
DI void ml_out_unit(const Frame& F, int chain, int c, int nchain = -1, int nc = 0) {
    bf16* const PROJ_ = WSP(bf16, WS_PROJ); float* const GATES_ = WSP(float, WS_GATES); float* const MST_ = WSP(float, WS_MST); bf16* const CST_ = WSP(bf16, WS_CST); float* const NST_ = WSP(float, WS_NST); bf16* const MIX_ = WSP(bf16, WS_MIX); const float* const g_out_ml_ = inp(I_GOML);
    LAS unsigned char* L = F.lds;
    LAS float* Lbs = (LAS float*)(L + 49152); LAS float* Lav = (LAS float*)(L + 49408); LAS float* Lex = (LAS float*)(L + 49664);
    const int tid = F.tid, lane = F.lane, w = F.wave, r = lane & 31, hi = lane >> 5;
    const int i16 = lane & 15, qq = i16 >> 2, pp = i16 & 3, blk = (lane >> 4) & 1;
    const int b = chain >> 2, hh = chain & 3; const size_t rowbase = (size_t)b * SEQ; const int t0 = c * 64;
    const int tb = w >> 2, vb = w & 3;
    const bf16* P = PROJ_;
    {
        const int kc = tid & 15, kr0 = tid >> 4;
#pragma unroll
        for (int which = 0; which < 2; ++which) {
            const int colbase = (which ? 512 : 0) + hh * 128 + kc * 8;
            float cw[4][8]; load_cw8(F, colbase, cw);
            const bf16* Xg = P + rowbase * NPROJ + C_QML + colbase;
#pragma unroll
            for (int i = 0; i < 2; ++i) { const int row = kr0 + 32 * i; v4u xr[4];
#pragma unroll
                for (int j = 0; j < 4; ++j) { const int tt = t0 + row - 3 + j; xr[j] = (tt >= 0) ? *(const GAS v4u*)(Xg + (size_t)tt * NPROJ) : (v4u){0u, 0u, 0u, 0u}; }
                float y[8]; conv_silu8(xr, cw, which ? 0.08838834764831845f : 1.0f, y);
                v4u o; o.x = cvtpk(y[0], y[1]); o.y = cvtpk(y[2], y[3]); o.z = cvtpk(y[4], y[5]); o.w = cvtpk(y[6], y[7]);
                *(LAS v4u*)(L + which * 16384 + row * 256 + ((kc ^ (row & 15)) * 16)) = o; }
        }
#pragma unroll
        for (int i = 0; i < 2; ++i) { const int row = kr0 + 32 * i;
            const v4u v = *(const GAS v4u*)(P + (rowbase + t0 + row) * NPROJ + C_VML + hh * 128 + kc * 8);
            *(LAS v4u*)(L + 32768 + (kc >> 2) * 4096 + row * 64 + (kc & 3) * 16) = v; }
        if (w == 0) { const float* Gg = GATES_ + (rowbase + t0 + lane) * 8; const float a = wave_scan_incl(log_sigmoid(Gg[4 + hh]), lane); Lav[lane] = a; Lbs[lane] = Gg[hh] - a; }
    }
    const float mprev = (c > 0) ? MST_[chain * 64 + c - 1] : 0.f;
    bf16x8 cf[8], nf[8];
    if (c > 0) {
        const bf16* Cp = CST_ + ((size_t)(chain * 64 + c - 1) * 128 + vb * 32 + r) * 128 + 8 * hi;
        const float* Np = NST_ + (size_t)(chain * 64 + c - 1) * 128 + 8 * hi;
        const bool nrow = (r == 0) || (r == 4);
#pragma unroll
        for (int kk = 0; kk < 8; ++kk) { cf[kk] = *(const GAS bf16x8*)(Cp + 16 * kk);
            const f32x4 n0 = *(const f32x4*)(Np + 16 * kk), n1 = *(const f32x4*)(Np + 16 * kk + 4);
            v4u o; o.x = cvtpk(n0.x, n0.y); o.y = cvtpk(n0.z, n0.w); o.z = cvtpk(n1.x, n1.y); o.w = cvtpk(n1.z, n1.w);
            if (!nrow) o = (v4u){0u, 0u, 0u, 0u};
            nf[kk] = __builtin_bit_cast(bf16x8, o); }
    }
    unsigned tch0 = 0u, tch1 = 0u;
    if (nchain >= 0) {
        const unsigned nhh = (unsigned)nchain & 3u, nrow0 = (unsigned)(nchain >> 2) * SEQ + (unsigned)nc * 64u, cst = (unsigned)(nchain * 64 + nc - 1);
        const unsigned rr = (unsigned)tid >> 2, part = (unsigned)tid & 3u;
        unsigned o0 = (unsigned)WS_PROJ + ((nrow0 - 3u + rr) * NPROJ + C_QML + (part >> 1) * 512u + nhh * 128u + (part & 1u) * 64u) * 2u; bool v0 = (nc > 0) || (rr >= 3u);
        if (tid >= 268) { o0 = (unsigned)WS_CST + cst * 32768u + (unsigned)(tid - 268) * 128u; v0 = nc > 0; }
        unsigned o1 = (unsigned)WS_PROJ + ((nrow0 + rr) * NPROJ + ((part >> 1) ? C_OML : C_VML) + nhh * 128u + (part & 1u) * 64u) * 2u; bool v1 = true;
        if (tid >= 256) { o1 = (unsigned)WS_CST + cst * 32768u + (unsigned)(244 + tid - 256) * 128u; v1 = nc > 0; }
        if (tid >= 268) { o1 = (unsigned)WS_NST + cst * 512u + (unsigned)(tid - 268) * 128u; }
        if (tid >= 272) { o1 = (unsigned)WS_GATES + nrow0 * 32u + (unsigned)(tid - 272) * 128u; v1 = tid < 288; }
        const GAS unsigned char* wsb = (const GAS unsigned char*)F.ws;
        if (v0) tch0 = *(const GAS unsigned*)(wsb + o0);
        if (v1) tch1 = *(const GAS unsigned*)(wsb + o1);
    }
    __syncthreads();
    bf16x8 qf[8];
    f32x16 s0, s1;
#pragma unroll
    for (int i = 0; i < 16; ++i) { s0[i] = 0.f; s1[i] = 0.f; }
#pragma unroll
    for (int kk = 0; kk < 8; ++kk) { const int ch = 2 * kk + hi; const int rq_ = 32 * tb + r;
        qf[kk] = *(const LAS bf16x8*)(L + rq_ * 256 + ((ch ^ (rq_ & 15)) * 16));
        const bf16x8 a0 = *(const LAS bf16x8*)(L + 16384 + r * 256 + ((ch ^ (r & 15)) * 16));
        const bf16x8 a1 = *(const LAS bf16x8*)(L + 16384 + (32 + r) * 256 + ((ch ^ ((32 + r) & 15)) * 16));
        s0 = MFMA_BF16(a0, qf[kk], s0); s1 = MFMA_BF16(a1, qf[kk], s1); }
    const int tl = 32 * tb + r; const float a_t = Lav[tl];
    f32x16 d0, d1; float mrow = -INFINITY;
#pragma unroll
    for (int g = 0; g < 4; ++g) { const f32x4 b0 = *(const LAS f32x4*)(Lbs + 8 * g + 4 * hi), b1 = *(const LAS f32x4*)(Lbs + 32 + 8 * g + 4 * hi);
#pragma unroll
        for (int e = 0; e < 4; ++e) { const int sl = 8 * g + 4 * hi + e;
            d0[4 * g + e] = (sl <= tl) ? a_t + b0[e] : -INFINITY; d1[4 * g + e] = (32 + sl <= tl) ? a_t + b1[e] : -INFINITY;
            mrow = fmaxf(mrow, fmaxf(d0[4 * g + e], d1[4 * g + e])); } }
    mrow = fmaxf(swap_max(mrow), a_t + mprev);
    float psum = 0.f;
#pragma unroll
    for (int i = 0; i < 16; ++i) { s0[i] *= fexp(d0[i] - mrow); s1[i] *= fexp(d1[i] - mrow); psum += s0[i] + s1[i]; }
    const float w_inter = fexp(a_t + mprev - mrow);
    float den = swap_add(psum);
    const bf16x8 P00 = packbf(s0, 0), P01 = packbf(s0, 1), P10 = packbf(s1, 0), P11 = packbf(s1, 1);
    f32x16 num;
#pragma unroll
    for (int i = 0; i < 16; ++i) num[i] = 0.f;
    {
        LAS unsigned char* vb_ = L + 32768 + vb * 4096 + (4 * hi + qq) * 64 + 32 * blk + 8 * pp;
        num = MFMA_BF16(cat8(trrd(vb_), trrd(vb_ + 8 * 64)), P00, num); num = MFMA_BF16(cat8(trrd(vb_ + 16 * 64), trrd(vb_ + 24 * 64)), P01, num);
        num = MFMA_BF16(cat8(trrd(vb_ + 32 * 64), trrd(vb_ + 40 * 64)), P10, num); num = MFMA_BF16(cat8(trrd(vb_ + 48 * 64), trrd(vb_ + 56 * 64)), P11, num);
    }
    if (c > 0) {
        f32x16 it, dn;
#pragma unroll
        for (int i = 0; i < 16; ++i) { it[i] = 0.f; dn[i] = 0.f; }
#pragma unroll
        for (int kk = 0; kk < 8; ++kk) { it = MFMA_BF16(cf[kk], qf[kk], it); dn = MFMA_BF16(nf[kk], qf[kk], dn); }
#pragma unroll
        for (int i = 0; i < 16; ++i) num[i] += w_inter * it[i];
        den += w_inter * dn[0];
    }
    const float inv = __builtin_amdgcn_rcpf(fmaxf(fabsf(den), fexp(-mrow)));
    float ss = 0.f;
#pragma unroll
    for (int i = 0; i < 16; ++i) { num[i] *= inv; ss += num[i] * num[i]; }
    ss = swap_add(ss);
    if (lane < 32) Lex[(tb * 4 + vb) * 32 + r] = ss;
    __syncthreads();
    const float tot = (Lex[(tb * 4 + 0) * 32 + r] + Lex[(tb * 4 + 1) * 32 + r]) + (Lex[(tb * 4 + 2) * 32 + r] + Lex[(tb * 4 + 3) * 32 + r]);
    const float rstd = 1.f / sqrtf(tot * (1.f / 128.f) + EPS);
    {
        const size_t trow = rowbase + t0 + tl;
        const bf16* Og = P + trow * NPROJ + C_OML + hh * 128 + vb * 32 + 4 * hi;
        bf16* Mp = MIX_ + trow * D + 512 + hh * 128 + vb * 32 + 4 * hi;
        const float* go = g_out_ml_ + hh * 128 + vb * 32 + 4 * hi;
#pragma unroll
        for (int g = 0; g < 4; ++g) { const u32x2 og = *(const GAS u32x2*)(Og + 8 * g); const f32x4 gg = *(const f32x4*)(go + 8 * g);
            const float o0 = bflo(og.x), o1 = bfhi(og.x), o2 = bflo(og.y), o3 = bfhi(og.y);
            u32x2 o; o.x = cvtpk(num[4 * g] * rstd * gg.x * __builtin_amdgcn_rcpf(1.f + fexp(-o0)), num[4 * g + 1] * rstd * gg.y * __builtin_amdgcn_rcpf(1.f + fexp(-o1)));
            o.y = cvtpk(num[4 * g + 2] * rstd * gg.z * __builtin_amdgcn_rcpf(1.f + fexp(-o2)), num[4 * g + 3] * rstd * gg.w * __builtin_amdgcn_rcpf(1.f + fexp(-o3)));
            *(GAS u32x2*)(Mp + 8 * g) = o; }
    }
    asm volatile("" :: "v"(tch0), "v"(tch1));
    __syncthreads();
}

#define TK_CE(A, B) do { const float hi_ = fmaxf((A), (B)), lo_ = fminf((A), (B)); (A) = hi_; (B) = lo_; } while (0)
DI void tk_sort16(float (&a)[16]) {
    TK_CE(a[0], a[1]); TK_CE(a[2], a[3]); TK_CE(a[0], a[2]); TK_CE(a[1], a[3]); TK_CE(a[1], a[2]); TK_CE(a[4], a[5]); TK_CE(a[6], a[7]); TK_CE(a[4], a[6]); TK_CE(a[5], a[7]); TK_CE(a[5], a[6]); TK_CE(a[0], a[4]); TK_CE(a[2], a[6]); TK_CE(a[2], a[4]); TK_CE(a[1], a[5]); TK_CE(a[3], a[7]); TK_CE(a[3], a[5]); TK_CE(a[1], a[2]); TK_CE(a[3], a[4]); TK_CE(a[5], a[6]); TK_CE(a[8], a[9]); TK_CE(a[10], a[11]); TK_CE(a[8], a[10]); TK_CE(a[9], a[11]); TK_CE(a[9], a[10]); TK_CE(a[12], a[13]); TK_CE(a[14], a[15]); TK_CE(a[12], a[14]); TK_CE(a[13], a[15]); TK_CE(a[13], a[14]); TK_CE(a[8], a[12]); TK_CE(a[10], a[14]); TK_CE(a[10], a[12]); TK_CE(a[9], a[13]); TK_CE(a[11], a[15]); TK_CE(a[11], a[13]); TK_CE(a[9], a[10]); TK_CE(a[11], a[12]); TK_CE(a[13], a[14]); TK_CE(a[0], a[8]); TK_CE(a[4], a[12]); TK_CE(a[4], a[8]); TK_CE(a[2], a[10]); TK_CE(a[6], a[14]); TK_CE(a[6], a[10]); TK_CE(a[2], a[4]); TK_CE(a[6], a[8]); TK_CE(a[10], a[12]); TK_CE(a[1], a[9]); TK_CE(a[5], a[13]); TK_CE(a[5], a[9]); TK_CE(a[3], a[11]); TK_CE(a[7], a[15]); TK_CE(a[7], a[11]); TK_CE(a[3], a[5]); TK_CE(a[7], a[9]); TK_CE(a[11], a[13]); TK_CE(a[1], a[2]); TK_CE(a[3], a[4]); TK_CE(a[5], a[6]); TK_CE(a[7], a[8]); TK_CE(a[9], a[10]); TK_CE(a[11], a[12]); TK_CE(a[13], a[14]);
}
DI void tk_merge16(float (&a)[16], const float (&b)[16]) {
#pragma unroll
    for (int i = 0; i < 16; ++i) a[i] = fmaxf(a[i], b[15 - i]);
#pragma unroll
    for (int j = 8; j > 0; j >>= 1)
#pragma unroll
        for (int i = 0; i < 16; ++i) { const int l = i ^ j; if (l > i) TK_CE(a[i], a[l]); }
}
DI void tk_stage2(const LAS float* la, const LAS float* lb, int* IDX_, float* GATEW_, size_t o) {
        float a[16], bb[16], cnd[64];
#pragma unroll
        for (int q = 0; q < 16; ++q) { a[q] = la[q]; bb[q] = lb[q]; }
        int cnt = 0;
#pragma unroll
        for (int i = 0; i < 16; ++i)
#pragma unroll
            for (int j = 0; j < 16; ++j) if ((i + 1) * (j + 1) <= 16) { cnd[cnt] = __uint_as_float((__float_as_uint(a[i] + bb[j]) & ~0xFFu) | (unsigned)(i * 16 + j)); ++cnt; }
#pragma unroll
        for (int q = 50; q < 64; ++q) cnd[q] = -INFINITY;
        float top[16];
#pragma unroll
        for (int c = 0; c < 4; ++c) { float ch[16];
#pragma unroll
            for (int q = 0; q < 16; ++q) ch[q] = cnd[16 * c + q];
            tk_sort16(ch);
            if (c == 0) {
#pragma unroll
                for (int q = 0; q < 16; ++q) top[q] = ch[q];
            } else tk_merge16(top, ch); }
        float sv[16]; int ei[16]; float mx = -INFINITY;
#pragma unroll
        for (int q = 0; q < 16; ++q) { const unsigned code = __float_as_uint(top[q]) & 0xFFu; const float va = la[code >> 4], vb = lb[code & 15u];
            ei[q] = (int)((__float_as_uint(va) & 0x7Fu) * 128u + (__float_as_uint(vb) & 0x7Fu)); sv[q] = va + vb; mx = fmaxf(mx, sv[q]); }
        float sum = 0.f;
#pragma unroll
        for (int q = 0; q < 16; ++q) { sv[q] = fexp(sv[q] - mx); sum += sv[q]; }
        const float inv = 1.f / sum;
#pragma unroll
#define TK_PK(Q) (((__builtin_bit_cast(unsigned, sv[(Q)] * inv) + 0x2000u) & 0xFFFFC000u) | (unsigned)ei[(Q)])
        for (int q = 0; q < 16; q += 4) *(GAS v4u*)(IDX_ + o + q) = (v4u){TK_PK(q), TK_PK(q + 1), TK_PK(q + 2), TK_PK(q + 3)};
#undef TK_PK
        (void)GATEW_;
    }
struct EpiTopK {
    static constexpr bool PERM = false, AFTER_DRAIN = true;
    int* IDX; float* GATEW;
    DI void fused(f32x4 (&acc)[2][2][4][2], const pg8::Unit& u, int wr, int wc, int fr, int fq, LAS unsigned char* lds, int wid, int lane) const {
        LAS float* Tl = (LAS float*)lds;
        LAS float* Lh2 = (LAS float*)lds;
        LAS float* Ls = (LAS float*)(lds + 36864);
        const int tid = wid * 64 + lane, tl = tid & 127, p = (tid >> 7) & 1, half = tid >> 8;
        float keep[16], fin[16];
#pragma unroll
        for (int q = 0; q < 16; ++q) { keep[q] = 0.f; fin[q] = 0.f; }
#pragma unroll
        for (int ai = 0; ai < 2; ++ai) {
#pragma unroll
            for (int bj = 0; bj < 2; ++bj)
#pragma unroll
                for (int m = 0; m < 4; ++m)
#pragma unroll
                    for (int n = 0; n < 2; ++n) { LAS float* d = Tl + (wr * 64 + m * 16 + fr) * 257 + bj * 128 + wc * 32 + n * 16 + fq * 4; const f32x4 v = acc[ai][bj][m][n]; d[0] = v.x; d[1] = v.y; d[2] = v.z; d[3] = v.w; }
            __syncthreads();
            float run[16];
            {
                const LAS float* src = Tl + tl * 257 + p * 128 + half * 64;
#pragma unroll
                for (int c = 0; c < 4; ++c) { float ch[16];
#pragma unroll
                    for (int q = 0; q < 16; ++q) ch[q] = __uint_as_float((__float_as_uint(src[16 * c + q]) & ~0x7Fu) | (unsigned)(half * 64 + 16 * c + q));
                    tk_sort16(ch);
                    if (c == 0) {
#pragma unroll
                        for (int q = 0; q < 16; ++q) run[q] = ch[q];
                    } else tk_merge16(run, ch); }
            }
            __syncthreads();
#pragma unroll
            for (int q = 0; q < 16; ++q) Lh2[((tl * 2 + p) * 2 + half) * 17 + q] = run[q];
            __syncthreads();
            if (half == 0) { float oth[16];
#pragma unroll
                for (int q = 0; q < 16; ++q) oth[q] = Lh2[((tl * 2 + p) * 2 + 1) * 17 + q];
                tk_merge16(run, oth);
                if (ai == 0) {
#pragma unroll
                    for (int q = 0; q < 16; ++q) keep[q] = run[q]; }
                else {
#pragma unroll
                    for (int q = 0; q < 16; ++q) fin[q] = run[q]; } }
            __syncthreads();
        }
        if (half == 0) {
#pragma unroll
            for (int q = 0; q < 16; ++q) { Ls[(tl * 2 + p) * 17 + q] = keep[q]; Ls[(256 + tl * 2 + p) * 17 + q] = fin[q]; } }
        __syncthreads();
        if (tid < 256) tk_stage2(Ls + (tid * 2) * 17, Ls + (tid * 2) * 17 + 17, IDX, GATEW, (size_t)(u.pm * 256 + tid) * 128 + u.pn * 16);
        __syncthreads();
    }
};
struct OneUnit {
    pg8::Unit u;
    __device__ __forceinline__ bool next(int i, pg8::Unit& o) const { if (i) return false; o = u; return true; }
    __device__ __forceinline__ void a_ready(const pg8::Unit&) const {}
    __device__ __forceinline__ void done(const pg8::Unit&) const {}
};

DI float gelu_erf(float x) { return 0.5f * x * (1.f + erff(x * 0.7071067811865476f)); }
#define DPP_ADD(v, ctrl, rmask) ((v) + __builtin_bit_cast(float, __builtin_amdgcn_update_dpp(0, __builtin_bit_cast(int, (v)), (ctrl), (rmask), 0xF, false)))
#ifndef PEER_EBL
#define PEER_EBL 9
#endif
constexpr int PEER_EB_LOG = PEER_EBL;
#ifndef PEER_PROBE_MASK
#define PEER_PROBE_MASK 0xFFFF
#endif
typedef float f32x2v __attribute__((ext_vector_type(2)));
DI float gelu_cdf(float v) {
    const float av = fabsf(v), t = __builtin_amdgcn_rcpf(av * 0.2316418882f + 1.0f);
    float q = t * 0.5307027145f - 0.7265760135f; q = q * t + 0.7107068705f; q = q * t - 0.142248368f; q = q * t + 0.127414796f; q = q * t;
    const float m = v * (q * ex2(v * v * -0.72134752044f));
    return v < 0.f ? m : v - m;
}
#define DPP_ADDI(v, ctrl, rmask) ((v) + __builtin_amdgcn_update_dpp(0, (v), (ctrl), (rmask), 0xF, false))
DI void peer_phase(const Frame& F, bool scratch_dst) {
    bf16* const XN_ = WSP(bf16, WS_XN); int* const IDX_ = WSP(int, WS_IDX); float* const GATEW_ = WSP(float, WS_GATE); float* const mod_ = WSP(float, WS_MOD); float* const out_ = (float*)inp(I_OUT); const bf16* const X1B_ = WSP(bf16, WS_X1B);
    const unsigned char* const EU4 = WSP(unsigned char, WS_EXPU); const unsigned char* const EV4 = WSP(unsigned char, WS_EXPV); const float* const SUI_ = WSP(float, WS_SUI); const float* const SVI_ = WSP(float, WS_SVI);
    const int gw = F.vcu * NWAVES + F.wave, NGW = F.G * NWAVES, lane = F.lane, g = lane >> 3, j = lane & 7;
    LAS unsigned char* wl = F.lds + F.wave * 17408;
    volatile LAS int* Le = (volatile LAS int*)(wl + g * 512); volatile LAS float* Lg = (volatile LAS float*)(wl + 4096 + g * 512); volatile LAS int* Lp = (volatile LAS int*)(wl + 8192 + g * 512);
    volatile LAS int* Lx = (volatile LAS int*)(wl + 12288 + g * 512); LAS int* Lh = (LAS int*)(wl + 16384 + g * 128);
    for (int grp = gw; grp < T / 8; grp += NGW) {
        const size_t t = (size_t)grp * 8 + g;
        int xh[16], xl[16]; float sxi;
#ifdef PEER_DUP_S
        auto qs_ = [&]() __attribute__((always_inline)) {
#endif
        {
            const unsigned char* xq = WSP(unsigned char, WS_XQ) + t * 1024 + 16 * j;
#pragma unroll
            for (int q = 0; q < 4; ++q) { const v4u a = *(const GAS v4u*)(xq + 128 * q), b = *(const GAS v4u*)(xq + 512 + 128 * q);
#pragma unroll
                for (int w_ = 0; w_ < 4; ++w_) { xh[4 * q + w_] = (int)a[w_]; xl[4 * q + w_] = (int)b[w_]; } }
            sxi = WSP(float, WS_XS)[t];
        }
        {
            int ide[16]; float gte[16]; int rk[16];
#pragma unroll
            for (int m = 0; m < 16; ++m) { const unsigned pk_ = (unsigned)IDX_[t * 128 + j + 8 * m]; ide[m] = (int)(pk_ & 0x3FFFu); gte[m] = __builtin_bit_cast(float, pk_ & 0xFFFFC000u); }
#pragma unroll
            for (int m = 0; m < 4; ++m) Lh[j + 8 * m] = 0;
#pragma unroll
            for (int m = 0; m < 16; ++m) rk[m] = __hip_atomic_fetch_add(Lh + (ide[m] >> PEER_EB_LOG), 1, __ATOMIC_RELAXED, __HIP_MEMORY_SCOPE_WORKGROUP);
            {
                const int h0 = ((volatile LAS int*)Lh)[4 * j], h1 = ((volatile LAS int*)Lh)[4 * j + 1], h2 = ((volatile LAS int*)Lh)[4 * j + 2], h3 = ((volatile LAS int*)Lh)[4 * j + 3];
                const int tot = (h0 + h1) + (h2 + h3); int inc = tot;
#pragma unroll
                for (int o = 1; o < 8; o <<= 1) { const int tt = __shfl_up(inc, o, 8); if (j >= o) inc += tt; }
                const int ex = inc - tot;
                ((volatile LAS int*)Lh)[4 * j] = ex; ((volatile LAS int*)Lh)[4 * j + 1] = ex + h0; ((volatile LAS int*)Lh)[4 * j + 2] = ex + h0 + h1; ((volatile LAS int*)Lh)[4 * j + 3] = ex + h0 + h1 + h2;
            }
#pragma unroll
            for (int m = 0; m < 16; ++m) { const int pos = ((volatile LAS int*)Lh)[ide[m] >> PEER_EB_LOG] + rk[m]; Le[pos] = ide[m]; Lg[pos] = gte[m] * SVI_[ide[m]]; Lp[pos] = __builtin_bit_cast(int, SUI_[ide[m]] * sxi); }
        }
#ifdef PEER_DUP_S
        }; qs_(); __builtin_amdgcn_sched_barrier(0); qs_();
#endif
        v4u R0[4], R1[4], R2[4], R3[4];
#define PEER_LOADU(RR, S0) do { const size_t ro_ = (size_t)(Le[(S0)] & (scratch_dst ? PEER_PROBE_MASK : 0xFFFF)) * 512 + 16 * j; _Pragma("unroll") for (int q = 0; q < 4; ++q) RR[q] = *(const GAS v4u*)(EU4 + ro_ + 128 * q); } while (0)
#define PEER_DOTU(RR, EOUT) do { int h0_ = 0, h1_ = 0, l0_ = 0, l1_ = 0; \
            _Pragma("unroll") for (int q = 0; q < 4; q += 2) _Pragma("unroll") for (int w_ = 0; w_ < 4; ++w_) { \
                h0_ = __builtin_amdgcn_sdot8((int)RR[q][w_], xh[4 * q + w_], h0_, false); l0_ = __builtin_amdgcn_sdot8((int)RR[q][w_], xl[4 * q + w_], l0_, false); \
                h1_ = __builtin_amdgcn_sdot8((int)RR[q + 1][w_], xh[4 * q + 4 + w_], h1_, false); l1_ = __builtin_amdgcn_sdot8((int)RR[q + 1][w_], xl[4 * q + 4 + w_], l1_, false); } \
            int e_ = ((h0_ + h1_) << 4) + (l0_ + l1_); e_ = DPP_ADDI(e_, 0xB1, 0xF); e_ = DPP_ADDI(e_, 0x4E, 0xF); e_ = DPP_ADDI(e_, 0x141, 0xF); EOUT = e_; } while (0)
#define PEER_SWEEPU(BODY0, BODY1, BODY2, BODY3) do { \
            PEER_LOADU(R0, 0); PEER_LOADU(R1, 1); PEER_LOADU(R2, 2); PEER_LOADU(R3, 3); \
            for (int s = 0; s < 128; s += 4) { \
                BODY0; if (s + 4 < 128) PEER_LOADU(R0, s + 4); \
                BODY1; if (s + 4 < 128) PEER_LOADU(R1, s + 5); \
                BODY2; if (s + 4 < 128) PEER_LOADU(R2, s + 6); \
                BODY3; if (s + 4 < 128) PEER_LOADU(R3, s + 7); } } while (0)
#define PEER_FIN(RR, SS) do { int e1_; PEER_DOTU(RR, e1_); Lx[(SS)] = e1_; } while (0)
        PEER_SWEEPU(PEER_FIN(R0, s), PEER_FIN(R1, s + 1), PEER_FIN(R2, s + 2), PEER_FIN(R3, s + 3));
#ifdef PEER_DUP_U
        PEER_SWEEPU(PEER_FIN(R0, s), PEER_FIN(R1, s + 1), PEER_FIN(R2, s + 2), PEER_FIN(R3, s + 3));
#endif
#undef PEER_FIN
        float yscale; int csum8;
        {
            float cf_[16]; float cmax = 0.f;
#pragma unroll
            for (int i = 0; i < 16; ++i) { const int ix = 16 * j + i; cf_[i] = Lg[ix] * gelu_cdf((float)Lx[ix] * __builtin_bit_cast(float, Lp[ix])); cmax = fmaxf(cmax, fabsf(cf_[i])); }
            cmax = fmaxf(cmax, __shfl_xor(cmax, 1, 8)); cmax = fmaxf(cmax, __shfl_xor(cmax, 2, 8)); cmax = fmaxf(cmax, __shfl_xor(cmax, 4, 8));
            const float cqs = cmax > 0.f ? 127.f / cmax : 0.f; yscale = cmax > 0.f ? cmax / 127.f : 0.f;
            int pk_[4]; int cs_ = 0;
#pragma unroll
            for (int m = 0; m < 4; ++m) { const int q0 = (int)rintf(cf_[4 * m] * cqs), q1 = (int)rintf(cf_[4 * m + 1] * cqs), q2 = (int)rintf(cf_[4 * m + 2] * cqs), q3 = (int)rintf(cf_[4 * m + 3] * cqs);
                cs_ += (q0 + q1) + (q2 + q3);
                pk_[m] = (int)((unsigned)(q0 & 0xff) | ((unsigned)(q1 & 0xff) << 8) | ((unsigned)(q2 & 0xff) << 16) | ((unsigned)q3 << 24)); }
            cs_ += __shfl_xor(cs_, 1, 8); cs_ += __shfl_xor(cs_, 2, 8); cs_ += __shfl_xor(cs_, 4, 8); csum8 = 8 * cs_;
#pragma unroll
            for (int m = 0; m < 4; ++m) Lp[4 * j + m] = pk_[m];
        }
#ifndef PEER_DUP_V
#define PEER_DUP_V 1
#endif
#pragma unroll
        for (int HH = 0; HH < 2 * PEER_DUP_V; ++HH) { const int H = HH & 1;
            int ya[32], yl[32];
#pragma unroll
            for (int i = 0; i < 32; ++i) { ya[i] = 0; yl[i] = 0; }
            v4u RV[8][2];
#define PEER_ROFFV(S0) ((size_t)(Le[(S0)] & (scratch_dst ? PEER_PROBE_MASK : 0xFFFF)) * 512 + 256 * H + 16 * j)
#pragma unroll
            for (int r = 0; r < 8; ++r) { const size_t ro_ = PEER_ROFFV(r); RV[r][0] = *(const GAS v4u*)(EV4 + ro_); RV[r][1] = *(const GAS v4u*)(EV4 + ro_ + 128); }
            for (int bt = 0; bt < 16; ++bt) {
                const int c0_ = Lp[2 * bt], c1_ = Lp[2 * bt + 1];
                size_t ron[8];
#pragma unroll
                for (int r = 0; r < 8; ++r) ron[r] = (bt + 1 < 16) ? PEER_ROFFV(8 * bt + 8 + r) : 0;
#pragma unroll
                for (int q = 0; q < 2; ++q) {
#pragma unroll
                    for (int hb = 0; hb < 2; ++hb) { const int cq_ = hb ? c1_ : c0_;
#pragma unroll
                        for (int w_ = 0; w_ < 4; ++w_) { const unsigned a0 = RV[4 * hb][q][w_], a1 = RV[4 * hb + 1][q][w_], a2 = RV[4 * hb + 2][q][w_], a3 = RV[4 * hb + 3][q][w_];
                            const unsigned p0 = __builtin_amdgcn_perm(a1, a0, 0x05010400u), p1 = __builtin_amdgcn_perm(a1, a0, 0x07030602u), p2 = __builtin_amdgcn_perm(a3, a2, 0x05010400u), p3 = __builtin_amdgcn_perm(a3, a2, 0x07030602u);
                            unsigned Tb[4]; Tb[0] = __builtin_amdgcn_perm(p2, p0, 0x05040100u); Tb[1] = __builtin_amdgcn_perm(p2, p0, 0x07060302u); Tb[2] = __builtin_amdgcn_perm(p3, p1, 0x05040100u); Tb[3] = __builtin_amdgcn_perm(p3, p1, 0x07060302u);
#pragma unroll
                            for (int b_ = 0; b_ < 4; ++b_) { ya[16 * q + 4 * w_ + b_] = __builtin_amdgcn_sdot4((int)Tb[b_], cq_, ya[16 * q + 4 * w_ + b_], false);
                                yl[16 * q + 4 * w_ + b_] = __builtin_amdgcn_sdot4((int)(Tb[b_] & 0x0F0F0F0Fu), cq_, yl[16 * q + 4 * w_ + b_], false); } } }
                    if (bt + 1 < 16) {
#pragma unroll
                        for (int r = 0; r < 8; ++r) RV[r][q] = *(const GAS v4u*)(EV4 + ron[r] + 128 * q); }
                }
            }
#undef PEER_ROFFV
            int to_ = grp * 8 + g, jo_ = j; asm volatile("" : "+v"(to_), "+v"(jo_));
            const int b = to_ / SEQ; const unsigned eo_ = (unsigned)to_ * D + 128 * H + 8 * jo_;
            const float* g2 = mod_ + b * NMOD + 5120 + 128 * H + 8 * jo_;
            const bf16* ip = X1B_ + eo_; float* op = ((scratch_dst || HH + 2 < 2 * PEER_DUP_V) ? WSP(float, WS_SCORES) : out_) + eo_;
#pragma unroll
            for (int q = 0; q < 2; ++q) { __builtin_amdgcn_sched_barrier(0);
#pragma unroll
                for (int w_ = 0; w_ < 4; ++w_)
#pragma unroll
                    for (int nh = 0; nh < 2; ++nh) { const int co = 256 * (2 * (w_ & 1) + nh) + 64 * q + 4 * (w_ >> 1); const int yb = 16 * q + 4 * w_ + 2 * nh;
                        const unsigned long long xw_ = *(const GAS unsigned long long*)(ip + co); const unsigned xlo_ = (unsigned)xw_, xhi_ = (unsigned)(xw_ >> 32); const f32x4 x1 = (f32x4){bflo(xlo_), bfhi(xlo_), bflo(xhi_), bfhi(xhi_)}; const f32x4 gg = *(const f32x4*)(g2 + co) * yscale;
                        f32x4 o; o.x = x1.x + gg.x * (float)(yl[yb] - csum8); o.y = x1.y + gg.y * (float)((ya[yb] - yl[yb]) >> 4); o.z = x1.z + gg.z * (float)(yl[yb + 1] - csum8); o.w = x1.w + gg.w * (float)((ya[yb + 1] - yl[yb + 1]) >> 4);
                        *(GAS f32x4*)(op + co) = o; } }
        }
#undef PEER_LOADU
#undef PEER_DOTU
#undef PEER_SWEEPU
    }
}

DI void ph_inproj(const Frame& F) {
    pg8::Gemm g{WSP(bf16, WS_XN), WSP(bf16, WS_WIN), T, NPROJ, D}; pg8::StaticOrder S; S.init(T, NPROJ, F.G, (int)blockIdx.x);
    pg8::EpiBf16<0> E{WSP(bf16, WS_PROJ), NPROJ, nullptr, 0, 0, 1.f};
    pg8::gemm_phase<pg8::EpiBf16<0>, pg8::StaticOrder, PG8_ALIGN, PG8_SP2>(F.lds, g, S, E);
}
DI void ph_mix(const Frame& F, bool probe_first) {
    stage_conv_w(F);
    {
        int u = F.vcu;
        MlLocalRegs ra;
        if (u < 2048) ml_local_load(F, u >> 6, u & 63, ra);
        const int gwv = F.vcu * NWAVES + F.wave, NGWv = F.G * NWAVES;
        int eb = 2 * gwv;
        while (u < 2048) {
            const int un = u + F.G;
            MlLocalRegs rb;
            if (un < 2048) ml_local_load(F, un >> 6, un & 63, rb);
            ExpRows2 er; const bool ew = eb < 16384;
            if (ew) exp_load2(F, eb, er);
            ml_local_unit(F, u >> 6, u & 63, ra);
            if (ew) exp_conv2(F, eb, er);
            eb += 2 * NGWv;
            ra = rb; u = un;
        }
        for (; eb < 16384; eb += 2 * NGWv) { ExpRows2 er; exp_load2(F, eb, er); exp_conv2(F, eb, er); }
    }
    (void)probe_first;
}
DI void ph_scan_attn(const Frame& F) {
    ml_scan_phase(F);
    __syncthreads();
    const int gwv = F.vcu * NWAVES + F.wave, NGWv = F.G * NWAVES;
    int eb = 16384 + 2 * gwv;
    for (int u = F.vcu; u < 1024; u += F.G) { const int qb = 15 - (u >> 6), bh = u & 63;
        ExpRows2 er; const bool ew = eb < 32768;
        if (ew) exp_load2(F, eb, er);
        sb_unit(F, bh >> 3, bh & 7, qb);
        if (ew) exp_conv2(F, eb, er);
        eb += 2 * NGWv; }
    for (; eb < 32768; eb += 2 * NGWv) { ExpRows2 er; exp_load2(F, eb, er); exp_conv2(F, eb, er); }
}
DI void ph_mlout(const Frame& F) { stage_conv_w(F); for (int u = F.vcu; u < 2048; u += F.G) { const int un = u + F.G; ml_out_unit(F, u >> 6, u & 63, un < 2048 ? (un >> 6) : -1, un & 63); } }
#ifndef P5_ALIGN
#define P5_ALIGN PG8_ALIGN
#endif
DI void ph_outproj(const Frame& F) {
    pg8::Gemm g{WSP(bf16, WS_MIX), WSP(bf16, WS_WOUT), T, D, D}; pg8::StaticOrder S; S.init(T, D, F.G, (int)blockIdx.x);
    pg8::EpiResGateBf16 E{inp(I_X), WSP(pg8::bf16_t, WS_X1B), WSP(float, WS_MOD) + 2048, NMOD, SEQ, D};
    pg8::gemm_phase<pg8::EpiResGateBf16, pg8::StaticOrder, P5_ALIGN, PG8_SP2>(F.lds, g, S, E);
}
DI void ph_scores(const Frame& F) {
    pg8::Gemm g{WSP(bf16, WS_XN), WSP(bf16, WS_WEFF), T, NSC, D}; pg8::StaticOrder S; S.init(T, NSC, F.G, (int)blockIdx.x);
    EpiTopK E{WSP(int, WS_IDX), WSP(float, WS_GATE)};
    pg8::Unit un;
    for (int i = 0; S.next(i, un); ++i) { OneUnit S1{un}; pg8::gemm_phase<EpiTopK, OneUnit, false, PG8_SP2>(F.lds, g, S1, E); }
}
constexpr int N_PHASES = 11;
struct Args { const float* in[19]; float* out; unsigned char* ws; int ph_lo, ph_hi; };
__global__ void __launch_bounds__(NTHR, 2) hybrid_fwd(Args args) {
    extern __shared__ __attribute__((aligned(16))) unsigned char lds_raw[];
    Frame F;
    F.lds = (LAS unsigned char*)lds_raw;
    F.MISC = (volatile LAS unsigned*)(F.lds + LDSCTL_OFF + 320);
    F.tid = threadIdx.x; F.lane = F.tid & 63; F.wave = __builtin_amdgcn_readfirstlane(F.tid >> 6);
    F.G = gridDim.x; { const int bx = blockIdx.x; F.vcu = (F.G % 8 == 0) ? (bx % 8) * (F.G / 8) + bx / 8 : bx; }
    F.ws = args.ws;
    F.ctl = (gu32*)(F.ws + WS_CTL);
    for (int u = F.tid; u < (LDS_BYTES - LDSCTL_OFF) / 4; u += NTHR) ((LAS unsigned*)(F.lds + LDSCTL_OFF))[u] = 0u;
    __syncthreads();
    const int lo = args.ph_lo, hi = args.ph_hi;
    const bool one_launch = (hi - lo) > 1;
    XcdBarrier bar; bar.bar = (unsigned*)(F.ctl + CW_BAR); bar.x = 0; bar.st = nullptr;
    if (one_launch) bar = xcd_barrier_post((unsigned*)(F.ctl + CW_BAR), F.MISC + 8);
#ifndef PHMASK
#define PHMASK 0x7ff
#endif
#define IN(k) (((PHMASK >> (k)) & 1) && lo <= (k) && (k) < hi)
#define SEAM(k) do { if (IN(k) && IN((k) + 1)) xcd_barrier(bar); } while (0)
#ifndef REPMASK
#define REPMASK 0
#endif

#define RUN(k, ...) do { if (IN(k)) { if ((REPMASK >> (k)) & 1) { { const bool first = true; (void)first; __VA_ARGS__; } xcd_barrier(bar); } { const bool first = false; (void)first; __VA_ARGS__; } } } while (0)
    RUN(0, p0_phase(F, first ? P0_PARTS : 15)); SEAM(0);
    RUN(1, norm_phase<true>(F, inp(I_X), inp(I_GN1), 0, 1024)); SEAM(1);
    RUN(2, ph_inproj(F)); SEAM(2);
    RUN(3, ph_mix(F, first)); SEAM(3);
    RUN(10, ph_scan_attn(F)); if (IN(10) && IN(4)) xcd_barrier(bar);
    RUN(4, ph_mlout(F)); SEAM(4);
    RUN(5, ph_outproj(F)); SEAM(5);
    RUN(6, norm_phase<false, true>(F, (const float*)WSP(bf16, WS_X1B), inp(I_GN2), 3072, 4096)); SEAM(6);
    RUN(7, ph_scores(F)); if (IN(7) && IN(9)) xcd_barrier(bar);
    RUN(9, peer_phase(F, first));
#undef RUN
#undef IN
#undef SEAM
}

#ifndef MK_PER_PHASE
#define MK_PER_PHASE 0
#endif
extern "C" void kernel_launch(void* const* d_in, const int* in_sizes, int n_in, void* d_out, int out_size, void* d_ws, size_t ws_size, hipStream_t stream) {
    static int grid = 0;
    if (grid == 0) {
        if (n_in != 19 || in_sizes[0] != T * D || out_size != T * D || ws_size < WS_END) { fprintf(stderr, "kernel_launch: unexpected shapes (n_in %d, in0 %d, out %d, ws %zu)\n", n_in, n_in > 0 ? in_sizes[0] : -1, out_size, ws_size); grid = -1; return; }
        int dev = 0, cus = 0, per_cu = 0;
        if (hipGetDevice(&dev) != hipSuccess || hipDeviceGetAttribute(&cus, hipDeviceAttributeMultiprocessorCount, dev) != hipSuccess) { grid = -1; return; }
        if (hipFuncSetAttribute((const void*)hybrid_fwd, hipFuncAttributeMaxDynamicSharedMemorySize, LDS_BYTES) != hipSuccess) { fprintf(stderr, "kernel_launch: hipFuncSetAttribute failed\n"); grid = -1; return; }
        if (hipOccupancyMaxActiveBlocksPerMultiprocessor(&per_cu, (const void*)hybrid_fwd, NTHR, LDS_BYTES) != hipSuccess || per_cu < 1) fprintf(stderr, "kernel_launch: occupancy query says %d\n", per_cu);
        (void)hipGetLastError();
        grid = cus;
    }
    if (grid < 0) return;
    if (hipMemsetAsync((char*)d_ws + WS_CTL, 0, CTL_ZERO_BYTES, stream) != hipSuccess) { fprintf(stderr, "kernel_launch: memset failed\n"); return; }
    Args a{};
    for (int i = 0; i < 19; ++i) a.in[i] = (const float*)d_in[i];
    a.out = (float*)d_out; a.ws = (unsigned char*)d_ws;
#if MK_PER_PHASE
    { const int order[N_PHASES] = {0, 1, 2, 3, 10, 4, 5, 6, 7, 8, 9}; for (int i = 0; i < N_PHASES; ++i) { a.ph_lo = order[i]; a.ph_hi = order[i] + 1; hipLaunchKernelGGL(hybrid_fwd, dim3(grid), dim3(NTHR), LDS_BYTES, stream, a); } }
#else
    a.ph_lo = 0; a.ph_hi = N_PHASES;
    hipLaunchKernelGGL(hybrid_fwd, dim3(grid), dim3(NTHR), LDS_BYTES, stream, a);
#endif
    const hipError_t le = hipPeekAtLastError();
    if (le != hipSuccess) fprintf(stderr, "kernel_launch: launch failed: %s\n", hipGetErrorName(le));
}
```

```cpp
#include <cmath>
#include <hip/hip_runtime.h>
#include <cstdio>
#include <cstdint>
namespace pg8 {
#define PG8_LAS __attribute__((address_space(3)))
typedef unsigned short bf16_t;
typedef short bf16x8 __attribute__((ext_vector_type(8)));
typedef float f32x4 __attribute__((ext_vector_type(4)));
typedef unsigned u32x4 __attribute__((ext_vector_type(4)));
constexpr int BM = 256, BK = 64, HALF = 128, HTB = HALF * BK * 2  , STAGE_BYTES = 8 * HTB, NXCD = 8,
#ifndef PG8_WGM
#define PG8_WGM 4
#endif
WGM = PG8_WGM;

__host__ __device__ __forceinline__ int lds_byte(int r, int c) { const int st = (r >> 4) * 2 + (c >> 5), rr = r & 15, cc = c & 31, ob = rr * 64 + cc * 2; return st * 1024 + (ob ^ (((ob >> 9) & 1) << 5)); }
__host__ __device__ __forceinline__ void stage_rc(int b, int& R, int& C) { const int st = b / 1024, sb = b % 1024, swz = sb ^ (((sb >> 9) & 1) << 5); R = (st >> 1) * 16 + swz / 64; C = (st & 1) * 32 + (swz % 64) / 2; }
__host__ __device__ __forceinline__ int perm32(int rho) { const int n = rho >> 4, i = rho & 15; return 8 * (i >> 2) + 4 * n + (i & 3); }

struct Unit { int pm, pn; };
struct Gemm { const bf16_t* A; const bf16_t* Bt; int M, N, K; };

struct StaticOrder {
    int nM, nN, nwg, G, c;
    __host__ __device__ void init(int M, int N, int G_, int c_) { nM = M / BM; nN = N / BM; nwg = nM * nN; G = G_; c = c_; }
    __host__ __device__ bool next(int i, Unit& u) const {
        const long L = (long)i * G + c; if (L >= nwg) return false;
        int wgid = (int)L; { const int q = nwg / NXCD, r = nwg % NXCD, xcd = wgid % NXCD, off = wgid / NXCD; wgid = (xcd < r ? xcd * (q + 1) : r * (q + 1) + (xcd - r) * q) + off; }
        const int nig = WGM * nN, gid = wgid / nig, fm = gid * WGM, gsz = (nM - fm) < WGM ? (nM - fm) : WGM;
        u.pm = fm + ((wgid % nig) % gsz); u.pn = (wgid % nig) / gsz; return true;
    }
    __device__ __forceinline__ void a_ready(const Unit&) const {}
    __device__ __forceinline__ void done(const Unit&) const {}
};

__device__ __forceinline__ unsigned cvt_pk_bf16(float lo, float hi) { unsigned r; asm volatile("v_cvt_pk_bf16_f32 %0, %1, %2" : "=v"(r) : "v"(lo), "v"(hi)); return r; }
typedef float f32x2 __attribute__((ext_vector_type(2)));
__device__ __forceinline__ f32x2 gelu_pk(f32x2 v) {
    const f32x2 av = __builtin_elementwise_abs(v), d = av * 0.2316418882f + 1.0f;
    f32x2 t; t.x = __builtin_amdgcn_rcpf(d.x); t.y = __builtin_amdgcn_rcpf(d.y);
    f32x2 q = t * 0.5307027145f + (-0.7265760135f); q = q * t + 0.7107068705f; q = q * t + (-0.142248368f); q = q * t + 0.127414796f; q = q * t;
    const f32x2 s = (v * v) * (-0.72134752044f);
    f32x2 e; e.x = __builtin_amdgcn_exp2f(s.x); e.y = __builtin_amdgcn_exp2f(s.y);
    const f32x2 m = v * (q * e), r = v - m;
    f32x2 o; o.x = v.x < 0.f ? m.x : r.x; o.y = v.y < 0.f ? m.y : r.y; return o;
}

template <int ACT  > struct EpiBf16 {
    static constexpr bool PERM = true, AFTER_DRAIN = false; static_assert(ACT == 0 || ACT == 1, "EpiBf16: ACT is 0 (none) or 1 (gelu_pk)");
    bf16_t* O; int ldc; const float* bias; int split_cols; size_t split_stride; float scale0;
    __device__ __forceinline__ void operator()(const f32x4 (&acc)[2][2][4][2], const Unit& u, int wr, int wc, int fr, int fq) const {
        const int row0 = u.pm * BM + wr * 64 + fr; int colt = u.pn * BM; bf16_t* base = O;
        float sc = 1.f; if (split_cols) { const int t = colt / split_cols; base += (size_t)t * split_stride; colt -= t * split_cols; if (t == 0) sc = scale0; }
        const int col0 = colt + wc * 32 + 8 * fq, bcol0 = u.pn * BM + wc * 32 + 8 * fq;
        f32x4 bv[2][2];
#pragma unroll
        for (int bj = 0; bj < 2; ++bj)
#pragma unroll
            for (int n = 0; n < 2; ++n) bv[bj][n] = bias ? *(const f32x4*)(bias + bcol0 + bj * HALF + 4 * n) : (f32x4){0.f, 0.f, 0.f, 0.f};
#pragma unroll
        for (int ai = 0; ai < 2; ++ai)
#pragma unroll
            for (int m = 0; m < 4; ++m) { bf16_t* rowp = base + (size_t)(row0 + ai * HALF + m * 16) * ldc + col0;
#pragma unroll
                for (int bj = 0; bj < 2; ++bj) { f32x4 v0 = acc[ai][bj][m][0] + bv[bj][0], v1 = acc[ai][bj][m][1] + bv[bj][1];
                    if (ACT == 1) { f32x2 a = gelu_pk((f32x2){v0[0], v0[1]}), b = gelu_pk((f32x2){v0[2], v0[3]}), c = gelu_pk((f32x2){v1[0], v1[1]}), d = gelu_pk((f32x2){v1[2], v1[3]});
                        v0 = (f32x4){a.x, a.y, b.x, b.y}; v1 = (f32x4){c.x, c.y, d.x, d.y}; }
                    v0 = v0 * sc; v1 = v1 * sc; u32x4 w; w.x = cvt_pk_bf16(v0[0], v0[1]); w.y = cvt_pk_bf16(v0[2], v0[3]); w.z = cvt_pk_bf16(v1[0], v1[1]); w.w = cvt_pk_bf16(v1[2], v1[3]);
                    *(u32x4*)(rowp + bj * HALF) = w; } }
    }
};
template <class Epi, class Sched, bool ALIGN_EPI = false, bool SP2 = false>
__device__ __forceinline__ void gemm_phase(PG8_LAS unsigned char* lds, const Gemm g, const Sched& S, const Epi& E) {
    const int tid = threadIdx.x, wid = __builtin_amdgcn_readfirstlane(tid >> 6), lane = tid & 63, wr = wid >> 2, wc = wid & 3, fr = lane & 15, fq = lane >> 4;
    const int K = g.K, nt = K / BK;
    unsigned voffA[2], voffB[2];
#pragma unroll
    for (int i = 0; i < 2; ++i) { int R, C; stage_rc(tid * 16 + i * 8192, R, C); const int Rb = Epi::PERM ? ((R & ~31) + perm32(R & 31)) : R;
        voffA[i] = (unsigned)(R * K + C) * 2u; voffB[i] = (unsigned)(Rb * K + C) * 2u; }
    const size_t kstep = (size_t)(BK * 2);
    const size_t hstep = (size_t)HALF * K * 2;
    const size_t tstep = 2 * hstep;
    const unsigned ldsw = (unsigned)wid * 1024u;
    const int aoff = lds_byte(wr * 64 + fr, fq * 8), boff = lds_byte(wc * 32 + fr, fq * 8);
#define PG8_SA(b, h) (((b) * 2 + (h)) * HTB)
#define PG8_SB(b, h) ((4 + (b) * 2 + (h)) * HTB)
#define PG8_STAGE(bufoff, gbase, voff) do { _Pragma("unroll") for (int _i = 0; _i < 2; ++_i) \
        __builtin_amdgcn_global_load_lds((const unsigned*)((const char*)(gbase) + (voff)[_i]), (PG8_LAS unsigned*)(lds + (bufoff) + ldsw + _i * 8192), 16, 0, 0); } while (0)
#define PG8_LDA(dst, b, h) do { _Pragma("unroll") for (int m = 0; m < 4; ++m) _Pragma("unroll") for (int k = 0; k < 2; ++k) dst[m][k] = *(const PG8_LAS bf16x8*)(lds + PG8_SA(b, h) + aoff + m * 2048 + k * 1024); } while (0)
#define PG8_LDB(dst, b, h) do { _Pragma("unroll") for (int n = 0; n < 2; ++n) _Pragma("unroll") for (int k = 0; k < 2; ++k) dst[n][k] = *(const PG8_LAS bf16x8*)(lds + PG8_SB(b, h) + boff + n * 2048 + k * 1024); } while (0)
#define PG8_MMA(ai, bj, At, Bt) do { __builtin_amdgcn_s_setprio(1); _Pragma("unroll") for (int m = 0; m < 4; ++m) _Pragma("unroll") for (int n = 0; n < 2; ++n) _Pragma("unroll") for (int k = 0; k < 2; ++k) \
        acc[ai][bj][m][n] = __builtin_amdgcn_mfma_f32_16x16x32_bf16(Bt[n][k], At[m][k], acc[ai][bj][m][n], 0, 0, 0); __builtin_amdgcn_s_setprio(0); } while (0)
#define PG8_WAIT_V(n) asm volatile("s_waitcnt vmcnt(" #n ")" ::: "memory")
#define PG8_WAIT_L(n) asm volatile("s_waitcnt lgkmcnt(" #n ")" ::: "memory")
#define PG8_BAR __builtin_amdgcn_s_barrier()
#define PG8_SCHED __builtin_amdgcn_sched_barrier(0)
    Unit cur, nxt; int ui = 0;
    if (!S.next(0, cur)) return;
    f32x4 acc[2][2][4][2];
#pragma unroll
    for (int a = 0; a < 2; ++a)
#pragma unroll
        for (int b = 0; b < 2; ++b)
#pragma unroll
            for (int m = 0; m < 4; ++m)
#pragma unroll
                for (int n = 0; n < 2; ++n) acc[a][b][m][n] = (f32x4){0.f, 0.f, 0.f, 0.f};
    bf16x8 At[4][2], B0[2][2], B1[2][2];
    const char* cA = (const char*)g.A + (size_t)cur.pm * tstep; const char* cB = (const char*)g.Bt + (size_t)cur.pn * tstep;
    S.a_ready(cur);
    if constexpr (SP2) {
        PG8_STAGE(PG8_SB(0, 0), cB, voffB); PG8_STAGE(PG8_SB(0, 1), cB + hstep, voffB); PG8_STAGE(PG8_SA(0, 0), cA, voffA); PG8_STAGE(PG8_SA(0, 1), cA + hstep, voffA);
        if (wr == 1) PG8_BAR;
        PG8_WAIT_V(2); PG8_BAR;
        PG8_STAGE(PG8_SB(1, 0), cB + kstep, voffB); PG8_STAGE(PG8_SA(1, 0), cA + kstep, voffA); PG8_STAGE(PG8_SB(1, 1), cB + hstep + kstep, voffB);
        PG8_WAIT_V(6); PG8_BAR;
    } else {
        PG8_STAGE(PG8_SB(0, 0), cB, voffB); PG8_STAGE(PG8_SA(0, 0), cA, voffA); PG8_STAGE(PG8_SB(0, 1), cB + hstep, voffB); PG8_STAGE(PG8_SA(0, 1), cA + hstep, voffA);
        if (wr == 1) PG8_BAR;
        PG8_WAIT_V(4); PG8_BAR;
        PG8_STAGE(PG8_SB(1, 0), cB + kstep, voffB); PG8_STAGE(PG8_SA(1, 0), cA + kstep, voffA); PG8_STAGE(PG8_SB(1, 1), cB + hstep + kstep, voffB);
        PG8_WAIT_V(6); PG8_BAR;
    }
    for (;;) {
        const bool has_next = S.next(ui + 1, nxt);
        const char* nA = has_next ? (const char*)g.A + (size_t)nxt.pm * tstep : cA; const char* nB = has_next ? (const char*)g.Bt + (size_t)nxt.pn * tstep : cB;
        for (int t = 0; t < nt; t += 2) {
            const bool last = (t == nt - 2);
            const char* a1 = cA + (size_t)(t + 1) * kstep;
            const char* a2 = last ? nA : cA + (size_t)(t + 2) * kstep; const char* b2 = last ? nB : cB + (size_t)(t + 2) * kstep;
            const char* a3 = a2 + kstep; const char* b3 = b2 + kstep;
            if (last && has_next) S.a_ready(nxt);
            if constexpr (SP2) {
            PG8_LDB(B0, 0, 0); PG8_LDB(B1, 0, 1); PG8_SCHED; PG8_LDA(At, 0, 0); PG8_STAGE(PG8_SA(1, 1), a1 + hstep, voffA);
            PG8_WAIT_V(8); PG8_WAIT_L(0); PG8_BAR; PG8_MMA(0, 0, At, B0); PG8_MMA(0, 1, At, B1); PG8_BAR; PG8_SCHED;
            PG8_LDA(At, 0, 1); PG8_STAGE(PG8_SB(0, 0), b2, voffB); PG8_STAGE(PG8_SB(0, 1), b2 + hstep, voffB); PG8_STAGE(PG8_SA(0, 0), a2, voffA);
            PG8_WAIT_V(8); PG8_WAIT_L(0); PG8_BAR; PG8_MMA(1, 0, At, B0); PG8_MMA(1, 1, At, B1); PG8_BAR; PG8_SCHED;
            PG8_LDB(B0, 1, 0); PG8_LDB(B1, 1, 1); PG8_SCHED; PG8_LDA(At, 1, 0); PG8_STAGE(PG8_SA(0, 1), a2 + hstep, voffA);
            PG8_WAIT_V(8); PG8_WAIT_L(0); PG8_BAR; PG8_MMA(0, 0, At, B0); PG8_MMA(0, 1, At, B1); PG8_BAR; PG8_SCHED;
            PG8_LDA(At, 1, 1); PG8_STAGE(PG8_SB(1, 0), b3, voffB); PG8_STAGE(PG8_SB(1, 1), b3 + hstep, voffB); PG8_STAGE(PG8_SA(1, 0), a3, voffA);
            PG8_WAIT_V(8); PG8_WAIT_L(0); PG8_BAR; PG8_MMA(1, 0, At, B0); PG8_MMA(1, 1, At, B1); PG8_BAR; PG8_SCHED;
            } else {
            PG8_LDB(B0, 0, 0); PG8_SCHED; PG8_LDA(At, 0, 0); PG8_STAGE(PG8_SA(1, 1), a1 + hstep, voffA);
            PG8_WAIT_L(8); PG8_BAR; PG8_WAIT_L(0); PG8_MMA(0, 0, At, B0); PG8_BAR; PG8_SCHED;
            PG8_LDB(B1, 0, 1); PG8_STAGE(PG8_SB(0, 0), b2, voffB);
            PG8_BAR; PG8_WAIT_L(0); PG8_MMA(0, 1, At, B1); PG8_BAR;
            PG8_LDA(At, 0, 1); PG8_STAGE(PG8_SA(0, 0), a2, voffA);
            PG8_BAR; PG8_WAIT_L(0); PG8_MMA(1, 0, At, B0); PG8_BAR; PG8_SCHED;
            PG8_STAGE(PG8_SB(0, 1), b2 + hstep, voffB);
            PG8_WAIT_V(6); PG8_BAR; PG8_MMA(1, 1, At, B1); PG8_BAR;
            PG8_LDB(B0, 1, 0); PG8_SCHED; PG8_LDA(At, 1, 0); PG8_STAGE(PG8_SA(0, 1), a2 + hstep, voffA);
            PG8_WAIT_L(8); PG8_BAR; PG8_WAIT_L(0); PG8_MMA(0, 0, At, B0); PG8_BAR; PG8_SCHED;
            PG8_LDB(B1, 1, 1); PG8_STAGE(PG8_SB(1, 0), b3, voffB);
            PG8_BAR; PG8_WAIT_L(0); PG8_MMA(0, 1, At, B1); PG8_BAR;
            PG8_LDA(At, 1, 1); PG8_STAGE(PG8_SA(1, 0), a3, voffA);
            PG8_BAR; PG8_WAIT_L(0); PG8_MMA(1, 0, At, B0); PG8_BAR; PG8_SCHED;
            PG8_STAGE(PG8_SB(1, 1), b3 + hstep, voffB);
            PG8_WAIT_V(6); PG8_BAR; PG8_MMA(1, 1, At, B1); PG8_BAR;
            }
        }
        if constexpr (ALIGN_EPI) { if (wr == 0) PG8_BAR; }
        if constexpr (!Epi::AFTER_DRAIN) { E(acc, cur, wr, wc, fr, fq); S.done(cur); }
        if (!has_next) break;
#pragma unroll
        for (int a = 0; a < 2; ++a)
#pragma unroll
            for (int b = 0; b < 2; ++b)
#pragma unroll
                for (int m = 0; m < 4; ++m)
#pragma unroll
                    for (int n = 0; n < 2; ++n) acc[a][b][m][n] = (f32x4){0.f, 0.f, 0.f, 0.f};
        cur = nxt; cA = nA; cB = nB; ++ui;
        if constexpr (ALIGN_EPI) { if (wr == 1) PG8_BAR; }
    }
    PG8_WAIT_V(0);
    if constexpr (!ALIGN_EPI) { if (wr == 0) PG8_BAR; }
    PG8_BAR;
    if constexpr (Epi::AFTER_DRAIN) { E.fused(acc, cur, wr, wc, fr, fq, lds, wid, lane); S.done(cur); }
#undef PG8_SA
#undef PG8_SB
#undef PG8_STAGE
#undef PG8_LDA
#undef PG8_LDB
#undef PG8_MMA
#undef PG8_WAIT_V
#undef PG8_WAIT_L
#undef PG8_BAR
#undef PG8_SCHED
}
}

#ifndef PG8_SP2
#define PG8_SP2 true
#endif
#ifndef PG8_ALIGN
#define PG8_ALIGN true
#endif

namespace pg8 {
struct EpiResGate {
    static constexpr bool PERM = false, AFTER_DRAIN = false;
    const float* base; float* out; const float* gate; int gate_ld; int rows_per_batch; int ldc;
    __device__ __forceinline__ void operator()(const f32x4 (&acc)[2][2][4][2], const Unit& u, int wr, int wc, int fr, int fq) const {
        const int row0 = u.pm * BM + wr * 64 + fr, col0 = u.pn * BM + wc * 32 + 4 * fq;
        const float* gp = gate + (size_t)((u.pm * BM) / rows_per_batch) * gate_ld + col0;
        f32x4 gv[2][2];
#pragma unroll
        for (int bj = 0; bj < 2; ++bj)
#pragma unroll
            for (int n = 0; n < 2; ++n) gv[bj][n] = *(const f32x4*)(gp + bj * HALF + n * 16);
#pragma unroll
        for (int ai = 0; ai < 2; ++ai)
#pragma unroll
            for (int m = 0; m < 4; ++m) { const size_t off = (size_t)(row0 + ai * HALF + m * 16) * ldc + col0;
#pragma unroll
                for (int bj = 0; bj < 2; ++bj)
#pragma unroll
                    for (int n = 0; n < 2; ++n) { const f32x4 bs = *(const f32x4*)(base + off + bj * HALF + n * 16);
                        *(f32x4*)(out + off + bj * HALF + n * 16) = bs + gv[bj][n] * acc[ai][bj][m][n]; } }
    }
};
struct EpiResGateBf16 {
    static constexpr bool PERM = false, AFTER_DRAIN = false;
    const float* base; bf16_t* out; const float* gate; int gate_ld; int rows_per_batch; int ldc;
    __device__ __forceinline__ void operator()(const f32x4 (&acc)[2][2][4][2], const Unit& u, int wr, int wc, int fr, int fq) const {
        const int row0 = u.pm * BM + wr * 64 + fr, col0 = u.pn * BM + wc * 32 + 4 * fq;
        const float* gp = gate + (size_t)((u.pm * BM) / rows_per_batch) * gate_ld + col0;
        f32x4 gv[2][2];
#pragma unroll
        for (int bj = 0; bj < 2; ++bj)
#pragma unroll
            for (int n = 0; n < 2; ++n) gv[bj][n] = *(const f32x4*)(gp + bj * HALF + n * 16);
#pragma unroll
        for (int ai = 0; ai < 2; ++ai) {
            f32x4 bs[4][2][2];
#pragma unroll
            for (int m = 0; m < 4; ++m) { const size_t off = (size_t)(row0 + ai * HALF + m * 16) * ldc + col0;
#pragma unroll
                for (int bj = 0; bj < 2; ++bj)
#pragma unroll
                    for (int n = 0; n < 2; ++n) bs[m][bj][n] = __builtin_nontemporal_load((const f32x4*)(base + off + bj * HALF + n * 16)); }
            __builtin_amdgcn_sched_barrier(0);
#pragma unroll
            for (int m = 0; m < 4; ++m) { const size_t off = (size_t)(row0 + ai * HALF + m * 16) * ldc + col0;
#pragma unroll
                for (int bj = 0; bj < 2; ++bj)
#pragma unroll
                    for (int n = 0; n < 2; ++n) { const f32x4 r = bs[m][bj][n] + gv[bj][n] * acc[ai][bj][m][n];
                        *(unsigned long long*)(out + off + bj * HALF + n * 16) = (unsigned long long)cvt_pk_bf16(r.x, r.y) | ((unsigned long long)cvt_pk_bf16(r.z, r.w) << 32); } }
        }
    }
};
struct EpiF32 {
    static constexpr bool PERM = false, AFTER_DRAIN = false;
    float* O; int ldc;
    __device__ __forceinline__ void operator()(const f32x4 (&acc)[2][2][4][2], const Unit& u, int wr, int wc, int fr, int fq) const {
        const int row0 = u.pm * BM + wr * 64 + fr, col0 = u.pn * BM + wc * 32 + 4 * fq;
#pragma unroll
        for (int ai = 0; ai < 2; ++ai)
#pragma unroll
            for (int m = 0; m < 4; ++m) { const size_t off = (size_t)(row0 + ai * HALF + m * 16) * ldc + col0;
#pragma unroll
                for (int bj = 0; bj < 2; ++bj)
#pragma unroll
                    for (int n = 0; n < 2; ++n) *(f32x4*)(O + off + bj * HALF + n * 16) = acc[ai][bj][m][n]; }
    }
};
}
#define GAS __attribute__((address_space(1)))
#define LAS __attribute__((address_space(3)))
typedef unsigned short bf16;
typedef unsigned v4u __attribute__((ext_vector_type(4)));
typedef float f32x4 __attribute__((ext_vector_type(4)));
typedef short bf16x8 __attribute__((ext_vector_type(8)));
typedef GAS unsigned gu32;
typedef GAS unsigned long long gu64;
#define RLX_AGENT __ATOMIC_RELAXED, __HIP_MEMORY_SCOPE_AGENT
#define LDS_WAIT() asm volatile("s_waitcnt lgkmcnt(0)" ::: "memory")
#define VM_WAIT() asm volatile("s_waitcnt vmcnt(0)" ::: "memory")
__device__ __forceinline__ unsigned long long rt() { return __builtin_amdgcn_s_memrealtime(); }
__device__ __forceinline__ unsigned f2bf(float f) { unsigned u = __builtin_bit_cast(unsigned, f); return (u + 0x7fffu + ((u >> 16) & 1u)) >> 16; }
__device__ __forceinline__ unsigned pk2(float lo, float hi) { return f2bf(lo) | (f2bf(hi) << 16); }

#define XB_TMO      128
#define XB_XCNT(j)  (256  + 64 * (j))
#define XB_XSUB(j)  (1280 + 64 * (j))
#define XB_XGEN(j)  (2304 + 64 * (j))
#define XB_TOP      3328
#define XB_TOPGEN   3392
#define XCD_BAR_WORDS 3456
#define XB_SPIN_CAP (1u << 24)

__device__ __forceinline__ unsigned xb_ld(unsigned* p)              { return __hip_atomic_load(p, __ATOMIC_RELAXED, __HIP_MEMORY_SCOPE_AGENT); }
__device__ __forceinline__ unsigned xb_add(unsigned* p, unsigned v) { return __hip_atomic_fetch_add(p, v, __ATOMIC_RELAXED, __HIP_MEMORY_SCOPE_AGENT); }
__device__ __forceinline__ unsigned xb_xcc_id() { return (unsigned)__builtin_amdgcn_s_getreg((3 << 11) | 20) & 0xFu; }
#define XB_SPIN(cond, bar) do { unsigned _sp = 0; while (cond) { __builtin_amdgcn_s_sleep(1); \
    if ((++_sp & 255u) == 0u) { if (xb_ld(&(bar)[XB_TMO])) break; if (_sp > XB_SPIN_CAP) { atomicAdd(&(bar)[XB_TMO], 1u); break; } } } } while (0)

struct XcdBarrier {
    unsigned* bar; unsigned x;
    volatile LAS unsigned* st;
};

__device__ __forceinline__ XcdBarrier xcd_barrier_post(unsigned* bar, volatile LAS unsigned* st) {
    XcdBarrier b; b.bar = bar; b.x = xb_xcc_id(); b.st = st;
    if (threadIdx.x == 0) (void)xb_add(&bar[XB_XCNT(b.x)], 1u);
    return b;
}
__device__ __forceinline__ void xcd_barrier_complete(unsigned* bar, unsigned x, unsigned& nloc, unsigned& nx) {
    const unsigned G = gridDim.x * gridDim.y * gridDim.z;
    unsigned sum, cnt, mine, sp = 0u;
    for (;;) {
        sum = 0u; cnt = 0u; mine = 0u;
#pragma unroll
        for (unsigned j = 0; j < 16; ++j) { const unsigned c = xb_ld(&bar[XB_XCNT(j)]); sum += c; cnt += (c > 0u) ? 1u : 0u; mine = (j == x) ? c : mine; }
        if (sum == G) break;
        __builtin_amdgcn_s_sleep(1);
        if ((++sp & 255u) == 0u) { if (xb_ld(&bar[XB_TMO])) break; if (sp > XB_SPIN_CAP) { atomicAdd(&bar[XB_TMO], 1u); break; } }
    }
    nloc = mine > 0u ? mine : 1u; nx = cnt > 0u ? cnt : 1u;
}

__device__ __forceinline__ void xcd_barrier(const XcdBarrier& b) {
    asm volatile("s_waitcnt vmcnt(0)" ::: "memory");
    __syncthreads();
    if (threadIdx.x == 0) {
        unsigned* bar = b.bar;
        __builtin_amdgcn_s_waitcnt(0);
        unsigned nloc = b.st[0], nx = b.st[1];
        if (nloc == 0u) { xcd_barrier_complete(bar, b.x, nloc, nx); b.st[0] = nloc; b.st[1] = nx; }
        const unsigned old = xb_add(&bar[XB_XSUB(b.x)], 1u);
        const unsigned gen = old / nloc;
        if (old + 1u == (gen + 1u) * nloc) {
            __builtin_amdgcn_fence(__ATOMIC_RELEASE, "agent");
            asm volatile("s_waitcnt vmcnt(0)" ::: "memory");
            const unsigned og = xb_add(&bar[XB_TOP], 1u);
            const unsigned tg = og / nx;
            if (og + 1u == (tg + 1u) * nx) xb_add(&bar[XB_TOPGEN], 1u);
            else XB_SPIN(xb_ld(&bar[XB_TOPGEN]) == tg, bar);
            __builtin_amdgcn_fence(__ATOMIC_ACQUIRE, "agent");
            xb_add(&bar[XB_XGEN(b.x)], 1u);
            asm volatile("s_waitcnt vmcnt(0)" ::: "memory");
        } else {
            XB_SPIN(xb_ld(&bar[XB_XGEN(b.x)]) == gen, bar);
            __builtin_amdgcn_fence(__ATOMIC_ACQUIRE, "agent");
            asm volatile("s_waitcnt vmcnt(0)" ::: "memory");
        }
    }
    __syncthreads();
}

constexpr int NWAVES = 8, NTHR = 512;
constexpr int NB = 8, SEQ = 4096, T = NB * SEQ, D = 1024, NPROJ = 3584, NIN = 3592, NMOD = 6144, NSC = 2048;
constexpr int C_QSB = 0, C_KSB = 512, C_VSB = 1024, C_QML = 1536, C_KML = 2048, C_VML = 2560, C_OML = 3072;
constexpr float EPS = 1e-6f, LOG2E = 1.4426950408889634f;
constexpr size_t MiB = 1u << 20;
constexpr size_t WS_CTL = 0, CTL_ZERO_BYTES = 1 * MiB;
constexpr size_t WS_MOD = 256 * 1024;
constexpr size_t WS_WIN = 2 * MiB, WS_WOUT = 10 * MiB, WS_WEFF = 12 * MiB;
constexpr size_t WS_XN = 16 * MiB;
constexpr size_t WS_PROJ = 80 * MiB;
constexpr size_t WS_MIX = 304 * MiB;
constexpr size_t WS_EXPU = 368 * MiB, WS_EXPV = 400 * MiB;
constexpr size_t WS_CST = 432 * MiB;
constexpr size_t WS_NST = 496 * MiB;
constexpr size_t WS_MST = 497 * MiB;
constexpr size_t WS_GATES = 498 * MiB;
constexpr size_t WS_XQ = 272 * MiB;
constexpr size_t WS_XS = 499 * MiB + 256 * 1024;
constexpr size_t WS_X1B = 208 * MiB;
constexpr size_t WS_SCORES = 80 * MiB;
constexpr size_t WS_IDX = 336 * MiB, WS_GATE = 352 * MiB;
constexpr size_t WS_SCL = 499 * MiB;
constexpr size_t WS_SUI = 499 * MiB + 65536, WS_SVI = 499 * MiB + 131072;
constexpr size_t WS_END = 500 * MiB;
constexpr int CW_Q3 = 64;
constexpr int CW_BAR = 4096;
constexpr int LDS_BYTES = 147456, LDSCTL_OFF = 143360;

typedef float f32x16 __attribute__((ext_vector_type(16)));
typedef float f32x2_t __attribute__((ext_vector_type(2)));
typedef __bf16 bf16x2_t __attribute__((ext_vector_type(2)));
typedef _Float16 f16x8 __attribute__((ext_vector_type(8)));
typedef short s16x4 __attribute__((ext_vector_type(4)));
typedef unsigned u32x2 __attribute__((ext_vector_type(2)));
#define DI __device__ __forceinline__
DI unsigned cvtpk(float lo, float hi) { f32x2_t v = {lo, hi}; bf16x2_t b = __builtin_convertvector(v, bf16x2_t); return __builtin_bit_cast(unsigned, b); }
DI float bflo(unsigned u) { return __uint_as_float(u << 16); }
DI float bfhi(unsigned u) { return __uint_as_float(u & 0xffff0000u); }
DI int crow(int i, int hi) { return (i & 3) + 8 * (i >> 2) + 4 * hi; }
DI int krow(int s, int hi, int j) { return 16 * s + 8 * (j >> 2) + 4 * hi + (j & 3); }
DI float swap_add(float v) { auto rr = __builtin_amdgcn_permlane32_swap(__float_as_uint(v), __float_as_uint(v), false, false); return __uint_as_float(rr[0]) + __uint_as_float(rr[1]); }
DI float swap_max(float v) { auto rr = __builtin_amdgcn_permlane32_swap(__float_as_uint(v), __float_as_uint(v), false, false); return fmaxf(__uint_as_float(rr[0]), __uint_as_float(rr[1])); }
DI float dot2bf(unsigned a, unsigned b, float acc) { return __builtin_amdgcn_fdot2_f32_bf16(__builtin_bit_cast(bf16x2_t, a), __builtin_bit_cast(bf16x2_t, b), acc, false); }
DI float ex2(float x) { return __builtin_amdgcn_exp2f(x); }
DI float lg2(float x) { return __builtin_amdgcn_logf(x); }
DI float fexp(float x) { return __builtin_amdgcn_exp2f(x * LOG2E); }
DI float wave_sum(float v) {
#pragma unroll
    for (int o = 1; o < 64; o <<= 1) v += __shfl_xor(v, o);
    return v;
}
DI float wave_max(float v) {
#pragma unroll
    for (int o = 1; o < 64; o <<= 1) v = fmaxf(v, __shfl_xor(v, o));
    return v;
}
#define DPP_MAXF(v, ctrl, rmask) fmaxf((v), __builtin_bit_cast(float, __builtin_amdgcn_update_dpp(0, __builtin_bit_cast(int, (v)), (ctrl), (rmask), 0xF, false)))
DI float wave_max_nonneg(float v) {
    v = DPP_MAXF(v, 0xB1, 0xF); v = DPP_MAXF(v, 0x4E, 0xF); v = DPP_MAXF(v, 0x141, 0xF); v = DPP_MAXF(v, 0x140, 0xF); v = DPP_MAXF(v, 0x142, 0xA); v = DPP_MAXF(v, 0x143, 0xC);
    return __builtin_bit_cast(float, __builtin_amdgcn_readlane(__builtin_bit_cast(int, v), 63));
}
#define DPP_ADDF(v, ctrl, rmask) ((v) + __builtin_bit_cast(float, __builtin_amdgcn_update_dpp(0, __builtin_bit_cast(int, (v)), (ctrl), (rmask), 0xF, false)))
DI float wave_sum_u(float v) {
    v = DPP_ADDF(v, 0xB1, 0xF); v = DPP_ADDF(v, 0x4E, 0xF); v = DPP_ADDF(v, 0x141, 0xF); v = DPP_ADDF(v, 0x140, 0xF); v = DPP_ADDF(v, 0x142, 0xA); v = DPP_ADDF(v, 0x143, 0xC);
    return __builtin_bit_cast(float, __builtin_amdgcn_readlane(__builtin_bit_cast(int, v), 63));
}
typedef short v4i16_t __attribute__((ext_vector_type(4)));
DI s16x4 trrd(LAS unsigned char* p) { return __builtin_bit_cast(s16x4, __builtin_amdgcn_ds_read_tr16_b64_v4i16((LAS v4i16_t*)p)); }
DI bf16x8 cat8(s16x4 a, s16x4 b) { return (bf16x8){a[0], a[1], a[2], a[3], b[0], b[1], b[2], b[3]}; }
#define MFMA_BF16(a, b, c) __builtin_amdgcn_mfma_f32_32x32x16_bf16((a), (b), (c), 0, 0, 0)
#define MFMA_F16(a, b, c) __builtin_amdgcn_mfma_f32_32x32x16_f16((a), (b), (c), 0, 0, 0)
DI unsigned pkh(float a, float b) { return __builtin_bit_cast(unsigned, __builtin_amdgcn_cvt_pkrtz(a, b)); }
DI bf16x8 packbf(const f32x16& x, int s) { v4u p; p.x = cvtpk(x[8 * s], x[8 * s + 1]); p.y = cvtpk(x[8 * s + 2], x[8 * s + 3]); p.z = cvtpk(x[8 * s + 4], x[8 * s + 5]); p.w = cvtpk(x[8 * s + 6], x[8 * s + 7]); return __builtin_bit_cast(bf16x8, p); }
DI f16x8 packh(const f32x16& x, int s) { v4u p; p.x = pkh(x[8 * s], x[8 * s + 1]); p.y = pkh(x[8 * s + 2], x[8 * s + 3]); p.z = pkh(x[8 * s + 4], x[8 * s + 5]); p.w = pkh(x[8 * s + 6], x[8 * s + 7]); return __builtin_bit_cast(f16x8, p); }

struct Frame {
    LAS unsigned char* lds;
    volatile LAS unsigned* MISC;
    gu32* ctl;
    unsigned char* ws;
    int tid, lane, wave, vcu, G;
};
DI const float* inp(int i) { const __attribute__((address_space(4))) unsigned long long* kp = (const __attribute__((address_space(4))) unsigned long long*)__builtin_amdgcn_kernarg_segment_ptr(); return (const float*)(const GAS float*)(*(volatile const __attribute__((address_space(4))) unsigned long long*)(kp + i)); }
enum { I_X = 0, I_C, I_WADA, I_BADA, I_GN1, I_WIN, I_BIG, I_BFG, I_CONVW, I_GQ, I_GK, I_GOSB, I_GOML, I_WOUT, I_GN2, I_WQ, I_SK, I_EU, I_EV, I_OUT };
#define WSP(type, off) ((type*)(F.ws + (off)))

DI void p0_transpose_item(const float* W, int K, int N, int ld, bf16* WT, LAS float* scr, int item, int lane) {
    const int nblk = N / 32, kb = item / nblk, nb = item % nblk, k0 = 64 * kb, n0 = 32 * nb;
    float tv[32];
#pragma unroll
    for (int i = 0; i < 32; ++i) tv[i] = W[(size_t)(k0 + 2 * i + (lane >> 5)) * ld + n0 + (lane & 31)];
#pragma unroll
    for (int i = 0; i < 32; ++i) scr[(2 * i + (lane >> 5)) * 33 + (lane & 31)] = tv[i];
    LDS_WAIT(); asm volatile("" ::: "memory");
    const int c = lane & 7;
#pragma unroll
    for (int j = 0; j < 4; ++j) { const int n = (lane >> 3) + 8 * j; const LAS float* s = scr + (8 * c) * 33 + n;
        v4u o; o.x = pk2(s[0 * 33], s[1 * 33]); o.y = pk2(s[2 * 33], s[3 * 33]); o.z = pk2(s[4 * 33], s[5 * 33]); o.w = pk2(s[6 * 33], s[7 * 33]);
        *(GAS v4u*)(WT + (size_t)(n0 + n) * K + k0 + 8 * c) = o; }
    LDS_WAIT(); asm volatile("" ::: "memory");
}
DI void p0_mod_block(const Frame& F, int item) {
    const float* const c_ = inp(I_C); const float* const w_ada_ = inp(I_WADA); const float* const b_ada_ = inp(I_BADA); float* const mod_ = WSP(float, WS_MOD);
    LAS float* scr = (LAS float*)(F.lds + F.wave * 16384);
    const int j = item * 64 + F.lane, d0 = F.wave * 128;
    const int rg = F.lane >> 4, cl = F.lane & 15;
    f32x4 wv[32];
    { const float* wp = w_ada_ + (size_t)(d0 + rg) * NMOD + item * 64 + 4 * cl;
#pragma unroll
      for (int i = 0; i < 32; ++i) wv[i] = __builtin_nontemporal_load((const GAS f32x4*)(wp + (size_t)(4 * i) * NMOD)); }
#pragma unroll
    for (int b = 0; b < 8; ++b)
#pragma unroll
        for (int q = 0; q < 2; ++q) { const float cv = c_[b * D + d0 + 64 * q + F.lane]; scr[b * 128 + 64 * q + F.lane] = cv / (1.f + fexp(-cv)); }
    LDS_WAIT(); asm volatile("" ::: "memory");
    f32x4 acc[8];
#pragma unroll
    for (int b = 0; b < 8; ++b) acc[b] = (f32x4){0.f, 0.f, 0.f, 0.f};
#pragma unroll
    for (int i = 0; i < 32; ++i)
#pragma unroll
        for (int b = 0; b < 8; ++b) acc[b] += wv[i] * scr[b * 128 + 4 * i + rg];
#pragma unroll
    for (int b = 0; b < 8; ++b)
#pragma unroll
        for (int c = 0; c < 4; ++c) { float v = acc[b][c]; v += __shfl_xor(v, 16); v += __shfl_xor(v, 32); acc[b][c] = v; }
    if (rg == 0) {
#pragma unroll
        for (int b = 0; b < 8; ++b) *(LAS f32x4*)(scr + 1024 + b * 64 + 4 * cl) = acc[b]; }
    __syncthreads();
    float tot = b_ada_[j];
#pragma unroll
    for (int w = 0; w < 8; ++w) tot += ((LAS float*)(F.lds + w * 16384))[1024 + F.wave * 64 + F.lane];
    mod_[F.wave * NMOD + j] = tot;
    __syncthreads();
}
DI void p0_weff_item(const Frame& F, int item) {
    const float* const sub_keys_ = inp(I_SK); const float* const w_q_peer_ = inp(I_WQ); bf16* const Weff_t_ = WSP(bf16, WS_WEFF);
    const int hp = item >> 4, dblk = item & 15, dt = F.wave >> 2, nt = F.wave & 3, r = F.lane & 31, hi = F.lane >> 5;
    const float* ap = w_q_peer_ + (size_t)(64 * dblk + 32 * dt + r) * NSC + hp * 128 + 8 * hi;
    const float* bp = sub_keys_ + (size_t)hp * 16384 + (size_t)(32 * nt + r) * 128 + 8 * hi;
    f32x4 av[16], bv[16];
#pragma unroll
    for (int kk = 0; kk < 8; ++kk) { av[2 * kk] = *(const GAS f32x4*)(ap + 16 * kk); av[2 * kk + 1] = *(const GAS f32x4*)(ap + 16 * kk + 4); bv[2 * kk] = *(const GAS f32x4*)(bp + 16 * kk); bv[2 * kk + 1] = *(const GAS f32x4*)(bp + 16 * kk + 4); }
    f32x16 acc;
#pragma unroll
    for (int i = 0; i < 16; ++i) acc[i] = 0.f;
#define WEFF_SPLIT(V0, V1, HI, LO) do { v4u h_, l_; \
        h_.x = cvtpk(V0.x, V0.y); h_.y = cvtpk(V0.z, V0.w); h_.z = cvtpk(V1.x, V1.y); h_.w = cvtpk(V1.z, V1.w); \
        l_.x = cvtpk(V0.x - bflo(h_.x), V0.y - bfhi(h_.x)); l_.y = cvtpk(V0.z - bflo(h_.y), V0.w - bfhi(h_.y)); l_.z = cvtpk(V1.x - bflo(h_.z), V1.y - bfhi(h_.z)); l_.w = cvtpk(V1.z - bflo(h_.w), V1.w - bfhi(h_.w)); \
        HI = __builtin_bit_cast(bf16x8, h_); LO = __builtin_bit_cast(bf16x8, l_); } while (0)
#pragma unroll
    for (int kk = 0; kk < 8; ++kk) { bf16x8 ah, al, bh, bl; WEFF_SPLIT(av[2 * kk], av[2 * kk + 1], ah, al); WEFF_SPLIT(bv[2 * kk], bv[2 * kk + 1], bh, bl);
        acc = MFMA_BF16(al, bh, acc); acc = MFMA_BF16(ah, bl, acc); acc = MFMA_BF16(ah, bh, acc); __builtin_amdgcn_sched_barrier(0); }
#undef WEFF_SPLIT
    bf16* op = Weff_t_ + (size_t)(hp * 128 + 32 * nt + r) * D + 64 * dblk + 32 * dt + 4 * hi;
#pragma unroll
    for (int g = 0; g < 4; ++g) *(GAS unsigned long long*)(op + 8 * g) = (unsigned long long)pk2(acc[4 * g], acc[4 * g + 1]) | ((unsigned long long)pk2(acc[4 * g + 2], acc[4 * g + 3]) << 32);
}
struct ExpRows2 { f32x4 v[2][4]; };
DI void exp_load2(const Frame& F, int blk0, ExpRows2& R) {
    const float* const expert_u_ = inp(I_EU); const float* const expert_v_ = inp(I_EV);
#pragma unroll
    for (int bb = 0; bb < 2; ++bb) { const int blk = blk0 + bb; const float* src = (blk < 16384 ? expert_u_ : expert_v_) + (size_t)(blk & 16383) * 1024 + 4 * F.lane;
#pragma unroll
        for (int k = 0; k < 4; ++k) R.v[bb][k] = __builtin_nontemporal_load((const GAS f32x4*)(src + 256 * k)); }
}
DI void exp_conv2(const Frame& F, int blk0, const ExpRows2& R) {
    float* const SUI_ = WSP(float, WS_SUI); float* const SVI_ = WSP(float, WS_SVI);
#pragma unroll
    for (int bb = 0; bb < 2; ++bb) { const int blk = blk0 + bb; const bool isu = blk < 16384; const int e = blk & 16383;
        float mx = 0.f;
#pragma unroll
        for (int k = 0; k < 4; ++k) mx = fmaxf(mx, fmaxf(fmaxf(fabsf(R.v[bb][k].x), fabsf(R.v[bb][k].y)), fmaxf(fabsf(R.v[bb][k].z), fabsf(R.v[bb][k].w))));
        mx = wave_max_nonneg(mx);
        {
            float best = 3.0e38f, bs = 0.f;
#define EXP_TRY(FAC) do { const float s_ = mx * ((FAC) / 7.f), inv_ = s_ > 0.f ? 1.f / s_ : 0.f; float er_ = 0.f; \
                _Pragma("unroll") for (int k = 0; k < 4; ++k) _Pragma("unroll") for (int c = 0; c < 4; ++c) { const float v_ = R.v[bb][k][c]; const float d_ = v_ - s_ * fminf(fmaxf(rintf(v_ * inv_), -7.f), 7.f); er_ += d_ * d_; } \
                er_ = wave_sum_u(er_); if (er_ < best) { best = er_; bs = s_; } } while (0)
            EXP_TRY(1.f); EXP_TRY(0.74f);
#undef EXP_TRY
            const float inv = bs > 0.f ? 1.f / bs : 0.f;
            unsigned w01[2] = {0u, 0u};
#pragma unroll
            for (int k = 0; k < 4; ++k)
#pragma unroll
                for (int c = 0; c < 4; ++c) { const int q = (int)fminf(fmaxf(rintf(R.v[bb][k][c] * inv), -7.f), 7.f); w01[k >> 1] |= (unsigned)((isu || (c & 1)) ? (q & 15) : (q + 8)) << (4 * (4 * (k & 1) + c)); }
            if (F.lane == 0) (isu ? SUI_ : SVI_)[e] = bs;
            typedef unsigned v2u_ __attribute__((ext_vector_type(2)));
            v2u_ wv; wv.x = w01[0]; wv.y = w01[1];
            *(GAS v2u_*)((isu ? WSP(unsigned char, WS_EXPU) : WSP(unsigned char, WS_EXPV)) + (size_t)e * 512 + 8 * F.lane) = wv;
        } }
}
#ifndef P0_PARTS
#define P0_PARTS 15
#endif
DI void p0_phase(const Frame& F, int parts = 15) {
    const float* const w_in_ = inp(I_WIN); bf16* const Win_t_ = WSP(bf16, WS_WIN); const float* const w_out_ = inp(I_WOUT); bf16* const Wout_t_ = WSP(bf16, WS_WOUT); const float* const expert_v_ = inp(I_EV); const float* const expert_u_ = inp(I_EU);
    LAS float* scr = (LAS float*)(F.lds + F.wave * 16384);
    const int gw = F.vcu * NWAVES + F.wave, NGW = F.G * NWAVES;
    if (parts & 1) for (int it = F.vcu; it < 96; it += F.G) p0_mod_block(F, it);
    constexpr int I_WIN = 16 * 112, I_WOUT = 16 * 32, NITEMS = I_WIN + I_WOUT;
    if (parts & 2) for (int it = gw; it < NITEMS; it += NGW) {
        int r = it;
        if (r < I_WIN) { p0_transpose_item(w_in_, D, NPROJ, NIN, Win_t_, scr, r, F.lane); continue; } r -= I_WIN;
        p0_transpose_item(w_out_, D, D, D, Wout_t_, scr, r, F.lane);
    }
    __syncthreads();
    if (parts & 8) for (int it = F.vcu; it < 256; it += F.G) p0_weff_item(F, it);
}

template <bool DOGATES, bool SRCB = false>
DI void norm_phase(const Frame& F, const float* src, const float* g, int shift_off, int scale_off) {
    const float* const w_in_ = inp(I_WIN); float* const mod_ = WSP(float, WS_MOD); bf16* const XN_ = WSP(bf16, WS_XN); float* const GATES_ = WSP(float, WS_GATES); const float* const b_igate_ = inp(I_BIG); const float* const b_fgate_ = inp(I_BFG);
    LAS float* W8 = (LAS float*)F.lds;
    if (DOGATES) {
        for (int i = 0; i < 16; ++i) { const int idx = F.tid + 512 * i; W8[idx] = w_in_[(size_t)(idx & 1023) * NIN + NPROJ + (idx >> 10)]; }
        __syncthreads();
    }
    const int gw = F.vcu * NWAVES + F.wave, NGW = F.G * NWAVES;
    for (int ch = gw; ch < T / 16; ch += NGW) {
        const int r0 = ch * 16, b = r0 / SEQ;
        f32x4 A[4], Bv[4];
#pragma unroll
        for (int j = 0; j < 4; ++j) { const int col = 4 * F.lane + 256 * j; const f32x4 gg = *(const f32x4*)(g + col), sc = *(const f32x4*)(mod_ + b * NMOD + scale_off + col);
            A[j] = gg * (sc + 1.0f); Bv[j] = *(const f32x4*)(mod_ + b * NMOD + shift_off + col); }
        f32x4 nx[4];
#define NORM_LOADROW(ROW) do { if (SRCB) { const GAS unsigned long long* xb_ = (const GAS unsigned long long*)((const bf16*)src + (size_t)(ROW) * D) + F.lane; \
              _Pragma("unroll") for (int j = 0; j < 4; ++j) { const unsigned long long w_ = __builtin_nontemporal_load(xb_ + 64 * j); const unsigned lo_ = (unsigned)w_, hi_ = (unsigned)(w_ >> 32); \
                  nx[j] = (f32x4){bflo(lo_), bfhi(lo_), bflo(hi_), bfhi(hi_)}; } } \
          else { const GAS f32x4* xr_ = (const GAS f32x4*)(src + (size_t)(ROW) * D) + F.lane; _Pragma("unroll") for (int j = 0; j < 4; ++j) nx[j] = __builtin_nontemporal_load(xr_ + 64 * j); } } while (0)
        NORM_LOADROW(r0);
        for (int rr = 0; rr < 16; ++rr) {
            const int row = r0 + rr;
            f32x4 v[4]; float s = 0.f;
#pragma unroll
            for (int j = 0; j < 4; ++j) { v[j] = nx[j]; s += (v[j].x * v[j].x + v[j].y * v[j].y) + (v[j].z * v[j].z + v[j].w * v[j].w); }
            if (rr + 1 < 16) NORM_LOADROW(row + 1);
            const float rstd = 1.f / sqrtf(wave_sum_u(s) * (1.f / D) + EPS);
#pragma unroll
            for (int j = 0; j < 4; ++j) v[j] = v[j] * rstd * A[j] + Bv[j];
            GAS unsigned long long* o8 = (GAS unsigned long long*)(XN_ + (size_t)row * D) + F.lane;
#pragma unroll
            for (int j = 0; j < 4; ++j) o8[64 * j] = (unsigned long long)pk2(v[j].x, v[j].y) | ((unsigned long long)pk2(v[j].z, v[j].w) << 32);
            if (SRCB) {
                float mx = 0.f;
#pragma unroll
                for (int j = 0; j < 4; ++j) mx = fmaxf(mx, fmaxf(fmaxf(fabsf(v[j].x), fabsf(v[j].y)), fmaxf(fabsf(v[j].z), fabsf(v[j].w))));
                mx = wave_max_nonneg(mx);
                const float sx = mx > 0.f ? 119.f / mx : 0.f;
                unsigned lo_[2] = {0u, 0u}, hi_[2] = {0u, 0u};
#pragma unroll
                for (int j = 0; j < 4; ++j)
#pragma unroll
                    for (int c = 0; c < 4; ++c) { const int t_ = (int)rintf(v[j][c] * sx) + 8; const int sh_ = 4 * (4 * (j & 1) + c);
                        lo_[j >> 1] |= (unsigned)(t_ & 15) << sh_; hi_[j >> 1] |= (unsigned)((t_ >> 4) & 15) << sh_; }
                typedef unsigned v2u_ __attribute__((ext_vector_type(2)));
                unsigned char* xq = WSP(unsigned char, WS_XQ) + (size_t)row * 1024 + 8 * F.lane;
                v2u_ hv, lv; hv.x = hi_[0]; hv.y = hi_[1]; lv.x = lo_[0] ^ 0x88888888u; lv.y = lo_[1] ^ 0x88888888u;
                *(GAS v2u_*)xq = hv; *(GAS v2u_*)(xq + 512) = lv;
                if (F.lane == 0) WSP(float, WS_XS)[row] = mx > 0.f ? mx / 119.f : 0.f;
            }
            if (DOGATES) {
                float res = 0.f;
#pragma unroll
                for (int hh = 0; hh < 8; ++hh) { float p = 0.f;
#pragma unroll
                    for (int j = 0; j < 4; ++j) { const f32x4 w = *(const LAS f32x4*)(W8 + hh * 1024 + 4 * F.lane + 256 * j); p += (v[j].x * w.x + v[j].y * w.y) + (v[j].z * w.z + v[j].w * w.w); }
                    p = wave_sum_u(p); if (F.lane == hh) res = p; }
                if (F.lane < 8) GATES_[(size_t)row * 8 + F.lane] = res + (F.lane < 4 ? b_igate_[F.lane] : b_fgate_[F.lane - 4]);
            }
        }
    }
}

DI void sb_unit(const Frame& F, int b, int h, int qb) {
    bf16* const PROJ_ = WSP(bf16, WS_PROJ); const float* const g_q_sb_ = inp(I_GQ); const float* const g_k_sb_ = inp(I_GK); bf16* const MIX_ = WSP(bf16, WS_MIX); const float* const g_out_sb_ = inp(I_GOSB);
    const int lane = F.lane, w = F.wave, r = lane & 31, hi = lane >> 5;
    const int i16 = lane & 15, qq = i16 >> 2, pp = i16 & 3, blk = (lane >> 4) & 1;
    LAS unsigned char* Wb = F.lds + w * 16384;
    const size_t rowbase = (size_t)b * SEQ; const int q0 = qb * 256, qw0 = q0 + 32 * w, tq = qw0 + r;
    const bf16* P = PROJ_;
    const bf16* kpiece[4]; const bf16* vpiece[4];
#pragma unroll
    for (int i = 0; i < 4; ++i) { const int krow_ = 8 * i + (lane >> 3), kch = (lane & 7) ^ ((krow_ >> 1) & 7); kpiece[i] = P + (rowbase + krow_) * NPROJ + C_KSB + h * 64 + 8 * kch;
        const int vkey = 16 * (i & 1) + (lane >> 2); vpiece[i] = P + (rowbase + vkey) * NPROJ + C_VSB + h * 64 + 32 * (i >> 1) + 8 * (lane & 3); }
#define SB_DMA(T_, BUF_) do { _Pragma("unroll") for (int i_ = 0; i_ < 4; ++i_) { \
        __builtin_amdgcn_global_load_lds((const unsigned*)(kpiece[i_] + (size_t)(32 * (T_)) * NPROJ), (LAS unsigned*)(Wb + 8192 * (BUF_) + 1024 * i_), 16, 0, 0); \
        __builtin_amdgcn_global_load_lds((const unsigned*)(vpiece[i_] + (size_t)(32 * (T_)) * NPROJ), (LAS unsigned*)(Wb + 8192 * (BUF_) + 4096 + 1024 * i_), 16, 0, 0); } } while (0)
    const int tw = (qw0 + 30) >> 5;
    SB_DMA(tw, 0);
    bf16x8 qf[4];
    {
        const bf16* Qp = P + (rowbase + tq) * NPROJ + C_QSB + h * 64 + 8 * hi;
        v4u qraw[4]; float ss = 0.f;
#pragma unroll
        for (int kk = 0; kk < 4; ++kk) { qraw[kk] = *(const GAS v4u*)(Qp + 16 * kk);
#pragma unroll
            for (int e = 0; e < 4; ++e) { const float a = bflo(qraw[kk][e]), c = bfhi(qraw[kk][e]); ss += a * a + c * c; } }
        ss = swap_add(ss);
        const float rq = __builtin_amdgcn_rsqf(ss * (1.f / 64.f) + EPS) * (0.125f * LOG2E);
#pragma unroll
        for (int kk = 0; kk < 4; ++kk) { const int d0 = 16 * kk + 8 * hi;
            const f32x4 g0 = *(const f32x4*)(g_q_sb_ + d0) * *(const f32x4*)(g_k_sb_ + d0), g1 = *(const f32x4*)(g_q_sb_ + d0 + 4) * *(const f32x4*)(g_k_sb_ + d0 + 4);
            v4u o; o.x = cvtpk(bflo(qraw[kk].x) * rq * g0.x, bfhi(qraw[kk].x) * rq * g0.y); o.y = cvtpk(bflo(qraw[kk].y) * rq * g0.z, bfhi(qraw[kk].y) * rq * g0.w);
            o.z = cvtpk(bflo(qraw[kk].z) * rq * g1.x, bfhi(qraw[kk].z) * rq * g1.y); o.w = cvtpk(bflo(qraw[kk].w) * rq * g1.z, bfhi(qraw[kk].w) * rq * g1.w);
            qf[kk] = __builtin_bit_cast(bf16x8, o); }
    }
    f16x8 U0, U1, E0;
#pragma unroll
    for (int j = 0; j < 8; ++j) { U0[j] = (krow(0, hi, j) > r) ? (_Float16)1.0f : (_Float16)0.0f; U1[j] = (krow(1, hi, j) > r) ? (_Float16)1.0f : (_Float16)0.0f;
        E0[j] = (j == 0 && hi == 0) ? (_Float16)1.0f : (_Float16)0.0f; }
    f32x16 o0, o1;
#pragma unroll
    for (int i = 0; i < 16; ++i) { o0[i] = 0.f; o1[i] = 0.f; }
    float R = 0.f;
    const int kfoff = r * 128, kfsw = (r >> 1) & 7;
    for (int t = tw; t >= 0; --t) {
        const int buf = (tw - t) & 1;
        LAS unsigned char* Kb = Wb + 8192 * buf; LAS unsigned char* Vb = Kb + 4096;
        asm volatile("s_waitcnt vmcnt(0)" ::: "memory");
        if (t > 0) SB_DMA(t - 1, buf ^ 1);
        bf16x8 kf[4]; float ssk = 0.f;
#pragma unroll
        for (int kk = 0; kk < 4; ++kk) { const v4u kv = *(const LAS v4u*)(Kb + kfoff + (((2 * kk + hi) ^ kfsw) * 16)); kf[kk] = __builtin_bit_cast(bf16x8, kv);
            ssk = dot2bf(kv.x, kv.x, ssk); ssk = dot2bf(kv.y, kv.y, ssk); ssk = dot2bf(kv.z, kv.z, ssk); ssk = dot2bf(kv.w, kv.w, ssk); }
        ssk = swap_add(ssk);
        const float rk = __builtin_amdgcn_rsqf(ssk * (1.f / 64.f) + EPS);
        f16x8 RKA;
#pragma unroll
        for (int e = 0; e < 8; ++e) RKA[e] = (_Float16)0.0f;
        RKA[0] = (hi == 0) ? (_Float16)rk : (_Float16)0.0f;
        f32x16 s, rkd;
#pragma unroll
        for (int i = 0; i < 16; ++i) { s[i] = 0.f; rkd[i] = 0.f; }
        rkd = MFMA_F16(RKA, E0, rkd);
#pragma unroll
        for (int kk = 0; kk < 4; ++kk) s = MFMA_BF16(kf[kk], qf[kk], s);
        float tsum = 0.f; unsigned lp[8];
        if (32 * t + 31 < qw0) {
#pragma unroll
            for (int i = 0; i < 16; i += 2) {
                const float z0_ = s[i] * rkd[i], z1_ = s[i + 1] * rkd[i + 1];
                const float a0_ = -lg2(1.f + ex2(z0_)), a1_ = -lg2(1.f + ex2(z1_));
                tsum += a0_ + a1_;
                s[i] = z0_ + a0_; s[i + 1] = z1_ + a1_;
                lp[i >> 1] = pkh(a0_, a1_); }
        } else {
            const int kq = tq - 32 * t;
#pragma unroll
            for (int i = 0; i < 16; i += 2) {
                const float z0_ = s[i] * rkd[i], z1_ = s[i + 1] * rkd[i + 1];
                float a0_ = -lg2(1.f + ex2(z0_)), a1_ = -lg2(1.f + ex2(z1_));
                const bool ma0 = crow(i, hi) >= kq, ma1 = crow(i + 1, hi) >= kq;
                a0_ = ma0 ? 0.f : a0_; a1_ = ma1 ? 0.f : a1_;
                tsum += a0_ + a1_;
                s[i] = ma0 ? -INFINITY : z0_ + a0_; s[i + 1] = ma1 ? -INFINITY : z1_ + a1_;
                lp[i >> 1] = pkh(a0_, a1_); }
        }
        f32x16 c;
#pragma unroll
        for (int i = 0; i < 16; ++i) c[i] = R;
        c = MFMA_F16(U0, __builtin_bit_cast(f16x8, (v4u){lp[0], lp[1], lp[2], lp[3]}), c); c = MFMA_F16(U1, __builtin_bit_cast(f16x8, (v4u){lp[4], lp[5], lp[6], lp[7]}), c);
#pragma unroll
        for (int i = 0; i < 16; ++i) s[i] = ex2(s[i] + c[i]);
        const bf16x8 W0 = packbf(s, 0), W1 = packbf(s, 1);
        LAS unsigned char* vb_ = Vb + (4 * hi + qq) * 64 + 32 * blk + 8 * pp;
        o0 = MFMA_BF16(cat8(trrd(vb_), trrd(vb_ + 8 * 64)), W0, o0); o0 = MFMA_BF16(cat8(trrd(vb_ + 16 * 64), trrd(vb_ + 24 * 64)), W1, o0);
        o1 = MFMA_BF16(cat8(trrd(vb_ + 2048), trrd(vb_ + 2048 + 8 * 64)), W0, o1); o1 = MFMA_BF16(cat8(trrd(vb_ + 2048 + 16 * 64), trrd(vb_ + 2048 + 24 * 64)), W1, o1);
        R += swap_add(tsum);
        if (__all(R < -150.f)) break;
    }
    asm volatile("s_waitcnt vmcnt(0)" ::: "memory");
#undef SB_DMA
    {
        float ss = 0.f;
#pragma unroll
        for (int i = 0; i < 16; ++i) ss += o0[i] * o0[i] + o1[i] * o1[i];
        ss = swap_add(ss);
        const float ro = __builtin_amdgcn_rsqf(ss * (1.f / 64.f) + EPS);
        bf16* Op = MIX_ + (rowbase + tq) * D + h * 64;
        const float* go = g_out_sb_ + h * 64;
#pragma unroll
        for (int g = 0; g < 4; ++g) { const int d0 = 8 * g + 4 * hi; const f32x4 ga = *(const f32x4*)(go + d0), gb = *(const f32x4*)(go + 32 + d0);
            u32x2 wa, wb; wa.x = cvtpk(o0[4 * g] * ro * ga.x, o0[4 * g + 1] * ro * ga.y); wa.y = cvtpk(o0[4 * g + 2] * ro * ga.z, o0[4 * g + 3] * ro * ga.w);
            wb.x = cvtpk(o1[4 * g] * ro * gb.x, o1[4 * g + 1] * ro * gb.y); wb.y = cvtpk(o1[4 * g + 2] * ro * gb.z, o1[4 * g + 3] * ro * gb.w);
            *(GAS u32x2*)(Op + d0) = wa; *(GAS u32x2*)(Op + 32 + d0) = wb; }
    }
    __syncthreads();
}

DI void conv_silu8(const v4u (&xr)[4], const float (&cw)[4][8], float scale, float (&y)[8]) {
#pragma unroll
    for (int e = 0; e < 8; ++e) y[e] = 0.f;
#pragma unroll
    for (int j = 0; j < 4; ++j) {
        y[0] += cw[j][0] * bflo(xr[j].x); y[1] += cw[j][1] * bfhi(xr[j].x); y[2] += cw[j][2] * bflo(xr[j].y); y[3] += cw[j][3] * bfhi(xr[j].y);
        y[4] += cw[j][4] * bflo(xr[j].z); y[5] += cw[j][5] * bfhi(xr[j].z); y[6] += cw[j][6] * bflo(xr[j].w); y[7] += cw[j][7] * bfhi(xr[j].w); }
#pragma unroll
    for (int e = 0; e < 8; ++e) y[e] = scale * y[e] * __builtin_amdgcn_rcpf(1.f + fexp(-y[e]));
}
DI float log_sigmoid(float x) { return fminf(x, 0.f) - 0.6931471805599453f * lg2(1.f + fexp(-fabsf(x))); }
DI float wave_scan_incl(float a, int lane) {
#pragma unroll
    for (int o = 1; o < 64; o <<= 1) { const float t = __shfl_up(a, o); if (lane >= o) a += t; }
    return a;
}

constexpr int LDS_CW = 65536;
DI void stage_conv_w(const Frame& F) {
    const float* const conv_w_ = inp(I_CONVW); LAS float* cwl = (LAS float*)(F.lds + LDS_CW);
    for (int i = F.tid; i < 4096; i += NTHR) cwl[i] = conv_w_[i];
    __syncthreads();
}
DI void load_cw8(const Frame& F, int colbase, float (&cw)[4][8]) {
    const LAS float* cwl = (const LAS float*)(F.lds + LDS_CW);
#pragma unroll
    for (int j = 0; j < 4; ++j) { const f32x4 a = *(const LAS f32x4*)(cwl + j * 1024 + colbase), b = *(const LAS f32x4*)(cwl + j * 1024 + colbase + 4);
        cw[j][0] = a.x; cw[j][1] = a.y; cw[j][2] = a.z; cw[j][3] = a.w; cw[j][4] = b.x; cw[j][5] = b.y; cw[j][6] = b.z; cw[j][7] = b.w; }
}
struct MlLocalRegs { v4u kraw[2][4]; v4u vraw[2]; float gi, gf; };
DI void ml_local_load(const Frame& F, int chain, int c, MlLocalRegs& R) {
    bf16* const PROJ_ = WSP(bf16, WS_PROJ); float* const GATES_ = WSP(float, WS_GATES);
    const int tid = F.tid, lane = F.lane;
    const int b = chain >> 2, hh = chain & 3; const size_t rowbase = (size_t)b * SEQ; const int t0 = c * 64;
    const bf16* P = PROJ_;
    const int kc = tid & 15, kr0 = tid >> 4;
    const bf16* Kg = P + rowbase * NPROJ + C_KML + hh * 128 + kc * 8;
#pragma unroll
    for (int i = 0; i < 2; ++i)
#pragma unroll
        for (int j = 0; j < 4; ++j) { const int tt = t0 + kr0 + 32 * i - 3 + j; R.kraw[i][j] = (tt >= 0) ? *(const GAS v4u*)(Kg + (size_t)tt * NPROJ) : (v4u){0u, 0u, 0u, 0u}; }
#pragma unroll
    for (int i = 0; i < 2; ++i) R.vraw[i] = *(const GAS v4u*)(P + (rowbase + t0 + kr0 + 32 * i) * NPROJ + C_VML + hh * 128 + kc * 8);
    const float* Gg = GATES_ + (rowbase + t0 + lane) * 8;
    R.gi = Gg[hh]; R.gf = Gg[4 + hh];
}
DI void ml_local_unit(const Frame& F, int chain, int c, const MlLocalRegs& RG) {
    bf16* const CST_ = WSP(bf16, WS_CST); float* const NST_ = WSP(float, WS_NST); float* const SCL_ = WSP(float, WS_SCL);
    LAS unsigned char* L = F.lds;
    LAS float* Lws = (LAS float*)(L + 32768);
    const int tid = F.tid, lane = F.lane, w = F.wave, r = lane & 31, hi = lane >> 5;
    const int i16 = lane & 15, qq = i16 >> 2, pp = i16 & 3, blk = (lane >> 4) & 1;
    const int hh = chain & 3;
    const int kbk = w & 3, vb0 = 2 * (w >> 2);
    const int kc = tid & 15, kr0 = tid >> 4;
    v4u kraw[2][4], vraw[2];
#pragma unroll
    for (int i = 0; i < 2; ++i) { vraw[i] = RG.vraw[i];
#pragma unroll
        for (int j = 0; j < 4; ++j) kraw[i][j] = RG.kraw[i][j]; }
    const float gi = RG.gi, gf = RG.gf;
    const float a = wave_scan_incl(log_sigmoid(gf), lane);
    const float a_end = __shfl(a, 63);
    const float lw = a_end - a + gi;
    const float m_loc = wave_max(lw);
    const float ws = fexp(lw - m_loc);
    if (w == 0) Lws[lane] = ws;
    {
        float cw[4][8]; load_cw8(F, 512 + hh * 128 + kc * 8, cw);
#pragma unroll
        for (int i = 0; i < 2; ++i) { float y[8]; conv_silu8(kraw[i], cw, 0.08838834764831845f, y);
            v4u o; o.x = cvtpk(y[0], y[1]); o.y = cvtpk(y[2], y[3]); o.z = cvtpk(y[4], y[5]); o.w = cvtpk(y[6], y[7]);
            *(LAS v4u*)(L + (kc >> 2) * 4096 + (kr0 + 32 * i) * 64 + (kc & 3) * 16) = o; }
#pragma unroll
        for (int i = 0; i < 2; ++i) { const int row = kr0 + 32 * i; const float wsr = __shfl(ws, row);
            v4u o; o.x = cvtpk(bflo(vraw[i].x) * wsr, bfhi(vraw[i].x) * wsr); o.y = cvtpk(bflo(vraw[i].y) * wsr, bfhi(vraw[i].y) * wsr); o.z = cvtpk(bflo(vraw[i].z) * wsr, bfhi(vraw[i].z) * wsr); o.w = cvtpk(bflo(vraw[i].w) * wsr, bfhi(vraw[i].w) * wsr);
            *(LAS v4u*)(L + 16384 + (kc >> 2) * 4096 + row * 64 + (kc & 3) * 16) = o; }
    }
    __syncthreads();
    f32x16 acc0, acc1;
#pragma unroll
    for (int i = 0; i < 16; ++i) { acc0[i] = 0.f; acc1[i] = 0.f; }
#pragma unroll
    for (int kk = 0; kk < 4; ++kk) { const int rows = 16 * kk + 8 * hi + qq;
        LAS unsigned char* ka = L + kbk * 4096 + rows * 64 + 32 * blk + 8 * pp; LAS unsigned char* va = L + 16384 + vb0 * 4096 + rows * 64 + 32 * blk + 8 * pp;
        const bf16x8 A = cat8(trrd(ka), trrd(ka + 4 * 64));
        acc0 = MFMA_BF16(A, cat8(trrd(va), trrd(va + 4 * 64)), acc0); acc1 = MFMA_BF16(A, cat8(trrd(va + 4096), trrd(va + 4096 + 4 * 64)), acc1); }
    {
        bf16* Cp = CST_ + ((size_t)(chain * 64 + c) * 128 + vb0 * 32 + r) * 128 + kbk * 32 + 4 * hi;
#pragma unroll
        for (int g = 0; g < 4; ++g) { u32x2 o; o.x = cvtpk(acc0[4 * g], acc0[4 * g + 1]); o.y = cvtpk(acc0[4 * g + 2], acc0[4 * g + 3]); *(GAS u32x2*)(Cp + 8 * g) = o;
            u32x2 o1; o1.x = cvtpk(acc1[4 * g], acc1[4 * g + 1]); o1.y = cvtpk(acc1[4 * g + 2], acc1[4 * g + 3]); *(GAS u32x2*)(Cp + 32 * 128 + 8 * g) = o1; }
    }
    {
        const int k = 16 * w + (lane & 15), sq = lane >> 4; float part = 0.f;
        const LAS unsigned short* kcol = (const LAS unsigned short*)(L + (k >> 5) * 4096 + (k & 31) * 2);
#pragma unroll
        for (int e = 0; e < 16; ++e) part += Lws[16 * sq + e] * __uint_as_float((unsigned)kcol[(16 * sq + e) * 32] << 16);
        part += __shfl_xor(part, 16); part += __shfl_xor(part, 32);
        if (lane < 16) NST_[(size_t)(chain * 64 + c) * 128 + k] = part;
        if (tid == 0) { SCL_[(chain * 64 + c) * 2] = a_end; SCL_[(chain * 64 + c) * 2 + 1] = m_loc; }
    }
    __syncthreads();
}
DI void ml_scan_phase(const Frame& F) {
    bf16* const CST_ = WSP(bf16, WS_CST); float* const NST_ = WSP(float, WS_NST); float* const SCL_ = WSP(float, WS_SCL); float* const MST_ = WSP(float, WS_MST);
    for (int gt = F.vcu * NTHR + F.tid; gt < 32 * 4096; gt += F.G * NTHR) {
        const int chain = gt >> 12, rem = gt & 4095;
        const float ae_l = SCL_[(chain * 64 + F.lane) * 2], ml_l = SCL_[(chain * 64 + F.lane) * 2 + 1];
        u32x2* Cp = (u32x2*)(CST_ + (size_t)chain * 64 * 16384 + (size_t)rem * 4);
        f32x4* Np = (f32x4*)(NST_ + (size_t)chain * 64 * 128 + rem * 4);
        const bool do_n = rem < 32;
        float c0 = 0.f, c1 = 0.f, c2 = 0.f, c3 = 0.f; f32x4 nn = {0.f, 0.f, 0.f, 0.f}; float m = 0.f;
        u32x2 dr[8]; f32x4 nr[8];
#pragma unroll
        for (int i = 0; i < 8; ++i) { dr[i] = Cp[(size_t)i * 4096]; if (do_n) nr[i] = Np[i * 32]; }
        for (int c0_ = 0; c0_ < 64; c0_ += 8) {
#pragma unroll
            for (int i = 0; i < 8; ++i) { const int c = c0_ + i;
                if (c < 63) {
                    const u32x2 dcur = dr[i]; const f32x4 dn = nr[i];
                    if (c + 8 < 63) { dr[i] = Cp[(size_t)(c + 8) * 4096]; if (do_n) nr[i] = Np[(c + 8) * 32]; }
                    const float ae = __builtin_bit_cast(float, __builtin_amdgcn_readlane(__builtin_bit_cast(int, ae_l), c)), ml = __builtin_bit_cast(float, __builtin_amdgcn_readlane(__builtin_bit_cast(int, ml_l), c));
                    const float mn = fmaxf(ae + m, ml), d1 = fexp(ae + m - mn), d2 = fexp(ml - mn);
                    c0 = d1 * c0 + d2 * bflo(dcur.x); c1 = d1 * c1 + d2 * bfhi(dcur.x); c2 = d1 * c2 + d2 * bflo(dcur.y); c3 = d1 * c3 + d2 * bfhi(dcur.y);
                    u32x2 o; o.x = cvtpk(c0, c1); o.y = cvtpk(c2, c3); Cp[(size_t)c * 4096] = o;
                    if (do_n) { nn = nn * d1 + dn * d2; Np[c * 32] = nn; }
                    if (rem == 0) MST_[chain * 64 + c] = mn;
                    m = mn; } }
        }
    }
}
DI void ml_out_unit(const Frame& F, int chain, int c, int nchain = -1, int nc = 0) {
    bf16* const PROJ_ = WSP(bf16, WS_PROJ); float* const GATES_ = WSP(float, WS_GATES); float* const MST_ = WSP(float, WS_MST); bf16* const CST_ = WSP(bf16, WS_CST); float* const NST_ = WSP(float, WS_NST); bf16* const MIX_ = WSP(bf16, WS_MIX); const float* const g_out_ml_ = inp(I_GOML);
    LAS unsigned char* L = F.lds;
    LAS float* Lbs = (LAS float*)(L + 49152); LAS float* Lav = (LAS float*)(L + 49408); LAS float* Lex = (LAS float*)(L + 49664);
    const int tid = F.tid, lane = F.lane, w = F.wave, r = lane & 31, hi = lane >> 5;
    const int i16 = lane & 15, qq = i16 >> 2, pp = i16 & 3, blk = (lane >> 4) & 1;
    const int b = chain >> 2, hh = chain & 3; const size_t rowbase = (size_t)b * SEQ; const int t0 = c * 64;
    const int tb = w >> 2, vb = w & 3;
    const bf16* P = PROJ_;
    {
        const int kc = tid & 15, kr0 = tid >> 4;
#pragma unroll
        for (int which = 0; which < 2; ++which) {
            const int colbase = (which ? 512 : 0) + hh * 128 + kc * 8;
            float cw[4][8]; load_cw8(F, colbase, cw);
            const bf16* Xg = P + rowbase * NPROJ + C_QML + colbase;
#pragma unroll
            for (int i = 0; i < 2; ++i) { const int row = kr0 + 32 * i; v4u xr[4];
#pragma unroll
                for (int j = 0; j < 4; ++j) { const int tt = t0 + row - 3 + j; xr[j] = (tt >= 0) ? *(const GAS v4u*)(Xg + (size_t)tt * NPROJ) : (v4u){0u, 0u, 0u, 0u}; }
                float y[8]; conv_silu8(xr, cw, which ? 0.08838834764831845f : 1.0f, y);
                v4u o; o.x = cvtpk(y[0], y[1]); o.y = cvtpk(y[2], y[3]); o.z = cvtpk(y[4], y[5]); o.w = cvtpk(y[6], y[7]);
                *(LAS v4u*)(L + which * 16384 + row * 256 + ((kc ^ (row & 15)) * 16)) = o; }
        }
#pragma unroll
        for (int i = 0; i < 2; ++i) { const int row = kr0 + 32 * i;
            const v4u v = *(const GAS v4u*)(P + (rowbase + t0 + row) * NPROJ + C_VML + hh * 128 + kc * 8);
            *(LAS v4u*)(L + 32768 + (kc >> 2) * 4096 + row * 64 + (kc & 3) * 16) = v; }
        if (w == 0) { const float* Gg = GATES_ + (rowbase + t0 + lane) * 8; const float a = wave_scan_incl(log_sigmoid(Gg[4 + hh]), lane); Lav[lane] = a; Lbs[lane] = Gg[hh] - a; }
    }
    const float mprev = (c > 0) ? MST_[chain * 64 + c - 1] : 0.f;
    bf16x8 cf[8], nf[8];
    if (c > 0) {
        const bf16* Cp = CST_ + ((size_t)(chain * 64 + c - 1) * 128 + vb * 32 + r) * 128 + 8 * hi;
        const float* Np = NST_ + (size_t)(chain * 64 + c - 1) * 128 + 8 * hi;
        const bool nrow = (r == 0) || (r == 4);
#pragma unroll
        for (int kk = 0; kk < 8; ++kk) { cf[kk] = *(const GAS bf16x8*)(Cp + 16 * kk);
            const f32x4 n0 = *(const f32x4*)(Np + 16 * kk), n1 = *(const f32x4*)(Np + 16 * kk + 4);
            v4u o; o.x = cvtpk(n0.x, n0.y); o.y = cvtpk(n0.z, n0.w); o.z = cvtpk(n1.x, n1.y); o.w = cvtpk(n1.z, n1.w);
            if (!nrow) o = (v4u){0u, 0u, 0u, 0u};
            nf[kk] = __builtin_bit_cast(bf16x8, o); }
    }
    unsigned tch0 = 0u, tch1 = 0u;
    if (nchain >= 0) {
        const unsigned nhh = (unsigned)nchain & 3u, nrow0 = (unsigned)(nchain >> 2) * SEQ + (unsigned)nc * 64u, cst = (unsigned)(nchain * 64 + nc - 1);
        const unsigned rr = (unsigned)tid >> 2, part = (unsigned)tid & 3u;
        unsigned o0 = (unsigned)WS_PROJ + ((nrow0 - 3u + rr) * NPROJ + C_QML + (part >> 1) * 512u + nhh * 128u + (part & 1u) * 64u) * 2u; bool v0 = (nc > 0) || (rr >= 3u);
        if (tid >= 268) { o0 = (unsigned)WS_CST + cst * 32768u + (unsigned)(tid - 268) * 128u; v0 = nc > 0; }
        unsigned o1 = (unsigned)WS_PROJ + ((nrow0 + rr) * NPROJ + ((part >> 1) ? C_OML : C_VML) + nhh * 128u + (part & 1u) * 64u) * 2u; bool v1 = true;
        if (tid >= 256) { o1 = (unsigned)WS_CST + cst * 32768u + (unsigned)(244 + tid - 256) * 128u; v1 = nc > 0; }
        if (tid >= 268) { o1 = (unsigned)WS_NST + cst * 512u + (unsigned)(tid - 268) * 128u; }
        if (tid >= 272) { o1 = (unsigned)WS_GATES + nrow0 * 32u + (unsigned)(tid - 272) * 128u; v1 = tid < 288; }
        const GAS unsigned char* wsb = (const GAS unsigned char*)F.ws;
        if (v0) tch0 = *(const GAS unsigned*)(wsb + o0);
        if (v1) tch1 = *(const GAS unsigned*)(wsb + o1);
    }
    __syncthreads();
    bf16x8 qf[8];
    f32x16 s0, s1;
#pragma unroll
    for (int i = 0; i < 16; ++i) { s0[i] = 0.f; s1[i] = 0.f; }
#pragma unroll
    for (int kk = 0; kk < 8; ++kk) { const int ch = 2 * kk + hi; const int rq_ = 32 * tb + r;
        qf[kk] = *(const LAS bf16x8*)(L + rq_ * 256 + ((ch ^ (rq_ & 15)) * 16));
        const bf16x8 a0 = *(const LAS bf16x8*)(L + 16384 + r * 256 + ((ch ^ (r & 15)) * 16));
        const bf16x8 a1 = *(const LAS bf16x8*)(L + 16384 + (32 + r) * 256 + ((ch ^ ((32 + r) & 15)) * 16));
        s0 = MFMA_BF16(a0, qf[kk], s0); s1 = MFMA_BF16(a1, qf[kk], s1); }
    const int tl = 32 * tb + r; const float a_t = Lav[tl];
    f32x16 d0, d1; float mrow = -INFINITY;
#pragma unroll
    for (int g = 0; g < 4; ++g) { const f32x4 b0 = *(const LAS f32x4*)(Lbs + 8 * g + 4 * hi), b1 = *(const LAS f32x4*)(Lbs + 32 + 8 * g + 4 * hi);
#pragma unroll
        for (int e = 0; e < 4; ++e) { const int sl = 8 * g + 4 * hi + e;
            d0[4 * g + e] = (sl <= tl) ? a_t + b0[e] : -INFINITY; d1[4 * g + e] = (32 + sl <= tl) ? a_t + b1[e] : -INFINITY;
            mrow = fmaxf(mrow, fmaxf(d0[4 * g + e], d1[4 * g + e])); } }
    mrow = fmaxf(swap_max(mrow), a_t + mprev);
    float psum = 0.f;
#pragma unroll
    for (int i = 0; i < 16; ++i) { s0[i] *= fexp(d0[i] - mrow); s1[i] *= fexp(d1[i] - mrow); psum += s0[i] + s1[i]; }
    const float w_inter = fexp(a_t + mprev - mrow);
    float den = swap_add(psum);
    const bf16x8 P00 = packbf(s0, 0), P01 = packbf(s0, 1), P10 = packbf(s1, 0), P11 = packbf(s1, 1);
    f32x16 num;
#pragma unroll
    for (int i = 0; i < 16; ++i) num[i] = 0.f;
    {
        LAS unsigned char* vb_ = L + 32768 + vb * 4096 + (4 * hi + qq) * 64 + 32 * blk + 8 * pp;
        num = MFMA_BF16(cat8(trrd(vb_), trrd(vb_ + 8 * 64)), P00, num); num = MFMA_BF16(cat8(trrd(vb_ + 16 * 64), trrd(vb_ + 24 * 64)), P01, num);
        num = MFMA_BF16(cat8(trrd(vb_ + 32 * 64), trrd(vb_ + 40 * 64)), P10, num); num = MFMA_BF16(cat8(trrd(vb_ + 48 * 64), trrd(vb_ + 56 * 64)), P11, num);
    }
    if (c > 0) {
        f32x16 it, dn;
#pragma unroll
        for (int i = 0; i < 16; ++i) { it[i] = 0.f; dn[i] = 0.f; }
#pragma unroll
        for (int kk = 0; kk < 8; ++kk) { it = MFMA_BF16(cf[kk], qf[kk], it); dn = MFMA_BF16(nf[kk], qf[kk], dn); }
#pragma unroll
        for (int i = 0; i < 16; ++i) num[i] += w_inter * it[i];
        den += w_inter * dn[0];
    }
    const float inv = __builtin_amdgcn_rcpf(fmaxf(fabsf(den), fexp(-mrow)));
    float ss = 0.f;
#pragma unroll
    for (int i = 0; i < 16; ++i) { num[i] *= inv; ss += num[i] * num[i]; }
    ss = swap_add(ss);
    if (lane < 32) Lex[(tb * 4 + vb) * 32 + r] = ss;
    __syncthreads();
    const float tot = (Lex[(tb * 4 + 0) * 32 + r] + Lex[(tb * 4 + 1) * 32 + r]) + (Lex[(tb * 4 + 2) * 32 + r] + Lex[(tb * 4 + 3) * 32 + r]);
    const float rstd = 1.f / sqrtf(tot * (1.f / 128.f) + EPS);
    {
        const size_t trow = rowbase + t0 + tl;
        const bf16* Og = P + trow * NPROJ + C_OML + hh * 128 + vb * 32 + 4 * hi;
        bf16* Mp = MIX_ + trow * D + 512 + hh * 128 + vb * 32 + 4 * hi;
        const float* go = g_out_ml_ + hh * 128 + vb * 32 + 4 * hi;
#pragma unroll
        for (int g = 0; g < 4; ++g) { const u32x2 og = *(const GAS u32x2*)(Og + 8 * g); const f32x4 gg = *(const f32x4*)(go + 8 * g);
            const float o0 = bflo(og.x), o1 = bfhi(og.x), o2 = bflo(og.y), o3 = bfhi(og.y);
            u32x2 o; o.x = cvtpk(num[4 * g] * rstd * gg.x * __builtin_amdgcn_rcpf(1.f + fexp(-o0)), num[4 * g + 1] * rstd * gg.y * __builtin_amdgcn_rcpf(1.f + fexp(-o1)));
            o.y = cvtpk(num[4 * g + 2] * rstd * gg.z * __builtin_amdgcn_rcpf(1.f + fexp(-o2)), num[4 * g + 3] * rstd * gg.w * __builtin_amdgcn_rcpf(1.f + fexp(-o3)));
            *(GAS u32x2*)(Mp + 8 * g) = o; }
    }
    asm volatile("" :: "v"(tch0), "v"(tch1));
    __syncthreads();
}

#define TK_CE(A, B) do { const float hi_ = fmaxf((A), (B)), lo_ = fminf((A), (B)); (A) = hi_; (B) = lo_; } while (0)
DI void tk_sort16(float (&a)[16]) {
    TK_CE(a[0], a[1]); TK_CE(a[2], a[3]); TK_CE(a[0], a[2]); TK_CE(a[1], a[3]); TK_CE(a[1], a[2]); TK_CE(a[4], a[5]); TK_CE(a[6], a[7]); TK_CE(a[4], a[6]); TK_CE(a[5], a[7]); TK_CE(a[5], a[6]); TK_CE(a[0], a[4]); TK_CE(a[2], a[6]); TK_CE(a[2], a[4]); TK_CE(a[1], a[5]); TK_CE(a[3], a[7]); TK_CE(a[3], a[5]); TK_CE(a[1], a[2]); TK_CE(a[3], a[4]); TK_CE(a[5], a[6]); TK_CE(a[8], a[9]); TK_CE(a[10], a[11]); TK_CE(a[8], a[10]); TK_CE(a[9], a[11]); TK_CE(a[9], a[10]); TK_CE(a[12], a[13]); TK_CE(a[14], a[15]); TK_CE(a[12], a[14]); TK_CE(a[13], a[15]); TK_CE(a[13], a[14]); TK_CE(a[8], a[12]); TK_CE(a[10], a[14]); TK_CE(a[10], a[12]); TK_CE(a[9], a[13]); TK_CE(a[11], a[15]); TK_CE(a[11], a[13]); TK_CE(a[9], a[10]); TK_CE(a[11], a[12]); TK_CE(a[13], a[14]); TK_CE(a[0], a[8]); TK_CE(a[4], a[12]); TK_CE(a[4], a[8]); TK_CE(a[2], a[10]); TK_CE(a[6], a[14]); TK_CE(a[6], a[10]); TK_CE(a[2], a[4]); TK_CE(a[6], a[8]); TK_CE(a[10], a[12]); TK_CE(a[1], a[9]); TK_CE(a[5], a[13]); TK_CE(a[5], a[9]); TK_CE(a[3], a[11]); TK_CE(a[7], a[15]); TK_CE(a[7], a[11]); TK_CE(a[3], a[5]); TK_CE(a[7], a[9]); TK_CE(a[11], a[13]); TK_CE(a[1], a[2]); TK_CE(a[3], a[4]); TK_CE(a[5], a[6]); TK_CE(a[7], a[8]); TK_CE(a[9], a[10]); TK_CE(a[11], a[12]); TK_CE(a[13], a[14]);
}
DI void tk_merge16(float (&a)[16], const float (&b)[16]) {
#pragma unroll
    for (int i = 0; i < 16; ++i) a[i] = fmaxf(a[i], b[15 - i]);
#pragma unroll
    for (int j = 8; j > 0; j >>= 1)
#pragma unroll
        for (int i = 0; i < 16; ++i) { const int l = i ^ j; if (l > i) TK_CE(a[i], a[l]); }
}
DI void tk_stage2(const LAS float* la, const LAS float* lb, int* IDX_, float* GATEW_, size_t o) {
        float a[16], bb[16], cnd[64];
#pragma unroll
        for (int q = 0; q < 16; ++q) { a[q] = la[q]; bb[q] = lb[q]; }
        int cnt = 0;
#pragma unroll
        for (int i = 0; i < 16; ++i)
#pragma unroll
            for (int j = 0; j < 16; ++j) if ((i + 1) * (j + 1) <= 16) { cnd[cnt] = __uint_as_float((__float_as_uint(a[i] + bb[j]) & ~0xFFu) | (unsigned)(i * 16 + j)); ++cnt; }
#pragma unroll
        for (int q = 50; q < 64; ++q) cnd[q] = -INFINITY;
        float top[16];
#pragma unroll
        for (int c = 0; c < 4; ++c) { float ch[16];
#pragma unroll
            for (int q = 0; q < 16; ++q) ch[q] = cnd[16 * c + q];
            tk_sort16(ch);
            if (c == 0) {
#pragma unroll
                for (int q = 0; q < 16; ++q) top[q] = ch[q];
            } else tk_merge16(top, ch); }
        float sv[16]; int ei[16]; float mx = -INFINITY;
#pragma unroll
        for (int q = 0; q < 16; ++q) { const unsigned code = __float_as_uint(top[q]) & 0xFFu; const float va = la[code >> 4], vb = lb[code & 15u];
            ei[q] = (int)((__float_as_uint(va) & 0x7Fu) * 128u + (__float_as_uint(vb) & 0x7Fu)); sv[q] = va + vb; mx = fmaxf(mx, sv[q]); }
        float sum = 0.f;
#pragma unroll
        for (int q = 0; q < 16; ++q) { sv[q] = fexp(sv[q] - mx); sum += sv[q]; }
        const float inv = 1.f / sum;
#pragma unroll
#define TK_PK(Q) (((__builtin_bit_cast(unsigned, sv[(Q)] * inv) + 0x2000u) & 0xFFFFC000u) | (unsigned)ei[(Q)])
        for (int q = 0; q < 16; q += 4) *(GAS v4u*)(IDX_ + o + q) = (v4u){TK_PK(q), TK_PK(q + 1), TK_PK(q + 2), TK_PK(q + 3)};
#undef TK_PK
        (void)GATEW_;
    }
struct EpiTopK {
    static constexpr bool PERM = false, AFTER_DRAIN = true;
    int* IDX; float* GATEW;
    DI void fused(f32x4 (&acc)[2][2][4][2], const pg8::Unit& u, int wr, int wc, int fr, int fq, LAS unsigned char* lds, int wid, int lane) const {
        LAS float* Tl = (LAS float*)lds;
        LAS float* Lh2 = (LAS float*)lds;
        LAS float* Ls = (LAS float*)(lds + 36864);
        const int tid = wid * 64 + lane, tl = tid & 127, p = (tid >> 7) & 1, half = tid >> 8;
        float keep[16], fin[16];
#pragma unroll
        for (int q = 0; q < 16; ++q) { keep[q] = 0.f; fin[q] = 0.f; }
#pragma unroll
        for (int ai = 0; ai < 2; ++ai) {
#pragma unroll
            for (int bj = 0; bj < 2; ++bj)
#pragma unroll
                for (int m = 0; m < 4; ++m)
#pragma unroll
                    for (int n = 0; n < 2; ++n) { LAS float* d = Tl + (wr * 64 + m * 16 + fr) * 257 + bj * 128 + wc * 32 + n * 16 + fq * 4; const f32x4 v = acc[ai][bj][m][n]; d[0] = v.x; d[1] = v.y; d[2] = v.z; d[3] = v.w; }
            __syncthreads();
            float run[16];
            {
                const LAS float* src = Tl + tl * 257 + p * 128 + half * 64;
#pragma unroll
                for (int c = 0; c < 4; ++c) { float ch[16];
#pragma unroll
                    for (int q = 0; q < 16; ++q) ch[q] = __uint_as_float((__float_as_uint(src[16 * c + q]) & ~0x7Fu) | (unsigned)(half * 64 + 16 * c + q));
                    tk_sort16(ch);
                    if (c == 0) {
#pragma unroll
                        for (int q = 0; q < 16; ++q) run[q] = ch[q];
                    } else tk_merge16(run, ch); }
            }
            __syncthreads();
#pragma unroll
            for (int q = 0; q < 16; ++q) Lh2[((tl * 2 + p) * 2 + half) * 17 + q] = run[q];
            __syncthreads();
            if (half == 0) { float oth[16];
#pragma unroll
                for (int q = 0; q < 16; ++q) oth[q] = Lh2[((tl * 2 + p) * 2 + 1) * 17 + q];
                tk_merge16(run, oth);
                if (ai == 0) {
#pragma unroll
                    for (int q = 0; q < 16; ++q) keep[q] = run[q]; }
                else {
#pragma unroll
                    for (int q = 0; q < 16; ++q) fin[q] = run[q]; } }
            __syncthreads();
        }
        if (half == 0) {
#pragma unroll
            for (int q = 0; q < 16; ++q) { Ls[(tl * 2 + p) * 17 + q] = keep[q]; Ls[(256 + tl * 2 + p) * 17 + q] = fin[q]; } }
        __syncthreads();
        if (tid < 256) tk_stage2(Ls + (tid * 2) * 17, Ls + (tid * 2) * 17 + 17, IDX, GATEW, (size_t)(u.pm * 256 + tid) * 128 + u.pn * 16);
        __syncthreads();
    }
};
struct OneUnit {
    pg8::Unit u;
    __device__ __forceinline__ bool next(int i, pg8::Unit& o) const { if (i) return false; o = u; return true; }
    __device__ __forceinline__ void a_ready(const pg8::Unit&) const {}
    __device__ __forceinline__ void done(const pg8::Unit&) const {}
};

DI float gelu_erf(float x) { return 0.5f * x * (1.f + erff(x * 0.7071067811865476f)); }
#define DPP_ADD(v, ctrl, rmask) ((v) + __builtin_bit_cast(float, __builtin_amdgcn_update_dpp(0, __builtin_bit_cast(int, (v)), (ctrl), (rmask), 0xF, false)))
#ifndef PEER_EBL
#define PEER_EBL 9
#endif
constexpr int PEER_EB_LOG = PEER_EBL;
#ifndef PEER_PROBE_MASK
#define PEER_PROBE_MASK 0xFFFF
#endif
typedef float f32x2v __attribute__((ext_vector_type(2)));
DI float gelu_cdf(float v) {
    const float av = fabsf(v), t = __builtin_amdgcn_rcpf(av * 0.2316418882f + 1.0f);
    float q = t * 0.5307027145f - 0.7265760135f; q = q * t + 0.7107068705f; q = q * t - 0.142248368f; q = q * t + 0.127414796f; q = q * t;
    const float m = v * (q * ex2(v * v * -0.72134752044f));
    return v < 0.f ? m : v - m;
}
#define DPP_ADDI(v, ctrl, rmask) ((v) + __builtin_amdgcn_update_dpp(0, (v), (ctrl), (rmask), 0xF, false))
DI void peer_phase(const Frame& F, bool scratch_dst) {
    bf16* const XN_ = WSP(bf16, WS_XN); int* const IDX_ = WSP(int, WS_IDX); float* const GATEW_ = WSP(float, WS_GATE); float* const mod_ = WSP(float, WS_MOD); float* const out_ = (float*)inp(I_OUT); const bf16* const X1B_ = WSP(bf16, WS_X1B);
    const unsigned char* const EU4 = WSP(unsigned char, WS_EXPU); const unsigned char* const EV4 = WSP(unsigned char, WS_EXPV); const float* const SUI_ = WSP(float, WS_SUI); const float* const SVI_ = WSP(float, WS_SVI);
    const int gw = F.vcu * NWAVES + F.wave, NGW = F.G * NWAVES, lane = F.lane, g = lane >> 3, j = lane & 7;
    LAS unsigned char* wl = F.lds + F.wave * 17408;
    volatile LAS int* Le = (volatile LAS int*)(wl + g * 512); volatile LAS float* Lg = (volatile LAS float*)(wl + 4096 + g * 512); volatile LAS int* Lp = (volatile LAS int*)(wl + 8192 + g * 512);
    volatile LAS int* Lx = (volatile LAS int*)(wl + 12288 + g * 512); LAS int* Lh = (LAS int*)(wl + 16384 + g * 128);
    for (int grp = gw; grp < T / 8; grp += NGW) {
        const size_t t = (size_t)grp * 8 + g;
        int xh[16], xl[16]; float sxi;
#ifdef PEER_DUP_S
        auto qs_ = [&]() __attribute__((always_inline)) {
#endif
        {
            const unsigned char* xq = WSP(unsigned char, WS_XQ) + t * 1024 + 16 * j;
#pragma unroll
            for (int q = 0; q < 4; ++q) { const v4u a = *(const GAS v4u*)(xq + 128 * q), b = *(const GAS v4u*)(xq + 512 + 128 * q);
#pragma unroll
                for (int w_ = 0; w_ < 4; ++w_) { xh[4 * q + w_] = (int)a[w_]; xl[4 * q + w_] = (int)b[w_]; } }
            sxi = WSP(float, WS_XS)[t];
        }
        {
            int ide[16]; float gte[16]; int rk[16];
#pragma unroll
            for (int m = 0; m < 16; ++m) { const unsigned pk_ = (unsigned)IDX_[t * 128 + j + 8 * m]; ide[m] = (int)(pk_ & 0x3FFFu); gte[m] = __builtin_bit_cast(float, pk_ & 0xFFFFC000u); }
#pragma unroll
            for (int m = 0; m < 4; ++m) Lh[j + 8 * m] = 0;
#pragma unroll
            for (int m = 0; m < 16; ++m) rk[m] = __hip_atomic_fetch_add(Lh + (ide[m] >> PEER_EB_LOG), 1, __ATOMIC_RELAXED, __HIP_MEMORY_SCOPE_WORKGROUP);
            {
                const int h0 = ((volatile LAS int*)Lh)[4 * j], h1 = ((volatile LAS int*)Lh)[4 * j + 1], h2 = ((volatile LAS int*)Lh)[4 * j + 2], h3 = ((volatile LAS int*)Lh)[4 * j + 3];
                const int tot = (h0 + h1) + (h2 + h3); int inc = tot;
#pragma unroll
                for (int o = 1; o < 8; o <<= 1) { const int tt = __shfl_up(inc, o, 8); if (j >= o) inc += tt; }
                const int ex = inc - tot;
                ((volatile LAS int*)Lh)[4 * j] = ex; ((volatile LAS int*)Lh)[4 * j + 1] = ex + h0; ((volatile LAS int*)Lh)[4 * j + 2] = ex + h0 + h1; ((volatile LAS int*)Lh)[4 * j + 3] = ex + h0 + h1 + h2;
            }
#pragma unroll
            for (int m = 0; m < 16; ++m) { const int pos = ((volatile LAS int*)Lh)[ide[m] >> PEER_EB_LOG] + rk[m]; Le[pos] = ide[m]; Lg[pos] = gte[m] * SVI_[ide[m]]; Lp[pos] = __builtin_bit_cast(int, SUI_[ide[m]] * sxi); }
        }
#ifdef PEER_DUP_S
        }; qs_(); __builtin_amdgcn_sched_barrier(0); qs_();
#endif
        v4u R0[4], R1[4], R2[4], R3[4];
#define PEER_LOADU(RR, S0) do { const size_t ro_ = (size_t)(Le[(S0)] & (scratch_dst ? PEER_PROBE_MASK : 0xFFFF)) * 512 + 16 * j; _Pragma("unroll") for (int q = 0; q < 4; ++q) RR[q] = *(const GAS v4u*)(EU4 + ro_ + 128 * q); } while (0)
#define PEER_DOTU(RR, EOUT) do { int h0_ = 0, h1_ = 0, l0_ = 0, l1_ = 0; \
            _Pragma("unroll") for (int q = 0; q < 4; q += 2) _Pragma("unroll") for (int w_ = 0; w_ < 4; ++w_) { \
                h0_ = __builtin_amdgcn_sdot8((int)RR[q][w_], xh[4 * q + w_], h0_, false); l0_ = __builtin_amdgcn_sdot8((int)RR[q][w_], xl[4 * q + w_], l0_, false); \
                h1_ = __builtin_amdgcn_sdot8((int)RR[q + 1][w_], xh[4 * q + 4 + w_], h1_, false); l1_ = __builtin_amdgcn_sdot8((int)RR[q + 1][w_], xl[4 * q + 4 + w_], l1_, false); } \
            int e_ = ((h0_ + h1_) << 4) + (l0_ + l1_); e_ = DPP_ADDI(e_, 0xB1, 0xF); e_ = DPP_ADDI(e_, 0x4E, 0xF); e_ = DPP_ADDI(e_, 0x141, 0xF); EOUT = e_; } while (0)
#define PEER_SWEEPU(BODY0, BODY1, BODY2, BODY3) do { \
            PEER_LOADU(R0, 0); PEER_LOADU(R1, 1); PEER_LOADU(R2, 2); PEER_LOADU(R3, 3); \
            for (int s = 0; s < 128; s += 4) { \
                BODY0; if (s + 4 < 128) PEER_LOADU(R0, s + 4); \
                BODY1; if (s + 4 < 128) PEER_LOADU(R1, s + 5); \
                BODY2; if (s + 4 < 128) PEER_LOADU(R2, s + 6); \
                BODY3; if (s + 4 < 128) PEER_LOADU(R3, s + 7); } } while (0)
#define PEER_FIN(RR, SS) do { int e1_; PEER_DOTU(RR, e1_); Lx[(SS)] = e1_; } while (0)
        PEER_SWEEPU(PEER_FIN(R0, s), PEER_FIN(R1, s + 1), PEER_FIN(R2, s + 2), PEER_FIN(R3, s + 3));
#ifdef PEER_DUP_U
        PEER_SWEEPU(PEER_FIN(R0, s), PEER_FIN(R1, s + 1), PEER_FIN(R2, s + 2), PEER_FIN(R3, s + 3));
#endif
#undef PEER_FIN
        float yscale; int csum8;
        {
            float cf_[16]; float cmax = 0.f;
#pragma unroll
            for (int i = 0; i < 16; ++i) { const int ix = 16 * j + i; cf_[i] = Lg[ix] * gelu_cdf((float)Lx[ix] * __builtin_bit_cast(float, Lp[ix])); cmax = fmaxf(cmax, fabsf(cf_[i])); }
            cmax = fmaxf(cmax, __shfl_xor(cmax, 1, 8)); cmax = fmaxf(cmax, __shfl_xor(cmax, 2, 8)); cmax = fmaxf(cmax, __shfl_xor(cmax, 4, 8));
            const float cqs = cmax > 0.f ? 127.f / cmax : 0.f; yscale = cmax > 0.f ? cmax / 127.f : 0.f;
            int pk_[4]; int cs_ = 0;
#pragma unroll
            for (int m = 0; m < 4; ++m) { const int q0 = (int)rintf(cf_[4 * m] * cqs), q1 = (int)rintf(cf_[4 * m + 1] * cqs), q2 = (int)rintf(cf_[4 * m + 2] * cqs), q3 = (int)rintf(cf_[4 * m + 3] * cqs);
                cs_ += (q0 + q1) + (q2 + q3);
                pk_[m] = (int)((unsigned)(q0 & 0xff) | ((unsigned)(q1 & 0xff) << 8) | ((unsigned)(q2 & 0xff) << 16) | ((unsigned)q3 << 24)); }
            cs_ += __shfl_xor(cs_, 1, 8); cs_ += __shfl_xor(cs_, 2, 8); cs_ += __shfl_xor(cs_, 4, 8); csum8 = 8 * cs_;
#pragma unroll
            for (int m = 0; m < 4; ++m) Lp[4 * j + m] = pk_[m];
        }
#ifndef PEER_DUP_V
#define PEER_DUP_V 1
#endif
#pragma unroll
        for (int HH = 0; HH < 2 * PEER_DUP_V; ++HH) { const int H = HH & 1;
            int ya[32], yl[32];
#pragma unroll
            for (int i = 0; i < 32; ++i) { ya[i] = 0; yl[i] = 0; }
            v4u RV[8][2];
#define PEER_ROFFV(S0) ((size_t)(Le[(S0)] & (scratch_dst ? PEER_PROBE_MASK : 0xFFFF)) * 512 + 256 * H + 16 * j)
#pragma unroll
            for (int r = 0; r < 8; ++r) { const size_t ro_ = PEER_ROFFV(r); RV[r][0] = *(const GAS v4u*)(EV4 + ro_); RV[r][1] = *(const GAS v4u*)(EV4 + ro_ + 128); }
            for (int bt = 0; bt < 16; ++bt) {
                const int c0_ = Lp[2 * bt], c1_ = Lp[2 * bt + 1];
                size_t ron[8];
#pragma unroll
                for (int r = 0; r < 8; ++r) ron[r] = (bt + 1 < 16) ? PEER_ROFFV(8 * bt + 8 + r) : 0;
#pragma unroll
                for (int q = 0; q < 2; ++q) {
#pragma unroll
                    for (int hb = 0; hb < 2; ++hb) { const int cq_ = hb ? c1_ : c0_;
#pragma unroll
                        for (int w_ = 0; w_ < 4; ++w_) { const unsigned a0 = RV[4 * hb][q][w_], a1 = RV[4 * hb + 1][q][w_], a2 = RV[4 * hb + 2][q][w_], a3 = RV[4 * hb + 3][q][w_];
                            const unsigned p0 = __builtin_amdgcn_perm(a1, a0, 0x05010400u), p1 = __builtin_amdgcn_perm(a1, a0, 0x07030602u), p2 = __builtin_amdgcn_perm(a3, a2, 0x05010400u), p3 = __builtin_amdgcn_perm(a3, a2, 0x07030602u);
                            unsigned Tb[4]; Tb[0] = __builtin_amdgcn_perm(p2, p0, 0x05040100u); Tb[1] = __builtin_amdgcn_perm(p2, p0, 0x07060302u); Tb[2] = __builtin_amdgcn_perm(p3, p1, 0x05040100u); Tb[3] = __builtin_amdgcn_perm(p3, p1, 0x07060302u);
#pragma unroll
                            for (int b_ = 0; b_ < 4; ++b_) { ya[16 * q + 4 * w_ + b_] = __builtin_amdgcn_sdot4((int)Tb[b_], cq_, ya[16 * q + 4 * w_ + b_], false);
                                yl[16 * q + 4 * w_ + b_] = __builtin_amdgcn_sdot4((int)(Tb[b_] & 0x0F0F0F0Fu), cq_, yl[16 * q + 4 * w_ + b_], false); } } }
                    if (bt + 1 < 16) {
#pragma unroll
                        for (int r = 0; r < 8; ++r) RV[r][q] = *(const GAS v4u*)(EV4 + ron[r] + 128 * q); }
                }
            }
#undef PEER_ROFFV
            int to_ = grp * 8 + g, jo_ = j; asm volatile("" : "+v"(to_), "+v"(jo_));
            const int b = to_ / SEQ; const unsigned eo_ = (unsigned)to_ * D + 128 * H + 8 * jo_;
            const float* g2 = mod_ + b * NMOD + 5120 + 128 * H + 8 * jo_;
            const bf16* ip = X1B_ + eo_; float* op = ((scratch_dst || HH + 2 < 2 * PEER_DUP_V) ? WSP(float, WS_SCORES) : out_) + eo_;
#pragma unroll
            for (int q = 0; q < 2; ++q) { __builtin_amdgcn_sched_barrier(0);
#pragma unroll
                for (int w_ = 0; w_ < 4; ++w_)
#pragma unroll
                    for (int nh = 0; nh < 2; ++nh) { const int co = 256 * (2 * (w_ & 1) + nh) + 64 * q + 4 * (w_ >> 1); const int yb = 16 * q + 4 * w_ + 2 * nh;
                        const unsigned long long xw_ = *(const GAS unsigned long long*)(ip + co); const unsigned xlo_ = (unsigned)xw_, xhi_ = (unsigned)(xw_ >> 32); const f32x4 x1 = (f32x4){bflo(xlo_), bfhi(xlo_), bflo(xhi_), bfhi(xhi_)}; const f32x4 gg = *(const f32x4*)(g2 + co) * yscale;
                        f32x4 o; o.x = x1.x + gg.x * (float)(yl[yb] - csum8); o.y = x1.y + gg.y * (float)((ya[yb] - yl[yb]) >> 4); o.z = x1.z + gg.z * (float)(yl[yb + 1] - csum8); o.w = x1.w + gg.w * (float)((ya[yb + 1] - yl[yb + 1]) >> 4);
                        *(GAS f32x4*)(op + co) = o; } }
        }
#undef PEER_LOADU
#undef PEER_DOTU
#undef PEER_SWEEPU
    }
}

DI void ph_inproj(const Frame& F) {
    pg8::Gemm g{WSP(bf16, WS_XN), WSP(bf16, WS_WIN), T, NPROJ, D}; pg8::StaticOrder S; S.init(T, NPROJ, F.G, (int)blockIdx.x);
    pg8::EpiBf16<0> E{WSP(bf16, WS_PROJ), NPROJ, nullptr, 0, 0, 1.f};
    pg8::gemm_phase<pg8::EpiBf16<0>, pg8::StaticOrder, PG8_ALIGN, PG8_SP2>(F.lds, g, S, E);
}
DI void ph_mix(const Frame& F, bool probe_first) {
    stage_conv_w(F);
    {
        int u = F.vcu;
        MlLocalRegs ra;
        if (u < 2048) ml_local_load(F, u >> 6, u & 63, ra);
        const int gwv = F.vcu * NWAVES + F.wave, NGWv = F.G * NWAVES;
        int eb = 2 * gwv;
        while (u < 2048) {
            const int un = u + F.G;
            MlLocalRegs rb;
            if (un < 2048) ml_local_load(F, un >> 6, un & 63, rb);
            ExpRows2 er; const bool ew = eb < 16384;
            if (ew) exp_load2(F, eb, er);
            ml_local_unit(F, u >> 6, u & 63, ra);
            if (ew) exp_conv2(F, eb, er);
            eb += 2 * NGWv;
            ra = rb; u = un;
        }
        for (; eb < 16384; eb += 2 * NGWv) { ExpRows2 er; exp_load2(F, eb, er); exp_conv2(F, eb, er); }
    }
    (void)probe_first;
}
DI void ph_scan_attn(const Frame& F) {
    ml_scan_phase(F);
    __syncthreads();
    const int gwv = F.vcu * NWAVES + F.wave, NGWv = F.G * NWAVES;
    int eb = 16384 + 2 * gwv;
    for (int u = F.vcu; u < 1024; u += F.G) { const int qb = 15 - (u >> 6), bh = u & 63;
        ExpRows2 er; const bool ew = eb < 32768;
        if (ew) exp_load2(F, eb, er);
        sb_unit(F, bh >> 3, bh & 7, qb);
        if (ew) exp_conv2(F, eb, er);
        eb += 2 * NGWv; }
    for (; eb < 32768; eb += 2 * NGWv) { ExpRows2 er; exp_load2(F, eb, er); exp_conv2(F, eb, er); }
}
DI void ph_mlout(const Frame& F) { stage_conv_w(F); for (int u = F.vcu; u < 2048; u += F.G) { const int un = u + F.G; ml_out_unit(F, u >> 6, u & 63, un < 2048 ? (un >> 6) : -1, un & 63); } }
#ifndef P5_ALIGN
#define P5_ALIGN PG8_ALIGN
#endif
DI void ph_outproj(const Frame& F) {
    pg8::Gemm g{WSP(bf16, WS_MIX), WSP(bf16, WS_WOUT), T, D, D}; pg8::StaticOrder S; S.init(T, D, F.G, (int)blockIdx.x);
    pg8::EpiResGateBf16 E{inp(I_X), WSP(pg8::bf16_t, WS_X1B), WSP(float, WS_MOD) + 2048, NMOD, SEQ, D};
    pg8::gemm_phase<pg8::EpiResGateBf16, pg8::StaticOrder, P5_ALIGN, PG8_SP2>(F.lds, g, S, E);
}
DI void ph_scores(const Frame& F) {
    pg8::Gemm g{WSP(bf16, WS_XN), WSP(bf16, WS_WEFF), T, NSC, D}; pg8::StaticOrder S; S.init(T, NSC, F.G, (int)blockIdx.x);
    EpiTopK E{WSP(int, WS_IDX), WSP(float, WS_GATE)};
    pg8::Unit un;
    for (int i = 0; S.next(i, un); ++i) { OneUnit S1{un}; pg8::gemm_phase<EpiTopK, OneUnit, false, PG8_SP2>(F.lds, g, S1, E); }
}
constexpr int N_PHASES = 11;
struct Args { const float* in[19]; float* out; unsigned char* ws; int ph_lo, ph_hi; };
__global__ void __launch_bounds__(NTHR, 2) hybrid_fwd(Args args) {
    extern __shared__ __attribute__((aligned(16))) unsigned char lds_raw[];
    Frame F;
    F.lds = (LAS unsigned char*)lds_raw;
    F.MISC = (volatile LAS unsigned*)(F.lds + LDSCTL_OFF + 320);
    F.tid = threadIdx.x; F.lane = F.tid & 63; F.wave = __builtin_amdgcn_readfirstlane(F.tid >> 6);
    F.G = gridDim.x; { const int bx = blockIdx.x; F.vcu = (F.G % 8 == 0) ? (bx % 8) * (F.G / 8) + bx / 8 : bx; }
    F.ws = args.ws;
    F.ctl = (gu32*)(F.ws + WS_CTL);
    for (int u = F.tid; u < (LDS_BYTES - LDSCTL_OFF) / 4; u += NTHR) ((LAS unsigned*)(F.lds + LDSCTL_OFF))[u] = 0u;
    __syncthreads();
    const int lo = args.ph_lo, hi = args.ph_hi;
    const bool one_launch = (hi - lo) > 1;
    XcdBarrier bar; bar.bar = (unsigned*)(F.ctl + CW_BAR); bar.x = 0; bar.st = nullptr;
    if (one_launch) bar = xcd_barrier_post((unsigned*)(F.ctl + CW_BAR), F.MISC + 8);
#ifndef PHMASK
#define PHMASK 0x7ff
#endif
#define IN(k) (((PHMASK >> (k)) & 1) && lo <= (k) && (k) < hi)
#define SEAM(k) do { if (IN(k) && IN((k) + 1)) xcd_barrier(bar); } while (0)
#ifndef REPMASK
#define REPMASK 0
#endif

#define RUN(k, ...) do { if (IN(k)) { if ((REPMASK >> (k)) & 1) { { const bool first = true; (void)first; __VA_ARGS__; } xcd_barrier(bar); } { const bool first = false; (void)first; __VA_ARGS__; } } } while (0)
    RUN(0, p0_phase(F, first ? P0_PARTS : 15)); SEAM(0);
    RUN(1, norm_phase<true>(F, inp(I_X), inp(I_GN1), 0, 1024)); SEAM(1);
    RUN(2, ph_inproj(F)); SEAM(2);
    RUN(3, ph_mix(F, first)); SEAM(3);
    RUN(10, ph_scan_attn(F)); if (IN(10) && IN(4)) xcd_barrier(bar);
    RUN(4, ph_mlout(F)); SEAM(4);
    RUN(5, ph_outproj(F)); SEAM(5);
    RUN(6, norm_phase<false, true>(F, (const float*)WSP(bf16, WS_X1B), inp(I_GN2), 3072, 4096)); SEAM(6);
    RUN(7, ph_scores(F)); if (IN(7) && IN(9)) xcd_barrier(bar);
    RUN(9, peer_phase(F, first));
#undef RUN
#undef IN
#undef SEAM
}

#ifndef MK_PER_PHASE
#define MK_PER_PHASE 0
#endif
extern "C" void kernel_launch(void* const* d_in, const int* in_sizes, int n_in, void* d_out, int out_size, void* d_ws, size_t ws_size, hipStream_t stream) {
    static int grid = 0;
    if (grid == 0) {
        if (n_in != 19 || in_sizes[0] != T * D || out_size != T * D || ws_size < WS_END) { fprintf(stderr, "kernel_launch: unexpected shapes (n_in %d, in0 %d, out %d, ws %zu)\n", n_in, n_in > 0 ? in_sizes[0] : -1, out_size, ws_size); grid = -1; return; }
        int dev = 0, cus = 0, per_cu = 0;
        if (hipGetDevice(&dev) != hipSuccess || hipDeviceGetAttribute(&cus, hipDeviceAttributeMultiprocessorCount, dev) != hipSuccess) { grid = -1; return; }
        if (hipFuncSetAttribute((const void*)hybrid_fwd, hipFuncAttributeMaxDynamicSharedMemorySize, LDS_BYTES) != hipSuccess) { fprintf(stderr, "kernel_launch: hipFuncSetAttribute failed\n"); grid = -1; return; }
        if (hipOccupancyMaxActiveBlocksPerMultiprocessor(&per_cu, (const void*)hybrid_fwd, NTHR, LDS_BYTES) != hipSuccess || per_cu < 1) fprintf(stderr, "kernel_launch: occupancy query says %d\n", per_cu);
        (void)hipGetLastError();
        grid = cus;
    }
    if (grid < 0) return;
    if (hipMemsetAsync((char*)d_ws + WS_CTL, 0, CTL_ZERO_BYTES, stream) != hipSuccess) { fprintf(stderr, "kernel_launch: memset failed\n"); return; }
    Args a{};
    for (int i = 0; i < 19; ++i) a.in[i] = (const float*)d_in[i];
    a.out = (float*)d_out; a.ws = (unsigned char*)d_ws;
#if MK_PER_PHASE
    { const int order[N_PHASES] = {0, 1, 2, 3, 10, 4, 5, 6, 7, 8, 9}; for (int i = 0; i < N_PHASES; ++i) { a.ph_lo = order[i]; a.ph_hi = order[i] + 1; hipLaunchKernelGGL(hybrid_fwd, dim3(grid), dim3(NTHR), LDS_BYTES, stream, a); } }
#else
    a.ph_lo = 0; a.ph_hi = N_PHASES;
    hipLaunchKernelGGL(hybrid_fwd, dim3(grid), dim3(NTHR), LDS_BYTES, stream, a);
#endif
    const hipError_t le = hipPeekAtLastError();
    if (le != hipSuccess) fprintf(stderr, "kernel_launch: launch failed: %s\n", hipGetErrorName(le));
}
```

```cpp
#include <cmath>
#include <hip/hip_runtime.h>
#include <cstdio>
#include <cstdint>
namespace pg8 {
#define PG8_LAS __attribute__((address_space(3)))
typedef unsigned short bf16_t;
typedef short bf16x8 __attribute__((ext_vector_type(8)));
typedef float f32x4 __attribute__((ext_vector_type(4)));
typedef unsigned u32x4 __attribute__((ext_vector_type(4)));
constexpr int BM = 256, BK = 64, HALF = 128, HTB = HALF * BK * 2  , STAGE_BYTES = 8 * HTB, NXCD = 8,
#ifndef PG8_WGM
#define PG8_WGM 4
#endif
WGM = PG8_WGM;

__host__ __device__ __forceinline__ int lds_byte(int r, int c) { const int st = (r >> 4) * 2 + (c >> 5), rr = r & 15, cc = c & 31, ob = rr * 64 + cc * 2; return st * 1024 + (ob ^ (((ob >> 9) & 1) << 5)); }
__host__ __device__ __forceinline__ void stage_rc(int b, int& R, int& C) { const int st = b / 1024, sb = b % 1024, swz = sb ^ (((sb >> 9) & 1) << 5); R = (st >> 1) * 16 + swz / 64; C = (st & 1) * 32 + (swz % 64) / 2; }
__host__ __device__ __forceinline__ int perm32(int rho) { const int n = rho >> 4, i = rho & 15; return 8 * (i >> 2) + 4 * n + (i & 3); }

struct Unit { int pm, pn; };
struct Gemm { const bf16_t* A; const bf16_t* Bt; int M, N, K; };

struct StaticOrder {
    int nM, nN, nwg, G, c;
    __host__ __device__ void init(int M, int N, int G_, int c_) { nM = M / BM; nN = N / BM; nwg = nM * nN; G = G_; c = c_; }
    __host__ __device__ bool next(int i, Unit& u) const {
        const long L = (long)i * G + c; if (L >= nwg) return false;
        int wgid = (int)L; { const int q = nwg / NXCD, r = nwg % NXCD, xcd = wgid % NXCD, off = wgid / NXCD; wgid = (xcd < r ? xcd * (q + 1) : r * (q + 1) + (xcd - r) * q) + off; }
        const int nig = WGM * nN, gid = wgid / nig, fm = gid * WGM, gsz = (nM - fm) < WGM ? (nM - fm) : WGM;
        u.pm = fm + ((wgid % nig) % gsz); u.pn = (wgid % nig) / gsz; return true;
    }
    __device__ __forceinline__ void a_ready(const Unit&) const {}
    __device__ __forceinline__ void done(const Unit&) const {}
};

__device__ __forceinline__ unsigned cvt_pk_bf16(float lo, float hi) { unsigned r; asm volatile("v_cvt_pk_bf16_f32 %0, %1, %2" : "=v"(r) : "v"(lo), "v"(hi)); return r; }
typedef float f32x2 __attribute__((ext_vector_type(2)));
__device__ __forceinline__ f32x2 gelu_pk(f32x2 v) {
    const f32x2 av = __builtin_elementwise_abs(v), d = av * 0.2316418882f + 1.0f;
    f32x2 t; t.x = __builtin_amdgcn_rcpf(d.x); t.y = __builtin_amdgcn_rcpf(d.y);
    f32x2 q = t * 0.5307027145f + (-0.7265760135f); q = q * t + 0.7107068705f; q = q * t + (-0.142248368f); q = q * t + 0.127414796f; q = q * t;
    const f32x2 s = (v * v) * (-0.72134752044f);
    f32x2 e; e.x = __builtin_amdgcn_exp2f(s.x); e.y = __builtin_amdgcn_exp2f(s.y);
    const f32x2 m = v * (q * e), r = v - m;
    f32x2 o; o.x = v.x < 0.f ? m.x : r.x; o.y = v.y < 0.f ? m.y : r.y; return o;
}

template <int ACT  > struct EpiBf16 {
    static constexpr bool PERM = true, AFTER_DRAIN = false; static_assert(ACT == 0 || ACT == 1, "EpiBf16: ACT is 0 (none) or 1 (gelu_pk)");
    bf16_t* O; int ldc; const float* bias; int split_cols; size_t split_stride; float scale0;
    __device__ __forceinline__ void operator()(const f32x4 (&acc)[2][2][4][2], const Unit& u, int wr, int wc, int fr, int fq) const {
        const int row0 = u.pm * BM + wr * 64 + fr; int colt = u.pn * BM; bf16_t* base = O;
        float sc = 1.f; if (split_cols) { const int t = colt / split_cols; base += (size_t)t * split_stride; colt -= t * split_cols; if (t == 0) sc = scale0; }
        const int col0 = colt + wc * 32 + 8 * fq, bcol0 = u.pn * BM + wc * 32 + 8 * fq;
        f32x4 bv[2][2];
#pragma unroll
        for (int bj = 0; bj < 2; ++bj)
#pragma unroll
            for (int n = 0; n < 2; ++n) bv[bj][n] = bias ? *(const f32x4*)(bias + bcol0 + bj * HALF + 4 * n) : (f32x4){0.f, 0.f, 0.f, 0.f};
#pragma unroll
        for (int ai = 0; ai < 2; ++ai)
#pragma unroll
            for (int m = 0; m < 4; ++m) { bf16_t* rowp = base + (size_t)(row0 + ai * HALF + m * 16) * ldc + col0;
#pragma unroll
                for (int bj = 0; bj < 2; ++bj) { f32x4 v0 = acc[ai][bj][m][0] + bv[bj][0], v1 = acc[ai][bj][m][1] + bv[bj][1];
                    if (ACT == 1) { f32x2 a = gelu_pk((f32x2){v0[0], v0[1]}), b = gelu_pk((f32x2){v0[2], v0[3]}), c = gelu_pk((f32x2){v1[0], v1[1]}), d = gelu_pk((f32x2){v1[2], v1[3]});
                        v0 = (f32x4){a.x, a.y, b.x, b.y}; v1 = (f32x4){c.x, c.y, d.x, d.y}; }
                    v0 = v0 * sc; v1 = v1 * sc; u32x4 w; w.x = cvt_pk_bf16(v0[0], v0[1]); w.y = cvt_pk_bf16(v0[2], v0[3]); w.z = cvt_pk_bf16(v1[0], v1[1]); w.w = cvt_pk_bf16(v1[2], v1[3]);
                    *(u32x4*)(rowp + bj * HALF) = w; } }
    }
};
template <class Epi, class Sched, bool ALIGN_EPI = false, bool SP2 = false>
__device__ __forceinline__ void gemm_phase(PG8_LAS unsigned char* lds, const Gemm g, const Sched& S, const Epi& E) {
    const int tid = threadIdx.x, wid = __builtin_amdgcn_readfirstlane(tid >> 6), lane = tid & 63, wr = wid >> 2, wc = wid & 3, fr = lane & 15, fq = lane >> 4;
    const int K = g.K, nt = K / BK;
    unsigned voffA[2], voffB[2];
#pragma unroll
    for (int i = 0; i < 2; ++i) { int R, C; stage_rc(tid * 16 + i * 8192, R, C); const int Rb = Epi::PERM ? ((R & ~31) + perm32(R & 31)) : R;
        voffA[i] = (unsigned)(R * K + C) * 2u; voffB[i] = (unsigned)(Rb * K + C) * 2u; }
    const size_t kstep = (size_t)(BK * 2);
    const size_t hstep = (size_t)HALF * K * 2;
    const size_t tstep = 2 * hstep;
    const unsigned ldsw = (unsigned)wid * 1024u;
    const int aoff = lds_byte(wr * 64 + fr, fq * 8), boff = lds_byte(wc * 32 + fr, fq * 8);
#define PG8_SA(b, h) (((b) * 2 + (h)) * HTB)
#define PG8_SB(b, h) ((4 + (b) * 2 + (h)) * HTB)
#define PG8_STAGE(bufoff, gbase, voff) do { _Pragma("unroll") for (int _i = 0; _i < 2; ++_i) \
        __builtin_amdgcn_global_load_lds((const unsigned*)((const char*)(gbase) + (voff)[_i]), (PG8_LAS unsigned*)(lds + (bufoff) + ldsw + _i * 8192), 16, 0, 0); } while (0)
#define PG8_LDA(dst, b, h) do { _Pragma("unroll") for (int m = 0; m < 4; ++m) _Pragma("unroll") for (int k = 0; k < 2; ++k) dst[m][k] = *(const PG8_LAS bf16x8*)(lds + PG8_SA(b, h) + aoff + m * 2048 + k * 1024); } while (0)
#define PG8_LDB(dst, b, h) do { _Pragma("unroll") for (int n = 0; n < 2; ++n) _Pragma("unroll") for (int k = 0; k < 2; ++k) dst[n][k] = *(const PG8_LAS bf16x8*)(lds + PG8_SB(b, h) + boff + n * 2048 + k * 1024); } while (0)
#define PG8_MMA(ai, bj, At, Bt) do { __builtin_amdgcn_s_setprio(1); _Pragma("unroll") for (int m = 0; m < 4; ++m) _Pragma("unroll") for (int n = 0; n < 2; ++n) _Pragma("unroll") for (int k = 0; k < 2; ++k) \
        acc[ai][bj][m][n] = __builtin_amdgcn_mfma_f32_16x16x32_bf16(Bt[n][k], At[m][k], acc[ai][bj][m][n], 0, 0, 0); __builtin_amdgcn_s_setprio(0); } while (0)
#define PG8_WAIT_V(n) asm volatile("s_waitcnt vmcnt(" #n ")" ::: "memory")
#define PG8_WAIT_L(n) asm volatile("s_waitcnt lgkmcnt(" #n ")" ::: "memory")
#define PG8_BAR __builtin_amdgcn_s_barrier()
#define PG8_SCHED __builtin_amdgcn_sched_barrier(0)
    Unit cur, nxt; int ui = 0;
    if (!S.next(0, cur)) return;
    f32x4 acc[2][2][4][2];
#pragma unroll
    for (int a = 0; a < 2; ++a)
#pragma unroll
        for (int b = 0; b < 2; ++b)
#pragma unroll
            for (int m = 0; m < 4; ++m)
#pragma unroll
                for (int n = 0; n < 2; ++n) acc[a][b][m][n] = (f32x4){0.f, 0.f, 0.f, 0.f};
    bf16x8 At[4][2], B0[2][2], B1[2][2];
    const char* cA = (const char*)g.A + (size_t)cur.pm * tstep; const char* cB = (const char*)g.Bt + (size_t)cur.pn * tstep;
    S.a_ready(cur);
    if constexpr (SP2) {
        PG8_STAGE(PG8_SB(0, 0), cB, voffB); PG8_STAGE(PG8_SB(0, 1), cB + hstep, voffB); PG8_STAGE(PG8_SA(0, 0), cA, voffA); PG8_STAGE(PG8_SA(0, 1), cA + hstep, voffA);
        if (wr == 1) PG8_BAR;
        PG8_WAIT_V(2); PG8_BAR;
        PG8_STAGE(PG8_SB(1, 0), cB + kstep, voffB); PG8_STAGE(PG8_SA(1, 0), cA + kstep, voffA); PG8_STAGE(PG8_SB(1, 1), cB + hstep + kstep, voffB);
        PG8_WAIT_V(6); PG8_BAR;
    } else {
        PG8_STAGE(PG8_SB(0, 0), cB, voffB); PG8_STAGE(PG8_SA(0, 0), cA, voffA); PG8_STAGE(PG8_SB(0, 1), cB + hstep, voffB); PG8_STAGE(PG8_SA(0, 1), cA + hstep, voffA);
        if (wr == 1) PG8_BAR;
        PG8_WAIT_V(4); PG8_BAR;
        PG8_STAGE(PG8_SB(1, 0), cB + kstep, voffB); PG8_STAGE(PG8_SA(1, 0), cA + kstep, voffA); PG8_STAGE(PG8_SB(1, 1), cB + hstep + kstep, voffB);
        PG8_WAIT_V(6); PG8_BAR;
    }
    for (;;) {
        const bool has_next = S.next(ui + 1, nxt);
        const char* nA = has_next ? (const char*)g.A + (size_t)nxt.pm * tstep : cA; const char* nB = has_next ? (const char*)g.Bt + (size_t)nxt.pn * tstep : cB;
        for (int t = 0; t < nt; t += 2) {
            const bool last = (t == nt - 2);
            const char* a1 = cA + (size_t)(t + 1) * kstep;
            const char* a2 = last ? nA : cA + (size_t)(t + 2) * kstep; const char* b2 = last ? nB : cB + (size_t)(t + 2) * kstep;
            const char* a3 = a2 + kstep; const char* b3 = b2 + kstep;
            if (last && has_next) S.a_ready(nxt);
            if constexpr (SP2) {
            PG8_LDB(B0, 0, 0); PG8_LDB(B1, 0, 1); PG8_SCHED; PG8_LDA(At, 0, 0); PG8_STAGE(PG8_SA(1, 1), a1 + hstep, voffA);
            PG8_WAIT_V(8); PG8_WAIT_L(0); PG8_BAR; PG8_MMA(0, 0, At, B0); PG8_MMA(0, 1, At, B1); PG8_BAR; PG8_SCHED;
            PG8_LDA(At, 0, 1); PG8_STAGE(PG8_SB(0, 0), b2, voffB); PG8_STAGE(PG8_SB(0, 1), b2 + hstep, voffB); PG8_STAGE(PG8_SA(0, 0), a2, voffA);
            PG8_WAIT_V(8); PG8_WAIT_L(0); PG8_BAR; PG8_MMA(1, 0, At, B0); PG8_MMA(1, 1, At, B1); PG8_BAR; PG8_SCHED;
            PG8_LDB(B0, 1, 0); PG8_LDB(B1, 1, 1); PG8_SCHED; PG8_LDA(At, 1, 0); PG8_STAGE(PG8_SA(0, 1), a2 + hstep, voffA);
            PG8_WAIT_V(8); PG8_WAIT_L(0); PG8_BAR; PG8_MMA(0, 0, At, B0); PG8_MMA(0, 1, At, B1); PG8_BAR; PG8_SCHED;
            PG8_LDA(At, 1, 1); PG8_STAGE(PG8_SB(1, 0), b3, voffB); PG8_STAGE(PG8_SB(1, 1), b3 + hstep, voffB); PG8_STAGE(PG8_SA(1, 0), a3, voffA);
            PG8_WAIT_V(8); PG8_WAIT_L(0); PG8_BAR; PG8_MMA(1, 0, At, B0); PG8_MMA(1, 1, At, B1); PG8_BAR; PG8_SCHED;
            } else {
            PG8_LDB(B0, 0, 0); PG8_SCHED; PG8_LDA(At, 0, 0); PG8_STAGE(PG8_SA(1, 1), a1 + hstep, voffA);
            PG8_WAIT_L(8); PG8_BAR; PG8_WAIT_L(0); PG8_MMA(0, 0, At, B0); PG8_BAR; PG8_SCHED;
            PG8_LDB(B1, 0, 1); PG8_STAGE(PG8_SB(0, 0), b2, voffB);
            PG8_BAR; PG8_WAIT_L(0); PG8_MMA(0, 1, At, B1); PG8_BAR;
            PG8_LDA(At, 0, 1); PG8_STAGE(PG8_SA(0, 0), a2, voffA);
            PG8_BAR; PG8_WAIT_L(0); PG8_MMA(1, 0, At, B0); PG8_BAR; PG8_SCHED;
            PG8_STAGE(PG8_SB(0, 1), b2 + hstep, voffB);
            PG8_WAIT_V(6); PG8_BAR; PG8_MMA(1, 1, At, B1); PG8_BAR;
            PG8_LDB(B0, 1, 0); PG8_SCHED; PG8_LDA(At, 1, 0); PG8_STAGE(PG8_SA(0, 1), a2 + hstep, voffA);
            PG8_WAIT_L(8); PG8_BAR; PG8_WAIT_L(0); PG8_MMA(0, 0, At, B0); PG8_BAR; PG8_SCHED;
            PG8_LDB(B1, 1, 1); PG8_STAGE(PG8_SB(1, 0), b3, voffB);
            PG8_BAR; PG8_WAIT_L(0); PG8_MMA(0, 1, At, B1); PG8_BAR;
            PG8_LDA(At, 1, 1); PG8_STAGE(PG8_SA(1, 0), a3, voffA);
            PG8_BAR; PG8_WAIT_L(0); PG8_MMA(1, 0, At, B0); PG8_BAR; PG8_SCHED;
            PG8_STAGE(PG8_SB(1, 1), b3 + hstep, voffB);
            PG8_WAIT_V(6); PG8_BAR; PG8_MMA(1, 1, At, B1); PG8_BAR;
            }
        }
        if constexpr (ALIGN_EPI) { if (wr == 0) PG8_BAR; }
        if constexpr (!Epi::AFTER_DRAIN) { E(acc, cur, wr, wc, fr, fq); S.done(cur); }
        if (!has_next) break;
#pragma unroll
        for (int a = 0; a < 2; ++a)
#pragma unroll
            for (int b = 0; b < 2; ++b)
#pragma unroll
                for (int m = 0; m < 4; ++m)
#pragma unroll
                    for (int n = 0; n < 2; ++n) acc[a][b][m][n] = (f32x4){0.f, 0.f, 0.f, 0.f};
        cur = nxt; cA = nA; cB = nB; ++ui;
        if constexpr (ALIGN_EPI) { if (wr == 1) PG8_BAR; }
    }
    PG8_WAIT_V(0);
    if constexpr (!ALIGN_EPI) { if (wr == 0) PG8_BAR; }
    PG8_BAR;
    if constexpr (Epi::AFTER_DRAIN) { E.fused(acc, cur, wr, wc, fr, fq, lds, wid, lane); S.done(cur); }
#undef PG8_SA
#undef PG8_SB
#undef PG8_STAGE
#undef PG8_LDA
#undef PG8_LDB
#undef PG8_MMA
#undef PG8_WAIT_V
#undef PG8_WAIT_L
#undef PG8_BAR
#undef PG8_SCHED
}
}

#ifndef PG8_SP2
#define PG8_SP2 true
#endif
#ifndef PG8_ALIGN
#define PG8_ALIGN true
#endif

namespace pg8 {
struct EpiResGate {
    static constexpr bool PERM = false, AFTER_DRAIN = false;
    const float* base; float* out; const float* gate; int gate_ld; int rows_per_batch; int ldc;
    __device__ __forceinline__ void operator()(const f32x4 (&acc)[2][2][4][2], const Unit& u, int wr, int wc, int fr, int fq) const {
        const int row0 = u.pm * BM + wr * 64 + fr, col0 = u.pn * BM + wc * 32 + 4 * fq;
        const float* gp = gate + (size_t)((u.pm * BM) / rows_per_batch) * gate_ld + col0;
        f32x4 gv[2][2];
#pragma unroll
        for (int bj = 0; bj < 2; ++bj)
#pragma unroll
            for (int n = 0; n < 2; ++n) gv[bj][n] = *(const f32x4*)(gp + bj * HALF + n * 16);
#pragma unroll
        for (int ai = 0; ai < 2; ++ai)
#pragma unroll
            for (int m = 0; m < 4; ++m) { const size_t off = (size_t)(row0 + ai * HALF + m * 16) * ldc + col0;
#pragma unroll
                for (int bj = 0; bj < 2; ++bj)
#pragma unroll
                    for (int n = 0; n < 2; ++n) { const f32x4 bs = *(const f32x4*)(base + off + bj * HALF + n * 16);
                        *(f32x4*)(out + off + bj * HALF + n * 16) = bs + gv[bj][n] * acc[ai][bj][m][n]; } }
    }
};
struct EpiResGateBf16 {
    static constexpr bool PERM = false, AFTER_DRAIN = false;
    const float* base; bf16_t* out; const float* gate; int gate_ld; int rows_per_batch; int ldc;
    __device__ __forceinline__ void operator()(const f32x4 (&acc)[2][2][4][2], const Unit& u, int wr, int wc, int fr, int fq) const {
        const int row0 = u.pm * BM + wr * 64 + fr, col0 = u.pn * BM + wc * 32 + 4 * fq;
        const float* gp = gate + (size_t)((u.pm * BM) / rows_per_batch) * gate_ld + col0;
        f32x4 gv[2][2];
#pragma unroll
        for (int bj = 0; bj < 2; ++bj)
#pragma unroll
            for (int n = 0; n < 2; ++n) gv[bj][n] = *(const f32x4*)(gp + bj * HALF + n * 16);
#pragma unroll
        for (int ai = 0; ai < 2; ++ai) {
            f32x4 bs[4][2][2];
#pragma unroll
            for (int m = 0; m < 4; ++m) { const size_t off = (size_t)(row0 + ai * HALF + m * 16) * ldc + col0;
#pragma unroll
                for (int bj = 0; bj < 2; ++bj)
#pragma unroll
                    for (int n = 0; n < 2; ++n) bs[m][bj][n] = __builtin_nontemporal_load((const f32x4*)(base + off + bj * HALF + n * 16)); }
            __builtin_amdgcn_sched_barrier(0);
#pragma unroll
            for (int m = 0; m < 4; ++m) { const size_t off = (size_t)(row0 + ai * HALF + m * 16) * ldc + col0;
#pragma unroll
                for (int bj = 0; bj < 2; ++bj)
#pragma unroll
                    for (int n = 0; n < 2; ++n) { const f32x4 r = bs[m][bj][n] + gv[bj][n] * acc[ai][bj][m][n];
                        *(unsigned long long*)(out + off + bj * HALF + n * 16) = (unsigned long long)cvt_pk_bf16(r.x, r.y) | ((unsigned long long)cvt_pk_bf16(r.z, r.w) << 32); } }
        }
    }
};
struct EpiF32 {
    static constexpr bool PERM = false, AFTER_DRAIN = false;
    float* O; int ldc;
    __device__ __forceinline__ void operator()(const f32x4 (&acc)[2][2][4][2], const Unit& u, int wr, int wc, int fr, int fq) const {
        const int row0 = u.pm * BM + wr * 64 + fr, col0 = u.pn * BM + wc * 32 + 4 * fq;
#pragma unroll
        for (int ai = 0; ai < 2; ++ai)
#pragma unroll
            for (int m = 0; m < 4; ++m) { const size_t off = (size_t)(row0 + ai * HALF + m * 16) * ldc + col0;
#pragma unroll
                for (int bj = 0; bj < 2; ++bj)
#pragma unroll
                    for (int n = 0; n < 2; ++n) *(f32x4*)(O + off + bj * HALF + n * 16) = acc[ai][bj][m][n]; }
    }
};
}
#define GAS __attribute__((address_space(1)))
#define LAS __attribute__((address_space(3)))
typedef unsigned short bf16;
typedef unsigned v4u __attribute__((ext_vector_type(4)));
typedef float f32x4 __attribute__((ext_vector_type(4)));
typedef short bf16x8 __attribute__((ext_vector_type(8)));
typedef GAS unsigned gu32;
typedef GAS unsigned long long gu64;
#define RLX_AGENT __ATOMIC_RELAXED, __HIP_MEMORY_SCOPE_AGENT
#define LDS_WAIT() asm volatile("s_waitcnt lgkmcnt(0)" ::: "memory")
#define VM_WAIT() asm volatile("s_waitcnt vmcnt(0)" ::: "memory")
__device__ __forceinline__ unsigned long long rt() { return __builtin_amdgcn_s_memrealtime(); }
__device__ __forceinline__ unsigned f2bf(float f) { unsigned u = __builtin_bit_cast(unsigned, f); return (u + 0x7fffu + ((u >> 16) & 1u)) >> 16; }
__device__ __forceinline__ unsigned pk2(float lo, float hi) { return f2bf(lo) | (f2bf(hi) << 16); }

#define XB_TMO      128
#define XB_XCNT(j)  (256  + 64 * (j))
#define XB_XSUB(j)  (1280 + 64 * (j))
#define XB_XGEN(j)  (2304 + 64 * (j))
#define XB_TOP      3328
#define XB_TOPGEN   3392
#define XCD_BAR_WORDS 3456
#define XB_SPIN_CAP (1u << 24)

__device__ __forceinline__ unsigned xb_ld(unsigned* p)              { return __hip_atomic_load(p, __ATOMIC_RELAXED, __HIP_MEMORY_SCOPE_AGENT); }
__device__ __forceinline__ unsigned xb_add(unsigned* p, unsigned v) { return __hip_atomic_fetch_add(p, v, __ATOMIC_RELAXED, __HIP_MEMORY_SCOPE_AGENT); }
__device__ __forceinline__ unsigned xb_xcc_id() { return (unsigned)__builtin_amdgcn_s_getreg((3 << 11) | 20) & 0xFu; }
#define XB_SPIN(cond, bar) do { unsigned _sp = 0; while (cond) { __builtin_amdgcn_s_sleep(1); \
    if ((++_sp & 255u) == 0u) { if (xb_ld(&(bar)[XB_TMO])) break; if (_sp > XB_SPIN_CAP) { atomicAdd(&(bar)[XB_TMO], 1u); break; } } } } while (0)

struct XcdBarrier {
    unsigned* bar; unsigned x;
    volatile LAS unsigned* st;
};

__device__ __forceinline__ XcdBarrier xcd_barrier_post(unsigned* bar, volatile LAS unsigned* st) {
    XcdBarrier b; b.bar = bar; b.x = xb_xcc_id(); b.st = st;
    if (threadIdx.x == 0) (void)xb_add(&bar[XB_XCNT(b.x)], 1u);
    return b;
}
__device__ __forceinline__ void xcd_barrier_complete(unsigned* bar, unsigned x, unsigned& nloc, unsigned& nx) {
    const unsigned G = gridDim.x * gridDim.y * gridDim.z;
    unsigned sum, cnt, mine, sp = 0u;
    for (;;) {
        sum = 0u; cnt = 0u; mine = 0u;
#pragma unroll
        for (unsigned j = 0; j < 16; ++j) { const unsigned c = xb_ld(&bar[XB_XCNT(j)]); sum += c; cnt += (c > 0u) ? 1u : 0u; mine = (j == x) ? c : mine; }
        if (sum == G) break;
        __builtin_amdgcn_s_sleep(1);
        if ((++sp & 255u) == 0u) { if (xb_ld(&bar[XB_TMO])) break; if (sp > XB_SPIN_CAP) { atomicAdd(&bar[XB_TMO], 1u); break; } }
    }
    nloc = mine > 0u ? mine : 1u; nx = cnt > 0u ? cnt : 1u;
}

__device__ __forceinline__ void xcd_barrier(const XcdBarrier& b) {
    asm volatile("s_waitcnt vmcnt(0)" ::: "memory");
    __syncthreads();
    if (threadIdx.x == 0) {
        unsigned* bar = b.bar;
        __builtin_amdgcn_s_waitcnt(0);
        unsigned nloc = b.st[0], nx = b.st[1];
        if (nloc == 0u) { xcd_barrier_complete(bar, b.x, nloc, nx); b.st[0] = nloc; b.st[1] = nx; }
        const unsigned old = xb_add(&bar[XB_XSUB(b.x)], 1u);
        const unsigned gen = old / nloc;
        if (old + 1u == (gen + 1u) * nloc) {
            __builtin_amdgcn_fence(__ATOMIC_RELEASE, "agent");
            asm volatile("s_waitcnt vmcnt(0)" ::: "memory");
            const unsigned og = xb_add(&bar[XB_TOP], 1u);
            const unsigned tg = og / nx;
            if (og + 1u == (tg + 1u) * nx) xb_add(&bar[XB_TOPGEN], 1u);
            else XB_SPIN(xb_ld(&bar[XB_TOPGEN]) == tg, bar);
            __builtin_amdgcn_fence(__ATOMIC_ACQUIRE, "agent");
            xb_add(&bar[XB_XGEN(b.x)], 1u);
            asm volatile("s_waitcnt vmcnt(0)" ::: "memory");
        } else {
            XB_SPIN(xb_ld(&bar[XB_XGEN(b.x)]) == gen, bar);
            __builtin_amdgcn_fence(__ATOMIC_ACQUIRE, "agent");
            asm volatile("s_waitcnt vmcnt(0)" ::: "memory");
        }
    }
    __syncthreads();
}

constexpr int NWAVES = 8, NTHR = 512;
constexpr int NB = 8, SEQ = 4096, T = NB * SEQ, D = 1024, NPROJ = 3584, NIN = 3592, NMOD = 6144, NSC = 2048;
constexpr int C_QSB = 0, C_KSB = 512, C_VSB = 1024, C_QML = 1536, C_KML = 2048, C_VML = 2560, C_OML = 3072;
constexpr float EPS = 1e-6f, LOG2E = 1.4426950408889634f;
constexpr size_t MiB = 1u << 20;
constexpr size_t WS_CTL = 0, CTL_ZERO_BYTES = 1 * MiB;
constexpr size_t WS_MOD = 256 * 1024;
constexpr size_t WS_WIN = 2 * MiB, WS_WOUT = 10 * MiB, WS_WEFF = 12 * MiB;
constexpr size_t WS_XN = 16 * MiB;
constexpr size_t WS_PROJ = 80 * MiB;
constexpr size_t WS_MIX = 304 * MiB;
constexpr size_t WS_EXPU = 368 * MiB, WS_EXPV = 400 * MiB;
constexpr size_t WS_CST = 432 * MiB;
constexpr size_t WS_NST = 496 * MiB;
constexpr size_t WS_NSTB = 497 * MiB + 512 * 1024;
constexpr size_t WS_MST = 497 * MiB;
constexpr size_t WS_GATES = 498 * MiB;
constexpr size_t WS_XQ = 272 * MiB;
constexpr size_t WS_XS = 499 * MiB + 256 * 1024;
constexpr size_t WS_X1B = 208 * MiB;
constexpr size_t WS_SCORES = 80 * MiB;
constexpr size_t WS_IDX = 336 * MiB, WS_GATE = 352 * MiB;
constexpr size_t WS_SCL = 499 * MiB;
constexpr size_t WS_SUI = 499 * MiB + 65536, WS_SVI = 499 * MiB + 131072;
constexpr size_t WS_END = 500 * MiB;
constexpr int CW_Q3 = 64;
constexpr int CW_BAR = 4096;
constexpr int LDS_BYTES = 147456, LDSCTL_OFF = 143360;

typedef float f32x16 __attribute__((ext_vector_type(16)));
typedef float f32x2_t __attribute__((ext_vector_type(2)));
typedef __bf16 bf16x2_t __attribute__((ext_vector_type(2)));
typedef _Float16 f16x8 __attribute__((ext_vector_type(8)));
typedef short s16x4 __attribute__((ext_vector_type(4)));
typedef unsigned u32x2 __attribute__((ext_vector_type(2)));
#define DI __device__ __forceinline__
DI unsigned cvtpk(float lo, float hi) { f32x2_t v = {lo, hi}; bf16x2_t b = __builtin_convertvector(v, bf16x2_t); return __builtin_bit_cast(unsigned, b); }
DI float bflo(unsigned u) { return __uint_as_float(u << 16); }
DI float bfhi(unsigned u) { return __uint_as_float(u & 0xffff0000u); }
DI int crow(int i, int hi) { return (i & 3) + 8 * (i >> 2) + 4 * hi; }
DI int krow(int s, int hi, int j) { return 16 * s + 8 * (j >> 2) + 4 * hi + (j & 3); }
DI float swap_add(float v) { auto rr = __builtin_amdgcn_permlane32_swap(__float_as_uint(v), __float_as_uint(v), false, false); return __uint_as_float(rr[0]) + __uint_as_float(rr[1]); }
DI float swap_max(float v) { auto rr = __builtin_amdgcn_permlane32_swap(__float_as_uint(v), __float_as_uint(v), false, false); return fmaxf(__uint_as_float(rr[0]), __uint_as_float(rr[1])); }
DI float dot2bf(unsigned a, unsigned b, float acc) { return __builtin_amdgcn_fdot2_f32_bf16(__builtin_bit_cast(bf16x2_t, a), __builtin_bit_cast(bf16x2_t, b), acc, false); }
DI float ex2(float x) { return __builtin_amdgcn_exp2f(x); }
DI float lg2(float x) { return __builtin_amdgcn_logf(x); }
DI float fexp(float x) { return __builtin_amdgcn_exp2f(x * LOG2E); }
DI float wave_sum(float v) {
#pragma unroll
    for (int o = 1; o < 64; o <<= 1) v += __shfl_xor(v, o);
    return v;
}
DI float wave_max(float v) {
#pragma unroll
    for (int o = 1; o < 64; o <<= 1) v = fmaxf(v, __shfl_xor(v, o));
    return v;
}
#define DPP_MAXF(v, ctrl, rmask) fmaxf((v), __builtin_bit_cast(float, __builtin_amdgcn_update_dpp(0, __builtin_bit_cast(int, (v)), (ctrl), (rmask), 0xF, false)))
DI float wave_max_nonneg(float v) {
    v = DPP_MAXF(v, 0xB1, 0xF); v = DPP_MAXF(v, 0x4E, 0xF); v = DPP_MAXF(v, 0x141, 0xF); v = DPP_MAXF(v, 0x140, 0xF); v = DPP_MAXF(v, 0x142, 0xA); v = DPP_MAXF(v, 0x143, 0xC);
    return __builtin_bit_cast(float, __builtin_amdgcn_readlane(__builtin_bit_cast(int, v), 63));
}
#define DPP_ADDF(v, ctrl, rmask) ((v) + __builtin_bit_cast(float, __builtin_amdgcn_update_dpp(0, __builtin_bit_cast(int, (v)), (ctrl), (rmask), 0xF, false)))
DI float wave_sum_u(float v) {
    v = DPP_ADDF(v, 0xB1, 0xF); v = DPP_ADDF(v, 0x4E, 0xF); v = DPP_ADDF(v, 0x141, 0xF); v = DPP_ADDF(v, 0x140, 0xF); v = DPP_ADDF(v, 0x142, 0xA); v = DPP_ADDF(v, 0x143, 0xC);
    return __builtin_bit_cast(float, __builtin_amdgcn_readlane(__builtin_bit_cast(int, v), 63));
}
typedef short v4i16_t __attribute__((ext_vector_type(4)));
DI s16x4 trrd(LAS unsigned char* p) { return __builtin_bit_cast(s16x4, __builtin_amdgcn_ds_read_tr16_b64_v4i16((LAS v4i16_t*)p)); }
DI bf16x8 cat8(s16x4 a, s16x4 b) { return (bf16x8){a[0], a[1], a[2], a[3], b[0], b[1], b[2], b[3]}; }
#define MFMA_BF16(a, b, c) __builtin_amdgcn_mfma_f32_32x32x16_bf16((a), (b), (c), 0, 0, 0)
#define MFMA_F16(a, b, c) __builtin_amdgcn_mfma_f32_32x32x16_f16((a), (b), (c), 0, 0, 0)
DI unsigned pkh(float a, float b) { return __builtin_bit_cast(unsigned, __builtin_amdgcn_cvt_pkrtz(a, b)); }
DI bf16x8 packbf(const f32x16& x, int s) { v4u p; p.x = cvtpk(x[8 * s], x[8 * s + 1]); p.y = cvtpk(x[8 * s + 2], x[8 * s + 3]); p.z = cvtpk(x[8 * s + 4], x[8 * s + 5]); p.w = cvtpk(x[8 * s + 6], x[8 * s + 7]); return __builtin_bit_cast(bf16x8, p); }
DI f16x8 packh(const f32x16& x, int s) { v4u p; p.x = pkh(x[8 * s], x[8 * s + 1]); p.y = pkh(x[8 * s + 2], x[8 * s + 3]); p.z = pkh(x[8 * s + 4], x[8 * s + 5]); p.w = pkh(x[8 * s + 6], x[8 * s + 7]); return __builtin_bit_cast(f16x8, p); }

struct Frame {
    LAS unsigned char* lds;
    volatile LAS unsigned* MISC;
    gu32* ctl;
    unsigned char* ws;
    int tid, lane, wave, vcu, G;
};
DI const float* inp(int i) { const __attribute__((address_space(4))) unsigned long long* kp = (const __attribute__((address_space(4))) unsigned long long*)__builtin_amdgcn_kernarg_segment_ptr(); return (const float*)(const GAS float*)(*(volatile const __attribute__((address_space(4))) unsigned long long*)(kp + i)); }
enum { I_X = 0, I_C, I_WADA, I_BADA, I_GN1, I_WIN, I_BIG, I_BFG, I_CONVW, I_GQ, I_GK, I_GOSB, I_GOML, I_WOUT, I_GN2, I_WQ, I_SK, I_EU, I_EV, I_OUT };
#define WSP(type, off) ((type*)(F.ws + (off)))

DI void p0_transpose_item(const float* W, int K, int N, int ld, bf16* WT, LAS float* scr, int item, int lane) {
    const int nblk = N / 32, kb = item / nblk, nb = item % nblk, k0 = 64 * kb, n0 = 32 * nb;
    float tv[32];
#pragma unroll
    for (int i = 0; i < 32; ++i) tv[i] = W[(size_t)(k0 + 2 * i + (lane >> 5)) * ld + n0 + (lane & 31)];
#pragma unroll
    for (int i = 0; i < 32; ++i) scr[(2 * i + (lane >> 5)) * 33 + (lane & 31)] = tv[i];
    LDS_WAIT(); asm volatile("" ::: "memory");
    const int c = lane & 7;
#pragma unroll
    for (int j = 0; j < 4; ++j) { const int n = (lane >> 3) + 8 * j; const LAS float* s = scr + (8 * c) * 33 + n;
        v4u o; o.x = pk2(s[0 * 33], s[1 * 33]); o.y = pk2(s[2 * 33], s[3 * 33]); o.z = pk2(s[4 * 33], s[5 * 33]); o.w = pk2(s[6 * 33], s[7 * 33]);
        *(GAS v4u*)(WT + (size_t)(n0 + n) * K + k0 + 8 * c) = o; }
    LDS_WAIT(); asm volatile("" ::: "memory");
}
DI void p0_mod_block(const Frame& F, int item) {
    const float* const c_ = inp(I_C); const float* const w_ada_ = inp(I_WADA); const float* const b_ada_ = inp(I_BADA); float* const mod_ = WSP(float, WS_MOD);
    LAS float* scr = (LAS float*)(F.lds + F.wave * 16384);
    const int d0 = F.wave * 128;
    const int rg = F.lane >> 3, cl = F.lane & 7;
    f32x4 wv[16];
    { const float* wp = w_ada_ + (size_t)(d0 + rg) * NMOD + item * 32 + 4 * cl;
#pragma unroll
      for (int i = 0; i < 16; ++i) wv[i] = __builtin_nontemporal_load((const GAS f32x4*)(wp + (size_t)(8 * i) * NMOD)); }
#pragma unroll
    for (int b = 0; b < 8; ++b)
#pragma unroll
        for (int q = 0; q < 2; ++q) { const float cv = c_[b * D + d0 + 64 * q + F.lane]; scr[b * 128 + 64 * q + F.lane] = cv / (1.f + fexp(-cv)); }
    LDS_WAIT(); asm volatile("" ::: "memory");
    f32x4 acc[8];
#pragma unroll
    for (int b = 0; b < 8; ++b) acc[b] = (f32x4){0.f, 0.f, 0.f, 0.f};
#pragma unroll
    for (int i = 0; i < 16; ++i)
#pragma unroll
        for (int b = 0; b < 8; ++b) acc[b] += wv[i] * scr[b * 128 + 8 * i + rg];
#pragma unroll
    for (int b = 0; b < 8; ++b)
#pragma unroll
        for (int c = 0; c < 4; ++c) { float v = acc[b][c]; v += __shfl_xor(v, 8); v += __shfl_xor(v, 16); v += __shfl_xor(v, 32); acc[b][c] = v; }
    if (rg == 0) {
#pragma unroll
        for (int b = 0; b < 8; ++b) *(LAS f32x4*)(scr + 1024 + b * 32 + 4 * cl) = acc[b]; }
    __syncthreads();
    if (F.lane < 32) { const int j = item * 32 + F.lane;
        float tot = b_ada_[j];
#pragma unroll
        for (int w = 0; w < 8; ++w) tot += ((LAS float*)(F.lds + w * 16384))[1024 + F.wave * 32 + F.lane];
        mod_[F.wave * NMOD + j] = tot; }
    __syncthreads();
}
DI void p0_weff_item(const Frame& F, int item) {
    const float* const sub_keys_ = inp(I_SK); const float* const w_q_peer_ = inp(I_WQ); bf16* const Weff_t_ = WSP(bf16, WS_WEFF);
    const int hp = item >> 4, dblk = item & 15, dt = F.wave >> 2, nt = F.wave & 3, r = F.lane & 31, hi = F.lane >> 5;
    const float* ap = w_q_peer_ + (size_t)(64 * dblk + 32 * dt + r) * NSC + hp * 128 + 8 * hi;
    const float* bp = sub_keys_ + (size_t)hp * 16384 + (size_t)(32 * nt + r) * 128 + 8 * hi;
    f32x4 av[16], bv[16];
#pragma unroll
    for (int kk = 0; kk < 8; ++kk) { av[2 * kk] = *(const GAS f32x4*)(ap + 16 * kk); av[2 * kk + 1] = *(const GAS f32x4*)(ap + 16 * kk + 4); bv[2 * kk] = *(const GAS f32x4*)(bp + 16 * kk); bv[2 * kk + 1] = *(const GAS f32x4*)(bp + 16 * kk + 4); }
    f32x16 acc;
#pragma unroll
    for (int i = 0; i < 16; ++i) acc[i] = 0.f;
#define WEFF_SPLIT(V0, V1, HI, LO) do { v4u h_, l_; \
        h_.x = cvtpk(V0.x, V0.y); h_.y = cvtpk(V0.z, V0.w); h_.z = cvtpk(V1.x, V1.y); h_.w = cvtpk(V1.z, V1.w); \
        l_.x = cvtpk(V0.x - bflo(h_.x), V0.y - bfhi(h_.x)); l_.y = cvtpk(V0.z - bflo(h_.y), V0.w - bfhi(h_.y)); l_.z = cvtpk(V1.x - bflo(h_.z), V1.y - bfhi(h_.z)); l_.w = cvtpk(V1.z - bflo(h_.w), V1.w - bfhi(h_.w)); \
        HI = __builtin_bit_cast(bf16x8, h_); LO = __builtin_bit_cast(bf16x8, l_); } while (0)
#pragma unroll
    for (int kk = 0; kk < 8; ++kk) { bf16x8 ah, al, bh, bl; WEFF_SPLIT(av[2 * kk], av[2 * kk + 1], ah, al); WEFF_SPLIT(bv[2 * kk], bv[2 * kk + 1], bh, bl);
        acc = MFMA_BF16(al, bh, acc); acc = MFMA_BF16(ah, bl, acc); acc = MFMA_BF16(ah, bh, acc); __builtin_amdgcn_sched_barrier(0); }
#undef WEFF_SPLIT
    bf16* op = Weff_t_ + (size_t)(hp * 128 + 32 * nt + r) * D + 64 * dblk + 32 * dt + 4 * hi;
#pragma unroll
    for (int g = 0; g < 4; ++g) *(GAS unsigned long long*)(op + 8 * g) = (unsigned long long)pk2(acc[4 * g], acc[4 * g + 1]) | ((unsigned long long)pk2(acc[4 * g + 2], acc[4 * g + 3]) << 32);
}
struct ExpRows2 { f32x4 v[2][4]; };
DI void exp_load2(const Frame& F, int blk0, ExpRows2& R) {
    const float* const expert_u_ = inp(I_EU); const float* const expert_v_ = inp(I_EV);
#pragma unroll
    for (int bb = 0; bb < 2; ++bb) { const int blk = blk0 + bb; const float* src = (blk < 16384 ? expert_u_ : expert_v_) + (size_t)(blk & 16383) * 1024 + 4 * F.lane;
#pragma unroll
        for (int k = 0; k < 4; ++k) R.v[bb][k] = __builtin_nontemporal_load((const GAS f32x4*)(src + 256 * k)); }
}
DI void exp_conv2(const Frame& F, int blk0, const ExpRows2& R) {
    float* const SUI_ = WSP(float, WS_SUI);
#pragma unroll
    for (int bb = 0; bb < 2; ++bb) { const int blk = blk0 + bb; const bool isu = blk < 16384; const int e = blk & 16383;
        float mx = 0.f;
#pragma unroll
        for (int k = 0; k < 4; ++k) mx = fmaxf(mx, fmaxf(fmaxf(fabsf(R.v[bb][k].x), fabsf(R.v[bb][k].y)), fmaxf(fabsf(R.v[bb][k].z), fabsf(R.v[bb][k].w))));
        mx = wave_max_nonneg(mx);
        {
            const float s1_ = mx * (1.f / 7.f), s2_ = mx * (0.74f / 7.f), lim_ = 7.f * s2_;
            float ce_ = 0.f;
#pragma unroll
            for (int k = 0; k < 4; ++k)
#pragma unroll
                for (int c = 0; c < 4; ++c) { const float t_ = fmaxf(fabsf(R.v[bb][k][c]) - lim_, 0.f); ce_ += t_ * t_; }
            ce_ = wave_sum_u(ce_);
            const float bs = (ce_ < (1024.f / 12.f) * (s1_ * s1_ - s2_ * s2_)) ? s2_ : s1_;
            const float inv = bs > 0.f ? 1.f / bs : 0.f;
            unsigned w01[2] = {0u, 0u};
#pragma unroll
            for (int k = 0; k < 4; ++k)
#pragma unroll
                for (int c = 0; c < 4; ++c) { const int q = (int)fminf(fmaxf(rintf(R.v[bb][k][c] * inv), -7.f), 7.f); w01[k >> 1] |= (unsigned)((isu || (c & 1)) ? (q & 15) : (q + 8)) << (4 * (4 * (k & 1) + c)); }
            if (F.lane == 0) SUI_[2 * e + (isu ? 0 : 1)] = bs;
            typedef unsigned v2u_ __attribute__((ext_vector_type(2)));
            v2u_ wv; wv.x = w01[0]; wv.y = w01[1];
            *(GAS v2u_*)((isu ? WSP(unsigned char, WS_EXPU) : WSP(unsigned char, WS_EXPV)) + (size_t)e * 512 + 8 * F.lane) = wv;
        } }
}
#ifndef P0_PARTS
#define P0_PARTS 15
#endif
DI void p0_phase(const Frame& F, int parts = 15) {
    const float* const w_in_ = inp(I_WIN); bf16* const Win_t_ = WSP(bf16, WS_WIN); const float* const w_out_ = inp(I_WOUT); bf16* const Wout_t_ = WSP(bf16, WS_WOUT); const float* const expert_v_ = inp(I_EV); const float* const expert_u_ = inp(I_EU);
    LAS float* scr = (LAS float*)(F.lds + F.wave * 16384);
    const int gw = F.vcu * NWAVES + F.wave, NGW = F.G * NWAVES;
    if (parts & 1) for (int it = F.vcu; it < 192; it += F.G) p0_mod_block(F, it);
    constexpr int I_WIN = 16 * 112, I_WOUT = 16 * 32, NITEMS = I_WIN + I_WOUT;
    if (parts & 2) for (int it = gw; it < NITEMS; it += NGW) {
        int r = it;
        if (r < I_WIN) { p0_transpose_item(w_in_, D, NPROJ, NIN, Win_t_, scr, r, F.lane); continue; } r -= I_WIN;
        p0_transpose_item(w_out_, D, D, D, Wout_t_, scr, r, F.lane);
    }
    __syncthreads();
    if (parts & 8) for (int it = F.vcu; it < 256; it += F.G) p0_weff_item(F, it);
}

template <bool DOGATES, bool SRCB = false>
DI void norm_phase(const Frame& F, const float* src, const float* g, int shift_off, int scale_off) {
    const float* const w_in_ = inp(I_WIN); float* const mod_ = WSP(float, WS_MOD); bf16* const XN_ = WSP(bf16, WS_XN); float* const GATES_ = WSP(float, WS_GATES); const float* const b_igate_ = inp(I_BIG); const float* const b_fgate_ = inp(I_BFG);
    LAS float* W8 = (LAS float*)F.lds;
    if (DOGATES) {
        for (int i = 0; i < 16; ++i) { const int idx = F.tid + 512 * i; W8[idx] = w_in_[(size_t)(idx & 1023) * NIN + NPROJ + (idx >> 10)]; }
        __syncthreads();
    }
    const int gw = F.vcu * NWAVES + F.wave, NGW = F.G * NWAVES;
    for (int ch = gw; ch < T / 16; ch += NGW) {
        const int r0 = ch * 16, b = r0 / SEQ;
        f32x4 A[4], Bv[4];
#pragma unroll
        for (int j = 0; j < 4; ++j) { const int col = 4 * F.lane + 256 * j; const f32x4 gg = *(const f32x4*)(g + col), sc = *(const f32x4*)(mod_ + b * NMOD + scale_off + col);
            A[j] = gg * (sc + 1.0f); Bv[j] = *(const f32x4*)(mod_ + b * NMOD + shift_off + col); }
        f32x4 nx[4];
#define NORM_LOADROW(ROW) do { if (SRCB) { const GAS unsigned long long* xb_ = (const GAS unsigned long long*)((const bf16*)src + (size_t)(ROW) * D) + F.lane; \
              _Pragma("unroll") for (int j = 0; j < 4; ++j) { const unsigned long long w_ = __builtin_nontemporal_load(xb_ + 64 * j); const unsigned lo_ = (unsigned)w_, hi_ = (unsigned)(w_ >> 32); \
                  nx[j] = (f32x4){bflo(lo_), bfhi(lo_), bflo(hi_), bfhi(hi_)}; } } \
          else { const GAS f32x4* xr_ = (const GAS f32x4*)(src + (size_t)(ROW) * D) + F.lane; _Pragma("unroll") for (int j = 0; j < 4; ++j) nx[j] = __builtin_nontemporal_load(xr_ + 64 * j); } } while (0)
        NORM_LOADROW(r0);
        for (int rr = 0; rr < 16; ++rr) {
            const int row = r0 + rr;
            f32x4 v[4]; float s = 0.f;
#pragma unroll
            for (int j = 0; j < 4; ++j) { v[j] = nx[j]; s += (v[j].x * v[j].x + v[j].y * v[j].y) + (v[j].z * v[j].z + v[j].w * v[j].w); }
            if (rr + 1 < 16) NORM_LOADROW(row + 1);
            const float rstd = 1.f / sqrtf(wave_sum_u(s) * (1.f / D) + EPS);
#pragma unroll
            for (int j = 0; j < 4; ++j) v[j] = v[j] * rstd * A[j] + Bv[j];
            GAS unsigned long long* o8 = (GAS unsigned long long*)(XN_ + (size_t)row * D) + F.lane;
#pragma unroll
            for (int j = 0; j < 4; ++j) o8[64 * j] = (unsigned long long)pk2(v[j].x, v[j].y) | ((unsigned long long)pk2(v[j].z, v[j].w) << 32);
            if (SRCB) {
                float mx = 0.f;
#pragma unroll
                for (int j = 0; j < 4; ++j) mx = fmaxf(mx, fmaxf(fmaxf(fabsf(v[j].x), fabsf(v[j].y)), fmaxf(fabsf(v[j].z), fabsf(v[j].w))));
                mx = wave_max_nonneg(mx);
                const float sx = mx > 0.f ? 119.f / mx : 0.f;
                unsigned lo_[2] = {0u, 0u}, hi_[2] = {0u, 0u};
#pragma unroll
                for (int j = 0; j < 4; ++j)
#pragma unroll
                    for (int c = 0; c < 4; ++c) { const int t_ = (int)rintf(v[j][c] * sx) + 8; const int sh_ = 4 * (4 * (j & 1) + c);
                        lo_[j >> 1] |= (unsigned)(t_ & 15) << sh_; hi_[j >> 1] |= (unsigned)((t_ >> 4) & 15) << sh_; }
                typedef unsigned v2u_ __attribute__((ext_vector_type(2)));
                unsigned char* xq = WSP(unsigned char, WS_XQ) + (size_t)row * 1024 + 8 * F.lane;
                v2u_ hv, lv; hv.x = hi_[0]; hv.y = hi_[1]; lv.x = lo_[0] ^ 0x88888888u; lv.y = lo_[1] ^ 0x88888888u;
                *(GAS v2u_*)xq = hv; *(GAS v2u_*)(xq + 512) = lv;
                if (F.lane == 0) WSP(float, WS_XS)[row] = mx > 0.f ? mx / 119.f : 0.f;
            }
            if (DOGATES) {
                float res = 0.f;
#pragma unroll
                for (int hh = 0; hh < 8; ++hh) { float p = 0.f;
#pragma unroll
                    for (int j = 0; j < 4; ++j) { const f32x4 w = *(const LAS f32x4*)(W8 + hh * 1024 + 4 * F.lane + 256 * j); p += (v[j].x * w.x + v[j].y * w.y) + (v[j].z * w.z + v[j].w * w.w); }
                    p = wave_sum_u(p); if (F.lane == hh) res = p; }
                if (F.lane < 8) GATES_[(size_t)row * 8 + F.lane] = res + (F.lane < 4 ? b_igate_[F.lane] : b_fgate_[F.lane - 4]);
            }
        }
    }
}

#ifndef SB_EXIT_LOG2
#define SB_EXIT_LOG2 (-64.f)
#endif
DI void sb_unit(const Frame& F, int b, int h, int qb) {
    bf16* const PROJ_ = WSP(bf16, WS_PROJ); const float* const g_q_sb_ = inp(I_GQ); const float* const g_k_sb_ = inp(I_GK); bf16* const MIX_ = WSP(bf16, WS_MIX); const float* const g_out_sb_ = inp(I_GOSB);
    const int lane = F.lane, w = F.wave, r = lane & 31, hi = lane >> 5;
    const int i16 = lane & 15, qq = i16 >> 2, pp = i16 & 3, blk = (lane >> 4) & 1;
    LAS unsigned char* Wb = F.lds + w * 16384;
    const size_t rowbase = (size_t)b * SEQ; const int q0 = qb * 256, qw0 = q0 + 32 * w, tq = qw0 + r;
    const bf16* P = PROJ_;
    const bf16* kpiece[4]; const bf16* vpiece[4];
#pragma unroll
    for (int i = 0; i < 4; ++i) { const int krow_ = 8 * i + (lane >> 3), kch = (lane & 7) ^ ((krow_ >> 1) & 7); kpiece[i] = P + (rowbase + krow_) * NPROJ + C_KSB + h * 64 + 8 * kch;
        const int vkey = 16 * (i & 1) + (lane >> 2); vpiece[i] = P + (rowbase + vkey) * NPROJ + C_VSB + h * 64 + 32 * (i >> 1) + 8 * (lane & 3); }
#define SB_DMA(T_, BUF_) do { _Pragma("unroll") for (int i_ = 0; i_ < 4; ++i_) { \
        __builtin_amdgcn_global_load_lds((const unsigned*)(kpiece[i_] + (size_t)(32 * (T_)) * NPROJ), (LAS unsigned*)(Wb + 8192 * (BUF_) + 1024 * i_), 16, 0, 0); \
        __builtin_amdgcn_global_load_lds((const unsigned*)(vpiece[i_] + (size_t)(32 * (T_)) * NPROJ), (LAS unsigned*)(Wb + 8192 * (BUF_) + 4096 + 1024 * i_), 16, 0, 0); } } while (0)
    const int tw = (qw0 + 30) >> 5;
    SB_DMA(tw, 0);
    bf16x8 qf[4];
    {
        const bf16* Qp = P + (rowbase + tq) * NPROJ + C_QSB + h * 64 + 8 * hi;
        v4u qraw[4]; float ss = 0.f;
#pragma unroll
        for (int kk = 0; kk < 4; ++kk) { qraw[kk] = *(const GAS v4u*)(Qp + 16 * kk);
#pragma unroll
            for (int e = 0; e < 4; ++e) { const float a = bflo(qraw[kk][e]), c = bfhi(qraw[kk][e]); ss += a * a + c * c; } }
        ss = swap_add(ss);
        const float rq = __builtin_amdgcn_rsqf(ss * (1.f / 64.f) + EPS) * (0.125f * LOG2E);
#pragma unroll
        for (int kk = 0; kk < 4; ++kk) { const int d0 = 16 * kk + 8 * hi;
            const f32x4 g0 = *(const f32x4*)(g_q_sb_ + d0) * *(const f32x4*)(g_k_sb_ + d0), g1 = *(const f32x4*)(g_q_sb_ + d0 + 4) * *(const f32x4*)(g_k_sb_ + d0 + 4);
            v4u o; o.x = cvtpk(bflo(qraw[kk].x) * rq * g0.x, bfhi(qraw[kk].x) * rq * g0.y); o.y = cvtpk(bflo(qraw[kk].y) * rq * g0.z, bfhi(qraw[kk].y) * rq * g0.w);
            o.z = cvtpk(bflo(qraw[kk].z) * rq * g1.x, bfhi(qraw[kk].z) * rq * g1.y); o.w = cvtpk(bflo(qraw[kk].w) * rq * g1.z, bfhi(qraw[kk].w) * rq * g1.w);
            qf[kk] = __builtin_bit_cast(bf16x8, o); }
    }
    f16x8 U0, U1, E0;
#pragma unroll
    for (int j = 0; j < 8; ++j) { U0[j] = (krow(0, hi, j) > r) ? (_Float16)1.0f : (_Float16)0.0f; U1[j] = (krow(1, hi, j) > r) ? (_Float16)1.0f : (_Float16)0.0f;
        E0[j] = (j == 0 && hi == 0) ? (_Float16)1.0f : (_Float16)0.0f; }
    f32x16 o0, o1;
#pragma unroll
    for (int i = 0; i < 16; ++i) { o0[i] = 0.f; o1[i] = 0.f; }
    float R = 0.f;
    const int kfoff = r * 128, kfsw = (r >> 1) & 7;
    for (int t = tw; t >= 0; --t) {
        const int buf = (tw - t) & 1;
        LAS unsigned char* Kb = Wb + 8192 * buf; LAS unsigned char* Vb = Kb + 4096;
        asm volatile("s_waitcnt vmcnt(0)" ::: "memory");
        if (t > 0) SB_DMA(t - 1, buf ^ 1);
        bf16x8 kf[4]; float ssk = 0.f;
#pragma unroll
        for (int kk = 0; kk < 4; ++kk) { const v4u kv = *(const LAS v4u*)(Kb + kfoff + (((2 * kk + hi) ^ kfsw) * 16)); kf[kk] = __builtin_bit_cast(bf16x8, kv);
            ssk = dot2bf(kv.x, kv.x, ssk); ssk = dot2bf(kv.y, kv.y, ssk); ssk = dot2bf(kv.z, kv.z, ssk); ssk = dot2bf(kv.w, kv.w, ssk); }
        ssk = swap_add(ssk);
        const float rk = __builtin_amdgcn_rsqf(ssk * (1.f / 64.f) + EPS);
        f16x8 RKA;
#pragma unroll
        for (int e = 0; e < 8; ++e) RKA[e] = (_Float16)0.0f;
        RKA[0] = (hi == 0) ? (_Float16)rk : (_Float16)0.0f;
        f32x16 s, rkd;
#pragma unroll
        for (int i = 0; i < 16; ++i) { s[i] = 0.f; rkd[i] = 0.f; }
        rkd = MFMA_F16(RKA, E0, rkd);
#pragma unroll
        for (int kk = 0; kk < 4; ++kk) s = MFMA_BF16(kf[kk], qf[kk], s);
        float tsum = 0.f; unsigned lp[8];
        if (32 * t + 31 < qw0) {
#pragma unroll
            for (int i = 0; i < 16; i += 2) {
                const float z0_ = s[i] * rkd[i], z1_ = s[i + 1] * rkd[i + 1];
                const float a0_ = -lg2(1.f + ex2(z0_)), a1_ = -lg2(1.f + ex2(z1_));
                tsum += a0_ + a1_;
                s[i] = z0_ + a0_; s[i + 1] = z1_ + a1_;
                lp[i >> 1] = pkh(a0_, a1_); }
        } else {
            const int kq = tq - 32 * t;
#pragma unroll
            for (int i = 0; i < 16; i += 2) {
                const float z0_ = s[i] * rkd[i], z1_ = s[i + 1] * rkd[i + 1];
                float a0_ = -lg2(1.f + ex2(z0_)), a1_ = -lg2(1.f + ex2(z1_));
                const bool ma0 = crow(i, hi) >= kq, ma1 = crow(i + 1, hi) >= kq;
                a0_ = ma0 ? 0.f : a0_; a1_ = ma1 ? 0.f : a1_;
                tsum += a0_ + a1_;
                s[i] = ma0 ? -INFINITY : z0_ + a0_; s[i + 1] = ma1 ? -INFINITY : z1_ + a1_;
                lp[i >> 1] = pkh(a0_, a1_); }
        }
        f32x16 c;
#pragma unroll
        for (int i = 0; i < 16; ++i) c[i] = R;
        c = MFMA_F16(U0, __builtin_bit_cast(f16x8, (v4u){lp[0], lp[1], lp[2], lp[3]}), c); c = MFMA_F16(U1, __builtin_bit_cast(f16x8, (v4u){lp[4], lp[5], lp[6], lp[7]}), c);
#pragma unroll
        for (int i = 0; i < 16; ++i) s[i] = ex2(s[i] + c[i]);
        const bf16x8 W0 = packbf(s, 0), W1 = packbf(s, 1);
        LAS unsigned char* vb_ = Vb + (4 * hi + qq) * 64 + 32 * blk + 8 * pp;
        o0 = MFMA_BF16(cat8(trrd(vb_), trrd(vb_ + 8 * 64)), W0, o0); o0 = MFMA_BF16(cat8(trrd(vb_ + 16 * 64), trrd(vb_ + 24 * 64)), W1, o0);
        o1 = MFMA_BF16(cat8(trrd(vb_ + 2048), trrd(vb_ + 2048 + 8 * 64)), W0, o1); o1 = MFMA_BF16(cat8(trrd(vb_ + 2048 + 16 * 64), trrd(vb_ + 2048 + 24 * 64)), W1, o1);
        R += swap_add(tsum);
        if (__all(R < SB_EXIT_LOG2)) break;
    }
    asm volatile("s_waitcnt vmcnt(0)" ::: "memory");
#undef SB_DMA
    {
        float ss = 0.f;
#pragma unroll
        for (int i = 0; i < 16; ++i) ss += o0[i] * o0[i] + o1[i] * o1[i];
        ss = swap_add(ss);
        const float ro = __builtin_amdgcn_rsqf(ss * (1.f / 64.f) + EPS);
        bf16* Op = MIX_ + (rowbase + tq) * D + h * 64;
        const float* go = g_out_sb_ + h * 64;
#pragma unroll
        for (int g = 0; g < 4; ++g) { const int d0 = 8 * g + 4 * hi; const f32x4 ga = *(const f32x4*)(go + d0), gb = *(const f32x4*)(go + 32 + d0);
            u32x2 wa, wb; wa.x = cvtpk(o0[4 * g] * ro * ga.x, o0[4 * g + 1] * ro * ga.y); wa.y = cvtpk(o0[4 * g + 2] * ro * ga.z, o0[4 * g + 3] * ro * ga.w);
            wb.x = cvtpk(o1[4 * g] * ro * gb.x, o1[4 * g + 1] * ro * gb.y); wb.y = cvtpk(o1[4 * g + 2] * ro * gb.z, o1[4 * g + 3] * ro * gb.w);
            *(GAS u32x2*)(Op + d0) = wa; *(GAS u32x2*)(Op + 32 + d0) = wb; }
    }
    __syncthreads();
}

DI void conv_silu8(const v4u (&xr)[4], const float (&cw)[4][8], float scale, float (&y)[8]) {
#pragma unroll
    for (int e = 0; e < 8; ++e) y[e] = 0.f;
#pragma unroll
    for (int j = 0; j < 4; ++j) {
        y[0] += cw[j][0] * bflo(xr[j].x); y[1] += cw[j][1] * bfhi(xr[j].x); y[2] += cw[j][2] * bflo(xr[j].y); y[3] += cw[j][3] * bfhi(xr[j].y);
        y[4] += cw[j][4] * bflo(xr[j].z); y[5] += cw[j][5] * bfhi(xr[j].z); y[6] += cw[j][6] * bflo(xr[j].w); y[7] += cw[j][7] * bfhi(xr[j].w); }
#pragma unroll
    for (int e = 0; e < 8; ++e) y[e] = scale * y[e] * __builtin_amdgcn_rcpf(1.f + fexp(-y[e]));
}
DI float log_sigmoid(float x) { return fminf(x, 0.f) - 0.6931471805599453f * lg2(1.f + fexp(-fabsf(x))); }
DI float wave_scan_incl(float a, int lane) {
#pragma unroll
    for (int o = 1; o < 64; o <<= 1) { const float t = __shfl_up(a, o); if (lane >= o) a += t; }
    return a;
}

constexpr int LDS_CW = 65536;
DI void stage_conv_w(const Frame& F) {
    const float* const conv_w_ = inp(I_CONVW); LAS float* cwl = (LAS float*)(F.lds + LDS_CW);
    for (int i = F.tid; i < 4096; i += NTHR) cwl[i] = conv_w_[i];
    __syncthreads();
}
DI void load_cw8(const Frame& F, int colbase, float (&cw)[4][8]) {
    const LAS float* cwl = (const LAS float*)(F.lds + LDS_CW);
#pragma unroll
    for (int j = 0; j < 4; ++j) { const f32x4 a = *(const LAS f32x4*)(cwl + j * 1024 + colbase), b = *(const LAS f32x4*)(cwl + j * 1024 + colbase + 4);
        cw[j][0] = a.x; cw[j][1] = a.y; cw[j][2] = a.z; cw[j][3] = a.w; cw[j][4] = b.x; cw[j][5] = b.y; cw[j][6] = b.z; cw[j][7] = b.w; }
}
struct MlLocalRegs { v4u kraw[2][4]; v4u vraw[2]; float gi, gf; };
DI void ml_local_load(const Frame& F, int chain, int c, MlLocalRegs& R) {
    bf16* const PROJ_ = WSP(bf16, WS_PROJ); float* const GATES_ = WSP(float, WS_GATES);
    const int tid = F.tid, lane = F.lane;
    const int b = chain >> 2, hh = chain & 3; const size_t rowbase = (size_t)b * SEQ; const int t0 = c * 64;
    const bf16* P = PROJ_;
    const int kc = tid & 15, kr0 = tid >> 4;
    const bf16* Kg = P + rowbase * NPROJ + C_KML + hh * 128 + kc * 8;
#pragma unroll
    for (int i = 0; i < 2; ++i)
#pragma unroll
        for (int j = 0; j < 4; ++j) { const int tt = t0 + kr0 + 32 * i - 3 + j; const v4u kv_ = *(const GAS v4u*)(Kg + (size_t)(tt < 0 ? 0 : tt) * NPROJ);
            R.kraw[i][j] = (tt >= 0) ? kv_ : (v4u){0u, 0u, 0u, 0u}; }
#pragma unroll
    for (int i = 0; i < 2; ++i) R.vraw[i] = *(const GAS v4u*)(P + (rowbase + t0 + kr0 + 32 * i) * NPROJ + C_VML + hh * 128 + kc * 8);
    const float* Gg = GATES_ + (rowbase + t0 + lane) * 8;
    R.gi = Gg[hh]; R.gf = Gg[4 + hh];
}
DI void ml_local_unit(const Frame& F, int chain, int c, const MlLocalRegs& RG) {
    bf16* const CST_ = WSP(bf16, WS_CST); float* const NST_ = WSP(float, WS_NST); float* const SCL_ = WSP(float, WS_SCL);
    LAS unsigned char* L = F.lds;
    LAS float* Lws = (LAS float*)(L + 32768);
    const int tid = F.tid, lane = F.lane, w = F.wave, r = lane & 31, hi = lane >> 5;
    const int i16 = lane & 15, qq = i16 >> 2, pp = i16 & 3, blk = (lane >> 4) & 1;
    const int hh = chain & 3;
    const int kbk = w & 3, vb0 = 2 * (w >> 2);
    const int kc = tid & 15, kr0 = tid >> 4;
    v4u kraw[2][4], vraw[2];
#pragma unroll
    for (int i = 0; i < 2; ++i) { vraw[i] = RG.vraw[i];
#pragma unroll
        for (int j = 0; j < 4; ++j) kraw[i][j] = RG.kraw[i][j]; }
    const float gi = RG.gi, gf = RG.gf;
    const float a = wave_scan_incl(log_sigmoid(gf), lane);
    const float a_end = __shfl(a, 63);
    const float lw = a_end - a + gi;
    const float m_loc = wave_max(lw);
    const float ws = fexp(lw - m_loc);
    if (w == 0) Lws[lane] = ws;
    {
        float cw[4][8]; load_cw8(F, 512 + hh * 128 + kc * 8, cw);
#pragma unroll
        for (int i = 0; i < 2; ++i) { float y[8]; conv_silu8(kraw[i], cw, 0.08838834764831845f, y);
            v4u o; o.x = cvtpk(y[0], y[1]); o.y = cvtpk(y[2], y[3]); o.z = cvtpk(y[4], y[5]); o.w = cvtpk(y[6], y[7]);
            *(LAS v4u*)(L + (kc >> 2) * 4096 + (kr0 + 32 * i) * 64 + (kc & 3) * 16) = o; }
#pragma unroll
        for (int i = 0; i < 2; ++i) { const int row = kr0 + 32 * i; const float wsr = __shfl(ws, row);
            v4u o; o.x = cvtpk(bflo(vraw[i].x) * wsr, bfhi(vraw[i].x) * wsr); o.y = cvtpk(bflo(vraw[i].y) * wsr, bfhi(vraw[i].y) * wsr); o.z = cvtpk(bflo(vraw[i].z) * wsr, bfhi(vraw[i].z) * wsr); o.w = cvtpk(bflo(vraw[i].w) * wsr, bfhi(vraw[i].w) * wsr);
            *(LAS v4u*)(L + 16384 + (kc >> 2) * 4096 + row * 64 + (kc & 3) * 16) = o; }
    }
    __syncthreads();
    f32x16 acc0, acc1;
#pragma unroll
    for (int i = 0; i < 16; ++i) { acc0[i] = 0.f; acc1[i] = 0.f; }
#pragma unroll
    for (int kk = 0; kk < 4; ++kk) { const int rows = 16 * kk + 8 * hi + qq;
        LAS unsigned char* ka = L + kbk * 4096 + rows * 64 + 32 * blk + 8 * pp; LAS unsigned char* va = L + 16384 + vb0 * 4096 + rows * 64 + 32 * blk + 8 * pp;
        const bf16x8 A = cat8(trrd(ka), trrd(ka + 4 * 64));
        acc0 = MFMA_BF16(A, cat8(trrd(va), trrd(va + 4 * 64)), acc0); acc1 = MFMA_BF16(A, cat8(trrd(va + 4096), trrd(va + 4096 + 4 * 64)), acc1); }
    {
        bf16* Cp = CST_ + ((size_t)(chain * 64 + c) * 128 + vb0 * 32 + r) * 128 + kbk * 32 + 4 * hi;
#pragma unroll
        for (int g = 0; g < 4; ++g) { u32x2 o; o.x = cvtpk(acc0[4 * g], acc0[4 * g + 1]); o.y = cvtpk(acc0[4 * g + 2], acc0[4 * g + 3]); *(GAS u32x2*)(Cp + 8 * g) = o;
            u32x2 o1; o1.x = cvtpk(acc1[4 * g], acc1[4 * g + 1]); o1.y = cvtpk(acc1[4 * g + 2], acc1[4 * g + 3]); *(GAS u32x2*)(Cp + 32 * 128 + 8 * g) = o1; }
    }
    {
        const int k = 16 * w + (lane & 15), sq = lane >> 4; float part = 0.f;
        const LAS unsigned short* kcol = (const LAS unsigned short*)(L + (k >> 5) * 4096 + (k & 31) * 2);
#pragma unroll
        for (int e = 0; e < 16; ++e) part += Lws[16 * sq + e] * __uint_as_float((unsigned)kcol[(16 * sq + e) * 32] << 16);
        part += __shfl_xor(part, 16); part += __shfl_xor(part, 32);
        if (lane < 16) NST_[(size_t)(chain * 64 + c) * 128 + k] = part;
        if (tid == 0) { SCL_[(chain * 64 + c) * 2] = a_end; SCL_[(chain * 64 + c) * 2 + 1] = m_loc; }
    }
    __syncthreads();
}
DI void ml_scan_phase(const Frame& F) {
    bf16* const CST_ = WSP(bf16, WS_CST); float* const NST_ = WSP(float, WS_NST); float* const SCL_ = WSP(float, WS_SCL); float* const MST_ = WSP(float, WS_MST);
    for (int gt = F.vcu * NTHR + F.tid; gt < 32 * 4096; gt += F.G * NTHR) {
        const int chain = gt >> 12, rem = gt & 4095;
        const float ae_l = SCL_[(chain * 64 + F.lane) * 2], ml_l = SCL_[(chain * 64 + F.lane) * 2 + 1];
        u32x2* Cp = (u32x2*)(CST_ + (size_t)chain * 64 * 16384 + (size_t)rem * 4);
        f32x4* Np = (f32x4*)(NST_ + (size_t)chain * 64 * 128 + rem * 4);
        u32x2* NBp = (u32x2*)(WSP(bf16, WS_NSTB) + (size_t)chain * 64 * 128 + rem * 4);
        const bool do_n = rem < 32;
        float c0 = 0.f, c1 = 0.f, c2 = 0.f, c3 = 0.f; f32x4 nn = {0.f, 0.f, 0.f, 0.f}; float m = 0.f;
        u32x2 dr[8]; f32x4 nr[8];
#pragma unroll
        for (int i = 0; i < 8; ++i) { dr[i] = Cp[(size_t)i * 4096]; if (do_n) nr[i] = Np[i * 32]; }
        for (int c0_ = 0; c0_ < 64; c0_ += 8) {
#pragma unroll
            for (int i = 0; i < 8; ++i) { const int c = c0_ + i;
                if (c < 63) {
                    const u32x2 dcur = dr[i]; const f32x4 dn = nr[i];
                    if (c + 8 < 63) { dr[i] = Cp[(size_t)(c + 8) * 4096]; if (do_n) nr[i] = Np[(c + 8) * 32]; }
                    const float ae = __builtin_bit_cast(float, __builtin_amdgcn_readlane(__builtin_bit_cast(int, ae_l), c)), ml = __builtin_bit_cast(float, __builtin_amdgcn_readlane(__builtin_bit_cast(int, ml_l), c));
                    const float mn = fmaxf(ae + m, ml), d1 = fexp(ae + m - mn), d2 = fexp(ml - mn);
                    c0 = d1 * c0 + d2 * bflo(dcur.x); c1 = d1 * c1 + d2 * bfhi(dcur.x); c2 = d1 * c2 + d2 * bflo(dcur.y); c3 = d1 * c3 + d2 * bfhi(dcur.y);
                    u32x2 o; o.x = cvtpk(c0, c1); o.y = cvtpk(c2, c3); Cp[(size_t)c * 4096] = o;
                    if (do_n) { nn = nn * d1 + dn * d2; Np[c * 32] = nn; u32x2 nb_; nb_.x = cvtpk(nn.x, nn.y); nb_.y = cvtpk(nn.z, nn.w); NBp[c * 32] = nb_; }
                    if (rem == 0) MST_[chain * 64 + c] = mn;
                    m = mn; } }
        }
    }
}
DI void ml_out_unit(const Frame& F, int chain, int c, int nchain = -1, int nc = 0) {
    bf16* const PROJ_ = WSP(bf16, WS_PROJ); float* const GATES_ = WSP(float, WS_GATES); float* const MST_ = WSP(float, WS_MST); bf16* const CST_ = WSP(bf16, WS_CST); float* const NST_ = WSP(float, WS_NST); bf16* const MIX_ = WSP(bf16, WS_MIX); const float* const g_out_ml_ = inp(I_GOML);
    LAS unsigned char* L = F.lds;
    LAS float* Lbs = (LAS float*)(L + 49152); LAS float* Lav = (LAS float*)(L + 49408); LAS float* Lex = (LAS float*)(L + 49664);
    const int tid = F.tid, lane = F.lane, w = F.wave, r = lane & 31, hi = lane >> 5;
    const int i16 = lane & 15, qq = i16 >> 2, pp = i16 & 3, blk = (lane >> 4) & 1;
    const int b = chain >> 2, hh = chain & 3; const size_t rowbase = (size_t)b * SEQ; const int t0 = c * 64;
    const int tb = w >> 2, vb = w & 3;
    const bf16* P = PROJ_;
    {
        const int kc = tid & 15, kr0 = tid >> 4;
        v4u vraw[2];
#pragma unroll
        for (int i = 0; i < 2; ++i) vraw[i] = *(const GAS v4u*)(P + (rowbase + t0 + kr0 + 32 * i) * NPROJ + C_VML + hh * 128 + kc * 8);
        v4u xr[2][2][4];
#pragma unroll
        for (int which = 0; which < 2; ++which) { const bf16* Xg = P + rowbase * NPROJ + C_QML + (which ? 512 : 0) + hh * 128 + kc * 8;
#pragma unroll
            for (int i = 0; i < 2; ++i)
#pragma unroll
                for (int j = 0; j < 4; ++j) { const int tt = t0 + kr0 + 32 * i - 3 + j; xr[which][i][j] = (tt >= 0) ? *(const GAS v4u*)(Xg + (size_t)tt * NPROJ) : (v4u){0u, 0u, 0u, 0u}; } }
#pragma unroll
        for (int which = 0; which < 2; ++which) {
            const int colbase = (which ? 512 : 0) + hh * 128 + kc * 8;
            float cw[4][8]; load_cw8(F, colbase, cw);
#pragma unroll
            for (int i = 0; i < 2; ++i) { const int row = kr0 + 32 * i;
                float y[8]; conv_silu8(xr[which][i], cw, which ? 0.08838834764831845f : 1.0f, y);
                v4u o; o.x = cvtpk(y[0], y[1]); o.y = cvtpk(y[2], y[3]); o.z = cvtpk(y[4], y[5]); o.w = cvtpk(y[6], y[7]);
                *(LAS v4u*)(L + which * 16384 + row * 256 + ((kc ^ (row & 15)) * 16)) = o; }
        }
#pragma unroll
        for (int i = 0; i < 2; ++i) { const int row = kr0 + 32 * i;
            *(LAS v4u*)(L + 32768 + (kc >> 2) * 4096 + row * 64 + (kc & 3) * 16) = vraw[i]; }
        if (w == 0) { const float* Gg = GATES_ + (rowbase + t0 + lane) * 8; const float a = wave_scan_incl(log_sigmoid(Gg[4 + hh]), lane); Lav[lane] = a; Lbs[lane] = Gg[hh] - a; }
    }
    const float mprev = (c > 0) ? MST_[chain * 64 + c - 1] : 0.f;
    bf16x8 cf[8], nf[8];
    if (c > 0) {
        const bf16* Cp = CST_ + ((size_t)(chain * 64 + c - 1) * 128 + vb * 32 + r) * 128 + 8 * hi;
        const bf16* NBq = WSP(bf16, WS_NSTB) + (size_t)(chain * 64 + c - 1) * 128 + 8 * hi;
        const bool nrow = (r == 0) || (r == 4);
#pragma unroll
        for (int kk = 0; kk < 8; ++kk) { cf[kk] = *(const GAS bf16x8*)(Cp + 16 * kk);
            v4u o = {0u, 0u, 0u, 0u};
            if (nrow) o = *(const GAS v4u*)(NBq + 16 * kk);
            nf[kk] = __builtin_bit_cast(bf16x8, o); }
    }
    unsigned tch0 = 0u, tch1 = 0u;
    if (nchain >= 0) {
        const unsigned nhh = (unsigned)nchain & 3u, nrow0 = (unsigned)(nchain >> 2) * SEQ + (unsigned)nc * 64u, cst = (unsigned)(nchain * 64 + nc - 1);
        const unsigned rr = (unsigned)tid >> 2, part = (unsigned)tid & 3u;
        unsigned o0 = (unsigned)WS_PROJ + ((nrow0 - 3u + rr) * NPROJ + C_QML + (part >> 1) * 512u + nhh * 128u + (part & 1u) * 64u) * 2u; bool v0 = (nc > 0) || (rr >= 3u);
        if (tid >= 268) { o0 = (unsigned)WS_CST + cst * 32768u + (unsigned)(tid - 268) * 128u; v0 = nc > 0; }
        unsigned o1 = (unsigned)WS_PROJ + ((nrow0 + rr) * NPROJ + ((part >> 1) ? C_OML : C_VML) + nhh * 128u + (part & 1u) * 64u) * 2u; bool v1 = true;
        if (tid >= 256) { o1 = (unsigned)WS_CST + cst * 32768u + (unsigned)(244 + tid - 256) * 128u; v1 = nc > 0; }
        if (tid >= 268) { o1 = (unsigned)WS_NSTB + cst * 256u + (unsigned)((tid - 268) & 1) * 128u; }
        if (tid >= 272) { o1 = (unsigned)WS_GATES + nrow0 * 32u + (unsigned)(tid - 272) * 128u; v1 = tid < 288; }
        const GAS unsigned char* wsb = (const GAS unsigned char*)F.ws;
        if (v0) tch0 = *(const GAS unsigned*)(wsb + o0);
        if (v1) tch1 = *(const GAS unsigned*)(wsb + o1);
    }
    __syncthreads();
    bf16x8 qf[8];
    f32x16 s0, s1;
#pragma unroll
    for (int i = 0; i < 16; ++i) { s0[i] = 0.f; s1[i] = 0.f; }
#pragma unroll
    for (int kk = 0; kk < 8; ++kk) { const int ch = 2 * kk + hi; const int rq_ = 32 * tb + r;
        qf[kk] = *(const LAS bf16x8*)(L + rq_ * 256 + ((ch ^ (rq_ & 15)) * 16));
        const bf16x8 a0 = *(const LAS bf16x8*)(L + 16384 + r * 256 + ((ch ^ (r & 15)) * 16));
        const bf16x8 a1 = *(const LAS bf16x8*)(L + 16384 + (32 + r) * 256 + ((ch ^ ((32 + r) & 15)) * 16));
        s0 = MFMA_BF16(a0, qf[kk], s0); s1 = MFMA_BF16(a1, qf[kk], s1); }
    const int tl = 32 * tb + r; const float a_t = Lav[tl];
    f32x16 d0, d1; float mrow = -INFINITY;
#pragma unroll
    for (int g = 0; g < 4; ++g) { const f32x4 b0 = *(const LAS f32x4*)(Lbs + 8 * g + 4 * hi), b1 = *(const LAS f32x4*)(Lbs + 32 + 8 * g + 4 * hi);
#pragma unroll
        for (int e = 0; e < 4; ++e) { const int sl = 8 * g + 4 * hi + e;
            d0[4 * g + e] = (sl <= tl) ? a_t + b0[e] : -INFINITY; d1[4 * g + e] = (32 + sl <= tl) ? a_t + b1[e] : -INFINITY;
            mrow = fmaxf(mrow, fmaxf(d0[4 * g + e], d1[4 * g + e])); } }
    mrow = fmaxf(swap_max(mrow), a_t + mprev);
    float psum = 0.f;
#pragma unroll
    for (int i = 0; i < 16; ++i) { s0[i] *= fexp(d0[i] - mrow); s1[i] *= fexp(d1[i] - mrow); psum += s0[i] + s1[i]; }
    const float w_inter = fexp(a_t + mprev - mrow);
    float den = swap_add(psum);
    const bf16x8 P00 = packbf(s0, 0), P01 = packbf(s0, 1), P10 = packbf(s1, 0), P11 = packbf(s1, 1);
    u32x2 ogv[4];
    { const bf16* Og0 = P + (rowbase + t0 + 32 * tb + r) * NPROJ + C_OML + hh * 128 + vb * 32 + 4 * hi;
#pragma unroll
      for (int g = 0; g < 4; ++g) ogv[g] = *(const GAS u32x2*)(Og0 + 8 * g); }
    f32x16 num;
#pragma unroll
    for (int i = 0; i < 16; ++i) num[i] = 0.f;
    {
        LAS unsigned char* vb_ = L + 32768 + vb * 4096 + (4 * hi + qq) * 64 + 32 * blk + 8 * pp;
        num = MFMA_BF16(cat8(trrd(vb_), trrd(vb_ + 8 * 64)), P00, num); num = MFMA_BF16(cat8(trrd(vb_ + 16 * 64), trrd(vb_ + 24 * 64)), P01, num);
        num = MFMA_BF16(cat8(trrd(vb_ + 32 * 64), trrd(vb_ + 40 * 64)), P10, num); num = MFMA_BF16(cat8(trrd(vb_ + 48 * 64), trrd(vb_ + 56 * 64)), P11, num);
    }
    if (c > 0) {
        f32x16 it, dn;
#pragma unroll
        for (int i = 0; i < 16; ++i) { it[i] = 0.f; dn[i] = 0.f; }
#pragma unroll
        for (int kk = 0; kk < 8; ++kk) { it = MFMA_BF16(cf[kk], qf[kk], it); dn = MFMA_BF16(nf[kk], qf[kk], dn); }
#pragma unroll
        for (int i = 0; i < 16; ++i) num[i] += w_inter * it[i];
        den += w_inter * dn[0];
    }
    const float inv = __builtin_amdgcn_rcpf(fmaxf(fabsf(den), fexp(-mrow)));
    float ss = 0.f;
#pragma unroll
    for (int i = 0; i < 16; ++i) { num[i] *= inv; ss += num[i] * num[i]; }
    ss = swap_add(ss);
    if (lane < 32) Lex[(tb * 4 + vb) * 32 + r] = ss;
    __syncthreads();
    const float tot = (Lex[(tb * 4 + 0) * 32 + r] + Lex[(tb * 4 + 1) * 32 + r]) + (Lex[(tb * 4 + 2) * 32 + r] + Lex[(tb * 4 + 3) * 32 + r]);
    const float rstd = 1.f / sqrtf(tot * (1.f / 128.f) + EPS);
    {
        const size_t trow = rowbase + t0 + tl;
        bf16* Mp = MIX_ + trow * D + 512 + hh * 128 + vb * 32 + 4 * hi;
        const float* go = g_out_ml_ + hh * 128 + vb * 32 + 4 * hi;
#pragma unroll
        for (int g = 0; g < 4; ++g) { const u32x2 og = ogv[g]; const f32x4 gg = *(const f32x4*)(go + 8 * g);
            const float o0 = bflo(og.x), o1 = bfhi(og.x), o2 = bflo(og.y), o3 = bfhi(og.y);
            u32x2 o; o.x = cvtpk(num[4 * g] * rstd * gg.x * __builtin_amdgcn_rcpf(1.f + fexp(-o0)), num[4 * g + 1] * rstd * gg.y * __builtin_amdgcn_rcpf(1.f + fexp(-o1)));
            o.y = cvtpk(num[4 * g + 2] * rstd * gg.z * __builtin_amdgcn_rcpf(1.f + fexp(-o2)), num[4 * g + 3] * rstd * gg.w * __builtin_amdgcn_rcpf(1.f + fexp(-o3)));
            *(GAS u32x2*)(Mp + 8 * g) = o; }
    }
    asm volatile("" :: "v"(tch0), "v"(tch1));
    __syncthreads();
}

#define TK_CE(A, B) do { const float hi_ = fmaxf((A), (B)), lo_ = fminf((A), (B)); (A) = hi_; (B) = lo_; } while (0)
DI void tk_sort16(float (&a)[16]) {
    TK_CE(a[0], a[1]); TK_CE(a[2], a[3]); TK_CE(a[0], a[2]); TK_CE(a[1], a[3]); TK_CE(a[1], a[2]); TK_CE(a[4], a[5]); TK_CE(a[6], a[7]); TK_CE(a[4], a[6]); TK_CE(a[5], a[7]); TK_CE(a[5], a[6]); TK_CE(a[0], a[4]); TK_CE(a[2], a[6]); TK_CE(a[2], a[4]); TK_CE(a[1], a[5]); TK_CE(a[3], a[7]); TK_CE(a[3], a[5]); TK_CE(a[1], a[2]); TK_CE(a[3], a[4]); TK_CE(a[5], a[6]); TK_CE(a[8], a[9]); TK_CE(a[10], a[11]); TK_CE(a[8], a[10]); TK_CE(a[9], a[11]); TK_CE(a[9], a[10]); TK_CE(a[12], a[13]); TK_CE(a[14], a[15]); TK_CE(a[12], a[14]); TK_CE(a[13], a[15]); TK_CE(a[13], a[14]); TK_CE(a[8], a[12]); TK_CE(a[10], a[14]); TK_CE(a[10], a[12]); TK_CE(a[9], a[13]); TK_CE(a[11], a[15]); TK_CE(a[11], a[13]); TK_CE(a[9], a[10]); TK_CE(a[11], a[12]); TK_CE(a[13], a[14]); TK_CE(a[0], a[8]); TK_CE(a[4], a[12]); TK_CE(a[4], a[8]); TK_CE(a[2], a[10]); TK_CE(a[6], a[14]); TK_CE(a[6], a[10]); TK_CE(a[2], a[4]); TK_CE(a[6], a[8]); TK_CE(a[10], a[12]); TK_CE(a[1], a[9]); TK_CE(a[5], a[13]); TK_CE(a[5], a[9]); TK_CE(a[3], a[11]); TK_CE(a[7], a[15]); TK_CE(a[7], a[11]); TK_CE(a[3], a[5]); TK_CE(a[7], a[9]); TK_CE(a[11], a[13]); TK_CE(a[1], a[2]); TK_CE(a[3], a[4]); TK_CE(a[5], a[6]); TK_CE(a[7], a[8]); TK_CE(a[9], a[10]); TK_CE(a[11], a[12]); TK_CE(a[13], a[14]);
}
DI void tk_merge16(float (&a)[16], const float (&b)[16]) {
#pragma unroll
    for (int i = 0; i < 16; ++i) a[i] = fmaxf(a[i], b[15 - i]);
#pragma unroll
    for (int j = 8; j > 0; j >>= 1)
#pragma unroll
        for (int i = 0; i < 16; ++i) { const int l = i ^ j; if (l > i) TK_CE(a[i], a[l]); }
}
DI void tk_stage2(const LAS float* la, const LAS float* lb, int* IDX_, float* GATEW_, size_t o) {
        float a[16], bb[16], cnd[64];
#pragma unroll
        for (int q = 0; q < 16; ++q) { a[q] = la[q]; bb[q] = lb[q]; }
        int cnt = 0;
#pragma unroll
        for (int i = 0; i < 16; ++i)
#pragma unroll
            for (int j = 0; j < 16; ++j) if ((i + 1) * (j + 1) <= 16) { cnd[cnt] = __uint_as_float((__float_as_uint(a[i] + bb[j]) & ~0xFFu) | (unsigned)(i * 16 + j)); ++cnt; }
#pragma unroll
        for (int q = 50; q < 64; ++q) cnd[q] = -INFINITY;
        float top[16];
#pragma unroll
        for (int c = 0; c < 4; ++c) { float ch[16];
#pragma unroll
            for (int q = 0; q < 16; ++q) ch[q] = cnd[16 * c + q];
            tk_sort16(ch);
            if (c == 0) {
#pragma unroll
                for (int q = 0; q < 16; ++q) top[q] = ch[q];
            } else tk_merge16(top, ch); }
        float sv[16]; int ei[16]; float mx = -INFINITY;
#pragma unroll
        for (int q = 0; q < 16; ++q) { const unsigned code = __float_as_uint(top[q]) & 0xFFu; const float va = la[code >> 4], vb = lb[code & 15u];
            ei[q] = (int)((__float_as_uint(va) & 0x7Fu) * 128u + (__float_as_uint(vb) & 0x7Fu)); sv[q] = va + vb; mx = fmaxf(mx, sv[q]); }
        float sum = 0.f;
#pragma unroll
        for (int q = 0; q < 16; ++q) { sv[q] = fexp(sv[q] - mx); sum += sv[q]; }
        const float inv = 1.f / sum;
#pragma unroll
#define TK_PK(Q) (((__builtin_bit_cast(unsigned, sv[(Q)] * inv) + 0x2000u) & 0xFFFFC000u) | (unsigned)ei[(Q)])
        for (int q = 0; q < 16; q += 4) *(GAS v4u*)(IDX_ + o + q) = (v4u){TK_PK(q), TK_PK(q + 1), TK_PK(q + 2), TK_PK(q + 3)};
#undef TK_PK
        (void)GATEW_;
    }
struct EpiTopK {
    static constexpr bool PERM = false, AFTER_DRAIN = true;
    int* IDX; float* GATEW;
    DI void fused(f32x4 (&acc)[2][2][4][2], const pg8::Unit& u, int wr, int wc, int fr, int fq, LAS unsigned char* lds, int wid, int lane) const {
        LAS float* Tl = (LAS float*)lds;
        LAS float* Lh2 = (LAS float*)lds;
        LAS float* Ls = (LAS float*)(lds + 36864);
        const int tid = wid * 64 + lane, tl = tid & 127, p = (tid >> 7) & 1, half = tid >> 8;
        float keep[16], fin[16];
#pragma unroll
        for (int q = 0; q < 16; ++q) { keep[q] = 0.f; fin[q] = 0.f; }
#pragma unroll
        for (int ai = 0; ai < 2; ++ai) {
#pragma unroll
            for (int bj = 0; bj < 2; ++bj)
#pragma unroll
                for (int m = 0; m < 4; ++m)
#pragma unroll
                    for (int n = 0; n < 2; ++n) *(LAS f32x4*)(Tl + (wr * 64 + m * 16 + fr) * 260 + bj * 128 + wc * 32 + n * 16 + fq * 4) = acc[ai][bj][m][n];
            __syncthreads();
            float run[16];
            {
                const LAS float* src = Tl + tl * 260 + p * 128 + half * 64;
#pragma unroll
                for (int c = 0; c < 4; ++c) { float ch[16];
#pragma unroll
                    for (int q4 = 0; q4 < 4; ++q4) { const f32x4 sv_ = *(const LAS f32x4*)(src + 16 * c + 4 * q4);
#pragma unroll
                        for (int e = 0; e < 4; ++e) ch[4 * q4 + e] = __uint_as_float((__float_as_uint(sv_[e]) & ~0x7Fu) | (unsigned)(half * 64 + 16 * c + 4 * q4 + e)); }
                    tk_sort16(ch);
                    if (c == 0) {
#pragma unroll
                        for (int q = 0; q < 16; ++q) run[q] = ch[q];
                    } else tk_merge16(run, ch); }
            }
            __syncthreads();
#pragma unroll
            for (int q = 0; q < 16; ++q) Lh2[((tl * 2 + p) * 2 + half) * 17 + q] = run[q];
            __syncthreads();
            if (half == 0) { float oth[16];
#pragma unroll
                for (int q = 0; q < 16; ++q) oth[q] = Lh2[((tl * 2 + p) * 2 + 1) * 17 + q];
                tk_merge16(run, oth);
                if (ai == 0) {
#pragma unroll
                    for (int q = 0; q < 16; ++q) keep[q] = run[q]; }
                else {
#pragma unroll
                    for (int q = 0; q < 16; ++q) fin[q] = run[q]; } }
            __syncthreads();
        }
        if (half == 0) {
#pragma unroll
            for (int q = 0; q < 16; ++q) { Ls[(tl * 2 + p) * 17 + q] = keep[q]; Ls[(256 + tl * 2 + p) * 17 + q] = fin[q]; } }
        __syncthreads();
        if (tid < 256) tk_stage2(Ls + (tid * 2) * 17, Ls + (tid * 2) * 17 + 17, IDX, GATEW, (size_t)(u.pm * 256 + tid) * 128 + u.pn * 16);
        asm volatile("s_waitcnt lgkmcnt(0)" ::: "memory"); __builtin_amdgcn_s_barrier(); asm volatile("" ::: "memory");
    }
};
struct OneUnit {
    pg8::Unit u;
    __device__ __forceinline__ bool next(int i, pg8::Unit& o) const { if (i) return false; o = u; return true; }
    __device__ __forceinline__ void a_ready(const pg8::Unit&) const {}
    __device__ __forceinline__ void done(const pg8::Unit&) const {}
};

DI float gelu_erf(float x) { return 0.5f * x * (1.f + erff(x * 0.7071067811865476f)); }
#define DPP_ADD(v, ctrl, rmask) ((v) + __builtin_bit_cast(float, __builtin_amdgcn_update_dpp(0, __builtin_bit_cast(int, (v)), (ctrl), (rmask), 0xF, false)))
#ifndef PEER_EBL
#define PEER_EBL 9
#endif
constexpr int PEER_EB_LOG = PEER_EBL;
#ifndef PEER_PROBE_MASK
#define PEER_PROBE_MASK 0xFFFF
#endif
typedef float f32x2v __attribute__((ext_vector_type(2)));
DI float gelu_cdf(float v) {
    const float av = fabsf(v), t = __builtin_amdgcn_rcpf(av * 0.2316418882f + 1.0f);
    float q = t * 0.5307027145f - 0.7265760135f; q = q * t + 0.7107068705f; q = q * t - 0.142248368f; q = q * t + 0.127414796f; q = q * t;
    const float m = v * (q * ex2(v * v * -0.72134752044f));
    return v < 0.f ? m : v - m;
}
#define DPP_ADDI(v, ctrl, rmask) ((v) + __builtin_amdgcn_update_dpp(0, (v), (ctrl), (rmask), 0xF, false))
DI void peer_phase(const Frame& F, bool scratch_dst) {
    bf16* const XN_ = WSP(bf16, WS_XN); int* const IDX_ = WSP(int, WS_IDX); float* const GATEW_ = WSP(float, WS_GATE); float* const mod_ = WSP(float, WS_MOD); float* const out_ = (float*)inp(I_OUT); const bf16* const X1B_ = WSP(bf16, WS_X1B);
    const unsigned char* const EU4 = WSP(unsigned char, WS_EXPU); const unsigned char* const EV4 = WSP(unsigned char, WS_EXPV); const float* const SUI_ = WSP(float, WS_SUI);
    const int gw = F.vcu * NWAVES + F.wave, NGW = F.G * NWAVES, lane = F.lane, g = lane >> 3, j = lane & 7;
    LAS unsigned char* wl = F.lds + F.wave * 17408;
    volatile LAS int* Le = (volatile LAS int*)(wl + g * 512); volatile LAS float* Lg = (volatile LAS float*)(wl + 4096 + g * 512); volatile LAS int* Lp = (volatile LAS int*)(wl + 8192 + g * 512);
    volatile LAS int* Lx = (volatile LAS int*)(wl + 12288 + g * 512); LAS int* Lh = (LAS int*)(wl + 16384 + g * 128);
#ifdef PEER_STAGGER
    if (F.wave & 1) { for (int i_ = 0; i_ < PEER_STAGGER; ++i_) __builtin_amdgcn_s_sleep(127); }
#endif
    for (int grp = gw; grp < T / 8; grp += NGW) {
        const size_t t = (size_t)grp * 8 + g;
        int xh[16], xl[16]; float sxi;
#ifdef PEER_DUP_S
        auto qs_ = [&]() __attribute__((always_inline)) {
#endif
        {
            const unsigned char* xq = WSP(unsigned char, WS_XQ) + t * 1024 + 16 * j;
#pragma unroll
            for (int q = 0; q < 4; ++q) { const v4u a = *(const GAS v4u*)(xq + 128 * q), b = *(const GAS v4u*)(xq + 512 + 128 * q);
#pragma unroll
                for (int w_ = 0; w_ < 4; ++w_) { xh[4 * q + w_] = (int)a[w_]; xl[4 * q + w_] = (int)b[w_]; } }
            sxi = WSP(float, WS_XS)[t];
        }
        {
            int ide[16]; float gte[16]; int rk[16];
#pragma unroll
            for (int m = 0; m < 16; ++m) { const unsigned pk_ = (unsigned)IDX_[t * 128 + j + 8 * m]; ide[m] = (int)(pk_ & 0x3FFFu); gte[m] = __builtin_bit_cast(float, pk_ & 0xFFFFC000u); }
#pragma unroll
            for (int m = 0; m < 4; ++m) Lh[j + 8 * m] = 0;
#pragma unroll
            for (int m = 0; m < 16; ++m) rk[m] = __hip_atomic_fetch_add(Lh + (ide[m] >> PEER_EB_LOG), 1, __ATOMIC_RELAXED, __HIP_MEMORY_SCOPE_WORKGROUP);
            {
                const int h0 = ((volatile LAS int*)Lh)[4 * j], h1 = ((volatile LAS int*)Lh)[4 * j + 1], h2 = ((volatile LAS int*)Lh)[4 * j + 2], h3 = ((volatile LAS int*)Lh)[4 * j + 3];
                const int tot = (h0 + h1) + (h2 + h3); int inc = tot;
#pragma unroll
                for (int o = 1; o < 8; o <<= 1) { const int tt = __shfl_up(inc, o, 8); if (j >= o) inc += tt; }
                const int ex = inc - tot;
                ((volatile LAS int*)Lh)[4 * j] = ex; ((volatile LAS int*)Lh)[4 * j + 1] = ex + h0; ((volatile LAS int*)Lh)[4 * j + 2] = ex + h0 + h1; ((volatile LAS int*)Lh)[4 * j + 3] = ex + h0 + h1 + h2;
            }
#pragma unroll
            for (int m = 0; m < 16; ++m) { const int pos = ((volatile LAS int*)Lh)[ide[m] >> PEER_EB_LOG] + rk[m]; const f32x2v sc_ = *(const GAS f32x2v*)(SUI_ + 2 * ide[m]); Le[pos] = ide[m]; Lg[pos] = gte[m] * sc_.y; Lp[pos] = __builtin_bit_cast(int, sc_.x * sxi); }
        }
#ifdef PEER_DUP_S
        }; qs_(); __builtin_amdgcn_sched_barrier(0); qs_();
#endif
        v4u R0[4], R1[4], R2[4], R3[4];
#define PEER_LOADU(RR, S0) do { const size_t ro_ = (size_t)(Le[(S0)] & (scratch_dst ? PEER_PROBE_MASK : 0xFFFF)) * 512 + 16 * j; _Pragma("unroll") for (int q = 0; q < 4; ++q) RR[q] = *(const GAS v4u*)(EU4 + ro_ + 128 * q); } while (0)
#define PEER_DOTU(RR, EOUT) do { int h0_ = 0, h1_ = 0, l0_ = 0, l1_ = 0; \
            _Pragma("unroll") for (int q = 0; q < 4; q += 2) _Pragma("unroll") for (int w_ = 0; w_ < 4; ++w_) { \
                h0_ = __builtin_amdgcn_sdot8((int)RR[q][w_], xh[4 * q + w_], h0_, false); l0_ = __builtin_amdgcn_sdot8((int)RR[q][w_], xl[4 * q + w_], l0_, false); \
                h1_ = __builtin_amdgcn_sdot8((int)RR[q + 1][w_], xh[4 * q + 4 + w_], h1_, false); l1_ = __builtin_amdgcn_sdot8((int)RR[q + 1][w_], xl[4 * q + 4 + w_], l1_, false); } \
            int e_ = ((h0_ + h1_) << 4) + (l0_ + l1_); e_ = DPP_ADDI(e_, 0xB1, 0xF); e_ = DPP_ADDI(e_, 0x4E, 0xF); e_ = DPP_ADDI(e_, 0x141, 0xF); EOUT = e_; } while (0)
#define PEER_SWEEPU(BODY0, BODY1, BODY2, BODY3) do { \
            PEER_LOADU(R0, 0); PEER_LOADU(R1, 1); PEER_LOADU(R2, 2); PEER_LOADU(R3, 3); \
            for (int s = 0; s < 128; s += 4) { \
                BODY0; if (s + 4 < 128) PEER_LOADU(R0, s + 4); \
                BODY1; if (s + 4 < 128) PEER_LOADU(R1, s + 5); \
                BODY2; if (s + 4 < 128) PEER_LOADU(R2, s + 6); \
                BODY3; if (s + 4 < 128) PEER_LOADU(R3, s + 7); } } while (0)
        if ((T / 8) % NGW == 0) __builtin_amdgcn_s_barrier();
#define PEER_FIN(RR, SS) do { int e1_; PEER_DOTU(RR, e1_); Lx[(SS)] = e1_; } while (0)
        PEER_SWEEPU(PEER_FIN(R0, s), PEER_FIN(R1, s + 1), PEER_FIN(R2, s + 2), PEER_FIN(R3, s + 3));
#ifdef PEER_DUP_U
        PEER_SWEEPU(PEER_FIN(R0, s), PEER_FIN(R1, s + 1), PEER_FIN(R2, s + 2), PEER_FIN(R3, s + 3));
#endif
#undef PEER_FIN
        v4u RV[8][2];
#define PEER_RVFILL(HC) do { _Pragma("unroll") for (int r = 0; r < 8; ++r) { const unsigned ro_ = (unsigned)(Le[r] & (scratch_dst ? PEER_PROBE_MASK : 0xFFFF)) * 512u + (unsigned)(256 * (HC) + 16 * j); \
            RV[r][0] = *(const GAS v4u*)(EV4 + ro_); RV[r][1] = *(const GAS v4u*)(EV4 + ro_ + 128); } } while (0)
        PEER_RVFILL(0);
        float yscale; int csum8;
        {
            float cf_[16]; float cmax = 0.f;
#pragma unroll
            for (int i = 0; i < 16; ++i) { const int ix = 16 * j + i; cf_[i] = Lg[ix] * gelu_cdf((float)Lx[ix] * __builtin_bit_cast(float, Lp[ix])); cmax = fmaxf(cmax, fabsf(cf_[i])); }
            cmax = fmaxf(cmax, __shfl_xor(cmax, 1, 8)); cmax = fmaxf(cmax, __shfl_xor(cmax, 2, 8)); cmax = fmaxf(cmax, __shfl_xor(cmax, 4, 8));
            const float cqs = cmax > 0.f ? 127.f / cmax : 0.f; yscale = cmax > 0.f ? cmax / 127.f : 0.f;
            int pk_[4]; int cs_ = 0;
#pragma unroll
            for (int m = 0; m < 4; ++m) { const int q0 = (int)rintf(cf_[4 * m] * cqs), q1 = (int)rintf(cf_[4 * m + 1] * cqs), q2 = (int)rintf(cf_[4 * m + 2] * cqs), q3 = (int)rintf(cf_[4 * m + 3] * cqs);
                cs_ += (q0 + q1) + (q2 + q3);
                pk_[m] = (int)((unsigned)(q0 & 0xff) | ((unsigned)(q1 & 0xff) << 8) | ((unsigned)(q2 & 0xff) << 16) | ((unsigned)q3 << 24)); }
            cs_ += __shfl_xor(cs_, 1, 8); cs_ += __shfl_xor(cs_, 2, 8); cs_ += __shfl_xor(cs_, 4, 8); csum8 = 8 * cs_;
#pragma unroll
            for (int m = 0; m < 4; ++m) Lp[4 * j + m] = pk_[m];
        }
        {
            const float* g2row = mod_ + (int)(t / SEQ) * NMOD + 5120 + 16 * lane;
            LAS float* LG2w = (LAS float*)(wl + 4096) + 16 * lane;
#pragma unroll
            for (int i = 0; i < 4; ++i) { const f32x4 gv_ = *(const f32x4*)(g2row + 4 * i); *(LAS f32x4*)(LG2w + 4 * i) = gv_; }
        }
#ifndef PEER_DUP_V
#define PEER_DUP_V 1
#endif
#pragma unroll
        for (int HH = 0; HH < 2 * PEER_DUP_V; ++HH) { const int H = HH & 1;
            if ((T / 8) % NGW == 0) __builtin_amdgcn_s_barrier();
            int ya[32], yl[32];
#pragma unroll
            for (int i = 0; i < 32; ++i) { ya[i] = 0; yl[i] = 0; }
#define PEER_ROFFV(S0) ((unsigned)(Le[(S0)] & (scratch_dst ? PEER_PROBE_MASK : 0xFFFF)) * 512u + (unsigned)(256 * H + 16 * j))
            const unsigned tchx_ = *(const GAS unsigned*)(X1B_ + t * D + 256 * (j >> 1) + 128 * H + 64 * (j & 1));
            for (int bt = 0; bt < 16; ++bt) {
                const int c0_ = Lp[2 * bt], c1_ = Lp[2 * bt + 1];
                unsigned ron[8];
#pragma unroll
                for (int r = 0; r < 8; ++r) ron[r] = (bt + 1 < 16) ? PEER_ROFFV(8 * bt + 8 + r) : 0u;
#pragma unroll
                for (int q = 0; q < 2; ++q) {
#pragma unroll
                    for (int hb = 0; hb < 2; ++hb) { const int cq_ = hb ? c1_ : c0_;
#pragma unroll
                        for (int w_ = 0; w_ < 4; ++w_) { const unsigned a0 = RV[4 * hb][q][w_], a1 = RV[4 * hb + 1][q][w_], a2 = RV[4 * hb + 2][q][w_], a3 = RV[4 * hb + 3][q][w_];
                            const unsigned p0 = __builtin_amdgcn_perm(a1, a0, 0x05010400u), p1 = __builtin_amdgcn_perm(a1, a0, 0x07030602u), p2 = __builtin_amdgcn_perm(a3, a2, 0x05010400u), p3 = __builtin_amdgcn_perm(a3, a2, 0x07030602u);
                            unsigned Tb[4]; Tb[0] = __builtin_amdgcn_perm(p2, p0, 0x05040100u); Tb[1] = __builtin_amdgcn_perm(p2, p0, 0x07060302u); Tb[2] = __builtin_amdgcn_perm(p3, p1, 0x05040100u); Tb[3] = __builtin_amdgcn_perm(p3, p1, 0x07060302u);
#pragma unroll
                            for (int b_ = 0; b_ < 4; ++b_) { ya[16 * q + 4 * w_ + b_] = __builtin_amdgcn_sdot4((int)Tb[b_], cq_, ya[16 * q + 4 * w_ + b_], false);
                                yl[16 * q + 4 * w_ + b_] = __builtin_amdgcn_sdot4((int)(Tb[b_] & 0x0F0F0F0Fu), cq_, yl[16 * q + 4 * w_ + b_], false); } } }
                    if (bt + 1 < 16) {
#pragma unroll
                        for (int r = 0; r < 8; ++r) RV[r][q] = *(const GAS v4u*)(EV4 + ron[r] + 128 * q); }
                }
            }
#undef PEER_ROFFV
            if (HH + 1 < 2 * PEER_DUP_V) PEER_RVFILL((HH + 1) & 1);
            asm volatile("" :: "v"(tchx_));
            int to_ = grp * 8 + g, jo_ = j; asm volatile("" : "+v"(to_), "+v"(jo_));
            const int b = to_ / SEQ; const unsigned eo_ = (unsigned)to_ * D + 128 * H + 8 * jo_;
            const LAS float* g2 = (const LAS float*)(wl + 4096) + 128 * H + 8 * jo_; (void)b;
            const bf16* ip = X1B_ + eo_; float* op = ((scratch_dst || HH + 2 < 2 * PEER_DUP_V) ? WSP(float, WS_SCORES) : out_) + eo_;
#pragma unroll
            for (int q = 0; q < 2; ++q) { __builtin_amdgcn_sched_barrier(0);
#pragma unroll
                for (int w_ = 0; w_ < 4; ++w_)
#pragma unroll
                    for (int nh = 0; nh < 2; ++nh) { const int co = 256 * (2 * (w_ & 1) + nh) + 64 * q + 4 * (w_ >> 1); const int yb = 16 * q + 4 * w_ + 2 * nh;
                        const unsigned long long xw_ = *(const GAS unsigned long long*)(ip + co); const unsigned xlo_ = (unsigned)xw_, xhi_ = (unsigned)(xw_ >> 32); const f32x4 x1 = (f32x4){bflo(xlo_), bfhi(xlo_), bflo(xhi_), bfhi(xhi_)}; const f32x4 gg = *(const LAS f32x4*)(g2 + co) * yscale;
                        f32x4 o; o.x = x1.x + gg.x * (float)(yl[yb] - csum8); o.y = x1.y + gg.y * (float)((ya[yb] - yl[yb]) >> 4); o.z = x1.z + gg.z * (float)(yl[yb + 1] - csum8); o.w = x1.w + gg.w * (float)((ya[yb + 1] - yl[yb + 1]) >> 4);
                        *(GAS f32x4*)(op + co) = o; } }
        }
#undef PEER_LOADU
#undef PEER_DOTU
#undef PEER_SWEEPU
    }
}

DI void ph_inproj(const Frame& F) {
    pg8::Gemm g{WSP(bf16, WS_XN), WSP(bf16, WS_WIN), T, NPROJ, D}; pg8::StaticOrder S; S.init(T, NPROJ, F.G, (int)blockIdx.x);
    pg8::EpiBf16<0> E{WSP(bf16, WS_PROJ), NPROJ, nullptr, 0, 0, 1.f};
    pg8::gemm_phase<pg8::EpiBf16<0>, pg8::StaticOrder, PG8_ALIGN, PG8_SP2>(F.lds, g, S, E);
}
DI void ph_mix(const Frame& F, bool probe_first) {
    stage_conv_w(F);
    {
        int u = F.vcu;
        MlLocalRegs ra;
        if (u < 2048) ml_local_load(F, u >> 6, u & 63, ra);
        const int gwv = F.vcu * NWAVES + F.wave, NGWv = F.G * NWAVES;
        int eb = 2 * gwv;
        while (u < 2048 && eb < 16384) {
            const int un = u + F.G, unc = un < 2048 ? un : u;
            MlLocalRegs rb; ml_local_load(F, unc >> 6, unc & 63, rb);
            ExpRows2 er; exp_load2(F, eb, er);
            ml_local_unit(F, u >> 6, u & 63, ra);
            exp_conv2(F, eb, er);
            eb += 2 * NGWv;
            ra = rb; u = un;
        }
        while (u < 2048) {
            const int un = u + F.G, unc = un < 2048 ? un : u;
            MlLocalRegs rb; ml_local_load(F, unc >> 6, unc & 63, rb);
            ml_local_unit(F, u >> 6, u & 63, ra);
            ra = rb; u = un;
        }
        for (; eb < 16384; eb += 2 * NGWv) { ExpRows2 er; exp_load2(F, eb, er); exp_conv2(F, eb, er); }
    }
    (void)probe_first;
}
DI void ph_scan_attn(const Frame& F) {
    ml_scan_phase(F);
    __syncthreads();
    const int gwv = F.vcu * NWAVES + F.wave, NGWv = F.G * NWAVES;
    int eb = 16384 + 2 * gwv;
    for (int u = F.vcu; u < 1024; u += F.G) { const int qb = 15 - (u >> 6), bh = u & 63;
        ExpRows2 er; const bool ew = eb < 32768;
        if (ew) exp_load2(F, eb, er);
        sb_unit(F, bh >> 3, bh & 7, qb);
        if (ew) exp_conv2(F, eb, er);
        eb += 2 * NGWv; }
    for (; eb < 32768; eb += 2 * NGWv) { ExpRows2 er; exp_load2(F, eb, er); exp_conv2(F, eb, er); }
}
#ifndef P4_TOUCH
#define P4_TOUCH 0
#endif
DI void ph_mlout(const Frame& F) { stage_conv_w(F); for (int u = F.vcu; u < 2048; u += F.G) { const int un = u + F.G; ml_out_unit(F, u >> 6, u & 63, (P4_TOUCH && un < 2048) ? (un >> 6) : -1, un & 63); } }
#ifndef P5_ALIGN
#define P5_ALIGN PG8_ALIGN
#endif
DI void ph_outproj(const Frame& F) {
    pg8::Gemm g{WSP(bf16, WS_MIX), WSP(bf16, WS_WOUT), T, D, D}; pg8::StaticOrder S; S.init(T, D, F.G, (int)blockIdx.x);
    pg8::EpiResGateBf16 E{inp(I_X), WSP(pg8::bf16_t, WS_X1B), WSP(float, WS_MOD) + 2048, NMOD, SEQ, D};
    pg8::gemm_phase<pg8::EpiResGateBf16, pg8::StaticOrder, P5_ALIGN, PG8_SP2>(F.lds, g, S, E);
}
DI void ph_scores(const Frame& F) {
    pg8::Gemm g{WSP(bf16, WS_XN), WSP(bf16, WS_WEFF), T, NSC, D}; pg8::StaticOrder S; S.init(T, NSC, F.G, (int)blockIdx.x);
    EpiTopK E{WSP(int, WS_IDX), WSP(float, WS_GATE)};
    pg8::Unit un;
    for (int i = 0; S.next(i, un); ++i) { OneUnit S1{un}; pg8::gemm_phase<EpiTopK, OneUnit, false, PG8_SP2>(F.lds, g, S1, E); }
}
constexpr int N_PHASES = 11;
struct Args { const float* in[19]; float* out; unsigned char* ws; int ph_lo, ph_hi; };
__global__ void __launch_bounds__(NTHR, 2) hybrid_fwd(Args args) {
    extern __shared__ __attribute__((aligned(16))) unsigned char lds_raw[];
    Frame F;
    F.lds = (LAS unsigned char*)lds_raw;
    F.MISC = (volatile LAS unsigned*)(F.lds + LDSCTL_OFF + 320);
    F.tid = threadIdx.x; F.lane = F.tid & 63; F.wave = __builtin_amdgcn_readfirstlane(F.tid >> 6);
    F.G = gridDim.x; { const int bx = blockIdx.x; F.vcu = (F.G % 8 == 0) ? (bx % 8) * (F.G / 8) + bx / 8 : bx; }
    F.ws = args.ws;
    F.ctl = (gu32*)(F.ws + WS_CTL);
    for (int u = F.tid; u < (LDS_BYTES - LDSCTL_OFF) / 4; u += NTHR) ((LAS unsigned*)(F.lds + LDSCTL_OFF))[u] = 0u;
    __syncthreads();
    const int lo = args.ph_lo, hi = args.ph_hi;
    const bool one_launch = (hi - lo) > 1;
    XcdBarrier bar; bar.bar = (unsigned*)(F.ctl + CW_BAR); bar.x = 0; bar.st = nullptr;
    if (one_launch) bar = xcd_barrier_post((unsigned*)(F.ctl + CW_BAR), F.MISC + 8);
#ifndef PHMASK
#define PHMASK 0x7ff
#endif
#define IN(k) (((PHMASK >> (k)) & 1) && lo <= (k) && (k) < hi)
#define SEAM(k) do { if (IN(k) && IN((k) + 1)) xcd_barrier(bar); } while (0)
#ifndef REPMASK
#define REPMASK 0
#endif

#define RUN(k, ...) do { if (IN(k)) { if ((REPMASK >> (k)) & 1) { { const bool first = true; (void)first; __VA_ARGS__; } xcd_barrier(bar); } { const bool first = false; (void)first; __VA_ARGS__; } } } while (0)
    RUN(0, p0_phase(F, first ? P0_PARTS : 15)); SEAM(0);
    RUN(1, norm_phase<true>(F, inp(I_X), inp(I_GN1), 0, 1024)); SEAM(1);
    RUN(2, ph_inproj(F)); SEAM(2);
    RUN(3, ph_mix(F, first)); SEAM(3);
    RUN(10, ph_scan_attn(F)); if (IN(10) && IN(4)) xcd_barrier(bar);
    RUN(4, ph_mlout(F)); SEAM(4);
    RUN(5, ph_outproj(F)); SEAM(5);
    RUN(6, norm_phase<false, true>(F, (const float*)WSP(bf16, WS_X1B), inp(I_GN2), 3072, 4096)); SEAM(6);
    RUN(7, ph_scores(F)); if (IN(7) && IN(9)) xcd_barrier(bar);
    RUN(9, peer_phase(F, first));
#undef RUN
#undef IN
#undef SEAM
}

#ifndef MK_PER_PHASE
#define MK_PER_PHASE 0
#endif
extern "C" void kernel_launch(void* const* d_in, const int* in_sizes, int n_in, void* d_out, int out_size, void* d_ws, size_t ws_size, hipStream_t stream) {
    static int grid = 0;
    if (grid == 0) {
        if (n_in != 19 || in_sizes[0] != T * D || out_size != T * D || ws_size < WS_END) { fprintf(stderr, "kernel_launch: unexpected shapes (n_in %d, in0 %d, out %d, ws %zu)\n", n_in, n_in > 0 ? in_sizes[0] : -1, out_size, ws_size); grid = -1; return; }
        int dev = 0, cus = 0, per_cu = 0;
        if (hipGetDevice(&dev) != hipSuccess || hipDeviceGetAttribute(&cus, hipDeviceAttributeMultiprocessorCount, dev) != hipSuccess) { grid = -1; return; }
        if (hipFuncSetAttribute((const void*)hybrid_fwd, hipFuncAttributeMaxDynamicSharedMemorySize, LDS_BYTES) != hipSuccess) { fprintf(stderr, "kernel_launch: hipFuncSetAttribute failed\n"); grid = -1; return; }
        if (hipOccupancyMaxActiveBlocksPerMultiprocessor(&per_cu, (const void*)hybrid_fwd, NTHR, LDS_BYTES) != hipSuccess || per_cu < 1) fprintf(stderr, "kernel_launch: occupancy query says %d\n", per_cu);
        (void)hipGetLastError();
        grid = cus;
    }
    if (grid < 0) return;
    if (hipMemsetAsync((char*)d_ws + WS_CTL, 0, CTL_ZERO_BYTES, stream) != hipSuccess) { fprintf(stderr, "kernel_launch: memset failed\n"); return; }
    Args a{};
    for (int i = 0; i < 19; ++i) a.in[i] = (const float*)d_in[i];
    a.out = (float*)d_out; a.ws = (unsigned char*)d_ws;
#if MK_PER_PHASE
    { const int order[N_PHASES] = {0, 1, 2, 3, 10, 4, 5, 6, 7, 8, 9}; for (int i = 0; i < N_PHASES; ++i) { a.ph_lo = order[i]; a.ph_hi = order[i] + 1; hipLaunchKernelGGL(hybrid_fwd, dim3(grid), dim3(NTHR), LDS_BYTES, stream, a); } }
#else
    a.ph_lo = 0; a.ph_hi = N_PHASES;
    hipLaunchKernelGGL(hybrid_fwd, dim3(grid), dim3(NTHR), LDS_BYTES, stream, a);
#endif
    const hipError_t le = hipPeekAtLastError();
    if (le != hipSuccess) fprintf(stderr, "kernel_launch: launch failed: %s\n", hipGetErrorName(le));
}
```
